# Optimizing an MI355X kernel written in HIP

```python
import jax, jax.numpy as jnp
from jax import lax
import numpy as np

D_MODEL = 2048
BATCH = 2
SEQ = 4096
DEPTH = 2
DEC_BATCH = 8
DEC_SEQ = 8
PAST_LEN = 16384
PAGE_SIZE = 128

D_A = D_MODEL // 2
DH_A = 128
H_A = D_A // DH_A
D_B = D_MODEL - D_A
DH_B = 64
H_B = D_B // DH_B
LORA_W = 96
LORA_A = 96
LORA_G = 256
B_COLS = 3 * D_B + LORA_W + LORA_A + LORA_G
SPLIT_B = [D_B, 2 * D_B, 3 * D_B, 3 * D_B + LORA_W, 3 * D_B + LORA_W + LORA_A]
IN_COLS = 3 * D_A + B_COLS
POOL_WINDOWS = (2, 4, 8, 16)
N_POOL_GROUPS = len(POOL_WINDOWS)
G_POOL = D_MODEL // N_POOL_GROUPS
POOL_BUF = max(POOL_WINDOWS) - 1
D_FF = 4 * D_MODEL
N_AB = (DEPTH + 1) // 2
N_C = DEPTH // 2
Q_BLOCK = 128
EPS_RMS = 1e-6
EPS_LNX = 64e-5

kernel_name = 'hybrid_stickbreak_rwkv7_pool_decoder_step'


def rms_norm(x, g):
    xf = x.astype(jnp.float32)
    y = xf * lax.rsqrt(jnp.mean(xf * xf, axis=-1, keepdims=True) + EPS_RMS)
    return (y * g.astype(jnp.float32)).astype(x.dtype)


def adaln(c, w_ada, b_ada):
    mod = jax.nn.silu(c) @ w_ada + b_ada
    return jnp.split(mod[:, None, :], 6, axis=-1)


def modulate(x, g, shift, scale):
    return rms_norm(x, g) * (1 + scale) + shift


def stick_breaking(q, q_pos, k, v, k_pos, bias):
    z = (jnp.einsum('bqhd,bkhd->bhqk', q, k).astype(jnp.float32) * (DH_A ** -0.5)
         + bias.astype(jnp.float32)[None, :, None, None])
    mask = k_pos[None, :] < q_pos[:, None]
    neg = jnp.where(mask, jax.nn.log_sigmoid(-z), 0.0)
    after = lax.cumsum(neg, axis=3, reverse=True) - neg
    w = jnp.where(mask, jnp.exp(jax.nn.log_sigmoid(z) + after), 0.0)
    return jnp.einsum('bhqk,bkhd->bqhd', w.astype(v.dtype), v)


def stick_breaking_prompt(q, k, v, bias):
    Bt, S = q.shape[:2]
    nb = S // Q_BLOCK
    pos = jnp.arange(S, dtype=jnp.int32)
    qb = q.reshape(Bt, nb, Q_BLOCK, H_A, DH_A).transpose(1, 0, 2, 3, 4)
    qpos = pos.reshape(nb, Q_BLOCK)
    out = lax.map(lambda blk: stick_breaking(blk[0], blk[1], k, v, pos, bias), (qb, qpos))
    return out.transpose(1, 0, 2, 3, 4).reshape(Bt, S, H_A, DH_A)


def make_attend(past, bias):
    if past is None:
        return lambda q, k, v: stick_breaking_prompt(q, k, v, bias)
    k_past, v_past = past

    def attend(q, k, v):
        n_past, T = k_past.shape[1], q.shape[1]
        kf = jnp.concatenate([k_past, k], axis=1)
        vf = jnp.concatenate([v_past, v], axis=1)
        q_pos = n_past + jnp.arange(T, dtype=jnp.int32)
        k_pos = jnp.arange(n_past + T, dtype=jnp.int32)
        return stick_breaking(q, q_pos, kf, vf, k_pos, bias)
    return attend


def rwkv7_scan(r, decay, k, v, kk, a, s0):
    def step(S, inp):
        r_t, w_t, k_t, v_t, kk_t, a_t = inp
        sa = jnp.einsum('bhvk,bhk->bhv', S, -kk_t)
        S = (S * w_t[:, :, None, :] + sa[..., None] * (kk_t * a_t)[:, :, None, :]
             + v_t[..., None] * k_t[:, :, None, :])
        return S, jnp.einsum('bhvk,bhk->bhv', S, r_t)
    xs = tuple(jnp.swapaxes(t, 0, 1) for t in (r, decay, k, v, kk, a))
    S, y = lax.scan(step, s0, xs)
    return jnp.swapaxes(y, 0, 1), S


def rwkv7_branch(pb, pb_prev, s0, W, i):
    Bt, T, _ = pb.shape
    f32 = jnp.float32
    heads = lambda t: t.reshape(Bt, T, H_B, DH_B)
    z = pb + W['mu_shift'][i] * (jnp.concatenate([pb_prev, pb[:, :-1]], axis=1) - pb)
    zr, zk, zv, zw, za, zg = jnp.split(z, SPLIT_B, axis=-1)
    w_log = -jax.nn.softplus(-(W['w0'][i] + jnp.tanh(zw) @ W['w_up'][i])) - 0.5
    decay = jnp.exp(-jnp.exp(w_log.astype(f32)))
    a = jax.nn.sigmoid(W['a0'][i] + za @ W['a_up'][i])
    g = jax.nn.sigmoid(zg) @ W['g_up'][i]
    kk = heads((zk * W['k_k'][i]).astype(f32))
    kk = kk * lax.rsqrt(jnp.sum(kk * kk, axis=-1, keepdims=True) + 1e-12)
    k = zk * (1 + (a - 1) * W['k_a'][i])
    r4, k4, v4, a4 = [heads(t.astype(f32)) for t in (zr, k, zv, a)]
    y, s_new = rwkv7_scan(r4, heads(decay), k4, v4, kk, a4, s0.astype(f32))
    mean = jnp.mean(y, axis=-1, keepdims=True)
    var = jnp.mean(jnp.square(y - mean), axis=-1, keepdims=True)
    y = ((y - mean) * lax.rsqrt(var + EPS_LNX)).reshape(Bt, T, D_B) * W['lnx_g'][i] + W['lnx_b'][i]
    bonus = jnp.sum(r4 * k4 * W['r_k'][i], axis=-1, keepdims=True) * v4
    y = y + bonus.reshape(Bt, T, D_B)
    return (y * g).astype(pb.dtype), s_new


def ab_mixer(h, attend, shift_prev, s0, W, i):
    Bt, T, _ = h.shape
    p = h @ W['w_in'][i]
    q = p[..., :D_A].reshape(Bt, T, H_A, DH_A)
    k = p[..., D_A:2 * D_A].reshape(Bt, T, H_A, DH_A)
    v = p[..., 2 * D_A:3 * D_A].reshape(Bt, T, H_A, DH_A)
    o_a = attend(q, k, v).reshape(Bt, T, D_A)
    pb = p[..., 3 * D_A:]
    o_b, s_new = rwkv7_branch(pb, shift_prev[:, None, :], s0, W, i)
    out = jnp.concatenate([o_a, o_b.astype(o_a.dtype)], axis=-1) @ W['w_out'][i]
    return out, k, v, pb[:, -1], s_new


def pool_mixer(ext, n_prev, pos0, w_pool, pool_scale):
    Bt, L, _ = ext.shape
    T = L - n_prev
    xf = ext.astype(jnp.float32)
    csum = jnp.concatenate([jnp.zeros_like(xf[:, :1]), jnp.cumsum(xf, axis=1)], axis=1)
    t_ext = jnp.arange(n_prev, L, dtype=jnp.int32)
    pos = pos0 + jnp.arange(T, dtype=jnp.int32)
    cur = xf[:, n_prev:]
    groups = []
    for gi, wlen in enumerate(POOL_WINDOWS):
        sl = slice(gi * G_POOL, (gi + 1) * G_POOL)
        lo = jnp.maximum(t_ext + 1 - wlen, 0)
        win = csum[:, t_ext + 1, sl] - csum[:, lo, sl]
        cnt = jnp.minimum(wlen, pos + 1).astype(jnp.float32)
        groups.append(win / cnt[None, :, None] - cur[..., sl])
    m = jnp.stack(groups, axis=2)
    y = jnp.einsum('btgc,gcd->btgd', m, w_pool.astype(jnp.float32)).reshape(Bt, T, D_MODEL)
    return (y * pool_scale).astype(ext.dtype)


def mlp(h, w1, w2):
    return jnp.square(jax.nn.relu(h @ w1)) @ w2


def trunk(x, c, pos0, past_kv, shift0, wkv0, pool0, W):
    ks, vs, wkvs, shifts, pools = [], [], [], [], []
    for l in range(DEPTH):
        mod = adaln(c, W['w_ada'][l], W['b_ada'][l])
        g = W['norm_g'][l]
        h = modulate(x, g[0], mod[0], mod[1])
        if l % 2 == 0:
            i = l // 2
            attend = make_attend(None if past_kv is None else past_kv[i], W['sb_bias'][i])
            out, k_new, v_new, sh, s_new = ab_mixer(h, attend, shift0[i], wkv0[i], W, i)
            ks.append(k_new)
            vs.append(v_new)
            shifts.append(sh)
            wkvs.append(s_new)
        else:
            j = l // 2
            ext = jnp.concatenate([pool0[j].astype(h.dtype), h], axis=1)
            out = pool_mixer(ext, pool0[j].shape[1], pos0, W['w_pool'][j], W['pool_scale'][j])
            pools.append(ext[:, -POOL_BUF:])
        x = x + mod[2] * rms_norm(out, g[1])
        h = modulate(x, g[2], mod[3], mod[4])
        x = x + mod[5] * rms_norm(mlp(h, W['w_mlp1'][l], W['w_mlp2'][l]), g[3])
    return (x, jnp.stack(ks, axis=1), jnp.stack(vs, axis=1), jnp.stack(wkvs, axis=0),
            jnp.stack(shifts, axis=0), jnp.stack(pools, axis=0))


def setup_inputs(seed: int = 0) -> dict:
    key = jax.random.key(seed)
    keys = iter(jax.random.split(key, 48))
    f32 = jnp.float32
    nrm = lambda shape, s: jax.random.normal(next(keys), shape, f32) * s
    n_pages = PAST_LEN // PAGE_SIZE
    n_used = DEC_BATCH * n_pages
    n_pool = n_used + (n_used + 3) // 4
    perm = jax.random.permutation(next(keys), n_pool)
    page_table = perm[:n_used].reshape(DEC_BATCH, n_pages).astype(jnp.int32)
    return {
        'x_prompt': nrm((BATCH, SEQ, D_MODEL), 1.0),
        'x_sample': nrm((DEC_BATCH, DEC_SEQ, D_MODEL), 1.0),
        'cache_k': nrm((n_pool, N_AB, PAGE_SIZE, H_A, DH_A), 1.0),
        'cache_v': nrm((n_pool, N_AB, PAGE_SIZE, H_A, DH_A), 1.0),
        'page_table': page_table,
        'state_wkv': nrm((N_AB, DEC_BATCH, H_B, DH_B, DH_B), 1.0),
        'state_shift': nrm((N_AB, DEC_BATCH, B_COLS), 1.0),
        'state_pool': nrm((N_C, DEC_BATCH, POOL_BUF, D_MODEL), 1.0),
        'c_prompt': nrm((BATCH, D_MODEL), 1.0),
        'c_sample': nrm((DEC_BATCH, D_MODEL), 1.0),
        'w_ada': nrm((DEPTH, D_MODEL, 6 * D_MODEL), 0.5 * D_MODEL ** -0.5),
        'b_ada': nrm((DEPTH, 6 * D_MODEL), 0.01),
        'norm_g': 1.0 + nrm((DEPTH, 4, D_MODEL), 0.05),
        'w_in': nrm((N_AB, D_MODEL, IN_COLS), D_MODEL ** -0.5),
        'w_out': nrm((N_AB, D_MODEL, D_MODEL), D_MODEL ** -0.5),
        'sb_bias': -6.0 + nrm((N_AB, H_A), 0.5),
        'mu_shift': jax.random.uniform(next(keys), (N_AB, B_COLS), f32),
        'w0': -1.0 + nrm((N_AB, D_B), 0.5),
        'w_up': nrm((N_AB, LORA_W, D_B), 0.1 * LORA_W ** -0.5),
        'a0': nrm((N_AB, D_B), 0.1),
        'a_up': nrm((N_AB, LORA_A, D_B), 0.1 * LORA_A ** -0.5),
        'g_up': nrm((N_AB, LORA_G, D_B), LORA_G ** -0.5),
        'k_k': 0.85 + nrm((N_AB, D_B), 0.05),
        'k_a': 1.0 + nrm((N_AB, D_B), 0.05),
        'r_k': nrm((N_AB, H_B, DH_B), 0.1),
        'lnx_g': 1.0 + nrm((N_AB, D_B), 0.05),
        'lnx_b': nrm((N_AB, D_B), 0.01),
        'w_pool': nrm((N_C, N_POOL_GROUPS, G_POOL, G_POOL), G_POOL ** -0.5),
        'pool_scale': 1.0 + nrm((N_C, D_MODEL), 0.1),
        'w_mlp1': nrm((DEPTH, D_MODEL, D_FF), D_MODEL ** -0.5),
        'w_mlp2': nrm((DEPTH, D_FF, D_MODEL), D_FF ** -0.5),
    }


def reference(x_prompt, x_sample, cache_k, cache_v, page_table, state_wkv, state_shift, state_pool,
              c_prompt, c_sample, w_ada, b_ada, norm_g, w_in, w_out, sb_bias, mu_shift, w0, w_up, a0,
              a_up, g_up, k_k, k_a, r_k, lnx_g, lnx_b, w_pool, pool_scale, w_mlp1, w_mlp2):
    W = {'w_ada': w_ada, 'b_ada': b_ada, 'norm_g': norm_g, 'w_in': w_in, 'w_out': w_out,
         'sb_bias': sb_bias, 'mu_shift': mu_shift, 'w0': w0, 'w_up': w_up, 'a0': a0, 'a_up': a_up,
         'g_up': g_up, 'k_k': k_k, 'k_a': k_a, 'r_k': r_k, 'lnx_g': lnx_g, 'lnx_b': lnx_b,
         'w_pool': w_pool, 'pool_scale': pool_scale, 'w_mlp1': w_mlp1, 'w_mlp2': w_mlp2}
    bp, bs = x_prompt.shape[0], x_sample.shape[0]
    shift0 = jnp.zeros((N_AB, bp, B_COLS), x_prompt.dtype)
    wkv0 = jnp.zeros((N_AB, bp, H_B, DH_B, DH_B), jnp.float32)
    pool0 = jnp.zeros((N_C, bp, 0, D_MODEL), x_prompt.dtype)
    y_prompt, k_p, v_p, wkv_p, sh_p, pool_p = trunk(x_prompt, c_prompt, 0, None, shift0, wkv0, pool0, W)
    past_len = page_table.shape[1] * PAGE_SIZE
    past_kv = [(cache_k[page_table, i].reshape(bs, past_len, H_A, DH_A),
                cache_v[page_table, i].reshape(bs, past_len, H_A, DH_A)) for i in range(N_AB)]
    y_sample, k_s, v_s, wkv_s, sh_s, pool_s = trunk(x_sample, c_sample, past_len, past_kv,
                                                    state_shift, state_wkv, state_pool, W)
    return (y_prompt, y_sample, k_p, v_p, k_s, v_s, wkv_p, wkv_s, sh_p, sh_s, pool_p, pool_s)
```

```cpp
#include <hip/hip_runtime.h>
#include <cstdio>
#include <cstdint>
namespace pg8 {
#define PG8_LAS __attribute__((address_space(3)))
typedef unsigned short bf16_t;
typedef short bf16x8 __attribute__((ext_vector_type(8)));
typedef float f32x4 __attribute__((ext_vector_type(4)));
typedef unsigned u32x4 __attribute__((ext_vector_type(4)));
constexpr int BM = 256, BK = 64, HALF = 128, HTB = HALF * BK * 2  , STAGE_BYTES = 8 * HTB, NXCD = 8, WGM = 8;

__host__ __device__ __forceinline__ int lds_byte(int r, int c) { const int st = (r >> 4) * 2 + (c >> 5), rr = r & 15, cc = c & 31, ob = rr * 64 + cc * 2; return st * 1024 + (ob ^ (((ob >> 9) & 1) << 5)); }
__host__ __device__ __forceinline__ void stage_rc(int b, int& R, int& C) { const int st = b / 1024, sb = b % 1024, swz = sb ^ (((sb >> 9) & 1) << 5); R = (st >> 1) * 16 + swz / 64; C = (st & 1) * 32 + (swz % 64) / 2; }
__host__ __device__ __forceinline__ int perm32(int rho) { const int n = rho >> 4, i = rho & 15; return 8 * (i >> 2) + 4 * n + (i & 3); }

struct Unit { int pm, pn, kc; };
struct Gemm { const bf16_t* A; const bf16_t* Bt; int M, N, K, lda, ldb; };

struct StaticOrder {
    int nM, nN, nwg, G, c;
    __host__ __device__ void init(int M, int N, int G_, int c_) { nM = M / BM; nN = N / BM; nwg = nM * nN; G = G_; c = c_; }
    __host__ __device__ bool next(int i, Unit& u) const {
        const long L = (long)i * G + c; if (L >= nwg) return false;
        int wgid = (int)L; { const int q = nwg / NXCD, r = nwg % NXCD, xcd = wgid % NXCD, off = wgid / NXCD; wgid = (xcd < r ? xcd * (q + 1) : r * (q + 1) + (xcd - r) * q) + off; }
        const int nig = WGM * nN, gid = wgid / nig, fm = gid * WGM, gsz = (nM - fm) < WGM ? (nM - fm) : WGM;
        u.pm = fm + ((wgid % nig) % gsz); u.pn = (wgid % nig) / gsz; u.kc = -1; return true;
    }
    __device__ __forceinline__ int nt(const Unit&, const Gemm& g) const { return g.K / BK; }
    __device__ __forceinline__ void a_ready(const Unit&) const {}
    __device__ __forceinline__ void done(const Unit&) const {}
    __device__ __forceinline__ size_t a_off(const Unit& u, const Gemm& g) const { return (size_t)u.pm * BM * g.lda * 2; }
    __device__ __forceinline__ size_t b_off(const Unit& u, const Gemm& g) const { return (size_t)u.pn * BM * g.ldb * 2; }
};
struct LoraOrder : StaticOrder {
    __device__ __forceinline__ int k0(const Unit& u) const { return u.pn < 4 ? 0 : (u.pn < 8 ? 64 : 192); }
    __device__ __forceinline__ int nt(const Unit& u, const Gemm&) const { return u.pn < 8 ? 2 : 4; }
    __device__ __forceinline__ size_t a_off(const Unit& u, const Gemm& g) const { return (size_t)u.pm * BM * g.lda * 2 + (size_t)k0(u) * 2; }
    __device__ __forceinline__ size_t b_off(const Unit& u, const Gemm& g) const { return (size_t)u.pn * BM * g.ldb * 2 + (size_t)k0(u) * 2; }
};
__device__ __forceinline__ unsigned cvt_pk_bf16(float lo, float hi) { unsigned r; asm volatile("v_cvt_pk_bf16_f32 %0, %1, %2" : "=v"(r) : "v"(lo), "v"(hi)); return r; }

struct EpiF32 {
    static constexpr bool PERM = false, AFTER_DRAIN = false;
    float* C; int ldc; const float* cscale;
    __device__ __forceinline__ void operator()(const f32x4 (&acc)[2][2][4][2], const Unit& u, int wr, int wc, int fr, int fq) const {
        const int row0 = u.pm * BM + wr * 64 + fr, col0 = u.pn * BM + wc * 32 + 4 * fq;
        f32x4 sv[2][2];
#pragma unroll
        for (int bj = 0; bj < 2; ++bj)
#pragma unroll
            for (int n = 0; n < 2; ++n) sv[bj][n] = cscale ? *(const f32x4*)(cscale + col0 + bj * HALF + n * 16) : (f32x4){1.f, 1.f, 1.f, 1.f};
#pragma unroll
        for (int ai = 0; ai < 2; ++ai)
#pragma unroll
            for (int m = 0; m < 4; ++m) { float* rowp = C + (size_t)(row0 + ai * HALF + m * 16) * ldc + col0;
#pragma unroll
                for (int bj = 0; bj < 2; ++bj)
#pragma unroll
                    for (int n = 0; n < 2; ++n) *(f32x4*)(rowp + bj * HALF + n * 16) = acc[ai][bj][m][n] * sv[bj][n]; }
    }
};
typedef unsigned u32x2h __attribute__((ext_vector_type(2)));
struct EpiLora {
    static constexpr bool PERM = false, AFTER_DRAIN = false;
    float* C; bf16_t* H; int ldc;
    __device__ __forceinline__ void operator()(const f32x4 (&acc)[2][2][4][2], const Unit& u, int wr, int wc, int fr, int fq) const {
        const int row0 = u.pm * BM + wr * 64 + fr, col0 = u.pn * BM + wc * 32 + 4 * fq;
#pragma unroll
        for (int ai = 0; ai < 2; ++ai)
#pragma unroll
            for (int m = 0; m < 4; ++m) { const size_t ro = (size_t)(row0 + ai * HALF + m * 16) * ldc + col0;
#pragma unroll
                for (int bj = 0; bj < 2; ++bj)
#pragma unroll
                    for (int n = 0; n < 2; ++n) { const f32x4 v = acc[ai][bj][m][n];
                        if (u.pm < 32) { u32x2h w; w.x = cvt_pk_bf16(v[0], v[1]); w.y = cvt_pk_bf16(v[2], v[3]); *(u32x2h*)(H + ro + bj * HALF + n * 16) = w; }
                        else *(f32x4*)(C + ro + bj * HALF + n * 16) = v; } }
    }
};
struct EpiRelu2 {
    static constexpr bool PERM = true, AFTER_DRAIN = false;
    bf16_t* O; int ldc; float* PART;
    __device__ __forceinline__ void operator()(const f32x4 (&acc)[2][2][4][2], const Unit& u, int wr, int wc, int fr, int fq) const {
        const int row0 = u.pm * BM + wr * 64 + fr, col0 = u.pn * BM + wc * 32 + 8 * fq;
        if (u.kc >= 0) {
            if (wr == 0) {
#pragma unroll
                for (int m = 0; m < 4; ++m) { float* rowp = PART + ((size_t)u.kc * 64 + m * 16 + fr) * ldc + col0;
#pragma unroll
                    for (int bj = 0; bj < 2; ++bj) { *(f32x4*)(rowp + bj * HALF) = acc[0][bj][m][0]; *(f32x4*)(rowp + bj * HALF + 4) = acc[0][bj][m][1]; } } }
            return;
        }
#pragma unroll
        for (int ai = 0; ai < 2; ++ai)
#pragma unroll
            for (int m = 0; m < 4; ++m) { bf16_t* rowp = O + (size_t)(row0 + ai * HALF + m * 16) * ldc + col0;
#pragma unroll
                for (int bj = 0; bj < 2; ++bj) { f32x4 v0 = acc[ai][bj][m][0], v1 = acc[ai][bj][m][1];
#pragma unroll
                    for (int j = 0; j < 4; ++j) { const float a = v0[j] > 0.f ? v0[j] : 0.f, b = v1[j] > 0.f ? v1[j] : 0.f; v0[j] = a * a; v1[j] = b * b; }
                    u32x4 w; w.x = cvt_pk_bf16(v0[0], v0[1]); w.y = cvt_pk_bf16(v0[2], v0[3]); w.z = cvt_pk_bf16(v1[0], v1[1]); w.w = cvt_pk_bf16(v1[2], v1[3]);
                    *(u32x4*)(rowp + bj * HALF) = w; } }
    }
};
template <bool POOL> struct MixOrder {
    StaticOrder so; int nmain, nN, kdiv, ntot, G, c;
    __device__ void init(int N, int K, int G_, int c_) { nN = N / BM; so.init(32 * BM, N, G_, c_); nmain = 32 * nN; kdiv = (POOL ? 512 : K) / 256; ntot = nmain + nN * kdiv; G = G_; c = c_; }
    __device__ bool next(int i, Unit& u) const {
        const int L = i * G + c; if (L >= ntot) return false;
        if (L < nmain) return so.next(i, u);
        const int j = L - nmain; u.pm = 32; u.pn = j % nN; u.kc = j / nN; return true;
    }
    __device__ __forceinline__ int nt(const Unit& u, const Gemm& g) const { return u.kc >= 0 ? 4 : (POOL ? 8 : g.K / BK); }
    __device__ __forceinline__ size_t a_off(const Unit& u, const Gemm& g) const { return (size_t)u.pm * BM * g.lda * 2 + (size_t)((POOL ? (u.pn >> 1) * 512 : 0) + (u.kc >= 0 ? u.kc * 256 : 0)) * 2; }
    __device__ __forceinline__ size_t b_off(const Unit& u, const Gemm& g) const { return (size_t)u.pn * BM * g.ldb * 2 + (size_t)((POOL ? (u.pn >> 1) * 512 : 0) + (u.kc >= 0 ? u.kc * 256 : 0)) * 2; }
    __device__ __forceinline__ void a_ready(const Unit&) const {}
    __device__ __forceinline__ void done(const Unit&) const {}
};
template <int PROW> struct EpiF32S {
    static constexpr bool PERM = false, AFTER_DRAIN = false;
    bf16_t* C; int ldc; const float* cscale; float* PART;
    __device__ __forceinline__ f32x4 scl(int c) const { return cscale ? *(const f32x4*)(cscale + c) : (f32x4){1.f, 1.f, 1.f, 1.f}; }
    __device__ __forceinline__ void operator()(const f32x4 (&acc)[2][2][4][2], const Unit& u, int wr, int wc, int fr, int fq) const {
        asm volatile("" : "+v"(fr), "+v"(fq));
        const int col0 = u.pn * BM + wc * 32 + 4 * fq;
        if (u.kc < 0) {
            bf16_t* Ct = C + (size_t)u.pm * BM * ldc; const unsigned e0 = (unsigned)((wr * 64 + fr) * ldc + col0);
#pragma unroll
            for (int bj = 0; bj < 2; ++bj)
#pragma unroll
                for (int n = 0; n < 2; ++n) { const f32x4 sv = scl(col0 + bj * HALF + n * 16);
#pragma unroll
                    for (int ai = 0; ai < 2; ++ai)
#pragma unroll
                        for (int m = 0; m < 4; ++m) { const f32x4 v = acc[ai][bj][m][n] * sv; const unsigned w0 = cvt_pk_bf16(v[0], v[1]), w1 = cvt_pk_bf16(v[2], v[3]);
                            *(unsigned long long*)(Ct + e0 + (unsigned)((ai * HALF + m * 16) * ldc) + bj * HALF + n * 16) = (unsigned long long)w0 | ((unsigned long long)w1 << 32); } }
        } else if (PROW == 256) {
            float* Pk = PART + (size_t)u.kc * 256 * ldc; const unsigned e0 = (unsigned)((wr * 64 + fr) * ldc + col0);
#pragma unroll
            for (int bj = 0; bj < 2; ++bj)
#pragma unroll
                for (int n = 0; n < 2; ++n) { const f32x4 sv = scl(col0 + bj * HALF + n * 16);
#pragma unroll
                    for (int ai = 0; ai < 2; ++ai)
#pragma unroll
                        for (int m = 0; m < 4; ++m) *(f32x4*)(Pk + e0 + (unsigned)((ai * HALF + m * 16) * ldc) + bj * HALF + n * 16) = acc[ai][bj][m][n] * sv; }
        } else if (wr == 0) {
            float* Pk = PART + (size_t)u.kc * 64 * ldc; const unsigned e0 = (unsigned)(fr * ldc + col0);
#pragma unroll
            for (int bj = 0; bj < 2; ++bj)
#pragma unroll
                for (int n = 0; n < 2; ++n) { const f32x4 sv = scl(col0 + bj * HALF + n * 16);
#pragma unroll
                    for (int m = 0; m < 4; ++m) *(f32x4*)(Pk + e0 + (unsigned)(m * 16 * ldc) + bj * HALF + n * 16) = acc[0][bj][m][n] * sv; }
        }
    }
};
template <class Epi, class Sched, bool ALIGN_EPI = false, bool SP2 = false>
__device__ __forceinline__ void gemm_phase(PG8_LAS unsigned char* lds, const Gemm g, const Sched& S, const Epi& E) {
    const int tid = threadIdx.x, wid = __builtin_amdgcn_readfirstlane(tid >> 6), lane = tid & 63, wr = wid >> 2, wc = wid & 3, fr = lane & 15, fq = lane >> 4;
    unsigned voffA[2], voffB[2];
#pragma unroll
    for (int i = 0; i < 2; ++i) { int R, C; stage_rc(tid * 16 + i * 8192, R, C); const int Rb = Epi::PERM ? ((R & ~31) + perm32(R & 31)) : R;
        voffA[i] = (unsigned)(R * g.lda + C) * 2u; voffB[i] = (unsigned)(Rb * g.ldb + C) * 2u; }
    const size_t kstep = (size_t)(BK * 2);
    const size_t hsA = (size_t)HALF * g.lda * 2, hsB = (size_t)HALF * g.ldb * 2;
    const unsigned ldsw = (unsigned)wid * 1024u;
    const int aoff = lds_byte(wr * 64 + fr, fq * 8), boff = lds_byte(wc * 32 + fr, fq * 8);
#define PG8_SA(b, h) (((b) * 2 + (h)) * HTB)
#define PG8_SB(b, h) ((4 + (b) * 2 + (h)) * HTB)
#define PG8_STAGE(bufoff, gbase, voff) do { _Pragma("unroll") for (int _i = 0; _i < 2; ++_i) \
        __builtin_amdgcn_global_load_lds((const unsigned*)((const char*)(gbase) + (voff)[_i]), (PG8_LAS unsigned*)(lds + (bufoff) + ldsw + _i * 8192), 16, 0, 0); } while (0)
#define PG8_LDA(dst, b, h) do { _Pragma("unroll") for (int m = 0; m < 4; ++m) _Pragma("unroll") for (int k = 0; k < 2; ++k) dst[m][k] = *(const PG8_LAS bf16x8*)(lds + PG8_SA(b, h) + aoff + m * 2048 + k * 1024); } while (0)
#define PG8_LDB(dst, b, h) do { _Pragma("unroll") for (int n = 0; n < 2; ++n) _Pragma("unroll") for (int k = 0; k < 2; ++k) dst[n][k] = *(const PG8_LAS bf16x8*)(lds + PG8_SB(b, h) + boff + n * 2048 + k * 1024); } while (0)
#define PG8_MMA(ai, bj, At, Bt) do { __builtin_amdgcn_s_setprio(1); _Pragma("unroll") for (int m = 0; m < 4; ++m) _Pragma("unroll") for (int n = 0; n < 2; ++n) _Pragma("unroll") for (int k = 0; k < 2; ++k) \
        acc[ai][bj][m][n] = __builtin_amdgcn_mfma_f32_16x16x32_bf16(Bt[n][k], At[m][k], acc[ai][bj][m][n], 0, 0, 0); __builtin_amdgcn_s_setprio(0); } while (0)
#define PG8_WAIT_V(n) asm volatile("s_waitcnt vmcnt(" #n ")" ::: "memory")
#define PG8_WAIT_L(n) asm volatile("s_waitcnt lgkmcnt(" #n ")" ::: "memory")
#define PG8_BAR __builtin_amdgcn_s_barrier()
#define PG8_SCHED __builtin_amdgcn_sched_barrier(0)
    Unit cur, nxt; int ui = 0;
    if (!S.next(0, cur)) return;
    int nt = S.nt(cur, g);
    f32x4 acc[2][2][4][2];
#pragma unroll
    for (int a = 0; a < 2; ++a)
#pragma unroll
        for (int b = 0; b < 2; ++b)
#pragma unroll
            for (int m = 0; m < 4; ++m)
#pragma unroll
                for (int n = 0; n < 2; ++n) acc[a][b][m][n] = (f32x4){0.f, 0.f, 0.f, 0.f};
    bf16x8 At[4][2], B0[2][2], B1[2][2];
    const char* cA = (const char*)g.A + S.a_off(cur, g); const char* cB = (const char*)g.Bt + S.b_off(cur, g);
    S.a_ready(cur);
    if constexpr (SP2) {
        PG8_STAGE(PG8_SB(0, 0), cB, voffB); PG8_STAGE(PG8_SB(0, 1), cB + hsB, voffB); PG8_STAGE(PG8_SA(0, 0), cA, voffA); PG8_STAGE(PG8_SA(0, 1), cA + hsA, voffA);
        if (wr == 1) PG8_BAR;
        PG8_WAIT_V(2); PG8_BAR;
        PG8_STAGE(PG8_SB(1, 0), cB + kstep, voffB); PG8_STAGE(PG8_SA(1, 0), cA + kstep, voffA); PG8_STAGE(PG8_SB(1, 1), cB + hsB + kstep, voffB);
        PG8_WAIT_V(6); PG8_BAR;
    } else {
        PG8_STAGE(PG8_SB(0, 0), cB, voffB); PG8_STAGE(PG8_SA(0, 0), cA, voffA); PG8_STAGE(PG8_SB(0, 1), cB + hsB, voffB); PG8_STAGE(PG8_SA(0, 1), cA + hsA, voffA);
        if (wr == 1) PG8_BAR;
        PG8_WAIT_V(4); PG8_BAR;
        PG8_STAGE(PG8_SB(1, 0), cB + kstep, voffB); PG8_STAGE(PG8_SA(1, 0), cA + kstep, voffA); PG8_STAGE(PG8_SB(1, 1), cB + hsB + kstep, voffB);
        PG8_WAIT_V(6); PG8_BAR;
    }
    for (;;) {
        const bool has_next = S.next(ui + 1, nxt);
        const char* nA = has_next ? (const char*)g.A + S.a_off(nxt, g) : cA; const char* nB = has_next ? (const char*)g.Bt + S.b_off(nxt, g) : cB;
        for (int t = 0; t < nt; t += 2) {
            const bool last = (t == nt - 2);
            const char* a1 = cA + (size_t)(t + 1) * kstep;
            const char* a2 = last ? nA : cA + (size_t)(t + 2) * kstep; const char* b2 = last ? nB : cB + (size_t)(t + 2) * kstep;
            const char* a3 = a2 + kstep; const char* b3 = b2 + kstep;
            if (last && has_next) S.a_ready(nxt);
            if constexpr (SP2) {
            PG8_LDB(B0, 0, 0); PG8_LDB(B1, 0, 1); PG8_SCHED; PG8_LDA(At, 0, 0); PG8_STAGE(PG8_SA(1, 1), a1 + hsA, voffA);
            PG8_WAIT_V(8); PG8_WAIT_L(0); PG8_BAR; PG8_MMA(0, 0, At, B0); PG8_MMA(0, 1, At, B1); PG8_BAR; PG8_SCHED;
            PG8_LDA(At, 0, 1); PG8_STAGE(PG8_SB(0, 0), b2, voffB); PG8_STAGE(PG8_SB(0, 1), b2 + hsB, voffB); PG8_STAGE(PG8_SA(0, 0), a2, voffA);
            PG8_WAIT_V(8); PG8_WAIT_L(0); PG8_BAR; PG8_MMA(1, 0, At, B0); PG8_MMA(1, 1, At, B1); PG8_BAR; PG8_SCHED;
            PG8_LDB(B0, 1, 0); PG8_LDB(B1, 1, 1); PG8_SCHED; PG8_LDA(At, 1, 0); PG8_STAGE(PG8_SA(0, 1), a2 + hsA, voffA);
            PG8_WAIT_V(8); PG8_WAIT_L(0); PG8_BAR; PG8_MMA(0, 0, At, B0); PG8_MMA(0, 1, At, B1); PG8_BAR; PG8_SCHED;
            PG8_LDA(At, 1, 1); PG8_STAGE(PG8_SB(1, 0), b3, voffB); PG8_STAGE(PG8_SB(1, 1), b3 + hsB, voffB); PG8_STAGE(PG8_SA(1, 0), a3, voffA);
            PG8_WAIT_V(8); PG8_WAIT_L(0); PG8_BAR; PG8_MMA(1, 0, At, B0); PG8_MMA(1, 1, At, B1); PG8_BAR; PG8_SCHED;
            } else {
            PG8_LDB(B0, 0, 0); PG8_SCHED; PG8_LDA(At, 0, 0); PG8_STAGE(PG8_SA(1, 1), a1 + hsA, voffA);
            PG8_WAIT_L(8); PG8_BAR; PG8_WAIT_L(0); PG8_MMA(0, 0, At, B0); PG8_BAR; PG8_SCHED;
            PG8_LDB(B1, 0, 1); PG8_STAGE(PG8_SB(0, 0), b2, voffB);
            PG8_BAR; PG8_WAIT_L(0); PG8_MMA(0, 1, At, B1); PG8_BAR;
            PG8_LDA(At, 0, 1); PG8_STAGE(PG8_SA(0, 0), a2, voffA);
            PG8_BAR; PG8_WAIT_L(0); PG8_MMA(1, 0, At, B0); PG8_BAR; PG8_SCHED;
            PG8_STAGE(PG8_SB(0, 1), b2 + hsB, voffB);
            PG8_WAIT_V(6); PG8_BAR; PG8_MMA(1, 1, At, B1); PG8_BAR;
            PG8_LDB(B0, 1, 0); PG8_SCHED; PG8_LDA(At, 1, 0); PG8_STAGE(PG8_SA(0, 1), a2 + hsA, voffA);
            PG8_WAIT_L(8); PG8_BAR; PG8_WAIT_L(0); PG8_MMA(0, 0, At, B0); PG8_BAR; PG8_SCHED;
            PG8_LDB(B1, 1, 1); PG8_STAGE(PG8_SB(1, 0), b3, voffB);
            PG8_BAR; PG8_WAIT_L(0); PG8_MMA(0, 1, At, B1); PG8_BAR;
            PG8_LDA(At, 1, 1); PG8_STAGE(PG8_SA(1, 0), a3, voffA);
            PG8_BAR; PG8_WAIT_L(0); PG8_MMA(1, 0, At, B0); PG8_BAR; PG8_SCHED;
            PG8_STAGE(PG8_SB(1, 1), b3 + hsB, voffB);
            PG8_WAIT_V(6); PG8_BAR; PG8_MMA(1, 1, At, B1); PG8_BAR;
            }
        }
        if constexpr (ALIGN_EPI) { if (wr == 0) PG8_BAR; }
        if constexpr (!Epi::AFTER_DRAIN) { E(acc, cur, wr, wc, fr, fq); S.done(cur); }
        if (!has_next) break;
#pragma unroll
        for (int a = 0; a < 2; ++a)
#pragma unroll
            for (int b = 0; b < 2; ++b)
#pragma unroll
                for (int m = 0; m < 4; ++m)
#pragma unroll
                    for (int n = 0; n < 2; ++n) acc[a][b][m][n] = (f32x4){0.f, 0.f, 0.f, 0.f};
        cur = nxt; cA = nA; cB = nB; ++ui; nt = S.nt(cur, g);
        if constexpr (ALIGN_EPI) { if (wr == 1) PG8_BAR; }
    }
    PG8_WAIT_V(0);
    if constexpr (!ALIGN_EPI) { if (wr == 0) PG8_BAR; }
    PG8_BAR;
    if constexpr (Epi::AFTER_DRAIN) { E.fused(acc, cur, wr, wc, fr, fq, lds, wid, lane); S.done(cur); }
#undef PG8_SA
#undef PG8_SB
#undef PG8_STAGE
#undef PG8_LDA
#undef PG8_LDB
#undef PG8_MMA
#undef PG8_WAIT_V
#undef PG8_WAIT_L
#undef PG8_BAR
#undef PG8_SCHED
}
}

constexpr int DM = 2048, SEQ = 4096, NBATCH = 2, NPR = NBATCH * SEQ, DBAT = 8, DSEQ = 8, NSM = DBAT * DSEQ, NTOK = NPR + NSM, MP = 8448;
constexpr int HA = 8, DHA = 128, HB = 16, DHB = 64, DBR = 1024;
constexpr int BCOLS = 3520, INCOLS = 6592, INPAD = 6656, DFF = 8192, NPAGES = 128, PAGESZ = 128, PAST = 16384, PBUF = 15, NMR = 10;
constexpr float EPS_RMS = 1e-6f, EPS_LNX = 64e-5f, QK_SCALE = 0.08838834764831845f;
enum { I_XP = 0, I_XS, I_CK, I_CV, I_PT, I_SWKV, I_SSH, I_SPOOL, I_CP, I_CS, I_WADA, I_BADA, I_NG, I_WIN, I_WOUT, I_SBB, I_MU, I_W0, I_WUP, I_A0, I_AUP, I_GUP, I_KK, I_KA, I_RK, I_LNG, I_LNB, I_WPOOL, I_PSC, I_W1, I_W2, N_IN };
constexpr size_t O_YP = 0, O_YS = O_YP + (size_t)NPR * DM, O_KP = O_YS + (size_t)NSM * DM, O_VP = O_KP + (size_t)NPR * 1024, O_KS = O_VP + (size_t)NPR * 1024, O_VS = O_KS + (size_t)NSM * 1024,
                 O_WKVP = O_VS + (size_t)NSM * 1024, O_WKVS = O_WKVP + (size_t)NBATCH * HB * 64 * 64, O_SHP = O_WKVS + (size_t)DBAT * HB * 64 * 64, O_SHS = O_SHP + (size_t)NBATCH * BCOLS,
                 O_PLP = O_SHS + (size_t)DBAT * BCOLS, O_PLS = O_PLP + (size_t)NBATCH * PBUF * DM, O_END = O_PLS + (size_t)DBAT * PBUF * DM;
constexpr size_t MiB = 1u << 20;
constexpr size_t WS_CTL = 0, CTL_ZERO_BYTES = 64 * 1024, WS_MOD = 1 * MiB, WS_WIN = 2 * MiB, WS_WOUT = 28 * MiB, WS_W1 = 36 * MiB, WS_W2 = 100 * MiB, WS_WPOOL = 164 * MiB,
                 WS_H = 172 * MiB, WS_OAB = 205 * MiB, WS_M = 238 * MiB, WS_P = 271 * MiB, WS_OUT = 486 * MiB, WS_XR = 552 * MiB, WS_HF = 617 * MiB, WS_U = 682 * MiB,
                 WS_RWV = 814 * MiB, WS_SCL = 1072 * MiB, WS_G = 1075 * MiB, WS_Y = 1108 * MiB, WS_PU = 1141 * MiB, WS_Z = 1205 * MiB, WS_SC = 1237 * MiB, WS_QB = 1269 * MiB, WS_KB = 1286 * MiB, WS_VB = 1303 * MiB, WS_OP = 1320 * MiB, WS_CL = 1384 * MiB, WS_SPART = 1385 * MiB, WS_SCAR = 1394 * MiB, WS_LA = 1395 * MiB, WS_LWT = 1404 * MiB, WS_LWO = 1408 * MiB, WS_YC = 1508 * MiB, WS_PART = 1541 * MiB, WS_PARTU = 1558 * MiB, WS_END = 1575 * MiB;
static_assert(WS_WIN + (size_t)INPAD * DM * 2 <= WS_WOUT && WS_P + (size_t)MP * INPAD * 4 <= WS_OUT && WS_U + (size_t)MP * DFF * 2 <= WS_RWV && WS_RWV + (size_t)NTOK * HB * 512 * 4 <= WS_SCL, "ws map");
constexpr int CW_BAR = 4096;
constexpr int RING_BYTES = 131072, LDSCTL_OFF = RING_BYTES, MISC_OFF = LDSCTL_OFF + 320, LDS_BYTES = 147456;
constexpr int NWAVES = 8, NTHR = 512;

#define GAS __attribute__((address_space(1)))
#define LAS __attribute__((address_space(3)))
typedef unsigned short bf16;
__device__ __forceinline__ float ldbf(const bf16* p) { return __uint_as_float((unsigned)*p << 16); }
__device__ __forceinline__ float ldbf_nt(const bf16* p) { return __uint_as_float((unsigned)__builtin_nontemporal_load(p) << 16); }
typedef float f32x4 __attribute__((ext_vector_type(4)));
typedef float f32x2 __attribute__((ext_vector_type(2)));
typedef unsigned u32x2 __attribute__((ext_vector_type(2)));
typedef unsigned u32x4 __attribute__((ext_vector_type(4)));
#define LDS_WAIT() asm volatile("s_waitcnt lgkmcnt(0)" ::: "memory")
#define VM_WAIT() asm volatile("s_waitcnt vmcnt(0)" ::: "memory")
using pg8::cvt_pk_bf16;
constexpr size_t WS_PBH = WS_RWV, WS_LWH = WS_RWV + 64 * MiB;
static_assert((size_t)NPR * 3072 * 2 <= 64 * MiB && 128 * MiB <= (size_t)NPR * HB * 512 * 4, "bf16 prompt copies fit below the sample rows of RWV");
constexpr int PBLD = 3584;
struct EpiIn {
    static constexpr bool PERM = false, AFTER_DRAIN = false;
    bf16 *QB, *KB, *VB; float* PB; float* out; bf16* PBH;
    __device__ __forceinline__ void operator()(const pg8::f32x4 (&acc)[2][2][4][2], const pg8::Unit& u, int wr, int wc, int fr, int fq) const {
        const int row0 = u.pm * 256 + wr * 64 + fr, colt = u.pn * 256 + wc * 32 + 4 * fq;
        if (u.pn >= 12) {
#pragma unroll
            for (int ai = 0; ai < 2; ++ai)
#pragma unroll
                for (int m = 0; m < 4; ++m) {
                    if (u.pm < 32 && u.pn < 24) { bf16* rowh = PBH + (size_t)(row0 + ai * 128 + m * 16) * 3072 + (colt - 3072);
#pragma unroll
                        for (int bj = 0; bj < 2; ++bj)
#pragma unroll
                            for (int n = 0; n < 2; ++n) { const pg8::f32x4 v = acc[ai][bj][m][n]; u32x2 w; w.x = cvt_pk_bf16(v[0], v[1]); w.y = cvt_pk_bf16(v[2], v[3]); *(u32x2*)(rowh + bj * 128 + n * 16) = w; } }
                    else { float* rowp = PB + (size_t)(row0 + ai * 128 + m * 16) * PBLD + (colt - 3072);
#pragma unroll
                        for (int bj = 0; bj < 2; ++bj)
#pragma unroll
                            for (int n = 0; n < 2; ++n) *(pg8::f32x4*)(rowp + bj * 128 + n * 16) = acc[ai][bj][m][n]; } }
        } else {
            const int sel = u.pn >> 2, c0 = colt - sel * 1024;
            static_assert(WS_KB - WS_QB == WS_VB - WS_KB && O_VP - O_KP == (size_t)NPR * 1024 && O_VS - O_KS == (size_t)NSM * 1024, "q/k/v buffers are equally spaced");
            bf16* Bt = QB + (size_t)sel * ((WS_KB - WS_QB) / 2) + (size_t)u.pm * 256 * 1024;
            float* Ot = u.pm < 32 ? out + O_KP + (size_t)(sel ? sel - 1 : 0) * NPR * 1024 + (size_t)u.pm * 256 * 1024 : out + O_KS + (size_t)(sel ? sel - 1 : 0) * NSM * 1024;
            const int rl0 = wr * 64 + fr;
#pragma unroll
            for (int ai = 0; ai < 2; ++ai)
#pragma unroll
                for (int m = 0; m < 4; ++m) { const int rl = rl0 + ai * 128 + m * 16; const unsigned eo = (unsigned)(rl * 1024 + c0);
                    const bool wo = sel != 0 && (u.pm < 32 || rl < NSM);
#pragma unroll
                    for (int bj = 0; bj < 2; ++bj)
#pragma unroll
                        for (int n = 0; n < 2; ++n) { const pg8::f32x4 v = acc[ai][bj][m][n]; u32x2 w; w.x = cvt_pk_bf16(v[0], v[1]); w.y = cvt_pk_bf16(v[2], v[3]);
                            *(u32x2*)(Bt + eo + bj * 128 + n * 16) = w; if (wo) *(pg8::f32x4*)(Ot + eo + bj * 128 + n * 16) = v; }
                    asm volatile("" ::: "memory"); }
        }
    }
};

#define XB_TMO      128
#define XB_XCNT(j)  (256  + 64 * (j))
#define XB_XSUB(j)  (1280 + 64 * (j))
#define XB_XGEN(j)  (2304 + 64 * (j))
#define XB_TOP      3328
#define XB_TOPGEN   3392
#define XCD_BAR_WORDS 3456
#define XB_SPIN_CAP (1u << 18)

__device__ __forceinline__ unsigned xb_ld(unsigned* p)              { return __hip_atomic_load(p, __ATOMIC_RELAXED, __HIP_MEMORY_SCOPE_AGENT); }
__device__ __forceinline__ unsigned xb_add(unsigned* p, unsigned v) { return __hip_atomic_fetch_add(p, v, __ATOMIC_RELAXED, __HIP_MEMORY_SCOPE_AGENT); }
__device__ __forceinline__ unsigned xb_xcc_id() { return (unsigned)__builtin_amdgcn_s_getreg((3 << 11) | 20) & 0xFu; }
#define XB_SPIN(cond, bar) do { unsigned _sp = 0; while (cond) { __builtin_amdgcn_s_sleep(1); \
    if ((++_sp & 255u) == 0u) { if (xb_ld(&(bar)[XB_TMO])) break; if (_sp > XB_SPIN_CAP) { atomicAdd(&(bar)[XB_TMO], 1u); break; } } } } while (0)

struct XcdBarrier {
    unsigned* bar; unsigned x;
    volatile LAS unsigned* st;
};

__device__ __forceinline__ XcdBarrier xcd_barrier_post(unsigned* bar, volatile LAS unsigned* st) {
    XcdBarrier b; b.bar = bar; b.x = xb_xcc_id(); b.st = st;
    if (threadIdx.x == 0) (void)xb_add(&bar[XB_XCNT(b.x)], 1u);
    return b;
}
__device__ __forceinline__ void xcd_barrier_complete(unsigned* bar, unsigned x, unsigned& nloc, unsigned& nx) {
    const unsigned G = gridDim.x * gridDim.y * gridDim.z;
    unsigned sum, cnt, mine, sp = 0u;
    for (;;) {
        sum = 0u; cnt = 0u; mine = 0u;
#pragma unroll
        for (unsigned j = 0; j < 16; ++j) { const unsigned c = xb_ld(&bar[XB_XCNT(j)]); sum += c; cnt += (c > 0u) ? 1u : 0u; mine = (j == x) ? c : mine; }
        if (sum == G) break;
        __builtin_amdgcn_s_sleep(1);
        if ((++sp & 255u) == 0u) { if (xb_ld(&bar[XB_TMO])) break; if (sp > XB_SPIN_CAP) { atomicAdd(&bar[XB_TMO], 1u); break; } }
    }
    nloc = mine > 0u ? mine : 1u; nx = cnt > 0u ? cnt : 1u;
}

__device__ __forceinline__ void xcd_barrier(const XcdBarrier& b) {
    asm volatile("s_waitcnt vmcnt(0)" ::: "memory");
    __syncthreads();
    if (threadIdx.x == 0) {
        unsigned* bar = b.bar;
        __builtin_amdgcn_s_waitcnt(0);
        unsigned nloc = b.st[0], nx = b.st[1];
        if (nloc == 0u) { xcd_barrier_complete(bar, b.x, nloc, nx); b.st[0] = nloc; b.st[1] = nx; }
        const unsigned old = xb_add(&bar[XB_XSUB(b.x)], 1u);
        const unsigned gen = old / nloc;
        if (old + 1u == (gen + 1u) * nloc) {
            __builtin_amdgcn_fence(__ATOMIC_RELEASE, "agent");
            asm volatile("s_waitcnt vmcnt(0)" ::: "memory");
            const unsigned og = xb_add(&bar[XB_TOP], 1u);
            const unsigned tg = og / nx;
            if (og + 1u == (tg + 1u) * nx) xb_add(&bar[XB_TOPGEN], 1u);
            else XB_SPIN(xb_ld(&bar[XB_TOPGEN]) == tg, bar);
            __builtin_amdgcn_fence(__ATOMIC_ACQUIRE, "agent");
            xb_add(&bar[XB_XGEN(b.x)], 1u);
            asm volatile("s_waitcnt vmcnt(0)" ::: "memory");
        } else {
            XB_SPIN(xb_ld(&bar[XB_XGEN(b.x)]) == gen, bar);
            __builtin_amdgcn_fence(__ATOMIC_ACQUIRE, "agent");
            asm volatile("s_waitcnt vmcnt(0)" ::: "memory");
        }
    }
    __syncthreads();
}


struct Ctx {
    LAS unsigned char* lds; int tid, lane, wave, vcu, G;
    __device__ __forceinline__ const float* in(int i) const { return ((const float* const __attribute__((address_space(4)))*)__builtin_amdgcn_kernarg_segment_ptr())[i]; }
    __device__ __forceinline__ float* outp() const { return ((float* const __attribute__((address_space(4)))*)__builtin_amdgcn_kernarg_segment_ptr())[N_IN]; }
    __device__ __forceinline__ unsigned char* wsp() const { return ((unsigned char* const __attribute__((address_space(4)))*)__builtin_amdgcn_kernarg_segment_ptr())[N_IN + 1]; }
};
template <int CTRL> __device__ __forceinline__ float dpp_f(float x) { return __builtin_bit_cast(float, __builtin_amdgcn_mov_dpp(__builtin_bit_cast(int, x), CTRL, 0xf, 0xf, true)); }
#define readlane_f(x, l) __builtin_bit_cast(float, __builtin_amdgcn_readlane(__builtin_bit_cast(int, (float)(x)), (l)))
__device__ __forceinline__ float wave_sum(float v) {
    v += dpp_f<0xB1>(v); v += dpp_f<0x4E>(v); v += dpp_f<0x141>(v); v += dpp_f<0x140>(v);
    auto s = __builtin_amdgcn_permlane16_swap(__float_as_uint(v), __float_as_uint(v), false, false);
    v = __uint_as_float(s[0]) + __uint_as_float(s[1]);
    auto t = __builtin_amdgcn_permlane32_swap(__float_as_uint(v), __float_as_uint(v), false, false);
    return __uint_as_float(t[0]) + __uint_as_float(t[1]);
}
__device__ __forceinline__ float sigmoidf_(float x) { return 1.f / (1.f + __expf(-x)); }
__device__ __forceinline__ float softplusf_(float x) { return fmaxf(x, 0.f) + log1pf(__expf(-fabsf(x))); }
__device__ __forceinline__ int mod_row(int r) { return r < NPR ? (r >> 12) : 2 + ((r - NPR) >> 3); }
#define WSP(T, off) ((T*)(F.wsp() + (off)))

struct CvtItem { const float* W; bf16* WT; int ldw, ldt, k0, n0; };
__device__ __forceinline__ void item_load(float (&tv)[32], const CvtItem& d, int lane) {
#pragma unroll
    for (int i = 0; i < 32; ++i) tv[i] = __builtin_nontemporal_load(d.W + (size_t)(d.k0 + 2 * i + (lane >> 5)) * d.ldw + d.n0 + (lane & 31));
}
__device__ __forceinline__ void item_store(const float (&tv)[32], const CvtItem& d, LAS float* scr, int lane) {
#pragma unroll
    for (int i = 0; i < 32; ++i) scr[(2 * i + (lane >> 5)) * 33 + (lane & 31)] = tv[i];
    LDS_WAIT(); asm volatile("" ::: "memory");
    const int c = lane & 7;
#pragma unroll
    for (int j = 0; j < 4; ++j) { const int n = (lane >> 3) + 8 * j; const LAS float* s = scr + (8 * c) * 33 + n;
        u32x4 o; o.x = cvt_pk_bf16(s[0 * 33], s[1 * 33]); o.y = cvt_pk_bf16(s[2 * 33], s[3 * 33]); o.z = cvt_pk_bf16(s[4 * 33], s[5 * 33]); o.w = cvt_pk_bf16(s[6 * 33], s[7 * 33]);
        *(GAS u32x4*)(d.WT + (size_t)(d.n0 + n) * d.ldt + d.k0 + 8 * c) = o; }
    LDS_WAIT(); asm volatile("" ::: "memory");
}
constexpr int IT_IN = 32 * 206, IT_OUT = 32 * 64, IT_W1 = 32 * 256, IT_W2 = 128 * 64, IT_PL = 8 * 16, NIT_ALL = IT_IN + IT_OUT + 2 * IT_W1 + 2 * IT_W2 + 4 * IT_PL;
__device__ __forceinline__ CvtItem item_decode(Ctx& F, int it) {
    int r = it; CvtItem d; int N;
    if (r < IT_IN) { d.W = F.in(I_WIN); d.WT = WSP(bf16, WS_WIN); N = INCOLS; d.ldt = DM; }
    else if ((r -= IT_IN) < IT_OUT) { d.W = F.in(I_WOUT); d.WT = WSP(bf16, WS_WOUT); N = DM; d.ldt = DM; }
    else if ((r -= IT_OUT) < 2 * IT_W1) { const int l = r / IT_W1; r -= l * IT_W1; d.W = F.in(I_W1) + (size_t)l * DM * DFF; d.WT = WSP(bf16, WS_W1) + (size_t)l * DFF * DM; N = DFF; d.ldt = DM; }
    else if ((r -= 2 * IT_W1) < 2 * IT_W2) { const int l = r / IT_W2; r -= l * IT_W2; d.W = F.in(I_W2) + (size_t)l * DFF * DM; d.WT = WSP(bf16, WS_W2) + (size_t)l * DM * DFF; N = DM; d.ldt = DFF; }
    else { r -= 2 * IT_W2; const int g = r / IT_PL; r -= g * IT_PL; d.W = F.in(I_WPOOL) + (size_t)g * 512 * 512; d.WT = WSP(bf16, WS_WPOOL) + (size_t)(g * 512) * DM + g * 512; N = 512; d.ldt = DM; }
    const int nblk = N / 32, kb = r / nblk, nb = r - kb * nblk;
    d.ldw = N; d.k0 = 64 * kb; d.n0 = 32 * nb; return d;
}
__device__ __forceinline__ void convert_run(Ctx& F, int first, int stride, int lim, LAS float* scr) {
    int it = first; if (it >= lim) return;
    float ta[32], tb[32]; CvtItem da = item_decode(F, it), db = da; item_load(ta, da, F.lane);
    for (;;) {
        const int i2 = it + stride; const bool h2 = i2 < lim; if (h2) { db = item_decode(F, i2); item_load(tb, db, F.lane); }
        item_store(ta, da, scr, F.lane); if (!h2) break;
        const int i3 = i2 + stride; const bool h3 = i3 < lim; if (h3) { da = item_decode(F, i3); item_load(ta, da, F.lane); }
        item_store(tb, db, scr, F.lane); if (!h3) break;
        it = i3; }
}
constexpr int NCVT = 40, N_HIDE = 24000;
__device__ __forceinline__ void phase_prologue(Ctx& F) {
    LAS float* scr = (LAS float*)(F.lds + F.wave * 16384);
    const int gw = F.vcu * NWAVES + F.wave, NGW = F.G * NWAVES;
    convert_run(F, gw, NGW, IT_IN, scr);
    if (F.G > NCVT + 8) convert_run(F, IT_IN + N_HIDE + gw, NGW, NIT_ALL, scr); else convert_run(F, IT_IN + gw, NGW, NIT_ALL, scr);
    for (int i = F.vcu * NTHR + F.tid; i < 3072 * 64; i += F.G * NTHR) {
        const int kc = i / 3072, n = i - kc * 3072, reg = n >> 10, nn = n & 1023;
        float v[8];
        if (reg == 0) {
#pragma unroll
            for (int j = 0; j < 8; ++j) { const int k = 8 * kc + j; v[j] = (k < 96) ? F.in(I_WUP)[(size_t)k * 1024 + nn] : 0.f; } }
        else if (reg == 1) {
#pragma unroll
            for (int j = 0; j < 8; ++j) { const int k = 8 * kc + j - 96; v[j] = (k >= 0 && k < 96) ? F.in(I_AUP)[(size_t)k * 1024 + nn] : 0.f; } }
        else {
#pragma unroll
            for (int j = 0; j < 8; ++j) { const int k = 8 * kc + j - 192; v[j] = (k >= 0 && k < 256) ? F.in(I_GUP)[(size_t)k * 1024 + nn] : 0.f; } }
        u32x4 o; o.x = cvt_pk_bf16(v[0], v[1]); o.y = cvt_pk_bf16(v[2], v[3]); o.z = cvt_pk_bf16(v[4], v[5]); o.w = cvt_pk_bf16(v[6], v[7]);
        *(GAS u32x4*)(WSP(bf16, WS_LWT) + (size_t)n * 512 + 8 * kc) = o;
    }
    __syncthreads();
    LAS float* sc = (LAS float*)F.lds;
    LAS float* part = (LAS float*)(F.lds + 81920);
    for (int i = F.tid; i < NMR * DM; i += NTHR) { const int r = i >> 11, k = i & 2047; const float c = r < 2 ? F.in(I_CP)[r * DM + k] : F.in(I_CS)[(r - 2) * DM + k]; sc[i] = c / (1.f + __expf(-c)); }
    __syncthreads();
    float* MOD = WSP(float, WS_MOD);
    float* MODP = WSP(float, WS_G);
    for (int u = F.vcu; u < 512; u += F.G) {
        const bool whole = u < 256; const int task = whole ? u : 256 + ((u - 256) >> 1), kh = whole ? 0 : (u - 256) & 1, klen = whole ? 256 : 128;
        const int l = task / 192, cb = (task - l * 192) * 64;
        const float* W = F.in(I_WADA) + (size_t)l * DM * 12288 + cb + F.lane;
        float acc[NMR];
#pragma unroll
        for (int r = 0; r < NMR; ++r) acc[r] = 0.f;
        const int kbeg = kh * 1024 + F.wave * klen;
        for (int k = kbeg; k < kbeg + klen; k += 16) {
            float wv[16];
#pragma unroll
            for (int j = 0; j < 16; ++j) wv[j] = __builtin_nontemporal_load(W + (size_t)(k + j) * 12288);
#pragma unroll
            for (int j = 0; j < 16; j += 4)
#pragma unroll
                for (int r = 0; r < NMR; ++r) { const f32x4 s = *(const LAS f32x4*)(sc + r * DM + k + j); acc[r] += (s.x * wv[j] + s.y * wv[j + 1]) + (s.z * wv[j + 2] + s.w * wv[j + 3]); }
        }
#pragma unroll
        for (int r = 0; r < NMR; ++r) part[(F.wave * NMR + r) * 64 + F.lane] = acc[r];
        __syncthreads();
        for (int i = F.tid; i < NMR * 64; i += NTHR) { const int r = i >> 6, c = i & 63; float s = 0.f;
#pragma unroll
            for (int w = 0; w < NWAVES; ++w) s += part[(w * NMR + r) * 64 + c];
            if (kh == 0) s += F.in(I_BADA)[l * 12288 + cb + c];
            if (whole) MOD[(size_t)(l * NMR + r) * 12288 + cb + c] = s; else MODP[((size_t)kh * NMR + r) * 8192 + (cb - 4096) + c] = s; }
        __syncthreads();
    }
}

struct Row { f32x4 v[8]; };
__device__ __forceinline__ void row_load(Row& R, const float* p, int lane) {
#pragma unroll
    for (int j = 0; j < 8; ++j) R.v[j] = *(const GAS f32x4*)(p + j * 256 + lane * 4);
}
__device__ __forceinline__ void row_load_bf16(Row& R, const bf16* p, int lane) {
#pragma unroll
    for (int j = 0; j < 8; ++j) { const u32x2 w = *(const GAS u32x2*)(p + j * 256 + lane * 4);
        R.v[j] = (f32x4){__uint_as_float(w.x << 16), __uint_as_float(w.x & 0xffff0000u), __uint_as_float(w.y << 16), __uint_as_float(w.y & 0xffff0000u)}; }
}
__device__ __forceinline__ float row_sumsq(const Row& R) { float s = 0.f;
#pragma unroll
    for (int j = 0; j < 8; ++j) s += (R.v[j].x * R.v[j].x + R.v[j].y * R.v[j].y) + (R.v[j].z * R.v[j].z + R.v[j].w * R.v[j].w);
    return wave_sum(s); }
__device__ __forceinline__ const float* x_in_row(Ctx& F, int r) { return r < NPR ? F.in(I_XP) + (size_t)r * DM : F.in(I_XS) + (size_t)(r - NPR) * DM; }
__device__ __forceinline__ void row_modulate(Row& H, const Row& X, float rstd, const float* g, const float* shift, const float* scale, int lane) {
#pragma unroll
    for (int j = 0; j < 8; ++j) { const int c = j * 256 + lane * 4; const f32x4 gg = *(const GAS f32x4*)(g + c), sh = *(const GAS f32x4*)(shift + c), sc = *(const GAS f32x4*)(scale + c);
        H.v[j] = X.v[j] * rstd * gg * (sc + 1.f) + sh; }
}
__device__ __forceinline__ void row_store_bf16(const Row& H, bf16* p, int lane) {
#pragma unroll
    for (int j = 0; j < 8; ++j) { u32x2 w; w.x = cvt_pk_bf16(H.v[j].x, H.v[j].y); w.y = cvt_pk_bf16(H.v[j].z, H.v[j].w); *(GAS u32x2*)(p + j * 256 + lane * 4) = w; }
}
__device__ __forceinline__ void row_store_f32(const Row& H, float* p, int lane) {
#pragma unroll
    for (int j = 0; j < 8; ++j) *(GAS f32x4*)(p + j * 256 + lane * 4) = H.v[j];
}
__device__ __forceinline__ void phase_mod0(Ctx& F) {
    const int gw = F.vcu * NWAVES + F.wave, NGW = F.G * NWAVES; const float* MOD = WSP(float, WS_MOD); bf16* Hb = WSP(bf16, WS_H);
    for (int r = gw; r < NTOK; r += NGW) {
        Row X, H; row_load(X, x_in_row(F, r), F.lane);
        const float rstd = rsqrtf(row_sumsq(X) * (1.f / DM) + EPS_RMS);
        const float* m = MOD + (size_t)(0 * NMR + mod_row(r)) * 12288;
        row_modulate(H, X, rstd, F.in(I_NG) + 0 * DM, m + 0 * DM, m + 1 * DM, F.lane);
        row_store_bf16(H, Hb + (size_t)r * DM, F.lane);
    }
}
__device__ __forceinline__ void row_residual(Row& X, const Row& O, const float* ga, const float* gate, int lane) {
    const float rstd = rsqrtf(row_sumsq(O) * (1.f / DM) + EPS_RMS);
#pragma unroll
    for (int j = 0; j < 8; ++j) { const int c = j * 256 + lane * 4; const f32x4 gg = *(const GAS f32x4*)(ga + c), gt = *(const GAS f32x4*)(gate + c); X.v[j] = X.v[j] + gt * (O.v[j] * rstd * gg); }
}
template <int NK> __device__ __forceinline__ void row_load_out(Ctx& F, Row& O, int r, int lane) {
    if (r < NPR) { const bf16* op = WSP(bf16, WS_OUT) + (size_t)r * DM;
#pragma unroll
        for (int j = 0; j < 8; ++j) { const u32x2 w = *(const GAS u32x2*)(op + j * 256 + lane * 4);
            O.v[j] = (f32x4){__uint_as_float(w.x << 16), __uint_as_float(w.x & 0xffff0000u), __uint_as_float(w.y << 16), __uint_as_float(w.y & 0xffff0000u)}; }
        return; }
    const float* pp = WSP(float, WS_PART) + (size_t)(r - NPR) * DM;
    row_load(O, pp, lane);
    for (int kc = 1; kc < NK; ++kc) { Row T; row_load(T, pp + (size_t)kc * 64 * DM, lane);
#pragma unroll
        for (int j = 0; j < 8; ++j) O.v[j] += T.v[j]; }
}
__device__ __forceinline__ f32x4 ld_bf4(const bf16* p) { const u32x2 w = *(const GAS u32x2*)p; return (f32x4){__uint_as_float(w.x << 16), __uint_as_float(w.x & 0xffff0000u), __uint_as_float(w.y << 16), __uint_as_float(w.y & 0xffff0000u)}; }
__device__ __forceinline__ void row_load_pool(Ctx& F, Row& O, int r, int lane) {
    if (r < NPR) { const int t = r & (SEQ - 1); const bf16* op = WSP(bf16, WS_OUT) + (size_t)r * DM + lane * 4;
#pragma unroll
        for (int j8 = 0; j8 < 8; ++j8) { constexpr int dummy = 0; (void)dummy; const int wlen = 2 << (j8 >> 1), n = (t + 1) < wlen ? (t + 1) : wlen;
            const f32x4 cur = ld_bf4(op + j8 * 256); f32x4 sum = cur;
            for (int j = 1; j < n; ++j) sum += ld_bf4(op + j8 * 256 - (size_t)j * DM);
            O.v[j8] = sum * (1.f / (float)n) - cur; }
    } else { const int rs = r - NPR, b = rs >> 3, t = rs & 7; const float* pp = WSP(float, WS_PART) + lane * 4;
#pragma unroll
        for (int j8 = 0; j8 < 8; ++j8) { const int wlen = 2 << (j8 >> 1); f32x4 cur = {0.f, 0.f, 0.f, 0.f}, sum = {0.f, 0.f, 0.f, 0.f};
            for (int j = 0; j < wlen; ++j) { const int tj = t - j, pr = tj >= 0 ? rs - j : 64 + b * PBUF + PBUF + tj;
                const f32x4 g = *(const GAS f32x4*)(pp + (size_t)pr * DM + j8 * 256) + *(const GAS f32x4*)(pp + (size_t)(256 + pr) * DM + j8 * 256);
                sum += g; if (j == 0) cur = g; }
            O.v[j8] = sum * (1.f / (float)wlen) - cur; }
    }
}
template <int L> __device__ __forceinline__ void phase_postmix(Ctx& F) {
    const int gw = F.vcu * NWAVES + F.wave, NGW = F.G * NWAVES; const float* MOD = WSP(float, WS_MOD); bf16* Hb = WSP(bf16, WS_H); bf16* XR = WSP(bf16, WS_XR);
    const float* ng = F.in(I_NG) + (size_t)L * 4 * DM;
    for (int r = gw; r < NTOK; r += NGW) {
        Row X, O, H; if (L == 0) row_load(X, x_in_row(F, r), F.lane); else row_load_bf16(X, XR + (size_t)r * DM, F.lane); if (L == 0) row_load_out<8>(F, O, r, F.lane); else row_load_pool(F, O, r, F.lane);
        const float* m = MOD + (size_t)(L * NMR + mod_row(r)) * 12288;
        row_residual(X, O, ng + 1 * DM, m + 2 * DM, F.lane);
        row_store_bf16(X, XR + (size_t)r * DM, F.lane);
        const float rstd = rsqrtf(row_sumsq(X) * (1.f / DM) + EPS_RMS);
        row_modulate(H, X, rstd, ng + 2 * DM, m + 3 * DM, m + 4 * DM, F.lane);
        row_store_bf16(H, Hb + (size_t)r * DM, F.lane);
    }
}
template <int L> __device__ __forceinline__ void phase_postmlp(Ctx& F) {
    const int gw = F.vcu * NWAVES + F.wave, NGW = F.G * NWAVES; const float* MOD = WSP(float, WS_MOD); bf16* XR = WSP(bf16, WS_XR);
    const float* ng = F.in(I_NG) + (size_t)L * 4 * DM;
    for (int r = gw; r < NTOK; r += NGW) {
        Row X, O; row_load_bf16(X, XR + (size_t)r * DM, F.lane); row_load_out<32>(F, O, r, F.lane);
        const float* m = MOD + (size_t)(L * NMR + mod_row(r)) * 12288;
        row_residual(X, O, ng + 3 * DM, m + 5 * DM, F.lane);
        if (L == 0) {
            row_store_bf16(X, XR + (size_t)r * DM, F.lane);
            Row H; const float rstd = rsqrtf(row_sumsq(X) * (1.f / DM) + EPS_RMS);
            const float* m1 = MOD + (size_t)(1 * NMR + mod_row(r)) * 12288;
            row_modulate(H, X, rstd, F.in(I_NG) + (size_t)4 * DM, m1 + 0 * DM, m1 + 1 * DM, F.lane);
            row_store_bf16(H, WSP(bf16, WS_H) + (size_t)r * DM, F.lane);
            if (r < NPR) { const int t = r & (SEQ - 1); if (t >= SEQ - PBUF) row_store_f32(H, F.outp() + O_PLP + ((size_t)(r >> 12) * PBUF + (t - (SEQ - PBUF))) * DM, F.lane); }
            else { const int rs = r - NPR; row_store_f32(H, F.outp() + O_PLS + ((size_t)(rs >> 3) * PBUF + 7 + (rs & 7)) * DM, F.lane); }
        } else {
            float* y = r < NPR ? F.outp() + O_YP + (size_t)r * DM : F.outp() + O_YS + (size_t)(r - NPR) * DM;
            row_store_f32(X, y, F.lane);
        }
    }
    if (L == 0) {
        const float* SP = F.in(I_SPOOL); bf16* Hb = WSP(bf16, WS_H);
        for (int i = F.vcu * NTHR + F.tid; i < DBAT * PBUF * 512; i += F.G * NTHR) { const int c4 = (i & 511) * 4, bi = i >> 9, b = bi / PBUF, k = bi - b * PBUF;
            const f32x4 v = *(const GAS f32x4*)(SP + (size_t)bi * DM + c4); u32x2 w; w.x = cvt_pk_bf16(v.x, v.y); w.y = cvt_pk_bf16(v.z, v.w);
            *(GAS u32x2*)(Hb + (size_t)(NTOK + bi) * DM + c4) = w;
            if (k >= 8) *(GAS f32x4*)(F.outp() + O_PLS + ((size_t)b * PBUF + (k - 8)) * DM + c4) = v; }
    }
}

__device__ __forceinline__ void phase_kv_prep(Ctx& F) {
    { const float* MODP = WSP(float, WS_G); float* MOD = WSP(float, WS_MOD);
      for (int i = F.vcu * NTHR + F.tid; i < NMR * 8192; i += F.G * NTHR) { const int r = i >> 13, c = i & 8191; MOD[(size_t)(1 * NMR + r) * 12288 + 4096 + c] = MODP[(size_t)r * 8192 + c] + MODP[((size_t)NMR + r) * 8192 + c]; } }
    const float* P = WSP(float, WS_P);
    for (int i = F.vcu * NTHR + F.tid; i < (NBATCH + DBAT) * BCOLS; i += F.G * NTHR) {
        const int b = i / BCOLS, c = i - b * BCOLS; const int r = b < NBATCH ? b * SEQ + SEQ - 1 : NPR + (b - NBATCH) * DSEQ + DSEQ - 1;
        F.outp()[(b < NBATCH ? O_SHP + (size_t)b * BCOLS : O_SHS + (size_t)(b - NBATCH) * BCOLS) + c] = (b < NBATCH && c < 3072) ? ldbf(WSP(bf16, WS_PBH) + (size_t)r * 3072 + c) : P[(size_t)r * PBLD + c];
    }
    { const int gw = F.vcu * NWAVES + F.wave, NGW = F.G * NWAVES; const float* mu = F.in(I_MU); bf16* LA = WSP(bf16, WS_LA);
      for (int r = gw; r < NTOK; r += NGW) {
        const float* pb = P + (size_t)r * PBLD; const float* prev; bool hp;
        if (r < NPR) { const int t = r & (SEQ - 1); hp = t > 0; prev = pb - PBLD; }
        else { const int rs = r - NPR, b = rs >> 3, t = rs & 7; hp = true; prev = t > 0 ? pb - PBLD : F.in(I_SSH) + (size_t)b * BCOLS; }
        float v[8];
        { const int c0 = 3072 + F.lane * 8; const bool act = F.lane < 56; const f32x4 z4 = {0.f, 0.f, 0.f, 0.f};
          f32x4 pa = z4, pc = z4, qa = z4, qc = z4, ma = z4, mc = z4;
          if (act) { pa = *(const GAS f32x4*)(pb + c0); pc = *(const GAS f32x4*)(pb + c0 + 4); ma = *(const GAS f32x4*)(mu + c0); mc = *(const GAS f32x4*)(mu + c0 + 4);
                     if (hp) { qa = *(const GAS f32x4*)(prev + c0); qc = *(const GAS f32x4*)(prev + c0 + 4); } }
          const f32x4 za = pa + ma * (qa - pa), zc = pc + mc * (qc - pc);
          const float kz = F.lane < 12 ? 2.f : 1.f;
#pragma unroll
          for (int j = 0; j < 8; ++j) { const float z = j < 4 ? za[j & 3] : zc[j & 3]; const float sg = 1.f / (1.f + __expf(-kz * z));
              v[j] = !act ? 0.f : (F.lane < 12 ? 2.f * sg - 1.f : (F.lane < 24 ? z : sg)); } }
        u32x4 o; o.x = cvt_pk_bf16(v[0], v[1]); o.y = cvt_pk_bf16(v[2], v[3]); o.z = cvt_pk_bf16(v[4], v[5]); o.w = cvt_pk_bf16(v[6], v[7]);
        *(GAS u32x4*)(LA + (size_t)r * 512 + F.lane * 8) = o;
      } }
}
__device__ __forceinline__ void phase_rwkv_prep(Ctx& F) {
    const float* P = WSP(float, WS_P); const float* LWO = WSP(float, WS_LWO);
    const int gw = F.vcu * NWAVES + F.wave, NGW = F.G * NWAVES;
    float* RWV = WSP(float, WS_RWV); float* SCL = WSP(float, WS_SCL);
    const float* mu = F.in(I_MU);
    for (int u = gw; u < NSM * 4; u += NGW) {
        const int r = NPR + (u >> 2), hq = u & 3;
        const float* pb = P + (size_t)r * PBLD; const float* prev; const bool hp = true;
        { const int rs = r - NPR, b = rs >> 3, t = rs & 7; prev = t > 0 ? pb - PBLD : F.in(I_SSH) + (size_t)b * BCOLS; }
        const float* lw = LWO + (size_t)r * 3072;
        float pr[4], pk[4], pv[4], qr_[4], qk[4], qv[4], lwl[4], lal[4], lgl[4];
#pragma unroll
        for (int i = 0; i < 4; ++i) { const int col = (hq * 4 + i) * 64 + F.lane;
            pr[i] = pb[col]; pk[i] = pb[1024 + col]; pv[i] = pb[2048 + col];
            qr_[i] = hp ? prev[col] : 0.f; qk[i] = hp ? prev[1024 + col] : 0.f; qv[i] = hp ? prev[2048 + col] : 0.f;
            lwl[i] = lw[col]; lal[i] = lw[1024 + col]; lgl[i] = lw[2048 + col]; }
#pragma unroll
        for (int i = 0; i < 4; ++i) { const int h = hq * 4 + i, col = h * 64 + F.lane;
            const float zr = pr[i] + mu[col] * (qr_[i] - pr[i]), zk = pk[i] + mu[1024 + col] * (qk[i] - pk[i]), zv = pv[i] + mu[2048 + col] * (qv[i] - pv[i]);
            const float wl = F.in(I_W0)[col] + lwl[i], al = F.in(I_A0)[col] + lal[i], gl = lgl[i];
            const float wlog = -softplusf_(-wl) - 0.5f, decay = __expf(-__expf(wlog));
            const float a = sigmoidf_(al);
            const float kkr = zk * F.in(I_KK)[col], kk = kkr * rsqrtf(wave_sum(kkr * kkr) + 1e-12f);
            const float k = zk * (1.f + (a - 1.f) * F.in(I_KA)[col]);
            const float bb = kk * a;
            const float bonus = wave_sum(zr * k * F.in(I_RK)[col]), beta = wave_sum(bb * zr), kappa = wave_sum(k * zr);
            float* base = RWV + ((size_t)r * HB + h) * 512;
            base[F.lane] = decay; base[64 + F.lane] = kk; base[128 + F.lane] = bb; base[192 + F.lane] = k; base[256 + F.lane] = zr; base[320 + F.lane] = zv; base[384 + F.lane] = decay * zr;
            if (F.lane == 0) { float* s_ = SCL + ((size_t)r * HB + h) * 4; s_[0] = beta; s_[1] = kappa; s_[2] = bonus; s_[3] = 0.f; }
        }
    }
}

namespace sba {
typedef short bf16x8 __attribute__((ext_vector_type(8)));
typedef short s16x4 __attribute__((ext_vector_type(4)));
typedef float f32x16 __attribute__((ext_vector_type(16)));
constexpr int SHM = 16384, LDQ = 1024;
#define SB_KSWZ(row, colB) ((row) * 256 + ((colB) ^ (((row) & 7) << 4)))
#define SB_SBAR() __builtin_amdgcn_sched_barrier(0)
__device__ __forceinline__ int v_st(int k, int c) { const int kk = (k & ~0xC) | ((k & 4) << 1) | ((k & 8) >> 1); return ((kk >> 3) * 4 + (c >> 5)) * 512 + ((kk & 7) * 32 + (c & 31)) * 2; }
__device__ __forceinline__ int v_rd_base(int lane) { return ((lane & 3) << 3) | (((lane >> 2) & 3) << 6) | (((lane >> 4) & 1) << 5) | (((lane >> 5) & 1) << 8); }
__device__ __forceinline__ int crow(int r, int hi) { return (r & 3) + 8 * (r >> 2) + 4 * hi; }
__device__ __forceinline__ void qkt(f32x16& p0, f32x16& p1, const char* Kt, int r32, int hi, const bf16x8* qr) {
    p0 = f32x16{}; p1 = f32x16{};
    const char* kb[4];
#pragma unroll
    for (int dd = 0; dd < 4; ++dd) kb[dd] = Kt + SB_KSWZ(r32, (dd * 16 + hi * 8) * 2);
#pragma unroll
    for (int d0 = 0; d0 < 8; ++d0) { const char* a = kb[d0 & 3] + (d0 >> 2) * 128;
        const bf16x8 b0 = *reinterpret_cast<const bf16x8*>(a);
        const bf16x8 b1 = *reinterpret_cast<const bf16x8*>(a + 32 * 256);
        p0 = __builtin_amdgcn_mfma_f32_32x32x16_bf16(b0, qr[d0], p0, 0, 0, 0);
        p1 = __builtin_amdgcn_mfma_f32_32x32x16_bf16(b1, qr[d0], p1, 0, 0, 0); }
}
__device__ __forceinline__ void pv_tile(f32x16* o, int vb0, bf16x8 pa0, bf16x8 pa1, bf16x8 pa2, bf16x8 pa3) {
#define SB_TRRD(dst, off) asm volatile("ds_read_b64_tr_b16 %0, %1 offset:%2" : "=&v"(dst) : "v"(vb0), "i"(off) : "memory")
#define SB_PV_D0(d0) do { s16x4 l0, l1, l2, l3, h0, h1, h2, h3; constexpr int b_ = (d0) * 512; \
        SB_TRRD(l0, b_); SB_TRRD(h0, b_ + 2048); SB_TRRD(l1, b_ + 4096); SB_TRRD(h1, b_ + 6144); SB_TRRD(l2, b_ + 8192); SB_TRRD(h2, b_ + 10240); SB_TRRD(l3, b_ + 12288); SB_TRRD(h3, b_ + 14336); \
        asm volatile("s_waitcnt lgkmcnt(0)" ::: "memory"); SB_SBAR(); \
        o[d0] = __builtin_amdgcn_mfma_f32_32x32x16_bf16(pa0, (bf16x8){l0[0], l0[1], l0[2], l0[3], h0[0], h0[1], h0[2], h0[3]}, o[d0], 0, 0, 0); \
        o[d0] = __builtin_amdgcn_mfma_f32_32x32x16_bf16(pa1, (bf16x8){l1[0], l1[1], l1[2], l1[3], h1[0], h1[1], h1[2], h1[3]}, o[d0], 0, 0, 0); \
        o[d0] = __builtin_amdgcn_mfma_f32_32x32x16_bf16(pa2, (bf16x8){l2[0], l2[1], l2[2], l2[3], h2[0], h2[1], h2[2], h2[3]}, o[d0], 0, 0, 0); \
        o[d0] = __builtin_amdgcn_mfma_f32_32x32x16_bf16(pa3, (bf16x8){l3[0], l3[1], l3[2], l3[3], h3[0], h3[1], h3[2], h3[3]}, o[d0], 0, 0, 0); } while (0)
    SB_PV_D0(0); SB_PV_D0(1); SB_PV_D0(2); SB_PV_D0(3);
#undef SB_PV_D0
#undef SB_TRRD
}
__device__ __forceinline__ float swap_other(float x, int hi) {
    auto rr = __builtin_amdgcn_permlane32_swap(__float_as_uint(x), __float_as_uint(x), false, false);
    return __uint_as_float(hi ? rr[0] : rr[1]);
}
template <bool MASK> __device__ __forceinline__ void sb_weights(f32x16& p0, f32x16& p1, float& carry, float C2, float b2, int dq, int hi) {
    float T[8];
#pragma unroll
    for (int g = 0; g < 8; ++g) {
        float iv[4], be[4];
#pragma unroll
        for (int k = 0; k < 4; ++k) { const int r = (g & 3) * 4 + k; const float s = g < 4 ? p0[r] : p1[r];
            const float z2 = fminf(fmaf(s, C2, b2), 64.f), e = __builtin_amdgcn_exp2f(z2), i_ = __builtin_amdgcn_rcpf(1.f + e); float b_ = e * i_, ii = i_;
            if (MASK) { const int c = (r & 3) + 8 * (r >> 2) + (g < 4 ? 0 : 32); const bool vis = c < dq; ii = vis ? ii : 1.f; b_ = vis ? b_ : 0.f; }
            iv[k] = ii; be[k] = b_; }
        const float ex2 = iv[3], ex1 = iv[2] * iv[3], ex0 = iv[1] * ex1; T[g] = iv[0] * ex0;
        const float w0 = be[0] * ex0, w1 = be[1] * ex1, w2 = be[2] * ex2, w3 = be[3];
        if (g < 4) { p0[(g & 3) * 4 + 0] = w0; p0[(g & 3) * 4 + 1] = w1; p0[(g & 3) * 4 + 2] = w2; p0[(g & 3) * 4 + 3] = w3; }
        else { p1[(g & 3) * 4 + 0] = w0; p1[(g & 3) * 4 + 1] = w1; p1[(g & 3) * 4 + 2] = w2; p1[(g & 3) * 4 + 3] = w3; }
    }
    float suf = carry;
#pragma unroll
    for (int g = 7; g >= 0; --g) {
        const float To = swap_other(T[g], hi);
        const float E = hi ? suf : suf * To;
#pragma unroll
        for (int k = 0; k < 4; ++k) { if (g < 4) p0[(g & 3) * 4 + k] *= E; else p1[(g & 3) * 4 + k] *= E; }
        suf = suf * (T[g] * To);
    }
    carry = suf;
}
__device__ __forceinline__ void pack_p(const f32x16& p0, const f32x16& p1, bf16x8& pa0, bf16x8& pa1, bf16x8& pa2, bf16x8& pa3) {
#define SB_PK4(P, B_, OUT) do { unsigned a0 = cvt_pk_bf16(P[B_ + 0], P[B_ + 1]), a1 = cvt_pk_bf16(P[B_ + 2], P[B_ + 3]); \
        unsigned b0 = cvt_pk_bf16(P[B_ + 4], P[B_ + 5]), b1 = cvt_pk_bf16(P[B_ + 6], P[B_ + 7]); \
        auto r0 = __builtin_amdgcn_permlane32_swap(a0, b0, false, false); auto r1 = __builtin_amdgcn_permlane32_swap(a1, b1, false, false); \
        u32x4 w = {r0[0], r1[0], r0[1], r1[1]}; OUT = *reinterpret_cast<bf16x8*>(&w); } while (0)
    SB_PK4(p0, 0, pa0); SB_PK4(p0, 8, pa1); SB_PK4(p1, 0, pa2); SB_PK4(p1, 8, pa3);
#undef SB_PK4
}
__device__ __forceinline__ void attn_half(Ctx& F, int bh, int x, int half) {
    const int tid = F.tid, wid = F.wave, lane = F.lane, r32 = lane & 31, hi = lane >> 5, b = bh >> 3, h = bh & 7;
    const bf16* Qg = WSP(bf16, WS_QB) + (size_t)(b * SEQ + 256 * x) * LDQ + h * 128;
    const bf16* Kg = WSP(bf16, WS_KB) + (size_t)(b * SEQ) * LDQ + h * 128; const bf16* Vg = WSP(bf16, WS_VB) + (size_t)(b * SEQ) * LDQ + h * 128;
    const int NT = 4 * (x + 1), t_hi = half == 0 ? NT : NT / 2, t_lo = half == 0 ? NT / 2 : 0;
    const int qlo = 256 * x + 32 * wid, qpos = qlo + r32;
    char* V_lds = (char*)F.lds; char* K_lds = (char*)F.lds + 2 * SHM;
    bf16x8 qr[8];
#pragma unroll
    for (int d0 = 0; d0 < 8; ++d0) qr[d0] = *reinterpret_cast<const bf16x8*>(Qg + (size_t)(wid * 32 + r32) * LDQ + d0 * 16 + hi * 8);
    const int sr = tid >> 4, sc = (tid & 15) * 8, vst0 = v_st(sr, sc), vst1 = v_st(32 + sr, sc), kws = SB_KSWZ(sr, sc * 2);
    const int vb0 = (int)(uintptr_t)V_lds + v_rd_base(lane);
    bf16x8 st_k0, st_k1, st_v0, st_v1;
    const unsigned so0 = (unsigned)(sr * LDQ + sc) * 2u, so1 = so0 + 32u * LDQ * 2u;
#define SB_SLOAD(t) do { const char* kt_ = (const char*)Kg + (size_t)(t) * (64 * LDQ * 2); const char* vt_ = (const char*)Vg + (size_t)(t) * (64 * LDQ * 2); \
        st_k0 = *reinterpret_cast<const bf16x8*>(kt_ + so0); st_k1 = *reinterpret_cast<const bf16x8*>(kt_ + so1); st_v0 = *reinterpret_cast<const bf16x8*>(vt_ + so0); st_v1 = *reinterpret_cast<const bf16x8*>(vt_ + so1); } while (0)
#define SB_SWRITE(bf) do { *(bf16x8*)(K_lds + (bf) * SHM + kws) = st_k0; *(bf16x8*)(K_lds + (bf) * SHM + kws + 32 * 256) = st_k1; \
        *(bf16x8*)(V_lds + (bf) * SHM + vst0) = st_v0; *(bf16x8*)(V_lds + (bf) * SHM + vst1) = st_v1; } while (0)
    __syncthreads();
    SB_SLOAD(t_hi - 1); VM_WAIT(); SB_SWRITE(0);
    __syncthreads();
    const float C2 = QK_SCALE * 1.4426950408889634f, b2 = F.in(I_SBB)[h] * 1.4426950408889634f;
    float carry = 1.f; f32x16 o[4] = {};
    int buf = 0;
    for (int t = t_hi - 1; t >= t_lo; --t) {
        if (t > t_lo) SB_SLOAD(t - 1);
        const int kb = 64 * t;
        if (kb < qlo + 31) {
            f32x16 p0, p1; bf16x8 pa0, pa1, pa2, pa3;
            qkt(p0, p1, K_lds + buf * SHM, r32, hi, qr);
            if (kb + 63 >= qlo) sb_weights<true>(p0, p1, carry, C2, b2, qpos - kb - 4 * hi, hi); else sb_weights<false>(p0, p1, carry, C2, b2, 0, hi);
            pack_p(p0, p1, pa0, pa1, pa2, pa3);
            pv_tile(o, vb0 + buf * SHM, pa0, pa1, pa2, pa3);
        }
        if (t > t_lo) { VM_WAIT(); SB_SWRITE(buf ^ 1); }
        __syncthreads();
        buf ^= 1;
    }
#undef SB_SLOAD
#undef SB_SWRITE
    float* Op = WSP(float, WS_OP) + ((size_t)half * NPR + b * SEQ + 256 * x + wid * 32) * 1024 + h * 128;
    const unsigned lo_ = (unsigned)(4 * hi * 1024 + r32);
#pragma unroll
    for (int r = 0; r < 16; ++r) { float* Opr = Op + (size_t)((r & 3) + 8 * (r >> 2)) * 1024;
#pragma unroll
        for (int d0 = 0; d0 < 4; ++d0) Opr[lo_ + d0 * 32] = o[d0][r]; }
    if (half == 0 && hi == 0) WSP(float, WS_CL)[(size_t)(b * SEQ + qpos) * HA + h] = carry;
}
#undef SB_KSWZ
#undef SB_SBAR
}
namespace sba {
__device__ __forceinline__ void sb_weights32(f32x16& p0, float& carry, float C2, float b2, int hi) {
    float T[4];
#pragma unroll
    for (int g = 0; g < 4; ++g) {
        float iv[4], be[4];
#pragma unroll
        for (int k = 0; k < 4; ++k) { const float z2 = fminf(fmaf(p0[g * 4 + k], C2, b2), 64.f), e = __builtin_amdgcn_exp2f(z2), i_ = __builtin_amdgcn_rcpf(1.f + e); iv[k] = i_; be[k] = e * i_; }
        const float ex2 = iv[3], ex1 = iv[2] * iv[3], ex0 = iv[1] * ex1; T[g] = iv[0] * ex0;
        p0[g * 4 + 0] = be[0] * ex0; p0[g * 4 + 1] = be[1] * ex1; p0[g * 4 + 2] = be[2] * ex2; p0[g * 4 + 3] = be[3];
    }
    float suf = carry;
#pragma unroll
    for (int g = 3; g >= 0; --g) { const float To = swap_other(T[g], hi); const float E = hi ? suf : suf * To;
#pragma unroll
        for (int k = 0; k < 4; ++k) p0[g * 4 + k] *= E;
        suf = suf * (T[g] * To); }
    carry = suf;
}
__device__ __forceinline__ void attn_sample_unit(Ctx& F, int bh, int pg, char* wl  ) {
    const int lane = F.lane, r32 = lane & 31, hi = lane >> 5, b = bh >> 3, h = bh & 7;
    char* K_lds = wl; char* V_lds = wl + 8192;
    bf16x8 qr[8];
    { const bf16* Qg = WSP(bf16, WS_QB) + (size_t)(NPR + b * DSEQ + (r32 & 7)) * LDQ + h * 128;
#pragma unroll
      for (int d0 = 0; d0 < 8; ++d0) { bf16x8 v = *reinterpret_cast<const bf16x8*>(Qg + d0 * 16 + hi * 8); if (r32 >= 8) v = bf16x8{}; qr[d0] = v; } }
    const int kl = lane >> 5, c4 = (lane & 31) * 4;
    const unsigned goff = (unsigned)(kl * 1024 + c4) * 4u;
    const int vb0 = (int)(uintptr_t)V_lds + v_rd_base(lane);
    const float C2 = QK_SCALE * 1.4426950408889634f, b2 = F.in(I_SBB)[h] * 1.4426950408889634f;
    const int* pt = ((const int*)F.in(I_PT)) + b * NPAGES + pg * 4;
    f32x4 sa[8], sb[8];
#define SU_BASE(n) ({ const int i_ = (n) >> 2, k_ = (n) & 3, tt_ = 15 - i_; const int phys_ = pt[tt_ >> 2]; \
        (const char*)((k_ & 2) ? F.in(I_CV) : F.in(I_CK)) + (((size_t)phys_ * PAGESZ + (tt_ & 3) * 32 + (k_ & 1) * 16) * 1024 + h * 128) * 4; })
#define SU_LOAD(S, n) do { const char* bp_ = SU_BASE(n); _Pragma("unroll") for (int j = 0; j < 8; ++j) S[j] = __builtin_nontemporal_load((const GAS f32x4*)(bp_ + goff + (size_t)j * 8192)); } while (0)
#define SU_WRK(S, kh) do { _Pragma("unroll") for (int j = 0; j < 8; ++j) { const int key = (kh) * 16 + 2 * j + kl; u32x2 w; w.x = cvt_pk_bf16(S[j].x, S[j].y); w.y = cvt_pk_bf16(S[j].z, S[j].w); \
        *(u32x2*)(K_lds + (key * 256 + ((c4 * 2) ^ ((key & 7) << 4)))) = w; } } while (0)
#define SU_WRV(S, kh) do { _Pragma("unroll") for (int j = 0; j < 8; ++j) { const int key = (kh) * 16 + 2 * j + kl; u32x2 w; w.x = cvt_pk_bf16(S[j].x, S[j].y); w.y = cvt_pk_bf16(S[j].z, S[j].w); \
        *(u32x2*)(V_lds + v_st(key, c4)) = w; } } while (0)
    SU_LOAD(sa, 0); SU_LOAD(sb, 1);
    float carry = 1.f; f32x16 o[4] = {};
    for (int i = 0; i < 16; ++i) {
        asm volatile("s_waitcnt vmcnt(8)" ::: "memory"); SU_WRK(sa, 0); SU_LOAD(sa, 4 * i + 2);
        asm volatile("s_waitcnt vmcnt(8)" ::: "memory"); SU_WRK(sb, 1); SU_LOAD(sb, 4 * i + 3);
        asm volatile("s_waitcnt vmcnt(8)" ::: "memory"); SU_WRV(sa, 0); if (i < 15) SU_LOAD(sa, 4 * i + 4);
        if (i < 15) asm volatile("s_waitcnt vmcnt(8)" ::: "memory"); else asm volatile("s_waitcnt vmcnt(0)" ::: "memory");
        SU_WRV(sb, 1); if (i < 15) SU_LOAD(sb, 4 * i + 5);
        asm volatile("s_waitcnt lgkmcnt(0)" ::: "memory");
        f32x16 p0 = f32x16{};
        { const char* kb[4];
#pragma unroll
          for (int dd = 0; dd < 4; ++dd) kb[dd] = K_lds + (r32 * 256 + (((dd * 16 + hi * 8) * 2) ^ ((r32 & 7) << 4)));
#pragma unroll
          for (int d0 = 0; d0 < 8; ++d0) { const bf16x8 b0 = *reinterpret_cast<const bf16x8*>(kb[d0 & 3] + (d0 >> 2) * 128); p0 = __builtin_amdgcn_mfma_f32_32x32x16_bf16(b0, qr[d0], p0, 0, 0, 0); } }
        sb_weights32(p0, carry, C2, b2, hi);
        bf16x8 pa0, pa1;
        { unsigned a0 = cvt_pk_bf16(p0[0], p0[1]), a1 = cvt_pk_bf16(p0[2], p0[3]), b0 = cvt_pk_bf16(p0[4], p0[5]), b1 = cvt_pk_bf16(p0[6], p0[7]);
          auto r0 = __builtin_amdgcn_permlane32_swap(a0, b0, false, false); auto r1 = __builtin_amdgcn_permlane32_swap(a1, b1, false, false);
          u32x4 w = {r0[0], r1[0], r0[1], r1[1]}; pa0 = *reinterpret_cast<bf16x8*>(&w); }
        { unsigned a0 = cvt_pk_bf16(p0[8], p0[9]), a1 = cvt_pk_bf16(p0[10], p0[11]), b0 = cvt_pk_bf16(p0[12], p0[13]), b1 = cvt_pk_bf16(p0[14], p0[15]);
          auto r0 = __builtin_amdgcn_permlane32_swap(a0, b0, false, false); auto r1 = __builtin_amdgcn_permlane32_swap(a1, b1, false, false);
          u32x4 w = {r0[0], r1[0], r0[1], r1[1]}; pa1 = *reinterpret_cast<bf16x8*>(&w); }
#define SU_TRRD(dst, off) asm volatile("ds_read_b64_tr_b16 %0, %1 offset:%2" : "=&v"(dst) : "v"(vb0), "i"(off) : "memory")
#define SU_PV(d0) do { s16x4 l0, l1, h0, h1; constexpr int b_ = (d0) * 512; SU_TRRD(l0, b_); SU_TRRD(h0, b_ + 2048); SU_TRRD(l1, b_ + 4096); SU_TRRD(h1, b_ + 6144); \
        asm volatile("s_waitcnt lgkmcnt(0)" ::: "memory"); __builtin_amdgcn_sched_barrier(0); \
        o[d0] = __builtin_amdgcn_mfma_f32_32x32x16_bf16(pa0, (bf16x8){l0[0], l0[1], l0[2], l0[3], h0[0], h0[1], h0[2], h0[3]}, o[d0], 0, 0, 0); \
        o[d0] = __builtin_amdgcn_mfma_f32_32x32x16_bf16(pa1, (bf16x8){l1[0], l1[1], l1[2], l1[3], h1[0], h1[1], h1[2], h1[3]}, o[d0], 0, 0, 0); } while (0)
        SU_PV(0); SU_PV(1); SU_PV(2); SU_PV(3);
        asm volatile("s_waitcnt lgkmcnt(0)" ::: "memory");
    }
#undef SU_PV
#undef SU_TRRD
#undef SU_WRV
#undef SU_WRK
#undef SU_LOAD
#undef SU_BASE
    float* Sp = WSP(float, WS_SPART) + ((size_t)(bh * 32 + pg) * 8) * 128;
#pragma unroll
    for (int r = 0; r < 4; ++r)
#pragma unroll
        for (int d0 = 0; d0 < 4; ++d0) Sp[(size_t)(r + 4 * hi) * 128 + d0 * 32 + r32] = o[d0][r];
    if (hi == 0 && r32 < 8) WSP(float, WS_SCAR)[(size_t)(bh * 32 + pg) * 8 + r32] = carry;
}
}
__device__ __forceinline__ void sample_combine(Ctx& F) {
    const int gw = F.vcu * NWAVES + F.wave, NGW = F.G * NWAVES; bf16* OAB = WSP(bf16, WS_OAB);
    const float* SPt = WSP(float, WS_SPART); const float* SCr = WSP(float, WS_SCAR);
    for (int task = gw; task < DBAT * HA * DSEQ; task += NGW) { const int bh = task >> 3, i = task & 7, b = bh >> 3, h = bh & 7; const float bias = F.in(I_SBB)[h];
        f32x2 po[32]; float sc[32];
#pragma unroll
        for (int pg = 0; pg < 32; ++pg) { po[pg] = *(const GAS f32x2*)(SPt + ((size_t)(bh * 32 + pg) * 8 + i) * 128 + 2 * F.lane); sc[pg] = SCr[(size_t)(bh * 32 + pg) * 8 + i]; }
        f32x2 q; { const unsigned qw = *(const GAS unsigned*)(WSP(bf16, WS_QB) + (size_t)(NPR + b * DSEQ + i) * 1024 + h * 128 + 2 * F.lane); q.x = __uint_as_float(qw << 16); q.y = __uint_as_float(qw & 0xffff0000u); }
        float carry = 1.f, a0 = 0.f, a1 = 0.f;
        for (int j = i - 1; j >= 0; --j) { const size_t ko = (size_t)(b * DSEQ + j) * 1024 + h * 128 + 2 * F.lane; const f32x2 k = *(const GAS f32x2*)(F.outp() + O_KS + ko), v = *(const GAS f32x2*)(F.outp() + O_VS + ko);
            const float z = wave_sum(q.x * k.x + q.y * k.y) * QK_SCALE + bias, e = __expf(fminf(z, 40.f)), om = 1.f / (1.f + e), w = e * om * carry;
            a0 += w * v.x; a1 += w * v.y; carry *= om; }
#pragma unroll
        for (int pg = 31; pg >= 0; --pg) { a0 += carry * po[pg].x; a1 += carry * po[pg].y; carry *= sc[pg]; }
        *(GAS unsigned*)(OAB + (size_t)(NPR + b * DSEQ + i) * DM + h * 128 + 2 * F.lane) = cvt_pk_bf16(a0, a1);
    }
}
__device__ __forceinline__ void phase_attn_prompt(Ctx& F) {
    for (int it2 = 2 * F.vcu; it2 < 2 * NBATCH * HA * 16; it2 += (it2 & 1) ? 2 * F.G - 1 : 1) { const int item = it2 >> 1, half = it2 & 1, bh = item >> 4, x = item & 15;
        sba::attn_half(F, bh, half ? 15 - x : x, half); }
    __syncthreads();
}
__device__ __forceinline__ void dots16(float& sig, float& rho, float kkv, float wrv, const float (&s)[16]) {
    asm("s_nop 1\n\t"
        "v_fmac_f32_dpp %0, %2, %4 row_newbcast:0 row_mask:0xf bank_mask:0xf\n\t"
        "v_fmac_f32_dpp %1, %3, %4 row_newbcast:0 row_mask:0xf bank_mask:0xf\n\t"
        "v_fmac_f32_dpp %0, %2, %5 row_newbcast:1 row_mask:0xf bank_mask:0xf\n\t"
        "v_fmac_f32_dpp %1, %3, %5 row_newbcast:1 row_mask:0xf bank_mask:0xf\n\t"
        "v_fmac_f32_dpp %0, %2, %6 row_newbcast:2 row_mask:0xf bank_mask:0xf\n\t"
        "v_fmac_f32_dpp %1, %3, %6 row_newbcast:2 row_mask:0xf bank_mask:0xf\n\t"
        "v_fmac_f32_dpp %0, %2, %7 row_newbcast:3 row_mask:0xf bank_mask:0xf\n\t"
        "v_fmac_f32_dpp %1, %3, %7 row_newbcast:3 row_mask:0xf bank_mask:0xf\n\t"
        "v_fmac_f32_dpp %0, %2, %8 row_newbcast:4 row_mask:0xf bank_mask:0xf\n\t"
        "v_fmac_f32_dpp %1, %3, %8 row_newbcast:4 row_mask:0xf bank_mask:0xf\n\t"
        "v_fmac_f32_dpp %0, %2, %9 row_newbcast:5 row_mask:0xf bank_mask:0xf\n\t"
        "v_fmac_f32_dpp %1, %3, %9 row_newbcast:5 row_mask:0xf bank_mask:0xf\n\t"
        "v_fmac_f32_dpp %0, %2, %10 row_newbcast:6 row_mask:0xf bank_mask:0xf\n\t"
        "v_fmac_f32_dpp %1, %3, %10 row_newbcast:6 row_mask:0xf bank_mask:0xf\n\t"
        "v_fmac_f32_dpp %0, %2, %11 row_newbcast:7 row_mask:0xf bank_mask:0xf\n\t"
        "v_fmac_f32_dpp %1, %3, %11 row_newbcast:7 row_mask:0xf bank_mask:0xf\n\t"
        "v_fmac_f32_dpp %0, %2, %12 row_newbcast:8 row_mask:0xf bank_mask:0xf\n\t"
        "v_fmac_f32_dpp %1, %3, %12 row_newbcast:8 row_mask:0xf bank_mask:0xf\n\t"
        "v_fmac_f32_dpp %0, %2, %13 row_newbcast:9 row_mask:0xf bank_mask:0xf\n\t"
        "v_fmac_f32_dpp %1, %3, %13 row_newbcast:9 row_mask:0xf bank_mask:0xf\n\t"
        "v_fmac_f32_dpp %0, %2, %14 row_newbcast:10 row_mask:0xf bank_mask:0xf\n\t"
        "v_fmac_f32_dpp %1, %3, %14 row_newbcast:10 row_mask:0xf bank_mask:0xf\n\t"
        "v_fmac_f32_dpp %0, %2, %15 row_newbcast:11 row_mask:0xf bank_mask:0xf\n\t"
        "v_fmac_f32_dpp %1, %3, %15 row_newbcast:11 row_mask:0xf bank_mask:0xf\n\t"
        "v_fmac_f32_dpp %0, %2, %16 row_newbcast:12 row_mask:0xf bank_mask:0xf\n\t"
        "v_fmac_f32_dpp %1, %3, %16 row_newbcast:12 row_mask:0xf bank_mask:0xf\n\t"
        "v_fmac_f32_dpp %0, %2, %17 row_newbcast:13 row_mask:0xf bank_mask:0xf\n\t"
        "v_fmac_f32_dpp %1, %3, %17 row_newbcast:13 row_mask:0xf bank_mask:0xf\n\t"
        "v_fmac_f32_dpp %0, %2, %18 row_newbcast:14 row_mask:0xf bank_mask:0xf\n\t"
        "v_fmac_f32_dpp %1, %3, %18 row_newbcast:14 row_mask:0xf bank_mask:0xf\n\t"
        "v_fmac_f32_dpp %0, %2, %19 row_newbcast:15 row_mask:0xf bank_mask:0xf\n\t"
        "v_fmac_f32_dpp %1, %3, %19 row_newbcast:15 row_mask:0xf bank_mask:0xf\n\t"
        "s_nop 1"
        : "+v"(sig), "+v"(rho) : "v"(kkv), "v"(wrv), "v"(s[0]), "v"(s[1]), "v"(s[2]), "v"(s[3]), "v"(s[4]), "v"(s[5]), "v"(s[6]), "v"(s[7]), "v"(s[8]), "v"(s[9]), "v"(s[10]), "v"(s[11]), "v"(s[12]), "v"(s[13]), "v"(s[14]), "v"(s[15]));
}
__device__ __forceinline__ void dot16(float& acc, float zv, const float (&s)[16]) {
    asm("s_nop 1\n\t"
        "v_fmac_f32_dpp %0, %1, %2 row_newbcast:0 row_mask:0xf bank_mask:0xf\n\t"
        "v_fmac_f32_dpp %0, %1, %3 row_newbcast:1 row_mask:0xf bank_mask:0xf\n\t"
        "v_fmac_f32_dpp %0, %1, %4 row_newbcast:2 row_mask:0xf bank_mask:0xf\n\t"
        "v_fmac_f32_dpp %0, %1, %5 row_newbcast:3 row_mask:0xf bank_mask:0xf\n\t"
        "v_fmac_f32_dpp %0, %1, %6 row_newbcast:4 row_mask:0xf bank_mask:0xf\n\t"
        "v_fmac_f32_dpp %0, %1, %7 row_newbcast:5 row_mask:0xf bank_mask:0xf\n\t"
        "v_fmac_f32_dpp %0, %1, %8 row_newbcast:6 row_mask:0xf bank_mask:0xf\n\t"
        "v_fmac_f32_dpp %0, %1, %9 row_newbcast:7 row_mask:0xf bank_mask:0xf\n\t"
        "v_fmac_f32_dpp %0, %1, %10 row_newbcast:8 row_mask:0xf bank_mask:0xf\n\t"
        "v_fmac_f32_dpp %0, %1, %11 row_newbcast:9 row_mask:0xf bank_mask:0xf\n\t"
        "v_fmac_f32_dpp %0, %1, %12 row_newbcast:10 row_mask:0xf bank_mask:0xf\n\t"
        "v_fmac_f32_dpp %0, %1, %13 row_newbcast:11 row_mask:0xf bank_mask:0xf\n\t"
        "v_fmac_f32_dpp %0, %1, %14 row_newbcast:12 row_mask:0xf bank_mask:0xf\n\t"
        "v_fmac_f32_dpp %0, %1, %15 row_newbcast:13 row_mask:0xf bank_mask:0xf\n\t"
        "v_fmac_f32_dpp %0, %1, %16 row_newbcast:14 row_mask:0xf bank_mask:0xf\n\t"
        "v_fmac_f32_dpp %0, %1, %17 row_newbcast:15 row_mask:0xf bank_mask:0xf\n\t"
        "s_nop 1"
        : "+v"(acc) : "v"(zv), "v"(s[0]), "v"(s[1]), "v"(s[2]), "v"(s[3]), "v"(s[4]), "v"(s[5]), "v"(s[6]), "v"(s[7]), "v"(s[8]), "v"(s[9]), "v"(s[10]), "v"(s[11]), "v"(s[12]), "v"(s[13]), "v"(s[14]), "v"(s[15]));
}
__device__ __forceinline__ void upd16_v(float (&s)[16], float wv, float kv, float bv, float vv, float ns) {
    asm("s_nop 1\n\t"
        "v_mul_f32_dpp %0, %16, %0 row_newbcast:0 row_mask:0xf bank_mask:0xf\n\t"
        "v_mul_f32_dpp %1, %16, %1 row_newbcast:1 row_mask:0xf bank_mask:0xf\n\t"
        "v_mul_f32_dpp %2, %16, %2 row_newbcast:2 row_mask:0xf bank_mask:0xf\n\t"
        "v_mul_f32_dpp %3, %16, %3 row_newbcast:3 row_mask:0xf bank_mask:0xf\n\t"
        "v_mul_f32_dpp %4, %16, %4 row_newbcast:4 row_mask:0xf bank_mask:0xf\n\t"
        "v_mul_f32_dpp %5, %16, %5 row_newbcast:5 row_mask:0xf bank_mask:0xf\n\t"
        "v_mul_f32_dpp %6, %16, %6 row_newbcast:6 row_mask:0xf bank_mask:0xf\n\t"
        "v_mul_f32_dpp %7, %16, %7 row_newbcast:7 row_mask:0xf bank_mask:0xf\n\t"
        "v_mul_f32_dpp %8, %16, %8 row_newbcast:8 row_mask:0xf bank_mask:0xf\n\t"
        "v_mul_f32_dpp %9, %16, %9 row_newbcast:9 row_mask:0xf bank_mask:0xf\n\t"
        "v_mul_f32_dpp %10, %16, %10 row_newbcast:10 row_mask:0xf bank_mask:0xf\n\t"
        "v_mul_f32_dpp %11, %16, %11 row_newbcast:11 row_mask:0xf bank_mask:0xf\n\t"
        "v_mul_f32_dpp %12, %16, %12 row_newbcast:12 row_mask:0xf bank_mask:0xf\n\t"
        "v_mul_f32_dpp %13, %16, %13 row_newbcast:13 row_mask:0xf bank_mask:0xf\n\t"
        "v_mul_f32_dpp %14, %16, %14 row_newbcast:14 row_mask:0xf bank_mask:0xf\n\t"
        "v_mul_f32_dpp %15, %16, %15 row_newbcast:15 row_mask:0xf bank_mask:0xf\n\t"
        "v_fmac_f32_dpp %0, %17, %19 row_newbcast:0 row_mask:0xf bank_mask:0xf\n\t"
        "v_fmac_f32_dpp %1, %17, %19 row_newbcast:1 row_mask:0xf bank_mask:0xf\n\t"
        "v_fmac_f32_dpp %2, %17, %19 row_newbcast:2 row_mask:0xf bank_mask:0xf\n\t"
        "v_fmac_f32_dpp %3, %17, %19 row_newbcast:3 row_mask:0xf bank_mask:0xf\n\t"
        "v_fmac_f32_dpp %4, %17, %19 row_newbcast:4 row_mask:0xf bank_mask:0xf\n\t"
        "v_fmac_f32_dpp %5, %17, %19 row_newbcast:5 row_mask:0xf bank_mask:0xf\n\t"
        "v_fmac_f32_dpp %6, %17, %19 row_newbcast:6 row_mask:0xf bank_mask:0xf\n\t"
        "v_fmac_f32_dpp %7, %17, %19 row_newbcast:7 row_mask:0xf bank_mask:0xf\n\t"
        "v_fmac_f32_dpp %8, %17, %19 row_newbcast:8 row_mask:0xf bank_mask:0xf\n\t"
        "v_fmac_f32_dpp %9, %17, %19 row_newbcast:9 row_mask:0xf bank_mask:0xf\n\t"
        "v_fmac_f32_dpp %10, %17, %19 row_newbcast:10 row_mask:0xf bank_mask:0xf\n\t"
        "v_fmac_f32_dpp %11, %17, %19 row_newbcast:11 row_mask:0xf bank_mask:0xf\n\t"
        "v_fmac_f32_dpp %12, %17, %19 row_newbcast:12 row_mask:0xf bank_mask:0xf\n\t"
        "v_fmac_f32_dpp %13, %17, %19 row_newbcast:13 row_mask:0xf bank_mask:0xf\n\t"
        "v_fmac_f32_dpp %14, %17, %19 row_newbcast:14 row_mask:0xf bank_mask:0xf\n\t"
        "v_fmac_f32_dpp %15, %17, %19 row_newbcast:15 row_mask:0xf bank_mask:0xf\n\t"
        "v_fmac_f32_dpp %0, %18, %20 row_newbcast:0 row_mask:0xf bank_mask:0xf\n\t"
        "v_fmac_f32_dpp %1, %18, %20 row_newbcast:1 row_mask:0xf bank_mask:0xf\n\t"
        "v_fmac_f32_dpp %2, %18, %20 row_newbcast:2 row_mask:0xf bank_mask:0xf\n\t"
        "v_fmac_f32_dpp %3, %18, %20 row_newbcast:3 row_mask:0xf bank_mask:0xf\n\t"
        "v_fmac_f32_dpp %4, %18, %20 row_newbcast:4 row_mask:0xf bank_mask:0xf\n\t"
        "v_fmac_f32_dpp %5, %18, %20 row_newbcast:5 row_mask:0xf bank_mask:0xf\n\t"
        "v_fmac_f32_dpp %6, %18, %20 row_newbcast:6 row_mask:0xf bank_mask:0xf\n\t"
        "v_fmac_f32_dpp %7, %18, %20 row_newbcast:7 row_mask:0xf bank_mask:0xf\n\t"
        "v_fmac_f32_dpp %8, %18, %20 row_newbcast:8 row_mask:0xf bank_mask:0xf\n\t"
        "v_fmac_f32_dpp %9, %18, %20 row_newbcast:9 row_mask:0xf bank_mask:0xf\n\t"
        "v_fmac_f32_dpp %10, %18, %20 row_newbcast:10 row_mask:0xf bank_mask:0xf\n\t"
        "v_fmac_f32_dpp %11, %18, %20 row_newbcast:11 row_mask:0xf bank_mask:0xf\n\t"
        "v_fmac_f32_dpp %12, %18, %20 row_newbcast:12 row_mask:0xf bank_mask:0xf\n\t"
        "v_fmac_f32_dpp %13, %18, %20 row_newbcast:13 row_mask:0xf bank_mask:0xf\n\t"
        "v_fmac_f32_dpp %14, %18, %20 row_newbcast:14 row_mask:0xf bank_mask:0xf\n\t"
        "v_fmac_f32_dpp %15, %18, %20 row_newbcast:15 row_mask:0xf bank_mask:0xf\n\t"
        "s_nop 1"
        : "+v"(s[0]), "+v"(s[1]), "+v"(s[2]), "+v"(s[3]), "+v"(s[4]), "+v"(s[5]), "+v"(s[6]), "+v"(s[7]), "+v"(s[8]), "+v"(s[9]), "+v"(s[10]), "+v"(s[11]), "+v"(s[12]), "+v"(s[13]), "+v"(s[14]), "+v"(s[15]) : "v"(wv), "v"(kv), "v"(bv), "v"(vv), "v"(ns));
}
__device__ __forceinline__ void upd16_nov(float (&s)[16], float wv, float kv, float bv, float vv, float ns) {
    asm("s_nop 1\n\t"
        "v_mul_f32_dpp %0, %16, %0 row_newbcast:0 row_mask:0xf bank_mask:0xf\n\t"
        "v_mul_f32_dpp %1, %16, %1 row_newbcast:1 row_mask:0xf bank_mask:0xf\n\t"
        "v_mul_f32_dpp %2, %16, %2 row_newbcast:2 row_mask:0xf bank_mask:0xf\n\t"
        "v_mul_f32_dpp %3, %16, %3 row_newbcast:3 row_mask:0xf bank_mask:0xf\n\t"
        "v_mul_f32_dpp %4, %16, %4 row_newbcast:4 row_mask:0xf bank_mask:0xf\n\t"
        "v_mul_f32_dpp %5, %16, %5 row_newbcast:5 row_mask:0xf bank_mask:0xf\n\t"
        "v_mul_f32_dpp %6, %16, %6 row_newbcast:6 row_mask:0xf bank_mask:0xf\n\t"
        "v_mul_f32_dpp %7, %16, %7 row_newbcast:7 row_mask:0xf bank_mask:0xf\n\t"
        "v_mul_f32_dpp %8, %16, %8 row_newbcast:8 row_mask:0xf bank_mask:0xf\n\t"
        "v_mul_f32_dpp %9, %16, %9 row_newbcast:9 row_mask:0xf bank_mask:0xf\n\t"
        "v_mul_f32_dpp %10, %16, %10 row_newbcast:10 row_mask:0xf bank_mask:0xf\n\t"
        "v_mul_f32_dpp %11, %16, %11 row_newbcast:11 row_mask:0xf bank_mask:0xf\n\t"
        "v_mul_f32_dpp %12, %16, %12 row_newbcast:12 row_mask:0xf bank_mask:0xf\n\t"
        "v_mul_f32_dpp %13, %16, %13 row_newbcast:13 row_mask:0xf bank_mask:0xf\n\t"
        "v_mul_f32_dpp %14, %16, %14 row_newbcast:14 row_mask:0xf bank_mask:0xf\n\t"
        "v_mul_f32_dpp %15, %16, %15 row_newbcast:15 row_mask:0xf bank_mask:0xf\n\t"
        "v_fmac_f32_dpp %0, %18, %20 row_newbcast:0 row_mask:0xf bank_mask:0xf\n\t"
        "v_fmac_f32_dpp %1, %18, %20 row_newbcast:1 row_mask:0xf bank_mask:0xf\n\t"
        "v_fmac_f32_dpp %2, %18, %20 row_newbcast:2 row_mask:0xf bank_mask:0xf\n\t"
        "v_fmac_f32_dpp %3, %18, %20 row_newbcast:3 row_mask:0xf bank_mask:0xf\n\t"
        "v_fmac_f32_dpp %4, %18, %20 row_newbcast:4 row_mask:0xf bank_mask:0xf\n\t"
        "v_fmac_f32_dpp %5, %18, %20 row_newbcast:5 row_mask:0xf bank_mask:0xf\n\t"
        "v_fmac_f32_dpp %6, %18, %20 row_newbcast:6 row_mask:0xf bank_mask:0xf\n\t"
        "v_fmac_f32_dpp %7, %18, %20 row_newbcast:7 row_mask:0xf bank_mask:0xf\n\t"
        "v_fmac_f32_dpp %8, %18, %20 row_newbcast:8 row_mask:0xf bank_mask:0xf\n\t"
        "v_fmac_f32_dpp %9, %18, %20 row_newbcast:9 row_mask:0xf bank_mask:0xf\n\t"
        "v_fmac_f32_dpp %10, %18, %20 row_newbcast:10 row_mask:0xf bank_mask:0xf\n\t"
        "v_fmac_f32_dpp %11, %18, %20 row_newbcast:11 row_mask:0xf bank_mask:0xf\n\t"
        "v_fmac_f32_dpp %12, %18, %20 row_newbcast:12 row_mask:0xf bank_mask:0xf\n\t"
        "v_fmac_f32_dpp %13, %18, %20 row_newbcast:13 row_mask:0xf bank_mask:0xf\n\t"
        "v_fmac_f32_dpp %14, %18, %20 row_newbcast:14 row_mask:0xf bank_mask:0xf\n\t"
        "v_fmac_f32_dpp %15, %18, %20 row_newbcast:15 row_mask:0xf bank_mask:0xf\n\t"
        "s_nop 1"
        : "+v"(s[0]), "+v"(s[1]), "+v"(s[2]), "+v"(s[3]), "+v"(s[4]), "+v"(s[5]), "+v"(s[6]), "+v"(s[7]), "+v"(s[8]), "+v"(s[9]), "+v"(s[10]), "+v"(s[11]), "+v"(s[12]), "+v"(s[13]), "+v"(s[14]), "+v"(s[15]) : "v"(wv), "v"(kv), "v"(bv), "v"(vv), "v"(ns));
}
__device__ __forceinline__ float xrow16_sum(float x) {
    auto s = __builtin_amdgcn_permlane16_swap(__float_as_uint(x), __float_as_uint(x), false, false);
    x = __uint_as_float(s[0]) + __uint_as_float(s[1]);
    auto t = __builtin_amdgcn_permlane32_swap(__float_as_uint(x), __float_as_uint(x), false, false);
    return __uint_as_float(t[0]) + __uint_as_float(t[1]);
}
struct StepIn { float wv, kkv, bv, kv, wrv, vv, beta, kappa; };
template <bool PROW> __device__ __forceinline__ void scan_load(StepIn& x, const float* RWV, const float* SCL, int r, int h, int lane, int row) {
    const float* base = RWV + ((size_t)r * HB + h) * 512; const float* sc = SCL + ((size_t)r * HB + h) * 4;
    x.wv = base[lane]; x.kkv = base[64 + lane]; x.bv = base[128 + lane]; x.wrv = base[384 + lane]; x.beta = sc[0];
    if (!PROW) { x.kv = base[192 + lane]; x.vv = base[320 + row]; x.kappa = sc[1]; } else { x.kv = 0.f; x.vv = 0.f; x.kappa = 0.f; }
}
template <bool PROW, bool SAMP> __device__ __forceinline__ void scan_wave(Ctx& F, int bh, int c, int g) {
    const int lane = F.lane, q = lane >> 4, m = lane & 15, row = 16 * g + m, h = bh & 15, b = bh >> 4;
    constexpr int L = SAMP ? DSEQ : 64; const int r0 = SAMP ? NPR + b * DSEQ : b * SEQ + c * 64; const int ch = bh * 64 + c;
    const float* RWV = WSP(float, WS_RWV); const float* SCL = WSP(float, WS_SCL); float* Y = WSP(float, WS_Y); float* Z = WSP(float, WS_Z); float* PU = WSP(float, WS_PU);
    float s[16];
    if (SAMP) { const float* st = F.in(I_SWKV) + ((size_t)bh * 64 + row) * 64 + 16 * q;
#pragma unroll
        for (int i = 0; i < 16; i += 4) { const f32x4 v = *(const GAS f32x4*)(st + i); s[i] = v.x; s[i + 1] = v.y; s[i + 2] = v.z; s[i + 3] = v.w; } }
    else {
#pragma unroll
        for (int i = 0; i < 16; ++i) s[i] = (PROW && (16 * q + i) == row) ? 1.f : 0.f; }
    StepIn buf[4];
#pragma unroll
    for (int u = 0; u < 4; ++u) scan_load<PROW>(buf[u], RWV, SCL, r0 + u, h, lane, row);
    for (int t = 0; t < L; t += 4) {
#pragma unroll
        for (int u = 0; u < 4; ++u) {
            const StepIn x = buf[u];
            if (t + u + 4 < L) scan_load<PROW>(buf[u], RWV, SCL, r0 + t + u + 4, h, lane, row);
            float sig = 0.f, rho = 0.f;
            dots16(sig, rho, x.kkv, x.wrv, s);
            sig = xrow16_sum(sig); rho = xrow16_sum(rho);
            const float ns = -sig;
            float y = rho + ns * x.beta; if (!PROW) y += x.vv * x.kappa;
            if (q == 0) { if (PROW) Z[((size_t)ch * 64 + t + u) * 64 + row] = y; else Y[(size_t)(r0 + t + u) * 1024 + h * 64 + row] = y; }
            if (PROW) upd16_nov(s, x.wv, x.kv, x.bv, x.vv, ns); else upd16_v(s, x.wv, x.kv, x.bv, x.vv, ns);
        }
    }
    float* dst = SAMP ? F.outp() + O_WKVS + ((size_t)bh * 64 + row) * 64 + 16 * q : PU + (((size_t)ch * 2 + (PROW ? 1 : 0)) * 64 + row) * 64 + 16 * q;
#pragma unroll
    for (int i = 0; i < 16; i += 4) *(GAS f32x4*)(dst + i) = (f32x4){s[i], s[i + 1], s[i + 2], s[i + 3]};
}
__device__ __forceinline__ void dots2_h0(float& sgu, float& rhu, float& sgp, float& rhp, float kkv, float wrv, const float (&su)[16], const float (&sp)[16]) {
    asm("s_nop 1\n\t"
        "v_fmac_f32_dpp %0, %4, %6 row_newbcast:0 row_mask:0xf bank_mask:0xf\n\t"
        "v_fmac_f32_dpp %1, %5, %6 row_newbcast:0 row_mask:0xf bank_mask:0xf\n\t"
        "v_fmac_f32_dpp %2, %4, %14 row_newbcast:0 row_mask:0xf bank_mask:0xf\n\t"
        "v_fmac_f32_dpp %3, %5, %14 row_newbcast:0 row_mask:0xf bank_mask:0xf\n\t"
        "v_fmac_f32_dpp %0, %4, %7 row_newbcast:1 row_mask:0xf bank_mask:0xf\n\t"
        "v_fmac_f32_dpp %1, %5, %7 row_newbcast:1 row_mask:0xf bank_mask:0xf\n\t"
        "v_fmac_f32_dpp %2, %4, %15 row_newbcast:1 row_mask:0xf bank_mask:0xf\n\t"
        "v_fmac_f32_dpp %3, %5, %15 row_newbcast:1 row_mask:0xf bank_mask:0xf\n\t"
        "v_fmac_f32_dpp %0, %4, %8 row_newbcast:2 row_mask:0xf bank_mask:0xf\n\t"
        "v_fmac_f32_dpp %1, %5, %8 row_newbcast:2 row_mask:0xf bank_mask:0xf\n\t"
        "v_fmac_f32_dpp %2, %4, %16 row_newbcast:2 row_mask:0xf bank_mask:0xf\n\t"
        "v_fmac_f32_dpp %3, %5, %16 row_newbcast:2 row_mask:0xf bank_mask:0xf\n\t"
        "v_fmac_f32_dpp %0, %4, %9 row_newbcast:3 row_mask:0xf bank_mask:0xf\n\t"
        "v_fmac_f32_dpp %1, %5, %9 row_newbcast:3 row_mask:0xf bank_mask:0xf\n\t"
        "v_fmac_f32_dpp %2, %4, %17 row_newbcast:3 row_mask:0xf bank_mask:0xf\n\t"
        "v_fmac_f32_dpp %3, %5, %17 row_newbcast:3 row_mask:0xf bank_mask:0xf\n\t"
        "v_fmac_f32_dpp %0, %4, %10 row_newbcast:4 row_mask:0xf bank_mask:0xf\n\t"
        "v_fmac_f32_dpp %1, %5, %10 row_newbcast:4 row_mask:0xf bank_mask:0xf\n\t"
        "v_fmac_f32_dpp %2, %4, %18 row_newbcast:4 row_mask:0xf bank_mask:0xf\n\t"
        "v_fmac_f32_dpp %3, %5, %18 row_newbcast:4 row_mask:0xf bank_mask:0xf\n\t"
        "v_fmac_f32_dpp %0, %4, %11 row_newbcast:5 row_mask:0xf bank_mask:0xf\n\t"
        "v_fmac_f32_dpp %1, %5, %11 row_newbcast:5 row_mask:0xf bank_mask:0xf\n\t"
        "v_fmac_f32_dpp %2, %4, %19 row_newbcast:5 row_mask:0xf bank_mask:0xf\n\t"
        "v_fmac_f32_dpp %3, %5, %19 row_newbcast:5 row_mask:0xf bank_mask:0xf\n\t"
        "v_fmac_f32_dpp %0, %4, %12 row_newbcast:6 row_mask:0xf bank_mask:0xf\n\t"
        "v_fmac_f32_dpp %1, %5, %12 row_newbcast:6 row_mask:0xf bank_mask:0xf\n\t"
        "v_fmac_f32_dpp %2, %4, %20 row_newbcast:6 row_mask:0xf bank_mask:0xf\n\t"
        "v_fmac_f32_dpp %3, %5, %20 row_newbcast:6 row_mask:0xf bank_mask:0xf\n\t"
        "v_fmac_f32_dpp %0, %4, %13 row_newbcast:7 row_mask:0xf bank_mask:0xf\n\t"
        "v_fmac_f32_dpp %1, %5, %13 row_newbcast:7 row_mask:0xf bank_mask:0xf\n\t"
        "v_fmac_f32_dpp %2, %4, %21 row_newbcast:7 row_mask:0xf bank_mask:0xf\n\t"
        "v_fmac_f32_dpp %3, %5, %21 row_newbcast:7 row_mask:0xf bank_mask:0xf\n\t"
        "s_nop 1"
        : "+v"(sgu), "+v"(rhu), "+v"(sgp), "+v"(rhp) : "v"(kkv), "v"(wrv), "v"(su[0]), "v"(su[1]), "v"(su[2]), "v"(su[3]), "v"(su[4]), "v"(su[5]), "v"(su[6]), "v"(su[7]), "v"(sp[0]), "v"(sp[1]), "v"(sp[2]), "v"(sp[3]), "v"(sp[4]), "v"(sp[5]), "v"(sp[6]), "v"(sp[7]));
}
__device__ __forceinline__ void dots2_h1(float& sgu, float& rhu, float& sgp, float& rhp, float kkv, float wrv, const float (&su)[16], const float (&sp)[16]) {
    asm("s_nop 1\n\t"
        "v_fmac_f32_dpp %0, %4, %6 row_newbcast:8 row_mask:0xf bank_mask:0xf\n\t"
        "v_fmac_f32_dpp %1, %5, %6 row_newbcast:8 row_mask:0xf bank_mask:0xf\n\t"
        "v_fmac_f32_dpp %2, %4, %14 row_newbcast:8 row_mask:0xf bank_mask:0xf\n\t"
        "v_fmac_f32_dpp %3, %5, %14 row_newbcast:8 row_mask:0xf bank_mask:0xf\n\t"
        "v_fmac_f32_dpp %0, %4, %7 row_newbcast:9 row_mask:0xf bank_mask:0xf\n\t"
        "v_fmac_f32_dpp %1, %5, %7 row_newbcast:9 row_mask:0xf bank_mask:0xf\n\t"
        "v_fmac_f32_dpp %2, %4, %15 row_newbcast:9 row_mask:0xf bank_mask:0xf\n\t"
        "v_fmac_f32_dpp %3, %5, %15 row_newbcast:9 row_mask:0xf bank_mask:0xf\n\t"
        "v_fmac_f32_dpp %0, %4, %8 row_newbcast:10 row_mask:0xf bank_mask:0xf\n\t"
        "v_fmac_f32_dpp %1, %5, %8 row_newbcast:10 row_mask:0xf bank_mask:0xf\n\t"
        "v_fmac_f32_dpp %2, %4, %16 row_newbcast:10 row_mask:0xf bank_mask:0xf\n\t"
        "v_fmac_f32_dpp %3, %5, %16 row_newbcast:10 row_mask:0xf bank_mask:0xf\n\t"
        "v_fmac_f32_dpp %0, %4, %9 row_newbcast:11 row_mask:0xf bank_mask:0xf\n\t"
        "v_fmac_f32_dpp %1, %5, %9 row_newbcast:11 row_mask:0xf bank_mask:0xf\n\t"
        "v_fmac_f32_dpp %2, %4, %17 row_newbcast:11 row_mask:0xf bank_mask:0xf\n\t"
        "v_fmac_f32_dpp %3, %5, %17 row_newbcast:11 row_mask:0xf bank_mask:0xf\n\t"
        "v_fmac_f32_dpp %0, %4, %10 row_newbcast:12 row_mask:0xf bank_mask:0xf\n\t"
        "v_fmac_f32_dpp %1, %5, %10 row_newbcast:12 row_mask:0xf bank_mask:0xf\n\t"
        "v_fmac_f32_dpp %2, %4, %18 row_newbcast:12 row_mask:0xf bank_mask:0xf\n\t"
        "v_fmac_f32_dpp %3, %5, %18 row_newbcast:12 row_mask:0xf bank_mask:0xf\n\t"
        "v_fmac_f32_dpp %0, %4, %11 row_newbcast:13 row_mask:0xf bank_mask:0xf\n\t"
        "v_fmac_f32_dpp %1, %5, %11 row_newbcast:13 row_mask:0xf bank_mask:0xf\n\t"
        "v_fmac_f32_dpp %2, %4, %19 row_newbcast:13 row_mask:0xf bank_mask:0xf\n\t"
        "v_fmac_f32_dpp %3, %5, %19 row_newbcast:13 row_mask:0xf bank_mask:0xf\n\t"
        "v_fmac_f32_dpp %0, %4, %12 row_newbcast:14 row_mask:0xf bank_mask:0xf\n\t"
        "v_fmac_f32_dpp %1, %5, %12 row_newbcast:14 row_mask:0xf bank_mask:0xf\n\t"
        "v_fmac_f32_dpp %2, %4, %20 row_newbcast:14 row_mask:0xf bank_mask:0xf\n\t"
        "v_fmac_f32_dpp %3, %5, %20 row_newbcast:14 row_mask:0xf bank_mask:0xf\n\t"
        "v_fmac_f32_dpp %0, %4, %13 row_newbcast:15 row_mask:0xf bank_mask:0xf\n\t"
        "v_fmac_f32_dpp %1, %5, %13 row_newbcast:15 row_mask:0xf bank_mask:0xf\n\t"
        "v_fmac_f32_dpp %2, %4, %21 row_newbcast:15 row_mask:0xf bank_mask:0xf\n\t"
        "v_fmac_f32_dpp %3, %5, %21 row_newbcast:15 row_mask:0xf bank_mask:0xf\n\t"
        "s_nop 1"
        : "+v"(sgu), "+v"(rhu), "+v"(sgp), "+v"(rhp) : "v"(kkv), "v"(wrv), "v"(su[8]), "v"(su[9]), "v"(su[10]), "v"(su[11]), "v"(su[12]), "v"(su[13]), "v"(su[14]), "v"(su[15]), "v"(sp[8]), "v"(sp[9]), "v"(sp[10]), "v"(sp[11]), "v"(sp[12]), "v"(sp[13]), "v"(sp[14]), "v"(sp[15]));
}
__device__ __forceinline__ void scan_wave_up(Ctx& F, int bh, int c, int g) {
    const int lane = F.lane, q = lane >> 4, m = lane & 15, row = 16 * g + m, h = bh & 15, b = bh >> 4;
    const int r0 = b * SEQ + c * 64, ch = bh * 64 + c;
    const float* RWV = WSP(float, WS_RWV); const float* SCL = WSP(float, WS_SCL); float* Y = WSP(float, WS_Y); float* Z = WSP(float, WS_Z); float* PU = WSP(float, WS_PU);
    float su[16], sp[16];
#pragma unroll
    for (int i = 0; i < 16; ++i) { su[i] = 0.f; sp[i] = ((16 * q + i) == row) ? 1.f : 0.f; }
    StepIn buf[4];
#pragma unroll
    for (int u = 0; u < 4; ++u) scan_load<false>(buf[u], RWV, SCL, r0 + u, h, lane, row);
    for (int t = 0; t < 64; t += 4) {
#pragma unroll
        for (int u = 0; u < 4; ++u) {
            const StepIn x = buf[u];
            if (t + u + 4 < 64) scan_load<false>(buf[u], RWV, SCL, r0 + t + u + 4, h, lane, row);
            float sgu = 0.f, rhu = 0.f, sgp = 0.f, rhp = 0.f;
            dots2_h0(sgu, rhu, sgp, rhp, x.kkv, x.wrv, su, sp); dots2_h1(sgu, rhu, sgp, rhp, x.kkv, x.wrv, su, sp);
            sgu = xrow16_sum(sgu); rhu = xrow16_sum(rhu); sgp = xrow16_sum(sgp); rhp = xrow16_sum(rhp);
            const float nsu = -sgu, nsp = -sgp;
            const float y = rhu + nsu * x.beta + x.vv * x.kappa, z = rhp + nsp * x.beta;
            if (q == 0) { Y[(size_t)(r0 + t + u) * 1024 + h * 64 + row] = y; Z[((size_t)ch * 64 + t + u) * 64 + row] = z; }
            upd16_v(su, x.wv, x.kv, x.bv, x.vv, nsu); upd16_nov(sp, x.wv, x.kv, x.bv, x.vv, nsp);
        }
    }
    float* du = PU + (((size_t)ch * 2 + 0) * 64 + row) * 64 + 16 * q; float* dp = PU + (((size_t)ch * 2 + 1) * 64 + row) * 64 + 16 * q;
#pragma unroll
    for (int i = 0; i < 16; i += 4) { *(GAS f32x4*)(du + i) = (f32x4){su[i], su[i + 1], su[i + 2], su[i + 3]}; *(GAS f32x4*)(dp + i) = (f32x4){sp[i], sp[i + 1], sp[i + 2], sp[i + 3]}; }
}
__device__ __forceinline__ void phase_scan1_stream(Ctx& F) {
    LAS int* ctr = (LAS int*)(F.lds + LDSCTL_OFF);
    __syncthreads(); if (F.tid == 0) *ctr = 0; __syncthreads();
    if (F.wave >= 6) { for (int u = F.vcu * 2 + (F.wave - 6); u < DBAT * HA * 32; u += 2 * F.G) sba::attn_sample_unit(F, u >> 5, u & 31, (char*)F.lds + F.wave * 16384); }
    constexpr int NSU = DBAT * HB / 2, NU = NSU + NBATCH * HB * 64;
    const int nunits = F.vcu < NU ? (NU - 1 - F.vcu) / F.G + 1 : 0, ntasks = nunits * 8;
    for (;;) {
        int t = 0; if (F.lane == 0) t = __hip_atomic_fetch_add(ctr, 1, __ATOMIC_RELAXED, __HIP_MEMORY_SCOPE_WORKGROUP);
        t = __builtin_amdgcn_readfirstlane(t); if (t >= ntasks) break;
        const int u = F.vcu + (t >> 3) * F.G, g8 = t & 7;
        if (u < NSU) scan_wave<false, true>(F, u * 2 + (g8 >> 2), 0, g8 & 3);
        else if (g8 < 4) { const int ch = u - NSU; scan_wave_up(F, ch >> 6, ch & 63, g8); }
    }
}
namespace msc {
using sba::bf16x8; using sba::f32x16; using sba::crow; using sba::swap_other;
constexpr int S_AQ = 136, S_BKT = 104, S_L = 40;
constexpr int O_AQ = 0, O_BK = 32 * S_AQ, O_L24 = O_BK, O_TL3 = O_BK + 32 * S_L, O_BKT = 2 * 32 * S_AQ, BLK_BYTES = O_BKT + 64 * S_BKT, O_GL = 4 * BLK_BYTES, O_GP = O_GL + 256, GRP_BYTES = O_GP + 4 * 256;
static_assert(BLK_BYTES % 8 == 0 && 2 * GRP_BYTES <= RING_BYTES, "scan LDS map");
typedef __bf16 nbf2 __attribute__((ext_vector_type(2)));
__device__ __forceinline__ unsigned cvt2(float lo, float hi) { return __builtin_bit_cast(unsigned, __builtin_convertvector((f32x2){lo, hi}, nbf2)); }
__device__ __forceinline__ bf16x8 pack8(float a0, float a1, float a2, float a3, float a4, float a5, float a6, float a7) {
    u32x4 w = {cvt2(a0, a1), cvt2(a2, a3), cvt2(a4, a5), cvt2(a6, a7)}; return *reinterpret_cast<bf16x8*>(&w); }
__device__ __forceinline__ bf16x8 pack_lo(const f32x16& c) { return pack8(c[0], c[1], c[2], c[3], c[4], c[5], c[6], c[7]); }
__device__ __forceinline__ bf16x8 pack_hi(const f32x16& c) { return pack8(c[8], c[9], c[10], c[11], c[12], c[13], c[14], c[15]); }
__device__ __forceinline__ bf16x8 perm_read(const LAS char* img, int row, int pitch, int col0, int g) {
    const LAS char* p = img + row * pitch + (col0 + 4 * g) * 2; const u32x2 lo = *(const LAS u32x2*)p, hi = *(const LAS u32x2*)(p + 16);
    u32x4 w = {lo.x, lo.y, hi.x, hi.y}; return *reinterpret_cast<bf16x8*>(&w); }
__device__ __forceinline__ bf16x8 nat_read(const LAS char* img, int row, int pitch, int col0) {
    const LAS char* p = img + row * pitch + col0 * 2; const u32x2 lo = *(const LAS u32x2*)p, hi = *(const LAS u32x2*)(p + 8);
    u32x4 w = {lo.x, lo.y, hi.x, hi.y}; return *reinterpret_cast<bf16x8*>(&w); }
__device__ __forceinline__ unsigned short bf1(float x) { return (unsigned short)(cvt_pk_bf16(x, 0.f) & 0xffffu); }
struct PrepRegs { float pr[17], pk[17], pv[17], lwl[16]; const bf16* lw; };
__device__ __forceinline__ void prep_load(Ctx& F, PrepRegs& L, int rb, int h) {
    const bf16* pb = WSP(bf16, WS_PBH) + (size_t)rb * 3072 + h * 64 + F.lane; const bf16* lw = WSP(bf16, WS_LWH) + (size_t)rb * 3072 + h * 64 + F.lane;
    L.lw = lw;
#pragma unroll
    for (int t = 0; t < 16; ++t) L.lwl[t] = ldbf_nt(lw + (size_t)t * 3072);
    if ((rb & (SEQ - 1)) != 0) { L.pr[0] = ldbf_nt(pb - 3072); L.pk[0] = ldbf_nt(pb + 1024 - 3072); L.pv[0] = ldbf_nt(pb + 2048 - 3072); } else { L.pr[0] = 0.f; L.pk[0] = 0.f; L.pv[0] = 0.f; }
#pragma unroll
    for (int t = 0; t < 16; ++t) { L.pr[t + 1] = ldbf_nt(pb + (size_t)t * 3072); L.pk[t + 1] = ldbf_nt(pb + (size_t)t * 3072 + 1024); L.pv[t + 1] = ldbf_nt(pb + (size_t)t * 3072 + 2048); }
}
__device__ __forceinline__ void prep_block(Ctx& F, PrepRegs& L, int rb, int h, int j, LAS char* gbase) {
    const int lane = F.lane, n = lane & 31, hi = lane >> 5, col = h * 64 + lane; LAS char* blk = gbase + j * BLK_BYTES;
    float lal[16];
#pragma unroll
    for (int t = 0; t < 16; ++t) lal[t] = ldbf_nt(L.lw + (size_t)t * 3072 + 1024);
    const float* mu = F.in(I_MU); const float mu_r = mu[col], mu_k = mu[1024 + col], mu_v = mu[2048 + col];
    const float w0 = F.in(I_W0)[col], a0 = F.in(I_A0)[col], kkw = F.in(I_KK)[col], kaw = F.in(I_KA)[col], rkw = F.in(I_RK)[col];
    float cw[16];
#pragma unroll
    for (int t = 0; t < 16; ++t) { const float wl = w0 + L.lwl[t], wlog = -softplusf_(-wl) - 0.5f; cw[t] = __expf(-__expf(wlog)); }
#pragma unroll
    for (int t = 1; t < 16; ++t) cw[t] *= cw[t - 1];
    *(LAS float*)(gbase + O_GP + (j * 64 + lane) * 4) = cw[15];
    __syncthreads();
    const float g0 = *(const LAS float*)(gbase + O_GP + lane * 4), g1 = *(const LAS float*)(gbase + O_GP + (64 + lane) * 4), g2 = *(const LAS float*)(gbase + O_GP + (128 + lane) * 4);
    const float G0 = (j > 0 ? g0 : 1.f) * (j > 1 ? g1 : 1.f) * (j > 2 ? g2 : 1.f);
    if (j == 3) *(LAS float*)(gbase + O_GL + lane * 4) = G0 * cw[15];
    float* SCL = WSP(float, WS_SCL) + ((size_t)rb * HB + h) * 4;
#pragma unroll
    for (int tl = 0; tl < 16; tl += 2) {
        float nb[2], kt[2], vz[2];
#pragma unroll
        for (int u = 0; u < 2; ++u) { const int t = tl + u;
            const float zr = L.pr[t + 1] + mu_r * (L.pr[t] - L.pr[t + 1]), zk = L.pk[t + 1] + mu_k * (L.pk[t] - L.pk[t + 1]); vz[u] = L.pv[t + 1] + mu_v * (L.pv[t] - L.pv[t + 1]);
            const float a_ = sigmoidf_(a0 + lal[t]);
            const float kkr = zk * kkw, kk = kkr * rsqrtf(wave_sum(kkr * kkr) + 1e-12f);
            const float k = zk * (1.f + (a_ - 1.f) * kaw), bb = kk * a_;
            const float bonus = wave_sum(zr * k * rkw);
            if (lane == 0) SCL[(size_t)t * HB * 4 + 2] = bonus;
            const float Gp = t ? G0 * cw[t ? t - 1 : 0] : G0, G = G0 * cw[t], gi = 1.f / G;
            const float a = kk * Gp, q = zr * G, bt = bb * gi; kt[u] = k * gi; nb[u] = -bt;
            *(LAS unsigned short*)(blk + O_AQ + t * S_AQ + lane * 2) = bf1(a); *(LAS unsigned short*)(blk + O_AQ + (16 + t) * S_AQ + lane * 2) = bf1(q);
            *(LAS unsigned short*)(blk + O_BK + t * S_AQ + lane * 2) = bf1(bt); *(LAS unsigned short*)(blk + O_BK + (16 + t) * S_AQ + lane * 2) = bf1(kt[u]); }
        *(LAS unsigned*)(blk + O_BKT + lane * S_BKT + tl * 2) = cvt_pk_bf16(nb[0], nb[1]); *(LAS unsigned*)(blk + O_BKT + lane * S_BKT + (16 + tl) * 2) = cvt_pk_bf16(kt[0], kt[1]);
        *(LAS unsigned*)(blk + O_BKT + lane * S_BKT + (32 + tl) * 2) = cvt_pk_bf16(vz[0], vz[1]);
    }
    LDS_WAIT(); asm volatile("" ::: "memory");
    f32x16 mt = f32x16{};
#pragma unroll
    for (int ks = 0; ks < 4; ++ks) mt = __builtin_amdgcn_mfma_f32_32x32x16_bf16(nat_read(blk + O_AQ, n, S_AQ, 16 * ks + 8 * hi), nat_read(blk + O_BK, n, S_AQ, 16 * ks + 8 * hi), mt, 0, 0, 0);
    float l1[8];
    const int i = n & 15;
#pragma unroll
    for (int r = 0; r < 16; ++r) { const int t = crow(r, hi) & 15; float val = mt[r];
        if (r < 8) { val = t > i ? val : 0.f; if (n >= 16) *(LAS unsigned short*)(blk + O_L24 + t * S_L + i * 2) = bf1(val); l1[r] = val; }
        else { val = t >= i ? val : 0.f; if (n >= 16) *(LAS unsigned short*)(blk + O_L24 + (16 + t) * S_L + i * 2) = bf1(val); else *(LAS unsigned short*)(blk + O_TL3 + (16 + t) * S_L + i * 2) = bf1(-val); } }
    float rowv[16];
#pragma unroll
    for (int r = 0; r < 8; ++r) { const float own = l1[r], oth = swap_other(own, hi); const int p0 = (r & 3) + 8 * (r >> 2); rowv[p0] = hi ? oth : own; rowv[p0 + 4] = hi ? own : oth; }
    float tl_[16];
    tl_[0] = lane == 0 ? 1.f : 0.f;
#pragma unroll
    for (int t = 1; t < 16; ++t) { float acc = lane == t ? 1.f : 0.f;
#pragma unroll
        for (int jj = 0; jj < t; ++jj) acc -= readlane_f(rowv[t], jj) * tl_[jj];
        tl_[t] = acc; }
    if (lane < 16) {
#pragma unroll
        for (int t = 0; t < 16; ++t) *(LAS unsigned short*)(blk + O_TL3 + t * S_L + lane * 2) = bf1(tl_[t]); }
    LDS_WAIT(); asm volatile("" ::: "memory");
}
__device__ __forceinline__ void chain(Ctx& F, int bh, int c, int isP, int half, const LAS char* gbase) {
    const int lane = F.lane, n = lane & 31, hi = lane >> 5, rowg = 32 * half + n, h = bh & 15, b = bh >> 4, r0 = b * SEQ + c * 64, ch = bh * 64 + c;
    const float* RWV = WSP(float, WS_RWV);
    f32x16 st0 = f32x16{}, st1 = f32x16{};
    if (isP) {
#pragma unroll
        for (int r = 0; r < 16; ++r) { st0[r] = crow(r, hi) == rowg ? 1.f : 0.f; st1[r] = 32 + crow(r, hi) == rowg ? 1.f : 0.f; } }
    for (int blk_i = 0; blk_i < 4; ++blk_i) {
        const LAS char* blk = gbase + blk_i * BLK_BYTES;
        f32x16 wt = f32x16{};
        wt = __builtin_amdgcn_mfma_f32_32x32x16_bf16(perm_read(blk + O_AQ, n, S_AQ, 0, hi), pack_lo(st0), wt, 0, 0, 0);
        wt = __builtin_amdgcn_mfma_f32_32x32x16_bf16(perm_read(blk + O_AQ, n, S_AQ, 16, hi), pack_hi(st0), wt, 0, 0, 0);
        wt = __builtin_amdgcn_mfma_f32_32x32x16_bf16(perm_read(blk + O_AQ, n, S_AQ, 32, hi), pack_lo(st1), wt, 0, 0, 0);
        wt = __builtin_amdgcn_mfma_f32_32x32x16_bf16(perm_read(blk + O_AQ, n, S_AQ, 48, hi), pack_hi(st1), wt, 0, 0, 0);
        bf16x8 bV = bf16x8{};
        if (!isP) { bV = perm_read(blk + O_BKT, rowg, S_BKT, 32, hi);
            wt = __builtin_amdgcn_mfma_f32_32x32x16_bf16(perm_read(blk + O_L24, n, S_L, 0, hi), bV, wt, 0, 0, 0); }
        const bf16x8 tl3 = perm_read(blk + O_TL3, n, S_L, 0, hi);
        const bf16x8 a_tl = n < 16 ? tl3 : bf16x8{}, a_l3 = n >= 16 ? tl3 : bf16x8{};
        const f32x16 sg = __builtin_amdgcn_mfma_f32_32x32x16_bf16(a_tl, pack_lo(wt), f32x16{}, 0, 0, 0);
        const bf16x8 bSg = pack_lo(sg);
        const f32x16 yy = __builtin_amdgcn_mfma_f32_32x32x16_bf16(a_l3, bSg, wt, 0, 0, 0);
#pragma unroll
        for (int r = 8; r < 16; ++r) { const int t = blk_i * 16 + (r & 3) + 8 * ((r - 8) >> 2) + 4 * hi;
            if (isP) WSP(float, WS_Z)[((size_t)ch * 64 + t) * 64 + rowg] = yy[r]; else WSP(float, WS_Y)[(size_t)(r0 + t) * 1024 + h * 64 + rowg] = yy[r]; }
        st0 = __builtin_amdgcn_mfma_f32_32x32x16_bf16(perm_read(blk + O_BKT, n, S_BKT, 0, hi), bSg, st0, 0, 0, 0);
        st1 = __builtin_amdgcn_mfma_f32_32x32x16_bf16(perm_read(blk + O_BKT, 32 + n, S_BKT, 0, hi), bSg, st1, 0, 0, 0);
        if (!isP) { st0 = __builtin_amdgcn_mfma_f32_32x32x16_bf16(perm_read(blk + O_BKT, n, S_BKT, 16, hi), bV, st0, 0, 0, 0);
                    st1 = __builtin_amdgcn_mfma_f32_32x32x16_bf16(perm_read(blk + O_BKT, 32 + n, S_BKT, 16, hi), bV, st1, 0, 0, 0); }
    }
    const LAS float* GL = (const LAS float*)(gbase + O_GL); float* dst = WSP(float, WS_PU) + (((size_t)ch * 2 + isP) * 64 + rowg) * 64;
#pragma unroll
    for (int g4 = 0; g4 < 4; ++g4) { const int k0 = 8 * g4 + 4 * hi; const f32x4 ga = *(const LAS f32x4*)(GL + k0), gb = *(const LAS f32x4*)(GL + 32 + k0);
        *(GAS f32x4*)(dst + k0) = (f32x4){st0[4 * g4] * ga.x, st0[4 * g4 + 1] * ga.y, st0[4 * g4 + 2] * ga.z, st0[4 * g4 + 3] * ga.w};
        *(GAS f32x4*)(dst + 32 + k0) = (f32x4){st1[4 * g4] * gb.x, st1[4 * g4 + 1] * gb.y, st1[4 * g4 + 2] * gb.z, st1[4 * g4 + 3] * gb.w}; }
}
}
__device__ __forceinline__ void phase_sample_stream(Ctx& F) {
    for (int u = F.vcu * NWAVES + F.wave; u < DBAT * HA * 32; u += NWAVES * F.G) sba::attn_sample_unit(F, (u >> 8) * HA + (u & 7), (u >> 3) & 31, (char*)F.lds + F.wave * 16384);
}
__device__ __forceinline__ void phase_scan1_mfma(Ctx& F) {
    __syncthreads();
    const int grp = F.wave >> 2, wq = F.wave & 3; LAS char* gbase = (LAS char*)F.lds + grp * msc::GRP_BYTES;
    msc::PrepRegs L;
    { const int ch = 2 * F.vcu + grp; if (ch < NBATCH * HB * 64) msc::prep_load(F, L, (ch >> 10) * SEQ + (ch & 63) * 64 + 16 * wq, (ch >> 6) & 15); }
    for (int base = 2 * F.vcu; base < NBATCH * HB * 64; base += 2 * F.G) {
        const int ch = base + grp, bh = ch >> 6, c = ch & 63;
        msc::prep_block(F, L, (bh >> 4) * SEQ + c * 64 + 16 * wq, bh & 15, wq, gbase);
        __syncthreads();
        { const int chn = ch + 2 * F.G; if (chn < NBATCH * HB * 64) msc::prep_load(F, L, (chn >> 10) * SEQ + (chn & 63) * 64 + 16 * wq, (chn >> 6) & 15); }
        msc::chain(F, bh, c, wq >> 1, wq & 1, gbase);
    }
}
__device__ __forceinline__ void phase_scan2(Ctx& F) {
    LAS float* Pb = (LAS float*)(F.lds + 4096);
    const float* PU = WSP(float, WS_PU); float* SC = WSP(float, WS_SC);
    for (int unit = F.vcu; unit < NBATCH * HB * 8; unit += F.G) {
        const int bh = unit >> 3, r0 = (unit & 7) * 8, r = F.wave, col = F.lane;
        __syncthreads();
        { const float* P0 = PU + ((size_t)(bh * 64) * 2 + 1) * 4096; const f32x4 a = *(const GAS f32x4*)(P0 + F.tid * 4), bq = *(const GAS f32x4*)(P0 + 2048 + F.tid * 4);
          *(LAS f32x4*)(Pb + F.tid * 4) = a; *(LAS f32x4*)(Pb + 2048 + F.tid * 4) = bq; }
        float ucur = PU[((size_t)(bh * 64) * 2 + 0) * 4096 + (r0 + r) * 64 + col], scur = 0.f;
        __syncthreads();
        for (int c = 0; c < 64; ++c) {
            const int ch = bh * 64 + c; LAS float* Pc = Pb + (c & 1) * 4096;
            SC[((size_t)ch * 64 + r0 + r) * 64 + col] = scur;
            f32x4 pa = {0.f, 0.f, 0.f, 0.f}, pq = {0.f, 0.f, 0.f, 0.f}; float unext = 0.f;
            if (c + 1 < 64) { const float* Pn = PU + ((size_t)(ch + 1) * 2 + 1) * 4096; pa = *(const GAS f32x4*)(Pn + F.tid * 4); pq = *(const GAS f32x4*)(Pn + 2048 + F.tid * 4);
                unext = PU[((size_t)(ch + 1) * 2 + 0) * 4096 + (r0 + r) * 64 + col]; }
            float a0 = ucur, a1 = 0.f, a2 = 0.f, a3 = 0.f;
#pragma unroll
            for (int j = 0; j < 64; j += 4) {
                const float s0 = readlane_f(scur, j), s1 = readlane_f(scur, j + 1), s2 = readlane_f(scur, j + 2), s3 = readlane_f(scur, j + 3);
                a0 += s0 * Pc[(j + 0) * 64 + col]; a1 += s1 * Pc[(j + 1) * 64 + col]; a2 += s2 * Pc[(j + 2) * 64 + col]; a3 += s3 * Pc[(j + 3) * 64 + col]; }
            const float acc = (a0 + a1) + (a2 + a3);
            if (c + 1 < 64) { LAS float* Pn = Pb + ((c + 1) & 1) * 4096; *(LAS f32x4*)(Pn + F.tid * 4) = pa; *(LAS f32x4*)(Pn + 2048 + F.tid * 4) = pq; }
            __syncthreads();
            scur = acc; ucur = unext;
        }
        F.outp()[O_WKVP + ((size_t)bh * 64 + r0 + r) * 64 + col] = scur;
    }
}
__device__ __forceinline__ void phase_scan3(Ctx& F) {
    const int gw = F.vcu * NWAVES + F.wave, NGW = F.G * NWAVES, lane = F.lane, q = lane >> 4, m = lane & 15;
    const float* SC = WSP(float, WS_SC); const float* Z = WSP(float, WS_Z); float* Y = WSP(float, WS_YC);
    for (int task = gw; task < NBATCH * HB * 63 * 4; task += NGW) {
        const int g = task & 3, cc = task >> 2, bh = cc / 63, c = 1 + (cc - bh * 63), ch = bh * 64 + c, h = bh & 15, b = bh >> 4, row = 16 * g + m;
        const float* st = SC + ((size_t)ch * 64 + row) * 64 + 16 * q; float s[16];
#pragma unroll
        for (int i = 0; i < 16; i += 4) { const f32x4 v = *(const GAS f32x4*)(st + i); s[i] = v.x; s[i + 1] = v.y; s[i + 2] = v.z; s[i + 3] = v.w; }
        const float* zp = Z + (size_t)ch * 4096 + lane; float* yp = Y + (size_t)(b * SEQ + c * 64) * 1024 + h * 64 + row;
        float zb[4];
#pragma unroll
        for (int u = 0; u < 4; ++u) zb[u] = zp[u * 64];
        for (int t = 0; t < 64; t += 4) {
#pragma unroll
            for (int u = 0; u < 4; ++u) {
                const float zv = zb[u]; if (t + u + 4 < 64) zb[u] = zp[(t + u + 4) * 64];
                float acc = 0.f; dot16(acc, zv, s); acc = xrow16_sum(acc);
                if (q == 0) yp[(size_t)(t + u) * 1024] = acc;
            }
        }
    }
}
__device__ __forceinline__ float sum32(float v) {
    v += dpp_f<0xB1>(v); v += dpp_f<0x4E>(v); v += dpp_f<0x141>(v); v += dpp_f<0x140>(v);
    auto s = __builtin_amdgcn_permlane16_swap(__float_as_uint(v), __float_as_uint(v), false, false);
    return __uint_as_float(s[0]) + __uint_as_float(s[1]);
}
__device__ __forceinline__ sba::bf16x8 ld8_bf16(const float* p) { const f32x4 a = *(const GAS f32x4*)p, b = *(const GAS f32x4*)(p + 4); return msc::pack8(a.x, a.y, a.z, a.w, b.x, b.y, b.z, b.w); }
__device__ __forceinline__ void phase_scan3_post(Ctx& F) {
    const int gw = F.vcu * NWAVES + F.wave, NGW = F.G * NWAVES, lane = F.lane, n = lane & 31, hi = lane >> 5;
    const float* SC = WSP(float, WS_SC); const float* Z = WSP(float, WS_Z); const float* Y = WSP(float, WS_Y); const bf16* LWH = WSP(bf16, WS_LWH); const bf16* PBH = WSP(bf16, WS_PBH);
    const float* SCL = WSP(float, WS_SCL); bf16* OAB = WSP(bf16, WS_OAB);
    for (int ch = gw; ch < NBATCH * HB * 64; ch += NGW) {
        const int bh = ch >> 6, c = ch & 63, h = bh & 15, b = bh >> 4, r0 = b * SEQ + c * 64, col0 = h * 64 + n;
        const float lg0 = F.in(I_LNG)[col0], lg1 = F.in(I_LNG)[col0 + 32], lb0 = F.in(I_LNB)[col0], lb1 = F.in(I_LNB)[col0 + 32], mv0 = F.in(I_MU)[2048 + col0], mv1 = F.in(I_MU)[2048 + col0 + 32];
        sba::bf16x8 sb0[4], sb1[4];
        if (c > 0) { const float* Sp = SC + (size_t)ch * 4096 + n * 64 + 8 * hi;
#pragma unroll
            for (int ks = 0; ks < 4; ++ks) { sb0[ks] = ld8_bf16(Sp + 16 * ks); sb1[ks] = ld8_bf16(Sp + 32 * 64 + 16 * ks); } }
        else {
#pragma unroll
            for (int ks = 0; ks < 4; ++ks) { sb0[ks] = sba::bf16x8{}; sb1[ks] = sba::bf16x8{}; } }
        for (int tt = 0; tt < 2; ++tt) {
            sba::f32x16 a0 = sba::f32x16{}, a1 = sba::f32x16{};
            if (c > 0) { const float* Zp = Z + (size_t)ch * 4096 + (32 * tt + n) * 64 + 8 * hi;
#pragma unroll
                for (int ks = 0; ks < 4; ++ks) { const sba::bf16x8 za = ld8_bf16(Zp + 16 * ks);
                    a0 = __builtin_amdgcn_mfma_f32_32x32x16_bf16(za, sb0[ks], a0, 0, 0, 0); a1 = __builtin_amdgcn_mfma_f32_32x32x16_bf16(za, sb1[ks], a1, 0, 0, 0); } }
#pragma unroll
            for (int rg = 0; rg < 16; rg += 4) {
                float y0[4], y1[4], g0[4], g1[4], p0[4], p1[4], q0[4], q1[4], bn[4];
#pragma unroll
                for (int i = 0; i < 4; ++i) { const int t = 32 * tt + sba::crow(rg + i, hi), r = r0 + t;
                    y0[i] = Y[(size_t)r * 1024 + col0]; y1[i] = Y[(size_t)r * 1024 + col0 + 32];
                    g0[i] = ldbf(LWH + (size_t)r * 3072 + 2048 + col0); g1[i] = ldbf(LWH + (size_t)r * 3072 + 2048 + col0 + 32);
                    const bf16* pb = PBH + (size_t)r * 3072 + 2048 + col0; p0[i] = ldbf(pb); p1[i] = ldbf(pb + 32);
                    const bool hp = (r & (SEQ - 1)) != 0; q0[i] = hp ? ldbf(pb - 3072) : 0.f; q1[i] = hp ? ldbf(pb + 32 - 3072) : 0.f;
                    bn[i] = SCL[((size_t)r * HB + h) * 4 + 2]; }
#pragma unroll
                for (int i = 0; i < 4; ++i) { const int t = 32 * tt + sba::crow(rg + i, hi), r = r0 + t;
                    const float v0 = y0[i] + a0[rg + i], v1 = y1[i] + a1[rg + i];
                    const float mean = sum32(v0 + v1) * (1.f / 64.f), d0 = v0 - mean, d1 = v1 - mean, var = sum32(d0 * d0 + d1 * d1) * (1.f / 64.f), rs = rsqrtf(var + EPS_LNX);
                    const float zv0 = p0[i] + mv0 * (q0[i] - p0[i]), zv1 = p1[i] + mv1 * (q1[i] - p1[i]);
                    const float o0 = (d0 * rs * lg0 + lb0 + bn[i] * zv0) * g0[i], o1 = (d1 * rs * lg1 + lb1 + bn[i] * zv1) * g1[i];
                    const float o0n = dpp_f<0xB1>(o0), o1n = dpp_f<0xB1>(o1);
                    if ((lane & 1) == 0) { *(GAS unsigned*)(OAB + (size_t)r * DM + 1024 + col0) = cvt_pk_bf16(o0, o0n); *(GAS unsigned*)(OAB + (size_t)r * DM + 1024 + col0 + 32) = cvt_pk_bf16(o1, o1n); } }
            }
        }
    }
}
__device__ __forceinline__ void phase_postscan(Ctx& F) {
    const int gw = F.vcu * NWAVES + F.wave, NGW = F.G * NWAVES;
    const float* Y = WSP(float, WS_Y); const float* RWV = WSP(float, WS_RWV); const float* SCL = WSP(float, WS_SCL); const float* LWO = WSP(float, WS_LWO); const float* Pp = WSP(float, WS_P); bf16* OAB = WSP(bf16, WS_OAB);
    for (int u = NPR * 4 + gw; u < NTOK * 4; u += NGW) {
        const int r = u >> 2, hq = u & 3; const bool corr = false;
        float yv[4], gv[4], vv[4], bn[4];
#pragma unroll
        for (int i = 0; i < 4; ++i) { const int h = hq * 4 + i, col = h * 64 + F.lane;
            yv[i] = Y[(size_t)r * 1024 + col]; if (corr) yv[i] += WSP(float, WS_YC)[(size_t)r * 1024 + col];
            gv[i] = LWO[(size_t)r * 3072 + 2048 + col]; bn[i] = SCL[((size_t)r * HB + h) * 4 + 2];
            vv[i] = RWV[((size_t)r * HB + h) * 512 + 320 + F.lane]; }
#pragma unroll
        for (int i = 0; i < 4; ++i) { const int h = hq * 4 + i, col = h * 64 + F.lane;
            const float mean = wave_sum(yv[i]) * (1.f / 64.f), d = yv[i] - mean, var = wave_sum(d * d) * (1.f / 64.f);
            const float yn = d * rsqrtf(var + EPS_LNX) * F.in(I_LNG)[col] + F.in(I_LNB)[col] + bn[i] * vv[i];
            const float o = yn * gv[i];
            const float o1 = dpp_f<0xB1>(o);
            if ((F.lane & 1) == 0) *(GAS unsigned*)(OAB + (size_t)r * DM + 1024 + col) = cvt_pk_bf16(o, o1); }
    }
    sample_combine(F);
    const float* OP = WSP(float, WS_OP); const float* CL = WSP(float, WS_CL);
    for (size_t i = (size_t)F.vcu * NTHR + F.tid; i < (size_t)NPR * 256; i += (size_t)F.G * NTHR) {
        const int r = (int)(i >> 8), c4 = (int)(i & 255) * 4, h = c4 >> 7;
        const f32x4 a = *(const GAS f32x4*)(OP + (size_t)r * 1024 + c4), e = *(const GAS f32x4*)(OP + ((size_t)NPR + r) * 1024 + c4); const float cl = CL[(size_t)r * HA + h];
        const f32x4 o = a + e * cl; u32x2 w; w.x = cvt_pk_bf16(o.x, o.y); w.y = cvt_pk_bf16(o.z, o.w);
        *(GAS u32x2*)(OAB + (size_t)r * DM + c4) = w;
    }
}
__device__ __forceinline__ void phase_usample(Ctx& F) {
    const float* PU_ = WSP(float, WS_PARTU); bf16* U = WSP(bf16, WS_U);
    for (int i = F.vcu * NTHR + F.tid; i < NSM * DFF / 4; i += F.G * NTHR) { const int r = i / (DFF / 4), c4 = (i - r * (DFF / 4)) * 4;
        f32x4 a = *(const GAS f32x4*)(PU_ + (size_t)r * DFF + c4);
#pragma unroll
        for (int kc = 1; kc < 8; ++kc) a += *(const GAS f32x4*)(PU_ + ((size_t)kc * 64 + r) * DFF + c4);
        const float x0 = fmaxf(a.x, 0.f), x1 = fmaxf(a.y, 0.f), x2 = fmaxf(a.z, 0.f), x3 = fmaxf(a.w, 0.f);
        u32x2 w; w.x = cvt_pk_bf16(x0 * x0, x1 * x1); w.y = cvt_pk_bf16(x2 * x2, x3 * x3);
        *(GAS u32x2*)(U + (size_t)(NPR + r) * DFF + c4) = w; }
}
#ifndef MK_SPLIT
#define MK_SPLIT 0
#endif
constexpr int NPHASE = 21;
struct Args { const void* in[N_IN]; float* out; unsigned char* ws; int ph_lo, ph_hi; };
__global__ void __launch_bounds__(NTHR, 2) mega_fwd(Args args) {
    extern __shared__ __attribute__((aligned(16))) unsigned char lds_raw[];
    Ctx F;
    F.lds = (LAS unsigned char*)lds_raw; F.tid = threadIdx.x; F.lane = F.tid & 63; F.wave = __builtin_amdgcn_readfirstlane(F.tid >> 6);
    F.G = gridDim.x; { const int bx = blockIdx.x; F.vcu = (F.G % 8 == 0) ? (bx % 8) * (F.G / 8) + bx / 8 : bx; }
    for (int u = F.tid; u < (LDS_BYTES - LDSCTL_OFF) / 4; u += NTHR) ((LAS unsigned*)(F.lds + LDSCTL_OFF))[u] = 0u;
    __syncthreads();
    unsigned* ctl = (unsigned*)(args.ws + WS_CTL);
    XcdBarrier bar; bar.bar = ctl + CW_BAR; bar.x = 0; bar.st = nullptr;
    if (!MK_SPLIT) bar = xcd_barrier_post(ctl + CW_BAR, (volatile LAS unsigned*)(F.lds + MISC_OFF) + 8);
    const int lo = args.ph_lo, hi = args.ph_hi;
#define IN(k) (lo <= (k) && (k) < hi)
#define SEAM(k) do { if (IN(k) && IN((k) + 1)) xcd_barrier(bar); } while (0)
    if (IN(0)) { phase_prologue(F); } SEAM(0);
    if (IN(1)) { phase_mod0(F); } SEAM(1);
    if (IN(2)) { const bool hide = F.G > NCVT + 8; const int ng = hide ? F.G - NCVT : F.G;
        if ((int)blockIdx.x < ng) { pg8::Gemm g{WSP(bf16, WS_H), WSP(bf16, WS_WIN), MP, INPAD, DM, DM, DM}; pg8::StaticOrder S; S.init(MP, INPAD, ng, (int)blockIdx.x); EpiIn E{WSP(bf16, WS_QB), WSP(bf16, WS_KB), WSP(bf16, WS_VB), WSP(float, WS_P), F.outp(), WSP(bf16, WS_PBH)};
            pg8::gemm_phase<EpiIn, pg8::StaticOrder, true, true>(F.lds, g, S, E); }
        else convert_run(F, IT_IN + ((int)blockIdx.x - ng) * NWAVES + F.wave, NCVT * NWAVES, IT_IN + N_HIDE, (LAS float*)(F.lds + F.wave * 16384)); } SEAM(2);
    if (IN(3)) { phase_kv_prep(F); } SEAM(3);
    if (IN(4)) { pg8::Gemm g{WSP(bf16, WS_LA), WSP(bf16, WS_LWT), MP, 3072, 512, 512, 512}; pg8::LoraOrder S; S.init(MP, 3072, F.G, (int)blockIdx.x); pg8::EpiLora E{WSP(float, WS_LWO), WSP(bf16, WS_LWH), 3072};
        pg8::gemm_phase<pg8::EpiLora, pg8::LoraOrder, true, true>(F.lds, g, S, E); } SEAM(4);
    if (IN(6)) { phase_rwkv_prep(F);
        const bool stream_first = (F.vcu & 1) != 0;
        if (stream_first) phase_sample_stream(F); else phase_scan1_mfma(F);
        __syncthreads();
        phase_attn_prompt(F);
        if (!stream_first) phase_sample_stream(F); else phase_scan1_mfma(F); } SEAM(7);
    if (IN(8)) {
        if (F.wave < 2) for (int t = F.vcu * 2 + F.wave; t < DBAT * HB * 4; t += 2 * F.G) scan_wave<false, true>(F, t >> 2, 0, t & 3);
        phase_scan2(F); } SEAM(8);
    if (IN(10)) { phase_scan3_post(F); phase_postscan(F); } SEAM(10);
    if (IN(11)) { pg8::Gemm g{WSP(bf16, WS_OAB), WSP(bf16, WS_WOUT), MP, DM, DM, DM, DM}; pg8::MixOrder<false> S; S.init(DM, DM, F.G, (int)blockIdx.x); pg8::EpiF32S<64> E{WSP(bf16, WS_OUT), DM, nullptr, WSP(float, WS_PART)};
        pg8::gemm_phase<pg8::EpiF32S<64>, pg8::MixOrder<false>, true, true>(F.lds, g, S, E); } SEAM(11);
    if (IN(12)) { phase_postmix<0>(F); } SEAM(12);
    if (IN(13)) { pg8::Gemm g{WSP(bf16, WS_H), WSP(bf16, WS_W1), MP, DFF, DM, DM, DM}; pg8::MixOrder<false> S; S.init(DFF, DM, F.G, (int)blockIdx.x); pg8::EpiRelu2 E{WSP(bf16, WS_U), DFF, WSP(float, WS_PARTU)};
        pg8::gemm_phase<pg8::EpiRelu2, pg8::MixOrder<false>, true, true>(F.lds, g, S, E); } SEAM(13);
    if (IN(14)) { phase_usample(F); if (!MK_SPLIT) xcd_barrier(bar); pg8::Gemm g{WSP(bf16, WS_U), WSP(bf16, WS_W2), MP, DM, DFF, DFF, DFF}; pg8::MixOrder<false> S; S.init(DM, DFF, F.G, (int)blockIdx.x); pg8::EpiF32S<64> E{WSP(bf16, WS_OUT), DM, nullptr, WSP(float, WS_PART)};
        pg8::gemm_phase<pg8::EpiF32S<64>, pg8::MixOrder<false>, true, true>(F.lds, g, S, E); } SEAM(14);
    if (IN(15)) { phase_postmlp<0>(F); } SEAM(15);
    if (IN(16)) { pg8::Gemm g{WSP(bf16, WS_H), WSP(bf16, WS_WPOOL), MP, DM, DM, DM, DM}; pg8::MixOrder<true> S; S.init(DM, DM, F.G, (int)blockIdx.x); pg8::EpiF32S<256> E{WSP(bf16, WS_OUT), DM, F.in(I_PSC), WSP(float, WS_PART)};
        pg8::gemm_phase<pg8::EpiF32S<256>, pg8::MixOrder<true>, true, true>(F.lds, g, S, E); } SEAM(16);
    if (IN(17)) { phase_postmix<1>(F); } SEAM(17);
    if (IN(18)) { pg8::Gemm g{WSP(bf16, WS_H), WSP(bf16, WS_W1) + (size_t)DFF * DM, MP, DFF, DM, DM, DM}; pg8::MixOrder<false> S; S.init(DFF, DM, F.G, (int)blockIdx.x); pg8::EpiRelu2 E{WSP(bf16, WS_U), DFF, WSP(float, WS_PARTU)};
        pg8::gemm_phase<pg8::EpiRelu2, pg8::MixOrder<false>, true, true>(F.lds, g, S, E); } SEAM(18);
    if (IN(19)) { phase_usample(F); if (!MK_SPLIT) xcd_barrier(bar); pg8::Gemm g{WSP(bf16, WS_U), WSP(bf16, WS_W2) + (size_t)DM * DFF, MP, DM, DFF, DFF, DFF}; pg8::MixOrder<false> S; S.init(DM, DFF, F.G, (int)blockIdx.x); pg8::EpiF32S<64> E{WSP(bf16, WS_OUT), DM, nullptr, WSP(float, WS_PART)};
        pg8::gemm_phase<pg8::EpiF32S<64>, pg8::MixOrder<false>, true, true>(F.lds, g, S, E); } SEAM(19);
    if (IN(20)) { phase_postmlp<1>(F); }
#undef IN
#undef SEAM
}

extern "C" void kernel_launch(void* const* d_in, const int* in_sizes, int n_in, void* d_out, int out_size, void* d_ws, size_t ws_size, hipStream_t stream) {
    static int grid = 0;
    if (grid == 0) {
        if (n_in != N_IN || (size_t)out_size != O_END || ws_size < WS_END) { fprintf(stderr, "kernel_launch: unexpected shapes: n_in %d out %d ws %zu (want %d, %zu, >= %zu)\n", n_in, out_size, ws_size, (int)N_IN, (size_t)O_END, (size_t)WS_END); grid = -1; return; }
        int dev = 0, cus = 0, per_cu = 0;
        if (hipGetDevice(&dev) != hipSuccess || hipDeviceGetAttribute(&cus, hipDeviceAttributeMultiprocessorCount, dev) != hipSuccess) { grid = -1; return; }
        if (hipFuncSetAttribute((const void*)mega_fwd, hipFuncAttributeMaxDynamicSharedMemorySize, LDS_BYTES) != hipSuccess) { fprintf(stderr, "kernel_launch: hipFuncSetAttribute failed\n"); grid = -1; return; }
        if (hipOccupancyMaxActiveBlocksPerMultiprocessor(&per_cu, (const void*)mega_fwd, NTHR, LDS_BYTES) != hipSuccess || per_cu < 1) fprintf(stderr, "kernel_launch: occupancy query reports %d blocks per CU\n", per_cu);
        (void)hipGetLastError();
        grid = cus;
    }
    if (grid < 0) return;
    hipMemsetAsync((char*)d_ws + WS_CTL, 0, CTL_ZERO_BYTES, stream);
    Args a{};
    for (int i = 0; i < N_IN; ++i) a.in[i] = d_in[i];
    a.out = (float*)d_out; a.ws = (unsigned char*)d_ws;
#if MK_SPLIT
    for (int p = 0; p < NPHASE; ++p) { a.ph_lo = p; a.ph_hi = p + 1; hipLaunchKernelGGL(mega_fwd, dim3(grid), dim3(NTHR), LDS_BYTES, stream, a); }
#else
    a.ph_lo = 0; a.ph_hi = NPHASE;
    hipLaunchKernelGGL(mega_fwd, dim3(grid), dim3(NTHR), LDS_BYTES, stream, a);
#endif
    const hipError_t le = hipPeekAtLastError();
    if (le != hipSuccess) fprintf(stderr, "kernel_launch: launch failed: %s\n", hipGetErrorName(le));
}
```

```cpp
#include <hip/hip_runtime.h>
#include <cstdio>
#include <cstdint>
namespace pg8 {
#define PG8_LAS __attribute__((address_space(3)))
typedef unsigned short bf16_t;
typedef short bf16x8 __attribute__((ext_vector_type(8)));
typedef float f32x4 __attribute__((ext_vector_type(4)));
typedef unsigned u32x4 __attribute__((ext_vector_type(4)));
constexpr int BM = 256, BK = 64, HALF = 128, HTB = HALF * BK * 2  , STAGE_BYTES = 8 * HTB, NXCD = 8, WGM = 8;

__host__ __device__ __forceinline__ int lds_byte(int r, int c) { const int st = (r >> 4) * 2 + (c >> 5), rr = r & 15, cc = c & 31, ob = rr * 64 + cc * 2; return st * 1024 + (ob ^ (((ob >> 9) & 1) << 5)); }
__host__ __device__ __forceinline__ void stage_rc(int b, int& R, int& C) { const int st = b / 1024, sb = b % 1024, swz = sb ^ (((sb >> 9) & 1) << 5); R = (st >> 1) * 16 + swz / 64; C = (st & 1) * 32 + (swz % 64) / 2; }
__host__ __device__ __forceinline__ int perm32(int rho) { const int n = rho >> 4, i = rho & 15; return 8 * (i >> 2) + 4 * n + (i & 3); }

struct Unit { int pm, pn, kc; };
struct Gemm { const bf16_t* A; const bf16_t* Bt; int M, N, K, lda, ldb; };

struct StaticOrder {
    int nM, nN, nwg, G, c;
    __host__ __device__ void init(int M, int N, int G_, int c_) { nM = M / BM; nN = N / BM; nwg = nM * nN; G = G_; c = c_; }
    __host__ __device__ bool next(int i, Unit& u) const {
        const long L = (long)i * G + c; if (L >= nwg) return false;
        int wgid = (int)L; { const int q = nwg / NXCD, r = nwg % NXCD, xcd = wgid % NXCD, off = wgid / NXCD; wgid = (xcd < r ? xcd * (q + 1) : r * (q + 1) + (xcd - r) * q) + off; }
        const int nig = WGM * nN, gid = wgid / nig, fm = gid * WGM, gsz = (nM - fm) < WGM ? (nM - fm) : WGM;
        u.pm = fm + ((wgid % nig) % gsz); u.pn = (wgid % nig) / gsz; u.kc = -1; return true;
    }
    __device__ __forceinline__ int nt(const Unit&, const Gemm& g) const { return g.K / BK; }
    __device__ __forceinline__ void a_ready(const Unit&) const {}
    __device__ __forceinline__ void done(const Unit&) const {}
    __device__ __forceinline__ size_t a_off(const Unit& u, const Gemm& g) const { return (size_t)u.pm * BM * g.lda * 2; }
    __device__ __forceinline__ size_t b_off(const Unit& u, const Gemm& g) const { return (size_t)u.pn * BM * g.ldb * 2; }
};
struct LoraOrder : StaticOrder {
    __device__ __forceinline__ int k0(const Unit& u) const { return u.pn < 4 ? 0 : (u.pn < 8 ? 64 : 192); }
    __device__ __forceinline__ int nt(const Unit& u, const Gemm&) const { return u.pn < 8 ? 2 : 4; }
    __device__ __forceinline__ size_t a_off(const Unit& u, const Gemm& g) const { return (size_t)u.pm * BM * g.lda * 2 + (size_t)k0(u) * 2; }
    __device__ __forceinline__ size_t b_off(const Unit& u, const Gemm& g) const { return (size_t)u.pn * BM * g.ldb * 2 + (size_t)k0(u) * 2; }
};
__device__ __forceinline__ unsigned cvt_pk_bf16(float lo, float hi) { unsigned r; asm volatile("v_cvt_pk_bf16_f32 %0, %1, %2" : "=v"(r) : "v"(lo), "v"(hi)); return r; }

struct EpiF32 {
    static constexpr bool PERM = false, AFTER_DRAIN = false;
    float* C; int ldc; const float* cscale;
    __device__ __forceinline__ void operator()(const f32x4 (&acc)[2][2][4][2], const Unit& u, int wr, int wc, int fr, int fq) const {
        const int row0 = u.pm * BM + wr * 64 + fr, col0 = u.pn * BM + wc * 32 + 4 * fq;
        f32x4 sv[2][2];
#pragma unroll
        for (int bj = 0; bj < 2; ++bj)
#pragma unroll
            for (int n = 0; n < 2; ++n) sv[bj][n] = cscale ? *(const f32x4*)(cscale + col0 + bj * HALF + n * 16) : (f32x4){1.f, 1.f, 1.f, 1.f};
#pragma unroll
        for (int ai = 0; ai < 2; ++ai)
#pragma unroll
            for (int m = 0; m < 4; ++m) { float* rowp = C + (size_t)(row0 + ai * HALF + m * 16) * ldc + col0;
#pragma unroll
                for (int bj = 0; bj < 2; ++bj)
#pragma unroll
                    for (int n = 0; n < 2; ++n) *(f32x4*)(rowp + bj * HALF + n * 16) = acc[ai][bj][m][n] * sv[bj][n]; }
    }
};
typedef unsigned u32x2h __attribute__((ext_vector_type(2)));
struct EpiLora {
    static constexpr bool PERM = false, AFTER_DRAIN = false;
    float* C; bf16_t* H; int ldc;
    __device__ __forceinline__ void operator()(const f32x4 (&acc)[2][2][4][2], const Unit& u, int wr, int wc, int fr, int fq) const {
        const int row0 = u.pm * BM + wr * 64 + fr, col0 = u.pn * BM + wc * 32 + 4 * fq;
#pragma unroll
        for (int ai = 0; ai < 2; ++ai)
#pragma unroll
            for (int m = 0; m < 4; ++m) { const size_t ro = (size_t)(row0 + ai * HALF + m * 16) * ldc + col0;
#pragma unroll
                for (int bj = 0; bj < 2; ++bj)
#pragma unroll
                    for (int n = 0; n < 2; ++n) { const f32x4 v = acc[ai][bj][m][n];
                        if (u.pm < 32) { u32x2h w; w.x = cvt_pk_bf16(v[0], v[1]); w.y = cvt_pk_bf16(v[2], v[3]); *(u32x2h*)(H + ro + bj * HALF + n * 16) = w; }
                        else *(f32x4*)(C + ro + bj * HALF + n * 16) = v; } }
    }
};
struct EpiRelu2 {
    static constexpr bool PERM = true, AFTER_DRAIN = false;
    bf16_t* O; int ldc; float* PART;
    __device__ __forceinline__ void operator()(const f32x4 (&acc)[2][2][4][2], const Unit& u, int wr, int wc, int fr, int fq) const {
        const int row0 = u.pm * BM + wr * 64 + fr, col0 = u.pn * BM + wc * 32 + 8 * fq;
        if (u.kc >= 0) {
            if (wr == 0) {
#pragma unroll
                for (int m = 0; m < 4; ++m) { float* rowp = PART + ((size_t)u.kc * 64 + m * 16 + fr) * ldc + col0;
#pragma unroll
                    for (int bj = 0; bj < 2; ++bj) { *(f32x4*)(rowp + bj * HALF) = acc[0][bj][m][0]; *(f32x4*)(rowp + bj * HALF + 4) = acc[0][bj][m][1]; } } }
            return;
        }
#pragma unroll
        for (int ai = 0; ai < 2; ++ai)
#pragma unroll
            for (int m = 0; m < 4; ++m) { bf16_t* rowp = O + (size_t)(row0 + ai * HALF + m * 16) * ldc + col0;
#pragma unroll
                for (int bj = 0; bj < 2; ++bj) { f32x4 v0 = acc[ai][bj][m][0], v1 = acc[ai][bj][m][1];
#pragma unroll
                    for (int j = 0; j < 4; ++j) { const float a = v0[j] > 0.f ? v0[j] : 0.f, b = v1[j] > 0.f ? v1[j] : 0.f; v0[j] = a * a; v1[j] = b * b; }
                    u32x4 w; w.x = cvt_pk_bf16(v0[0], v0[1]); w.y = cvt_pk_bf16(v0[2], v0[3]); w.z = cvt_pk_bf16(v1[0], v1[1]); w.w = cvt_pk_bf16(v1[2], v1[3]);
                    *(u32x4*)(rowp + bj * HALF) = w; } }
    }
};
template <bool POOL> struct MixOrder {
    StaticOrder so; int nmain, nN, kdiv, ntot, G, c;
    __device__ void init(int N, int K, int G_, int c_) { nN = N / BM; so.init(32 * BM, N, G_, c_); nmain = 32 * nN; kdiv = (POOL ? 512 : K) / 256; ntot = nmain + nN * kdiv; G = G_; c = c_; }
    __device__ bool next(int i, Unit& u) const {
        const int L = i * G + c; if (L >= ntot) return false;
        if (L < nmain) return so.next(i, u);
        const int j = L - nmain; u.pm = 32; u.pn = j % nN; u.kc = j / nN; return true;
    }
    __device__ __forceinline__ int nt(const Unit& u, const Gemm& g) const { return u.kc >= 0 ? 4 : (POOL ? 8 : g.K / BK); }
    __device__ __forceinline__ size_t a_off(const Unit& u, const Gemm& g) const { return (size_t)u.pm * BM * g.lda * 2 + (size_t)((POOL ? (u.pn >> 1) * 512 : 0) + (u.kc >= 0 ? u.kc * 256 : 0)) * 2; }
    __device__ __forceinline__ size_t b_off(const Unit& u, const Gemm& g) const { return (size_t)u.pn * BM * g.ldb * 2 + (size_t)((POOL ? (u.pn >> 1) * 512 : 0) + (u.kc >= 0 ? u.kc * 256 : 0)) * 2; }
    __device__ __forceinline__ void a_ready(const Unit&) const {}
    __device__ __forceinline__ void done(const Unit&) const {}
};
template <int PROW> struct EpiF32S {
    static constexpr bool PERM = false, AFTER_DRAIN = false;
    bf16_t* C; int ldc; const float* cscale; float* PART;
    __device__ __forceinline__ f32x4 scl(int c) const { return cscale ? *(const f32x4*)(cscale + c) : (f32x4){1.f, 1.f, 1.f, 1.f}; }
    __device__ __forceinline__ void operator()(const f32x4 (&acc)[2][2][4][2], const Unit& u, int wr, int wc, int fr, int fq) const {
        asm volatile("" : "+v"(fr), "+v"(fq));
        const int col0 = u.pn * BM + wc * 32 + 4 * fq;
        if (u.kc < 0) {
            bf16_t* Ct = C + (size_t)u.pm * BM * ldc; const unsigned e0 = (unsigned)((wr * 64 + fr) * ldc + col0);
#pragma unroll
            for (int bj = 0; bj < 2; ++bj)
#pragma unroll
                for (int n = 0; n < 2; ++n) { const f32x4 sv = scl(col0 + bj * HALF + n * 16);
#pragma unroll
                    for (int ai = 0; ai < 2; ++ai)
#pragma unroll
                        for (int m = 0; m < 4; ++m) { const f32x4 v = acc[ai][bj][m][n] * sv; const unsigned w0 = cvt_pk_bf16(v[0], v[1]), w1 = cvt_pk_bf16(v[2], v[3]);
                            *(unsigned long long*)(Ct + e0 + (unsigned)((ai * HALF + m * 16) * ldc) + bj * HALF + n * 16) = (unsigned long long)w0 | ((unsigned long long)w1 << 32); } }
        } else if (PROW == 256) {
            float* Pk = PART + (size_t)u.kc * 256 * ldc; const unsigned e0 = (unsigned)((wr * 64 + fr) * ldc + col0);
#pragma unroll
            for (int bj = 0; bj < 2; ++bj)
#pragma unroll
                for (int n = 0; n < 2; ++n) { const f32x4 sv = scl(col0 + bj * HALF + n * 16);
#pragma unroll
                    for (int ai = 0; ai < 2; ++ai)
#pragma unroll
                        for (int m = 0; m < 4; ++m) *(f32x4*)(Pk + e0 + (unsigned)((ai * HALF + m * 16) * ldc) + bj * HALF + n * 16) = acc[ai][bj][m][n] * sv; }
        } else if (wr == 0) {
            float* Pk = PART + (size_t)u.kc * 64 * ldc; const unsigned e0 = (unsigned)(fr * ldc + col0);
#pragma unroll
            for (int bj = 0; bj < 2; ++bj)
#pragma unroll
                for (int n = 0; n < 2; ++n) { const f32x4 sv = scl(col0 + bj * HALF + n * 16);
#pragma unroll
                    for (int m = 0; m < 4; ++m) *(f32x4*)(Pk + e0 + (unsigned)(m * 16 * ldc) + bj * HALF + n * 16) = acc[0][bj][m][n] * sv; }
        }
    }
};
template <class Epi, class Sched, bool ALIGN_EPI = false, bool SP2 = false>
__device__ __forceinline__ void gemm_phase(PG8_LAS unsigned char* lds, const Gemm g, const Sched& S, const Epi& E) {
    const int tid = threadIdx.x, wid = __builtin_amdgcn_readfirstlane(tid >> 6), lane = tid & 63, wr = wid >> 2, wc = wid & 3, fr = lane & 15, fq = lane >> 4;
    unsigned voffA[2], voffB[2];
#pragma unroll
    for (int i = 0; i < 2; ++i) { int R, C; stage_rc(tid * 16 + i * 8192, R, C); const int Rb = Epi::PERM ? ((R & ~31) + perm32(R & 31)) : R;
        voffA[i] = (unsigned)(R * g.lda + C) * 2u; voffB[i] = (unsigned)(Rb * g.ldb + C) * 2u; }
    const size_t kstep = (size_t)(BK * 2);
    const size_t hsA = (size_t)HALF * g.lda * 2, hsB = (size_t)HALF * g.ldb * 2;
    const unsigned ldsw = (unsigned)wid * 1024u;
    const int aoff = lds_byte(wr * 64 + fr, fq * 8), boff = lds_byte(wc * 32 + fr, fq * 8);
#define PG8_SA(b, h) (((b) * 2 + (h)) * HTB)
#define PG8_SB(b, h) ((4 + (b) * 2 + (h)) * HTB)
#define PG8_STAGE(bufoff, gbase, voff) do { _Pragma("unroll") for (int _i = 0; _i < 2; ++_i) \
        __builtin_amdgcn_global_load_lds((const unsigned*)((const char*)(gbase) + (voff)[_i]), (PG8_LAS unsigned*)(lds + (bufoff) + ldsw + _i * 8192), 16, 0, 0); } while (0)
#define PG8_LDA(dst, b, h) do { _Pragma("unroll") for (int m = 0; m < 4; ++m) _Pragma("unroll") for (int k = 0; k < 2; ++k) dst[m][k] = *(const PG8_LAS bf16x8*)(lds + PG8_SA(b, h) + aoff + m * 2048 + k * 1024); } while (0)
#define PG8_LDB(dst, b, h) do { _Pragma("unroll") for (int n = 0; n < 2; ++n) _Pragma("unroll") for (int k = 0; k < 2; ++k) dst[n][k] = *(const PG8_LAS bf16x8*)(lds + PG8_SB(b, h) + boff + n * 2048 + k * 1024); } while (0)
#define PG8_MMA(ai, bj, At, Bt) do { __builtin_amdgcn_s_setprio(1); _Pragma("unroll") for (int m = 0; m < 4; ++m) _Pragma("unroll") for (int n = 0; n < 2; ++n) _Pragma("unroll") for (int k = 0; k < 2; ++k) \
        acc[ai][bj][m][n] = __builtin_amdgcn_mfma_f32_16x16x32_bf16(Bt[n][k], At[m][k], acc[ai][bj][m][n], 0, 0, 0); __builtin_amdgcn_s_setprio(0); } while (0)
#define PG8_WAIT_V(n) asm volatile("s_waitcnt vmcnt(" #n ")" ::: "memory")
#define PG8_WAIT_L(n) asm volatile("s_waitcnt lgkmcnt(" #n ")" ::: "memory")
#define PG8_BAR __builtin_amdgcn_s_barrier()
#define PG8_SCHED __builtin_amdgcn_sched_barrier(0)
    Unit cur, nxt; int ui = 0;
    if (!S.next(0, cur)) return;
    int nt = S.nt(cur, g);
    f32x4 acc[2][2][4][2];
#pragma unroll
    for (int a = 0; a < 2; ++a)
#pragma unroll
        for (int b = 0; b < 2; ++b)
#pragma unroll
            for (int m = 0; m < 4; ++m)
#pragma unroll
                for (int n = 0; n < 2; ++n) acc[a][b][m][n] = (f32x4){0.f, 0.f, 0.f, 0.f};
    bf16x8 At[4][2], B0[2][2], B1[2][2];
    const char* cA = (const char*)g.A + S.a_off(cur, g); const char* cB = (const char*)g.Bt + S.b_off(cur, g);
    S.a_ready(cur);
    if constexpr (SP2) {
        PG8_STAGE(PG8_SB(0, 0), cB, voffB); PG8_STAGE(PG8_SB(0, 1), cB + hsB, voffB); PG8_STAGE(PG8_SA(0, 0), cA, voffA); PG8_STAGE(PG8_SA(0, 1), cA + hsA, voffA);
        if (wr == 1) PG8_BAR;
        PG8_WAIT_V(2); PG8_BAR;
        PG8_STAGE(PG8_SB(1, 0), cB + kstep, voffB); PG8_STAGE(PG8_SA(1, 0), cA + kstep, voffA); PG8_STAGE(PG8_SB(1, 1), cB + hsB + kstep, voffB);
        PG8_WAIT_V(6); PG8_BAR;
    } else {
        PG8_STAGE(PG8_SB(0, 0), cB, voffB); PG8_STAGE(PG8_SA(0, 0), cA, voffA); PG8_STAGE(PG8_SB(0, 1), cB + hsB, voffB); PG8_STAGE(PG8_SA(0, 1), cA + hsA, voffA);
        if (wr == 1) PG8_BAR;
        PG8_WAIT_V(4); PG8_BAR;
        PG8_STAGE(PG8_SB(1, 0), cB + kstep, voffB); PG8_STAGE(PG8_SA(1, 0), cA + kstep, voffA); PG8_STAGE(PG8_SB(1, 1), cB + hsB + kstep, voffB);
        PG8_WAIT_V(6); PG8_BAR;
    }
    for (;;) {
        const bool has_next = S.next(ui + 1, nxt);
        const char* nA = has_next ? (const char*)g.A + S.a_off(nxt, g) : cA; const char* nB = has_next ? (const char*)g.Bt + S.b_off(nxt, g) : cB;
        for (int t = 0; t < nt; t += 2) {
            const bool last = (t == nt - 2);
            const char* a1 = cA + (size_t)(t + 1) * kstep;
            const char* a2 = last ? nA : cA + (size_t)(t + 2) * kstep; const char* b2 = last ? nB : cB + (size_t)(t + 2) * kstep;
            const char* a3 = a2 + kstep; const char* b3 = b2 + kstep;
            if (last && has_next) S.a_ready(nxt);
            if constexpr (SP2) {
            PG8_LDB(B0, 0, 0); PG8_LDB(B1, 0, 1); PG8_SCHED; PG8_LDA(At, 0, 0); PG8_STAGE(PG8_SA(1, 1), a1 + hsA, voffA);
            PG8_WAIT_V(8); PG8_WAIT_L(0); PG8_BAR; PG8_MMA(0, 0, At, B0); PG8_MMA(0, 1, At, B1); PG8_BAR; PG8_SCHED;
            PG8_LDA(At, 0, 1); PG8_STAGE(PG8_SB(0, 0), b2, voffB); PG8_STAGE(PG8_SB(0, 1), b2 + hsB, voffB); PG8_STAGE(PG8_SA(0, 0), a2, voffA);
            PG8_WAIT_V(8); PG8_WAIT_L(0); PG8_BAR; PG8_MMA(1, 0, At, B0); PG8_MMA(1, 1, At, B1); PG8_BAR; PG8_SCHED;
            PG8_LDB(B0, 1, 0); PG8_LDB(B1, 1, 1); PG8_SCHED; PG8_LDA(At, 1, 0); PG8_STAGE(PG8_SA(0, 1), a2 + hsA, voffA);
            PG8_WAIT_V(8); PG8_WAIT_L(0); PG8_BAR; PG8_MMA(0, 0, At, B0); PG8_MMA(0, 1, At, B1); PG8_BAR; PG8_SCHED;
            PG8_LDA(At, 1, 1); PG8_STAGE(PG8_SB(1, 0), b3, voffB); PG8_STAGE(PG8_SB(1, 1), b3 + hsB, voffB); PG8_STAGE(PG8_SA(1, 0), a3, voffA);
            PG8_WAIT_V(8); PG8_WAIT_L(0); PG8_BAR; PG8_MMA(1, 0, At, B0); PG8_MMA(1, 1, At, B1); PG8_BAR; PG8_SCHED;
            } else {
            PG8_LDB(B0, 0, 0); PG8_SCHED; PG8_LDA(At, 0, 0); PG8_STAGE(PG8_SA(1, 1), a1 + hsA, voffA);
            PG8_WAIT_L(8); PG8_BAR; PG8_WAIT_L(0); PG8_MMA(0, 0, At, B0); PG8_BAR; PG8_SCHED;
            PG8_LDB(B1, 0, 1); PG8_STAGE(PG8_SB(0, 0), b2, voffB);
            PG8_BAR; PG8_WAIT_L(0); PG8_MMA(0, 1, At, B1); PG8_BAR;
            PG8_LDA(At, 0, 1); PG8_STAGE(PG8_SA(0, 0), a2, voffA);
            PG8_BAR; PG8_WAIT_L(0); PG8_MMA(1, 0, At, B0); PG8_BAR; PG8_SCHED;
            PG8_STAGE(PG8_SB(0, 1), b2 + hsB, voffB);
            PG8_WAIT_V(6); PG8_BAR; PG8_MMA(1, 1, At, B1); PG8_BAR;
            PG8_LDB(B0, 1, 0); PG8_SCHED; PG8_LDA(At, 1, 0); PG8_STAGE(PG8_SA(0, 1), a2 + hsA, voffA);
            PG8_WAIT_L(8); PG8_BAR; PG8_WAIT_L(0); PG8_MMA(0, 0, At, B0); PG8_BAR; PG8_SCHED;
            PG8_LDB(B1, 1, 1); PG8_STAGE(PG8_SB(1, 0), b3, voffB);
            PG8_BAR; PG8_WAIT_L(0); PG8_MMA(0, 1, At, B1); PG8_BAR;
            PG8_LDA(At, 1, 1); PG8_STAGE(PG8_SA(1, 0), a3, voffA);
            PG8_BAR; PG8_WAIT_L(0); PG8_MMA(1, 0, At, B0); PG8_BAR; PG8_SCHED;
            PG8_STAGE(PG8_SB(1, 1), b3 + hsB, voffB);
            PG8_WAIT_V(6); PG8_BAR; PG8_MMA(1, 1, At, B1); PG8_BAR;
            }
        }
        if constexpr (ALIGN_EPI) { if (wr == 0) PG8_BAR; }
        if constexpr (!Epi::AFTER_DRAIN) { E(acc, cur, wr, wc, fr, fq); S.done(cur); }
        if (!has_next) break;
#pragma unroll
        for (int a = 0; a < 2; ++a)
#pragma unroll
            for (int b = 0; b < 2; ++b)
#pragma unroll
                for (int m = 0; m < 4; ++m)
#pragma unroll
                    for (int n = 0; n < 2; ++n) acc[a][b][m][n] = (f32x4){0.f, 0.f, 0.f, 0.f};
        cur = nxt; cA = nA; cB = nB; ++ui; nt = S.nt(cur, g);
        if constexpr (ALIGN_EPI) { if (wr == 1) PG8_BAR; }
    }
    PG8_WAIT_V(0);
    if constexpr (!ALIGN_EPI) { if (wr == 0) PG8_BAR; }
    PG8_BAR;
    if constexpr (Epi::AFTER_DRAIN) { E.fused(acc, cur, wr, wc, fr, fq, lds, wid, lane); S.done(cur); }
#undef PG8_SA
#undef PG8_SB
#undef PG8_STAGE
#undef PG8_LDA
#undef PG8_LDB
#undef PG8_MMA
#undef PG8_WAIT_V
#undef PG8_WAIT_L
#undef PG8_BAR
#undef PG8_SCHED
}
}

constexpr int DM = 2048, SEQ = 4096, NBATCH = 2, NPR = NBATCH * SEQ, DBAT = 8, DSEQ = 8, NSM = DBAT * DSEQ, NTOK = NPR + NSM, MP = 8448;
constexpr int HA = 8, DHA = 128, HB = 16, DHB = 64, DBR = 1024;
constexpr int BCOLS = 3520, INCOLS = 6592, INPAD = 6656, DFF = 8192, NPAGES = 128, PAGESZ = 128, PAST = 16384, PBUF = 15, NMR = 10;
constexpr float EPS_RMS = 1e-6f, EPS_LNX = 64e-5f, QK_SCALE = 0.08838834764831845f;
enum { I_XP = 0, I_XS, I_CK, I_CV, I_PT, I_SWKV, I_SSH, I_SPOOL, I_CP, I_CS, I_WADA, I_BADA, I_NG, I_WIN, I_WOUT, I_SBB, I_MU, I_W0, I_WUP, I_A0, I_AUP, I_GUP, I_KK, I_KA, I_RK, I_LNG, I_LNB, I_WPOOL, I_PSC, I_W1, I_W2, N_IN };
constexpr size_t O_YP = 0, O_YS = O_YP + (size_t)NPR * DM, O_KP = O_YS + (size_t)NSM * DM, O_VP = O_KP + (size_t)NPR * 1024, O_KS = O_VP + (size_t)NPR * 1024, O_VS = O_KS + (size_t)NSM * 1024,
                 O_WKVP = O_VS + (size_t)NSM * 1024, O_WKVS = O_WKVP + (size_t)NBATCH * HB * 64 * 64, O_SHP = O_WKVS + (size_t)DBAT * HB * 64 * 64, O_SHS = O_SHP + (size_t)NBATCH * BCOLS,
                 O_PLP = O_SHS + (size_t)DBAT * BCOLS, O_PLS = O_PLP + (size_t)NBATCH * PBUF * DM, O_END = O_PLS + (size_t)DBAT * PBUF * DM;
constexpr size_t MiB = 1u << 20;
constexpr size_t WS_CTL = 0, CTL_ZERO_BYTES = 64 * 1024, WS_MOD = 1 * MiB, WS_WIN = 2 * MiB, WS_WOUT = 28 * MiB, WS_W1 = 36 * MiB, WS_W2 = 100 * MiB, WS_WPOOL = 164 * MiB,
                 WS_H = 172 * MiB, WS_OAB = 205 * MiB, WS_M = 238 * MiB, WS_P = 271 * MiB, WS_OUT = 486 * MiB, WS_XR = 552 * MiB, WS_HF = 617 * MiB, WS_U = 682 * MiB,
                 WS_RWV = 814 * MiB, WS_SCL = 1072 * MiB, WS_G = 1075 * MiB, WS_Y = 1108 * MiB, WS_PU = 1141 * MiB, WS_Z = 1205 * MiB, WS_SC = 1237 * MiB, WS_QB = 1269 * MiB, WS_KB = 1286 * MiB, WS_VB = 1303 * MiB, WS_OP = 1320 * MiB, WS_CL = 1384 * MiB, WS_SPART = 1385 * MiB, WS_SCAR = 1394 * MiB, WS_LA = 1395 * MiB, WS_LWT = 1404 * MiB, WS_LWO = 1408 * MiB, WS_YC = 1508 * MiB, WS_PART = 1541 * MiB, WS_PARTU = 1558 * MiB, WS_END = 1575 * MiB;
static_assert(WS_WIN + (size_t)INPAD * DM * 2 <= WS_WOUT && WS_P + (size_t)MP * INPAD * 4 <= WS_OUT && WS_U + (size_t)MP * DFF * 2 <= WS_RWV && WS_RWV + (size_t)NTOK * HB * 512 * 4 <= WS_SCL, "ws map");
constexpr int CW_BAR = 4096;
constexpr int RING_BYTES = 131072, LDSCTL_OFF = RING_BYTES, MISC_OFF = LDSCTL_OFF + 320, LDS_BYTES = 147456;
constexpr int NWAVES = 8, NTHR = 512;

#define GAS __attribute__((address_space(1)))
#define LAS __attribute__((address_space(3)))
typedef unsigned short bf16;
__device__ __forceinline__ float ldbf(const bf16* p) { return __uint_as_float((unsigned)*p << 16); }
__device__ __forceinline__ float ldbf_nt(const bf16* p) { return __uint_as_float((unsigned)__builtin_nontemporal_load(p) << 16); }
typedef float f32x4 __attribute__((ext_vector_type(4)));
typedef float f32x2 __attribute__((ext_vector_type(2)));
typedef unsigned u32x2 __attribute__((ext_vector_type(2)));
typedef unsigned u32x4 __attribute__((ext_vector_type(4)));
#define LDS_WAIT() asm volatile("s_waitcnt lgkmcnt(0)" ::: "memory")
#define VM_WAIT() asm volatile("s_waitcnt vmcnt(0)" ::: "memory")
using pg8::cvt_pk_bf16;
constexpr size_t WS_PBH = WS_RWV, WS_LWH = WS_RWV + 64 * MiB;
static_assert((size_t)NPR * 3072 * 2 <= 64 * MiB && 128 * MiB <= (size_t)NPR * HB * 512 * 4, "bf16 prompt copies fit below the sample rows of RWV");
constexpr int PBLD = 3584;
struct EpiIn {
    static constexpr bool PERM = false, AFTER_DRAIN = false;
    bf16 *QB, *KB, *VB; float* PB; float* out; bf16* PBH;
    __device__ __forceinline__ void operator()(const pg8::f32x4 (&acc)[2][2][4][2], const pg8::Unit& u, int wr, int wc, int fr, int fq) const {
        const int row0 = u.pm * 256 + wr * 64 + fr, colt = u.pn * 256 + wc * 32 + 4 * fq;
        if (u.pn >= 12) {
#pragma unroll
            for (int ai = 0; ai < 2; ++ai)
#pragma unroll
                for (int m = 0; m < 4; ++m) {
                    if (u.pm < 32 && u.pn < 24) { bf16* rowh = PBH + (size_t)(row0 + ai * 128 + m * 16) * 3072 + (colt - 3072);
#pragma unroll
                        for (int bj = 0; bj < 2; ++bj)
#pragma unroll
                            for (int n = 0; n < 2; ++n) { const pg8::f32x4 v = acc[ai][bj][m][n]; u32x2 w; w.x = cvt_pk_bf16(v[0], v[1]); w.y = cvt_pk_bf16(v[2], v[3]); *(u32x2*)(rowh + bj * 128 + n * 16) = w; } }
                    else { float* rowp = PB + (size_t)(row0 + ai * 128 + m * 16) * PBLD + (colt - 3072);
#pragma unroll
                        for (int bj = 0; bj < 2; ++bj)
#pragma unroll
                            for (int n = 0; n < 2; ++n) *(pg8::f32x4*)(rowp + bj * 128 + n * 16) = acc[ai][bj][m][n]; } }
        } else {
            const int sel = u.pn >> 2, c0 = colt - sel * 1024;
            static_assert(WS_KB - WS_QB == WS_VB - WS_KB && O_VP - O_KP == (size_t)NPR * 1024 && O_VS - O_KS == (size_t)NSM * 1024, "q/k/v buffers are equally spaced");
            bf16* Bt = QB + (size_t)sel * ((WS_KB - WS_QB) / 2) + (size_t)u.pm * 256 * 1024;
            float* Ot = u.pm < 32 ? out + O_KP + (size_t)(sel ? sel - 1 : 0) * NPR * 1024 + (size_t)u.pm * 256 * 1024 : out + O_KS + (size_t)(sel ? sel - 1 : 0) * NSM * 1024;
            const int rl0 = wr * 64 + fr;
#pragma unroll
            for (int ai = 0; ai < 2; ++ai)
#pragma unroll
                for (int m = 0; m < 4; ++m) { const int rl = rl0 + ai * 128 + m * 16; const unsigned eo = (unsigned)(rl * 1024 + c0);
                    const bool wo = sel != 0 && (u.pm < 32 || rl < NSM);
#pragma unroll
                    for (int bj = 0; bj < 2; ++bj)
#pragma unroll
                        for (int n = 0; n < 2; ++n) { const pg8::f32x4 v = acc[ai][bj][m][n]; u32x2 w; w.x = cvt_pk_bf16(v[0], v[1]); w.y = cvt_pk_bf16(v[2], v[3]);
                            *(u32x2*)(Bt + eo + bj * 128 + n * 16) = w; if (wo) *(pg8::f32x4*)(Ot + eo + bj * 128 + n * 16) = v; }
                    asm volatile("" ::: "memory"); }
        }
    }
};

#define XB_TMO      128
#define XB_XCNT(j)  (256  + 64 * (j))
#define XB_XSUB(j)  (1280 + 64 * (j))
#define XB_XGEN(j)  (2304 + 64 * (j))
#define XB_TOP      3328
#define XB_TOPGEN   3392
#define XCD_BAR_WORDS 3456
#define XB_SPIN_CAP (1u << 18)

__device__ __forceinline__ unsigned xb_ld(unsigned* p)              { return __hip_atomic_load(p, __ATOMIC_RELAXED, __HIP_MEMORY_SCOPE_AGENT); }
__device__ __forceinline__ unsigned xb_add(unsigned* p, unsigned v) { return __hip_atomic_fetch_add(p, v, __ATOMIC_RELAXED, __HIP_MEMORY_SCOPE_AGENT); }
__device__ __forceinline__ unsigned xb_xcc_id() { return (unsigned)__builtin_amdgcn_s_getreg((3 << 11) | 20) & 0xFu; }
#define XB_SPIN(cond, bar) do { unsigned _sp = 0; while (cond) { __builtin_amdgcn_s_sleep(1); \
    if ((++_sp & 255u) == 0u) { if (xb_ld(&(bar)[XB_TMO])) break; if (_sp > XB_SPIN_CAP) { atomicAdd(&(bar)[XB_TMO], 1u); break; } } } } while (0)

struct XcdBarrier {
    unsigned* bar; unsigned x;
    volatile LAS unsigned* st;
};

__device__ __forceinline__ XcdBarrier xcd_barrier_post(unsigned* bar, volatile LAS unsigned* st) {
    XcdBarrier b; b.bar = bar; b.x = xb_xcc_id(); b.st = st;
    if (threadIdx.x == 0) (void)xb_add(&bar[XB_XCNT(b.x)], 1u);
    return b;
}
__device__ __forceinline__ void xcd_barrier_complete(unsigned* bar, unsigned x, unsigned& nloc, unsigned& nx) {
    const unsigned G = gridDim.x * gridDim.y * gridDim.z;
    unsigned sum, cnt, mine, sp = 0u;
    for (;;) {
        sum = 0u; cnt = 0u; mine = 0u;
#pragma unroll
        for (unsigned j = 0; j < 16; ++j) { const unsigned c = xb_ld(&bar[XB_XCNT(j)]); sum += c; cnt += (c > 0u) ? 1u : 0u; mine = (j == x) ? c : mine; }
        if (sum == G) break;
        __builtin_amdgcn_s_sleep(1);
        if ((++sp & 255u) == 0u) { if (xb_ld(&bar[XB_TMO])) break; if (sp > XB_SPIN_CAP) { atomicAdd(&bar[XB_TMO], 1u); break; } }
    }
    nloc = mine > 0u ? mine : 1u; nx = cnt > 0u ? cnt : 1u;
}

__device__ __forceinline__ void xcd_barrier(const XcdBarrier& b) {
    asm volatile("s_waitcnt vmcnt(0)" ::: "memory");
    __syncthreads();
    if (threadIdx.x == 0) {
        unsigned* bar = b.bar;
        __builtin_amdgcn_s_waitcnt(0);
        unsigned nloc = b.st[0], nx = b.st[1];
        if (nloc == 0u) { xcd_barrier_complete(bar, b.x, nloc, nx); b.st[0] = nloc; b.st[1] = nx; }
        const unsigned old = xb_add(&bar[XB_XSUB(b.x)], 1u);
        const unsigned gen = old / nloc;
        if (old + 1u == (gen + 1u) * nloc) {
            __builtin_amdgcn_fence(__ATOMIC_RELEASE, "agent");
            asm volatile("s_waitcnt vmcnt(0)" ::: "memory");
            const unsigned og = xb_add(&bar[XB_TOP], 1u);
            const unsigned tg = og / nx;
            if (og + 1u == (tg + 1u) * nx) xb_add(&bar[XB_TOPGEN], 1u);
            else XB_SPIN(xb_ld(&bar[XB_TOPGEN]) == tg, bar);
            __builtin_amdgcn_fence(__ATOMIC_ACQUIRE, "agent");
            xb_add(&bar[XB_XGEN(b.x)], 1u);
            asm volatile("s_waitcnt vmcnt(0)" ::: "memory");
        } else {
            XB_SPIN(xb_ld(&bar[XB_XGEN(b.x)]) == gen, bar);
            __builtin_amdgcn_fence(__ATOMIC_ACQUIRE, "agent");
            asm volatile("s_waitcnt vmcnt(0)" ::: "memory");
        }
    }
    __syncthreads();
}


struct Ctx {
    LAS unsigned char* lds; int tid, lane, wave, vcu, G;
    __device__ __forceinline__ const float* in(int i) const { return ((const float* const __attribute__((address_space(4)))*)__builtin_amdgcn_kernarg_segment_ptr())[i]; }
    __device__ __forceinline__ float* outp() const { return ((float* const __attribute__((address_space(4)))*)__builtin_amdgcn_kernarg_segment_ptr())[N_IN]; }
    __device__ __forceinline__ unsigned char* wsp() const { return ((unsigned char* const __attribute__((address_space(4)))*)__builtin_amdgcn_kernarg_segment_ptr())[N_IN + 1]; }
};
template <int CTRL> __device__ __forceinline__ float dpp_f(float x) { return __builtin_bit_cast(float, __builtin_amdgcn_mov_dpp(__builtin_bit_cast(int, x), CTRL, 0xf, 0xf, true)); }
#define readlane_f(x, l) __builtin_bit_cast(float, __builtin_amdgcn_readlane(__builtin_bit_cast(int, (float)(x)), (l)))
__device__ __forceinline__ float wave_sum(float v) {
    v += dpp_f<0xB1>(v); v += dpp_f<0x4E>(v); v += dpp_f<0x141>(v); v += dpp_f<0x140>(v);
    auto s = __builtin_amdgcn_permlane16_swap(__float_as_uint(v), __float_as_uint(v), false, false);
    v = __uint_as_float(s[0]) + __uint_as_float(s[1]);
    auto t = __builtin_amdgcn_permlane32_swap(__float_as_uint(v), __float_as_uint(v), false, false);
    return __uint_as_float(t[0]) + __uint_as_float(t[1]);
}
__device__ __forceinline__ float sigmoidf_(float x) { return 1.f / (1.f + __expf(-x)); }
__device__ __forceinline__ float softplusf_(float x) { return fmaxf(x, 0.f) + log1pf(__expf(-fabsf(x))); }
__device__ __forceinline__ int mod_row(int r) { return r < NPR ? (r >> 12) : 2 + ((r - NPR) >> 3); }
#define WSP(T, off) ((T*)(F.wsp() + (off)))

struct CvtItem { const float* W; bf16* WT; int ldw, ldt, k0, n0; };
__device__ __forceinline__ void item_load(float (&tv)[32], const CvtItem& d, int lane) {
#pragma unroll
    for (int i = 0; i < 32; ++i) tv[i] = __builtin_nontemporal_load(d.W + (size_t)(d.k0 + 2 * i + (lane >> 5)) * d.ldw + d.n0 + (lane & 31));
}
__device__ __forceinline__ void item_store(const float (&tv)[32], const CvtItem& d, LAS float* scr, int lane) {
#pragma unroll
    for (int i = 0; i < 32; ++i) scr[(2 * i + (lane >> 5)) * 33 + (lane & 31)] = tv[i];
    LDS_WAIT(); asm volatile("" ::: "memory");
    const int c = lane & 7;
#pragma unroll
    for (int j = 0; j < 4; ++j) { const int n = (lane >> 3) + 8 * j; const LAS float* s = scr + (8 * c) * 33 + n;
        u32x4 o; o.x = cvt_pk_bf16(s[0 * 33], s[1 * 33]); o.y = cvt_pk_bf16(s[2 * 33], s[3 * 33]); o.z = cvt_pk_bf16(s[4 * 33], s[5 * 33]); o.w = cvt_pk_bf16(s[6 * 33], s[7 * 33]);
        *(GAS u32x4*)(d.WT + (size_t)(d.n0 + n) * d.ldt + d.k0 + 8 * c) = o; }
    LDS_WAIT(); asm volatile("" ::: "memory");
}
constexpr int IT_IN = 32 * 206, IT_OUT = 32 * 64, IT_W1 = 32 * 256, IT_W2 = 128 * 64, IT_PL = 8 * 16, NIT_ALL = IT_IN + IT_OUT + 2 * IT_W1 + 2 * IT_W2 + 4 * IT_PL;
__device__ __forceinline__ CvtItem item_decode(Ctx& F, int it) {
    int r = it; CvtItem d; int N;
    if (r < IT_IN) { d.W = F.in(I_WIN); d.WT = WSP(bf16, WS_WIN); N = INCOLS; d.ldt = DM; }
    else if ((r -= IT_IN) < IT_OUT) { d.W = F.in(I_WOUT); d.WT = WSP(bf16, WS_WOUT); N = DM; d.ldt = DM; }
    else if ((r -= IT_OUT) < 2 * IT_W1) { const int l = r / IT_W1; r -= l * IT_W1; d.W = F.in(I_W1) + (size_t)l * DM * DFF; d.WT = WSP(bf16, WS_W1) + (size_t)l * DFF * DM; N = DFF; d.ldt = DM; }
    else if ((r -= 2 * IT_W1) < 2 * IT_W2) { const int l = r / IT_W2; r -= l * IT_W2; d.W = F.in(I_W2) + (size_t)l * DFF * DM; d.WT = WSP(bf16, WS_W2) + (size_t)l * DM * DFF; N = DM; d.ldt = DFF; }
    else { r -= 2 * IT_W2; const int g = r / IT_PL; r -= g * IT_PL; d.W = F.in(I_WPOOL) + (size_t)g * 512 * 512; d.WT = WSP(bf16, WS_WPOOL) + (size_t)(g * 512) * DM + g * 512; N = 512; d.ldt = DM; }
    const int nblk = N / 32, kb = r / nblk, nb = r - kb * nblk;
    d.ldw = N; d.k0 = 64 * kb; d.n0 = 32 * nb; return d;
}
__device__ __forceinline__ void convert_run(Ctx& F, int first, int stride, int lim, LAS float* scr) {
    int it = first; if (it >= lim) return;
    float ta[32], tb[32]; CvtItem da = item_decode(F, it), db = da; item_load(ta, da, F.lane);
    for (;;) {
        const int i2 = it + stride; const bool h2 = i2 < lim; if (h2) { db = item_decode(F, i2); item_load(tb, db, F.lane); }
        item_store(ta, da, scr, F.lane); if (!h2) break;
        const int i3 = i2 + stride; const bool h3 = i3 < lim; if (h3) { da = item_decode(F, i3); item_load(ta, da, F.lane); }
        item_store(tb, db, scr, F.lane); if (!h3) break;
        it = i3; }
}
constexpr int NCVT = 40, N_HIDE = 24000;
__device__ __forceinline__ void phase_prologue(Ctx& F) {
    LAS float* scr = (LAS float*)(F.lds + F.wave * 16384);
    const int gw = F.vcu * NWAVES + F.wave, NGW = F.G * NWAVES;
    convert_run(F, gw, NGW, IT_IN, scr);
    if (F.G > NCVT + 8) convert_run(F, IT_IN + N_HIDE + gw, NGW, NIT_ALL, scr); else convert_run(F, IT_IN + gw, NGW, NIT_ALL, scr);
    for (int i = F.vcu * NTHR + F.tid; i < 3072 * 64; i += F.G * NTHR) {
        const int kc = i / 3072, n = i - kc * 3072, reg = n >> 10, nn = n & 1023;
        float v[8];
        if (reg == 0) {
#pragma unroll
            for (int j = 0; j < 8; ++j) { const int k = 8 * kc + j; v[j] = (k < 96) ? F.in(I_WUP)[(size_t)k * 1024 + nn] : 0.f; } }
        else if (reg == 1) {
#pragma unroll
            for (int j = 0; j < 8; ++j) { const int k = 8 * kc + j - 96; v[j] = (k >= 0 && k < 96) ? F.in(I_AUP)[(size_t)k * 1024 + nn] : 0.f; } }
        else {
#pragma unroll
            for (int j = 0; j < 8; ++j) { const int k = 8 * kc + j - 192; v[j] = (k >= 0 && k < 256) ? F.in(I_GUP)[(size_t)k * 1024 + nn] : 0.f; } }
        u32x4 o; o.x = cvt_pk_bf16(v[0], v[1]); o.y = cvt_pk_bf16(v[2], v[3]); o.z = cvt_pk_bf16(v[4], v[5]); o.w = cvt_pk_bf16(v[6], v[7]);
        *(GAS u32x4*)(WSP(bf16, WS_LWT) + (size_t)n * 512 + 8 * kc) = o;
    }
    __syncthreads();
    LAS float* sc = (LAS float*)F.lds;
    LAS float* part = (LAS float*)(F.lds + 81920);
    for (int i = F.tid; i < NMR * DM; i += NTHR) { const int r = i >> 11, k = i & 2047; const float c = r < 2 ? F.in(I_CP)[r * DM + k] : F.in(I_CS)[(r - 2) * DM + k]; sc[i] = c / (1.f + __expf(-c)); }
    __syncthreads();
    float* MOD = WSP(float, WS_MOD);
    float* MODP = WSP(float, WS_G);
    for (int u = F.vcu; u < 512; u += F.G) {
        const bool whole = u < 256; const int task = whole ? u : 256 + ((u - 256) >> 1), kh = whole ? 0 : (u - 256) & 1, klen = whole ? 256 : 128;
        const int l = task / 192, cb = (task - l * 192) * 64;
        const float* W = F.in(I_WADA) + (size_t)l * DM * 12288 + cb + F.lane;
        float acc[NMR];
#pragma unroll
        for (int r = 0; r < NMR; ++r) acc[r] = 0.f;
        const int kbeg = kh * 1024 + F.wave * klen;
        for (int k = kbeg; k < kbeg + klen; k += 16) {
            float wv[16];
#pragma unroll
            for (int j = 0; j < 16; ++j) wv[j] = __builtin_nontemporal_load(W + (size_t)(k + j) * 12288);
#pragma unroll
            for (int j = 0; j < 16; j += 4)
#pragma unroll
                for (int r = 0; r < NMR; ++r) { const f32x4 s = *(const LAS f32x4*)(sc + r * DM + k + j); acc[r] += (s.x * wv[j] + s.y * wv[j + 1]) + (s.z * wv[j + 2] + s.w * wv[j + 3]); }
        }
#pragma unroll
        for (int r = 0; r < NMR; ++r) part[(F.wave * NMR + r) * 64 + F.lane] = acc[r];
        __syncthreads();
        for (int i = F.tid; i < NMR * 64; i += NTHR) { const int r = i >> 6, c = i & 63; float s = 0.f;
#pragma unroll
            for (int w = 0; w < NWAVES; ++w) s += part[(w * NMR + r) * 64 + c];
            if (kh == 0) s += F.in(I_BADA)[l * 12288 + cb + c];
            if (whole) MOD[(size_t)(l * NMR + r) * 12288 + cb + c] = s; else MODP[((size_t)kh * NMR + r) * 8192 + (cb - 4096) + c] = s; }
        __syncthreads();
    }
}

struct Row { f32x4 v[8]; };
__device__ __forceinline__ void row_load(Row& R, const float* p, int lane) {
#pragma unroll
    for (int j = 0; j < 8; ++j) R.v[j] = *(const GAS f32x4*)(p + j * 256 + lane * 4);
}
__device__ __forceinline__ void row_load_bf16(Row& R, const bf16* p, int lane) {
#pragma unroll
    for (int j = 0; j < 8; ++j) { const u32x2 w = *(const GAS u32x2*)(p + j * 256 + lane * 4);
        R.v[j] = (f32x4){__uint_as_float(w.x << 16), __uint_as_float(w.x & 0xffff0000u), __uint_as_float(w.y << 16), __uint_as_float(w.y & 0xffff0000u)}; }
}
__device__ __forceinline__ float row_sumsq(const Row& R) { float s = 0.f;
#pragma unroll
    for (int j = 0; j < 8; ++j) s += (R.v[j].x * R.v[j].x + R.v[j].y * R.v[j].y) + (R.v[j].z * R.v[j].z + R.v[j].w * R.v[j].w);
    return wave_sum(s); }
__device__ __forceinline__ const float* x_in_row(Ctx& F, int r) { return r < NPR ? F.in(I_XP) + (size_t)r * DM : F.in(I_XS) + (size_t)(r - NPR) * DM; }
__device__ __forceinline__ void row_modulate(Row& H, const Row& X, float rstd, const float* g, const float* shift, const float* scale, int lane) {
#pragma unroll
    for (int j = 0; j < 8; ++j) { const int c = j * 256 + lane * 4; const f32x4 gg = *(const GAS f32x4*)(g + c), sh = *(const GAS f32x4*)(shift + c), sc = *(const GAS f32x4*)(scale + c);
        H.v[j] = X.v[j] * rstd * gg * (sc + 1.f) + sh; }
}
__device__ __forceinline__ void row_store_bf16(const Row& H, bf16* p, int lane) {
#pragma unroll
    for (int j = 0; j < 8; ++j) { u32x2 w; w.x = cvt_pk_bf16(H.v[j].x, H.v[j].y); w.y = cvt_pk_bf16(H.v[j].z, H.v[j].w); *(GAS u32x2*)(p + j * 256 + lane * 4) = w; }
}
__device__ __forceinline__ void row_store_f32(const Row& H, float* p, int lane) {
#pragma unroll
    for (int j = 0; j < 8; ++j) *(GAS f32x4*)(p + j * 256 + lane * 4) = H.v[j];
}
__device__ __forceinline__ void row_store_f32_nt(const Row& H, float* p, int lane) {
#pragma unroll
    for (int j = 0; j < 8; ++j) __builtin_nontemporal_store(H.v[j], (GAS f32x4*)(p + j * 256 + lane * 4));
}
__device__ __forceinline__ void phase_mod0(Ctx& F) {
    const int gw = F.vcu * NWAVES + F.wave, NGW = F.G * NWAVES; const float* MOD = WSP(float, WS_MOD); bf16* Hb = WSP(bf16, WS_H);
    for (int r = gw; r < NTOK; r += NGW) {
        Row X, H; row_load(X, x_in_row(F, r), F.lane);
        const float rstd = rsqrtf(row_sumsq(X) * (1.f / DM) + EPS_RMS);
        const float* m = MOD + (size_t)(0 * NMR + mod_row(r)) * 12288;
        row_modulate(H, X, rstd, F.in(I_NG) + 0 * DM, m + 0 * DM, m + 1 * DM, F.lane);
        row_store_bf16(H, Hb + (size_t)r * DM, F.lane);
    }
}
__device__ __forceinline__ void row_residual(Row& X, const Row& O, const float* ga, const float* gate, int lane) {
    const float rstd = rsqrtf(row_sumsq(O) * (1.f / DM) + EPS_RMS);
#pragma unroll
    for (int j = 0; j < 8; ++j) { const int c = j * 256 + lane * 4; const f32x4 gg = *(const GAS f32x4*)(ga + c), gt = *(const GAS f32x4*)(gate + c); X.v[j] = X.v[j] + gt * (O.v[j] * rstd * gg); }
}
template <int NK> __device__ __forceinline__ void row_load_out(Ctx& F, Row& O, int r, int lane) {
    if (r < NPR) { const bf16* op = WSP(bf16, WS_OUT) + (size_t)r * DM;
#pragma unroll
        for (int j = 0; j < 8; ++j) { const u32x2 w = *(const GAS u32x2*)(op + j * 256 + lane * 4);
            O.v[j] = (f32x4){__uint_as_float(w.x << 16), __uint_as_float(w.x & 0xffff0000u), __uint_as_float(w.y << 16), __uint_as_float(w.y & 0xffff0000u)}; }
        return; }
    const float* pp = WSP(float, WS_PART) + (size_t)(r - NPR) * DM;
    row_load(O, pp, lane);
    for (int kc = 1; kc < NK; ++kc) { Row T; row_load(T, pp + (size_t)kc * 64 * DM, lane);
#pragma unroll
        for (int j = 0; j < 8; ++j) O.v[j] += T.v[j]; }
}
__device__ __forceinline__ f32x4 ld_bf4(const bf16* p) { const u32x2 w = *(const GAS u32x2*)p; return (f32x4){__uint_as_float(w.x << 16), __uint_as_float(w.x & 0xffff0000u), __uint_as_float(w.y << 16), __uint_as_float(w.y & 0xffff0000u)}; }
__device__ __forceinline__ void row_load_pool(Ctx& F, Row& O, int r, int lane) {
    if (r < NPR) { const int t = r & (SEQ - 1); const bf16* op = WSP(bf16, WS_OUT) + (size_t)r * DM + lane * 4;
#pragma unroll
        for (int j8 = 0; j8 < 8; ++j8) { constexpr int dummy = 0; (void)dummy; const int wlen = 2 << (j8 >> 1), n = (t + 1) < wlen ? (t + 1) : wlen;
            const f32x4 cur = ld_bf4(op + j8 * 256); f32x4 sum = cur;
            for (int j = 1; j < n; ++j) sum += ld_bf4(op + j8 * 256 - (size_t)j * DM);
            O.v[j8] = sum * (1.f / (float)n) - cur; }
    } else { const int rs = r - NPR, b = rs >> 3, t = rs & 7; const float* pp = WSP(float, WS_PART) + lane * 4;
#pragma unroll
        for (int j8 = 0; j8 < 8; ++j8) { const int wlen = 2 << (j8 >> 1); f32x4 cur = {0.f, 0.f, 0.f, 0.f}, sum = {0.f, 0.f, 0.f, 0.f};
            for (int j = 0; j < wlen; ++j) { const int tj = t - j, pr = tj >= 0 ? rs - j : 64 + b * PBUF + PBUF + tj;
                const f32x4 g = *(const GAS f32x4*)(pp + (size_t)pr * DM + j8 * 256) + *(const GAS f32x4*)(pp + (size_t)(256 + pr) * DM + j8 * 256);
                sum += g; if (j == 0) cur = g; }
            O.v[j8] = sum * (1.f / (float)wlen) - cur; }
    }
}
template <int L> __device__ __forceinline__ void phase_postmix(Ctx& F) {
    const int gw = F.vcu * NWAVES + F.wave, NGW = F.G * NWAVES; const float* MOD = WSP(float, WS_MOD); bf16* Hb = WSP(bf16, WS_H); bf16* XR = WSP(bf16, WS_XR);
    const float* ng = F.in(I_NG) + (size_t)L * 4 * DM;
    for (int r = gw; r < NTOK; r += NGW) {
        Row X, O, H; if (L == 0) row_load(X, x_in_row(F, r), F.lane); else row_load_bf16(X, XR + (size_t)r * DM, F.lane); if (L == 0) row_load_out<8>(F, O, r, F.lane); else row_load_pool(F, O, r, F.lane);
        const float* m = MOD + (size_t)(L * NMR + mod_row(r)) * 12288;
        row_residual(X, O, ng + 1 * DM, m + 2 * DM, F.lane);
        row_store_bf16(X, XR + (size_t)r * DM, F.lane);
        const float rstd = rsqrtf(row_sumsq(X) * (1.f / DM) + EPS_RMS);
        row_modulate(H, X, rstd, ng + 2 * DM, m + 3 * DM, m + 4 * DM, F.lane);
        row_store_bf16(H, Hb + (size_t)r * DM, F.lane);
    }
}
template <int L> __device__ __forceinline__ void phase_postmlp(Ctx& F) {
    const int gw = F.vcu * NWAVES + F.wave, NGW = F.G * NWAVES; const float* MOD = WSP(float, WS_MOD); bf16* XR = WSP(bf16, WS_XR);
    const float* ng = F.in(I_NG) + (size_t)L * 4 * DM;
    for (int r = gw; r < NTOK; r += NGW) {
        Row X, O; row_load_bf16(X, XR + (size_t)r * DM, F.lane); row_load_out<32>(F, O, r, F.lane);
        const float* m = MOD + (size_t)(L * NMR + mod_row(r)) * 12288;
        row_residual(X, O, ng + 3 * DM, m + 5 * DM, F.lane);
        if (L == 0) {
            row_store_bf16(X, XR + (size_t)r * DM, F.lane);
            Row H; const float rstd = rsqrtf(row_sumsq(X) * (1.f / DM) + EPS_RMS);
            const float* m1 = MOD + (size_t)(1 * NMR + mod_row(r)) * 12288;
            row_modulate(H, X, rstd, F.in(I_NG) + (size_t)4 * DM, m1 + 0 * DM, m1 + 1 * DM, F.lane);
            row_store_bf16(H, WSP(bf16, WS_H) + (size_t)r * DM, F.lane);
            if (r < NPR) { const int t = r & (SEQ - 1); if (t >= SEQ - PBUF) row_store_f32(H, F.outp() + O_PLP + ((size_t)(r >> 12) * PBUF + (t - (SEQ - PBUF))) * DM, F.lane); }
            else { const int rs = r - NPR; row_store_f32(H, F.outp() + O_PLS + ((size_t)(rs >> 3) * PBUF + 7 + (rs & 7)) * DM, F.lane); }
        } else {
            float* y = r < NPR ? F.outp() + O_YP + (size_t)r * DM : F.outp() + O_YS + (size_t)(r - NPR) * DM;
            row_store_f32_nt(X, y, F.lane);
        }
    }
    if (L == 0) {
        const float* SP = F.in(I_SPOOL); bf16* Hb = WSP(bf16, WS_H);
        for (int i = F.vcu * NTHR + F.tid; i < DBAT * PBUF * 512; i += F.G * NTHR) { const int c4 = (i & 511) * 4, bi = i >> 9, b = bi / PBUF, k = bi - b * PBUF;
            const f32x4 v = *(const GAS f32x4*)(SP + (size_t)bi * DM + c4); u32x2 w; w.x = cvt_pk_bf16(v.x, v.y); w.y = cvt_pk_bf16(v.z, v.w);
            *(GAS u32x2*)(Hb + (size_t)(NTOK + bi) * DM + c4) = w;
            if (k >= 8) *(GAS f32x4*)(F.outp() + O_PLS + ((size_t)b * PBUF + (k - 8)) * DM + c4) = v; }
    }
}

__device__ __forceinline__ void phase_kv_prep(Ctx& F) {
    { const float* MODP = WSP(float, WS_G); float* MOD = WSP(float, WS_MOD);
      for (int i = F.vcu * NTHR + F.tid; i < NMR * 8192; i += F.G * NTHR) { const int r = i >> 13, c = i & 8191; MOD[(size_t)(1 * NMR + r) * 12288 + 4096 + c] = MODP[(size_t)r * 8192 + c] + MODP[((size_t)NMR + r) * 8192 + c]; } }
    const float* P = WSP(float, WS_P);
    for (int i = F.vcu * NTHR + F.tid; i < (NBATCH + DBAT) * BCOLS; i += F.G * NTHR) {
        const int b = i / BCOLS, c = i - b * BCOLS; const int r = b < NBATCH ? b * SEQ + SEQ - 1 : NPR + (b - NBATCH) * DSEQ + DSEQ - 1;
        F.outp()[(b < NBATCH ? O_SHP + (size_t)b * BCOLS : O_SHS + (size_t)(b - NBATCH) * BCOLS) + c] = (b < NBATCH && c < 3072) ? ldbf(WSP(bf16, WS_PBH) + (size_t)r * 3072 + c) : P[(size_t)r * PBLD + c];
    }
    { const int gw = F.vcu * NWAVES + F.wave, NGW = F.G * NWAVES; const float* mu = F.in(I_MU); bf16* LA = WSP(bf16, WS_LA);
      for (int r = gw; r < NTOK; r += NGW) {
        const float* pb = P + (size_t)r * PBLD; const float* prev; bool hp;
        if (r < NPR) { const int t = r & (SEQ - 1); hp = t > 0; prev = pb - PBLD; }
        else { const int rs = r - NPR, b = rs >> 3, t = rs & 7; hp = true; prev = t > 0 ? pb - PBLD : F.in(I_SSH) + (size_t)b * BCOLS; }
        float v[8];
        { const int c0 = 3072 + F.lane * 8; const bool act = F.lane < 56; const f32x4 z4 = {0.f, 0.f, 0.f, 0.f};
          f32x4 pa = z4, pc = z4, qa = z4, qc = z4, ma = z4, mc = z4;
          if (act) { pa = *(const GAS f32x4*)(pb + c0); pc = *(const GAS f32x4*)(pb + c0 + 4); ma = *(const GAS f32x4*)(mu + c0); mc = *(const GAS f32x4*)(mu + c0 + 4);
                     if (hp) { qa = *(const GAS f32x4*)(prev + c0); qc = *(const GAS f32x4*)(prev + c0 + 4); } }
          const f32x4 za = pa + ma * (qa - pa), zc = pc + mc * (qc - pc);
          const float kz = F.lane < 12 ? 2.f : 1.f;
#pragma unroll
          for (int j = 0; j < 8; ++j) { const float z = j < 4 ? za[j & 3] : zc[j & 3]; const float sg = 1.f / (1.f + __expf(-kz * z));
              v[j] = !act ? 0.f : (F.lane < 12 ? 2.f * sg - 1.f : (F.lane < 24 ? z : sg)); } }
        u32x4 o; o.x = cvt_pk_bf16(v[0], v[1]); o.y = cvt_pk_bf16(v[2], v[3]); o.z = cvt_pk_bf16(v[4], v[5]); o.w = cvt_pk_bf16(v[6], v[7]);
        *(GAS u32x4*)(LA + (size_t)r * 512 + F.lane * 8) = o;
      } }
}
__device__ __forceinline__ void phase_rwkv_prep(Ctx& F) {
    const float* P = WSP(float, WS_P); const float* LWO = WSP(float, WS_LWO);
    const int gw = F.vcu * NWAVES + F.wave, NGW = F.G * NWAVES;
    float* RWV = WSP(float, WS_RWV); float* SCL = WSP(float, WS_SCL);
    const float* mu = F.in(I_MU);
    for (int u = gw; u < NSM * 4; u += NGW) {
        const int r = NPR + (u >> 2), hq = u & 3;
        const float* pb = P + (size_t)r * PBLD; const float* prev; const bool hp = true;
        { const int rs = r - NPR, b = rs >> 3, t = rs & 7; prev = t > 0 ? pb - PBLD : F.in(I_SSH) + (size_t)b * BCOLS; }
        const float* lw = LWO + (size_t)r * 3072;
        float pr[4], pk[4], pv[4], qr_[4], qk[4], qv[4], lwl[4], lal[4], lgl[4];
#pragma unroll
        for (int i = 0; i < 4; ++i) { const int col = (hq * 4 + i) * 64 + F.lane;
            pr[i] = pb[col]; pk[i] = pb[1024 + col]; pv[i] = pb[2048 + col];
            qr_[i] = hp ? prev[col] : 0.f; qk[i] = hp ? prev[1024 + col] : 0.f; qv[i] = hp ? prev[2048 + col] : 0.f;
            lwl[i] = lw[col]; lal[i] = lw[1024 + col]; lgl[i] = lw[2048 + col]; }
#pragma unroll
        for (int i = 0; i < 4; ++i) { const int h = hq * 4 + i, col = h * 64 + F.lane;
            const float zr = pr[i] + mu[col] * (qr_[i] - pr[i]), zk = pk[i] + mu[1024 + col] * (qk[i] - pk[i]), zv = pv[i] + mu[2048 + col] * (qv[i] - pv[i]);
            const float wl = F.in(I_W0)[col] + lwl[i], al = F.in(I_A0)[col] + lal[i], gl = lgl[i];
            const float wlog = -softplusf_(-wl) - 0.5f, decay = __expf(-__expf(wlog));
            const float a = sigmoidf_(al);
            const float kkr = zk * F.in(I_KK)[col], kk = kkr * rsqrtf(wave_sum(kkr * kkr) + 1e-12f);
            const float k = zk * (1.f + (a - 1.f) * F.in(I_KA)[col]);
            const float bb = kk * a;
            const float bonus = wave_sum(zr * k * F.in(I_RK)[col]), beta = wave_sum(bb * zr), kappa = wave_sum(k * zr);
            float* base = RWV + ((size_t)r * HB + h) * 512;
            base[F.lane] = decay; base[64 + F.lane] = kk; base[128 + F.lane] = bb; base[192 + F.lane] = k; base[256 + F.lane] = zr; base[320 + F.lane] = zv; base[384 + F.lane] = decay * zr;
            if (F.lane == 0) { float* s_ = SCL + ((size_t)r * HB + h) * 4; s_[0] = beta; s_[1] = kappa; s_[2] = bonus; s_[3] = 0.f; }
        }
    }
}

namespace sba {
typedef short bf16x8 __attribute__((ext_vector_type(8)));
typedef short s16x4 __attribute__((ext_vector_type(4)));
typedef float f32x16 __attribute__((ext_vector_type(16)));
constexpr int SHM = 16384, LDQ = 1024;
#define SB_KSWZ(row, colB) ((row) * 256 + ((colB) ^ (((row) & 7) << 4)))
#define SB_SBAR() __builtin_amdgcn_sched_barrier(0)
__device__ __forceinline__ int v_st(int k, int c) { const int kk = (k & ~0xC) | ((k & 4) << 1) | ((k & 8) >> 1); return ((kk >> 3) * 4 + (c >> 5)) * 512 + ((kk & 7) * 32 + (c & 31)) * 2; }
__device__ __forceinline__ int v_rd_base(int lane) { return ((lane & 3) << 3) | (((lane >> 2) & 3) << 6) | (((lane >> 4) & 1) << 5) | (((lane >> 5) & 1) << 8); }
__device__ __forceinline__ int crow(int r, int hi) { return (r & 3) + 8 * (r >> 2) + 4 * hi; }
__device__ __forceinline__ void qkt(f32x16& p0, f32x16& p1, const char* Kt, int r32, int hi, const bf16x8* qr) {
    p0 = f32x16{}; p1 = f32x16{};
    const char* kb[4];
#pragma unroll
    for (int dd = 0; dd < 4; ++dd) kb[dd] = Kt + SB_KSWZ(r32, (dd * 16 + hi * 8) * 2);
#pragma unroll
    for (int d0 = 0; d0 < 8; ++d0) { const char* a = kb[d0 & 3] + (d0 >> 2) * 128;
        const bf16x8 b0 = *reinterpret_cast<const bf16x8*>(a);
        const bf16x8 b1 = *reinterpret_cast<const bf16x8*>(a + 32 * 256);
        p0 = __builtin_amdgcn_mfma_f32_32x32x16_bf16(b0, qr[d0], p0, 0, 0, 0);
        p1 = __builtin_amdgcn_mfma_f32_32x32x16_bf16(b1, qr[d0], p1, 0, 0, 0); }
}
__device__ __forceinline__ void pv_tile(f32x16* o, int vb0, bf16x8 pa0, bf16x8 pa1, bf16x8 pa2, bf16x8 pa3) {
#define SB_TRRD(dst, off) asm volatile("ds_read_b64_tr_b16 %0, %1 offset:%2" : "=&v"(dst) : "v"(vb0), "i"(off) : "memory")
#define SB_PV_D0(d0) do { s16x4 l0, l1, l2, l3, h0, h1, h2, h3; constexpr int b_ = (d0) * 512; \
        SB_TRRD(l0, b_); SB_TRRD(h0, b_ + 2048); SB_TRRD(l1, b_ + 4096); SB_TRRD(h1, b_ + 6144); SB_TRRD(l2, b_ + 8192); SB_TRRD(h2, b_ + 10240); SB_TRRD(l3, b_ + 12288); SB_TRRD(h3, b_ + 14336); \
        asm volatile("s_waitcnt lgkmcnt(0)" ::: "memory"); SB_SBAR(); \
        o[d0] = __builtin_amdgcn_mfma_f32_32x32x16_bf16(pa0, (bf16x8){l0[0], l0[1], l0[2], l0[3], h0[0], h0[1], h0[2], h0[3]}, o[d0], 0, 0, 0); \
        o[d0] = __builtin_amdgcn_mfma_f32_32x32x16_bf16(pa1, (bf16x8){l1[0], l1[1], l1[2], l1[3], h1[0], h1[1], h1[2], h1[3]}, o[d0], 0, 0, 0); \
        o[d0] = __builtin_amdgcn_mfma_f32_32x32x16_bf16(pa2, (bf16x8){l2[0], l2[1], l2[2], l2[3], h2[0], h2[1], h2[2], h2[3]}, o[d0], 0, 0, 0); \
        o[d0] = __builtin_amdgcn_mfma_f32_32x32x16_bf16(pa3, (bf16x8){l3[0], l3[1], l3[2], l3[3], h3[0], h3[1], h3[2], h3[3]}, o[d0], 0, 0, 0); } while (0)
    SB_PV_D0(0); SB_PV_D0(1); SB_PV_D0(2); SB_PV_D0(3);
#undef SB_PV_D0
#undef SB_TRRD
}
__device__ __forceinline__ float swap_other(float x, int hi) {
    auto rr = __builtin_amdgcn_permlane32_swap(__float_as_uint(x), __float_as_uint(x), false, false);
    return __uint_as_float(hi ? rr[0] : rr[1]);
}
template <bool MASK> __device__ __forceinline__ void sb_weights(f32x16& p0, f32x16& p1, float& carry, float C2, float b2, int dq, int hi) {
    float T[8];
#pragma unroll
    for (int g = 0; g < 8; ++g) {
        float iv[4], be[4];
#pragma unroll
        for (int k = 0; k < 4; ++k) { const int r = (g & 3) * 4 + k; const float s = g < 4 ? p0[r] : p1[r];
            const float z2 = fminf(fmaf(s, C2, b2), 64.f), e = __builtin_amdgcn_exp2f(z2), i_ = __builtin_amdgcn_rcpf(1.f + e); float b_ = e * i_, ii = i_;
            if (MASK) { const int c = (r & 3) + 8 * (r >> 2) + (g < 4 ? 0 : 32); const bool vis = c < dq; ii = vis ? ii : 1.f; b_ = vis ? b_ : 0.f; }
            iv[k] = ii; be[k] = b_; }
        const float ex2 = iv[3], ex1 = iv[2] * iv[3], ex0 = iv[1] * ex1; T[g] = iv[0] * ex0;
        const float w0 = be[0] * ex0, w1 = be[1] * ex1, w2 = be[2] * ex2, w3 = be[3];
        if (g < 4) { p0[(g & 3) * 4 + 0] = w0; p0[(g & 3) * 4 + 1] = w1; p0[(g & 3) * 4 + 2] = w2; p0[(g & 3) * 4 + 3] = w3; }
        else { p1[(g & 3) * 4 + 0] = w0; p1[(g & 3) * 4 + 1] = w1; p1[(g & 3) * 4 + 2] = w2; p1[(g & 3) * 4 + 3] = w3; }
    }
    float suf = carry;
#pragma unroll
    for (int g = 7; g >= 0; --g) {
        const float To = swap_other(T[g], hi);
        const float E = hi ? suf : suf * To;
#pragma unroll
        for (int k = 0; k < 4; ++k) { if (g < 4) p0[(g & 3) * 4 + k] *= E; else p1[(g & 3) * 4 + k] *= E; }
        suf = suf * (T[g] * To);
    }
    carry = suf;
}
__device__ __forceinline__ void pack_p(const f32x16& p0, const f32x16& p1, bf16x8& pa0, bf16x8& pa1, bf16x8& pa2, bf16x8& pa3) {
#define SB_PK4(P, B_, OUT) do { unsigned a0 = cvt_pk_bf16(P[B_ + 0], P[B_ + 1]), a1 = cvt_pk_bf16(P[B_ + 2], P[B_ + 3]); \
        unsigned b0 = cvt_pk_bf16(P[B_ + 4], P[B_ + 5]), b1 = cvt_pk_bf16(P[B_ + 6], P[B_ + 7]); \
        auto r0 = __builtin_amdgcn_permlane32_swap(a0, b0, false, false); auto r1 = __builtin_amdgcn_permlane32_swap(a1, b1, false, false); \
        u32x4 w = {r0[0], r1[0], r0[1], r1[1]}; OUT = *reinterpret_cast<bf16x8*>(&w); } while (0)
    SB_PK4(p0, 0, pa0); SB_PK4(p0, 8, pa1); SB_PK4(p1, 0, pa2); SB_PK4(p1, 8, pa3);
#undef SB_PK4
}
__device__ __forceinline__ void attn_half(Ctx& F, int bh, int x, int half) {
    const int tid = F.tid, wid = F.wave, lane = F.lane, r32 = lane & 31, hi = lane >> 5, b = bh >> 3, h = bh & 7;
    const bf16* Qg = WSP(bf16, WS_QB) + (size_t)(b * SEQ + 256 * x) * LDQ + h * 128;
    const bf16* Kg = WSP(bf16, WS_KB) + (size_t)(b * SEQ) * LDQ + h * 128; const bf16* Vg = WSP(bf16, WS_VB) + (size_t)(b * SEQ) * LDQ + h * 128;
    const int NT = 4 * (x + 1), t_hi = half == 0 ? NT : NT / 2, t_lo = half == 0 ? NT / 2 : 0;
    const int qlo = 256 * x + 32 * wid, qpos = qlo + r32;
    char* V_lds = (char*)F.lds; char* K_lds = (char*)F.lds + 2 * SHM;
    bf16x8 qr[8];
#pragma unroll
    for (int d0 = 0; d0 < 8; ++d0) qr[d0] = *reinterpret_cast<const bf16x8*>(Qg + (size_t)(wid * 32 + r32) * LDQ + d0 * 16 + hi * 8);
    const int sr = tid >> 4, sc = (tid & 15) * 8, vst0 = v_st(sr, sc), vst1 = v_st(32 + sr, sc), kws = SB_KSWZ(sr, sc * 2);
    const int vb0 = (int)(uintptr_t)V_lds + v_rd_base(lane);
    bf16x8 st_k0, st_k1, st_v0, st_v1;
    const unsigned so0 = (unsigned)(sr * LDQ + sc) * 2u, so1 = so0 + 32u * LDQ * 2u;
#define SB_SLOAD(t) do { const char* kt_ = (const char*)Kg + (size_t)(t) * (64 * LDQ * 2); const char* vt_ = (const char*)Vg + (size_t)(t) * (64 * LDQ * 2); \
        st_k0 = *reinterpret_cast<const bf16x8*>(kt_ + so0); st_k1 = *reinterpret_cast<const bf16x8*>(kt_ + so1); st_v0 = *reinterpret_cast<const bf16x8*>(vt_ + so0); st_v1 = *reinterpret_cast<const bf16x8*>(vt_ + so1); } while (0)
#define SB_SWRITE(bf) do { *(bf16x8*)(K_lds + (bf) * SHM + kws) = st_k0; *(bf16x8*)(K_lds + (bf) * SHM + kws + 32 * 256) = st_k1; \
        *(bf16x8*)(V_lds + (bf) * SHM + vst0) = st_v0; *(bf16x8*)(V_lds + (bf) * SHM + vst1) = st_v1; } while (0)
    __syncthreads();
    SB_SLOAD(t_hi - 1); VM_WAIT(); SB_SWRITE(0);
    __syncthreads();
    const float C2 = QK_SCALE * 1.4426950408889634f, b2 = F.in(I_SBB)[h] * 1.4426950408889634f;
    float carry = 1.f; f32x16 o[4] = {};
    int buf = 0;
    for (int t = t_hi - 1; t >= t_lo; --t) {
        if (t > t_lo) SB_SLOAD(t - 1);
        const int kb = 64 * t;
        if (kb < qlo + 31) {
            f32x16 p0, p1; bf16x8 pa0, pa1, pa2, pa3;
            qkt(p0, p1, K_lds + buf * SHM, r32, hi, qr);
            if (kb + 63 >= qlo) sb_weights<true>(p0, p1, carry, C2, b2, qpos - kb - 4 * hi, hi); else sb_weights<false>(p0, p1, carry, C2, b2, 0, hi);
            pack_p(p0, p1, pa0, pa1, pa2, pa3);
            pv_tile(o, vb0 + buf * SHM, pa0, pa1, pa2, pa3);
        }
        if (t > t_lo) { VM_WAIT(); SB_SWRITE(buf ^ 1); }
        __syncthreads();
        buf ^= 1;
    }
#undef SB_SLOAD
#undef SB_SWRITE
    float* Op = WSP(float, WS_OP) + ((size_t)half * NPR + b * SEQ + 256 * x + wid * 32) * 1024 + h * 128;
    const unsigned lo_ = (unsigned)(4 * hi * 1024 + r32);
#pragma unroll
    for (int r = 0; r < 16; ++r) { float* Opr = Op + (size_t)((r & 3) + 8 * (r >> 2)) * 1024;
#pragma unroll
        for (int d0 = 0; d0 < 4; ++d0) Opr[lo_ + d0 * 32] = o[d0][r]; }
    if (half == 0 && hi == 0) WSP(float, WS_CL)[(size_t)(b * SEQ + qpos) * HA + h] = carry;
}
#undef SB_KSWZ
#undef SB_SBAR
}
namespace sba {
__device__ __forceinline__ void sb_weights32(f32x16& p0, float& carry, float C2, float b2, int hi) {
    float T[4];
#pragma unroll
    for (int g = 0; g < 4; ++g) {
        float iv[4], be[4];
#pragma unroll
        for (int k = 0; k < 4; ++k) { const float z2 = fminf(fmaf(p0[g * 4 + k], C2, b2), 64.f), e = __builtin_amdgcn_exp2f(z2), i_ = __builtin_amdgcn_rcpf(1.f + e); iv[k] = i_; be[k] = e * i_; }
        const float ex2 = iv[3], ex1 = iv[2] * iv[3], ex0 = iv[1] * ex1; T[g] = iv[0] * ex0;
        p0[g * 4 + 0] = be[0] * ex0; p0[g * 4 + 1] = be[1] * ex1; p0[g * 4 + 2] = be[2] * ex2; p0[g * 4 + 3] = be[3];
    }
    float suf = carry;
#pragma unroll
    for (int g = 3; g >= 0; --g) { const float To = swap_other(T[g], hi); const float E = hi ? suf : suf * To;
#pragma unroll
        for (int k = 0; k < 4; ++k) p0[g * 4 + k] *= E;
        suf = suf * (T[g] * To); }
    carry = suf;
}
__device__ __forceinline__ void attn_sample_unit(Ctx& F, int bh, int pg, char* wl  ) {
    const int lane = F.lane, r32 = lane & 31, hi = lane >> 5, b = bh >> 3, h = bh & 7;
    char* K_lds = wl; char* V_lds = wl + 8192;
    bf16x8 qr[8];
    { const bf16* Qg = WSP(bf16, WS_QB) + (size_t)(NPR + b * DSEQ + (r32 & 7)) * LDQ + h * 128;
#pragma unroll
      for (int d0 = 0; d0 < 8; ++d0) { bf16x8 v = *reinterpret_cast<const bf16x8*>(Qg + d0 * 16 + hi * 8); if (r32 >= 8) v = bf16x8{}; qr[d0] = v; } }
    const int kl = lane >> 5, c4 = (lane & 31) * 4;
    const unsigned goff = (unsigned)(kl * 1024 + c4) * 4u;
    const int vb0 = (int)(uintptr_t)V_lds + v_rd_base(lane);
    const float C2 = QK_SCALE * 1.4426950408889634f, b2 = F.in(I_SBB)[h] * 1.4426950408889634f;
    const int* pt = ((const int*)F.in(I_PT)) + b * NPAGES + pg * 4;
    f32x4 sa[8], sb[8];
#define SU_BASE(n) ({ const int i_ = (n) >> 2, k_ = (n) & 3, tt_ = 15 - i_; const int phys_ = pt[tt_ >> 2]; \
        (const char*)((k_ & 2) ? F.in(I_CV) : F.in(I_CK)) + (((size_t)phys_ * PAGESZ + (tt_ & 3) * 32 + (k_ & 1) * 16) * 1024 + h * 128) * 4; })
#define SU_LOAD(S, n) do { const char* bp_ = SU_BASE(n); _Pragma("unroll") for (int j = 0; j < 8; ++j) S[j] = __builtin_nontemporal_load((const GAS f32x4*)(bp_ + goff + (size_t)j * 8192)); } while (0)
#define SU_WRK(S, kh) do { _Pragma("unroll") for (int j = 0; j < 8; ++j) { const int key = (kh) * 16 + 2 * j + kl; u32x2 w; w.x = cvt_pk_bf16(S[j].x, S[j].y); w.y = cvt_pk_bf16(S[j].z, S[j].w); \
        *(u32x2*)(K_lds + (key * 256 + ((c4 * 2) ^ ((key & 7) << 4)))) = w; } } while (0)
#define SU_WRV(S, kh) do { _Pragma("unroll") for (int j = 0; j < 8; ++j) { const int key = (kh) * 16 + 2 * j + kl; u32x2 w; w.x = cvt_pk_bf16(S[j].x, S[j].y); w.y = cvt_pk_bf16(S[j].z, S[j].w); \
        *(u32x2*)(V_lds + v_st(key, c4)) = w; } } while (0)
    SU_LOAD(sa, 0); SU_LOAD(sb, 1);
    float carry = 1.f; f32x16 o[4] = {};
    for (int i = 0; i < 16; ++i) {
        asm volatile("s_waitcnt vmcnt(8)" ::: "memory"); SU_WRK(sa, 0); SU_LOAD(sa, 4 * i + 2);
        asm volatile("s_waitcnt vmcnt(8)" ::: "memory"); SU_WRK(sb, 1); SU_LOAD(sb, 4 * i + 3);
        asm volatile("s_waitcnt vmcnt(8)" ::: "memory"); SU_WRV(sa, 0); if (i < 15) SU_LOAD(sa, 4 * i + 4);
        if (i < 15) asm volatile("s_waitcnt vmcnt(8)" ::: "memory"); else asm volatile("s_waitcnt vmcnt(0)" ::: "memory");
        SU_WRV(sb, 1); if (i < 15) SU_LOAD(sb, 4 * i + 5);
        asm volatile("s_waitcnt lgkmcnt(0)" ::: "memory");
        f32x16 p0 = f32x16{};
        { const char* kb[4];
#pragma unroll
          for (int dd = 0; dd < 4; ++dd) kb[dd] = K_lds + (r32 * 256 + (((dd * 16 + hi * 8) * 2) ^ ((r32 & 7) << 4)));
#pragma unroll
          for (int d0 = 0; d0 < 8; ++d0) { const bf16x8 b0 = *reinterpret_cast<const bf16x8*>(kb[d0 & 3] + (d0 >> 2) * 128); p0 = __builtin_amdgcn_mfma_f32_32x32x16_bf16(b0, qr[d0], p0, 0, 0, 0); } }
        sb_weights32(p0, carry, C2, b2, hi);
        bf16x8 pa0, pa1;
        { unsigned a0 = cvt_pk_bf16(p0[0], p0[1]), a1 = cvt_pk_bf16(p0[2], p0[3]), b0 = cvt_pk_bf16(p0[4], p0[5]), b1 = cvt_pk_bf16(p0[6], p0[7]);
          auto r0 = __builtin_amdgcn_permlane32_swap(a0, b0, false, false); auto r1 = __builtin_amdgcn_permlane32_swap(a1, b1, false, false);
          u32x4 w = {r0[0], r1[0], r0[1], r1[1]}; pa0 = *reinterpret_cast<bf16x8*>(&w); }
        { unsigned a0 = cvt_pk_bf16(p0[8], p0[9]), a1 = cvt_pk_bf16(p0[10], p0[11]), b0 = cvt_pk_bf16(p0[12], p0[13]), b1 = cvt_pk_bf16(p0[14], p0[15]);
          auto r0 = __builtin_amdgcn_permlane32_swap(a0, b0, false, false); auto r1 = __builtin_amdgcn_permlane32_swap(a1, b1, false, false);
          u32x4 w = {r0[0], r1[0], r0[1], r1[1]}; pa1 = *reinterpret_cast<bf16x8*>(&w); }
#define SU_TRRD(dst, off) asm volatile("ds_read_b64_tr_b16 %0, %1 offset:%2" : "=&v"(dst) : "v"(vb0), "i"(off) : "memory")
#define SU_PV(d0) do { s16x4 l0, l1, h0, h1; constexpr int b_ = (d0) * 512; SU_TRRD(l0, b_); SU_TRRD(h0, b_ + 2048); SU_TRRD(l1, b_ + 4096); SU_TRRD(h1, b_ + 6144); \
        asm volatile("s_waitcnt lgkmcnt(0)" ::: "memory"); __builtin_amdgcn_sched_barrier(0); \
        o[d0] = __builtin_amdgcn_mfma_f32_32x32x16_bf16(pa0, (bf16x8){l0[0], l0[1], l0[2], l0[3], h0[0], h0[1], h0[2], h0[3]}, o[d0], 0, 0, 0); \
        o[d0] = __builtin_amdgcn_mfma_f32_32x32x16_bf16(pa1, (bf16x8){l1[0], l1[1], l1[2], l1[3], h1[0], h1[1], h1[2], h1[3]}, o[d0], 0, 0, 0); } while (0)
        SU_PV(0); SU_PV(1); SU_PV(2); SU_PV(3);
        asm volatile("s_waitcnt lgkmcnt(0)" ::: "memory");
    }
#undef SU_PV
#undef SU_TRRD
#undef SU_WRV
#undef SU_WRK
#undef SU_LOAD
#undef SU_BASE
    float* Sp = WSP(float, WS_SPART) + ((size_t)(bh * 32 + pg) * 8) * 128;
#pragma unroll
    for (int r = 0; r < 4; ++r)
#pragma unroll
        for (int d0 = 0; d0 < 4; ++d0) Sp[(size_t)(r + 4 * hi) * 128 + d0 * 32 + r32] = o[d0][r];
    if (hi == 0 && r32 < 8) WSP(float, WS_SCAR)[(size_t)(bh * 32 + pg) * 8 + r32] = carry;
}
}
__device__ __forceinline__ void sample_combine(Ctx& F) {
    const int gw = F.vcu * NWAVES + F.wave, NGW = F.G * NWAVES; bf16* OAB = WSP(bf16, WS_OAB);
    const float* SPt = WSP(float, WS_SPART); const float* SCr = WSP(float, WS_SCAR);
    for (int task = gw; task < DBAT * HA * DSEQ; task += NGW) { const int bh = task >> 3, i = task & 7, b = bh >> 3, h = bh & 7; const float bias = F.in(I_SBB)[h];
        f32x2 po[32]; float sc[32];
#pragma unroll
        for (int pg = 0; pg < 32; ++pg) { po[pg] = *(const GAS f32x2*)(SPt + ((size_t)(bh * 32 + pg) * 8 + i) * 128 + 2 * F.lane); sc[pg] = SCr[(size_t)(bh * 32 + pg) * 8 + i]; }
        f32x2 q; { const unsigned qw = *(const GAS unsigned*)(WSP(bf16, WS_QB) + (size_t)(NPR + b * DSEQ + i) * 1024 + h * 128 + 2 * F.lane); q.x = __uint_as_float(qw << 16); q.y = __uint_as_float(qw & 0xffff0000u); }
        float carry = 1.f, a0 = 0.f, a1 = 0.f;
        for (int j = i - 1; j >= 0; --j) { const size_t ko = (size_t)(b * DSEQ + j) * 1024 + h * 128 + 2 * F.lane; const f32x2 k = *(const GAS f32x2*)(F.outp() + O_KS + ko), v = *(const GAS f32x2*)(F.outp() + O_VS + ko);
            const float z = wave_sum(q.x * k.x + q.y * k.y) * QK_SCALE + bias, e = __expf(fminf(z, 40.f)), om = 1.f / (1.f + e), w = e * om * carry;
            a0 += w * v.x; a1 += w * v.y; carry *= om; }
#pragma unroll
        for (int pg = 31; pg >= 0; --pg) { a0 += carry * po[pg].x; a1 += carry * po[pg].y; carry *= sc[pg]; }
        *(GAS unsigned*)(OAB + (size_t)(NPR + b * DSEQ + i) * DM + h * 128 + 2 * F.lane) = cvt_pk_bf16(a0, a1);
    }
}
__device__ __forceinline__ void phase_attn_prompt(Ctx& F) {
    for (int it2 = 2 * F.vcu; it2 < 2 * NBATCH * HA * 16; it2 += (it2 & 1) ? 2 * F.G - 1 : 1) { const int item = it2 >> 1, half = it2 & 1, bh = item >> 4, x = item & 15;
        sba::attn_half(F, bh, half ? 15 - x : x, half); }
    __syncthreads();
}
__device__ __forceinline__ void dots16(float& sig, float& rho, float kkv, float wrv, const float (&s)[16]) {
    asm("s_nop 1\n\t"
        "v_fmac_f32_dpp %0, %2, %4 row_newbcast:0 row_mask:0xf bank_mask:0xf\n\t"
        "v_fmac_f32_dpp %1, %3, %4 row_newbcast:0 row_mask:0xf bank_mask:0xf\n\t"
        "v_fmac_f32_dpp %0, %2, %5 row_newbcast:1 row_mask:0xf bank_mask:0xf\n\t"
        "v_fmac_f32_dpp %1, %3, %5 row_newbcast:1 row_mask:0xf bank_mask:0xf\n\t"
        "v_fmac_f32_dpp %0, %2, %6 row_newbcast:2 row_mask:0xf bank_mask:0xf\n\t"
        "v_fmac_f32_dpp %1, %3, %6 row_newbcast:2 row_mask:0xf bank_mask:0xf\n\t"
        "v_fmac_f32_dpp %0, %2, %7 row_newbcast:3 row_mask:0xf bank_mask:0xf\n\t"
        "v_fmac_f32_dpp %1, %3, %7 row_newbcast:3 row_mask:0xf bank_mask:0xf\n\t"
        "v_fmac_f32_dpp %0, %2, %8 row_newbcast:4 row_mask:0xf bank_mask:0xf\n\t"
        "v_fmac_f32_dpp %1, %3, %8 row_newbcast:4 row_mask:0xf bank_mask:0xf\n\t"
        "v_fmac_f32_dpp %0, %2, %9 row_newbcast:5 row_mask:0xf bank_mask:0xf\n\t"
        "v_fmac_f32_dpp %1, %3, %9 row_newbcast:5 row_mask:0xf bank_mask:0xf\n\t"
        "v_fmac_f32_dpp %0, %2, %10 row_newbcast:6 row_mask:0xf bank_mask:0xf\n\t"
        "v_fmac_f32_dpp %1, %3, %10 row_newbcast:6 row_mask:0xf bank_mask:0xf\n\t"
        "v_fmac_f32_dpp %0, %2, %11 row_newbcast:7 row_mask:0xf bank_mask:0xf\n\t"
        "v_fmac_f32_dpp %1, %3, %11 row_newbcast:7 row_mask:0xf bank_mask:0xf\n\t"
        "v_fmac_f32_dpp %0, %2, %12 row_newbcast:8 row_mask:0xf bank_mask:0xf\n\t"
        "v_fmac_f32_dpp %1, %3, %12 row_newbcast:8 row_mask:0xf bank_mask:0xf\n\t"
        "v_fmac_f32_dpp %0, %2, %13 row_newbcast:9 row_mask:0xf bank_mask:0xf\n\t"
        "v_fmac_f32_dpp %1, %3, %13 row_newbcast:9 row_mask:0xf bank_mask:0xf\n\t"
        "v_fmac_f32_dpp %0, %2, %14 row_newbcast:10 row_mask:0xf bank_mask:0xf\n\t"
        "v_fmac_f32_dpp %1, %3, %14 row_newbcast:10 row_mask:0xf bank_mask:0xf\n\t"
        "v_fmac_f32_dpp %0, %2, %15 row_newbcast:11 row_mask:0xf bank_mask:0xf\n\t"
        "v_fmac_f32_dpp %1, %3, %15 row_newbcast:11 row_mask:0xf bank_mask:0xf\n\t"
        "v_fmac_f32_dpp %0, %2, %16 row_newbcast:12 row_mask:0xf bank_mask:0xf\n\t"
        "v_fmac_f32_dpp %1, %3, %16 row_newbcast:12 row_mask:0xf bank_mask:0xf\n\t"
        "v_fmac_f32_dpp %0, %2, %17 row_newbcast:13 row_mask:0xf bank_mask:0xf\n\t"
        "v_fmac_f32_dpp %1, %3, %17 row_newbcast:13 row_mask:0xf bank_mask:0xf\n\t"
        "v_fmac_f32_dpp %0, %2, %18 row_newbcast:14 row_mask:0xf bank_mask:0xf\n\t"
        "v_fmac_f32_dpp %1, %3, %18 row_newbcast:14 row_mask:0xf bank_mask:0xf\n\t"
        "v_fmac_f32_dpp %0, %2, %19 row_newbcast:15 row_mask:0xf bank_mask:0xf\n\t"
        "v_fmac_f32_dpp %1, %3, %19 row_newbcast:15 row_mask:0xf bank_mask:0xf\n\t"
        "s_nop 1"
        : "+v"(sig), "+v"(rho) : "v"(kkv), "v"(wrv), "v"(s[0]), "v"(s[1]), "v"(s[2]), "v"(s[3]), "v"(s[4]), "v"(s[5]), "v"(s[6]), "v"(s[7]), "v"(s[8]), "v"(s[9]), "v"(s[10]), "v"(s[11]), "v"(s[12]), "v"(s[13]), "v"(s[14]), "v"(s[15]));
}
__device__ __forceinline__ void dot16(float& acc, float zv, const float (&s)[16]) {
    asm("s_nop 1\n\t"
        "v_fmac_f32_dpp %0, %1, %2 row_newbcast:0 row_mask:0xf bank_mask:0xf\n\t"
        "v_fmac_f32_dpp %0, %1, %3 row_newbcast:1 row_mask:0xf bank_mask:0xf\n\t"
        "v_fmac_f32_dpp %0, %1, %4 row_newbcast:2 row_mask:0xf bank_mask:0xf\n\t"
        "v_fmac_f32_dpp %0, %1, %5 row_newbcast:3 row_mask:0xf bank_mask:0xf\n\t"
        "v_fmac_f32_dpp %0, %1, %6 row_newbcast:4 row_mask:0xf bank_mask:0xf\n\t"
        "v_fmac_f32_dpp %0, %1, %7 row_newbcast:5 row_mask:0xf bank_mask:0xf\n\t"
        "v_fmac_f32_dpp %0, %1, %8 row_newbcast:6 row_mask:0xf bank_mask:0xf\n\t"
        "v_fmac_f32_dpp %0, %1, %9 row_newbcast:7 row_mask:0xf bank_mask:0xf\n\t"
        "v_fmac_f32_dpp %0, %1, %10 row_newbcast:8 row_mask:0xf bank_mask:0xf\n\t"
        "v_fmac_f32_dpp %0, %1, %11 row_newbcast:9 row_mask:0xf bank_mask:0xf\n\t"
        "v_fmac_f32_dpp %0, %1, %12 row_newbcast:10 row_mask:0xf bank_mask:0xf\n\t"
        "v_fmac_f32_dpp %0, %1, %13 row_newbcast:11 row_mask:0xf bank_mask:0xf\n\t"
        "v_fmac_f32_dpp %0, %1, %14 row_newbcast:12 row_mask:0xf bank_mask:0xf\n\t"
        "v_fmac_f32_dpp %0, %1, %15 row_newbcast:13 row_mask:0xf bank_mask:0xf\n\t"
        "v_fmac_f32_dpp %0, %1, %16 row_newbcast:14 row_mask:0xf bank_mask:0xf\n\t"
        "v_fmac_f32_dpp %0, %1, %17 row_newbcast:15 row_mask:0xf bank_mask:0xf\n\t"
        "s_nop 1"
        : "+v"(acc) : "v"(zv), "v"(s[0]), "v"(s[1]), "v"(s[2]), "v"(s[3]), "v"(s[4]), "v"(s[5]), "v"(s[6]), "v"(s[7]), "v"(s[8]), "v"(s[9]), "v"(s[10]), "v"(s[11]), "v"(s[12]), "v"(s[13]), "v"(s[14]), "v"(s[15]));
}
__device__ __forceinline__ void upd16_v(float (&s)[16], float wv, float kv, float bv, float vv, float ns) {
    asm("s_nop 1\n\t"
        "v_mul_f32_dpp %0, %16, %0 row_newbcast:0 row_mask:0xf bank_mask:0xf\n\t"
        "v_mul_f32_dpp %1, %16, %1 row_newbcast:1 row_mask:0xf bank_mask:0xf\n\t"
        "v_mul_f32_dpp %2, %16, %2 row_newbcast:2 row_mask:0xf bank_mask:0xf\n\t"
        "v_mul_f32_dpp %3, %16, %3 row_newbcast:3 row_mask:0xf bank_mask:0xf\n\t"
        "v_mul_f32_dpp %4, %16, %4 row_newbcast:4 row_mask:0xf bank_mask:0xf\n\t"
        "v_mul_f32_dpp %5, %16, %5 row_newbcast:5 row_mask:0xf bank_mask:0xf\n\t"
        "v_mul_f32_dpp %6, %16, %6 row_newbcast:6 row_mask:0xf bank_mask:0xf\n\t"
        "v_mul_f32_dpp %7, %16, %7 row_newbcast:7 row_mask:0xf bank_mask:0xf\n\t"
        "v_mul_f32_dpp %8, %16, %8 row_newbcast:8 row_mask:0xf bank_mask:0xf\n\t"
        "v_mul_f32_dpp %9, %16, %9 row_newbcast:9 row_mask:0xf bank_mask:0xf\n\t"
        "v_mul_f32_dpp %10, %16, %10 row_newbcast:10 row_mask:0xf bank_mask:0xf\n\t"
        "v_mul_f32_dpp %11, %16, %11 row_newbcast:11 row_mask:0xf bank_mask:0xf\n\t"
        "v_mul_f32_dpp %12, %16, %12 row_newbcast:12 row_mask:0xf bank_mask:0xf\n\t"
        "v_mul_f32_dpp %13, %16, %13 row_newbcast:13 row_mask:0xf bank_mask:0xf\n\t"
        "v_mul_f32_dpp %14, %16, %14 row_newbcast:14 row_mask:0xf bank_mask:0xf\n\t"
        "v_mul_f32_dpp %15, %16, %15 row_newbcast:15 row_mask:0xf bank_mask:0xf\n\t"
        "v_fmac_f32_dpp %0, %17, %19 row_newbcast:0 row_mask:0xf bank_mask:0xf\n\t"
        "v_fmac_f32_dpp %1, %17, %19 row_newbcast:1 row_mask:0xf bank_mask:0xf\n\t"
        "v_fmac_f32_dpp %2, %17, %19 row_newbcast:2 row_mask:0xf bank_mask:0xf\n\t"
        "v_fmac_f32_dpp %3, %17, %19 row_newbcast:3 row_mask:0xf bank_mask:0xf\n\t"
        "v_fmac_f32_dpp %4, %17, %19 row_newbcast:4 row_mask:0xf bank_mask:0xf\n\t"
        "v_fmac_f32_dpp %5, %17, %19 row_newbcast:5 row_mask:0xf bank_mask:0xf\n\t"
        "v_fmac_f32_dpp %6, %17, %19 row_newbcast:6 row_mask:0xf bank_mask:0xf\n\t"
        "v_fmac_f32_dpp %7, %17, %19 row_newbcast:7 row_mask:0xf bank_mask:0xf\n\t"
        "v_fmac_f32_dpp %8, %17, %19 row_newbcast:8 row_mask:0xf bank_mask:0xf\n\t"
        "v_fmac_f32_dpp %9, %17, %19 row_newbcast:9 row_mask:0xf bank_mask:0xf\n\t"
        "v_fmac_f32_dpp %10, %17, %19 row_newbcast:10 row_mask:0xf bank_mask:0xf\n\t"
        "v_fmac_f32_dpp %11, %17, %19 row_newbcast:11 row_mask:0xf bank_mask:0xf\n\t"
        "v_fmac_f32_dpp %12, %17, %19 row_newbcast:12 row_mask:0xf bank_mask:0xf\n\t"
        "v_fmac_f32_dpp %13, %17, %19 row_newbcast:13 row_mask:0xf bank_mask:0xf\n\t"
        "v_fmac_f32_dpp %14, %17, %19 row_newbcast:14 row_mask:0xf bank_mask:0xf\n\t"
        "v_fmac_f32_dpp %15, %17, %19 row_newbcast:15 row_mask:0xf bank_mask:0xf\n\t"
        "v_fmac_f32_dpp %0, %18, %20 row_newbcast:0 row_mask:0xf bank_mask:0xf\n\t"
        "v_fmac_f32_dpp %1, %18, %20 row_newbcast:1 row_mask:0xf bank_mask:0xf\n\t"
        "v_fmac_f32_dpp %2, %18, %20 row_newbcast:2 row_mask:0xf bank_mask:0xf\n\t"
        "v_fmac_f32_dpp %3, %18, %20 row_newbcast:3 row_mask:0xf bank_mask:0xf\n\t"
        "v_fmac_f32_dpp %4, %18, %20 row_newbcast:4 row_mask:0xf bank_mask:0xf\n\t"
        "v_fmac_f32_dpp %5, %18, %20 row_newbcast:5 row_mask:0xf bank_mask:0xf\n\t"
        "v_fmac_f32_dpp %6, %18, %20 row_newbcast:6 row_mask:0xf bank_mask:0xf\n\t"
        "v_fmac_f32_dpp %7, %18, %20 row_newbcast:7 row_mask:0xf bank_mask:0xf\n\t"
        "v_fmac_f32_dpp %8, %18, %20 row_newbcast:8 row_mask:0xf bank_mask:0xf\n\t"
        "v_fmac_f32_dpp %9, %18, %20 row_newbcast:9 row_mask:0xf bank_mask:0xf\n\t"
        "v_fmac_f32_dpp %10, %18, %20 row_newbcast:10 row_mask:0xf bank_mask:0xf\n\t"
        "v_fmac_f32_dpp %11, %18, %20 row_newbcast:11 row_mask:0xf bank_mask:0xf\n\t"
        "v_fmac_f32_dpp %12, %18, %20 row_newbcast:12 row_mask:0xf bank_mask:0xf\n\t"
        "v_fmac_f32_dpp %13, %18, %20 row_newbcast:13 row_mask:0xf bank_mask:0xf\n\t"
        "v_fmac_f32_dpp %14, %18, %20 row_newbcast:14 row_mask:0xf bank_mask:0xf\n\t"
        "v_fmac_f32_dpp %15, %18, %20 row_newbcast:15 row_mask:0xf bank_mask:0xf\n\t"
        "s_nop 1"
        : "+v"(s[0]), "+v"(s[1]), "+v"(s[2]), "+v"(s[3]), "+v"(s[4]), "+v"(s[5]), "+v"(s[6]), "+v"(s[7]), "+v"(s[8]), "+v"(s[9]), "+v"(s[10]), "+v"(s[11]), "+v"(s[12]), "+v"(s[13]), "+v"(s[14]), "+v"(s[15]) : "v"(wv), "v"(kv), "v"(bv), "v"(vv), "v"(ns));
}
__device__ __forceinline__ void upd16_nov(float (&s)[16], float wv, float kv, float bv, float vv, float ns) {
    asm("s_nop 1\n\t"
        "v_mul_f32_dpp %0, %16, %0 row_newbcast:0 row_mask:0xf bank_mask:0xf\n\t"
        "v_mul_f32_dpp %1, %16, %1 row_newbcast:1 row_mask:0xf bank_mask:0xf\n\t"
        "v_mul_f32_dpp %2, %16, %2 row_newbcast:2 row_mask:0xf bank_mask:0xf\n\t"
        "v_mul_f32_dpp %3, %16, %3 row_newbcast:3 row_mask:0xf bank_mask:0xf\n\t"
        "v_mul_f32_dpp %4, %16, %4 row_newbcast:4 row_mask:0xf bank_mask:0xf\n\t"
        "v_mul_f32_dpp %5, %16, %5 row_newbcast:5 row_mask:0xf bank_mask:0xf\n\t"
        "v_mul_f32_dpp %6, %16, %6 row_newbcast:6 row_mask:0xf bank_mask:0xf\n\t"
        "v_mul_f32_dpp %7, %16, %7 row_newbcast:7 row_mask:0xf bank_mask:0xf\n\t"
        "v_mul_f32_dpp %8, %16, %8 row_newbcast:8 row_mask:0xf bank_mask:0xf\n\t"
        "v_mul_f32_dpp %9, %16, %9 row_newbcast:9 row_mask:0xf bank_mask:0xf\n\t"
        "v_mul_f32_dpp %10, %16, %10 row_newbcast:10 row_mask:0xf bank_mask:0xf\n\t"
        "v_mul_f32_dpp %11, %16, %11 row_newbcast:11 row_mask:0xf bank_mask:0xf\n\t"
        "v_mul_f32_dpp %12, %16, %12 row_newbcast:12 row_mask:0xf bank_mask:0xf\n\t"
        "v_mul_f32_dpp %13, %16, %13 row_newbcast:13 row_mask:0xf bank_mask:0xf\n\t"
        "v_mul_f32_dpp %14, %16, %14 row_newbcast:14 row_mask:0xf bank_mask:0xf\n\t"
        "v_mul_f32_dpp %15, %16, %15 row_newbcast:15 row_mask:0xf bank_mask:0xf\n\t"
        "v_fmac_f32_dpp %0, %18, %20 row_newbcast:0 row_mask:0xf bank_mask:0xf\n\t"
        "v_fmac_f32_dpp %1, %18, %20 row_newbcast:1 row_mask:0xf bank_mask:0xf\n\t"
        "v_fmac_f32_dpp %2, %18, %20 row_newbcast:2 row_mask:0xf bank_mask:0xf\n\t"
        "v_fmac_f32_dpp %3, %18, %20 row_newbcast:3 row_mask:0xf bank_mask:0xf\n\t"
        "v_fmac_f32_dpp %4, %18, %20 row_newbcast:4 row_mask:0xf bank_mask:0xf\n\t"
        "v_fmac_f32_dpp %5, %18, %20 row_newbcast:5 row_mask:0xf bank_mask:0xf\n\t"
        "v_fmac_f32_dpp %6, %18, %20 row_newbcast:6 row_mask:0xf bank_mask:0xf\n\t"
        "v_fmac_f32_dpp %7, %18, %20 row_newbcast:7 row_mask:0xf bank_mask:0xf\n\t"
        "v_fmac_f32_dpp %8, %18, %20 row_newbcast:8 row_mask:0xf bank_mask:0xf\n\t"
        "v_fmac_f32_dpp %9, %18, %20 row_newbcast:9 row_mask:0xf bank_mask:0xf\n\t"
        "v_fmac_f32_dpp %10, %18, %20 row_newbcast:10 row_mask:0xf bank_mask:0xf\n\t"
        "v_fmac_f32_dpp %11, %18, %20 row_newbcast:11 row_mask:0xf bank_mask:0xf\n\t"
        "v_fmac_f32_dpp %12, %18, %20 row_newbcast:12 row_mask:0xf bank_mask:0xf\n\t"
        "v_fmac_f32_dpp %13, %18, %20 row_newbcast:13 row_mask:0xf bank_mask:0xf\n\t"
        "v_fmac_f32_dpp %14, %18, %20 row_newbcast:14 row_mask:0xf bank_mask:0xf\n\t"
        "v_fmac_f32_dpp %15, %18, %20 row_newbcast:15 row_mask:0xf bank_mask:0xf\n\t"
        "s_nop 1"
        : "+v"(s[0]), "+v"(s[1]), "+v"(s[2]), "+v"(s[3]), "+v"(s[4]), "+v"(s[5]), "+v"(s[6]), "+v"(s[7]), "+v"(s[8]), "+v"(s[9]), "+v"(s[10]), "+v"(s[11]), "+v"(s[12]), "+v"(s[13]), "+v"(s[14]), "+v"(s[15]) : "v"(wv), "v"(kv), "v"(bv), "v"(vv), "v"(ns));
}
__device__ __forceinline__ float xrow16_sum(float x) {
    auto s = __builtin_amdgcn_permlane16_swap(__float_as_uint(x), __float_as_uint(x), false, false);
    x = __uint_as_float(s[0]) + __uint_as_float(s[1]);
    auto t = __builtin_amdgcn_permlane32_swap(__float_as_uint(x), __float_as_uint(x), false, false);
    return __uint_as_float(t[0]) + __uint_as_float(t[1]);
}
struct StepIn { float wv, kkv, bv, kv, wrv, vv, beta, kappa; };
template <bool PROW> __device__ __forceinline__ void scan_load(StepIn& x, const float* RWV, const float* SCL, int r, int h, int lane, int row) {
    const float* base = RWV + ((size_t)r * HB + h) * 512; const float* sc = SCL + ((size_t)r * HB + h) * 4;
    x.wv = base[lane]; x.kkv = base[64 + lane]; x.bv = base[128 + lane]; x.wrv = base[384 + lane]; x.beta = sc[0];
    if (!PROW) { x.kv = base[192 + lane]; x.vv = base[320 + row]; x.kappa = sc[1]; } else { x.kv = 0.f; x.vv = 0.f; x.kappa = 0.f; }
}
template <bool PROW, bool SAMP> __device__ __forceinline__ void scan_wave(Ctx& F, int bh, int c, int g) {
    const int lane = F.lane, q = lane >> 4, m = lane & 15, row = 16 * g + m, h = bh & 15, b = bh >> 4;
    constexpr int L = SAMP ? DSEQ : 64; const int r0 = SAMP ? NPR + b * DSEQ : b * SEQ + c * 64; const int ch = bh * 64 + c;
    const float* RWV = WSP(float, WS_RWV); const float* SCL = WSP(float, WS_SCL); float* Y = WSP(float, WS_Y); float* Z = WSP(float, WS_Z); float* PU = WSP(float, WS_PU);
    float s[16];
    if (SAMP) { const float* st = F.in(I_SWKV) + ((size_t)bh * 64 + row) * 64 + 16 * q;
#pragma unroll
        for (int i = 0; i < 16; i += 4) { const f32x4 v = *(const GAS f32x4*)(st + i); s[i] = v.x; s[i + 1] = v.y; s[i + 2] = v.z; s[i + 3] = v.w; } }
    else {
#pragma unroll
        for (int i = 0; i < 16; ++i) s[i] = (PROW && (16 * q + i) == row) ? 1.f : 0.f; }
    StepIn buf[4];
#pragma unroll
    for (int u = 0; u < 4; ++u) scan_load<PROW>(buf[u], RWV, SCL, r0 + u, h, lane, row);
    for (int t = 0; t < L; t += 4) {
#pragma unroll
        for (int u = 0; u < 4; ++u) {
            const StepIn x = buf[u];
            if (t + u + 4 < L) scan_load<PROW>(buf[u], RWV, SCL, r0 + t + u + 4, h, lane, row);
            float sig = 0.f, rho = 0.f;
            dots16(sig, rho, x.kkv, x.wrv, s);
            sig = xrow16_sum(sig); rho = xrow16_sum(rho);
            const float ns = -sig;
            float y = rho + ns * x.beta; if (!PROW) y += x.vv * x.kappa;
            if (q == 0) { if (PROW) Z[((size_t)ch * 64 + t + u) * 64 + row] = y; else Y[(size_t)(r0 + t + u) * 1024 + h * 64 + row] = y; }
            if (PROW) upd16_nov(s, x.wv, x.kv, x.bv, x.vv, ns); else upd16_v(s, x.wv, x.kv, x.bv, x.vv, ns);
        }
    }
    float* dst = SAMP ? F.outp() + O_WKVS + ((size_t)bh * 64 + row) * 64 + 16 * q : PU + (((size_t)ch * 2 + (PROW ? 1 : 0)) * 64 + row) * 64 + 16 * q;
#pragma unroll
    for (int i = 0; i < 16; i += 4) *(GAS f32x4*)(dst + i) = (f32x4){s[i], s[i + 1], s[i + 2], s[i + 3]};
}
__device__ __forceinline__ void dots2_h0(float& sgu, float& rhu, float& sgp, float& rhp, float kkv, float wrv, const float (&su)[16], const float (&sp)[16]) {
    asm("s_nop 1\n\t"
        "v_fmac_f32_dpp %0, %4, %6 row_newbcast:0 row_mask:0xf bank_mask:0xf\n\t"
        "v_fmac_f32_dpp %1, %5, %6 row_newbcast:0 row_mask:0xf bank_mask:0xf\n\t"
        "v_fmac_f32_dpp %2, %4, %14 row_newbcast:0 row_mask:0xf bank_mask:0xf\n\t"
        "v_fmac_f32_dpp %3, %5, %14 row_newbcast:0 row_mask:0xf bank_mask:0xf\n\t"
        "v_fmac_f32_dpp %0, %4, %7 row_newbcast:1 row_mask:0xf bank_mask:0xf\n\t"
        "v_fmac_f32_dpp %1, %5, %7 row_newbcast:1 row_mask:0xf bank_mask:0xf\n\t"
        "v_fmac_f32_dpp %2, %4, %15 row_newbcast:1 row_mask:0xf bank_mask:0xf\n\t"
        "v_fmac_f32_dpp %3, %5, %15 row_newbcast:1 row_mask:0xf bank_mask:0xf\n\t"
        "v_fmac_f32_dpp %0, %4, %8 row_newbcast:2 row_mask:0xf bank_mask:0xf\n\t"
        "v_fmac_f32_dpp %1, %5, %8 row_newbcast:2 row_mask:0xf bank_mask:0xf\n\t"
        "v_fmac_f32_dpp %2, %4, %16 row_newbcast:2 row_mask:0xf bank_mask:0xf\n\t"
        "v_fmac_f32_dpp %3, %5, %16 row_newbcast:2 row_mask:0xf bank_mask:0xf\n\t"
        "v_fmac_f32_dpp %0, %4, %9 row_newbcast:3 row_mask:0xf bank_mask:0xf\n\t"
        "v_fmac_f32_dpp %1, %5, %9 row_newbcast:3 row_mask:0xf bank_mask:0xf\n\t"
        "v_fmac_f32_dpp %2, %4, %17 row_newbcast:3 row_mask:0xf bank_mask:0xf\n\t"
        "v_fmac_f32_dpp %3, %5, %17 row_newbcast:3 row_mask:0xf bank_mask:0xf\n\t"
        "v_fmac_f32_dpp %0, %4, %10 row_newbcast:4 row_mask:0xf bank_mask:0xf\n\t"
        "v_fmac_f32_dpp %1, %5, %10 row_newbcast:4 row_mask:0xf bank_mask:0xf\n\t"
        "v_fmac_f32_dpp %2, %4, %18 row_newbcast:4 row_mask:0xf bank_mask:0xf\n\t"
        "v_fmac_f32_dpp %3, %5, %18 row_newbcast:4 row_mask:0xf bank_mask:0xf\n\t"
        "v_fmac_f32_dpp %0, %4, %11 row_newbcast:5 row_mask:0xf bank_mask:0xf\n\t"
        "v_fmac_f32_dpp %1, %5, %11 row_newbcast:5 row_mask:0xf bank_mask:0xf\n\t"
        "v_fmac_f32_dpp %2, %4, %19 row_newbcast:5 row_mask:0xf bank_mask:0xf\n\t"
        "v_fmac_f32_dpp %3, %5, %19 row_newbcast:5 row_mask:0xf bank_mask:0xf\n\t"
        "v_fmac_f32_dpp %0, %4, %12 row_newbcast:6 row_mask:0xf bank_mask:0xf\n\t"
        "v_fmac_f32_dpp %1, %5, %12 row_newbcast:6 row_mask:0xf bank_mask:0xf\n\t"
        "v_fmac_f32_dpp %2, %4, %20 row_newbcast:6 row_mask:0xf bank_mask:0xf\n\t"
        "v_fmac_f32_dpp %3, %5, %20 row_newbcast:6 row_mask:0xf bank_mask:0xf\n\t"
        "v_fmac_f32_dpp %0, %4, %13 row_newbcast:7 row_mask:0xf bank_mask:0xf\n\t"
        "v_fmac_f32_dpp %1, %5, %13 row_newbcast:7 row_mask:0xf bank_mask:0xf\n\t"
        "v_fmac_f32_dpp %2, %4, %21 row_newbcast:7 row_mask:0xf bank_mask:0xf\n\t"
        "v_fmac_f32_dpp %3, %5, %21 row_newbcast:7 row_mask:0xf bank_mask:0xf\n\t"
        "s_nop 1"
        : "+v"(sgu), "+v"(rhu), "+v"(sgp), "+v"(rhp) : "v"(kkv), "v"(wrv), "v"(su[0]), "v"(su[1]), "v"(su[2]), "v"(su[3]), "v"(su[4]), "v"(su[5]), "v"(su[6]), "v"(su[7]), "v"(sp[0]), "v"(sp[1]), "v"(sp[2]), "v"(sp[3]), "v"(sp[4]), "v"(sp[5]), "v"(sp[6]), "v"(sp[7]));
}
__device__ __forceinline__ void dots2_h1(float& sgu, float& rhu, float& sgp, float& rhp, float kkv, float wrv, const float (&su)[16], const float (&sp)[16]) {
    asm("s_nop 1\n\t"
        "v_fmac_f32_dpp %0, %4, %6 row_newbcast:8 row_mask:0xf bank_mask:0xf\n\t"
        "v_fmac_f32_dpp %1, %5, %6 row_newbcast:8 row_mask:0xf bank_mask:0xf\n\t"
        "v_fmac_f32_dpp %2, %4, %14 row_newbcast:8 row_mask:0xf bank_mask:0xf\n\t"
        "v_fmac_f32_dpp %3, %5, %14 row_newbcast:8 row_mask:0xf bank_mask:0xf\n\t"
        "v_fmac_f32_dpp %0, %4, %7 row_newbcast:9 row_mask:0xf bank_mask:0xf\n\t"
        "v_fmac_f32_dpp %1, %5, %7 row_newbcast:9 row_mask:0xf bank_mask:0xf\n\t"
        "v_fmac_f32_dpp %2, %4, %15 row_newbcast:9 row_mask:0xf bank_mask:0xf\n\t"
        "v_fmac_f32_dpp %3, %5, %15 row_newbcast:9 row_mask:0xf bank_mask:0xf\n\t"
        "v_fmac_f32_dpp %0, %4, %8 row_newbcast:10 row_mask:0xf bank_mask:0xf\n\t"
        "v_fmac_f32_dpp %1, %5, %8 row_newbcast:10 row_mask:0xf bank_mask:0xf\n\t"
        "v_fmac_f32_dpp %2, %4, %16 row_newbcast:10 row_mask:0xf bank_mask:0xf\n\t"
        "v_fmac_f32_dpp %3, %5, %16 row_newbcast:10 row_mask:0xf bank_mask:0xf\n\t"
        "v_fmac_f32_dpp %0, %4, %9 row_newbcast:11 row_mask:0xf bank_mask:0xf\n\t"
        "v_fmac_f32_dpp %1, %5, %9 row_newbcast:11 row_mask:0xf bank_mask:0xf\n\t"
        "v_fmac_f32_dpp %2, %4, %17 row_newbcast:11 row_mask:0xf bank_mask:0xf\n\t"
        "v_fmac_f32_dpp %3, %5, %17 row_newbcast:11 row_mask:0xf bank_mask:0xf\n\t"
        "v_fmac_f32_dpp %0, %4, %10 row_newbcast:12 row_mask:0xf bank_mask:0xf\n\t"
        "v_fmac_f32_dpp %1, %5, %10 row_newbcast:12 row_mask:0xf bank_mask:0xf\n\t"
        "v_fmac_f32_dpp %2, %4, %18 row_newbcast:12 row_mask:0xf bank_mask:0xf\n\t"
        "v_fmac_f32_dpp %3, %5, %18 row_newbcast:12 row_mask:0xf bank_mask:0xf\n\t"
        "v_fmac_f32_dpp %0, %4, %11 row_newbcast:13 row_mask:0xf bank_mask:0xf\n\t"
        "v_fmac_f32_dpp %1, %5, %11 row_newbcast:13 row_mask:0xf bank_mask:0xf\n\t"
        "v_fmac_f32_dpp %2, %4, %19 row_newbcast:13 row_mask:0xf bank_mask:0xf\n\t"
        "v_fmac_f32_dpp %3, %5, %19 row_newbcast:13 row_mask:0xf bank_mask:0xf\n\t"
        "v_fmac_f32_dpp %0, %4, %12 row_newbcast:14 row_mask:0xf bank_mask:0xf\n\t"
        "v_fmac_f32_dpp %1, %5, %12 row_newbcast:14 row_mask:0xf bank_mask:0xf\n\t"
        "v_fmac_f32_dpp %2, %4, %20 row_newbcast:14 row_mask:0xf bank_mask:0xf\n\t"
        "v_fmac_f32_dpp %3, %5, %20 row_newbcast:14 row_mask:0xf bank_mask:0xf\n\t"
        "v_fmac_f32_dpp %0, %4, %13 row_newbcast:15 row_mask:0xf bank_mask:0xf\n\t"
        "v_fmac_f32_dpp %1, %5, %13 row_newbcast:15 row_mask:0xf bank_mask:0xf\n\t"
        "v_fmac_f32_dpp %2, %4, %21 row_newbcast:15 row_mask:0xf bank_mask:0xf\n\t"
        "v_fmac_f32_dpp %3, %5, %21 row_newbcast:15 row_mask:0xf bank_mask:0xf\n\t"
        "s_nop 1"
        : "+v"(sgu), "+v"(rhu), "+v"(sgp), "+v"(rhp) : "v"(kkv), "v"(wrv), "v"(su[8]), "v"(su[9]), "v"(su[10]), "v"(su[11]), "v"(su[12]), "v"(su[13]), "v"(su[14]), "v"(su[15]), "v"(sp[8]), "v"(sp[9]), "v"(sp[10]), "v"(sp[11]), "v"(sp[12]), "v"(sp[13]), "v"(sp[14]), "v"(sp[15]));
}
__device__ __forceinline__ void scan_wave_up(Ctx& F, int bh, int c, int g) {
    const int lane = F.lane, q = lane >> 4, m = lane & 15, row = 16 * g + m, h = bh & 15, b = bh >> 4;
    const int r0 = b * SEQ + c * 64, ch = bh * 64 + c;
    const float* RWV = WSP(float, WS_RWV); const float* SCL = WSP(float, WS_SCL); float* Y = WSP(float, WS_Y); float* Z = WSP(float, WS_Z); float* PU = WSP(float, WS_PU);
    float su[16], sp[16];
#pragma unroll
    for (int i = 0; i < 16; ++i) { su[i] = 0.f; sp[i] = ((16 * q + i) == row) ? 1.f : 0.f; }
    StepIn buf[4];
#pragma unroll
    for (int u = 0; u < 4; ++u) scan_load<false>(buf[u], RWV, SCL, r0 + u, h, lane, row);
    for (int t = 0; t < 64; t += 4) {
#pragma unroll
        for (int u = 0; u < 4; ++u) {
            const StepIn x = buf[u];
            if (t + u + 4 < 64) scan_load<false>(buf[u], RWV, SCL, r0 + t + u + 4, h, lane, row);
            float sgu = 0.f, rhu = 0.f, sgp = 0.f, rhp = 0.f;
            dots2_h0(sgu, rhu, sgp, rhp, x.kkv, x.wrv, su, sp); dots2_h1(sgu, rhu, sgp, rhp, x.kkv, x.wrv, su, sp);
            sgu = xrow16_sum(sgu); rhu = xrow16_sum(rhu); sgp = xrow16_sum(sgp); rhp = xrow16_sum(rhp);
            const float nsu = -sgu, nsp = -sgp;
            const float y = rhu + nsu * x.beta + x.vv * x.kappa, z = rhp + nsp * x.beta;
            if (q == 0) { Y[(size_t)(r0 + t + u) * 1024 + h * 64 + row] = y; Z[((size_t)ch * 64 + t + u) * 64 + row] = z; }
            upd16_v(su, x.wv, x.kv, x.bv, x.vv, nsu); upd16_nov(sp, x.wv, x.kv, x.bv, x.vv, nsp);
        }
    }
    float* du = PU + (((size_t)ch * 2 + 0) * 64 + row) * 64 + 16 * q; float* dp = PU + (((size_t)ch * 2 + 1) * 64 + row) * 64 + 16 * q;
#pragma unroll
    for (int i = 0; i < 16; i += 4) { *(GAS f32x4*)(du + i) = (f32x4){su[i], su[i + 1], su[i + 2], su[i + 3]}; *(GAS f32x4*)(dp + i) = (f32x4){sp[i], sp[i + 1], sp[i + 2], sp[i + 3]}; }
}
__device__ __forceinline__ void phase_scan1_stream(Ctx& F) {
    LAS int* ctr = (LAS int*)(F.lds + LDSCTL_OFF);
    __syncthreads(); if (F.tid == 0) *ctr = 0; __syncthreads();
    if (F.wave >= 6) { for (int u = F.vcu * 2 + (F.wave - 6); u < DBAT * HA * 32; u += 2 * F.G) sba::attn_sample_unit(F, u >> 5, u & 31, (char*)F.lds + F.wave * 16384); }
    constexpr int NSU = DBAT * HB / 2, NU = NSU + NBATCH * HB * 64;
    const int nunits = F.vcu < NU ? (NU - 1 - F.vcu) / F.G + 1 : 0, ntasks = nunits * 8;
    for (;;) {
        int t = 0; if (F.lane == 0) t = __hip_atomic_fetch_add(ctr, 1, __ATOMIC_RELAXED, __HIP_MEMORY_SCOPE_WORKGROUP);
        t = __builtin_amdgcn_readfirstlane(t); if (t >= ntasks) break;
        const int u = F.vcu + (t >> 3) * F.G, g8 = t & 7;
        if (u < NSU) scan_wave<false, true>(F, u * 2 + (g8 >> 2), 0, g8 & 3);
        else if (g8 < 4) { const int ch = u - NSU; scan_wave_up(F, ch >> 6, ch & 63, g8); }
    }
}
namespace msc {
using sba::bf16x8; using sba::f32x16; using sba::crow; using sba::swap_other;
constexpr int S_AQ = 136, S_BKT = 104, S_L = 40;
constexpr int O_AQ = 0, O_BK = 32 * S_AQ, O_L24 = O_BK, O_TL3 = O_BK + 32 * S_L, O_BKT = 2 * 32 * S_AQ, BLK_BYTES = O_BKT + 64 * S_BKT, O_GL = 4 * BLK_BYTES, O_GP = O_GL + 256, GRP_BYTES = O_GP + 4 * 256;
static_assert(BLK_BYTES % 8 == 0 && 2 * GRP_BYTES <= RING_BYTES, "scan LDS map");
typedef __bf16 nbf2 __attribute__((ext_vector_type(2)));
__device__ __forceinline__ unsigned cvt2(float lo, float hi) { return __builtin_bit_cast(unsigned, __builtin_convertvector((f32x2){lo, hi}, nbf2)); }
__device__ __forceinline__ bf16x8 pack8(float a0, float a1, float a2, float a3, float a4, float a5, float a6, float a7) {
    u32x4 w = {cvt2(a0, a1), cvt2(a2, a3), cvt2(a4, a5), cvt2(a6, a7)}; return *reinterpret_cast<bf16x8*>(&w); }
__device__ __forceinline__ bf16x8 pack_lo(const f32x16& c) { return pack8(c[0], c[1], c[2], c[3], c[4], c[5], c[6], c[7]); }
__device__ __forceinline__ bf16x8 pack_hi(const f32x16& c) { return pack8(c[8], c[9], c[10], c[11], c[12], c[13], c[14], c[15]); }
__device__ __forceinline__ bf16x8 perm_read(const LAS char* img, int row, int pitch, int col0, int g) {
    const LAS char* p = img + row * pitch + (col0 + 4 * g) * 2; const u32x2 lo = *(const LAS u32x2*)p, hi = *(const LAS u32x2*)(p + 16);
    u32x4 w = {lo.x, lo.y, hi.x, hi.y}; return *reinterpret_cast<bf16x8*>(&w); }
__device__ __forceinline__ bf16x8 nat_read(const LAS char* img, int row, int pitch, int col0) {
    const LAS char* p = img + row * pitch + col0 * 2; const u32x2 lo = *(const LAS u32x2*)p, hi = *(const LAS u32x2*)(p + 8);
    u32x4 w = {lo.x, lo.y, hi.x, hi.y}; return *reinterpret_cast<bf16x8*>(&w); }
__device__ __forceinline__ unsigned short bf1(float x) { return (unsigned short)(cvt_pk_bf16(x, 0.f) & 0xffffu); }
struct PrepRegs { float pr[17], pk[17], pv[17], lwl[16]; const bf16* lw; };
__device__ __forceinline__ void prep_load(Ctx& F, PrepRegs& L, int rb, int h) {
    const bf16* pb = WSP(bf16, WS_PBH) + (size_t)rb * 3072 + h * 64 + F.lane; const bf16* lw = WSP(bf16, WS_LWH) + (size_t)rb * 3072 + h * 64 + F.lane;
    L.lw = lw;
#pragma unroll
    for (int t = 0; t < 16; ++t) L.lwl[t] = ldbf_nt(lw + (size_t)t * 3072);
    if ((rb & (SEQ - 1)) != 0) { L.pr[0] = ldbf_nt(pb - 3072); L.pk[0] = ldbf_nt(pb + 1024 - 3072); L.pv[0] = ldbf_nt(pb + 2048 - 3072); } else { L.pr[0] = 0.f; L.pk[0] = 0.f; L.pv[0] = 0.f; }
#pragma unroll
    for (int t = 0; t < 16; ++t) { L.pr[t + 1] = ldbf_nt(pb + (size_t)t * 3072); L.pk[t + 1] = ldbf_nt(pb + (size_t)t * 3072 + 1024); L.pv[t + 1] = ldbf_nt(pb + (size_t)t * 3072 + 2048); }
}
__device__ __forceinline__ void prep_block(Ctx& F, PrepRegs& L, int rb, int h, int j, LAS char* gbase) {
    const int lane = F.lane, n = lane & 31, hi = lane >> 5, col = h * 64 + lane; LAS char* blk = gbase + j * BLK_BYTES;
    float lal[16];
#pragma unroll
    for (int t = 0; t < 16; ++t) lal[t] = ldbf_nt(L.lw + (size_t)t * 3072 + 1024);
    const float* mu = F.in(I_MU); const float mu_r = mu[col], mu_k = mu[1024 + col], mu_v = mu[2048 + col];
    const float w0 = F.in(I_W0)[col], a0 = F.in(I_A0)[col], kkw = F.in(I_KK)[col], kaw = F.in(I_KA)[col], rkw = F.in(I_RK)[col];
    float cw[16];
#pragma unroll
    for (int t = 0; t < 16; ++t) { const float wl = w0 + L.lwl[t], wlog = -softplusf_(-wl) - 0.5f; cw[t] = __expf(-__expf(wlog)); }
#pragma unroll
    for (int t = 1; t < 16; ++t) cw[t] *= cw[t - 1];
    *(LAS float*)(gbase + O_GP + (j * 64 + lane) * 4) = cw[15];
    __syncthreads();
    const float g0 = *(const LAS float*)(gbase + O_GP + lane * 4), g1 = *(const LAS float*)(gbase + O_GP + (64 + lane) * 4), g2 = *(const LAS float*)(gbase + O_GP + (128 + lane) * 4);
    const float G0 = (j > 0 ? g0 : 1.f) * (j > 1 ? g1 : 1.f) * (j > 2 ? g2 : 1.f);
    if (j == 3) *(LAS float*)(gbase + O_GL + lane * 4) = G0 * cw[15];
    float* SCL = WSP(float, WS_SCL) + ((size_t)rb * HB + h) * 4;
#pragma unroll
    for (int tl = 0; tl < 16; tl += 2) {
        float nb[2], kt[2], vz[2];
#pragma unroll
        for (int u = 0; u < 2; ++u) { const int t = tl + u;
            const float zr = L.pr[t + 1] + mu_r * (L.pr[t] - L.pr[t + 1]), zk = L.pk[t + 1] + mu_k * (L.pk[t] - L.pk[t + 1]); vz[u] = L.pv[t + 1] + mu_v * (L.pv[t] - L.pv[t + 1]);
            const float a_ = sigmoidf_(a0 + lal[t]);
            const float kkr = zk * kkw, kk = kkr * rsqrtf(wave_sum(kkr * kkr) + 1e-12f);
            const float k = zk * (1.f + (a_ - 1.f) * kaw), bb = kk * a_;
            const float bonus = wave_sum(zr * k * rkw);
            if (lane == 0) SCL[(size_t)t * HB * 4 + 2] = bonus;
            const float Gp = t ? G0 * cw[t ? t - 1 : 0] : G0, G = G0 * cw[t], gi = 1.f / G;
            const float a = kk * Gp, q = zr * G, bt = bb * gi; kt[u] = k * gi; nb[u] = -bt;
            *(LAS unsigned short*)(blk + O_AQ + t * S_AQ + lane * 2) = bf1(a); *(LAS unsigned short*)(blk + O_AQ + (16 + t) * S_AQ + lane * 2) = bf1(q);
            *(LAS unsigned short*)(blk + O_BK + t * S_AQ + lane * 2) = bf1(bt); *(LAS unsigned short*)(blk + O_BK + (16 + t) * S_AQ + lane * 2) = bf1(kt[u]); }
        *(LAS unsigned*)(blk + O_BKT + lane * S_BKT + tl * 2) = cvt_pk_bf16(nb[0], nb[1]); *(LAS unsigned*)(blk + O_BKT + lane * S_BKT + (16 + tl) * 2) = cvt_pk_bf16(kt[0], kt[1]);
        *(LAS unsigned*)(blk + O_BKT + lane * S_BKT + (32 + tl) * 2) = cvt_pk_bf16(vz[0], vz[1]);
    }
    LDS_WAIT(); asm volatile("" ::: "memory");
    f32x16 mt = f32x16{};
#pragma unroll
    for (int ks = 0; ks < 4; ++ks) mt = __builtin_amdgcn_mfma_f32_32x32x16_bf16(nat_read(blk + O_AQ, n, S_AQ, 16 * ks + 8 * hi), nat_read(blk + O_BK, n, S_AQ, 16 * ks + 8 * hi), mt, 0, 0, 0);
    float l1[8];
    const int i = n & 15;
#pragma unroll
    for (int r = 0; r < 16; ++r) { const int t = crow(r, hi) & 15; float val = mt[r];
        if (r < 8) { val = t > i ? val : 0.f; if (n >= 16) *(LAS unsigned short*)(blk + O_L24 + t * S_L + i * 2) = bf1(val); l1[r] = val; }
        else { val = t >= i ? val : 0.f; if (n >= 16) *(LAS unsigned short*)(blk + O_L24 + (16 + t) * S_L + i * 2) = bf1(val); else *(LAS unsigned short*)(blk + O_TL3 + (16 + t) * S_L + i * 2) = bf1(-val); } }
    float rowv[16];
#pragma unroll
    for (int r = 0; r < 8; ++r) { const float own = l1[r], oth = swap_other(own, hi); const int p0 = (r & 3) + 8 * (r >> 2); rowv[p0] = hi ? oth : own; rowv[p0 + 4] = hi ? own : oth; }
    float tl_[16];
    tl_[0] = lane == 0 ? 1.f : 0.f;
#pragma unroll
    for (int t = 1; t < 16; ++t) { float acc = lane == t ? 1.f : 0.f;
#pragma unroll
        for (int jj = 0; jj < t; ++jj) acc -= readlane_f(rowv[t], jj) * tl_[jj];
        tl_[t] = acc; }
    if (lane < 16) {
#pragma unroll
        for (int t = 0; t < 16; ++t) *(LAS unsigned short*)(blk + O_TL3 + t * S_L + lane * 2) = bf1(tl_[t]); }
    LDS_WAIT(); asm volatile("" ::: "memory");
}
__device__ __forceinline__ void chain(Ctx& F, int bh, int c, int isP, int half, const LAS char* gbase) {
    const int lane = F.lane, n = lane & 31, hi = lane >> 5, rowg = 32 * half + n, h = bh & 15, b = bh >> 4, r0 = b * SEQ + c * 64, ch = bh * 64 + c;
    const float* RWV = WSP(float, WS_RWV);
    f32x16 st0 = f32x16{}, st1 = f32x16{};
    if (isP) {
#pragma unroll
        for (int r = 0; r < 16; ++r) { st0[r] = crow(r, hi) == rowg ? 1.f : 0.f; st1[r] = 32 + crow(r, hi) == rowg ? 1.f : 0.f; } }
    for (int blk_i = 0; blk_i < 4; ++blk_i) {
        const LAS char* blk = gbase + blk_i * BLK_BYTES;
        f32x16 wt = f32x16{};
        wt = __builtin_amdgcn_mfma_f32_32x32x16_bf16(perm_read(blk + O_AQ, n, S_AQ, 0, hi), pack_lo(st0), wt, 0, 0, 0);
        wt = __builtin_amdgcn_mfma_f32_32x32x16_bf16(perm_read(blk + O_AQ, n, S_AQ, 16, hi), pack_hi(st0), wt, 0, 0, 0);
        wt = __builtin_amdgcn_mfma_f32_32x32x16_bf16(perm_read(blk + O_AQ, n, S_AQ, 32, hi), pack_lo(st1), wt, 0, 0, 0);
        wt = __builtin_amdgcn_mfma_f32_32x32x16_bf16(perm_read(blk + O_AQ, n, S_AQ, 48, hi), pack_hi(st1), wt, 0, 0, 0);
        bf16x8 bV = bf16x8{};
        if (!isP) { bV = perm_read(blk + O_BKT, rowg, S_BKT, 32, hi);
            wt = __builtin_amdgcn_mfma_f32_32x32x16_bf16(perm_read(blk + O_L24, n, S_L, 0, hi), bV, wt, 0, 0, 0); }
        const bf16x8 tl3 = perm_read(blk + O_TL3, n, S_L, 0, hi);
        const bf16x8 a_tl = n < 16 ? tl3 : bf16x8{}, a_l3 = n >= 16 ? tl3 : bf16x8{};
        const f32x16 sg = __builtin_amdgcn_mfma_f32_32x32x16_bf16(a_tl, pack_lo(wt), f32x16{}, 0, 0, 0);
        const bf16x8 bSg = pack_lo(sg);
        const f32x16 yy = __builtin_amdgcn_mfma_f32_32x32x16_bf16(a_l3, bSg, wt, 0, 0, 0);
#pragma unroll
        for (int r = 8; r < 16; ++r) { const int t = blk_i * 16 + (r & 3) + 8 * ((r - 8) >> 2) + 4 * hi;
            if (isP) WSP(float, WS_Z)[((size_t)ch * 64 + t) * 64 + rowg] = yy[r]; else WSP(float, WS_Y)[(size_t)(r0 + t) * 1024 + h * 64 + rowg] = yy[r]; }
        st0 = __builtin_amdgcn_mfma_f32_32x32x16_bf16(perm_read(blk + O_BKT, n, S_BKT, 0, hi), bSg, st0, 0, 0, 0);
        st1 = __builtin_amdgcn_mfma_f32_32x32x16_bf16(perm_read(blk + O_BKT, 32 + n, S_BKT, 0, hi), bSg, st1, 0, 0, 0);
        if (!isP) { st0 = __builtin_amdgcn_mfma_f32_32x32x16_bf16(perm_read(blk + O_BKT, n, S_BKT, 16, hi), bV, st0, 0, 0, 0);
                    st1 = __builtin_amdgcn_mfma_f32_32x32x16_bf16(perm_read(blk + O_BKT, 32 + n, S_BKT, 16, hi), bV, st1, 0, 0, 0); }
    }
    const LAS float* GL = (const LAS float*)(gbase + O_GL); float* dst = WSP(float, WS_PU) + (((size_t)ch * 2 + isP) * 64 + rowg) * 64;
#pragma unroll
    for (int g4 = 0; g4 < 4; ++g4) { const int k0 = 8 * g4 + 4 * hi; const f32x4 ga = *(const LAS f32x4*)(GL + k0), gb = *(const LAS f32x4*)(GL + 32 + k0);
        *(GAS f32x4*)(dst + k0) = (f32x4){st0[4 * g4] * ga.x, st0[4 * g4 + 1] * ga.y, st0[4 * g4 + 2] * ga.z, st0[4 * g4 + 3] * ga.w};
        *(GAS f32x4*)(dst + 32 + k0) = (f32x4){st1[4 * g4] * gb.x, st1[4 * g4 + 1] * gb.y, st1[4 * g4 + 2] * gb.z, st1[4 * g4 + 3] * gb.w}; }
}
}
__device__ __forceinline__ void phase_sample_stream(Ctx& F) {
    for (int u = F.vcu * NWAVES + F.wave; u < DBAT * HA * 32; u += NWAVES * F.G) sba::attn_sample_unit(F, (u >> 8) * HA + (u & 7), (u >> 3) & 31, (char*)F.lds + F.wave * 16384);
}
__device__ __forceinline__ void phase_scan1_mfma(Ctx& F) {
    __syncthreads();
    const int grp = F.wave >> 2, wq = F.wave & 3; LAS char* gbase = (LAS char*)F.lds + grp * msc::GRP_BYTES;
    msc::PrepRegs L;
    { const int ch = 2 * F.vcu + grp; if (ch < NBATCH * HB * 64) msc::prep_load(F, L, (ch >> 10) * SEQ + (ch & 63) * 64 + 16 * wq, (ch >> 6) & 15); }
    for (int base = 2 * F.vcu; base < NBATCH * HB * 64; base += 2 * F.G) {
        const int ch = base + grp, bh = ch >> 6, c = ch & 63;
        msc::prep_block(F, L, (bh >> 4) * SEQ + c * 64 + 16 * wq, bh & 15, wq, gbase);
        __syncthreads();
        { const int chn = ch + 2 * F.G; if (chn < NBATCH * HB * 64) msc::prep_load(F, L, (chn >> 10) * SEQ + (chn & 63) * 64 + 16 * wq, (chn >> 6) & 15); }
        msc::chain(F, bh, c, wq >> 1, wq & 1, gbase);
    }
}
__device__ __forceinline__ void phase_scan2(Ctx& F) {
    LAS float* Pb = (LAS float*)(F.lds + 4096);
    const float* PU = WSP(float, WS_PU); float* SC = WSP(float, WS_SC);
    for (int unit = F.vcu; unit < NBATCH * HB * 8; unit += F.G) {
        const int bh = unit >> 3, r0 = (unit & 7) * 8, r = F.wave, col = F.lane;
        __syncthreads();
        { const float* P0 = PU + ((size_t)(bh * 64) * 2 + 1) * 4096; const f32x4 a = *(const GAS f32x4*)(P0 + F.tid * 4), bq = *(const GAS f32x4*)(P0 + 2048 + F.tid * 4);
          *(LAS f32x4*)(Pb + F.tid * 4) = a; *(LAS f32x4*)(Pb + 2048 + F.tid * 4) = bq; }
        float ucur = PU[((size_t)(bh * 64) * 2 + 0) * 4096 + (r0 + r) * 64 + col], scur = 0.f;
        __syncthreads();
        for (int c = 0; c < 64; ++c) {
            const int ch = bh * 64 + c; LAS float* Pc = Pb + (c & 1) * 4096;
            SC[((size_t)ch * 64 + r0 + r) * 64 + col] = scur;
            f32x4 pa = {0.f, 0.f, 0.f, 0.f}, pq = {0.f, 0.f, 0.f, 0.f}; float unext = 0.f;
            if (c + 1 < 64) { const float* Pn = PU + ((size_t)(ch + 1) * 2 + 1) * 4096; pa = *(const GAS f32x4*)(Pn + F.tid * 4); pq = *(const GAS f32x4*)(Pn + 2048 + F.tid * 4);
                unext = PU[((size_t)(ch + 1) * 2 + 0) * 4096 + (r0 + r) * 64 + col]; }
            float a0 = ucur, a1 = 0.f, a2 = 0.f, a3 = 0.f;
#pragma unroll
            for (int j = 0; j < 64; j += 4) {
                const float s0 = readlane_f(scur, j), s1 = readlane_f(scur, j + 1), s2 = readlane_f(scur, j + 2), s3 = readlane_f(scur, j + 3);
                a0 += s0 * Pc[(j + 0) * 64 + col]; a1 += s1 * Pc[(j + 1) * 64 + col]; a2 += s2 * Pc[(j + 2) * 64 + col]; a3 += s3 * Pc[(j + 3) * 64 + col]; }
            const float acc = (a0 + a1) + (a2 + a3);
            if (c + 1 < 64) { LAS float* Pn = Pb + ((c + 1) & 1) * 4096; *(LAS f32x4*)(Pn + F.tid * 4) = pa; *(LAS f32x4*)(Pn + 2048 + F.tid * 4) = pq; }
            __syncthreads();
            scur = acc; ucur = unext;
        }
        F.outp()[O_WKVP + ((size_t)bh * 64 + r0 + r) * 64 + col] = scur;
    }
}
__device__ __forceinline__ void phase_scan3(Ctx& F) {
    const int gw = F.vcu * NWAVES + F.wave, NGW = F.G * NWAVES, lane = F.lane, q = lane >> 4, m = lane & 15;
    const float* SC = WSP(float, WS_SC); const float* Z = WSP(float, WS_Z); float* Y = WSP(float, WS_YC);
    for (int task = gw; task < NBATCH * HB * 63 * 4; task += NGW) {
        const int g = task & 3, cc = task >> 2, bh = cc / 63, c = 1 + (cc - bh * 63), ch = bh * 64 + c, h = bh & 15, b = bh >> 4, row = 16 * g + m;
        const float* st = SC + ((size_t)ch * 64 + row) * 64 + 16 * q; float s[16];
#pragma unroll
        for (int i = 0; i < 16; i += 4) { const f32x4 v = *(const GAS f32x4*)(st + i); s[i] = v.x; s[i + 1] = v.y; s[i + 2] = v.z; s[i + 3] = v.w; }
        const float* zp = Z + (size_t)ch * 4096 + lane; float* yp = Y + (size_t)(b * SEQ + c * 64) * 1024 + h * 64 + row;
        float zb[4];
#pragma unroll
        for (int u = 0; u < 4; ++u) zb[u] = zp[u * 64];
        for (int t = 0; t < 64; t += 4) {
#pragma unroll
            for (int u = 0; u < 4; ++u) {
                const float zv = zb[u]; if (t + u + 4 < 64) zb[u] = zp[(t + u + 4) * 64];
                float acc = 0.f; dot16(acc, zv, s); acc = xrow16_sum(acc);
                if (q == 0) yp[(size_t)(t + u) * 1024] = acc;
            }
        }
    }
}
__device__ __forceinline__ float sum32(float v) {
    v += dpp_f<0xB1>(v); v += dpp_f<0x4E>(v); v += dpp_f<0x141>(v); v += dpp_f<0x140>(v);
    auto s = __builtin_amdgcn_permlane16_swap(__float_as_uint(v), __float_as_uint(v), false, false);
    return __uint_as_float(s[0]) + __uint_as_float(s[1]);
}
__device__ __forceinline__ sba::bf16x8 ld8_bf16(const float* p) { const f32x4 a = *(const GAS f32x4*)p, b = *(const GAS f32x4*)(p + 4); return msc::pack8(a.x, a.y, a.z, a.w, b.x, b.y, b.z, b.w); }
__device__ __forceinline__ void phase_scan3_post(Ctx& F) {
    const int gw = F.vcu * NWAVES + F.wave, NGW = F.G * NWAVES, lane = F.lane, n = lane & 31, hi = lane >> 5;
    const float* SC = WSP(float, WS_SC); const float* Z = WSP(float, WS_Z); const float* Y = WSP(float, WS_Y); const bf16* LWH = WSP(bf16, WS_LWH); const bf16* PBH = WSP(bf16, WS_PBH);
    const float* SCL = WSP(float, WS_SCL); bf16* OAB = WSP(bf16, WS_OAB);
    for (int ch = gw; ch < NBATCH * HB * 64; ch += NGW) {
        const int bh = ch >> 6, c = ch & 63, h = bh & 15, b = bh >> 4, r0 = b * SEQ + c * 64, col0 = h * 64 + n;
        const float lg0 = F.in(I_LNG)[col0], lg1 = F.in(I_LNG)[col0 + 32], lb0 = F.in(I_LNB)[col0], lb1 = F.in(I_LNB)[col0 + 32], mv0 = F.in(I_MU)[2048 + col0], mv1 = F.in(I_MU)[2048 + col0 + 32];
        sba::bf16x8 sb0[4], sb1[4];
        if (c > 0) { const float* Sp = SC + (size_t)ch * 4096 + n * 64 + 8 * hi;
#pragma unroll
            for (int ks = 0; ks < 4; ++ks) { sb0[ks] = ld8_bf16(Sp + 16 * ks); sb1[ks] = ld8_bf16(Sp + 32 * 64 + 16 * ks); } }
        else {
#pragma unroll
            for (int ks = 0; ks < 4; ++ks) { sb0[ks] = sba::bf16x8{}; sb1[ks] = sba::bf16x8{}; } }
        for (int tt = 0; tt < 2; ++tt) {
            sba::f32x16 a0 = sba::f32x16{}, a1 = sba::f32x16{};
            if (c > 0) { const float* Zp = Z + (size_t)ch * 4096 + (32 * tt + n) * 64 + 8 * hi;
#pragma unroll
                for (int ks = 0; ks < 4; ++ks) { const sba::bf16x8 za = ld8_bf16(Zp + 16 * ks);
                    a0 = __builtin_amdgcn_mfma_f32_32x32x16_bf16(za, sb0[ks], a0, 0, 0, 0); a1 = __builtin_amdgcn_mfma_f32_32x32x16_bf16(za, sb1[ks], a1, 0, 0, 0); } }
#pragma unroll
            for (int rg = 0; rg < 16; rg += 4) {
                float y0[4], y1[4], g0[4], g1[4], p0[4], p1[4], q0[4], q1[4], bn[4];
#pragma unroll
                for (int i = 0; i < 4; ++i) { const int t = 32 * tt + sba::crow(rg + i, hi), r = r0 + t;
                    y0[i] = Y[(size_t)r * 1024 + col0]; y1[i] = Y[(size_t)r * 1024 + col0 + 32];
                    g0[i] = ldbf(LWH + (size_t)r * 3072 + 2048 + col0); g1[i] = ldbf(LWH + (size_t)r * 3072 + 2048 + col0 + 32);
                    const bf16* pb = PBH + (size_t)r * 3072 + 2048 + col0; p0[i] = ldbf(pb); p1[i] = ldbf(pb + 32);
                    const bool hp = (r & (SEQ - 1)) != 0; q0[i] = hp ? ldbf(pb - 3072) : 0.f; q1[i] = hp ? ldbf(pb + 32 - 3072) : 0.f;
                    bn[i] = SCL[((size_t)r * HB + h) * 4 + 2]; }
#pragma unroll
                for (int i = 0; i < 4; ++i) { const int t = 32 * tt + sba::crow(rg + i, hi), r = r0 + t;
                    const float v0 = y0[i] + a0[rg + i], v1 = y1[i] + a1[rg + i];
                    const float mean = sum32(v0 + v1) * (1.f / 64.f), d0 = v0 - mean, d1 = v1 - mean, var = sum32(d0 * d0 + d1 * d1) * (1.f / 64.f), rs = rsqrtf(var + EPS_LNX);
                    const float zv0 = p0[i] + mv0 * (q0[i] - p0[i]), zv1 = p1[i] + mv1 * (q1[i] - p1[i]);
                    const float o0 = (d0 * rs * lg0 + lb0 + bn[i] * zv0) * g0[i], o1 = (d1 * rs * lg1 + lb1 + bn[i] * zv1) * g1[i];
                    const float o0n = dpp_f<0xB1>(o0), o1n = dpp_f<0xB1>(o1);
                    if ((lane & 1) == 0) { *(GAS unsigned*)(OAB + (size_t)r * DM + 1024 + col0) = cvt_pk_bf16(o0, o0n); *(GAS unsigned*)(OAB + (size_t)r * DM + 1024 + col0 + 32) = cvt_pk_bf16(o1, o1n); } }
            }
        }
    }
}
__device__ __forceinline__ void phase_postscan(Ctx& F) {
    const int gw = F.vcu * NWAVES + F.wave, NGW = F.G * NWAVES;
    const float* Y = WSP(float, WS_Y); const float* RWV = WSP(float, WS_RWV); const float* SCL = WSP(float, WS_SCL); const float* LWO = WSP(float, WS_LWO); const float* Pp = WSP(float, WS_P); bf16* OAB = WSP(bf16, WS_OAB);
    for (int u = NPR * 4 + gw; u < NTOK * 4; u += NGW) {
        const int r = u >> 2, hq = u & 3; const bool corr = false;
        float yv[4], gv[4], vv[4], bn[4];
#pragma unroll
        for (int i = 0; i < 4; ++i) { const int h = hq * 4 + i, col = h * 64 + F.lane;
            yv[i] = Y[(size_t)r * 1024 + col]; if (corr) yv[i] += WSP(float, WS_YC)[(size_t)r * 1024 + col];
            gv[i] = LWO[(size_t)r * 3072 + 2048 + col]; bn[i] = SCL[((size_t)r * HB + h) * 4 + 2];
            vv[i] = RWV[((size_t)r * HB + h) * 512 + 320 + F.lane]; }
#pragma unroll
        for (int i = 0; i < 4; ++i) { const int h = hq * 4 + i, col = h * 64 + F.lane;
            const float mean = wave_sum(yv[i]) * (1.f / 64.f), d = yv[i] - mean, var = wave_sum(d * d) * (1.f / 64.f);
            const float yn = d * rsqrtf(var + EPS_LNX) * F.in(I_LNG)[col] + F.in(I_LNB)[col] + bn[i] * vv[i];
            const float o = yn * gv[i];
            const float o1 = dpp_f<0xB1>(o);
            if ((F.lane & 1) == 0) *(GAS unsigned*)(OAB + (size_t)r * DM + 1024 + col) = cvt_pk_bf16(o, o1); }
    }
    sample_combine(F);
    const float* OP = WSP(float, WS_OP); const float* CL = WSP(float, WS_CL);
    for (size_t i = (size_t)F.vcu * NTHR + F.tid; i < (size_t)NPR * 256; i += (size_t)F.G * NTHR) {
        const int r = (int)(i >> 8), c4 = (int)(i & 255) * 4, h = c4 >> 7;
        const f32x4 a = *(const GAS f32x4*)(OP + (size_t)r * 1024 + c4), e = *(const GAS f32x4*)(OP + ((size_t)NPR + r) * 1024 + c4); const float cl = CL[(size_t)r * HA + h];
        const f32x4 o = a + e * cl; u32x2 w; w.x = cvt_pk_bf16(o.x, o.y); w.y = cvt_pk_bf16(o.z, o.w);
        *(GAS u32x2*)(OAB + (size_t)r * DM + c4) = w;
    }
}
__device__ __forceinline__ void phase_usample(Ctx& F) {
    const float* PU_ = WSP(float, WS_PARTU); bf16* U = WSP(bf16, WS_U);
    for (int i = F.vcu * NTHR + F.tid; i < NSM * DFF / 4; i += F.G * NTHR) { const int r = i / (DFF / 4), c4 = (i - r * (DFF / 4)) * 4;
        f32x4 a = *(const GAS f32x4*)(PU_ + (size_t)r * DFF + c4);
#pragma unroll
        for (int kc = 1; kc < 8; ++kc) a += *(const GAS f32x4*)(PU_ + ((size_t)kc * 64 + r) * DFF + c4);
        const float x0 = fmaxf(a.x, 0.f), x1 = fmaxf(a.y, 0.f), x2 = fmaxf(a.z, 0.f), x3 = fmaxf(a.w, 0.f);
        u32x2 w; w.x = cvt_pk_bf16(x0 * x0, x1 * x1); w.y = cvt_pk_bf16(x2 * x2, x3 * x3);
        *(GAS u32x2*)(U + (size_t)(NPR + r) * DFF + c4) = w; }
}
#ifndef MK_SPLIT
#define MK_SPLIT 0
#endif
constexpr int NPHASE = 21;
struct Args { const void* in[N_IN]; float* out; unsigned char* ws; int ph_lo, ph_hi; };
__global__ void __launch_bounds__(NTHR, 2) mega_fwd(Args args) {
    extern __shared__ __attribute__((aligned(16))) unsigned char lds_raw[];
    Ctx F;
    F.lds = (LAS unsigned char*)lds_raw; F.tid = threadIdx.x; F.lane = F.tid & 63; F.wave = __builtin_amdgcn_readfirstlane(F.tid >> 6);
    F.G = gridDim.x; { const int bx = blockIdx.x; F.vcu = (F.G % 8 == 0) ? (bx % 8) * (F.G / 8) + bx / 8 : bx; }
    for (int u = F.tid; u < (LDS_BYTES - LDSCTL_OFF) / 4; u += NTHR) ((LAS unsigned*)(F.lds + LDSCTL_OFF))[u] = 0u;
    __syncthreads();
    unsigned* ctl = (unsigned*)(args.ws + WS_CTL);
    XcdBarrier bar; bar.bar = ctl + CW_BAR; bar.x = 0; bar.st = nullptr;
    if (!MK_SPLIT) bar = xcd_barrier_post(ctl + CW_BAR, (volatile LAS unsigned*)(F.lds + MISC_OFF) + 8);
    const int lo = args.ph_lo, hi = args.ph_hi;
#define IN(k) (lo <= (k) && (k) < hi)
#define SEAM(k) do { if (IN(k) && IN((k) + 1)) xcd_barrier(bar); } while (0)
    if (IN(0)) { phase_prologue(F); } SEAM(0);
    if (IN(1)) { phase_mod0(F); } SEAM(1);
    if (IN(2)) { const bool hide = F.G > NCVT + 8; const int ng = hide ? F.G - NCVT : F.G;
        if ((int)blockIdx.x < ng) { pg8::Gemm g{WSP(bf16, WS_H), WSP(bf16, WS_WIN), MP, INPAD, DM, DM, DM}; pg8::StaticOrder S; S.init(MP, INPAD, ng, (int)blockIdx.x); EpiIn E{WSP(bf16, WS_QB), WSP(bf16, WS_KB), WSP(bf16, WS_VB), WSP(float, WS_P), F.outp(), WSP(bf16, WS_PBH)};
            pg8::gemm_phase<EpiIn, pg8::StaticOrder, true, true>(F.lds, g, S, E); }
        else convert_run(F, IT_IN + ((int)blockIdx.x - ng) * NWAVES + F.wave, NCVT * NWAVES, IT_IN + N_HIDE, (LAS float*)(F.lds + F.wave * 16384)); } SEAM(2);
    if (IN(3)) { phase_kv_prep(F); } SEAM(3);
    if (IN(4)) { pg8::Gemm g{WSP(bf16, WS_LA), WSP(bf16, WS_LWT), MP, 3072, 512, 512, 512}; pg8::LoraOrder S; S.init(MP, 3072, F.G, (int)blockIdx.x); pg8::EpiLora E{WSP(float, WS_LWO), WSP(bf16, WS_LWH), 3072};
        pg8::gemm_phase<pg8::EpiLora, pg8::LoraOrder, true, true>(F.lds, g, S, E); } SEAM(4);
    if (IN(6)) { phase_rwkv_prep(F);
        const bool stream_first = (F.vcu & 1) != 0;
        if (stream_first) phase_sample_stream(F); else phase_scan1_mfma(F);
        __syncthreads();
        phase_attn_prompt(F);
        if (!stream_first) phase_sample_stream(F); else phase_scan1_mfma(F); } SEAM(7);
    if (IN(8)) {
        if (F.wave < 2) for (int t = F.vcu * 2 + F.wave; t < DBAT * HB * 4; t += 2 * F.G) scan_wave<false, true>(F, t >> 2, 0, t & 3);
        phase_scan2(F); } SEAM(8);
    if (IN(10)) { phase_scan3_post(F); phase_postscan(F); } SEAM(10);
    if (IN(11)) { pg8::Gemm g{WSP(bf16, WS_OAB), WSP(bf16, WS_WOUT), MP, DM, DM, DM, DM}; pg8::MixOrder<false> S; S.init(DM, DM, F.G, (int)blockIdx.x); pg8::EpiF32S<64> E{WSP(bf16, WS_OUT), DM, nullptr, WSP(float, WS_PART)};
        pg8::gemm_phase<pg8::EpiF32S<64>, pg8::MixOrder<false>, true, true>(F.lds, g, S, E); } SEAM(11);
    if (IN(12)) { phase_postmix<0>(F); } SEAM(12);
    if (IN(13)) { pg8::Gemm g{WSP(bf16, WS_H), WSP(bf16, WS_W1), MP, DFF, DM, DM, DM}; pg8::MixOrder<false> S; S.init(DFF, DM, F.G, (int)blockIdx.x); pg8::EpiRelu2 E{WSP(bf16, WS_U), DFF, WSP(float, WS_PARTU)};
        pg8::gemm_phase<pg8::EpiRelu2, pg8::MixOrder<false>, true, true>(F.lds, g, S, E); } SEAM(13);
    if (IN(14)) { phase_usample(F); if (!MK_SPLIT) xcd_barrier(bar); pg8::Gemm g{WSP(bf16, WS_U), WSP(bf16, WS_W2), MP, DM, DFF, DFF, DFF}; pg8::MixOrder<false> S; S.init(DM, DFF, F.G, (int)blockIdx.x); pg8::EpiF32S<64> E{WSP(bf16, WS_OUT), DM, nullptr, WSP(float, WS_PART)};
        pg8::gemm_phase<pg8::EpiF32S<64>, pg8::MixOrder<false>, true, true>(F.lds, g, S, E); } SEAM(14);
    if (IN(15)) { phase_postmlp<0>(F); } SEAM(15);
    if (IN(16)) { pg8::Gemm g{WSP(bf16, WS_H), WSP(bf16, WS_WPOOL), MP, DM, DM, DM, DM}; pg8::MixOrder<true> S; S.init(DM, DM, F.G, (int)blockIdx.x); pg8::EpiF32S<256> E{WSP(bf16, WS_OUT), DM, F.in(I_PSC), WSP(float, WS_PART)};
        pg8::gemm_phase<pg8::EpiF32S<256>, pg8::MixOrder<true>, true, true>(F.lds, g, S, E); } SEAM(16);
    if (IN(17)) { phase_postmix<1>(F); } SEAM(17);
    if (IN(18)) { pg8::Gemm g{WSP(bf16, WS_H), WSP(bf16, WS_W1) + (size_t)DFF * DM, MP, DFF, DM, DM, DM}; pg8::MixOrder<false> S; S.init(DFF, DM, F.G, (int)blockIdx.x); pg8::EpiRelu2 E{WSP(bf16, WS_U), DFF, WSP(float, WS_PARTU)};
        pg8::gemm_phase<pg8::EpiRelu2, pg8::MixOrder<false>, true, true>(F.lds, g, S, E); } SEAM(18);
    if (IN(19)) { phase_usample(F); if (!MK_SPLIT) xcd_barrier(bar); pg8::Gemm g{WSP(bf16, WS_U), WSP(bf16, WS_W2) + (size_t)DM * DFF, MP, DM, DFF, DFF, DFF}; pg8::MixOrder<false> S; S.init(DM, DFF, F.G, (int)blockIdx.x); pg8::EpiF32S<64> E{WSP(bf16, WS_OUT), DM, nullptr, WSP(float, WS_PART)};
        pg8::gemm_phase<pg8::EpiF32S<64>, pg8::MixOrder<false>, true, true>(F.lds, g, S, E); } SEAM(19);
    if (IN(20)) { phase_postmlp<1>(F); }
#undef IN
#undef SEAM
}

extern "C" void kernel_launch(void* const* d_in, const int* in_sizes, int n_in, void* d_out, int out_size, void* d_ws, size_t ws_size, hipStream_t stream) {
    static int grid = 0;
    if (grid == 0) {
        if (n_in != N_IN || (size_t)out_size != O_END || ws_size < WS_END) { fprintf(stderr, "kernel_launch: unexpected shapes: n_in %d out %d ws %zu (want %d, %zu, >= %zu)\n", n_in, out_size, ws_size, (int)N_IN, (size_t)O_END, (size_t)WS_END); grid = -1; return; }
        int dev = 0, cus = 0, per_cu = 0;
        if (hipGetDevice(&dev) != hipSuccess || hipDeviceGetAttribute(&cus, hipDeviceAttributeMultiprocessorCount, dev) != hipSuccess) { grid = -1; return; }
        if (hipFuncSetAttribute((const void*)mega_fwd, hipFuncAttributeMaxDynamicSharedMemorySize, LDS_BYTES) != hipSuccess) { fprintf(stderr, "kernel_launch: hipFuncSetAttribute failed\n"); grid = -1; return; }
        if (hipOccupancyMaxActiveBlocksPerMultiprocessor(&per_cu, (const void*)mega_fwd, NTHR, LDS_BYTES) != hipSuccess || per_cu < 1) fprintf(stderr, "kernel_launch: occupancy query reports %d blocks per CU\n", per_cu);
        (void)hipGetLastError();
        grid = cus;
    }
    if (grid < 0) return;
    hipMemsetAsync((char*)d_ws + WS_CTL, 0, CTL_ZERO_BYTES, stream);
    Args a{};
    for (int i = 0; i < N_IN; ++i) a.in[i] = d_in[i];
    a.out = (float*)d_out; a.ws = (unsigned char*)d_ws;
#if MK_SPLIT
    for (int p = 0; p < NPHASE; ++p) { a.ph_lo = p; a.ph_hi = p + 1; hipLaunchKernelGGL(mega_fwd, dim3(grid), dim3(NTHR), LDS_BYTES, stream, a); }
#else
    a.ph_lo = 0; a.ph_hi = NPHASE;
    hipLaunchKernelGGL(mega_fwd, dim3(grid), dim3(NTHR), LDS_BYTES, stream, a);
#endif
    const hipError_t le = hipPeekAtLastError();
    if (le != hipSuccess) fprintf(stderr, "kernel_launch: launch failed: %s\n", hipGetErrorName(le));
}
```

```cpp
#include <hip/hip_runtime.h>
#include <cstdio>
#include <cstdint>
namespace pg8 {
#define PG8_LAS __attribute__((address_space(3)))
typedef unsigned short bf16_t;
typedef short bf16x8 __attribute__((ext_vector_type(8)));
typedef float f32x4 __attribute__((ext_vector_type(4)));
typedef unsigned u32x4 __attribute__((ext_vector_type(4)));
constexpr int BM = 256, BK = 64, HALF = 128, HTB = HALF * BK * 2  , STAGE_BYTES = 8 * HTB, NXCD = 8, WGM = 8;

__host__ __device__ __forceinline__ int lds_byte(int r, int c) { const int st = (r >> 4) * 2 + (c >> 5), rr = r & 15, cc = c & 31, ob = rr * 64 + cc * 2; return st * 1024 + (ob ^ (((ob >> 9) & 1) << 5)); }
__host__ __device__ __forceinline__ void stage_rc(int b, int& R, int& C) { const int st = b / 1024, sb = b % 1024, swz = sb ^ (((sb >> 9) & 1) << 5); R = (st >> 1) * 16 + swz / 64; C = (st & 1) * 32 + (swz % 64) / 2; }
__host__ __device__ __forceinline__ int perm32(int rho) { const int n = rho >> 4, i = rho & 15; return 8 * (i >> 2) + 4 * n + (i & 3); }

struct Unit { int pm, pn, kc; };
struct Gemm { const bf16_t* A; const bf16_t* Bt; int M, N, K, lda, ldb; };

struct StaticOrder {
    int nM, nN, nwg, G, c;
    __host__ __device__ void init(int M, int N, int G_, int c_) { nM = M / BM; nN = N / BM; nwg = nM * nN; G = G_; c = c_; }
    __host__ __device__ bool next(int i, Unit& u) const {
        const long L = (long)i * G + c; if (L >= nwg) return false;
        int wgid = (int)L; { const int q = nwg / NXCD, r = nwg % NXCD, xcd = wgid % NXCD, off = wgid / NXCD; wgid = (xcd < r ? xcd * (q + 1) : r * (q + 1) + (xcd - r) * q) + off; }
        const int nig = WGM * nN, gid = wgid / nig, fm = gid * WGM, gsz = (nM - fm) < WGM ? (nM - fm) : WGM;
        u.pm = fm + ((wgid % nig) % gsz); u.pn = (wgid % nig) / gsz; u.kc = -1; return true;
    }
    __device__ __forceinline__ int nt(const Unit&, const Gemm& g) const { return g.K / BK; }
    __device__ __forceinline__ void a_ready(const Unit&) const {}
    __device__ __forceinline__ void done(const Unit&) const {}
    __device__ __forceinline__ size_t a_off(const Unit& u, const Gemm& g) const { return (size_t)u.pm * BM * g.lda * 2; }
    __device__ __forceinline__ size_t b_off(const Unit& u, const Gemm& g) const { return (size_t)u.pn * BM * g.ldb * 2; }
};
struct LoraOrder : StaticOrder {
    __device__ __forceinline__ int k0(const Unit& u) const { return u.pn < 4 ? 0 : (u.pn < 8 ? 64 : 192); }
    __device__ __forceinline__ int nt(const Unit& u, const Gemm&) const { return u.pn < 8 ? 2 : 4; }
    __device__ __forceinline__ size_t a_off(const Unit& u, const Gemm& g) const { return (size_t)u.pm * BM * g.lda * 2 + (size_t)k0(u) * 2; }
    __device__ __forceinline__ size_t b_off(const Unit& u, const Gemm& g) const { return (size_t)u.pn * BM * g.ldb * 2 + (size_t)k0(u) * 2; }
};
__device__ __forceinline__ unsigned cvt_pk_bf16(float lo, float hi) { unsigned r; asm volatile("v_cvt_pk_bf16_f32 %0, %1, %2" : "=v"(r) : "v"(lo), "v"(hi)); return r; }

struct EpiF32 {
    static constexpr bool PERM = false, AFTER_DRAIN = false;
    float* C; int ldc; const float* cscale;
    __device__ __forceinline__ void operator()(const f32x4 (&acc)[2][2][4][2], const Unit& u, int wr, int wc, int fr, int fq) const {
        const int row0 = u.pm * BM + wr * 64 + fr, col0 = u.pn * BM + wc * 32 + 4 * fq;
        f32x4 sv[2][2];
#pragma unroll
        for (int bj = 0; bj < 2; ++bj)
#pragma unroll
            for (int n = 0; n < 2; ++n) sv[bj][n] = cscale ? *(const f32x4*)(cscale + col0 + bj * HALF + n * 16) : (f32x4){1.f, 1.f, 1.f, 1.f};
#pragma unroll
        for (int ai = 0; ai < 2; ++ai)
#pragma unroll
            for (int m = 0; m < 4; ++m) { float* rowp = C + (size_t)(row0 + ai * HALF + m * 16) * ldc + col0;
#pragma unroll
                for (int bj = 0; bj < 2; ++bj)
#pragma unroll
                    for (int n = 0; n < 2; ++n) *(f32x4*)(rowp + bj * HALF + n * 16) = acc[ai][bj][m][n] * sv[bj][n]; }
    }
};
typedef unsigned u32x2h __attribute__((ext_vector_type(2)));
struct EpiLora {
    static constexpr bool PERM = false, AFTER_DRAIN = false;
    float* C; bf16_t* H; int ldc;
    __device__ __forceinline__ void operator()(const f32x4 (&acc)[2][2][4][2], const Unit& u, int wr, int wc, int fr, int fq) const {
        const int row0 = u.pm * BM + wr * 64 + fr, col0 = u.pn * BM + wc * 32 + 4 * fq;
#pragma unroll
        for (int ai = 0; ai < 2; ++ai)
#pragma unroll
            for (int m = 0; m < 4; ++m) { const size_t ro = (size_t)(row0 + ai * HALF + m * 16) * ldc + col0;
#pragma unroll
                for (int bj = 0; bj < 2; ++bj)
#pragma unroll
                    for (int n = 0; n < 2; ++n) { const f32x4 v = acc[ai][bj][m][n];
                        if (u.pm < 32) { u32x2h w; w.x = cvt_pk_bf16(v[0], v[1]); w.y = cvt_pk_bf16(v[2], v[3]); *(u32x2h*)(H + ro + bj * HALF + n * 16) = w; }
                        else *(f32x4*)(C + ro + bj * HALF + n * 16) = v; } }
    }
};
struct EpiRelu2 {
    static constexpr bool PERM = true, AFTER_DRAIN = false;
    bf16_t* O; int ldc; float* PART;
    __device__ __forceinline__ void operator()(const f32x4 (&acc)[2][2][4][2], const Unit& u, int wr, int wc, int fr, int fq) const {
        const int row0 = u.pm * BM + wr * 64 + fr, col0 = u.pn * BM + wc * 32 + 8 * fq;
        if (u.kc >= 0) {
            if (wr == 0) {
#pragma unroll
                for (int m = 0; m < 4; ++m) { float* rowp = PART + ((size_t)u.kc * 64 + m * 16 + fr) * ldc + col0;
#pragma unroll
                    for (int bj = 0; bj < 2; ++bj) { *(f32x4*)(rowp + bj * HALF) = acc[0][bj][m][0]; *(f32x4*)(rowp + bj * HALF + 4) = acc[0][bj][m][1]; } } }
            return;
        }
#pragma unroll
        for (int ai = 0; ai < 2; ++ai)
#pragma unroll
            for (int m = 0; m < 4; ++m) { bf16_t* rowp = O + (size_t)(row0 + ai * HALF + m * 16) * ldc + col0;
#pragma unroll
                for (int bj = 0; bj < 2; ++bj) { f32x4 v0 = acc[ai][bj][m][0], v1 = acc[ai][bj][m][1];
#pragma unroll
                    for (int j = 0; j < 4; ++j) { const float a = v0[j] > 0.f ? v0[j] : 0.f, b = v1[j] > 0.f ? v1[j] : 0.f; v0[j] = a * a; v1[j] = b * b; }
                    u32x4 w; w.x = cvt_pk_bf16(v0[0], v0[1]); w.y = cvt_pk_bf16(v0[2], v0[3]); w.z = cvt_pk_bf16(v1[0], v1[1]); w.w = cvt_pk_bf16(v1[2], v1[3]);
                    *(u32x4*)(rowp + bj * HALF) = w; } }
    }
};
template <bool POOL> struct MixOrder {
    StaticOrder so; int nmain, nN, kdiv, ntot, G, c;
    __device__ void init(int N, int K, int G_, int c_) { nN = N / BM; so.init(32 * BM, N, G_, c_); nmain = 32 * nN; kdiv = (POOL ? 512 : K) / 256; ntot = nmain + nN * kdiv; G = G_; c = c_; }
    __device__ bool next(int i, Unit& u) const {
        const int L = i * G + c; if (L >= ntot) return false;
        if (L < nmain) return so.next(i, u);
        const int j = L - nmain; u.pm = 32; u.pn = j % nN; u.kc = j / nN; return true;
    }
    __device__ __forceinline__ int nt(const Unit& u, const Gemm& g) const { return u.kc >= 0 ? 4 : (POOL ? 8 : g.K / BK); }
    __device__ __forceinline__ size_t a_off(const Unit& u, const Gemm& g) const { return (size_t)u.pm * BM * g.lda * 2 + (size_t)((POOL ? (u.pn >> 1) * 512 : 0) + (u.kc >= 0 ? u.kc * 256 : 0)) * 2; }
    __device__ __forceinline__ size_t b_off(const Unit& u, const Gemm& g) const { return (size_t)u.pn * BM * g.ldb * 2 + (size_t)((POOL ? (u.pn >> 1) * 512 : 0) + (u.kc >= 0 ? u.kc * 256 : 0)) * 2; }
    __device__ __forceinline__ void a_ready(const Unit&) const {}
    __device__ __forceinline__ void done(const Unit&) const {}
};
template <int PROW> struct EpiF32S {
    static constexpr bool PERM = false, AFTER_DRAIN = false;
    bf16_t* C; int ldc; const float* cscale; float* PART;
    __device__ __forceinline__ f32x4 scl(int c) const { return cscale ? *(const f32x4*)(cscale + c) : (f32x4){1.f, 1.f, 1.f, 1.f}; }
    __device__ __forceinline__ void operator()(const f32x4 (&acc)[2][2][4][2], const Unit& u, int wr, int wc, int fr, int fq) const {
        asm volatile("" : "+v"(fr), "+v"(fq));
        const int col0 = u.pn * BM + wc * 32 + 4 * fq;
        if (u.kc < 0) {
            bf16_t* Ct = C + (size_t)u.pm * BM * ldc; const unsigned e0 = (unsigned)((wr * 64 + fr) * ldc + col0);
#pragma unroll
            for (int bj = 0; bj < 2; ++bj)
#pragma unroll
                for (int n = 0; n < 2; ++n) { const f32x4 sv = scl(col0 + bj * HALF + n * 16);
#pragma unroll
                    for (int ai = 0; ai < 2; ++ai)
#pragma unroll
                        for (int m = 0; m < 4; ++m) { const f32x4 v = acc[ai][bj][m][n] * sv; const unsigned w0 = cvt_pk_bf16(v[0], v[1]), w1 = cvt_pk_bf16(v[2], v[3]);
                            *(unsigned long long*)(Ct + e0 + (unsigned)((ai * HALF + m * 16) * ldc) + bj * HALF + n * 16) = (unsigned long long)w0 | ((unsigned long long)w1 << 32); } }
        } else if (PROW == 256) {
            float* Pk = PART + (size_t)u.kc * 256 * ldc; const unsigned e0 = (unsigned)((wr * 64 + fr) * ldc + col0);
#pragma unroll
            for (int bj = 0; bj < 2; ++bj)
#pragma unroll
                for (int n = 0; n < 2; ++n) { const f32x4 sv = scl(col0 + bj * HALF + n * 16);
#pragma unroll
                    for (int ai = 0; ai < 2; ++ai)
#pragma unroll
                        for (int m = 0; m < 4; ++m) *(f32x4*)(Pk + e0 + (unsigned)((ai * HALF + m * 16) * ldc) + bj * HALF + n * 16) = acc[ai][bj][m][n] * sv; }
        } else if (wr == 0) {
            float* Pk = PART + (size_t)u.kc * 64 * ldc; const unsigned e0 = (unsigned)(fr * ldc + col0);
#pragma unroll
            for (int bj = 0; bj < 2; ++bj)
#pragma unroll
                for (int n = 0; n < 2; ++n) { const f32x4 sv = scl(col0 + bj * HALF + n * 16);
#pragma unroll
                    for (int m = 0; m < 4; ++m) *(f32x4*)(Pk + e0 + (unsigned)(m * 16 * ldc) + bj * HALF + n * 16) = acc[0][bj][m][n] * sv; }
        }
    }
};
template <class Epi, class Sched, bool ALIGN_EPI = false, bool SP2 = false>
__device__ __forceinline__ void gemm_phase(PG8_LAS unsigned char* lds, const Gemm g, const Sched& S, const Epi& E) {
    const int tid = threadIdx.x, wid = __builtin_amdgcn_readfirstlane(tid >> 6), lane = tid & 63, wr = wid >> 2, wc = wid & 3, fr = lane & 15, fq = lane >> 4;
    unsigned voffA[2], voffB[2];
#pragma unroll
    for (int i = 0; i < 2; ++i) { int R, C; stage_rc(tid * 16 + i * 8192, R, C); const int Rb = Epi::PERM ? ((R & ~31) + perm32(R & 31)) : R;
        voffA[i] = (unsigned)(R * g.lda + C) * 2u; voffB[i] = (unsigned)(Rb * g.ldb + C) * 2u; }
    const size_t kstep = (size_t)(BK * 2);
    const size_t hsA = (size_t)HALF * g.lda * 2, hsB = (size_t)HALF * g.ldb * 2;
    const unsigned ldsw = (unsigned)wid * 1024u;
    const int aoff = lds_byte(wr * 64 + fr, fq * 8), boff = lds_byte(wc * 32 + fr, fq * 8);
#define PG8_SA(b, h) (((b) * 2 + (h)) * HTB)
#define PG8_SB(b, h) ((4 + (b) * 2 + (h)) * HTB)
#define PG8_STAGE(bufoff, gbase, voff) do { _Pragma("unroll") for (int _i = 0; _i < 2; ++_i) \
        __builtin_amdgcn_global_load_lds((const unsigned*)((const char*)(gbase) + (voff)[_i]), (PG8_LAS unsigned*)(lds + (bufoff) + ldsw + _i * 8192), 16, 0, 0); } while (0)
#define PG8_LDA(dst, b, h) do { _Pragma("unroll") for (int m = 0; m < 4; ++m) _Pragma("unroll") for (int k = 0; k < 2; ++k) dst[m][k] = *(const PG8_LAS bf16x8*)(lds + PG8_SA(b, h) + aoff + m * 2048 + k * 1024); } while (0)
#define PG8_LDB(dst, b, h) do { _Pragma("unroll") for (int n = 0; n < 2; ++n) _Pragma("unroll") for (int k = 0; k < 2; ++k) dst[n][k] = *(const PG8_LAS bf16x8*)(lds + PG8_SB(b, h) + boff + n * 2048 + k * 1024); } while (0)
#define PG8_MMA(ai, bj, At, Bt) do { __builtin_amdgcn_s_setprio(1); _Pragma("unroll") for (int m = 0; m < 4; ++m) _Pragma("unroll") for (int n = 0; n < 2; ++n) _Pragma("unroll") for (int k = 0; k < 2; ++k) \
        acc[ai][bj][m][n] = __builtin_amdgcn_mfma_f32_16x16x32_bf16(Bt[n][k], At[m][k], acc[ai][bj][m][n], 0, 0, 0); __builtin_amdgcn_s_setprio(0); } while (0)
#define PG8_WAIT_V(n) asm volatile("s_waitcnt vmcnt(" #n ")" ::: "memory")
#define PG8_WAIT_L(n) asm volatile("s_waitcnt lgkmcnt(" #n ")" ::: "memory")
#define PG8_BAR __builtin_amdgcn_s_barrier()
#define PG8_SCHED __builtin_amdgcn_sched_barrier(0)
    Unit cur, nxt; int ui = 0;
    if (!S.next(0, cur)) return;
    int nt = S.nt(cur, g);
    f32x4 acc[2][2][4][2];
#pragma unroll
    for (int a = 0; a < 2; ++a)
#pragma unroll
        for (int b = 0; b < 2; ++b)
#pragma unroll
            for (int m = 0; m < 4; ++m)
#pragma unroll
                for (int n = 0; n < 2; ++n) acc[a][b][m][n] = (f32x4){0.f, 0.f, 0.f, 0.f};
    bf16x8 At[4][2], B0[2][2], B1[2][2];
    const char* cA = (const char*)g.A + S.a_off(cur, g); const char* cB = (const char*)g.Bt + S.b_off(cur, g);
    S.a_ready(cur);
    if constexpr (SP2) {
        PG8_STAGE(PG8_SB(0, 0), cB, voffB); PG8_STAGE(PG8_SB(0, 1), cB + hsB, voffB); PG8_STAGE(PG8_SA(0, 0), cA, voffA); PG8_STAGE(PG8_SA(0, 1), cA + hsA, voffA);
        if (wr == 1) PG8_BAR;
        PG8_WAIT_V(2); PG8_BAR;
        PG8_STAGE(PG8_SB(1, 0), cB + kstep, voffB); PG8_STAGE(PG8_SA(1, 0), cA + kstep, voffA); PG8_STAGE(PG8_SB(1, 1), cB + hsB + kstep, voffB);
        PG8_WAIT_V(6); PG8_BAR;
    } else {
        PG8_STAGE(PG8_SB(0, 0), cB, voffB); PG8_STAGE(PG8_SA(0, 0), cA, voffA); PG8_STAGE(PG8_SB(0, 1), cB + hsB, voffB); PG8_STAGE(PG8_SA(0, 1), cA + hsA, voffA);
        if (wr == 1) PG8_BAR;
        PG8_WAIT_V(4); PG8_BAR;
        PG8_STAGE(PG8_SB(1, 0), cB + kstep, voffB); PG8_STAGE(PG8_SA(1, 0), cA + kstep, voffA); PG8_STAGE(PG8_SB(1, 1), cB + hsB + kstep, voffB);
        PG8_WAIT_V(6); PG8_BAR;
    }
    for (;;) {
        const bool has_next = S.next(ui + 1, nxt);
        const char* nA = has_next ? (const char*)g.A + S.a_off(nxt, g) : cA; const char* nB = has_next ? (const char*)g.Bt + S.b_off(nxt, g) : cB;
        for (int t = 0; t < nt; t += 2) {
            const bool last = (t == nt - 2);
            const char* a1 = cA + (size_t)(t + 1) * kstep;
            const char* a2 = last ? nA : cA + (size_t)(t + 2) * kstep; const char* b2 = last ? nB : cB + (size_t)(t + 2) * kstep;
            const char* a3 = a2 + kstep; const char* b3 = b2 + kstep;
            if (last && has_next) S.a_ready(nxt);
            if constexpr (SP2) {
            PG8_LDB(B0, 0, 0); PG8_LDB(B1, 0, 1); PG8_SCHED; PG8_LDA(At, 0, 0); PG8_STAGE(PG8_SA(1, 1), a1 + hsA, voffA);
            PG8_WAIT_V(8); PG8_WAIT_L(0); PG8_BAR; PG8_MMA(0, 0, At, B0); PG8_MMA(0, 1, At, B1); PG8_BAR; PG8_SCHED;
            PG8_LDA(At, 0, 1); PG8_STAGE(PG8_SB(0, 0), b2, voffB); PG8_STAGE(PG8_SB(0, 1), b2 + hsB, voffB); PG8_STAGE(PG8_SA(0, 0), a2, voffA);
            PG8_WAIT_V(8); PG8_WAIT_L(0); PG8_BAR; PG8_MMA(1, 0, At, B0); PG8_MMA(1, 1, At, B1); PG8_BAR; PG8_SCHED;
            PG8_LDB(B0, 1, 0); PG8_LDB(B1, 1, 1); PG8_SCHED; PG8_LDA(At, 1, 0); PG8_STAGE(PG8_SA(0, 1), a2 + hsA, voffA);
            PG8_WAIT_V(8); PG8_WAIT_L(0); PG8_BAR; PG8_MMA(0, 0, At, B0); PG8_MMA(0, 1, At, B1); PG8_BAR; PG8_SCHED;
            PG8_LDA(At, 1, 1); PG8_STAGE(PG8_SB(1, 0), b3, voffB); PG8_STAGE(PG8_SB(1, 1), b3 + hsB, voffB); PG8_STAGE(PG8_SA(1, 0), a3, voffA);
            PG8_WAIT_V(8); PG8_WAIT_L(0); PG8_BAR; PG8_MMA(1, 0, At, B0); PG8_MMA(1, 1, At, B1); PG8_BAR; PG8_SCHED;
            } else {
            PG8_LDB(B0, 0, 0); PG8_SCHED; PG8_LDA(At, 0, 0); PG8_STAGE(PG8_SA(1, 1), a1 + hsA, voffA);
            PG8_WAIT_L(8); PG8_BAR; PG8_WAIT_L(0); PG8_MMA(0, 0, At, B0); PG8_BAR; PG8_SCHED;
            PG8_LDB(B1, 0, 1); PG8_STAGE(PG8_SB(0, 0), b2, voffB);
            PG8_BAR; PG8_WAIT_L(0); PG8_MMA(0, 1, At, B1); PG8_BAR;
            PG8_LDA(At, 0, 1); PG8_STAGE(PG8_SA(0, 0), a2, voffA);
            PG8_BAR; PG8_WAIT_L(0); PG8_MMA(1, 0, At, B0); PG8_BAR; PG8_SCHED;
            PG8_STAGE(PG8_SB(0, 1), b2 + hsB, voffB);
            PG8_WAIT_V(6); PG8_BAR; PG8_MMA(1, 1, At, B1); PG8_BAR;
            PG8_LDB(B0, 1, 0); PG8_SCHED; PG8_LDA(At, 1, 0); PG8_STAGE(PG8_SA(0, 1), a2 + hsA, voffA);
            PG8_WAIT_L(8); PG8_BAR; PG8_WAIT_L(0); PG8_MMA(0, 0, At, B0); PG8_BAR; PG8_SCHED;
            PG8_LDB(B1, 1, 1); PG8_STAGE(PG8_SB(1, 0), b3, voffB);
            PG8_BAR; PG8_WAIT_L(0); PG8_MMA(0, 1, At, B1); PG8_BAR;
            PG8_LDA(At, 1, 1); PG8_STAGE(PG8_SA(1, 0), a3, voffA);
            PG8_BAR; PG8_WAIT_L(0); PG8_MMA(1, 0, At, B0); PG8_BAR; PG8_SCHED;
            PG8_STAGE(PG8_SB(1, 1), b3 + hsB, voffB);
            PG8_WAIT_V(6); PG8_BAR; PG8_MMA(1, 1, At, B1); PG8_BAR;
            }
        }
        if constexpr (ALIGN_EPI) { if (wr == 0) PG8_BAR; }
        if constexpr (!Epi::AFTER_DRAIN) { E(acc, cur, wr, wc, fr, fq); S.done(cur); }
        if (!has_next) break;
#pragma unroll
        for (int a = 0; a < 2; ++a)
#pragma unroll
            for (int b = 0; b < 2; ++b)
#pragma unroll
                for (int m = 0; m < 4; ++m)
#pragma unroll
                    for (int n = 0; n < 2; ++n) acc[a][b][m][n] = (f32x4){0.f, 0.f, 0.f, 0.f};
        cur = nxt; cA = nA; cB = nB; ++ui; nt = S.nt(cur, g);
        if constexpr (ALIGN_EPI) { if (wr == 1) PG8_BAR; }
    }
    PG8_WAIT_V(0);
    if constexpr (!ALIGN_EPI) { if (wr == 0) PG8_BAR; }
    PG8_BAR;
    if constexpr (Epi::AFTER_DRAIN) { E.fused(acc, cur, wr, wc, fr, fq, lds, wid, lane); S.done(cur); }
#undef PG8_SA
#undef PG8_SB
#undef PG8_STAGE
#undef PG8_LDA
#undef PG8_LDB
#undef PG8_MMA
#undef PG8_WAIT_V
#undef PG8_WAIT_L
#undef PG8_BAR
#undef PG8_SCHED
}
}

constexpr int DM = 2048, SEQ = 4096, NBATCH = 2, NPR = NBATCH * SEQ, DBAT = 8, DSEQ = 8, NSM = DBAT * DSEQ, NTOK = NPR + NSM, MP = 8448;
constexpr int HA = 8, DHA = 128, HB = 16, DHB = 64, DBR = 1024;
constexpr int BCOLS = 3520, INCOLS = 6592, INPAD = 6656, DFF = 8192, NPAGES = 128, PAGESZ = 128, PAST = 16384, PBUF = 15, NMR = 10;
constexpr float EPS_RMS = 1e-6f, EPS_LNX = 64e-5f, QK_SCALE = 0.08838834764831845f;
enum { I_XP = 0, I_XS, I_CK, I_CV, I_PT, I_SWKV, I_SSH, I_SPOOL, I_CP, I_CS, I_WADA, I_BADA, I_NG, I_WIN, I_WOUT, I_SBB, I_MU, I_W0, I_WUP, I_A0, I_AUP, I_GUP, I_KK, I_KA, I_RK, I_LNG, I_LNB, I_WPOOL, I_PSC, I_W1, I_W2, N_IN };
constexpr size_t O_YP = 0, O_YS = O_YP + (size_t)NPR * DM, O_KP = O_YS + (size_t)NSM * DM, O_VP = O_KP + (size_t)NPR * 1024, O_KS = O_VP + (size_t)NPR * 1024, O_VS = O_KS + (size_t)NSM * 1024,
                 O_WKVP = O_VS + (size_t)NSM * 1024, O_WKVS = O_WKVP + (size_t)NBATCH * HB * 64 * 64, O_SHP = O_WKVS + (size_t)DBAT * HB * 64 * 64, O_SHS = O_SHP + (size_t)NBATCH * BCOLS,
                 O_PLP = O_SHS + (size_t)DBAT * BCOLS, O_PLS = O_PLP + (size_t)NBATCH * PBUF * DM, O_END = O_PLS + (size_t)DBAT * PBUF * DM;
constexpr size_t MiB = 1u << 20;
constexpr size_t WS_CTL = 0, CTL_ZERO_BYTES = 64 * 1024, WS_MOD = 1 * MiB, WS_WIN = 2 * MiB, WS_WOUT = 28 * MiB, WS_W1 = 36 * MiB, WS_W2 = 100 * MiB, WS_WPOOL = 164 * MiB,
                 WS_H = 172 * MiB, WS_OAB = 205 * MiB, WS_M = 238 * MiB, WS_P = 271 * MiB, WS_OUT = 486 * MiB, WS_XR = 552 * MiB, WS_HF = 617 * MiB, WS_U = 682 * MiB,
                 WS_RWV = 814 * MiB, WS_SCL = 1072 * MiB, WS_G = 1075 * MiB, WS_Y = 1108 * MiB, WS_PU = 1141 * MiB, WS_Z = 1205 * MiB, WS_SC = 1237 * MiB, WS_QB = 1269 * MiB, WS_KB = 1286 * MiB, WS_VB = 1303 * MiB, WS_OP = 1320 * MiB, WS_CL = 1384 * MiB, WS_SPART = 1385 * MiB, WS_SCAR = 1394 * MiB, WS_LA = 1395 * MiB, WS_LWT = 1404 * MiB, WS_LWO = 1408 * MiB, WS_YC = 1508 * MiB, WS_PART = 1541 * MiB, WS_PARTU = 1558 * MiB, WS_END = 1575 * MiB;
static_assert(WS_WIN + (size_t)INPAD * DM * 2 <= WS_WOUT && WS_P + (size_t)MP * INPAD * 4 <= WS_OUT && WS_U + (size_t)MP * DFF * 2 <= WS_RWV && WS_RWV + (size_t)NTOK * HB * 512 * 4 <= WS_SCL, "ws map");
constexpr int CW_BAR = 4096;
constexpr int RING_BYTES = 131072, LDSCTL_OFF = RING_BYTES, MISC_OFF = LDSCTL_OFF + 320, LDS_BYTES = 147456;
constexpr int NWAVES = 8, NTHR = 512;

#define GAS __attribute__((address_space(1)))
#define LAS __attribute__((address_space(3)))
typedef unsigned short bf16;
__device__ __forceinline__ float ldbf(const bf16* p) { return __uint_as_float((unsigned)*p << 16); }
__device__ __forceinline__ float ldbf_nt(const bf16* p) { return __uint_as_float((unsigned)__builtin_nontemporal_load(p) << 16); }
typedef float f32x4 __attribute__((ext_vector_type(4)));
typedef float f32x2 __attribute__((ext_vector_type(2)));
typedef unsigned u32x2 __attribute__((ext_vector_type(2)));
typedef unsigned u32x4 __attribute__((ext_vector_type(4)));
#define LDS_WAIT() asm volatile("s_waitcnt lgkmcnt(0)" ::: "memory")
#define VM_WAIT() asm volatile("s_waitcnt vmcnt(0)" ::: "memory")
using pg8::cvt_pk_bf16;
constexpr size_t WS_PBH = WS_RWV, WS_LWH = WS_RWV + 64 * MiB;
static_assert((size_t)NPR * 3072 * 2 <= 64 * MiB && 128 * MiB <= (size_t)NPR * HB * 512 * 4, "bf16 prompt copies fit below the sample rows of RWV");
constexpr int PBLD = 3584;
struct EpiIn {
    static constexpr bool PERM = false, AFTER_DRAIN = false;
    bf16 *QB, *KB, *VB; float* PB; float* out; bf16* PBH;
    __device__ __forceinline__ void operator()(const pg8::f32x4 (&acc)[2][2][4][2], const pg8::Unit& u, int wr, int wc, int fr, int fq) const {
        const int row0 = u.pm * 256 + wr * 64 + fr, colt = u.pn * 256 + wc * 32 + 4 * fq;
        if (u.pn >= 12) {
#pragma unroll
            for (int ai = 0; ai < 2; ++ai)
#pragma unroll
                for (int m = 0; m < 4; ++m) {
                    if (u.pm < 32 && u.pn < 24) { bf16* rowh = PBH + (size_t)(row0 + ai * 128 + m * 16) * 3072 + (colt - 3072);
#pragma unroll
                        for (int bj = 0; bj < 2; ++bj)
#pragma unroll
                            for (int n = 0; n < 2; ++n) { const pg8::f32x4 v = acc[ai][bj][m][n]; u32x2 w; w.x = cvt_pk_bf16(v[0], v[1]); w.y = cvt_pk_bf16(v[2], v[3]); *(u32x2*)(rowh + bj * 128 + n * 16) = w; } }
                    else { float* rowp = PB + (size_t)(row0 + ai * 128 + m * 16) * PBLD + (colt - 3072);
#pragma unroll
                        for (int bj = 0; bj < 2; ++bj)
#pragma unroll
                            for (int n = 0; n < 2; ++n) *(pg8::f32x4*)(rowp + bj * 128 + n * 16) = acc[ai][bj][m][n]; } }
        } else {
            const int sel = u.pn >> 2, c0 = colt - sel * 1024;
            static_assert(WS_KB - WS_QB == WS_VB - WS_KB && O_VP - O_KP == (size_t)NPR * 1024 && O_VS - O_KS == (size_t)NSM * 1024, "q/k/v buffers are equally spaced");
            bf16* Bt = QB + (size_t)sel * ((WS_KB - WS_QB) / 2) + (size_t)u.pm * 256 * 1024;
            float* Ot = u.pm < 32 ? out + O_KP + (size_t)(sel ? sel - 1 : 0) * NPR * 1024 + (size_t)u.pm * 256 * 1024 : out + O_KS + (size_t)(sel ? sel - 1 : 0) * NSM * 1024;
            const int rl0 = wr * 64 + fr;
#pragma unroll
            for (int ai = 0; ai < 2; ++ai)
#pragma unroll
                for (int m = 0; m < 4; ++m) { const int rl = rl0 + ai * 128 + m * 16; const unsigned eo = (unsigned)(rl * 1024 + c0);
                    const bool wo = sel != 0 && (u.pm < 32 || rl < NSM);
#pragma unroll
                    for (int bj = 0; bj < 2; ++bj)
#pragma unroll
                        for (int n = 0; n < 2; ++n) { const pg8::f32x4 v = acc[ai][bj][m][n]; u32x2 w; w.x = cvt_pk_bf16(v[0], v[1]); w.y = cvt_pk_bf16(v[2], v[3]);
                            *(u32x2*)(Bt + eo + bj * 128 + n * 16) = w; if (wo) *(pg8::f32x4*)(Ot + eo + bj * 128 + n * 16) = v; }
                    asm volatile("" ::: "memory"); }
        }
    }
};

#define XB_TMO      128
#define XB_XCNT(j)  (256  + 64 * (j))
#define XB_XSUB(j)  (1280 + 64 * (j))
#define XB_XGEN(j)  (2304 + 64 * (j))
#define XB_TOP      3328
#define XB_TOPGEN   3392
#define XCD_BAR_WORDS 3456
#define XB_SPIN_CAP (1u << 18)

__device__ __forceinline__ unsigned xb_ld(unsigned* p)              { return __hip_atomic_load(p, __ATOMIC_RELAXED, __HIP_MEMORY_SCOPE_AGENT); }
__device__ __forceinline__ unsigned xb_add(unsigned* p, unsigned v) { return __hip_atomic_fetch_add(p, v, __ATOMIC_RELAXED, __HIP_MEMORY_SCOPE_AGENT); }
__device__ __forceinline__ unsigned xb_xcc_id() { return (unsigned)__builtin_amdgcn_s_getreg((3 << 11) | 20) & 0xFu; }
#define XB_SPIN(cond, bar) do { unsigned _sp = 0; while (cond) { __builtin_amdgcn_s_sleep(1); \
    if ((++_sp & 255u) == 0u) { if (xb_ld(&(bar)[XB_TMO])) break; if (_sp > XB_SPIN_CAP) { atomicAdd(&(bar)[XB_TMO], 1u); break; } } } } while (0)

struct XcdBarrier {
    unsigned* bar; unsigned x;
    volatile LAS unsigned* st;
};

__device__ __forceinline__ XcdBarrier xcd_barrier_post(unsigned* bar, volatile LAS unsigned* st) {
    XcdBarrier b; b.bar = bar; b.x = xb_xcc_id(); b.st = st;
    if (threadIdx.x == 0) (void)xb_add(&bar[XB_XCNT(b.x)], 1u);
    return b;
}
__device__ __forceinline__ void xcd_barrier_complete(unsigned* bar, unsigned x, unsigned& nloc, unsigned& nx) {
    const unsigned G = gridDim.x * gridDim.y * gridDim.z;
    unsigned sum, cnt, mine, sp = 0u;
    for (;;) {
        sum = 0u; cnt = 0u; mine = 0u;
#pragma unroll
        for (unsigned j = 0; j < 16; ++j) { const unsigned c = xb_ld(&bar[XB_XCNT(j)]); sum += c; cnt += (c > 0u) ? 1u : 0u; mine = (j == x) ? c : mine; }
        if (sum == G) break;
        __builtin_amdgcn_s_sleep(1);
        if ((++sp & 255u) == 0u) { if (xb_ld(&bar[XB_TMO])) break; if (sp > XB_SPIN_CAP) { atomicAdd(&bar[XB_TMO], 1u); break; } }
    }
    nloc = mine > 0u ? mine : 1u; nx = cnt > 0u ? cnt : 1u;
}

__device__ __forceinline__ void xcd_barrier(const XcdBarrier& b) {
    asm volatile("s_waitcnt vmcnt(0)" ::: "memory");
    __syncthreads();
    if (threadIdx.x == 0) {
        unsigned* bar = b.bar;
        __builtin_amdgcn_s_waitcnt(0);
        unsigned nloc = b.st[0], nx = b.st[1];
        if (nloc == 0u) { xcd_barrier_complete(bar, b.x, nloc, nx); b.st[0] = nloc; b.st[1] = nx; }
        const unsigned old = xb_add(&bar[XB_XSUB(b.x)], 1u);
        const unsigned gen = old / nloc;
        if (old + 1u == (gen + 1u) * nloc) {
            __builtin_amdgcn_fence(__ATOMIC_RELEASE, "agent");
            asm volatile("s_waitcnt vmcnt(0)" ::: "memory");
            const unsigned og = xb_add(&bar[XB_TOP], 1u);
            const unsigned tg = og / nx;
            if (og + 1u == (tg + 1u) * nx) xb_add(&bar[XB_TOPGEN], 1u);
            else XB_SPIN(xb_ld(&bar[XB_TOPGEN]) == tg, bar);
            __builtin_amdgcn_fence(__ATOMIC_ACQUIRE, "agent");
            xb_add(&bar[XB_XGEN(b.x)], 1u);
            asm volatile("s_waitcnt vmcnt(0)" ::: "memory");
        } else {
            XB_SPIN(xb_ld(&bar[XB_XGEN(b.x)]) == gen, bar);
            __builtin_amdgcn_fence(__ATOMIC_ACQUIRE, "agent");
            asm volatile("s_waitcnt vmcnt(0)" ::: "memory");
        }
    }
    __syncthreads();
}


struct Ctx {
    LAS unsigned char* lds; int tid, lane, wave, vcu, G;
    __device__ __forceinline__ const float* in(int i) const { return ((const float* const __attribute__((address_space(4)))*)__builtin_amdgcn_kernarg_segment_ptr())[i]; }
    __device__ __forceinline__ float* outp() const { return ((float* const __attribute__((address_space(4)))*)__builtin_amdgcn_kernarg_segment_ptr())[N_IN]; }
    __device__ __forceinline__ unsigned char* wsp() const { return ((unsigned char* const __attribute__((address_space(4)))*)__builtin_amdgcn_kernarg_segment_ptr())[N_IN + 1]; }
};
template <int CTRL> __device__ __forceinline__ float dpp_f(float x) { return __builtin_bit_cast(float, __builtin_amdgcn_mov_dpp(__builtin_bit_cast(int, x), CTRL, 0xf, 0xf, true)); }
#define readlane_f(x, l) __builtin_bit_cast(float, __builtin_amdgcn_readlane(__builtin_bit_cast(int, (float)(x)), (l)))
__device__ __forceinline__ float wave_sum(float v) {
    v += dpp_f<0xB1>(v); v += dpp_f<0x4E>(v); v += dpp_f<0x141>(v); v += dpp_f<0x140>(v);
    auto s = __builtin_amdgcn_permlane16_swap(__float_as_uint(v), __float_as_uint(v), false, false);
    v = __uint_as_float(s[0]) + __uint_as_float(s[1]);
    auto t = __builtin_amdgcn_permlane32_swap(__float_as_uint(v), __float_as_uint(v), false, false);
    return __uint_as_float(t[0]) + __uint_as_float(t[1]);
}
__device__ __forceinline__ float sigmoidf_(float x) { return 1.f / (1.f + __expf(-x)); }
__device__ __forceinline__ float softplusf_(float x) { return fmaxf(x, 0.f) + log1pf(__expf(-fabsf(x))); }
__device__ __forceinline__ int mod_row(int r) { return r < NPR ? (r >> 12) : 2 + ((r - NPR) >> 3); }
#define WSP(T, off) ((T*)(F.wsp() + (off)))

struct CvtItem { const float* W; bf16* WT; int ldw, ldt, k0, n0; };
__device__ __forceinline__ void item_load(float (&tv)[32], const CvtItem& d, int lane) {
#pragma unroll
    for (int i = 0; i < 32; ++i) tv[i] = __builtin_nontemporal_load(d.W + (size_t)(d.k0 + 2 * i + (lane >> 5)) * d.ldw + d.n0 + (lane & 31));
}
__device__ __forceinline__ void item_store(const float (&tv)[32], const CvtItem& d, LAS float* scr, int lane) {
#pragma unroll
    for (int i = 0; i < 32; ++i) scr[(2 * i + (lane >> 5)) * 33 + (lane & 31)] = tv[i];
    LDS_WAIT(); asm volatile("" ::: "memory");
    const int c = lane & 7;
#pragma unroll
    for (int j = 0; j < 4; ++j) { const int n = (lane >> 3) + 8 * j; const LAS float* s = scr + (8 * c) * 33 + n;
        u32x4 o; o.x = cvt_pk_bf16(s[0 * 33], s[1 * 33]); o.y = cvt_pk_bf16(s[2 * 33], s[3 * 33]); o.z = cvt_pk_bf16(s[4 * 33], s[5 * 33]); o.w = cvt_pk_bf16(s[6 * 33], s[7 * 33]);
        *(GAS u32x4*)(d.WT + (size_t)(d.n0 + n) * d.ldt + d.k0 + 8 * c) = o; }
    LDS_WAIT(); asm volatile("" ::: "memory");
}
constexpr int IT_IN = 32 * 206, IT_OUT = 32 * 64, IT_W1 = 32 * 256, IT_W2 = 128 * 64, IT_PL = 8 * 16, NIT_ALL = IT_IN + IT_OUT + 2 * IT_W1 + 2 * IT_W2 + 4 * IT_PL;
__device__ __forceinline__ CvtItem item_decode(Ctx& F, int it) {
    int r = it; CvtItem d; int N;
    if (r < IT_IN) { d.W = F.in(I_WIN); d.WT = WSP(bf16, WS_WIN); N = INCOLS; d.ldt = DM; }
    else if ((r -= IT_IN) < IT_OUT) { d.W = F.in(I_WOUT); d.WT = WSP(bf16, WS_WOUT); N = DM; d.ldt = DM; }
    else if ((r -= IT_OUT) < 2 * IT_W1) { const int l = r / IT_W1; r -= l * IT_W1; d.W = F.in(I_W1) + (size_t)l * DM * DFF; d.WT = WSP(bf16, WS_W1) + (size_t)l * DFF * DM; N = DFF; d.ldt = DM; }
    else if ((r -= 2 * IT_W1) < 2 * IT_W2) { const int l = r / IT_W2; r -= l * IT_W2; d.W = F.in(I_W2) + (size_t)l * DFF * DM; d.WT = WSP(bf16, WS_W2) + (size_t)l * DM * DFF; N = DM; d.ldt = DFF; }
    else { r -= 2 * IT_W2; const int g = r / IT_PL; r -= g * IT_PL; d.W = F.in(I_WPOOL) + (size_t)g * 512 * 512; d.WT = WSP(bf16, WS_WPOOL) + (size_t)(g * 512) * DM + g * 512; N = 512; d.ldt = DM; }
    const int nblk = N / 32, kb = r / nblk, nb = r - kb * nblk;
    d.ldw = N; d.k0 = 64 * kb; d.n0 = 32 * nb; return d;
}
__device__ __forceinline__ void convert_run(Ctx& F, int first, int stride, int lim, LAS float* scr) {
    int it = first; if (it >= lim) return;
    float ta[32], tb[32]; CvtItem da = item_decode(F, it), db = da; item_load(ta, da, F.lane);
    for (;;) {
        const int i2 = it + stride; const bool h2 = i2 < lim; if (h2) { db = item_decode(F, i2); item_load(tb, db, F.lane); }
        item_store(ta, da, scr, F.lane); if (!h2) break;
        const int i3 = i2 + stride; const bool h3 = i3 < lim; if (h3) { da = item_decode(F, i3); item_load(ta, da, F.lane); }
        item_store(tb, db, scr, F.lane); if (!h3) break;
        it = i3; }
}
constexpr int NCVT = 40, N_HIDE = 24000;
__device__ __forceinline__ void phase_prologue(Ctx& F) {
    LAS float* scr = (LAS float*)(F.lds + F.wave * 16384);
    const int gw = F.vcu * NWAVES + F.wave, NGW = F.G * NWAVES;
    convert_run(F, gw, NGW, IT_IN, scr);
    if (F.G > NCVT + 8) convert_run(F, IT_IN + N_HIDE + gw, NGW, NIT_ALL, scr); else convert_run(F, IT_IN + gw, NGW, NIT_ALL, scr);
    for (int i = F.vcu * NTHR + F.tid; i < 3072 * 64; i += F.G * NTHR) {
        const int kc = i / 3072, n = i - kc * 3072, reg = n >> 10, nn = n & 1023;
        float v[8];
        if (reg == 0) {
#pragma unroll
            for (int j = 0; j < 8; ++j) { const int k = 8 * kc + j; v[j] = (k < 96) ? F.in(I_WUP)[(size_t)k * 1024 + nn] : 0.f; } }
        else if (reg == 1) {
#pragma unroll
            for (int j = 0; j < 8; ++j) { const int k = 8 * kc + j - 96; v[j] = (k >= 0 && k < 96) ? F.in(I_AUP)[(size_t)k * 1024 + nn] : 0.f; } }
        else {
#pragma unroll
            for (int j = 0; j < 8; ++j) { const int k = 8 * kc + j - 192; v[j] = (k >= 0 && k < 256) ? F.in(I_GUP)[(size_t)k * 1024 + nn] : 0.f; } }
        u32x4 o; o.x = cvt_pk_bf16(v[0], v[1]); o.y = cvt_pk_bf16(v[2], v[3]); o.z = cvt_pk_bf16(v[4], v[5]); o.w = cvt_pk_bf16(v[6], v[7]);
        *(GAS u32x4*)(WSP(bf16, WS_LWT) + (size_t)n * 512 + 8 * kc) = o;
    }
    __syncthreads();
    LAS float* sc = (LAS float*)F.lds;
    LAS float* part = (LAS float*)(F.lds + 81920);
    for (int i = F.tid; i < NMR * DM; i += NTHR) { const int r = i >> 11, k = i & 2047; const float c = r < 2 ? F.in(I_CP)[r * DM + k] : F.in(I_CS)[(r - 2) * DM + k]; sc[i] = c / (1.f + __expf(-c)); }
    __syncthreads();
    float* MOD = WSP(float, WS_MOD);
    float* MODP = WSP(float, WS_G);
    for (int u = F.vcu; u < 512; u += F.G) {
        const bool whole = u < 256; const int task = whole ? u : 256 + ((u - 256) >> 1), kh = whole ? 0 : (u - 256) & 1, klen = whole ? 256 : 128;
        const int l = task / 192, cb = (task - l * 192) * 64;
        const float* W = F.in(I_WADA) + (size_t)l * DM * 12288 + cb + F.lane;
        float acc[NMR];
#pragma unroll
        for (int r = 0; r < NMR; ++r) acc[r] = 0.f;
        const int kbeg = kh * 1024 + F.wave * klen;
        for (int k = kbeg; k < kbeg + klen; k += 16) {
            float wv[16];
#pragma unroll
            for (int j = 0; j < 16; ++j) wv[j] = __builtin_nontemporal_load(W + (size_t)(k + j) * 12288);
#pragma unroll
            for (int j = 0; j < 16; j += 4)
#pragma unroll
                for (int r = 0; r < NMR; ++r) { const f32x4 s = *(const LAS f32x4*)(sc + r * DM + k + j); acc[r] += (s.x * wv[j] + s.y * wv[j + 1]) + (s.z * wv[j + 2] + s.w * wv[j + 3]); }
        }
#pragma unroll
        for (int r = 0; r < NMR; ++r) part[(F.wave * NMR + r) * 64 + F.lane] = acc[r];
        __syncthreads();
        for (int i = F.tid; i < NMR * 64; i += NTHR) { const int r = i >> 6, c = i & 63; float s = 0.f;
#pragma unroll
            for (int w = 0; w < NWAVES; ++w) s += part[(w * NMR + r) * 64 + c];
            if (kh == 0) s += F.in(I_BADA)[l * 12288 + cb + c];
            if (whole) MOD[(size_t)(l * NMR + r) * 12288 + cb + c] = s; else MODP[((size_t)kh * NMR + r) * 8192 + (cb - 4096) + c] = s; }
        __syncthreads();
    }
}

struct Row { f32x4 v[8]; };
__device__ __forceinline__ void row_load(Row& R, const float* p, int lane) {
#pragma unroll
    for (int j = 0; j < 8; ++j) R.v[j] = *(const GAS f32x4*)(p + j * 256 + lane * 4);
}
__device__ __forceinline__ void row_load_bf16(Row& R, const bf16* p, int lane) {
#pragma unroll
    for (int j = 0; j < 8; ++j) { const u32x2 w = *(const GAS u32x2*)(p + j * 256 + lane * 4);
        R.v[j] = (f32x4){__uint_as_float(w.x << 16), __uint_as_float(w.x & 0xffff0000u), __uint_as_float(w.y << 16), __uint_as_float(w.y & 0xffff0000u)}; }
}
__device__ __forceinline__ float row_sumsq(const Row& R) { float s = 0.f;
#pragma unroll
    for (int j = 0; j < 8; ++j) s += (R.v[j].x * R.v[j].x + R.v[j].y * R.v[j].y) + (R.v[j].z * R.v[j].z + R.v[j].w * R.v[j].w);
    return wave_sum(s); }
__device__ __forceinline__ const float* x_in_row(Ctx& F, int r) { return r < NPR ? F.in(I_XP) + (size_t)r * DM : F.in(I_XS) + (size_t)(r - NPR) * DM; }
__device__ __forceinline__ void row_modulate(Row& H, const Row& X, float rstd, const float* g, const float* shift, const float* scale, int lane) {
#pragma unroll
    for (int j = 0; j < 8; ++j) { const int c = j * 256 + lane * 4; const f32x4 gg = *(const GAS f32x4*)(g + c), sh = *(const GAS f32x4*)(shift + c), sc = *(const GAS f32x4*)(scale + c);
        H.v[j] = X.v[j] * rstd * gg * (sc + 1.f) + sh; }
}
__device__ __forceinline__ void row_store_bf16(const Row& H, bf16* p, int lane) {
#pragma unroll
    for (int j = 0; j < 8; ++j) { u32x2 w; w.x = cvt_pk_bf16(H.v[j].x, H.v[j].y); w.y = cvt_pk_bf16(H.v[j].z, H.v[j].w); *(GAS u32x2*)(p + j * 256 + lane * 4) = w; }
}
__device__ __forceinline__ void row_store_f32(const Row& H, float* p, int lane) {
#pragma unroll
    for (int j = 0; j < 8; ++j) *(GAS f32x4*)(p + j * 256 + lane * 4) = H.v[j];
}
__device__ __forceinline__ void row_store_f32_nt(const Row& H, float* p, int lane) {
#pragma unroll
    for (int j = 0; j < 8; ++j) __builtin_nontemporal_store(H.v[j], (GAS f32x4*)(p + j * 256 + lane * 4));
}
struct RowB { u32x2 w[8]; };
__device__ __forceinline__ void rowb_load(RowB& R, const bf16* p, int lane) {
#pragma unroll
    for (int j = 0; j < 8; ++j) R.w[j] = *(const GAS u32x2*)(p + j * 256 + lane * 4);
}
__device__ __forceinline__ void rowb_cvt(Row& R, const RowB& B) {
#pragma unroll
    for (int j = 0; j < 8; ++j) R.v[j] = (f32x4){__uint_as_float(B.w[j].x << 16), __uint_as_float(B.w[j].x & 0xffff0000u), __uint_as_float(B.w[j].y << 16), __uint_as_float(B.w[j].y & 0xffff0000u)};
}
constexpr int PSET_FLOATS = 3 * DM;
static_assert(NSM == 64 && 3 * PSET_FLOATS * 4 <= RING_BYTES, "row phases: 8 workgroups x 8 waves take the sample rows; three parameter sets in LDS");
template <int KIND, int L> __device__ __forceinline__ void stage_row_params(Ctx& F) {
    const float* MOD = WSP(float, WS_MOD); const float* ng = F.in(I_NG) + (size_t)L * 4 * DM;
    const int nset = F.vcu < 8 ? 3 : 2;
#define RP_LD4(p) (*(const GAS f32x4*)(p))
    for (int i = F.tid; i < nset * (DM / 4); i += NTHR) {
        const int s = i >> 9, c = (i & 511) * 4, mr = s < 2 ? s : 2 + F.vcu;
        const float* m = MOD + (size_t)(L * NMR + mr) * 12288;
        f32x4 v0 = {0.f, 0.f, 0.f, 0.f}, v1 = v0, v2 = v0;
        if (KIND == 0) { v1 = RP_LD4(ng + c) * (RP_LD4(m + DM + c) + 1.f); v2 = RP_LD4(m + c); }
        else if (KIND == 1) { v0 = RP_LD4(m + 2 * DM + c) * RP_LD4(ng + DM + c); v1 = RP_LD4(ng + 2 * DM + c) * (RP_LD4(m + 4 * DM + c) + 1.f); v2 = RP_LD4(m + 3 * DM + c); }
        else { v0 = RP_LD4(m + 5 * DM + c) * RP_LD4(ng + 3 * DM + c);
               if (KIND == 2) { const float* m1 = MOD + (size_t)(1 * NMR + mr) * 12288; v1 = RP_LD4(F.in(I_NG) + (size_t)4 * DM + c) * (RP_LD4(m1 + DM + c) + 1.f); v2 = RP_LD4(m1 + c); } }
        LAS float* d = (LAS float*)F.lds + s * PSET_FLOATS + c;
        *(LAS f32x4*)d = v0; *(LAS f32x4*)(d + DM) = v1; *(LAS f32x4*)(d + 2 * DM) = v2;
    }
#undef RP_LD4
    __syncthreads();
}
__device__ __forceinline__ const LAS float* row_pset(Ctx& F, int r) { return (const LAS float*)F.lds + (r < NPR ? (r >> 12) : 2) * PSET_FLOATS; }
__device__ __forceinline__ void row_residual_l(Row& X, const Row& O, const LAS float* ps, int lane) {
    const float rstd = rsqrtf(row_sumsq(O) * (1.f / DM) + EPS_RMS);
#pragma unroll
    for (int j = 0; j < 8; ++j) { const f32x4 gt = *(const LAS f32x4*)(ps + j * 256 + lane * 4); X.v[j] = X.v[j] + gt * (O.v[j] * rstd); }
}
__device__ __forceinline__ void row_modulate_l(Row& H, const Row& X, const LAS float* ps, int lane) {
    const float rstd = rsqrtf(row_sumsq(X) * (1.f / DM) + EPS_RMS);
#pragma unroll
    for (int j = 0; j < 8; ++j) { const int c = j * 256 + lane * 4; const f32x4 a = *(const LAS f32x4*)(ps + DM + c), sh = *(const LAS f32x4*)(ps + 2 * DM + c); H.v[j] = X.v[j] * rstd * a + sh; }
}
__device__ __forceinline__ void phase_mod0(Ctx& F) {
    stage_row_params<0, 0>(F);
    const int gw = F.vcu * NWAVES + F.wave, NGW = F.G * NWAVES, samp = F.vcu < 8 ? NPR + F.vcu * 8 + F.wave : NTOK; bf16* Hb = WSP(bf16, WS_H);
    Row Xn; row_load(Xn, x_in_row(F, gw), F.lane);
    for (int r = gw; r < NPR; r += NGW) {
        Row X = Xn, H; const int rn = r + NGW, rp = rn < NPR ? rn : (samp < NTOK ? samp : r);
        row_load(Xn, x_in_row(F, rp), F.lane);
        row_modulate_l(H, X, row_pset(F, r), F.lane);
        row_store_bf16(H, Hb + (size_t)r * DM, F.lane);
    }
    if (samp < NTOK) { Row H; row_modulate_l(H, Xn, row_pset(F, samp), F.lane); row_store_bf16(H, Hb + (size_t)samp * DM, F.lane); }
}
__device__ __forceinline__ void row_residual(Row& X, const Row& O, const float* ga, const float* gate, int lane) {
    const float rstd = rsqrtf(row_sumsq(O) * (1.f / DM) + EPS_RMS);
#pragma unroll
    for (int j = 0; j < 8; ++j) { const int c = j * 256 + lane * 4; const f32x4 gg = *(const GAS f32x4*)(ga + c), gt = *(const GAS f32x4*)(gate + c); X.v[j] = X.v[j] + gt * (O.v[j] * rstd * gg); }
}
template <int NK> __device__ __forceinline__ void row_load_out(Ctx& F, Row& O, int r, int lane) {
    if (r < NPR) { const bf16* op = WSP(bf16, WS_OUT) + (size_t)r * DM;
#pragma unroll
        for (int j = 0; j < 8; ++j) { const u32x2 w = *(const GAS u32x2*)(op + j * 256 + lane * 4);
            O.v[j] = (f32x4){__uint_as_float(w.x << 16), __uint_as_float(w.x & 0xffff0000u), __uint_as_float(w.y << 16), __uint_as_float(w.y & 0xffff0000u)}; }
        return; }
    const float* pp = WSP(float, WS_PART) + (size_t)(r - NPR) * DM;
    row_load(O, pp, lane);
    for (int kc = 1; kc < NK; ++kc) { Row T; row_load(T, pp + (size_t)kc * 64 * DM, lane);
#pragma unroll
        for (int j = 0; j < 8; ++j) O.v[j] += T.v[j]; }
}
__device__ __forceinline__ f32x4 ld_bf4(const bf16* p) { const u32x2 w = *(const GAS u32x2*)p; return (f32x4){__uint_as_float(w.x << 16), __uint_as_float(w.x & 0xffff0000u), __uint_as_float(w.y << 16), __uint_as_float(w.y & 0xffff0000u)}; }
__device__ __forceinline__ void row_load_pool(Ctx& F, Row& O, int r, int lane) {
    if (r < NPR) { const int t = r & (SEQ - 1); const bf16* op = WSP(bf16, WS_OUT) + (size_t)r * DM + lane * 4;
#pragma unroll
        for (int j8 = 0; j8 < 8; ++j8) { constexpr int dummy = 0; (void)dummy; const int wlen = 2 << (j8 >> 1), n = (t + 1) < wlen ? (t + 1) : wlen;
            const f32x4 cur = ld_bf4(op + j8 * 256); f32x4 sum = cur;
            for (int j = 1; j < n; ++j) sum += ld_bf4(op + j8 * 256 - (size_t)j * DM);
            O.v[j8] = sum * (1.f / (float)n) - cur; }
    } else { const int rs = r - NPR, b = rs >> 3, t = rs & 7; const float* pp = WSP(float, WS_PART) + lane * 4;
#pragma unroll
        for (int j8 = 0; j8 < 8; ++j8) { const int wlen = 2 << (j8 >> 1); f32x4 cur = {0.f, 0.f, 0.f, 0.f}, sum = {0.f, 0.f, 0.f, 0.f};
            for (int j = 0; j < wlen; ++j) { const int tj = t - j, pr = tj >= 0 ? rs - j : 64 + b * PBUF + PBUF + tj;
                const f32x4 g = *(const GAS f32x4*)(pp + (size_t)pr * DM + j8 * 256) + *(const GAS f32x4*)(pp + (size_t)(256 + pr) * DM + j8 * 256);
                sum += g; if (j == 0) cur = g; }
            O.v[j8] = sum * (1.f / (float)wlen) - cur; }
    }
}
template <int L> __device__ __forceinline__ void phase_postmix(Ctx& F) {
    stage_row_params<1, L>(F);
    const int gw = F.vcu * NWAVES + F.wave, NGW = F.G * NWAVES, samp = F.vcu < 8 ? NPR + F.vcu * 8 + F.wave : NTOK;
    bf16* Hb = WSP(bf16, WS_H); bf16* XR = WSP(bf16, WS_XR); const bf16* OUTb = WSP(bf16, WS_OUT);
    Row Xf; RowB Xb, Ob;
    if (L == 0) { row_load(Xf, x_in_row(F, gw), F.lane); rowb_load(Ob, OUTb + (size_t)gw * DM, F.lane); } else rowb_load(Xb, XR + (size_t)gw * DM, F.lane);
    for (int r = gw; r < NPR; r += NGW) {
        Row X, O, H; const int rn = r + NGW, rp = rn < NPR ? rn : (samp < NTOK ? samp : r), ro = rn < NPR ? rn : r;
        if (L == 0) { X = Xf; rowb_cvt(O, Ob); row_load(Xf, x_in_row(F, rp), F.lane); rowb_load(Ob, OUTb + (size_t)ro * DM, F.lane); }
        else { rowb_cvt(X, Xb); rowb_load(Xb, XR + (size_t)rp * DM, F.lane); row_load_pool(F, O, r, F.lane); }
        const LAS float* ps = row_pset(F, r);
        row_residual_l(X, O, ps, F.lane);
        row_store_bf16(X, XR + (size_t)r * DM, F.lane);
        row_modulate_l(H, X, ps, F.lane);
        row_store_bf16(H, Hb + (size_t)r * DM, F.lane);
    }
    if (samp < NTOK) { Row X, O, H; if (L == 0) { X = Xf; row_load_out<8>(F, O, samp, F.lane); } else { rowb_cvt(X, Xb); row_load_pool(F, O, samp, F.lane); }
        const LAS float* ps = row_pset(F, samp);
        row_residual_l(X, O, ps, F.lane);
        row_store_bf16(X, XR + (size_t)samp * DM, F.lane);
        row_modulate_l(H, X, ps, F.lane);
        row_store_bf16(H, Hb + (size_t)samp * DM, F.lane); }
}
template <int L> __device__ __forceinline__ void phase_postmlp(Ctx& F) {
    stage_row_params<L == 0 ? 2 : 3, L>(F);
    const int gw = F.vcu * NWAVES + F.wave, NGW = F.G * NWAVES, samp = F.vcu < 8 ? NPR + F.vcu * 8 + F.wave : NTOK;
    bf16* XR = WSP(bf16, WS_XR); const bf16* OUTb = WSP(bf16, WS_OUT);
    RowB Xb, Ob; rowb_load(Xb, XR + (size_t)gw * DM, F.lane); rowb_load(Ob, OUTb + (size_t)gw * DM, F.lane);
    for (int r = gw; r < NPR; r += NGW) {
        Row X, O; const int rn = r + NGW, rp = rn < NPR ? rn : (samp < NTOK ? samp : r), ro = rn < NPR ? rn : r;
        rowb_cvt(X, Xb); rowb_cvt(O, Ob); rowb_load(Xb, XR + (size_t)rp * DM, F.lane); rowb_load(Ob, OUTb + (size_t)ro * DM, F.lane);
        const LAS float* ps = row_pset(F, r);
        row_residual_l(X, O, ps, F.lane);
        if (L == 0) {
            row_store_bf16(X, XR + (size_t)r * DM, F.lane);
            Row H; row_modulate_l(H, X, ps, F.lane);
            row_store_bf16(H, WSP(bf16, WS_H) + (size_t)r * DM, F.lane);
            const int t = r & (SEQ - 1); if (t >= SEQ - PBUF) row_store_f32(H, F.outp() + O_PLP + ((size_t)(r >> 12) * PBUF + (t - (SEQ - PBUF))) * DM, F.lane);
        } else row_store_f32_nt(X, F.outp() + O_YP + (size_t)r * DM, F.lane);
    }
    if (samp < NTOK) { Row X, O; rowb_cvt(X, Xb); row_load_out<32>(F, O, samp, F.lane);
        const LAS float* ps = row_pset(F, samp); const int rs = samp - NPR;
        row_residual_l(X, O, ps, F.lane);
        if (L == 0) {
            row_store_bf16(X, XR + (size_t)samp * DM, F.lane);
            Row H; row_modulate_l(H, X, ps, F.lane);
            row_store_bf16(H, WSP(bf16, WS_H) + (size_t)samp * DM, F.lane);
            row_store_f32(H, F.outp() + O_PLS + ((size_t)(rs >> 3) * PBUF + 7 + (rs & 7)) * DM, F.lane);
        } else row_store_f32_nt(X, F.outp() + O_YS + (size_t)rs * DM, F.lane); }
    if (L == 0) {
        const float* SP = F.in(I_SPOOL); bf16* Hb = WSP(bf16, WS_H);
        for (int i = F.vcu * NTHR + F.tid; i < DBAT * PBUF * 512; i += F.G * NTHR) { const int c4 = (i & 511) * 4, bi = i >> 9, b = bi / PBUF, k = bi - b * PBUF;
            const f32x4 v = *(const GAS f32x4*)(SP + (size_t)bi * DM + c4); u32x2 w; w.x = cvt_pk_bf16(v.x, v.y); w.y = cvt_pk_bf16(v.z, v.w);
            *(GAS u32x2*)(Hb + (size_t)(NTOK + bi) * DM + c4) = w;
            if (k >= 8) *(GAS f32x4*)(F.outp() + O_PLS + ((size_t)b * PBUF + (k - 8)) * DM + c4) = v; }
    }
}

__device__ __forceinline__ void phase_kv_prep(Ctx& F) {
    { const float* MODP = WSP(float, WS_G); float* MOD = WSP(float, WS_MOD);
      for (int i = F.vcu * NTHR + F.tid; i < NMR * 8192; i += F.G * NTHR) { const int r = i >> 13, c = i & 8191; MOD[(size_t)(1 * NMR + r) * 12288 + 4096 + c] = MODP[(size_t)r * 8192 + c] + MODP[((size_t)NMR + r) * 8192 + c]; } }
    const float* P = WSP(float, WS_P);
    for (int i = F.vcu * NTHR + F.tid; i < (NBATCH + DBAT) * BCOLS; i += F.G * NTHR) {
        const int b = i / BCOLS, c = i - b * BCOLS; const int r = b < NBATCH ? b * SEQ + SEQ - 1 : NPR + (b - NBATCH) * DSEQ + DSEQ - 1;
        F.outp()[(b < NBATCH ? O_SHP + (size_t)b * BCOLS : O_SHS + (size_t)(b - NBATCH) * BCOLS) + c] = (b < NBATCH && c < 3072) ? ldbf(WSP(bf16, WS_PBH) + (size_t)r * 3072 + c) : P[(size_t)r * PBLD + c];
    }
    { const int gw = F.vcu * NWAVES + F.wave, NGW = F.G * NWAVES; const float* mu = F.in(I_MU); bf16* LA = WSP(bf16, WS_LA);
      for (int r = gw; r < NTOK; r += NGW) {
        const float* pb = P + (size_t)r * PBLD; const float* prev; bool hp;
        if (r < NPR) { const int t = r & (SEQ - 1); hp = t > 0; prev = pb - PBLD; }
        else { const int rs = r - NPR, b = rs >> 3, t = rs & 7; hp = true; prev = t > 0 ? pb - PBLD : F.in(I_SSH) + (size_t)b * BCOLS; }
        float v[8];
        { const int c0 = 3072 + F.lane * 8; const bool act = F.lane < 56; const f32x4 z4 = {0.f, 0.f, 0.f, 0.f};
          f32x4 pa = z4, pc = z4, qa = z4, qc = z4, ma = z4, mc = z4;
          if (act) { pa = *(const GAS f32x4*)(pb + c0); pc = *(const GAS f32x4*)(pb + c0 + 4); ma = *(const GAS f32x4*)(mu + c0); mc = *(const GAS f32x4*)(mu + c0 + 4);
                     if (hp) { qa = *(const GAS f32x4*)(prev + c0); qc = *(const GAS f32x4*)(prev + c0 + 4); } }
          const f32x4 za = pa + ma * (qa - pa), zc = pc + mc * (qc - pc);
          const float kz = F.lane < 12 ? 2.f : 1.f;
#pragma unroll
          for (int j = 0; j < 8; ++j) { const float z = j < 4 ? za[j & 3] : zc[j & 3]; const float sg = 1.f / (1.f + __expf(-kz * z));
              v[j] = !act ? 0.f : (F.lane < 12 ? 2.f * sg - 1.f : (F.lane < 24 ? z : sg)); } }
        u32x4 o; o.x = cvt_pk_bf16(v[0], v[1]); o.y = cvt_pk_bf16(v[2], v[3]); o.z = cvt_pk_bf16(v[4], v[5]); o.w = cvt_pk_bf16(v[6], v[7]);
        *(GAS u32x4*)(LA + (size_t)r * 512 + F.lane * 8) = o;
      } }
}
__device__ __forceinline__ void phase_rwkv_prep(Ctx& F) {
    const float* P = WSP(float, WS_P); const float* LWO = WSP(float, WS_LWO);
    const int gw = F.vcu * NWAVES + F.wave, NGW = F.G * NWAVES;
    float* RWV = WSP(float, WS_RWV); float* SCL = WSP(float, WS_SCL);
    const float* mu = F.in(I_MU);
    for (int u = gw; u < NSM * 4; u += NGW) {
        const int r = NPR + (u >> 2), hq = u & 3;
        const float* pb = P + (size_t)r * PBLD; const float* prev; const bool hp = true;
        { const int rs = r - NPR, b = rs >> 3, t = rs & 7; prev = t > 0 ? pb - PBLD : F.in(I_SSH) + (size_t)b * BCOLS; }
        const float* lw = LWO + (size_t)r * 3072;
        float pr[4], pk[4], pv[4], qr_[4], qk[4], qv[4], lwl[4], lal[4], lgl[4];
#pragma unroll
        for (int i = 0; i < 4; ++i) { const int col = (hq * 4 + i) * 64 + F.lane;
            pr[i] = pb[col]; pk[i] = pb[1024 + col]; pv[i] = pb[2048 + col];
            qr_[i] = hp ? prev[col] : 0.f; qk[i] = hp ? prev[1024 + col] : 0.f; qv[i] = hp ? prev[2048 + col] : 0.f;
            lwl[i] = lw[col]; lal[i] = lw[1024 + col]; lgl[i] = lw[2048 + col]; }
#pragma unroll
        for (int i = 0; i < 4; ++i) { const int h = hq * 4 + i, col = h * 64 + F.lane;
            const float zr = pr[i] + mu[col] * (qr_[i] - pr[i]), zk = pk[i] + mu[1024 + col] * (qk[i] - pk[i]), zv = pv[i] + mu[2048 + col] * (qv[i] - pv[i]);
            const float wl = F.in(I_W0)[col] + lwl[i], al = F.in(I_A0)[col] + lal[i], gl = lgl[i];
            const float wlog = -softplusf_(-wl) - 0.5f, decay = __expf(-__expf(wlog));
            const float a = sigmoidf_(al);
            const float kkr = zk * F.in(I_KK)[col], kk = kkr * rsqrtf(wave_sum(kkr * kkr) + 1e-12f);
            const float k = zk * (1.f + (a - 1.f) * F.in(I_KA)[col]);
            const float bb = kk * a;
            const float bonus = wave_sum(zr * k * F.in(I_RK)[col]), beta = wave_sum(bb * zr), kappa = wave_sum(k * zr);
            float* base = RWV + ((size_t)r * HB + h) * 512;
            base[F.lane] = decay; base[64 + F.lane] = kk; base[128 + F.lane] = bb; base[192 + F.lane] = k; base[256 + F.lane] = zr; base[320 + F.lane] = zv; base[384 + F.lane] = decay * zr;
            if (F.lane == 0) { float* s_ = SCL + ((size_t)r * HB + h) * 4; s_[0] = beta; s_[1] = kappa; s_[2] = bonus; s_[3] = 0.f; }
        }
    }
}

namespace sba {
typedef short bf16x8 __attribute__((ext_vector_type(8)));
typedef short s16x4 __attribute__((ext_vector_type(4)));
typedef float f32x16 __attribute__((ext_vector_type(16)));
constexpr int SHM = 16384, LDQ = 1024;
#define SB_KSWZ(row, colB) ((row) * 256 + ((colB) ^ (((row) & 7) << 4)))
#define SB_SBAR() __builtin_amdgcn_sched_barrier(0)
__device__ __forceinline__ int v_st(int k, int c) { const int kk = (k & ~0xC) | ((k & 4) << 1) | ((k & 8) >> 1); return ((kk >> 3) * 4 + (c >> 5)) * 512 + ((kk & 7) * 32 + (c & 31)) * 2; }
__device__ __forceinline__ int v_rd_base(int lane) { return ((lane & 3) << 3) | (((lane >> 2) & 3) << 6) | (((lane >> 4) & 1) << 5) | (((lane >> 5) & 1) << 8); }
__device__ __forceinline__ int crow(int r, int hi) { return (r & 3) + 8 * (r >> 2) + 4 * hi; }
__device__ __forceinline__ void qkt(f32x16& p0, f32x16& p1, const char* Kt, int r32, int hi, const bf16x8* qr) {
    p0 = f32x16{}; p1 = f32x16{};
    const char* kb[4];
#pragma unroll
    for (int dd = 0; dd < 4; ++dd) kb[dd] = Kt + SB_KSWZ(r32, (dd * 16 + hi * 8) * 2);
#pragma unroll
    for (int d0 = 0; d0 < 8; ++d0) { const char* a = kb[d0 & 3] + (d0 >> 2) * 128;
        const bf16x8 b0 = *reinterpret_cast<const bf16x8*>(a);
        const bf16x8 b1 = *reinterpret_cast<const bf16x8*>(a + 32 * 256);
        p0 = __builtin_amdgcn_mfma_f32_32x32x16_bf16(b0, qr[d0], p0, 0, 0, 0);
        p1 = __builtin_amdgcn_mfma_f32_32x32x16_bf16(b1, qr[d0], p1, 0, 0, 0); }
}
__device__ __forceinline__ void pv_tile(f32x16* o, int vb0, bf16x8 pa0, bf16x8 pa1, bf16x8 pa2, bf16x8 pa3) {
#define SB_TRRD(dst, off) asm volatile("ds_read_b64_tr_b16 %0, %1 offset:%2" : "=&v"(dst) : "v"(vb0), "i"(off) : "memory")
#define SB_PV_D0(d0) do { s16x4 l0, l1, l2, l3, h0, h1, h2, h3; constexpr int b_ = (d0) * 512; \
        SB_TRRD(l0, b_); SB_TRRD(h0, b_ + 2048); SB_TRRD(l1, b_ + 4096); SB_TRRD(h1, b_ + 6144); SB_TRRD(l2, b_ + 8192); SB_TRRD(h2, b_ + 10240); SB_TRRD(l3, b_ + 12288); SB_TRRD(h3, b_ + 14336); \
        asm volatile("s_waitcnt lgkmcnt(0)" ::: "memory"); SB_SBAR(); \
        o[d0] = __builtin_amdgcn_mfma_f32_32x32x16_bf16(pa0, (bf16x8){l0[0], l0[1], l0[2], l0[3], h0[0], h0[1], h0[2], h0[3]}, o[d0], 0, 0, 0); \
        o[d0] = __builtin_amdgcn_mfma_f32_32x32x16_bf16(pa1, (bf16x8){l1[0], l1[1], l1[2], l1[3], h1[0], h1[1], h1[2], h1[3]}, o[d0], 0, 0, 0); \
        o[d0] = __builtin_amdgcn_mfma_f32_32x32x16_bf16(pa2, (bf16x8){l2[0], l2[1], l2[2], l2[3], h2[0], h2[1], h2[2], h2[3]}, o[d0], 0, 0, 0); \
        o[d0] = __builtin_amdgcn_mfma_f32_32x32x16_bf16(pa3, (bf16x8){l3[0], l3[1], l3[2], l3[3], h3[0], h3[1], h3[2], h3[3]}, o[d0], 0, 0, 0); } while (0)
    SB_PV_D0(0); SB_PV_D0(1); SB_PV_D0(2); SB_PV_D0(3);
#undef SB_PV_D0
#undef SB_TRRD
}
__device__ __forceinline__ float swap_other(float x, int hi) {
    auto rr = __builtin_amdgcn_permlane32_swap(__float_as_uint(x), __float_as_uint(x), false, false);
    return __uint_as_float(hi ? rr[0] : rr[1]);
}
template <bool MASK> __device__ __forceinline__ void sb_weights(f32x16& p0, f32x16& p1, float& carry, float C2, float b2, int dq, int hi) {
    float T[8];
#pragma unroll
    for (int g = 0; g < 8; ++g) {
        float iv[4], be[4];
#pragma unroll
        for (int k = 0; k < 4; ++k) { const int r = (g & 3) * 4 + k; const float s = g < 4 ? p0[r] : p1[r];
            const float z2 = fminf(fmaf(s, C2, b2), 64.f), e = __builtin_amdgcn_exp2f(z2), i_ = __builtin_amdgcn_rcpf(1.f + e); float b_ = e * i_, ii = i_;
            if (MASK) { const int c = (r & 3) + 8 * (r >> 2) + (g < 4 ? 0 : 32); const bool vis = c < dq; ii = vis ? ii : 1.f; b_ = vis ? b_ : 0.f; }
            iv[k] = ii; be[k] = b_; }
        const float ex2 = iv[3], ex1 = iv[2] * iv[3], ex0 = iv[1] * ex1; T[g] = iv[0] * ex0;
        const float w0 = be[0] * ex0, w1 = be[1] * ex1, w2 = be[2] * ex2, w3 = be[3];
        if (g < 4) { p0[(g & 3) * 4 + 0] = w0; p0[(g & 3) * 4 + 1] = w1; p0[(g & 3) * 4 + 2] = w2; p0[(g & 3) * 4 + 3] = w3; }
        else { p1[(g & 3) * 4 + 0] = w0; p1[(g & 3) * 4 + 1] = w1; p1[(g & 3) * 4 + 2] = w2; p1[(g & 3) * 4 + 3] = w3; }
    }
    float suf = carry;
#pragma unroll
    for (int g = 7; g >= 0; --g) {
        const float To = swap_other(T[g], hi);
        const float E = hi ? suf : suf * To;
#pragma unroll
        for (int k = 0; k < 4; ++k) { if (g < 4) p0[(g & 3) * 4 + k] *= E; else p1[(g & 3) * 4 + k] *= E; }
        suf = suf * (T[g] * To);
    }
    carry = suf;
}
__device__ __forceinline__ void pack_p(const f32x16& p0, const f32x16& p1, bf16x8& pa0, bf16x8& pa1, bf16x8& pa2, bf16x8& pa3) {
#define SB_PK4(P, B_, OUT) do { unsigned a0 = cvt_pk_bf16(P[B_ + 0], P[B_ + 1]), a1 = cvt_pk_bf16(P[B_ + 2], P[B_ + 3]); \
        unsigned b0 = cvt_pk_bf16(P[B_ + 4], P[B_ + 5]), b1 = cvt_pk_bf16(P[B_ + 6], P[B_ + 7]); \
        auto r0 = __builtin_amdgcn_permlane32_swap(a0, b0, false, false); auto r1 = __builtin_amdgcn_permlane32_swap(a1, b1, false, false); \
        u32x4 w = {r0[0], r1[0], r0[1], r1[1]}; OUT = *reinterpret_cast<bf16x8*>(&w); } while (0)
    SB_PK4(p0, 0, pa0); SB_PK4(p0, 8, pa1); SB_PK4(p1, 0, pa2); SB_PK4(p1, 8, pa3);
#undef SB_PK4
}
__device__ __forceinline__ void attn_half(Ctx& F, int bh, int x, int half) {
    const int tid = F.tid, wid = F.wave, lane = F.lane, r32 = lane & 31, hi = lane >> 5, b = bh >> 3, h = bh & 7;
    const bf16* Qg = WSP(bf16, WS_QB) + (size_t)(b * SEQ + 256 * x) * LDQ + h * 128;
    const bf16* Kg = WSP(bf16, WS_KB) + (size_t)(b * SEQ) * LDQ + h * 128; const bf16* Vg = WSP(bf16, WS_VB) + (size_t)(b * SEQ) * LDQ + h * 128;
    const int NT = 4 * (x + 1), t_hi = half == 0 ? NT : NT / 2, t_lo = half == 0 ? NT / 2 : 0;
    const int qlo = 256 * x + 32 * wid, qpos = qlo + r32;
    char* V_lds = (char*)F.lds; char* K_lds = (char*)F.lds + 2 * SHM;
    bf16x8 qr[8];
#pragma unroll
    for (int d0 = 0; d0 < 8; ++d0) qr[d0] = *reinterpret_cast<const bf16x8*>(Qg + (size_t)(wid * 32 + r32) * LDQ + d0 * 16 + hi * 8);
    const int sr = tid >> 4, sc = (tid & 15) * 8, vst0 = v_st(sr, sc), vst1 = v_st(32 + sr, sc), kws = SB_KSWZ(sr, sc * 2);
    const int vb0 = (int)(uintptr_t)V_lds + v_rd_base(lane);
    bf16x8 st_k0, st_k1, st_v0, st_v1;
    const unsigned so0 = (unsigned)(sr * LDQ + sc) * 2u, so1 = so0 + 32u * LDQ * 2u;
#define SB_SLOAD(t) do { const char* kt_ = (const char*)Kg + (size_t)(t) * (64 * LDQ * 2); const char* vt_ = (const char*)Vg + (size_t)(t) * (64 * LDQ * 2); \
        st_k0 = *reinterpret_cast<const bf16x8*>(kt_ + so0); st_k1 = *reinterpret_cast<const bf16x8*>(kt_ + so1); st_v0 = *reinterpret_cast<const bf16x8*>(vt_ + so0); st_v1 = *reinterpret_cast<const bf16x8*>(vt_ + so1); } while (0)
#define SB_SWRITE(bf) do { *(bf16x8*)(K_lds + (bf) * SHM + kws) = st_k0; *(bf16x8*)(K_lds + (bf) * SHM + kws + 32 * 256) = st_k1; \
        *(bf16x8*)(V_lds + (bf) * SHM + vst0) = st_v0; *(bf16x8*)(V_lds + (bf) * SHM + vst1) = st_v1; } while (0)
    __syncthreads();
    SB_SLOAD(t_hi - 1); VM_WAIT(); SB_SWRITE(0);
    __syncthreads();
    const float C2 = QK_SCALE * 1.4426950408889634f, b2 = F.in(I_SBB)[h] * 1.4426950408889634f;
    float carry = 1.f; f32x16 o[4] = {};
    int buf = 0;
    for (int t = t_hi - 1; t >= t_lo; --t) {
        if (t > t_lo) SB_SLOAD(t - 1);
        const int kb = 64 * t;
        if (kb < qlo + 31) {
            f32x16 p0, p1; bf16x8 pa0, pa1, pa2, pa3;
            qkt(p0, p1, K_lds + buf * SHM, r32, hi, qr);
            if (kb + 63 >= qlo) sb_weights<true>(p0, p1, carry, C2, b2, qpos - kb - 4 * hi, hi); else sb_weights<false>(p0, p1, carry, C2, b2, 0, hi);
            pack_p(p0, p1, pa0, pa1, pa2, pa3);
            pv_tile(o, vb0 + buf * SHM, pa0, pa1, pa2, pa3);
        }
        if (t > t_lo) { VM_WAIT(); SB_SWRITE(buf ^ 1); }
        __syncthreads();
        buf ^= 1;
    }
#undef SB_SLOAD
#undef SB_SWRITE
    float* Op = WSP(float, WS_OP) + ((size_t)half * NPR + b * SEQ + 256 * x + wid * 32) * 1024 + h * 128;
    const unsigned lo_ = (unsigned)(4 * hi * 1024 + r32);
#pragma unroll
    for (int r = 0; r < 16; ++r) { float* Opr = Op + (size_t)((r & 3) + 8 * (r >> 2)) * 1024;
#pragma unroll
        for (int d0 = 0; d0 < 4; ++d0) Opr[lo_ + d0 * 32] = o[d0][r]; }
    if (half == 0 && hi == 0) WSP(float, WS_CL)[(size_t)(b * SEQ + qpos) * HA + h] = carry;
}
#undef SB_KSWZ
#undef SB_SBAR
}
namespace sba {
__device__ __forceinline__ void sb_weights32(f32x16& p0, float& carry, float C2, float b2, int hi) {
    float T[4];
#pragma unroll
    for (int g = 0; g < 4; ++g) {
        float iv[4], be[4];
#pragma unroll
        for (int k = 0; k < 4; ++k) { const float z2 = fminf(fmaf(p0[g * 4 + k], C2, b2), 64.f), e = __builtin_amdgcn_exp2f(z2), i_ = __builtin_amdgcn_rcpf(1.f + e); iv[k] = i_; be[k] = e * i_; }
        const float ex2 = iv[3], ex1 = iv[2] * iv[3], ex0 = iv[1] * ex1; T[g] = iv[0] * ex0;
        p0[g * 4 + 0] = be[0] * ex0; p0[g * 4 + 1] = be[1] * ex1; p0[g * 4 + 2] = be[2] * ex2; p0[g * 4 + 3] = be[3];
    }
    float suf = carry;
#pragma unroll
    for (int g = 3; g >= 0; --g) { const float To = swap_other(T[g], hi); const float E = hi ? suf : suf * To;
#pragma unroll
        for (int k = 0; k < 4; ++k) p0[g * 4 + k] *= E;
        suf = suf * (T[g] * To); }
    carry = suf;
}
__device__ __forceinline__ void attn_sample_unit(Ctx& F, int bh, int pg, char* wl  ) {
    const int lane = F.lane, r32 = lane & 31, hi = lane >> 5, b = bh >> 3, h = bh & 7;
    char* K_lds = wl; char* V_lds = wl + 8192;
    bf16x8 qr[8];
    { const bf16* Qg = WSP(bf16, WS_QB) + (size_t)(NPR + b * DSEQ + (r32 & 7)) * LDQ + h * 128;
#pragma unroll
      for (int d0 = 0; d0 < 8; ++d0) { bf16x8 v = *reinterpret_cast<const bf16x8*>(Qg + d0 * 16 + hi * 8); if (r32 >= 8) v = bf16x8{}; qr[d0] = v; } }
    const int kl = lane >> 5, c4 = (lane & 31) * 4;
    const unsigned goff = (unsigned)(kl * 1024 + c4) * 4u;
    const int vb0 = (int)(uintptr_t)V_lds + v_rd_base(lane);
    const float C2 = QK_SCALE * 1.4426950408889634f, b2 = F.in(I_SBB)[h] * 1.4426950408889634f;
    const int* pt = ((const int*)F.in(I_PT)) + b * NPAGES + pg * 4;
    f32x4 sa[8], sb[8];
#define SU_BASE(n) ({ const int i_ = (n) >> 2, k_ = (n) & 3, tt_ = 15 - i_; const int phys_ = pt[tt_ >> 2]; \
        (const char*)((k_ & 2) ? F.in(I_CV) : F.in(I_CK)) + (((size_t)phys_ * PAGESZ + (tt_ & 3) * 32 + (k_ & 1) * 16) * 1024 + h * 128) * 4; })
#define SU_LOAD(S, n) do { const char* bp_ = SU_BASE(n); _Pragma("unroll") for (int j = 0; j < 8; ++j) S[j] = __builtin_nontemporal_load((const GAS f32x4*)(bp_ + goff + (size_t)j * 8192)); } while (0)
#define SU_WRK(S, kh) do { _Pragma("unroll") for (int j = 0; j < 8; ++j) { const int key = (kh) * 16 + 2 * j + kl; u32x2 w; w.x = cvt_pk_bf16(S[j].x, S[j].y); w.y = cvt_pk_bf16(S[j].z, S[j].w); \
        *(u32x2*)(K_lds + (key * 256 + ((c4 * 2) ^ ((key & 7) << 4)))) = w; } } while (0)
#define SU_WRV(S, kh) do { _Pragma("unroll") for (int j = 0; j < 8; ++j) { const int key = (kh) * 16 + 2 * j + kl; u32x2 w; w.x = cvt_pk_bf16(S[j].x, S[j].y); w.y = cvt_pk_bf16(S[j].z, S[j].w); \
        *(u32x2*)(V_lds + v_st(key, c4)) = w; } } while (0)
    SU_LOAD(sa, 0); SU_LOAD(sb, 1);
    float carry = 1.f; f32x16 o[4] = {};
    for (int i = 0; i < 16; ++i) {
        asm volatile("s_waitcnt vmcnt(8)" ::: "memory"); SU_WRK(sa, 0); SU_LOAD(sa, 4 * i + 2);
        asm volatile("s_waitcnt vmcnt(8)" ::: "memory"); SU_WRK(sb, 1); SU_LOAD(sb, 4 * i + 3);
        asm volatile("s_waitcnt vmcnt(8)" ::: "memory"); SU_WRV(sa, 0); if (i < 15) SU_LOAD(sa, 4 * i + 4);
        if (i < 15) asm volatile("s_waitcnt vmcnt(8)" ::: "memory"); else asm volatile("s_waitcnt vmcnt(0)" ::: "memory");
        SU_WRV(sb, 1); if (i < 15) SU_LOAD(sb, 4 * i + 5);
        asm volatile("s_waitcnt lgkmcnt(0)" ::: "memory");
        f32x16 p0 = f32x16{};
        { const char* kb[4];
#pragma unroll
          for (int dd = 0; dd < 4; ++dd) kb[dd] = K_lds + (r32 * 256 + (((dd * 16 + hi * 8) * 2) ^ ((r32 & 7) << 4)));
#pragma unroll
          for (int d0 = 0; d0 < 8; ++d0) { const bf16x8 b0 = *reinterpret_cast<const bf16x8*>(kb[d0 & 3] + (d0 >> 2) * 128); p0 = __builtin_amdgcn_mfma_f32_32x32x16_bf16(b0, qr[d0], p0, 0, 0, 0); } }
        sb_weights32(p0, carry, C2, b2, hi);
        bf16x8 pa0, pa1;
        { unsigned a0 = cvt_pk_bf16(p0[0], p0[1]), a1 = cvt_pk_bf16(p0[2], p0[3]), b0 = cvt_pk_bf16(p0[4], p0[5]), b1 = cvt_pk_bf16(p0[6], p0[7]);
          auto r0 = __builtin_amdgcn_permlane32_swap(a0, b0, false, false); auto r1 = __builtin_amdgcn_permlane32_swap(a1, b1, false, false);
          u32x4 w = {r0[0], r1[0], r0[1], r1[1]}; pa0 = *reinterpret_cast<bf16x8*>(&w); }
        { unsigned a0 = cvt_pk_bf16(p0[8], p0[9]), a1 = cvt_pk_bf16(p0[10], p0[11]), b0 = cvt_pk_bf16(p0[12], p0[13]), b1 = cvt_pk_bf16(p0[14], p0[15]);
          auto r0 = __builtin_amdgcn_permlane32_swap(a0, b0, false, false); auto r1 = __builtin_amdgcn_permlane32_swap(a1, b1, false, false);
          u32x4 w = {r0[0], r1[0], r0[1], r1[1]}; pa1 = *reinterpret_cast<bf16x8*>(&w); }
#define SU_TRRD(dst, off) asm volatile("ds_read_b64_tr_b16 %0, %1 offset:%2" : "=&v"(dst) : "v"(vb0), "i"(off) : "memory")
#define SU_PV(d0) do { s16x4 l0, l1, h0, h1; constexpr int b_ = (d0) * 512; SU_TRRD(l0, b_); SU_TRRD(h0, b_ + 2048); SU_TRRD(l1, b_ + 4096); SU_TRRD(h1, b_ + 6144); \
        asm volatile("s_waitcnt lgkmcnt(0)" ::: "memory"); __builtin_amdgcn_sched_barrier(0); \
        o[d0] = __builtin_amdgcn_mfma_f32_32x32x16_bf16(pa0, (bf16x8){l0[0], l0[1], l0[2], l0[3], h0[0], h0[1], h0[2], h0[3]}, o[d0], 0, 0, 0); \
        o[d0] = __builtin_amdgcn_mfma_f32_32x32x16_bf16(pa1, (bf16x8){l1[0], l1[1], l1[2], l1[3], h1[0], h1[1], h1[2], h1[3]}, o[d0], 0, 0, 0); } while (0)
        SU_PV(0); SU_PV(1); SU_PV(2); SU_PV(3);
        asm volatile("s_waitcnt lgkmcnt(0)" ::: "memory");
    }
#undef SU_PV
#undef SU_TRRD
#undef SU_WRV
#undef SU_WRK
#undef SU_LOAD
#undef SU_BASE
    float* Sp = WSP(float, WS_SPART) + ((size_t)(bh * 32 + pg) * 8) * 128;
#pragma unroll
    for (int r = 0; r < 4; ++r)
#pragma unroll
        for (int d0 = 0; d0 < 4; ++d0) Sp[(size_t)(r + 4 * hi) * 128 + d0 * 32 + r32] = o[d0][r];
    if (hi == 0 && r32 < 8) WSP(float, WS_SCAR)[(size_t)(bh * 32 + pg) * 8 + r32] = carry;
}
}
__device__ __forceinline__ void sample_combine(Ctx& F) {
    const int gw = F.vcu * NWAVES + F.wave, NGW = F.G * NWAVES; bf16* OAB = WSP(bf16, WS_OAB);
    const float* SPt = WSP(float, WS_SPART); const float* SCr = WSP(float, WS_SCAR);
    for (int task = gw; task < DBAT * HA * DSEQ; task += NGW) { const int bh = task >> 3, i = task & 7, b = bh >> 3, h = bh & 7; const float bias = F.in(I_SBB)[h];
        f32x2 po[32]; float sc[32];
#pragma unroll
        for (int pg = 0; pg < 32; ++pg) { po[pg] = *(const GAS f32x2*)(SPt + ((size_t)(bh * 32 + pg) * 8 + i) * 128 + 2 * F.lane); sc[pg] = SCr[(size_t)(bh * 32 + pg) * 8 + i]; }
        f32x2 q; { const unsigned qw = *(const GAS unsigned*)(WSP(bf16, WS_QB) + (size_t)(NPR + b * DSEQ + i) * 1024 + h * 128 + 2 * F.lane); q.x = __uint_as_float(qw << 16); q.y = __uint_as_float(qw & 0xffff0000u); }
        float carry = 1.f, a0 = 0.f, a1 = 0.f;
        for (int j = i - 1; j >= 0; --j) { const size_t ko = (size_t)(b * DSEQ + j) * 1024 + h * 128 + 2 * F.lane; const f32x2 k = *(const GAS f32x2*)(F.outp() + O_KS + ko), v = *(const GAS f32x2*)(F.outp() + O_VS + ko);
            const float z = wave_sum(q.x * k.x + q.y * k.y) * QK_SCALE + bias, e = __expf(fminf(z, 40.f)), om = 1.f / (1.f + e), w = e * om * carry;
            a0 += w * v.x; a1 += w * v.y; carry *= om; }
#pragma unroll
        for (int pg = 31; pg >= 0; --pg) { a0 += carry * po[pg].x; a1 += carry * po[pg].y; carry *= sc[pg]; }
        *(GAS unsigned*)(OAB + (size_t)(NPR + b * DSEQ + i) * DM + h * 128 + 2 * F.lane) = cvt_pk_bf16(a0, a1);
    }
}
__device__ __forceinline__ void phase_attn_prompt(Ctx& F) {
    for (int it2 = 2 * F.vcu; it2 < 2 * NBATCH * HA * 16; it2 += (it2 & 1) ? 2 * F.G - 1 : 1) { const int item = it2 >> 1, half = it2 & 1, bh = item >> 4, x = item & 15;
        sba::attn_half(F, bh, half ? 15 - x : x, half); }
    __syncthreads();
}
__device__ __forceinline__ void dots16(float& sig, float& rho, float kkv, float wrv, const float (&s)[16]) {
    asm("s_nop 1\n\t"
        "v_fmac_f32_dpp %0, %2, %4 row_newbcast:0 row_mask:0xf bank_mask:0xf\n\t"
        "v_fmac_f32_dpp %1, %3, %4 row_newbcast:0 row_mask:0xf bank_mask:0xf\n\t"
        "v_fmac_f32_dpp %0, %2, %5 row_newbcast:1 row_mask:0xf bank_mask:0xf\n\t"
        "v_fmac_f32_dpp %1, %3, %5 row_newbcast:1 row_mask:0xf bank_mask:0xf\n\t"
        "v_fmac_f32_dpp %0, %2, %6 row_newbcast:2 row_mask:0xf bank_mask:0xf\n\t"
        "v_fmac_f32_dpp %1, %3, %6 row_newbcast:2 row_mask:0xf bank_mask:0xf\n\t"
        "v_fmac_f32_dpp %0, %2, %7 row_newbcast:3 row_mask:0xf bank_mask:0xf\n\t"
        "v_fmac_f32_dpp %1, %3, %7 row_newbcast:3 row_mask:0xf bank_mask:0xf\n\t"
        "v_fmac_f32_dpp %0, %2, %8 row_newbcast:4 row_mask:0xf bank_mask:0xf\n\t"
        "v_fmac_f32_dpp %1, %3, %8 row_newbcast:4 row_mask:0xf bank_mask:0xf\n\t"
        "v_fmac_f32_dpp %0, %2, %9 row_newbcast:5 row_mask:0xf bank_mask:0xf\n\t"
        "v_fmac_f32_dpp %1, %3, %9 row_newbcast:5 row_mask:0xf bank_mask:0xf\n\t"
        "v_fmac_f32_dpp %0, %2, %10 row_newbcast:6 row_mask:0xf bank_mask:0xf\n\t"
        "v_fmac_f32_dpp %1, %3, %10 row_newbcast:6 row_mask:0xf bank_mask:0xf\n\t"
        "v_fmac_f32_dpp %0, %2, %11 row_newbcast:7 row_mask:0xf bank_mask:0xf\n\t"
        "v_fmac_f32_dpp %1, %3, %11 row_newbcast:7 row_mask:0xf bank_mask:0xf\n\t"
        "v_fmac_f32_dpp %0, %2, %12 row_newbcast:8 row_mask:0xf bank_mask:0xf\n\t"
        "v_fmac_f32_dpp %1, %3, %12 row_newbcast:8 row_mask:0xf bank_mask:0xf\n\t"
        "v_fmac_f32_dpp %0, %2, %13 row_newbcast:9 row_mask:0xf bank_mask:0xf\n\t"
        "v_fmac_f32_dpp %1, %3, %13 row_newbcast:9 row_mask:0xf bank_mask:0xf\n\t"
        "v_fmac_f32_dpp %0, %2, %14 row_newbcast:10 row_mask:0xf bank_mask:0xf\n\t"
        "v_fmac_f32_dpp %1, %3, %14 row_newbcast:10 row_mask:0xf bank_mask:0xf\n\t"
        "v_fmac_f32_dpp %0, %2, %15 row_newbcast:11 row_mask:0xf bank_mask:0xf\n\t"
        "v_fmac_f32_dpp %1, %3, %15 row_newbcast:11 row_mask:0xf bank_mask:0xf\n\t"
        "v_fmac_f32_dpp %0, %2, %16 row_newbcast:12 row_mask:0xf bank_mask:0xf\n\t"
        "v_fmac_f32_dpp %1, %3, %16 row_newbcast:12 row_mask:0xf bank_mask:0xf\n\t"
        "v_fmac_f32_dpp %0, %2, %17 row_newbcast:13 row_mask:0xf bank_mask:0xf\n\t"
        "v_fmac_f32_dpp %1, %3, %17 row_newbcast:13 row_mask:0xf bank_mask:0xf\n\t"
        "v_fmac_f32_dpp %0, %2, %18 row_newbcast:14 row_mask:0xf bank_mask:0xf\n\t"
        "v_fmac_f32_dpp %1, %3, %18 row_newbcast:14 row_mask:0xf bank_mask:0xf\n\t"
        "v_fmac_f32_dpp %0, %2, %19 row_newbcast:15 row_mask:0xf bank_mask:0xf\n\t"
        "v_fmac_f32_dpp %1, %3, %19 row_newbcast:15 row_mask:0xf bank_mask:0xf\n\t"
        "s_nop 1"
        : "+v"(sig), "+v"(rho) : "v"(kkv), "v"(wrv), "v"(s[0]), "v"(s[1]), "v"(s[2]), "v"(s[3]), "v"(s[4]), "v"(s[5]), "v"(s[6]), "v"(s[7]), "v"(s[8]), "v"(s[9]), "v"(s[10]), "v"(s[11]), "v"(s[12]), "v"(s[13]), "v"(s[14]), "v"(s[15]));
}
__device__ __forceinline__ void dot16(float& acc, float zv, const float (&s)[16]) {
    asm("s_nop 1\n\t"
        "v_fmac_f32_dpp %0, %1, %2 row_newbcast:0 row_mask:0xf bank_mask:0xf\n\t"
        "v_fmac_f32_dpp %0, %1, %3 row_newbcast:1 row_mask:0xf bank_mask:0xf\n\t"
        "v_fmac_f32_dpp %0, %1, %4 row_newbcast:2 row_mask:0xf bank_mask:0xf\n\t"
        "v_fmac_f32_dpp %0, %1, %5 row_newbcast:3 row_mask:0xf bank_mask:0xf\n\t"
        "v_fmac_f32_dpp %0, %1, %6 row_newbcast:4 row_mask:0xf bank_mask:0xf\n\t"
        "v_fmac_f32_dpp %0, %1, %7 row_newbcast:5 row_mask:0xf bank_mask:0xf\n\t"
        "v_fmac_f32_dpp %0, %1, %8 row_newbcast:6 row_mask:0xf bank_mask:0xf\n\t"
        "v_fmac_f32_dpp %0, %1, %9 row_newbcast:7 row_mask:0xf bank_mask:0xf\n\t"
        "v_fmac_f32_dpp %0, %1, %10 row_newbcast:8 row_mask:0xf bank_mask:0xf\n\t"
        "v_fmac_f32_dpp %0, %1, %11 row_newbcast:9 row_mask:0xf bank_mask:0xf\n\t"
        "v_fmac_f32_dpp %0, %1, %12 row_newbcast:10 row_mask:0xf bank_mask:0xf\n\t"
        "v_fmac_f32_dpp %0, %1, %13 row_newbcast:11 row_mask:0xf bank_mask:0xf\n\t"
        "v_fmac_f32_dpp %0, %1, %14 row_newbcast:12 row_mask:0xf bank_mask:0xf\n\t"
        "v_fmac_f32_dpp %0, %1, %15 row_newbcast:13 row_mask:0xf bank_mask:0xf\n\t"
        "v_fmac_f32_dpp %0, %1, %16 row_newbcast:14 row_mask:0xf bank_mask:0xf\n\t"
        "v_fmac_f32_dpp %0, %1, %17 row_newbcast:15 row_mask:0xf bank_mask:0xf\n\t"
        "s_nop 1"
        : "+v"(acc) : "v"(zv), "v"(s[0]), "v"(s[1]), "v"(s[2]), "v"(s[3]), "v"(s[4]), "v"(s[5]), "v"(s[6]), "v"(s[7]), "v"(s[8]), "v"(s[9]), "v"(s[10]), "v"(s[11]), "v"(s[12]), "v"(s[13]), "v"(s[14]), "v"(s[15]));
}
__device__ __forceinline__ void upd16_v(float (&s)[16], float wv, float kv, float bv, float vv, float ns) {
    asm("s_nop 1\n\t"
        "v_mul_f32_dpp %0, %16, %0 row_newbcast:0 row_mask:0xf bank_mask:0xf\n\t"
        "v_mul_f32_dpp %1, %16, %1 row_newbcast:1 row_mask:0xf bank_mask:0xf\n\t"
        "v_mul_f32_dpp %2, %16, %2 row_newbcast:2 row_mask:0xf bank_mask:0xf\n\t"
        "v_mul_f32_dpp %3, %16, %3 row_newbcast:3 row_mask:0xf bank_mask:0xf\n\t"
        "v_mul_f32_dpp %4, %16, %4 row_newbcast:4 row_mask:0xf bank_mask:0xf\n\t"
        "v_mul_f32_dpp %5, %16, %5 row_newbcast:5 row_mask:0xf bank_mask:0xf\n\t"
        "v_mul_f32_dpp %6, %16, %6 row_newbcast:6 row_mask:0xf bank_mask:0xf\n\t"
        "v_mul_f32_dpp %7, %16, %7 row_newbcast:7 row_mask:0xf bank_mask:0xf\n\t"
        "v_mul_f32_dpp %8, %16, %8 row_newbcast:8 row_mask:0xf bank_mask:0xf\n\t"
        "v_mul_f32_dpp %9, %16, %9 row_newbcast:9 row_mask:0xf bank_mask:0xf\n\t"
        "v_mul_f32_dpp %10, %16, %10 row_newbcast:10 row_mask:0xf bank_mask:0xf\n\t"
        "v_mul_f32_dpp %11, %16, %11 row_newbcast:11 row_mask:0xf bank_mask:0xf\n\t"
        "v_mul_f32_dpp %12, %16, %12 row_newbcast:12 row_mask:0xf bank_mask:0xf\n\t"
        "v_mul_f32_dpp %13, %16, %13 row_newbcast:13 row_mask:0xf bank_mask:0xf\n\t"
        "v_mul_f32_dpp %14, %16, %14 row_newbcast:14 row_mask:0xf bank_mask:0xf\n\t"
        "v_mul_f32_dpp %15, %16, %15 row_newbcast:15 row_mask:0xf bank_mask:0xf\n\t"
        "v_fmac_f32_dpp %0, %17, %19 row_newbcast:0 row_mask:0xf bank_mask:0xf\n\t"
        "v_fmac_f32_dpp %1, %17, %19 row_newbcast:1 row_mask:0xf bank_mask:0xf\n\t"
        "v_fmac_f32_dpp %2, %17, %19 row_newbcast:2 row_mask:0xf bank_mask:0xf\n\t"
        "v_fmac_f32_dpp %3, %17, %19 row_newbcast:3 row_mask:0xf bank_mask:0xf\n\t"
        "v_fmac_f32_dpp %4, %17, %19 row_newbcast:4 row_mask:0xf bank_mask:0xf\n\t"
        "v_fmac_f32_dpp %5, %17, %19 row_newbcast:5 row_mask:0xf bank_mask:0xf\n\t"
        "v_fmac_f32_dpp %6, %17, %19 row_newbcast:6 row_mask:0xf bank_mask:0xf\n\t"
        "v_fmac_f32_dpp %7, %17, %19 row_newbcast:7 row_mask:0xf bank_mask:0xf\n\t"
        "v_fmac_f32_dpp %8, %17, %19 row_newbcast:8 row_mask:0xf bank_mask:0xf\n\t"
        "v_fmac_f32_dpp %9, %17, %19 row_newbcast:9 row_mask:0xf bank_mask:0xf\n\t"
        "v_fmac_f32_dpp %10, %17, %19 row_newbcast:10 row_mask:0xf bank_mask:0xf\n\t"
        "v_fmac_f32_dpp %11, %17, %19 row_newbcast:11 row_mask:0xf bank_mask:0xf\n\t"
        "v_fmac_f32_dpp %12, %17, %19 row_newbcast:12 row_mask:0xf bank_mask:0xf\n\t"
        "v_fmac_f32_dpp %13, %17, %19 row_newbcast:13 row_mask:0xf bank_mask:0xf\n\t"
        "v_fmac_f32_dpp %14, %17, %19 row_newbcast:14 row_mask:0xf bank_mask:0xf\n\t"
        "v_fmac_f32_dpp %15, %17, %19 row_newbcast:15 row_mask:0xf bank_mask:0xf\n\t"
        "v_fmac_f32_dpp %0, %18, %20 row_newbcast:0 row_mask:0xf bank_mask:0xf\n\t"
        "v_fmac_f32_dpp %1, %18, %20 row_newbcast:1 row_mask:0xf bank_mask:0xf\n\t"
        "v_fmac_f32_dpp %2, %18, %20 row_newbcast:2 row_mask:0xf bank_mask:0xf\n\t"
        "v_fmac_f32_dpp %3, %18, %20 row_newbcast:3 row_mask:0xf bank_mask:0xf\n\t"
        "v_fmac_f32_dpp %4, %18, %20 row_newbcast:4 row_mask:0xf bank_mask:0xf\n\t"
        "v_fmac_f32_dpp %5, %18, %20 row_newbcast:5 row_mask:0xf bank_mask:0xf\n\t"
        "v_fmac_f32_dpp %6, %18, %20 row_newbcast:6 row_mask:0xf bank_mask:0xf\n\t"
        "v_fmac_f32_dpp %7, %18, %20 row_newbcast:7 row_mask:0xf bank_mask:0xf\n\t"
        "v_fmac_f32_dpp %8, %18, %20 row_newbcast:8 row_mask:0xf bank_mask:0xf\n\t"
        "v_fmac_f32_dpp %9, %18, %20 row_newbcast:9 row_mask:0xf bank_mask:0xf\n\t"
        "v_fmac_f32_dpp %10, %18, %20 row_newbcast:10 row_mask:0xf bank_mask:0xf\n\t"
        "v_fmac_f32_dpp %11, %18, %20 row_newbcast:11 row_mask:0xf bank_mask:0xf\n\t"
        "v_fmac_f32_dpp %12, %18, %20 row_newbcast:12 row_mask:0xf bank_mask:0xf\n\t"
        "v_fmac_f32_dpp %13, %18, %20 row_newbcast:13 row_mask:0xf bank_mask:0xf\n\t"
        "v_fmac_f32_dpp %14, %18, %20 row_newbcast:14 row_mask:0xf bank_mask:0xf\n\t"
        "v_fmac_f32_dpp %15, %18, %20 row_newbcast:15 row_mask:0xf bank_mask:0xf\n\t"
        "s_nop 1"
        : "+v"(s[0]), "+v"(s[1]), "+v"(s[2]), "+v"(s[3]), "+v"(s[4]), "+v"(s[5]), "+v"(s[6]), "+v"(s[7]), "+v"(s[8]), "+v"(s[9]), "+v"(s[10]), "+v"(s[11]), "+v"(s[12]), "+v"(s[13]), "+v"(s[14]), "+v"(s[15]) : "v"(wv), "v"(kv), "v"(bv), "v"(vv), "v"(ns));
}
__device__ __forceinline__ void upd16_nov(float (&s)[16], float wv, float kv, float bv, float vv, float ns) {
    asm("s_nop 1\n\t"
        "v_mul_f32_dpp %0, %16, %0 row_newbcast:0 row_mask:0xf bank_mask:0xf\n\t"
        "v_mul_f32_dpp %1, %16, %1 row_newbcast:1 row_mask:0xf bank_mask:0xf\n\t"
        "v_mul_f32_dpp %2, %16, %2 row_newbcast:2 row_mask:0xf bank_mask:0xf\n\t"
        "v_mul_f32_dpp %3, %16, %3 row_newbcast:3 row_mask:0xf bank_mask:0xf\n\t"
        "v_mul_f32_dpp %4, %16, %4 row_newbcast:4 row_mask:0xf bank_mask:0xf\n\t"
        "v_mul_f32_dpp %5, %16, %5 row_newbcast:5 row_mask:0xf bank_mask:0xf\n\t"
        "v_mul_f32_dpp %6, %16, %6 row_newbcast:6 row_mask:0xf bank_mask:0xf\n\t"
        "v_mul_f32_dpp %7, %16, %7 row_newbcast:7 row_mask:0xf bank_mask:0xf\n\t"
        "v_mul_f32_dpp %8, %16, %8 row_newbcast:8 row_mask:0xf bank_mask:0xf\n\t"
        "v_mul_f32_dpp %9, %16, %9 row_newbcast:9 row_mask:0xf bank_mask:0xf\n\t"
        "v_mul_f32_dpp %10, %16, %10 row_newbcast:10 row_mask:0xf bank_mask:0xf\n\t"
        "v_mul_f32_dpp %11, %16, %11 row_newbcast:11 row_mask:0xf bank_mask:0xf\n\t"
        "v_mul_f32_dpp %12, %16, %12 row_newbcast:12 row_mask:0xf bank_mask:0xf\n\t"
        "v_mul_f32_dpp %13, %16, %13 row_newbcast:13 row_mask:0xf bank_mask:0xf\n\t"
        "v_mul_f32_dpp %14, %16, %14 row_newbcast:14 row_mask:0xf bank_mask:0xf\n\t"
        "v_mul_f32_dpp %15, %16, %15 row_newbcast:15 row_mask:0xf bank_mask:0xf\n\t"
        "v_fmac_f32_dpp %0, %18, %20 row_newbcast:0 row_mask:0xf bank_mask:0xf\n\t"
        "v_fmac_f32_dpp %1, %18, %20 row_newbcast:1 row_mask:0xf bank_mask:0xf\n\t"
        "v_fmac_f32_dpp %2, %18, %20 row_newbcast:2 row_mask:0xf bank_mask:0xf\n\t"
        "v_fmac_f32_dpp %3, %18, %20 row_newbcast:3 row_mask:0xf bank_mask:0xf\n\t"
        "v_fmac_f32_dpp %4, %18, %20 row_newbcast:4 row_mask:0xf bank_mask:0xf\n\t"
        "v_fmac_f32_dpp %5, %18, %20 row_newbcast:5 row_mask:0xf bank_mask:0xf\n\t"
        "v_fmac_f32_dpp %6, %18, %20 row_newbcast:6 row_mask:0xf bank_mask:0xf\n\t"
        "v_fmac_f32_dpp %7, %18, %20 row_newbcast:7 row_mask:0xf bank_mask:0xf\n\t"
        "v_fmac_f32_dpp %8, %18, %20 row_newbcast:8 row_mask:0xf bank_mask:0xf\n\t"
        "v_fmac_f32_dpp %9, %18, %20 row_newbcast:9 row_mask:0xf bank_mask:0xf\n\t"
        "v_fmac_f32_dpp %10, %18, %20 row_newbcast:10 row_mask:0xf bank_mask:0xf\n\t"
        "v_fmac_f32_dpp %11, %18, %20 row_newbcast:11 row_mask:0xf bank_mask:0xf\n\t"
        "v_fmac_f32_dpp %12, %18, %20 row_newbcast:12 row_mask:0xf bank_mask:0xf\n\t"
        "v_fmac_f32_dpp %13, %18, %20 row_newbcast:13 row_mask:0xf bank_mask:0xf\n\t"
        "v_fmac_f32_dpp %14, %18, %20 row_newbcast:14 row_mask:0xf bank_mask:0xf\n\t"
        "v_fmac_f32_dpp %15, %18, %20 row_newbcast:15 row_mask:0xf bank_mask:0xf\n\t"
        "s_nop 1"
        : "+v"(s[0]), "+v"(s[1]), "+v"(s[2]), "+v"(s[3]), "+v"(s[4]), "+v"(s[5]), "+v"(s[6]), "+v"(s[7]), "+v"(s[8]), "+v"(s[9]), "+v"(s[10]), "+v"(s[11]), "+v"(s[12]), "+v"(s[13]), "+v"(s[14]), "+v"(s[15]) : "v"(wv), "v"(kv), "v"(bv), "v"(vv), "v"(ns));
}
__device__ __forceinline__ float xrow16_sum(float x) {
    auto s = __builtin_amdgcn_permlane16_swap(__float_as_uint(x), __float_as_uint(x), false, false);
    x = __uint_as_float(s[0]) + __uint_as_float(s[1]);
    auto t = __builtin_amdgcn_permlane32_swap(__float_as_uint(x), __float_as_uint(x), false, false);
    return __uint_as_float(t[0]) + __uint_as_float(t[1]);
}
struct StepIn { float wv, kkv, bv, kv, wrv, vv, beta, kappa; };
template <bool PROW> __device__ __forceinline__ void scan_load(StepIn& x, const float* RWV, const float* SCL, int r, int h, int lane, int row) {
    const float* base = RWV + ((size_t)r * HB + h) * 512; const float* sc = SCL + ((size_t)r * HB + h) * 4;
    x.wv = base[lane]; x.kkv = base[64 + lane]; x.bv = base[128 + lane]; x.wrv = base[384 + lane]; x.beta = sc[0];
    if (!PROW) { x.kv = base[192 + lane]; x.vv = base[320 + row]; x.kappa = sc[1]; } else { x.kv = 0.f; x.vv = 0.f; x.kappa = 0.f; }
}
template <bool PROW, bool SAMP> __device__ __forceinline__ void scan_wave(Ctx& F, int bh, int c, int g) {
    const int lane = F.lane, q = lane >> 4, m = lane & 15, row = 16 * g + m, h = bh & 15, b = bh >> 4;
    constexpr int L = SAMP ? DSEQ : 64; const int r0 = SAMP ? NPR + b * DSEQ : b * SEQ + c * 64; const int ch = bh * 64 + c;
    const float* RWV = WSP(float, WS_RWV); const float* SCL = WSP(float, WS_SCL); float* Y = WSP(float, WS_Y); float* Z = WSP(float, WS_Z); float* PU = WSP(float, WS_PU);
    float s[16];
    if (SAMP) { const float* st = F.in(I_SWKV) + ((size_t)bh * 64 + row) * 64 + 16 * q;
#pragma unroll
        for (int i = 0; i < 16; i += 4) { const f32x4 v = *(const GAS f32x4*)(st + i); s[i] = v.x; s[i + 1] = v.y; s[i + 2] = v.z; s[i + 3] = v.w; } }
    else {
#pragma unroll
        for (int i = 0; i < 16; ++i) s[i] = (PROW && (16 * q + i) == row) ? 1.f : 0.f; }
    StepIn buf[4];
#pragma unroll
    for (int u = 0; u < 4; ++u) scan_load<PROW>(buf[u], RWV, SCL, r0 + u, h, lane, row);
    for (int t = 0; t < L; t += 4) {
#pragma unroll
        for (int u = 0; u < 4; ++u) {
            const StepIn x = buf[u];
            if (t + u + 4 < L) scan_load<PROW>(buf[u], RWV, SCL, r0 + t + u + 4, h, lane, row);
            float sig = 0.f, rho = 0.f;
            dots16(sig, rho, x.kkv, x.wrv, s);
            sig = xrow16_sum(sig); rho = xrow16_sum(rho);
            const float ns = -sig;
            float y = rho + ns * x.beta; if (!PROW) y += x.vv * x.kappa;
            if (q == 0) { if (PROW) Z[((size_t)ch * 64 + t + u) * 64 + row] = y; else Y[(size_t)(r0 + t + u) * 1024 + h * 64 + row] = y; }
            if (PROW) upd16_nov(s, x.wv, x.kv, x.bv, x.vv, ns); else upd16_v(s, x.wv, x.kv, x.bv, x.vv, ns);
        }
    }
    float* dst = SAMP ? F.outp() + O_WKVS + ((size_t)bh * 64 + row) * 64 + 16 * q : PU + (((size_t)ch * 2 + (PROW ? 1 : 0)) * 64 + row) * 64 + 16 * q;
#pragma unroll
    for (int i = 0; i < 16; i += 4) *(GAS f32x4*)(dst + i) = (f32x4){s[i], s[i + 1], s[i + 2], s[i + 3]};
}
__device__ __forceinline__ void dots2_h0(float& sgu, float& rhu, float& sgp, float& rhp, float kkv, float wrv, const float (&su)[16], const float (&sp)[16]) {
    asm("s_nop 1\n\t"
        "v_fmac_f32_dpp %0, %4, %6 row_newbcast:0 row_mask:0xf bank_mask:0xf\n\t"
        "v_fmac_f32_dpp %1, %5, %6 row_newbcast:0 row_mask:0xf bank_mask:0xf\n\t"
        "v_fmac_f32_dpp %2, %4, %14 row_newbcast:0 row_mask:0xf bank_mask:0xf\n\t"
        "v_fmac_f32_dpp %3, %5, %14 row_newbcast:0 row_mask:0xf bank_mask:0xf\n\t"
        "v_fmac_f32_dpp %0, %4, %7 row_newbcast:1 row_mask:0xf bank_mask:0xf\n\t"
        "v_fmac_f32_dpp %1, %5, %7 row_newbcast:1 row_mask:0xf bank_mask:0xf\n\t"
        "v_fmac_f32_dpp %2, %4, %15 row_newbcast:1 row_mask:0xf bank_mask:0xf\n\t"
        "v_fmac_f32_dpp %3, %5, %15 row_newbcast:1 row_mask:0xf bank_mask:0xf\n\t"
        "v_fmac_f32_dpp %0, %4, %8 row_newbcast:2 row_mask:0xf bank_mask:0xf\n\t"
        "v_fmac_f32_dpp %1, %5, %8 row_newbcast:2 row_mask:0xf bank_mask:0xf\n\t"
        "v_fmac_f32_dpp %2, %4, %16 row_newbcast:2 row_mask:0xf bank_mask:0xf\n\t"
        "v_fmac_f32_dpp %3, %5, %16 row_newbcast:2 row_mask:0xf bank_mask:0xf\n\t"
        "v_fmac_f32_dpp %0, %4, %9 row_newbcast:3 row_mask:0xf bank_mask:0xf\n\t"
        "v_fmac_f32_dpp %1, %5, %9 row_newbcast:3 row_mask:0xf bank_mask:0xf\n\t"
        "v_fmac_f32_dpp %2, %4, %17 row_newbcast:3 row_mask:0xf bank_mask:0xf\n\t"
        "v_fmac_f32_dpp %3, %5, %17 row_newbcast:3 row_mask:0xf bank_mask:0xf\n\t"
        "v_fmac_f32_dpp %0, %4, %10 row_newbcast:4 row_mask:0xf bank_mask:0xf\n\t"
        "v_fmac_f32_dpp %1, %5, %10 row_newbcast:4 row_mask:0xf bank_mask:0xf\n\t"
        "v_fmac_f32_dpp %2, %4, %18 row_newbcast:4 row_mask:0xf bank_mask:0xf\n\t"
        "v_fmac_f32_dpp %3, %5, %18 row_newbcast:4 row_mask:0xf bank_mask:0xf\n\t"
        "v_fmac_f32_dpp %0, %4, %11 row_newbcast:5 row_mask:0xf bank_mask:0xf\n\t"
        "v_fmac_f32_dpp %1, %5, %11 row_newbcast:5 row_mask:0xf bank_mask:0xf\n\t"
        "v_fmac_f32_dpp %2, %4, %19 row_newbcast:5 row_mask:0xf bank_mask:0xf\n\t"
        "v_fmac_f32_dpp %3, %5, %19 row_newbcast:5 row_mask:0xf bank_mask:0xf\n\t"
        "v_fmac_f32_dpp %0, %4, %12 row_newbcast:6 row_mask:0xf bank_mask:0xf\n\t"
        "v_fmac_f32_dpp %1, %5, %12 row_newbcast:6 row_mask:0xf bank_mask:0xf\n\t"
        "v_fmac_f32_dpp %2, %4, %20 row_newbcast:6 row_mask:0xf bank_mask:0xf\n\t"
        "v_fmac_f32_dpp %3, %5, %20 row_newbcast:6 row_mask:0xf bank_mask:0xf\n\t"
        "v_fmac_f32_dpp %0, %4, %13 row_newbcast:7 row_mask:0xf bank_mask:0xf\n\t"
        "v_fmac_f32_dpp %1, %5, %13 row_newbcast:7 row_mask:0xf bank_mask:0xf\n\t"
        "v_fmac_f32_dpp %2, %4, %21 row_newbcast:7 row_mask:0xf bank_mask:0xf\n\t"
        "v_fmac_f32_dpp %3, %5, %21 row_newbcast:7 row_mask:0xf bank_mask:0xf\n\t"
        "s_nop 1"
        : "+v"(sgu), "+v"(rhu), "+v"(sgp), "+v"(rhp) : "v"(kkv), "v"(wrv), "v"(su[0]), "v"(su[1]), "v"(su[2]), "v"(su[3]), "v"(su[4]), "v"(su[5]), "v"(su[6]), "v"(su[7]), "v"(sp[0]), "v"(sp[1]), "v"(sp[2]), "v"(sp[3]), "v"(sp[4]), "v"(sp[5]), "v"(sp[6]), "v"(sp[7]));
}
__device__ __forceinline__ void dots2_h1(float& sgu, float& rhu, float& sgp, float& rhp, float kkv, float wrv, const float (&su)[16], const float (&sp)[16]) {
    asm("s_nop 1\n\t"
        "v_fmac_f32_dpp %0, %4, %6 row_newbcast:8 row_mask:0xf bank_mask:0xf\n\t"
        "v_fmac_f32_dpp %1, %5, %6 row_newbcast:8 row_mask:0xf bank_mask:0xf\n\t"
        "v_fmac_f32_dpp %2, %4, %14 row_newbcast:8 row_mask:0xf bank_mask:0xf\n\t"
        "v_fmac_f32_dpp %3, %5, %14 row_newbcast:8 row_mask:0xf bank_mask:0xf\n\t"
        "v_fmac_f32_dpp %0, %4, %7 row_newbcast:9 row_mask:0xf bank_mask:0xf\n\t"
        "v_fmac_f32_dpp %1, %5, %7 row_newbcast:9 row_mask:0xf bank_mask:0xf\n\t"
        "v_fmac_f32_dpp %2, %4, %15 row_newbcast:9 row_mask:0xf bank_mask:0xf\n\t"
        "v_fmac_f32_dpp %3, %5, %15 row_newbcast:9 row_mask:0xf bank_mask:0xf\n\t"
        "v_fmac_f32_dpp %0, %4, %8 row_newbcast:10 row_mask:0xf bank_mask:0xf\n\t"
        "v_fmac_f32_dpp %1, %5, %8 row_newbcast:10 row_mask:0xf bank_mask:0xf\n\t"
        "v_fmac_f32_dpp %2, %4, %16 row_newbcast:10 row_mask:0xf bank_mask:0xf\n\t"
        "v_fmac_f32_dpp %3, %5, %16 row_newbcast:10 row_mask:0xf bank_mask:0xf\n\t"
        "v_fmac_f32_dpp %0, %4, %9 row_newbcast:11 row_mask:0xf bank_mask:0xf\n\t"
        "v_fmac_f32_dpp %1, %5, %9 row_newbcast:11 row_mask:0xf bank_mask:0xf\n\t"
        "v_fmac_f32_dpp %2, %4, %17 row_newbcast:11 row_mask:0xf bank_mask:0xf\n\t"
        "v_fmac_f32_dpp %3, %5, %17 row_newbcast:11 row_mask:0xf bank_mask:0xf\n\t"
        "v_fmac_f32_dpp %0, %4, %10 row_newbcast:12 row_mask:0xf bank_mask:0xf\n\t"
        "v_fmac_f32_dpp %1, %5, %10 row_newbcast:12 row_mask:0xf bank_mask:0xf\n\t"
        "v_fmac_f32_dpp %2, %4, %18 row_newbcast:12 row_mask:0xf bank_mask:0xf\n\t"
        "v_fmac_f32_dpp %3, %5, %18 row_newbcast:12 row_mask:0xf bank_mask:0xf\n\t"
        "v_fmac_f32_dpp %0, %4, %11 row_newbcast:13 row_mask:0xf bank_mask:0xf\n\t"
        "v_fmac_f32_dpp %1, %5, %11 row_newbcast:13 row_mask:0xf bank_mask:0xf\n\t"
        "v_fmac_f32_dpp %2, %4, %19 row_newbcast:13 row_mask:0xf bank_mask:0xf\n\t"
        "v_fmac_f32_dpp %3, %5, %19 row_newbcast:13 row_mask:0xf bank_mask:0xf\n\t"
        "v_fmac_f32_dpp %0, %4, %12 row_newbcast:14 row_mask:0xf bank_mask:0xf\n\t"
        "v_fmac_f32_dpp %1, %5, %12 row_newbcast:14 row_mask:0xf bank_mask:0xf\n\t"
        "v_fmac_f32_dpp %2, %4, %20 row_newbcast:14 row_mask:0xf bank_mask:0xf\n\t"
        "v_fmac_f32_dpp %3, %5, %20 row_newbcast:14 row_mask:0xf bank_mask:0xf\n\t"
        "v_fmac_f32_dpp %0, %4, %13 row_newbcast:15 row_mask:0xf bank_mask:0xf\n\t"
        "v_fmac_f32_dpp %1, %5, %13 row_newbcast:15 row_mask:0xf bank_mask:0xf\n\t"
        "v_fmac_f32_dpp %2, %4, %21 row_newbcast:15 row_mask:0xf bank_mask:0xf\n\t"
        "v_fmac_f32_dpp %3, %5, %21 row_newbcast:15 row_mask:0xf bank_mask:0xf\n\t"
        "s_nop 1"
        : "+v"(sgu), "+v"(rhu), "+v"(sgp), "+v"(rhp) : "v"(kkv), "v"(wrv), "v"(su[8]), "v"(su[9]), "v"(su[10]), "v"(su[11]), "v"(su[12]), "v"(su[13]), "v"(su[14]), "v"(su[15]), "v"(sp[8]), "v"(sp[9]), "v"(sp[10]), "v"(sp[11]), "v"(sp[12]), "v"(sp[13]), "v"(sp[14]), "v"(sp[15]));
}
__device__ __forceinline__ void scan_wave_up(Ctx& F, int bh, int c, int g) {
    const int lane = F.lane, q = lane >> 4, m = lane & 15, row = 16 * g + m, h = bh & 15, b = bh >> 4;
    const int r0 = b * SEQ + c * 64, ch = bh * 64 + c;
    const float* RWV = WSP(float, WS_RWV); const float* SCL = WSP(float, WS_SCL); float* Y = WSP(float, WS_Y); float* Z = WSP(float, WS_Z); float* PU = WSP(float, WS_PU);
    float su[16], sp[16];
#pragma unroll
    for (int i = 0; i < 16; ++i) { su[i] = 0.f; sp[i] = ((16 * q + i) == row) ? 1.f : 0.f; }
    StepIn buf[4];
#pragma unroll
    for (int u = 0; u < 4; ++u) scan_load<false>(buf[u], RWV, SCL, r0 + u, h, lane, row);
    for (int t = 0; t < 64; t += 4) {
#pragma unroll
        for (int u = 0; u < 4; ++u) {
            const StepIn x = buf[u];
            if (t + u + 4 < 64) scan_load<false>(buf[u], RWV, SCL, r0 + t + u + 4, h, lane, row);
            float sgu = 0.f, rhu = 0.f, sgp = 0.f, rhp = 0.f;
            dots2_h0(sgu, rhu, sgp, rhp, x.kkv, x.wrv, su, sp); dots2_h1(sgu, rhu, sgp, rhp, x.kkv, x.wrv, su, sp);
            sgu = xrow16_sum(sgu); rhu = xrow16_sum(rhu); sgp = xrow16_sum(sgp); rhp = xrow16_sum(rhp);
            const float nsu = -sgu, nsp = -sgp;
            const float y = rhu + nsu * x.beta + x.vv * x.kappa, z = rhp + nsp * x.beta;
            if (q == 0) { Y[(size_t)(r0 + t + u) * 1024 + h * 64 + row] = y; Z[((size_t)ch * 64 + t + u) * 64 + row] = z; }
            upd16_v(su, x.wv, x.kv, x.bv, x.vv, nsu); upd16_nov(sp, x.wv, x.kv, x.bv, x.vv, nsp);
        }
    }
    float* du = PU + (((size_t)ch * 2 + 0) * 64 + row) * 64 + 16 * q; float* dp = PU + (((size_t)ch * 2 + 1) * 64 + row) * 64 + 16 * q;
#pragma unroll
    for (int i = 0; i < 16; i += 4) { *(GAS f32x4*)(du + i) = (f32x4){su[i], su[i + 1], su[i + 2], su[i + 3]}; *(GAS f32x4*)(dp + i) = (f32x4){sp[i], sp[i + 1], sp[i + 2], sp[i + 3]}; }
}
__device__ __forceinline__ void phase_scan1_stream(Ctx& F) {
    LAS int* ctr = (LAS int*)(F.lds + LDSCTL_OFF);
    __syncthreads(); if (F.tid == 0) *ctr = 0; __syncthreads();
    if (F.wave >= 6) { for (int u = F.vcu * 2 + (F.wave - 6); u < DBAT * HA * 32; u += 2 * F.G) sba::attn_sample_unit(F, u >> 5, u & 31, (char*)F.lds + F.wave * 16384); }
    constexpr int NSU = DBAT * HB / 2, NU = NSU + NBATCH * HB * 64;
    const int nunits = F.vcu < NU ? (NU - 1 - F.vcu) / F.G + 1 : 0, ntasks = nunits * 8;
    for (;;) {
        int t = 0; if (F.lane == 0) t = __hip_atomic_fetch_add(ctr, 1, __ATOMIC_RELAXED, __HIP_MEMORY_SCOPE_WORKGROUP);
        t = __builtin_amdgcn_readfirstlane(t); if (t >= ntasks) break;
        const int u = F.vcu + (t >> 3) * F.G, g8 = t & 7;
        if (u < NSU) scan_wave<false, true>(F, u * 2 + (g8 >> 2), 0, g8 & 3);
        else if (g8 < 4) { const int ch = u - NSU; scan_wave_up(F, ch >> 6, ch & 63, g8); }
    }
}
namespace msc {
using sba::bf16x8; using sba::f32x16; using sba::crow; using sba::swap_other;
constexpr int S_AQ = 136, S_BKT = 104, S_L = 40;
constexpr int O_AQ = 0, O_BK = 32 * S_AQ, O_L24 = O_BK, O_TL3 = O_BK + 32 * S_L, O_BKT = 2 * 32 * S_AQ, BLK_BYTES = O_BKT + 64 * S_BKT, O_GL = 4 * BLK_BYTES, O_GP = O_GL + 256, GRP_BYTES = O_GP + 4 * 256;
static_assert(BLK_BYTES % 8 == 0 && 2 * GRP_BYTES <= RING_BYTES, "scan LDS map");
typedef __bf16 nbf2 __attribute__((ext_vector_type(2)));
__device__ __forceinline__ unsigned cvt2(float lo, float hi) { return __builtin_bit_cast(unsigned, __builtin_convertvector((f32x2){lo, hi}, nbf2)); }
__device__ __forceinline__ bf16x8 pack8(float a0, float a1, float a2, float a3, float a4, float a5, float a6, float a7) {
    u32x4 w = {cvt2(a0, a1), cvt2(a2, a3), cvt2(a4, a5), cvt2(a6, a7)}; return *reinterpret_cast<bf16x8*>(&w); }
__device__ __forceinline__ bf16x8 pack_lo(const f32x16& c) { return pack8(c[0], c[1], c[2], c[3], c[4], c[5], c[6], c[7]); }
__device__ __forceinline__ bf16x8 pack_hi(const f32x16& c) { return pack8(c[8], c[9], c[10], c[11], c[12], c[13], c[14], c[15]); }
__device__ __forceinline__ bf16x8 perm_read(const LAS char* img, int row, int pitch, int col0, int g) {
    const LAS char* p = img + row * pitch + (col0 + 4 * g) * 2; const u32x2 lo = *(const LAS u32x2*)p, hi = *(const LAS u32x2*)(p + 16);
    u32x4 w = {lo.x, lo.y, hi.x, hi.y}; return *reinterpret_cast<bf16x8*>(&w); }
__device__ __forceinline__ bf16x8 nat_read(const LAS char* img, int row, int pitch, int col0) {
    const LAS char* p = img + row * pitch + col0 * 2; const u32x2 lo = *(const LAS u32x2*)p, hi = *(const LAS u32x2*)(p + 8);
    u32x4 w = {lo.x, lo.y, hi.x, hi.y}; return *reinterpret_cast<bf16x8*>(&w); }
__device__ __forceinline__ unsigned short bf1(float x) { return (unsigned short)(cvt_pk_bf16(x, 0.f) & 0xffffu); }
struct PrepRegs { float pr[17], pk[17], pv[17], lwl[16]; const bf16* lw; };
__device__ __forceinline__ void prep_load(Ctx& F, PrepRegs& L, int rb, int h) {
    const bf16* pb = WSP(bf16, WS_PBH) + (size_t)rb * 3072 + h * 64 + F.lane; const bf16* lw = WSP(bf16, WS_LWH) + (size_t)rb * 3072 + h * 64 + F.lane;
    L.lw = lw;
#pragma unroll
    for (int t = 0; t < 16; ++t) L.lwl[t] = ldbf_nt(lw + (size_t)t * 3072);
    if ((rb & (SEQ - 1)) != 0) { L.pr[0] = ldbf_nt(pb - 3072); L.pk[0] = ldbf_nt(pb + 1024 - 3072); L.pv[0] = ldbf_nt(pb + 2048 - 3072); } else { L.pr[0] = 0.f; L.pk[0] = 0.f; L.pv[0] = 0.f; }
#pragma unroll
    for (int t = 0; t < 16; ++t) { L.pr[t + 1] = ldbf_nt(pb + (size_t)t * 3072); L.pk[t + 1] = ldbf_nt(pb + (size_t)t * 3072 + 1024); L.pv[t + 1] = ldbf_nt(pb + (size_t)t * 3072 + 2048); }
}
__device__ __forceinline__ void prep_block(Ctx& F, PrepRegs& L, int rb, int h, int j, LAS char* gbase) {
    const int lane = F.lane, n = lane & 31, hi = lane >> 5, col = h * 64 + lane; LAS char* blk = gbase + j * BLK_BYTES;
    float lal[16];
#pragma unroll
    for (int t = 0; t < 16; ++t) lal[t] = ldbf_nt(L.lw + (size_t)t * 3072 + 1024);
    const float* mu = F.in(I_MU); const float mu_r = mu[col], mu_k = mu[1024 + col], mu_v = mu[2048 + col];
    const float w0 = F.in(I_W0)[col], a0 = F.in(I_A0)[col], kkw = F.in(I_KK)[col], kaw = F.in(I_KA)[col], rkw = F.in(I_RK)[col];
    float cw[16];
#pragma unroll
    for (int t = 0; t < 16; ++t) { const float wl = w0 + L.lwl[t], wlog = -softplusf_(-wl) - 0.5f; cw[t] = __expf(-__expf(wlog)); }
#pragma unroll
    for (int t = 1; t < 16; ++t) cw[t] *= cw[t - 1];
    *(LAS float*)(gbase + O_GP + (j * 64 + lane) * 4) = cw[15];
    __syncthreads();
    const float g0 = *(const LAS float*)(gbase + O_GP + lane * 4), g1 = *(const LAS float*)(gbase + O_GP + (64 + lane) * 4), g2 = *(const LAS float*)(gbase + O_GP + (128 + lane) * 4);
    const float G0 = (j > 0 ? g0 : 1.f) * (j > 1 ? g1 : 1.f) * (j > 2 ? g2 : 1.f);
    if (j == 3) *(LAS float*)(gbase + O_GL + lane * 4) = G0 * cw[15];
    float* SCL = WSP(float, WS_SCL) + ((size_t)rb * HB + h) * 4;
#pragma unroll
    for (int tl = 0; tl < 16; tl += 2) {
        float nb[2], kt[2], vz[2];
#pragma unroll
        for (int u = 0; u < 2; ++u) { const int t = tl + u;
            const float zr = L.pr[t + 1] + mu_r * (L.pr[t] - L.pr[t + 1]), zk = L.pk[t + 1] + mu_k * (L.pk[t] - L.pk[t + 1]); vz[u] = L.pv[t + 1] + mu_v * (L.pv[t] - L.pv[t + 1]);
            const float a_ = sigmoidf_(a0 + lal[t]);
            const float kkr = zk * kkw, kk = kkr * rsqrtf(wave_sum(kkr * kkr) + 1e-12f);
            const float k = zk * (1.f + (a_ - 1.f) * kaw), bb = kk * a_;
            const float bonus = wave_sum(zr * k * rkw);
            if (lane == 0) SCL[(size_t)t * HB * 4 + 2] = bonus;
            const float Gp = t ? G0 * cw[t ? t - 1 : 0] : G0, G = G0 * cw[t], gi = 1.f / G;
            const float a = kk * Gp, q = zr * G, bt = bb * gi; kt[u] = k * gi; nb[u] = -bt;
            *(LAS unsigned short*)(blk + O_AQ + t * S_AQ + lane * 2) = bf1(a); *(LAS unsigned short*)(blk + O_AQ + (16 + t) * S_AQ + lane * 2) = bf1(q);
            *(LAS unsigned short*)(blk + O_BK + t * S_AQ + lane * 2) = bf1(bt); *(LAS unsigned short*)(blk + O_BK + (16 + t) * S_AQ + lane * 2) = bf1(kt[u]); }
        *(LAS unsigned*)(blk + O_BKT + lane * S_BKT + tl * 2) = cvt_pk_bf16(nb[0], nb[1]); *(LAS unsigned*)(blk + O_BKT + lane * S_BKT + (16 + tl) * 2) = cvt_pk_bf16(kt[0], kt[1]);
        *(LAS unsigned*)(blk + O_BKT + lane * S_BKT + (32 + tl) * 2) = cvt_pk_bf16(vz[0], vz[1]);
    }
    LDS_WAIT(); asm volatile("" ::: "memory");
    f32x16 mt = f32x16{};
#pragma unroll
    for (int ks = 0; ks < 4; ++ks) mt = __builtin_amdgcn_mfma_f32_32x32x16_bf16(nat_read(blk + O_AQ, n, S_AQ, 16 * ks + 8 * hi), nat_read(blk + O_BK, n, S_AQ, 16 * ks + 8 * hi), mt, 0, 0, 0);
    float l1[8];
    const int i = n & 15;
#pragma unroll
    for (int r = 0; r < 16; ++r) { const int t = crow(r, hi) & 15; float val = mt[r];
        if (r < 8) { val = t > i ? val : 0.f; if (n >= 16) *(LAS unsigned short*)(blk + O_L24 + t * S_L + i * 2) = bf1(val); l1[r] = val; }
        else { val = t >= i ? val : 0.f; if (n >= 16) *(LAS unsigned short*)(blk + O_L24 + (16 + t) * S_L + i * 2) = bf1(val); else *(LAS unsigned short*)(blk + O_TL3 + (16 + t) * S_L + i * 2) = bf1(-val); } }
    float rowv[16];
#pragma unroll
    for (int r = 0; r < 8; ++r) { const float own = l1[r], oth = swap_other(own, hi); const int p0 = (r & 3) + 8 * (r >> 2); rowv[p0] = hi ? oth : own; rowv[p0 + 4] = hi ? own : oth; }
    float tl_[16];
    tl_[0] = lane == 0 ? 1.f : 0.f;
#pragma unroll
    for (int t = 1; t < 16; ++t) { float acc = lane == t ? 1.f : 0.f;
#pragma unroll
        for (int jj = 0; jj < t; ++jj) acc -= readlane_f(rowv[t], jj) * tl_[jj];
        tl_[t] = acc; }
    if (lane < 16) {
#pragma unroll
        for (int t = 0; t < 16; ++t) *(LAS unsigned short*)(blk + O_TL3 + t * S_L + lane * 2) = bf1(tl_[t]); }
    LDS_WAIT(); asm volatile("" ::: "memory");
}
__device__ __forceinline__ void chain(Ctx& F, int bh, int c, int isP, int half, const LAS char* gbase) {
    const int lane = F.lane, n = lane & 31, hi = lane >> 5, rowg = 32 * half + n, h = bh & 15, b = bh >> 4, r0 = b * SEQ + c * 64, ch = bh * 64 + c;
    const float* RWV = WSP(float, WS_RWV);
    f32x16 st0 = f32x16{}, st1 = f32x16{};
    if (isP) {
#pragma unroll
        for (int r = 0; r < 16; ++r) { st0[r] = crow(r, hi) == rowg ? 1.f : 0.f; st1[r] = 32 + crow(r, hi) == rowg ? 1.f : 0.f; } }
    for (int blk_i = 0; blk_i < 4; ++blk_i) {
        const LAS char* blk = gbase + blk_i * BLK_BYTES;
        f32x16 wt = f32x16{};
        wt = __builtin_amdgcn_mfma_f32_32x32x16_bf16(perm_read(blk + O_AQ, n, S_AQ, 0, hi), pack_lo(st0), wt, 0, 0, 0);
        wt = __builtin_amdgcn_mfma_f32_32x32x16_bf16(perm_read(blk + O_AQ, n, S_AQ, 16, hi), pack_hi(st0), wt, 0, 0, 0);
        wt = __builtin_amdgcn_mfma_f32_32x32x16_bf16(perm_read(blk + O_AQ, n, S_AQ, 32, hi), pack_lo(st1), wt, 0, 0, 0);
        wt = __builtin_amdgcn_mfma_f32_32x32x16_bf16(perm_read(blk + O_AQ, n, S_AQ, 48, hi), pack_hi(st1), wt, 0, 0, 0);
        bf16x8 bV = bf16x8{};
        if (!isP) { bV = perm_read(blk + O_BKT, rowg, S_BKT, 32, hi);
            wt = __builtin_amdgcn_mfma_f32_32x32x16_bf16(perm_read(blk + O_L24, n, S_L, 0, hi), bV, wt, 0, 0, 0); }
        const bf16x8 tl3 = perm_read(blk + O_TL3, n, S_L, 0, hi);
        const bf16x8 a_tl = n < 16 ? tl3 : bf16x8{}, a_l3 = n >= 16 ? tl3 : bf16x8{};
        const f32x16 sg = __builtin_amdgcn_mfma_f32_32x32x16_bf16(a_tl, pack_lo(wt), f32x16{}, 0, 0, 0);
        const bf16x8 bSg = pack_lo(sg);
        const f32x16 yy = __builtin_amdgcn_mfma_f32_32x32x16_bf16(a_l3, bSg, wt, 0, 0, 0);
#pragma unroll
        for (int r = 8; r < 16; ++r) { const int t = blk_i * 16 + (r & 3) + 8 * ((r - 8) >> 2) + 4 * hi;
            if (isP) WSP(float, WS_Z)[((size_t)ch * 64 + t) * 64 + rowg] = yy[r]; else WSP(float, WS_Y)[(size_t)(r0 + t) * 1024 + h * 64 + rowg] = yy[r]; }
        st0 = __builtin_amdgcn_mfma_f32_32x32x16_bf16(perm_read(blk + O_BKT, n, S_BKT, 0, hi), bSg, st0, 0, 0, 0);
        st1 = __builtin_amdgcn_mfma_f32_32x32x16_bf16(perm_read(blk + O_BKT, 32 + n, S_BKT, 0, hi), bSg, st1, 0, 0, 0);
        if (!isP) { st0 = __builtin_amdgcn_mfma_f32_32x32x16_bf16(perm_read(blk + O_BKT, n, S_BKT, 16, hi), bV, st0, 0, 0, 0);
                    st1 = __builtin_amdgcn_mfma_f32_32x32x16_bf16(perm_read(blk + O_BKT, 32 + n, S_BKT, 16, hi), bV, st1, 0, 0, 0); }
    }
    const LAS float* GL = (const LAS float*)(gbase + O_GL); float* dst = WSP(float, WS_PU) + (((size_t)ch * 2 + isP) * 64 + rowg) * 64;
#pragma unroll
    for (int g4 = 0; g4 < 4; ++g4) { const int k0 = 8 * g4 + 4 * hi; const f32x4 ga = *(const LAS f32x4*)(GL + k0), gb = *(const LAS f32x4*)(GL + 32 + k0);
        *(GAS f32x4*)(dst + k0) = (f32x4){st0[4 * g4] * ga.x, st0[4 * g4 + 1] * ga.y, st0[4 * g4 + 2] * ga.z, st0[4 * g4 + 3] * ga.w};
        *(GAS f32x4*)(dst + 32 + k0) = (f32x4){st1[4 * g4] * gb.x, st1[4 * g4 + 1] * gb.y, st1[4 * g4 + 2] * gb.z, st1[4 * g4 + 3] * gb.w}; }
}
}
__device__ __forceinline__ void phase_sample_stream(Ctx& F) {
    for (int u = F.vcu * NWAVES + F.wave; u < DBAT * HA * 32; u += NWAVES * F.G) sba::attn_sample_unit(F, (u >> 8) * HA + (u & 7), (u >> 3) & 31, (char*)F.lds + F.wave * 16384);
}
__device__ __forceinline__ void phase_scan1_mfma(Ctx& F) {
    __syncthreads();
    const int grp = F.wave >> 2, wq = F.wave & 3; LAS char* gbase = (LAS char*)F.lds + grp * msc::GRP_BYTES;
    msc::PrepRegs L;
    { const int ch = 2 * F.vcu + grp; if (ch < NBATCH * HB * 64) msc::prep_load(F, L, (ch >> 10) * SEQ + (ch & 63) * 64 + 16 * wq, (ch >> 6) & 15); }
    for (int base = 2 * F.vcu; base < NBATCH * HB * 64; base += 2 * F.G) {
        const int ch = base + grp, bh = ch >> 6, c = ch & 63;
        msc::prep_block(F, L, (bh >> 4) * SEQ + c * 64 + 16 * wq, bh & 15, wq, gbase);
        __syncthreads();
        { const int chn = ch + 2 * F.G; if (chn < NBATCH * HB * 64) msc::prep_load(F, L, (chn >> 10) * SEQ + (chn & 63) * 64 + 16 * wq, (chn >> 6) & 15); }
        msc::chain(F, bh, c, wq >> 1, wq & 1, gbase);
    }
}
__device__ __forceinline__ void phase_scan2(Ctx& F) {
    LAS float* Pb = (LAS float*)(F.lds + 4096);
    const float* PU = WSP(float, WS_PU); float* SC = WSP(float, WS_SC);
    for (int unit = F.vcu; unit < NBATCH * HB * 8; unit += F.G) {
        const int bh = unit >> 3, r0 = (unit & 7) * 8, r = F.wave, col = F.lane;
        __syncthreads();
        { const float* P0 = PU + ((size_t)(bh * 64) * 2 + 1) * 4096; const f32x4 a = *(const GAS f32x4*)(P0 + F.tid * 4), bq = *(const GAS f32x4*)(P0 + 2048 + F.tid * 4);
          *(LAS f32x4*)(Pb + F.tid * 4) = a; *(LAS f32x4*)(Pb + 2048 + F.tid * 4) = bq; }
        float ucur = PU[((size_t)(bh * 64) * 2 + 0) * 4096 + (r0 + r) * 64 + col], scur = 0.f;
        __syncthreads();
        for (int c = 0; c < 64; ++c) {
            const int ch = bh * 64 + c; LAS float* Pc = Pb + (c & 1) * 4096;
            SC[((size_t)ch * 64 + r0 + r) * 64 + col] = scur;
            f32x4 pa = {0.f, 0.f, 0.f, 0.f}, pq = {0.f, 0.f, 0.f, 0.f}; float unext = 0.f;
            if (c + 1 < 64) { const float* Pn = PU + ((size_t)(ch + 1) * 2 + 1) * 4096; pa = *(const GAS f32x4*)(Pn + F.tid * 4); pq = *(const GAS f32x4*)(Pn + 2048 + F.tid * 4);
                unext = PU[((size_t)(ch + 1) * 2 + 0) * 4096 + (r0 + r) * 64 + col]; }
            float a0 = ucur, a1 = 0.f, a2 = 0.f, a3 = 0.f;
#pragma unroll
            for (int j = 0; j < 64; j += 4) {
                const float s0 = readlane_f(scur, j), s1 = readlane_f(scur, j + 1), s2 = readlane_f(scur, j + 2), s3 = readlane_f(scur, j + 3);
                a0 += s0 * Pc[(j + 0) * 64 + col]; a1 += s1 * Pc[(j + 1) * 64 + col]; a2 += s2 * Pc[(j + 2) * 64 + col]; a3 += s3 * Pc[(j + 3) * 64 + col]; }
            const float acc = (a0 + a1) + (a2 + a3);
            if (c + 1 < 64) { LAS float* Pn = Pb + ((c + 1) & 1) * 4096; *(LAS f32x4*)(Pn + F.tid * 4) = pa; *(LAS f32x4*)(Pn + 2048 + F.tid * 4) = pq; }
            __syncthreads();
            scur = acc; ucur = unext;
        }
        F.outp()[O_WKVP + ((size_t)bh * 64 + r0 + r) * 64 + col] = scur;
    }
}
__device__ __forceinline__ void phase_scan3(Ctx& F) {
    const int gw = F.vcu * NWAVES + F.wave, NGW = F.G * NWAVES, lane = F.lane, q = lane >> 4, m = lane & 15;
    const float* SC = WSP(float, WS_SC); const float* Z = WSP(float, WS_Z); float* Y = WSP(float, WS_YC);
    for (int task = gw; task < NBATCH * HB * 63 * 4; task += NGW) {
        const int g = task & 3, cc = task >> 2, bh = cc / 63, c = 1 + (cc - bh * 63), ch = bh * 64 + c, h = bh & 15, b = bh >> 4, row = 16 * g + m;
        const float* st = SC + ((size_t)ch * 64 + row) * 64 + 16 * q; float s[16];
#pragma unroll
        for (int i = 0; i < 16; i += 4) { const f32x4 v = *(const GAS f32x4*)(st + i); s[i] = v.x; s[i + 1] = v.y; s[i + 2] = v.z; s[i + 3] = v.w; }
        const float* zp = Z + (size_t)ch * 4096 + lane; float* yp = Y + (size_t)(b * SEQ + c * 64) * 1024 + h * 64 + row;
        float zb[4];
#pragma unroll
        for (int u = 0; u < 4; ++u) zb[u] = zp[u * 64];
        for (int t = 0; t < 64; t += 4) {
#pragma unroll
            for (int u = 0; u < 4; ++u) {
                const float zv = zb[u]; if (t + u + 4 < 64) zb[u] = zp[(t + u + 4) * 64];
                float acc = 0.f; dot16(acc, zv, s); acc = xrow16_sum(acc);
                if (q == 0) yp[(size_t)(t + u) * 1024] = acc;
            }
        }
    }
}
__device__ __forceinline__ float sum32(float v) {
    v += dpp_f<0xB1>(v); v += dpp_f<0x4E>(v); v += dpp_f<0x141>(v); v += dpp_f<0x140>(v);
    auto s = __builtin_amdgcn_permlane16_swap(__float_as_uint(v), __float_as_uint(v), false, false);
    return __uint_as_float(s[0]) + __uint_as_float(s[1]);
}
__device__ __forceinline__ sba::bf16x8 ld8_bf16(const float* p) { const f32x4 a = *(const GAS f32x4*)p, b = *(const GAS f32x4*)(p + 4); return msc::pack8(a.x, a.y, a.z, a.w, b.x, b.y, b.z, b.w); }
__device__ __forceinline__ void phase_scan3_post(Ctx& F) {
    const int gw = F.vcu * NWAVES + F.wave, NGW = F.G * NWAVES, lane = F.lane, n = lane & 31, hi = lane >> 5;
    const float* SC = WSP(float, WS_SC); const float* Z = WSP(float, WS_Z); const float* Y = WSP(float, WS_Y); const bf16* LWH = WSP(bf16, WS_LWH); const bf16* PBH = WSP(bf16, WS_PBH);
    const float* SCL = WSP(float, WS_SCL); bf16* OAB = WSP(bf16, WS_OAB);
    for (int ch = gw; ch < NBATCH * HB * 64; ch += NGW) {
        const int bh = ch >> 6, c = ch & 63, h = bh & 15, b = bh >> 4, r0 = b * SEQ + c * 64, col0 = h * 64 + n;
        const float lg0 = F.in(I_LNG)[col0], lg1 = F.in(I_LNG)[col0 + 32], lb0 = F.in(I_LNB)[col0], lb1 = F.in(I_LNB)[col0 + 32], mv0 = F.in(I_MU)[2048 + col0], mv1 = F.in(I_MU)[2048 + col0 + 32];
        sba::bf16x8 sb0[4], sb1[4];
        if (c > 0) { const float* Sp = SC + (size_t)ch * 4096 + n * 64 + 8 * hi;
#pragma unroll
            for (int ks = 0; ks < 4; ++ks) { sb0[ks] = ld8_bf16(Sp + 16 * ks); sb1[ks] = ld8_bf16(Sp + 32 * 64 + 16 * ks); } }
        else {
#pragma unroll
            for (int ks = 0; ks < 4; ++ks) { sb0[ks] = sba::bf16x8{}; sb1[ks] = sba::bf16x8{}; } }
        for (int tt = 0; tt < 2; ++tt) {
            sba::f32x16 a0 = sba::f32x16{}, a1 = sba::f32x16{};
            if (c > 0) { const float* Zp = Z + (size_t)ch * 4096 + (32 * tt + n) * 64 + 8 * hi;
#pragma unroll
                for (int ks = 0; ks < 4; ++ks) { const sba::bf16x8 za = ld8_bf16(Zp + 16 * ks);
                    a0 = __builtin_amdgcn_mfma_f32_32x32x16_bf16(za, sb0[ks], a0, 0, 0, 0); a1 = __builtin_amdgcn_mfma_f32_32x32x16_bf16(za, sb1[ks], a1, 0, 0, 0); } }
#pragma unroll
            for (int rg = 0; rg < 16; rg += 4) {
                float y0[4], y1[4], g0[4], g1[4], p0[4], p1[4], q0[4], q1[4], bn[4];
#pragma unroll
                for (int i = 0; i < 4; ++i) { const int t = 32 * tt + sba::crow(rg + i, hi), r = r0 + t;
                    y0[i] = Y[(size_t)r * 1024 + col0]; y1[i] = Y[(size_t)r * 1024 + col0 + 32];
                    g0[i] = ldbf(LWH + (size_t)r * 3072 + 2048 + col0); g1[i] = ldbf(LWH + (size_t)r * 3072 + 2048 + col0 + 32);
                    const bf16* pb = PBH + (size_t)r * 3072 + 2048 + col0; p0[i] = ldbf(pb); p1[i] = ldbf(pb + 32);
                    const bool hp = (r & (SEQ - 1)) != 0; q0[i] = hp ? ldbf(pb - 3072) : 0.f; q1[i] = hp ? ldbf(pb + 32 - 3072) : 0.f;
                    bn[i] = SCL[((size_t)r * HB + h) * 4 + 2]; }
#pragma unroll
                for (int i = 0; i < 4; ++i) { const int t = 32 * tt + sba::crow(rg + i, hi), r = r0 + t;
                    const float v0 = y0[i] + a0[rg + i], v1 = y1[i] + a1[rg + i];
                    const float mean = sum32(v0 + v1) * (1.f / 64.f), d0 = v0 - mean, d1 = v1 - mean, var = sum32(d0 * d0 + d1 * d1) * (1.f / 64.f), rs = rsqrtf(var + EPS_LNX);
                    const float zv0 = p0[i] + mv0 * (q0[i] - p0[i]), zv1 = p1[i] + mv1 * (q1[i] - p1[i]);
                    const float o0 = (d0 * rs * lg0 + lb0 + bn[i] * zv0) * g0[i], o1 = (d1 * rs * lg1 + lb1 + bn[i] * zv1) * g1[i];
                    const float o0n = dpp_f<0xB1>(o0), o1n = dpp_f<0xB1>(o1);
                    if ((lane & 1) == 0) { *(GAS unsigned*)(OAB + (size_t)r * DM + 1024 + col0) = cvt_pk_bf16(o0, o0n); *(GAS unsigned*)(OAB + (size_t)r * DM + 1024 + col0 + 32) = cvt_pk_bf16(o1, o1n); } }
            }
        }
    }
}
__device__ __forceinline__ void phase_postscan(Ctx& F) {
    const int gw = F.vcu * NWAVES + F.wave, NGW = F.G * NWAVES;
    const float* Y = WSP(float, WS_Y); const float* RWV = WSP(float, WS_RWV); const float* SCL = WSP(float, WS_SCL); const float* LWO = WSP(float, WS_LWO); const float* Pp = WSP(float, WS_P); bf16* OAB = WSP(bf16, WS_OAB);
    for (int u = NPR * 4 + gw; u < NTOK * 4; u += NGW) {
        const int r = u >> 2, hq = u & 3; const bool corr = false;
        float yv[4], gv[4], vv[4], bn[4];
#pragma unroll
        for (int i = 0; i < 4; ++i) { const int h = hq * 4 + i, col = h * 64 + F.lane;
            yv[i] = Y[(size_t)r * 1024 + col]; if (corr) yv[i] += WSP(float, WS_YC)[(size_t)r * 1024 + col];
            gv[i] = LWO[(size_t)r * 3072 + 2048 + col]; bn[i] = SCL[((size_t)r * HB + h) * 4 + 2];
            vv[i] = RWV[((size_t)r * HB + h) * 512 + 320 + F.lane]; }
#pragma unroll
        for (int i = 0; i < 4; ++i) { const int h = hq * 4 + i, col = h * 64 + F.lane;
            const float mean = wave_sum(yv[i]) * (1.f / 64.f), d = yv[i] - mean, var = wave_sum(d * d) * (1.f / 64.f);
            const float yn = d * rsqrtf(var + EPS_LNX) * F.in(I_LNG)[col] + F.in(I_LNB)[col] + bn[i] * vv[i];
            const float o = yn * gv[i];
            const float o1 = dpp_f<0xB1>(o);
            if ((F.lane & 1) == 0) *(GAS unsigned*)(OAB + (size_t)r * DM + 1024 + col) = cvt_pk_bf16(o, o1); }
    }
    sample_combine(F);
    const float* OP = WSP(float, WS_OP); const float* CL = WSP(float, WS_CL);
    for (size_t i = (size_t)F.vcu * NTHR + F.tid; i < (size_t)NPR * 256; i += (size_t)F.G * NTHR) {
        const int r = (int)(i >> 8), c4 = (int)(i & 255) * 4, h = c4 >> 7;
        const f32x4 a = *(const GAS f32x4*)(OP + (size_t)r * 1024 + c4), e = *(const GAS f32x4*)(OP + ((size_t)NPR + r) * 1024 + c4); const float cl = CL[(size_t)r * HA + h];
        const f32x4 o = a + e * cl; u32x2 w; w.x = cvt_pk_bf16(o.x, o.y); w.y = cvt_pk_bf16(o.z, o.w);
        *(GAS u32x2*)(OAB + (size_t)r * DM + c4) = w;
    }
}
__device__ __forceinline__ void phase_usample(Ctx& F) {
    const float* PU_ = WSP(float, WS_PARTU); bf16* U = WSP(bf16, WS_U);
    for (int i = F.vcu * NTHR + F.tid; i < NSM * DFF / 4; i += F.G * NTHR) { const int r = i / (DFF / 4), c4 = (i - r * (DFF / 4)) * 4;
        f32x4 a = *(const GAS f32x4*)(PU_ + (size_t)r * DFF + c4);
#pragma unroll
        for (int kc = 1; kc < 8; ++kc) a += *(const GAS f32x4*)(PU_ + ((size_t)kc * 64 + r) * DFF + c4);
        const float x0 = fmaxf(a.x, 0.f), x1 = fmaxf(a.y, 0.f), x2 = fmaxf(a.z, 0.f), x3 = fmaxf(a.w, 0.f);
        u32x2 w; w.x = cvt_pk_bf16(x0 * x0, x1 * x1); w.y = cvt_pk_bf16(x2 * x2, x3 * x3);
        *(GAS u32x2*)(U + (size_t)(NPR + r) * DFF + c4) = w; }
}
#ifndef MK_SPLIT
#define MK_SPLIT 0
#endif
constexpr int NPHASE = 21;
struct Args { const void* in[N_IN]; float* out; unsigned char* ws; int ph_lo, ph_hi; };
__global__ void __launch_bounds__(NTHR, 2) mega_fwd(Args args) {
    extern __shared__ __attribute__((aligned(16))) unsigned char lds_raw[];
    Ctx F;
    F.lds = (LAS unsigned char*)lds_raw; F.tid = threadIdx.x; F.lane = F.tid & 63; F.wave = __builtin_amdgcn_readfirstlane(F.tid >> 6);
    F.G = gridDim.x; { const int bx = blockIdx.x; F.vcu = (F.G % 8 == 0) ? (bx % 8) * (F.G / 8) + bx / 8 : bx; }
    for (int u = F.tid; u < (LDS_BYTES - LDSCTL_OFF) / 4; u += NTHR) ((LAS unsigned*)(F.lds + LDSCTL_OFF))[u] = 0u;
    __syncthreads();
    unsigned* ctl = (unsigned*)(args.ws + WS_CTL);
    XcdBarrier bar; bar.bar = ctl + CW_BAR; bar.x = 0; bar.st = nullptr;
    if (!MK_SPLIT) bar = xcd_barrier_post(ctl + CW_BAR, (volatile LAS unsigned*)(F.lds + MISC_OFF) + 8);
    const int lo = args.ph_lo, hi = args.ph_hi;
#define IN(k) (lo <= (k) && (k) < hi)
#define SEAM(k) do { if (IN(k) && IN((k) + 1)) xcd_barrier(bar); } while (0)
    if (IN(0)) { phase_prologue(F); } SEAM(0);
    if (IN(1)) { phase_mod0(F); } SEAM(1);
    if (IN(2)) { const bool hide = F.G > NCVT + 8; const int ng = hide ? F.G - NCVT : F.G;
        if ((int)blockIdx.x < ng) { pg8::Gemm g{WSP(bf16, WS_H), WSP(bf16, WS_WIN), MP, INPAD, DM, DM, DM}; pg8::StaticOrder S; S.init(MP, INPAD, ng, (int)blockIdx.x); EpiIn E{WSP(bf16, WS_QB), WSP(bf16, WS_KB), WSP(bf16, WS_VB), WSP(float, WS_P), F.outp(), WSP(bf16, WS_PBH)};
            pg8::gemm_phase<EpiIn, pg8::StaticOrder, true, true>(F.lds, g, S, E); }
        else convert_run(F, IT_IN + ((int)blockIdx.x - ng) * NWAVES + F.wave, NCVT * NWAVES, IT_IN + N_HIDE, (LAS float*)(F.lds + F.wave * 16384)); } SEAM(2);
    if (IN(3)) { phase_kv_prep(F); } SEAM(3);
    if (IN(4)) { pg8::Gemm g{WSP(bf16, WS_LA), WSP(bf16, WS_LWT), MP, 3072, 512, 512, 512}; pg8::LoraOrder S; S.init(MP, 3072, F.G, (int)blockIdx.x); pg8::EpiLora E{WSP(float, WS_LWO), WSP(bf16, WS_LWH), 3072};
        pg8::gemm_phase<pg8::EpiLora, pg8::LoraOrder, true, true>(F.lds, g, S, E); } SEAM(4);
    if (IN(6)) { phase_rwkv_prep(F);
        const bool stream_first = (F.vcu & 1) != 0;
        if (stream_first) phase_sample_stream(F); else phase_scan1_mfma(F);
        __syncthreads();
        phase_attn_prompt(F);
        if (!stream_first) phase_sample_stream(F); else phase_scan1_mfma(F); } SEAM(7);
    if (IN(8)) {
        if (F.wave < 2) for (int t = F.vcu * 2 + F.wave; t < DBAT * HB * 4; t += 2 * F.G) scan_wave<false, true>(F, t >> 2, 0, t & 3);
        phase_scan2(F); } SEAM(8);
    if (IN(10)) { phase_scan3_post(F); phase_postscan(F); } SEAM(10);
    if (IN(11)) { pg8::Gemm g{WSP(bf16, WS_OAB), WSP(bf16, WS_WOUT), MP, DM, DM, DM, DM}; pg8::MixOrder<false> S; S.init(DM, DM, F.G, (int)blockIdx.x); pg8::EpiF32S<64> E{WSP(bf16, WS_OUT), DM, nullptr, WSP(float, WS_PART)};
        pg8::gemm_phase<pg8::EpiF32S<64>, pg8::MixOrder<false>, true, true>(F.lds, g, S, E); } SEAM(11);
    if (IN(12)) { phase_postmix<0>(F); } SEAM(12);
    if (IN(13)) { pg8::Gemm g{WSP(bf16, WS_H), WSP(bf16, WS_W1), MP, DFF, DM, DM, DM}; pg8::MixOrder<false> S; S.init(DFF, DM, F.G, (int)blockIdx.x); pg8::EpiRelu2 E{WSP(bf16, WS_U), DFF, WSP(float, WS_PARTU)};
        pg8::gemm_phase<pg8::EpiRelu2, pg8::MixOrder<false>, true, true>(F.lds, g, S, E); } SEAM(13);
    if (IN(14)) { phase_usample(F); if (!MK_SPLIT) xcd_barrier(bar); pg8::Gemm g{WSP(bf16, WS_U), WSP(bf16, WS_W2), MP, DM, DFF, DFF, DFF}; pg8::MixOrder<false> S; S.init(DM, DFF, F.G, (int)blockIdx.x); pg8::EpiF32S<64> E{WSP(bf16, WS_OUT), DM, nullptr, WSP(float, WS_PART)};
        pg8::gemm_phase<pg8::EpiF32S<64>, pg8::MixOrder<false>, true, true>(F.lds, g, S, E); } SEAM(14);
    if (IN(15)) { phase_postmlp<0>(F); } SEAM(15);
    if (IN(16)) { pg8::Gemm g{WSP(bf16, WS_H), WSP(bf16, WS_WPOOL), MP, DM, DM, DM, DM}; pg8::MixOrder<true> S; S.init(DM, DM, F.G, (int)blockIdx.x); pg8::EpiF32S<256> E{WSP(bf16, WS_OUT), DM, F.in(I_PSC), WSP(float, WS_PART)};
        pg8::gemm_phase<pg8::EpiF32S<256>, pg8::MixOrder<true>, true, true>(F.lds, g, S, E); } SEAM(16);
    if (IN(17)) { phase_postmix<1>(F); } SEAM(17);
    if (IN(18)) { pg8::Gemm g{WSP(bf16, WS_H), WSP(bf16, WS_W1) + (size_t)DFF * DM, MP, DFF, DM, DM, DM}; pg8::MixOrder<false> S; S.init(DFF, DM, F.G, (int)blockIdx.x); pg8::EpiRelu2 E{WSP(bf16, WS_U), DFF, WSP(float, WS_PARTU)};
        pg8::gemm_phase<pg8::EpiRelu2, pg8::MixOrder<false>, true, true>(F.lds, g, S, E); } SEAM(18);
    if (IN(19)) { phase_usample(F); if (!MK_SPLIT) xcd_barrier(bar); pg8::Gemm g{WSP(bf16, WS_U), WSP(bf16, WS_W2) + (size_t)DM * DFF, MP, DM, DFF, DFF, DFF}; pg8::MixOrder<false> S; S.init(DM, DFF, F.G, (int)blockIdx.x); pg8::EpiF32S<64> E{WSP(bf16, WS_OUT), DM, nullptr, WSP(float, WS_PART)};
        pg8::gemm_phase<pg8::EpiF32S<64>, pg8::MixOrder<false>, true, true>(F.lds, g, S, E); } SEAM(19);
    if (IN(20)) { phase_postmlp<1>(F); }
#undef IN
#undef SEAM
}

extern "C" void kernel_launch(void* const* d_in, const int* in_sizes, int n_in, void* d_out, int out_size, void* d_ws, size_t ws_size, hipStream_t stream) {
    static int grid = 0;
    if (grid == 0) {
        if (n_in != N_IN || (size_t)out_size != O_END || ws_size < WS_END) { fprintf(stderr, "kernel_launch: unexpected shapes: n_in %d out %d ws %zu (want %d, %zu, >= %zu)\n", n_in, out_size, ws_size, (int)N_IN, (size_t)O_END, (size_t)WS_END); grid = -1; return; }
        int dev = 0, cus = 0, per_cu = 0;
        if (hipGetDevice(&dev) != hipSuccess || hipDeviceGetAttribute(&cus, hipDeviceAttributeMultiprocessorCount, dev) != hipSuccess) { grid = -1; return; }
        if (hipFuncSetAttribute((const void*)mega_fwd, hipFuncAttributeMaxDynamicSharedMemorySize, LDS_BYTES) != hipSuccess) { fprintf(stderr, "kernel_launch: hipFuncSetAttribute failed\n"); grid = -1; return; }
        if (hipOccupancyMaxActiveBlocksPerMultiprocessor(&per_cu, (const void*)mega_fwd, NTHR, LDS_BYTES) != hipSuccess || per_cu < 1) fprintf(stderr, "kernel_launch: occupancy query reports %d blocks per CU\n", per_cu);
        (void)hipGetLastError();
        grid = cus;
    }
    if (grid < 0) return;
    hipMemsetAsync((char*)d_ws + WS_CTL, 0, CTL_ZERO_BYTES, stream);
    Args a{};
    for (int i = 0; i < N_IN; ++i) a.in[i] = d_in[i];
    a.out = (float*)d_out; a.ws = (unsigned char*)d_ws;
#if MK_SPLIT
    for (int p = 0; p < NPHASE; ++p) { a.ph_lo = p; a.ph_hi = p + 1; hipLaunchKernelGGL(mega_fwd, dim3(grid), dim3(NTHR), LDS_BYTES, stream, a); }
#else
    a.ph_lo = 0; a.ph_hi = NPHASE;
    hipLaunchKernelGGL(mega_fwd, dim3(grid), dim3(NTHR), LDS_BYTES, stream, a);
#endif
    const hipError_t le = hipPeekAtLastError();
    if (le != hipSuccess) fprintf(stderr, "kernel_launch: launch failed: %s\n", hipGetErrorName(le));
}
```

```cpp
#include <hip/hip_runtime.h>
#include <cstdio>
#include <cstdint>
namespace pg8 {
#define PG8_LAS __attribute__((address_space(3)))
typedef unsigned short bf16_t;
typedef short bf16x8 __attribute__((ext_vector_type(8)));
typedef float f32x4 __attribute__((ext_vector_type(4)));
typedef unsigned u32x4 __attribute__((ext_vector_type(4)));
constexpr int BM = 256, BK = 64, HALF = 128, HTB = HALF * BK * 2  , STAGE_BYTES = 8 * HTB, NXCD = 8, WGM = 8;

__host__ __device__ __forceinline__ int lds_byte(int r, int c) { const int st = (r >> 4) * 2 + (c >> 5), rr = r & 15, cc = c & 31, ob = rr * 64 + cc * 2; return st * 1024 + (ob ^ (((ob >> 9) & 1) << 5)); }
__host__ __device__ __forceinline__ void stage_rc(int b, int& R, int& C) { const int st = b / 1024, sb = b % 1024, swz = sb ^ (((sb >> 9) & 1) << 5); R = (st >> 1) * 16 + swz / 64; C = (st & 1) * 32 + (swz % 64) / 2; }
__host__ __device__ __forceinline__ int perm32(int rho) { const int n = rho >> 4, i = rho & 15; return 8 * (i >> 2) + 4 * n + (i & 3); }

struct Unit { int pm, pn, kc; };
struct Gemm { const bf16_t* A; const bf16_t* Bt; int M, N, K, lda, ldb; };

struct StaticOrder {
    int nM, nN, nwg, G, c;
    __host__ __device__ void init(int M, int N, int G_, int c_) { nM = M / BM; nN = N / BM; nwg = nM * nN; G = G_; c = c_; }
    __host__ __device__ bool next(int i, Unit& u) const {
        const long L = (long)i * G + c; if (L >= nwg) return false;
        int wgid = (int)L; { const int q = nwg / NXCD, r = nwg % NXCD, xcd = wgid % NXCD, off = wgid / NXCD; wgid = (xcd < r ? xcd * (q + 1) : r * (q + 1) + (xcd - r) * q) + off; }
        const int nig = WGM * nN, gid = wgid / nig, fm = gid * WGM, gsz = (nM - fm) < WGM ? (nM - fm) : WGM;
        u.pm = fm + ((wgid % nig) % gsz); u.pn = (wgid % nig) / gsz; u.kc = -1; return true;
    }
    __device__ __forceinline__ int nt(const Unit&, const Gemm& g) const { return g.K / BK; }
    __device__ __forceinline__ void a_ready(const Unit&) const {}
    __device__ __forceinline__ void done(const Unit&) const {}
    __device__ __forceinline__ size_t a_off(const Unit& u, const Gemm& g) const { return (size_t)u.pm * BM * g.lda * 2; }
    __device__ __forceinline__ size_t b_off(const Unit& u, const Gemm& g) const { return (size_t)u.pn * BM * g.ldb * 2; }
};
struct LoraOrder : StaticOrder {
    __device__ __forceinline__ int k0(const Unit& u) const { return u.pn < 4 ? 0 : (u.pn < 8 ? 64 : 192); }
    __device__ __forceinline__ int nt(const Unit& u, const Gemm&) const { return u.pn < 8 ? 2 : 4; }
    __device__ __forceinline__ size_t a_off(const Unit& u, const Gemm& g) const { return (size_t)u.pm * BM * g.lda * 2 + (size_t)k0(u) * 2; }
    __device__ __forceinline__ size_t b_off(const Unit& u, const Gemm& g) const { return (size_t)u.pn * BM * g.ldb * 2 + (size_t)k0(u) * 2; }
};
__device__ __forceinline__ unsigned cvt_pk_bf16(float lo, float hi) { unsigned r; asm volatile("v_cvt_pk_bf16_f32 %0, %1, %2" : "=v"(r) : "v"(lo), "v"(hi)); return r; }

struct EpiF32 {
    static constexpr bool PERM = false, AFTER_DRAIN = false;
    float* C; int ldc; const float* cscale;
    __device__ __forceinline__ void operator()(const f32x4 (&acc)[2][2][4][2], const Unit& u, int wr, int wc, int fr, int fq) const {
        const int row0 = u.pm * BM + wr * 64 + fr, col0 = u.pn * BM + wc * 32 + 4 * fq;
        f32x4 sv[2][2];
#pragma unroll
        for (int bj = 0; bj < 2; ++bj)
#pragma unroll
            for (int n = 0; n < 2; ++n) sv[bj][n] = cscale ? *(const f32x4*)(cscale + col0 + bj * HALF + n * 16) : (f32x4){1.f, 1.f, 1.f, 1.f};
#pragma unroll
        for (int ai = 0; ai < 2; ++ai)
#pragma unroll
            for (int m = 0; m < 4; ++m) { float* rowp = C + (size_t)(row0 + ai * HALF + m * 16) * ldc + col0;
#pragma unroll
                for (int bj = 0; bj < 2; ++bj)
#pragma unroll
                    for (int n = 0; n < 2; ++n) *(f32x4*)(rowp + bj * HALF + n * 16) = acc[ai][bj][m][n] * sv[bj][n]; }
    }
};
typedef unsigned u32x2h __attribute__((ext_vector_type(2)));
struct EpiLora {
    static constexpr bool PERM = false, AFTER_DRAIN = false;
    float* C; bf16_t* H; int ldc;
    __device__ __forceinline__ void operator()(const f32x4 (&acc)[2][2][4][2], const Unit& u, int wr, int wc, int fr, int fq) const {
        const int row0 = u.pm * BM + wr * 64 + fr, col0 = u.pn * BM + wc * 32 + 4 * fq;
#pragma unroll
        for (int ai = 0; ai < 2; ++ai)
#pragma unroll
            for (int m = 0; m < 4; ++m) { const size_t ro = (size_t)(row0 + ai * HALF + m * 16) * ldc + col0;
#pragma unroll
                for (int bj = 0; bj < 2; ++bj)
#pragma unroll
                    for (int n = 0; n < 2; ++n) { const f32x4 v = acc[ai][bj][m][n];
                        if (u.pm < 32) { u32x2h w; w.x = cvt_pk_bf16(v[0], v[1]); w.y = cvt_pk_bf16(v[2], v[3]); *(u32x2h*)(H + ro + bj * HALF + n * 16) = w; }
                        else *(f32x4*)(C + ro + bj * HALF + n * 16) = v; } }
    }
};
struct EpiRelu2 {
    static constexpr bool PERM = true, AFTER_DRAIN = false;
    bf16_t* O; int ldc; float* PART;
    __device__ __forceinline__ void operator()(const f32x4 (&acc)[2][2][4][2], const Unit& u, int wr, int wc, int fr, int fq) const {
        const int row0 = u.pm * BM + wr * 64 + fr, col0 = u.pn * BM + wc * 32 + 8 * fq;
        if (u.kc >= 0) {
            if (wr == 0) {
#pragma unroll
                for (int m = 0; m < 4; ++m) { float* rowp = PART + ((size_t)u.kc * 64 + m * 16 + fr) * ldc + col0;
#pragma unroll
                    for (int bj = 0; bj < 2; ++bj) { *(f32x4*)(rowp + bj * HALF) = acc[0][bj][m][0]; *(f32x4*)(rowp + bj * HALF + 4) = acc[0][bj][m][1]; } } }
            return;
        }
#pragma unroll
        for (int ai = 0; ai < 2; ++ai)
#pragma unroll
            for (int m = 0; m < 4; ++m) { bf16_t* rowp = O + (size_t)(row0 + ai * HALF + m * 16) * ldc + col0;
#pragma unroll
                for (int bj = 0; bj < 2; ++bj) { f32x4 v0 = acc[ai][bj][m][0], v1 = acc[ai][bj][m][1];
#pragma unroll
                    for (int j = 0; j < 4; ++j) { const float a = v0[j] > 0.f ? v0[j] : 0.f, b = v1[j] > 0.f ? v1[j] : 0.f; v0[j] = a * a; v1[j] = b * b; }
                    u32x4 w; w.x = cvt_pk_bf16(v0[0], v0[1]); w.y = cvt_pk_bf16(v0[2], v0[3]); w.z = cvt_pk_bf16(v1[0], v1[1]); w.w = cvt_pk_bf16(v1[2], v1[3]);
                    *(u32x4*)(rowp + bj * HALF) = w; } }
    }
};
template <bool POOL> struct MixOrder {
    StaticOrder so; int nmain, nN, kdiv, ntot, G, c;
    __device__ void init(int N, int K, int G_, int c_) { nN = N / BM; so.init(32 * BM, N, G_, c_); nmain = 32 * nN; kdiv = (POOL ? 512 : K) / 256; ntot = nmain + nN * kdiv; G = G_; c = c_; }
    __device__ bool next(int i, Unit& u) const {
        const int L = i * G + c; if (L >= ntot) return false;
        if (L < nmain) return so.next(i, u);
        const int j = L - nmain; u.pm = 32; u.pn = j % nN; u.kc = j / nN; return true;
    }
    __device__ __forceinline__ int nt(const Unit& u, const Gemm& g) const { return u.kc >= 0 ? 4 : (POOL ? 8 : g.K / BK); }
    __device__ __forceinline__ size_t a_off(const Unit& u, const Gemm& g) const { return (size_t)u.pm * BM * g.lda * 2 + (size_t)((POOL ? (u.pn >> 1) * 512 : 0) + (u.kc >= 0 ? u.kc * 256 : 0)) * 2; }
    __device__ __forceinline__ size_t b_off(const Unit& u, const Gemm& g) const { return (size_t)u.pn * BM * g.ldb * 2 + (size_t)((POOL ? (u.pn >> 1) * 512 : 0) + (u.kc >= 0 ? u.kc * 256 : 0)) * 2; }
    __device__ __forceinline__ void a_ready(const Unit&) const {}
    __device__ __forceinline__ void done(const Unit&) const {}
};
template <int PROW> struct EpiF32S {
    static constexpr bool PERM = false, AFTER_DRAIN = false;
    bf16_t* C; int ldc; const float* cscale; float* PART;
    __device__ __forceinline__ f32x4 scl(int c) const { return cscale ? *(const f32x4*)(cscale + c) : (f32x4){1.f, 1.f, 1.f, 1.f}; }
    __device__ __forceinline__ void operator()(const f32x4 (&acc)[2][2][4][2], const Unit& u, int wr, int wc, int fr, int fq) const {
        asm volatile("" : "+v"(fr), "+v"(fq));
        const int col0 = u.pn * BM + wc * 32 + 4 * fq;
        if (u.kc < 0) {
            bf16_t* Ct = C + (size_t)u.pm * BM * ldc; const unsigned e0 = (unsigned)((wr * 64 + fr) * ldc + col0);
#pragma unroll
            for (int bj = 0; bj < 2; ++bj)
#pragma unroll
                for (int n = 0; n < 2; ++n) { const f32x4 sv = scl(col0 + bj * HALF + n * 16);
#pragma unroll
                    for (int ai = 0; ai < 2; ++ai)
#pragma unroll
                        for (int m = 0; m < 4; ++m) { const f32x4 v = acc[ai][bj][m][n] * sv; const unsigned w0 = cvt_pk_bf16(v[0], v[1]), w1 = cvt_pk_bf16(v[2], v[3]);
                            *(unsigned long long*)(Ct + e0 + (unsigned)((ai * HALF + m * 16) * ldc) + bj * HALF + n * 16) = (unsigned long long)w0 | ((unsigned long long)w1 << 32); } }
        } else if (PROW == 256) {
            float* Pk = PART + (size_t)u.kc * 256 * ldc; const unsigned e0 = (unsigned)((wr * 64 + fr) * ldc + col0);
#pragma unroll
            for (int bj = 0; bj < 2; ++bj)
#pragma unroll
                for (int n = 0; n < 2; ++n) { const f32x4 sv = scl(col0 + bj * HALF + n * 16);
#pragma unroll
                    for (int ai = 0; ai < 2; ++ai)
#pragma unroll
                        for (int m = 0; m < 4; ++m) *(f32x4*)(Pk + e0 + (unsigned)((ai * HALF + m * 16) * ldc) + bj * HALF + n * 16) = acc[ai][bj][m][n] * sv; }
        } else if (wr == 0) {
            float* Pk = PART + (size_t)u.kc * 64 * ldc; const unsigned e0 = (unsigned)(fr * ldc + col0);
#pragma unroll
            for (int bj = 0; bj < 2; ++bj)
#pragma unroll
                for (int n = 0; n < 2; ++n) { const f32x4 sv = scl(col0 + bj * HALF + n * 16);
#pragma unroll
                    for (int m = 0; m < 4; ++m) *(f32x4*)(Pk + e0 + (unsigned)(m * 16 * ldc) + bj * HALF + n * 16) = acc[0][bj][m][n] * sv; }
        }
    }
};
template <class Epi, class Sched, bool ALIGN_EPI = false, bool SP2 = false>
__device__ __forceinline__ void gemm_phase(PG8_LAS unsigned char* lds, const Gemm g, const Sched& S, const Epi& E) {
    const int tid = threadIdx.x, wid = __builtin_amdgcn_readfirstlane(tid >> 6), lane = tid & 63, wr = wid >> 2, wc = wid & 3, fr = lane & 15, fq = lane >> 4;
    unsigned voffA[2], voffB[2];
#pragma unroll
    for (int i = 0; i < 2; ++i) { int R, C; stage_rc(tid * 16 + i * 8192, R, C); const int Rb = Epi::PERM ? ((R & ~31) + perm32(R & 31)) : R;
        voffA[i] = (unsigned)(R * g.lda + C) * 2u; voffB[i] = (unsigned)(Rb * g.ldb + C) * 2u; }
    const size_t kstep = (size_t)(BK * 2);
    const size_t hsA = (size_t)HALF * g.lda * 2, hsB = (size_t)HALF * g.ldb * 2;
    const unsigned ldsw = (unsigned)wid * 1024u;
    const int aoff = lds_byte(wr * 64 + fr, fq * 8), boff = lds_byte(wc * 32 + fr, fq * 8);
#define PG8_SA(b, h) (((b) * 2 + (h)) * HTB)
#define PG8_SB(b, h) ((4 + (b) * 2 + (h)) * HTB)
#define PG8_STAGE(bufoff, gbase, voff) do { _Pragma("unroll") for (int _i = 0; _i < 2; ++_i) \
        __builtin_amdgcn_global_load_lds((const unsigned*)((const char*)(gbase) + (voff)[_i]), (PG8_LAS unsigned*)(lds + (bufoff) + ldsw + _i * 8192), 16, 0, 0); } while (0)
#define PG8_LDA(dst, b, h) do { _Pragma("unroll") for (int m = 0; m < 4; ++m) _Pragma("unroll") for (int k = 0; k < 2; ++k) dst[m][k] = *(const PG8_LAS bf16x8*)(lds + PG8_SA(b, h) + aoff + m * 2048 + k * 1024); } while (0)
#define PG8_LDB(dst, b, h) do { _Pragma("unroll") for (int n = 0; n < 2; ++n) _Pragma("unroll") for (int k = 0; k < 2; ++k) dst[n][k] = *(const PG8_LAS bf16x8*)(lds + PG8_SB(b, h) + boff + n * 2048 + k * 1024); } while (0)
#define PG8_MMA(ai, bj, At, Bt) do { __builtin_amdgcn_s_setprio(1); _Pragma("unroll") for (int m = 0; m < 4; ++m) _Pragma("unroll") for (int n = 0; n < 2; ++n) _Pragma("unroll") for (int k = 0; k < 2; ++k) \
        acc[ai][bj][m][n] = __builtin_amdgcn_mfma_f32_16x16x32_bf16(Bt[n][k], At[m][k], acc[ai][bj][m][n], 0, 0, 0); __builtin_amdgcn_s_setprio(0); } while (0)
#define PG8_WAIT_V(n) asm volatile("s_waitcnt vmcnt(" #n ")" ::: "memory")
#define PG8_WAIT_L(n) asm volatile("s_waitcnt lgkmcnt(" #n ")" ::: "memory")
#define PG8_BAR __builtin_amdgcn_s_barrier()
#define PG8_SCHED __builtin_amdgcn_sched_barrier(0)
    Unit cur, nxt; int ui = 0;
    if (!S.next(0, cur)) return;
    int nt = S.nt(cur, g);
    f32x4 acc[2][2][4][2];
#pragma unroll
    for (int a = 0; a < 2; ++a)
#pragma unroll
        for (int b = 0; b < 2; ++b)
#pragma unroll
            for (int m = 0; m < 4; ++m)
#pragma unroll
                for (int n = 0; n < 2; ++n) acc[a][b][m][n] = (f32x4){0.f, 0.f, 0.f, 0.f};
    bf16x8 At[4][2], B0[2][2], B1[2][2];
    const char* cA = (const char*)g.A + S.a_off(cur, g); const char* cB = (const char*)g.Bt + S.b_off(cur, g);
    S.a_ready(cur);
    if constexpr (SP2) {
        PG8_STAGE(PG8_SB(0, 0), cB, voffB); PG8_STAGE(PG8_SB(0, 1), cB + hsB, voffB); PG8_STAGE(PG8_SA(0, 0), cA, voffA); PG8_STAGE(PG8_SA(0, 1), cA + hsA, voffA);
        if (wr == 1) PG8_BAR;
        PG8_WAIT_V(2); PG8_BAR;
        PG8_STAGE(PG8_SB(1, 0), cB + kstep, voffB); PG8_STAGE(PG8_SA(1, 0), cA + kstep, voffA); PG8_STAGE(PG8_SB(1, 1), cB + hsB + kstep, voffB);
        PG8_WAIT_V(6); PG8_BAR;
    } else {
        PG8_STAGE(PG8_SB(0, 0), cB, voffB); PG8_STAGE(PG8_SA(0, 0), cA, voffA); PG8_STAGE(PG8_SB(0, 1), cB + hsB, voffB); PG8_STAGE(PG8_SA(0, 1), cA + hsA, voffA);
        if (wr == 1) PG8_BAR;
        PG8_WAIT_V(4); PG8_BAR;
        PG8_STAGE(PG8_SB(1, 0), cB + kstep, voffB); PG8_STAGE(PG8_SA(1, 0), cA + kstep, voffA); PG8_STAGE(PG8_SB(1, 1), cB + hsB + kstep, voffB);
        PG8_WAIT_V(6); PG8_BAR;
    }
    for (;;) {
        const bool has_next = S.next(ui + 1, nxt);
        const char* nA = has_next ? (const char*)g.A + S.a_off(nxt, g) : cA; const char* nB = has_next ? (const char*)g.Bt + S.b_off(nxt, g) : cB;
        for (int t = 0; t < nt; t += 2) {
            const bool last = (t == nt - 2);
            const char* a1 = cA + (size_t)(t + 1) * kstep;
            const char* a2 = last ? nA : cA + (size_t)(t + 2) * kstep; const char* b2 = last ? nB : cB + (size_t)(t + 2) * kstep;
            const char* a3 = a2 + kstep; const char* b3 = b2 + kstep;
            if (last && has_next) S.a_ready(nxt);
            if constexpr (SP2) {
            PG8_LDB(B0, 0, 0); PG8_LDB(B1, 0, 1); PG8_SCHED; PG8_LDA(At, 0, 0); PG8_STAGE(PG8_SA(1, 1), a1 + hsA, voffA);
            PG8_WAIT_V(8); PG8_WAIT_L(0); PG8_BAR; PG8_MMA(0, 0, At, B0); PG8_MMA(0, 1, At, B1); PG8_BAR; PG8_SCHED;
            PG8_LDA(At, 0, 1); PG8_STAGE(PG8_SB(0, 0), b2, voffB); PG8_STAGE(PG8_SB(0, 1), b2 + hsB, voffB); PG8_STAGE(PG8_SA(0, 0), a2, voffA);
            PG8_WAIT_V(8); PG8_WAIT_L(0); PG8_BAR; PG8_MMA(1, 0, At, B0); PG8_MMA(1, 1, At, B1); PG8_BAR; PG8_SCHED;
            PG8_LDB(B0, 1, 0); PG8_LDB(B1, 1, 1); PG8_SCHED; PG8_LDA(At, 1, 0); PG8_STAGE(PG8_SA(0, 1), a2 + hsA, voffA);
            PG8_WAIT_V(8); PG8_WAIT_L(0); PG8_BAR; PG8_MMA(0, 0, At, B0); PG8_MMA(0, 1, At, B1); PG8_BAR; PG8_SCHED;
            PG8_LDA(At, 1, 1); PG8_STAGE(PG8_SB(1, 0), b3, voffB); PG8_STAGE(PG8_SB(1, 1), b3 + hsB, voffB); PG8_STAGE(PG8_SA(1, 0), a3, voffA);
            PG8_WAIT_V(8); PG8_WAIT_L(0); PG8_BAR; PG8_MMA(1, 0, At, B0); PG8_MMA(1, 1, At, B1); PG8_BAR; PG8_SCHED;
            } else {
            PG8_LDB(B0, 0, 0); PG8_SCHED; PG8_LDA(At, 0, 0); PG8_STAGE(PG8_SA(1, 1), a1 + hsA, voffA);
            PG8_WAIT_L(8); PG8_BAR; PG8_WAIT_L(0); PG8_MMA(0, 0, At, B0); PG8_BAR; PG8_SCHED;
            PG8_LDB(B1, 0, 1); PG8_STAGE(PG8_SB(0, 0), b2, voffB);
            PG8_BAR; PG8_WAIT_L(0); PG8_MMA(0, 1, At, B1); PG8_BAR;
            PG8_LDA(At, 0, 1); PG8_STAGE(PG8_SA(0, 0), a2, voffA);
            PG8_BAR; PG8_WAIT_L(0); PG8_MMA(1, 0, At, B0); PG8_BAR; PG8_SCHED;
            PG8_STAGE(PG8_SB(0, 1), b2 + hsB, voffB);
            PG8_WAIT_V(6); PG8_BAR; PG8_MMA(1, 1, At, B1); PG8_BAR;
            PG8_LDB(B0, 1, 0); PG8_SCHED; PG8_LDA(At, 1, 0); PG8_STAGE(PG8_SA(0, 1), a2 + hsA, voffA);
            PG8_WAIT_L(8); PG8_BAR; PG8_WAIT_L(0); PG8_MMA(0, 0, At, B0); PG8_BAR; PG8_SCHED;
            PG8_LDB(B1, 1, 1); PG8_STAGE(PG8_SB(1, 0), b3, voffB);
            PG8_BAR; PG8_WAIT_L(0); PG8_MMA(0, 1, At, B1); PG8_BAR;
            PG8_LDA(At, 1, 1); PG8_STAGE(PG8_SA(1, 0), a3, voffA);
            PG8_BAR; PG8_WAIT_L(0); PG8_MMA(1, 0, At, B0); PG8_BAR; PG8_SCHED;
            PG8_STAGE(PG8_SB(1, 1), b3 + hsB, voffB);
            PG8_WAIT_V(6); PG8_BAR; PG8_MMA(1, 1, At, B1); PG8_BAR;
            }
        }
        if constexpr (ALIGN_EPI) { if (wr == 0) PG8_BAR; }
        if constexpr (!Epi::AFTER_DRAIN) { E(acc, cur, wr, wc, fr, fq); S.done(cur); }
        if (!has_next) break;
#pragma unroll
        for (int a = 0; a < 2; ++a)
#pragma unroll
            for (int b = 0; b < 2; ++b)
#pragma unroll
                for (int m = 0; m < 4; ++m)
#pragma unroll
                    for (int n = 0; n < 2; ++n) acc[a][b][m][n] = (f32x4){0.f, 0.f, 0.f, 0.f};
        cur = nxt; cA = nA; cB = nB; ++ui; nt = S.nt(cur, g);
        if constexpr (ALIGN_EPI) { if (wr == 1) PG8_BAR; }
    }
    PG8_WAIT_V(0);
    if constexpr (!ALIGN_EPI) { if (wr == 0) PG8_BAR; }
    PG8_BAR;
    if constexpr (Epi::AFTER_DRAIN) { E.fused(acc, cur, wr, wc, fr, fq, lds, wid, lane); S.done(cur); }
#undef PG8_SA
#undef PG8_SB
#undef PG8_STAGE
#undef PG8_LDA
#undef PG8_LDB
#undef PG8_MMA
#undef PG8_WAIT_V
#undef PG8_WAIT_L
#undef PG8_BAR
#undef PG8_SCHED
}
}

constexpr int DM = 2048, SEQ = 4096, NBATCH = 2, NPR = NBATCH * SEQ, DBAT = 8, DSEQ = 8, NSM = DBAT * DSEQ, NTOK = NPR + NSM, MP = 8448;
constexpr int HA = 8, DHA = 128, HB = 16, DHB = 64, DBR = 1024;
constexpr int BCOLS = 3520, INCOLS = 6592, INPAD = 6656, DFF = 8192, NPAGES = 128, PAGESZ = 128, PAST = 16384, PBUF = 15, NMR = 10;
constexpr float EPS_RMS = 1e-6f, EPS_LNX = 64e-5f, QK_SCALE = 0.08838834764831845f;
enum { I_XP = 0, I_XS, I_CK, I_CV, I_PT, I_SWKV, I_SSH, I_SPOOL, I_CP, I_CS, I_WADA, I_BADA, I_NG, I_WIN, I_WOUT, I_SBB, I_MU, I_W0, I_WUP, I_A0, I_AUP, I_GUP, I_KK, I_KA, I_RK, I_LNG, I_LNB, I_WPOOL, I_PSC, I_W1, I_W2, N_IN };
constexpr size_t O_YP = 0, O_YS = O_YP + (size_t)NPR * DM, O_KP = O_YS + (size_t)NSM * DM, O_VP = O_KP + (size_t)NPR * 1024, O_KS = O_VP + (size_t)NPR * 1024, O_VS = O_KS + (size_t)NSM * 1024,
                 O_WKVP = O_VS + (size_t)NSM * 1024, O_WKVS = O_WKVP + (size_t)NBATCH * HB * 64 * 64, O_SHP = O_WKVS + (size_t)DBAT * HB * 64 * 64, O_SHS = O_SHP + (size_t)NBATCH * BCOLS,
                 O_PLP = O_SHS + (size_t)DBAT * BCOLS, O_PLS = O_PLP + (size_t)NBATCH * PBUF * DM, O_END = O_PLS + (size_t)DBAT * PBUF * DM;
constexpr size_t MiB = 1u << 20;
constexpr size_t WS_CTL = 0, CTL_ZERO_BYTES = 64 * 1024, WS_MOD = 1 * MiB, WS_WIN = 2 * MiB, WS_WOUT = 28 * MiB, WS_W1 = 36 * MiB, WS_W2 = 100 * MiB, WS_WPOOL = 164 * MiB,
                 WS_H = 172 * MiB, WS_OAB = 205 * MiB, WS_M = 238 * MiB, WS_P = 271 * MiB, WS_OUT = 486 * MiB, WS_XR = 552 * MiB, WS_HF = 617 * MiB, WS_U = 682 * MiB,
                 WS_RWV = 814 * MiB, WS_SCL = 1072 * MiB, WS_G = 1075 * MiB, WS_Y = 1108 * MiB, WS_PU = 1141 * MiB, WS_Z = 1205 * MiB, WS_SC = 1237 * MiB, WS_QB = 1269 * MiB, WS_KB = 1286 * MiB, WS_VB = 1303 * MiB, WS_OP = 1320 * MiB, WS_CL = 1384 * MiB, WS_SPART = 1385 * MiB, WS_SCAR = 1394 * MiB, WS_LA = 1395 * MiB, WS_LWT = 1404 * MiB, WS_LWO = 1408 * MiB, WS_YC = 1508 * MiB, WS_PART = 1541 * MiB, WS_PARTU = 1558 * MiB, WS_END = 1575 * MiB;
static_assert(WS_WIN + (size_t)INPAD * DM * 2 <= WS_WOUT && WS_P + (size_t)MP * INPAD * 4 <= WS_OUT && WS_U + (size_t)MP * DFF * 2 <= WS_RWV && WS_RWV + (size_t)NTOK * HB * 512 * 4 <= WS_SCL, "ws map");
constexpr int CW_BAR = 4096;
constexpr int RING_BYTES = 131072, LDSCTL_OFF = RING_BYTES, MISC_OFF = LDSCTL_OFF + 320, LDS_BYTES = 147456;
constexpr int NWAVES = 8, NTHR = 512;

#define GAS __attribute__((address_space(1)))
#define LAS __attribute__((address_space(3)))
typedef unsigned short bf16;
__device__ __forceinline__ float ldbf(const bf16* p) { return __uint_as_float((unsigned)*p << 16); }
__device__ __forceinline__ float ldbf_nt(const bf16* p) { return __uint_as_float((unsigned)__builtin_nontemporal_load(p) << 16); }
typedef float f32x4 __attribute__((ext_vector_type(4)));
typedef float f32x2 __attribute__((ext_vector_type(2)));
typedef unsigned u32x2 __attribute__((ext_vector_type(2)));
typedef unsigned u32x4 __attribute__((ext_vector_type(4)));
#define LDS_WAIT() asm volatile("s_waitcnt lgkmcnt(0)" ::: "memory")
#define VM_WAIT() asm volatile("s_waitcnt vmcnt(0)" ::: "memory")
using pg8::cvt_pk_bf16;
constexpr size_t WS_PBH = WS_RWV, WS_LWH = WS_RWV + 64 * MiB;
static_assert((size_t)NPR * 3072 * 2 <= 64 * MiB && 128 * MiB <= (size_t)NPR * HB * 512 * 4, "bf16 prompt copies fit below the sample rows of RWV");
constexpr int PBLD = 3584;
struct EpiIn {
    static constexpr bool PERM = false, AFTER_DRAIN = false;
    bf16 *QB, *KB, *VB; float* PB; float* out; bf16* PBH;
    __device__ __forceinline__ void operator()(const pg8::f32x4 (&acc)[2][2][4][2], const pg8::Unit& u, int wr, int wc, int fr, int fq) const {
        const int row0 = u.pm * 256 + wr * 64 + fr, colt = u.pn * 256 + wc * 32 + 4 * fq;
        if (u.pn >= 12) {
#pragma unroll
            for (int ai = 0; ai < 2; ++ai)
#pragma unroll
                for (int m = 0; m < 4; ++m) {
                    if (u.pm < 32 && u.pn < 24) { bf16* rowh = PBH + (size_t)(row0 + ai * 128 + m * 16) * 3072 + (colt - 3072);
#pragma unroll
                        for (int bj = 0; bj < 2; ++bj)
#pragma unroll
                            for (int n = 0; n < 2; ++n) { const pg8::f32x4 v = acc[ai][bj][m][n]; u32x2 w; w.x = cvt_pk_bf16(v[0], v[1]); w.y = cvt_pk_bf16(v[2], v[3]); *(u32x2*)(rowh + bj * 128 + n * 16) = w; } }
                    else { float* rowp = PB + (size_t)(row0 + ai * 128 + m * 16) * PBLD + (colt - 3072);
#pragma unroll
                        for (int bj = 0; bj < 2; ++bj)
#pragma unroll
                            for (int n = 0; n < 2; ++n) *(pg8::f32x4*)(rowp + bj * 128 + n * 16) = acc[ai][bj][m][n]; } }
        } else {
            const int sel = u.pn >> 2, c0 = colt - sel * 1024;
            static_assert(WS_KB - WS_QB == WS_VB - WS_KB && O_VP - O_KP == (size_t)NPR * 1024 && O_VS - O_KS == (size_t)NSM * 1024, "q/k/v buffers are equally spaced");
            bf16* Bt = QB + (size_t)sel * ((WS_KB - WS_QB) / 2) + (size_t)u.pm * 256 * 1024;
            float* Ot = u.pm < 32 ? out + O_KP + (size_t)(sel ? sel - 1 : 0) * NPR * 1024 + (size_t)u.pm * 256 * 1024 : out + O_KS + (size_t)(sel ? sel - 1 : 0) * NSM * 1024;
            const int rl0 = wr * 64 + fr;
#pragma unroll
            for (int ai = 0; ai < 2; ++ai)
#pragma unroll
                for (int m = 0; m < 4; ++m) { const int rl = rl0 + ai * 128 + m * 16; const unsigned eo = (unsigned)(rl * 1024 + c0);
                    const bool wo = sel != 0 && (u.pm < 32 || rl < NSM);
#pragma unroll
                    for (int bj = 0; bj < 2; ++bj)
#pragma unroll
                        for (int n = 0; n < 2; ++n) { const pg8::f32x4 v = acc[ai][bj][m][n]; u32x2 w; w.x = cvt_pk_bf16(v[0], v[1]); w.y = cvt_pk_bf16(v[2], v[3]);
                            *(u32x2*)(Bt + eo + bj * 128 + n * 16) = w; if (wo) *(pg8::f32x4*)(Ot + eo + bj * 128 + n * 16) = v; }
                    asm volatile("" ::: "memory"); }
        }
    }
};

#define XB_TMO      128
#define XB_XCNT(j)  (256  + 64 * (j))
#define XB_XSUB(j)  (1280 + 64 * (j))
#define XB_XGEN(j)  (2304 + 64 * (j))
#define XB_TOP      3328
#define XB_TOPGEN   3392
#define XCD_BAR_WORDS 3456
#define XB_SPIN_CAP (1u << 18)

__device__ __forceinline__ unsigned xb_ld(unsigned* p)              { return __hip_atomic_load(p, __ATOMIC_RELAXED, __HIP_MEMORY_SCOPE_AGENT); }
__device__ __forceinline__ unsigned xb_add(unsigned* p, unsigned v) { return __hip_atomic_fetch_add(p, v, __ATOMIC_RELAXED, __HIP_MEMORY_SCOPE_AGENT); }
__device__ __forceinline__ unsigned xb_xcc_id() { return (unsigned)__builtin_amdgcn_s_getreg((3 << 11) | 20) & 0xFu; }
#define XB_SPIN(cond, bar) do { unsigned _sp = 0; while (cond) { __builtin_amdgcn_s_sleep(1); \
    if ((++_sp & 255u) == 0u) { if (xb_ld(&(bar)[XB_TMO])) break; if (_sp > XB_SPIN_CAP) { atomicAdd(&(bar)[XB_TMO], 1u); break; } } } } while (0)

struct XcdBarrier {
    unsigned* bar; unsigned x;
    volatile LAS unsigned* st;
};

__device__ __forceinline__ XcdBarrier xcd_barrier_post(unsigned* bar, volatile LAS unsigned* st) {
    XcdBarrier b; b.bar = bar; b.x = xb_xcc_id(); b.st = st;
    if (threadIdx.x == 0) (void)xb_add(&bar[XB_XCNT(b.x)], 1u);
    return b;
}
__device__ __forceinline__ void xcd_barrier_complete(unsigned* bar, unsigned x, unsigned& nloc, unsigned& nx) {
    const unsigned G = gridDim.x * gridDim.y * gridDim.z;
    unsigned sum, cnt, mine, sp = 0u;
    for (;;) {
        sum = 0u; cnt = 0u; mine = 0u;
#pragma unroll
        for (unsigned j = 0; j < 16; ++j) { const unsigned c = xb_ld(&bar[XB_XCNT(j)]); sum += c; cnt += (c > 0u) ? 1u : 0u; mine = (j == x) ? c : mine; }
        if (sum == G) break;
        __builtin_amdgcn_s_sleep(1);
        if ((++sp & 255u) == 0u) { if (xb_ld(&bar[XB_TMO])) break; if (sp > XB_SPIN_CAP) { atomicAdd(&bar[XB_TMO], 1u); break; } }
    }
    nloc = mine > 0u ? mine : 1u; nx = cnt > 0u ? cnt : 1u;
}

__device__ __forceinline__ void xcd_barrier(const XcdBarrier& b) {
    asm volatile("s_waitcnt vmcnt(0)" ::: "memory");
    __syncthreads();
    if (threadIdx.x == 0) {
        unsigned* bar = b.bar;
        __builtin_amdgcn_s_waitcnt(0);
        unsigned nloc = b.st[0], nx = b.st[1];
        if (nloc == 0u) { xcd_barrier_complete(bar, b.x, nloc, nx); b.st[0] = nloc; b.st[1] = nx; }
        const unsigned old = xb_add(&bar[XB_XSUB(b.x)], 1u);
        const unsigned gen = old / nloc;
        if (old + 1u == (gen + 1u) * nloc) {
            __builtin_amdgcn_fence(__ATOMIC_RELEASE, "agent");
            asm volatile("s_waitcnt vmcnt(0)" ::: "memory");
            const unsigned og = xb_add(&bar[XB_TOP], 1u);
            const unsigned tg = og / nx;
            if (og + 1u == (tg + 1u) * nx) xb_add(&bar[XB_TOPGEN], 1u);
            else XB_SPIN(xb_ld(&bar[XB_TOPGEN]) == tg, bar);
            __builtin_amdgcn_fence(__ATOMIC_ACQUIRE, "agent");
            xb_add(&bar[XB_XGEN(b.x)], 1u);
            asm volatile("s_waitcnt vmcnt(0)" ::: "memory");
        } else {
            XB_SPIN(xb_ld(&bar[XB_XGEN(b.x)]) == gen, bar);
            __builtin_amdgcn_fence(__ATOMIC_ACQUIRE, "agent");
            asm volatile("s_waitcnt vmcnt(0)" ::: "memory");
        }
    }
    __syncthreads();
}


struct Ctx {
    LAS unsigned char* lds; int tid, lane, wave, vcu, G;
    __device__ __forceinline__ const float* in(int i) const { return ((const float* const __attribute__((address_space(4)))*)__builtin_amdgcn_kernarg_segment_ptr())[i]; }
    __device__ __forceinline__ float* outp() const { return ((float* const __attribute__((address_space(4)))*)__builtin_amdgcn_kernarg_segment_ptr())[N_IN]; }
    __device__ __forceinline__ unsigned char* wsp() const { return ((unsigned char* const __attribute__((address_space(4)))*)__builtin_amdgcn_kernarg_segment_ptr())[N_IN + 1]; }
};
template <int CTRL> __device__ __forceinline__ float dpp_f(float x) { return __builtin_bit_cast(float, __builtin_amdgcn_mov_dpp(__builtin_bit_cast(int, x), CTRL, 0xf, 0xf, true)); }
#define readlane_f(x, l) __builtin_bit_cast(float, __builtin_amdgcn_readlane(__builtin_bit_cast(int, (float)(x)), (l)))
__device__ __forceinline__ float wave_sum(float v) {
    v += dpp_f<0xB1>(v); v += dpp_f<0x4E>(v); v += dpp_f<0x141>(v); v += dpp_f<0x140>(v);
    auto s = __builtin_amdgcn_permlane16_swap(__float_as_uint(v), __float_as_uint(v), false, false);
    v = __uint_as_float(s[0]) + __uint_as_float(s[1]);
    auto t = __builtin_amdgcn_permlane32_swap(__float_as_uint(v), __float_as_uint(v), false, false);
    return __uint_as_float(t[0]) + __uint_as_float(t[1]);
}
__device__ __forceinline__ float sigmoidf_(float x) { return 1.f / (1.f + __expf(-x)); }
__device__ __forceinline__ float softplusf_(float x) { return fmaxf(x, 0.f) + log1pf(__expf(-fabsf(x))); }
__device__ __forceinline__ int mod_row(int r) { return r < NPR ? (r >> 12) : 2 + ((r - NPR) >> 3); }
#define WSP(T, off) ((T*)(F.wsp() + (off)))

struct CvtItem { const float* W; bf16* WT; int ldw, ldt, k0, n0; };
__device__ __forceinline__ void item_load(float (&tv)[32], const CvtItem& d, int lane) {
#pragma unroll
    for (int i = 0; i < 32; ++i) tv[i] = __builtin_nontemporal_load(d.W + (size_t)(d.k0 + 2 * i + (lane >> 5)) * d.ldw + d.n0 + (lane & 31));
}
__device__ __forceinline__ void item_store(const float (&tv)[32], const CvtItem& d, LAS float* scr, int lane) {
#pragma unroll
    for (int i = 0; i < 32; ++i) scr[(2 * i + (lane >> 5)) * 33 + (lane & 31)] = tv[i];
    LDS_WAIT(); asm volatile("" ::: "memory");
    const int c = lane & 7;
#pragma unroll
    for (int j = 0; j < 4; ++j) { const int n = (lane >> 3) + 8 * j; const LAS float* s = scr + (8 * c) * 33 + n;
        u32x4 o; o.x = cvt_pk_bf16(s[0 * 33], s[1 * 33]); o.y = cvt_pk_bf16(s[2 * 33], s[3 * 33]); o.z = cvt_pk_bf16(s[4 * 33], s[5 * 33]); o.w = cvt_pk_bf16(s[6 * 33], s[7 * 33]);
        *(GAS u32x4*)(d.WT + (size_t)(d.n0 + n) * d.ldt + d.k0 + 8 * c) = o; }
    LDS_WAIT(); asm volatile("" ::: "memory");
}
constexpr int IT_IN = 32 * 206, IT_OUT = 32 * 64, IT_W1 = 32 * 256, IT_W2 = 128 * 64, IT_PL = 8 * 16, NIT_ALL = IT_IN + IT_OUT + 2 * IT_W1 + 2 * IT_W2 + 4 * IT_PL;
__device__ __forceinline__ CvtItem item_decode(Ctx& F, int it) {
    int r = it; CvtItem d; int N;
    if (r < IT_IN) { d.W = F.in(I_WIN); d.WT = WSP(bf16, WS_WIN); N = INCOLS; d.ldt = DM; }
    else if ((r -= IT_IN) < IT_OUT) { d.W = F.in(I_WOUT); d.WT = WSP(bf16, WS_WOUT); N = DM; d.ldt = DM; }
    else if ((r -= IT_OUT) < 2 * IT_W1) { const int l = r / IT_W1; r -= l * IT_W1; d.W = F.in(I_W1) + (size_t)l * DM * DFF; d.WT = WSP(bf16, WS_W1) + (size_t)l * DFF * DM; N = DFF; d.ldt = DM; }
    else if ((r -= 2 * IT_W1) < 2 * IT_W2) { const int l = r / IT_W2; r -= l * IT_W2; d.W = F.in(I_W2) + (size_t)l * DFF * DM; d.WT = WSP(bf16, WS_W2) + (size_t)l * DM * DFF; N = DM; d.ldt = DFF; }
    else { r -= 2 * IT_W2; const int g = r / IT_PL; r -= g * IT_PL; d.W = F.in(I_WPOOL) + (size_t)g * 512 * 512; d.WT = WSP(bf16, WS_WPOOL) + (size_t)(g * 512) * DM + g * 512; N = 512; d.ldt = DM; }
    const int nblk = N / 32, kb = r / nblk, nb = r - kb * nblk;
    d.ldw = N; d.k0 = 64 * kb; d.n0 = 32 * nb; return d;
}
__device__ __forceinline__ void convert_run(Ctx& F, int first, int stride, int lim, LAS float* scr) {
    int it = first; if (it >= lim) return;
    float ta[32], tb[32]; CvtItem da = item_decode(F, it), db = da; item_load(ta, da, F.lane);
    for (;;) {
        const int i2 = it + stride; const bool h2 = i2 < lim; if (h2) { db = item_decode(F, i2); item_load(tb, db, F.lane); }
        item_store(ta, da, scr, F.lane); if (!h2) break;
        const int i3 = i2 + stride; const bool h3 = i3 < lim; if (h3) { da = item_decode(F, i3); item_load(ta, da, F.lane); }
        item_store(tb, db, scr, F.lane); if (!h3) break;
        it = i3; }
}
constexpr int NCVT = 40, N_HIDE = 24000;
__device__ __forceinline__ void phase_prologue(Ctx& F) {
    LAS float* scr = (LAS float*)(F.lds + F.wave * 16384);
    const int gw = F.vcu * NWAVES + F.wave, NGW = F.G * NWAVES;
    convert_run(F, gw, NGW, IT_IN, scr);
    if (F.G > NCVT + 8) convert_run(F, IT_IN + N_HIDE + gw, NGW, NIT_ALL, scr); else convert_run(F, IT_IN + gw, NGW, NIT_ALL, scr);
    for (int i = F.vcu * NTHR + F.tid; i < 3072 * 64; i += F.G * NTHR) {
        const int kc = i / 3072, n = i - kc * 3072, reg = n >> 10, nn = n & 1023;
        float v[8];
        if (reg == 0) {
#pragma unroll
            for (int j = 0; j < 8; ++j) { const int k = 8 * kc + j; v[j] = (k < 96) ? F.in(I_WUP)[(size_t)k * 1024 + nn] : 0.f; } }
        else if (reg == 1) {
#pragma unroll
            for (int j = 0; j < 8; ++j) { const int k = 8 * kc + j - 96; v[j] = (k >= 0 && k < 96) ? F.in(I_AUP)[(size_t)k * 1024 + nn] : 0.f; } }
        else {
#pragma unroll
            for (int j = 0; j < 8; ++j) { const int k = 8 * kc + j - 192; v[j] = (k >= 0 && k < 256) ? F.in(I_GUP)[(size_t)k * 1024 + nn] : 0.f; } }
        u32x4 o; o.x = cvt_pk_bf16(v[0], v[1]); o.y = cvt_pk_bf16(v[2], v[3]); o.z = cvt_pk_bf16(v[4], v[5]); o.w = cvt_pk_bf16(v[6], v[7]);
        *(GAS u32x4*)(WSP(bf16, WS_LWT) + (size_t)n * 512 + 8 * kc) = o;
    }
    __syncthreads();
    LAS float* sc = (LAS float*)F.lds;
    LAS float* part = (LAS float*)(F.lds + 81920);
    for (int i = F.tid; i < NMR * DM; i += NTHR) { const int r = i >> 11, k = i & 2047; const float c = r < 2 ? F.in(I_CP)[r * DM + k] : F.in(I_CS)[(r - 2) * DM + k]; sc[i] = c / (1.f + __expf(-c)); }
    __syncthreads();
    float* MOD = WSP(float, WS_MOD);
    float* MODP = WSP(float, WS_G);
    for (int u = F.vcu; u < 512; u += F.G) {
        const bool whole = u < 256; const int task = whole ? u : 256 + ((u - 256) >> 1), kh = whole ? 0 : (u - 256) & 1, klen = whole ? 256 : 128;
        const int l = task / 192, cb = (task - l * 192) * 64;
        const float* W = F.in(I_WADA) + (size_t)l * DM * 12288 + cb + F.lane;
        float acc[NMR];
#pragma unroll
        for (int r = 0; r < NMR; ++r) acc[r] = 0.f;
        const int kbeg = kh * 1024 + F.wave * klen;
        for (int k = kbeg; k < kbeg + klen; k += 16) {
            float wv[16];
#pragma unroll
            for (int j = 0; j < 16; ++j) wv[j] = __builtin_nontemporal_load(W + (size_t)(k + j) * 12288);
#pragma unroll
            for (int j = 0; j < 16; j += 4)
#pragma unroll
                for (int r = 0; r < NMR; ++r) { const f32x4 s = *(const LAS f32x4*)(sc + r * DM + k + j); acc[r] += (s.x * wv[j] + s.y * wv[j + 1]) + (s.z * wv[j + 2] + s.w * wv[j + 3]); }
        }
#pragma unroll
        for (int r = 0; r < NMR; ++r) part[(F.wave * NMR + r) * 64 + F.lane] = acc[r];
        __syncthreads();
        for (int i = F.tid; i < NMR * 64; i += NTHR) { const int r = i >> 6, c = i & 63; float s = 0.f;
#pragma unroll
            for (int w = 0; w < NWAVES; ++w) s += part[(w * NMR + r) * 64 + c];
            if (kh == 0) s += F.in(I_BADA)[l * 12288 + cb + c];
            if (whole) MOD[(size_t)(l * NMR + r) * 12288 + cb + c] = s; else MODP[((size_t)kh * NMR + r) * 8192 + (cb - 4096) + c] = s; }
        __syncthreads();
    }
}

struct Row { f32x4 v[8]; };
__device__ __forceinline__ void row_load(Row& R, const float* p, int lane) {
#pragma unroll
    for (int j = 0; j < 8; ++j) R.v[j] = *(const GAS f32x4*)(p + j * 256 + lane * 4);
}
__device__ __forceinline__ void row_load_bf16(Row& R, const bf16* p, int lane) {
#pragma unroll
    for (int j = 0; j < 8; ++j) { const u32x2 w = *(const GAS u32x2*)(p + j * 256 + lane * 4);
        R.v[j] = (f32x4){__uint_as_float(w.x << 16), __uint_as_float(w.x & 0xffff0000u), __uint_as_float(w.y << 16), __uint_as_float(w.y & 0xffff0000u)}; }
}
__device__ __forceinline__ float row_sumsq(const Row& R) { float s = 0.f;
#pragma unroll
    for (int j = 0; j < 8; ++j) s += (R.v[j].x * R.v[j].x + R.v[j].y * R.v[j].y) + (R.v[j].z * R.v[j].z + R.v[j].w * R.v[j].w);
    return wave_sum(s); }
__device__ __forceinline__ const float* x_in_row(Ctx& F, int r) { return r < NPR ? F.in(I_XP) + (size_t)r * DM : F.in(I_XS) + (size_t)(r - NPR) * DM; }
__device__ __forceinline__ void row_modulate(Row& H, const Row& X, float rstd, const float* g, const float* shift, const float* scale, int lane) {
#pragma unroll
    for (int j = 0; j < 8; ++j) { const int c = j * 256 + lane * 4; const f32x4 gg = *(const GAS f32x4*)(g + c), sh = *(const GAS f32x4*)(shift + c), sc = *(const GAS f32x4*)(scale + c);
        H.v[j] = X.v[j] * rstd * gg * (sc + 1.f) + sh; }
}
__device__ __forceinline__ void row_store_bf16(const Row& H, bf16* p, int lane) {
#pragma unroll
    for (int j = 0; j < 8; ++j) { u32x2 w; w.x = cvt_pk_bf16(H.v[j].x, H.v[j].y); w.y = cvt_pk_bf16(H.v[j].z, H.v[j].w); *(GAS u32x2*)(p + j * 256 + lane * 4) = w; }
}
__device__ __forceinline__ void row_store_f32(const Row& H, float* p, int lane) {
#pragma unroll
    for (int j = 0; j < 8; ++j) *(GAS f32x4*)(p + j * 256 + lane * 4) = H.v[j];
}
__device__ __forceinline__ void row_store_f32_nt(const Row& H, float* p, int lane) {
#pragma unroll
    for (int j = 0; j < 8; ++j) __builtin_nontemporal_store(H.v[j], (GAS f32x4*)(p + j * 256 + lane * 4));
}
struct RowB { u32x2 w[8]; };
__device__ __forceinline__ void rowb_load(RowB& R, const bf16* p, int lane) {
#pragma unroll
    for (int j = 0; j < 8; ++j) R.w[j] = *(const GAS u32x2*)(p + j * 256 + lane * 4);
}
__device__ __forceinline__ void rowb_cvt(Row& R, const RowB& B) {
#pragma unroll
    for (int j = 0; j < 8; ++j) R.v[j] = (f32x4){__uint_as_float(B.w[j].x << 16), __uint_as_float(B.w[j].x & 0xffff0000u), __uint_as_float(B.w[j].y << 16), __uint_as_float(B.w[j].y & 0xffff0000u)};
}
constexpr int PSET_FLOATS = 3 * DM;
static_assert(NSM == 64 && 3 * PSET_FLOATS * 4 + 7 * DM * 4 <= RING_BYTES, "row phases: 8 workgroups x 8 waves take the sample rows; three parameter sets in LDS");
template <int KIND, int L> __device__ __forceinline__ void stage_row_params(Ctx& F) {
    const float* MOD = WSP(float, WS_MOD); const float* ng = F.in(I_NG) + (size_t)L * 4 * DM;
    const int nset = F.vcu < 64 ? 3 : 2;
#define RP_LD4(p) (*(const GAS f32x4*)(p))
    for (int i = F.tid; i < nset * (DM / 4); i += NTHR) {
        const int s = i >> 9, c = (i & 511) * 4, mr = s < 2 ? s : 2 + (F.vcu >> 3);
        const float* m = MOD + (size_t)(L * NMR + mr) * 12288;
        f32x4 v0 = {0.f, 0.f, 0.f, 0.f}, v1 = v0, v2 = v0;
        if (KIND == 0) { v1 = RP_LD4(ng + c) * (RP_LD4(m + DM + c) + 1.f); v2 = RP_LD4(m + c); }
        else if (KIND == 1) { v0 = RP_LD4(m + 2 * DM + c) * RP_LD4(ng + DM + c); v1 = RP_LD4(ng + 2 * DM + c) * (RP_LD4(m + 4 * DM + c) + 1.f); v2 = RP_LD4(m + 3 * DM + c); }
        else { v0 = RP_LD4(m + 5 * DM + c) * RP_LD4(ng + 3 * DM + c);
               if (KIND == 2) { const float* m1 = MOD + (size_t)(1 * NMR + mr) * 12288; v1 = RP_LD4(F.in(I_NG) + (size_t)4 * DM + c) * (RP_LD4(m1 + DM + c) + 1.f); v2 = RP_LD4(m1 + c); } }
        LAS float* d = (LAS float*)F.lds + s * PSET_FLOATS + c;
        *(LAS f32x4*)d = v0; *(LAS f32x4*)(d + DM) = v1; *(LAS f32x4*)(d + 2 * DM) = v2;
    }
#undef RP_LD4
    __syncthreads();
}
__device__ __forceinline__ const LAS float* row_pset(Ctx& F, int r) { return (const LAS float*)F.lds + (r < NPR ? (r >> 12) : 2) * PSET_FLOATS; }
__device__ __forceinline__ void row_residual_l(Row& X, const Row& O, const LAS float* ps, int lane) {
    const float rstd = rsqrtf(row_sumsq(O) * (1.f / DM) + EPS_RMS);
#pragma unroll
    for (int j = 0; j < 8; ++j) { const f32x4 gt = *(const LAS f32x4*)(ps + j * 256 + lane * 4); X.v[j] = X.v[j] + gt * (O.v[j] * rstd); }
}
__device__ __forceinline__ void row_modulate_l(Row& H, const Row& X, const LAS float* ps, int lane) {
    const float rstd = rsqrtf(row_sumsq(X) * (1.f / DM) + EPS_RMS);
#pragma unroll
    for (int j = 0; j < 8; ++j) { const int c = j * 256 + lane * 4; const f32x4 a = *(const LAS f32x4*)(ps + DM + c), sh = *(const LAS f32x4*)(ps + 2 * DM + c); H.v[j] = X.v[j] * rstd * a + sh; }
}
__device__ __forceinline__ void phase_mod0(Ctx& F) {
    stage_row_params<0, 0>(F);
    const int gw = F.vcu * NWAVES + F.wave, NGW = F.G * NWAVES, samp = (F.vcu < 64 && F.wave == 0) ? NPR + F.vcu : NTOK; bf16* Hb = WSP(bf16, WS_H);
    Row Xn; row_load(Xn, x_in_row(F, gw), F.lane);
    for (int r = gw; r < NPR; r += NGW) {
        Row X = Xn, H; const int rn = r + NGW, rp = rn < NPR ? rn : (samp < NTOK ? samp : r);
        row_load(Xn, x_in_row(F, rp), F.lane);
        row_modulate_l(H, X, row_pset(F, r), F.lane);
        row_store_bf16(H, Hb + (size_t)r * DM, F.lane);
    }
    if (samp < NTOK) { Row H; row_modulate_l(H, Xn, row_pset(F, samp), F.lane); row_store_bf16(H, Hb + (size_t)samp * DM, F.lane); }
}
__device__ __forceinline__ void row_residual(Row& X, const Row& O, const float* ga, const float* gate, int lane) {
    const float rstd = rsqrtf(row_sumsq(O) * (1.f / DM) + EPS_RMS);
#pragma unroll
    for (int j = 0; j < 8; ++j) { const int c = j * 256 + lane * 4; const f32x4 gg = *(const GAS f32x4*)(ga + c), gt = *(const GAS f32x4*)(gate + c); X.v[j] = X.v[j] + gt * (O.v[j] * rstd * gg); }
}
template <int NK> __device__ __forceinline__ void row_load_out(Ctx& F, Row& O, int r, int lane) {
    if (r < NPR) { const bf16* op = WSP(bf16, WS_OUT) + (size_t)r * DM;
#pragma unroll
        for (int j = 0; j < 8; ++j) { const u32x2 w = *(const GAS u32x2*)(op + j * 256 + lane * 4);
            O.v[j] = (f32x4){__uint_as_float(w.x << 16), __uint_as_float(w.x & 0xffff0000u), __uint_as_float(w.y << 16), __uint_as_float(w.y & 0xffff0000u)}; }
        return; }
    const float* pp = WSP(float, WS_PART) + (size_t)(r - NPR) * DM;
    row_load(O, pp, lane);
    for (int kc = 1; kc < NK; ++kc) { Row T; row_load(T, pp + (size_t)kc * 64 * DM, lane);
#pragma unroll
        for (int j = 0; j < 8; ++j) O.v[j] += T.v[j]; }
}
__device__ __forceinline__ f32x4 ld_bf4(const bf16* p) { const u32x2 w = *(const GAS u32x2*)p; return (f32x4){__uint_as_float(w.x << 16), __uint_as_float(w.x & 0xffff0000u), __uint_as_float(w.y << 16), __uint_as_float(w.y & 0xffff0000u)}; }
__device__ __forceinline__ void row_load_pool(Ctx& F, Row& O, int r, int lane) {
    if (r < NPR) { const int t = r & (SEQ - 1); const bf16* op = WSP(bf16, WS_OUT) + (size_t)r * DM + lane * 4;
#pragma unroll
        for (int j8 = 0; j8 < 8; ++j8) { constexpr int dummy = 0; (void)dummy; const int wlen = 2 << (j8 >> 1), n = (t + 1) < wlen ? (t + 1) : wlen;
            const f32x4 cur = ld_bf4(op + j8 * 256); f32x4 sum = cur;
            for (int j = 1; j < n; ++j) sum += ld_bf4(op + j8 * 256 - (size_t)j * DM);
            O.v[j8] = sum * (1.f / (float)n) - cur; }
    } else { const int rs = r - NPR, b = rs >> 3, t = rs & 7; const float* pp = WSP(float, WS_PART) + lane * 4;
#pragma unroll
        for (int j8 = 0; j8 < 8; ++j8) { const int wlen = 2 << (j8 >> 1); f32x4 cur = {0.f, 0.f, 0.f, 0.f}, sum = {0.f, 0.f, 0.f, 0.f};
            for (int j = 0; j < wlen; ++j) { const int tj = t - j, pr = tj >= 0 ? rs - j : 64 + b * PBUF + PBUF + tj;
                const f32x4 g = *(const GAS f32x4*)(pp + (size_t)pr * DM + j8 * 256) + *(const GAS f32x4*)(pp + (size_t)(256 + pr) * DM + j8 * 256);
                sum += g; if (j == 0) cur = g; }
            O.v[j8] = sum * (1.f / (float)wlen) - cur; }
    }
}
template <int NK> __device__ __forceinline__ void sample_row_gather(Ctx& F, Row& O, int s) {
    constexpr int PER = NK / 8; const float* pp = WSP(float, WS_PART) + ((size_t)(F.wave * PER) * 64 + s) * DM; Row T[PER];
#pragma unroll
    for (int k = 0; k < PER; ++k) row_load(T[k], pp + (size_t)k * 64 * DM, F.lane);
    O = T[0];
#pragma unroll
    for (int k = 1; k < PER; ++k)
#pragma unroll
        for (int j = 0; j < 8; ++j) O.v[j] += T[k].v[j];
    LAS float* sl = (LAS float*)F.lds + 3 * PSET_FLOATS;
    if (F.wave > 0) {
#pragma unroll
        for (int j = 0; j < 8; ++j) *(LAS f32x4*)(sl + (F.wave - 1) * DM + j * 256 + F.lane * 4) = O.v[j]; }
    __syncthreads();
    if (F.wave == 0) {
#pragma unroll
        for (int w = 0; w < 7; ++w)
#pragma unroll
            for (int j = 0; j < 8; ++j) O.v[j] += *(const LAS f32x4*)(sl + w * DM + j * 256 + F.lane * 4); }
}
template <int L> __device__ __forceinline__ void phase_postmix(Ctx& F) {
    stage_row_params<1, L>(F);
    const int gw = F.vcu * NWAVES + F.wave, NGW = F.G * NWAVES, samp = (F.vcu < 64 && F.wave == 0) ? NPR + F.vcu : NTOK;
    bf16* Hb = WSP(bf16, WS_H); bf16* XR = WSP(bf16, WS_XR); const bf16* OUTb = WSP(bf16, WS_OUT);
    Row Xf; RowB Xb, Ob;
    if (L == 0) { row_load(Xf, x_in_row(F, gw), F.lane); rowb_load(Ob, OUTb + (size_t)gw * DM, F.lane); } else rowb_load(Xb, XR + (size_t)gw * DM, F.lane);
    for (int r = gw; r < NPR; r += NGW) {
        Row X, O, H; const int rn = r + NGW, rp = rn < NPR ? rn : (samp < NTOK ? samp : r), ro = rn < NPR ? rn : r;
        if (L == 0) { X = Xf; rowb_cvt(O, Ob); row_load(Xf, x_in_row(F, rp), F.lane); rowb_load(Ob, OUTb + (size_t)ro * DM, F.lane); }
        else { rowb_cvt(X, Xb); rowb_load(Xb, XR + (size_t)rp * DM, F.lane); row_load_pool(F, O, r, F.lane); }
        const LAS float* ps = row_pset(F, r);
        row_residual_l(X, O, ps, F.lane);
        row_store_bf16(X, XR + (size_t)r * DM, F.lane);
        row_modulate_l(H, X, ps, F.lane);
        row_store_bf16(H, Hb + (size_t)r * DM, F.lane);
    }
    Row Og; if (L == 0 && F.vcu < 64) sample_row_gather<8>(F, Og, F.vcu);
    if (samp < NTOK) { Row X, O, H; if (L == 0) { X = Xf; O = Og; } else { rowb_cvt(X, Xb); row_load_pool(F, O, samp, F.lane); }
        const LAS float* ps = row_pset(F, samp);
        row_residual_l(X, O, ps, F.lane);
        row_store_bf16(X, XR + (size_t)samp * DM, F.lane);
        row_modulate_l(H, X, ps, F.lane);
        row_store_bf16(H, Hb + (size_t)samp * DM, F.lane); }
}
template <int L> __device__ __forceinline__ void phase_postmlp(Ctx& F) {
    stage_row_params<L == 0 ? 2 : 3, L>(F);
    const int gw = F.vcu * NWAVES + F.wave, NGW = F.G * NWAVES, samp = (F.vcu < 64 && F.wave == 0) ? NPR + F.vcu : NTOK;
    bf16* XR = WSP(bf16, WS_XR); const bf16* OUTb = WSP(bf16, WS_OUT);
    RowB Xb, Ob; rowb_load(Xb, XR + (size_t)gw * DM, F.lane); rowb_load(Ob, OUTb + (size_t)gw * DM, F.lane);
    for (int r = gw; r < NPR; r += NGW) {
        Row X, O; const int rn = r + NGW, rp = rn < NPR ? rn : (samp < NTOK ? samp : r), ro = rn < NPR ? rn : r;
        rowb_cvt(X, Xb); rowb_cvt(O, Ob); rowb_load(Xb, XR + (size_t)rp * DM, F.lane); rowb_load(Ob, OUTb + (size_t)ro * DM, F.lane);
        const LAS float* ps = row_pset(F, r);
        row_residual_l(X, O, ps, F.lane);
        if (L == 0) {
            row_store_bf16(X, XR + (size_t)r * DM, F.lane);
            Row H; row_modulate_l(H, X, ps, F.lane);
            row_store_bf16(H, WSP(bf16, WS_H) + (size_t)r * DM, F.lane);
            const int t = r & (SEQ - 1); if (t >= SEQ - PBUF) row_store_f32(H, F.outp() + O_PLP + ((size_t)(r >> 12) * PBUF + (t - (SEQ - PBUF))) * DM, F.lane);
        } else row_store_f32_nt(X, F.outp() + O_YP + (size_t)r * DM, F.lane);
    }
    Row Og; if (F.vcu < 64) sample_row_gather<32>(F, Og, F.vcu);
    if (samp < NTOK) { Row X, O = Og; rowb_cvt(X, Xb);
        const LAS float* ps = row_pset(F, samp); const int rs = samp - NPR;
        row_residual_l(X, O, ps, F.lane);
        if (L == 0) {
            row_store_bf16(X, XR + (size_t)samp * DM, F.lane);
            Row H; row_modulate_l(H, X, ps, F.lane);
            row_store_bf16(H, WSP(bf16, WS_H) + (size_t)samp * DM, F.lane);
            row_store_f32(H, F.outp() + O_PLS + ((size_t)(rs >> 3) * PBUF + 7 + (rs & 7)) * DM, F.lane);
        } else row_store_f32_nt(X, F.outp() + O_YS + (size_t)rs * DM, F.lane); }
    if (L == 0) {
        const float* SP = F.in(I_SPOOL); bf16* Hb = WSP(bf16, WS_H);
        for (int i = F.vcu * NTHR + F.tid; i < DBAT * PBUF * 512; i += F.G * NTHR) { const int c4 = (i & 511) * 4, bi = i >> 9, b = bi / PBUF, k = bi - b * PBUF;
            const f32x4 v = *(const GAS f32x4*)(SP + (size_t)bi * DM + c4); u32x2 w; w.x = cvt_pk_bf16(v.x, v.y); w.y = cvt_pk_bf16(v.z, v.w);
            *(GAS u32x2*)(Hb + (size_t)(NTOK + bi) * DM + c4) = w;
            if (k >= 8) *(GAS f32x4*)(F.outp() + O_PLS + ((size_t)b * PBUF + (k - 8)) * DM + c4) = v; }
    }
}

__device__ __forceinline__ void phase_kv_prep(Ctx& F) {
    { const float* MODP = WSP(float, WS_G); float* MOD = WSP(float, WS_MOD);
      for (int i = F.vcu * NTHR + F.tid; i < NMR * 8192; i += F.G * NTHR) { const int r = i >> 13, c = i & 8191; MOD[(size_t)(1 * NMR + r) * 12288 + 4096 + c] = MODP[(size_t)r * 8192 + c] + MODP[((size_t)NMR + r) * 8192 + c]; } }
    const float* P = WSP(float, WS_P);
    for (int i = F.vcu * NTHR + F.tid; i < (NBATCH + DBAT) * BCOLS; i += F.G * NTHR) {
        const int b = i / BCOLS, c = i - b * BCOLS; const int r = b < NBATCH ? b * SEQ + SEQ - 1 : NPR + (b - NBATCH) * DSEQ + DSEQ - 1;
        F.outp()[(b < NBATCH ? O_SHP + (size_t)b * BCOLS : O_SHS + (size_t)(b - NBATCH) * BCOLS) + c] = (b < NBATCH && c < 3072) ? ldbf(WSP(bf16, WS_PBH) + (size_t)r * 3072 + c) : P[(size_t)r * PBLD + c];
    }
    { const int gw = F.vcu * NWAVES + F.wave, NGW = F.G * NWAVES; const float* mu = F.in(I_MU); bf16* LA = WSP(bf16, WS_LA);
      for (int r = gw; r < NTOK; r += NGW) {
        const float* pb = P + (size_t)r * PBLD; const float* prev; bool hp;
        if (r < NPR) { const int t = r & (SEQ - 1); hp = t > 0; prev = pb - PBLD; }
        else { const int rs = r - NPR, b = rs >> 3, t = rs & 7; hp = true; prev = t > 0 ? pb - PBLD : F.in(I_SSH) + (size_t)b * BCOLS; }
        float v[8];
        { const int c0 = 3072 + F.lane * 8; const bool act = F.lane < 56; const f32x4 z4 = {0.f, 0.f, 0.f, 0.f};
          f32x4 pa = z4, pc = z4, qa = z4, qc = z4, ma = z4, mc = z4;
          if (act) { pa = *(const GAS f32x4*)(pb + c0); pc = *(const GAS f32x4*)(pb + c0 + 4); ma = *(const GAS f32x4*)(mu + c0); mc = *(const GAS f32x4*)(mu + c0 + 4);
                     if (hp) { qa = *(const GAS f32x4*)(prev + c0); qc = *(const GAS f32x4*)(prev + c0 + 4); } }
          const f32x4 za = pa + ma * (qa - pa), zc = pc + mc * (qc - pc);
          const float kz = F.lane < 12 ? 2.f : 1.f;
#pragma unroll
          for (int j = 0; j < 8; ++j) { const float z = j < 4 ? za[j & 3] : zc[j & 3]; const float sg = 1.f / (1.f + __expf(-kz * z));
              v[j] = !act ? 0.f : (F.lane < 12 ? 2.f * sg - 1.f : (F.lane < 24 ? z : sg)); } }
        u32x4 o; o.x = cvt_pk_bf16(v[0], v[1]); o.y = cvt_pk_bf16(v[2], v[3]); o.z = cvt_pk_bf16(v[4], v[5]); o.w = cvt_pk_bf16(v[6], v[7]);
        *(GAS u32x4*)(LA + (size_t)r * 512 + F.lane * 8) = o;
      } }
}
__device__ __forceinline__ void phase_rwkv_prep(Ctx& F) {
    const float* P = WSP(float, WS_P); const float* LWO = WSP(float, WS_LWO);
    const int gw = F.vcu * NWAVES + F.wave, NGW = F.G * NWAVES;
    float* RWV = WSP(float, WS_RWV); float* SCL = WSP(float, WS_SCL);
    const float* mu = F.in(I_MU);
    for (int u = gw; u < NSM * 4; u += NGW) {
        const int r = NPR + (u >> 2), hq = u & 3;
        const float* pb = P + (size_t)r * PBLD; const float* prev; const bool hp = true;
        { const int rs = r - NPR, b = rs >> 3, t = rs & 7; prev = t > 0 ? pb - PBLD : F.in(I_SSH) + (size_t)b * BCOLS; }
        const float* lw = LWO + (size_t)r * 3072;
        float pr[4], pk[4], pv[4], qr_[4], qk[4], qv[4], lwl[4], lal[4], lgl[4];
#pragma unroll
        for (int i = 0; i < 4; ++i) { const int col = (hq * 4 + i) * 64 + F.lane;
            pr[i] = pb[col]; pk[i] = pb[1024 + col]; pv[i] = pb[2048 + col];
            qr_[i] = hp ? prev[col] : 0.f; qk[i] = hp ? prev[1024 + col] : 0.f; qv[i] = hp ? prev[2048 + col] : 0.f;
            lwl[i] = lw[col]; lal[i] = lw[1024 + col]; lgl[i] = lw[2048 + col]; }
#pragma unroll
        for (int i = 0; i < 4; ++i) { const int h = hq * 4 + i, col = h * 64 + F.lane;
            const float zr = pr[i] + mu[col] * (qr_[i] - pr[i]), zk = pk[i] + mu[1024 + col] * (qk[i] - pk[i]), zv = pv[i] + mu[2048 + col] * (qv[i] - pv[i]);
            const float wl = F.in(I_W0)[col] + lwl[i], al = F.in(I_A0)[col] + lal[i], gl = lgl[i];
            const float wlog = -softplusf_(-wl) - 0.5f, decay = __expf(-__expf(wlog));
            const float a = sigmoidf_(al);
            const float kkr = zk * F.in(I_KK)[col], kk = kkr * rsqrtf(wave_sum(kkr * kkr) + 1e-12f);
            const float k = zk * (1.f + (a - 1.f) * F.in(I_KA)[col]);
            const float bb = kk * a;
            const float bonus = wave_sum(zr * k * F.in(I_RK)[col]), beta = wave_sum(bb * zr), kappa = wave_sum(k * zr);
            float* base = RWV + ((size_t)r * HB + h) * 512;
            base[F.lane] = decay; base[64 + F.lane] = kk; base[128 + F.lane] = bb; base[192 + F.lane] = k; base[256 + F.lane] = zr; base[320 + F.lane] = zv; base[384 + F.lane] = decay * zr;
            if (F.lane == 0) { float* s_ = SCL + ((size_t)r * HB + h) * 4; s_[0] = beta; s_[1] = kappa; s_[2] = bonus; s_[3] = 0.f; }
        }
    }
}

namespace sba {
typedef short bf16x8 __attribute__((ext_vector_type(8)));
typedef short s16x4 __attribute__((ext_vector_type(4)));
typedef float f32x16 __attribute__((ext_vector_type(16)));
constexpr int SHM = 16384, LDQ = 1024;
#define SB_KSWZ(row, colB) ((row) * 256 + ((colB) ^ (((row) & 7) << 4)))
#define SB_SBAR() __builtin_amdgcn_sched_barrier(0)
__device__ __forceinline__ int v_st(int k, int c) { const int kk = (k & ~0xC) | ((k & 4) << 1) | ((k & 8) >> 1); return ((kk >> 3) * 4 + (c >> 5)) * 512 + ((kk & 7) * 32 + (c & 31)) * 2; }
__device__ __forceinline__ int v_rd_base(int lane) { return ((lane & 3) << 3) | (((lane >> 2) & 3) << 6) | (((lane >> 4) & 1) << 5) | (((lane >> 5) & 1) << 8); }
__device__ __forceinline__ int crow(int r, int hi) { return (r & 3) + 8 * (r >> 2) + 4 * hi; }
__device__ __forceinline__ void qkt(f32x16& p0, f32x16& p1, const char* Kt, int r32, int hi, const bf16x8* qr) {
    p0 = f32x16{}; p1 = f32x16{};
    const char* kb[4];
#pragma unroll
    for (int dd = 0; dd < 4; ++dd) kb[dd] = Kt + SB_KSWZ(r32, (dd * 16 + hi * 8) * 2);
#pragma unroll
    for (int d0 = 0; d0 < 8; ++d0) { const char* a = kb[d0 & 3] + (d0 >> 2) * 128;
        const bf16x8 b0 = *reinterpret_cast<const bf16x8*>(a);
        const bf16x8 b1 = *reinterpret_cast<const bf16x8*>(a + 32 * 256);
        p0 = __builtin_amdgcn_mfma_f32_32x32x16_bf16(b0, qr[d0], p0, 0, 0, 0);
        p1 = __builtin_amdgcn_mfma_f32_32x32x16_bf16(b1, qr[d0], p1, 0, 0, 0); }
}
__device__ __forceinline__ void pv_tile(f32x16* o, int vb0, bf16x8 pa0, bf16x8 pa1, bf16x8 pa2, bf16x8 pa3) {
#define SB_TRRD(dst, off) asm volatile("ds_read_b64_tr_b16 %0, %1 offset:%2" : "=&v"(dst) : "v"(vb0), "i"(off) : "memory")
#define SB_PV_D0(d0) do { s16x4 l0, l1, l2, l3, h0, h1, h2, h3; constexpr int b_ = (d0) * 512; \
        SB_TRRD(l0, b_); SB_TRRD(h0, b_ + 2048); SB_TRRD(l1, b_ + 4096); SB_TRRD(h1, b_ + 6144); SB_TRRD(l2, b_ + 8192); SB_TRRD(h2, b_ + 10240); SB_TRRD(l3, b_ + 12288); SB_TRRD(h3, b_ + 14336); \
        asm volatile("s_waitcnt lgkmcnt(0)" ::: "memory"); SB_SBAR(); \
        o[d0] = __builtin_amdgcn_mfma_f32_32x32x16_bf16(pa0, (bf16x8){l0[0], l0[1], l0[2], l0[3], h0[0], h0[1], h0[2], h0[3]}, o[d0], 0, 0, 0); \
        o[d0] = __builtin_amdgcn_mfma_f32_32x32x16_bf16(pa1, (bf16x8){l1[0], l1[1], l1[2], l1[3], h1[0], h1[1], h1[2], h1[3]}, o[d0], 0, 0, 0); \
        o[d0] = __builtin_amdgcn_mfma_f32_32x32x16_bf16(pa2, (bf16x8){l2[0], l2[1], l2[2], l2[3], h2[0], h2[1], h2[2], h2[3]}, o[d0], 0, 0, 0); \
        o[d0] = __builtin_amdgcn_mfma_f32_32x32x16_bf16(pa3, (bf16x8){l3[0], l3[1], l3[2], l3[3], h3[0], h3[1], h3[2], h3[3]}, o[d0], 0, 0, 0); } while (0)
    SB_PV_D0(0); SB_PV_D0(1); SB_PV_D0(2); SB_PV_D0(3);
#undef SB_PV_D0
#undef SB_TRRD
}
__device__ __forceinline__ float swap_other(float x, int hi) {
    auto rr = __builtin_amdgcn_permlane32_swap(__float_as_uint(x), __float_as_uint(x), false, false);
    return __uint_as_float(hi ? rr[0] : rr[1]);
}
template <bool MASK> __device__ __forceinline__ void sb_weights(f32x16& p0, f32x16& p1, float& carry, float C2, float b2, int dq, int hi) {
    float T[8];
#pragma unroll
    for (int g = 0; g < 8; ++g) {
        float iv[4], be[4];
#pragma unroll
        for (int k = 0; k < 4; ++k) { const int r = (g & 3) * 4 + k; const float s = g < 4 ? p0[r] : p1[r];
            const float z2 = fminf(fmaf(s, C2, b2), 64.f), e = __builtin_amdgcn_exp2f(z2), i_ = __builtin_amdgcn_rcpf(1.f + e); float b_ = e * i_, ii = i_;
            if (MASK) { const int c = (r & 3) + 8 * (r >> 2) + (g < 4 ? 0 : 32); const bool vis = c < dq; ii = vis ? ii : 1.f; b_ = vis ? b_ : 0.f; }
            iv[k] = ii; be[k] = b_; }
        const float ex2 = iv[3], ex1 = iv[2] * iv[3], ex0 = iv[1] * ex1; T[g] = iv[0] * ex0;
        const float w0 = be[0] * ex0, w1 = be[1] * ex1, w2 = be[2] * ex2, w3 = be[3];
        if (g < 4) { p0[(g & 3) * 4 + 0] = w0; p0[(g & 3) * 4 + 1] = w1; p0[(g & 3) * 4 + 2] = w2; p0[(g & 3) * 4 + 3] = w3; }
        else { p1[(g & 3) * 4 + 0] = w0; p1[(g & 3) * 4 + 1] = w1; p1[(g & 3) * 4 + 2] = w2; p1[(g & 3) * 4 + 3] = w3; }
    }
    float suf = carry;
#pragma unroll
    for (int g = 7; g >= 0; --g) {
        const float To = swap_other(T[g], hi);
        const float E = hi ? suf : suf * To;
#pragma unroll
        for (int k = 0; k < 4; ++k) { if (g < 4) p0[(g & 3) * 4 + k] *= E; else p1[(g & 3) * 4 + k] *= E; }
        suf = suf * (T[g] * To);
    }
    carry = suf;
}
__device__ __forceinline__ void pack_p(const f32x16& p0, const f32x16& p1, bf16x8& pa0, bf16x8& pa1, bf16x8& pa2, bf16x8& pa3) {
#define SB_PK4(P, B_, OUT) do { unsigned a0 = cvt_pk_bf16(P[B_ + 0], P[B_ + 1]), a1 = cvt_pk_bf16(P[B_ + 2], P[B_ + 3]); \
        unsigned b0 = cvt_pk_bf16(P[B_ + 4], P[B_ + 5]), b1 = cvt_pk_bf16(P[B_ + 6], P[B_ + 7]); \
        auto r0 = __builtin_amdgcn_permlane32_swap(a0, b0, false, false); auto r1 = __builtin_amdgcn_permlane32_swap(a1, b1, false, false); \
        u32x4 w = {r0[0], r1[0], r0[1], r1[1]}; OUT = *reinterpret_cast<bf16x8*>(&w); } while (0)
    SB_PK4(p0, 0, pa0); SB_PK4(p0, 8, pa1); SB_PK4(p1, 0, pa2); SB_PK4(p1, 8, pa3);
#undef SB_PK4
}
__device__ __forceinline__ void attn_half(Ctx& F, int bh, int x, int half) {
    const int tid = F.tid, wid = F.wave, lane = F.lane, r32 = lane & 31, hi = lane >> 5, b = bh >> 3, h = bh & 7;
    const bf16* Qg = WSP(bf16, WS_QB) + (size_t)(b * SEQ + 256 * x) * LDQ + h * 128;
    const bf16* Kg = WSP(bf16, WS_KB) + (size_t)(b * SEQ) * LDQ + h * 128; const bf16* Vg = WSP(bf16, WS_VB) + (size_t)(b * SEQ) * LDQ + h * 128;
    const int NT = 4 * (x + 1), t_hi = half == 0 ? NT : NT / 2, t_lo = half == 0 ? NT / 2 : 0;
    const int qlo = 256 * x + 32 * wid, qpos = qlo + r32;
    char* V_lds = (char*)F.lds; char* K_lds = (char*)F.lds + 2 * SHM;
    bf16x8 qr[8];
#pragma unroll
    for (int d0 = 0; d0 < 8; ++d0) qr[d0] = *reinterpret_cast<const bf16x8*>(Qg + (size_t)(wid * 32 + r32) * LDQ + d0 * 16 + hi * 8);
    const int sr = tid >> 4, sc = (tid & 15) * 8, vst0 = v_st(sr, sc), vst1 = v_st(32 + sr, sc), kws = SB_KSWZ(sr, sc * 2);
    const int vb0 = (int)(uintptr_t)V_lds + v_rd_base(lane);
    bf16x8 st_k0, st_k1, st_v0, st_v1;
    const unsigned so0 = (unsigned)(sr * LDQ + sc) * 2u, so1 = so0 + 32u * LDQ * 2u;
#define SB_SLOAD(t) do { const char* kt_ = (const char*)Kg + (size_t)(t) * (64 * LDQ * 2); const char* vt_ = (const char*)Vg + (size_t)(t) * (64 * LDQ * 2); \
        st_k0 = *reinterpret_cast<const bf16x8*>(kt_ + so0); st_k1 = *reinterpret_cast<const bf16x8*>(kt_ + so1); st_v0 = *reinterpret_cast<const bf16x8*>(vt_ + so0); st_v1 = *reinterpret_cast<const bf16x8*>(vt_ + so1); } while (0)
#define SB_SWRITE(bf) do { *(bf16x8*)(K_lds + (bf) * SHM + kws) = st_k0; *(bf16x8*)(K_lds + (bf) * SHM + kws + 32 * 256) = st_k1; \
        *(bf16x8*)(V_lds + (bf) * SHM + vst0) = st_v0; *(bf16x8*)(V_lds + (bf) * SHM + vst1) = st_v1; } while (0)
    __syncthreads();
    SB_SLOAD(t_hi - 1); VM_WAIT(); SB_SWRITE(0);
    __syncthreads();
    const float C2 = QK_SCALE * 1.4426950408889634f, b2 = F.in(I_SBB)[h] * 1.4426950408889634f;
    float carry = 1.f; f32x16 o[4] = {};
    int buf = 0;
    for (int t = t_hi - 1; t >= t_lo; --t) {
        if (t > t_lo) SB_SLOAD(t - 1);
        const int kb = 64 * t;
        if (kb < qlo + 31) {
            f32x16 p0, p1; bf16x8 pa0, pa1, pa2, pa3;
            qkt(p0, p1, K_lds + buf * SHM, r32, hi, qr);
            if (kb + 63 >= qlo) sb_weights<true>(p0, p1, carry, C2, b2, qpos - kb - 4 * hi, hi); else sb_weights<false>(p0, p1, carry, C2, b2, 0, hi);
            pack_p(p0, p1, pa0, pa1, pa2, pa3);
            pv_tile(o, vb0 + buf * SHM, pa0, pa1, pa2, pa3);
        }
        if (t > t_lo) { VM_WAIT(); SB_SWRITE(buf ^ 1); }
        __syncthreads();
        buf ^= 1;
    }
#undef SB_SLOAD
#undef SB_SWRITE
    float* Op = WSP(float, WS_OP) + ((size_t)half * NPR + b * SEQ + 256 * x + wid * 32) * 1024 + h * 128;
    const unsigned lo_ = (unsigned)(4 * hi * 1024 + r32);
#pragma unroll
    for (int r = 0; r < 16; ++r) { float* Opr = Op + (size_t)((r & 3) + 8 * (r >> 2)) * 1024;
#pragma unroll
        for (int d0 = 0; d0 < 4; ++d0) Opr[lo_ + d0 * 32] = o[d0][r]; }
    if (half == 0 && hi == 0) WSP(float, WS_CL)[(size_t)(b * SEQ + qpos) * HA + h] = carry;
}
#undef SB_KSWZ
#undef SB_SBAR
}
namespace sba {
__device__ __forceinline__ void sb_weights32(f32x16& p0, float& carry, float C2, float b2, int hi) {
    float T[4];
#pragma unroll
    for (int g = 0; g < 4; ++g) {
        float iv[4], be[4];
#pragma unroll
        for (int k = 0; k < 4; ++k) { const float z2 = fminf(fmaf(p0[g * 4 + k], C2, b2), 64.f), e = __builtin_amdgcn_exp2f(z2), i_ = __builtin_amdgcn_rcpf(1.f + e); iv[k] = i_; be[k] = e * i_; }
        const float ex2 = iv[3], ex1 = iv[2] * iv[3], ex0 = iv[1] * ex1; T[g] = iv[0] * ex0;
        p0[g * 4 + 0] = be[0] * ex0; p0[g * 4 + 1] = be[1] * ex1; p0[g * 4 + 2] = be[2] * ex2; p0[g * 4 + 3] = be[3];
    }
    float suf = carry;
#pragma unroll
    for (int g = 3; g >= 0; --g) { const float To = swap_other(T[g], hi); const float E = hi ? suf : suf * To;
#pragma unroll
        for (int k = 0; k < 4; ++k) p0[g * 4 + k] *= E;
        suf = suf * (T[g] * To); }
    carry = suf;
}
__device__ __forceinline__ void attn_sample_unit(Ctx& F, int bh, int pg, char* wl  ) {
    const int lane = F.lane, r32 = lane & 31, hi = lane >> 5, b = bh >> 3, h = bh & 7;
    char* K_lds = wl; char* V_lds = wl + 8192;
    bf16x8 qr[8];
    { const bf16* Qg = WSP(bf16, WS_QB) + (size_t)(NPR + b * DSEQ + (r32 & 7)) * LDQ + h * 128;
#pragma unroll
      for (int d0 = 0; d0 < 8; ++d0) { bf16x8 v = *reinterpret_cast<const bf16x8*>(Qg + d0 * 16 + hi * 8); if (r32 >= 8) v = bf16x8{}; qr[d0] = v; } }
    const int kl = lane >> 5, c4 = (lane & 31) * 4;
    const unsigned goff = (unsigned)(kl * 1024 + c4) * 4u;
    const int vb0 = (int)(uintptr_t)V_lds + v_rd_base(lane);
    const float C2 = QK_SCALE * 1.4426950408889634f, b2 = F.in(I_SBB)[h] * 1.4426950408889634f;
    const int* pt = ((const int*)F.in(I_PT)) + b * NPAGES + pg * 4;
    f32x4 sa[8], sb[8];
#define SU_BASE(n) ({ const int i_ = (n) >> 2, k_ = (n) & 3, tt_ = 15 - i_; const int phys_ = pt[tt_ >> 2]; \
        (const char*)((k_ & 2) ? F.in(I_CV) : F.in(I_CK)) + (((size_t)phys_ * PAGESZ + (tt_ & 3) * 32 + (k_ & 1) * 16) * 1024 + h * 128) * 4; })
#define SU_LOAD(S, n) do { const char* bp_ = SU_BASE(n); _Pragma("unroll") for (int j = 0; j < 8; ++j) S[j] = __builtin_nontemporal_load((const GAS f32x4*)(bp_ + goff + (size_t)j * 8192)); } while (0)
#define SU_WRK(S, kh) do { _Pragma("unroll") for (int j = 0; j < 8; ++j) { const int key = (kh) * 16 + 2 * j + kl; u32x2 w; w.x = cvt_pk_bf16(S[j].x, S[j].y); w.y = cvt_pk_bf16(S[j].z, S[j].w); \
        *(u32x2*)(K_lds + (key * 256 + ((c4 * 2) ^ ((key & 7) << 4)))) = w; } } while (0)
#define SU_WRV(S, kh) do { _Pragma("unroll") for (int j = 0; j < 8; ++j) { const int key = (kh) * 16 + 2 * j + kl; u32x2 w; w.x = cvt_pk_bf16(S[j].x, S[j].y); w.y = cvt_pk_bf16(S[j].z, S[j].w); \
        *(u32x2*)(V_lds + v_st(key, c4)) = w; } } while (0)
    SU_LOAD(sa, 0); SU_LOAD(sb, 1);
    float carry = 1.f; f32x16 o[4] = {};
    for (int i = 0; i < 16; ++i) {
        asm volatile("s_waitcnt vmcnt(8)" ::: "memory"); SU_WRK(sa, 0); SU_LOAD(sa, 4 * i + 2);
        asm volatile("s_waitcnt vmcnt(8)" ::: "memory"); SU_WRK(sb, 1); SU_LOAD(sb, 4 * i + 3);
        asm volatile("s_waitcnt vmcnt(8)" ::: "memory"); SU_WRV(sa, 0); if (i < 15) SU_LOAD(sa, 4 * i + 4);
        if (i < 15) asm volatile("s_waitcnt vmcnt(8)" ::: "memory"); else asm volatile("s_waitcnt vmcnt(0)" ::: "memory");
        SU_WRV(sb, 1); if (i < 15) SU_LOAD(sb, 4 * i + 5);
        asm volatile("s_waitcnt lgkmcnt(0)" ::: "memory");
        f32x16 p0 = f32x16{};
        { const char* kb[4];
#pragma unroll
          for (int dd = 0; dd < 4; ++dd) kb[dd] = K_lds + (r32 * 256 + (((dd * 16 + hi * 8) * 2) ^ ((r32 & 7) << 4)));
#pragma unroll
          for (int d0 = 0; d0 < 8; ++d0) { const bf16x8 b0 = *reinterpret_cast<const bf16x8*>(kb[d0 & 3] + (d0 >> 2) * 128); p0 = __builtin_amdgcn_mfma_f32_32x32x16_bf16(b0, qr[d0], p0, 0, 0, 0); } }
        sb_weights32(p0, carry, C2, b2, hi);
        bf16x8 pa0, pa1;
        { unsigned a0 = cvt_pk_bf16(p0[0], p0[1]), a1 = cvt_pk_bf16(p0[2], p0[3]), b0 = cvt_pk_bf16(p0[4], p0[5]), b1 = cvt_pk_bf16(p0[6], p0[7]);
          auto r0 = __builtin_amdgcn_permlane32_swap(a0, b0, false, false); auto r1 = __builtin_amdgcn_permlane32_swap(a1, b1, false, false);
          u32x4 w = {r0[0], r1[0], r0[1], r1[1]}; pa0 = *reinterpret_cast<bf16x8*>(&w); }
        { unsigned a0 = cvt_pk_bf16(p0[8], p0[9]), a1 = cvt_pk_bf16(p0[10], p0[11]), b0 = cvt_pk_bf16(p0[12], p0[13]), b1 = cvt_pk_bf16(p0[14], p0[15]);
          auto r0 = __builtin_amdgcn_permlane32_swap(a0, b0, false, false); auto r1 = __builtin_amdgcn_permlane32_swap(a1, b1, false, false);
          u32x4 w = {r0[0], r1[0], r0[1], r1[1]}; pa1 = *reinterpret_cast<bf16x8*>(&w); }
#define SU_TRRD(dst, off) asm volatile("ds_read_b64_tr_b16 %0, %1 offset:%2" : "=&v"(dst) : "v"(vb0), "i"(off) : "memory")
#define SU_PV(d0) do { s16x4 l0, l1, h0, h1; constexpr int b_ = (d0) * 512; SU_TRRD(l0, b_); SU_TRRD(h0, b_ + 2048); SU_TRRD(l1, b_ + 4096); SU_TRRD(h1, b_ + 6144); \
        asm volatile("s_waitcnt lgkmcnt(0)" ::: "memory"); __builtin_amdgcn_sched_barrier(0); \
        o[d0] = __builtin_amdgcn_mfma_f32_32x32x16_bf16(pa0, (bf16x8){l0[0], l0[1], l0[2], l0[3], h0[0], h0[1], h0[2], h0[3]}, o[d0], 0, 0, 0); \
        o[d0] = __builtin_amdgcn_mfma_f32_32x32x16_bf16(pa1, (bf16x8){l1[0], l1[1], l1[2], l1[3], h1[0], h1[1], h1[2], h1[3]}, o[d0], 0, 0, 0); } while (0)
        SU_PV(0); SU_PV(1); SU_PV(2); SU_PV(3);
        asm volatile("s_waitcnt lgkmcnt(0)" ::: "memory");
    }
#undef SU_PV
#undef SU_TRRD
#undef SU_WRV
#undef SU_WRK
#undef SU_LOAD
#undef SU_BASE
    float* Sp = WSP(float, WS_SPART) + ((size_t)(bh * 32 + pg) * 8) * 128;
#pragma unroll
    for (int r = 0; r < 4; ++r)
#pragma unroll
        for (int d0 = 0; d0 < 4; ++d0) Sp[(size_t)(r + 4 * hi) * 128 + d0 * 32 + r32] = o[d0][r];
    if (hi == 0 && r32 < 8) WSP(float, WS_SCAR)[(size_t)(bh * 32 + pg) * 8 + r32] = carry;
}
}
__device__ __forceinline__ void sample_combine(Ctx& F) {
    const int gw = F.vcu * NWAVES + F.wave, NGW = F.G * NWAVES; bf16* OAB = WSP(bf16, WS_OAB);
    const float* SPt = WSP(float, WS_SPART); const float* SCr = WSP(float, WS_SCAR);
    for (int task = gw; task < DBAT * HA * DSEQ; task += NGW) { const int bh = task >> 3, i = task & 7, b = bh >> 3, h = bh & 7; const float bias = F.in(I_SBB)[h];
        f32x2 po[32]; float sc[32];
#pragma unroll
        for (int pg = 0; pg < 32; ++pg) { po[pg] = *(const GAS f32x2*)(SPt + ((size_t)(bh * 32 + pg) * 8 + i) * 128 + 2 * F.lane); sc[pg] = SCr[(size_t)(bh * 32 + pg) * 8 + i]; }
        f32x2 q; { const unsigned qw = *(const GAS unsigned*)(WSP(bf16, WS_QB) + (size_t)(NPR + b * DSEQ + i) * 1024 + h * 128 + 2 * F.lane); q.x = __uint_as_float(qw << 16); q.y = __uint_as_float(qw & 0xffff0000u); }
        float carry = 1.f, a0 = 0.f, a1 = 0.f;
        for (int j = i - 1; j >= 0; --j) { const size_t ko = (size_t)(b * DSEQ + j) * 1024 + h * 128 + 2 * F.lane; const f32x2 k = *(const GAS f32x2*)(F.outp() + O_KS + ko), v = *(const GAS f32x2*)(F.outp() + O_VS + ko);
            const float z = wave_sum(q.x * k.x + q.y * k.y) * QK_SCALE + bias, e = __expf(fminf(z, 40.f)), om = 1.f / (1.f + e), w = e * om * carry;
            a0 += w * v.x; a1 += w * v.y; carry *= om; }
#pragma unroll
        for (int pg = 31; pg >= 0; --pg) { a0 += carry * po[pg].x; a1 += carry * po[pg].y; carry *= sc[pg]; }
        *(GAS unsigned*)(OAB + (size_t)(NPR + b * DSEQ + i) * DM + h * 128 + 2 * F.lane) = cvt_pk_bf16(a0, a1);
    }
}
__device__ __forceinline__ void phase_attn_prompt(Ctx& F) {
    for (int it2 = 2 * F.vcu; it2 < 2 * NBATCH * HA * 16; it2 += (it2 & 1) ? 2 * F.G - 1 : 1) { const int item = it2 >> 1, half = it2 & 1, bh = item >> 4, x = item & 15;
        sba::attn_half(F, bh, half ? 15 - x : x, half); }
    __syncthreads();
}
__device__ __forceinline__ void dots16(float& sig, float& rho, float kkv, float wrv, const float (&s)[16]) {
    asm("s_nop 1\n\t"
        "v_fmac_f32_dpp %0, %2, %4 row_newbcast:0 row_mask:0xf bank_mask:0xf\n\t"
        "v_fmac_f32_dpp %1, %3, %4 row_newbcast:0 row_mask:0xf bank_mask:0xf\n\t"
        "v_fmac_f32_dpp %0, %2, %5 row_newbcast:1 row_mask:0xf bank_mask:0xf\n\t"
        "v_fmac_f32_dpp %1, %3, %5 row_newbcast:1 row_mask:0xf bank_mask:0xf\n\t"
        "v_fmac_f32_dpp %0, %2, %6 row_newbcast:2 row_mask:0xf bank_mask:0xf\n\t"
        "v_fmac_f32_dpp %1, %3, %6 row_newbcast:2 row_mask:0xf bank_mask:0xf\n\t"
        "v_fmac_f32_dpp %0, %2, %7 row_newbcast:3 row_mask:0xf bank_mask:0xf\n\t"
        "v_fmac_f32_dpp %1, %3, %7 row_newbcast:3 row_mask:0xf bank_mask:0xf\n\t"
        "v_fmac_f32_dpp %0, %2, %8 row_newbcast:4 row_mask:0xf bank_mask:0xf\n\t"
        "v_fmac_f32_dpp %1, %3, %8 row_newbcast:4 row_mask:0xf bank_mask:0xf\n\t"
        "v_fmac_f32_dpp %0, %2, %9 row_newbcast:5 row_mask:0xf bank_mask:0xf\n\t"
        "v_fmac_f32_dpp %1, %3, %9 row_newbcast:5 row_mask:0xf bank_mask:0xf\n\t"
        "v_fmac_f32_dpp %0, %2, %10 row_newbcast:6 row_mask:0xf bank_mask:0xf\n\t"
        "v_fmac_f32_dpp %1, %3, %10 row_newbcast:6 row_mask:0xf bank_mask:0xf\n\t"
        "v_fmac_f32_dpp %0, %2, %11 row_newbcast:7 row_mask:0xf bank_mask:0xf\n\t"
        "v_fmac_f32_dpp %1, %3, %11 row_newbcast:7 row_mask:0xf bank_mask:0xf\n\t"
        "v_fmac_f32_dpp %0, %2, %12 row_newbcast:8 row_mask:0xf bank_mask:0xf\n\t"
        "v_fmac_f32_dpp %1, %3, %12 row_newbcast:8 row_mask:0xf bank_mask:0xf\n\t"
        "v_fmac_f32_dpp %0, %2, %13 row_newbcast:9 row_mask:0xf bank_mask:0xf\n\t"
        "v_fmac_f32_dpp %1, %3, %13 row_newbcast:9 row_mask:0xf bank_mask:0xf\n\t"
        "v_fmac_f32_dpp %0, %2, %14 row_newbcast:10 row_mask:0xf bank_mask:0xf\n\t"
        "v_fmac_f32_dpp %1, %3, %14 row_newbcast:10 row_mask:0xf bank_mask:0xf\n\t"
        "v_fmac_f32_dpp %0, %2, %15 row_newbcast:11 row_mask:0xf bank_mask:0xf\n\t"
        "v_fmac_f32_dpp %1, %3, %15 row_newbcast:11 row_mask:0xf bank_mask:0xf\n\t"
        "v_fmac_f32_dpp %0, %2, %16 row_newbcast:12 row_mask:0xf bank_mask:0xf\n\t"
        "v_fmac_f32_dpp %1, %3, %16 row_newbcast:12 row_mask:0xf bank_mask:0xf\n\t"
        "v_fmac_f32_dpp %0, %2, %17 row_newbcast:13 row_mask:0xf bank_mask:0xf\n\t"
        "v_fmac_f32_dpp %1, %3, %17 row_newbcast:13 row_mask:0xf bank_mask:0xf\n\t"
        "v_fmac_f32_dpp %0, %2, %18 row_newbcast:14 row_mask:0xf bank_mask:0xf\n\t"
        "v_fmac_f32_dpp %1, %3, %18 row_newbcast:14 row_mask:0xf bank_mask:0xf\n\t"
        "v_fmac_f32_dpp %0, %2, %19 row_newbcast:15 row_mask:0xf bank_mask:0xf\n\t"
        "v_fmac_f32_dpp %1, %3, %19 row_newbcast:15 row_mask:0xf bank_mask:0xf\n\t"
        "s_nop 1"
        : "+v"(sig), "+v"(rho) : "v"(kkv), "v"(wrv), "v"(s[0]), "v"(s[1]), "v"(s[2]), "v"(s[3]), "v"(s[4]), "v"(s[5]), "v"(s[6]), "v"(s[7]), "v"(s[8]), "v"(s[9]), "v"(s[10]), "v"(s[11]), "v"(s[12]), "v"(s[13]), "v"(s[14]), "v"(s[15]));
}
__device__ __forceinline__ void dot16(float& acc, float zv, const float (&s)[16]) {
    asm("s_nop 1\n\t"
        "v_fmac_f32_dpp %0, %1, %2 row_newbcast:0 row_mask:0xf bank_mask:0xf\n\t"
        "v_fmac_f32_dpp %0, %1, %3 row_newbcast:1 row_mask:0xf bank_mask:0xf\n\t"
        "v_fmac_f32_dpp %0, %1, %4 row_newbcast:2 row_mask:0xf bank_mask:0xf\n\t"
        "v_fmac_f32_dpp %0, %1, %5 row_newbcast:3 row_mask:0xf bank_mask:0xf\n\t"
        "v_fmac_f32_dpp %0, %1, %6 row_newbcast:4 row_mask:0xf bank_mask:0xf\n\t"
        "v_fmac_f32_dpp %0, %1, %7 row_newbcast:5 row_mask:0xf bank_mask:0xf\n\t"
        "v_fmac_f32_dpp %0, %1, %8 row_newbcast:6 row_mask:0xf bank_mask:0xf\n\t"
        "v_fmac_f32_dpp %0, %1, %9 row_newbcast:7 row_mask:0xf bank_mask:0xf\n\t"
        "v_fmac_f32_dpp %0, %1, %10 row_newbcast:8 row_mask:0xf bank_mask:0xf\n\t"
        "v_fmac_f32_dpp %0, %1, %11 row_newbcast:9 row_mask:0xf bank_mask:0xf\n\t"
        "v_fmac_f32_dpp %0, %1, %12 row_newbcast:10 row_mask:0xf bank_mask:0xf\n\t"
        "v_fmac_f32_dpp %0, %1, %13 row_newbcast:11 row_mask:0xf bank_mask:0xf\n\t"
        "v_fmac_f32_dpp %0, %1, %14 row_newbcast:12 row_mask:0xf bank_mask:0xf\n\t"
        "v_fmac_f32_dpp %0, %1, %15 row_newbcast:13 row_mask:0xf bank_mask:0xf\n\t"
        "v_fmac_f32_dpp %0, %1, %16 row_newbcast:14 row_mask:0xf bank_mask:0xf\n\t"
        "v_fmac_f32_dpp %0, %1, %17 row_newbcast:15 row_mask:0xf bank_mask:0xf\n\t"
        "s_nop 1"
        : "+v"(acc) : "v"(zv), "v"(s[0]), "v"(s[1]), "v"(s[2]), "v"(s[3]), "v"(s[4]), "v"(s[5]), "v"(s[6]), "v"(s[7]), "v"(s[8]), "v"(s[9]), "v"(s[10]), "v"(s[11]), "v"(s[12]), "v"(s[13]), "v"(s[14]), "v"(s[15]));
}
__device__ __forceinline__ void upd16_v(float (&s)[16], float wv, float kv, float bv, float vv, float ns) {
    asm("s_nop 1\n\t"
        "v_mul_f32_dpp %0, %16, %0 row_newbcast:0 row_mask:0xf bank_mask:0xf\n\t"
        "v_mul_f32_dpp %1, %16, %1 row_newbcast:1 row_mask:0xf bank_mask:0xf\n\t"
        "v_mul_f32_dpp %2, %16, %2 row_newbcast:2 row_mask:0xf bank_mask:0xf\n\t"
        "v_mul_f32_dpp %3, %16, %3 row_newbcast:3 row_mask:0xf bank_mask:0xf\n\t"
        "v_mul_f32_dpp %4, %16, %4 row_newbcast:4 row_mask:0xf bank_mask:0xf\n\t"
        "v_mul_f32_dpp %5, %16, %5 row_newbcast:5 row_mask:0xf bank_mask:0xf\n\t"
        "v_mul_f32_dpp %6, %16, %6 row_newbcast:6 row_mask:0xf bank_mask:0xf\n\t"
        "v_mul_f32_dpp %7, %16, %7 row_newbcast:7 row_mask:0xf bank_mask:0xf\n\t"
        "v_mul_f32_dpp %8, %16, %8 row_newbcast:8 row_mask:0xf bank_mask:0xf\n\t"
        "v_mul_f32_dpp %9, %16, %9 row_newbcast:9 row_mask:0xf bank_mask:0xf\n\t"
        "v_mul_f32_dpp %10, %16, %10 row_newbcast:10 row_mask:0xf bank_mask:0xf\n\t"
        "v_mul_f32_dpp %11, %16, %11 row_newbcast:11 row_mask:0xf bank_mask:0xf\n\t"
        "v_mul_f32_dpp %12, %16, %12 row_newbcast:12 row_mask:0xf bank_mask:0xf\n\t"
        "v_mul_f32_dpp %13, %16, %13 row_newbcast:13 row_mask:0xf bank_mask:0xf\n\t"
        "v_mul_f32_dpp %14, %16, %14 row_newbcast:14 row_mask:0xf bank_mask:0xf\n\t"
        "v_mul_f32_dpp %15, %16, %15 row_newbcast:15 row_mask:0xf bank_mask:0xf\n\t"
        "v_fmac_f32_dpp %0, %17, %19 row_newbcast:0 row_mask:0xf bank_mask:0xf\n\t"
        "v_fmac_f32_dpp %1, %17, %19 row_newbcast:1 row_mask:0xf bank_mask:0xf\n\t"
        "v_fmac_f32_dpp %2, %17, %19 row_newbcast:2 row_mask:0xf bank_mask:0xf\n\t"
        "v_fmac_f32_dpp %3, %17, %19 row_newbcast:3 row_mask:0xf bank_mask:0xf\n\t"
        "v_fmac_f32_dpp %4, %17, %19 row_newbcast:4 row_mask:0xf bank_mask:0xf\n\t"
        "v_fmac_f32_dpp %5, %17, %19 row_newbcast:5 row_mask:0xf bank_mask:0xf\n\t"
        "v_fmac_f32_dpp %6, %17, %19 row_newbcast:6 row_mask:0xf bank_mask:0xf\n\t"
        "v_fmac_f32_dpp %7, %17, %19 row_newbcast:7 row_mask:0xf bank_mask:0xf\n\t"
        "v_fmac_f32_dpp %8, %17, %19 row_newbcast:8 row_mask:0xf bank_mask:0xf\n\t"
        "v_fmac_f32_dpp %9, %17, %19 row_newbcast:9 row_mask:0xf bank_mask:0xf\n\t"
        "v_fmac_f32_dpp %10, %17, %19 row_newbcast:10 row_mask:0xf bank_mask:0xf\n\t"
        "v_fmac_f32_dpp %11, %17, %19 row_newbcast:11 row_mask:0xf bank_mask:0xf\n\t"
        "v_fmac_f32_dpp %12, %17, %19 row_newbcast:12 row_mask:0xf bank_mask:0xf\n\t"
        "v_fmac_f32_dpp %13, %17, %19 row_newbcast:13 row_mask:0xf bank_mask:0xf\n\t"
        "v_fmac_f32_dpp %14, %17, %19 row_newbcast:14 row_mask:0xf bank_mask:0xf\n\t"
        "v_fmac_f32_dpp %15, %17, %19 row_newbcast:15 row_mask:0xf bank_mask:0xf\n\t"
        "v_fmac_f32_dpp %0, %18, %20 row_newbcast:0 row_mask:0xf bank_mask:0xf\n\t"
        "v_fmac_f32_dpp %1, %18, %20 row_newbcast:1 row_mask:0xf bank_mask:0xf\n\t"
        "v_fmac_f32_dpp %2, %18, %20 row_newbcast:2 row_mask:0xf bank_mask:0xf\n\t"
        "v_fmac_f32_dpp %3, %18, %20 row_newbcast:3 row_mask:0xf bank_mask:0xf\n\t"
        "v_fmac_f32_dpp %4, %18, %20 row_newbcast:4 row_mask:0xf bank_mask:0xf\n\t"
        "v_fmac_f32_dpp %5, %18, %20 row_newbcast:5 row_mask:0xf bank_mask:0xf\n\t"
        "v_fmac_f32_dpp %6, %18, %20 row_newbcast:6 row_mask:0xf bank_mask:0xf\n\t"
        "v_fmac_f32_dpp %7, %18, %20 row_newbcast:7 row_mask:0xf bank_mask:0xf\n\t"
        "v_fmac_f32_dpp %8, %18, %20 row_newbcast:8 row_mask:0xf bank_mask:0xf\n\t"
        "v_fmac_f32_dpp %9, %18, %20 row_newbcast:9 row_mask:0xf bank_mask:0xf\n\t"
        "v_fmac_f32_dpp %10, %18, %20 row_newbcast:10 row_mask:0xf bank_mask:0xf\n\t"
        "v_fmac_f32_dpp %11, %18, %20 row_newbcast:11 row_mask:0xf bank_mask:0xf\n\t"
        "v_fmac_f32_dpp %12, %18, %20 row_newbcast:12 row_mask:0xf bank_mask:0xf\n\t"
        "v_fmac_f32_dpp %13, %18, %20 row_newbcast:13 row_mask:0xf bank_mask:0xf\n\t"
        "v_fmac_f32_dpp %14, %18, %20 row_newbcast:14 row_mask:0xf bank_mask:0xf\n\t"
        "v_fmac_f32_dpp %15, %18, %20 row_newbcast:15 row_mask:0xf bank_mask:0xf\n\t"
        "s_nop 1"
        : "+v"(s[0]), "+v"(s[1]), "+v"(s[2]), "+v"(s[3]), "+v"(s[4]), "+v"(s[5]), "+v"(s[6]), "+v"(s[7]), "+v"(s[8]), "+v"(s[9]), "+v"(s[10]), "+v"(s[11]), "+v"(s[12]), "+v"(s[13]), "+v"(s[14]), "+v"(s[15]) : "v"(wv), "v"(kv), "v"(bv), "v"(vv), "v"(ns));
}
__device__ __forceinline__ void upd16_nov(float (&s)[16], float wv, float kv, float bv, float vv, float ns) {
    asm("s_nop 1\n\t"
        "v_mul_f32_dpp %0, %16, %0 row_newbcast:0 row_mask:0xf bank_mask:0xf\n\t"
        "v_mul_f32_dpp %1, %16, %1 row_newbcast:1 row_mask:0xf bank_mask:0xf\n\t"
        "v_mul_f32_dpp %2, %16, %2 row_newbcast:2 row_mask:0xf bank_mask:0xf\n\t"
        "v_mul_f32_dpp %3, %16, %3 row_newbcast:3 row_mask:0xf bank_mask:0xf\n\t"
        "v_mul_f32_dpp %4, %16, %4 row_newbcast:4 row_mask:0xf bank_mask:0xf\n\t"
        "v_mul_f32_dpp %5, %16, %5 row_newbcast:5 row_mask:0xf bank_mask:0xf\n\t"
        "v_mul_f32_dpp %6, %16, %6 row_newbcast:6 row_mask:0xf bank_mask:0xf\n\t"
        "v_mul_f32_dpp %7, %16, %7 row_newbcast:7 row_mask:0xf bank_mask:0xf\n\t"
        "v_mul_f32_dpp %8, %16, %8 row_newbcast:8 row_mask:0xf bank_mask:0xf\n\t"
        "v_mul_f32_dpp %9, %16, %9 row_newbcast:9 row_mask:0xf bank_mask:0xf\n\t"
        "v_mul_f32_dpp %10, %16, %10 row_newbcast:10 row_mask:0xf bank_mask:0xf\n\t"
        "v_mul_f32_dpp %11, %16, %11 row_newbcast:11 row_mask:0xf bank_mask:0xf\n\t"
        "v_mul_f32_dpp %12, %16, %12 row_newbcast:12 row_mask:0xf bank_mask:0xf\n\t"
        "v_mul_f32_dpp %13, %16, %13 row_newbcast:13 row_mask:0xf bank_mask:0xf\n\t"
        "v_mul_f32_dpp %14, %16, %14 row_newbcast:14 row_mask:0xf bank_mask:0xf\n\t"
        "v_mul_f32_dpp %15, %16, %15 row_newbcast:15 row_mask:0xf bank_mask:0xf\n\t"
        "v_fmac_f32_dpp %0, %18, %20 row_newbcast:0 row_mask:0xf bank_mask:0xf\n\t"
        "v_fmac_f32_dpp %1, %18, %20 row_newbcast:1 row_mask:0xf bank_mask:0xf\n\t"
        "v_fmac_f32_dpp %2, %18, %20 row_newbcast:2 row_mask:0xf bank_mask:0xf\n\t"
        "v_fmac_f32_dpp %3, %18, %20 row_newbcast:3 row_mask:0xf bank_mask:0xf\n\t"
        "v_fmac_f32_dpp %4, %18, %20 row_newbcast:4 row_mask:0xf bank_mask:0xf\n\t"
        "v_fmac_f32_dpp %5, %18, %20 row_newbcast:5 row_mask:0xf bank_mask:0xf\n\t"
        "v_fmac_f32_dpp %6, %18, %20 row_newbcast:6 row_mask:0xf bank_mask:0xf\n\t"
        "v_fmac_f32_dpp %7, %18, %20 row_newbcast:7 row_mask:0xf bank_mask:0xf\n\t"
        "v_fmac_f32_dpp %8, %18, %20 row_newbcast:8 row_mask:0xf bank_mask:0xf\n\t"
        "v_fmac_f32_dpp %9, %18, %20 row_newbcast:9 row_mask:0xf bank_mask:0xf\n\t"
        "v_fmac_f32_dpp %10, %18, %20 row_newbcast:10 row_mask:0xf bank_mask:0xf\n\t"
        "v_fmac_f32_dpp %11, %18, %20 row_newbcast:11 row_mask:0xf bank_mask:0xf\n\t"
        "v_fmac_f32_dpp %12, %18, %20 row_newbcast:12 row_mask:0xf bank_mask:0xf\n\t"
        "v_fmac_f32_dpp %13, %18, %20 row_newbcast:13 row_mask:0xf bank_mask:0xf\n\t"
        "v_fmac_f32_dpp %14, %18, %20 row_newbcast:14 row_mask:0xf bank_mask:0xf\n\t"
        "v_fmac_f32_dpp %15, %18, %20 row_newbcast:15 row_mask:0xf bank_mask:0xf\n\t"
        "s_nop 1"
        : "+v"(s[0]), "+v"(s[1]), "+v"(s[2]), "+v"(s[3]), "+v"(s[4]), "+v"(s[5]), "+v"(s[6]), "+v"(s[7]), "+v"(s[8]), "+v"(s[9]), "+v"(s[10]), "+v"(s[11]), "+v"(s[12]), "+v"(s[13]), "+v"(s[14]), "+v"(s[15]) : "v"(wv), "v"(kv), "v"(bv), "v"(vv), "v"(ns));
}
__device__ __forceinline__ float xrow16_sum(float x) {
    auto s = __builtin_amdgcn_permlane16_swap(__float_as_uint(x), __float_as_uint(x), false, false);
    x = __uint_as_float(s[0]) + __uint_as_float(s[1]);
    auto t = __builtin_amdgcn_permlane32_swap(__float_as_uint(x), __float_as_uint(x), false, false);
    return __uint_as_float(t[0]) + __uint_as_float(t[1]);
}
struct StepIn { float wv, kkv, bv, kv, wrv, vv, beta, kappa; };
template <bool PROW> __device__ __forceinline__ void scan_load(StepIn& x, const float* RWV, const float* SCL, int r, int h, int lane, int row) {
    const float* base = RWV + ((size_t)r * HB + h) * 512; const float* sc = SCL + ((size_t)r * HB + h) * 4;
    x.wv = base[lane]; x.kkv = base[64 + lane]; x.bv = base[128 + lane]; x.wrv = base[384 + lane]; x.beta = sc[0];
    if (!PROW) { x.kv = base[192 + lane]; x.vv = base[320 + row]; x.kappa = sc[1]; } else { x.kv = 0.f; x.vv = 0.f; x.kappa = 0.f; }
}
template <bool PROW, bool SAMP> __device__ __forceinline__ void scan_wave(Ctx& F, int bh, int c, int g) {
    const int lane = F.lane, q = lane >> 4, m = lane & 15, row = 16 * g + m, h = bh & 15, b = bh >> 4;
    constexpr int L = SAMP ? DSEQ : 64; const int r0 = SAMP ? NPR + b * DSEQ : b * SEQ + c * 64; const int ch = bh * 64 + c;
    const float* RWV = WSP(float, WS_RWV); const float* SCL = WSP(float, WS_SCL); float* Y = WSP(float, WS_Y); float* Z = WSP(float, WS_Z); float* PU = WSP(float, WS_PU);
    float s[16];
    if (SAMP) { const float* st = F.in(I_SWKV) + ((size_t)bh * 64 + row) * 64 + 16 * q;
#pragma unroll
        for (int i = 0; i < 16; i += 4) { const f32x4 v = *(const GAS f32x4*)(st + i); s[i] = v.x; s[i + 1] = v.y; s[i + 2] = v.z; s[i + 3] = v.w; } }
    else {
#pragma unroll
        for (int i = 0; i < 16; ++i) s[i] = (PROW && (16 * q + i) == row) ? 1.f : 0.f; }
    StepIn buf[4];
#pragma unroll
    for (int u = 0; u < 4; ++u) scan_load<PROW>(buf[u], RWV, SCL, r0 + u, h, lane, row);
    for (int t = 0; t < L; t += 4) {
#pragma unroll
        for (int u = 0; u < 4; ++u) {
            const StepIn x = buf[u];
            if (t + u + 4 < L) scan_load<PROW>(buf[u], RWV, SCL, r0 + t + u + 4, h, lane, row);
            float sig = 0.f, rho = 0.f;
            dots16(sig, rho, x.kkv, x.wrv, s);
            sig = xrow16_sum(sig); rho = xrow16_sum(rho);
            const float ns = -sig;
            float y = rho + ns * x.beta; if (!PROW) y += x.vv * x.kappa;
            if (q == 0) { if (PROW) Z[((size_t)ch * 64 + t + u) * 64 + row] = y; else Y[(size_t)(r0 + t + u) * 1024 + h * 64 + row] = y; }
            if (PROW) upd16_nov(s, x.wv, x.kv, x.bv, x.vv, ns); else upd16_v(s, x.wv, x.kv, x.bv, x.vv, ns);
        }
    }
    float* dst = SAMP ? F.outp() + O_WKVS + ((size_t)bh * 64 + row) * 64 + 16 * q : PU + (((size_t)ch * 2 + (PROW ? 1 : 0)) * 64 + row) * 64 + 16 * q;
#pragma unroll
    for (int i = 0; i < 16; i += 4) *(GAS f32x4*)(dst + i) = (f32x4){s[i], s[i + 1], s[i + 2], s[i + 3]};
}
__device__ __forceinline__ void dots2_h0(float& sgu, float& rhu, float& sgp, float& rhp, float kkv, float wrv, const float (&su)[16], const float (&sp)[16]) {
    asm("s_nop 1\n\t"
        "v_fmac_f32_dpp %0, %4, %6 row_newbcast:0 row_mask:0xf bank_mask:0xf\n\t"
        "v_fmac_f32_dpp %1, %5, %6 row_newbcast:0 row_mask:0xf bank_mask:0xf\n\t"
        "v_fmac_f32_dpp %2, %4, %14 row_newbcast:0 row_mask:0xf bank_mask:0xf\n\t"
        "v_fmac_f32_dpp %3, %5, %14 row_newbcast:0 row_mask:0xf bank_mask:0xf\n\t"
        "v_fmac_f32_dpp %0, %4, %7 row_newbcast:1 row_mask:0xf bank_mask:0xf\n\t"
        "v_fmac_f32_dpp %1, %5, %7 row_newbcast:1 row_mask:0xf bank_mask:0xf\n\t"
        "v_fmac_f32_dpp %2, %4, %15 row_newbcast:1 row_mask:0xf bank_mask:0xf\n\t"
        "v_fmac_f32_dpp %3, %5, %15 row_newbcast:1 row_mask:0xf bank_mask:0xf\n\t"
        "v_fmac_f32_dpp %0, %4, %8 row_newbcast:2 row_mask:0xf bank_mask:0xf\n\t"
        "v_fmac_f32_dpp %1, %5, %8 row_newbcast:2 row_mask:0xf bank_mask:0xf\n\t"
        "v_fmac_f32_dpp %2, %4, %16 row_newbcast:2 row_mask:0xf bank_mask:0xf\n\t"
        "v_fmac_f32_dpp %3, %5, %16 row_newbcast:2 row_mask:0xf bank_mask:0xf\n\t"
        "v_fmac_f32_dpp %0, %4, %9 row_newbcast:3 row_mask:0xf bank_mask:0xf\n\t"
        "v_fmac_f32_dpp %1, %5, %9 row_newbcast:3 row_mask:0xf bank_mask:0xf\n\t"
        "v_fmac_f32_dpp %2, %4, %17 row_newbcast:3 row_mask:0xf bank_mask:0xf\n\t"
        "v_fmac_f32_dpp %3, %5, %17 row_newbcast:3 row_mask:0xf bank_mask:0xf\n\t"
        "v_fmac_f32_dpp %0, %4, %10 row_newbcast:4 row_mask:0xf bank_mask:0xf\n\t"
        "v_fmac_f32_dpp %1, %5, %10 row_newbcast:4 row_mask:0xf bank_mask:0xf\n\t"
        "v_fmac_f32_dpp %2, %4, %18 row_newbcast:4 row_mask:0xf bank_mask:0xf\n\t"
        "v_fmac_f32_dpp %3, %5, %18 row_newbcast:4 row_mask:0xf bank_mask:0xf\n\t"
        "v_fmac_f32_dpp %0, %4, %11 row_newbcast:5 row_mask:0xf bank_mask:0xf\n\t"
        "v_fmac_f32_dpp %1, %5, %11 row_newbcast:5 row_mask:0xf bank_mask:0xf\n\t"
        "v_fmac_f32_dpp %2, %4, %19 row_newbcast:5 row_mask:0xf bank_mask:0xf\n\t"
        "v_fmac_f32_dpp %3, %5, %19 row_newbcast:5 row_mask:0xf bank_mask:0xf\n\t"
        "v_fmac_f32_dpp %0, %4, %12 row_newbcast:6 row_mask:0xf bank_mask:0xf\n\t"
        "v_fmac_f32_dpp %1, %5, %12 row_newbcast:6 row_mask:0xf bank_mask:0xf\n\t"
        "v_fmac_f32_dpp %2, %4, %20 row_newbcast:6 row_mask:0xf bank_mask:0xf\n\t"
        "v_fmac_f32_dpp %3, %5, %20 row_newbcast:6 row_mask:0xf bank_mask:0xf\n\t"
        "v_fmac_f32_dpp %0, %4, %13 row_newbcast:7 row_mask:0xf bank_mask:0xf\n\t"
        "v_fmac_f32_dpp %1, %5, %13 row_newbcast:7 row_mask:0xf bank_mask:0xf\n\t"
        "v_fmac_f32_dpp %2, %4, %21 row_newbcast:7 row_mask:0xf bank_mask:0xf\n\t"
        "v_fmac_f32_dpp %3, %5, %21 row_newbcast:7 row_mask:0xf bank_mask:0xf\n\t"
        "s_nop 1"
        : "+v"(sgu), "+v"(rhu), "+v"(sgp), "+v"(rhp) : "v"(kkv), "v"(wrv), "v"(su[0]), "v"(su[1]), "v"(su[2]), "v"(su[3]), "v"(su[4]), "v"(su[5]), "v"(su[6]), "v"(su[7]), "v"(sp[0]), "v"(sp[1]), "v"(sp[2]), "v"(sp[3]), "v"(sp[4]), "v"(sp[5]), "v"(sp[6]), "v"(sp[7]));
}
__device__ __forceinline__ void dots2_h1(float& sgu, float& rhu, float& sgp, float& rhp, float kkv, float wrv, const float (&su)[16], const float (&sp)[16]) {
    asm("s_nop 1\n\t"
        "v_fmac_f32_dpp %0, %4, %6 row_newbcast:8 row_mask:0xf bank_mask:0xf\n\t"
        "v_fmac_f32_dpp %1, %5, %6 row_newbcast:8 row_mask:0xf bank_mask:0xf\n\t"
        "v_fmac_f32_dpp %2, %4, %14 row_newbcast:8 row_mask:0xf bank_mask:0xf\n\t"
        "v_fmac_f32_dpp %3, %5, %14 row_newbcast:8 row_mask:0xf bank_mask:0xf\n\t"
        "v_fmac_f32_dpp %0, %4, %7 row_newbcast:9 row_mask:0xf bank_mask:0xf\n\t"
        "v_fmac_f32_dpp %1, %5, %7 row_newbcast:9 row_mask:0xf bank_mask:0xf\n\t"
        "v_fmac_f32_dpp %2, %4, %15 row_newbcast:9 row_mask:0xf bank_mask:0xf\n\t"
        "v_fmac_f32_dpp %3, %5, %15 row_newbcast:9 row_mask:0xf bank_mask:0xf\n\t"
        "v_fmac_f32_dpp %0, %4, %8 row_newbcast:10 row_mask:0xf bank_mask:0xf\n\t"
        "v_fmac_f32_dpp %1, %5, %8 row_newbcast:10 row_mask:0xf bank_mask:0xf\n\t"
        "v_fmac_f32_dpp %2, %4, %16 row_newbcast:10 row_mask:0xf bank_mask:0xf\n\t"
        "v_fmac_f32_dpp %3, %5, %16 row_newbcast:10 row_mask:0xf bank_mask:0xf\n\t"
        "v_fmac_f32_dpp %0, %4, %9 row_newbcast:11 row_mask:0xf bank_mask:0xf\n\t"
        "v_fmac_f32_dpp %1, %5, %9 row_newbcast:11 row_mask:0xf bank_mask:0xf\n\t"
        "v_fmac_f32_dpp %2, %4, %17 row_newbcast:11 row_mask:0xf bank_mask:0xf\n\t"
        "v_fmac_f32_dpp %3, %5, %17 row_newbcast:11 row_mask:0xf bank_mask:0xf\n\t"
        "v_fmac_f32_dpp %0, %4, %10 row_newbcast:12 row_mask:0xf bank_mask:0xf\n\t"
        "v_fmac_f32_dpp %1, %5, %10 row_newbcast:12 row_mask:0xf bank_mask:0xf\n\t"
        "v_fmac_f32_dpp %2, %4, %18 row_newbcast:12 row_mask:0xf bank_mask:0xf\n\t"
        "v_fmac_f32_dpp %3, %5, %18 row_newbcast:12 row_mask:0xf bank_mask:0xf\n\t"
        "v_fmac_f32_dpp %0, %4, %11 row_newbcast:13 row_mask:0xf bank_mask:0xf\n\t"
        "v_fmac_f32_dpp %1, %5, %11 row_newbcast:13 row_mask:0xf bank_mask:0xf\n\t"
        "v_fmac_f32_dpp %2, %4, %19 row_newbcast:13 row_mask:0xf bank_mask:0xf\n\t"
        "v_fmac_f32_dpp %3, %5, %19 row_newbcast:13 row_mask:0xf bank_mask:0xf\n\t"
        "v_fmac_f32_dpp %0, %4, %12 row_newbcast:14 row_mask:0xf bank_mask:0xf\n\t"
        "v_fmac_f32_dpp %1, %5, %12 row_newbcast:14 row_mask:0xf bank_mask:0xf\n\t"
        "v_fmac_f32_dpp %2, %4, %20 row_newbcast:14 row_mask:0xf bank_mask:0xf\n\t"
        "v_fmac_f32_dpp %3, %5, %20 row_newbcast:14 row_mask:0xf bank_mask:0xf\n\t"
        "v_fmac_f32_dpp %0, %4, %13 row_newbcast:15 row_mask:0xf bank_mask:0xf\n\t"
        "v_fmac_f32_dpp %1, %5, %13 row_newbcast:15 row_mask:0xf bank_mask:0xf\n\t"
        "v_fmac_f32_dpp %2, %4, %21 row_newbcast:15 row_mask:0xf bank_mask:0xf\n\t"
        "v_fmac_f32_dpp %3, %5, %21 row_newbcast:15 row_mask:0xf bank_mask:0xf\n\t"
        "s_nop 1"
        : "+v"(sgu), "+v"(rhu), "+v"(sgp), "+v"(rhp) : "v"(kkv), "v"(wrv), "v"(su[8]), "v"(su[9]), "v"(su[10]), "v"(su[11]), "v"(su[12]), "v"(su[13]), "v"(su[14]), "v"(su[15]), "v"(sp[8]), "v"(sp[9]), "v"(sp[10]), "v"(sp[11]), "v"(sp[12]), "v"(sp[13]), "v"(sp[14]), "v"(sp[15]));
}
__device__ __forceinline__ void scan_wave_up(Ctx& F, int bh, int c, int g) {
    const int lane = F.lane, q = lane >> 4, m = lane & 15, row = 16 * g + m, h = bh & 15, b = bh >> 4;
    const int r0 = b * SEQ + c * 64, ch = bh * 64 + c;
    const float* RWV = WSP(float, WS_RWV); const float* SCL = WSP(float, WS_SCL); float* Y = WSP(float, WS_Y); float* Z = WSP(float, WS_Z); float* PU = WSP(float, WS_PU);
    float su[16], sp[16];
#pragma unroll
    for (int i = 0; i < 16; ++i) { su[i] = 0.f; sp[i] = ((16 * q + i) == row) ? 1.f : 0.f; }
    StepIn buf[4];
#pragma unroll
    for (int u = 0; u < 4; ++u) scan_load<false>(buf[u], RWV, SCL, r0 + u, h, lane, row);
    for (int t = 0; t < 64; t += 4) {
#pragma unroll
        for (int u = 0; u < 4; ++u) {
            const StepIn x = buf[u];
            if (t + u + 4 < 64) scan_load<false>(buf[u], RWV, SCL, r0 + t + u + 4, h, lane, row);
            float sgu = 0.f, rhu = 0.f, sgp = 0.f, rhp = 0.f;
            dots2_h0(sgu, rhu, sgp, rhp, x.kkv, x.wrv, su, sp); dots2_h1(sgu, rhu, sgp, rhp, x.kkv, x.wrv, su, sp);
            sgu = xrow16_sum(sgu); rhu = xrow16_sum(rhu); sgp = xrow16_sum(sgp); rhp = xrow16_sum(rhp);
            const float nsu = -sgu, nsp = -sgp;
            const float y = rhu + nsu * x.beta + x.vv * x.kappa, z = rhp + nsp * x.beta;
            if (q == 0) { Y[(size_t)(r0 + t + u) * 1024 + h * 64 + row] = y; Z[((size_t)ch * 64 + t + u) * 64 + row] = z; }
            upd16_v(su, x.wv, x.kv, x.bv, x.vv, nsu); upd16_nov(sp, x.wv, x.kv, x.bv, x.vv, nsp);
        }
    }
    float* du = PU + (((size_t)ch * 2 + 0) * 64 + row) * 64 + 16 * q; float* dp = PU + (((size_t)ch * 2 + 1) * 64 + row) * 64 + 16 * q;
#pragma unroll
    for (int i = 0; i < 16; i += 4) { *(GAS f32x4*)(du + i) = (f32x4){su[i], su[i + 1], su[i + 2], su[i + 3]}; *(GAS f32x4*)(dp + i) = (f32x4){sp[i], sp[i + 1], sp[i + 2], sp[i + 3]}; }
}
__device__ __forceinline__ void phase_scan1_stream(Ctx& F) {
    LAS int* ctr = (LAS int*)(F.lds + LDSCTL_OFF);
    __syncthreads(); if (F.tid == 0) *ctr = 0; __syncthreads();
    if (F.wave >= 6) { for (int u = F.vcu * 2 + (F.wave - 6); u < DBAT * HA * 32; u += 2 * F.G) sba::attn_sample_unit(F, u >> 5, u & 31, (char*)F.lds + F.wave * 16384); }
    constexpr int NSU = DBAT * HB / 2, NU = NSU + NBATCH * HB * 64;
    const int nunits = F.vcu < NU ? (NU - 1 - F.vcu) / F.G + 1 : 0, ntasks = nunits * 8;
    for (;;) {
        int t = 0; if (F.lane == 0) t = __hip_atomic_fetch_add(ctr, 1, __ATOMIC_RELAXED, __HIP_MEMORY_SCOPE_WORKGROUP);
        t = __builtin_amdgcn_readfirstlane(t); if (t >= ntasks) break;
        const int u = F.vcu + (t >> 3) * F.G, g8 = t & 7;
        if (u < NSU) scan_wave<false, true>(F, u * 2 + (g8 >> 2), 0, g8 & 3);
        else if (g8 < 4) { const int ch = u - NSU; scan_wave_up(F, ch >> 6, ch & 63, g8); }
    }
}
namespace msc {
using sba::bf16x8; using sba::f32x16; using sba::crow; using sba::swap_other;
constexpr int S_AQ = 136, S_BKT = 104, S_L = 40;
constexpr int O_AQ = 0, O_BK = 32 * S_AQ, O_L24 = O_BK, O_TL3 = O_BK + 32 * S_L, O_BKT = 2 * 32 * S_AQ, BLK_BYTES = O_BKT + 64 * S_BKT, O_GL = 4 * BLK_BYTES, O_GP = O_GL + 256, GRP_BYTES = O_GP + 4 * 256;
static_assert(BLK_BYTES % 8 == 0 && 2 * GRP_BYTES <= RING_BYTES, "scan LDS map");
typedef __bf16 nbf2 __attribute__((ext_vector_type(2)));
__device__ __forceinline__ unsigned cvt2(float lo, float hi) { return __builtin_bit_cast(unsigned, __builtin_convertvector((f32x2){lo, hi}, nbf2)); }
__device__ __forceinline__ bf16x8 pack8(float a0, float a1, float a2, float a3, float a4, float a5, float a6, float a7) {
    u32x4 w = {cvt2(a0, a1), cvt2(a2, a3), cvt2(a4, a5), cvt2(a6, a7)}; return *reinterpret_cast<bf16x8*>(&w); }
__device__ __forceinline__ bf16x8 pack_lo(const f32x16& c) { return pack8(c[0], c[1], c[2], c[3], c[4], c[5], c[6], c[7]); }
__device__ __forceinline__ bf16x8 pack_hi(const f32x16& c) { return pack8(c[8], c[9], c[10], c[11], c[12], c[13], c[14], c[15]); }
__device__ __forceinline__ bf16x8 perm_read(const LAS char* img, int row, int pitch, int col0, int g) {
    const LAS char* p = img + row * pitch + (col0 + 4 * g) * 2; const u32x2 lo = *(const LAS u32x2*)p, hi = *(const LAS u32x2*)(p + 16);
    u32x4 w = {lo.x, lo.y, hi.x, hi.y}; return *reinterpret_cast<bf16x8*>(&w); }
__device__ __forceinline__ bf16x8 nat_read(const LAS char* img, int row, int pitch, int col0) {
    const LAS char* p = img + row * pitch + col0 * 2; const u32x2 lo = *(const LAS u32x2*)p, hi = *(const LAS u32x2*)(p + 8);
    u32x4 w = {lo.x, lo.y, hi.x, hi.y}; return *reinterpret_cast<bf16x8*>(&w); }
__device__ __forceinline__ unsigned short bf1(float x) { return (unsigned short)(cvt_pk_bf16(x, 0.f) & 0xffffu); }
struct PrepRegs { float pr[17], pk[17], pv[17], lwl[16]; const bf16* lw; };
__device__ __forceinline__ void prep_load(Ctx& F, PrepRegs& L, int rb, int h) {
    const bf16* pb = WSP(bf16, WS_PBH) + (size_t)rb * 3072 + h * 64 + F.lane; const bf16* lw = WSP(bf16, WS_LWH) + (size_t)rb * 3072 + h * 64 + F.lane;
    L.lw = lw;
#pragma unroll
    for (int t = 0; t < 16; ++t) L.lwl[t] = ldbf_nt(lw + (size_t)t * 3072);
    if ((rb & (SEQ - 1)) != 0) { L.pr[0] = ldbf_nt(pb - 3072); L.pk[0] = ldbf_nt(pb + 1024 - 3072); L.pv[0] = ldbf_nt(pb + 2048 - 3072); } else { L.pr[0] = 0.f; L.pk[0] = 0.f; L.pv[0] = 0.f; }
#pragma unroll
    for (int t = 0; t < 16; ++t) { L.pr[t + 1] = ldbf_nt(pb + (size_t)t * 3072); L.pk[t + 1] = ldbf_nt(pb + (size_t)t * 3072 + 1024); L.pv[t + 1] = ldbf_nt(pb + (size_t)t * 3072 + 2048); }
}
__device__ __forceinline__ void prep_block(Ctx& F, PrepRegs& L, int rb, int h, int j, LAS char* gbase) {
    const int lane = F.lane, n = lane & 31, hi = lane >> 5, col = h * 64 + lane; LAS char* blk = gbase + j * BLK_BYTES;
    float lal[16];
#pragma unroll
    for (int t = 0; t < 16; ++t) lal[t] = ldbf_nt(L.lw + (size_t)t * 3072 + 1024);
    const float* mu = F.in(I_MU); const float mu_r = mu[col], mu_k = mu[1024 + col], mu_v = mu[2048 + col];
    const float w0 = F.in(I_W0)[col], a0 = F.in(I_A0)[col], kkw = F.in(I_KK)[col], kaw = F.in(I_KA)[col], rkw = F.in(I_RK)[col];
    float cw[16];
#pragma unroll
    for (int t = 0; t < 16; ++t) { const float wl = w0 + L.lwl[t], wlog = -softplusf_(-wl) - 0.5f; cw[t] = __expf(-__expf(wlog)); }
#pragma unroll
    for (int t = 1; t < 16; ++t) cw[t] *= cw[t - 1];
    *(LAS float*)(gbase + O_GP + (j * 64 + lane) * 4) = cw[15];
    __syncthreads();
    const float g0 = *(const LAS float*)(gbase + O_GP + lane * 4), g1 = *(const LAS float*)(gbase + O_GP + (64 + lane) * 4), g2 = *(const LAS float*)(gbase + O_GP + (128 + lane) * 4);
    const float G0 = (j > 0 ? g0 : 1.f) * (j > 1 ? g1 : 1.f) * (j > 2 ? g2 : 1.f);
    if (j == 3) *(LAS float*)(gbase + O_GL + lane * 4) = G0 * cw[15];
    float* SCL = WSP(float, WS_SCL) + ((size_t)rb * HB + h) * 4;
#pragma unroll
    for (int tl = 0; tl < 16; tl += 2) {
        float nb[2], kt[2], vz[2];
#pragma unroll
        for (int u = 0; u < 2; ++u) { const int t = tl + u;
            const float zr = L.pr[t + 1] + mu_r * (L.pr[t] - L.pr[t + 1]), zk = L.pk[t + 1] + mu_k * (L.pk[t] - L.pk[t + 1]); vz[u] = L.pv[t + 1] + mu_v * (L.pv[t] - L.pv[t + 1]);
            const float a_ = sigmoidf_(a0 + lal[t]);
            const float kkr = zk * kkw, kk = kkr * rsqrtf(wave_sum(kkr * kkr) + 1e-12f);
            const float k = zk * (1.f + (a_ - 1.f) * kaw), bb = kk * a_;
            const float bonus = wave_sum(zr * k * rkw);
            if (lane == 0) SCL[(size_t)t * HB * 4 + 2] = bonus;
            const float Gp = t ? G0 * cw[t ? t - 1 : 0] : G0, G = G0 * cw[t], gi = 1.f / G;
            const float a = kk * Gp, q = zr * G, bt = bb * gi; kt[u] = k * gi; nb[u] = -bt;
            *(LAS unsigned short*)(blk + O_AQ + t * S_AQ + lane * 2) = bf1(a); *(LAS unsigned short*)(blk + O_AQ + (16 + t) * S_AQ + lane * 2) = bf1(q);
            *(LAS unsigned short*)(blk + O_BK + t * S_AQ + lane * 2) = bf1(bt); *(LAS unsigned short*)(blk + O_BK + (16 + t) * S_AQ + lane * 2) = bf1(kt[u]); }
        *(LAS unsigned*)(blk + O_BKT + lane * S_BKT + tl * 2) = cvt_pk_bf16(nb[0], nb[1]); *(LAS unsigned*)(blk + O_BKT + lane * S_BKT + (16 + tl) * 2) = cvt_pk_bf16(kt[0], kt[1]);
        *(LAS unsigned*)(blk + O_BKT + lane * S_BKT + (32 + tl) * 2) = cvt_pk_bf16(vz[0], vz[1]);
    }
    LDS_WAIT(); asm volatile("" ::: "memory");
    f32x16 mt = f32x16{};
#pragma unroll
    for (int ks = 0; ks < 4; ++ks) mt = __builtin_amdgcn_mfma_f32_32x32x16_bf16(nat_read(blk + O_AQ, n, S_AQ, 16 * ks + 8 * hi), nat_read(blk + O_BK, n, S_AQ, 16 * ks + 8 * hi), mt, 0, 0, 0);
    float l1[8];
    const int i = n & 15;
#pragma unroll
    for (int r = 0; r < 16; ++r) { const int t = crow(r, hi) & 15; float val = mt[r];
        if (r < 8) { val = t > i ? val : 0.f; if (n >= 16) *(LAS unsigned short*)(blk + O_L24 + t * S_L + i * 2) = bf1(val); l1[r] = val; }
        else { val = t >= i ? val : 0.f; if (n >= 16) *(LAS unsigned short*)(blk + O_L24 + (16 + t) * S_L + i * 2) = bf1(val); else *(LAS unsigned short*)(blk + O_TL3 + (16 + t) * S_L + i * 2) = bf1(-val); } }
    float rowv[16];
#pragma unroll
    for (int r = 0; r < 8; ++r) { const float own = l1[r], oth = swap_other(own, hi); const int p0 = (r & 3) + 8 * (r >> 2); rowv[p0] = hi ? oth : own; rowv[p0 + 4] = hi ? own : oth; }
    float tl_[16];
    tl_[0] = lane == 0 ? 1.f : 0.f;
#pragma unroll
    for (int t = 1; t < 16; ++t) { float acc = lane == t ? 1.f : 0.f;
#pragma unroll
        for (int jj = 0; jj < t; ++jj) acc -= readlane_f(rowv[t], jj) * tl_[jj];
        tl_[t] = acc; }
    if (lane < 16) {
#pragma unroll
        for (int t = 0; t < 16; ++t) *(LAS unsigned short*)(blk + O_TL3 + t * S_L + lane * 2) = bf1(tl_[t]); }
    LDS_WAIT(); asm volatile("" ::: "memory");
}
__device__ __forceinline__ void chain(Ctx& F, int bh, int c, int isP, int half, const LAS char* gbase) {
    const int lane = F.lane, n = lane & 31, hi = lane >> 5, rowg = 32 * half + n, h = bh & 15, b = bh >> 4, r0 = b * SEQ + c * 64, ch = bh * 64 + c;
    const float* RWV = WSP(float, WS_RWV);
    f32x16 st0 = f32x16{}, st1 = f32x16{};
    if (isP) {
#pragma unroll
        for (int r = 0; r < 16; ++r) { st0[r] = crow(r, hi) == rowg ? 1.f : 0.f; st1[r] = 32 + crow(r, hi) == rowg ? 1.f : 0.f; } }
    for (int blk_i = 0; blk_i < 4; ++blk_i) {
        const LAS char* blk = gbase + blk_i * BLK_BYTES;
        f32x16 wt = f32x16{};
        wt = __builtin_amdgcn_mfma_f32_32x32x16_bf16(perm_read(blk + O_AQ, n, S_AQ, 0, hi), pack_lo(st0), wt, 0, 0, 0);
        wt = __builtin_amdgcn_mfma_f32_32x32x16_bf16(perm_read(blk + O_AQ, n, S_AQ, 16, hi), pack_hi(st0), wt, 0, 0, 0);
        wt = __builtin_amdgcn_mfma_f32_32x32x16_bf16(perm_read(blk + O_AQ, n, S_AQ, 32, hi), pack_lo(st1), wt, 0, 0, 0);
        wt = __builtin_amdgcn_mfma_f32_32x32x16_bf16(perm_read(blk + O_AQ, n, S_AQ, 48, hi), pack_hi(st1), wt, 0, 0, 0);
        bf16x8 bV = bf16x8{};
        if (!isP) { bV = perm_read(blk + O_BKT, rowg, S_BKT, 32, hi);
            wt = __builtin_amdgcn_mfma_f32_32x32x16_bf16(perm_read(blk + O_L24, n, S_L, 0, hi), bV, wt, 0, 0, 0); }
        const bf16x8 tl3 = perm_read(blk + O_TL3, n, S_L, 0, hi);
        const bf16x8 a_tl = n < 16 ? tl3 : bf16x8{}, a_l3 = n >= 16 ? tl3 : bf16x8{};
        const f32x16 sg = __builtin_amdgcn_mfma_f32_32x32x16_bf16(a_tl, pack_lo(wt), f32x16{}, 0, 0, 0);
        const bf16x8 bSg = pack_lo(sg);
        const f32x16 yy = __builtin_amdgcn_mfma_f32_32x32x16_bf16(a_l3, bSg, wt, 0, 0, 0);
#pragma unroll
        for (int r = 8; r < 16; ++r) { const int t = blk_i * 16 + (r & 3) + 8 * ((r - 8) >> 2) + 4 * hi;
            if (isP) WSP(float, WS_Z)[((size_t)ch * 64 + t) * 64 + rowg] = yy[r]; else WSP(float, WS_Y)[(size_t)(r0 + t) * 1024 + h * 64 + rowg] = yy[r]; }
        st0 = __builtin_amdgcn_mfma_f32_32x32x16_bf16(perm_read(blk + O_BKT, n, S_BKT, 0, hi), bSg, st0, 0, 0, 0);
        st1 = __builtin_amdgcn_mfma_f32_32x32x16_bf16(perm_read(blk + O_BKT, 32 + n, S_BKT, 0, hi), bSg, st1, 0, 0, 0);
        if (!isP) { st0 = __builtin_amdgcn_mfma_f32_32x32x16_bf16(perm_read(blk + O_BKT, n, S_BKT, 16, hi), bV, st0, 0, 0, 0);
                    st1 = __builtin_amdgcn_mfma_f32_32x32x16_bf16(perm_read(blk + O_BKT, 32 + n, S_BKT, 16, hi), bV, st1, 0, 0, 0); }
    }
    const LAS float* GL = (const LAS float*)(gbase + O_GL); float* dst = WSP(float, WS_PU) + (((size_t)ch * 2 + isP) * 64 + rowg) * 64;
#pragma unroll
    for (int g4 = 0; g4 < 4; ++g4) { const int k0 = 8 * g4 + 4 * hi; const f32x4 ga = *(const LAS f32x4*)(GL + k0), gb = *(const LAS f32x4*)(GL + 32 + k0);
        *(GAS f32x4*)(dst + k0) = (f32x4){st0[4 * g4] * ga.x, st0[4 * g4 + 1] * ga.y, st0[4 * g4 + 2] * ga.z, st0[4 * g4 + 3] * ga.w};
        *(GAS f32x4*)(dst + 32 + k0) = (f32x4){st1[4 * g4] * gb.x, st1[4 * g4 + 1] * gb.y, st1[4 * g4 + 2] * gb.z, st1[4 * g4 + 3] * gb.w}; }
}
}
__device__ __forceinline__ void phase_sample_stream(Ctx& F) {
    for (int u = F.vcu * NWAVES + F.wave; u < DBAT * HA * 32; u += NWAVES * F.G) sba::attn_sample_unit(F, (u >> 8) * HA + (u & 7), (u >> 3) & 31, (char*)F.lds + F.wave * 16384);
}
__device__ __forceinline__ void phase_scan1_mfma(Ctx& F) {
    __syncthreads();
    const int grp = F.wave >> 2, wq = F.wave & 3; LAS char* gbase = (LAS char*)F.lds + grp * msc::GRP_BYTES;
    msc::PrepRegs L;
    { const int ch = 2 * F.vcu + grp; if (ch < NBATCH * HB * 64) msc::prep_load(F, L, (ch >> 10) * SEQ + (ch & 63) * 64 + 16 * wq, (ch >> 6) & 15); }
    for (int base = 2 * F.vcu; base < NBATCH * HB * 64; base += 2 * F.G) {
        const int ch = base + grp, bh = ch >> 6, c = ch & 63;
        msc::prep_block(F, L, (bh >> 4) * SEQ + c * 64 + 16 * wq, bh & 15, wq, gbase);
        __syncthreads();
        { const int chn = ch + 2 * F.G; if (chn < NBATCH * HB * 64) msc::prep_load(F, L, (chn >> 10) * SEQ + (chn & 63) * 64 + 16 * wq, (chn >> 6) & 15); }
        msc::chain(F, bh, c, wq >> 1, wq & 1, gbase);
    }
}
__device__ __forceinline__ void phase_scan2(Ctx& F) {
    LAS float* Pb = (LAS float*)(F.lds + 4096);
    const float* PU = WSP(float, WS_PU); float* SC = WSP(float, WS_SC);
    for (int unit = F.vcu; unit < NBATCH * HB * 8; unit += F.G) {
        const int bh = unit >> 3, r0 = (unit & 7) * 8, r = F.wave, col = F.lane;
        __syncthreads();
        { const float* P0 = PU + ((size_t)(bh * 64) * 2 + 1) * 4096; const f32x4 a = *(const GAS f32x4*)(P0 + F.tid * 4), bq = *(const GAS f32x4*)(P0 + 2048 + F.tid * 4);
          *(LAS f32x4*)(Pb + F.tid * 4) = a; *(LAS f32x4*)(Pb + 2048 + F.tid * 4) = bq; }
        float ucur = PU[((size_t)(bh * 64) * 2 + 0) * 4096 + (r0 + r) * 64 + col], scur = 0.f;
        __syncthreads();
        for (int c = 0; c < 64; ++c) {
            const int ch = bh * 64 + c; LAS float* Pc = Pb + (c & 1) * 4096;
            SC[((size_t)ch * 64 + r0 + r) * 64 + col] = scur;
            f32x4 pa = {0.f, 0.f, 0.f, 0.f}, pq = {0.f, 0.f, 0.f, 0.f}; float unext = 0.f;
            if (c + 1 < 64) { const float* Pn = PU + ((size_t)(ch + 1) * 2 + 1) * 4096; pa = *(const GAS f32x4*)(Pn + F.tid * 4); pq = *(const GAS f32x4*)(Pn + 2048 + F.tid * 4);
                unext = PU[((size_t)(ch + 1) * 2 + 0) * 4096 + (r0 + r) * 64 + col]; }
            float a0 = ucur, a1 = 0.f, a2 = 0.f, a3 = 0.f;
#pragma unroll
            for (int j = 0; j < 64; j += 4) {
                const float s0 = readlane_f(scur, j), s1 = readlane_f(scur, j + 1), s2 = readlane_f(scur, j + 2), s3 = readlane_f(scur, j + 3);
                a0 += s0 * Pc[(j + 0) * 64 + col]; a1 += s1 * Pc[(j + 1) * 64 + col]; a2 += s2 * Pc[(j + 2) * 64 + col]; a3 += s3 * Pc[(j + 3) * 64 + col]; }
            const float acc = (a0 + a1) + (a2 + a3);
            if (c + 1 < 64) { LAS float* Pn = Pb + ((c + 1) & 1) * 4096; *(LAS f32x4*)(Pn + F.tid * 4) = pa; *(LAS f32x4*)(Pn + 2048 + F.tid * 4) = pq; }
            __syncthreads();
            scur = acc; ucur = unext;
        }
        F.outp()[O_WKVP + ((size_t)bh * 64 + r0 + r) * 64 + col] = scur;
    }
}
__device__ __forceinline__ void phase_scan3(Ctx& F) {
    const int gw = F.vcu * NWAVES + F.wave, NGW = F.G * NWAVES, lane = F.lane, q = lane >> 4, m = lane & 15;
    const float* SC = WSP(float, WS_SC); const float* Z = WSP(float, WS_Z); float* Y = WSP(float, WS_YC);
    for (int task = gw; task < NBATCH * HB * 63 * 4; task += NGW) {
        const int g = task & 3, cc = task >> 2, bh = cc / 63, c = 1 + (cc - bh * 63), ch = bh * 64 + c, h = bh & 15, b = bh >> 4, row = 16 * g + m;
        const float* st = SC + ((size_t)ch * 64 + row) * 64 + 16 * q; float s[16];
#pragma unroll
        for (int i = 0; i < 16; i += 4) { const f32x4 v = *(const GAS f32x4*)(st + i); s[i] = v.x; s[i + 1] = v.y; s[i + 2] = v.z; s[i + 3] = v.w; }
        const float* zp = Z + (size_t)ch * 4096 + lane; float* yp = Y + (size_t)(b * SEQ + c * 64) * 1024 + h * 64 + row;
        float zb[4];
#pragma unroll
        for (int u = 0; u < 4; ++u) zb[u] = zp[u * 64];
        for (int t = 0; t < 64; t += 4) {
#pragma unroll
            for (int u = 0; u < 4; ++u) {
                const float zv = zb[u]; if (t + u + 4 < 64) zb[u] = zp[(t + u + 4) * 64];
                float acc = 0.f; dot16(acc, zv, s); acc = xrow16_sum(acc);
                if (q == 0) yp[(size_t)(t + u) * 1024] = acc;
            }
        }
    }
}
__device__ __forceinline__ float sum32(float v) {
    v += dpp_f<0xB1>(v); v += dpp_f<0x4E>(v); v += dpp_f<0x141>(v); v += dpp_f<0x140>(v);
    auto s = __builtin_amdgcn_permlane16_swap(__float_as_uint(v), __float_as_uint(v), false, false);
    return __uint_as_float(s[0]) + __uint_as_float(s[1]);
}
__device__ __forceinline__ sba::bf16x8 ld8_bf16(const float* p) { const f32x4 a = *(const GAS f32x4*)p, b = *(const GAS f32x4*)(p + 4); return msc::pack8(a.x, a.y, a.z, a.w, b.x, b.y, b.z, b.w); }
__device__ __forceinline__ void phase_scan3_post(Ctx& F) {
    const int gw = F.vcu * NWAVES + F.wave, NGW = F.G * NWAVES, lane = F.lane, n = lane & 31, hi = lane >> 5;
    const float* SC = WSP(float, WS_SC); const float* Z = WSP(float, WS_Z); const float* Y = WSP(float, WS_Y); const bf16* LWH = WSP(bf16, WS_LWH); const bf16* PBH = WSP(bf16, WS_PBH);
    const float* SCL = WSP(float, WS_SCL); bf16* OAB = WSP(bf16, WS_OAB);
    for (int ch = gw; ch < NBATCH * HB * 64; ch += NGW) {
        const int bh = ch >> 6, c = ch & 63, h = bh & 15, b = bh >> 4, r0 = b * SEQ + c * 64, col0 = h * 64 + n;
        const float lg0 = F.in(I_LNG)[col0], lg1 = F.in(I_LNG)[col0 + 32], lb0 = F.in(I_LNB)[col0], lb1 = F.in(I_LNB)[col0 + 32], mv0 = F.in(I_MU)[2048 + col0], mv1 = F.in(I_MU)[2048 + col0 + 32];
        sba::bf16x8 sb0[4], sb1[4];
        if (c > 0) { const float* Sp = SC + (size_t)ch * 4096 + n * 64 + 8 * hi;
#pragma unroll
            for (int ks = 0; ks < 4; ++ks) { sb0[ks] = ld8_bf16(Sp + 16 * ks); sb1[ks] = ld8_bf16(Sp + 32 * 64 + 16 * ks); } }
        else {
#pragma unroll
            for (int ks = 0; ks < 4; ++ks) { sb0[ks] = sba::bf16x8{}; sb1[ks] = sba::bf16x8{}; } }
        for (int tt = 0; tt < 2; ++tt) {
            sba::f32x16 a0 = sba::f32x16{}, a1 = sba::f32x16{};
            if (c > 0) { const float* Zp = Z + (size_t)ch * 4096 + (32 * tt + n) * 64 + 8 * hi;
#pragma unroll
                for (int ks = 0; ks < 4; ++ks) { const sba::bf16x8 za = ld8_bf16(Zp + 16 * ks);
                    a0 = __builtin_amdgcn_mfma_f32_32x32x16_bf16(za, sb0[ks], a0, 0, 0, 0); a1 = __builtin_amdgcn_mfma_f32_32x32x16_bf16(za, sb1[ks], a1, 0, 0, 0); } }
#pragma unroll
            for (int rg = 0; rg < 16; rg += 4) {
                float y0[4], y1[4], g0[4], g1[4], p0[4], p1[4], q0[4], q1[4], bn[4];
#pragma unroll
                for (int i = 0; i < 4; ++i) { const int t = 32 * tt + sba::crow(rg + i, hi), r = r0 + t;
                    y0[i] = Y[(size_t)r * 1024 + col0]; y1[i] = Y[(size_t)r * 1024 + col0 + 32];
                    g0[i] = ldbf(LWH + (size_t)r * 3072 + 2048 + col0); g1[i] = ldbf(LWH + (size_t)r * 3072 + 2048 + col0 + 32);
                    const bf16* pb = PBH + (size_t)r * 3072 + 2048 + col0; p0[i] = ldbf(pb); p1[i] = ldbf(pb + 32);
                    const bool hp = (r & (SEQ - 1)) != 0; q0[i] = hp ? ldbf(pb - 3072) : 0.f; q1[i] = hp ? ldbf(pb + 32 - 3072) : 0.f;
                    bn[i] = SCL[((size_t)r * HB + h) * 4 + 2]; }
#pragma unroll
                for (int i = 0; i < 4; ++i) { const int t = 32 * tt + sba::crow(rg + i, hi), r = r0 + t;
                    const float v0 = y0[i] + a0[rg + i], v1 = y1[i] + a1[rg + i];
                    const float mean = sum32(v0 + v1) * (1.f / 64.f), d0 = v0 - mean, d1 = v1 - mean, var = sum32(d0 * d0 + d1 * d1) * (1.f / 64.f), rs = rsqrtf(var + EPS_LNX);
                    const float zv0 = p0[i] + mv0 * (q0[i] - p0[i]), zv1 = p1[i] + mv1 * (q1[i] - p1[i]);
                    const float o0 = (d0 * rs * lg0 + lb0 + bn[i] * zv0) * g0[i], o1 = (d1 * rs * lg1 + lb1 + bn[i] * zv1) * g1[i];
                    const float o0n = dpp_f<0xB1>(o0), o1n = dpp_f<0xB1>(o1);
                    if ((lane & 1) == 0) { *(GAS unsigned*)(OAB + (size_t)r * DM + 1024 + col0) = cvt_pk_bf16(o0, o0n); *(GAS unsigned*)(OAB + (size_t)r * DM + 1024 + col0 + 32) = cvt_pk_bf16(o1, o1n); } }
            }
        }
    }
}
__device__ __forceinline__ void phase_postscan(Ctx& F) {
    const int gw = F.vcu * NWAVES + F.wave, NGW = F.G * NWAVES;
    const float* Y = WSP(float, WS_Y); const float* RWV = WSP(float, WS_RWV); const float* SCL = WSP(float, WS_SCL); const float* LWO = WSP(float, WS_LWO); const float* Pp = WSP(float, WS_P); bf16* OAB = WSP(bf16, WS_OAB);
    for (int u = NPR * 4 + gw; u < NTOK * 4; u += NGW) {
        const int r = u >> 2, hq = u & 3; const bool corr = false;
        float yv[4], gv[4], vv[4], bn[4];
#pragma unroll
        for (int i = 0; i < 4; ++i) { const int h = hq * 4 + i, col = h * 64 + F.lane;
            yv[i] = Y[(size_t)r * 1024 + col]; if (corr) yv[i] += WSP(float, WS_YC)[(size_t)r * 1024 + col];
            gv[i] = LWO[(size_t)r * 3072 + 2048 + col]; bn[i] = SCL[((size_t)r * HB + h) * 4 + 2];
            vv[i] = RWV[((size_t)r * HB + h) * 512 + 320 + F.lane]; }
#pragma unroll
        for (int i = 0; i < 4; ++i) { const int h = hq * 4 + i, col = h * 64 + F.lane;
            const float mean = wave_sum(yv[i]) * (1.f / 64.f), d = yv[i] - mean, var = wave_sum(d * d) * (1.f / 64.f);
            const float yn = d * rsqrtf(var + EPS_LNX) * F.in(I_LNG)[col] + F.in(I_LNB)[col] + bn[i] * vv[i];
            const float o = yn * gv[i];
            const float o1 = dpp_f<0xB1>(o);
            if ((F.lane & 1) == 0) *(GAS unsigned*)(OAB + (size_t)r * DM + 1024 + col) = cvt_pk_bf16(o, o1); }
    }
    sample_combine(F);
    const float* OP = WSP(float, WS_OP); const float* CL = WSP(float, WS_CL);
    for (size_t i = (size_t)F.vcu * NTHR + F.tid; i < (size_t)NPR * 256; i += (size_t)F.G * NTHR) {
        const int r = (int)(i >> 8), c4 = (int)(i & 255) * 4, h = c4 >> 7;
        const f32x4 a = *(const GAS f32x4*)(OP + (size_t)r * 1024 + c4), e = *(const GAS f32x4*)(OP + ((size_t)NPR + r) * 1024 + c4); const float cl = CL[(size_t)r * HA + h];
        const f32x4 o = a + e * cl; u32x2 w; w.x = cvt_pk_bf16(o.x, o.y); w.y = cvt_pk_bf16(o.z, o.w);
        *(GAS u32x2*)(OAB + (size_t)r * DM + c4) = w;
    }
}
__device__ __forceinline__ void phase_usample(Ctx& F) {
    const float* PU_ = WSP(float, WS_PARTU); bf16* U = WSP(bf16, WS_U);
    for (int i = F.vcu * NTHR + F.tid; i < NSM * DFF / 4; i += F.G * NTHR) { const int r = i / (DFF / 4), c4 = (i - r * (DFF / 4)) * 4;
        f32x4 a = *(const GAS f32x4*)(PU_ + (size_t)r * DFF + c4);
#pragma unroll
        for (int kc = 1; kc < 8; ++kc) a += *(const GAS f32x4*)(PU_ + ((size_t)kc * 64 + r) * DFF + c4);
        const float x0 = fmaxf(a.x, 0.f), x1 = fmaxf(a.y, 0.f), x2 = fmaxf(a.z, 0.f), x3 = fmaxf(a.w, 0.f);
        u32x2 w; w.x = cvt_pk_bf16(x0 * x0, x1 * x1); w.y = cvt_pk_bf16(x2 * x2, x3 * x3);
        *(GAS u32x2*)(U + (size_t)(NPR + r) * DFF + c4) = w; }
}
#ifndef MK_SPLIT
#define MK_SPLIT 0
#endif
constexpr int NPHASE = 21;
struct Args { const void* in[N_IN]; float* out; unsigned char* ws; int ph_lo, ph_hi; };
__global__ void __launch_bounds__(NTHR, 2) mega_fwd(Args args) {
    extern __shared__ __attribute__((aligned(16))) unsigned char lds_raw[];
    Ctx F;
    F.lds = (LAS unsigned char*)lds_raw; F.tid = threadIdx.x; F.lane = F.tid & 63; F.wave = __builtin_amdgcn_readfirstlane(F.tid >> 6);
    F.G = gridDim.x; { const int bx = blockIdx.x; F.vcu = (F.G % 8 == 0) ? (bx % 8) * (F.G / 8) + bx / 8 : bx; }
    for (int u = F.tid; u < (LDS_BYTES - LDSCTL_OFF) / 4; u += NTHR) ((LAS unsigned*)(F.lds + LDSCTL_OFF))[u] = 0u;
    __syncthreads();
    unsigned* ctl = (unsigned*)(args.ws + WS_CTL);
    XcdBarrier bar; bar.bar = ctl + CW_BAR; bar.x = 0; bar.st = nullptr;
    if (!MK_SPLIT) bar = xcd_barrier_post(ctl + CW_BAR, (volatile LAS unsigned*)(F.lds + MISC_OFF) + 8);
    const int lo = args.ph_lo, hi = args.ph_hi;
#define IN(k) (lo <= (k) && (k) < hi)
#define SEAM(k) do { if (IN(k) && IN((k) + 1)) xcd_barrier(bar); } while (0)
    if (IN(0)) { phase_prologue(F); } SEAM(0);
    if (IN(1)) { phase_mod0(F); } SEAM(1);
    if (IN(2)) { const bool hide = F.G > NCVT + 8; const int ng = hide ? F.G - NCVT : F.G;
        if ((int)blockIdx.x < ng) { pg8::Gemm g{WSP(bf16, WS_H), WSP(bf16, WS_WIN), MP, INPAD, DM, DM, DM}; pg8::StaticOrder S; S.init(MP, INPAD, ng, (int)blockIdx.x); EpiIn E{WSP(bf16, WS_QB), WSP(bf16, WS_KB), WSP(bf16, WS_VB), WSP(float, WS_P), F.outp(), WSP(bf16, WS_PBH)};
            pg8::gemm_phase<EpiIn, pg8::StaticOrder, true, true>(F.lds, g, S, E); }
        else convert_run(F, IT_IN + ((int)blockIdx.x - ng) * NWAVES + F.wave, NCVT * NWAVES, IT_IN + N_HIDE, (LAS float*)(F.lds + F.wave * 16384)); } SEAM(2);
    if (IN(3)) { phase_kv_prep(F); } SEAM(3);
    if (IN(4)) { pg8::Gemm g{WSP(bf16, WS_LA), WSP(bf16, WS_LWT), MP, 3072, 512, 512, 512}; pg8::LoraOrder S; S.init(MP, 3072, F.G, (int)blockIdx.x); pg8::EpiLora E{WSP(float, WS_LWO), WSP(bf16, WS_LWH), 3072};
        pg8::gemm_phase<pg8::EpiLora, pg8::LoraOrder, true, true>(F.lds, g, S, E); } SEAM(4);
    if (IN(6)) { phase_rwkv_prep(F);
        const bool stream_first = (F.vcu & 1) != 0;
        if (stream_first) phase_sample_stream(F); else phase_scan1_mfma(F);
        __syncthreads();
        phase_attn_prompt(F);
        if (!stream_first) phase_sample_stream(F); else phase_scan1_mfma(F); } SEAM(7);
    if (IN(8)) {
        if (F.wave < 2) for (int t = F.vcu * 2 + F.wave; t < DBAT * HB * 4; t += 2 * F.G) scan_wave<false, true>(F, t >> 2, 0, t & 3);
        phase_scan2(F); } SEAM(8);
    if (IN(10)) { phase_scan3_post(F); phase_postscan(F); } SEAM(10);
    if (IN(11)) { pg8::Gemm g{WSP(bf16, WS_OAB), WSP(bf16, WS_WOUT), MP, DM, DM, DM, DM}; pg8::MixOrder<false> S; S.init(DM, DM, F.G, (int)blockIdx.x); pg8::EpiF32S<64> E{WSP(bf16, WS_OUT), DM, nullptr, WSP(float, WS_PART)};
        pg8::gemm_phase<pg8::EpiF32S<64>, pg8::MixOrder<false>, true, true>(F.lds, g, S, E); } SEAM(11);
    if (IN(12)) { phase_postmix<0>(F); } SEAM(12);
    if (IN(13)) { pg8::Gemm g{WSP(bf16, WS_H), WSP(bf16, WS_W1), MP, DFF, DM, DM, DM}; pg8::MixOrder<false> S; S.init(DFF, DM, F.G, (int)blockIdx.x); pg8::EpiRelu2 E{WSP(bf16, WS_U), DFF, WSP(float, WS_PARTU)};
        pg8::gemm_phase<pg8::EpiRelu2, pg8::MixOrder<false>, true, true>(F.lds, g, S, E); } SEAM(13);
    if (IN(14)) { phase_usample(F); if (!MK_SPLIT) xcd_barrier(bar); pg8::Gemm g{WSP(bf16, WS_U), WSP(bf16, WS_W2), MP, DM, DFF, DFF, DFF}; pg8::MixOrder<false> S; S.init(DM, DFF, F.G, (int)blockIdx.x); pg8::EpiF32S<64> E{WSP(bf16, WS_OUT), DM, nullptr, WSP(float, WS_PART)};
        pg8::gemm_phase<pg8::EpiF32S<64>, pg8::MixOrder<false>, true, true>(F.lds, g, S, E); } SEAM(14);
    if (IN(15)) { phase_postmlp<0>(F); } SEAM(15);
    if (IN(16)) { pg8::Gemm g{WSP(bf16, WS_H), WSP(bf16, WS_WPOOL), MP, DM, DM, DM, DM}; pg8::MixOrder<true> S; S.init(DM, DM, F.G, (int)blockIdx.x); pg8::EpiF32S<256> E{WSP(bf16, WS_OUT), DM, F.in(I_PSC), WSP(float, WS_PART)};
        pg8::gemm_phase<pg8::EpiF32S<256>, pg8::MixOrder<true>, true, true>(F.lds, g, S, E); } SEAM(16);
    if (IN(17)) { phase_postmix<1>(F); } SEAM(17);
    if (IN(18)) { pg8::Gemm g{WSP(bf16, WS_H), WSP(bf16, WS_W1) + (size_t)DFF * DM, MP, DFF, DM, DM, DM}; pg8::MixOrder<false> S; S.init(DFF, DM, F.G, (int)blockIdx.x); pg8::EpiRelu2 E{WSP(bf16, WS_U), DFF, WSP(float, WS_PARTU)};
        pg8::gemm_phase<pg8::EpiRelu2, pg8::MixOrder<false>, true, true>(F.lds, g, S, E); } SEAM(18);
    if (IN(19)) { phase_usample(F); if (!MK_SPLIT) xcd_barrier(bar); pg8::Gemm g{WSP(bf16, WS_U), WSP(bf16, WS_W2) + (size_t)DM * DFF, MP, DM, DFF, DFF, DFF}; pg8::MixOrder<false> S; S.init(DM, DFF, F.G, (int)blockIdx.x); pg8::EpiF32S<64> E{WSP(bf16, WS_OUT), DM, nullptr, WSP(float, WS_PART)};
        pg8::gemm_phase<pg8::EpiF32S<64>, pg8::MixOrder<false>, true, true>(F.lds, g, S, E); } SEAM(19);
    if (IN(20)) { phase_postmlp<1>(F); }
#undef IN
#undef SEAM
}

extern "C" void kernel_launch(void* const* d_in, const int* in_sizes, int n_in, void* d_out, int out_size, void* d_ws, size_t ws_size, hipStream_t stream) {
    static int grid = 0;
    if (grid == 0) {
        if (n_in != N_IN || (size_t)out_size != O_END || ws_size < WS_END) { fprintf(stderr, "kernel_launch: unexpected shapes: n_in %d out %d ws %zu (want %d, %zu, >= %zu)\n", n_in, out_size, ws_size, (int)N_IN, (size_t)O_END, (size_t)WS_END); grid = -1; return; }
        int dev = 0, cus = 0, per_cu = 0;
        if (hipGetDevice(&dev) != hipSuccess || hipDeviceGetAttribute(&cus, hipDeviceAttributeMultiprocessorCount, dev) != hipSuccess) { grid = -1; return; }
        if (hipFuncSetAttribute((const void*)mega_fwd, hipFuncAttributeMaxDynamicSharedMemorySize, LDS_BYTES) != hipSuccess) { fprintf(stderr, "kernel_launch: hipFuncSetAttribute failed\n"); grid = -1; return; }
        if (hipOccupancyMaxActiveBlocksPerMultiprocessor(&per_cu, (const void*)mega_fwd, NTHR, LDS_BYTES) != hipSuccess || per_cu < 1) fprintf(stderr, "kernel_launch: occupancy query reports %d blocks per CU\n", per_cu);
        (void)hipGetLastError();
        grid = cus;
    }
    if (grid < 0) return;
    hipMemsetAsync((char*)d_ws + WS_CTL, 0, CTL_ZERO_BYTES, stream);
    Args a{};
    for (int i = 0; i < N_IN; ++i) a.in[i] = d_in[i];
    a.out = (float*)d_out; a.ws = (unsigned char*)d_ws;
#if MK_SPLIT
    for (int p = 0; p < NPHASE; ++p) { a.ph_lo = p; a.ph_hi = p + 1; hipLaunchKernelGGL(mega_fwd, dim3(grid), dim3(NTHR), LDS_BYTES, stream, a); }
#else
    a.ph_lo = 0; a.ph_hi = NPHASE;
    hipLaunchKernelGGL(mega_fwd, dim3(grid), dim3(NTHR), LDS_BYTES, stream, a);
#endif
    const hipError_t le = hipPeekAtLastError();
    if (le != hipSuccess) fprintf(stderr, "kernel_launch: launch failed: %s\n", hipGetErrorName(le));
}
```

```cpp
#include <hip/hip_runtime.h>
#include <cstdio>
#include <cstdint>
namespace pg8 {
#define PG8_LAS __attribute__((address_space(3)))
typedef unsigned short bf16_t;
typedef short bf16x8 __attribute__((ext_vector_type(8)));
typedef float f32x4 __attribute__((ext_vector_type(4)));
typedef unsigned u32x4 __attribute__((ext_vector_type(4)));
constexpr int BM = 256, BK = 64, HALF = 128, HTB = HALF * BK * 2  , STAGE_BYTES = 8 * HTB, NXCD = 8, WGM = 8;

__host__ __device__ __forceinline__ int lds_byte(int r, int c) { const int st = (r >> 4) * 2 + (c >> 5), rr = r & 15, cc = c & 31, ob = rr * 64 + cc * 2; return st * 1024 + (ob ^ (((ob >> 9) & 1) << 5)); }
__host__ __device__ __forceinline__ void stage_rc(int b, int& R, int& C) { const int st = b / 1024, sb = b % 1024, swz = sb ^ (((sb >> 9) & 1) << 5); R = (st >> 1) * 16 + swz / 64; C = (st & 1) * 32 + (swz % 64) / 2; }
__host__ __device__ __forceinline__ int perm32(int rho) { const int n = rho >> 4, i = rho & 15; return 8 * (i >> 2) + 4 * n + (i & 3); }

struct Unit { int pm, pn, kc; };
struct Gemm { const bf16_t* A; const bf16_t* Bt; int M, N, K, lda, ldb; };

struct StaticOrder {
    int nM, nN, nwg, G, c;
    __host__ __device__ void init(int M, int N, int G_, int c_) { nM = M / BM; nN = N / BM; nwg = nM * nN; G = G_; c = c_; }
    __host__ __device__ bool next(int i, Unit& u) const {
        const long L = (long)i * G + c; if (L >= nwg) return false;
        int wgid = (int)L; { const int q = nwg / NXCD, r = nwg % NXCD, xcd = wgid % NXCD, off = wgid / NXCD; wgid = (xcd < r ? xcd * (q + 1) : r * (q + 1) + (xcd - r) * q) + off; }
        const int nig = WGM * nN, gid = wgid / nig, fm = gid * WGM, gsz = (nM - fm) < WGM ? (nM - fm) : WGM;
        u.pm = fm + ((wgid % nig) % gsz); u.pn = (wgid % nig) / gsz; u.kc = -1; return true;
    }
    __device__ __forceinline__ int nt(const Unit&, const Gemm& g) const { return g.K / BK; }
    __device__ __forceinline__ void a_ready(const Unit&) const {}
    __device__ __forceinline__ void done(const Unit&) const {}
    __device__ __forceinline__ size_t a_off(const Unit& u, const Gemm& g) const { return (size_t)u.pm * BM * g.lda * 2; }
    __device__ __forceinline__ size_t b_off(const Unit& u, const Gemm& g) const { return (size_t)u.pn * BM * g.ldb * 2; }
};
struct LoraOrder : StaticOrder {
    __device__ __forceinline__ int k0(const Unit& u) const { return u.pn < 4 ? 0 : (u.pn < 8 ? 64 : 192); }
    __device__ __forceinline__ int nt(const Unit& u, const Gemm&) const { return u.pn < 8 ? 2 : 4; }
    __device__ __forceinline__ size_t a_off(const Unit& u, const Gemm& g) const { return (size_t)u.pm * BM * g.lda * 2 + (size_t)k0(u) * 2; }
    __device__ __forceinline__ size_t b_off(const Unit& u, const Gemm& g) const { return (size_t)u.pn * BM * g.ldb * 2 + (size_t)k0(u) * 2; }
};
__device__ __forceinline__ unsigned cvt_pk_bf16(float lo, float hi) { unsigned r; asm volatile("v_cvt_pk_bf16_f32 %0, %1, %2" : "=v"(r) : "v"(lo), "v"(hi)); return r; }

struct EpiF32 {
    static constexpr bool PERM = false, AFTER_DRAIN = false;
    float* C; int ldc; const float* cscale;
    __device__ __forceinline__ void operator()(const f32x4 (&acc)[2][2][4][2], const Unit& u, int wr, int wc, int fr, int fq) const {
        const int row0 = u.pm * BM + wr * 64 + fr, col0 = u.pn * BM + wc * 32 + 4 * fq;
        f32x4 sv[2][2];
#pragma unroll
        for (int bj = 0; bj < 2; ++bj)
#pragma unroll
            for (int n = 0; n < 2; ++n) sv[bj][n] = cscale ? *(const f32x4*)(cscale + col0 + bj * HALF + n * 16) : (f32x4){1.f, 1.f, 1.f, 1.f};
#pragma unroll
        for (int ai = 0; ai < 2; ++ai)
#pragma unroll
            for (int m = 0; m < 4; ++m) { float* rowp = C + (size_t)(row0 + ai * HALF + m * 16) * ldc + col0;
#pragma unroll
                for (int bj = 0; bj < 2; ++bj)
#pragma unroll
                    for (int n = 0; n < 2; ++n) *(f32x4*)(rowp + bj * HALF + n * 16) = acc[ai][bj][m][n] * sv[bj][n]; }
    }
};
typedef unsigned u32x2h __attribute__((ext_vector_type(2)));
struct EpiLora {
    static constexpr bool PERM = false, AFTER_DRAIN = false;
    float* C; bf16_t* H; int ldc;
    __device__ __forceinline__ void operator()(const f32x4 (&acc)[2][2][4][2], const Unit& u, int wr, int wc, int fr, int fq) const {
        const int row0 = u.pm * BM + wr * 64 + fr, col0 = u.pn * BM + wc * 32 + 4 * fq;
#pragma unroll
        for (int ai = 0; ai < 2; ++ai)
#pragma unroll
            for (int m = 0; m < 4; ++m) { const size_t ro = (size_t)(row0 + ai * HALF + m * 16) * ldc + col0;
#pragma unroll
                for (int bj = 0; bj < 2; ++bj)
#pragma unroll
                    for (int n = 0; n < 2; ++n) { const f32x4 v = acc[ai][bj][m][n];
                        if (u.pm < 32) { u32x2h w; w.x = cvt_pk_bf16(v[0], v[1]); w.y = cvt_pk_bf16(v[2], v[3]); *(u32x2h*)(H + ro + bj * HALF + n * 16) = w; }
                        else *(f32x4*)(C + ro + bj * HALF + n * 16) = v; } }
    }
};
struct EpiRelu2 {
    static constexpr bool PERM = true, AFTER_DRAIN = false;
    bf16_t* O; int ldc; float* PART;
    __device__ __forceinline__ void operator()(const f32x4 (&acc)[2][2][4][2], const Unit& u, int wr, int wc, int fr, int fq) const {
        const int row0 = u.pm * BM + wr * 64 + fr, col0 = u.pn * BM + wc * 32 + 8 * fq;
        if (u.kc >= 0) {
            if (wr == 0) {
#pragma unroll
                for (int m = 0; m < 4; ++m) { float* rowp = PART + ((size_t)u.kc * 64 + m * 16 + fr) * ldc + col0;
#pragma unroll
                    for (int bj = 0; bj < 2; ++bj) { *(f32x4*)(rowp + bj * HALF) = acc[0][bj][m][0]; *(f32x4*)(rowp + bj * HALF + 4) = acc[0][bj][m][1]; } } }
            return;
        }
#pragma unroll
        for (int ai = 0; ai < 2; ++ai)
#pragma unroll
            for (int m = 0; m < 4; ++m) { bf16_t* rowp = O + (size_t)(row0 + ai * HALF + m * 16) * ldc + col0;
#pragma unroll
                for (int bj = 0; bj < 2; ++bj) { f32x4 v0 = acc[ai][bj][m][0], v1 = acc[ai][bj][m][1];
#pragma unroll
                    for (int j = 0; j < 4; ++j) { const float a = v0[j] > 0.f ? v0[j] : 0.f, b = v1[j] > 0.f ? v1[j] : 0.f; v0[j] = a * a; v1[j] = b * b; }
                    u32x4 w; w.x = cvt_pk_bf16(v0[0], v0[1]); w.y = cvt_pk_bf16(v0[2], v0[3]); w.z = cvt_pk_bf16(v1[0], v1[1]); w.w = cvt_pk_bf16(v1[2], v1[3]);
                    *(u32x4*)(rowp + bj * HALF) = w; } }
    }
};
template <bool POOL> struct MixOrder {
    StaticOrder so; int nmain, nN, kdiv, ntot, G, c;
    __device__ void init(int N, int K, int G_, int c_) { nN = N / BM; so.init(32 * BM, N, G_, c_); nmain = 32 * nN; kdiv = (POOL ? 512 : K) / 256; ntot = nmain + nN * kdiv; G = G_; c = c_; }
    __device__ bool next(int i, Unit& u) const {
        const int L = i * G + c; if (L >= ntot) return false;
        if (L < nmain) return so.next(i, u);
        const int j = L - nmain; u.pm = 32; u.pn = j % nN; u.kc = j / nN; return true;
    }
    __device__ __forceinline__ int nt(const Unit& u, const Gemm& g) const { return u.kc >= 0 ? 4 : (POOL ? 8 : g.K / BK); }
    __device__ __forceinline__ size_t a_off(const Unit& u, const Gemm& g) const { return (size_t)u.pm * BM * g.lda * 2 + (size_t)((POOL ? (u.pn >> 1) * 512 : 0) + (u.kc >= 0 ? u.kc * 256 : 0)) * 2; }
    __device__ __forceinline__ size_t b_off(const Unit& u, const Gemm& g) const { return (size_t)u.pn * BM * g.ldb * 2 + (size_t)((POOL ? (u.pn >> 1) * 512 : 0) + (u.kc >= 0 ? u.kc * 256 : 0)) * 2; }
    __device__ __forceinline__ void a_ready(const Unit&) const {}
    __device__ __forceinline__ void done(const Unit&) const {}
};
template <int PROW> struct EpiF32S {
    static constexpr bool PERM = false, AFTER_DRAIN = false;
    bf16_t* C; int ldc; const float* cscale; float* PART;
    __device__ __forceinline__ f32x4 scl(int c) const { return cscale ? *(const f32x4*)(cscale + c) : (f32x4){1.f, 1.f, 1.f, 1.f}; }
    __device__ __forceinline__ void operator()(const f32x4 (&acc)[2][2][4][2], const Unit& u, int wr, int wc, int fr, int fq) const {
        asm volatile("" : "+v"(fr), "+v"(fq));
        const int col0 = u.pn * BM + wc * 32 + 4 * fq;
        if (u.kc < 0) {
            bf16_t* Ct = C + (size_t)u.pm * BM * ldc; const unsigned e0 = (unsigned)((wr * 64 + fr) * ldc + col0);
#pragma unroll
            for (int bj = 0; bj < 2; ++bj)
#pragma unroll
                for (int n = 0; n < 2; ++n) { const f32x4 sv = scl(col0 + bj * HALF + n * 16);
#pragma unroll
                    for (int ai = 0; ai < 2; ++ai)
#pragma unroll
                        for (int m = 0; m < 4; ++m) { const f32x4 v = acc[ai][bj][m][n] * sv; const unsigned w0 = cvt_pk_bf16(v[0], v[1]), w1 = cvt_pk_bf16(v[2], v[3]);
                            *(unsigned long long*)(Ct + e0 + (unsigned)((ai * HALF + m * 16) * ldc) + bj * HALF + n * 16) = (unsigned long long)w0 | ((unsigned long long)w1 << 32); } }
        } else if (PROW == 256) {
            float* Pk = PART + (size_t)u.kc * 256 * ldc; const unsigned e0 = (unsigned)((wr * 64 + fr) * ldc + col0);
#pragma unroll
            for (int bj = 0; bj < 2; ++bj)
#pragma unroll
                for (int n = 0; n < 2; ++n) { const f32x4 sv = scl(col0 + bj * HALF + n * 16);
#pragma unroll
                    for (int ai = 0; ai < 2; ++ai)
#pragma unroll
                        for (int m = 0; m < 4; ++m) *(f32x4*)(Pk + e0 + (unsigned)((ai * HALF + m * 16) * ldc) + bj * HALF + n * 16) = acc[ai][bj][m][n] * sv; }
        } else if (wr == 0) {
            float* Pk = PART + (size_t)u.kc * 64 * ldc; const unsigned e0 = (unsigned)(fr * ldc + col0);
#pragma unroll
            for (int bj = 0; bj < 2; ++bj)
#pragma unroll
                for (int n = 0; n < 2; ++n) { const f32x4 sv = scl(col0 + bj * HALF + n * 16);
#pragma unroll
                    for (int m = 0; m < 4; ++m) *(f32x4*)(Pk + e0 + (unsigned)(m * 16 * ldc) + bj * HALF + n * 16) = acc[0][bj][m][n] * sv; }
        }
    }
};
template <class Epi, class Sched, bool ALIGN_EPI = false, bool SP2 = false>
__device__ __forceinline__ void gemm_phase(PG8_LAS unsigned char* lds, const Gemm g, const Sched& S, const Epi& E) {
    const int tid = threadIdx.x, wid = __builtin_amdgcn_readfirstlane(tid >> 6), lane = tid & 63, wr = wid >> 2, wc = wid & 3, fr = lane & 15, fq = lane >> 4;
    unsigned voffA[2], voffB[2];
#pragma unroll
    for (int i = 0; i < 2; ++i) { int R, C; stage_rc(tid * 16 + i * 8192, R, C); const int Rb = Epi::PERM ? ((R & ~31) + perm32(R & 31)) : R;
        voffA[i] = (unsigned)(R * g.lda + C) * 2u; voffB[i] = (unsigned)(Rb * g.ldb + C) * 2u; }
    const size_t kstep = (size_t)(BK * 2);
    const size_t hsA = (size_t)HALF * g.lda * 2, hsB = (size_t)HALF * g.ldb * 2;
    const unsigned ldsw = (unsigned)wid * 1024u;
    const int aoff = lds_byte(wr * 64 + fr, fq * 8), boff = lds_byte(wc * 32 + fr, fq * 8);
#define PG8_SA(b, h) (((b) * 2 + (h)) * HTB)
#define PG8_SB(b, h) ((4 + (b) * 2 + (h)) * HTB)
#define PG8_STAGE(bufoff, gbase, voff) do { _Pragma("unroll") for (int _i = 0; _i < 2; ++_i) \
        __builtin_amdgcn_global_load_lds((const unsigned*)((const char*)(gbase) + (voff)[_i]), (PG8_LAS unsigned*)(lds + (bufoff) + ldsw + _i * 8192), 16, 0, 0); } while (0)
#define PG8_LDA(dst, b, h) do { _Pragma("unroll") for (int m = 0; m < 4; ++m) _Pragma("unroll") for (int k = 0; k < 2; ++k) dst[m][k] = *(const PG8_LAS bf16x8*)(lds + PG8_SA(b, h) + aoff + m * 2048 + k * 1024); } while (0)
#define PG8_LDB(dst, b, h) do { _Pragma("unroll") for (int n = 0; n < 2; ++n) _Pragma("unroll") for (int k = 0; k < 2; ++k) dst[n][k] = *(const PG8_LAS bf16x8*)(lds + PG8_SB(b, h) + boff + n * 2048 + k * 1024); } while (0)
#define PG8_MMA(ai, bj, At, Bt) do { __builtin_amdgcn_s_setprio(1); _Pragma("unroll") for (int m = 0; m < 4; ++m) _Pragma("unroll") for (int n = 0; n < 2; ++n) _Pragma("unroll") for (int k = 0; k < 2; ++k) \
        acc[ai][bj][m][n] = __builtin_amdgcn_mfma_f32_16x16x32_bf16(Bt[n][k], At[m][k], acc[ai][bj][m][n], 0, 0, 0); __builtin_amdgcn_s_setprio(0); } while (0)
#define PG8_WAIT_V(n) asm volatile("s_waitcnt vmcnt(" #n ")" ::: "memory")
#define PG8_WAIT_L(n) asm volatile("s_waitcnt lgkmcnt(" #n ")" ::: "memory")
#define PG8_BAR __builtin_amdgcn_s_barrier()
#define PG8_SCHED __builtin_amdgcn_sched_barrier(0)
    Unit cur, nxt; int ui = 0;
    if (!S.next(0, cur)) return;
    int nt = S.nt(cur, g);
    f32x4 acc[2][2][4][2];
#pragma unroll
    for (int a = 0; a < 2; ++a)
#pragma unroll
        for (int b = 0; b < 2; ++b)
#pragma unroll
            for (int m = 0; m < 4; ++m)
#pragma unroll
                for (int n = 0; n < 2; ++n) acc[a][b][m][n] = (f32x4){0.f, 0.f, 0.f, 0.f};
    bf16x8 At[4][2], B0[2][2], B1[2][2];
    const char* cA = (const char*)g.A + S.a_off(cur, g); const char* cB = (const char*)g.Bt + S.b_off(cur, g);
    S.a_ready(cur);
    if constexpr (SP2) {
        PG8_STAGE(PG8_SB(0, 0), cB, voffB); PG8_STAGE(PG8_SB(0, 1), cB + hsB, voffB); PG8_STAGE(PG8_SA(0, 0), cA, voffA); PG8_STAGE(PG8_SA(0, 1), cA + hsA, voffA);
        if (wr == 1) PG8_BAR;
        PG8_WAIT_V(2); PG8_BAR;
        PG8_STAGE(PG8_SB(1, 0), cB + kstep, voffB); PG8_STAGE(PG8_SA(1, 0), cA + kstep, voffA); PG8_STAGE(PG8_SB(1, 1), cB + hsB + kstep, voffB);
        PG8_WAIT_V(6); PG8_BAR;
    } else {
        PG8_STAGE(PG8_SB(0, 0), cB, voffB); PG8_STAGE(PG8_SA(0, 0), cA, voffA); PG8_STAGE(PG8_SB(0, 1), cB + hsB, voffB); PG8_STAGE(PG8_SA(0, 1), cA + hsA, voffA);
        if (wr == 1) PG8_BAR;
        PG8_WAIT_V(4); PG8_BAR;
        PG8_STAGE(PG8_SB(1, 0), cB + kstep, voffB); PG8_STAGE(PG8_SA(1, 0), cA + kstep, voffA); PG8_STAGE(PG8_SB(1, 1), cB + hsB + kstep, voffB);
        PG8_WAIT_V(6); PG8_BAR;
    }
    for (;;) {
        const bool has_next = S.next(ui + 1, nxt);
        const char* nA = has_next ? (const char*)g.A + S.a_off(nxt, g) : cA; const char* nB = has_next ? (const char*)g.Bt + S.b_off(nxt, g) : cB;
        for (int t = 0; t < nt; t += 2) {
            const bool last = (t == nt - 2);
            const char* a1 = cA + (size_t)(t + 1) * kstep;
            const char* a2 = last ? nA : cA + (size_t)(t + 2) * kstep; const char* b2 = last ? nB : cB + (size_t)(t + 2) * kstep;
            const char* a3 = a2 + kstep; const char* b3 = b2 + kstep;
            if (last && has_next) S.a_ready(nxt);
            if constexpr (SP2) {
            PG8_LDB(B0, 0, 0); PG8_LDB(B1, 0, 1); PG8_SCHED; PG8_LDA(At, 0, 0); PG8_STAGE(PG8_SA(1, 1), a1 + hsA, voffA);
            PG8_WAIT_V(8); PG8_WAIT_L(0); PG8_BAR; PG8_MMA(0, 0, At, B0); PG8_MMA(0, 1, At, B1); PG8_BAR; PG8_SCHED;
            PG8_LDA(At, 0, 1); PG8_STAGE(PG8_SB(0, 0), b2, voffB); PG8_STAGE(PG8_SB(0, 1), b2 + hsB, voffB); PG8_STAGE(PG8_SA(0, 0), a2, voffA);
            PG8_WAIT_V(8); PG8_WAIT_L(0); PG8_BAR; PG8_MMA(1, 0, At, B0); PG8_MMA(1, 1, At, B1); PG8_BAR; PG8_SCHED;
            PG8_LDB(B0, 1, 0); PG8_LDB(B1, 1, 1); PG8_SCHED; PG8_LDA(At, 1, 0); PG8_STAGE(PG8_SA(0, 1), a2 + hsA, voffA);
            PG8_WAIT_V(8); PG8_WAIT_L(0); PG8_BAR; PG8_MMA(0, 0, At, B0); PG8_MMA(0, 1, At, B1); PG8_BAR; PG8_SCHED;
            PG8_LDA(At, 1, 1); PG8_STAGE(PG8_SB(1, 0), b3, voffB); PG8_STAGE(PG8_SB(1, 1), b3 + hsB, voffB); PG8_STAGE(PG8_SA(1, 0), a3, voffA);
            PG8_WAIT_V(8); PG8_WAIT_L(0); PG8_BAR; PG8_MMA(1, 0, At, B0); PG8_MMA(1, 1, At, B1); PG8_BAR; PG8_SCHED;
            } else {
            PG8_LDB(B0, 0, 0); PG8_SCHED; PG8_LDA(At, 0, 0); PG8_STAGE(PG8_SA(1, 1), a1 + hsA, voffA);
            PG8_WAIT_L(8); PG8_BAR; PG8_WAIT_L(0); PG8_MMA(0, 0, At, B0); PG8_BAR; PG8_SCHED;
            PG8_LDB(B1, 0, 1); PG8_STAGE(PG8_SB(0, 0), b2, voffB);
            PG8_BAR; PG8_WAIT_L(0); PG8_MMA(0, 1, At, B1); PG8_BAR;
            PG8_LDA(At, 0, 1); PG8_STAGE(PG8_SA(0, 0), a2, voffA);
            PG8_BAR; PG8_WAIT_L(0); PG8_MMA(1, 0, At, B0); PG8_BAR; PG8_SCHED;
            PG8_STAGE(PG8_SB(0, 1), b2 + hsB, voffB);
            PG8_WAIT_V(6); PG8_BAR; PG8_MMA(1, 1, At, B1); PG8_BAR;
            PG8_LDB(B0, 1, 0); PG8_SCHED; PG8_LDA(At, 1, 0); PG8_STAGE(PG8_SA(0, 1), a2 + hsA, voffA);
            PG8_WAIT_L(8); PG8_BAR; PG8_WAIT_L(0); PG8_MMA(0, 0, At, B0); PG8_BAR; PG8_SCHED;
            PG8_LDB(B1, 1, 1); PG8_STAGE(PG8_SB(1, 0), b3, voffB);
            PG8_BAR; PG8_WAIT_L(0); PG8_MMA(0, 1, At, B1); PG8_BAR;
            PG8_LDA(At, 1, 1); PG8_STAGE(PG8_SA(1, 0), a3, voffA);
            PG8_BAR; PG8_WAIT_L(0); PG8_MMA(1, 0, At, B0); PG8_BAR; PG8_SCHED;
            PG8_STAGE(PG8_SB(1, 1), b3 + hsB, voffB);
            PG8_WAIT_V(6); PG8_BAR; PG8_MMA(1, 1, At, B1); PG8_BAR;
            }
        }
        if constexpr (ALIGN_EPI) { if (wr == 0) PG8_BAR; }
        if constexpr (!Epi::AFTER_DRAIN) { E(acc, cur, wr, wc, fr, fq); S.done(cur); }
        if (!has_next) break;
#pragma unroll
        for (int a = 0; a < 2; ++a)
#pragma unroll
            for (int b = 0; b < 2; ++b)
#pragma unroll
                for (int m = 0; m < 4; ++m)
#pragma unroll
                    for (int n = 0; n < 2; ++n) acc[a][b][m][n] = (f32x4){0.f, 0.f, 0.f, 0.f};
        cur = nxt; cA = nA; cB = nB; ++ui; nt = S.nt(cur, g);
        if constexpr (ALIGN_EPI) { if (wr == 1) PG8_BAR; }
    }
    PG8_WAIT_V(0);
    if constexpr (!ALIGN_EPI) { if (wr == 0) PG8_BAR; }
    PG8_BAR;
    if constexpr (Epi::AFTER_DRAIN) { E.fused(acc, cur, wr, wc, fr, fq, lds, wid, lane); S.done(cur); }
#undef PG8_SA
#undef PG8_SB
#undef PG8_STAGE
#undef PG8_LDA
#undef PG8_LDB
#undef PG8_MMA
#undef PG8_WAIT_V
#undef PG8_WAIT_L
#undef PG8_BAR
#undef PG8_SCHED
}
}

constexpr int DM = 2048, SEQ = 4096, NBATCH = 2, NPR = NBATCH * SEQ, DBAT = 8, DSEQ = 8, NSM = DBAT * DSEQ, NTOK = NPR + NSM, MP = 8448;
constexpr int HA = 8, DHA = 128, HB = 16, DHB = 64, DBR = 1024;
constexpr int BCOLS = 3520, INCOLS = 6592, INPAD = 6656, DFF = 8192, NPAGES = 128, PAGESZ = 128, PAST = 16384, PBUF = 15, NMR = 10;
constexpr float EPS_RMS = 1e-6f, EPS_LNX = 64e-5f, QK_SCALE = 0.08838834764831845f;
enum { I_XP = 0, I_XS, I_CK, I_CV, I_PT, I_SWKV, I_SSH, I_SPOOL, I_CP, I_CS, I_WADA, I_BADA, I_NG, I_WIN, I_WOUT, I_SBB, I_MU, I_W0, I_WUP, I_A0, I_AUP, I_GUP, I_KK, I_KA, I_RK, I_LNG, I_LNB, I_WPOOL, I_PSC, I_W1, I_W2, N_IN };
constexpr size_t O_YP = 0, O_YS = O_YP + (size_t)NPR * DM, O_KP = O_YS + (size_t)NSM * DM, O_VP = O_KP + (size_t)NPR * 1024, O_KS = O_VP + (size_t)NPR * 1024, O_VS = O_KS + (size_t)NSM * 1024,
                 O_WKVP = O_VS + (size_t)NSM * 1024, O_WKVS = O_WKVP + (size_t)NBATCH * HB * 64 * 64, O_SHP = O_WKVS + (size_t)DBAT * HB * 64 * 64, O_SHS = O_SHP + (size_t)NBATCH * BCOLS,
                 O_PLP = O_SHS + (size_t)DBAT * BCOLS, O_PLS = O_PLP + (size_t)NBATCH * PBUF * DM, O_END = O_PLS + (size_t)DBAT * PBUF * DM;
constexpr size_t MiB = 1u << 20;
constexpr size_t WS_CTL = 0, CTL_ZERO_BYTES = 64 * 1024, WS_MOD = 1 * MiB, WS_WIN = 2 * MiB, WS_WOUT = 28 * MiB, WS_W1 = 36 * MiB, WS_W2 = 100 * MiB, WS_WPOOL = 164 * MiB,
                 WS_H = 172 * MiB, WS_OAB = 205 * MiB, WS_M = 238 * MiB, WS_P = 271 * MiB, WS_OUT = 486 * MiB, WS_XR = 552 * MiB, WS_HF = 617 * MiB, WS_U = 682 * MiB,
                 WS_RWV = 814 * MiB, WS_SCL = 1072 * MiB, WS_G = 1075 * MiB, WS_Y = 1108 * MiB, WS_PU = 1141 * MiB, WS_Z = 1205 * MiB, WS_SC = 1237 * MiB, WS_QB = 1269 * MiB, WS_KB = 1286 * MiB, WS_VB = 1303 * MiB, WS_OP = 1320 * MiB, WS_CL = 1384 * MiB, WS_SPART = 1385 * MiB, WS_SCAR = 1394 * MiB, WS_LA = 1395 * MiB, WS_LWT = 1404 * MiB, WS_LWO = 1408 * MiB, WS_YC = 1508 * MiB, WS_PART = 1541 * MiB, WS_PARTU = 1558 * MiB, WS_END = 1575 * MiB;
static_assert(WS_WIN + (size_t)INPAD * DM * 2 <= WS_WOUT && WS_P + (size_t)MP * INPAD * 4 <= WS_OUT && WS_U + (size_t)MP * DFF * 2 <= WS_RWV && WS_RWV + (size_t)NTOK * HB * 512 * 4 <= WS_SCL, "ws map");
constexpr int CW_BAR = 4096;
constexpr int RING_BYTES = 131072, LDSCTL_OFF = RING_BYTES, MISC_OFF = LDSCTL_OFF + 320, LDS_BYTES = 147456;
constexpr int NWAVES = 8, NTHR = 512;

#define GAS __attribute__((address_space(1)))
#define LAS __attribute__((address_space(3)))
typedef unsigned short bf16;
__device__ __forceinline__ float ldbf(const bf16* p) { return __uint_as_float((unsigned)*p << 16); }
__device__ __forceinline__ float ldbf_nt(const bf16* p) { return __uint_as_float((unsigned)__builtin_nontemporal_load(p) << 16); }
typedef float f32x4 __attribute__((ext_vector_type(4)));
typedef float f32x2 __attribute__((ext_vector_type(2)));
typedef unsigned u32x2 __attribute__((ext_vector_type(2)));
typedef unsigned u32x4 __attribute__((ext_vector_type(4)));
#define LDS_WAIT() asm volatile("s_waitcnt lgkmcnt(0)" ::: "memory")
#define VM_WAIT() asm volatile("s_waitcnt vmcnt(0)" ::: "memory")
using pg8::cvt_pk_bf16;
constexpr size_t WS_PBH = WS_RWV, WS_LWH = WS_RWV + 64 * MiB;
static_assert((size_t)NPR * 3072 * 2 <= 64 * MiB && 128 * MiB <= (size_t)NPR * HB * 512 * 4, "bf16 prompt copies fit below the sample rows of RWV");
constexpr int PBLD = 3584;
struct EpiIn {
    static constexpr bool PERM = false, AFTER_DRAIN = false;
    bf16 *QB, *KB, *VB; float* PB; float* out; bf16* PBH;
    __device__ __forceinline__ void operator()(const pg8::f32x4 (&acc)[2][2][4][2], const pg8::Unit& u, int wr, int wc, int fr, int fq) const {
        const int row0 = u.pm * 256 + wr * 64 + fr, colt = u.pn * 256 + wc * 32 + 4 * fq;
        if (u.pn >= 12) {
#pragma unroll
            for (int ai = 0; ai < 2; ++ai)
#pragma unroll
                for (int m = 0; m < 4; ++m) {
                    if (u.pm < 32 && u.pn < 24) { bf16* rowh = PBH + (size_t)(row0 + ai * 128 + m * 16) * 3072 + (colt - 3072);
#pragma unroll
                        for (int bj = 0; bj < 2; ++bj)
#pragma unroll
                            for (int n = 0; n < 2; ++n) { const pg8::f32x4 v = acc[ai][bj][m][n]; u32x2 w; w.x = cvt_pk_bf16(v[0], v[1]); w.y = cvt_pk_bf16(v[2], v[3]); *(u32x2*)(rowh + bj * 128 + n * 16) = w; } }
                    else { float* rowp = PB + (size_t)(row0 + ai * 128 + m * 16) * PBLD + (colt - 3072);
#pragma unroll
                        for (int bj = 0; bj < 2; ++bj)
#pragma unroll
                            for (int n = 0; n < 2; ++n) *(pg8::f32x4*)(rowp + bj * 128 + n * 16) = acc[ai][bj][m][n]; } }
        } else {
            const int sel = u.pn >> 2, c0 = colt - sel * 1024;
            static_assert(WS_KB - WS_QB == WS_VB - WS_KB && O_VP - O_KP == (size_t)NPR * 1024 && O_VS - O_KS == (size_t)NSM * 1024, "q/k/v buffers are equally spaced");
            bf16* Bt = QB + (size_t)sel * ((WS_KB - WS_QB) / 2) + (size_t)u.pm * 256 * 1024;
            float* Ot = u.pm < 32 ? out + O_KP + (size_t)(sel ? sel - 1 : 0) * NPR * 1024 + (size_t)u.pm * 256 * 1024 : out + O_KS + (size_t)(sel ? sel - 1 : 0) * NSM * 1024;
            const int rl0 = wr * 64 + fr;
#pragma unroll
            for (int ai = 0; ai < 2; ++ai)
#pragma unroll
                for (int m = 0; m < 4; ++m) { const int rl = rl0 + ai * 128 + m * 16; const unsigned eo = (unsigned)(rl * 1024 + c0);
                    const bool wo = sel != 0 && (u.pm < 32 || rl < NSM);
#pragma unroll
                    for (int bj = 0; bj < 2; ++bj)
#pragma unroll
                        for (int n = 0; n < 2; ++n) { const pg8::f32x4 v = acc[ai][bj][m][n]; u32x2 w; w.x = cvt_pk_bf16(v[0], v[1]); w.y = cvt_pk_bf16(v[2], v[3]);
                            *(u32x2*)(Bt + eo + bj * 128 + n * 16) = w; if (wo) *(pg8::f32x4*)(Ot + eo + bj * 128 + n * 16) = v; }
                    asm volatile("" ::: "memory"); }
        }
    }
};

#define XB_TMO      128
#define XB_XCNT(j)  (256  + 64 * (j))
#define XB_XSUB(j)  (1280 + 64 * (j))
#define XB_XGEN(j)  (2304 + 64 * (j))
#define XB_TOP      3328
#define XB_TOPGEN   3392
#define XCD_BAR_WORDS 3456
#define XB_SPIN_CAP (1u << 18)

__device__ __forceinline__ unsigned xb_ld(unsigned* p)              { return __hip_atomic_load(p, __ATOMIC_RELAXED, __HIP_MEMORY_SCOPE_AGENT); }
__device__ __forceinline__ unsigned xb_add(unsigned* p, unsigned v) { return __hip_atomic_fetch_add(p, v, __ATOMIC_RELAXED, __HIP_MEMORY_SCOPE_AGENT); }
__device__ __forceinline__ unsigned xb_xcc_id() { return (unsigned)__builtin_amdgcn_s_getreg((3 << 11) | 20) & 0xFu; }
#define XB_SPIN(cond, bar) do { unsigned _sp = 0; while (cond) { __builtin_amdgcn_s_sleep(1); \
    if ((++_sp & 255u) == 0u) { if (xb_ld(&(bar)[XB_TMO])) break; if (_sp > XB_SPIN_CAP) { atomicAdd(&(bar)[XB_TMO], 1u); break; } } } } while (0)

struct XcdBarrier {
    unsigned* bar; unsigned x;
    volatile LAS unsigned* st;
};

__device__ __forceinline__ XcdBarrier xcd_barrier_post(unsigned* bar, volatile LAS unsigned* st) {
    XcdBarrier b; b.bar = bar; b.x = xb_xcc_id(); b.st = st;
    if (threadIdx.x == 0) (void)xb_add(&bar[XB_XCNT(b.x)], 1u);
    return b;
}
__device__ __forceinline__ void xcd_barrier_complete(unsigned* bar, unsigned x, unsigned& nloc, unsigned& nx) {
    const unsigned G = gridDim.x * gridDim.y * gridDim.z;
    unsigned sum, cnt, mine, sp = 0u;
    for (;;) {
        sum = 0u; cnt = 0u; mine = 0u;
#pragma unroll
        for (unsigned j = 0; j < 16; ++j) { const unsigned c = xb_ld(&bar[XB_XCNT(j)]); sum += c; cnt += (c > 0u) ? 1u : 0u; mine = (j == x) ? c : mine; }
        if (sum == G) break;
        __builtin_amdgcn_s_sleep(1);
        if ((++sp & 255u) == 0u) { if (xb_ld(&bar[XB_TMO])) break; if (sp > XB_SPIN_CAP) { atomicAdd(&bar[XB_TMO], 1u); break; } }
    }
    nloc = mine > 0u ? mine : 1u; nx = cnt > 0u ? cnt : 1u;
}

__device__ __forceinline__ void xcd_barrier(const XcdBarrier& b) {
    asm volatile("s_waitcnt vmcnt(0)" ::: "memory");
    __syncthreads();
    if (threadIdx.x == 0) {
        unsigned* bar = b.bar;
        __builtin_amdgcn_s_waitcnt(0);
        unsigned nloc = b.st[0], nx = b.st[1];
        if (nloc == 0u) { xcd_barrier_complete(bar, b.x, nloc, nx); b.st[0] = nloc; b.st[1] = nx; }
        const unsigned old = xb_add(&bar[XB_XSUB(b.x)], 1u);
        const unsigned gen = old / nloc;
        if (old + 1u == (gen + 1u) * nloc) {
            __builtin_amdgcn_fence(__ATOMIC_RELEASE, "agent");
            asm volatile("s_waitcnt vmcnt(0)" ::: "memory");
            const unsigned og = xb_add(&bar[XB_TOP], 1u);
            const unsigned tg = og / nx;
            if (og + 1u == (tg + 1u) * nx) xb_add(&bar[XB_TOPGEN], 1u);
            else XB_SPIN(xb_ld(&bar[XB_TOPGEN]) == tg, bar);
            __builtin_amdgcn_fence(__ATOMIC_ACQUIRE, "agent");
            xb_add(&bar[XB_XGEN(b.x)], 1u);
            asm volatile("s_waitcnt vmcnt(0)" ::: "memory");
        } else {
            XB_SPIN(xb_ld(&bar[XB_XGEN(b.x)]) == gen, bar);
            __builtin_amdgcn_fence(__ATOMIC_ACQUIRE, "agent");
            asm volatile("s_waitcnt vmcnt(0)" ::: "memory");
        }
    }
    __syncthreads();
}


struct Ctx {
    LAS unsigned char* lds; int tid, lane, wave, vcu, G;
    __device__ __forceinline__ const float* in(int i) const { return ((const float* const __attribute__((address_space(4)))*)__builtin_amdgcn_kernarg_segment_ptr())[i]; }
    __device__ __forceinline__ float* outp() const { return ((float* const __attribute__((address_space(4)))*)__builtin_amdgcn_kernarg_segment_ptr())[N_IN]; }
    __device__ __forceinline__ unsigned char* wsp() const { return ((unsigned char* const __attribute__((address_space(4)))*)__builtin_amdgcn_kernarg_segment_ptr())[N_IN + 1]; }
};
template <int CTRL> __device__ __forceinline__ float dpp_f(float x) { return __builtin_bit_cast(float, __builtin_amdgcn_mov_dpp(__builtin_bit_cast(int, x), CTRL, 0xf, 0xf, true)); }
#define readlane_f(x, l) __builtin_bit_cast(float, __builtin_amdgcn_readlane(__builtin_bit_cast(int, (float)(x)), (l)))
__device__ __forceinline__ float wave_sum(float v) {
    v += dpp_f<0xB1>(v); v += dpp_f<0x4E>(v); v += dpp_f<0x141>(v); v += dpp_f<0x140>(v);
    auto s = __builtin_amdgcn_permlane16_swap(__float_as_uint(v), __float_as_uint(v), false, false);
    v = __uint_as_float(s[0]) + __uint_as_float(s[1]);
    auto t = __builtin_amdgcn_permlane32_swap(__float_as_uint(v), __float_as_uint(v), false, false);
    return __uint_as_float(t[0]) + __uint_as_float(t[1]);
}
__device__ __forceinline__ float sigmoidf_(float x) { return 1.f / (1.f + __expf(-x)); }
__device__ __forceinline__ float softplusf_(float x) { return fmaxf(x, 0.f) + log1pf(__expf(-fabsf(x))); }
__device__ __forceinline__ int mod_row(int r) { return r < NPR ? (r >> 12) : 2 + ((r - NPR) >> 3); }
#define WSP(T, off) ((T*)(F.wsp() + (off)))

struct CvtItem { const float* W; bf16* WT; int ldw, ldt, k0, n0; };
__device__ __forceinline__ void item_load(float (&tv)[32], const CvtItem& d, int lane) {
#pragma unroll
    for (int i = 0; i < 32; ++i) tv[i] = __builtin_nontemporal_load(d.W + (size_t)(d.k0 + 2 * i + (lane >> 5)) * d.ldw + d.n0 + (lane & 31));
}
__device__ __forceinline__ void item_store(const float (&tv)[32], const CvtItem& d, LAS float* scr, int lane) {
#pragma unroll
    for (int i = 0; i < 32; ++i) scr[(2 * i + (lane >> 5)) * 33 + (lane & 31)] = tv[i];
    LDS_WAIT(); asm volatile("" ::: "memory");
    const int c = lane & 7;
#pragma unroll
    for (int j = 0; j < 4; ++j) { const int n = (lane >> 3) + 8 * j; const LAS float* s = scr + (8 * c) * 33 + n;
        u32x4 o; o.x = cvt_pk_bf16(s[0 * 33], s[1 * 33]); o.y = cvt_pk_bf16(s[2 * 33], s[3 * 33]); o.z = cvt_pk_bf16(s[4 * 33], s[5 * 33]); o.w = cvt_pk_bf16(s[6 * 33], s[7 * 33]);
        *(GAS u32x4*)(d.WT + (size_t)(d.n0 + n) * d.ldt + d.k0 + 8 * c) = o; }
    LDS_WAIT(); asm volatile("" ::: "memory");
}
constexpr int IT_IN = 32 * 206, IT_OUT = 32 * 64, IT_W1 = 32 * 256, IT_W2 = 128 * 64, IT_PL = 8 * 16, NIT_ALL = IT_IN + IT_OUT + 2 * IT_W1 + 2 * IT_W2 + 4 * IT_PL;
__device__ __forceinline__ CvtItem item_decode(Ctx& F, int it) {
    int r = it; CvtItem d; int N;
    if (r < IT_IN) { d.W = F.in(I_WIN); d.WT = WSP(bf16, WS_WIN); N = INCOLS; d.ldt = DM; }
    else if ((r -= IT_IN) < IT_OUT) { d.W = F.in(I_WOUT); d.WT = WSP(bf16, WS_WOUT); N = DM; d.ldt = DM; }
    else if ((r -= IT_OUT) < 2 * IT_W1) { const int l = r / IT_W1; r -= l * IT_W1; d.W = F.in(I_W1) + (size_t)l * DM * DFF; d.WT = WSP(bf16, WS_W1) + (size_t)l * DFF * DM; N = DFF; d.ldt = DM; }
    else if ((r -= 2 * IT_W1) < 2 * IT_W2) { const int l = r / IT_W2; r -= l * IT_W2; d.W = F.in(I_W2) + (size_t)l * DFF * DM; d.WT = WSP(bf16, WS_W2) + (size_t)l * DM * DFF; N = DM; d.ldt = DFF; }
    else { r -= 2 * IT_W2; const int g = r / IT_PL; r -= g * IT_PL; d.W = F.in(I_WPOOL) + (size_t)g * 512 * 512; d.WT = WSP(bf16, WS_WPOOL) + (size_t)(g * 512) * DM + g * 512; N = 512; d.ldt = DM; }
    const int nblk = N / 32, kb = r / nblk, nb = r - kb * nblk;
    d.ldw = N; d.k0 = 64 * kb; d.n0 = 32 * nb; return d;
}
__device__ __forceinline__ void convert_run(Ctx& F, int first, int stride, int lim, LAS float* scr) {
    int it = first; if (it >= lim) return;
    float ta[32], tb[32]; CvtItem da = item_decode(F, it), db = da; item_load(ta, da, F.lane);
    for (;;) {
        const int i2 = it + stride; const bool h2 = i2 < lim; if (h2) { db = item_decode(F, i2); item_load(tb, db, F.lane); }
        item_store(ta, da, scr, F.lane); if (!h2) break;
        const int i3 = i2 + stride; const bool h3 = i3 < lim; if (h3) { da = item_decode(F, i3); item_load(ta, da, F.lane); }
        item_store(tb, db, scr, F.lane); if (!h3) break;
        it = i3; }
}
constexpr int NCVT = 40, N_HIDE = 24000;
__device__ __forceinline__ void phase_prologue(Ctx& F) {
    LAS float* scr = (LAS float*)(F.lds + F.wave * 16384);
    const int gw = F.vcu * NWAVES + F.wave, NGW = F.G * NWAVES;
    convert_run(F, gw, NGW, IT_IN, scr);
    if (F.G > NCVT + 8) convert_run(F, IT_IN + N_HIDE + gw, NGW, NIT_ALL, scr); else convert_run(F, IT_IN + gw, NGW, NIT_ALL, scr);
    for (int i = F.vcu * NTHR + F.tid; i < 3072 * 64; i += F.G * NTHR) {
        const int kc = i / 3072, n = i - kc * 3072, reg = n >> 10, nn = n & 1023;
        float v[8];
        if (reg == 0) {
#pragma unroll
            for (int j = 0; j < 8; ++j) { const int k = 8 * kc + j; v[j] = (k < 96) ? F.in(I_WUP)[(size_t)k * 1024 + nn] : 0.f; } }
        else if (reg == 1) {
#pragma unroll
            for (int j = 0; j < 8; ++j) { const int k = 8 * kc + j - 96; v[j] = (k >= 0 && k < 96) ? F.in(I_AUP)[(size_t)k * 1024 + nn] : 0.f; } }
        else {
#pragma unroll
            for (int j = 0; j < 8; ++j) { const int k = 8 * kc + j - 192; v[j] = (k >= 0 && k < 256) ? F.in(I_GUP)[(size_t)k * 1024 + nn] : 0.f; } }
        u32x4 o; o.x = cvt_pk_bf16(v[0], v[1]); o.y = cvt_pk_bf16(v[2], v[3]); o.z = cvt_pk_bf16(v[4], v[5]); o.w = cvt_pk_bf16(v[6], v[7]);
        *(GAS u32x4*)(WSP(bf16, WS_LWT) + (size_t)n * 512 + 8 * kc) = o;
    }
    __syncthreads();
    LAS float* sc = (LAS float*)F.lds;
    LAS float* part = (LAS float*)(F.lds + 81920);
    for (int i = F.tid; i < NMR * DM; i += NTHR) { const int r = i >> 11, k = i & 2047; const float c = r < 2 ? F.in(I_CP)[r * DM + k] : F.in(I_CS)[(r - 2) * DM + k]; sc[i] = c / (1.f + __expf(-c)); }
    __syncthreads();
    float* MOD = WSP(float, WS_MOD);
    float* MODP = WSP(float, WS_G);
    for (int u = F.vcu; u < 512; u += F.G) {
        const bool whole = u < 256; const int task = whole ? u : 256 + ((u - 256) >> 1), kh = whole ? 0 : (u - 256) & 1, klen = whole ? 256 : 128;
        const int l = task / 192, cb = (task - l * 192) * 64;
        const float* W = F.in(I_WADA) + (size_t)l * DM * 12288 + cb + F.lane;
        float acc[NMR];
#pragma unroll
        for (int r = 0; r < NMR; ++r) acc[r] = 0.f;
        const int kbeg = kh * 1024 + F.wave * klen;
        for (int k = kbeg; k < kbeg + klen; k += 16) {
            float wv[16];
#pragma unroll
            for (int j = 0; j < 16; ++j) wv[j] = __builtin_nontemporal_load(W + (size_t)(k + j) * 12288);
#pragma unroll
            for (int j = 0; j < 16; j += 4)
#pragma unroll
                for (int r = 0; r < NMR; ++r) { const f32x4 s = *(const LAS f32x4*)(sc + r * DM + k + j); acc[r] += (s.x * wv[j] + s.y * wv[j + 1]) + (s.z * wv[j + 2] + s.w * wv[j + 3]); }
        }
#pragma unroll
        for (int r = 0; r < NMR; ++r) part[(F.wave * NMR + r) * 64 + F.lane] = acc[r];
        __syncthreads();
        for (int i = F.tid; i < NMR * 64; i += NTHR) { const int r = i >> 6, c = i & 63; float s = 0.f;
#pragma unroll
            for (int w = 0; w < NWAVES; ++w) s += part[(w * NMR + r) * 64 + c];
            if (kh == 0) s += F.in(I_BADA)[l * 12288 + cb + c];
            if (whole) MOD[(size_t)(l * NMR + r) * 12288 + cb + c] = s; else MODP[((size_t)kh * NMR + r) * 8192 + (cb - 4096) + c] = s; }
        __syncthreads();
    }
}

struct Row { f32x4 v[8]; };
__device__ __forceinline__ void row_load(Row& R, const float* p, int lane) {
#pragma unroll
    for (int j = 0; j < 8; ++j) R.v[j] = *(const GAS f32x4*)(p + j * 256 + lane * 4);
}
__device__ __forceinline__ void row_load_bf16(Row& R, const bf16* p, int lane) {
#pragma unroll
    for (int j = 0; j < 8; ++j) { const u32x2 w = *(const GAS u32x2*)(p + j * 256 + lane * 4);
        R.v[j] = (f32x4){__uint_as_float(w.x << 16), __uint_as_float(w.x & 0xffff0000u), __uint_as_float(w.y << 16), __uint_as_float(w.y & 0xffff0000u)}; }
}
__device__ __forceinline__ float row_sumsq(const Row& R) { float s = 0.f;
#pragma unroll
    for (int j = 0; j < 8; ++j) s += (R.v[j].x * R.v[j].x + R.v[j].y * R.v[j].y) + (R.v[j].z * R.v[j].z + R.v[j].w * R.v[j].w);
    return wave_sum(s); }
__device__ __forceinline__ const float* x_in_row(Ctx& F, int r) { return r < NPR ? F.in(I_XP) + (size_t)r * DM : F.in(I_XS) + (size_t)(r - NPR) * DM; }
__device__ __forceinline__ void row_modulate(Row& H, const Row& X, float rstd, const float* g, const float* shift, const float* scale, int lane) {
#pragma unroll
    for (int j = 0; j < 8; ++j) { const int c = j * 256 + lane * 4; const f32x4 gg = *(const GAS f32x4*)(g + c), sh = *(const GAS f32x4*)(shift + c), sc = *(const GAS f32x4*)(scale + c);
        H.v[j] = X.v[j] * rstd * gg * (sc + 1.f) + sh; }
}
__device__ __forceinline__ void row_store_bf16(const Row& H, bf16* p, int lane) {
#pragma unroll
    for (int j = 0; j < 8; ++j) { u32x2 w; w.x = cvt_pk_bf16(H.v[j].x, H.v[j].y); w.y = cvt_pk_bf16(H.v[j].z, H.v[j].w); *(GAS u32x2*)(p + j * 256 + lane * 4) = w; }
}
__device__ __forceinline__ void row_store_f32(const Row& H, float* p, int lane) {
#pragma unroll
    for (int j = 0; j < 8; ++j) *(GAS f32x4*)(p + j * 256 + lane * 4) = H.v[j];
}
__device__ __forceinline__ void row_store_f32_nt(const Row& H, float* p, int lane) {
#pragma unroll
    for (int j = 0; j < 8; ++j) __builtin_nontemporal_store(H.v[j], (GAS f32x4*)(p + j * 256 + lane * 4));
}
struct RowB { u32x2 w[8]; };
__device__ __forceinline__ void rowb_load(RowB& R, const bf16* p, int lane) {
#pragma unroll
    for (int j = 0; j < 8; ++j) R.w[j] = *(const GAS u32x2*)(p + j * 256 + lane * 4);
}
__device__ __forceinline__ void rowb_cvt(Row& R, const RowB& B) {
#pragma unroll
    for (int j = 0; j < 8; ++j) R.v[j] = (f32x4){__uint_as_float(B.w[j].x << 16), __uint_as_float(B.w[j].x & 0xffff0000u), __uint_as_float(B.w[j].y << 16), __uint_as_float(B.w[j].y & 0xffff0000u)};
}
constexpr int PSET_FLOATS = 3 * DM;
static_assert(NSM == 64 && 3 * PSET_FLOATS * 4 + 7 * DM * 4 <= RING_BYTES, "row phases: 8 workgroups x 8 waves take the sample rows; three parameter sets in LDS");
template <int KIND, int L> __device__ __forceinline__ void stage_row_params(Ctx& F) {
    const float* MOD = WSP(float, WS_MOD); const float* ng = F.in(I_NG) + (size_t)L * 4 * DM;
    const int nset = F.vcu < 64 ? 3 : 2;
#define RP_LD4(p) (*(const GAS f32x4*)(p))
    for (int i = F.tid; i < nset * (DM / 4); i += NTHR) {
        const int s = i >> 9, c = (i & 511) * 4, mr = s < 2 ? s : 2 + (F.vcu >> 3);
        const float* m = MOD + (size_t)(L * NMR + mr) * 12288;
        f32x4 v0 = {0.f, 0.f, 0.f, 0.f}, v1 = v0, v2 = v0;
        if (KIND == 0) { v1 = RP_LD4(ng + c) * (RP_LD4(m + DM + c) + 1.f); v2 = RP_LD4(m + c); }
        else if (KIND == 1) { v0 = RP_LD4(m + 2 * DM + c) * RP_LD4(ng + DM + c); v1 = RP_LD4(ng + 2 * DM + c) * (RP_LD4(m + 4 * DM + c) + 1.f); v2 = RP_LD4(m + 3 * DM + c); }
        else { v0 = RP_LD4(m + 5 * DM + c) * RP_LD4(ng + 3 * DM + c);
               if (KIND == 2) { const float* m1 = MOD + (size_t)(1 * NMR + mr) * 12288; v1 = RP_LD4(F.in(I_NG) + (size_t)4 * DM + c) * (RP_LD4(m1 + DM + c) + 1.f); v2 = RP_LD4(m1 + c); } }
        LAS float* d = (LAS float*)F.lds + s * PSET_FLOATS + c;
        *(LAS f32x4*)d = v0; *(LAS f32x4*)(d + DM) = v1; *(LAS f32x4*)(d + 2 * DM) = v2;
    }
#undef RP_LD4
    __syncthreads();
}
__device__ __forceinline__ const LAS float* row_pset(Ctx& F, int r) { return (const LAS float*)F.lds + (r < NPR ? (r >> 12) : 2) * PSET_FLOATS; }
__device__ __forceinline__ void row_residual_l(Row& X, const Row& O, const LAS float* ps, int lane) {
    const float rstd = rsqrtf(row_sumsq(O) * (1.f / DM) + EPS_RMS);
#pragma unroll
    for (int j = 0; j < 8; ++j) { const f32x4 gt = *(const LAS f32x4*)(ps + j * 256 + lane * 4); X.v[j] = X.v[j] + gt * (O.v[j] * rstd); }
}
__device__ __forceinline__ void row_modulate_l(Row& H, const Row& X, const LAS float* ps, int lane) {
    const float rstd = rsqrtf(row_sumsq(X) * (1.f / DM) + EPS_RMS);
#pragma unroll
    for (int j = 0; j < 8; ++j) { const int c = j * 256 + lane * 4; const f32x4 a = *(const LAS f32x4*)(ps + DM + c), sh = *(const LAS f32x4*)(ps + 2 * DM + c); H.v[j] = X.v[j] * rstd * a + sh; }
}
__device__ __forceinline__ void phase_mod0(Ctx& F) {
    stage_row_params<0, 0>(F);
    const int gw = F.vcu * NWAVES + F.wave, NGW = F.G * NWAVES, samp = (F.vcu < 64 && F.wave == 0) ? NPR + F.vcu : NTOK; bf16* Hb = WSP(bf16, WS_H);
    Row Xn; row_load(Xn, x_in_row(F, gw), F.lane);
    for (int r = gw; r < NPR; r += NGW) {
        Row X = Xn, H; const int rn = r + NGW, rp = rn < NPR ? rn : (samp < NTOK ? samp : r);
        row_load(Xn, x_in_row(F, rp), F.lane);
        row_modulate_l(H, X, row_pset(F, r), F.lane);
        row_store_bf16(H, Hb + (size_t)r * DM, F.lane);
    }
    if (samp < NTOK) { Row H; row_modulate_l(H, Xn, row_pset(F, samp), F.lane); row_store_bf16(H, Hb + (size_t)samp * DM, F.lane); }
}
__device__ __forceinline__ void row_residual(Row& X, const Row& O, const float* ga, const float* gate, int lane) {
    const float rstd = rsqrtf(row_sumsq(O) * (1.f / DM) + EPS_RMS);
#pragma unroll
    for (int j = 0; j < 8; ++j) { const int c = j * 256 + lane * 4; const f32x4 gg = *(const GAS f32x4*)(ga + c), gt = *(const GAS f32x4*)(gate + c); X.v[j] = X.v[j] + gt * (O.v[j] * rstd * gg); }
}
template <int NK> __device__ __forceinline__ void row_load_out(Ctx& F, Row& O, int r, int lane) {
    if (r < NPR) { const bf16* op = WSP(bf16, WS_OUT) + (size_t)r * DM;
#pragma unroll
        for (int j = 0; j < 8; ++j) { const u32x2 w = *(const GAS u32x2*)(op + j * 256 + lane * 4);
            O.v[j] = (f32x4){__uint_as_float(w.x << 16), __uint_as_float(w.x & 0xffff0000u), __uint_as_float(w.y << 16), __uint_as_float(w.y & 0xffff0000u)}; }
        return; }
    const float* pp = WSP(float, WS_PART) + (size_t)(r - NPR) * DM;
    row_load(O, pp, lane);
    for (int kc = 1; kc < NK; ++kc) { Row T; row_load(T, pp + (size_t)kc * 64 * DM, lane);
#pragma unroll
        for (int j = 0; j < 8; ++j) O.v[j] += T.v[j]; }
}
__device__ __forceinline__ f32x4 ld_bf4(const bf16* p) { const u32x2 w = *(const GAS u32x2*)p; return (f32x4){__uint_as_float(w.x << 16), __uint_as_float(w.x & 0xffff0000u), __uint_as_float(w.y << 16), __uint_as_float(w.y & 0xffff0000u)}; }
__device__ __forceinline__ void row_load_pool(Ctx& F, Row& O, int r, int lane) {
    if (r < NPR && (r & (SEQ - 1)) >= PBUF) { const bf16* op = WSP(bf16, WS_OUT) + (size_t)r * DM + lane * 4;
#pragma unroll
        for (int j8 = 0; j8 < 8; ++j8) { const int wlen = 2 << (j8 >> 1);
            const f32x4 cur = ld_bf4(op + j8 * 256); f32x4 sum = cur;
#pragma unroll
            for (int j = 1; j < wlen; ++j) sum += ld_bf4(op + j8 * 256 - (size_t)j * DM);
            O.v[j8] = sum * (1.f / (float)wlen) - cur; }
    } else if (r < NPR) { const int t = r & (SEQ - 1); const bf16* op = WSP(bf16, WS_OUT) + (size_t)r * DM + lane * 4;
#pragma unroll
        for (int j8 = 0; j8 < 8; ++j8) { const int wlen = 2 << (j8 >> 1), n = (t + 1) < wlen ? (t + 1) : wlen;
            const f32x4 cur = ld_bf4(op + j8 * 256); f32x4 sum = cur;
            for (int j = 1; j < n; ++j) sum += ld_bf4(op + j8 * 256 - (size_t)j * DM);
            O.v[j8] = sum * (1.f / (float)n) - cur; }
    } else { const int rs = r - NPR, b = rs >> 3, t = rs & 7; const float* pp = WSP(float, WS_PART) + lane * 4;
#pragma unroll
        for (int j8 = 0; j8 < 8; ++j8) { const int wlen = 2 << (j8 >> 1); f32x4 cur = {0.f, 0.f, 0.f, 0.f}, sum = {0.f, 0.f, 0.f, 0.f};
#pragma unroll
            for (int j = 0; j < wlen; ++j) { const int tj = t - j, pr = tj >= 0 ? rs - j : 64 + b * PBUF + PBUF + tj;
                const f32x4 g = *(const GAS f32x4*)(pp + (size_t)pr * DM + j8 * 256) + *(const GAS f32x4*)(pp + (size_t)(256 + pr) * DM + j8 * 256);
                sum += g; if (j == 0) cur = g; }
            O.v[j8] = sum * (1.f / (float)wlen) - cur; }
    }
}
template <int NK> __device__ __forceinline__ void sample_row_gather(Ctx& F, Row& O, int s) {
    constexpr int PER = NK / 8; const float* pp = WSP(float, WS_PART) + ((size_t)(F.wave * PER) * 64 + s) * DM; Row T[PER];
#pragma unroll
    for (int k = 0; k < PER; ++k) row_load(T[k], pp + (size_t)k * 64 * DM, F.lane);
    O = T[0];
#pragma unroll
    for (int k = 1; k < PER; ++k)
#pragma unroll
        for (int j = 0; j < 8; ++j) O.v[j] += T[k].v[j];
    LAS float* sl = (LAS float*)F.lds + 3 * PSET_FLOATS;
    if (F.wave > 0) {
#pragma unroll
        for (int j = 0; j < 8; ++j) *(LAS f32x4*)(sl + (F.wave - 1) * DM + j * 256 + F.lane * 4) = O.v[j]; }
    __syncthreads();
    if (F.wave == 0) {
#pragma unroll
        for (int w = 0; w < 7; ++w)
#pragma unroll
            for (int j = 0; j < 8; ++j) O.v[j] += *(const LAS f32x4*)(sl + w * DM + j * 256 + F.lane * 4); }
}
template <int L> __device__ __forceinline__ void phase_postmix(Ctx& F) {
    stage_row_params<1, L>(F);
    const int gw = F.vcu * NWAVES + F.wave, NGW = F.G * NWAVES, samp = (F.vcu < 64 && F.wave == 0) ? NPR + F.vcu : NTOK;
    bf16* Hb = WSP(bf16, WS_H); bf16* XR = WSP(bf16, WS_XR); const bf16* OUTb = WSP(bf16, WS_OUT);
    Row Xf; RowB Xb, Ob;
    if (L == 0) { row_load(Xf, x_in_row(F, gw), F.lane); rowb_load(Ob, OUTb + (size_t)gw * DM, F.lane); } else rowb_load(Xb, XR + (size_t)gw * DM, F.lane);
    for (int r = gw; r < NPR; r += NGW) {
        Row X, O, H; const int rn = r + NGW, rp = rn < NPR ? rn : (samp < NTOK ? samp : r), ro = rn < NPR ? rn : r;
        if (L == 0) { X = Xf; rowb_cvt(O, Ob); row_load(Xf, x_in_row(F, rp), F.lane); rowb_load(Ob, OUTb + (size_t)ro * DM, F.lane); }
        else { rowb_cvt(X, Xb); rowb_load(Xb, XR + (size_t)rp * DM, F.lane); row_load_pool(F, O, r, F.lane); }
        const LAS float* ps = row_pset(F, r);
        row_residual_l(X, O, ps, F.lane);
        row_store_bf16(X, XR + (size_t)r * DM, F.lane);
        row_modulate_l(H, X, ps, F.lane);
        row_store_bf16(H, Hb + (size_t)r * DM, F.lane);
    }
    Row Og; if (L == 0 && F.vcu < 64) sample_row_gather<8>(F, Og, F.vcu);
    if (samp < NTOK) { Row X, O, H; if (L == 0) { X = Xf; O = Og; } else { rowb_cvt(X, Xb); row_load_pool(F, O, samp, F.lane); }
        const LAS float* ps = row_pset(F, samp);
        row_residual_l(X, O, ps, F.lane);
        row_store_bf16(X, XR + (size_t)samp * DM, F.lane);
        row_modulate_l(H, X, ps, F.lane);
        row_store_bf16(H, Hb + (size_t)samp * DM, F.lane); }
}
template <int L> __device__ __forceinline__ void phase_postmlp(Ctx& F) {
    stage_row_params<L == 0 ? 2 : 3, L>(F);
    const int gw = F.vcu * NWAVES + F.wave, NGW = F.G * NWAVES, samp = (F.vcu < 64 && F.wave == 0) ? NPR + F.vcu : NTOK;
    bf16* XR = WSP(bf16, WS_XR); const bf16* OUTb = WSP(bf16, WS_OUT);
    RowB Xb, Ob; rowb_load(Xb, XR + (size_t)gw * DM, F.lane); rowb_load(Ob, OUTb + (size_t)gw * DM, F.lane);
    for (int r = gw; r < NPR; r += NGW) {
        Row X, O; const int rn = r + NGW, rp = rn < NPR ? rn : (samp < NTOK ? samp : r), ro = rn < NPR ? rn : r;
        rowb_cvt(X, Xb); rowb_cvt(O, Ob); rowb_load(Xb, XR + (size_t)rp * DM, F.lane); rowb_load(Ob, OUTb + (size_t)ro * DM, F.lane);
        const LAS float* ps = row_pset(F, r);
        row_residual_l(X, O, ps, F.lane);
        if (L == 0) {
            row_store_bf16(X, XR + (size_t)r * DM, F.lane);
            Row H; row_modulate_l(H, X, ps, F.lane);
            row_store_bf16(H, WSP(bf16, WS_H) + (size_t)r * DM, F.lane);
            const int t = r & (SEQ - 1); if (t >= SEQ - PBUF) row_store_f32(H, F.outp() + O_PLP + ((size_t)(r >> 12) * PBUF + (t - (SEQ - PBUF))) * DM, F.lane);
        } else row_store_f32_nt(X, F.outp() + O_YP + (size_t)r * DM, F.lane);
    }
    Row Og; if (F.vcu < 64) sample_row_gather<32>(F, Og, F.vcu);
    if (samp < NTOK) { Row X, O = Og; rowb_cvt(X, Xb);
        const LAS float* ps = row_pset(F, samp); const int rs = samp - NPR;
        row_residual_l(X, O, ps, F.lane);
        if (L == 0) {
            row_store_bf16(X, XR + (size_t)samp * DM, F.lane);
            Row H; row_modulate_l(H, X, ps, F.lane);
            row_store_bf16(H, WSP(bf16, WS_H) + (size_t)samp * DM, F.lane);
            row_store_f32(H, F.outp() + O_PLS + ((size_t)(rs >> 3) * PBUF + 7 + (rs & 7)) * DM, F.lane);
        } else row_store_f32_nt(X, F.outp() + O_YS + (size_t)rs * DM, F.lane); }
    if (L == 0) {
        const float* SP = F.in(I_SPOOL); bf16* Hb = WSP(bf16, WS_H);
        for (int i = F.vcu * NTHR + F.tid; i < DBAT * PBUF * 512; i += F.G * NTHR) { const int c4 = (i & 511) * 4, bi = i >> 9, b = bi / PBUF, k = bi - b * PBUF;
            const f32x4 v = *(const GAS f32x4*)(SP + (size_t)bi * DM + c4); u32x2 w; w.x = cvt_pk_bf16(v.x, v.y); w.y = cvt_pk_bf16(v.z, v.w);
            *(GAS u32x2*)(Hb + (size_t)(NTOK + bi) * DM + c4) = w;
            if (k >= 8) *(GAS f32x4*)(F.outp() + O_PLS + ((size_t)b * PBUF + (k - 8)) * DM + c4) = v; }
    }
}

__device__ __forceinline__ void phase_kv_prep(Ctx& F) {
    { const float* MODP = WSP(float, WS_G); float* MOD = WSP(float, WS_MOD);
      for (int i = F.vcu * NTHR + F.tid; i < NMR * 8192; i += F.G * NTHR) { const int r = i >> 13, c = i & 8191; MOD[(size_t)(1 * NMR + r) * 12288 + 4096 + c] = MODP[(size_t)r * 8192 + c] + MODP[((size_t)NMR + r) * 8192 + c]; } }
    const float* P = WSP(float, WS_P);
    for (int i = F.vcu * NTHR + F.tid; i < (NBATCH + DBAT) * BCOLS; i += F.G * NTHR) {
        const int b = i / BCOLS, c = i - b * BCOLS; const int r = b < NBATCH ? b * SEQ + SEQ - 1 : NPR + (b - NBATCH) * DSEQ + DSEQ - 1;
        F.outp()[(b < NBATCH ? O_SHP + (size_t)b * BCOLS : O_SHS + (size_t)(b - NBATCH) * BCOLS) + c] = (b < NBATCH && c < 3072) ? ldbf(WSP(bf16, WS_PBH) + (size_t)r * 3072 + c) : P[(size_t)r * PBLD + c];
    }
    { const int gw = F.vcu * NWAVES + F.wave, NGW = F.G * NWAVES; const float* mu = F.in(I_MU); bf16* LA = WSP(bf16, WS_LA);
      for (int r = gw; r < NTOK; r += NGW) {
        const float* pb = P + (size_t)r * PBLD; const float* prev; bool hp;
        if (r < NPR) { const int t = r & (SEQ - 1); hp = t > 0; prev = pb - PBLD; }
        else { const int rs = r - NPR, b = rs >> 3, t = rs & 7; hp = true; prev = t > 0 ? pb - PBLD : F.in(I_SSH) + (size_t)b * BCOLS; }
        float v[8];
        { const int c0 = 3072 + F.lane * 8; const bool act = F.lane < 56; const f32x4 z4 = {0.f, 0.f, 0.f, 0.f};
          f32x4 pa = z4, pc = z4, qa = z4, qc = z4, ma = z4, mc = z4;
          if (act) { pa = *(const GAS f32x4*)(pb + c0); pc = *(const GAS f32x4*)(pb + c0 + 4); ma = *(const GAS f32x4*)(mu + c0); mc = *(const GAS f32x4*)(mu + c0 + 4);
                     if (hp) { qa = *(const GAS f32x4*)(prev + c0); qc = *(const GAS f32x4*)(prev + c0 + 4); } }
          const f32x4 za = pa + ma * (qa - pa), zc = pc + mc * (qc - pc);
          const float kz = F.lane < 12 ? 2.f : 1.f;
#pragma unroll
          for (int j = 0; j < 8; ++j) { const float z = j < 4 ? za[j & 3] : zc[j & 3]; const float sg = 1.f / (1.f + __expf(-kz * z));
              v[j] = !act ? 0.f : (F.lane < 12 ? 2.f * sg - 1.f : (F.lane < 24 ? z : sg)); } }
        u32x4 o; o.x = cvt_pk_bf16(v[0], v[1]); o.y = cvt_pk_bf16(v[2], v[3]); o.z = cvt_pk_bf16(v[4], v[5]); o.w = cvt_pk_bf16(v[6], v[7]);
        *(GAS u32x4*)(LA + (size_t)r * 512 + F.lane * 8) = o;
      } }
}
__device__ __forceinline__ void phase_rwkv_prep(Ctx& F) {
    const float* P = WSP(float, WS_P); const float* LWO = WSP(float, WS_LWO);
    const int gw = F.vcu * NWAVES + F.wave, NGW = F.G * NWAVES;
    float* RWV = WSP(float, WS_RWV); float* SCL = WSP(float, WS_SCL);
    const float* mu = F.in(I_MU);
    for (int u = gw; u < NSM * 4; u += NGW) {
        const int r = NPR + (u >> 2), hq = u & 3;
        const float* pb = P + (size_t)r * PBLD; const float* prev; const bool hp = true;
        { const int rs = r - NPR, b = rs >> 3, t = rs & 7; prev = t > 0 ? pb - PBLD : F.in(I_SSH) + (size_t)b * BCOLS; }
        const float* lw = LWO + (size_t)r * 3072;
        float pr[4], pk[4], pv[4], qr_[4], qk[4], qv[4], lwl[4], lal[4], lgl[4];
#pragma unroll
        for (int i = 0; i < 4; ++i) { const int col = (hq * 4 + i) * 64 + F.lane;
            pr[i] = pb[col]; pk[i] = pb[1024 + col]; pv[i] = pb[2048 + col];
            qr_[i] = hp ? prev[col] : 0.f; qk[i] = hp ? prev[1024 + col] : 0.f; qv[i] = hp ? prev[2048 + col] : 0.f;
            lwl[i] = lw[col]; lal[i] = lw[1024 + col]; lgl[i] = lw[2048 + col]; }
#pragma unroll
        for (int i = 0; i < 4; ++i) { const int h = hq * 4 + i, col = h * 64 + F.lane;
            const float zr = pr[i] + mu[col] * (qr_[i] - pr[i]), zk = pk[i] + mu[1024 + col] * (qk[i] - pk[i]), zv = pv[i] + mu[2048 + col] * (qv[i] - pv[i]);
            const float wl = F.in(I_W0)[col] + lwl[i], al = F.in(I_A0)[col] + lal[i], gl = lgl[i];
            const float wlog = -softplusf_(-wl) - 0.5f, decay = __expf(-__expf(wlog));
            const float a = sigmoidf_(al);
            const float kkr = zk * F.in(I_KK)[col], kk = kkr * rsqrtf(wave_sum(kkr * kkr) + 1e-12f);
            const float k = zk * (1.f + (a - 1.f) * F.in(I_KA)[col]);
            const float bb = kk * a;
            const float bonus = wave_sum(zr * k * F.in(I_RK)[col]), beta = wave_sum(bb * zr), kappa = wave_sum(k * zr);
            float* base = RWV + ((size_t)r * HB + h) * 512;
            base[F.lane] = decay; base[64 + F.lane] = kk; base[128 + F.lane] = bb; base[192 + F.lane] = k; base[256 + F.lane] = zr; base[320 + F.lane] = zv; base[384 + F.lane] = decay * zr;
            if (F.lane == 0) { float* s_ = SCL + ((size_t)r * HB + h) * 4; s_[0] = beta; s_[1] = kappa; s_[2] = bonus; s_[3] = 0.f; }
        }
    }
}

namespace sba {
typedef short bf16x8 __attribute__((ext_vector_type(8)));
typedef short s16x4 __attribute__((ext_vector_type(4)));
typedef float f32x16 __attribute__((ext_vector_type(16)));
constexpr int SHM = 16384, LDQ = 1024;
#define SB_KSWZ(row, colB) ((row) * 256 + ((colB) ^ (((row) & 7) << 4)))
#define SB_SBAR() __builtin_amdgcn_sched_barrier(0)
__device__ __forceinline__ int v_st(int k, int c) { const int kk = (k & ~0xC) | ((k & 4) << 1) | ((k & 8) >> 1); return ((kk >> 3) * 4 + (c >> 5)) * 512 + ((kk & 7) * 32 + (c & 31)) * 2; }
__device__ __forceinline__ int v_rd_base(int lane) { return ((lane & 3) << 3) | (((lane >> 2) & 3) << 6) | (((lane >> 4) & 1) << 5) | (((lane >> 5) & 1) << 8); }
__device__ __forceinline__ int crow(int r, int hi) { return (r & 3) + 8 * (r >> 2) + 4 * hi; }
__device__ __forceinline__ void qkt(f32x16& p0, f32x16& p1, const char* Kt, int r32, int hi, const bf16x8* qr) {
    p0 = f32x16{}; p1 = f32x16{};
    const char* kb[4];
#pragma unroll
    for (int dd = 0; dd < 4; ++dd) kb[dd] = Kt + SB_KSWZ(r32, (dd * 16 + hi * 8) * 2);
#pragma unroll
    for (int d0 = 0; d0 < 8; ++d0) { const char* a = kb[d0 & 3] + (d0 >> 2) * 128;
        const bf16x8 b0 = *reinterpret_cast<const bf16x8*>(a);
        const bf16x8 b1 = *reinterpret_cast<const bf16x8*>(a + 32 * 256);
        p0 = __builtin_amdgcn_mfma_f32_32x32x16_bf16(b0, qr[d0], p0, 0, 0, 0);
        p1 = __builtin_amdgcn_mfma_f32_32x32x16_bf16(b1, qr[d0], p1, 0, 0, 0); }
}
__device__ __forceinline__ void pv_tile(f32x16* o, int vb0, bf16x8 pa0, bf16x8 pa1, bf16x8 pa2, bf16x8 pa3) {
#define SB_TRRD(dst, off) asm volatile("ds_read_b64_tr_b16 %0, %1 offset:%2" : "=&v"(dst) : "v"(vb0), "i"(off) : "memory")
#define SB_PV_D0(d0) do { s16x4 l0, l1, l2, l3, h0, h1, h2, h3; constexpr int b_ = (d0) * 512; \
        SB_TRRD(l0, b_); SB_TRRD(h0, b_ + 2048); SB_TRRD(l1, b_ + 4096); SB_TRRD(h1, b_ + 6144); SB_TRRD(l2, b_ + 8192); SB_TRRD(h2, b_ + 10240); SB_TRRD(l3, b_ + 12288); SB_TRRD(h3, b_ + 14336); \
        asm volatile("s_waitcnt lgkmcnt(0)" ::: "memory"); SB_SBAR(); \
        o[d0] = __builtin_amdgcn_mfma_f32_32x32x16_bf16(pa0, (bf16x8){l0[0], l0[1], l0[2], l0[3], h0[0], h0[1], h0[2], h0[3]}, o[d0], 0, 0, 0); \
        o[d0] = __builtin_amdgcn_mfma_f32_32x32x16_bf16(pa1, (bf16x8){l1[0], l1[1], l1[2], l1[3], h1[0], h1[1], h1[2], h1[3]}, o[d0], 0, 0, 0); \
        o[d0] = __builtin_amdgcn_mfma_f32_32x32x16_bf16(pa2, (bf16x8){l2[0], l2[1], l2[2], l2[3], h2[0], h2[1], h2[2], h2[3]}, o[d0], 0, 0, 0); \
        o[d0] = __builtin_amdgcn_mfma_f32_32x32x16_bf16(pa3, (bf16x8){l3[0], l3[1], l3[2], l3[3], h3[0], h3[1], h3[2], h3[3]}, o[d0], 0, 0, 0); } while (0)
    SB_PV_D0(0); SB_PV_D0(1); SB_PV_D0(2); SB_PV_D0(3);
#undef SB_PV_D0
#undef SB_TRRD
}
__device__ __forceinline__ float swap_other(float x, int hi) {
    auto rr = __builtin_amdgcn_permlane32_swap(__float_as_uint(x), __float_as_uint(x), false, false);
    return __uint_as_float(hi ? rr[0] : rr[1]);
}
template <bool MASK> __device__ __forceinline__ void sb_weights(f32x16& p0, f32x16& p1, float& carry, float C2, float b2, int dq, int hi) {
    float T[8];
#pragma unroll
    for (int g = 0; g < 8; ++g) {
        float iv[4], be[4];
#pragma unroll
        for (int k = 0; k < 4; ++k) { const int r = (g & 3) * 4 + k; const float s = g < 4 ? p0[r] : p1[r];
            const float z2 = fminf(fmaf(s, C2, b2), 64.f), e = __builtin_amdgcn_exp2f(z2), i_ = __builtin_amdgcn_rcpf(1.f + e); float b_ = e * i_, ii = i_;
            if (MASK) { const int c = (r & 3) + 8 * (r >> 2) + (g < 4 ? 0 : 32); const bool vis = c < dq; ii = vis ? ii : 1.f; b_ = vis ? b_ : 0.f; }
            iv[k] = ii; be[k] = b_; }
        const float ex2 = iv[3], ex1 = iv[2] * iv[3], ex0 = iv[1] * ex1; T[g] = iv[0] * ex0;
        const float w0 = be[0] * ex0, w1 = be[1] * ex1, w2 = be[2] * ex2, w3 = be[3];
        if (g < 4) { p0[(g & 3) * 4 + 0] = w0; p0[(g & 3) * 4 + 1] = w1; p0[(g & 3) * 4 + 2] = w2; p0[(g & 3) * 4 + 3] = w3; }
        else { p1[(g & 3) * 4 + 0] = w0; p1[(g & 3) * 4 + 1] = w1; p1[(g & 3) * 4 + 2] = w2; p1[(g & 3) * 4 + 3] = w3; }
    }
    float suf = carry;
#pragma unroll
    for (int g = 7; g >= 0; --g) {
        const float To = swap_other(T[g], hi);
        const float E = hi ? suf : suf * To;
#pragma unroll
        for (int k = 0; k < 4; ++k) { if (g < 4) p0[(g & 3) * 4 + k] *= E; else p1[(g & 3) * 4 + k] *= E; }
        suf = suf * (T[g] * To);
    }
    carry = suf;
}
__device__ __forceinline__ void pack_p(const f32x16& p0, const f32x16& p1, bf16x8& pa0, bf16x8& pa1, bf16x8& pa2, bf16x8& pa3) {
#define SB_PK4(P, B_, OUT) do { unsigned a0 = cvt_pk_bf16(P[B_ + 0], P[B_ + 1]), a1 = cvt_pk_bf16(P[B_ + 2], P[B_ + 3]); \
        unsigned b0 = cvt_pk_bf16(P[B_ + 4], P[B_ + 5]), b1 = cvt_pk_bf16(P[B_ + 6], P[B_ + 7]); \
        auto r0 = __builtin_amdgcn_permlane32_swap(a0, b0, false, false); auto r1 = __builtin_amdgcn_permlane32_swap(a1, b1, false, false); \
        u32x4 w = {r0[0], r1[0], r0[1], r1[1]}; OUT = *reinterpret_cast<bf16x8*>(&w); } while (0)
    SB_PK4(p0, 0, pa0); SB_PK4(p0, 8, pa1); SB_PK4(p1, 0, pa2); SB_PK4(p1, 8, pa3);
#undef SB_PK4
}
__device__ __forceinline__ void attn_half(Ctx& F, int bh, int x, int half) {
    const int tid = F.tid, wid = F.wave, lane = F.lane, r32 = lane & 31, hi = lane >> 5, b = bh >> 3, h = bh & 7;
    const bf16* Qg = WSP(bf16, WS_QB) + (size_t)(b * SEQ + 256 * x) * LDQ + h * 128;
    const bf16* Kg = WSP(bf16, WS_KB) + (size_t)(b * SEQ) * LDQ + h * 128; const bf16* Vg = WSP(bf16, WS_VB) + (size_t)(b * SEQ) * LDQ + h * 128;
    const int NT = 4 * (x + 1), t_hi = half == 0 ? NT : NT / 2, t_lo = half == 0 ? NT / 2 : 0;
    const int qlo = 256 * x + 32 * wid, qpos = qlo + r32;
    char* V_lds = (char*)F.lds; char* K_lds = (char*)F.lds + 2 * SHM;
    bf16x8 qr[8];
#pragma unroll
    for (int d0 = 0; d0 < 8; ++d0) qr[d0] = *reinterpret_cast<const bf16x8*>(Qg + (size_t)(wid * 32 + r32) * LDQ + d0 * 16 + hi * 8);
    const int sr = tid >> 4, sc = (tid & 15) * 8, vst0 = v_st(sr, sc), vst1 = v_st(32 + sr, sc), kws = SB_KSWZ(sr, sc * 2);
    const int vb0 = (int)(uintptr_t)V_lds + v_rd_base(lane);
    bf16x8 st_k0, st_k1, st_v0, st_v1;
    const unsigned so0 = (unsigned)(sr * LDQ + sc) * 2u, so1 = so0 + 32u * LDQ * 2u;
#define SB_SLOAD(t) do { const char* kt_ = (const char*)Kg + (size_t)(t) * (64 * LDQ * 2); const char* vt_ = (const char*)Vg + (size_t)(t) * (64 * LDQ * 2); \
        st_k0 = *reinterpret_cast<const bf16x8*>(kt_ + so0); st_k1 = *reinterpret_cast<const bf16x8*>(kt_ + so1); st_v0 = *reinterpret_cast<const bf16x8*>(vt_ + so0); st_v1 = *reinterpret_cast<const bf16x8*>(vt_ + so1); } while (0)
#define SB_SWRITE(bf) do { *(bf16x8*)(K_lds + (bf) * SHM + kws) = st_k0; *(bf16x8*)(K_lds + (bf) * SHM + kws + 32 * 256) = st_k1; \
        *(bf16x8*)(V_lds + (bf) * SHM + vst0) = st_v0; *(bf16x8*)(V_lds + (bf) * SHM + vst1) = st_v1; } while (0)
    __syncthreads();
    SB_SLOAD(t_hi - 1); VM_WAIT(); SB_SWRITE(0);
    __syncthreads();
    const float C2 = QK_SCALE * 1.4426950408889634f, b2 = F.in(I_SBB)[h] * 1.4426950408889634f;
    float carry = 1.f; f32x16 o[4] = {};
    int buf = 0;
    for (int t = t_hi - 1; t >= t_lo; --t) {
        if (t > t_lo) SB_SLOAD(t - 1);
        const int kb = 64 * t;
        if (kb < qlo + 31) {
            f32x16 p0, p1; bf16x8 pa0, pa1, pa2, pa3;
            qkt(p0, p1, K_lds + buf * SHM, r32, hi, qr);
            if (kb + 63 >= qlo) sb_weights<true>(p0, p1, carry, C2, b2, qpos - kb - 4 * hi, hi); else sb_weights<false>(p0, p1, carry, C2, b2, 0, hi);
            pack_p(p0, p1, pa0, pa1, pa2, pa3);
            pv_tile(o, vb0 + buf * SHM, pa0, pa1, pa2, pa3);
        }
        if (t > t_lo) { VM_WAIT(); SB_SWRITE(buf ^ 1); }
        __syncthreads();
        buf ^= 1;
    }
#undef SB_SLOAD
#undef SB_SWRITE
    float* Op = WSP(float, WS_OP) + ((size_t)half * NPR + b * SEQ + 256 * x + wid * 32) * 1024 + h * 128;
    const unsigned lo_ = (unsigned)(4 * hi * 1024 + r32);
#pragma unroll
    for (int r = 0; r < 16; ++r) { float* Opr = Op + (size_t)((r & 3) + 8 * (r >> 2)) * 1024;
#pragma unroll
        for (int d0 = 0; d0 < 4; ++d0) Opr[lo_ + d0 * 32] = o[d0][r]; }
    if (half == 0 && hi == 0) WSP(float, WS_CL)[(size_t)(b * SEQ + qpos) * HA + h] = carry;
}
#undef SB_KSWZ
#undef SB_SBAR
}
namespace sba {
__device__ __forceinline__ void sb_weights32(f32x16& p0, float& carry, float C2, float b2, int hi) {
    float T[4];
#pragma unroll
    for (int g = 0; g < 4; ++g) {
        float iv[4], be[4];
#pragma unroll
        for (int k = 0; k < 4; ++k) { const float z2 = fminf(fmaf(p0[g * 4 + k], C2, b2), 64.f), e = __builtin_amdgcn_exp2f(z2), i_ = __builtin_amdgcn_rcpf(1.f + e); iv[k] = i_; be[k] = e * i_; }
        const float ex2 = iv[3], ex1 = iv[2] * iv[3], ex0 = iv[1] * ex1; T[g] = iv[0] * ex0;
        p0[g * 4 + 0] = be[0] * ex0; p0[g * 4 + 1] = be[1] * ex1; p0[g * 4 + 2] = be[2] * ex2; p0[g * 4 + 3] = be[3];
    }
    float suf = carry;
#pragma unroll
    for (int g = 3; g >= 0; --g) { const float To = swap_other(T[g], hi); const float E = hi ? suf : suf * To;
#pragma unroll
        for (int k = 0; k < 4; ++k) p0[g * 4 + k] *= E;
        suf = suf * (T[g] * To); }
    carry = suf;
}
__device__ __forceinline__ void attn_sample_unit(Ctx& F, int bh, int pg, char* wl  ) {
    const int lane = F.lane, r32 = lane & 31, hi = lane >> 5, b = bh >> 3, h = bh & 7;
    char* K_lds = wl; char* V_lds = wl + 8192;
    bf16x8 qr[8];
    { const bf16* Qg = WSP(bf16, WS_QB) + (size_t)(NPR + b * DSEQ + (r32 & 7)) * LDQ + h * 128;
#pragma unroll
      for (int d0 = 0; d0 < 8; ++d0) { bf16x8 v = *reinterpret_cast<const bf16x8*>(Qg + d0 * 16 + hi * 8); if (r32 >= 8) v = bf16x8{}; qr[d0] = v; } }
    const int kl = lane >> 5, c4 = (lane & 31) * 4;
    const unsigned goff = (unsigned)(kl * 1024 + c4) * 4u;
    const int vb0 = (int)(uintptr_t)V_lds + v_rd_base(lane);
    const float C2 = QK_SCALE * 1.4426950408889634f, b2 = F.in(I_SBB)[h] * 1.4426950408889634f;
    const int* pt = ((const int*)F.in(I_PT)) + b * NPAGES + pg * 4;
    f32x4 sa[8], sb[8];
#define SU_BASE(n) ({ const int i_ = (n) >> 2, k_ = (n) & 3, tt_ = 15 - i_; const int phys_ = pt[tt_ >> 2]; \
        (const char*)((k_ & 2) ? F.in(I_CV) : F.in(I_CK)) + (((size_t)phys_ * PAGESZ + (tt_ & 3) * 32 + (k_ & 1) * 16) * 1024 + h * 128) * 4; })
#define SU_LOAD(S, n) do { const char* bp_ = SU_BASE(n); _Pragma("unroll") for (int j = 0; j < 8; ++j) S[j] = __builtin_nontemporal_load((const GAS f32x4*)(bp_ + goff + (size_t)j * 8192)); } while (0)
#define SU_WRK(S, kh) do { _Pragma("unroll") for (int j = 0; j < 8; ++j) { const int key = (kh) * 16 + 2 * j + kl; u32x2 w; w.x = cvt_pk_bf16(S[j].x, S[j].y); w.y = cvt_pk_bf16(S[j].z, S[j].w); \
        *(u32x2*)(K_lds + (key * 256 + ((c4 * 2) ^ ((key & 7) << 4)))) = w; } } while (0)
#define SU_WRV(S, kh) do { _Pragma("unroll") for (int j = 0; j < 8; ++j) { const int key = (kh) * 16 + 2 * j + kl; u32x2 w; w.x = cvt_pk_bf16(S[j].x, S[j].y); w.y = cvt_pk_bf16(S[j].z, S[j].w); \
        *(u32x2*)(V_lds + v_st(key, c4)) = w; } } while (0)
    SU_LOAD(sa, 0); SU_LOAD(sb, 1);
    float carry = 1.f; f32x16 o[4] = {};
    for (int i = 0; i < 16; ++i) {
        asm volatile("s_waitcnt vmcnt(8)" ::: "memory"); SU_WRK(sa, 0); SU_LOAD(sa, 4 * i + 2);
        asm volatile("s_waitcnt vmcnt(8)" ::: "memory"); SU_WRK(sb, 1); SU_LOAD(sb, 4 * i + 3);
        asm volatile("s_waitcnt vmcnt(8)" ::: "memory"); SU_WRV(sa, 0); if (i < 15) SU_LOAD(sa, 4 * i + 4);
        if (i < 15) asm volatile("s_waitcnt vmcnt(8)" ::: "memory"); else asm volatile("s_waitcnt vmcnt(0)" ::: "memory");
        SU_WRV(sb, 1); if (i < 15) SU_LOAD(sb, 4 * i + 5);
        asm volatile("s_waitcnt lgkmcnt(0)" ::: "memory");
        f32x16 p0 = f32x16{};
        { const char* kb[4];
#pragma unroll
          for (int dd = 0; dd < 4; ++dd) kb[dd] = K_lds + (r32 * 256 + (((dd * 16 + hi * 8) * 2) ^ ((r32 & 7) << 4)));
#pragma unroll
          for (int d0 = 0; d0 < 8; ++d0) { const bf16x8 b0 = *reinterpret_cast<const bf16x8*>(kb[d0 & 3] + (d0 >> 2) * 128); p0 = __builtin_amdgcn_mfma_f32_32x32x16_bf16(b0, qr[d0], p0, 0, 0, 0); } }
        sb_weights32(p0, carry, C2, b2, hi);
        bf16x8 pa0, pa1;
        { unsigned a0 = cvt_pk_bf16(p0[0], p0[1]), a1 = cvt_pk_bf16(p0[2], p0[3]), b0 = cvt_pk_bf16(p0[4], p0[5]), b1 = cvt_pk_bf16(p0[6], p0[7]);
          auto r0 = __builtin_amdgcn_permlane32_swap(a0, b0, false, false); auto r1 = __builtin_amdgcn_permlane32_swap(a1, b1, false, false);
          u32x4 w = {r0[0], r1[0], r0[1], r1[1]}; pa0 = *reinterpret_cast<bf16x8*>(&w); }
        { unsigned a0 = cvt_pk_bf16(p0[8], p0[9]), a1 = cvt_pk_bf16(p0[10], p0[11]), b0 = cvt_pk_bf16(p0[12], p0[13]), b1 = cvt_pk_bf16(p0[14], p0[15]);
          auto r0 = __builtin_amdgcn_permlane32_swap(a0, b0, false, false); auto r1 = __builtin_amdgcn_permlane32_swap(a1, b1, false, false);
          u32x4 w = {r0[0], r1[0], r0[1], r1[1]}; pa1 = *reinterpret_cast<bf16x8*>(&w); }
#define SU_TRRD(dst, off) asm volatile("ds_read_b64_tr_b16 %0, %1 offset:%2" : "=&v"(dst) : "v"(vb0), "i"(off) : "memory")
#define SU_PV(d0) do { s16x4 l0, l1, h0, h1; constexpr int b_ = (d0) * 512; SU_TRRD(l0, b_); SU_TRRD(h0, b_ + 2048); SU_TRRD(l1, b_ + 4096); SU_TRRD(h1, b_ + 6144); \
        asm volatile("s_waitcnt lgkmcnt(0)" ::: "memory"); __builtin_amdgcn_sched_barrier(0); \
        o[d0] = __builtin_amdgcn_mfma_f32_32x32x16_bf16(pa0, (bf16x8){l0[0], l0[1], l0[2], l0[3], h0[0], h0[1], h0[2], h0[3]}, o[d0], 0, 0, 0); \
        o[d0] = __builtin_amdgcn_mfma_f32_32x32x16_bf16(pa1, (bf16x8){l1[0], l1[1], l1[2], l1[3], h1[0], h1[1], h1[2], h1[3]}, o[d0], 0, 0, 0); } while (0)
        SU_PV(0); SU_PV(1); SU_PV(2); SU_PV(3);
        asm volatile("s_waitcnt lgkmcnt(0)" ::: "memory");
    }
#undef SU_PV
#undef SU_TRRD
#undef SU_WRV
#undef SU_WRK
#undef SU_LOAD
#undef SU_BASE
    float* Sp = WSP(float, WS_SPART) + ((size_t)(bh * 32 + pg) * 8) * 128;
#pragma unroll
    for (int r = 0; r < 4; ++r)
#pragma unroll
        for (int d0 = 0; d0 < 4; ++d0) Sp[(size_t)(r + 4 * hi) * 128 + d0 * 32 + r32] = o[d0][r];
    if (hi == 0 && r32 < 8) WSP(float, WS_SCAR)[(size_t)(bh * 32 + pg) * 8 + r32] = carry;
}
}
__device__ __forceinline__ void sample_combine(Ctx& F) {
    const int gw = F.vcu * NWAVES + F.wave, NGW = F.G * NWAVES; bf16* OAB = WSP(bf16, WS_OAB);
    const float* SPt = WSP(float, WS_SPART); const float* SCr = WSP(float, WS_SCAR);
    for (int task = gw; task < DBAT * HA * DSEQ; task += NGW) { const int bh = task >> 3, i = task & 7, b = bh >> 3, h = bh & 7; const float bias = F.in(I_SBB)[h];
        f32x2 po[32]; float sc[32];
#pragma unroll
        for (int pg = 0; pg < 32; ++pg) { po[pg] = *(const GAS f32x2*)(SPt + ((size_t)(bh * 32 + pg) * 8 + i) * 128 + 2 * F.lane); sc[pg] = SCr[(size_t)(bh * 32 + pg) * 8 + i]; }
        f32x2 q; { const unsigned qw = *(const GAS unsigned*)(WSP(bf16, WS_QB) + (size_t)(NPR + b * DSEQ + i) * 1024 + h * 128 + 2 * F.lane); q.x = __uint_as_float(qw << 16); q.y = __uint_as_float(qw & 0xffff0000u); }
        float carry = 1.f, a0 = 0.f, a1 = 0.f;
        for (int j = i - 1; j >= 0; --j) { const size_t ko = (size_t)(b * DSEQ + j) * 1024 + h * 128 + 2 * F.lane; const f32x2 k = *(const GAS f32x2*)(F.outp() + O_KS + ko), v = *(const GAS f32x2*)(F.outp() + O_VS + ko);
            const float z = wave_sum(q.x * k.x + q.y * k.y) * QK_SCALE + bias, e = __expf(fminf(z, 40.f)), om = 1.f / (1.f + e), w = e * om * carry;
            a0 += w * v.x; a1 += w * v.y; carry *= om; }
#pragma unroll
        for (int pg = 31; pg >= 0; --pg) { a0 += carry * po[pg].x; a1 += carry * po[pg].y; carry *= sc[pg]; }
        *(GAS unsigned*)(OAB + (size_t)(NPR + b * DSEQ + i) * DM + h * 128 + 2 * F.lane) = cvt_pk_bf16(a0, a1);
    }
}
__device__ __forceinline__ void phase_attn_prompt(Ctx& F) {
    for (int it2 = 2 * F.vcu; it2 < 2 * NBATCH * HA * 16; it2 += (it2 & 1) ? 2 * F.G - 1 : 1) { const int item = it2 >> 1, half = it2 & 1, bh = item >> 4, x = item & 15;
        sba::attn_half(F, bh, half ? 15 - x : x, half); }
    __syncthreads();
}
__device__ __forceinline__ void dots16(float& sig, float& rho, float kkv, float wrv, const float (&s)[16]) {
    asm("s_nop 1\n\t"
        "v_fmac_f32_dpp %0, %2, %4 row_newbcast:0 row_mask:0xf bank_mask:0xf\n\t"
        "v_fmac_f32_dpp %1, %3, %4 row_newbcast:0 row_mask:0xf bank_mask:0xf\n\t"
        "v_fmac_f32_dpp %0, %2, %5 row_newbcast:1 row_mask:0xf bank_mask:0xf\n\t"
        "v_fmac_f32_dpp %1, %3, %5 row_newbcast:1 row_mask:0xf bank_mask:0xf\n\t"
        "v_fmac_f32_dpp %0, %2, %6 row_newbcast:2 row_mask:0xf bank_mask:0xf\n\t"
        "v_fmac_f32_dpp %1, %3, %6 row_newbcast:2 row_mask:0xf bank_mask:0xf\n\t"
        "v_fmac_f32_dpp %0, %2, %7 row_newbcast:3 row_mask:0xf bank_mask:0xf\n\t"
        "v_fmac_f32_dpp %1, %3, %7 row_newbcast:3 row_mask:0xf bank_mask:0xf\n\t"
        "v_fmac_f32_dpp %0, %2, %8 row_newbcast:4 row_mask:0xf bank_mask:0xf\n\t"
        "v_fmac_f32_dpp %1, %3, %8 row_newbcast:4 row_mask:0xf bank_mask:0xf\n\t"
        "v_fmac_f32_dpp %0, %2, %9 row_newbcast:5 row_mask:0xf bank_mask:0xf\n\t"
        "v_fmac_f32_dpp %1, %3, %9 row_newbcast:5 row_mask:0xf bank_mask:0xf\n\t"
        "v_fmac_f32_dpp %0, %2, %10 row_newbcast:6 row_mask:0xf bank_mask:0xf\n\t"
        "v_fmac_f32_dpp %1, %3, %10 row_newbcast:6 row_mask:0xf bank_mask:0xf\n\t"
        "v_fmac_f32_dpp %0, %2, %11 row_newbcast:7 row_mask:0xf bank_mask:0xf\n\t"
        "v_fmac_f32_dpp %1, %3, %11 row_newbcast:7 row_mask:0xf bank_mask:0xf\n\t"
        "v_fmac_f32_dpp %0, %2, %12 row_newbcast:8 row_mask:0xf bank_mask:0xf\n\t"
        "v_fmac_f32_dpp %1, %3, %12 row_newbcast:8 row_mask:0xf bank_mask:0xf\n\t"
        "v_fmac_f32_dpp %0, %2, %13 row_newbcast:9 row_mask:0xf bank_mask:0xf\n\t"
        "v_fmac_f32_dpp %1, %3, %13 row_newbcast:9 row_mask:0xf bank_mask:0xf\n\t"
        "v_fmac_f32_dpp %0, %2, %14 row_newbcast:10 row_mask:0xf bank_mask:0xf\n\t"
        "v_fmac_f32_dpp %1, %3, %14 row_newbcast:10 row_mask:0xf bank_mask:0xf\n\t"
        "v_fmac_f32_dpp %0, %2, %15 row_newbcast:11 row_mask:0xf bank_mask:0xf\n\t"
        "v_fmac_f32_dpp %1, %3, %15 row_newbcast:11 row_mask:0xf bank_mask:0xf\n\t"
        "v_fmac_f32_dpp %0, %2, %16 row_newbcast:12 row_mask:0xf bank_mask:0xf\n\t"
        "v_fmac_f32_dpp %1, %3, %16 row_newbcast:12 row_mask:0xf bank_mask:0xf\n\t"
        "v_fmac_f32_dpp %0, %2, %17 row_newbcast:13 row_mask:0xf bank_mask:0xf\n\t"
        "v_fmac_f32_dpp %1, %3, %17 row_newbcast:13 row_mask:0xf bank_mask:0xf\n\t"
        "v_fmac_f32_dpp %0, %2, %18 row_newbcast:14 row_mask:0xf bank_mask:0xf\n\t"
        "v_fmac_f32_dpp %1, %3, %18 row_newbcast:14 row_mask:0xf bank_mask:0xf\n\t"
        "v_fmac_f32_dpp %0, %2, %19 row_newbcast:15 row_mask:0xf bank_mask:0xf\n\t"
        "v_fmac_f32_dpp %1, %3, %19 row_newbcast:15 row_mask:0xf bank_mask:0xf\n\t"
        "s_nop 1"
        : "+v"(sig), "+v"(rho) : "v"(kkv), "v"(wrv), "v"(s[0]), "v"(s[1]), "v"(s[2]), "v"(s[3]), "v"(s[4]), "v"(s[5]), "v"(s[6]), "v"(s[7]), "v"(s[8]), "v"(s[9]), "v"(s[10]), "v"(s[11]), "v"(s[12]), "v"(s[13]), "v"(s[14]), "v"(s[15]));
}
__device__ __forceinline__ void dot16(float& acc, float zv, const float (&s)[16]) {
    asm("s_nop 1\n\t"
        "v_fmac_f32_dpp %0, %1, %2 row_newbcast:0 row_mask:0xf bank_mask:0xf\n\t"
        "v_fmac_f32_dpp %0, %1, %3 row_newbcast:1 row_mask:0xf bank_mask:0xf\n\t"
        "v_fmac_f32_dpp %0, %1, %4 row_newbcast:2 row_mask:0xf bank_mask:0xf\n\t"
        "v_fmac_f32_dpp %0, %1, %5 row_newbcast:3 row_mask:0xf bank_mask:0xf\n\t"
        "v_fmac_f32_dpp %0, %1, %6 row_newbcast:4 row_mask:0xf bank_mask:0xf\n\t"
        "v_fmac_f32_dpp %0, %1, %7 row_newbcast:5 row_mask:0xf bank_mask:0xf\n\t"
        "v_fmac_f32_dpp %0, %1, %8 row_newbcast:6 row_mask:0xf bank_mask:0xf\n\t"
        "v_fmac_f32_dpp %0, %1, %9 row_newbcast:7 row_mask:0xf bank_mask:0xf\n\t"
        "v_fmac_f32_dpp %0, %1, %10 row_newbcast:8 row_mask:0xf bank_mask:0xf\n\t"
        "v_fmac_f32_dpp %0, %1, %11 row_newbcast:9 row_mask:0xf bank_mask:0xf\n\t"
        "v_fmac_f32_dpp %0, %1, %12 row_newbcast:10 row_mask:0xf bank_mask:0xf\n\t"
        "v_fmac_f32_dpp %0, %1, %13 row_newbcast:11 row_mask:0xf bank_mask:0xf\n\t"
        "v_fmac_f32_dpp %0, %1, %14 row_newbcast:12 row_mask:0xf bank_mask:0xf\n\t"
        "v_fmac_f32_dpp %0, %1, %15 row_newbcast:13 row_mask:0xf bank_mask:0xf\n\t"
        "v_fmac_f32_dpp %0, %1, %16 row_newbcast:14 row_mask:0xf bank_mask:0xf\n\t"
        "v_fmac_f32_dpp %0, %1, %17 row_newbcast:15 row_mask:0xf bank_mask:0xf\n\t"
        "s_nop 1"
        : "+v"(acc) : "v"(zv), "v"(s[0]), "v"(s[1]), "v"(s[2]), "v"(s[3]), "v"(s[4]), "v"(s[5]), "v"(s[6]), "v"(s[7]), "v"(s[8]), "v"(s[9]), "v"(s[10]), "v"(s[11]), "v"(s[12]), "v"(s[13]), "v"(s[14]), "v"(s[15]));
}
__device__ __forceinline__ void upd16_v(float (&s)[16], float wv, float kv, float bv, float vv, float ns) {
    asm("s_nop 1\n\t"
        "v_mul_f32_dpp %0, %16, %0 row_newbcast:0 row_mask:0xf bank_mask:0xf\n\t"
        "v_mul_f32_dpp %1, %16, %1 row_newbcast:1 row_mask:0xf bank_mask:0xf\n\t"
        "v_mul_f32_dpp %2, %16, %2 row_newbcast:2 row_mask:0xf bank_mask:0xf\n\t"
        "v_mul_f32_dpp %3, %16, %3 row_newbcast:3 row_mask:0xf bank_mask:0xf\n\t"
        "v_mul_f32_dpp %4, %16, %4 row_newbcast:4 row_mask:0xf bank_mask:0xf\n\t"
        "v_mul_f32_dpp %5, %16, %5 row_newbcast:5 row_mask:0xf bank_mask:0xf\n\t"
        "v_mul_f32_dpp %6, %16, %6 row_newbcast:6 row_mask:0xf bank_mask:0xf\n\t"
        "v_mul_f32_dpp %7, %16, %7 row_newbcast:7 row_mask:0xf bank_mask:0xf\n\t"
        "v_mul_f32_dpp %8, %16, %8 row_newbcast:8 row_mask:0xf bank_mask:0xf\n\t"
        "v_mul_f32_dpp %9, %16, %9 row_newbcast:9 row_mask:0xf bank_mask:0xf\n\t"
        "v_mul_f32_dpp %10, %16, %10 row_newbcast:10 row_mask:0xf bank_mask:0xf\n\t"
        "v_mul_f32_dpp %11, %16, %11 row_newbcast:11 row_mask:0xf bank_mask:0xf\n\t"
        "v_mul_f32_dpp %12, %16, %12 row_newbcast:12 row_mask:0xf bank_mask:0xf\n\t"
        "v_mul_f32_dpp %13, %16, %13 row_newbcast:13 row_mask:0xf bank_mask:0xf\n\t"
        "v_mul_f32_dpp %14, %16, %14 row_newbcast:14 row_mask:0xf bank_mask:0xf\n\t"
        "v_mul_f32_dpp %15, %16, %15 row_newbcast:15 row_mask:0xf bank_mask:0xf\n\t"
        "v_fmac_f32_dpp %0, %17, %19 row_newbcast:0 row_mask:0xf bank_mask:0xf\n\t"
        "v_fmac_f32_dpp %1, %17, %19 row_newbcast:1 row_mask:0xf bank_mask:0xf\n\t"
        "v_fmac_f32_dpp %2, %17, %19 row_newbcast:2 row_mask:0xf bank_mask:0xf\n\t"
        "v_fmac_f32_dpp %3, %17, %19 row_newbcast:3 row_mask:0xf bank_mask:0xf\n\t"
        "v_fmac_f32_dpp %4, %17, %19 row_newbcast:4 row_mask:0xf bank_mask:0xf\n\t"
        "v_fmac_f32_dpp %5, %17, %19 row_newbcast:5 row_mask:0xf bank_mask:0xf\n\t"
        "v_fmac_f32_dpp %6, %17, %19 row_newbcast:6 row_mask:0xf bank_mask:0xf\n\t"
        "v_fmac_f32_dpp %7, %17, %19 row_newbcast:7 row_mask:0xf bank_mask:0xf\n\t"
        "v_fmac_f32_dpp %8, %17, %19 row_newbcast:8 row_mask:0xf bank_mask:0xf\n\t"
        "v_fmac_f32_dpp %9, %17, %19 row_newbcast:9 row_mask:0xf bank_mask:0xf\n\t"
        "v_fmac_f32_dpp %10, %17, %19 row_newbcast:10 row_mask:0xf bank_mask:0xf\n\t"
        "v_fmac_f32_dpp %11, %17, %19 row_newbcast:11 row_mask:0xf bank_mask:0xf\n\t"
        "v_fmac_f32_dpp %12, %17, %19 row_newbcast:12 row_mask:0xf bank_mask:0xf\n\t"
        "v_fmac_f32_dpp %13, %17, %19 row_newbcast:13 row_mask:0xf bank_mask:0xf\n\t"
        "v_fmac_f32_dpp %14, %17, %19 row_newbcast:14 row_mask:0xf bank_mask:0xf\n\t"
        "v_fmac_f32_dpp %15, %17, %19 row_newbcast:15 row_mask:0xf bank_mask:0xf\n\t"
        "v_fmac_f32_dpp %0, %18, %20 row_newbcast:0 row_mask:0xf bank_mask:0xf\n\t"
        "v_fmac_f32_dpp %1, %18, %20 row_newbcast:1 row_mask:0xf bank_mask:0xf\n\t"
        "v_fmac_f32_dpp %2, %18, %20 row_newbcast:2 row_mask:0xf bank_mask:0xf\n\t"
        "v_fmac_f32_dpp %3, %18, %20 row_newbcast:3 row_mask:0xf bank_mask:0xf\n\t"
        "v_fmac_f32_dpp %4, %18, %20 row_newbcast:4 row_mask:0xf bank_mask:0xf\n\t"
        "v_fmac_f32_dpp %5, %18, %20 row_newbcast:5 row_mask:0xf bank_mask:0xf\n\t"
        "v_fmac_f32_dpp %6, %18, %20 row_newbcast:6 row_mask:0xf bank_mask:0xf\n\t"
        "v_fmac_f32_dpp %7, %18, %20 row_newbcast:7 row_mask:0xf bank_mask:0xf\n\t"
        "v_fmac_f32_dpp %8, %18, %20 row_newbcast:8 row_mask:0xf bank_mask:0xf\n\t"
        "v_fmac_f32_dpp %9, %18, %20 row_newbcast:9 row_mask:0xf bank_mask:0xf\n\t"
        "v_fmac_f32_dpp %10, %18, %20 row_newbcast:10 row_mask:0xf bank_mask:0xf\n\t"
        "v_fmac_f32_dpp %11, %18, %20 row_newbcast:11 row_mask:0xf bank_mask:0xf\n\t"
        "v_fmac_f32_dpp %12, %18, %20 row_newbcast:12 row_mask:0xf bank_mask:0xf\n\t"
        "v_fmac_f32_dpp %13, %18, %20 row_newbcast:13 row_mask:0xf bank_mask:0xf\n\t"
        "v_fmac_f32_dpp %14, %18, %20 row_newbcast:14 row_mask:0xf bank_mask:0xf\n\t"
        "v_fmac_f32_dpp %15, %18, %20 row_newbcast:15 row_mask:0xf bank_mask:0xf\n\t"
        "s_nop 1"
        : "+v"(s[0]), "+v"(s[1]), "+v"(s[2]), "+v"(s[3]), "+v"(s[4]), "+v"(s[5]), "+v"(s[6]), "+v"(s[7]), "+v"(s[8]), "+v"(s[9]), "+v"(s[10]), "+v"(s[11]), "+v"(s[12]), "+v"(s[13]), "+v"(s[14]), "+v"(s[15]) : "v"(wv), "v"(kv), "v"(bv), "v"(vv), "v"(ns));
}
__device__ __forceinline__ void upd16_nov(float (&s)[16], float wv, float kv, float bv, float vv, float ns) {
    asm("s_nop 1\n\t"
        "v_mul_f32_dpp %0, %16, %0 row_newbcast:0 row_mask:0xf bank_mask:0xf\n\t"
        "v_mul_f32_dpp %1, %16, %1 row_newbcast:1 row_mask:0xf bank_mask:0xf\n\t"
        "v_mul_f32_dpp %2, %16, %2 row_newbcast:2 row_mask:0xf bank_mask:0xf\n\t"
        "v_mul_f32_dpp %3, %16, %3 row_newbcast:3 row_mask:0xf bank_mask:0xf\n\t"
        "v_mul_f32_dpp %4, %16, %4 row_newbcast:4 row_mask:0xf bank_mask:0xf\n\t"
        "v_mul_f32_dpp %5, %16, %5 row_newbcast:5 row_mask:0xf bank_mask:0xf\n\t"
        "v_mul_f32_dpp %6, %16, %6 row_newbcast:6 row_mask:0xf bank_mask:0xf\n\t"
        "v_mul_f32_dpp %7, %16, %7 row_newbcast:7 row_mask:0xf bank_mask:0xf\n\t"
        "v_mul_f32_dpp %8, %16, %8 row_newbcast:8 row_mask:0xf bank_mask:0xf\n\t"
        "v_mul_f32_dpp %9, %16, %9 row_newbcast:9 row_mask:0xf bank_mask:0xf\n\t"
        "v_mul_f32_dpp %10, %16, %10 row_newbcast:10 row_mask:0xf bank_mask:0xf\n\t"
        "v_mul_f32_dpp %11, %16, %11 row_newbcast:11 row_mask:0xf bank_mask:0xf\n\t"
        "v_mul_f32_dpp %12, %16, %12 row_newbcast:12 row_mask:0xf bank_mask:0xf\n\t"
        "v_mul_f32_dpp %13, %16, %13 row_newbcast:13 row_mask:0xf bank_mask:0xf\n\t"
        "v_mul_f32_dpp %14, %16, %14 row_newbcast:14 row_mask:0xf bank_mask:0xf\n\t"
        "v_mul_f32_dpp %15, %16, %15 row_newbcast:15 row_mask:0xf bank_mask:0xf\n\t"
        "v_fmac_f32_dpp %0, %18, %20 row_newbcast:0 row_mask:0xf bank_mask:0xf\n\t"
        "v_fmac_f32_dpp %1, %18, %20 row_newbcast:1 row_mask:0xf bank_mask:0xf\n\t"
        "v_fmac_f32_dpp %2, %18, %20 row_newbcast:2 row_mask:0xf bank_mask:0xf\n\t"
        "v_fmac_f32_dpp %3, %18, %20 row_newbcast:3 row_mask:0xf bank_mask:0xf\n\t"
        "v_fmac_f32_dpp %4, %18, %20 row_newbcast:4 row_mask:0xf bank_mask:0xf\n\t"
        "v_fmac_f32_dpp %5, %18, %20 row_newbcast:5 row_mask:0xf bank_mask:0xf\n\t"
        "v_fmac_f32_dpp %6, %18, %20 row_newbcast:6 row_mask:0xf bank_mask:0xf\n\t"
        "v_fmac_f32_dpp %7, %18, %20 row_newbcast:7 row_mask:0xf bank_mask:0xf\n\t"
        "v_fmac_f32_dpp %8, %18, %20 row_newbcast:8 row_mask:0xf bank_mask:0xf\n\t"
        "v_fmac_f32_dpp %9, %18, %20 row_newbcast:9 row_mask:0xf bank_mask:0xf\n\t"
        "v_fmac_f32_dpp %10, %18, %20 row_newbcast:10 row_mask:0xf bank_mask:0xf\n\t"
        "v_fmac_f32_dpp %11, %18, %20 row_newbcast:11 row_mask:0xf bank_mask:0xf\n\t"
        "v_fmac_f32_dpp %12, %18, %20 row_newbcast:12 row_mask:0xf bank_mask:0xf\n\t"
        "v_fmac_f32_dpp %13, %18, %20 row_newbcast:13 row_mask:0xf bank_mask:0xf\n\t"
        "v_fmac_f32_dpp %14, %18, %20 row_newbcast:14 row_mask:0xf bank_mask:0xf\n\t"
        "v_fmac_f32_dpp %15, %18, %20 row_newbcast:15 row_mask:0xf bank_mask:0xf\n\t"
        "s_nop 1"
        : "+v"(s[0]), "+v"(s[1]), "+v"(s[2]), "+v"(s[3]), "+v"(s[4]), "+v"(s[5]), "+v"(s[6]), "+v"(s[7]), "+v"(s[8]), "+v"(s[9]), "+v"(s[10]), "+v"(s[11]), "+v"(s[12]), "+v"(s[13]), "+v"(s[14]), "+v"(s[15]) : "v"(wv), "v"(kv), "v"(bv), "v"(vv), "v"(ns));
}
__device__ __forceinline__ float xrow16_sum(float x) {
    auto s = __builtin_amdgcn_permlane16_swap(__float_as_uint(x), __float_as_uint(x), false, false);
    x = __uint_as_float(s[0]) + __uint_as_float(s[1]);
    auto t = __builtin_amdgcn_permlane32_swap(__float_as_uint(x), __float_as_uint(x), false, false);
    return __uint_as_float(t[0]) + __uint_as_float(t[1]);
}
struct StepIn { float wv, kkv, bv, kv, wrv, vv, beta, kappa; };
template <bool PROW> __device__ __forceinline__ void scan_load(StepIn& x, const float* RWV, const float* SCL, int r, int h, int lane, int row) {
    const float* base = RWV + ((size_t)r * HB + h) * 512; const float* sc = SCL + ((size_t)r * HB + h) * 4;
    x.wv = base[lane]; x.kkv = base[64 + lane]; x.bv = base[128 + lane]; x.wrv = base[384 + lane]; x.beta = sc[0];
    if (!PROW) { x.kv = base[192 + lane]; x.vv = base[320 + row]; x.kappa = sc[1]; } else { x.kv = 0.f; x.vv = 0.f; x.kappa = 0.f; }
}
template <bool PROW, bool SAMP> __device__ __forceinline__ void scan_wave(Ctx& F, int bh, int c, int g) {
    const int lane = F.lane, q = lane >> 4, m = lane & 15, row = 16 * g + m, h = bh & 15, b = bh >> 4;
    constexpr int L = SAMP ? DSEQ : 64; const int r0 = SAMP ? NPR + b * DSEQ : b * SEQ + c * 64; const int ch = bh * 64 + c;
    const float* RWV = WSP(float, WS_RWV); const float* SCL = WSP(float, WS_SCL); float* Y = WSP(float, WS_Y); float* Z = WSP(float, WS_Z); float* PU = WSP(float, WS_PU);
    float s[16];
    if (SAMP) { const float* st = F.in(I_SWKV) + ((size_t)bh * 64 + row) * 64 + 16 * q;
#pragma unroll
        for (int i = 0; i < 16; i += 4) { const f32x4 v = *(const GAS f32x4*)(st + i); s[i] = v.x; s[i + 1] = v.y; s[i + 2] = v.z; s[i + 3] = v.w; } }
    else {
#pragma unroll
        for (int i = 0; i < 16; ++i) s[i] = (PROW && (16 * q + i) == row) ? 1.f : 0.f; }
    StepIn buf[4];
#pragma unroll
    for (int u = 0; u < 4; ++u) scan_load<PROW>(buf[u], RWV, SCL, r0 + u, h, lane, row);
    for (int t = 0; t < L; t += 4) {
#pragma unroll
        for (int u = 0; u < 4; ++u) {
            const StepIn x = buf[u];
            if (t + u + 4 < L) scan_load<PROW>(buf[u], RWV, SCL, r0 + t + u + 4, h, lane, row);
            float sig = 0.f, rho = 0.f;
            dots16(sig, rho, x.kkv, x.wrv, s);
            sig = xrow16_sum(sig); rho = xrow16_sum(rho);
            const float ns = -sig;
            float y = rho + ns * x.beta; if (!PROW) y += x.vv * x.kappa;
            if (q == 0) { if (PROW) Z[((size_t)ch * 64 + t + u) * 64 + row] = y; else Y[(size_t)(r0 + t + u) * 1024 + h * 64 + row] = y; }
            if (PROW) upd16_nov(s, x.wv, x.kv, x.bv, x.vv, ns); else upd16_v(s, x.wv, x.kv, x.bv, x.vv, ns);
        }
    }
    float* dst = SAMP ? F.outp() + O_WKVS + ((size_t)bh * 64 + row) * 64 + 16 * q : PU + (((size_t)ch * 2 + (PROW ? 1 : 0)) * 64 + row) * 64 + 16 * q;
#pragma unroll
    for (int i = 0; i < 16; i += 4) *(GAS f32x4*)(dst + i) = (f32x4){s[i], s[i + 1], s[i + 2], s[i + 3]};
}
__device__ __forceinline__ void dots2_h0(float& sgu, float& rhu, float& sgp, float& rhp, float kkv, float wrv, const float (&su)[16], const float (&sp)[16]) {
    asm("s_nop 1\n\t"
        "v_fmac_f32_dpp %0, %4, %6 row_newbcast:0 row_mask:0xf bank_mask:0xf\n\t"
        "v_fmac_f32_dpp %1, %5, %6 row_newbcast:0 row_mask:0xf bank_mask:0xf\n\t"
        "v_fmac_f32_dpp %2, %4, %14 row_newbcast:0 row_mask:0xf bank_mask:0xf\n\t"
        "v_fmac_f32_dpp %3, %5, %14 row_newbcast:0 row_mask:0xf bank_mask:0xf\n\t"
        "v_fmac_f32_dpp %0, %4, %7 row_newbcast:1 row_mask:0xf bank_mask:0xf\n\t"
        "v_fmac_f32_dpp %1, %5, %7 row_newbcast:1 row_mask:0xf bank_mask:0xf\n\t"
        "v_fmac_f32_dpp %2, %4, %15 row_newbcast:1 row_mask:0xf bank_mask:0xf\n\t"
        "v_fmac_f32_dpp %3, %5, %15 row_newbcast:1 row_mask:0xf bank_mask:0xf\n\t"
        "v_fmac_f32_dpp %0, %4, %8 row_newbcast:2 row_mask:0xf bank_mask:0xf\n\t"
        "v_fmac_f32_dpp %1, %5, %8 row_newbcast:2 row_mask:0xf bank_mask:0xf\n\t"
        "v_fmac_f32_dpp %2, %4, %16 row_newbcast:2 row_mask:0xf bank_mask:0xf\n\t"
        "v_fmac_f32_dpp %3, %5, %16 row_newbcast:2 row_mask:0xf bank_mask:0xf\n\t"
        "v_fmac_f32_dpp %0, %4, %9 row_newbcast:3 row_mask:0xf bank_mask:0xf\n\t"
        "v_fmac_f32_dpp %1, %5, %9 row_newbcast:3 row_mask:0xf bank_mask:0xf\n\t"
        "v_fmac_f32_dpp %2, %4, %17 row_newbcast:3 row_mask:0xf bank_mask:0xf\n\t"
        "v_fmac_f32_dpp %3, %5, %17 row_newbcast:3 row_mask:0xf bank_mask:0xf\n\t"
        "v_fmac_f32_dpp %0, %4, %10 row_newbcast:4 row_mask:0xf bank_mask:0xf\n\t"
        "v_fmac_f32_dpp %1, %5, %10 row_newbcast:4 row_mask:0xf bank_mask:0xf\n\t"
        "v_fmac_f32_dpp %2, %4, %18 row_newbcast:4 row_mask:0xf bank_mask:0xf\n\t"
        "v_fmac_f32_dpp %3, %5, %18 row_newbcast:4 row_mask:0xf bank_mask:0xf\n\t"
        "v_fmac_f32_dpp %0, %4, %11 row_newbcast:5 row_mask:0xf bank_mask:0xf\n\t"
        "v_fmac_f32_dpp %1, %5, %11 row_newbcast:5 row_mask:0xf bank_mask:0xf\n\t"
        "v_fmac_f32_dpp %2, %4, %19 row_newbcast:5 row_mask:0xf bank_mask:0xf\n\t"
        "v_fmac_f32_dpp %3, %5, %19 row_newbcast:5 row_mask:0xf bank_mask:0xf\n\t"
        "v_fmac_f32_dpp %0, %4, %12 row_newbcast:6 row_mask:0xf bank_mask:0xf\n\t"
        "v_fmac_f32_dpp %1, %5, %12 row_newbcast:6 row_mask:0xf bank_mask:0xf\n\t"
        "v_fmac_f32_dpp %2, %4, %20 row_newbcast:6 row_mask:0xf bank_mask:0xf\n\t"
        "v_fmac_f32_dpp %3, %5, %20 row_newbcast:6 row_mask:0xf bank_mask:0xf\n\t"
        "v_fmac_f32_dpp %0, %4, %13 row_newbcast:7 row_mask:0xf bank_mask:0xf\n\t"
        "v_fmac_f32_dpp %1, %5, %13 row_newbcast:7 row_mask:0xf bank_mask:0xf\n\t"
        "v_fmac_f32_dpp %2, %4, %21 row_newbcast:7 row_mask:0xf bank_mask:0xf\n\t"
        "v_fmac_f32_dpp %3, %5, %21 row_newbcast:7 row_mask:0xf bank_mask:0xf\n\t"
        "s_nop 1"
        : "+v"(sgu), "+v"(rhu), "+v"(sgp), "+v"(rhp) : "v"(kkv), "v"(wrv), "v"(su[0]), "v"(su[1]), "v"(su[2]), "v"(su[3]), "v"(su[4]), "v"(su[5]), "v"(su[6]), "v"(su[7]), "v"(sp[0]), "v"(sp[1]), "v"(sp[2]), "v"(sp[3]), "v"(sp[4]), "v"(sp[5]), "v"(sp[6]), "v"(sp[7]));
}
__device__ __forceinline__ void dots2_h1(float& sgu, float& rhu, float& sgp, float& rhp, float kkv, float wrv, const float (&su)[16], const float (&sp)[16]) {
    asm("s_nop 1\n\t"
        "v_fmac_f32_dpp %0, %4, %6 row_newbcast:8 row_mask:0xf bank_mask:0xf\n\t"
        "v_fmac_f32_dpp %1, %5, %6 row_newbcast:8 row_mask:0xf bank_mask:0xf\n\t"
        "v_fmac_f32_dpp %2, %4, %14 row_newbcast:8 row_mask:0xf bank_mask:0xf\n\t"
        "v_fmac_f32_dpp %3, %5, %14 row_newbcast:8 row_mask:0xf bank_mask:0xf\n\t"
        "v_fmac_f32_dpp %0, %4, %7 row_newbcast:9 row_mask:0xf bank_mask:0xf\n\t"
        "v_fmac_f32_dpp %1, %5, %7 row_newbcast:9 row_mask:0xf bank_mask:0xf\n\t"
        "v_fmac_f32_dpp %2, %4, %15 row_newbcast:9 row_mask:0xf bank_mask:0xf\n\t"
        "v_fmac_f32_dpp %3, %5, %15 row_newbcast:9 row_mask:0xf bank_mask:0xf\n\t"
        "v_fmac_f32_dpp %0, %4, %8 row_newbcast:10 row_mask:0xf bank_mask:0xf\n\t"
        "v_fmac_f32_dpp %1, %5, %8 row_newbcast:10 row_mask:0xf bank_mask:0xf\n\t"
        "v_fmac_f32_dpp %2, %4, %16 row_newbcast:10 row_mask:0xf bank_mask:0xf\n\t"
        "v_fmac_f32_dpp %3, %5, %16 row_newbcast:10 row_mask:0xf bank_mask:0xf\n\t"
        "v_fmac_f32_dpp %0, %4, %9 row_newbcast:11 row_mask:0xf bank_mask:0xf\n\t"
        "v_fmac_f32_dpp %1, %5, %9 row_newbcast:11 row_mask:0xf bank_mask:0xf\n\t"
        "v_fmac_f32_dpp %2, %4, %17 row_newbcast:11 row_mask:0xf bank_mask:0xf\n\t"
        "v_fmac_f32_dpp %3, %5, %17 row_newbcast:11 row_mask:0xf bank_mask:0xf\n\t"
        "v_fmac_f32_dpp %0, %4, %10 row_newbcast:12 row_mask:0xf bank_mask:0xf\n\t"
        "v_fmac_f32_dpp %1, %5, %10 row_newbcast:12 row_mask:0xf bank_mask:0xf\n\t"
        "v_fmac_f32_dpp %2, %4, %18 row_newbcast:12 row_mask:0xf bank_mask:0xf\n\t"
        "v_fmac_f32_dpp %3, %5, %18 row_newbcast:12 row_mask:0xf bank_mask:0xf\n\t"
        "v_fmac_f32_dpp %0, %4, %11 row_newbcast:13 row_mask:0xf bank_mask:0xf\n\t"
        "v_fmac_f32_dpp %1, %5, %11 row_newbcast:13 row_mask:0xf bank_mask:0xf\n\t"
        "v_fmac_f32_dpp %2, %4, %19 row_newbcast:13 row_mask:0xf bank_mask:0xf\n\t"
        "v_fmac_f32_dpp %3, %5, %19 row_newbcast:13 row_mask:0xf bank_mask:0xf\n\t"
        "v_fmac_f32_dpp %0, %4, %12 row_newbcast:14 row_mask:0xf bank_mask:0xf\n\t"
        "v_fmac_f32_dpp %1, %5, %12 row_newbcast:14 row_mask:0xf bank_mask:0xf\n\t"
        "v_fmac_f32_dpp %2, %4, %20 row_newbcast:14 row_mask:0xf bank_mask:0xf\n\t"
        "v_fmac_f32_dpp %3, %5, %20 row_newbcast:14 row_mask:0xf bank_mask:0xf\n\t"
        "v_fmac_f32_dpp %0, %4, %13 row_newbcast:15 row_mask:0xf bank_mask:0xf\n\t"
        "v_fmac_f32_dpp %1, %5, %13 row_newbcast:15 row_mask:0xf bank_mask:0xf\n\t"
        "v_fmac_f32_dpp %2, %4, %21 row_newbcast:15 row_mask:0xf bank_mask:0xf\n\t"
        "v_fmac_f32_dpp %3, %5, %21 row_newbcast:15 row_mask:0xf bank_mask:0xf\n\t"
        "s_nop 1"
        : "+v"(sgu), "+v"(rhu), "+v"(sgp), "+v"(rhp) : "v"(kkv), "v"(wrv), "v"(su[8]), "v"(su[9]), "v"(su[10]), "v"(su[11]), "v"(su[12]), "v"(su[13]), "v"(su[14]), "v"(su[15]), "v"(sp[8]), "v"(sp[9]), "v"(sp[10]), "v"(sp[11]), "v"(sp[12]), "v"(sp[13]), "v"(sp[14]), "v"(sp[15]));
}
__device__ __forceinline__ void scan_wave_up(Ctx& F, int bh, int c, int g) {
    const int lane = F.lane, q = lane >> 4, m = lane & 15, row = 16 * g + m, h = bh & 15, b = bh >> 4;
    const int r0 = b * SEQ + c * 64, ch = bh * 64 + c;
    const float* RWV = WSP(float, WS_RWV); const float* SCL = WSP(float, WS_SCL); float* Y = WSP(float, WS_Y); float* Z = WSP(float, WS_Z); float* PU = WSP(float, WS_PU);
    float su[16], sp[16];
#pragma unroll
    for (int i = 0; i < 16; ++i) { su[i] = 0.f; sp[i] = ((16 * q + i) == row) ? 1.f : 0.f; }
    StepIn buf[4];
#pragma unroll
    for (int u = 0; u < 4; ++u) scan_load<false>(buf[u], RWV, SCL, r0 + u, h, lane, row);
    for (int t = 0; t < 64; t += 4) {
#pragma unroll
        for (int u = 0; u < 4; ++u) {
            const StepIn x = buf[u];
            if (t + u + 4 < 64) scan_load<false>(buf[u], RWV, SCL, r0 + t + u + 4, h, lane, row);
            float sgu = 0.f, rhu = 0.f, sgp = 0.f, rhp = 0.f;
            dots2_h0(sgu, rhu, sgp, rhp, x.kkv, x.wrv, su, sp); dots2_h1(sgu, rhu, sgp, rhp, x.kkv, x.wrv, su, sp);
            sgu = xrow16_sum(sgu); rhu = xrow16_sum(rhu); sgp = xrow16_sum(sgp); rhp = xrow16_sum(rhp);
            const float nsu = -sgu, nsp = -sgp;
            const float y = rhu + nsu * x.beta + x.vv * x.kappa, z = rhp + nsp * x.beta;
            if (q == 0) { Y[(size_t)(r0 + t + u) * 1024 + h * 64 + row] = y; Z[((size_t)ch * 64 + t + u) * 64 + row] = z; }
            upd16_v(su, x.wv, x.kv, x.bv, x.vv, nsu); upd16_nov(sp, x.wv, x.kv, x.bv, x.vv, nsp);
        }
    }
    float* du = PU + (((size_t)ch * 2 + 0) * 64 + row) * 64 + 16 * q; float* dp = PU + (((size_t)ch * 2 + 1) * 64 + row) * 64 + 16 * q;
#pragma unroll
    for (int i = 0; i < 16; i += 4) { *(GAS f32x4*)(du + i) = (f32x4){su[i], su[i + 1], su[i + 2], su[i + 3]}; *(GAS f32x4*)(dp + i) = (f32x4){sp[i], sp[i + 1], sp[i + 2], sp[i + 3]}; }
}
__device__ __forceinline__ void phase_scan1_stream(Ctx& F) {
    LAS int* ctr = (LAS int*)(F.lds + LDSCTL_OFF);
    __syncthreads(); if (F.tid == 0) *ctr = 0; __syncthreads();
    if (F.wave >= 6) { for (int u = F.vcu * 2 + (F.wave - 6); u < DBAT * HA * 32; u += 2 * F.G) sba::attn_sample_unit(F, u >> 5, u & 31, (char*)F.lds + F.wave * 16384); }
    constexpr int NSU = DBAT * HB / 2, NU = NSU + NBATCH * HB * 64;
    const int nunits = F.vcu < NU ? (NU - 1 - F.vcu) / F.G + 1 : 0, ntasks = nunits * 8;
    for (;;) {
        int t = 0; if (F.lane == 0) t = __hip_atomic_fetch_add(ctr, 1, __ATOMIC_RELAXED, __HIP_MEMORY_SCOPE_WORKGROUP);
        t = __builtin_amdgcn_readfirstlane(t); if (t >= ntasks) break;
        const int u = F.vcu + (t >> 3) * F.G, g8 = t & 7;
        if (u < NSU) scan_wave<false, true>(F, u * 2 + (g8 >> 2), 0, g8 & 3);
        else if (g8 < 4) { const int ch = u - NSU; scan_wave_up(F, ch >> 6, ch & 63, g8); }
    }
}
namespace msc {
using sba::bf16x8; using sba::f32x16; using sba::crow; using sba::swap_other;
constexpr int S_AQ = 136, S_BKT = 104, S_L = 40;
constexpr int O_AQ = 0, O_BK = 32 * S_AQ, O_L24 = O_BK, O_TL3 = O_BK + 32 * S_L, O_BKT = 2 * 32 * S_AQ, BLK_BYTES = O_BKT + 64 * S_BKT, O_GL = 4 * BLK_BYTES, O_GP = O_GL + 256, GRP_BYTES = O_GP + 4 * 256;
static_assert(BLK_BYTES % 8 == 0 && 2 * GRP_BYTES <= RING_BYTES, "scan LDS map");
typedef __bf16 nbf2 __attribute__((ext_vector_type(2)));
__device__ __forceinline__ unsigned cvt2(float lo, float hi) { return __builtin_bit_cast(unsigned, __builtin_convertvector((f32x2){lo, hi}, nbf2)); }
__device__ __forceinline__ bf16x8 pack8(float a0, float a1, float a2, float a3, float a4, float a5, float a6, float a7) {
    u32x4 w = {cvt2(a0, a1), cvt2(a2, a3), cvt2(a4, a5), cvt2(a6, a7)}; return *reinterpret_cast<bf16x8*>(&w); }
__device__ __forceinline__ bf16x8 pack_lo(const f32x16& c) { return pack8(c[0], c[1], c[2], c[3], c[4], c[5], c[6], c[7]); }
__device__ __forceinline__ bf16x8 pack_hi(const f32x16& c) { return pack8(c[8], c[9], c[10], c[11], c[12], c[13], c[14], c[15]); }
__device__ __forceinline__ bf16x8 perm_read(const LAS char* img, int row, int pitch, int col0, int g) {
    const LAS char* p = img + row * pitch + (col0 + 4 * g) * 2; const u32x2 lo = *(const LAS u32x2*)p, hi = *(const LAS u32x2*)(p + 16);
    u32x4 w = {lo.x, lo.y, hi.x, hi.y}; return *reinterpret_cast<bf16x8*>(&w); }
__device__ __forceinline__ bf16x8 nat_read(const LAS char* img, int row, int pitch, int col0) {
    const LAS char* p = img + row * pitch + col0 * 2; const u32x2 lo = *(const LAS u32x2*)p, hi = *(const LAS u32x2*)(p + 8);
    u32x4 w = {lo.x, lo.y, hi.x, hi.y}; return *reinterpret_cast<bf16x8*>(&w); }
__device__ __forceinline__ unsigned short bf1(float x) { return (unsigned short)(cvt_pk_bf16(x, 0.f) & 0xffffu); }
struct PrepRegs { float pr[17], pk[17], pv[17], lwl[16]; const bf16* lw; };
__device__ __forceinline__ void prep_load(Ctx& F, PrepRegs& L, int rb, int h) {
    const bf16* pb = WSP(bf16, WS_PBH) + (size_t)rb * 3072 + h * 64 + F.lane; const bf16* lw = WSP(bf16, WS_LWH) + (size_t)rb * 3072 + h * 64 + F.lane;
    L.lw = lw;
#pragma unroll
    for (int t = 0; t < 16; ++t) L.lwl[t] = ldbf_nt(lw + (size_t)t * 3072);
    if ((rb & (SEQ - 1)) != 0) { L.pr[0] = ldbf_nt(pb - 3072); L.pk[0] = ldbf_nt(pb + 1024 - 3072); L.pv[0] = ldbf_nt(pb + 2048 - 3072); } else { L.pr[0] = 0.f; L.pk[0] = 0.f; L.pv[0] = 0.f; }
#pragma unroll
    for (int t = 0; t < 16; ++t) { L.pr[t + 1] = ldbf_nt(pb + (size_t)t * 3072); L.pk[t + 1] = ldbf_nt(pb + (size_t)t * 3072 + 1024); L.pv[t + 1] = ldbf_nt(pb + (size_t)t * 3072 + 2048); }
}
__device__ __forceinline__ void prep_block(Ctx& F, PrepRegs& L, int rb, int h, int j, LAS char* gbase) {
    const int lane = F.lane, n = lane & 31, hi = lane >> 5, col = h * 64 + lane; LAS char* blk = gbase + j * BLK_BYTES;
    float lal[16];
#pragma unroll
    for (int t = 0; t < 16; ++t) lal[t] = ldbf_nt(L.lw + (size_t)t * 3072 + 1024);
    const float* mu = F.in(I_MU); const float mu_r = mu[col], mu_k = mu[1024 + col], mu_v = mu[2048 + col];
    const float w0 = F.in(I_W0)[col], a0 = F.in(I_A0)[col], kkw = F.in(I_KK)[col], kaw = F.in(I_KA)[col], rkw = F.in(I_RK)[col];
    float cw[16];
#pragma unroll
    for (int t = 0; t < 16; ++t) { const float wl = w0 + L.lwl[t], wlog = -softplusf_(-wl) - 0.5f; cw[t] = __expf(-__expf(wlog)); }
#pragma unroll
    for (int t = 1; t < 16; ++t) cw[t] *= cw[t - 1];
    *(LAS float*)(gbase + O_GP + (j * 64 + lane) * 4) = cw[15];
    __syncthreads();
    const float g0 = *(const LAS float*)(gbase + O_GP + lane * 4), g1 = *(const LAS float*)(gbase + O_GP + (64 + lane) * 4), g2 = *(const LAS float*)(gbase + O_GP + (128 + lane) * 4);
    const float G0 = (j > 0 ? g0 : 1.f) * (j > 1 ? g1 : 1.f) * (j > 2 ? g2 : 1.f);
    if (j == 3) *(LAS float*)(gbase + O_GL + lane * 4) = G0 * cw[15];
    float* SCL = WSP(float, WS_SCL) + ((size_t)rb * HB + h) * 4;
#pragma unroll
    for (int tl = 0; tl < 16; tl += 2) {
        float nb[2], kt[2], vz[2];
#pragma unroll
        for (int u = 0; u < 2; ++u) { const int t = tl + u;
            const float zr = L.pr[t + 1] + mu_r * (L.pr[t] - L.pr[t + 1]), zk = L.pk[t + 1] + mu_k * (L.pk[t] - L.pk[t + 1]); vz[u] = L.pv[t + 1] + mu_v * (L.pv[t] - L.pv[t + 1]);
            const float a_ = sigmoidf_(a0 + lal[t]);
            const float kkr = zk * kkw, kk = kkr * rsqrtf(wave_sum(kkr * kkr) + 1e-12f);
            const float k = zk * (1.f + (a_ - 1.f) * kaw), bb = kk * a_;
            const float bonus = wave_sum(zr * k * rkw);
            if (lane == 0) SCL[(size_t)t * HB * 4 + 2] = bonus;
            const float Gp = t ? G0 * cw[t ? t - 1 : 0] : G0, G = G0 * cw[t], gi = 1.f / G;
            const float a = kk * Gp, q = zr * G, bt = bb * gi; kt[u] = k * gi; nb[u] = -bt;
            *(LAS unsigned short*)(blk + O_AQ + t * S_AQ + lane * 2) = bf1(a); *(LAS unsigned short*)(blk + O_AQ + (16 + t) * S_AQ + lane * 2) = bf1(q);
            *(LAS unsigned short*)(blk + O_BK + t * S_AQ + lane * 2) = bf1(bt); *(LAS unsigned short*)(blk + O_BK + (16 + t) * S_AQ + lane * 2) = bf1(kt[u]); }
        *(LAS unsigned*)(blk + O_BKT + lane * S_BKT + tl * 2) = cvt_pk_bf16(nb[0], nb[1]); *(LAS unsigned*)(blk + O_BKT + lane * S_BKT + (16 + tl) * 2) = cvt_pk_bf16(kt[0], kt[1]);
        *(LAS unsigned*)(blk + O_BKT + lane * S_BKT + (32 + tl) * 2) = cvt_pk_bf16(vz[0], vz[1]);
    }
    LDS_WAIT(); asm volatile("" ::: "memory");
    f32x16 mt = f32x16{};
#pragma unroll
    for (int ks = 0; ks < 4; ++ks) mt = __builtin_amdgcn_mfma_f32_32x32x16_bf16(nat_read(blk + O_AQ, n, S_AQ, 16 * ks + 8 * hi), nat_read(blk + O_BK, n, S_AQ, 16 * ks + 8 * hi), mt, 0, 0, 0);
    float l1[8];
    const int i = n & 15;
#pragma unroll
    for (int r = 0; r < 16; ++r) { const int t = crow(r, hi) & 15; float val = mt[r];
        if (r < 8) { val = t > i ? val : 0.f; if (n >= 16) *(LAS unsigned short*)(blk + O_L24 + t * S_L + i * 2) = bf1(val); l1[r] = val; }
        else { val = t >= i ? val : 0.f; if (n >= 16) *(LAS unsigned short*)(blk + O_L24 + (16 + t) * S_L + i * 2) = bf1(val); else *(LAS unsigned short*)(blk + O_TL3 + (16 + t) * S_L + i * 2) = bf1(-val); } }
    float rowv[16];
#pragma unroll
    for (int r = 0; r < 8; ++r) { const float own = l1[r], oth = swap_other(own, hi); const int p0 = (r & 3) + 8 * (r >> 2); rowv[p0] = hi ? oth : own; rowv[p0 + 4] = hi ? own : oth; }
    float tl_[16];
    tl_[0] = lane == 0 ? 1.f : 0.f;
#pragma unroll
    for (int t = 1; t < 16; ++t) { float acc = lane == t ? 1.f : 0.f;
#pragma unroll
        for (int jj = 0; jj < t; ++jj) acc -= readlane_f(rowv[t], jj) * tl_[jj];
        tl_[t] = acc; }
    if (lane < 16) {
#pragma unroll
        for (int t = 0; t < 16; ++t) *(LAS unsigned short*)(blk + O_TL3 + t * S_L + lane * 2) = bf1(tl_[t]); }
    LDS_WAIT(); asm volatile("" ::: "memory");
}
__device__ __forceinline__ void chain(Ctx& F, int bh, int c, int isP, int half, const LAS char* gbase) {
    const int lane = F.lane, n = lane & 31, hi = lane >> 5, rowg = 32 * half + n, h = bh & 15, b = bh >> 4, r0 = b * SEQ + c * 64, ch = bh * 64 + c;
    const float* RWV = WSP(float, WS_RWV);
    f32x16 st0 = f32x16{}, st1 = f32x16{};
    if (isP) {
#pragma unroll
        for (int r = 0; r < 16; ++r) { st0[r] = crow(r, hi) == rowg ? 1.f : 0.f; st1[r] = 32 + crow(r, hi) == rowg ? 1.f : 0.f; } }
    for (int blk_i = 0; blk_i < 4; ++blk_i) {
        const LAS char* blk = gbase + blk_i * BLK_BYTES;
        f32x16 wt = f32x16{};
        wt = __builtin_amdgcn_mfma_f32_32x32x16_bf16(perm_read(blk + O_AQ, n, S_AQ, 0, hi), pack_lo(st0), wt, 0, 0, 0);
        wt = __builtin_amdgcn_mfma_f32_32x32x16_bf16(perm_read(blk + O_AQ, n, S_AQ, 16, hi), pack_hi(st0), wt, 0, 0, 0);
        wt = __builtin_amdgcn_mfma_f32_32x32x16_bf16(perm_read(blk + O_AQ, n, S_AQ, 32, hi), pack_lo(st1), wt, 0, 0, 0);
        wt = __builtin_amdgcn_mfma_f32_32x32x16_bf16(perm_read(blk + O_AQ, n, S_AQ, 48, hi), pack_hi(st1), wt, 0, 0, 0);
        bf16x8 bV = bf16x8{};
        if (!isP) { bV = perm_read(blk + O_BKT, rowg, S_BKT, 32, hi);
            wt = __builtin_amdgcn_mfma_f32_32x32x16_bf16(perm_read(blk + O_L24, n, S_L, 0, hi), bV, wt, 0, 0, 0); }
        const bf16x8 tl3 = perm_read(blk + O_TL3, n, S_L, 0, hi);
        const bf16x8 a_tl = n < 16 ? tl3 : bf16x8{}, a_l3 = n >= 16 ? tl3 : bf16x8{};
        const f32x16 sg = __builtin_amdgcn_mfma_f32_32x32x16_bf16(a_tl, pack_lo(wt), f32x16{}, 0, 0, 0);
        const bf16x8 bSg = pack_lo(sg);
        const f32x16 yy = __builtin_amdgcn_mfma_f32_32x32x16_bf16(a_l3, bSg, wt, 0, 0, 0);
#pragma unroll
        for (int r = 8; r < 16; ++r) { const int t = blk_i * 16 + (r & 3) + 8 * ((r - 8) >> 2) + 4 * hi;
            if (isP) WSP(float, WS_Z)[((size_t)ch * 64 + t) * 64 + rowg] = yy[r]; else WSP(float, WS_Y)[(size_t)(r0 + t) * 1024 + h * 64 + rowg] = yy[r]; }
        st0 = __builtin_amdgcn_mfma_f32_32x32x16_bf16(perm_read(blk + O_BKT, n, S_BKT, 0, hi), bSg, st0, 0, 0, 0);
        st1 = __builtin_amdgcn_mfma_f32_32x32x16_bf16(perm_read(blk + O_BKT, 32 + n, S_BKT, 0, hi), bSg, st1, 0, 0, 0);
        if (!isP) { st0 = __builtin_amdgcn_mfma_f32_32x32x16_bf16(perm_read(blk + O_BKT, n, S_BKT, 16, hi), bV, st0, 0, 0, 0);
                    st1 = __builtin_amdgcn_mfma_f32_32x32x16_bf16(perm_read(blk + O_BKT, 32 + n, S_BKT, 16, hi), bV, st1, 0, 0, 0); }
    }
    const LAS float* GL = (const LAS float*)(gbase + O_GL); float* dst = WSP(float, WS_PU) + (((size_t)ch * 2 + isP) * 64 + rowg) * 64;
#pragma unroll
    for (int g4 = 0; g4 < 4; ++g4) { const int k0 = 8 * g4 + 4 * hi; const f32x4 ga = *(const LAS f32x4*)(GL + k0), gb = *(const LAS f32x4*)(GL + 32 + k0);
        *(GAS f32x4*)(dst + k0) = (f32x4){st0[4 * g4] * ga.x, st0[4 * g4 + 1] * ga.y, st0[4 * g4 + 2] * ga.z, st0[4 * g4 + 3] * ga.w};
        *(GAS f32x4*)(dst + 32 + k0) = (f32x4){st1[4 * g4] * gb.x, st1[4 * g4 + 1] * gb.y, st1[4 * g4 + 2] * gb.z, st1[4 * g4 + 3] * gb.w}; }
}
}
__device__ __forceinline__ void phase_sample_stream(Ctx& F) {
    for (int u = F.vcu * NWAVES + F.wave; u < DBAT * HA * 32; u += NWAVES * F.G) sba::attn_sample_unit(F, (u >> 8) * HA + (u & 7), (u >> 3) & 31, (char*)F.lds + F.wave * 16384);
}
__device__ __forceinline__ void phase_scan1_mfma(Ctx& F) {
    __syncthreads();
    const int grp = F.wave >> 2, wq = F.wave & 3; LAS char* gbase = (LAS char*)F.lds + grp * msc::GRP_BYTES;
    msc::PrepRegs L;
    { const int ch = 2 * F.vcu + grp; if (ch < NBATCH * HB * 64) msc::prep_load(F, L, (ch >> 10) * SEQ + (ch & 63) * 64 + 16 * wq, (ch >> 6) & 15); }
    for (int base = 2 * F.vcu; base < NBATCH * HB * 64; base += 2 * F.G) {
        const int ch = base + grp, bh = ch >> 6, c = ch & 63;
        msc::prep_block(F, L, (bh >> 4) * SEQ + c * 64 + 16 * wq, bh & 15, wq, gbase);
        __syncthreads();
        { const int chn = ch + 2 * F.G; if (chn < NBATCH * HB * 64) msc::prep_load(F, L, (chn >> 10) * SEQ + (chn & 63) * 64 + 16 * wq, (chn >> 6) & 15); }
        msc::chain(F, bh, c, wq >> 1, wq & 1, gbase);
    }
}
__device__ __forceinline__ void phase_scan2(Ctx& F) {
    LAS float* Pb = (LAS float*)(F.lds + 4096);
    const float* PU = WSP(float, WS_PU); float* SC = WSP(float, WS_SC);
    for (int unit = F.vcu; unit < NBATCH * HB * 8; unit += F.G) {
        const int bh = unit >> 3, r0 = (unit & 7) * 8, r = F.wave, col = F.lane;
        __syncthreads();
        { const float* P0 = PU + ((size_t)(bh * 64) * 2 + 1) * 4096; const f32x4 a = *(const GAS f32x4*)(P0 + F.tid * 4), bq = *(const GAS f32x4*)(P0 + 2048 + F.tid * 4);
          *(LAS f32x4*)(Pb + F.tid * 4) = a; *(LAS f32x4*)(Pb + 2048 + F.tid * 4) = bq; }
        float ucur = PU[((size_t)(bh * 64) * 2 + 0) * 4096 + (r0 + r) * 64 + col], scur = 0.f;
        __syncthreads();
        for (int c = 0; c < 64; ++c) {
            const int ch = bh * 64 + c; LAS float* Pc = Pb + (c & 1) * 4096;
            SC[((size_t)ch * 64 + r0 + r) * 64 + col] = scur;
            f32x4 pa = {0.f, 0.f, 0.f, 0.f}, pq = {0.f, 0.f, 0.f, 0.f}; float unext = 0.f;
            if (c + 1 < 64) { const float* Pn = PU + ((size_t)(ch + 1) * 2 + 1) * 4096; pa = *(const GAS f32x4*)(Pn + F.tid * 4); pq = *(const GAS f32x4*)(Pn + 2048 + F.tid * 4);
                unext = PU[((size_t)(ch + 1) * 2 + 0) * 4096 + (r0 + r) * 64 + col]; }
            float a0 = ucur, a1 = 0.f, a2 = 0.f, a3 = 0.f;
#pragma unroll
            for (int j = 0; j < 64; j += 4) {
                const float s0 = readlane_f(scur, j), s1 = readlane_f(scur, j + 1), s2 = readlane_f(scur, j + 2), s3 = readlane_f(scur, j + 3);
                a0 += s0 * Pc[(j + 0) * 64 + col]; a1 += s1 * Pc[(j + 1) * 64 + col]; a2 += s2 * Pc[(j + 2) * 64 + col]; a3 += s3 * Pc[(j + 3) * 64 + col]; }
            const float acc = (a0 + a1) + (a2 + a3);
            if (c + 1 < 64) { LAS float* Pn = Pb + ((c + 1) & 1) * 4096; *(LAS f32x4*)(Pn + F.tid * 4) = pa; *(LAS f32x4*)(Pn + 2048 + F.tid * 4) = pq; }
            __syncthreads();
            scur = acc; ucur = unext;
        }
        F.outp()[O_WKVP + ((size_t)bh * 64 + r0 + r) * 64 + col] = scur;
    }
}
__device__ __forceinline__ void phase_scan3(Ctx& F) {
    const int gw = F.vcu * NWAVES + F.wave, NGW = F.G * NWAVES, lane = F.lane, q = lane >> 4, m = lane & 15;
    const float* SC = WSP(float, WS_SC); const float* Z = WSP(float, WS_Z); float* Y = WSP(float, WS_YC);
    for (int task = gw; task < NBATCH * HB * 63 * 4; task += NGW) {
        const int g = task & 3, cc = task >> 2, bh = cc / 63, c = 1 + (cc - bh * 63), ch = bh * 64 + c, h = bh & 15, b = bh >> 4, row = 16 * g + m;
        const float* st = SC + ((size_t)ch * 64 + row) * 64 + 16 * q; float s[16];
#pragma unroll
        for (int i = 0; i < 16; i += 4) { const f32x4 v = *(const GAS f32x4*)(st + i); s[i] = v.x; s[i + 1] = v.y; s[i + 2] = v.z; s[i + 3] = v.w; }
        const float* zp = Z + (size_t)ch * 4096 + lane; float* yp = Y + (size_t)(b * SEQ + c * 64) * 1024 + h * 64 + row;
        float zb[4];
#pragma unroll
        for (int u = 0; u < 4; ++u) zb[u] = zp[u * 64];
        for (int t = 0; t < 64; t += 4) {
#pragma unroll
            for (int u = 0; u < 4; ++u) {
                const float zv = zb[u]; if (t + u + 4 < 64) zb[u] = zp[(t + u + 4) * 64];
                float acc = 0.f; dot16(acc, zv, s); acc = xrow16_sum(acc);
                if (q == 0) yp[(size_t)(t + u) * 1024] = acc;
            }
        }
    }
}
__device__ __forceinline__ float sum32(float v) {
    v += dpp_f<0xB1>(v); v += dpp_f<0x4E>(v); v += dpp_f<0x141>(v); v += dpp_f<0x140>(v);
    auto s = __builtin_amdgcn_permlane16_swap(__float_as_uint(v), __float_as_uint(v), false, false);
    return __uint_as_float(s[0]) + __uint_as_float(s[1]);
}
__device__ __forceinline__ sba::bf16x8 ld8_bf16(const float* p) { const f32x4 a = *(const GAS f32x4*)p, b = *(const GAS f32x4*)(p + 4); return msc::pack8(a.x, a.y, a.z, a.w, b.x, b.y, b.z, b.w); }
__device__ __forceinline__ void phase_scan3_post(Ctx& F) {
    const int gw = F.vcu * NWAVES + F.wave, NGW = F.G * NWAVES, lane = F.lane, n = lane & 31, hi = lane >> 5;
    const float* SC = WSP(float, WS_SC); const float* Z = WSP(float, WS_Z); const float* Y = WSP(float, WS_Y); const bf16* LWH = WSP(bf16, WS_LWH); const bf16* PBH = WSP(bf16, WS_PBH);
    const float* SCL = WSP(float, WS_SCL); bf16* OAB = WSP(bf16, WS_OAB);
    for (int ch = gw; ch < NBATCH * HB * 64; ch += NGW) {
        const int bh = ch >> 6, c = ch & 63, h = bh & 15, b = bh >> 4, r0 = b * SEQ + c * 64, col0 = h * 64 + n;
        const float lg0 = F.in(I_LNG)[col0], lg1 = F.in(I_LNG)[col0 + 32], lb0 = F.in(I_LNB)[col0], lb1 = F.in(I_LNB)[col0 + 32], mv0 = F.in(I_MU)[2048 + col0], mv1 = F.in(I_MU)[2048 + col0 + 32];
        sba::bf16x8 sb0[4], sb1[4];
        if (c > 0) { const float* Sp = SC + (size_t)ch * 4096 + n * 64 + 8 * hi;
#pragma unroll
            for (int ks = 0; ks < 4; ++ks) { sb0[ks] = ld8_bf16(Sp + 16 * ks); sb1[ks] = ld8_bf16(Sp + 32 * 64 + 16 * ks); } }
        else {
#pragma unroll
            for (int ks = 0; ks < 4; ++ks) { sb0[ks] = sba::bf16x8{}; sb1[ks] = sba::bf16x8{}; } }
        for (int tt = 0; tt < 2; ++tt) {
            sba::f32x16 a0 = sba::f32x16{}, a1 = sba::f32x16{};
            if (c > 0) { const float* Zp = Z + (size_t)ch * 4096 + (32 * tt + n) * 64 + 8 * hi;
#pragma unroll
                for (int ks = 0; ks < 4; ++ks) { const sba::bf16x8 za = ld8_bf16(Zp + 16 * ks);
                    a0 = __builtin_amdgcn_mfma_f32_32x32x16_bf16(za, sb0[ks], a0, 0, 0, 0); a1 = __builtin_amdgcn_mfma_f32_32x32x16_bf16(za, sb1[ks], a1, 0, 0, 0); } }
#pragma unroll
            for (int rg = 0; rg < 16; rg += 4) {
                float y0[4], y1[4], g0[4], g1[4], p0[4], p1[4], q0[4], q1[4], bn[4];
#pragma unroll
                for (int i = 0; i < 4; ++i) { const int t = 32 * tt + sba::crow(rg + i, hi), r = r0 + t;
                    y0[i] = Y[(size_t)r * 1024 + col0]; y1[i] = Y[(size_t)r * 1024 + col0 + 32];
                    g0[i] = ldbf(LWH + (size_t)r * 3072 + 2048 + col0); g1[i] = ldbf(LWH + (size_t)r * 3072 + 2048 + col0 + 32);
                    const bf16* pb = PBH + (size_t)r * 3072 + 2048 + col0; p0[i] = ldbf(pb); p1[i] = ldbf(pb + 32);
                    const bool hp = (r & (SEQ - 1)) != 0; q0[i] = hp ? ldbf(pb - 3072) : 0.f; q1[i] = hp ? ldbf(pb + 32 - 3072) : 0.f;
                    bn[i] = SCL[((size_t)r * HB + h) * 4 + 2]; }
#pragma unroll
                for (int i = 0; i < 4; ++i) { const int t = 32 * tt + sba::crow(rg + i, hi), r = r0 + t;
                    const float v0 = y0[i] + a0[rg + i], v1 = y1[i] + a1[rg + i];
                    const float mean = sum32(v0 + v1) * (1.f / 64.f), d0 = v0 - mean, d1 = v1 - mean, var = sum32(d0 * d0 + d1 * d1) * (1.f / 64.f), rs = rsqrtf(var + EPS_LNX);
                    const float zv0 = p0[i] + mv0 * (q0[i] - p0[i]), zv1 = p1[i] + mv1 * (q1[i] - p1[i]);
                    const float o0 = (d0 * rs * lg0 + lb0 + bn[i] * zv0) * g0[i], o1 = (d1 * rs * lg1 + lb1 + bn[i] * zv1) * g1[i];
                    const float o0n = dpp_f<0xB1>(o0), o1n = dpp_f<0xB1>(o1);
                    if ((lane & 1) == 0) { *(GAS unsigned*)(OAB + (size_t)r * DM + 1024 + col0) = cvt_pk_bf16(o0, o0n); *(GAS unsigned*)(OAB + (size_t)r * DM + 1024 + col0 + 32) = cvt_pk_bf16(o1, o1n); } }
            }
        }
    }
}
__device__ __forceinline__ void phase_postscan(Ctx& F) {
    const int gw = F.vcu * NWAVES + F.wave, NGW = F.G * NWAVES;
    const float* Y = WSP(float, WS_Y); const float* RWV = WSP(float, WS_RWV); const float* SCL = WSP(float, WS_SCL); const float* LWO = WSP(float, WS_LWO); const float* Pp = WSP(float, WS_P); bf16* OAB = WSP(bf16, WS_OAB);
    for (int u = NPR * 4 + gw; u < NTOK * 4; u += NGW) {
        const int r = u >> 2, hq = u & 3; const bool corr = false;
        float yv[4], gv[4], vv[4], bn[4];
#pragma unroll
        for (int i = 0; i < 4; ++i) { const int h = hq * 4 + i, col = h * 64 + F.lane;
            yv[i] = Y[(size_t)r * 1024 + col]; if (corr) yv[i] += WSP(float, WS_YC)[(size_t)r * 1024 + col];
            gv[i] = LWO[(size_t)r * 3072 + 2048 + col]; bn[i] = SCL[((size_t)r * HB + h) * 4 + 2];
            vv[i] = RWV[((size_t)r * HB + h) * 512 + 320 + F.lane]; }
#pragma unroll
        for (int i = 0; i < 4; ++i) { const int h = hq * 4 + i, col = h * 64 + F.lane;
            const float mean = wave_sum(yv[i]) * (1.f / 64.f), d = yv[i] - mean, var = wave_sum(d * d) * (1.f / 64.f);
            const float yn = d * rsqrtf(var + EPS_LNX) * F.in(I_LNG)[col] + F.in(I_LNB)[col] + bn[i] * vv[i];
            const float o = yn * gv[i];
            const float o1 = dpp_f<0xB1>(o);
            if ((F.lane & 1) == 0) *(GAS unsigned*)(OAB + (size_t)r * DM + 1024 + col) = cvt_pk_bf16(o, o1); }
    }
    sample_combine(F);
    const float* OP = WSP(float, WS_OP); const float* CL = WSP(float, WS_CL);
    for (size_t i = (size_t)F.vcu * NTHR + F.tid; i < (size_t)NPR * 256; i += (size_t)F.G * NTHR) {
        const int r = (int)(i >> 8), c4 = (int)(i & 255) * 4, h = c4 >> 7;
        const f32x4 a = *(const GAS f32x4*)(OP + (size_t)r * 1024 + c4), e = *(const GAS f32x4*)(OP + ((size_t)NPR + r) * 1024 + c4); const float cl = CL[(size_t)r * HA + h];
        const f32x4 o = a + e * cl; u32x2 w; w.x = cvt_pk_bf16(o.x, o.y); w.y = cvt_pk_bf16(o.z, o.w);
        *(GAS u32x2*)(OAB + (size_t)r * DM + c4) = w;
    }
}
__device__ __forceinline__ void phase_usample(Ctx& F) {
    const float* PU_ = WSP(float, WS_PARTU); bf16* U = WSP(bf16, WS_U);
    for (int i = F.vcu * NTHR + F.tid; i < NSM * DFF / 4; i += F.G * NTHR) { const int r = i / (DFF / 4), c4 = (i - r * (DFF / 4)) * 4;
        f32x4 a = *(const GAS f32x4*)(PU_ + (size_t)r * DFF + c4);
#pragma unroll
        for (int kc = 1; kc < 8; ++kc) a += *(const GAS f32x4*)(PU_ + ((size_t)kc * 64 + r) * DFF + c4);
        const float x0 = fmaxf(a.x, 0.f), x1 = fmaxf(a.y, 0.f), x2 = fmaxf(a.z, 0.f), x3 = fmaxf(a.w, 0.f);
        u32x2 w; w.x = cvt_pk_bf16(x0 * x0, x1 * x1); w.y = cvt_pk_bf16(x2 * x2, x3 * x3);
        *(GAS u32x2*)(U + (size_t)(NPR + r) * DFF + c4) = w; }
}
#ifndef MK_SPLIT
#define MK_SPLIT 0
#endif
constexpr int NPHASE = 21;
struct Args { const void* in[N_IN]; float* out; unsigned char* ws; int ph_lo, ph_hi; };
__global__ void __launch_bounds__(NTHR, 2) mega_fwd(Args args) {
    extern __shared__ __attribute__((aligned(16))) unsigned char lds_raw[];
    Ctx F;
    F.lds = (LAS unsigned char*)lds_raw; F.tid = threadIdx.x; F.lane = F.tid & 63; F.wave = __builtin_amdgcn_readfirstlane(F.tid >> 6);
    F.G = gridDim.x; { const int bx = blockIdx.x; F.vcu = (F.G % 8 == 0) ? (bx % 8) * (F.G / 8) + bx / 8 : bx; }
    for (int u = F.tid; u < (LDS_BYTES - LDSCTL_OFF) / 4; u += NTHR) ((LAS unsigned*)(F.lds + LDSCTL_OFF))[u] = 0u;
    __syncthreads();
    unsigned* ctl = (unsigned*)(args.ws + WS_CTL);
    XcdBarrier bar; bar.bar = ctl + CW_BAR; bar.x = 0; bar.st = nullptr;
    if (!MK_SPLIT) bar = xcd_barrier_post(ctl + CW_BAR, (volatile LAS unsigned*)(F.lds + MISC_OFF) + 8);
    const int lo = args.ph_lo, hi = args.ph_hi;
#define IN(k) (lo <= (k) && (k) < hi)
#define SEAM(k) do { if (IN(k) && IN((k) + 1)) xcd_barrier(bar); } while (0)
    if (IN(0)) { phase_prologue(F); } SEAM(0);
    if (IN(1)) { phase_mod0(F); } SEAM(1);
    if (IN(2)) { const bool hide = F.G > NCVT + 8; const int ng = hide ? F.G - NCVT : F.G;
        if ((int)blockIdx.x < ng) { pg8::Gemm g{WSP(bf16, WS_H), WSP(bf16, WS_WIN), MP, INPAD, DM, DM, DM}; pg8::StaticOrder S; S.init(MP, INPAD, ng, (int)blockIdx.x); EpiIn E{WSP(bf16, WS_QB), WSP(bf16, WS_KB), WSP(bf16, WS_VB), WSP(float, WS_P), F.outp(), WSP(bf16, WS_PBH)};
            pg8::gemm_phase<EpiIn, pg8::StaticOrder, true, true>(F.lds, g, S, E); }
        else convert_run(F, IT_IN + ((int)blockIdx.x - ng) * NWAVES + F.wave, NCVT * NWAVES, IT_IN + N_HIDE, (LAS float*)(F.lds + F.wave * 16384)); } SEAM(2);
    if (IN(3)) { phase_kv_prep(F); } SEAM(3);
    if (IN(4)) { pg8::Gemm g{WSP(bf16, WS_LA), WSP(bf16, WS_LWT), MP, 3072, 512, 512, 512}; pg8::LoraOrder S; S.init(MP, 3072, F.G, (int)blockIdx.x); pg8::EpiLora E{WSP(float, WS_LWO), WSP(bf16, WS_LWH), 3072};
        pg8::gemm_phase<pg8::EpiLora, pg8::LoraOrder, true, true>(F.lds, g, S, E); } SEAM(4);
    if (IN(6)) { phase_rwkv_prep(F);
        const bool stream_first = (F.vcu & 1) != 0;
        if (stream_first) phase_sample_stream(F); else phase_scan1_mfma(F);
        __syncthreads();
        phase_attn_prompt(F);
        if (!stream_first) phase_sample_stream(F); else phase_scan1_mfma(F); } SEAM(7);
    if (IN(8)) {
        if (F.wave < 2) for (int t = F.vcu * 2 + F.wave; t < DBAT * HB * 4; t += 2 * F.G) scan_wave<false, true>(F, t >> 2, 0, t & 3);
        phase_scan2(F); } SEAM(8);
    if (IN(10)) { phase_scan3_post(F); phase_postscan(F); } SEAM(10);
    if (IN(11)) { pg8::Gemm g{WSP(bf16, WS_OAB), WSP(bf16, WS_WOUT), MP, DM, DM, DM, DM}; pg8::MixOrder<false> S; S.init(DM, DM, F.G, (int)blockIdx.x); pg8::EpiF32S<64> E{WSP(bf16, WS_OUT), DM, nullptr, WSP(float, WS_PART)};
        pg8::gemm_phase<pg8::EpiF32S<64>, pg8::MixOrder<false>, true, true>(F.lds, g, S, E); } SEAM(11);
    if (IN(12)) { phase_postmix<0>(F); } SEAM(12);
    if (IN(13)) { pg8::Gemm g{WSP(bf16, WS_H), WSP(bf16, WS_W1), MP, DFF, DM, DM, DM}; pg8::MixOrder<false> S; S.init(DFF, DM, F.G, (int)blockIdx.x); pg8::EpiRelu2 E{WSP(bf16, WS_U), DFF, WSP(float, WS_PARTU)};
        pg8::gemm_phase<pg8::EpiRelu2, pg8::MixOrder<false>, true, true>(F.lds, g, S, E); } SEAM(13);
    if (IN(14)) { phase_usample(F); if (!MK_SPLIT) xcd_barrier(bar); pg8::Gemm g{WSP(bf16, WS_U), WSP(bf16, WS_W2), MP, DM, DFF, DFF, DFF}; pg8::MixOrder<false> S; S.init(DM, DFF, F.G, (int)blockIdx.x); pg8::EpiF32S<64> E{WSP(bf16, WS_OUT), DM, nullptr, WSP(float, WS_PART)};
        pg8::gemm_phase<pg8::EpiF32S<64>, pg8::MixOrder<false>, true, true>(F.lds, g, S, E); } SEAM(14);
    if (IN(15)) { phase_postmlp<0>(F); } SEAM(15);
    if (IN(16)) { pg8::Gemm g{WSP(bf16, WS_H), WSP(bf16, WS_WPOOL), MP, DM, DM, DM, DM}; pg8::MixOrder<true> S; S.init(DM, DM, F.G, (int)blockIdx.x); pg8::EpiF32S<256> E{WSP(bf16, WS_OUT), DM, F.in(I_PSC), WSP(float, WS_PART)};
        pg8::gemm_phase<pg8::EpiF32S<256>, pg8::MixOrder<true>, true, true>(F.lds, g, S, E); } SEAM(16);
    if (IN(17)) { phase_postmix<1>(F); } SEAM(17);
    if (IN(18)) { pg8::Gemm g{WSP(bf16, WS_H), WSP(bf16, WS_W1) + (size_t)DFF * DM, MP, DFF, DM, DM, DM}; pg8::MixOrder<false> S; S.init(DFF, DM, F.G, (int)blockIdx.x); pg8::EpiRelu2 E{WSP(bf16, WS_U), DFF, WSP(float, WS_PARTU)};
        pg8::gemm_phase<pg8::EpiRelu2, pg8::MixOrder<false>, true, true>(F.lds, g, S, E); } SEAM(18);
    if (IN(19)) { phase_usample(F); if (!MK_SPLIT) xcd_barrier(bar); pg8::Gemm g{WSP(bf16, WS_U), WSP(bf16, WS_W2) + (size_t)DM * DFF, MP, DM, DFF, DFF, DFF}; pg8::MixOrder<false> S; S.init(DM, DFF, F.G, (int)blockIdx.x); pg8::EpiF32S<64> E{WSP(bf16, WS_OUT), DM, nullptr, WSP(float, WS_PART)};
        pg8::gemm_phase<pg8::EpiF32S<64>, pg8::MixOrder<false>, true, true>(F.lds, g, S, E); } SEAM(19);
    if (IN(20)) { phase_postmlp<1>(F); }
#undef IN
#undef SEAM
}

extern "C" void kernel_launch(void* const* d_in, const int* in_sizes, int n_in, void* d_out, int out_size, void* d_ws, size_t ws_size, hipStream_t stream) {
    static int grid = 0;
    if (grid == 0) {
        if (n_in != N_IN || (size_t)out_size != O_END || ws_size < WS_END) { fprintf(stderr, "kernel_launch: unexpected shapes: n_in %d out %d ws %zu (want %d, %zu, >= %zu)\n", n_in, out_size, ws_size, (int)N_IN, (size_t)O_END, (size_t)WS_END); grid = -1; return; }
        int dev = 0, cus = 0, per_cu = 0;
        if (hipGetDevice(&dev) != hipSuccess || hipDeviceGetAttribute(&cus, hipDeviceAttributeMultiprocessorCount, dev) != hipSuccess) { grid = -1; return; }
        if (hipFuncSetAttribute((const void*)mega_fwd, hipFuncAttributeMaxDynamicSharedMemorySize, LDS_BYTES) != hipSuccess) { fprintf(stderr, "kernel_launch: hipFuncSetAttribute failed\n"); grid = -1; return; }
        if (hipOccupancyMaxActiveBlocksPerMultiprocessor(&per_cu, (const void*)mega_fwd, NTHR, LDS_BYTES) != hipSuccess || per_cu < 1) fprintf(stderr, "kernel_launch: occupancy query reports %d blocks per CU\n", per_cu);
        (void)hipGetLastError();
        grid = cus;
    }
    if (grid < 0) return;
    hipMemsetAsync((char*)d_ws + WS_CTL, 0, CTL_ZERO_BYTES, stream);
    Args a{};
    for (int i = 0; i < N_IN; ++i) a.in[i] = d_in[i];
    a.out = (float*)d_out; a.ws = (unsigned char*)d_ws;
#if MK_SPLIT
    for (int p = 0; p < NPHASE; ++p) { a.ph_lo = p; a.ph_hi = p + 1; hipLaunchKernelGGL(mega_fwd, dim3(grid), dim3(NTHR), LDS_BYTES, stream, a); }
#else
    a.ph_lo = 0; a.ph_hi = NPHASE;
    hipLaunchKernelGGL(mega_fwd, dim3(grid), dim3(NTHR), LDS_BYTES, stream, a);
#endif
    const hipError_t le = hipPeekAtLastError();
    if (le != hipSuccess) fprintf(stderr, "kernel_launch: launch failed: %s\n", hipGetErrorName(le));
}
```

```cpp
#include <hip/hip_runtime.h>
#include <cstdio>
#include <cstdint>
namespace pg8 {
#define PG8_LAS __attribute__((address_space(3)))
typedef unsigned short bf16_t;
typedef short bf16x8 __attribute__((ext_vector_type(8)));
typedef float f32x4 __attribute__((ext_vector_type(4)));
typedef unsigned u32x4 __attribute__((ext_vector_type(4)));
constexpr int BM = 256, BK = 64, HALF = 128, HTB = HALF * BK * 2  , STAGE_BYTES = 8 * HTB, NXCD = 8, WGM = 8;

__host__ __device__ __forceinline__ int lds_byte(int r, int c) { const int st = (r >> 4) * 2 + (c >> 5), rr = r & 15, cc = c & 31, ob = rr * 64 + cc * 2; return st * 1024 + (ob ^ (((ob >> 9) & 1) << 5)); }
__host__ __device__ __forceinline__ void stage_rc(int b, int& R, int& C) { const int st = b / 1024, sb = b % 1024, swz = sb ^ (((sb >> 9) & 1) << 5); R = (st >> 1) * 16 + swz / 64; C = (st & 1) * 32 + (swz % 64) / 2; }
__host__ __device__ __forceinline__ int perm32(int rho) { const int n = rho >> 4, i = rho & 15; return 8 * (i >> 2) + 4 * n + (i & 3); }

struct Unit { int pm, pn, kc; };
struct Gemm { const bf16_t* A; const bf16_t* Bt; int M, N, K, lda, ldb; };

struct StaticOrder {
    int nM, nN, nwg, G, c;
    __host__ __device__ void init(int M, int N, int G_, int c_) { nM = M / BM; nN = N / BM; nwg = nM * nN; G = G_; c = c_; }
    __host__ __device__ bool next(int i, Unit& u) const {
        const long L = (long)i * G + c; if (L >= nwg) return false;
        int wgid = (int)L; { const int q = nwg / NXCD, r = nwg % NXCD, xcd = wgid % NXCD, off = wgid / NXCD; wgid = (xcd < r ? xcd * (q + 1) : r * (q + 1) + (xcd - r) * q) + off; }
        const int nig = WGM * nN, gid = wgid / nig, fm = gid * WGM, gsz = (nM - fm) < WGM ? (nM - fm) : WGM;
        u.pm = fm + ((wgid % nig) % gsz); u.pn = (wgid % nig) / gsz; u.kc = -1; return true;
    }
    __device__ __forceinline__ int nt(const Unit&, const Gemm& g) const { return g.K / BK; }
    __device__ __forceinline__ void a_ready(const Unit&) const {}
    __device__ __forceinline__ void done(const Unit&) const {}
    __device__ __forceinline__ size_t a_off(const Unit& u, const Gemm& g) const { return (size_t)u.pm * BM * g.lda * 2; }
    __device__ __forceinline__ size_t b_off(const Unit& u, const Gemm& g) const { return (size_t)u.pn * BM * g.ldb * 2; }
};
struct LoraOrder : StaticOrder {
    __device__ __forceinline__ int k0(const Unit& u) const { return u.pn < 4 ? 0 : (u.pn < 8 ? 64 : 192); }
    __device__ __forceinline__ int nt(const Unit& u, const Gemm&) const { return u.pn < 8 ? 2 : 4; }
    __device__ __forceinline__ size_t a_off(const Unit& u, const Gemm& g) const { return (size_t)u.pm * BM * g.lda * 2 + (size_t)k0(u) * 2; }
    __device__ __forceinline__ size_t b_off(const Unit& u, const Gemm& g) const { return (size_t)u.pn * BM * g.ldb * 2 + (size_t)k0(u) * 2; }
};
__device__ __forceinline__ unsigned cvt_pk_bf16(float lo, float hi) { unsigned r; asm volatile("v_cvt_pk_bf16_f32 %0, %1, %2" : "=v"(r) : "v"(lo), "v"(hi)); return r; }

struct EpiF32 {
    static constexpr bool PERM = false, AFTER_DRAIN = false;
    float* C; int ldc; const float* cscale;
    __device__ __forceinline__ void operator()(const f32x4 (&acc)[2][2][4][2], const Unit& u, int wr, int wc, int fr, int fq) const {
        const int row0 = u.pm * BM + wr * 64 + fr, col0 = u.pn * BM + wc * 32 + 4 * fq;
        f32x4 sv[2][2];
#pragma unroll
        for (int bj = 0; bj < 2; ++bj)
#pragma unroll
            for (int n = 0; n < 2; ++n) sv[bj][n] = cscale ? *(const f32x4*)(cscale + col0 + bj * HALF + n * 16) : (f32x4){1.f, 1.f, 1.f, 1.f};
#pragma unroll
        for (int ai = 0; ai < 2; ++ai)
#pragma unroll
            for (int m = 0; m < 4; ++m) { float* rowp = C + (size_t)(row0 + ai * HALF + m * 16) * ldc + col0;
#pragma unroll
                for (int bj = 0; bj < 2; ++bj)
#pragma unroll
                    for (int n = 0; n < 2; ++n) *(f32x4*)(rowp + bj * HALF + n * 16) = acc[ai][bj][m][n] * sv[bj][n]; }
    }
};
typedef unsigned u32x2h __attribute__((ext_vector_type(2)));
struct EpiLora {
    static constexpr bool PERM = false, AFTER_DRAIN = false;
    float* C; bf16_t* H; int ldc;
    __device__ __forceinline__ void operator()(const f32x4 (&acc)[2][2][4][2], const Unit& u, int wr, int wc, int fr, int fq) const {
        const int row0 = u.pm * BM + wr * 64 + fr, col0 = u.pn * BM + wc * 32 + 4 * fq;
#pragma unroll
        for (int ai = 0; ai < 2; ++ai)
#pragma unroll
            for (int m = 0; m < 4; ++m) { const size_t ro = (size_t)(row0 + ai * HALF + m * 16) * ldc + col0;
#pragma unroll
                for (int bj = 0; bj < 2; ++bj)
#pragma unroll
                    for (int n = 0; n < 2; ++n) { const f32x4 v = acc[ai][bj][m][n];
                        if (u.pm < 32) { u32x2h w; w.x = cvt_pk_bf16(v[0], v[1]); w.y = cvt_pk_bf16(v[2], v[3]); *(u32x2h*)(H + ro + bj * HALF + n * 16) = w; }
                        else *(f32x4*)(C + ro + bj * HALF + n * 16) = v; } }
    }
};
struct EpiRelu2 {
    static constexpr bool PERM = true, AFTER_DRAIN = false;
    bf16_t* O; int ldc; float* PART;
    __device__ __forceinline__ void operator()(const f32x4 (&acc)[2][2][4][2], const Unit& u, int wr, int wc, int fr, int fq) const {
        const int row0 = u.pm * BM + wr * 64 + fr, col0 = u.pn * BM + wc * 32 + 8 * fq;
        if (u.kc >= 0) {
            if (wr == 0) {
#pragma unroll
                for (int m = 0; m < 4; ++m) { float* rowp = PART + ((size_t)u.kc * 64 + m * 16 + fr) * ldc + col0;
#pragma unroll
                    for (int bj = 0; bj < 2; ++bj) { *(f32x4*)(rowp + bj * HALF) = acc[0][bj][m][0]; *(f32x4*)(rowp + bj * HALF + 4) = acc[0][bj][m][1]; } } }
            return;
        }
#pragma unroll
        for (int ai = 0; ai < 2; ++ai)
#pragma unroll
            for (int m = 0; m < 4; ++m) { bf16_t* rowp = O + (size_t)(row0 + ai * HALF + m * 16) * ldc + col0;
#pragma unroll
                for (int bj = 0; bj < 2; ++bj) { f32x4 v0 = acc[ai][bj][m][0], v1 = acc[ai][bj][m][1];
#pragma unroll
                    for (int j = 0; j < 4; ++j) { const float a = v0[j] > 0.f ? v0[j] : 0.f, b = v1[j] > 0.f ? v1[j] : 0.f; v0[j] = a * a; v1[j] = b * b; }
                    u32x4 w; w.x = cvt_pk_bf16(v0[0], v0[1]); w.y = cvt_pk_bf16(v0[2], v0[3]); w.z = cvt_pk_bf16(v1[0], v1[1]); w.w = cvt_pk_bf16(v1[2], v1[3]);
                    *(u32x4*)(rowp + bj * HALF) = w; } }
    }
};
template <bool POOL> struct MixOrder {
    StaticOrder so; int nmain, nN, kdiv, ntot, G, c;
    __device__ void init(int N, int K, int G_, int c_) { nN = N / BM; so.init(32 * BM, N, G_, c_); nmain = 32 * nN; kdiv = (POOL ? 512 : K) / 256; ntot = nmain + nN * kdiv; G = G_; c = c_; }
    __device__ bool next(int i, Unit& u) const {
        const int L = i * G + c; if (L >= ntot) return false;
        if (L < nmain) return so.next(i, u);
        const int j = L - nmain; u.pm = 32; u.pn = j % nN; u.kc = j / nN; return true;
    }
    __device__ __forceinline__ int nt(const Unit& u, const Gemm& g) const { return u.kc >= 0 ? 4 : (POOL ? 8 : g.K / BK); }
    __device__ __forceinline__ size_t a_off(const Unit& u, const Gemm& g) const { return (size_t)u.pm * BM * g.lda * 2 + (size_t)((POOL ? (u.pn >> 1) * 512 : 0) + (u.kc >= 0 ? u.kc * 256 : 0)) * 2; }
    __device__ __forceinline__ size_t b_off(const Unit& u, const Gemm& g) const { return (size_t)u.pn * BM * g.ldb * 2 + (size_t)((POOL ? (u.pn >> 1) * 512 : 0) + (u.kc >= 0 ? u.kc * 256 : 0)) * 2; }
    __device__ __forceinline__ void a_ready(const Unit&) const {}
    __device__ __forceinline__ void done(const Unit&) const {}
};
template <int PROW> struct EpiF32S {
    static constexpr bool PERM = false, AFTER_DRAIN = false;
    bf16_t* C; int ldc; const float* cscale; float* PART;
    __device__ __forceinline__ f32x4 scl(int c) const { return cscale ? *(const f32x4*)(cscale + c) : (f32x4){1.f, 1.f, 1.f, 1.f}; }
    __device__ __forceinline__ void operator()(const f32x4 (&acc)[2][2][4][2], const Unit& u, int wr, int wc, int fr, int fq) const {
        asm volatile("" : "+v"(fr), "+v"(fq));
        const int col0 = u.pn * BM + wc * 32 + 4 * fq;
        if (u.kc < 0) {
            bf16_t* Ct = C + (size_t)u.pm * BM * ldc; const unsigned e0 = (unsigned)((wr * 64 + fr) * ldc + col0);
#pragma unroll
            for (int bj = 0; bj < 2; ++bj)
#pragma unroll
                for (int n = 0; n < 2; ++n) { const f32x4 sv = scl(col0 + bj * HALF + n * 16);
#pragma unroll
                    for (int ai = 0; ai < 2; ++ai)
#pragma unroll
                        for (int m = 0; m < 4; ++m) { const f32x4 v = acc[ai][bj][m][n] * sv; const unsigned w0 = cvt_pk_bf16(v[0], v[1]), w1 = cvt_pk_bf16(v[2], v[3]);
                            *(unsigned long long*)(Ct + e0 + (unsigned)((ai * HALF + m * 16) * ldc) + bj * HALF + n * 16) = (unsigned long long)w0 | ((unsigned long long)w1 << 32); } }
        } else if (PROW == 256) {
            float* Pk = PART + (size_t)u.kc * 256 * ldc; const unsigned e0 = (unsigned)((wr * 64 + fr) * ldc + col0);
#pragma unroll
            for (int bj = 0; bj < 2; ++bj)
#pragma unroll
                for (int n = 0; n < 2; ++n) { const f32x4 sv = scl(col0 + bj * HALF + n * 16);
#pragma unroll
                    for (int ai = 0; ai < 2; ++ai)
#pragma unroll
                        for (int m = 0; m < 4; ++m) *(f32x4*)(Pk + e0 + (unsigned)((ai * HALF + m * 16) * ldc) + bj * HALF + n * 16) = acc[ai][bj][m][n] * sv; }
        } else if (wr == 0) {
            float* Pk = PART + (size_t)u.kc * 64 * ldc; const unsigned e0 = (unsigned)(fr * ldc + col0);
#pragma unroll
            for (int bj = 0; bj < 2; ++bj)
#pragma unroll
                for (int n = 0; n < 2; ++n) { const f32x4 sv = scl(col0 + bj * HALF + n * 16);
#pragma unroll
                    for (int m = 0; m < 4; ++m) *(f32x4*)(Pk + e0 + (unsigned)(m * 16 * ldc) + bj * HALF + n * 16) = acc[0][bj][m][n] * sv; }
        }
    }
};
template <class Epi, class Sched, bool ALIGN_EPI = false, bool SP2 = false>
__device__ __forceinline__ void gemm_phase(PG8_LAS unsigned char* lds, const Gemm g, const Sched& S, const Epi& E) {
    const int tid = threadIdx.x, wid = __builtin_amdgcn_readfirstlane(tid >> 6), lane = tid & 63, wr = wid >> 2, wc = wid & 3, fr = lane & 15, fq = lane >> 4;
    unsigned voffA[2], voffB[2];
#pragma unroll
    for (int i = 0; i < 2; ++i) { int R, C; stage_rc(tid * 16 + i * 8192, R, C); const int Rb = Epi::PERM ? ((R & ~31) + perm32(R & 31)) : R;
        voffA[i] = (unsigned)(R * g.lda + C) * 2u; voffB[i] = (unsigned)(Rb * g.ldb + C) * 2u; }
    const size_t kstep = (size_t)(BK * 2);
    const size_t hsA = (size_t)HALF * g.lda * 2, hsB = (size_t)HALF * g.ldb * 2;
    const unsigned ldsw = (unsigned)wid * 1024u;
    const int aoff = lds_byte(wr * 64 + fr, fq * 8), boff = lds_byte(wc * 32 + fr, fq * 8);
#define PG8_SA(b, h) (((b) * 2 + (h)) * HTB)
#define PG8_SB(b, h) ((4 + (b) * 2 + (h)) * HTB)
#define PG8_STAGE(bufoff, gbase, voff) do { _Pragma("unroll") for (int _i = 0; _i < 2; ++_i) \
        __builtin_amdgcn_global_load_lds((const unsigned*)((const char*)(gbase) + (voff)[_i]), (PG8_LAS unsigned*)(lds + (bufoff) + ldsw + _i * 8192), 16, 0, 0); } while (0)
#define PG8_LDA(dst, b, h) do { _Pragma("unroll") for (int m = 0; m < 4; ++m) _Pragma("unroll") for (int k = 0; k < 2; ++k) dst[m][k] = *(const PG8_LAS bf16x8*)(lds + PG8_SA(b, h) + aoff + m * 2048 + k * 1024); } while (0)
#define PG8_LDB(dst, b, h) do { _Pragma("unroll") for (int n = 0; n < 2; ++n) _Pragma("unroll") for (int k = 0; k < 2; ++k) dst[n][k] = *(const PG8_LAS bf16x8*)(lds + PG8_SB(b, h) + boff + n * 2048 + k * 1024); } while (0)
#define PG8_MMA(ai, bj, At, Bt) do { __builtin_amdgcn_s_setprio(1); _Pragma("unroll") for (int m = 0; m < 4; ++m) _Pragma("unroll") for (int n = 0; n < 2; ++n) _Pragma("unroll") for (int k = 0; k < 2; ++k) \
        acc[ai][bj][m][n] = __builtin_amdgcn_mfma_f32_16x16x32_bf16(Bt[n][k], At[m][k], acc[ai][bj][m][n], 0, 0, 0); __builtin_amdgcn_s_setprio(0); } while (0)
#define PG8_WAIT_V(n) asm volatile("s_waitcnt vmcnt(" #n ")" ::: "memory")
#define PG8_WAIT_L(n) asm volatile("s_waitcnt lgkmcnt(" #n ")" ::: "memory")
#define PG8_BAR __builtin_amdgcn_s_barrier()
#define PG8_SCHED __builtin_amdgcn_sched_barrier(0)
    Unit cur, nxt; int ui = 0;
    if (!S.next(0, cur)) return;
    int nt = S.nt(cur, g);
    f32x4 acc[2][2][4][2];
#pragma unroll
    for (int a = 0; a < 2; ++a)
#pragma unroll
        for (int b = 0; b < 2; ++b)
#pragma unroll
            for (int m = 0; m < 4; ++m)
#pragma unroll
                for (int n = 0; n < 2; ++n) acc[a][b][m][n] = (f32x4){0.f, 0.f, 0.f, 0.f};
    bf16x8 At[4][2], B0[2][2], B1[2][2];
    const char* cA = (const char*)g.A + S.a_off(cur, g); const char* cB = (const char*)g.Bt + S.b_off(cur, g);
    S.a_ready(cur);
    if constexpr (SP2) {
        PG8_STAGE(PG8_SB(0, 0), cB, voffB); PG8_STAGE(PG8_SB(0, 1), cB + hsB, voffB); PG8_STAGE(PG8_SA(0, 0), cA, voffA); PG8_STAGE(PG8_SA(0, 1), cA + hsA, voffA);
        if (wr == 1) PG8_BAR;
        PG8_WAIT_V(2); PG8_BAR;
        PG8_STAGE(PG8_SB(1, 0), cB + kstep, voffB); PG8_STAGE(PG8_SA(1, 0), cA + kstep, voffA); PG8_STAGE(PG8_SB(1, 1), cB + hsB + kstep, voffB);
        PG8_WAIT_V(6); PG8_BAR;
    } else {
        PG8_STAGE(PG8_SB(0, 0), cB, voffB); PG8_STAGE(PG8_SA(0, 0), cA, voffA); PG8_STAGE(PG8_SB(0, 1), cB + hsB, voffB); PG8_STAGE(PG8_SA(0, 1), cA + hsA, voffA);
        if (wr == 1) PG8_BAR;
        PG8_WAIT_V(4); PG8_BAR;
        PG8_STAGE(PG8_SB(1, 0), cB + kstep, voffB); PG8_STAGE(PG8_SA(1, 0), cA + kstep, voffA); PG8_STAGE(PG8_SB(1, 1), cB + hsB + kstep, voffB);
        PG8_WAIT_V(6); PG8_BAR;
    }
    for (;;) {
        const bool has_next = S.next(ui + 1, nxt);
        const char* nA = has_next ? (const char*)g.A + S.a_off(nxt, g) : cA; const char* nB = has_next ? (const char*)g.Bt + S.b_off(nxt, g) : cB;
        for (int t = 0; t < nt; t += 2) {
            const bool last = (t == nt - 2);
            const char* a1 = cA + (size_t)(t + 1) * kstep;
            const char* a2 = last ? nA : cA + (size_t)(t + 2) * kstep; const char* b2 = last ? nB : cB + (size_t)(t + 2) * kstep;
            const char* a3 = a2 + kstep; const char* b3 = b2 + kstep;
            if (last && has_next) S.a_ready(nxt);
            if constexpr (SP2) {
            PG8_LDB(B0, 0, 0); PG8_LDB(B1, 0, 1); PG8_SCHED; PG8_LDA(At, 0, 0); PG8_STAGE(PG8_SA(1, 1), a1 + hsA, voffA);
            PG8_WAIT_V(8); PG8_WAIT_L(0); PG8_BAR; PG8_MMA(0, 0, At, B0); PG8_MMA(0, 1, At, B1); PG8_BAR; PG8_SCHED;
            PG8_LDA(At, 0, 1); PG8_STAGE(PG8_SB(0, 0), b2, voffB); PG8_STAGE(PG8_SB(0, 1), b2 + hsB, voffB); PG8_STAGE(PG8_SA(0, 0), a2, voffA);
            PG8_WAIT_V(8); PG8_WAIT_L(0); PG8_BAR; PG8_MMA(1, 0, At, B0); PG8_MMA(1, 1, At, B1); PG8_BAR; PG8_SCHED;
            PG8_LDB(B0, 1, 0); PG8_LDB(B1, 1, 1); PG8_SCHED; PG8_LDA(At, 1, 0); PG8_STAGE(PG8_SA(0, 1), a2 + hsA, voffA);
            PG8_WAIT_V(8); PG8_WAIT_L(0); PG8_BAR; PG8_MMA(0, 0, At, B0); PG8_MMA(0, 1, At, B1); PG8_BAR; PG8_SCHED;
            PG8_LDA(At, 1, 1); PG8_STAGE(PG8_SB(1, 0), b3, voffB); PG8_STAGE(PG8_SB(1, 1), b3 + hsB, voffB); PG8_STAGE(PG8_SA(1, 0), a3, voffA);
            PG8_WAIT_V(8); PG8_WAIT_L(0); PG8_BAR; PG8_MMA(1, 0, At, B0); PG8_MMA(1, 1, At, B1); PG8_BAR; PG8_SCHED;
            } else {
            PG8_LDB(B0, 0, 0); PG8_SCHED; PG8_LDA(At, 0, 0); PG8_STAGE(PG8_SA(1, 1), a1 + hsA, voffA);
            PG8_WAIT_L(8); PG8_BAR; PG8_WAIT_L(0); PG8_MMA(0, 0, At, B0); PG8_BAR; PG8_SCHED;
            PG8_LDB(B1, 0, 1); PG8_STAGE(PG8_SB(0, 0), b2, voffB);
            PG8_BAR; PG8_WAIT_L(0); PG8_MMA(0, 1, At, B1); PG8_BAR;
            PG8_LDA(At, 0, 1); PG8_STAGE(PG8_SA(0, 0), a2, voffA);
            PG8_BAR; PG8_WAIT_L(0); PG8_MMA(1, 0, At, B0); PG8_BAR; PG8_SCHED;
            PG8_STAGE(PG8_SB(0, 1), b2 + hsB, voffB);
            PG8_WAIT_V(6); PG8_BAR; PG8_MMA(1, 1, At, B1); PG8_BAR;
            PG8_LDB(B0, 1, 0); PG8_SCHED; PG8_LDA(At, 1, 0); PG8_STAGE(PG8_SA(0, 1), a2 + hsA, voffA);
            PG8_WAIT_L(8); PG8_BAR; PG8_WAIT_L(0); PG8_MMA(0, 0, At, B0); PG8_BAR; PG8_SCHED;
            PG8_LDB(B1, 1, 1); PG8_STAGE(PG8_SB(1, 0), b3, voffB);
            PG8_BAR; PG8_WAIT_L(0); PG8_MMA(0, 1, At, B1); PG8_BAR;
            PG8_LDA(At, 1, 1); PG8_STAGE(PG8_SA(1, 0), a3, voffA);
            PG8_BAR; PG8_WAIT_L(0); PG8_MMA(1, 0, At, B0); PG8_BAR; PG8_SCHED;
            PG8_STAGE(PG8_SB(1, 1), b3 + hsB, voffB);
            PG8_WAIT_V(6); PG8_BAR; PG8_MMA(1, 1, At, B1); PG8_BAR;
            }
        }
        if constexpr (ALIGN_EPI) { if (wr == 0) PG8_BAR; }
        if constexpr (!Epi::AFTER_DRAIN) { E(acc, cur, wr, wc, fr, fq); S.done(cur); }
        if (!has_next) break;
#pragma unroll
        for (int a = 0; a < 2; ++a)
#pragma unroll
            for (int b = 0; b < 2; ++b)
#pragma unroll
                for (int m = 0; m < 4; ++m)
#pragma unroll
                    for (int n = 0; n < 2; ++n) acc[a][b][m][n] = (f32x4){0.f, 0.f, 0.f, 0.f};
        cur = nxt; cA = nA; cB = nB; ++ui; nt = S.nt(cur, g);
        if constexpr (ALIGN_EPI) { if (wr == 1) PG8_BAR; }
    }
    PG8_WAIT_V(0);
    if constexpr (!ALIGN_EPI) { if (wr == 0) PG8_BAR; }
    PG8_BAR;
    if constexpr (Epi::AFTER_DRAIN) { E.fused(acc, cur, wr, wc, fr, fq, lds, wid, lane); S.done(cur); }
#undef PG8_SA
#undef PG8_SB
#undef PG8_STAGE
#undef PG8_LDA
#undef PG8_LDB
#undef PG8_MMA
#undef PG8_WAIT_V
#undef PG8_WAIT_L
#undef PG8_BAR
#undef PG8_SCHED
}
}

constexpr int DM = 2048, SEQ = 4096, NBATCH = 2, NPR = NBATCH * SEQ, DBAT = 8, DSEQ = 8, NSM = DBAT * DSEQ, NTOK = NPR + NSM, MP = 8448;
constexpr int HA = 8, DHA = 128, HB = 16, DHB = 64, DBR = 1024;
constexpr int BCOLS = 3520, INCOLS = 6592, INPAD = 6656, DFF = 8192, NPAGES = 128, PAGESZ = 128, PAST = 16384, PBUF = 15, NMR = 10;
constexpr float EPS_RMS = 1e-6f, EPS_LNX = 64e-5f, QK_SCALE = 0.08838834764831845f;
enum { I_XP = 0, I_XS, I_CK, I_CV, I_PT, I_SWKV, I_SSH, I_SPOOL, I_CP, I_CS, I_WADA, I_BADA, I_NG, I_WIN, I_WOUT, I_SBB, I_MU, I_W0, I_WUP, I_A0, I_AUP, I_GUP, I_KK, I_KA, I_RK, I_LNG, I_LNB, I_WPOOL, I_PSC, I_W1, I_W2, N_IN };
constexpr size_t O_YP = 0, O_YS = O_YP + (size_t)NPR * DM, O_KP = O_YS + (size_t)NSM * DM, O_VP = O_KP + (size_t)NPR * 1024, O_KS = O_VP + (size_t)NPR * 1024, O_VS = O_KS + (size_t)NSM * 1024,
                 O_WKVP = O_VS + (size_t)NSM * 1024, O_WKVS = O_WKVP + (size_t)NBATCH * HB * 64 * 64, O_SHP = O_WKVS + (size_t)DBAT * HB * 64 * 64, O_SHS = O_SHP + (size_t)NBATCH * BCOLS,
                 O_PLP = O_SHS + (size_t)DBAT * BCOLS, O_PLS = O_PLP + (size_t)NBATCH * PBUF * DM, O_END = O_PLS + (size_t)DBAT * PBUF * DM;
constexpr size_t MiB = 1u << 20;
constexpr size_t WS_CTL = 0, CTL_ZERO_BYTES = 64 * 1024, WS_MOD = 1 * MiB, WS_WIN = 2 * MiB, WS_WOUT = 28 * MiB, WS_W1 = 36 * MiB, WS_W2 = 100 * MiB, WS_WPOOL = 164 * MiB,
                 WS_H = 172 * MiB, WS_OAB = 205 * MiB, WS_M = 238 * MiB, WS_P = 271 * MiB, WS_OUT = 486 * MiB, WS_XR = 552 * MiB, WS_HF = 617 * MiB, WS_U = 682 * MiB,
                 WS_RWV = 814 * MiB, WS_SCL = 1072 * MiB, WS_G = 1075 * MiB, WS_Y = 1108 * MiB, WS_PU = 1141 * MiB, WS_Z = 1205 * MiB, WS_SC = 1237 * MiB, WS_QB = 1269 * MiB, WS_KB = 1286 * MiB, WS_VB = 1303 * MiB, WS_OP = 1320 * MiB, WS_CL = 1384 * MiB, WS_SPART = 1385 * MiB, WS_SCAR = 1394 * MiB, WS_LA = 1395 * MiB, WS_LWT = 1404 * MiB, WS_LWO = 1408 * MiB, WS_YC = 1508 * MiB, WS_PART = 1541 * MiB, WS_PARTU = 1558 * MiB, WS_END = 1575 * MiB;
static_assert(WS_WIN + (size_t)INPAD * DM * 2 <= WS_WOUT && WS_P + (size_t)MP * INPAD * 4 <= WS_OUT && WS_U + (size_t)MP * DFF * 2 <= WS_RWV && WS_RWV + (size_t)NTOK * HB * 512 * 4 <= WS_SCL, "ws map");
constexpr int CW_BAR = 4096;
constexpr int RING_BYTES = 131072, LDSCTL_OFF = RING_BYTES, MISC_OFF = LDSCTL_OFF + 320, LDS_BYTES = 147456;
constexpr int NWAVES = 8, NTHR = 512;

#define GAS __attribute__((address_space(1)))
#define LAS __attribute__((address_space(3)))
typedef unsigned short bf16;
__device__ __forceinline__ float ldbf(const bf16* p) { return __uint_as_float((unsigned)*p << 16); }
__device__ __forceinline__ float ldbf_nt(const bf16* p) { return __uint_as_float((unsigned)__builtin_nontemporal_load(p) << 16); }
typedef float f32x4 __attribute__((ext_vector_type(4)));
typedef float f32x2 __attribute__((ext_vector_type(2)));
typedef unsigned u32x2 __attribute__((ext_vector_type(2)));
typedef unsigned u32x4 __attribute__((ext_vector_type(4)));
#define LDS_WAIT() asm volatile("s_waitcnt lgkmcnt(0)" ::: "memory")
#define VM_WAIT() asm volatile("s_waitcnt vmcnt(0)" ::: "memory")
using pg8::cvt_pk_bf16;
constexpr size_t WS_PBH = WS_RWV, WS_LWH = WS_RWV + 64 * MiB;
static_assert((size_t)NPR * 3072 * 2 <= 64 * MiB && 128 * MiB <= (size_t)NPR * HB * 512 * 4, "bf16 prompt copies fit below the sample rows of RWV");
constexpr int PBLD = 3584;
struct EpiIn {
    static constexpr bool PERM = false, AFTER_DRAIN = false;
    bf16 *QB, *KB, *VB; float* PB; float* out; bf16* PBH;
    __device__ __forceinline__ void operator()(const pg8::f32x4 (&acc)[2][2][4][2], const pg8::Unit& u, int wr, int wc, int fr, int fq) const {
        const int row0 = u.pm * 256 + wr * 64 + fr, colt = u.pn * 256 + wc * 32 + 4 * fq;
        if (u.pn >= 12) {
#pragma unroll
            for (int ai = 0; ai < 2; ++ai)
#pragma unroll
                for (int m = 0; m < 4; ++m) {
                    if (u.pm < 32 && u.pn < 24) { bf16* rowh = PBH + (size_t)(row0 + ai * 128 + m * 16) * 3072 + (colt - 3072);
#pragma unroll
                        for (int bj = 0; bj < 2; ++bj)
#pragma unroll
                            for (int n = 0; n < 2; ++n) { const pg8::f32x4 v = acc[ai][bj][m][n]; u32x2 w; w.x = cvt_pk_bf16(v[0], v[1]); w.y = cvt_pk_bf16(v[2], v[3]); *(u32x2*)(rowh + bj * 128 + n * 16) = w; } }
                    else { float* rowp = PB + (size_t)(row0 + ai * 128 + m * 16) * PBLD + (colt - 3072);
#pragma unroll
                        for (int bj = 0; bj < 2; ++bj)
#pragma unroll
                            for (int n = 0; n < 2; ++n) *(pg8::f32x4*)(rowp + bj * 128 + n * 16) = acc[ai][bj][m][n]; } }
        } else {
            const int sel = u.pn >> 2, c0 = colt - sel * 1024;
            static_assert(WS_KB - WS_QB == WS_VB - WS_KB && O_VP - O_KP == (size_t)NPR * 1024 && O_VS - O_KS == (size_t)NSM * 1024, "q/k/v buffers are equally spaced");
            bf16* Bt = QB + (size_t)sel * ((WS_KB - WS_QB) / 2) + (size_t)u.pm * 256 * 1024;
            float* Ot = u.pm < 32 ? out + O_KP + (size_t)(sel ? sel - 1 : 0) * NPR * 1024 + (size_t)u.pm * 256 * 1024 : out + O_KS + (size_t)(sel ? sel - 1 : 0) * NSM * 1024;
            const int rl0 = wr * 64 + fr;
#pragma unroll
            for (int ai = 0; ai < 2; ++ai)
#pragma unroll
                for (int m = 0; m < 4; ++m) { const int rl = rl0 + ai * 128 + m * 16; const unsigned eo = (unsigned)(rl * 1024 + c0);
                    const bool wo = sel != 0 && (u.pm < 32 || rl < NSM);
#pragma unroll
                    for (int bj = 0; bj < 2; ++bj)
#pragma unroll
                        for (int n = 0; n < 2; ++n) { const pg8::f32x4 v = acc[ai][bj][m][n]; u32x2 w; w.x = cvt_pk_bf16(v[0], v[1]); w.y = cvt_pk_bf16(v[2], v[3]);
                            *(u32x2*)(Bt + eo + bj * 128 + n * 16) = w; if (wo) *(pg8::f32x4*)(Ot + eo + bj * 128 + n * 16) = v; }
                    asm volatile("" ::: "memory"); }
        }
    }
};

#define XB_TMO      128
#define XB_XCNT(j)  (256  + 64 * (j))
#define XB_XSUB(j)  (1280 + 64 * (j))
#define XB_XGEN(j)  (2304 + 64 * (j))
#define XB_TOP      3328
#define XB_TOPGEN   3392
#define XCD_BAR_WORDS 3456
#define XB_SPIN_CAP (1u << 18)

__device__ __forceinline__ unsigned xb_ld(unsigned* p)              { return __hip_atomic_load(p, __ATOMIC_RELAXED, __HIP_MEMORY_SCOPE_AGENT); }
__device__ __forceinline__ unsigned xb_add(unsigned* p, unsigned v) { return __hip_atomic_fetch_add(p, v, __ATOMIC_RELAXED, __HIP_MEMORY_SCOPE_AGENT); }
__device__ __forceinline__ unsigned xb_xcc_id() { return (unsigned)__builtin_amdgcn_s_getreg((3 << 11) | 20) & 0xFu; }
#define XB_SPIN(cond, bar) do { unsigned _sp = 0; while (cond) { __builtin_amdgcn_s_sleep(1); \
    if ((++_sp & 255u) == 0u) { if (xb_ld(&(bar)[XB_TMO])) break; if (_sp > XB_SPIN_CAP) { atomicAdd(&(bar)[XB_TMO], 1u); break; } } } } while (0)

struct XcdBarrier {
    unsigned* bar; unsigned x;
    volatile LAS unsigned* st;
};

__device__ __forceinline__ XcdBarrier xcd_barrier_post(unsigned* bar, volatile LAS unsigned* st) {
    XcdBarrier b; b.bar = bar; b.x = xb_xcc_id(); b.st = st;
    if (threadIdx.x == 0) (void)xb_add(&bar[XB_XCNT(b.x)], 1u);
    return b;
}
__device__ __forceinline__ void xcd_barrier_complete(unsigned* bar, unsigned x, unsigned& nloc, unsigned& nx) {
    const unsigned G = gridDim.x * gridDim.y * gridDim.z;
    unsigned sum, cnt, mine, sp = 0u;
    for (;;) {
        sum = 0u; cnt = 0u; mine = 0u;
#pragma unroll
        for (unsigned j = 0; j < 16; ++j) { const unsigned c = xb_ld(&bar[XB_XCNT(j)]); sum += c; cnt += (c > 0u) ? 1u : 0u; mine = (j == x) ? c : mine; }
        if (sum == G) break;
        __builtin_amdgcn_s_sleep(1);
        if ((++sp & 255u) == 0u) { if (xb_ld(&bar[XB_TMO])) break; if (sp > XB_SPIN_CAP) { atomicAdd(&bar[XB_TMO], 1u); break; } }
    }
    nloc = mine > 0u ? mine : 1u; nx = cnt > 0u ? cnt : 1u;
}

__device__ __forceinline__ void xcd_barrier(const XcdBarrier& b) {
    asm volatile("s_waitcnt vmcnt(0)" ::: "memory");
    __syncthreads();
    if (threadIdx.x == 0) {
        unsigned* bar = b.bar;
        __builtin_amdgcn_s_waitcnt(0);
        unsigned nloc = b.st[0], nx = b.st[1];
        if (nloc == 0u) { xcd_barrier_complete(bar, b.x, nloc, nx); b.st[0] = nloc; b.st[1] = nx; }
        const unsigned old = xb_add(&bar[XB_XSUB(b.x)], 1u);
        const unsigned gen = old / nloc;
        if (old + 1u == (gen + 1u) * nloc) {
            __builtin_amdgcn_fence(__ATOMIC_RELEASE, "agent");
            asm volatile("s_waitcnt vmcnt(0)" ::: "memory");
            const unsigned og = xb_add(&bar[XB_TOP], 1u);
            const unsigned tg = og / nx;
            if (og + 1u == (tg + 1u) * nx) xb_add(&bar[XB_TOPGEN], 1u);
            else XB_SPIN(xb_ld(&bar[XB_TOPGEN]) == tg, bar);
            __builtin_amdgcn_fence(__ATOMIC_ACQUIRE, "agent");
            xb_add(&bar[XB_XGEN(b.x)], 1u);
            asm volatile("s_waitcnt vmcnt(0)" ::: "memory");
        } else {
            XB_SPIN(xb_ld(&bar[XB_XGEN(b.x)]) == gen, bar);
            __builtin_amdgcn_fence(__ATOMIC_ACQUIRE, "agent");
            asm volatile("s_waitcnt vmcnt(0)" ::: "memory");
        }
    }
    __syncthreads();
}


struct Ctx {
    LAS unsigned char* lds; int tid, lane, wave, vcu, G;
    __device__ __forceinline__ const float* in(int i) const { return ((const float* const __attribute__((address_space(4)))*)__builtin_amdgcn_kernarg_segment_ptr())[i]; }
    __device__ __forceinline__ float* outp() const { return ((float* const __attribute__((address_space(4)))*)__builtin_amdgcn_kernarg_segment_ptr())[N_IN]; }
    __device__ __forceinline__ unsigned char* wsp() const { return ((unsigned char* const __attribute__((address_space(4)))*)__builtin_amdgcn_kernarg_segment_ptr())[N_IN + 1]; }
};
template <int CTRL> __device__ __forceinline__ float dpp_f(float x) { return __builtin_bit_cast(float, __builtin_amdgcn_mov_dpp(__builtin_bit_cast(int, x), CTRL, 0xf, 0xf, true)); }
#define readlane_f(x, l) __builtin_bit_cast(float, __builtin_amdgcn_readlane(__builtin_bit_cast(int, (float)(x)), (l)))
__device__ __forceinline__ float wave_sum(float v) {
    v += dpp_f<0xB1>(v); v += dpp_f<0x4E>(v); v += dpp_f<0x141>(v); v += dpp_f<0x140>(v);
    auto s = __builtin_amdgcn_permlane16_swap(__float_as_uint(v), __float_as_uint(v), false, false);
    v = __uint_as_float(s[0]) + __uint_as_float(s[1]);
    auto t = __builtin_amdgcn_permlane32_swap(__float_as_uint(v), __float_as_uint(v), false, false);
    return __uint_as_float(t[0]) + __uint_as_float(t[1]);
}
__device__ __forceinline__ float sigmoidf_(float x) { return 1.f / (1.f + __expf(-x)); }
__device__ __forceinline__ float softplusf_(float x) { return fmaxf(x, 0.f) + log1pf(__expf(-fabsf(x))); }
__device__ __forceinline__ int mod_row(int r) { return r < NPR ? (r >> 12) : 2 + ((r - NPR) >> 3); }
#define WSP(T, off) ((T*)(F.wsp() + (off)))

struct CvtItem { const float* W; bf16* WT; int ldw, ldt, k0, n0; };
__device__ __forceinline__ void item_load(float (&tv)[32], const CvtItem& d, int lane) {
#pragma unroll
    for (int i = 0; i < 32; ++i) tv[i] = __builtin_nontemporal_load(d.W + (size_t)(d.k0 + 2 * i + (lane >> 5)) * d.ldw + d.n0 + (lane & 31));
}
__device__ __forceinline__ void item_store(const float (&tv)[32], const CvtItem& d, LAS float* scr, int lane) {
#pragma unroll
    for (int i = 0; i < 32; ++i) scr[(2 * i + (lane >> 5)) * 33 + (lane & 31)] = tv[i];
    LDS_WAIT(); asm volatile("" ::: "memory");
    const int c = lane & 7;
#pragma unroll
    for (int j = 0; j < 4; ++j) { const int n = (lane >> 3) + 8 * j; const LAS float* s = scr + (8 * c) * 33 + n;
        u32x4 o; o.x = cvt_pk_bf16(s[0 * 33], s[1 * 33]); o.y = cvt_pk_bf16(s[2 * 33], s[3 * 33]); o.z = cvt_pk_bf16(s[4 * 33], s[5 * 33]); o.w = cvt_pk_bf16(s[6 * 33], s[7 * 33]);
        *(GAS u32x4*)(d.WT + (size_t)(d.n0 + n) * d.ldt + d.k0 + 8 * c) = o; }
    LDS_WAIT(); asm volatile("" ::: "memory");
}
constexpr int IT_IN = 32 * 206, IT_OUT = 32 * 64, IT_W1 = 32 * 256, IT_W2 = 128 * 64, IT_PL = 8 * 16, NIT_ALL = IT_IN + IT_OUT + 2 * IT_W1 + 2 * IT_W2 + 4 * IT_PL;
__device__ __forceinline__ CvtItem item_decode(Ctx& F, int it) {
    int r = it; CvtItem d; int N;
    if (r < IT_IN) { d.W = F.in(I_WIN); d.WT = WSP(bf16, WS_WIN); N = INCOLS; d.ldt = DM; }
    else if ((r -= IT_IN) < IT_OUT) { d.W = F.in(I_WOUT); d.WT = WSP(bf16, WS_WOUT); N = DM; d.ldt = DM; }
    else if ((r -= IT_OUT) < 2 * IT_W1) { const int l = r / IT_W1; r -= l * IT_W1; d.W = F.in(I_W1) + (size_t)l * DM * DFF; d.WT = WSP(bf16, WS_W1) + (size_t)l * DFF * DM; N = DFF; d.ldt = DM; }
    else if ((r -= 2 * IT_W1) < 2 * IT_W2) { const int l = r / IT_W2; r -= l * IT_W2; d.W = F.in(I_W2) + (size_t)l * DFF * DM; d.WT = WSP(bf16, WS_W2) + (size_t)l * DM * DFF; N = DM; d.ldt = DFF; }
    else { r -= 2 * IT_W2; const int g = r / IT_PL; r -= g * IT_PL; d.W = F.in(I_WPOOL) + (size_t)g * 512 * 512; d.WT = WSP(bf16, WS_WPOOL) + (size_t)(g * 512) * DM + g * 512; N = 512; d.ldt = DM; }
    const int nblk = N / 32, kb = r / nblk, nb = r - kb * nblk;
    d.ldw = N; d.k0 = 64 * kb; d.n0 = 32 * nb; return d;
}
__device__ __forceinline__ void convert_run(Ctx& F, int first, int stride, int lim, LAS float* scr) {
    int it = first; if (it >= lim) return;
    float ta[32], tb[32]; CvtItem da = item_decode(F, it), db = da; item_load(ta, da, F.lane);
    for (;;) {
        const int i2 = it + stride; const bool h2 = i2 < lim; if (h2) { db = item_decode(F, i2); item_load(tb, db, F.lane); }
        item_store(ta, da, scr, F.lane); if (!h2) break;
        const int i3 = i2 + stride; const bool h3 = i3 < lim; if (h3) { da = item_decode(F, i3); item_load(ta, da, F.lane); }
        item_store(tb, db, scr, F.lane); if (!h3) break;
        it = i3; }
}
constexpr int NCVT = 40, N_HIDE = 24000;
__device__ __forceinline__ void phase_prologue(Ctx& F) {
    LAS float* scr = (LAS float*)(F.lds + F.wave * 16384);
    const int gw = F.vcu * NWAVES + F.wave, NGW = F.G * NWAVES;
    convert_run(F, gw, NGW, IT_IN, scr);
    if (F.G > NCVT + 8) convert_run(F, IT_IN + N_HIDE + gw, NGW, NIT_ALL, scr); else convert_run(F, IT_IN + gw, NGW, NIT_ALL, scr);
    for (int i = F.vcu * NTHR + F.tid; i < 3072 * 64; i += F.G * NTHR) {
        const int kc = i / 3072, n = i - kc * 3072, reg = n >> 10, nn = n & 1023;
        float v[8];
        if (reg == 0) {
#pragma unroll
            for (int j = 0; j < 8; ++j) { const int k = 8 * kc + j; v[j] = (k < 96) ? F.in(I_WUP)[(size_t)k * 1024 + nn] : 0.f; } }
        else if (reg == 1) {
#pragma unroll
            for (int j = 0; j < 8; ++j) { const int k = 8 * kc + j - 96; v[j] = (k >= 0 && k < 96) ? F.in(I_AUP)[(size_t)k * 1024 + nn] : 0.f; } }
        else {
#pragma unroll
            for (int j = 0; j < 8; ++j) { const int k = 8 * kc + j - 192; v[j] = (k >= 0 && k < 256) ? F.in(I_GUP)[(size_t)k * 1024 + nn] : 0.f; } }
        u32x4 o; o.x = cvt_pk_bf16(v[0], v[1]); o.y = cvt_pk_bf16(v[2], v[3]); o.z = cvt_pk_bf16(v[4], v[5]); o.w = cvt_pk_bf16(v[6], v[7]);
        *(GAS u32x4*)(WSP(bf16, WS_LWT) + (size_t)n * 512 + 8 * kc) = o;
    }
    __syncthreads();
    LAS float* sc = (LAS float*)F.lds;
    LAS float* part = (LAS float*)(F.lds + 81920);
    for (int i = F.tid; i < NMR * DM; i += NTHR) { const int r = i >> 11, k = i & 2047; const float c = r < 2 ? F.in(I_CP)[r * DM + k] : F.in(I_CS)[(r - 2) * DM + k]; sc[i] = c / (1.f + __expf(-c)); }
    __syncthreads();
    float* MOD = WSP(float, WS_MOD);
    float* MODP = WSP(float, WS_G);
    for (int u = F.vcu; u < 512; u += F.G) {
        const bool whole = u < 256; const int task = whole ? u : 256 + ((u - 256) >> 1), kh = whole ? 0 : (u - 256) & 1, klen = whole ? 256 : 128;
        const int l = task / 192, cb = (task - l * 192) * 64;
        const float* W = F.in(I_WADA) + (size_t)l * DM * 12288 + cb + F.lane;
        float acc[NMR];
#pragma unroll
        for (int r = 0; r < NMR; ++r) acc[r] = 0.f;
        const int kbeg = kh * 1024 + F.wave * klen;
        float wa[8], wb[8]; const int kend = kbeg + klen;
#define ADA_LOAD(WV_, k_) do { _Pragma("unroll") for (int j = 0; j < 8; ++j) WV_[j] = __builtin_nontemporal_load(W + (size_t)((k_) + j) * 12288); } while (0)
#define ADA_USE(WV_, k_) do { _Pragma("unroll") for (int j = 0; j < 8; j += 4) _Pragma("unroll") for (int r = 0; r < NMR; ++r) { const f32x4 s = *(const LAS f32x4*)(sc + r * DM + (k_) + j); \
                acc[r] += (s.x * WV_[j] + s.y * WV_[j + 1]) + (s.z * WV_[j + 2] + s.w * WV_[j + 3]); } } while (0)
        ADA_LOAD(wa, kbeg); ADA_LOAD(wb, kbeg + 8);
        for (int k = kbeg; k < kend; k += 16) {
            ADA_USE(wa, k);
            { const int kn = k + 16 < kend ? k + 16 : kend - 16; ADA_LOAD(wa, kn); }
            ADA_USE(wb, k + 8);
            { const int kn = k + 16 < kend ? k + 24 : kend - 8; ADA_LOAD(wb, kn); }
        }
#undef ADA_LOAD
#undef ADA_USE
#pragma unroll
        for (int r = 0; r < NMR; ++r) part[(F.wave * NMR + r) * 64 + F.lane] = acc[r];
        __syncthreads();
        for (int i = F.tid; i < NMR * 64; i += NTHR) { const int r = i >> 6, c = i & 63; float s = 0.f;
#pragma unroll
            for (int w = 0; w < NWAVES; ++w) s += part[(w * NMR + r) * 64 + c];
            if (kh == 0) s += F.in(I_BADA)[l * 12288 + cb + c];
            if (whole) MOD[(size_t)(l * NMR + r) * 12288 + cb + c] = s; else MODP[((size_t)kh * NMR + r) * 8192 + (cb - 4096) + c] = s; }
        __syncthreads();
    }
}

struct Row { f32x4 v[8]; };
__device__ __forceinline__ void row_load(Row& R, const float* p, int lane) {
#pragma unroll
    for (int j = 0; j < 8; ++j) R.v[j] = *(const GAS f32x4*)(p + j * 256 + lane * 4);
}
__device__ __forceinline__ void row_load_bf16(Row& R, const bf16* p, int lane) {
#pragma unroll
    for (int j = 0; j < 8; ++j) { const u32x2 w = *(const GAS u32x2*)(p + j * 256 + lane * 4);
        R.v[j] = (f32x4){__uint_as_float(w.x << 16), __uint_as_float(w.x & 0xffff0000u), __uint_as_float(w.y << 16), __uint_as_float(w.y & 0xffff0000u)}; }
}
__device__ __forceinline__ float row_sumsq(const Row& R) { float s = 0.f;
#pragma unroll
    for (int j = 0; j < 8; ++j) s += (R.v[j].x * R.v[j].x + R.v[j].y * R.v[j].y) + (R.v[j].z * R.v[j].z + R.v[j].w * R.v[j].w);
    return wave_sum(s); }
__device__ __forceinline__ const float* x_in_row(Ctx& F, int r) { return r < NPR ? F.in(I_XP) + (size_t)r * DM : F.in(I_XS) + (size_t)(r - NPR) * DM; }
__device__ __forceinline__ void row_modulate(Row& H, const Row& X, float rstd, const float* g, const float* shift, const float* scale, int lane) {
#pragma unroll
    for (int j = 0; j < 8; ++j) { const int c = j * 256 + lane * 4; const f32x4 gg = *(const GAS f32x4*)(g + c), sh = *(const GAS f32x4*)(shift + c), sc = *(const GAS f32x4*)(scale + c);
        H.v[j] = X.v[j] * rstd * gg * (sc + 1.f) + sh; }
}
__device__ __forceinline__ void row_store_bf16(const Row& H, bf16* p, int lane) {
#pragma unroll
    for (int j = 0; j < 8; ++j) { u32x2 w; w.x = cvt_pk_bf16(H.v[j].x, H.v[j].y); w.y = cvt_pk_bf16(H.v[j].z, H.v[j].w); *(GAS u32x2*)(p + j * 256 + lane * 4) = w; }
}
__device__ __forceinline__ void row_store_f32(const Row& H, float* p, int lane) {
#pragma unroll
    for (int j = 0; j < 8; ++j) *(GAS f32x4*)(p + j * 256 + lane * 4) = H.v[j];
}
__device__ __forceinline__ void row_store_f32_nt(const Row& H, float* p, int lane) {
#pragma unroll
    for (int j = 0; j < 8; ++j) __builtin_nontemporal_store(H.v[j], (GAS f32x4*)(p + j * 256 + lane * 4));
}
struct RowB { u32x2 w[8]; };
__device__ __forceinline__ void rowb_load(RowB& R, const bf16* p, int lane) {
#pragma unroll
    for (int j = 0; j < 8; ++j) R.w[j] = *(const GAS u32x2*)(p + j * 256 + lane * 4);
}
__device__ __forceinline__ void rowb_cvt(Row& R, const RowB& B) {
#pragma unroll
    for (int j = 0; j < 8; ++j) R.v[j] = (f32x4){__uint_as_float(B.w[j].x << 16), __uint_as_float(B.w[j].x & 0xffff0000u), __uint_as_float(B.w[j].y << 16), __uint_as_float(B.w[j].y & 0xffff0000u)};
}
constexpr int PSET_FLOATS = 3 * DM;
static_assert(NSM == 64 && 3 * PSET_FLOATS * 4 + 7 * DM * 4 <= RING_BYTES, "row phases: 8 workgroups x 8 waves take the sample rows; three parameter sets in LDS");
template <int KIND, int L> __device__ __forceinline__ void stage_row_params(Ctx& F) {
    const float* MOD = WSP(float, WS_MOD); const float* ng = F.in(I_NG) + (size_t)L * 4 * DM;
    const int nset = F.vcu < 64 ? 3 : 2;
#define RP_LD4(p) (*(const GAS f32x4*)(p))
    for (int i = F.tid; i < nset * (DM / 4); i += NTHR) {
        const int s = i >> 9, c = (i & 511) * 4, mr = s < 2 ? s : 2 + (F.vcu >> 3);
        const float* m = MOD + (size_t)(L * NMR + mr) * 12288;
        f32x4 v0 = {0.f, 0.f, 0.f, 0.f}, v1 = v0, v2 = v0;
        if (KIND == 0) { v1 = RP_LD4(ng + c) * (RP_LD4(m + DM + c) + 1.f); v2 = RP_LD4(m + c); }
        else if (KIND == 1) { v0 = RP_LD4(m + 2 * DM + c) * RP_LD4(ng + DM + c); v1 = RP_LD4(ng + 2 * DM + c) * (RP_LD4(m + 4 * DM + c) + 1.f); v2 = RP_LD4(m + 3 * DM + c); }
        else { v0 = RP_LD4(m + 5 * DM + c) * RP_LD4(ng + 3 * DM + c);
               if (KIND == 2) { const float* m1 = MOD + (size_t)(1 * NMR + mr) * 12288; v1 = RP_LD4(F.in(I_NG) + (size_t)4 * DM + c) * (RP_LD4(m1 + DM + c) + 1.f); v2 = RP_LD4(m1 + c); } }
        LAS float* d = (LAS float*)F.lds + s * PSET_FLOATS + c;
        *(LAS f32x4*)d = v0; *(LAS f32x4*)(d + DM) = v1; *(LAS f32x4*)(d + 2 * DM) = v2;
    }
#undef RP_LD4
    __syncthreads();
}
__device__ __forceinline__ const LAS float* row_pset(Ctx& F, int r) { return (const LAS float*)F.lds + (r < NPR ? (r >> 12) : 2) * PSET_FLOATS; }
__device__ __forceinline__ void row_residual_l(Row& X, const Row& O, const LAS float* ps, int lane) {
    const float rstd = rsqrtf(row_sumsq(O) * (1.f / DM) + EPS_RMS);
#pragma unroll
    for (int j = 0; j < 8; ++j) { const f32x4 gt = *(const LAS f32x4*)(ps + j * 256 + lane * 4); X.v[j] = X.v[j] + gt * (O.v[j] * rstd); }
}
__device__ __forceinline__ void row_modulate_l(Row& H, const Row& X, const LAS float* ps, int lane) {
    const float rstd = rsqrtf(row_sumsq(X) * (1.f / DM) + EPS_RMS);
#pragma unroll
    for (int j = 0; j < 8; ++j) { const int c = j * 256 + lane * 4; const f32x4 a = *(const LAS f32x4*)(ps + DM + c), sh = *(const LAS f32x4*)(ps + 2 * DM + c); H.v[j] = X.v[j] * rstd * a + sh; }
}
__device__ __forceinline__ void phase_mod0(Ctx& F) {
    stage_row_params<0, 0>(F);
    const int gw = F.vcu * NWAVES + F.wave, NGW = F.G * NWAVES, samp = (F.vcu < 64 && F.wave == 0) ? NPR + F.vcu : NTOK; bf16* Hb = WSP(bf16, WS_H);
    Row Xn; row_load(Xn, x_in_row(F, gw), F.lane);
    for (int r = gw; r < NPR; r += NGW) {
        Row X = Xn, H; const int rn = r + NGW, rp = rn < NPR ? rn : (samp < NTOK ? samp : r);
        row_load(Xn, x_in_row(F, rp), F.lane);
        row_modulate_l(H, X, row_pset(F, r), F.lane);
        row_store_bf16(H, Hb + (size_t)r * DM, F.lane);
    }
    if (samp < NTOK) { Row H; row_modulate_l(H, Xn, row_pset(F, samp), F.lane); row_store_bf16(H, Hb + (size_t)samp * DM, F.lane); }
}
__device__ __forceinline__ void row_residual(Row& X, const Row& O, const float* ga, const float* gate, int lane) {
    const float rstd = rsqrtf(row_sumsq(O) * (1.f / DM) + EPS_RMS);
#pragma unroll
    for (int j = 0; j < 8; ++j) { const int c = j * 256 + lane * 4; const f32x4 gg = *(const GAS f32x4*)(ga + c), gt = *(const GAS f32x4*)(gate + c); X.v[j] = X.v[j] + gt * (O.v[j] * rstd * gg); }
}
template <int NK> __device__ __forceinline__ void row_load_out(Ctx& F, Row& O, int r, int lane) {
    if (r < NPR) { const bf16* op = WSP(bf16, WS_OUT) + (size_t)r * DM;
#pragma unroll
        for (int j = 0; j < 8; ++j) { const u32x2 w = *(const GAS u32x2*)(op + j * 256 + lane * 4);
            O.v[j] = (f32x4){__uint_as_float(w.x << 16), __uint_as_float(w.x & 0xffff0000u), __uint_as_float(w.y << 16), __uint_as_float(w.y & 0xffff0000u)}; }
        return; }
    const float* pp = WSP(float, WS_PART) + (size_t)(r - NPR) * DM;
    row_load(O, pp, lane);
    for (int kc = 1; kc < NK; ++kc) { Row T; row_load(T, pp + (size_t)kc * 64 * DM, lane);
#pragma unroll
        for (int j = 0; j < 8; ++j) O.v[j] += T.v[j]; }
}
__device__ __forceinline__ f32x4 ld_bf4(const bf16* p) { const u32x2 w = *(const GAS u32x2*)p; return (f32x4){__uint_as_float(w.x << 16), __uint_as_float(w.x & 0xffff0000u), __uint_as_float(w.y << 16), __uint_as_float(w.y & 0xffff0000u)}; }
__device__ __forceinline__ void row_load_pool(Ctx& F, Row& O, int r, int lane) {
    if (r < NPR && (r & (SEQ - 1)) >= PBUF) { const bf16* op = WSP(bf16, WS_OUT) + (size_t)r * DM + lane * 4;
#pragma unroll
        for (int j8 = 0; j8 < 8; ++j8) { const int wlen = 2 << (j8 >> 1);
            const f32x4 cur = ld_bf4(op + j8 * 256); f32x4 sum = cur;
#pragma unroll
            for (int j = 1; j < wlen; ++j) sum += ld_bf4(op + j8 * 256 - (size_t)j * DM);
            O.v[j8] = sum * (1.f / (float)wlen) - cur; }
    } else if (r < NPR) { const int t = r & (SEQ - 1); const bf16* op = WSP(bf16, WS_OUT) + (size_t)r * DM + lane * 4;
#pragma unroll
        for (int j8 = 0; j8 < 8; ++j8) { const int wlen = 2 << (j8 >> 1), n = (t + 1) < wlen ? (t + 1) : wlen;
            const f32x4 cur = ld_bf4(op + j8 * 256); f32x4 sum = cur;
            for (int j = 1; j < n; ++j) sum += ld_bf4(op + j8 * 256 - (size_t)j * DM);
            O.v[j8] = sum * (1.f / (float)n) - cur; }
    } else { const int rs = r - NPR, b = rs >> 3, t = rs & 7; const float* pp = WSP(float, WS_PART) + lane * 4;
#pragma unroll
        for (int j8 = 0; j8 < 8; ++j8) { const int wlen = 2 << (j8 >> 1); f32x4 cur = {0.f, 0.f, 0.f, 0.f}, sum = {0.f, 0.f, 0.f, 0.f};
#pragma unroll
            for (int j = 0; j < wlen; ++j) { const int tj = t - j, pr = tj >= 0 ? rs - j : 64 + b * PBUF + PBUF + tj;
                const f32x4 g = *(const GAS f32x4*)(pp + (size_t)pr * DM + j8 * 256) + *(const GAS f32x4*)(pp + (size_t)(256 + pr) * DM + j8 * 256);
                sum += g; if (j == 0) cur = g; }
            O.v[j8] = sum * (1.f / (float)wlen) - cur; }
    }
}
template <int NK> __device__ __forceinline__ void sample_row_gather(Ctx& F, Row& O, int s) {
    constexpr int PER = NK / 8; const float* pp = WSP(float, WS_PART) + ((size_t)(F.wave * PER) * 64 + s) * DM; Row T[PER];
#pragma unroll
    for (int k = 0; k < PER; ++k) row_load(T[k], pp + (size_t)k * 64 * DM, F.lane);
    O = T[0];
#pragma unroll
    for (int k = 1; k < PER; ++k)
#pragma unroll
        for (int j = 0; j < 8; ++j) O.v[j] += T[k].v[j];
    LAS float* sl = (LAS float*)F.lds + 3 * PSET_FLOATS;
    if (F.wave > 0) {
#pragma unroll
        for (int j = 0; j < 8; ++j) *(LAS f32x4*)(sl + (F.wave - 1) * DM + j * 256 + F.lane * 4) = O.v[j]; }
    __syncthreads();
    if (F.wave == 0) {
#pragma unroll
        for (int w = 0; w < 7; ++w)
#pragma unroll
            for (int j = 0; j < 8; ++j) O.v[j] += *(const LAS f32x4*)(sl + w * DM + j * 256 + F.lane * 4); }
}
template <int L> __device__ __forceinline__ void phase_postmix(Ctx& F) {
    stage_row_params<1, L>(F);
    const int gw = F.vcu * NWAVES + F.wave, NGW = F.G * NWAVES, samp = (F.vcu < 64 && F.wave == 0) ? NPR + F.vcu : NTOK;
    bf16* Hb = WSP(bf16, WS_H); bf16* XR = WSP(bf16, WS_XR); const bf16* OUTb = WSP(bf16, WS_OUT);
    Row Xf; RowB Xb, Ob;
    if (L == 0) { row_load(Xf, x_in_row(F, gw), F.lane); rowb_load(Ob, OUTb + (size_t)gw * DM, F.lane); } else rowb_load(Xb, XR + (size_t)gw * DM, F.lane);
    for (int r = gw; r < NPR; r += NGW) {
        Row X, O, H; const int rn = r + NGW, rp = rn < NPR ? rn : (samp < NTOK ? samp : r), ro = rn < NPR ? rn : r;
        if (L == 0) { X = Xf; rowb_cvt(O, Ob); row_load(Xf, x_in_row(F, rp), F.lane); rowb_load(Ob, OUTb + (size_t)ro * DM, F.lane); }
        else { rowb_cvt(X, Xb); rowb_load(Xb, XR + (size_t)rp * DM, F.lane); row_load_pool(F, O, r, F.lane); }
        const LAS float* ps = row_pset(F, r);
        row_residual_l(X, O, ps, F.lane);
        row_store_bf16(X, XR + (size_t)r * DM, F.lane);
        row_modulate_l(H, X, ps, F.lane);
        row_store_bf16(H, Hb + (size_t)r * DM, F.lane);
    }
    Row Og; if (L == 0 && F.vcu < 64) sample_row_gather<8>(F, Og, F.vcu);
    if (samp < NTOK) { Row X, O, H; if (L == 0) { X = Xf; O = Og; } else { rowb_cvt(X, Xb); row_load_pool(F, O, samp, F.lane); }
        const LAS float* ps = row_pset(F, samp);
        row_residual_l(X, O, ps, F.lane);
        row_store_bf16(X, XR + (size_t)samp * DM, F.lane);
        row_modulate_l(H, X, ps, F.lane);
        row_store_bf16(H, Hb + (size_t)samp * DM, F.lane); }
}
template <int L> __device__ __forceinline__ void phase_postmlp(Ctx& F) {
    stage_row_params<L == 0 ? 2 : 3, L>(F);
    const int gw = F.vcu * NWAVES + F.wave, NGW = F.G * NWAVES, samp = (F.vcu < 64 && F.wave == 0) ? NPR + F.vcu : NTOK;
    bf16* XR = WSP(bf16, WS_XR); const bf16* OUTb = WSP(bf16, WS_OUT);
    RowB Xb, Ob; rowb_load(Xb, XR + (size_t)gw * DM, F.lane); rowb_load(Ob, OUTb + (size_t)gw * DM, F.lane);
    for (int r = gw; r < NPR; r += NGW) {
        Row X, O; const int rn = r + NGW, rp = rn < NPR ? rn : (samp < NTOK ? samp : r), ro = rn < NPR ? rn : r;
        rowb_cvt(X, Xb); rowb_cvt(O, Ob); rowb_load(Xb, XR + (size_t)rp * DM, F.lane); rowb_load(Ob, OUTb + (size_t)ro * DM, F.lane);
        const LAS float* ps = row_pset(F, r);
        row_residual_l(X, O, ps, F.lane);
        if (L == 0) {
            row_store_bf16(X, XR + (size_t)r * DM, F.lane);
            Row H; row_modulate_l(H, X, ps, F.lane);
            row_store_bf16(H, WSP(bf16, WS_H) + (size_t)r * DM, F.lane);
            const int t = r & (SEQ - 1); if (t >= SEQ - PBUF) row_store_f32(H, F.outp() + O_PLP + ((size_t)(r >> 12) * PBUF + (t - (SEQ - PBUF))) * DM, F.lane);
        } else row_store_f32_nt(X, F.outp() + O_YP + (size_t)r * DM, F.lane);
    }
    Row Og; if (F.vcu < 64) sample_row_gather<32>(F, Og, F.vcu);
    if (samp < NTOK) { Row X, O = Og; rowb_cvt(X, Xb);
        const LAS float* ps = row_pset(F, samp); const int rs = samp - NPR;
        row_residual_l(X, O, ps, F.lane);
        if (L == 0) {
            row_store_bf16(X, XR + (size_t)samp * DM, F.lane);
            Row H; row_modulate_l(H, X, ps, F.lane);
            row_store_bf16(H, WSP(bf16, WS_H) + (size_t)samp * DM, F.lane);
            row_store_f32(H, F.outp() + O_PLS + ((size_t)(rs >> 3) * PBUF + 7 + (rs & 7)) * DM, F.lane);
        } else row_store_f32_nt(X, F.outp() + O_YS + (size_t)rs * DM, F.lane); }
    if (L == 0) {
        const float* SP = F.in(I_SPOOL); bf16* Hb = WSP(bf16, WS_H);
        for (int i = F.vcu * NTHR + F.tid; i < DBAT * PBUF * 512; i += F.G * NTHR) { const int c4 = (i & 511) * 4, bi = i >> 9, b = bi / PBUF, k = bi - b * PBUF;
            const f32x4 v = *(const GAS f32x4*)(SP + (size_t)bi * DM + c4); u32x2 w; w.x = cvt_pk_bf16(v.x, v.y); w.y = cvt_pk_bf16(v.z, v.w);
            *(GAS u32x2*)(Hb + (size_t)(NTOK + bi) * DM + c4) = w;
            if (k >= 8) *(GAS f32x4*)(F.outp() + O_PLS + ((size_t)b * PBUF + (k - 8)) * DM + c4) = v; }
    }
}

__device__ __forceinline__ void phase_kv_prep(Ctx& F) {
    { const float* MODP = WSP(float, WS_G); float* MOD = WSP(float, WS_MOD);
      for (int i = F.vcu * NTHR + F.tid; i < NMR * 8192; i += F.G * NTHR) { const int r = i >> 13, c = i & 8191; MOD[(size_t)(1 * NMR + r) * 12288 + 4096 + c] = MODP[(size_t)r * 8192 + c] + MODP[((size_t)NMR + r) * 8192 + c]; } }
    const float* P = WSP(float, WS_P);
    for (int i = F.vcu * NTHR + F.tid; i < (NBATCH + DBAT) * BCOLS; i += F.G * NTHR) {
        const int b = i / BCOLS, c = i - b * BCOLS; const int r = b < NBATCH ? b * SEQ + SEQ - 1 : NPR + (b - NBATCH) * DSEQ + DSEQ - 1;
        F.outp()[(b < NBATCH ? O_SHP + (size_t)b * BCOLS : O_SHS + (size_t)(b - NBATCH) * BCOLS) + c] = (b < NBATCH && c < 3072) ? ldbf(WSP(bf16, WS_PBH) + (size_t)r * 3072 + c) : P[(size_t)r * PBLD + c];
    }
    { const int gw = F.vcu * NWAVES + F.wave, NGW = F.G * NWAVES; const float* mu = F.in(I_MU); bf16* LA = WSP(bf16, WS_LA);
      for (int r = gw; r < NTOK; r += NGW) {
        const float* pb = P + (size_t)r * PBLD; const float* prev; bool hp;
        if (r < NPR) { const int t = r & (SEQ - 1); hp = t > 0; prev = pb - PBLD; }
        else { const int rs = r - NPR, b = rs >> 3, t = rs & 7; hp = true; prev = t > 0 ? pb - PBLD : F.in(I_SSH) + (size_t)b * BCOLS; }
        float v[8];
        { const int c0 = 3072 + F.lane * 8; const bool act = F.lane < 56; const f32x4 z4 = {0.f, 0.f, 0.f, 0.f};
          f32x4 pa = z4, pc = z4, qa = z4, qc = z4, ma = z4, mc = z4;
          if (act) { pa = *(const GAS f32x4*)(pb + c0); pc = *(const GAS f32x4*)(pb + c0 + 4); ma = *(const GAS f32x4*)(mu + c0); mc = *(const GAS f32x4*)(mu + c0 + 4);
                     if (hp) { qa = *(const GAS f32x4*)(prev + c0); qc = *(const GAS f32x4*)(prev + c0 + 4); } }
          const f32x4 za = pa + ma * (qa - pa), zc = pc + mc * (qc - pc);
          const float kz = F.lane < 12 ? 2.f : 1.f;
#pragma unroll
          for (int j = 0; j < 8; ++j) { const float z = j < 4 ? za[j & 3] : zc[j & 3]; const float sg = 1.f / (1.f + __expf(-kz * z));
              v[j] = !act ? 0.f : (F.lane < 12 ? 2.f * sg - 1.f : (F.lane < 24 ? z : sg)); } }
        u32x4 o; o.x = cvt_pk_bf16(v[0], v[1]); o.y = cvt_pk_bf16(v[2], v[3]); o.z = cvt_pk_bf16(v[4], v[5]); o.w = cvt_pk_bf16(v[6], v[7]);
        *(GAS u32x4*)(LA + (size_t)r * 512 + F.lane * 8) = o;
      } }
}
__device__ __forceinline__ void phase_rwkv_prep(Ctx& F) {
    const float* P = WSP(float, WS_P); const float* LWO = WSP(float, WS_LWO);
    const int gw = F.vcu * NWAVES + F.wave, NGW = F.G * NWAVES;
    float* RWV = WSP(float, WS_RWV); float* SCL = WSP(float, WS_SCL);
    const float* mu = F.in(I_MU);
    for (int u = gw; u < NSM * 4; u += NGW) {
        const int r = NPR + (u >> 2), hq = u & 3;
        const float* pb = P + (size_t)r * PBLD; const float* prev; const bool hp = true;
        { const int rs = r - NPR, b = rs >> 3, t = rs & 7; prev = t > 0 ? pb - PBLD : F.in(I_SSH) + (size_t)b * BCOLS; }
        const float* lw = LWO + (size_t)r * 3072;
        float pr[4], pk[4], pv[4], qr_[4], qk[4], qv[4], lwl[4], lal[4], lgl[4];
#pragma unroll
        for (int i = 0; i < 4; ++i) { const int col = (hq * 4 + i) * 64 + F.lane;
            pr[i] = pb[col]; pk[i] = pb[1024 + col]; pv[i] = pb[2048 + col];
            qr_[i] = hp ? prev[col] : 0.f; qk[i] = hp ? prev[1024 + col] : 0.f; qv[i] = hp ? prev[2048 + col] : 0.f;
            lwl[i] = lw[col]; lal[i] = lw[1024 + col]; lgl[i] = lw[2048 + col]; }
#pragma unroll
        for (int i = 0; i < 4; ++i) { const int h = hq * 4 + i, col = h * 64 + F.lane;
            const float zr = pr[i] + mu[col] * (qr_[i] - pr[i]), zk = pk[i] + mu[1024 + col] * (qk[i] - pk[i]), zv = pv[i] + mu[2048 + col] * (qv[i] - pv[i]);
            const float wl = F.in(I_W0)[col] + lwl[i], al = F.in(I_A0)[col] + lal[i], gl = lgl[i];
            const float wlog = -softplusf_(-wl) - 0.5f, decay = __expf(-__expf(wlog));
            const float a = sigmoidf_(al);
            const float kkr = zk * F.in(I_KK)[col], kk = kkr * rsqrtf(wave_sum(kkr * kkr) + 1e-12f);
            const float k = zk * (1.f + (a - 1.f) * F.in(I_KA)[col]);
            const float bb = kk * a;
            const float bonus = wave_sum(zr * k * F.in(I_RK)[col]), beta = wave_sum(bb * zr), kappa = wave_sum(k * zr);
            float* base = RWV + ((size_t)r * HB + h) * 512;
            base[F.lane] = decay; base[64 + F.lane] = kk; base[128 + F.lane] = bb; base[192 + F.lane] = k; base[256 + F.lane] = zr; base[320 + F.lane] = zv; base[384 + F.lane] = decay * zr;
            if (F.lane == 0) { float* s_ = SCL + ((size_t)r * HB + h) * 4; s_[0] = beta; s_[1] = kappa; s_[2] = bonus; s_[3] = 0.f; }
        }
    }
}

namespace sba {
typedef short bf16x8 __attribute__((ext_vector_type(8)));
typedef short s16x4 __attribute__((ext_vector_type(4)));
typedef float f32x16 __attribute__((ext_vector_type(16)));
constexpr int SHM = 16384, LDQ = 1024;
#define SB_KSWZ(row, colB) ((row) * 256 + ((colB) ^ (((row) & 7) << 4)))
#define SB_SBAR() __builtin_amdgcn_sched_barrier(0)
__device__ __forceinline__ int v_st(int k, int c) { const int kk = (k & ~0xC) | ((k & 4) << 1) | ((k & 8) >> 1); return ((kk >> 3) * 4 + (c >> 5)) * 512 + ((kk & 7) * 32 + (c & 31)) * 2; }
__device__ __forceinline__ int v_rd_base(int lane) { return ((lane & 3) << 3) | (((lane >> 2) & 3) << 6) | (((lane >> 4) & 1) << 5) | (((lane >> 5) & 1) << 8); }
__device__ __forceinline__ int crow(int r, int hi) { return (r & 3) + 8 * (r >> 2) + 4 * hi; }
__device__ __forceinline__ void qkt(f32x16& p0, f32x16& p1, const char* Kt, int r32, int hi, const bf16x8* qr) {
    p0 = f32x16{}; p1 = f32x16{};
    const char* kb[4];
#pragma unroll
    for (int dd = 0; dd < 4; ++dd) kb[dd] = Kt + SB_KSWZ(r32, (dd * 16 + hi * 8) * 2);
#pragma unroll
    for (int d0 = 0; d0 < 8; ++d0) { const char* a = kb[d0 & 3] + (d0 >> 2) * 128;
        const bf16x8 b0 = *reinterpret_cast<const bf16x8*>(a);
        const bf16x8 b1 = *reinterpret_cast<const bf16x8*>(a + 32 * 256);
        p0 = __builtin_amdgcn_mfma_f32_32x32x16_bf16(b0, qr[d0], p0, 0, 0, 0);
        p1 = __builtin_amdgcn_mfma_f32_32x32x16_bf16(b1, qr[d0], p1, 0, 0, 0); }
}
__device__ __forceinline__ void pv_tile(f32x16* o, int vb0, bf16x8 pa0, bf16x8 pa1, bf16x8 pa2, bf16x8 pa3) {
#define SB_TRRD(dst, off) asm volatile("ds_read_b64_tr_b16 %0, %1 offset:%2" : "=&v"(dst) : "v"(vb0), "i"(off) : "memory")
#define SB_PV_D0(d0) do { s16x4 l0, l1, l2, l3, h0, h1, h2, h3; constexpr int b_ = (d0) * 512; \
        SB_TRRD(l0, b_); SB_TRRD(h0, b_ + 2048); SB_TRRD(l1, b_ + 4096); SB_TRRD(h1, b_ + 6144); SB_TRRD(l2, b_ + 8192); SB_TRRD(h2, b_ + 10240); SB_TRRD(l3, b_ + 12288); SB_TRRD(h3, b_ + 14336); \
        asm volatile("s_waitcnt lgkmcnt(0)" ::: "memory"); SB_SBAR(); \
        o[d0] = __builtin_amdgcn_mfma_f32_32x32x16_bf16(pa0, (bf16x8){l0[0], l0[1], l0[2], l0[3], h0[0], h0[1], h0[2], h0[3]}, o[d0], 0, 0, 0); \
        o[d0] = __builtin_amdgcn_mfma_f32_32x32x16_bf16(pa1, (bf16x8){l1[0], l1[1], l1[2], l1[3], h1[0], h1[1], h1[2], h1[3]}, o[d0], 0, 0, 0); \
        o[d0] = __builtin_amdgcn_mfma_f32_32x32x16_bf16(pa2, (bf16x8){l2[0], l2[1], l2[2], l2[3], h2[0], h2[1], h2[2], h2[3]}, o[d0], 0, 0, 0); \
        o[d0] = __builtin_amdgcn_mfma_f32_32x32x16_bf16(pa3, (bf16x8){l3[0], l3[1], l3[2], l3[3], h3[0], h3[1], h3[2], h3[3]}, o[d0], 0, 0, 0); } while (0)
    SB_PV_D0(0); SB_PV_D0(1); SB_PV_D0(2); SB_PV_D0(3);
#undef SB_PV_D0
#undef SB_TRRD
}
__device__ __forceinline__ float swap_other(float x, int hi) {
    auto rr = __builtin_amdgcn_permlane32_swap(__float_as_uint(x), __float_as_uint(x), false, false);
    return __uint_as_float(hi ? rr[0] : rr[1]);
}
template <bool MASK> __device__ __forceinline__ void sb_weights(f32x16& p0, f32x16& p1, float& carry, float C2, float b2, int dq, int hi) {
    float T[8];
#pragma unroll
    for (int g = 0; g < 8; ++g) {
        float iv[4], be[4];
#pragma unroll
        for (int k = 0; k < 4; ++k) { const int r = (g & 3) * 4 + k; const float s = g < 4 ? p0[r] : p1[r];
            const float z2 = fminf(fmaf(s, C2, b2), 64.f), e = __builtin_amdgcn_exp2f(z2), i_ = __builtin_amdgcn_rcpf(1.f + e); float b_ = e * i_, ii = i_;
            if (MASK) { const int c = (r & 3) + 8 * (r >> 2) + (g < 4 ? 0 : 32); const bool vis = c < dq; ii = vis ? ii : 1.f; b_ = vis ? b_ : 0.f; }
            iv[k] = ii; be[k] = b_; }
        const float ex2 = iv[3], ex1 = iv[2] * iv[3], ex0 = iv[1] * ex1; T[g] = iv[0] * ex0;
        const float w0 = be[0] * ex0, w1 = be[1] * ex1, w2 = be[2] * ex2, w3 = be[3];
        if (g < 4) { p0[(g & 3) * 4 + 0] = w0; p0[(g & 3) * 4 + 1] = w1; p0[(g & 3) * 4 + 2] = w2; p0[(g & 3) * 4 + 3] = w3; }
        else { p1[(g & 3) * 4 + 0] = w0; p1[(g & 3) * 4 + 1] = w1; p1[(g & 3) * 4 + 2] = w2; p1[(g & 3) * 4 + 3] = w3; }
    }
    float suf = carry;
#pragma unroll
    for (int g = 7; g >= 0; --g) {
        const float To = swap_other(T[g], hi);
        const float E = hi ? suf : suf * To;
#pragma unroll
        for (int k = 0; k < 4; ++k) { if (g < 4) p0[(g & 3) * 4 + k] *= E; else p1[(g & 3) * 4 + k] *= E; }
        suf = suf * (T[g] * To);
    }
    carry = suf;
}
__device__ __forceinline__ void pack_p(const f32x16& p0, const f32x16& p1, bf16x8& pa0, bf16x8& pa1, bf16x8& pa2, bf16x8& pa3) {
#define SB_PK4(P, B_, OUT) do { unsigned a0 = cvt_pk_bf16(P[B_ + 0], P[B_ + 1]), a1 = cvt_pk_bf16(P[B_ + 2], P[B_ + 3]); \
        unsigned b0 = cvt_pk_bf16(P[B_ + 4], P[B_ + 5]), b1 = cvt_pk_bf16(P[B_ + 6], P[B_ + 7]); \
        auto r0 = __builtin_amdgcn_permlane32_swap(a0, b0, false, false); auto r1 = __builtin_amdgcn_permlane32_swap(a1, b1, false, false); \
        u32x4 w = {r0[0], r1[0], r0[1], r1[1]}; OUT = *reinterpret_cast<bf16x8*>(&w); } while (0)
    SB_PK4(p0, 0, pa0); SB_PK4(p0, 8, pa1); SB_PK4(p1, 0, pa2); SB_PK4(p1, 8, pa3);
#undef SB_PK4
}
__device__ __forceinline__ void attn_half(Ctx& F, int bh, int x, int half) {
    const int tid = F.tid, wid = F.wave, lane = F.lane, r32 = lane & 31, hi = lane >> 5, b = bh >> 3, h = bh & 7;
    const bf16* Qg = WSP(bf16, WS_QB) + (size_t)(b * SEQ + 256 * x) * LDQ + h * 128;
    const bf16* Kg = WSP(bf16, WS_KB) + (size_t)(b * SEQ) * LDQ + h * 128; const bf16* Vg = WSP(bf16, WS_VB) + (size_t)(b * SEQ) * LDQ + h * 128;
    const int NT = 4 * (x + 1), t_hi = half == 0 ? NT : NT / 2, t_lo = half == 0 ? NT / 2 : 0;
    const int qlo = 256 * x + 32 * wid, qpos = qlo + r32;
    char* V_lds = (char*)F.lds; char* K_lds = (char*)F.lds + 2 * SHM;
    bf16x8 qr[8];
#pragma unroll
    for (int d0 = 0; d0 < 8; ++d0) qr[d0] = *reinterpret_cast<const bf16x8*>(Qg + (size_t)(wid * 32 + r32) * LDQ + d0 * 16 + hi * 8);
    const int sr = tid >> 4, sc = (tid & 15) * 8, vst0 = v_st(sr, sc), vst1 = v_st(32 + sr, sc), kws = SB_KSWZ(sr, sc * 2);
    const int vb0 = (int)(uintptr_t)V_lds + v_rd_base(lane);
    bf16x8 st_k0, st_k1, st_v0, st_v1;
    const unsigned so0 = (unsigned)(sr * LDQ + sc) * 2u, so1 = so0 + 32u * LDQ * 2u;
#define SB_SLOAD(t) do { const char* kt_ = (const char*)Kg + (size_t)(t) * (64 * LDQ * 2); const char* vt_ = (const char*)Vg + (size_t)(t) * (64 * LDQ * 2); \
        st_k0 = *reinterpret_cast<const bf16x8*>(kt_ + so0); st_k1 = *reinterpret_cast<const bf16x8*>(kt_ + so1); st_v0 = *reinterpret_cast<const bf16x8*>(vt_ + so0); st_v1 = *reinterpret_cast<const bf16x8*>(vt_ + so1); } while (0)
#define SB_SWRITE(bf) do { *(bf16x8*)(K_lds + (bf) * SHM + kws) = st_k0; *(bf16x8*)(K_lds + (bf) * SHM + kws + 32 * 256) = st_k1; \
        *(bf16x8*)(V_lds + (bf) * SHM + vst0) = st_v0; *(bf16x8*)(V_lds + (bf) * SHM + vst1) = st_v1; } while (0)
    __syncthreads();
    SB_SLOAD(t_hi - 1); VM_WAIT(); SB_SWRITE(0);
    __syncthreads();
    const float C2 = QK_SCALE * 1.4426950408889634f, b2 = F.in(I_SBB)[h] * 1.4426950408889634f;
    float carry = 1.f; f32x16 o[4] = {};
    int buf = 0;
    for (int t = t_hi - 1; t >= t_lo; --t) {
        if (t > t_lo) SB_SLOAD(t - 1);
        const int kb = 64 * t;
        if (kb < qlo + 31) {
            f32x16 p0, p1; bf16x8 pa0, pa1, pa2, pa3;
            qkt(p0, p1, K_lds + buf * SHM, r32, hi, qr);
            if (kb + 63 >= qlo) sb_weights<true>(p0, p1, carry, C2, b2, qpos - kb - 4 * hi, hi); else sb_weights<false>(p0, p1, carry, C2, b2, 0, hi);
            pack_p(p0, p1, pa0, pa1, pa2, pa3);
            pv_tile(o, vb0 + buf * SHM, pa0, pa1, pa2, pa3);
        }
        if (t > t_lo) { VM_WAIT(); SB_SWRITE(buf ^ 1); }
        __syncthreads();
        buf ^= 1;
    }
#undef SB_SLOAD
#undef SB_SWRITE
    float* Op = WSP(float, WS_OP) + ((size_t)half * NPR + b * SEQ + 256 * x + wid * 32) * 1024 + h * 128;
    const unsigned lo_ = (unsigned)(4 * hi * 1024 + r32);
#pragma unroll
    for (int r = 0; r < 16; ++r) { float* Opr = Op + (size_t)((r & 3) + 8 * (r >> 2)) * 1024;
#pragma unroll
        for (int d0 = 0; d0 < 4; ++d0) Opr[lo_ + d0 * 32] = o[d0][r]; }
    if (half == 0 && hi == 0) WSP(float, WS_CL)[(size_t)(b * SEQ + qpos) * HA + h] = carry;
}
#undef SB_KSWZ
#undef SB_SBAR
}
namespace sba {
__device__ __forceinline__ void sb_weights32(f32x16& p0, float& carry, float C2, float b2, int hi) {
    float T[4];
#pragma unroll
    for (int g = 0; g < 4; ++g) {
        float iv[4], be[4];
#pragma unroll
        for (int k = 0; k < 4; ++k) { const float z2 = fminf(fmaf(p0[g * 4 + k], C2, b2), 64.f), e = __builtin_amdgcn_exp2f(z2), i_ = __builtin_amdgcn_rcpf(1.f + e); iv[k] = i_; be[k] = e * i_; }
        const float ex2 = iv[3], ex1 = iv[2] * iv[3], ex0 = iv[1] * ex1; T[g] = iv[0] * ex0;
        p0[g * 4 + 0] = be[0] * ex0; p0[g * 4 + 1] = be[1] * ex1; p0[g * 4 + 2] = be[2] * ex2; p0[g * 4 + 3] = be[3];
    }
    float suf = carry;
#pragma unroll
    for (int g = 3; g >= 0; --g) { const float To = swap_other(T[g], hi); const float E = hi ? suf : suf * To;
#pragma unroll
        for (int k = 0; k < 4; ++k) p0[g * 4 + k] *= E;
        suf = suf * (T[g] * To); }
    carry = suf;
}
__device__ __forceinline__ void attn_sample_unit(Ctx& F, int bh, int pg, char* wl  ) {
    const int lane = F.lane, r32 = lane & 31, hi = lane >> 5, b = bh >> 3, h = bh & 7;
    char* K_lds = wl; char* V_lds = wl + 8192;
    bf16x8 qr[8];
    { const bf16* Qg = WSP(bf16, WS_QB) + (size_t)(NPR + b * DSEQ + (r32 & 7)) * LDQ + h * 128;
#pragma unroll
      for (int d0 = 0; d0 < 8; ++d0) { bf16x8 v = *reinterpret_cast<const bf16x8*>(Qg + d0 * 16 + hi * 8); if (r32 >= 8) v = bf16x8{}; qr[d0] = v; } }
    const int kl = lane >> 5, c4 = (lane & 31) * 4;
    const unsigned goff = (unsigned)(kl * 1024 + c4) * 4u;
    const int vb0 = (int)(uintptr_t)V_lds + v_rd_base(lane);
    const float C2 = QK_SCALE * 1.4426950408889634f, b2 = F.in(I_SBB)[h] * 1.4426950408889634f;
    const int* pt = ((const int*)F.in(I_PT)) + b * NPAGES + pg * 4;
    f32x4 sa[8], sb[8];
#define SU_BASE(n) ({ const int i_ = (n) >> 2, k_ = (n) & 3, tt_ = 15 - i_; const int phys_ = pt[tt_ >> 2]; \
        (const char*)((k_ & 2) ? F.in(I_CV) : F.in(I_CK)) + (((size_t)phys_ * PAGESZ + (tt_ & 3) * 32 + (k_ & 1) * 16) * 1024 + h * 128) * 4; })
#define SU_LOAD(S, n) do { const char* bp_ = SU_BASE(n); _Pragma("unroll") for (int j = 0; j < 8; ++j) S[j] = __builtin_nontemporal_load((const GAS f32x4*)(bp_ + goff + (size_t)j * 8192)); } while (0)
#define SU_WRK(S, kh) do { _Pragma("unroll") for (int j = 0; j < 8; ++j) { const int key = (kh) * 16 + 2 * j + kl; u32x2 w; w.x = cvt_pk_bf16(S[j].x, S[j].y); w.y = cvt_pk_bf16(S[j].z, S[j].w); \
        *(u32x2*)(K_lds + (key * 256 + ((c4 * 2) ^ ((key & 7) << 4)))) = w; } } while (0)
#define SU_WRV(S, kh) do { _Pragma("unroll") for (int j = 0; j < 8; ++j) { const int key = (kh) * 16 + 2 * j + kl; u32x2 w; w.x = cvt_pk_bf16(S[j].x, S[j].y); w.y = cvt_pk_bf16(S[j].z, S[j].w); \
        *(u32x2*)(V_lds + v_st(key, c4)) = w; } } while (0)
    SU_LOAD(sa, 0); SU_LOAD(sb, 1);
    float carry = 1.f; f32x16 o[4] = {};
    for (int i = 0; i < 16; ++i) {
        asm volatile("s_waitcnt vmcnt(8)" ::: "memory"); SU_WRK(sa, 0); SU_LOAD(sa, 4 * i + 2);
        asm volatile("s_waitcnt vmcnt(8)" ::: "memory"); SU_WRK(sb, 1); SU_LOAD(sb, 4 * i + 3);
        asm volatile("s_waitcnt vmcnt(8)" ::: "memory"); SU_WRV(sa, 0); if (i < 15) SU_LOAD(sa, 4 * i + 4);
        if (i < 15) asm volatile("s_waitcnt vmcnt(8)" ::: "memory"); else asm volatile("s_waitcnt vmcnt(0)" ::: "memory");
        SU_WRV(sb, 1); if (i < 15) SU_LOAD(sb, 4 * i + 5);
        asm volatile("s_waitcnt lgkmcnt(0)" ::: "memory");
        f32x16 p0 = f32x16{};
        { const char* kb[4];
#pragma unroll
          for (int dd = 0; dd < 4; ++dd) kb[dd] = K_lds + (r32 * 256 + (((dd * 16 + hi * 8) * 2) ^ ((r32 & 7) << 4)));
#pragma unroll
          for (int d0 = 0; d0 < 8; ++d0) { const bf16x8 b0 = *reinterpret_cast<const bf16x8*>(kb[d0 & 3] + (d0 >> 2) * 128); p0 = __builtin_amdgcn_mfma_f32_32x32x16_bf16(b0, qr[d0], p0, 0, 0, 0); } }
        sb_weights32(p0, carry, C2, b2, hi);
        bf16x8 pa0, pa1;
        { unsigned a0 = cvt_pk_bf16(p0[0], p0[1]), a1 = cvt_pk_bf16(p0[2], p0[3]), b0 = cvt_pk_bf16(p0[4], p0[5]), b1 = cvt_pk_bf16(p0[6], p0[7]);
          auto r0 = __builtin_amdgcn_permlane32_swap(a0, b0, false, false); auto r1 = __builtin_amdgcn_permlane32_swap(a1, b1, false, false);
          u32x4 w = {r0[0], r1[0], r0[1], r1[1]}; pa0 = *reinterpret_cast<bf16x8*>(&w); }
        { unsigned a0 = cvt_pk_bf16(p0[8], p0[9]), a1 = cvt_pk_bf16(p0[10], p0[11]), b0 = cvt_pk_bf16(p0[12], p0[13]), b1 = cvt_pk_bf16(p0[14], p0[15]);
          auto r0 = __builtin_amdgcn_permlane32_swap(a0, b0, false, false); auto r1 = __builtin_amdgcn_permlane32_swap(a1, b1, false, false);
          u32x4 w = {r0[0], r1[0], r0[1], r1[1]}; pa1 = *reinterpret_cast<bf16x8*>(&w); }
#define SU_TRRD(dst, off) asm volatile("ds_read_b64_tr_b16 %0, %1 offset:%2" : "=&v"(dst) : "v"(vb0), "i"(off) : "memory")
#define SU_PV(d0) do { s16x4 l0, l1, h0, h1; constexpr int b_ = (d0) * 512; SU_TRRD(l0, b_); SU_TRRD(h0, b_ + 2048); SU_TRRD(l1, b_ + 4096); SU_TRRD(h1, b_ + 6144); \
        asm volatile("s_waitcnt lgkmcnt(0)" ::: "memory"); __builtin_amdgcn_sched_barrier(0); \
        o[d0] = __builtin_amdgcn_mfma_f32_32x32x16_bf16(pa0, (bf16x8){l0[0], l0[1], l0[2], l0[3], h0[0], h0[1], h0[2], h0[3]}, o[d0], 0, 0, 0); \
        o[d0] = __builtin_amdgcn_mfma_f32_32x32x16_bf16(pa1, (bf16x8){l1[0], l1[1], l1[2], l1[3], h1[0], h1[1], h1[2], h1[3]}, o[d0], 0, 0, 0); } while (0)
        SU_PV(0); SU_PV(1); SU_PV(2); SU_PV(3);
        asm volatile("s_waitcnt lgkmcnt(0)" ::: "memory");
    }
#undef SU_PV
#undef SU_TRRD
#undef SU_WRV
#undef SU_WRK
#undef SU_LOAD
#undef SU_BASE
    float* Sp = WSP(float, WS_SPART) + ((size_t)(bh * 32 + pg) * 8) * 128;
#pragma unroll
    for (int r = 0; r < 4; ++r)
#pragma unroll
        for (int d0 = 0; d0 < 4; ++d0) Sp[(size_t)(r + 4 * hi) * 128 + d0 * 32 + r32] = o[d0][r];
    if (hi == 0 && r32 < 8) WSP(float, WS_SCAR)[(size_t)(bh * 32 + pg) * 8 + r32] = carry;
}
}
__device__ __forceinline__ void sample_combine(Ctx& F) {
    const int gw = F.vcu * NWAVES + F.wave, NGW = F.G * NWAVES; bf16* OAB = WSP(bf16, WS_OAB);
    const float* SPt = WSP(float, WS_SPART); const float* SCr = WSP(float, WS_SCAR);
    for (int task = gw; task < DBAT * HA * DSEQ; task += NGW) { const int bh = task >> 3, i = task & 7, b = bh >> 3, h = bh & 7; const float bias = F.in(I_SBB)[h];
        f32x2 po[32]; float sc[32];
#pragma unroll
        for (int pg = 0; pg < 32; ++pg) { po[pg] = *(const GAS f32x2*)(SPt + ((size_t)(bh * 32 + pg) * 8 + i) * 128 + 2 * F.lane); sc[pg] = SCr[(size_t)(bh * 32 + pg) * 8 + i]; }
        f32x2 q; { const unsigned qw = *(const GAS unsigned*)(WSP(bf16, WS_QB) + (size_t)(NPR + b * DSEQ + i) * 1024 + h * 128 + 2 * F.lane); q.x = __uint_as_float(qw << 16); q.y = __uint_as_float(qw & 0xffff0000u); }
        float carry = 1.f, a0 = 0.f, a1 = 0.f;
        for (int j = i - 1; j >= 0; --j) { const size_t ko = (size_t)(b * DSEQ + j) * 1024 + h * 128 + 2 * F.lane; const f32x2 k = *(const GAS f32x2*)(F.outp() + O_KS + ko), v = *(const GAS f32x2*)(F.outp() + O_VS + ko);
            const float z = wave_sum(q.x * k.x + q.y * k.y) * QK_SCALE + bias, e = __expf(fminf(z, 40.f)), om = 1.f / (1.f + e), w = e * om * carry;
            a0 += w * v.x; a1 += w * v.y; carry *= om; }
#pragma unroll
        for (int pg = 31; pg >= 0; --pg) { a0 += carry * po[pg].x; a1 += carry * po[pg].y; carry *= sc[pg]; }
        *(GAS unsigned*)(OAB + (size_t)(NPR + b * DSEQ + i) * DM + h * 128 + 2 * F.lane) = cvt_pk_bf16(a0, a1);
    }
}
__device__ __forceinline__ void phase_attn_prompt(Ctx& F) {
    for (int it2 = 2 * F.vcu; it2 < 2 * NBATCH * HA * 16; it2 += (it2 & 1) ? 2 * F.G - 1 : 1) { const int item = it2 >> 1, half = it2 & 1, bh = item >> 4, x = item & 15;
        sba::attn_half(F, bh, half ? 15 - x : x, half); }
    __syncthreads();
}
__device__ __forceinline__ void dots16(float& sig, float& rho, float kkv, float wrv, const float (&s)[16]) {
    asm("s_nop 1\n\t"
        "v_fmac_f32_dpp %0, %2, %4 row_newbcast:0 row_mask:0xf bank_mask:0xf\n\t"
        "v_fmac_f32_dpp %1, %3, %4 row_newbcast:0 row_mask:0xf bank_mask:0xf\n\t"
        "v_fmac_f32_dpp %0, %2, %5 row_newbcast:1 row_mask:0xf bank_mask:0xf\n\t"
        "v_fmac_f32_dpp %1, %3, %5 row_newbcast:1 row_mask:0xf bank_mask:0xf\n\t"
        "v_fmac_f32_dpp %0, %2, %6 row_newbcast:2 row_mask:0xf bank_mask:0xf\n\t"
        "v_fmac_f32_dpp %1, %3, %6 row_newbcast:2 row_mask:0xf bank_mask:0xf\n\t"
        "v_fmac_f32_dpp %0, %2, %7 row_newbcast:3 row_mask:0xf bank_mask:0xf\n\t"
        "v_fmac_f32_dpp %1, %3, %7 row_newbcast:3 row_mask:0xf bank_mask:0xf\n\t"
        "v_fmac_f32_dpp %0, %2, %8 row_newbcast:4 row_mask:0xf bank_mask:0xf\n\t"
        "v_fmac_f32_dpp %1, %3, %8 row_newbcast:4 row_mask:0xf bank_mask:0xf\n\t"
        "v_fmac_f32_dpp %0, %2, %9 row_newbcast:5 row_mask:0xf bank_mask:0xf\n\t"
        "v_fmac_f32_dpp %1, %3, %9 row_newbcast:5 row_mask:0xf bank_mask:0xf\n\t"
        "v_fmac_f32_dpp %0, %2, %10 row_newbcast:6 row_mask:0xf bank_mask:0xf\n\t"
        "v_fmac_f32_dpp %1, %3, %10 row_newbcast:6 row_mask:0xf bank_mask:0xf\n\t"
        "v_fmac_f32_dpp %0, %2, %11 row_newbcast:7 row_mask:0xf bank_mask:0xf\n\t"
        "v_fmac_f32_dpp %1, %3, %11 row_newbcast:7 row_mask:0xf bank_mask:0xf\n\t"
        "v_fmac_f32_dpp %0, %2, %12 row_newbcast:8 row_mask:0xf bank_mask:0xf\n\t"
        "v_fmac_f32_dpp %1, %3, %12 row_newbcast:8 row_mask:0xf bank_mask:0xf\n\t"
        "v_fmac_f32_dpp %0, %2, %13 row_newbcast:9 row_mask:0xf bank_mask:0xf\n\t"
        "v_fmac_f32_dpp %1, %3, %13 row_newbcast:9 row_mask:0xf bank_mask:0xf\n\t"
        "v_fmac_f32_dpp %0, %2, %14 row_newbcast:10 row_mask:0xf bank_mask:0xf\n\t"
        "v_fmac_f32_dpp %1, %3, %14 row_newbcast:10 row_mask:0xf bank_mask:0xf\n\t"
        "v_fmac_f32_dpp %0, %2, %15 row_newbcast:11 row_mask:0xf bank_mask:0xf\n\t"
        "v_fmac_f32_dpp %1, %3, %15 row_newbcast:11 row_mask:0xf bank_mask:0xf\n\t"
        "v_fmac_f32_dpp %0, %2, %16 row_newbcast:12 row_mask:0xf bank_mask:0xf\n\t"
        "v_fmac_f32_dpp %1, %3, %16 row_newbcast:12 row_mask:0xf bank_mask:0xf\n\t"
        "v_fmac_f32_dpp %0, %2, %17 row_newbcast:13 row_mask:0xf bank_mask:0xf\n\t"
        "v_fmac_f32_dpp %1, %3, %17 row_newbcast:13 row_mask:0xf bank_mask:0xf\n\t"
        "v_fmac_f32_dpp %0, %2, %18 row_newbcast:14 row_mask:0xf bank_mask:0xf\n\t"
        "v_fmac_f32_dpp %1, %3, %18 row_newbcast:14 row_mask:0xf bank_mask:0xf\n\t"
        "v_fmac_f32_dpp %0, %2, %19 row_newbcast:15 row_mask:0xf bank_mask:0xf\n\t"
        "v_fmac_f32_dpp %1, %3, %19 row_newbcast:15 row_mask:0xf bank_mask:0xf\n\t"
        "s_nop 1"
        : "+v"(sig), "+v"(rho) : "v"(kkv), "v"(wrv), "v"(s[0]), "v"(s[1]), "v"(s[2]), "v"(s[3]), "v"(s[4]), "v"(s[5]), "v"(s[6]), "v"(s[7]), "v"(s[8]), "v"(s[9]), "v"(s[10]), "v"(s[11]), "v"(s[12]), "v"(s[13]), "v"(s[14]), "v"(s[15]));
}
__device__ __forceinline__ void dot16(float& acc, float zv, const float (&s)[16]) {
    asm("s_nop 1\n\t"
        "v_fmac_f32_dpp %0, %1, %2 row_newbcast:0 row_mask:0xf bank_mask:0xf\n\t"
        "v_fmac_f32_dpp %0, %1, %3 row_newbcast:1 row_mask:0xf bank_mask:0xf\n\t"
        "v_fmac_f32_dpp %0, %1, %4 row_newbcast:2 row_mask:0xf bank_mask:0xf\n\t"
        "v_fmac_f32_dpp %0, %1, %5 row_newbcast:3 row_mask:0xf bank_mask:0xf\n\t"
        "v_fmac_f32_dpp %0, %1, %6 row_newbcast:4 row_mask:0xf bank_mask:0xf\n\t"
        "v_fmac_f32_dpp %0, %1, %7 row_newbcast:5 row_mask:0xf bank_mask:0xf\n\t"
        "v_fmac_f32_dpp %0, %1, %8 row_newbcast:6 row_mask:0xf bank_mask:0xf\n\t"
        "v_fmac_f32_dpp %0, %1, %9 row_newbcast:7 row_mask:0xf bank_mask:0xf\n\t"
        "v_fmac_f32_dpp %0, %1, %10 row_newbcast:8 row_mask:0xf bank_mask:0xf\n\t"
        "v_fmac_f32_dpp %0, %1, %11 row_newbcast:9 row_mask:0xf bank_mask:0xf\n\t"
        "v_fmac_f32_dpp %0, %1, %12 row_newbcast:10 row_mask:0xf bank_mask:0xf\n\t"
        "v_fmac_f32_dpp %0, %1, %13 row_newbcast:11 row_mask:0xf bank_mask:0xf\n\t"
        "v_fmac_f32_dpp %0, %1, %14 row_newbcast:12 row_mask:0xf bank_mask:0xf\n\t"
        "v_fmac_f32_dpp %0, %1, %15 row_newbcast:13 row_mask:0xf bank_mask:0xf\n\t"
        "v_fmac_f32_dpp %0, %1, %16 row_newbcast:14 row_mask:0xf bank_mask:0xf\n\t"
        "v_fmac_f32_dpp %0, %1, %17 row_newbcast:15 row_mask:0xf bank_mask:0xf\n\t"
        "s_nop 1"
        : "+v"(acc) : "v"(zv), "v"(s[0]), "v"(s[1]), "v"(s[2]), "v"(s[3]), "v"(s[4]), "v"(s[5]), "v"(s[6]), "v"(s[7]), "v"(s[8]), "v"(s[9]), "v"(s[10]), "v"(s[11]), "v"(s[12]), "v"(s[13]), "v"(s[14]), "v"(s[15]));
}
__device__ __forceinline__ void upd16_v(float (&s)[16], float wv, float kv, float bv, float vv, float ns) {
    asm("s_nop 1\n\t"
        "v_mul_f32_dpp %0, %16, %0 row_newbcast:0 row_mask:0xf bank_mask:0xf\n\t"
        "v_mul_f32_dpp %1, %16, %1 row_newbcast:1 row_mask:0xf bank_mask:0xf\n\t"
        "v_mul_f32_dpp %2, %16, %2 row_newbcast:2 row_mask:0xf bank_mask:0xf\n\t"
        "v_mul_f32_dpp %3, %16, %3 row_newbcast:3 row_mask:0xf bank_mask:0xf\n\t"
        "v_mul_f32_dpp %4, %16, %4 row_newbcast:4 row_mask:0xf bank_mask:0xf\n\t"
        "v_mul_f32_dpp %5, %16, %5 row_newbcast:5 row_mask:0xf bank_mask:0xf\n\t"
        "v_mul_f32_dpp %6, %16, %6 row_newbcast:6 row_mask:0xf bank_mask:0xf\n\t"
        "v_mul_f32_dpp %7, %16, %7 row_newbcast:7 row_mask:0xf bank_mask:0xf\n\t"
        "v_mul_f32_dpp %8, %16, %8 row_newbcast:8 row_mask:0xf bank_mask:0xf\n\t"
        "v_mul_f32_dpp %9, %16, %9 row_newbcast:9 row_mask:0xf bank_mask:0xf\n\t"
        "v_mul_f32_dpp %10, %16, %10 row_newbcast:10 row_mask:0xf bank_mask:0xf\n\t"
        "v_mul_f32_dpp %11, %16, %11 row_newbcast:11 row_mask:0xf bank_mask:0xf\n\t"
        "v_mul_f32_dpp %12, %16, %12 row_newbcast:12 row_mask:0xf bank_mask:0xf\n\t"
        "v_mul_f32_dpp %13, %16, %13 row_newbcast:13 row_mask:0xf bank_mask:0xf\n\t"
        "v_mul_f32_dpp %14, %16, %14 row_newbcast:14 row_mask:0xf bank_mask:0xf\n\t"
        "v_mul_f32_dpp %15, %16, %15 row_newbcast:15 row_mask:0xf bank_mask:0xf\n\t"
        "v_fmac_f32_dpp %0, %17, %19 row_newbcast:0 row_mask:0xf bank_mask:0xf\n\t"
        "v_fmac_f32_dpp %1, %17, %19 row_newbcast:1 row_mask:0xf bank_mask:0xf\n\t"
        "v_fmac_f32_dpp %2, %17, %19 row_newbcast:2 row_mask:0xf bank_mask:0xf\n\t"
        "v_fmac_f32_dpp %3, %17, %19 row_newbcast:3 row_mask:0xf bank_mask:0xf\n\t"
        "v_fmac_f32_dpp %4, %17, %19 row_newbcast:4 row_mask:0xf bank_mask:0xf\n\t"
        "v_fmac_f32_dpp %5, %17, %19 row_newbcast:5 row_mask:0xf bank_mask:0xf\n\t"
        "v_fmac_f32_dpp %6, %17, %19 row_newbcast:6 row_mask:0xf bank_mask:0xf\n\t"
        "v_fmac_f32_dpp %7, %17, %19 row_newbcast:7 row_mask:0xf bank_mask:0xf\n\t"
        "v_fmac_f32_dpp %8, %17, %19 row_newbcast:8 row_mask:0xf bank_mask:0xf\n\t"
        "v_fmac_f32_dpp %9, %17, %19 row_newbcast:9 row_mask:0xf bank_mask:0xf\n\t"
        "v_fmac_f32_dpp %10, %17, %19 row_newbcast:10 row_mask:0xf bank_mask:0xf\n\t"
        "v_fmac_f32_dpp %11, %17, %19 row_newbcast:11 row_mask:0xf bank_mask:0xf\n\t"
        "v_fmac_f32_dpp %12, %17, %19 row_newbcast:12 row_mask:0xf bank_mask:0xf\n\t"
        "v_fmac_f32_dpp %13, %17, %19 row_newbcast:13 row_mask:0xf bank_mask:0xf\n\t"
        "v_fmac_f32_dpp %14, %17, %19 row_newbcast:14 row_mask:0xf bank_mask:0xf\n\t"
        "v_fmac_f32_dpp %15, %17, %19 row_newbcast:15 row_mask:0xf bank_mask:0xf\n\t"
        "v_fmac_f32_dpp %0, %18, %20 row_newbcast:0 row_mask:0xf bank_mask:0xf\n\t"
        "v_fmac_f32_dpp %1, %18, %20 row_newbcast:1 row_mask:0xf bank_mask:0xf\n\t"
        "v_fmac_f32_dpp %2, %18, %20 row_newbcast:2 row_mask:0xf bank_mask:0xf\n\t"
        "v_fmac_f32_dpp %3, %18, %20 row_newbcast:3 row_mask:0xf bank_mask:0xf\n\t"
        "v_fmac_f32_dpp %4, %18, %20 row_newbcast:4 row_mask:0xf bank_mask:0xf\n\t"
        "v_fmac_f32_dpp %5, %18, %20 row_newbcast:5 row_mask:0xf bank_mask:0xf\n\t"
        "v_fmac_f32_dpp %6, %18, %20 row_newbcast:6 row_mask:0xf bank_mask:0xf\n\t"
        "v_fmac_f32_dpp %7, %18, %20 row_newbcast:7 row_mask:0xf bank_mask:0xf\n\t"
        "v_fmac_f32_dpp %8, %18, %20 row_newbcast:8 row_mask:0xf bank_mask:0xf\n\t"
        "v_fmac_f32_dpp %9, %18, %20 row_newbcast:9 row_mask:0xf bank_mask:0xf\n\t"
        "v_fmac_f32_dpp %10, %18, %20 row_newbcast:10 row_mask:0xf bank_mask:0xf\n\t"
        "v_fmac_f32_dpp %11, %18, %20 row_newbcast:11 row_mask:0xf bank_mask:0xf\n\t"
        "v_fmac_f32_dpp %12, %18, %20 row_newbcast:12 row_mask:0xf bank_mask:0xf\n\t"
        "v_fmac_f32_dpp %13, %18, %20 row_newbcast:13 row_mask:0xf bank_mask:0xf\n\t"
        "v_fmac_f32_dpp %14, %18, %20 row_newbcast:14 row_mask:0xf bank_mask:0xf\n\t"
        "v_fmac_f32_dpp %15, %18, %20 row_newbcast:15 row_mask:0xf bank_mask:0xf\n\t"
        "s_nop 1"
        : "+v"(s[0]), "+v"(s[1]), "+v"(s[2]), "+v"(s[3]), "+v"(s[4]), "+v"(s[5]), "+v"(s[6]), "+v"(s[7]), "+v"(s[8]), "+v"(s[9]), "+v"(s[10]), "+v"(s[11]), "+v"(s[12]), "+v"(s[13]), "+v"(s[14]), "+v"(s[15]) : "v"(wv), "v"(kv), "v"(bv), "v"(vv), "v"(ns));
}
__device__ __forceinline__ void upd16_nov(float (&s)[16], float wv, float kv, float bv, float vv, float ns) {
    asm("s_nop 1\n\t"
        "v_mul_f32_dpp %0, %16, %0 row_newbcast:0 row_mask:0xf bank_mask:0xf\n\t"
        "v_mul_f32_dpp %1, %16, %1 row_newbcast:1 row_mask:0xf bank_mask:0xf\n\t"
        "v_mul_f32_dpp %2, %16, %2 row_newbcast:2 row_mask:0xf bank_mask:0xf\n\t"
        "v_mul_f32_dpp %3, %16, %3 row_newbcast:3 row_mask:0xf bank_mask:0xf\n\t"
        "v_mul_f32_dpp %4, %16, %4 row_newbcast:4 row_mask:0xf bank_mask:0xf\n\t"
        "v_mul_f32_dpp %5, %16, %5 row_newbcast:5 row_mask:0xf bank_mask:0xf\n\t"
        "v_mul_f32_dpp %6, %16, %6 row_newbcast:6 row_mask:0xf bank_mask:0xf\n\t"
        "v_mul_f32_dpp %7, %16, %7 row_newbcast:7 row_mask:0xf bank_mask:0xf\n\t"
        "v_mul_f32_dpp %8, %16, %8 row_newbcast:8 row_mask:0xf bank_mask:0xf\n\t"
        "v_mul_f32_dpp %9, %16, %9 row_newbcast:9 row_mask:0xf bank_mask:0xf\n\t"
        "v_mul_f32_dpp %10, %16, %10 row_newbcast:10 row_mask:0xf bank_mask:0xf\n\t"
        "v_mul_f32_dpp %11, %16, %11 row_newbcast:11 row_mask:0xf bank_mask:0xf\n\t"
        "v_mul_f32_dpp %12, %16, %12 row_newbcast:12 row_mask:0xf bank_mask:0xf\n\t"
        "v_mul_f32_dpp %13, %16, %13 row_newbcast:13 row_mask:0xf bank_mask:0xf\n\t"
        "v_mul_f32_dpp %14, %16, %14 row_newbcast:14 row_mask:0xf bank_mask:0xf\n\t"
        "v_mul_f32_dpp %15, %16, %15 row_newbcast:15 row_mask:0xf bank_mask:0xf\n\t"
        "v_fmac_f32_dpp %0, %18, %20 row_newbcast:0 row_mask:0xf bank_mask:0xf\n\t"
        "v_fmac_f32_dpp %1, %18, %20 row_newbcast:1 row_mask:0xf bank_mask:0xf\n\t"
        "v_fmac_f32_dpp %2, %18, %20 row_newbcast:2 row_mask:0xf bank_mask:0xf\n\t"
        "v_fmac_f32_dpp %3, %18, %20 row_newbcast:3 row_mask:0xf bank_mask:0xf\n\t"
        "v_fmac_f32_dpp %4, %18, %20 row_newbcast:4 row_mask:0xf bank_mask:0xf\n\t"
        "v_fmac_f32_dpp %5, %18, %20 row_newbcast:5 row_mask:0xf bank_mask:0xf\n\t"
        "v_fmac_f32_dpp %6, %18, %20 row_newbcast:6 row_mask:0xf bank_mask:0xf\n\t"
        "v_fmac_f32_dpp %7, %18, %20 row_newbcast:7 row_mask:0xf bank_mask:0xf\n\t"
        "v_fmac_f32_dpp %8, %18, %20 row_newbcast:8 row_mask:0xf bank_mask:0xf\n\t"
        "v_fmac_f32_dpp %9, %18, %20 row_newbcast:9 row_mask:0xf bank_mask:0xf\n\t"
        "v_fmac_f32_dpp %10, %18, %20 row_newbcast:10 row_mask:0xf bank_mask:0xf\n\t"
        "v_fmac_f32_dpp %11, %18, %20 row_newbcast:11 row_mask:0xf bank_mask:0xf\n\t"
        "v_fmac_f32_dpp %12, %18, %20 row_newbcast:12 row_mask:0xf bank_mask:0xf\n\t"
        "v_fmac_f32_dpp %13, %18, %20 row_newbcast:13 row_mask:0xf bank_mask:0xf\n\t"
        "v_fmac_f32_dpp %14, %18, %20 row_newbcast:14 row_mask:0xf bank_mask:0xf\n\t"
        "v_fmac_f32_dpp %15, %18, %20 row_newbcast:15 row_mask:0xf bank_mask:0xf\n\t"
        "s_nop 1"
        : "+v"(s[0]), "+v"(s[1]), "+v"(s[2]), "+v"(s[3]), "+v"(s[4]), "+v"(s[5]), "+v"(s[6]), "+v"(s[7]), "+v"(s[8]), "+v"(s[9]), "+v"(s[10]), "+v"(s[11]), "+v"(s[12]), "+v"(s[13]), "+v"(s[14]), "+v"(s[15]) : "v"(wv), "v"(kv), "v"(bv), "v"(vv), "v"(ns));
}
__device__ __forceinline__ float xrow16_sum(float x) {
    auto s = __builtin_amdgcn_permlane16_swap(__float_as_uint(x), __float_as_uint(x), false, false);
    x = __uint_as_float(s[0]) + __uint_as_float(s[1]);
    auto t = __builtin_amdgcn_permlane32_swap(__float_as_uint(x), __float_as_uint(x), false, false);
    return __uint_as_float(t[0]) + __uint_as_float(t[1]);
}
struct StepIn { float wv, kkv, bv, kv, wrv, vv, beta, kappa; };
template <bool PROW> __device__ __forceinline__ void scan_load(StepIn& x, const float* RWV, const float* SCL, int r, int h, int lane, int row) {
    const float* base = RWV + ((size_t)r * HB + h) * 512; const float* sc = SCL + ((size_t)r * HB + h) * 4;
    x.wv = base[lane]; x.kkv = base[64 + lane]; x.bv = base[128 + lane]; x.wrv = base[384 + lane]; x.beta = sc[0];
    if (!PROW) { x.kv = base[192 + lane]; x.vv = base[320 + row]; x.kappa = sc[1]; } else { x.kv = 0.f; x.vv = 0.f; x.kappa = 0.f; }
}
template <bool PROW, bool SAMP> __device__ __forceinline__ void scan_wave(Ctx& F, int bh, int c, int g) {
    const int lane = F.lane, q = lane >> 4, m = lane & 15, row = 16 * g + m, h = bh & 15, b = bh >> 4;
    constexpr int L = SAMP ? DSEQ : 64; const int r0 = SAMP ? NPR + b * DSEQ : b * SEQ + c * 64; const int ch = bh * 64 + c;
    const float* RWV = WSP(float, WS_RWV); const float* SCL = WSP(float, WS_SCL); float* Y = WSP(float, WS_Y); float* Z = WSP(float, WS_Z); float* PU = WSP(float, WS_PU);
    float s[16];
    if (SAMP) { const float* st = F.in(I_SWKV) + ((size_t)bh * 64 + row) * 64 + 16 * q;
#pragma unroll
        for (int i = 0; i < 16; i += 4) { const f32x4 v = *(const GAS f32x4*)(st + i); s[i] = v.x; s[i + 1] = v.y; s[i + 2] = v.z; s[i + 3] = v.w; } }
    else {
#pragma unroll
        for (int i = 0; i < 16; ++i) s[i] = (PROW && (16 * q + i) == row) ? 1.f : 0.f; }
    StepIn buf[4];
#pragma unroll
    for (int u = 0; u < 4; ++u) scan_load<PROW>(buf[u], RWV, SCL, r0 + u, h, lane, row);
    for (int t = 0; t < L; t += 4) {
#pragma unroll
        for (int u = 0; u < 4; ++u) {
            const StepIn x = buf[u];
            if (t + u + 4 < L) scan_load<PROW>(buf[u], RWV, SCL, r0 + t + u + 4, h, lane, row);
            float sig = 0.f, rho = 0.f;
            dots16(sig, rho, x.kkv, x.wrv, s);
            sig = xrow16_sum(sig); rho = xrow16_sum(rho);
            const float ns = -sig;
            float y = rho + ns * x.beta; if (!PROW) y += x.vv * x.kappa;
            if (q == 0) { if (PROW) Z[((size_t)ch * 64 + t + u) * 64 + row] = y; else Y[(size_t)(r0 + t + u) * 1024 + h * 64 + row] = y; }
            if (PROW) upd16_nov(s, x.wv, x.kv, x.bv, x.vv, ns); else upd16_v(s, x.wv, x.kv, x.bv, x.vv, ns);
        }
    }
    float* dst = SAMP ? F.outp() + O_WKVS + ((size_t)bh * 64 + row) * 64 + 16 * q : PU + (((size_t)ch * 2 + (PROW ? 1 : 0)) * 64 + row) * 64 + 16 * q;
#pragma unroll
    for (int i = 0; i < 16; i += 4) *(GAS f32x4*)(dst + i) = (f32x4){s[i], s[i + 1], s[i + 2], s[i + 3]};
}
__device__ __forceinline__ void dots2_h0(float& sgu, float& rhu, float& sgp, float& rhp, float kkv, float wrv, const float (&su)[16], const float (&sp)[16]) {
    asm("s_nop 1\n\t"
        "v_fmac_f32_dpp %0, %4, %6 row_newbcast:0 row_mask:0xf bank_mask:0xf\n\t"
        "v_fmac_f32_dpp %1, %5, %6 row_newbcast:0 row_mask:0xf bank_mask:0xf\n\t"
        "v_fmac_f32_dpp %2, %4, %14 row_newbcast:0 row_mask:0xf bank_mask:0xf\n\t"
        "v_fmac_f32_dpp %3, %5, %14 row_newbcast:0 row_mask:0xf bank_mask:0xf\n\t"
        "v_fmac_f32_dpp %0, %4, %7 row_newbcast:1 row_mask:0xf bank_mask:0xf\n\t"
        "v_fmac_f32_dpp %1, %5, %7 row_newbcast:1 row_mask:0xf bank_mask:0xf\n\t"
        "v_fmac_f32_dpp %2, %4, %15 row_newbcast:1 row_mask:0xf bank_mask:0xf\n\t"
        "v_fmac_f32_dpp %3, %5, %15 row_newbcast:1 row_mask:0xf bank_mask:0xf\n\t"
        "v_fmac_f32_dpp %0, %4, %8 row_newbcast:2 row_mask:0xf bank_mask:0xf\n\t"
        "v_fmac_f32_dpp %1, %5, %8 row_newbcast:2 row_mask:0xf bank_mask:0xf\n\t"
        "v_fmac_f32_dpp %2, %4, %16 row_newbcast:2 row_mask:0xf bank_mask:0xf\n\t"
        "v_fmac_f32_dpp %3, %5, %16 row_newbcast:2 row_mask:0xf bank_mask:0xf\n\t"
        "v_fmac_f32_dpp %0, %4, %9 row_newbcast:3 row_mask:0xf bank_mask:0xf\n\t"
        "v_fmac_f32_dpp %1, %5, %9 row_newbcast:3 row_mask:0xf bank_mask:0xf\n\t"
        "v_fmac_f32_dpp %2, %4, %17 row_newbcast:3 row_mask:0xf bank_mask:0xf\n\t"
        "v_fmac_f32_dpp %3, %5, %17 row_newbcast:3 row_mask:0xf bank_mask:0xf\n\t"
        "v_fmac_f32_dpp %0, %4, %10 row_newbcast:4 row_mask:0xf bank_mask:0xf\n\t"
        "v_fmac_f32_dpp %1, %5, %10 row_newbcast:4 row_mask:0xf bank_mask:0xf\n\t"
        "v_fmac_f32_dpp %2, %4, %18 row_newbcast:4 row_mask:0xf bank_mask:0xf\n\t"
        "v_fmac_f32_dpp %3, %5, %18 row_newbcast:4 row_mask:0xf bank_mask:0xf\n\t"
        "v_fmac_f32_dpp %0, %4, %11 row_newbcast:5 row_mask:0xf bank_mask:0xf\n\t"
        "v_fmac_f32_dpp %1, %5, %11 row_newbcast:5 row_mask:0xf bank_mask:0xf\n\t"
        "v_fmac_f32_dpp %2, %4, %19 row_newbcast:5 row_mask:0xf bank_mask:0xf\n\t"
        "v_fmac_f32_dpp %3, %5, %19 row_newbcast:5 row_mask:0xf bank_mask:0xf\n\t"
        "v_fmac_f32_dpp %0, %4, %12 row_newbcast:6 row_mask:0xf bank_mask:0xf\n\t"
        "v_fmac_f32_dpp %1, %5, %12 row_newbcast:6 row_mask:0xf bank_mask:0xf\n\t"
        "v_fmac_f32_dpp %2, %4, %20 row_newbcast:6 row_mask:0xf bank_mask:0xf\n\t"
        "v_fmac_f32_dpp %3, %5, %20 row_newbcast:6 row_mask:0xf bank_mask:0xf\n\t"
        "v_fmac_f32_dpp %0, %4, %13 row_newbcast:7 row_mask:0xf bank_mask:0xf\n\t"
        "v_fmac_f32_dpp %1, %5, %13 row_newbcast:7 row_mask:0xf bank_mask:0xf\n\t"
        "v_fmac_f32_dpp %2, %4, %21 row_newbcast:7 row_mask:0xf bank_mask:0xf\n\t"
        "v_fmac_f32_dpp %3, %5, %21 row_newbcast:7 row_mask:0xf bank_mask:0xf\n\t"
        "s_nop 1"
        : "+v"(sgu), "+v"(rhu), "+v"(sgp), "+v"(rhp) : "v"(kkv), "v"(wrv), "v"(su[0]), "v"(su[1]), "v"(su[2]), "v"(su[3]), "v"(su[4]), "v"(su[5]), "v"(su[6]), "v"(su[7]), "v"(sp[0]), "v"(sp[1]), "v"(sp[2]), "v"(sp[3]), "v"(sp[4]), "v"(sp[5]), "v"(sp[6]), "v"(sp[7]));
}
__device__ __forceinline__ void dots2_h1(float& sgu, float& rhu, float& sgp, float& rhp, float kkv, float wrv, const float (&su)[16], const float (&sp)[16]) {
    asm("s_nop 1\n\t"
        "v_fmac_f32_dpp %0, %4, %6 row_newbcast:8 row_mask:0xf bank_mask:0xf\n\t"
        "v_fmac_f32_dpp %1, %5, %6 row_newbcast:8 row_mask:0xf bank_mask:0xf\n\t"
        "v_fmac_f32_dpp %2, %4, %14 row_newbcast:8 row_mask:0xf bank_mask:0xf\n\t"
        "v_fmac_f32_dpp %3, %5, %14 row_newbcast:8 row_mask:0xf bank_mask:0xf\n\t"
        "v_fmac_f32_dpp %0, %4, %7 row_newbcast:9 row_mask:0xf bank_mask:0xf\n\t"
        "v_fmac_f32_dpp %1, %5, %7 row_newbcast:9 row_mask:0xf bank_mask:0xf\n\t"
        "v_fmac_f32_dpp %2, %4, %15 row_newbcast:9 row_mask:0xf bank_mask:0xf\n\t"
        "v_fmac_f32_dpp %3, %5, %15 row_newbcast:9 row_mask:0xf bank_mask:0xf\n\t"
        "v_fmac_f32_dpp %0, %4, %8 row_newbcast:10 row_mask:0xf bank_mask:0xf\n\t"
        "v_fmac_f32_dpp %1, %5, %8 row_newbcast:10 row_mask:0xf bank_mask:0xf\n\t"
        "v_fmac_f32_dpp %2, %4, %16 row_newbcast:10 row_mask:0xf bank_mask:0xf\n\t"
        "v_fmac_f32_dpp %3, %5, %16 row_newbcast:10 row_mask:0xf bank_mask:0xf\n\t"
        "v_fmac_f32_dpp %0, %4, %9 row_newbcast:11 row_mask:0xf bank_mask:0xf\n\t"
        "v_fmac_f32_dpp %1, %5, %9 row_newbcast:11 row_mask:0xf bank_mask:0xf\n\t"
        "v_fmac_f32_dpp %2, %4, %17 row_newbcast:11 row_mask:0xf bank_mask:0xf\n\t"
        "v_fmac_f32_dpp %3, %5, %17 row_newbcast:11 row_mask:0xf bank_mask:0xf\n\t"
        "v_fmac_f32_dpp %0, %4, %10 row_newbcast:12 row_mask:0xf bank_mask:0xf\n\t"
        "v_fmac_f32_dpp %1, %5, %10 row_newbcast:12 row_mask:0xf bank_mask:0xf\n\t"
        "v_fmac_f32_dpp %2, %4, %18 row_newbcast:12 row_mask:0xf bank_mask:0xf\n\t"
        "v_fmac_f32_dpp %3, %5, %18 row_newbcast:12 row_mask:0xf bank_mask:0xf\n\t"
        "v_fmac_f32_dpp %0, %4, %11 row_newbcast:13 row_mask:0xf bank_mask:0xf\n\t"
        "v_fmac_f32_dpp %1, %5, %11 row_newbcast:13 row_mask:0xf bank_mask:0xf\n\t"
        "v_fmac_f32_dpp %2, %4, %19 row_newbcast:13 row_mask:0xf bank_mask:0xf\n\t"
        "v_fmac_f32_dpp %3, %5, %19 row_newbcast:13 row_mask:0xf bank_mask:0xf\n\t"
        "v_fmac_f32_dpp %0, %4, %12 row_newbcast:14 row_mask:0xf bank_mask:0xf\n\t"
        "v_fmac_f32_dpp %1, %5, %12 row_newbcast:14 row_mask:0xf bank_mask:0xf\n\t"
        "v_fmac_f32_dpp %2, %4, %20 row_newbcast:14 row_mask:0xf bank_mask:0xf\n\t"
        "v_fmac_f32_dpp %3, %5, %20 row_newbcast:14 row_mask:0xf bank_mask:0xf\n\t"
        "v_fmac_f32_dpp %0, %4, %13 row_newbcast:15 row_mask:0xf bank_mask:0xf\n\t"
        "v_fmac_f32_dpp %1, %5, %13 row_newbcast:15 row_mask:0xf bank_mask:0xf\n\t"
        "v_fmac_f32_dpp %2, %4, %21 row_newbcast:15 row_mask:0xf bank_mask:0xf\n\t"
        "v_fmac_f32_dpp %3, %5, %21 row_newbcast:15 row_mask:0xf bank_mask:0xf\n\t"
        "s_nop 1"
        : "+v"(sgu), "+v"(rhu), "+v"(sgp), "+v"(rhp) : "v"(kkv), "v"(wrv), "v"(su[8]), "v"(su[9]), "v"(su[10]), "v"(su[11]), "v"(su[12]), "v"(su[13]), "v"(su[14]), "v"(su[15]), "v"(sp[8]), "v"(sp[9]), "v"(sp[10]), "v"(sp[11]), "v"(sp[12]), "v"(sp[13]), "v"(sp[14]), "v"(sp[15]));
}
__device__ __forceinline__ void scan_wave_up(Ctx& F, int bh, int c, int g) {
    const int lane = F.lane, q = lane >> 4, m = lane & 15, row = 16 * g + m, h = bh & 15, b = bh >> 4;
    const int r0 = b * SEQ + c * 64, ch = bh * 64 + c;
    const float* RWV = WSP(float, WS_RWV); const float* SCL = WSP(float, WS_SCL); float* Y = WSP(float, WS_Y); float* Z = WSP(float, WS_Z); float* PU = WSP(float, WS_PU);
    float su[16], sp[16];
#pragma unroll
    for (int i = 0; i < 16; ++i) { su[i] = 0.f; sp[i] = ((16 * q + i) == row) ? 1.f : 0.f; }
    StepIn buf[4];
#pragma unroll
    for (int u = 0; u < 4; ++u) scan_load<false>(buf[u], RWV, SCL, r0 + u, h, lane, row);
    for (int t = 0; t < 64; t += 4) {
#pragma unroll
        for (int u = 0; u < 4; ++u) {
            const StepIn x = buf[u];
            if (t + u + 4 < 64) scan_load<false>(buf[u], RWV, SCL, r0 + t + u + 4, h, lane, row);
            float sgu = 0.f, rhu = 0.f, sgp = 0.f, rhp = 0.f;
            dots2_h0(sgu, rhu, sgp, rhp, x.kkv, x.wrv, su, sp); dots2_h1(sgu, rhu, sgp, rhp, x.kkv, x.wrv, su, sp);
            sgu = xrow16_sum(sgu); rhu = xrow16_sum(rhu); sgp = xrow16_sum(sgp); rhp = xrow16_sum(rhp);
            const float nsu = -sgu, nsp = -sgp;
            const float y = rhu + nsu * x.beta + x.vv * x.kappa, z = rhp + nsp * x.beta;
            if (q == 0) { Y[(size_t)(r0 + t + u) * 1024 + h * 64 + row] = y; Z[((size_t)ch * 64 + t + u) * 64 + row] = z; }
            upd16_v(su, x.wv, x.kv, x.bv, x.vv, nsu); upd16_nov(sp, x.wv, x.kv, x.bv, x.vv, nsp);
        }
    }
    float* du = PU + (((size_t)ch * 2 + 0) * 64 + row) * 64 + 16 * q; float* dp = PU + (((size_t)ch * 2 + 1) * 64 + row) * 64 + 16 * q;
#pragma unroll
    for (int i = 0; i < 16; i += 4) { *(GAS f32x4*)(du + i) = (f32x4){su[i], su[i + 1], su[i + 2], su[i + 3]}; *(GAS f32x4*)(dp + i) = (f32x4){sp[i], sp[i + 1], sp[i + 2], sp[i + 3]}; }
}
__device__ __forceinline__ void phase_scan1_stream(Ctx& F) {
    LAS int* ctr = (LAS int*)(F.lds + LDSCTL_OFF);
    __syncthreads(); if (F.tid == 0) *ctr = 0; __syncthreads();
    if (F.wave >= 6) { for (int u = F.vcu * 2 + (F.wave - 6); u < DBAT * HA * 32; u += 2 * F.G) sba::attn_sample_unit(F, u >> 5, u & 31, (char*)F.lds + F.wave * 16384); }
    constexpr int NSU = DBAT * HB / 2, NU = NSU + NBATCH * HB * 64;
    const int nunits = F.vcu < NU ? (NU - 1 - F.vcu) / F.G + 1 : 0, ntasks = nunits * 8;
    for (;;) {
        int t = 0; if (F.lane == 0) t = __hip_atomic_fetch_add(ctr, 1, __ATOMIC_RELAXED, __HIP_MEMORY_SCOPE_WORKGROUP);
        t = __builtin_amdgcn_readfirstlane(t); if (t >= ntasks) break;
        const int u = F.vcu + (t >> 3) * F.G, g8 = t & 7;
        if (u < NSU) scan_wave<false, true>(F, u * 2 + (g8 >> 2), 0, g8 & 3);
        else if (g8 < 4) { const int ch = u - NSU; scan_wave_up(F, ch >> 6, ch & 63, g8); }
    }
}
namespace msc {
using sba::bf16x8; using sba::f32x16; using sba::crow; using sba::swap_other;
constexpr int S_AQ = 136, S_BKT = 104, S_L = 40;
constexpr int O_AQ = 0, O_BK = 32 * S_AQ, O_L24 = O_BK, O_TL3 = O_BK + 32 * S_L, O_BKT = 2 * 32 * S_AQ, BLK_BYTES = O_BKT + 64 * S_BKT, O_GL = 4 * BLK_BYTES, O_GP = O_GL + 256, GRP_BYTES = O_GP + 4 * 256;
static_assert(BLK_BYTES % 8 == 0 && 2 * GRP_BYTES <= RING_BYTES, "scan LDS map");
typedef __bf16 nbf2 __attribute__((ext_vector_type(2)));
__device__ __forceinline__ unsigned cvt2(float lo, float hi) { return __builtin_bit_cast(unsigned, __builtin_convertvector((f32x2){lo, hi}, nbf2)); }
__device__ __forceinline__ bf16x8 pack8(float a0, float a1, float a2, float a3, float a4, float a5, float a6, float a7) {
    u32x4 w = {cvt2(a0, a1), cvt2(a2, a3), cvt2(a4, a5), cvt2(a6, a7)}; return *reinterpret_cast<bf16x8*>(&w); }
__device__ __forceinline__ bf16x8 pack_lo(const f32x16& c) { return pack8(c[0], c[1], c[2], c[3], c[4], c[5], c[6], c[7]); }
__device__ __forceinline__ bf16x8 pack_hi(const f32x16& c) { return pack8(c[8], c[9], c[10], c[11], c[12], c[13], c[14], c[15]); }
__device__ __forceinline__ bf16x8 perm_read(const LAS char* img, int row, int pitch, int col0, int g) {
    const LAS char* p = img + row * pitch + (col0 + 4 * g) * 2; const u32x2 lo = *(const LAS u32x2*)p, hi = *(const LAS u32x2*)(p + 16);
    u32x4 w = {lo.x, lo.y, hi.x, hi.y}; return *reinterpret_cast<bf16x8*>(&w); }
__device__ __forceinline__ bf16x8 nat_read(const LAS char* img, int row, int pitch, int col0) {
    const LAS char* p = img + row * pitch + col0 * 2; const u32x2 lo = *(const LAS u32x2*)p, hi = *(const LAS u32x2*)(p + 8);
    u32x4 w = {lo.x, lo.y, hi.x, hi.y}; return *reinterpret_cast<bf16x8*>(&w); }
__device__ __forceinline__ unsigned short bf1(float x) { return (unsigned short)(cvt_pk_bf16(x, 0.f) & 0xffffu); }
struct PrepRegs { float pr[17], pk[17], pv[17], lwl[16]; const bf16* lw; };
__device__ __forceinline__ void prep_load(Ctx& F, PrepRegs& L, int rb, int h) {
    const bf16* pb = WSP(bf16, WS_PBH) + (size_t)rb * 3072 + h * 64 + F.lane; const bf16* lw = WSP(bf16, WS_LWH) + (size_t)rb * 3072 + h * 64 + F.lane;
    L.lw = lw;
#pragma unroll
    for (int t = 0; t < 16; ++t) L.lwl[t] = ldbf_nt(lw + (size_t)t * 3072);
    if ((rb & (SEQ - 1)) != 0) { L.pr[0] = ldbf_nt(pb - 3072); L.pk[0] = ldbf_nt(pb + 1024 - 3072); L.pv[0] = ldbf_nt(pb + 2048 - 3072); } else { L.pr[0] = 0.f; L.pk[0] = 0.f; L.pv[0] = 0.f; }
#pragma unroll
    for (int t = 0; t < 16; ++t) { L.pr[t + 1] = ldbf_nt(pb + (size_t)t * 3072); L.pk[t + 1] = ldbf_nt(pb + (size_t)t * 3072 + 1024); L.pv[t + 1] = ldbf_nt(pb + (size_t)t * 3072 + 2048); }
}
__device__ __forceinline__ void prep_block(Ctx& F, PrepRegs& L, int rb, int h, int j, LAS char* gbase) {
    const int lane = F.lane, n = lane & 31, hi = lane >> 5, col = h * 64 + lane; LAS char* blk = gbase + j * BLK_BYTES;
    float lal[16];
#pragma unroll
    for (int t = 0; t < 16; ++t) lal[t] = ldbf_nt(L.lw + (size_t)t * 3072 + 1024);
    const float* mu = F.in(I_MU); const float mu_r = mu[col], mu_k = mu[1024 + col], mu_v = mu[2048 + col];
    const float w0 = F.in(I_W0)[col], a0 = F.in(I_A0)[col], kkw = F.in(I_KK)[col], kaw = F.in(I_KA)[col], rkw = F.in(I_RK)[col];
    float cw[16];
#pragma unroll
    for (int t = 0; t < 16; ++t) { const float wl = w0 + L.lwl[t], wlog = -softplusf_(-wl) - 0.5f; cw[t] = __expf(-__expf(wlog)); }
#pragma unroll
    for (int t = 1; t < 16; ++t) cw[t] *= cw[t - 1];
    *(LAS float*)(gbase + O_GP + (j * 64 + lane) * 4) = cw[15];
    __syncthreads();
    const float g0 = *(const LAS float*)(gbase + O_GP + lane * 4), g1 = *(const LAS float*)(gbase + O_GP + (64 + lane) * 4), g2 = *(const LAS float*)(gbase + O_GP + (128 + lane) * 4);
    const float G0 = (j > 0 ? g0 : 1.f) * (j > 1 ? g1 : 1.f) * (j > 2 ? g2 : 1.f);
    if (j == 3) *(LAS float*)(gbase + O_GL + lane * 4) = G0 * cw[15];
    float* SCL = WSP(float, WS_SCL) + ((size_t)rb * HB + h) * 4;
#pragma unroll
    for (int tl = 0; tl < 16; tl += 2) {
        float nb[2], kt[2], vz[2];
#pragma unroll
        for (int u = 0; u < 2; ++u) { const int t = tl + u;
            const float zr = L.pr[t + 1] + mu_r * (L.pr[t] - L.pr[t + 1]), zk = L.pk[t + 1] + mu_k * (L.pk[t] - L.pk[t + 1]); vz[u] = L.pv[t + 1] + mu_v * (L.pv[t] - L.pv[t + 1]);
            const float a_ = sigmoidf_(a0 + lal[t]);
            const float kkr = zk * kkw, kk = kkr * rsqrtf(wave_sum(kkr * kkr) + 1e-12f);
            const float k = zk * (1.f + (a_ - 1.f) * kaw), bb = kk * a_;
            const float bonus = wave_sum(zr * k * rkw);
            if (lane == 0) SCL[(size_t)t * HB * 4 + 2] = bonus;
            const float Gp = t ? G0 * cw[t ? t - 1 : 0] : G0, G = G0 * cw[t], gi = 1.f / G;
            const float a = kk * Gp, q = zr * G, bt = bb * gi; kt[u] = k * gi; nb[u] = -bt;
            *(LAS unsigned short*)(blk + O_AQ + t * S_AQ + lane * 2) = bf1(a); *(LAS unsigned short*)(blk + O_AQ + (16 + t) * S_AQ + lane * 2) = bf1(q);
            *(LAS unsigned short*)(blk + O_BK + t * S_AQ + lane * 2) = bf1(bt); *(LAS unsigned short*)(blk + O_BK + (16 + t) * S_AQ + lane * 2) = bf1(kt[u]); }
        *(LAS unsigned*)(blk + O_BKT + lane * S_BKT + tl * 2) = cvt_pk_bf16(nb[0], nb[1]); *(LAS unsigned*)(blk + O_BKT + lane * S_BKT + (16 + tl) * 2) = cvt_pk_bf16(kt[0], kt[1]);
        *(LAS unsigned*)(blk + O_BKT + lane * S_BKT + (32 + tl) * 2) = cvt_pk_bf16(vz[0], vz[1]);
    }
    LDS_WAIT(); asm volatile("" ::: "memory");
    f32x16 mt = f32x16{};
#pragma unroll
    for (int ks = 0; ks < 4; ++ks) mt = __builtin_amdgcn_mfma_f32_32x32x16_bf16(nat_read(blk + O_AQ, n, S_AQ, 16 * ks + 8 * hi), nat_read(blk + O_BK, n, S_AQ, 16 * ks + 8 * hi), mt, 0, 0, 0);
    float l1[8];
    const int i = n & 15;
#pragma unroll
    for (int r = 0; r < 16; ++r) { const int t = crow(r, hi) & 15; float val = mt[r];
        if (r < 8) { val = t > i ? val : 0.f; if (n >= 16) *(LAS unsigned short*)(blk + O_L24 + t * S_L + i * 2) = bf1(val); l1[r] = val; }
        else { val = t >= i ? val : 0.f; if (n >= 16) *(LAS unsigned short*)(blk + O_L24 + (16 + t) * S_L + i * 2) = bf1(val); else *(LAS unsigned short*)(blk + O_TL3 + (16 + t) * S_L + i * 2) = bf1(-val); } }
    float rowv[16];
#pragma unroll
    for (int r = 0; r < 8; ++r) { const float own = l1[r], oth = swap_other(own, hi); const int p0 = (r & 3) + 8 * (r >> 2); rowv[p0] = hi ? oth : own; rowv[p0 + 4] = hi ? own : oth; }
    float tl_[16];
    tl_[0] = lane == 0 ? 1.f : 0.f;
#pragma unroll
    for (int t = 1; t < 16; ++t) { float acc = lane == t ? 1.f : 0.f;
#pragma unroll
        for (int jj = 0; jj < t; ++jj) acc -= readlane_f(rowv[t], jj) * tl_[jj];
        tl_[t] = acc; }
    if (lane < 16) {
#pragma unroll
        for (int t = 0; t < 16; ++t) *(LAS unsigned short*)(blk + O_TL3 + t * S_L + lane * 2) = bf1(tl_[t]); }
    LDS_WAIT(); asm volatile("" ::: "memory");
}
__device__ __forceinline__ void chain(Ctx& F, int bh, int c, int isP, int half, const LAS char* gbase) {
    const int lane = F.lane, n = lane & 31, hi = lane >> 5, rowg = 32 * half + n, h = bh & 15, b = bh >> 4, r0 = b * SEQ + c * 64, ch = bh * 64 + c;
    const float* RWV = WSP(float, WS_RWV);
    f32x16 st0 = f32x16{}, st1 = f32x16{};
    if (isP) {
#pragma unroll
        for (int r = 0; r < 16; ++r) { st0[r] = crow(r, hi) == rowg ? 1.f : 0.f; st1[r] = 32 + crow(r, hi) == rowg ? 1.f : 0.f; } }
    for (int blk_i = 0; blk_i < 4; ++blk_i) {
        const LAS char* blk = gbase + blk_i * BLK_BYTES;
        f32x16 wt = f32x16{};
        wt = __builtin_amdgcn_mfma_f32_32x32x16_bf16(perm_read(blk + O_AQ, n, S_AQ, 0, hi), pack_lo(st0), wt, 0, 0, 0);
        wt = __builtin_amdgcn_mfma_f32_32x32x16_bf16(perm_read(blk + O_AQ, n, S_AQ, 16, hi), pack_hi(st0), wt, 0, 0, 0);
        wt = __builtin_amdgcn_mfma_f32_32x32x16_bf16(perm_read(blk + O_AQ, n, S_AQ, 32, hi), pack_lo(st1), wt, 0, 0, 0);
        wt = __builtin_amdgcn_mfma_f32_32x32x16_bf16(perm_read(blk + O_AQ, n, S_AQ, 48, hi), pack_hi(st1), wt, 0, 0, 0);
        bf16x8 bV = bf16x8{};
        if (!isP) { bV = perm_read(blk + O_BKT, rowg, S_BKT, 32, hi);
            wt = __builtin_amdgcn_mfma_f32_32x32x16_bf16(perm_read(blk + O_L24, n, S_L, 0, hi), bV, wt, 0, 0, 0); }
        const bf16x8 tl3 = perm_read(blk + O_TL3, n, S_L, 0, hi);
        const bf16x8 a_tl = n < 16 ? tl3 : bf16x8{}, a_l3 = n >= 16 ? tl3 : bf16x8{};
        const f32x16 sg = __builtin_amdgcn_mfma_f32_32x32x16_bf16(a_tl, pack_lo(wt), f32x16{}, 0, 0, 0);
        const bf16x8 bSg = pack_lo(sg);
        const f32x16 yy = __builtin_amdgcn_mfma_f32_32x32x16_bf16(a_l3, bSg, wt, 0, 0, 0);
#pragma unroll
        for (int r = 8; r < 16; ++r) { const int t = blk_i * 16 + (r & 3) + 8 * ((r - 8) >> 2) + 4 * hi;
            if (isP) WSP(float, WS_Z)[((size_t)ch * 64 + t) * 64 + rowg] = yy[r]; else WSP(float, WS_Y)[(size_t)(r0 + t) * 1024 + h * 64 + rowg] = yy[r]; }
        st0 = __builtin_amdgcn_mfma_f32_32x32x16_bf16(perm_read(blk + O_BKT, n, S_BKT, 0, hi), bSg, st0, 0, 0, 0);
        st1 = __builtin_amdgcn_mfma_f32_32x32x16_bf16(perm_read(blk + O_BKT, 32 + n, S_BKT, 0, hi), bSg, st1, 0, 0, 0);
        if (!isP) { st0 = __builtin_amdgcn_mfma_f32_32x32x16_bf16(perm_read(blk + O_BKT, n, S_BKT, 16, hi), bV, st0, 0, 0, 0);
                    st1 = __builtin_amdgcn_mfma_f32_32x32x16_bf16(perm_read(blk + O_BKT, 32 + n, S_BKT, 16, hi), bV, st1, 0, 0, 0); }
    }
    const LAS float* GL = (const LAS float*)(gbase + O_GL); float* dst = WSP(float, WS_PU) + (((size_t)ch * 2 + isP) * 64 + rowg) * 64;
#pragma unroll
    for (int g4 = 0; g4 < 4; ++g4) { const int k0 = 8 * g4 + 4 * hi; const f32x4 ga = *(const LAS f32x4*)(GL + k0), gb = *(const LAS f32x4*)(GL + 32 + k0);
        *(GAS f32x4*)(dst + k0) = (f32x4){st0[4 * g4] * ga.x, st0[4 * g4 + 1] * ga.y, st0[4 * g4 + 2] * ga.z, st0[4 * g4 + 3] * ga.w};
        *(GAS f32x4*)(dst + 32 + k0) = (f32x4){st1[4 * g4] * gb.x, st1[4 * g4 + 1] * gb.y, st1[4 * g4 + 2] * gb.z, st1[4 * g4 + 3] * gb.w}; }
}
}
__device__ __forceinline__ void phase_sample_stream(Ctx& F) {
    for (int u = F.vcu * NWAVES + F.wave; u < DBAT * HA * 32; u += NWAVES * F.G) sba::attn_sample_unit(F, (u >> 8) * HA + (u & 7), (u >> 3) & 31, (char*)F.lds + F.wave * 16384);
}
__device__ __forceinline__ void phase_scan1_mfma(Ctx& F) {
    __syncthreads();
    const int grp = F.wave >> 2, wq = F.wave & 3; LAS char* gbase = (LAS char*)F.lds + grp * msc::GRP_BYTES;
    msc::PrepRegs L;
    { const int ch = 2 * F.vcu + grp; if (ch < NBATCH * HB * 64) msc::prep_load(F, L, (ch >> 10) * SEQ + (ch & 63) * 64 + 16 * wq, (ch >> 6) & 15); }
    for (int base = 2 * F.vcu; base < NBATCH * HB * 64; base += 2 * F.G) {
        const int ch = base + grp, bh = ch >> 6, c = ch & 63;
        msc::prep_block(F, L, (bh >> 4) * SEQ + c * 64 + 16 * wq, bh & 15, wq, gbase);
        __syncthreads();
        { const int chn = ch + 2 * F.G; if (chn < NBATCH * HB * 64) msc::prep_load(F, L, (chn >> 10) * SEQ + (chn & 63) * 64 + 16 * wq, (chn >> 6) & 15); }
        msc::chain(F, bh, c, wq >> 1, wq & 1, gbase);
    }
}
__device__ __forceinline__ void phase_scan2(Ctx& F) {
    LAS float* Pb = (LAS float*)(F.lds + 4096);
    const float* PU = WSP(float, WS_PU); float* SC = WSP(float, WS_SC);
    for (int unit = F.vcu; unit < NBATCH * HB * 8; unit += F.G) {
        const int bh = unit >> 3, r0 = (unit & 7) * 8, r = F.wave, col = F.lane;
        __syncthreads();
        { const float* P0 = PU + ((size_t)(bh * 64) * 2 + 1) * 4096; const f32x4 a = *(const GAS f32x4*)(P0 + F.tid * 4), bq = *(const GAS f32x4*)(P0 + 2048 + F.tid * 4);
          *(LAS f32x4*)(Pb + F.tid * 4) = a; *(LAS f32x4*)(Pb + 2048 + F.tid * 4) = bq; }
        float ucur = PU[((size_t)(bh * 64) * 2 + 0) * 4096 + (r0 + r) * 64 + col], scur = 0.f;
        __syncthreads();
        for (int c = 0; c < 64; ++c) {
            const int ch = bh * 64 + c; LAS float* Pc = Pb + (c & 1) * 4096;
            SC[((size_t)ch * 64 + r0 + r) * 64 + col] = scur;
            f32x4 pa = {0.f, 0.f, 0.f, 0.f}, pq = {0.f, 0.f, 0.f, 0.f}; float unext = 0.f;
            if (c + 1 < 64) { const float* Pn = PU + ((size_t)(ch + 1) * 2 + 1) * 4096; pa = *(const GAS f32x4*)(Pn + F.tid * 4); pq = *(const GAS f32x4*)(Pn + 2048 + F.tid * 4);
                unext = PU[((size_t)(ch + 1) * 2 + 0) * 4096 + (r0 + r) * 64 + col]; }
            float a0 = ucur, a1 = 0.f, a2 = 0.f, a3 = 0.f;
#pragma unroll
            for (int j = 0; j < 64; j += 4) {
                const float s0 = readlane_f(scur, j), s1 = readlane_f(scur, j + 1), s2 = readlane_f(scur, j + 2), s3 = readlane_f(scur, j + 3);
                a0 += s0 * Pc[(j + 0) * 64 + col]; a1 += s1 * Pc[(j + 1) * 64 + col]; a2 += s2 * Pc[(j + 2) * 64 + col]; a3 += s3 * Pc[(j + 3) * 64 + col]; }
            const float acc = (a0 + a1) + (a2 + a3);
            if (c + 1 < 64) { LAS float* Pn = Pb + ((c + 1) & 1) * 4096; *(LAS f32x4*)(Pn + F.tid * 4) = pa; *(LAS f32x4*)(Pn + 2048 + F.tid * 4) = pq; }
            __syncthreads();
            scur = acc; ucur = unext;
        }
        F.outp()[O_WKVP + ((size_t)bh * 64 + r0 + r) * 64 + col] = scur;
    }
}
__device__ __forceinline__ void phase_scan3(Ctx& F) {
    const int gw = F.vcu * NWAVES + F.wave, NGW = F.G * NWAVES, lane = F.lane, q = lane >> 4, m = lane & 15;
    const float* SC = WSP(float, WS_SC); const float* Z = WSP(float, WS_Z); float* Y = WSP(float, WS_YC);
    for (int task = gw; task < NBATCH * HB * 63 * 4; task += NGW) {
        const int g = task & 3, cc = task >> 2, bh = cc / 63, c = 1 + (cc - bh * 63), ch = bh * 64 + c, h = bh & 15, b = bh >> 4, row = 16 * g + m;
        const float* st = SC + ((size_t)ch * 64 + row) * 64 + 16 * q; float s[16];
#pragma unroll
        for (int i = 0; i < 16; i += 4) { const f32x4 v = *(const GAS f32x4*)(st + i); s[i] = v.x; s[i + 1] = v.y; s[i + 2] = v.z; s[i + 3] = v.w; }
        const float* zp = Z + (size_t)ch * 4096 + lane; float* yp = Y + (size_t)(b * SEQ + c * 64) * 1024 + h * 64 + row;
        float zb[4];
#pragma unroll
        for (int u = 0; u < 4; ++u) zb[u] = zp[u * 64];
        for (int t = 0; t < 64; t += 4) {
#pragma unroll
            for (int u = 0; u < 4; ++u) {
                const float zv = zb[u]; if (t + u + 4 < 64) zb[u] = zp[(t + u + 4) * 64];
                float acc = 0.f; dot16(acc, zv, s); acc = xrow16_sum(acc);
                if (q == 0) yp[(size_t)(t + u) * 1024] = acc;
            }
        }
    }
}
__device__ __forceinline__ float sum32(float v) {
    v += dpp_f<0xB1>(v); v += dpp_f<0x4E>(v); v += dpp_f<0x141>(v); v += dpp_f<0x140>(v);
    auto s = __builtin_amdgcn_permlane16_swap(__float_as_uint(v), __float_as_uint(v), false, false);
    return __uint_as_float(s[0]) + __uint_as_float(s[1]);
}
__device__ __forceinline__ sba::bf16x8 ld8_bf16(const float* p) { const f32x4 a = *(const GAS f32x4*)p, b = *(const GAS f32x4*)(p + 4); return msc::pack8(a.x, a.y, a.z, a.w, b.x, b.y, b.z, b.w); }
__device__ __forceinline__ void phase_scan3_post(Ctx& F) {
    const int gw = F.vcu * NWAVES + F.wave, NGW = F.G * NWAVES, lane = F.lane, n = lane & 31, hi = lane >> 5;
    const float* SC = WSP(float, WS_SC); const float* Z = WSP(float, WS_Z); const float* Y = WSP(float, WS_Y); const bf16* LWH = WSP(bf16, WS_LWH); const bf16* PBH = WSP(bf16, WS_PBH);
    const float* SCL = WSP(float, WS_SCL); bf16* OAB = WSP(bf16, WS_OAB);
    for (int ch = gw; ch < NBATCH * HB * 64; ch += NGW) {
        const int bh = ch >> 6, c = ch & 63, h = bh & 15, b = bh >> 4, r0 = b * SEQ + c * 64, col0 = h * 64 + n;
        const float lg0 = F.in(I_LNG)[col0], lg1 = F.in(I_LNG)[col0 + 32], lb0 = F.in(I_LNB)[col0], lb1 = F.in(I_LNB)[col0 + 32], mv0 = F.in(I_MU)[2048 + col0], mv1 = F.in(I_MU)[2048 + col0 + 32];
        sba::bf16x8 sb0[4], sb1[4];
        if (c > 0) { const float* Sp = SC + (size_t)ch * 4096 + n * 64 + 8 * hi;
#pragma unroll
            for (int ks = 0; ks < 4; ++ks) { sb0[ks] = ld8_bf16(Sp + 16 * ks); sb1[ks] = ld8_bf16(Sp + 32 * 64 + 16 * ks); } }
        else {
#pragma unroll
            for (int ks = 0; ks < 4; ++ks) { sb0[ks] = sba::bf16x8{}; sb1[ks] = sba::bf16x8{}; } }
        for (int tt = 0; tt < 2; ++tt) {
            sba::f32x16 a0 = sba::f32x16{}, a1 = sba::f32x16{};
            if (c > 0) { const float* Zp = Z + (size_t)ch * 4096 + (32 * tt + n) * 64 + 8 * hi;
#pragma unroll
                for (int ks = 0; ks < 4; ++ks) { const sba::bf16x8 za = ld8_bf16(Zp + 16 * ks);
                    a0 = __builtin_amdgcn_mfma_f32_32x32x16_bf16(za, sb0[ks], a0, 0, 0, 0); a1 = __builtin_amdgcn_mfma_f32_32x32x16_bf16(za, sb1[ks], a1, 0, 0, 0); } }
#pragma unroll
            for (int rg = 0; rg < 16; rg += 4) {
                float y0[4], y1[4], g0[4], g1[4], p0[4], p1[4], q0[4], q1[4], bn[4];
#pragma unroll
                for (int i = 0; i < 4; ++i) { const int t = 32 * tt + sba::crow(rg + i, hi), r = r0 + t;
                    y0[i] = Y[(size_t)r * 1024 + col0]; y1[i] = Y[(size_t)r * 1024 + col0 + 32];
                    g0[i] = ldbf(LWH + (size_t)r * 3072 + 2048 + col0); g1[i] = ldbf(LWH + (size_t)r * 3072 + 2048 + col0 + 32);
                    const bf16* pb = PBH + (size_t)r * 3072 + 2048 + col0; p0[i] = ldbf(pb); p1[i] = ldbf(pb + 32);
                    const bool hp = (r & (SEQ - 1)) != 0; q0[i] = hp ? ldbf(pb - 3072) : 0.f; q1[i] = hp ? ldbf(pb + 32 - 3072) : 0.f;
                    bn[i] = SCL[((size_t)r * HB + h) * 4 + 2]; }
#pragma unroll
                for (int i = 0; i < 4; ++i) { const int t = 32 * tt + sba::crow(rg + i, hi), r = r0 + t;
                    const float v0 = y0[i] + a0[rg + i], v1 = y1[i] + a1[rg + i];
                    const float mean = sum32(v0 + v1) * (1.f / 64.f), d0 = v0 - mean, d1 = v1 - mean, var = sum32(d0 * d0 + d1 * d1) * (1.f / 64.f), rs = rsqrtf(var + EPS_LNX);
                    const float zv0 = p0[i] + mv0 * (q0[i] - p0[i]), zv1 = p1[i] + mv1 * (q1[i] - p1[i]);
                    const float o0 = (d0 * rs * lg0 + lb0 + bn[i] * zv0) * g0[i], o1 = (d1 * rs * lg1 + lb1 + bn[i] * zv1) * g1[i];
                    const float o0n = dpp_f<0xB1>(o0), o1n = dpp_f<0xB1>(o1);
                    if ((lane & 1) == 0) { *(GAS unsigned*)(OAB + (size_t)r * DM + 1024 + col0) = cvt_pk_bf16(o0, o0n); *(GAS unsigned*)(OAB + (size_t)r * DM + 1024 + col0 + 32) = cvt_pk_bf16(o1, o1n); } }
            }
        }
    }
}
__device__ __forceinline__ void phase_postscan(Ctx& F) {
    const int gw = F.vcu * NWAVES + F.wave, NGW = F.G * NWAVES;
    const float* Y = WSP(float, WS_Y); const float* RWV = WSP(float, WS_RWV); const float* SCL = WSP(float, WS_SCL); const float* LWO = WSP(float, WS_LWO); const float* Pp = WSP(float, WS_P); bf16* OAB = WSP(bf16, WS_OAB);
    for (int u = NPR * 4 + gw; u < NTOK * 4; u += NGW) {
        const int r = u >> 2, hq = u & 3; const bool corr = false;
        float yv[4], gv[4], vv[4], bn[4];
#pragma unroll
        for (int i = 0; i < 4; ++i) { const int h = hq * 4 + i, col = h * 64 + F.lane;
            yv[i] = Y[(size_t)r * 1024 + col]; if (corr) yv[i] += WSP(float, WS_YC)[(size_t)r * 1024 + col];
            gv[i] = LWO[(size_t)r * 3072 + 2048 + col]; bn[i] = SCL[((size_t)r * HB + h) * 4 + 2];
            vv[i] = RWV[((size_t)r * HB + h) * 512 + 320 + F.lane]; }
#pragma unroll
        for (int i = 0; i < 4; ++i) { const int h = hq * 4 + i, col = h * 64 + F.lane;
            const float mean = wave_sum(yv[i]) * (1.f / 64.f), d = yv[i] - mean, var = wave_sum(d * d) * (1.f / 64.f);
            const float yn = d * rsqrtf(var + EPS_LNX) * F.in(I_LNG)[col] + F.in(I_LNB)[col] + bn[i] * vv[i];
            const float o = yn * gv[i];
            const float o1 = dpp_f<0xB1>(o);
            if ((F.lane & 1) == 0) *(GAS unsigned*)(OAB + (size_t)r * DM + 1024 + col) = cvt_pk_bf16(o, o1); }
    }
    sample_combine(F);
    const float* OP = WSP(float, WS_OP); const float* CL = WSP(float, WS_CL);
    for (size_t i = (size_t)F.vcu * NTHR + F.tid; i < (size_t)NPR * 256; i += (size_t)F.G * NTHR) {
        const int r = (int)(i >> 8), c4 = (int)(i & 255) * 4, h = c4 >> 7;
        const f32x4 a = *(const GAS f32x4*)(OP + (size_t)r * 1024 + c4), e = *(const GAS f32x4*)(OP + ((size_t)NPR + r) * 1024 + c4); const float cl = CL[(size_t)r * HA + h];
        const f32x4 o = a + e * cl; u32x2 w; w.x = cvt_pk_bf16(o.x, o.y); w.y = cvt_pk_bf16(o.z, o.w);
        *(GAS u32x2*)(OAB + (size_t)r * DM + c4) = w;
    }
}
__device__ __forceinline__ void phase_usample(Ctx& F) {
    const float* PU_ = WSP(float, WS_PARTU); bf16* U = WSP(bf16, WS_U);
    for (int i = F.vcu * NTHR + F.tid; i < NSM * DFF / 4; i += F.G * NTHR) { const int r = i / (DFF / 4), c4 = (i - r * (DFF / 4)) * 4;
        f32x4 a = *(const GAS f32x4*)(PU_ + (size_t)r * DFF + c4);
#pragma unroll
        for (int kc = 1; kc < 8; ++kc) a += *(const GAS f32x4*)(PU_ + ((size_t)kc * 64 + r) * DFF + c4);
        const float x0 = fmaxf(a.x, 0.f), x1 = fmaxf(a.y, 0.f), x2 = fmaxf(a.z, 0.f), x3 = fmaxf(a.w, 0.f);
        u32x2 w; w.x = cvt_pk_bf16(x0 * x0, x1 * x1); w.y = cvt_pk_bf16(x2 * x2, x3 * x3);
        *(GAS u32x2*)(U + (size_t)(NPR + r) * DFF + c4) = w; }
}
#ifndef MK_SPLIT
#define MK_SPLIT 0
#endif
constexpr int NPHASE = 21;
struct Args { const void* in[N_IN]; float* out; unsigned char* ws; int ph_lo, ph_hi; };
__global__ void __launch_bounds__(NTHR, 2) mega_fwd(Args args) {
    extern __shared__ __attribute__((aligned(16))) unsigned char lds_raw[];
    Ctx F;
    F.lds = (LAS unsigned char*)lds_raw; F.tid = threadIdx.x; F.lane = F.tid & 63; F.wave = __builtin_amdgcn_readfirstlane(F.tid >> 6);
    F.G = gridDim.x; { const int bx = blockIdx.x; F.vcu = (F.G % 8 == 0) ? (bx % 8) * (F.G / 8) + bx / 8 : bx; }
    for (int u = F.tid; u < (LDS_BYTES - LDSCTL_OFF) / 4; u += NTHR) ((LAS unsigned*)(F.lds + LDSCTL_OFF))[u] = 0u;
    __syncthreads();
    unsigned* ctl = (unsigned*)(args.ws + WS_CTL);
    XcdBarrier bar; bar.bar = ctl + CW_BAR; bar.x = 0; bar.st = nullptr;
    if (!MK_SPLIT) bar = xcd_barrier_post(ctl + CW_BAR, (volatile LAS unsigned*)(F.lds + MISC_OFF) + 8);
    const int lo = args.ph_lo, hi = args.ph_hi;
#define IN(k) (lo <= (k) && (k) < hi)
#define SEAM(k) do { if (IN(k) && IN((k) + 1)) xcd_barrier(bar); } while (0)
    if (IN(0)) { phase_prologue(F); } SEAM(0);
    if (IN(1)) { phase_mod0(F); } SEAM(1);
    if (IN(2)) { const bool hide = F.G > NCVT + 8; const int ng = hide ? F.G - NCVT : F.G;
        if ((int)blockIdx.x < ng) { pg8::Gemm g{WSP(bf16, WS_H), WSP(bf16, WS_WIN), MP, INPAD, DM, DM, DM}; pg8::StaticOrder S; S.init(MP, INPAD, ng, (int)blockIdx.x); EpiIn E{WSP(bf16, WS_QB), WSP(bf16, WS_KB), WSP(bf16, WS_VB), WSP(float, WS_P), F.outp(), WSP(bf16, WS_PBH)};
            pg8::gemm_phase<EpiIn, pg8::StaticOrder, true, true>(F.lds, g, S, E); }
        else convert_run(F, IT_IN + ((int)blockIdx.x - ng) * NWAVES + F.wave, NCVT * NWAVES, IT_IN + N_HIDE, (LAS float*)(F.lds + F.wave * 16384)); } SEAM(2);
    if (IN(3)) { phase_kv_prep(F); } SEAM(3);
    if (IN(4)) { pg8::Gemm g{WSP(bf16, WS_LA), WSP(bf16, WS_LWT), MP, 3072, 512, 512, 512}; pg8::LoraOrder S; S.init(MP, 3072, F.G, (int)blockIdx.x); pg8::EpiLora E{WSP(float, WS_LWO), WSP(bf16, WS_LWH), 3072};
        pg8::gemm_phase<pg8::EpiLora, pg8::LoraOrder, true, true>(F.lds, g, S, E); } SEAM(4);
    if (IN(6)) { phase_rwkv_prep(F);
        const bool stream_first = (F.vcu & 1) != 0;
        if (stream_first) phase_sample_stream(F); else phase_scan1_mfma(F);
        __syncthreads();
        phase_attn_prompt(F);
        if (!stream_first) phase_sample_stream(F); else phase_scan1_mfma(F); } SEAM(7);
    if (IN(8)) {
        if (F.wave < 2) for (int t = F.vcu * 2 + F.wave; t < DBAT * HB * 4; t += 2 * F.G) scan_wave<false, true>(F, t >> 2, 0, t & 3);
        phase_scan2(F); } SEAM(8);
    if (IN(10)) { phase_scan3_post(F); phase_postscan(F); } SEAM(10);
    if (IN(11)) { pg8::Gemm g{WSP(bf16, WS_OAB), WSP(bf16, WS_WOUT), MP, DM, DM, DM, DM}; pg8::MixOrder<false> S; S.init(DM, DM, F.G, (int)blockIdx.x); pg8::EpiF32S<64> E{WSP(bf16, WS_OUT), DM, nullptr, WSP(float, WS_PART)};
        pg8::gemm_phase<pg8::EpiF32S<64>, pg8::MixOrder<false>, true, true>(F.lds, g, S, E); } SEAM(11);
    if (IN(12)) { phase_postmix<0>(F); } SEAM(12);
    if (IN(13)) { pg8::Gemm g{WSP(bf16, WS_H), WSP(bf16, WS_W1), MP, DFF, DM, DM, DM}; pg8::MixOrder<false> S; S.init(DFF, DM, F.G, (int)blockIdx.x); pg8::EpiRelu2 E{WSP(bf16, WS_U), DFF, WSP(float, WS_PARTU)};
        pg8::gemm_phase<pg8::EpiRelu2, pg8::MixOrder<false>, true, true>(F.lds, g, S, E); } SEAM(13);
    if (IN(14)) { phase_usample(F); if (!MK_SPLIT) xcd_barrier(bar); pg8::Gemm g{WSP(bf16, WS_U), WSP(bf16, WS_W2), MP, DM, DFF, DFF, DFF}; pg8::MixOrder<false> S; S.init(DM, DFF, F.G, (int)blockIdx.x); pg8::EpiF32S<64> E{WSP(bf16, WS_OUT), DM, nullptr, WSP(float, WS_PART)};
        pg8::gemm_phase<pg8::EpiF32S<64>, pg8::MixOrder<false>, true, true>(F.lds, g, S, E); } SEAM(14);
    if (IN(15)) { phase_postmlp<0>(F); } SEAM(15);
    if (IN(16)) { pg8::Gemm g{WSP(bf16, WS_H), WSP(bf16, WS_WPOOL), MP, DM, DM, DM, DM}; pg8::MixOrder<true> S; S.init(DM, DM, F.G, (int)blockIdx.x); pg8::EpiF32S<256> E{WSP(bf16, WS_OUT), DM, F.in(I_PSC), WSP(float, WS_PART)};
        pg8::gemm_phase<pg8::EpiF32S<256>, pg8::MixOrder<true>, true, true>(F.lds, g, S, E); } SEAM(16);
    if (IN(17)) { phase_postmix<1>(F); } SEAM(17);
    if (IN(18)) { pg8::Gemm g{WSP(bf16, WS_H), WSP(bf16, WS_W1) + (size_t)DFF * DM, MP, DFF, DM, DM, DM}; pg8::MixOrder<false> S; S.init(DFF, DM, F.G, (int)blockIdx.x); pg8::EpiRelu2 E{WSP(bf16, WS_U), DFF, WSP(float, WS_PARTU)};
        pg8::gemm_phase<pg8::EpiRelu2, pg8::MixOrder<false>, true, true>(F.lds, g, S, E); } SEAM(18);
    if (IN(19)) { phase_usample(F); if (!MK_SPLIT) xcd_barrier(bar); pg8::Gemm g{WSP(bf16, WS_U), WSP(bf16, WS_W2) + (size_t)DM * DFF, MP, DM, DFF, DFF, DFF}; pg8::MixOrder<false> S; S.init(DM, DFF, F.G, (int)blockIdx.x); pg8::EpiF32S<64> E{WSP(bf16, WS_OUT), DM, nullptr, WSP(float, WS_PART)};
        pg8::gemm_phase<pg8::EpiF32S<64>, pg8::MixOrder<false>, true, true>(F.lds, g, S, E); } SEAM(19);
    if (IN(20)) { phase_postmlp<1>(F); }
#undef IN
#undef SEAM
}

extern "C" void kernel_launch(void* const* d_in, const int* in_sizes, int n_in, void* d_out, int out_size, void* d_ws, size_t ws_size, hipStream_t stream) {
    static int grid = 0;
    if (grid == 0) {
        if (n_in != N_IN || (size_t)out_size != O_END || ws_size < WS_END) { fprintf(stderr, "kernel_launch: unexpected shapes: n_in %d out %d ws %zu (want %d, %zu, >= %zu)\n", n_in, out_size, ws_size, (int)N_IN, (size_t)O_END, (size_t)WS_END); grid = -1; return; }
        int dev = 0, cus = 0, per_cu = 0;
        if (hipGetDevice(&dev) != hipSuccess || hipDeviceGetAttribute(&cus, hipDeviceAttributeMultiprocessorCount, dev) != hipSuccess) { grid = -1; return; }
        if (hipFuncSetAttribute((const void*)mega_fwd, hipFuncAttributeMaxDynamicSharedMemorySize, LDS_BYTES) != hipSuccess) { fprintf(stderr, "kernel_launch: hipFuncSetAttribute failed\n"); grid = -1; return; }
        if (hipOccupancyMaxActiveBlocksPerMultiprocessor(&per_cu, (const void*)mega_fwd, NTHR, LDS_BYTES) != hipSuccess || per_cu < 1) fprintf(stderr, "kernel_launch: occupancy query reports %d blocks per CU\n", per_cu);
        (void)hipGetLastError();
        grid = cus;
    }
    if (grid < 0) return;
    hipMemsetAsync((char*)d_ws + WS_CTL, 0, CTL_ZERO_BYTES, stream);
    Args a{};
    for (int i = 0; i < N_IN; ++i) a.in[i] = d_in[i];
    a.out = (float*)d_out; a.ws = (unsigned char*)d_ws;
#if MK_SPLIT
    for (int p = 0; p < NPHASE; ++p) { a.ph_lo = p; a.ph_hi = p + 1; hipLaunchKernelGGL(mega_fwd, dim3(grid), dim3(NTHR), LDS_BYTES, stream, a); }
#else
    a.ph_lo = 0; a.ph_hi = NPHASE;
    hipLaunchKernelGGL(mega_fwd, dim3(grid), dim3(NTHR), LDS_BYTES, stream, a);
#endif
    const hipError_t le = hipPeekAtLastError();
    if (le != hipSuccess) fprintf(stderr, "kernel_launch: launch failed: %s\n", hipGetErrorName(le));
}
```

```cpp
#include <hip/hip_runtime.h>
#include <cstdio>
#include <cstdint>
namespace pg8 {
#define PG8_LAS __attribute__((address_space(3)))
typedef unsigned short bf16_t;
typedef short bf16x8 __attribute__((ext_vector_type(8)));
typedef float f32x4 __attribute__((ext_vector_type(4)));
typedef unsigned u32x4 __attribute__((ext_vector_type(4)));
constexpr int BM = 256, BK = 64, HALF = 128, HTB = HALF * BK * 2  , STAGE_BYTES = 8 * HTB, NXCD = 8, WGM = 8;

__host__ __device__ __forceinline__ int lds_byte(int r, int c) { const int st = (r >> 4) * 2 + (c >> 5), rr = r & 15, cc = c & 31, ob = rr * 64 + cc * 2; return st * 1024 + (ob ^ (((ob >> 9) & 1) << 5)); }
__host__ __device__ __forceinline__ void stage_rc(int b, int& R, int& C) { const int st = b / 1024, sb = b % 1024, swz = sb ^ (((sb >> 9) & 1) << 5); R = (st >> 1) * 16 + swz / 64; C = (st & 1) * 32 + (swz % 64) / 2; }
__host__ __device__ __forceinline__ int perm32(int rho) { const int n = rho >> 4, i = rho & 15; return 8 * (i >> 2) + 4 * n + (i & 3); }

struct Unit { int pm, pn, kc; };
struct Gemm { const bf16_t* A; const bf16_t* Bt; int M, N, K, lda, ldb; };

struct StaticOrder {
    int nM, nN, nwg, G, c;
    __host__ __device__ void init(int M, int N, int G_, int c_) { nM = M / BM; nN = N / BM; nwg = nM * nN; G = G_; c = c_; }
    __host__ __device__ bool next(int i, Unit& u) const {
        const long L = (long)i * G + c; if (L >= nwg) return false;
        int wgid = (int)L; { const int q = nwg / NXCD, r = nwg % NXCD, xcd = wgid % NXCD, off = wgid / NXCD; wgid = (xcd < r ? xcd * (q + 1) : r * (q + 1) + (xcd - r) * q) + off; }
        const int nig = WGM * nN, gid = wgid / nig, fm = gid * WGM, gsz = (nM - fm) < WGM ? (nM - fm) : WGM;
        u.pm = fm + ((wgid % nig) % gsz); u.pn = (wgid % nig) / gsz; u.kc = -1; return true;
    }
    __device__ __forceinline__ int nt(const Unit&, const Gemm& g) const { return g.K / BK; }
    __device__ __forceinline__ void a_ready(const Unit&) const {}
    __device__ __forceinline__ void done(const Unit&) const {}
    __device__ __forceinline__ size_t a_off(const Unit& u, const Gemm& g) const { return (size_t)u.pm * BM * g.lda * 2; }
    __device__ __forceinline__ size_t b_off(const Unit& u, const Gemm& g) const { return (size_t)u.pn * BM * g.ldb * 2; }
};
struct LoraOrder : StaticOrder {
    __device__ __forceinline__ int k0(const Unit& u) const { return u.pn < 4 ? 0 : (u.pn < 8 ? 64 : 192); }
    __device__ __forceinline__ int nt(const Unit& u, const Gemm&) const { return u.pn < 8 ? 2 : 4; }
    __device__ __forceinline__ size_t a_off(const Unit& u, const Gemm& g) const { return (size_t)u.pm * BM * g.lda * 2 + (size_t)k0(u) * 2; }
    __device__ __forceinline__ size_t b_off(const Unit& u, const Gemm& g) const { return (size_t)u.pn * BM * g.ldb * 2 + (size_t)k0(u) * 2; }
};
__device__ __forceinline__ unsigned cvt_pk_bf16(float lo, float hi) { unsigned r; asm volatile("v_cvt_pk_bf16_f32 %0, %1, %2" : "=v"(r) : "v"(lo), "v"(hi)); return r; }

struct EpiF32 {
    static constexpr bool PERM = false, AFTER_DRAIN = false;
    float* C; int ldc; const float* cscale;
    __device__ __forceinline__ void operator()(const f32x4 (&acc)[2][2][4][2], const Unit& u, int wr, int wc, int fr, int fq) const {
        const int row0 = u.pm * BM + wr * 64 + fr, col0 = u.pn * BM + wc * 32 + 4 * fq;
        f32x4 sv[2][2];
#pragma unroll
        for (int bj = 0; bj < 2; ++bj)
#pragma unroll
            for (int n = 0; n < 2; ++n) sv[bj][n] = cscale ? *(const f32x4*)(cscale + col0 + bj * HALF + n * 16) : (f32x4){1.f, 1.f, 1.f, 1.f};
#pragma unroll
        for (int ai = 0; ai < 2; ++ai)
#pragma unroll
            for (int m = 0; m < 4; ++m) { float* rowp = C + (size_t)(row0 + ai * HALF + m * 16) * ldc + col0;
#pragma unroll
                for (int bj = 0; bj < 2; ++bj)
#pragma unroll
                    for (int n = 0; n < 2; ++n) *(f32x4*)(rowp + bj * HALF + n * 16) = acc[ai][bj][m][n] * sv[bj][n]; }
    }
};
typedef unsigned u32x2h __attribute__((ext_vector_type(2)));
struct EpiLora {
    static constexpr bool PERM = false, AFTER_DRAIN = false;
    float* C; bf16_t* H; int ldc;
    __device__ __forceinline__ void operator()(const f32x4 (&acc)[2][2][4][2], const Unit& u, int wr, int wc, int fr, int fq) const {
        const int row0 = u.pm * BM + wr * 64 + fr, col0 = u.pn * BM + wc * 32 + 4 * fq;
#pragma unroll
        for (int ai = 0; ai < 2; ++ai)
#pragma unroll
            for (int m = 0; m < 4; ++m) { const size_t ro = (size_t)(row0 + ai * HALF + m * 16) * ldc + col0;
#pragma unroll
                for (int bj = 0; bj < 2; ++bj)
#pragma unroll
                    for (int n = 0; n < 2; ++n) { const f32x4 v = acc[ai][bj][m][n];
                        if (u.pm < 32) { u32x2h w; w.x = cvt_pk_bf16(v[0], v[1]); w.y = cvt_pk_bf16(v[2], v[3]); *(u32x2h*)(H + ro + bj * HALF + n * 16) = w; }
                        else *(f32x4*)(C + ro + bj * HALF + n * 16) = v; } }
    }
};
struct EpiRelu2 {
    static constexpr bool PERM = true, AFTER_DRAIN = false;
    bf16_t* O; int ldc; float* PART;
    __device__ __forceinline__ void operator()(const f32x4 (&acc)[2][2][4][2], const Unit& u, int wr, int wc, int fr, int fq) const {
        const int row0 = u.pm * BM + wr * 64 + fr, col0 = u.pn * BM + wc * 32 + 8 * fq;
        if (u.kc >= 0) {
            if (wr == 0) {
#pragma unroll
                for (int m = 0; m < 4; ++m) { float* rowp = PART + ((size_t)u.kc * 64 + m * 16 + fr) * ldc + col0;
#pragma unroll
                    for (int bj = 0; bj < 2; ++bj) { *(f32x4*)(rowp + bj * HALF) = acc[0][bj][m][0]; *(f32x4*)(rowp + bj * HALF + 4) = acc[0][bj][m][1]; } } }
            return;
        }
#pragma unroll
        for (int ai = 0; ai < 2; ++ai)
#pragma unroll
            for (int m = 0; m < 4; ++m) { bf16_t* rowp = O + (size_t)(row0 + ai * HALF + m * 16) * ldc + col0;
#pragma unroll
                for (int bj = 0; bj < 2; ++bj) { f32x4 v0 = acc[ai][bj][m][0], v1 = acc[ai][bj][m][1];
#pragma unroll
                    for (int j = 0; j < 4; ++j) { const float a = v0[j] > 0.f ? v0[j] : 0.f, b = v1[j] > 0.f ? v1[j] : 0.f; v0[j] = a * a; v1[j] = b * b; }
                    u32x4 w; w.x = cvt_pk_bf16(v0[0], v0[1]); w.y = cvt_pk_bf16(v0[2], v0[3]); w.z = cvt_pk_bf16(v1[0], v1[1]); w.w = cvt_pk_bf16(v1[2], v1[3]);
                    *(u32x4*)(rowp + bj * HALF) = w; } }
    }
};
template <bool POOL> struct MixOrder {
    StaticOrder so; int nmain, nN, kdiv, ntot, G, c;
    __device__ void init(int N, int K, int G_, int c_) { nN = N / BM; so.init(32 * BM, N, G_, c_); nmain = 32 * nN; kdiv = (POOL ? 512 : K) / 256; ntot = nmain + nN * kdiv; G = G_; c = c_; }
    __device__ bool next(int i, Unit& u) const {
        const int L = i * G + c; if (L >= ntot) return false;
        if (L < nmain) return so.next(i, u);
        const int j = L - nmain; u.pm = 32; u.pn = j % nN; u.kc = j / nN; return true;
    }
    __device__ __forceinline__ int nt(const Unit& u, const Gemm& g) const { return u.kc >= 0 ? 4 : (POOL ? 8 : g.K / BK); }
    __device__ __forceinline__ size_t a_off(const Unit& u, const Gemm& g) const { return (size_t)u.pm * BM * g.lda * 2 + (size_t)((POOL ? (u.pn >> 1) * 512 : 0) + (u.kc >= 0 ? u.kc * 256 : 0)) * 2; }
    __device__ __forceinline__ size_t b_off(const Unit& u, const Gemm& g) const { return (size_t)u.pn * BM * g.ldb * 2 + (size_t)((POOL ? (u.pn >> 1) * 512 : 0) + (u.kc >= 0 ? u.kc * 256 : 0)) * 2; }
    __device__ __forceinline__ void a_ready(const Unit&) const {}
    __device__ __forceinline__ void done(const Unit&) const {}
};
template <int PROW> struct EpiF32S {
    static constexpr bool PERM = false, AFTER_DRAIN = false;
    bf16_t* C; int ldc; const float* cscale; float* PART;
    __device__ __forceinline__ f32x4 scl(int c) const { return cscale ? *(const f32x4*)(cscale + c) : (f32x4){1.f, 1.f, 1.f, 1.f}; }
    __device__ __forceinline__ void operator()(const f32x4 (&acc)[2][2][4][2], const Unit& u, int wr, int wc, int fr, int fq) const {
        asm volatile("" : "+v"(fr), "+v"(fq));
        const int col0 = u.pn * BM + wc * 32 + 4 * fq;
        if (u.kc < 0) {
            bf16_t* Ct = C + (size_t)u.pm * BM * ldc; const unsigned e0 = (unsigned)((wr * 64 + fr) * ldc + col0);
#pragma unroll
            for (int bj = 0; bj < 2; ++bj)
#pragma unroll
                for (int n = 0; n < 2; ++n) { const f32x4 sv = scl(col0 + bj * HALF + n * 16);
#pragma unroll
                    for (int ai = 0; ai < 2; ++ai)
#pragma unroll
                        for (int m = 0; m < 4; ++m) { const f32x4 v = acc[ai][bj][m][n] * sv; const unsigned w0 = cvt_pk_bf16(v[0], v[1]), w1 = cvt_pk_bf16(v[2], v[3]);
                            *(unsigned long long*)(Ct + e0 + (unsigned)((ai * HALF + m * 16) * ldc) + bj * HALF + n * 16) = (unsigned long long)w0 | ((unsigned long long)w1 << 32); } }
        } else if (PROW == 256) {
            float* Pk = PART + (size_t)u.kc * 256 * ldc; const unsigned e0 = (unsigned)((wr * 64 + fr) * ldc + col0);
#pragma unroll
            for (int bj = 0; bj < 2; ++bj)
#pragma unroll
                for (int n = 0; n < 2; ++n) { const f32x4 sv = scl(col0 + bj * HALF + n * 16);
#pragma unroll
                    for (int ai = 0; ai < 2; ++ai)
#pragma unroll
                        for (int m = 0; m < 4; ++m) *(f32x4*)(Pk + e0 + (unsigned)((ai * HALF + m * 16) * ldc) + bj * HALF + n * 16) = acc[ai][bj][m][n] * sv; }
        } else if (wr == 0) {
            float* Pk = PART + (size_t)u.kc * 64 * ldc; const unsigned e0 = (unsigned)(fr * ldc + col0);
#pragma unroll
            for (int bj = 0; bj < 2; ++bj)
#pragma unroll
                for (int n = 0; n < 2; ++n) { const f32x4 sv = scl(col0 + bj * HALF + n * 16);
#pragma unroll
                    for (int m = 0; m < 4; ++m) *(f32x4*)(Pk + e0 + (unsigned)(m * 16 * ldc) + bj * HALF + n * 16) = acc[0][bj][m][n] * sv; }
        }
    }
};
template <class Epi, class Sched, bool ALIGN_EPI = false, bool SP2 = false>
__device__ __forceinline__ void gemm_phase(PG8_LAS unsigned char* lds, const Gemm g, const Sched& S, const Epi& E) {
    const int tid = threadIdx.x, wid = __builtin_amdgcn_readfirstlane(tid >> 6), lane = tid & 63, wr = wid >> 2, wc = wid & 3, fr = lane & 15, fq = lane >> 4;
    unsigned voffA[2], voffB[2];
#pragma unroll
    for (int i = 0; i < 2; ++i) { int R, C; stage_rc(tid * 16 + i * 8192, R, C); const int Rb = Epi::PERM ? ((R & ~31) + perm32(R & 31)) : R;
        voffA[i] = (unsigned)(R * g.lda + C) * 2u; voffB[i] = (unsigned)(Rb * g.ldb + C) * 2u; }
    const size_t kstep = (size_t)(BK * 2);
    const size_t hsA = (size_t)HALF * g.lda * 2, hsB = (size_t)HALF * g.ldb * 2;
    const unsigned ldsw = (unsigned)wid * 1024u;
    const int aoff = lds_byte(wr * 64 + fr, fq * 8), boff = lds_byte(wc * 32 + fr, fq * 8);
#define PG8_SA(b, h) (((b) * 2 + (h)) * HTB)
#define PG8_SB(b, h) ((4 + (b) * 2 + (h)) * HTB)
#define PG8_STAGE(bufoff, gbase, voff) do { _Pragma("unroll") for (int _i = 0; _i < 2; ++_i) \
        __builtin_amdgcn_global_load_lds((const unsigned*)((const char*)(gbase) + (voff)[_i]), (PG8_LAS unsigned*)(lds + (bufoff) + ldsw + _i * 8192), 16, 0, 0); } while (0)
#define PG8_LDA(dst, b, h) do { _Pragma("unroll") for (int m = 0; m < 4; ++m) _Pragma("unroll") for (int k = 0; k < 2; ++k) dst[m][k] = *(const PG8_LAS bf16x8*)(lds + PG8_SA(b, h) + aoff + m * 2048 + k * 1024); } while (0)
#define PG8_LDB(dst, b, h) do { _Pragma("unroll") for (int n = 0; n < 2; ++n) _Pragma("unroll") for (int k = 0; k < 2; ++k) dst[n][k] = *(const PG8_LAS bf16x8*)(lds + PG8_SB(b, h) + boff + n * 2048 + k * 1024); } while (0)
#define PG8_MMA(ai, bj, At, Bt) do { __builtin_amdgcn_s_setprio(1); _Pragma("unroll") for (int m = 0; m < 4; ++m) _Pragma("unroll") for (int n = 0; n < 2; ++n) _Pragma("unroll") for (int k = 0; k < 2; ++k) \
        acc[ai][bj][m][n] = __builtin_amdgcn_mfma_f32_16x16x32_bf16(Bt[n][k], At[m][k], acc[ai][bj][m][n], 0, 0, 0); __builtin_amdgcn_s_setprio(0); } while (0)
#define PG8_WAIT_V(n) asm volatile("s_waitcnt vmcnt(" #n ")" ::: "memory")
#define PG8_WAIT_L(n) asm volatile("s_waitcnt lgkmcnt(" #n ")" ::: "memory")
#define PG8_BAR __builtin_amdgcn_s_barrier()
#define PG8_SCHED __builtin_amdgcn_sched_barrier(0)
    Unit cur, nxt; int ui = 0;
    if (!S.next(0, cur)) return;
    int nt = S.nt(cur, g);
    f32x4 acc[2][2][4][2];
#pragma unroll
    for (int a = 0; a < 2; ++a)
#pragma unroll
        for (int b = 0; b < 2; ++b)
#pragma unroll
            for (int m = 0; m < 4; ++m)
#pragma unroll
                for (int n = 0; n < 2; ++n) acc[a][b][m][n] = (f32x4){0.f, 0.f, 0.f, 0.f};
    bf16x8 At[4][2], B0[2][2], B1[2][2];
    const char* cA = (const char*)g.A + S.a_off(cur, g); const char* cB = (const char*)g.Bt + S.b_off(cur, g);
    S.a_ready(cur);
    if constexpr (SP2) {
        PG8_STAGE(PG8_SB(0, 0), cB, voffB); PG8_STAGE(PG8_SB(0, 1), cB + hsB, voffB); PG8_STAGE(PG8_SA(0, 0), cA, voffA); PG8_STAGE(PG8_SA(0, 1), cA + hsA, voffA);
        if (wr == 1) PG8_BAR;
        PG8_WAIT_V(2); PG8_BAR;
        PG8_STAGE(PG8_SB(1, 0), cB + kstep, voffB); PG8_STAGE(PG8_SA(1, 0), cA + kstep, voffA); PG8_STAGE(PG8_SB(1, 1), cB + hsB + kstep, voffB);
        PG8_WAIT_V(6); PG8_BAR;
    } else {
        PG8_STAGE(PG8_SB(0, 0), cB, voffB); PG8_STAGE(PG8_SA(0, 0), cA, voffA); PG8_STAGE(PG8_SB(0, 1), cB + hsB, voffB); PG8_STAGE(PG8_SA(0, 1), cA + hsA, voffA);
        if (wr == 1) PG8_BAR;
        PG8_WAIT_V(4); PG8_BAR;
        PG8_STAGE(PG8_SB(1, 0), cB + kstep, voffB); PG8_STAGE(PG8_SA(1, 0), cA + kstep, voffA); PG8_STAGE(PG8_SB(1, 1), cB + hsB + kstep, voffB);
        PG8_WAIT_V(6); PG8_BAR;
    }
    for (;;) {
        const bool has_next = S.next(ui + 1, nxt);
        const char* nA = has_next ? (const char*)g.A + S.a_off(nxt, g) : cA; const char* nB = has_next ? (const char*)g.Bt + S.b_off(nxt, g) : cB;
        for (int t = 0; t < nt; t += 2) {
            const bool last = (t == nt - 2);
            const char* a1 = cA + (size_t)(t + 1) * kstep;
            const char* a2 = last ? nA : cA + (size_t)(t + 2) * kstep; const char* b2 = last ? nB : cB + (size_t)(t + 2) * kstep;
            const char* a3 = a2 + kstep; const char* b3 = b2 + kstep;
            if (last && has_next) S.a_ready(nxt);
            if constexpr (SP2) {
            PG8_LDB(B0, 0, 0); PG8_LDB(B1, 0, 1); PG8_SCHED; PG8_LDA(At, 0, 0); PG8_STAGE(PG8_SA(1, 1), a1 + hsA, voffA);
            PG8_WAIT_V(8); PG8_WAIT_L(0); PG8_BAR; PG8_MMA(0, 0, At, B0); PG8_MMA(0, 1, At, B1); PG8_BAR; PG8_SCHED;
            PG8_LDA(At, 0, 1); PG8_STAGE(PG8_SB(0, 0), b2, voffB); PG8_STAGE(PG8_SB(0, 1), b2 + hsB, voffB); PG8_STAGE(PG8_SA(0, 0), a2, voffA);
            PG8_WAIT_V(8); PG8_WAIT_L(0); PG8_BAR; PG8_MMA(1, 0, At, B0); PG8_MMA(1, 1, At, B1); PG8_BAR; PG8_SCHED;
            PG8_LDB(B0, 1, 0); PG8_LDB(B1, 1, 1); PG8_SCHED; PG8_LDA(At, 1, 0); PG8_STAGE(PG8_SA(0, 1), a2 + hsA, voffA);
            PG8_WAIT_V(8); PG8_WAIT_L(0); PG8_BAR; PG8_MMA(0, 0, At, B0); PG8_MMA(0, 1, At, B1); PG8_BAR; PG8_SCHED;
            PG8_LDA(At, 1, 1); PG8_STAGE(PG8_SB(1, 0), b3, voffB); PG8_STAGE(PG8_SB(1, 1), b3 + hsB, voffB); PG8_STAGE(PG8_SA(1, 0), a3, voffA);
            PG8_WAIT_V(8); PG8_WAIT_L(0); PG8_BAR; PG8_MMA(1, 0, At, B0); PG8_MMA(1, 1, At, B1); PG8_BAR; PG8_SCHED;
            } else {
            PG8_LDB(B0, 0, 0); PG8_SCHED; PG8_LDA(At, 0, 0); PG8_STAGE(PG8_SA(1, 1), a1 + hsA, voffA);
            PG8_WAIT_L(8); PG8_BAR; PG8_WAIT_L(0); PG8_MMA(0, 0, At, B0); PG8_BAR; PG8_SCHED;
            PG8_LDB(B1, 0, 1); PG8_STAGE(PG8_SB(0, 0), b2, voffB);
            PG8_BAR; PG8_WAIT_L(0); PG8_MMA(0, 1, At, B1); PG8_BAR;
            PG8_LDA(At, 0, 1); PG8_STAGE(PG8_SA(0, 0), a2, voffA);
            PG8_BAR; PG8_WAIT_L(0); PG8_MMA(1, 0, At, B0); PG8_BAR; PG8_SCHED;
            PG8_STAGE(PG8_SB(0, 1), b2 + hsB, voffB);
            PG8_WAIT_V(6); PG8_BAR; PG8_MMA(1, 1, At, B1); PG8_BAR;
            PG8_LDB(B0, 1, 0); PG8_SCHED; PG8_LDA(At, 1, 0); PG8_STAGE(PG8_SA(0, 1), a2 + hsA, voffA);
            PG8_WAIT_L(8); PG8_BAR; PG8_WAIT_L(0); PG8_MMA(0, 0, At, B0); PG8_BAR; PG8_SCHED;
            PG8_LDB(B1, 1, 1); PG8_STAGE(PG8_SB(1, 0), b3, voffB);
            PG8_BAR; PG8_WAIT_L(0); PG8_MMA(0, 1, At, B1); PG8_BAR;
            PG8_LDA(At, 1, 1); PG8_STAGE(PG8_SA(1, 0), a3, voffA);
            PG8_BAR; PG8_WAIT_L(0); PG8_MMA(1, 0, At, B0); PG8_BAR; PG8_SCHED;
            PG8_STAGE(PG8_SB(1, 1), b3 + hsB, voffB);
            PG8_WAIT_V(6); PG8_BAR; PG8_MMA(1, 1, At, B1); PG8_BAR;
            }
        }
        if constexpr (ALIGN_EPI) { if (wr == 0) PG8_BAR; }
        if constexpr (!Epi::AFTER_DRAIN) { E(acc, cur, wr, wc, fr, fq); S.done(cur); }
        if (!has_next) break;
#pragma unroll
        for (int a = 0; a < 2; ++a)
#pragma unroll
            for (int b = 0; b < 2; ++b)
#pragma unroll
                for (int m = 0; m < 4; ++m)
#pragma unroll
                    for (int n = 0; n < 2; ++n) acc[a][b][m][n] = (f32x4){0.f, 0.f, 0.f, 0.f};
        cur = nxt; cA = nA; cB = nB; ++ui; nt = S.nt(cur, g);
        if constexpr (ALIGN_EPI) { if (wr == 1) PG8_BAR; }
    }
    PG8_WAIT_V(0);
    if constexpr (!ALIGN_EPI) { if (wr == 0) PG8_BAR; }
    PG8_BAR;
    if constexpr (Epi::AFTER_DRAIN) { E.fused(acc, cur, wr, wc, fr, fq, lds, wid, lane); S.done(cur); }
#undef PG8_SA
#undef PG8_SB
#undef PG8_STAGE
#undef PG8_LDA
#undef PG8_LDB
#undef PG8_MMA
#undef PG8_WAIT_V
#undef PG8_WAIT_L
#undef PG8_BAR
#undef PG8_SCHED
}
}

constexpr int DM = 2048, SEQ = 4096, NBATCH = 2, NPR = NBATCH * SEQ, DBAT = 8, DSEQ = 8, NSM = DBAT * DSEQ, NTOK = NPR + NSM, MP = 8448;
constexpr int HA = 8, DHA = 128, HB = 16, DHB = 64, DBR = 1024;
constexpr int BCOLS = 3520, INCOLS = 6592, INPAD = 6656, DFF = 8192, NPAGES = 128, PAGESZ = 128, PAST = 16384, PBUF = 15, NMR = 10;
constexpr float EPS_RMS = 1e-6f, EPS_LNX = 64e-5f, QK_SCALE = 0.08838834764831845f;
enum { I_XP = 0, I_XS, I_CK, I_CV, I_PT, I_SWKV, I_SSH, I_SPOOL, I_CP, I_CS, I_WADA, I_BADA, I_NG, I_WIN, I_WOUT, I_SBB, I_MU, I_W0, I_WUP, I_A0, I_AUP, I_GUP, I_KK, I_KA, I_RK, I_LNG, I_LNB, I_WPOOL, I_PSC, I_W1, I_W2, N_IN };
constexpr size_t O_YP = 0, O_YS = O_YP + (size_t)NPR * DM, O_KP = O_YS + (size_t)NSM * DM, O_VP = O_KP + (size_t)NPR * 1024, O_KS = O_VP + (size_t)NPR * 1024, O_VS = O_KS + (size_t)NSM * 1024,
                 O_WKVP = O_VS + (size_t)NSM * 1024, O_WKVS = O_WKVP + (size_t)NBATCH * HB * 64 * 64, O_SHP = O_WKVS + (size_t)DBAT * HB * 64 * 64, O_SHS = O_SHP + (size_t)NBATCH * BCOLS,
                 O_PLP = O_SHS + (size_t)DBAT * BCOLS, O_PLS = O_PLP + (size_t)NBATCH * PBUF * DM, O_END = O_PLS + (size_t)DBAT * PBUF * DM;
constexpr size_t MiB = 1u << 20;
constexpr size_t WS_CTL = 0, CTL_ZERO_BYTES = 64 * 1024, WS_MOD = 1 * MiB, WS_WIN = 2 * MiB, WS_WOUT = 28 * MiB, WS_W1 = 36 * MiB, WS_W2 = 100 * MiB, WS_WPOOL = 164 * MiB,
                 WS_H = 172 * MiB, WS_OAB = 205 * MiB, WS_M = 238 * MiB, WS_P = 271 * MiB, WS_OUT = 486 * MiB, WS_XR = 552 * MiB, WS_HF = 617 * MiB, WS_U = 682 * MiB,
                 WS_RWV = 814 * MiB, WS_SCL = 1072 * MiB, WS_G = 1075 * MiB, WS_Y = 1108 * MiB, WS_PU = 1141 * MiB, WS_Z = 1205 * MiB, WS_SC = 1237 * MiB, WS_QB = 1269 * MiB, WS_KB = 1286 * MiB, WS_VB = 1303 * MiB, WS_OP = 1320 * MiB, WS_CL = 1384 * MiB, WS_SPART = 1385 * MiB, WS_SCAR = 1394 * MiB, WS_LA = 1395 * MiB, WS_LWT = 1404 * MiB, WS_LWO = 1408 * MiB, WS_YC = 1508 * MiB, WS_PART = 1541 * MiB, WS_PARTU = 1558 * MiB, WS_END = 1575 * MiB;
static_assert(WS_WIN + (size_t)INPAD * DM * 2 <= WS_WOUT && WS_P + (size_t)MP * INPAD * 4 <= WS_OUT && WS_U + (size_t)MP * DFF * 2 <= WS_RWV && WS_RWV + (size_t)NTOK * HB * 512 * 4 <= WS_SCL, "ws map");
constexpr int CW_BAR = 4096;
constexpr int RING_BYTES = 131072, LDSCTL_OFF = RING_BYTES, MISC_OFF = LDSCTL_OFF + 320, LDS_BYTES = 147456;
constexpr int NWAVES = 8, NTHR = 512;

#define GAS __attribute__((address_space(1)))
#define LAS __attribute__((address_space(3)))
typedef unsigned short bf16;
__device__ __forceinline__ float ldbf(const bf16* p) { return __uint_as_float((unsigned)*p << 16); }
__device__ __forceinline__ float ldbf_nt(const bf16* p) { return __uint_as_float((unsigned)__builtin_nontemporal_load(p) << 16); }
typedef float f32x4 __attribute__((ext_vector_type(4)));
typedef float f32x2 __attribute__((ext_vector_type(2)));
typedef unsigned u32x2 __attribute__((ext_vector_type(2)));
typedef unsigned u32x4 __attribute__((ext_vector_type(4)));
#define LDS_WAIT() asm volatile("s_waitcnt lgkmcnt(0)" ::: "memory")
#define VM_WAIT() asm volatile("s_waitcnt vmcnt(0)" ::: "memory")
using pg8::cvt_pk_bf16;
constexpr size_t WS_PBH = WS_RWV, WS_LWH = WS_RWV + 64 * MiB;
static_assert((size_t)NPR * 3072 * 2 <= 64 * MiB && 128 * MiB <= (size_t)NPR * HB * 512 * 4, "bf16 prompt copies fit below the sample rows of RWV");
constexpr int PBLD = 3584;
struct EpiIn {
    static constexpr bool PERM = false, AFTER_DRAIN = false;
    bf16 *QB, *KB, *VB; float* PB; float* out; bf16* PBH;
    __device__ __forceinline__ void operator()(const pg8::f32x4 (&acc)[2][2][4][2], const pg8::Unit& u, int wr, int wc, int fr, int fq) const {
        const int row0 = u.pm * 256 + wr * 64 + fr, colt = u.pn * 256 + wc * 32 + 4 * fq;
        if (u.pn >= 12) {
#pragma unroll
            for (int ai = 0; ai < 2; ++ai)
#pragma unroll
                for (int m = 0; m < 4; ++m) {
                    if (u.pm < 32 && u.pn < 24) { bf16* rowh = PBH + (size_t)(row0 + ai * 128 + m * 16) * 3072 + (colt - 3072);
#pragma unroll
                        for (int bj = 0; bj < 2; ++bj)
#pragma unroll
                            for (int n = 0; n < 2; ++n) { const pg8::f32x4 v = acc[ai][bj][m][n]; u32x2 w; w.x = cvt_pk_bf16(v[0], v[1]); w.y = cvt_pk_bf16(v[2], v[3]); *(u32x2*)(rowh + bj * 128 + n * 16) = w; } }
                    else { float* rowp = PB + (size_t)(row0 + ai * 128 + m * 16) * PBLD + (colt - 3072);
#pragma unroll
                        for (int bj = 0; bj < 2; ++bj)
#pragma unroll
                            for (int n = 0; n < 2; ++n) *(pg8::f32x4*)(rowp + bj * 128 + n * 16) = acc[ai][bj][m][n]; } }
        } else {
            const int sel = u.pn >> 2, c0 = colt - sel * 1024;
            static_assert(WS_KB - WS_QB == WS_VB - WS_KB && O_VP - O_KP == (size_t)NPR * 1024 && O_VS - O_KS == (size_t)NSM * 1024, "q/k/v buffers are equally spaced");
            bf16* Bt = QB + (size_t)sel * ((WS_KB - WS_QB) / 2) + (size_t)u.pm * 256 * 1024;
            float* Ot = u.pm < 32 ? out + O_KP + (size_t)(sel ? sel - 1 : 0) * NPR * 1024 + (size_t)u.pm * 256 * 1024 : out + O_KS + (size_t)(sel ? sel - 1 : 0) * NSM * 1024;
            const int rl0 = wr * 64 + fr;
#pragma unroll
            for (int ai = 0; ai < 2; ++ai)
#pragma unroll
                for (int m = 0; m < 4; ++m) { const int rl = rl0 + ai * 128 + m * 16; const unsigned eo = (unsigned)(rl * 1024 + c0);
                    const bool wo = sel != 0 && (u.pm < 32 || rl < NSM);
#pragma unroll
                    for (int bj = 0; bj < 2; ++bj)
#pragma unroll
                        for (int n = 0; n < 2; ++n) { const pg8::f32x4 v = acc[ai][bj][m][n]; u32x2 w; w.x = cvt_pk_bf16(v[0], v[1]); w.y = cvt_pk_bf16(v[2], v[3]);
                            *(u32x2*)(Bt + eo + bj * 128 + n * 16) = w; if (wo) *(pg8::f32x4*)(Ot + eo + bj * 128 + n * 16) = v; }
                    asm volatile("" ::: "memory"); }
        }
    }
};

#define XB_TMO      128
#define XB_XCNT(j)  (256  + 64 * (j))
#define XB_XSUB(j)  (1280 + 64 * (j))
#define XB_XGEN(j)  (2304 + 64 * (j))
#define XB_TOP      3328
#define XB_TOPGEN   3392
#define XCD_BAR_WORDS 3456
#define XB_SPIN_CAP (1u << 18)

__device__ __forceinline__ unsigned xb_ld(unsigned* p)              { return __hip_atomic_load(p, __ATOMIC_RELAXED, __HIP_MEMORY_SCOPE_AGENT); }
__device__ __forceinline__ unsigned xb_add(unsigned* p, unsigned v) { return __hip_atomic_fetch_add(p, v, __ATOMIC_RELAXED, __HIP_MEMORY_SCOPE_AGENT); }
__device__ __forceinline__ unsigned xb_xcc_id() { return (unsigned)__builtin_amdgcn_s_getreg((3 << 11) | 20) & 0xFu; }
#define XB_SPIN(cond, bar) do { unsigned _sp = 0; while (cond) { __builtin_amdgcn_s_sleep(1); \
    if ((++_sp & 255u) == 0u) { if (xb_ld(&(bar)[XB_TMO])) break; if (_sp > XB_SPIN_CAP) { atomicAdd(&(bar)[XB_TMO], 1u); break; } } } } while (0)

struct XcdBarrier {
    unsigned* bar; unsigned x;
    volatile LAS unsigned* st;
};

__device__ __forceinline__ XcdBarrier xcd_barrier_post(unsigned* bar, volatile LAS unsigned* st) {
    XcdBarrier b; b.bar = bar; b.x = xb_xcc_id(); b.st = st;
    if (threadIdx.x == 0) (void)xb_add(&bar[XB_XCNT(b.x)], 1u);
    return b;
}
__device__ __forceinline__ void xcd_barrier_complete(unsigned* bar, unsigned x, unsigned& nloc, unsigned& nx) {
    const unsigned G = gridDim.x * gridDim.y * gridDim.z;
    unsigned sum, cnt, mine, sp = 0u;
    for (;;) {
        sum = 0u; cnt = 0u; mine = 0u;
#pragma unroll
        for (unsigned j = 0; j < 16; ++j) { const unsigned c = xb_ld(&bar[XB_XCNT(j)]); sum += c; cnt += (c > 0u) ? 1u : 0u; mine = (j == x) ? c : mine; }
        if (sum == G) break;
        __builtin_amdgcn_s_sleep(1);
        if ((++sp & 255u) == 0u) { if (xb_ld(&bar[XB_TMO])) break; if (sp > XB_SPIN_CAP) { atomicAdd(&bar[XB_TMO], 1u); break; } }
    }
    nloc = mine > 0u ? mine : 1u; nx = cnt > 0u ? cnt : 1u;
}

__device__ __forceinline__ void xcd_barrier(const XcdBarrier& b) {
    asm volatile("s_waitcnt vmcnt(0)" ::: "memory");
    __syncthreads();
    if (threadIdx.x == 0) {
        unsigned* bar = b.bar;
        __builtin_amdgcn_s_waitcnt(0);
        unsigned nloc = b.st[0], nx = b.st[1];
        if (nloc == 0u) { xcd_barrier_complete(bar, b.x, nloc, nx); b.st[0] = nloc; b.st[1] = nx; }
        const unsigned old = xb_add(&bar[XB_XSUB(b.x)], 1u);
        const unsigned gen = old / nloc;
        if (old + 1u == (gen + 1u) * nloc) {
            __builtin_amdgcn_fence(__ATOMIC_RELEASE, "agent");
            asm volatile("s_waitcnt vmcnt(0)" ::: "memory");
            const unsigned og = xb_add(&bar[XB_TOP], 1u);
            const unsigned tg = og / nx;
            if (og + 1u == (tg + 1u) * nx) xb_add(&bar[XB_TOPGEN], 1u);
            else XB_SPIN(xb_ld(&bar[XB_TOPGEN]) == tg, bar);
            __builtin_amdgcn_fence(__ATOMIC_ACQUIRE, "agent");
            xb_add(&bar[XB_XGEN(b.x)], 1u);
            asm volatile("s_waitcnt vmcnt(0)" ::: "memory");
        } else {
            XB_SPIN(xb_ld(&bar[XB_XGEN(b.x)]) == gen, bar);
            __builtin_amdgcn_fence(__ATOMIC_ACQUIRE, "agent");
            asm volatile("s_waitcnt vmcnt(0)" ::: "memory");
        }
    }
    __syncthreads();
}


struct Ctx {
    LAS unsigned char* lds; int tid, lane, wave, vcu, G;
    __device__ __forceinline__ const float* in(int i) const { return ((const float* const __attribute__((address_space(4)))*)__builtin_amdgcn_kernarg_segment_ptr())[i]; }
    __device__ __forceinline__ float* outp() const { return ((float* const __attribute__((address_space(4)))*)__builtin_amdgcn_kernarg_segment_ptr())[N_IN]; }
    __device__ __forceinline__ unsigned char* wsp() const { return ((unsigned char* const __attribute__((address_space(4)))*)__builtin_amdgcn_kernarg_segment_ptr())[N_IN + 1]; }
};
template <int CTRL> __device__ __forceinline__ float dpp_f(float x) { return __builtin_bit_cast(float, __builtin_amdgcn_mov_dpp(__builtin_bit_cast(int, x), CTRL, 0xf, 0xf, true)); }
#define readlane_f(x, l) __builtin_bit_cast(float, __builtin_amdgcn_readlane(__builtin_bit_cast(int, (float)(x)), (l)))
__device__ __forceinline__ float wave_sum(float v) {
    v += dpp_f<0xB1>(v); v += dpp_f<0x4E>(v); v += dpp_f<0x141>(v); v += dpp_f<0x140>(v);
    auto s = __builtin_amdgcn_permlane16_swap(__float_as_uint(v), __float_as_uint(v), false, false);
    v = __uint_as_float(s[0]) + __uint_as_float(s[1]);
    auto t = __builtin_amdgcn_permlane32_swap(__float_as_uint(v), __float_as_uint(v), false, false);
    return __uint_as_float(t[0]) + __uint_as_float(t[1]);
}
__device__ __forceinline__ float sigmoidf_(float x) { return 1.f / (1.f + __expf(-x)); }
__device__ __forceinline__ float softplusf_(float x) { return fmaxf(x, 0.f) + log1pf(__expf(-fabsf(x))); }
__device__ __forceinline__ int mod_row(int r) { return r < NPR ? (r >> 12) : 2 + ((r - NPR) >> 3); }
#define WSP(T, off) ((T*)(F.wsp() + (off)))

struct CvtItem { const float* W; bf16* WT; int ldw, ldt, k0, n0; };
__device__ __forceinline__ void item_load(float (&tv)[32], const CvtItem& d, int lane) {
#pragma unroll
    for (int i = 0; i < 32; ++i) tv[i] = __builtin_nontemporal_load(d.W + (size_t)(d.k0 + 2 * i + (lane >> 5)) * d.ldw + d.n0 + (lane & 31));
}
__device__ __forceinline__ void item_store(const float (&tv)[32], const CvtItem& d, LAS float* scr, int lane) {
#pragma unroll
    for (int i = 0; i < 32; ++i) scr[(2 * i + (lane >> 5)) * 33 + (lane & 31)] = tv[i];
    LDS_WAIT(); asm volatile("" ::: "memory");
    const int c = lane & 7;
#pragma unroll
    for (int j = 0; j < 4; ++j) { const int n = (lane >> 3) + 8 * j; const LAS float* s = scr + (8 * c) * 33 + n;
        u32x4 o; o.x = cvt_pk_bf16(s[0 * 33], s[1 * 33]); o.y = cvt_pk_bf16(s[2 * 33], s[3 * 33]); o.z = cvt_pk_bf16(s[4 * 33], s[5 * 33]); o.w = cvt_pk_bf16(s[6 * 33], s[7 * 33]);
        *(GAS u32x4*)(d.WT + (size_t)(d.n0 + n) * d.ldt + d.k0 + 8 * c) = o; }
    LDS_WAIT(); asm volatile("" ::: "memory");
}
constexpr int IT_IN = 32 * 206, IT_OUT = 32 * 64, IT_W1 = 32 * 256, IT_W2 = 128 * 64, IT_PL = 8 * 16, NIT_ALL = IT_IN + IT_OUT + 2 * IT_W1 + 2 * IT_W2 + 4 * IT_PL;
__device__ __forceinline__ CvtItem item_decode(Ctx& F, int it) {
    int r = it; CvtItem d; int N;
    if (r < IT_IN) { d.W = F.in(I_WIN); d.WT = WSP(bf16, WS_WIN); N = INCOLS; d.ldt = DM; }
    else if ((r -= IT_IN) < IT_OUT) { d.W = F.in(I_WOUT); d.WT = WSP(bf16, WS_WOUT); N = DM; d.ldt = DM; }
    else if ((r -= IT_OUT) < 2 * IT_W1) { const int l = r / IT_W1; r -= l * IT_W1; d.W = F.in(I_W1) + (size_t)l * DM * DFF; d.WT = WSP(bf16, WS_W1) + (size_t)l * DFF * DM; N = DFF; d.ldt = DM; }
    else if ((r -= 2 * IT_W1) < 2 * IT_W2) { const int l = r / IT_W2; r -= l * IT_W2; d.W = F.in(I_W2) + (size_t)l * DFF * DM; d.WT = WSP(bf16, WS_W2) + (size_t)l * DM * DFF; N = DM; d.ldt = DFF; }
    else { r -= 2 * IT_W2; const int g = r / IT_PL; r -= g * IT_PL; d.W = F.in(I_WPOOL) + (size_t)g * 512 * 512; d.WT = WSP(bf16, WS_WPOOL) + (size_t)(g * 512) * DM + g * 512; N = 512; d.ldt = DM; }
    const int nblk = N / 32, kb = r / nblk, nb = r - kb * nblk;
    d.ldw = N; d.k0 = 64 * kb; d.n0 = 32 * nb; return d;
}
__device__ __forceinline__ void convert_run(Ctx& F, int first, int stride, int lim, LAS float* scr) {
    int it = first; if (it >= lim) return;
    float ta[32], tb[32]; CvtItem da = item_decode(F, it), db = da; item_load(ta, da, F.lane);
    for (;;) {
        const int i2 = it + stride; const bool h2 = i2 < lim; if (h2) { db = item_decode(F, i2); item_load(tb, db, F.lane); }
        item_store(ta, da, scr, F.lane); if (!h2) break;
        const int i3 = i2 + stride; const bool h3 = i3 < lim; if (h3) { da = item_decode(F, i3); item_load(ta, da, F.lane); }
        item_store(tb, db, scr, F.lane); if (!h3) break;
        it = i3; }
}
constexpr int NCVT = 40, N_HIDE = 24000;
__device__ __forceinline__ void phase_prologue(Ctx& F) {
    LAS float* scr = (LAS float*)(F.lds + F.wave * 16384);
    const int gw = F.vcu * NWAVES + F.wave, NGW = F.G * NWAVES;
    convert_run(F, gw, NGW, IT_IN, scr);
    if (F.G > NCVT + 8) convert_run(F, IT_IN + N_HIDE + gw, NGW, NIT_ALL, scr); else convert_run(F, IT_IN + gw, NGW, NIT_ALL, scr);
    for (int i = F.vcu * NTHR + F.tid; i < 3072 * 64; i += F.G * NTHR) {
        const int kc = i / 3072, n = i - kc * 3072, reg = n >> 10, nn = n & 1023;
        float v[8];
        if (reg == 0) {
#pragma unroll
            for (int j = 0; j < 8; ++j) { const int k = 8 * kc + j; v[j] = (k < 96) ? F.in(I_WUP)[(size_t)k * 1024 + nn] : 0.f; } }
        else if (reg == 1) {
#pragma unroll
            for (int j = 0; j < 8; ++j) { const int k = 8 * kc + j - 96; v[j] = (k >= 0 && k < 96) ? F.in(I_AUP)[(size_t)k * 1024 + nn] : 0.f; } }
        else {
#pragma unroll
            for (int j = 0; j < 8; ++j) { const int k = 8 * kc + j - 192; v[j] = (k >= 0 && k < 256) ? F.in(I_GUP)[(size_t)k * 1024 + nn] : 0.f; } }
        u32x4 o; o.x = cvt_pk_bf16(v[0], v[1]); o.y = cvt_pk_bf16(v[2], v[3]); o.z = cvt_pk_bf16(v[4], v[5]); o.w = cvt_pk_bf16(v[6], v[7]);
        *(GAS u32x4*)(WSP(bf16, WS_LWT) + (size_t)n * 512 + 8 * kc) = o;
    }
    __syncthreads();
    LAS float* scs = (LAS float*)F.lds;
    LAS float* part = (LAS float*)(F.lds + 16384);
    float* PARTM = WSP(float, WS_G);
    for (int su = F.vcu; su < 768; su += F.G) {
        const int task = su >> 3, ke = su & 7, l = task / 48, cb = (task - l * 48) * 256;
        for (int i = F.tid; i < NMR * 256; i += NTHR) { const int r = i >> 8, k = ke * 256 + (i & 255); const float c = r < 2 ? F.in(I_CP)[r * DM + k] : F.in(I_CS)[(r - 2) * DM + k]; scs[i] = c / (1.f + __expf(-c)); }
        __syncthreads();
        const float* W = F.in(I_WADA) + ((size_t)l * DM + ke * 256 + F.wave * 32) * 12288 + cb + F.lane * 4;
        f32x4 acc[NMR];
#pragma unroll
        for (int r = 0; r < NMR; ++r) acc[r] = (f32x4){0.f, 0.f, 0.f, 0.f};
        for (int k = 0; k < 32; k += 8) {
            f32x4 wv[8];
#pragma unroll
            for (int j = 0; j < 8; ++j) wv[j] = __builtin_nontemporal_load((const GAS f32x4*)(W + (size_t)(k + j) * 12288));
#pragma unroll
            for (int j = 0; j < 8; j += 4)
#pragma unroll
                for (int r = 0; r < NMR; ++r) { const f32x4 sv = *(const LAS f32x4*)(scs + r * 256 + F.wave * 32 + k + j); acc[r] += (wv[j] * sv.x + wv[j + 1] * sv.y) + (wv[j + 2] * sv.z + wv[j + 3] * sv.w); }
        }
#pragma unroll
        for (int r = 0; r < NMR; ++r) *(LAS f32x4*)(part + (F.wave * NMR + r) * 256 + F.lane * 4) = acc[r];
        __syncthreads();
        for (int i = F.tid; i < NMR * 64; i += NTHR) { const int r = i >> 6, c4 = (i & 63) * 4; f32x4 sm = *(const LAS f32x4*)(part + r * 256 + c4);
#pragma unroll
            for (int w = 1; w < NWAVES; ++w) sm += *(const LAS f32x4*)(part + (w * NMR + r) * 256 + c4);
            *(GAS f32x4*)(PARTM + ((size_t)ke * 2 * NMR + l * NMR + r) * 12288 + cb + c4) = sm; }
        __syncthreads();
    }
}

struct Row { f32x4 v[8]; };
__device__ __forceinline__ void row_load(Row& R, const float* p, int lane) {
#pragma unroll
    for (int j = 0; j < 8; ++j) R.v[j] = *(const GAS f32x4*)(p + j * 256 + lane * 4);
}
__device__ __forceinline__ void row_load_bf16(Row& R, const bf16* p, int lane) {
#pragma unroll
    for (int j = 0; j < 8; ++j) { const u32x2 w = *(const GAS u32x2*)(p + j * 256 + lane * 4);
        R.v[j] = (f32x4){__uint_as_float(w.x << 16), __uint_as_float(w.x & 0xffff0000u), __uint_as_float(w.y << 16), __uint_as_float(w.y & 0xffff0000u)}; }
}
__device__ __forceinline__ float row_sumsq(const Row& R) { float s = 0.f;
#pragma unroll
    for (int j = 0; j < 8; ++j) s += (R.v[j].x * R.v[j].x + R.v[j].y * R.v[j].y) + (R.v[j].z * R.v[j].z + R.v[j].w * R.v[j].w);
    return wave_sum(s); }
__device__ __forceinline__ const float* x_in_row(Ctx& F, int r) { return r < NPR ? F.in(I_XP) + (size_t)r * DM : F.in(I_XS) + (size_t)(r - NPR) * DM; }
__device__ __forceinline__ void row_modulate(Row& H, const Row& X, float rstd, const float* g, const float* shift, const float* scale, int lane) {
#pragma unroll
    for (int j = 0; j < 8; ++j) { const int c = j * 256 + lane * 4; const f32x4 gg = *(const GAS f32x4*)(g + c), sh = *(const GAS f32x4*)(shift + c), sc = *(const GAS f32x4*)(scale + c);
        H.v[j] = X.v[j] * rstd * gg * (sc + 1.f) + sh; }
}
__device__ __forceinline__ void row_store_bf16(const Row& H, bf16* p, int lane) {
#pragma unroll
    for (int j = 0; j < 8; ++j) { u32x2 w; w.x = cvt_pk_bf16(H.v[j].x, H.v[j].y); w.y = cvt_pk_bf16(H.v[j].z, H.v[j].w); *(GAS u32x2*)(p + j * 256 + lane * 4) = w; }
}
__device__ __forceinline__ void row_store_f32(const Row& H, float* p, int lane) {
#pragma unroll
    for (int j = 0; j < 8; ++j) *(GAS f32x4*)(p + j * 256 + lane * 4) = H.v[j];
}
__device__ __forceinline__ void row_store_f32_nt(const Row& H, float* p, int lane) {
#pragma unroll
    for (int j = 0; j < 8; ++j) __builtin_nontemporal_store(H.v[j], (GAS f32x4*)(p + j * 256 + lane * 4));
}
struct RowB { u32x2 w[8]; };
__device__ __forceinline__ void rowb_load(RowB& R, const bf16* p, int lane) {
#pragma unroll
    for (int j = 0; j < 8; ++j) R.w[j] = *(const GAS u32x2*)(p + j * 256 + lane * 4);
}
__device__ __forceinline__ void rowb_cvt(Row& R, const RowB& B) {
#pragma unroll
    for (int j = 0; j < 8; ++j) R.v[j] = (f32x4){__uint_as_float(B.w[j].x << 16), __uint_as_float(B.w[j].x & 0xffff0000u), __uint_as_float(B.w[j].y << 16), __uint_as_float(B.w[j].y & 0xffff0000u)};
}
constexpr int PSET_FLOATS = 3 * DM;
static_assert(NSM == 64 && 3 * PSET_FLOATS * 4 + 7 * DM * 4 <= RING_BYTES, "row phases: 8 workgroups x 8 waves take the sample rows; three parameter sets in LDS");
template <int KIND, int L> __device__ __forceinline__ void stage_row_params(Ctx& F) {
    const float* MOD = WSP(float, WS_MOD); const float* ng = F.in(I_NG) + (size_t)L * 4 * DM;
    const int nset = F.vcu < 64 ? 3 : 2;
#define RP_LD4(p) (*(const GAS f32x4*)(p))
    for (int i = F.tid; i < nset * (DM / 4); i += NTHR) {
        const int s = i >> 9, c = (i & 511) * 4, mr = s < 2 ? s : 2 + (F.vcu >> 3);
        const float* m = MOD + (size_t)(L * NMR + mr) * 12288;
        f32x4 v0 = {0.f, 0.f, 0.f, 0.f}, v1 = v0, v2 = v0;
        if (KIND == 0) {
            const float* pm = WSP(float, WS_G) + (size_t)mr * 12288; f32x4 sh = RP_LD4(F.in(I_BADA) + c), scl = RP_LD4(F.in(I_BADA) + DM + c);
#pragma unroll
            for (int ke = 0; ke < 8; ++ke) { sh += RP_LD4(pm + (size_t)ke * 2 * NMR * 12288 + c); scl += RP_LD4(pm + (size_t)ke * 2 * NMR * 12288 + DM + c); }
            v1 = RP_LD4(ng + c) * (scl + 1.f); v2 = sh; }
        else if (KIND == 1) { v0 = RP_LD4(m + 2 * DM + c) * RP_LD4(ng + DM + c); v1 = RP_LD4(ng + 2 * DM + c) * (RP_LD4(m + 4 * DM + c) + 1.f); v2 = RP_LD4(m + 3 * DM + c); }
        else { v0 = RP_LD4(m + 5 * DM + c) * RP_LD4(ng + 3 * DM + c);
               if (KIND == 2) { const float* m1 = MOD + (size_t)(1 * NMR + mr) * 12288; v1 = RP_LD4(F.in(I_NG) + (size_t)4 * DM + c) * (RP_LD4(m1 + DM + c) + 1.f); v2 = RP_LD4(m1 + c); } }
        LAS float* d = (LAS float*)F.lds + s * PSET_FLOATS + c;
        *(LAS f32x4*)d = v0; *(LAS f32x4*)(d + DM) = v1; *(LAS f32x4*)(d + 2 * DM) = v2;
    }
#undef RP_LD4
    __syncthreads();
}
__device__ __forceinline__ const LAS float* row_pset(Ctx& F, int r) { return (const LAS float*)F.lds + (r < NPR ? (r >> 12) : 2) * PSET_FLOATS; }
__device__ __forceinline__ void row_residual_l(Row& X, const Row& O, const LAS float* ps, int lane) {
    const float rstd = rsqrtf(row_sumsq(O) * (1.f / DM) + EPS_RMS);
#pragma unroll
    for (int j = 0; j < 8; ++j) { const f32x4 gt = *(const LAS f32x4*)(ps + j * 256 + lane * 4); X.v[j] = X.v[j] + gt * (O.v[j] * rstd); }
}
__device__ __forceinline__ void row_modulate_l(Row& H, const Row& X, const LAS float* ps, int lane) {
    const float rstd = rsqrtf(row_sumsq(X) * (1.f / DM) + EPS_RMS);
#pragma unroll
    for (int j = 0; j < 8; ++j) { const int c = j * 256 + lane * 4; const f32x4 a = *(const LAS f32x4*)(ps + DM + c), sh = *(const LAS f32x4*)(ps + 2 * DM + c); H.v[j] = X.v[j] * rstd * a + sh; }
}
__device__ __forceinline__ void phase_mod0(Ctx& F) {
    stage_row_params<0, 0>(F);
    const int gw = F.vcu * NWAVES + F.wave, NGW = F.G * NWAVES, samp = (F.vcu < 64 && F.wave == 0) ? NPR + F.vcu : NTOK; bf16* Hb = WSP(bf16, WS_H);
    Row Xn; row_load(Xn, x_in_row(F, gw), F.lane);
    for (int r = gw; r < NPR; r += NGW) {
        Row X = Xn, H; const int rn = r + NGW, rp = rn < NPR ? rn : (samp < NTOK ? samp : r);
        row_load(Xn, x_in_row(F, rp), F.lane);
        row_modulate_l(H, X, row_pset(F, r), F.lane);
        row_store_bf16(H, Hb + (size_t)r * DM, F.lane);
    }
    if (samp < NTOK) { Row H; row_modulate_l(H, Xn, row_pset(F, samp), F.lane); row_store_bf16(H, Hb + (size_t)samp * DM, F.lane); }
}
__device__ __forceinline__ void row_residual(Row& X, const Row& O, const float* ga, const float* gate, int lane) {
    const float rstd = rsqrtf(row_sumsq(O) * (1.f / DM) + EPS_RMS);
#pragma unroll
    for (int j = 0; j < 8; ++j) { const int c = j * 256 + lane * 4; const f32x4 gg = *(const GAS f32x4*)(ga + c), gt = *(const GAS f32x4*)(gate + c); X.v[j] = X.v[j] + gt * (O.v[j] * rstd * gg); }
}
template <int NK> __device__ __forceinline__ void row_load_out(Ctx& F, Row& O, int r, int lane) {
    if (r < NPR) { const bf16* op = WSP(bf16, WS_OUT) + (size_t)r * DM;
#pragma unroll
        for (int j = 0; j < 8; ++j) { const u32x2 w = *(const GAS u32x2*)(op + j * 256 + lane * 4);
            O.v[j] = (f32x4){__uint_as_float(w.x << 16), __uint_as_float(w.x & 0xffff0000u), __uint_as_float(w.y << 16), __uint_as_float(w.y & 0xffff0000u)}; }
        return; }
    const float* pp = WSP(float, WS_PART) + (size_t)(r - NPR) * DM;
    row_load(O, pp, lane);
    for (int kc = 1; kc < NK; ++kc) { Row T; row_load(T, pp + (size_t)kc * 64 * DM, lane);
#pragma unroll
        for (int j = 0; j < 8; ++j) O.v[j] += T.v[j]; }
}
__device__ __forceinline__ f32x4 ld_bf4(const bf16* p) { const u32x2 w = *(const GAS u32x2*)p; return (f32x4){__uint_as_float(w.x << 16), __uint_as_float(w.x & 0xffff0000u), __uint_as_float(w.y << 16), __uint_as_float(w.y & 0xffff0000u)}; }
__device__ __forceinline__ void row_load_pool(Ctx& F, Row& O, int r, int lane) {
    if (r < NPR && (r & (SEQ - 1)) >= PBUF) { const bf16* op = WSP(bf16, WS_OUT) + (size_t)r * DM + lane * 4;
#pragma unroll
        for (int j8 = 0; j8 < 8; ++j8) { const int wlen = 2 << (j8 >> 1);
            const f32x4 cur = ld_bf4(op + j8 * 256); f32x4 sum = cur;
#pragma unroll
            for (int j = 1; j < wlen; ++j) sum += ld_bf4(op + j8 * 256 - (size_t)j * DM);
            O.v[j8] = sum * (1.f / (float)wlen) - cur; }
    } else if (r < NPR) { const int t = r & (SEQ - 1); const bf16* op = WSP(bf16, WS_OUT) + (size_t)r * DM + lane * 4;
#pragma unroll
        for (int j8 = 0; j8 < 8; ++j8) { const int wlen = 2 << (j8 >> 1), n = (t + 1) < wlen ? (t + 1) : wlen;
            const f32x4 cur = ld_bf4(op + j8 * 256); f32x4 sum = cur;
            for (int j = 1; j < n; ++j) sum += ld_bf4(op + j8 * 256 - (size_t)j * DM);
            O.v[j8] = sum * (1.f / (float)n) - cur; }
    } else { const int rs = r - NPR, b = rs >> 3, t = rs & 7; const float* pp = WSP(float, WS_PART) + lane * 4;
#pragma unroll
        for (int j8 = 0; j8 < 8; ++j8) { const int wlen = 2 << (j8 >> 1); f32x4 cur = {0.f, 0.f, 0.f, 0.f}, sum = {0.f, 0.f, 0.f, 0.f};
#pragma unroll
            for (int j = 0; j < wlen; ++j) { const int tj = t - j, pr = tj >= 0 ? rs - j : 64 + b * PBUF + PBUF + tj;
                const f32x4 g = *(const GAS f32x4*)(pp + (size_t)pr * DM + j8 * 256) + *(const GAS f32x4*)(pp + (size_t)(256 + pr) * DM + j8 * 256);
                sum += g; if (j == 0) cur = g; }
            O.v[j8] = sum * (1.f / (float)wlen) - cur; }
    }
}
template <int NK> __device__ __forceinline__ void sample_row_gather(Ctx& F, Row& O, int s) {
    constexpr int PER = NK / 8; const float* pp = WSP(float, WS_PART) + ((size_t)(F.wave * PER) * 64 + s) * DM; Row T[PER];
#pragma unroll
    for (int k = 0; k < PER; ++k) row_load(T[k], pp + (size_t)k * 64 * DM, F.lane);
    O = T[0];
#pragma unroll
    for (int k = 1; k < PER; ++k)
#pragma unroll
        for (int j = 0; j < 8; ++j) O.v[j] += T[k].v[j];
    LAS float* sl = (LAS float*)F.lds + 3 * PSET_FLOATS;
    if (F.wave > 0) {
#pragma unroll
        for (int j = 0; j < 8; ++j) *(LAS f32x4*)(sl + (F.wave - 1) * DM + j * 256 + F.lane * 4) = O.v[j]; }
    __syncthreads();
    if (F.wave == 0) {
#pragma unroll
        for (int w = 0; w < 7; ++w)
#pragma unroll
            for (int j = 0; j < 8; ++j) O.v[j] += *(const LAS f32x4*)(sl + w * DM + j * 256 + F.lane * 4); }
}
template <int L> __device__ __forceinline__ void phase_postmix(Ctx& F) {
    stage_row_params<1, L>(F);
    const int gw = F.vcu * NWAVES + F.wave, NGW = F.G * NWAVES, samp = (F.vcu < 64 && F.wave == 0) ? NPR + F.vcu : NTOK;
    bf16* Hb = WSP(bf16, WS_H); bf16* XR = WSP(bf16, WS_XR); const bf16* OUTb = WSP(bf16, WS_OUT);
    Row Xf; RowB Xb, Ob;
    if (L == 0) { row_load(Xf, x_in_row(F, gw), F.lane); rowb_load(Ob, OUTb + (size_t)gw * DM, F.lane); } else rowb_load(Xb, XR + (size_t)gw * DM, F.lane);
    for (int r = gw; r < NPR; r += NGW) {
        Row X, O, H; const int rn = r + NGW, rp = rn < NPR ? rn : (samp < NTOK ? samp : r), ro = rn < NPR ? rn : r;
        if (L == 0) { X = Xf; rowb_cvt(O, Ob); row_load(Xf, x_in_row(F, rp), F.lane); rowb_load(Ob, OUTb + (size_t)ro * DM, F.lane); }
        else { rowb_cvt(X, Xb); rowb_load(Xb, XR + (size_t)rp * DM, F.lane); row_load_pool(F, O, r, F.lane); }
        const LAS float* ps = row_pset(F, r);
        row_residual_l(X, O, ps, F.lane);
        row_store_bf16(X, XR + (size_t)r * DM, F.lane);
        row_modulate_l(H, X, ps, F.lane);
        row_store_bf16(H, Hb + (size_t)r * DM, F.lane);
    }
    Row Og; if (L == 0 && F.vcu < 64) sample_row_gather<8>(F, Og, F.vcu);
    if (samp < NTOK) { Row X, O, H; if (L == 0) { X = Xf; O = Og; } else { rowb_cvt(X, Xb); row_load_pool(F, O, samp, F.lane); }
        const LAS float* ps = row_pset(F, samp);
        row_residual_l(X, O, ps, F.lane);
        row_store_bf16(X, XR + (size_t)samp * DM, F.lane);
        row_modulate_l(H, X, ps, F.lane);
        row_store_bf16(H, Hb + (size_t)samp * DM, F.lane); }
}
template <int L> __device__ __forceinline__ void phase_postmlp(Ctx& F) {
    stage_row_params<L == 0 ? 2 : 3, L>(F);
    const int gw = F.vcu * NWAVES + F.wave, NGW = F.G * NWAVES, samp = (F.vcu < 64 && F.wave == 0) ? NPR + F.vcu : NTOK;
    bf16* XR = WSP(bf16, WS_XR); const bf16* OUTb = WSP(bf16, WS_OUT);
    RowB Xb, Ob; rowb_load(Xb, XR + (size_t)gw * DM, F.lane); rowb_load(Ob, OUTb + (size_t)gw * DM, F.lane);
    for (int r = gw; r < NPR; r += NGW) {
        Row X, O; const int rn = r + NGW, rp = rn < NPR ? rn : (samp < NTOK ? samp : r), ro = rn < NPR ? rn : r;
        rowb_cvt(X, Xb); rowb_cvt(O, Ob); rowb_load(Xb, XR + (size_t)rp * DM, F.lane); rowb_load(Ob, OUTb + (size_t)ro * DM, F.lane);
        const LAS float* ps = row_pset(F, r);
        row_residual_l(X, O, ps, F.lane);
        if (L == 0) {
            row_store_bf16(X, XR + (size_t)r * DM, F.lane);
            Row H; row_modulate_l(H, X, ps, F.lane);
            row_store_bf16(H, WSP(bf16, WS_H) + (size_t)r * DM, F.lane);
            const int t = r & (SEQ - 1); if (t >= SEQ - PBUF) row_store_f32(H, F.outp() + O_PLP + ((size_t)(r >> 12) * PBUF + (t - (SEQ - PBUF))) * DM, F.lane);
        } else row_store_f32_nt(X, F.outp() + O_YP + (size_t)r * DM, F.lane);
    }
    Row Og; if (F.vcu < 64) sample_row_gather<32>(F, Og, F.vcu);
    if (samp < NTOK) { Row X, O = Og; rowb_cvt(X, Xb);
        const LAS float* ps = row_pset(F, samp); const int rs = samp - NPR;
        row_residual_l(X, O, ps, F.lane);
        if (L == 0) {
            row_store_bf16(X, XR + (size_t)samp * DM, F.lane);
            Row H; row_modulate_l(H, X, ps, F.lane);
            row_store_bf16(H, WSP(bf16, WS_H) + (size_t)samp * DM, F.lane);
            row_store_f32(H, F.outp() + O_PLS + ((size_t)(rs >> 3) * PBUF + 7 + (rs & 7)) * DM, F.lane);
        } else row_store_f32_nt(X, F.outp() + O_YS + (size_t)rs * DM, F.lane); }
    if (L == 0) {
        const float* SP = F.in(I_SPOOL); bf16* Hb = WSP(bf16, WS_H);
        for (int i = F.vcu * NTHR + F.tid; i < DBAT * PBUF * 512; i += F.G * NTHR) { const int c4 = (i & 511) * 4, bi = i >> 9, b = bi / PBUF, k = bi - b * PBUF;
            const f32x4 v = *(const GAS f32x4*)(SP + (size_t)bi * DM + c4); u32x2 w; w.x = cvt_pk_bf16(v.x, v.y); w.y = cvt_pk_bf16(v.z, v.w);
            *(GAS u32x2*)(Hb + (size_t)(NTOK + bi) * DM + c4) = w;
            if (k >= 8) *(GAS f32x4*)(F.outp() + O_PLS + ((size_t)b * PBUF + (k - 8)) * DM + c4) = v; }
    }
}

__device__ __forceinline__ void phase_kv_prep(Ctx& F) {
    { const float* PM = WSP(float, WS_G); float* MOD = WSP(float, WS_MOD);
      for (int i = F.vcu * NTHR + F.tid; i < 2 * NMR * 12288 / 4; i += F.G * NTHR) { const int row = i / 3072, c4 = (i - row * 3072) * 4, l = row / NMR;
          f32x4 sm = *(const GAS f32x4*)(F.in(I_BADA) + (size_t)l * 12288 + c4);
#pragma unroll
          for (int ke = 0; ke < 8; ++ke) sm += *(const GAS f32x4*)(PM + ((size_t)ke * 2 * NMR + row) * 12288 + c4);
          *(GAS f32x4*)(MOD + (size_t)row * 12288 + c4) = sm; } }
    const float* P = WSP(float, WS_P);
    for (int i = F.vcu * NTHR + F.tid; i < (NBATCH + DBAT) * BCOLS; i += F.G * NTHR) {
        const int b = i / BCOLS, c = i - b * BCOLS; const int r = b < NBATCH ? b * SEQ + SEQ - 1 : NPR + (b - NBATCH) * DSEQ + DSEQ - 1;
        F.outp()[(b < NBATCH ? O_SHP + (size_t)b * BCOLS : O_SHS + (size_t)(b - NBATCH) * BCOLS) + c] = (b < NBATCH && c < 3072) ? ldbf(WSP(bf16, WS_PBH) + (size_t)r * 3072 + c) : P[(size_t)r * PBLD + c];
    }
    { const int gw = F.vcu * NWAVES + F.wave, NGW = F.G * NWAVES; const float* mu = F.in(I_MU); bf16* LA = WSP(bf16, WS_LA);
      for (int r = gw; r < NTOK; r += NGW) {
        const float* pb = P + (size_t)r * PBLD; const float* prev; bool hp;
        if (r < NPR) { const int t = r & (SEQ - 1); hp = t > 0; prev = pb - PBLD; }
        else { const int rs = r - NPR, b = rs >> 3, t = rs & 7; hp = true; prev = t > 0 ? pb - PBLD : F.in(I_SSH) + (size_t)b * BCOLS; }
        float v[8];
        { const int c0 = 3072 + F.lane * 8; const bool act = F.lane < 56; const f32x4 z4 = {0.f, 0.f, 0.f, 0.f};
          f32x4 pa = z4, pc = z4, qa = z4, qc = z4, ma = z4, mc = z4;
          if (act) { pa = *(const GAS f32x4*)(pb + c0); pc = *(const GAS f32x4*)(pb + c0 + 4); ma = *(const GAS f32x4*)(mu + c0); mc = *(const GAS f32x4*)(mu + c0 + 4);
                     if (hp) { qa = *(const GAS f32x4*)(prev + c0); qc = *(const GAS f32x4*)(prev + c0 + 4); } }
          const f32x4 za = pa + ma * (qa - pa), zc = pc + mc * (qc - pc);
          const float kz = F.lane < 12 ? 2.f : 1.f;
#pragma unroll
          for (int j = 0; j < 8; ++j) { const float z = j < 4 ? za[j & 3] : zc[j & 3]; const float sg = 1.f / (1.f + __expf(-kz * z));
              v[j] = !act ? 0.f : (F.lane < 12 ? 2.f * sg - 1.f : (F.lane < 24 ? z : sg)); } }
        u32x4 o; o.x = cvt_pk_bf16(v[0], v[1]); o.y = cvt_pk_bf16(v[2], v[3]); o.z = cvt_pk_bf16(v[4], v[5]); o.w = cvt_pk_bf16(v[6], v[7]);
        *(GAS u32x4*)(LA + (size_t)r * 512 + F.lane * 8) = o;
      } }
}
__device__ __forceinline__ void phase_rwkv_prep(Ctx& F) {
    const float* P = WSP(float, WS_P); const float* LWO = WSP(float, WS_LWO);
    const int gw = F.vcu * NWAVES + F.wave, NGW = F.G * NWAVES;
    float* RWV = WSP(float, WS_RWV); float* SCL = WSP(float, WS_SCL);
    const float* mu = F.in(I_MU);
    for (int u = gw; u < NSM * 4; u += NGW) {
        const int r = NPR + (u >> 2), hq = u & 3;
        const float* pb = P + (size_t)r * PBLD; const float* prev; const bool hp = true;
        { const int rs = r - NPR, b = rs >> 3, t = rs & 7; prev = t > 0 ? pb - PBLD : F.in(I_SSH) + (size_t)b * BCOLS; }
        const float* lw = LWO + (size_t)r * 3072;
        float pr[4], pk[4], pv[4], qr_[4], qk[4], qv[4], lwl[4], lal[4], lgl[4];
#pragma unroll
        for (int i = 0; i < 4; ++i) { const int col = (hq * 4 + i) * 64 + F.lane;
            pr[i] = pb[col]; pk[i] = pb[1024 + col]; pv[i] = pb[2048 + col];
            qr_[i] = hp ? prev[col] : 0.f; qk[i] = hp ? prev[1024 + col] : 0.f; qv[i] = hp ? prev[2048 + col] : 0.f;
            lwl[i] = lw[col]; lal[i] = lw[1024 + col]; lgl[i] = lw[2048 + col]; }
#pragma unroll
        for (int i = 0; i < 4; ++i) { const int h = hq * 4 + i, col = h * 64 + F.lane;
            const float zr = pr[i] + mu[col] * (qr_[i] - pr[i]), zk = pk[i] + mu[1024 + col] * (qk[i] - pk[i]), zv = pv[i] + mu[2048 + col] * (qv[i] - pv[i]);
            const float wl = F.in(I_W0)[col] + lwl[i], al = F.in(I_A0)[col] + lal[i], gl = lgl[i];
            const float wlog = -softplusf_(-wl) - 0.5f, decay = __expf(-__expf(wlog));
            const float a = sigmoidf_(al);
            const float kkr = zk * F.in(I_KK)[col], kk = kkr * rsqrtf(wave_sum(kkr * kkr) + 1e-12f);
            const float k = zk * (1.f + (a - 1.f) * F.in(I_KA)[col]);
            const float bb = kk * a;
            const float bonus = wave_sum(zr * k * F.in(I_RK)[col]), beta = wave_sum(bb * zr), kappa = wave_sum(k * zr);
            float* base = RWV + ((size_t)r * HB + h) * 512;
            base[F.lane] = decay; base[64 + F.lane] = kk; base[128 + F.lane] = bb; base[192 + F.lane] = k; base[256 + F.lane] = zr; base[320 + F.lane] = zv; base[384 + F.lane] = decay * zr;
            if (F.lane == 0) { float* s_ = SCL + ((size_t)r * HB + h) * 4; s_[0] = beta; s_[1] = kappa; s_[2] = bonus; s_[3] = 0.f; }
        }
    }
}

namespace sba {
typedef short bf16x8 __attribute__((ext_vector_type(8)));
typedef short s16x4 __attribute__((ext_vector_type(4)));
typedef float f32x16 __attribute__((ext_vector_type(16)));
constexpr int SHM = 16384, LDQ = 1024;
#define SB_KSWZ(row, colB) ((row) * 256 + ((colB) ^ (((row) & 7) << 4)))
#define SB_SBAR() __builtin_amdgcn_sched_barrier(0)
__device__ __forceinline__ int v_st(int k, int c) { const int kk = (k & ~0xC) | ((k & 4) << 1) | ((k & 8) >> 1); return ((kk >> 3) * 4 + (c >> 5)) * 512 + ((kk & 7) * 32 + (c & 31)) * 2; }
__device__ __forceinline__ int v_rd_base(int lane) { return ((lane & 3) << 3) | (((lane >> 2) & 3) << 6) | (((lane >> 4) & 1) << 5) | (((lane >> 5) & 1) << 8); }
__device__ __forceinline__ int crow(int r, int hi) { return (r & 3) + 8 * (r >> 2) + 4 * hi; }
__device__ __forceinline__ void qkt(f32x16& p0, f32x16& p1, const char* Kt, int r32, int hi, const bf16x8* qr) {
    p0 = f32x16{}; p1 = f32x16{};
    const char* kb[4];
#pragma unroll
    for (int dd = 0; dd < 4; ++dd) kb[dd] = Kt + SB_KSWZ(r32, (dd * 16 + hi * 8) * 2);
#pragma unroll
    for (int d0 = 0; d0 < 8; ++d0) { const char* a = kb[d0 & 3] + (d0 >> 2) * 128;
        const bf16x8 b0 = *reinterpret_cast<const bf16x8*>(a);
        const bf16x8 b1 = *reinterpret_cast<const bf16x8*>(a + 32 * 256);
        p0 = __builtin_amdgcn_mfma_f32_32x32x16_bf16(b0, qr[d0], p0, 0, 0, 0);
        p1 = __builtin_amdgcn_mfma_f32_32x32x16_bf16(b1, qr[d0], p1, 0, 0, 0); }
}
__device__ __forceinline__ void pv_tile(f32x16* o, int vb0, bf16x8 pa0, bf16x8 pa1, bf16x8 pa2, bf16x8 pa3) {
#define SB_TRRD(dst, off) asm volatile("ds_read_b64_tr_b16 %0, %1 offset:%2" : "=&v"(dst) : "v"(vb0), "i"(off) : "memory")
#define SB_PV_D0(d0) do { s16x4 l0, l1, l2, l3, h0, h1, h2, h3; constexpr int b_ = (d0) * 512; \
        SB_TRRD(l0, b_); SB_TRRD(h0, b_ + 2048); SB_TRRD(l1, b_ + 4096); SB_TRRD(h1, b_ + 6144); SB_TRRD(l2, b_ + 8192); SB_TRRD(h2, b_ + 10240); SB_TRRD(l3, b_ + 12288); SB_TRRD(h3, b_ + 14336); \
        asm volatile("s_waitcnt lgkmcnt(0)" ::: "memory"); SB_SBAR(); \
        o[d0] = __builtin_amdgcn_mfma_f32_32x32x16_bf16(pa0, (bf16x8){l0[0], l0[1], l0[2], l0[3], h0[0], h0[1], h0[2], h0[3]}, o[d0], 0, 0, 0); \
        o[d0] = __builtin_amdgcn_mfma_f32_32x32x16_bf16(pa1, (bf16x8){l1[0], l1[1], l1[2], l1[3], h1[0], h1[1], h1[2], h1[3]}, o[d0], 0, 0, 0); \
        o[d0] = __builtin_amdgcn_mfma_f32_32x32x16_bf16(pa2, (bf16x8){l2[0], l2[1], l2[2], l2[3], h2[0], h2[1], h2[2], h2[3]}, o[d0], 0, 0, 0); \
        o[d0] = __builtin_amdgcn_mfma_f32_32x32x16_bf16(pa3, (bf16x8){l3[0], l3[1], l3[2], l3[3], h3[0], h3[1], h3[2], h3[3]}, o[d0], 0, 0, 0); } while (0)
    SB_PV_D0(0); SB_PV_D0(1); SB_PV_D0(2); SB_PV_D0(3);
#undef SB_PV_D0
#undef SB_TRRD
}
__device__ __forceinline__ float swap_other(float x, int hi) {
    auto rr = __builtin_amdgcn_permlane32_swap(__float_as_uint(x), __float_as_uint(x), false, false);
    return __uint_as_float(hi ? rr[0] : rr[1]);
}
template <bool MASK> __device__ __forceinline__ void sb_weights(f32x16& p0, f32x16& p1, float& carry, float C2, float b2, int dq, int hi) {
    float T[8];
#pragma unroll
    for (int g = 0; g < 8; ++g) {
        float iv[4], be[4];
#pragma unroll
        for (int k = 0; k < 4; ++k) { const int r = (g & 3) * 4 + k; const float s = g < 4 ? p0[r] : p1[r];
            const float z2 = fminf(fmaf(s, C2, b2), 64.f), e = __builtin_amdgcn_exp2f(z2), i_ = __builtin_amdgcn_rcpf(1.f + e); float b_ = e * i_, ii = i_;
            if (MASK) { const int c = (r & 3) + 8 * (r >> 2) + (g < 4 ? 0 : 32); const bool vis = c < dq; ii = vis ? ii : 1.f; b_ = vis ? b_ : 0.f; }
            iv[k] = ii; be[k] = b_; }
        const float ex2 = iv[3], ex1 = iv[2] * iv[3], ex0 = iv[1] * ex1; T[g] = iv[0] * ex0;
        const float w0 = be[0] * ex0, w1 = be[1] * ex1, w2 = be[2] * ex2, w3 = be[3];
        if (g < 4) { p0[(g & 3) * 4 + 0] = w0; p0[(g & 3) * 4 + 1] = w1; p0[(g & 3) * 4 + 2] = w2; p0[(g & 3) * 4 + 3] = w3; }
        else { p1[(g & 3) * 4 + 0] = w0; p1[(g & 3) * 4 + 1] = w1; p1[(g & 3) * 4 + 2] = w2; p1[(g & 3) * 4 + 3] = w3; }
    }
    float suf = carry;
#pragma unroll
    for (int g = 7; g >= 0; --g) {
        const float To = swap_other(T[g], hi);
        const float E = hi ? suf : suf * To;
#pragma unroll
        for (int k = 0; k < 4; ++k) { if (g < 4) p0[(g & 3) * 4 + k] *= E; else p1[(g & 3) * 4 + k] *= E; }
        suf = suf * (T[g] * To);
    }
    carry = suf;
}
__device__ __forceinline__ void pack_p(const f32x16& p0, const f32x16& p1, bf16x8& pa0, bf16x8& pa1, bf16x8& pa2, bf16x8& pa3) {
#define SB_PK4(P, B_, OUT) do { unsigned a0 = cvt_pk_bf16(P[B_ + 0], P[B_ + 1]), a1 = cvt_pk_bf16(P[B_ + 2], P[B_ + 3]); \
        unsigned b0 = cvt_pk_bf16(P[B_ + 4], P[B_ + 5]), b1 = cvt_pk_bf16(P[B_ + 6], P[B_ + 7]); \
        auto r0 = __builtin_amdgcn_permlane32_swap(a0, b0, false, false); auto r1 = __builtin_amdgcn_permlane32_swap(a1, b1, false, false); \
        u32x4 w = {r0[0], r1[0], r0[1], r1[1]}; OUT = *reinterpret_cast<bf16x8*>(&w); } while (0)
    SB_PK4(p0, 0, pa0); SB_PK4(p0, 8, pa1); SB_PK4(p1, 0, pa2); SB_PK4(p1, 8, pa3);
#undef SB_PK4
}
__device__ __forceinline__ void attn_half(Ctx& F, int bh, int x, int half) {
    const int tid = F.tid, wid = F.wave, lane = F.lane, r32 = lane & 31, hi = lane >> 5, b = bh >> 3, h = bh & 7;
    const bf16* Qg = WSP(bf16, WS_QB) + (size_t)(b * SEQ + 256 * x) * LDQ + h * 128;
    const bf16* Kg = WSP(bf16, WS_KB) + (size_t)(b * SEQ) * LDQ + h * 128; const bf16* Vg = WSP(bf16, WS_VB) + (size_t)(b * SEQ) * LDQ + h * 128;
    const int NT = 4 * (x + 1), t_hi = half == 0 ? NT : NT / 2, t_lo = half == 0 ? NT / 2 : 0;
    const int qlo = 256 * x + 32 * wid, qpos = qlo + r32;
    char* V_lds = (char*)F.lds; char* K_lds = (char*)F.lds + 2 * SHM;
    bf16x8 qr[8];
#pragma unroll
    for (int d0 = 0; d0 < 8; ++d0) qr[d0] = *reinterpret_cast<const bf16x8*>(Qg + (size_t)(wid * 32 + r32) * LDQ + d0 * 16 + hi * 8);
    const int sr = tid >> 4, sc = (tid & 15) * 8, vst0 = v_st(sr, sc), vst1 = v_st(32 + sr, sc), kws = SB_KSWZ(sr, sc * 2);
    const int vb0 = (int)(uintptr_t)V_lds + v_rd_base(lane);
    bf16x8 st_k0, st_k1, st_v0, st_v1;
    const unsigned so0 = (unsigned)(sr * LDQ + sc) * 2u, so1 = so0 + 32u * LDQ * 2u;
#define SB_SLOAD(t) do { const char* kt_ = (const char*)Kg + (size_t)(t) * (64 * LDQ * 2); const char* vt_ = (const char*)Vg + (size_t)(t) * (64 * LDQ * 2); \
        st_k0 = *reinterpret_cast<const bf16x8*>(kt_ + so0); st_k1 = *reinterpret_cast<const bf16x8*>(kt_ + so1); st_v0 = *reinterpret_cast<const bf16x8*>(vt_ + so0); st_v1 = *reinterpret_cast<const bf16x8*>(vt_ + so1); } while (0)
#define SB_SWRITE(bf) do { *(bf16x8*)(K_lds + (bf) * SHM + kws) = st_k0; *(bf16x8*)(K_lds + (bf) * SHM + kws + 32 * 256) = st_k1; \
        *(bf16x8*)(V_lds + (bf) * SHM + vst0) = st_v0; *(bf16x8*)(V_lds + (bf) * SHM + vst1) = st_v1; } while (0)
    __syncthreads();
    SB_SLOAD(t_hi - 1); VM_WAIT(); SB_SWRITE(0);
    __syncthreads();
    const float C2 = QK_SCALE * 1.4426950408889634f, b2 = F.in(I_SBB)[h] * 1.4426950408889634f;
    float carry = 1.f; f32x16 o[4] = {};
    int buf = 0;
    for (int t = t_hi - 1; t >= t_lo; --t) {
        if (t > t_lo) SB_SLOAD(t - 1);
        const int kb = 64 * t;
        if (kb < qlo + 31) {
            f32x16 p0, p1; bf16x8 pa0, pa1, pa2, pa3;
            qkt(p0, p1, K_lds + buf * SHM, r32, hi, qr);
            if (kb + 63 >= qlo) sb_weights<true>(p0, p1, carry, C2, b2, qpos - kb - 4 * hi, hi); else sb_weights<false>(p0, p1, carry, C2, b2, 0, hi);
            pack_p(p0, p1, pa0, pa1, pa2, pa3);
            pv_tile(o, vb0 + buf * SHM, pa0, pa1, pa2, pa3);
        }
        if (t > t_lo) { VM_WAIT(); SB_SWRITE(buf ^ 1); }
        __syncthreads();
        buf ^= 1;
    }
#undef SB_SLOAD
#undef SB_SWRITE
    float* Op = WSP(float, WS_OP) + ((size_t)half * NPR + b * SEQ + 256 * x + wid * 32) * 1024 + h * 128;
    const unsigned lo_ = (unsigned)(4 * hi * 1024 + r32);
#pragma unroll
    for (int r = 0; r < 16; ++r) { float* Opr = Op + (size_t)((r & 3) + 8 * (r >> 2)) * 1024;
#pragma unroll
        for (int d0 = 0; d0 < 4; ++d0) Opr[lo_ + d0 * 32] = o[d0][r]; }
    if (half == 0 && hi == 0) WSP(float, WS_CL)[(size_t)(b * SEQ + qpos) * HA + h] = carry;
}
#undef SB_KSWZ
#undef SB_SBAR
}
namespace sba {
__device__ __forceinline__ void sb_weights32(f32x16& p0, float& carry, float C2, float b2, int hi) {
    float T[4];
#pragma unroll
    for (int g = 0; g < 4; ++g) {
        float iv[4], be[4];
#pragma unroll
        for (int k = 0; k < 4; ++k) { const float z2 = fminf(fmaf(p0[g * 4 + k], C2, b2), 64.f), e = __builtin_amdgcn_exp2f(z2), i_ = __builtin_amdgcn_rcpf(1.f + e); iv[k] = i_; be[k] = e * i_; }
        const float ex2 = iv[3], ex1 = iv[2] * iv[3], ex0 = iv[1] * ex1; T[g] = iv[0] * ex0;
        p0[g * 4 + 0] = be[0] * ex0; p0[g * 4 + 1] = be[1] * ex1; p0[g * 4 + 2] = be[2] * ex2; p0[g * 4 + 3] = be[3];
    }
    float suf = carry;
#pragma unroll
    for (int g = 3; g >= 0; --g) { const float To = swap_other(T[g], hi); const float E = hi ? suf : suf * To;
#pragma unroll
        for (int k = 0; k < 4; ++k) p0[g * 4 + k] *= E;
        suf = suf * (T[g] * To); }
    carry = suf;
}
__device__ __forceinline__ void attn_sample_unit(Ctx& F, int bh, int pg, char* wl  ) {
    const int lane = F.lane, r32 = lane & 31, hi = lane >> 5, b = bh >> 3, h = bh & 7;
    char* K_lds = wl; char* V_lds = wl + 8192;
    bf16x8 qr[8];
    { const bf16* Qg = WSP(bf16, WS_QB) + (size_t)(NPR + b * DSEQ + (r32 & 7)) * LDQ + h * 128;
#pragma unroll
      for (int d0 = 0; d0 < 8; ++d0) { bf16x8 v = *reinterpret_cast<const bf16x8*>(Qg + d0 * 16 + hi * 8); if (r32 >= 8) v = bf16x8{}; qr[d0] = v; } }
    const int kl = lane >> 5, c4 = (lane & 31) * 4;
    const unsigned goff = (unsigned)(kl * 1024 + c4) * 4u;
    const int vb0 = (int)(uintptr_t)V_lds + v_rd_base(lane);
    const float C2 = QK_SCALE * 1.4426950408889634f, b2 = F.in(I_SBB)[h] * 1.4426950408889634f;
    const int* pt = ((const int*)F.in(I_PT)) + b * NPAGES + pg * 4;
    f32x4 sa[8], sb[8];
#define SU_BASE(n) ({ const int i_ = (n) >> 2, k_ = (n) & 3, tt_ = 15 - i_; const int phys_ = pt[tt_ >> 2]; \
        (const char*)((k_ & 2) ? F.in(I_CV) : F.in(I_CK)) + (((size_t)phys_ * PAGESZ + (tt_ & 3) * 32 + (k_ & 1) * 16) * 1024 + h * 128) * 4; })
#define SU_LOAD(S, n) do { const char* bp_ = SU_BASE(n); _Pragma("unroll") for (int j = 0; j < 8; ++j) S[j] = __builtin_nontemporal_load((const GAS f32x4*)(bp_ + goff + (size_t)j * 8192)); } while (0)
#define SU_WRK(S, kh) do { _Pragma("unroll") for (int j = 0; j < 8; ++j) { const int key = (kh) * 16 + 2 * j + kl; u32x2 w; w.x = cvt_pk_bf16(S[j].x, S[j].y); w.y = cvt_pk_bf16(S[j].z, S[j].w); \
        *(u32x2*)(K_lds + (key * 256 + ((c4 * 2) ^ ((key & 7) << 4)))) = w; } } while (0)
#define SU_WRV(S, kh) do { _Pragma("unroll") for (int j = 0; j < 8; ++j) { const int key = (kh) * 16 + 2 * j + kl; u32x2 w; w.x = cvt_pk_bf16(S[j].x, S[j].y); w.y = cvt_pk_bf16(S[j].z, S[j].w); \
        *(u32x2*)(V_lds + v_st(key, c4)) = w; } } while (0)
    SU_LOAD(sa, 0); SU_LOAD(sb, 1);
    float carry = 1.f; f32x16 o[4] = {};
    for (int i = 0; i < 16; ++i) {
        asm volatile("s_waitcnt vmcnt(8)" ::: "memory"); SU_WRK(sa, 0); SU_LOAD(sa, 4 * i + 2);
        asm volatile("s_waitcnt vmcnt(8)" ::: "memory"); SU_WRK(sb, 1); SU_LOAD(sb, 4 * i + 3);
        asm volatile("s_waitcnt vmcnt(8)" ::: "memory"); SU_WRV(sa, 0); if (i < 15) SU_LOAD(sa, 4 * i + 4);
        if (i < 15) asm volatile("s_waitcnt vmcnt(8)" ::: "memory"); else asm volatile("s_waitcnt vmcnt(0)" ::: "memory");
        SU_WRV(sb, 1); if (i < 15) SU_LOAD(sb, 4 * i + 5);
        asm volatile("s_waitcnt lgkmcnt(0)" ::: "memory");
        f32x16 p0 = f32x16{};
        { const char* kb[4];
#pragma unroll
          for (int dd = 0; dd < 4; ++dd) kb[dd] = K_lds + (r32 * 256 + (((dd * 16 + hi * 8) * 2) ^ ((r32 & 7) << 4)));
#pragma unroll
          for (int d0 = 0; d0 < 8; ++d0) { const bf16x8 b0 = *reinterpret_cast<const bf16x8*>(kb[d0 & 3] + (d0 >> 2) * 128); p0 = __builtin_amdgcn_mfma_f32_32x32x16_bf16(b0, qr[d0], p0, 0, 0, 0); } }
        sb_weights32(p0, carry, C2, b2, hi);
        bf16x8 pa0, pa1;
        { unsigned a0 = cvt_pk_bf16(p0[0], p0[1]), a1 = cvt_pk_bf16(p0[2], p0[3]), b0 = cvt_pk_bf16(p0[4], p0[5]), b1 = cvt_pk_bf16(p0[6], p0[7]);
          auto r0 = __builtin_amdgcn_permlane32_swap(a0, b0, false, false); auto r1 = __builtin_amdgcn_permlane32_swap(a1, b1, false, false);
          u32x4 w = {r0[0], r1[0], r0[1], r1[1]}; pa0 = *reinterpret_cast<bf16x8*>(&w); }
        { unsigned a0 = cvt_pk_bf16(p0[8], p0[9]), a1 = cvt_pk_bf16(p0[10], p0[11]), b0 = cvt_pk_bf16(p0[12], p0[13]), b1 = cvt_pk_bf16(p0[14], p0[15]);
          auto r0 = __builtin_amdgcn_permlane32_swap(a0, b0, false, false); auto r1 = __builtin_amdgcn_permlane32_swap(a1, b1, false, false);
          u32x4 w = {r0[0], r1[0], r0[1], r1[1]}; pa1 = *reinterpret_cast<bf16x8*>(&w); }
#define SU_TRRD(dst, off) asm volatile("ds_read_b64_tr_b16 %0, %1 offset:%2" : "=&v"(dst) : "v"(vb0), "i"(off) : "memory")
#define SU_PV(d0) do { s16x4 l0, l1, h0, h1; constexpr int b_ = (d0) * 512; SU_TRRD(l0, b_); SU_TRRD(h0, b_ + 2048); SU_TRRD(l1, b_ + 4096); SU_TRRD(h1, b_ + 6144); \
        asm volatile("s_waitcnt lgkmcnt(0)" ::: "memory"); __builtin_amdgcn_sched_barrier(0); \
        o[d0] = __builtin_amdgcn_mfma_f32_32x32x16_bf16(pa0, (bf16x8){l0[0], l0[1], l0[2], l0[3], h0[0], h0[1], h0[2], h0[3]}, o[d0], 0, 0, 0); \
        o[d0] = __builtin_amdgcn_mfma_f32_32x32x16_bf16(pa1, (bf16x8){l1[0], l1[1], l1[2], l1[3], h1[0], h1[1], h1[2], h1[3]}, o[d0], 0, 0, 0); } while (0)
        SU_PV(0); SU_PV(1); SU_PV(2); SU_PV(3);
        asm volatile("s_waitcnt lgkmcnt(0)" ::: "memory");
    }
#undef SU_PV
#undef SU_TRRD
#undef SU_WRV
#undef SU_WRK
#undef SU_LOAD
#undef SU_BASE
    float* Sp = WSP(float, WS_SPART) + ((size_t)(bh * 32 + pg) * 8) * 128;
#pragma unroll
    for (int r = 0; r < 4; ++r)
#pragma unroll
        for (int d0 = 0; d0 < 4; ++d0) Sp[(size_t)(r + 4 * hi) * 128 + d0 * 32 + r32] = o[d0][r];
    if (hi == 0 && r32 < 8) WSP(float, WS_SCAR)[(size_t)(bh * 32 + pg) * 8 + r32] = carry;
}
}
__device__ __forceinline__ void sample_combine(Ctx& F) {
    const int gw = F.vcu * NWAVES + F.wave, NGW = F.G * NWAVES; bf16* OAB = WSP(bf16, WS_OAB);
    const float* SPt = WSP(float, WS_SPART); const float* SCr = WSP(float, WS_SCAR);
    for (int task = gw; task < DBAT * HA * DSEQ; task += NGW) { const int bh = task >> 3, i = task & 7, b = bh >> 3, h = bh & 7; const float bias = F.in(I_SBB)[h];
        f32x2 po[32]; float sc[32];
#pragma unroll
        for (int pg = 0; pg < 32; ++pg) { po[pg] = *(const GAS f32x2*)(SPt + ((size_t)(bh * 32 + pg) * 8 + i) * 128 + 2 * F.lane); sc[pg] = SCr[(size_t)(bh * 32 + pg) * 8 + i]; }
        f32x2 q; { const unsigned qw = *(const GAS unsigned*)(WSP(bf16, WS_QB) + (size_t)(NPR + b * DSEQ + i) * 1024 + h * 128 + 2 * F.lane); q.x = __uint_as_float(qw << 16); q.y = __uint_as_float(qw & 0xffff0000u); }
        float carry = 1.f, a0 = 0.f, a1 = 0.f;
        for (int j = i - 1; j >= 0; --j) { const size_t ko = (size_t)(b * DSEQ + j) * 1024 + h * 128 + 2 * F.lane; const f32x2 k = *(const GAS f32x2*)(F.outp() + O_KS + ko), v = *(const GAS f32x2*)(F.outp() + O_VS + ko);
            const float z = wave_sum(q.x * k.x + q.y * k.y) * QK_SCALE + bias, e = __expf(fminf(z, 40.f)), om = 1.f / (1.f + e), w = e * om * carry;
            a0 += w * v.x; a1 += w * v.y; carry *= om; }
#pragma unroll
        for (int pg = 31; pg >= 0; --pg) { a0 += carry * po[pg].x; a1 += carry * po[pg].y; carry *= sc[pg]; }
        *(GAS unsigned*)(OAB + (size_t)(NPR + b * DSEQ + i) * DM + h * 128 + 2 * F.lane) = cvt_pk_bf16(a0, a1);
    }
}
__device__ __forceinline__ void phase_attn_prompt(Ctx& F) {
    for (int it2 = 2 * F.vcu; it2 < 2 * NBATCH * HA * 16; it2 += (it2 & 1) ? 2 * F.G - 1 : 1) { const int item = it2 >> 1, half = it2 & 1, bh = item >> 4, x = item & 15;
        sba::attn_half(F, bh, half ? 15 - x : x, half); }
    __syncthreads();
}
__device__ __forceinline__ void dots16(float& sig, float& rho, float kkv, float wrv, const float (&s)[16]) {
    asm("s_nop 1\n\t"
        "v_fmac_f32_dpp %0, %2, %4 row_newbcast:0 row_mask:0xf bank_mask:0xf\n\t"
        "v_fmac_f32_dpp %1, %3, %4 row_newbcast:0 row_mask:0xf bank_mask:0xf\n\t"
        "v_fmac_f32_dpp %0, %2, %5 row_newbcast:1 row_mask:0xf bank_mask:0xf\n\t"
        "v_fmac_f32_dpp %1, %3, %5 row_newbcast:1 row_mask:0xf bank_mask:0xf\n\t"
        "v_fmac_f32_dpp %0, %2, %6 row_newbcast:2 row_mask:0xf bank_mask:0xf\n\t"
        "v_fmac_f32_dpp %1, %3, %6 row_newbcast:2 row_mask:0xf bank_mask:0xf\n\t"
        "v_fmac_f32_dpp %0, %2, %7 row_newbcast:3 row_mask:0xf bank_mask:0xf\n\t"
        "v_fmac_f32_dpp %1, %3, %7 row_newbcast:3 row_mask:0xf bank_mask:0xf\n\t"
        "v_fmac_f32_dpp %0, %2, %8 row_newbcast:4 row_mask:0xf bank_mask:0xf\n\t"
        "v_fmac_f32_dpp %1, %3, %8 row_newbcast:4 row_mask:0xf bank_mask:0xf\n\t"
        "v_fmac_f32_dpp %0, %2, %9 row_newbcast:5 row_mask:0xf bank_mask:0xf\n\t"
        "v_fmac_f32_dpp %1, %3, %9 row_newbcast:5 row_mask:0xf bank_mask:0xf\n\t"
        "v_fmac_f32_dpp %0, %2, %10 row_newbcast:6 row_mask:0xf bank_mask:0xf\n\t"
        "v_fmac_f32_dpp %1, %3, %10 row_newbcast:6 row_mask:0xf bank_mask:0xf\n\t"
        "v_fmac_f32_dpp %0, %2, %11 row_newbcast:7 row_mask:0xf bank_mask:0xf\n\t"
        "v_fmac_f32_dpp %1, %3, %11 row_newbcast:7 row_mask:0xf bank_mask:0xf\n\t"
        "v_fmac_f32_dpp %0, %2, %12 row_newbcast:8 row_mask:0xf bank_mask:0xf\n\t"
        "v_fmac_f32_dpp %1, %3, %12 row_newbcast:8 row_mask:0xf bank_mask:0xf\n\t"
        "v_fmac_f32_dpp %0, %2, %13 row_newbcast:9 row_mask:0xf bank_mask:0xf\n\t"
        "v_fmac_f32_dpp %1, %3, %13 row_newbcast:9 row_mask:0xf bank_mask:0xf\n\t"
        "v_fmac_f32_dpp %0, %2, %14 row_newbcast:10 row_mask:0xf bank_mask:0xf\n\t"
        "v_fmac_f32_dpp %1, %3, %14 row_newbcast:10 row_mask:0xf bank_mask:0xf\n\t"
        "v_fmac_f32_dpp %0, %2, %15 row_newbcast:11 row_mask:0xf bank_mask:0xf\n\t"
        "v_fmac_f32_dpp %1, %3, %15 row_newbcast:11 row_mask:0xf bank_mask:0xf\n\t"
        "v_fmac_f32_dpp %0, %2, %16 row_newbcast:12 row_mask:0xf bank_mask:0xf\n\t"
        "v_fmac_f32_dpp %1, %3, %16 row_newbcast:12 row_mask:0xf bank_mask:0xf\n\t"
        "v_fmac_f32_dpp %0, %2, %17 row_newbcast:13 row_mask:0xf bank_mask:0xf\n\t"
        "v_fmac_f32_dpp %1, %3, %17 row_newbcast:13 row_mask:0xf bank_mask:0xf\n\t"
        "v_fmac_f32_dpp %0, %2, %18 row_newbcast:14 row_mask:0xf bank_mask:0xf\n\t"
        "v_fmac_f32_dpp %1, %3, %18 row_newbcast:14 row_mask:0xf bank_mask:0xf\n\t"
        "v_fmac_f32_dpp %0, %2, %19 row_newbcast:15 row_mask:0xf bank_mask:0xf\n\t"
        "v_fmac_f32_dpp %1, %3, %19 row_newbcast:15 row_mask:0xf bank_mask:0xf\n\t"
        "s_nop 1"
        : "+v"(sig), "+v"(rho) : "v"(kkv), "v"(wrv), "v"(s[0]), "v"(s[1]), "v"(s[2]), "v"(s[3]), "v"(s[4]), "v"(s[5]), "v"(s[6]), "v"(s[7]), "v"(s[8]), "v"(s[9]), "v"(s[10]), "v"(s[11]), "v"(s[12]), "v"(s[13]), "v"(s[14]), "v"(s[15]));
}
__device__ __forceinline__ void dot16(float& acc, float zv, const float (&s)[16]) {
    asm("s_nop 1\n\t"
        "v_fmac_f32_dpp %0, %1, %2 row_newbcast:0 row_mask:0xf bank_mask:0xf\n\t"
        "v_fmac_f32_dpp %0, %1, %3 row_newbcast:1 row_mask:0xf bank_mask:0xf\n\t"
        "v_fmac_f32_dpp %0, %1, %4 row_newbcast:2 row_mask:0xf bank_mask:0xf\n\t"
        "v_fmac_f32_dpp %0, %1, %5 row_newbcast:3 row_mask:0xf bank_mask:0xf\n\t"
        "v_fmac_f32_dpp %0, %1, %6 row_newbcast:4 row_mask:0xf bank_mask:0xf\n\t"
        "v_fmac_f32_dpp %0, %1, %7 row_newbcast:5 row_mask:0xf bank_mask:0xf\n\t"
        "v_fmac_f32_dpp %0, %1, %8 row_newbcast:6 row_mask:0xf bank_mask:0xf\n\t"
        "v_fmac_f32_dpp %0, %1, %9 row_newbcast:7 row_mask:0xf bank_mask:0xf\n\t"
        "v_fmac_f32_dpp %0, %1, %10 row_newbcast:8 row_mask:0xf bank_mask:0xf\n\t"
        "v_fmac_f32_dpp %0, %1, %11 row_newbcast:9 row_mask:0xf bank_mask:0xf\n\t"
        "v_fmac_f32_dpp %0, %1, %12 row_newbcast:10 row_mask:0xf bank_mask:0xf\n\t"
        "v_fmac_f32_dpp %0, %1, %13 row_newbcast:11 row_mask:0xf bank_mask:0xf\n\t"
        "v_fmac_f32_dpp %0, %1, %14 row_newbcast:12 row_mask:0xf bank_mask:0xf\n\t"
        "v_fmac_f32_dpp %0, %1, %15 row_newbcast:13 row_mask:0xf bank_mask:0xf\n\t"
        "v_fmac_f32_dpp %0, %1, %16 row_newbcast:14 row_mask:0xf bank_mask:0xf\n\t"
        "v_fmac_f32_dpp %0, %1, %17 row_newbcast:15 row_mask:0xf bank_mask:0xf\n\t"
        "s_nop 1"
        : "+v"(acc) : "v"(zv), "v"(s[0]), "v"(s[1]), "v"(s[2]), "v"(s[3]), "v"(s[4]), "v"(s[5]), "v"(s[6]), "v"(s[7]), "v"(s[8]), "v"(s[9]), "v"(s[10]), "v"(s[11]), "v"(s[12]), "v"(s[13]), "v"(s[14]), "v"(s[15]));
}
__device__ __forceinline__ void upd16_v(float (&s)[16], float wv, float kv, float bv, float vv, float ns) {
    asm("s_nop 1\n\t"
        "v_mul_f32_dpp %0, %16, %0 row_newbcast:0 row_mask:0xf bank_mask:0xf\n\t"
        "v_mul_f32_dpp %1, %16, %1 row_newbcast:1 row_mask:0xf bank_mask:0xf\n\t"
        "v_mul_f32_dpp %2, %16, %2 row_newbcast:2 row_mask:0xf bank_mask:0xf\n\t"
        "v_mul_f32_dpp %3, %16, %3 row_newbcast:3 row_mask:0xf bank_mask:0xf\n\t"
        "v_mul_f32_dpp %4, %16, %4 row_newbcast:4 row_mask:0xf bank_mask:0xf\n\t"
        "v_mul_f32_dpp %5, %16, %5 row_newbcast:5 row_mask:0xf bank_mask:0xf\n\t"
        "v_mul_f32_dpp %6, %16, %6 row_newbcast:6 row_mask:0xf bank_mask:0xf\n\t"
        "v_mul_f32_dpp %7, %16, %7 row_newbcast:7 row_mask:0xf bank_mask:0xf\n\t"
        "v_mul_f32_dpp %8, %16, %8 row_newbcast:8 row_mask:0xf bank_mask:0xf\n\t"
        "v_mul_f32_dpp %9, %16, %9 row_newbcast:9 row_mask:0xf bank_mask:0xf\n\t"
        "v_mul_f32_dpp %10, %16, %10 row_newbcast:10 row_mask:0xf bank_mask:0xf\n\t"
        "v_mul_f32_dpp %11, %16, %11 row_newbcast:11 row_mask:0xf bank_mask:0xf\n\t"
        "v_mul_f32_dpp %12, %16, %12 row_newbcast:12 row_mask:0xf bank_mask:0xf\n\t"
        "v_mul_f32_dpp %13, %16, %13 row_newbcast:13 row_mask:0xf bank_mask:0xf\n\t"
        "v_mul_f32_dpp %14, %16, %14 row_newbcast:14 row_mask:0xf bank_mask:0xf\n\t"
        "v_mul_f32_dpp %15, %16, %15 row_newbcast:15 row_mask:0xf bank_mask:0xf\n\t"
        "v_fmac_f32_dpp %0, %17, %19 row_newbcast:0 row_mask:0xf bank_mask:0xf\n\t"
        "v_fmac_f32_dpp %1, %17, %19 row_newbcast:1 row_mask:0xf bank_mask:0xf\n\t"
        "v_fmac_f32_dpp %2, %17, %19 row_newbcast:2 row_mask:0xf bank_mask:0xf\n\t"
        "v_fmac_f32_dpp %3, %17, %19 row_newbcast:3 row_mask:0xf bank_mask:0xf\n\t"
        "v_fmac_f32_dpp %4, %17, %19 row_newbcast:4 row_mask:0xf bank_mask:0xf\n\t"
        "v_fmac_f32_dpp %5, %17, %19 row_newbcast:5 row_mask:0xf bank_mask:0xf\n\t"
        "v_fmac_f32_dpp %6, %17, %19 row_newbcast:6 row_mask:0xf bank_mask:0xf\n\t"
        "v_fmac_f32_dpp %7, %17, %19 row_newbcast:7 row_mask:0xf bank_mask:0xf\n\t"
        "v_fmac_f32_dpp %8, %17, %19 row_newbcast:8 row_mask:0xf bank_mask:0xf\n\t"
        "v_fmac_f32_dpp %9, %17, %19 row_newbcast:9 row_mask:0xf bank_mask:0xf\n\t"
        "v_fmac_f32_dpp %10, %17, %19 row_newbcast:10 row_mask:0xf bank_mask:0xf\n\t"
        "v_fmac_f32_dpp %11, %17, %19 row_newbcast:11 row_mask:0xf bank_mask:0xf\n\t"
        "v_fmac_f32_dpp %12, %17, %19 row_newbcast:12 row_mask:0xf bank_mask:0xf\n\t"
        "v_fmac_f32_dpp %13, %17, %19 row_newbcast:13 row_mask:0xf bank_mask:0xf\n\t"
        "v_fmac_f32_dpp %14, %17, %19 row_newbcast:14 row_mask:0xf bank_mask:0xf\n\t"
        "v_fmac_f32_dpp %15, %17, %19 row_newbcast:15 row_mask:0xf bank_mask:0xf\n\t"
        "v_fmac_f32_dpp %0, %18, %20 row_newbcast:0 row_mask:0xf bank_mask:0xf\n\t"
        "v_fmac_f32_dpp %1, %18, %20 row_newbcast:1 row_mask:0xf bank_mask:0xf\n\t"
        "v_fmac_f32_dpp %2, %18, %20 row_newbcast:2 row_mask:0xf bank_mask:0xf\n\t"
        "v_fmac_f32_dpp %3, %18, %20 row_newbcast:3 row_mask:0xf bank_mask:0xf\n\t"
        "v_fmac_f32_dpp %4, %18, %20 row_newbcast:4 row_mask:0xf bank_mask:0xf\n\t"
        "v_fmac_f32_dpp %5, %18, %20 row_newbcast:5 row_mask:0xf bank_mask:0xf\n\t"
        "v_fmac_f32_dpp %6, %18, %20 row_newbcast:6 row_mask:0xf bank_mask:0xf\n\t"
        "v_fmac_f32_dpp %7, %18, %20 row_newbcast:7 row_mask:0xf bank_mask:0xf\n\t"
        "v_fmac_f32_dpp %8, %18, %20 row_newbcast:8 row_mask:0xf bank_mask:0xf\n\t"
        "v_fmac_f32_dpp %9, %18, %20 row_newbcast:9 row_mask:0xf bank_mask:0xf\n\t"
        "v_fmac_f32_dpp %10, %18, %20 row_newbcast:10 row_mask:0xf bank_mask:0xf\n\t"
        "v_fmac_f32_dpp %11, %18, %20 row_newbcast:11 row_mask:0xf bank_mask:0xf\n\t"
        "v_fmac_f32_dpp %12, %18, %20 row_newbcast:12 row_mask:0xf bank_mask:0xf\n\t"
        "v_fmac_f32_dpp %13, %18, %20 row_newbcast:13 row_mask:0xf bank_mask:0xf\n\t"
        "v_fmac_f32_dpp %14, %18, %20 row_newbcast:14 row_mask:0xf bank_mask:0xf\n\t"
        "v_fmac_f32_dpp %15, %18, %20 row_newbcast:15 row_mask:0xf bank_mask:0xf\n\t"
        "s_nop 1"
        : "+v"(s[0]), "+v"(s[1]), "+v"(s[2]), "+v"(s[3]), "+v"(s[4]), "+v"(s[5]), "+v"(s[6]), "+v"(s[7]), "+v"(s[8]), "+v"(s[9]), "+v"(s[10]), "+v"(s[11]), "+v"(s[12]), "+v"(s[13]), "+v"(s[14]), "+v"(s[15]) : "v"(wv), "v"(kv), "v"(bv), "v"(vv), "v"(ns));
}
__device__ __forceinline__ void upd16_nov(float (&s)[16], float wv, float kv, float bv, float vv, float ns) {
    asm("s_nop 1\n\t"
        "v_mul_f32_dpp %0, %16, %0 row_newbcast:0 row_mask:0xf bank_mask:0xf\n\t"
        "v_mul_f32_dpp %1, %16, %1 row_newbcast:1 row_mask:0xf bank_mask:0xf\n\t"
        "v_mul_f32_dpp %2, %16, %2 row_newbcast:2 row_mask:0xf bank_mask:0xf\n\t"
        "v_mul_f32_dpp %3, %16, %3 row_newbcast:3 row_mask:0xf bank_mask:0xf\n\t"
        "v_mul_f32_dpp %4, %16, %4 row_newbcast:4 row_mask:0xf bank_mask:0xf\n\t"
        "v_mul_f32_dpp %5, %16, %5 row_newbcast:5 row_mask:0xf bank_mask:0xf\n\t"
        "v_mul_f32_dpp %6, %16, %6 row_newbcast:6 row_mask:0xf bank_mask:0xf\n\t"
        "v_mul_f32_dpp %7, %16, %7 row_newbcast:7 row_mask:0xf bank_mask:0xf\n\t"
        "v_mul_f32_dpp %8, %16, %8 row_newbcast:8 row_mask:0xf bank_mask:0xf\n\t"
        "v_mul_f32_dpp %9, %16, %9 row_newbcast:9 row_mask:0xf bank_mask:0xf\n\t"
        "v_mul_f32_dpp %10, %16, %10 row_newbcast:10 row_mask:0xf bank_mask:0xf\n\t"
        "v_mul_f32_dpp %11, %16, %11 row_newbcast:11 row_mask:0xf bank_mask:0xf\n\t"
        "v_mul_f32_dpp %12, %16, %12 row_newbcast:12 row_mask:0xf bank_mask:0xf\n\t"
        "v_mul_f32_dpp %13, %16, %13 row_newbcast:13 row_mask:0xf bank_mask:0xf\n\t"
        "v_mul_f32_dpp %14, %16, %14 row_newbcast:14 row_mask:0xf bank_mask:0xf\n\t"
        "v_mul_f32_dpp %15, %16, %15 row_newbcast:15 row_mask:0xf bank_mask:0xf\n\t"
        "v_fmac_f32_dpp %0, %18, %20 row_newbcast:0 row_mask:0xf bank_mask:0xf\n\t"
        "v_fmac_f32_dpp %1, %18, %20 row_newbcast:1 row_mask:0xf bank_mask:0xf\n\t"
        "v_fmac_f32_dpp %2, %18, %20 row_newbcast:2 row_mask:0xf bank_mask:0xf\n\t"
        "v_fmac_f32_dpp %3, %18, %20 row_newbcast:3 row_mask:0xf bank_mask:0xf\n\t"
        "v_fmac_f32_dpp %4, %18, %20 row_newbcast:4 row_mask:0xf bank_mask:0xf\n\t"
        "v_fmac_f32_dpp %5, %18, %20 row_newbcast:5 row_mask:0xf bank_mask:0xf\n\t"
        "v_fmac_f32_dpp %6, %18, %20 row_newbcast:6 row_mask:0xf bank_mask:0xf\n\t"
        "v_fmac_f32_dpp %7, %18, %20 row_newbcast:7 row_mask:0xf bank_mask:0xf\n\t"
        "v_fmac_f32_dpp %8, %18, %20 row_newbcast:8 row_mask:0xf bank_mask:0xf\n\t"
        "v_fmac_f32_dpp %9, %18, %20 row_newbcast:9 row_mask:0xf bank_mask:0xf\n\t"
        "v_fmac_f32_dpp %10, %18, %20 row_newbcast:10 row_mask:0xf bank_mask:0xf\n\t"
        "v_fmac_f32_dpp %11, %18, %20 row_newbcast:11 row_mask:0xf bank_mask:0xf\n\t"
        "v_fmac_f32_dpp %12, %18, %20 row_newbcast:12 row_mask:0xf bank_mask:0xf\n\t"
        "v_fmac_f32_dpp %13, %18, %20 row_newbcast:13 row_mask:0xf bank_mask:0xf\n\t"
        "v_fmac_f32_dpp %14, %18, %20 row_newbcast:14 row_mask:0xf bank_mask:0xf\n\t"
        "v_fmac_f32_dpp %15, %18, %20 row_newbcast:15 row_mask:0xf bank_mask:0xf\n\t"
        "s_nop 1"
        : "+v"(s[0]), "+v"(s[1]), "+v"(s[2]), "+v"(s[3]), "+v"(s[4]), "+v"(s[5]), "+v"(s[6]), "+v"(s[7]), "+v"(s[8]), "+v"(s[9]), "+v"(s[10]), "+v"(s[11]), "+v"(s[12]), "+v"(s[13]), "+v"(s[14]), "+v"(s[15]) : "v"(wv), "v"(kv), "v"(bv), "v"(vv), "v"(ns));
}
__device__ __forceinline__ float xrow16_sum(float x) {
    auto s = __builtin_amdgcn_permlane16_swap(__float_as_uint(x), __float_as_uint(x), false, false);
    x = __uint_as_float(s[0]) + __uint_as_float(s[1]);
    auto t = __builtin_amdgcn_permlane32_swap(__float_as_uint(x), __float_as_uint(x), false, false);
    return __uint_as_float(t[0]) + __uint_as_float(t[1]);
}
struct StepIn { float wv, kkv, bv, kv, wrv, vv, beta, kappa; };
template <bool PROW> __device__ __forceinline__ void scan_load(StepIn& x, const float* RWV, const float* SCL, int r, int h, int lane, int row) {
    const float* base = RWV + ((size_t)r * HB + h) * 512; const float* sc = SCL + ((size_t)r * HB + h) * 4;
    x.wv = base[lane]; x.kkv = base[64 + lane]; x.bv = base[128 + lane]; x.wrv = base[384 + lane]; x.beta = sc[0];
    if (!PROW) { x.kv = base[192 + lane]; x.vv = base[320 + row]; x.kappa = sc[1]; } else { x.kv = 0.f; x.vv = 0.f; x.kappa = 0.f; }
}
template <bool PROW, bool SAMP> __device__ __forceinline__ void scan_wave(Ctx& F, int bh, int c, int g) {
    const int lane = F.lane, q = lane >> 4, m = lane & 15, row = 16 * g + m, h = bh & 15, b = bh >> 4;
    constexpr int L = SAMP ? DSEQ : 64; const int r0 = SAMP ? NPR + b * DSEQ : b * SEQ + c * 64; const int ch = bh * 64 + c;
    const float* RWV = WSP(float, WS_RWV); const float* SCL = WSP(float, WS_SCL); float* Y = WSP(float, WS_Y); float* Z = WSP(float, WS_Z); float* PU = WSP(float, WS_PU);
    float s[16];
    if (SAMP) { const float* st = F.in(I_SWKV) + ((size_t)bh * 64 + row) * 64 + 16 * q;
#pragma unroll
        for (int i = 0; i < 16; i += 4) { const f32x4 v = *(const GAS f32x4*)(st + i); s[i] = v.x; s[i + 1] = v.y; s[i + 2] = v.z; s[i + 3] = v.w; } }
    else {
#pragma unroll
        for (int i = 0; i < 16; ++i) s[i] = (PROW && (16 * q + i) == row) ? 1.f : 0.f; }
    StepIn buf[4];
#pragma unroll
    for (int u = 0; u < 4; ++u) scan_load<PROW>(buf[u], RWV, SCL, r0 + u, h, lane, row);
    for (int t = 0; t < L; t += 4) {
#pragma unroll
        for (int u = 0; u < 4; ++u) {
            const StepIn x = buf[u];
            if (t + u + 4 < L) scan_load<PROW>(buf[u], RWV, SCL, r0 + t + u + 4, h, lane, row);
            float sig = 0.f, rho = 0.f;
            dots16(sig, rho, x.kkv, x.wrv, s);
            sig = xrow16_sum(sig); rho = xrow16_sum(rho);
            const float ns = -sig;
            float y = rho + ns * x.beta; if (!PROW) y += x.vv * x.kappa;
            if (q == 0) { if (PROW) Z[((size_t)ch * 64 + t + u) * 64 + row] = y; else Y[(size_t)(r0 + t + u) * 1024 + h * 64 + row] = y; }
            if (PROW) upd16_nov(s, x.wv, x.kv, x.bv, x.vv, ns); else upd16_v(s, x.wv, x.kv, x.bv, x.vv, ns);
        }
    }
    float* dst = SAMP ? F.outp() + O_WKVS + ((size_t)bh * 64 + row) * 64 + 16 * q : PU + (((size_t)ch * 2 + (PROW ? 1 : 0)) * 64 + row) * 64 + 16 * q;
#pragma unroll
    for (int i = 0; i < 16; i += 4) *(GAS f32x4*)(dst + i) = (f32x4){s[i], s[i + 1], s[i + 2], s[i + 3]};
}
__device__ __forceinline__ void dots2_h0(float& sgu, float& rhu, float& sgp, float& rhp, float kkv, float wrv, const float (&su)[16], const float (&sp)[16]) {
    asm("s_nop 1\n\t"
        "v_fmac_f32_dpp %0, %4, %6 row_newbcast:0 row_mask:0xf bank_mask:0xf\n\t"
        "v_fmac_f32_dpp %1, %5, %6 row_newbcast:0 row_mask:0xf bank_mask:0xf\n\t"
        "v_fmac_f32_dpp %2, %4, %14 row_newbcast:0 row_mask:0xf bank_mask:0xf\n\t"
        "v_fmac_f32_dpp %3, %5, %14 row_newbcast:0 row_mask:0xf bank_mask:0xf\n\t"
        "v_fmac_f32_dpp %0, %4, %7 row_newbcast:1 row_mask:0xf bank_mask:0xf\n\t"
        "v_fmac_f32_dpp %1, %5, %7 row_newbcast:1 row_mask:0xf bank_mask:0xf\n\t"
        "v_fmac_f32_dpp %2, %4, %15 row_newbcast:1 row_mask:0xf bank_mask:0xf\n\t"
        "v_fmac_f32_dpp %3, %5, %15 row_newbcast:1 row_mask:0xf bank_mask:0xf\n\t"
        "v_fmac_f32_dpp %0, %4, %8 row_newbcast:2 row_mask:0xf bank_mask:0xf\n\t"
        "v_fmac_f32_dpp %1, %5, %8 row_newbcast:2 row_mask:0xf bank_mask:0xf\n\t"
        "v_fmac_f32_dpp %2, %4, %16 row_newbcast:2 row_mask:0xf bank_mask:0xf\n\t"
        "v_fmac_f32_dpp %3, %5, %16 row_newbcast:2 row_mask:0xf bank_mask:0xf\n\t"
        "v_fmac_f32_dpp %0, %4, %9 row_newbcast:3 row_mask:0xf bank_mask:0xf\n\t"
        "v_fmac_f32_dpp %1, %5, %9 row_newbcast:3 row_mask:0xf bank_mask:0xf\n\t"
        "v_fmac_f32_dpp %2, %4, %17 row_newbcast:3 row_mask:0xf bank_mask:0xf\n\t"
        "v_fmac_f32_dpp %3, %5, %17 row_newbcast:3 row_mask:0xf bank_mask:0xf\n\t"
        "v_fmac_f32_dpp %0, %4, %10 row_newbcast:4 row_mask:0xf bank_mask:0xf\n\t"
        "v_fmac_f32_dpp %1, %5, %10 row_newbcast:4 row_mask:0xf bank_mask:0xf\n\t"
        "v_fmac_f32_dpp %2, %4, %18 row_newbcast:4 row_mask:0xf bank_mask:0xf\n\t"
        "v_fmac_f32_dpp %3, %5, %18 row_newbcast:4 row_mask:0xf bank_mask:0xf\n\t"
        "v_fmac_f32_dpp %0, %4, %11 row_newbcast:5 row_mask:0xf bank_mask:0xf\n\t"
        "v_fmac_f32_dpp %1, %5, %11 row_newbcast:5 row_mask:0xf bank_mask:0xf\n\t"
        "v_fmac_f32_dpp %2, %4, %19 row_newbcast:5 row_mask:0xf bank_mask:0xf\n\t"
        "v_fmac_f32_dpp %3, %5, %19 row_newbcast:5 row_mask:0xf bank_mask:0xf\n\t"
        "v_fmac_f32_dpp %0, %4, %12 row_newbcast:6 row_mask:0xf bank_mask:0xf\n\t"
        "v_fmac_f32_dpp %1, %5, %12 row_newbcast:6 row_mask:0xf bank_mask:0xf\n\t"
        "v_fmac_f32_dpp %2, %4, %20 row_newbcast:6 row_mask:0xf bank_mask:0xf\n\t"
        "v_fmac_f32_dpp %3, %5, %20 row_newbcast:6 row_mask:0xf bank_mask:0xf\n\t"
        "v_fmac_f32_dpp %0, %4, %13 row_newbcast:7 row_mask:0xf bank_mask:0xf\n\t"
        "v_fmac_f32_dpp %1, %5, %13 row_newbcast:7 row_mask:0xf bank_mask:0xf\n\t"
        "v_fmac_f32_dpp %2, %4, %21 row_newbcast:7 row_mask:0xf bank_mask:0xf\n\t"
        "v_fmac_f32_dpp %3, %5, %21 row_newbcast:7 row_mask:0xf bank_mask:0xf\n\t"
        "s_nop 1"
        : "+v"(sgu), "+v"(rhu), "+v"(sgp), "+v"(rhp) : "v"(kkv), "v"(wrv), "v"(su[0]), "v"(su[1]), "v"(su[2]), "v"(su[3]), "v"(su[4]), "v"(su[5]), "v"(su[6]), "v"(su[7]), "v"(sp[0]), "v"(sp[1]), "v"(sp[2]), "v"(sp[3]), "v"(sp[4]), "v"(sp[5]), "v"(sp[6]), "v"(sp[7]));
}
__device__ __forceinline__ void dots2_h1(float& sgu, float& rhu, float& sgp, float& rhp, float kkv, float wrv, const float (&su)[16], const float (&sp)[16]) {
    asm("s_nop 1\n\t"
        "v_fmac_f32_dpp %0, %4, %6 row_newbcast:8 row_mask:0xf bank_mask:0xf\n\t"
        "v_fmac_f32_dpp %1, %5, %6 row_newbcast:8 row_mask:0xf bank_mask:0xf\n\t"
        "v_fmac_f32_dpp %2, %4, %14 row_newbcast:8 row_mask:0xf bank_mask:0xf\n\t"
        "v_fmac_f32_dpp %3, %5, %14 row_newbcast:8 row_mask:0xf bank_mask:0xf\n\t"
        "v_fmac_f32_dpp %0, %4, %7 row_newbcast:9 row_mask:0xf bank_mask:0xf\n\t"
        "v_fmac_f32_dpp %1, %5, %7 row_newbcast:9 row_mask:0xf bank_mask:0xf\n\t"
        "v_fmac_f32_dpp %2, %4, %15 row_newbcast:9 row_mask:0xf bank_mask:0xf\n\t"
        "v_fmac_f32_dpp %3, %5, %15 row_newbcast:9 row_mask:0xf bank_mask:0xf\n\t"
        "v_fmac_f32_dpp %0, %4, %8 row_newbcast:10 row_mask:0xf bank_mask:0xf\n\t"
        "v_fmac_f32_dpp %1, %5, %8 row_newbcast:10 row_mask:0xf bank_mask:0xf\n\t"
        "v_fmac_f32_dpp %2, %4, %16 row_newbcast:10 row_mask:0xf bank_mask:0xf\n\t"
        "v_fmac_f32_dpp %3, %5, %16 row_newbcast:10 row_mask:0xf bank_mask:0xf\n\t"
        "v_fmac_f32_dpp %0, %4, %9 row_newbcast:11 row_mask:0xf bank_mask:0xf\n\t"
        "v_fmac_f32_dpp %1, %5, %9 row_newbcast:11 row_mask:0xf bank_mask:0xf\n\t"
        "v_fmac_f32_dpp %2, %4, %17 row_newbcast:11 row_mask:0xf bank_mask:0xf\n\t"
        "v_fmac_f32_dpp %3, %5, %17 row_newbcast:11 row_mask:0xf bank_mask:0xf\n\t"
        "v_fmac_f32_dpp %0, %4, %10 row_newbcast:12 row_mask:0xf bank_mask:0xf\n\t"
        "v_fmac_f32_dpp %1, %5, %10 row_newbcast:12 row_mask:0xf bank_mask:0xf\n\t"
        "v_fmac_f32_dpp %2, %4, %18 row_newbcast:12 row_mask:0xf bank_mask:0xf\n\t"
        "v_fmac_f32_dpp %3, %5, %18 row_newbcast:12 row_mask:0xf bank_mask:0xf\n\t"
        "v_fmac_f32_dpp %0, %4, %11 row_newbcast:13 row_mask:0xf bank_mask:0xf\n\t"
        "v_fmac_f32_dpp %1, %5, %11 row_newbcast:13 row_mask:0xf bank_mask:0xf\n\t"
        "v_fmac_f32_dpp %2, %4, %19 row_newbcast:13 row_mask:0xf bank_mask:0xf\n\t"
        "v_fmac_f32_dpp %3, %5, %19 row_newbcast:13 row_mask:0xf bank_mask:0xf\n\t"
        "v_fmac_f32_dpp %0, %4, %12 row_newbcast:14 row_mask:0xf bank_mask:0xf\n\t"
        "v_fmac_f32_dpp %1, %5, %12 row_newbcast:14 row_mask:0xf bank_mask:0xf\n\t"
        "v_fmac_f32_dpp %2, %4, %20 row_newbcast:14 row_mask:0xf bank_mask:0xf\n\t"
        "v_fmac_f32_dpp %3, %5, %20 row_newbcast:14 row_mask:0xf bank_mask:0xf\n\t"
        "v_fmac_f32_dpp %0, %4, %13 row_newbcast:15 row_mask:0xf bank_mask:0xf\n\t"
        "v_fmac_f32_dpp %1, %5, %13 row_newbcast:15 row_mask:0xf bank_mask:0xf\n\t"
        "v_fmac_f32_dpp %2, %4, %21 row_newbcast:15 row_mask:0xf bank_mask:0xf\n\t"
        "v_fmac_f32_dpp %3, %5, %21 row_newbcast:15 row_mask:0xf bank_mask:0xf\n\t"
        "s_nop 1"
        : "+v"(sgu), "+v"(rhu), "+v"(sgp), "+v"(rhp) : "v"(kkv), "v"(wrv), "v"(su[8]), "v"(su[9]), "v"(su[10]), "v"(su[11]), "v"(su[12]), "v"(su[13]), "v"(su[14]), "v"(su[15]), "v"(sp[8]), "v"(sp[9]), "v"(sp[10]), "v"(sp[11]), "v"(sp[12]), "v"(sp[13]), "v"(sp[14]), "v"(sp[15]));
}
__device__ __forceinline__ void scan_wave_up(Ctx& F, int bh, int c, int g) {
    const int lane = F.lane, q = lane >> 4, m = lane & 15, row = 16 * g + m, h = bh & 15, b = bh >> 4;
    const int r0 = b * SEQ + c * 64, ch = bh * 64 + c;
    const float* RWV = WSP(float, WS_RWV); const float* SCL = WSP(float, WS_SCL); float* Y = WSP(float, WS_Y); float* Z = WSP(float, WS_Z); float* PU = WSP(float, WS_PU);
    float su[16], sp[16];
#pragma unroll
    for (int i = 0; i < 16; ++i) { su[i] = 0.f; sp[i] = ((16 * q + i) == row) ? 1.f : 0.f; }
    StepIn buf[4];
#pragma unroll
    for (int u = 0; u < 4; ++u) scan_load<false>(buf[u], RWV, SCL, r0 + u, h, lane, row);
    for (int t = 0; t < 64; t += 4) {
#pragma unroll
        for (int u = 0; u < 4; ++u) {
            const StepIn x = buf[u];
            if (t + u + 4 < 64) scan_load<false>(buf[u], RWV, SCL, r0 + t + u + 4, h, lane, row);
            float sgu = 0.f, rhu = 0.f, sgp = 0.f, rhp = 0.f;
            dots2_h0(sgu, rhu, sgp, rhp, x.kkv, x.wrv, su, sp); dots2_h1(sgu, rhu, sgp, rhp, x.kkv, x.wrv, su, sp);
            sgu = xrow16_sum(sgu); rhu = xrow16_sum(rhu); sgp = xrow16_sum(sgp); rhp = xrow16_sum(rhp);
            const float nsu = -sgu, nsp = -sgp;
            const float y = rhu + nsu * x.beta + x.vv * x.kappa, z = rhp + nsp * x.beta;
            if (q == 0) { Y[(size_t)(r0 + t + u) * 1024 + h * 64 + row] = y; Z[((size_t)ch * 64 + t + u) * 64 + row] = z; }
            upd16_v(su, x.wv, x.kv, x.bv, x.vv, nsu); upd16_nov(sp, x.wv, x.kv, x.bv, x.vv, nsp);
        }
    }
    float* du = PU + (((size_t)ch * 2 + 0) * 64 + row) * 64 + 16 * q; float* dp = PU + (((size_t)ch * 2 + 1) * 64 + row) * 64 + 16 * q;
#pragma unroll
    for (int i = 0; i < 16; i += 4) { *(GAS f32x4*)(du + i) = (f32x4){su[i], su[i + 1], su[i + 2], su[i + 3]}; *(GAS f32x4*)(dp + i) = (f32x4){sp[i], sp[i + 1], sp[i + 2], sp[i + 3]}; }
}
__device__ __forceinline__ void phase_scan1_stream(Ctx& F) {
    LAS int* ctr = (LAS int*)(F.lds + LDSCTL_OFF);
    __syncthreads(); if (F.tid == 0) *ctr = 0; __syncthreads();
    if (F.wave >= 6) { for (int u = F.vcu * 2 + (F.wave - 6); u < DBAT * HA * 32; u += 2 * F.G) sba::attn_sample_unit(F, u >> 5, u & 31, (char*)F.lds + F.wave * 16384); }
    constexpr int NSU = DBAT * HB / 2, NU = NSU + NBATCH * HB * 64;
    const int nunits = F.vcu < NU ? (NU - 1 - F.vcu) / F.G + 1 : 0, ntasks = nunits * 8;
    for (;;) {
        int t = 0; if (F.lane == 0) t = __hip_atomic_fetch_add(ctr, 1, __ATOMIC_RELAXED, __HIP_MEMORY_SCOPE_WORKGROUP);
        t = __builtin_amdgcn_readfirstlane(t); if (t >= ntasks) break;
        const int u = F.vcu + (t >> 3) * F.G, g8 = t & 7;
        if (u < NSU) scan_wave<false, true>(F, u * 2 + (g8 >> 2), 0, g8 & 3);
        else if (g8 < 4) { const int ch = u - NSU; scan_wave_up(F, ch >> 6, ch & 63, g8); }
    }
}
namespace msc {
using sba::bf16x8; using sba::f32x16; using sba::crow; using sba::swap_other;
constexpr int S_AQ = 136, S_BKT = 104, S_L = 40;
constexpr int O_AQ = 0, O_BK = 32 * S_AQ, O_L24 = O_BK, O_TL3 = O_BK + 32 * S_L, O_BKT = 2 * 32 * S_AQ, BLK_BYTES = O_BKT + 64 * S_BKT, O_GL = 4 * BLK_BYTES, O_GP = O_GL + 256, GRP_BYTES = O_GP + 4 * 256;
static_assert(BLK_BYTES % 8 == 0 && 2 * GRP_BYTES <= RING_BYTES, "scan LDS map");
typedef __bf16 nbf2 __attribute__((ext_vector_type(2)));
__device__ __forceinline__ unsigned cvt2(float lo, float hi) { return __builtin_bit_cast(unsigned, __builtin_convertvector((f32x2){lo, hi}, nbf2)); }
__device__ __forceinline__ bf16x8 pack8(float a0, float a1, float a2, float a3, float a4, float a5, float a6, float a7) {
    u32x4 w = {cvt2(a0, a1), cvt2(a2, a3), cvt2(a4, a5), cvt2(a6, a7)}; return *reinterpret_cast<bf16x8*>(&w); }
__device__ __forceinline__ bf16x8 pack_lo(const f32x16& c) { return pack8(c[0], c[1], c[2], c[3], c[4], c[5], c[6], c[7]); }
__device__ __forceinline__ bf16x8 pack_hi(const f32x16& c) { return pack8(c[8], c[9], c[10], c[11], c[12], c[13], c[14], c[15]); }
__device__ __forceinline__ bf16x8 perm_read(const LAS char* img, int row, int pitch, int col0, int g) {
    const LAS char* p = img + row * pitch + (col0 + 4 * g) * 2; const u32x2 lo = *(const LAS u32x2*)p, hi = *(const LAS u32x2*)(p + 16);
    u32x4 w = {lo.x, lo.y, hi.x, hi.y}; return *reinterpret_cast<bf16x8*>(&w); }
__device__ __forceinline__ bf16x8 nat_read(const LAS char* img, int row, int pitch, int col0) {
    const LAS char* p = img + row * pitch + col0 * 2; const u32x2 lo = *(const LAS u32x2*)p, hi = *(const LAS u32x2*)(p + 8);
    u32x4 w = {lo.x, lo.y, hi.x, hi.y}; return *reinterpret_cast<bf16x8*>(&w); }
__device__ __forceinline__ unsigned short bf1(float x) { return (unsigned short)(cvt_pk_bf16(x, 0.f) & 0xffffu); }
struct PrepRegs { float pr[17], pk[17], pv[17], lwl[16]; const bf16* lw; };
__device__ __forceinline__ void prep_load(Ctx& F, PrepRegs& L, int rb, int h) {
    const bf16* pb = WSP(bf16, WS_PBH) + (size_t)rb * 3072 + h * 64 + F.lane; const bf16* lw = WSP(bf16, WS_LWH) + (size_t)rb * 3072 + h * 64 + F.lane;
    L.lw = lw;
#pragma unroll
    for (int t = 0; t < 16; ++t) L.lwl[t] = ldbf_nt(lw + (size_t)t * 3072);
    if ((rb & (SEQ - 1)) != 0) { L.pr[0] = ldbf_nt(pb - 3072); L.pk[0] = ldbf_nt(pb + 1024 - 3072); L.pv[0] = ldbf_nt(pb + 2048 - 3072); } else { L.pr[0] = 0.f; L.pk[0] = 0.f; L.pv[0] = 0.f; }
#pragma unroll
    for (int t = 0; t < 16; ++t) { L.pr[t + 1] = ldbf_nt(pb + (size_t)t * 3072); L.pk[t + 1] = ldbf_nt(pb + (size_t)t * 3072 + 1024); L.pv[t + 1] = ldbf_nt(pb + (size_t)t * 3072 + 2048); }
}
__device__ __forceinline__ void prep_block(Ctx& F, PrepRegs& L, int rb, int h, int j, LAS char* gbase) {
    const int lane = F.lane, n = lane & 31, hi = lane >> 5, col = h * 64 + lane; LAS char* blk = gbase + j * BLK_BYTES;
    float lal[16];
#pragma unroll
    for (int t = 0; t < 16; ++t) lal[t] = ldbf_nt(L.lw + (size_t)t * 3072 + 1024);
    const float* mu = F.in(I_MU); const float mu_r = mu[col], mu_k = mu[1024 + col], mu_v = mu[2048 + col];
    const float w0 = F.in(I_W0)[col], a0 = F.in(I_A0)[col], kkw = F.in(I_KK)[col], kaw = F.in(I_KA)[col], rkw = F.in(I_RK)[col];
    float cw[16];
#pragma unroll
    for (int t = 0; t < 16; ++t) { const float wl = w0 + L.lwl[t], wlog = -softplusf_(-wl) - 0.5f; cw[t] = __expf(-__expf(wlog)); }
#pragma unroll
    for (int t = 1; t < 16; ++t) cw[t] *= cw[t - 1];
    *(LAS float*)(gbase + O_GP + (j * 64 + lane) * 4) = cw[15];
    __syncthreads();
    const float g0 = *(const LAS float*)(gbase + O_GP + lane * 4), g1 = *(const LAS float*)(gbase + O_GP + (64 + lane) * 4), g2 = *(const LAS float*)(gbase + O_GP + (128 + lane) * 4);
    const float G0 = (j > 0 ? g0 : 1.f) * (j > 1 ? g1 : 1.f) * (j > 2 ? g2 : 1.f);
    if (j == 3) *(LAS float*)(gbase + O_GL + lane * 4) = G0 * cw[15];
    float* SCL = WSP(float, WS_SCL) + ((size_t)rb * HB + h) * 4;
#pragma unroll
    for (int tl = 0; tl < 16; tl += 2) {
        float nb[2], kt[2], vz[2];
#pragma unroll
        for (int u = 0; u < 2; ++u) { const int t = tl + u;
            const float zr = L.pr[t + 1] + mu_r * (L.pr[t] - L.pr[t + 1]), zk = L.pk[t + 1] + mu_k * (L.pk[t] - L.pk[t + 1]); vz[u] = L.pv[t + 1] + mu_v * (L.pv[t] - L.pv[t + 1]);
            const float a_ = sigmoidf_(a0 + lal[t]);
            const float kkr = zk * kkw, kk = kkr * rsqrtf(wave_sum(kkr * kkr) + 1e-12f);
            const float k = zk * (1.f + (a_ - 1.f) * kaw), bb = kk * a_;
            const float bonus = wave_sum(zr * k * rkw);
            if (lane == 0) SCL[(size_t)t * HB * 4 + 2] = bonus;
            const float Gp = t ? G0 * cw[t ? t - 1 : 0] : G0, G = G0 * cw[t], gi = 1.f / G;
            const float a = kk * Gp, q = zr * G, bt = bb * gi; kt[u] = k * gi; nb[u] = -bt;
            *(LAS unsigned short*)(blk + O_AQ + t * S_AQ + lane * 2) = bf1(a); *(LAS unsigned short*)(blk + O_AQ + (16 + t) * S_AQ + lane * 2) = bf1(q);
            *(LAS unsigned short*)(blk + O_BK + t * S_AQ + lane * 2) = bf1(bt); *(LAS unsigned short*)(blk + O_BK + (16 + t) * S_AQ + lane * 2) = bf1(kt[u]); }
        *(LAS unsigned*)(blk + O_BKT + lane * S_BKT + tl * 2) = cvt_pk_bf16(nb[0], nb[1]); *(LAS unsigned*)(blk + O_BKT + lane * S_BKT + (16 + tl) * 2) = cvt_pk_bf16(kt[0], kt[1]);
        *(LAS unsigned*)(blk + O_BKT + lane * S_BKT + (32 + tl) * 2) = cvt_pk_bf16(vz[0], vz[1]);
    }
    LDS_WAIT(); asm volatile("" ::: "memory");
    f32x16 mt = f32x16{};
#pragma unroll
    for (int ks = 0; ks < 4; ++ks) mt = __builtin_amdgcn_mfma_f32_32x32x16_bf16(nat_read(blk + O_AQ, n, S_AQ, 16 * ks + 8 * hi), nat_read(blk + O_BK, n, S_AQ, 16 * ks + 8 * hi), mt, 0, 0, 0);
    float l1[8];
    const int i = n & 15;
#pragma unroll
    for (int r = 0; r < 16; ++r) { const int t = crow(r, hi) & 15; float val = mt[r];
        if (r < 8) { val = t > i ? val : 0.f; if (n >= 16) *(LAS unsigned short*)(blk + O_L24 + t * S_L + i * 2) = bf1(val); l1[r] = val; }
        else { val = t >= i ? val : 0.f; if (n >= 16) *(LAS unsigned short*)(blk + O_L24 + (16 + t) * S_L + i * 2) = bf1(val); else *(LAS unsigned short*)(blk + O_TL3 + (16 + t) * S_L + i * 2) = bf1(-val); } }
    float rowv[16];
#pragma unroll
    for (int r = 0; r < 8; ++r) { const float own = l1[r], oth = swap_other(own, hi); const int p0 = (r & 3) + 8 * (r >> 2); rowv[p0] = hi ? oth : own; rowv[p0 + 4] = hi ? own : oth; }
    float tl_[16];
    tl_[0] = lane == 0 ? 1.f : 0.f;
#pragma unroll
    for (int t = 1; t < 16; ++t) { float acc = lane == t ? 1.f : 0.f;
#pragma unroll
        for (int jj = 0; jj < t; ++jj) acc -= readlane_f(rowv[t], jj) * tl_[jj];
        tl_[t] = acc; }
    if (lane < 16) {
#pragma unroll
        for (int t = 0; t < 16; ++t) *(LAS unsigned short*)(blk + O_TL3 + t * S_L + lane * 2) = bf1(tl_[t]); }
    LDS_WAIT(); asm volatile("" ::: "memory");
}
__device__ __forceinline__ void chain(Ctx& F, int bh, int c, int isP, int half, const LAS char* gbase) {
    const int lane = F.lane, n = lane & 31, hi = lane >> 5, rowg = 32 * half + n, h = bh & 15, b = bh >> 4, r0 = b * SEQ + c * 64, ch = bh * 64 + c;
    const float* RWV = WSP(float, WS_RWV);
    f32x16 st0 = f32x16{}, st1 = f32x16{};
    if (isP) {
#pragma unroll
        for (int r = 0; r < 16; ++r) { st0[r] = crow(r, hi) == rowg ? 1.f : 0.f; st1[r] = 32 + crow(r, hi) == rowg ? 1.f : 0.f; } }
    for (int blk_i = 0; blk_i < 4; ++blk_i) {
        const LAS char* blk = gbase + blk_i * BLK_BYTES;
        f32x16 wt = f32x16{};
        wt = __builtin_amdgcn_mfma_f32_32x32x16_bf16(perm_read(blk + O_AQ, n, S_AQ, 0, hi), pack_lo(st0), wt, 0, 0, 0);
        wt = __builtin_amdgcn_mfma_f32_32x32x16_bf16(perm_read(blk + O_AQ, n, S_AQ, 16, hi), pack_hi(st0), wt, 0, 0, 0);
        wt = __builtin_amdgcn_mfma_f32_32x32x16_bf16(perm_read(blk + O_AQ, n, S_AQ, 32, hi), pack_lo(st1), wt, 0, 0, 0);
        wt = __builtin_amdgcn_mfma_f32_32x32x16_bf16(perm_read(blk + O_AQ, n, S_AQ, 48, hi), pack_hi(st1), wt, 0, 0, 0);
        bf16x8 bV = bf16x8{};
        if (!isP) { bV = perm_read(blk + O_BKT, rowg, S_BKT, 32, hi);
            wt = __builtin_amdgcn_mfma_f32_32x32x16_bf16(perm_read(blk + O_L24, n, S_L, 0, hi), bV, wt, 0, 0, 0); }
        const bf16x8 tl3 = perm_read(blk + O_TL3, n, S_L, 0, hi);
        const bf16x8 a_tl = n < 16 ? tl3 : bf16x8{}, a_l3 = n >= 16 ? tl3 : bf16x8{};
        const f32x16 sg = __builtin_amdgcn_mfma_f32_32x32x16_bf16(a_tl, pack_lo(wt), f32x16{}, 0, 0, 0);
        const bf16x8 bSg = pack_lo(sg);
        const f32x16 yy = __builtin_amdgcn_mfma_f32_32x32x16_bf16(a_l3, bSg, wt, 0, 0, 0);
#pragma unroll
        for (int r = 8; r < 16; ++r) { const int t = blk_i * 16 + (r & 3) + 8 * ((r - 8) >> 2) + 4 * hi;
            if (isP) WSP(float, WS_Z)[((size_t)ch * 64 + t) * 64 + rowg] = yy[r]; else WSP(float, WS_Y)[(size_t)(r0 + t) * 1024 + h * 64 + rowg] = yy[r]; }
        st0 = __builtin_amdgcn_mfma_f32_32x32x16_bf16(perm_read(blk + O_BKT, n, S_BKT, 0, hi), bSg, st0, 0, 0, 0);
        st1 = __builtin_amdgcn_mfma_f32_32x32x16_bf16(perm_read(blk + O_BKT, 32 + n, S_BKT, 0, hi), bSg, st1, 0, 0, 0);
        if (!isP) { st0 = __builtin_amdgcn_mfma_f32_32x32x16_bf16(perm_read(blk + O_BKT, n, S_BKT, 16, hi), bV, st0, 0, 0, 0);
                    st1 = __builtin_amdgcn_mfma_f32_32x32x16_bf16(perm_read(blk + O_BKT, 32 + n, S_BKT, 16, hi), bV, st1, 0, 0, 0); }
    }
    const LAS float* GL = (const LAS float*)(gbase + O_GL); float* dst = WSP(float, WS_PU) + (((size_t)ch * 2 + isP) * 64 + rowg) * 64;
#pragma unroll
    for (int g4 = 0; g4 < 4; ++g4) { const int k0 = 8 * g4 + 4 * hi; const f32x4 ga = *(const LAS f32x4*)(GL + k0), gb = *(const LAS f32x4*)(GL + 32 + k0);
        *(GAS f32x4*)(dst + k0) = (f32x4){st0[4 * g4] * ga.x, st0[4 * g4 + 1] * ga.y, st0[4 * g4 + 2] * ga.z, st0[4 * g4 + 3] * ga.w};
        *(GAS f32x4*)(dst + 32 + k0) = (f32x4){st1[4 * g4] * gb.x, st1[4 * g4 + 1] * gb.y, st1[4 * g4 + 2] * gb.z, st1[4 * g4 + 3] * gb.w}; }
}
}
__device__ __forceinline__ void phase_sample_stream(Ctx& F) {
    for (int u = F.vcu * NWAVES + F.wave; u < DBAT * HA * 32; u += NWAVES * F.G) sba::attn_sample_unit(F, (u >> 8) * HA + (u & 7), (u >> 3) & 31, (char*)F.lds + F.wave * 16384);
}
__device__ __forceinline__ void phase_scan1_mfma(Ctx& F) {
    __syncthreads();
    const int grp = F.wave >> 2, wq = F.wave & 3; LAS char* gbase = (LAS char*)F.lds + grp * msc::GRP_BYTES;
    msc::PrepRegs L;
    { const int ch = 2 * F.vcu + grp; if (ch < NBATCH * HB * 64) msc::prep_load(F, L, (ch >> 10) * SEQ + (ch & 63) * 64 + 16 * wq, (ch >> 6) & 15); }
    for (int base = 2 * F.vcu; base < NBATCH * HB * 64; base += 2 * F.G) {
        const int ch = base + grp, bh = ch >> 6, c = ch & 63;
        msc::prep_block(F, L, (bh >> 4) * SEQ + c * 64 + 16 * wq, bh & 15, wq, gbase);
        __syncthreads();
        { const int chn = ch + 2 * F.G; if (chn < NBATCH * HB * 64) msc::prep_load(F, L, (chn >> 10) * SEQ + (chn & 63) * 64 + 16 * wq, (chn >> 6) & 15); }
        msc::chain(F, bh, c, wq >> 1, wq & 1, gbase);
    }
}
__device__ __forceinline__ void phase_scan2(Ctx& F) {
    LAS float* Pb = (LAS float*)(F.lds + 4096);
    const float* PU = WSP(float, WS_PU); float* SC = WSP(float, WS_SC);
    for (int unit = F.vcu; unit < NBATCH * HB * 8; unit += F.G) {
        const int bh = unit >> 3, r0 = (unit & 7) * 8, r = F.wave, col = F.lane;
        __syncthreads();
        { const float* P0 = PU + ((size_t)(bh * 64) * 2 + 1) * 4096; const f32x4 a = *(const GAS f32x4*)(P0 + F.tid * 4), bq = *(const GAS f32x4*)(P0 + 2048 + F.tid * 4);
          *(LAS f32x4*)(Pb + F.tid * 4) = a; *(LAS f32x4*)(Pb + 2048 + F.tid * 4) = bq; }
        float ucur = PU[((size_t)(bh * 64) * 2 + 0) * 4096 + (r0 + r) * 64 + col], scur = 0.f;
        __syncthreads();
        for (int c = 0; c < 64; ++c) {
            const int ch = bh * 64 + c; LAS float* Pc = Pb + (c & 1) * 4096;
            SC[((size_t)ch * 64 + r0 + r) * 64 + col] = scur;
            f32x4 pa = {0.f, 0.f, 0.f, 0.f}, pq = {0.f, 0.f, 0.f, 0.f}; float unext = 0.f;
            if (c + 1 < 64) { const float* Pn = PU + ((size_t)(ch + 1) * 2 + 1) * 4096; pa = *(const GAS f32x4*)(Pn + F.tid * 4); pq = *(const GAS f32x4*)(Pn + 2048 + F.tid * 4);
                unext = PU[((size_t)(ch + 1) * 2 + 0) * 4096 + (r0 + r) * 64 + col]; }
            float a0 = ucur, a1 = 0.f, a2 = 0.f, a3 = 0.f;
#pragma unroll
            for (int j = 0; j < 64; j += 4) {
                const float s0 = readlane_f(scur, j), s1 = readlane_f(scur, j + 1), s2 = readlane_f(scur, j + 2), s3 = readlane_f(scur, j + 3);
                a0 += s0 * Pc[(j + 0) * 64 + col]; a1 += s1 * Pc[(j + 1) * 64 + col]; a2 += s2 * Pc[(j + 2) * 64 + col]; a3 += s3 * Pc[(j + 3) * 64 + col]; }
            const float acc = (a0 + a1) + (a2 + a3);
            if (c + 1 < 64) { LAS float* Pn = Pb + ((c + 1) & 1) * 4096; *(LAS f32x4*)(Pn + F.tid * 4) = pa; *(LAS f32x4*)(Pn + 2048 + F.tid * 4) = pq; }
            __syncthreads();
            scur = acc; ucur = unext;
        }
        F.outp()[O_WKVP + ((size_t)bh * 64 + r0 + r) * 64 + col] = scur;
    }
}
__device__ __forceinline__ void phase_scan3(Ctx& F) {
    const int gw = F.vcu * NWAVES + F.wave, NGW = F.G * NWAVES, lane = F.lane, q = lane >> 4, m = lane & 15;
    const float* SC = WSP(float, WS_SC); const float* Z = WSP(float, WS_Z); float* Y = WSP(float, WS_YC);
    for (int task = gw; task < NBATCH * HB * 63 * 4; task += NGW) {
        const int g = task & 3, cc = task >> 2, bh = cc / 63, c = 1 + (cc - bh * 63), ch = bh * 64 + c, h = bh & 15, b = bh >> 4, row = 16 * g + m;
        const float* st = SC + ((size_t)ch * 64 + row) * 64 + 16 * q; float s[16];
#pragma unroll
        for (int i = 0; i < 16; i += 4) { const f32x4 v = *(const GAS f32x4*)(st + i); s[i] = v.x; s[i + 1] = v.y; s[i + 2] = v.z; s[i + 3] = v.w; }
        const float* zp = Z + (size_t)ch * 4096 + lane; float* yp = Y + (size_t)(b * SEQ + c * 64) * 1024 + h * 64 + row;
        float zb[4];
#pragma unroll
        for (int u = 0; u < 4; ++u) zb[u] = zp[u * 64];
        for (int t = 0; t < 64; t += 4) {
#pragma unroll
            for (int u = 0; u < 4; ++u) {
                const float zv = zb[u]; if (t + u + 4 < 64) zb[u] = zp[(t + u + 4) * 64];
                float acc = 0.f; dot16(acc, zv, s); acc = xrow16_sum(acc);
                if (q == 0) yp[(size_t)(t + u) * 1024] = acc;
            }
        }
    }
}
__device__ __forceinline__ float sum32(float v) {
    v += dpp_f<0xB1>(v); v += dpp_f<0x4E>(v); v += dpp_f<0x141>(v); v += dpp_f<0x140>(v);
    auto s = __builtin_amdgcn_permlane16_swap(__float_as_uint(v), __float_as_uint(v), false, false);
    return __uint_as_float(s[0]) + __uint_as_float(s[1]);
}
__device__ __forceinline__ sba::bf16x8 ld8_bf16(const float* p) { const f32x4 a = *(const GAS f32x4*)p, b = *(const GAS f32x4*)(p + 4); return msc::pack8(a.x, a.y, a.z, a.w, b.x, b.y, b.z, b.w); }
__device__ __forceinline__ void phase_scan3_post(Ctx& F) {
    const int gw = F.vcu * NWAVES + F.wave, NGW = F.G * NWAVES, lane = F.lane, n = lane & 31, hi = lane >> 5;
    const float* SC = WSP(float, WS_SC); const float* Z = WSP(float, WS_Z); const float* Y = WSP(float, WS_Y); const bf16* LWH = WSP(bf16, WS_LWH); const bf16* PBH = WSP(bf16, WS_PBH);
    const float* SCL = WSP(float, WS_SCL); bf16* OAB = WSP(bf16, WS_OAB);
    for (int ch = gw; ch < NBATCH * HB * 64; ch += NGW) {
        const int bh = ch >> 6, c = ch & 63, h = bh & 15, b = bh >> 4, r0 = b * SEQ + c * 64, col0 = h * 64 + n;
        const float lg0 = F.in(I_LNG)[col0], lg1 = F.in(I_LNG)[col0 + 32], lb0 = F.in(I_LNB)[col0], lb1 = F.in(I_LNB)[col0 + 32], mv0 = F.in(I_MU)[2048 + col0], mv1 = F.in(I_MU)[2048 + col0 + 32];
        sba::bf16x8 sb0[4], sb1[4];
        if (c > 0) { const float* Sp = SC + (size_t)ch * 4096 + n * 64 + 8 * hi;
#pragma unroll
            for (int ks = 0; ks < 4; ++ks) { sb0[ks] = ld8_bf16(Sp + 16 * ks); sb1[ks] = ld8_bf16(Sp + 32 * 64 + 16 * ks); } }
        else {
#pragma unroll
            for (int ks = 0; ks < 4; ++ks) { sb0[ks] = sba::bf16x8{}; sb1[ks] = sba::bf16x8{}; } }
        for (int tt = 0; tt < 2; ++tt) {
            sba::f32x16 a0 = sba::f32x16{}, a1 = sba::f32x16{};
            if (c > 0) { const float* Zp = Z + (size_t)ch * 4096 + (32 * tt + n) * 64 + 8 * hi;
#pragma unroll
                for (int ks = 0; ks < 4; ++ks) { const sba::bf16x8 za = ld8_bf16(Zp + 16 * ks);
                    a0 = __builtin_amdgcn_mfma_f32_32x32x16_bf16(za, sb0[ks], a0, 0, 0, 0); a1 = __builtin_amdgcn_mfma_f32_32x32x16_bf16(za, sb1[ks], a1, 0, 0, 0); } }
#pragma unroll
            for (int rg = 0; rg < 16; rg += 4) {
                float y0[4], y1[4], g0[4], g1[4], p0[4], p1[4], q0[4], q1[4], bn[4];
#pragma unroll
                for (int i = 0; i < 4; ++i) { const int t = 32 * tt + sba::crow(rg + i, hi), r = r0 + t;
                    y0[i] = Y[(size_t)r * 1024 + col0]; y1[i] = Y[(size_t)r * 1024 + col0 + 32];
                    g0[i] = ldbf(LWH + (size_t)r * 3072 + 2048 + col0); g1[i] = ldbf(LWH + (size_t)r * 3072 + 2048 + col0 + 32);
                    const bf16* pb = PBH + (size_t)r * 3072 + 2048 + col0; p0[i] = ldbf(pb); p1[i] = ldbf(pb + 32);
                    const bool hp = (r & (SEQ - 1)) != 0; q0[i] = hp ? ldbf(pb - 3072) : 0.f; q1[i] = hp ? ldbf(pb + 32 - 3072) : 0.f;
                    bn[i] = SCL[((size_t)r * HB + h) * 4 + 2]; }
#pragma unroll
                for (int i = 0; i < 4; ++i) { const int t = 32 * tt + sba::crow(rg + i, hi), r = r0 + t;
                    const float v0 = y0[i] + a0[rg + i], v1 = y1[i] + a1[rg + i];
                    const float mean = sum32(v0 + v1) * (1.f / 64.f), d0 = v0 - mean, d1 = v1 - mean, var = sum32(d0 * d0 + d1 * d1) * (1.f / 64.f), rs = rsqrtf(var + EPS_LNX);
                    const float zv0 = p0[i] + mv0 * (q0[i] - p0[i]), zv1 = p1[i] + mv1 * (q1[i] - p1[i]);
                    const float o0 = (d0 * rs * lg0 + lb0 + bn[i] * zv0) * g0[i], o1 = (d1 * rs * lg1 + lb1 + bn[i] * zv1) * g1[i];
                    const float o0n = dpp_f<0xB1>(o0), o1n = dpp_f<0xB1>(o1);
                    if ((lane & 1) == 0) { *(GAS unsigned*)(OAB + (size_t)r * DM + 1024 + col0) = cvt_pk_bf16(o0, o0n); *(GAS unsigned*)(OAB + (size_t)r * DM + 1024 + col0 + 32) = cvt_pk_bf16(o1, o1n); } }
            }
        }
    }
}
__device__ __forceinline__ void phase_postscan(Ctx& F) {
    const int gw = F.vcu * NWAVES + F.wave, NGW = F.G * NWAVES;
    const float* Y = WSP(float, WS_Y); const float* RWV = WSP(float, WS_RWV); const float* SCL = WSP(float, WS_SCL); const float* LWO = WSP(float, WS_LWO); const float* Pp = WSP(float, WS_P); bf16* OAB = WSP(bf16, WS_OAB);
    for (int u = NPR * 4 + gw; u < NTOK * 4; u += NGW) {
        const int r = u >> 2, hq = u & 3; const bool corr = false;
        float yv[4], gv[4], vv[4], bn[4];
#pragma unroll
        for (int i = 0; i < 4; ++i) { const int h = hq * 4 + i, col = h * 64 + F.lane;
            yv[i] = Y[(size_t)r * 1024 + col]; if (corr) yv[i] += WSP(float, WS_YC)[(size_t)r * 1024 + col];
            gv[i] = LWO[(size_t)r * 3072 + 2048 + col]; bn[i] = SCL[((size_t)r * HB + h) * 4 + 2];
            vv[i] = RWV[((size_t)r * HB + h) * 512 + 320 + F.lane]; }
#pragma unroll
        for (int i = 0; i < 4; ++i) { const int h = hq * 4 + i, col = h * 64 + F.lane;
            const float mean = wave_sum(yv[i]) * (1.f / 64.f), d = yv[i] - mean, var = wave_sum(d * d) * (1.f / 64.f);
            const float yn = d * rsqrtf(var + EPS_LNX) * F.in(I_LNG)[col] + F.in(I_LNB)[col] + bn[i] * vv[i];
            const float o = yn * gv[i];
            const float o1 = dpp_f<0xB1>(o);
            if ((F.lane & 1) == 0) *(GAS unsigned*)(OAB + (size_t)r * DM + 1024 + col) = cvt_pk_bf16(o, o1); }
    }
    sample_combine(F);
    const float* OP = WSP(float, WS_OP); const float* CL = WSP(float, WS_CL);
    for (size_t i = (size_t)F.vcu * NTHR + F.tid; i < (size_t)NPR * 256; i += (size_t)F.G * NTHR) {
        const int r = (int)(i >> 8), c4 = (int)(i & 255) * 4, h = c4 >> 7;
        const f32x4 a = *(const GAS f32x4*)(OP + (size_t)r * 1024 + c4), e = *(const GAS f32x4*)(OP + ((size_t)NPR + r) * 1024 + c4); const float cl = CL[(size_t)r * HA + h];
        const f32x4 o = a + e * cl; u32x2 w; w.x = cvt_pk_bf16(o.x, o.y); w.y = cvt_pk_bf16(o.z, o.w);
        *(GAS u32x2*)(OAB + (size_t)r * DM + c4) = w;
    }
}
__device__ __forceinline__ void phase_usample(Ctx& F) {
    const float* PU_ = WSP(float, WS_PARTU); bf16* U = WSP(bf16, WS_U);
    for (int i = F.vcu * NTHR + F.tid; i < NSM * DFF / 4; i += F.G * NTHR) { const int r = i / (DFF / 4), c4 = (i - r * (DFF / 4)) * 4;
        f32x4 a = *(const GAS f32x4*)(PU_ + (size_t)r * DFF + c4);
#pragma unroll
        for (int kc = 1; kc < 8; ++kc) a += *(const GAS f32x4*)(PU_ + ((size_t)kc * 64 + r) * DFF + c4);
        const float x0 = fmaxf(a.x, 0.f), x1 = fmaxf(a.y, 0.f), x2 = fmaxf(a.z, 0.f), x3 = fmaxf(a.w, 0.f);
        u32x2 w; w.x = cvt_pk_bf16(x0 * x0, x1 * x1); w.y = cvt_pk_bf16(x2 * x2, x3 * x3);
        *(GAS u32x2*)(U + (size_t)(NPR + r) * DFF + c4) = w; }
}
#ifndef MK_SPLIT
#define MK_SPLIT 0
#endif
constexpr int NPHASE = 21;
struct Args { const void* in[N_IN]; float* out; unsigned char* ws; int ph_lo, ph_hi; };
__global__ void __launch_bounds__(NTHR, 2) mega_fwd(Args args) {
    extern __shared__ __attribute__((aligned(16))) unsigned char lds_raw[];
    Ctx F;
    F.lds = (LAS unsigned char*)lds_raw; F.tid = threadIdx.x; F.lane = F.tid & 63; F.wave = __builtin_amdgcn_readfirstlane(F.tid >> 6);
    F.G = gridDim.x; { const int bx = blockIdx.x; F.vcu = (F.G % 8 == 0) ? (bx % 8) * (F.G / 8) + bx / 8 : bx; }
    for (int u = F.tid; u < (LDS_BYTES - LDSCTL_OFF) / 4; u += NTHR) ((LAS unsigned*)(F.lds + LDSCTL_OFF))[u] = 0u;
    __syncthreads();
    unsigned* ctl = (unsigned*)(args.ws + WS_CTL);
    XcdBarrier bar; bar.bar = ctl + CW_BAR; bar.x = 0; bar.st = nullptr;
    if (!MK_SPLIT) bar = xcd_barrier_post(ctl + CW_BAR, (volatile LAS unsigned*)(F.lds + MISC_OFF) + 8);
    const int lo = args.ph_lo, hi = args.ph_hi;
#define IN(k) (lo <= (k) && (k) < hi)
#define SEAM(k) do { if (IN(k) && IN((k) + 1)) xcd_barrier(bar); } while (0)
    if (IN(0)) { phase_prologue(F); } SEAM(0);
    if (IN(1)) { phase_mod0(F); } SEAM(1);
    if (IN(2)) { const bool hide = F.G > NCVT + 8; const int ng = hide ? F.G - NCVT : F.G;
        if ((int)blockIdx.x < ng) { pg8::Gemm g{WSP(bf16, WS_H), WSP(bf16, WS_WIN), MP, INPAD, DM, DM, DM}; pg8::StaticOrder S; S.init(MP, INPAD, ng, (int)blockIdx.x); EpiIn E{WSP(bf16, WS_QB), WSP(bf16, WS_KB), WSP(bf16, WS_VB), WSP(float, WS_P), F.outp(), WSP(bf16, WS_PBH)};
            pg8::gemm_phase<EpiIn, pg8::StaticOrder, true, true>(F.lds, g, S, E); }
        else convert_run(F, IT_IN + ((int)blockIdx.x - ng) * NWAVES + F.wave, NCVT * NWAVES, IT_IN + N_HIDE, (LAS float*)(F.lds + F.wave * 16384)); } SEAM(2);
    if (IN(3)) { phase_kv_prep(F); } SEAM(3);
    if (IN(4)) { pg8::Gemm g{WSP(bf16, WS_LA), WSP(bf16, WS_LWT), MP, 3072, 512, 512, 512}; pg8::LoraOrder S; S.init(MP, 3072, F.G, (int)blockIdx.x); pg8::EpiLora E{WSP(float, WS_LWO), WSP(bf16, WS_LWH), 3072};
        pg8::gemm_phase<pg8::EpiLora, pg8::LoraOrder, true, true>(F.lds, g, S, E); } SEAM(4);
    if (IN(6)) { phase_rwkv_prep(F);
        const bool stream_first = (F.vcu & 1) != 0;
        if (stream_first) phase_sample_stream(F); else phase_scan1_mfma(F);
        __syncthreads();
        phase_attn_prompt(F);
        if (!stream_first) phase_sample_stream(F); else phase_scan1_mfma(F); } SEAM(7);
    if (IN(8)) {
        if (F.wave < 2) for (int t = F.vcu * 2 + F.wave; t < DBAT * HB * 4; t += 2 * F.G) scan_wave<false, true>(F, t >> 2, 0, t & 3);
        phase_scan2(F); } SEAM(8);
    if (IN(10)) { phase_scan3_post(F); phase_postscan(F); } SEAM(10);
    if (IN(11)) { pg8::Gemm g{WSP(bf16, WS_OAB), WSP(bf16, WS_WOUT), MP, DM, DM, DM, DM}; pg8::MixOrder<false> S; S.init(DM, DM, F.G, (int)blockIdx.x); pg8::EpiF32S<64> E{WSP(bf16, WS_OUT), DM, nullptr, WSP(float, WS_PART)};
        pg8::gemm_phase<pg8::EpiF32S<64>, pg8::MixOrder<false>, true, true>(F.lds, g, S, E); } SEAM(11);
    if (IN(12)) { phase_postmix<0>(F); } SEAM(12);
    if (IN(13)) { pg8::Gemm g{WSP(bf16, WS_H), WSP(bf16, WS_W1), MP, DFF, DM, DM, DM}; pg8::MixOrder<false> S; S.init(DFF, DM, F.G, (int)blockIdx.x); pg8::EpiRelu2 E{WSP(bf16, WS_U), DFF, WSP(float, WS_PARTU)};
        pg8::gemm_phase<pg8::EpiRelu2, pg8::MixOrder<false>, true, true>(F.lds, g, S, E); } SEAM(13);
    if (IN(14)) { phase_usample(F); if (!MK_SPLIT) xcd_barrier(bar); pg8::Gemm g{WSP(bf16, WS_U), WSP(bf16, WS_W2), MP, DM, DFF, DFF, DFF}; pg8::MixOrder<false> S; S.init(DM, DFF, F.G, (int)blockIdx.x); pg8::EpiF32S<64> E{WSP(bf16, WS_OUT), DM, nullptr, WSP(float, WS_PART)};
        pg8::gemm_phase<pg8::EpiF32S<64>, pg8::MixOrder<false>, true, true>(F.lds, g, S, E); } SEAM(14);
    if (IN(15)) { phase_postmlp<0>(F); } SEAM(15);
    if (IN(16)) { pg8::Gemm g{WSP(bf16, WS_H), WSP(bf16, WS_WPOOL), MP, DM, DM, DM, DM}; pg8::MixOrder<true> S; S.init(DM, DM, F.G, (int)blockIdx.x); pg8::EpiF32S<256> E{WSP(bf16, WS_OUT), DM, F.in(I_PSC), WSP(float, WS_PART)};
        pg8::gemm_phase<pg8::EpiF32S<256>, pg8::MixOrder<true>, true, true>(F.lds, g, S, E); } SEAM(16);
    if (IN(17)) { phase_postmix<1>(F); } SEAM(17);
    if (IN(18)) { pg8::Gemm g{WSP(bf16, WS_H), WSP(bf16, WS_W1) + (size_t)DFF * DM, MP, DFF, DM, DM, DM}; pg8::MixOrder<false> S; S.init(DFF, DM, F.G, (int)blockIdx.x); pg8::EpiRelu2 E{WSP(bf16, WS_U), DFF, WSP(float, WS_PARTU)};
        pg8::gemm_phase<pg8::EpiRelu2, pg8::MixOrder<false>, true, true>(F.lds, g, S, E); } SEAM(18);
    if (IN(19)) { phase_usample(F); if (!MK_SPLIT) xcd_barrier(bar); pg8::Gemm g{WSP(bf16, WS_U), WSP(bf16, WS_W2) + (size_t)DM * DFF, MP, DM, DFF, DFF, DFF}; pg8::MixOrder<false> S; S.init(DM, DFF, F.G, (int)blockIdx.x); pg8::EpiF32S<64> E{WSP(bf16, WS_OUT), DM, nullptr, WSP(float, WS_PART)};
        pg8::gemm_phase<pg8::EpiF32S<64>, pg8::MixOrder<false>, true, true>(F.lds, g, S, E); } SEAM(19);
    if (IN(20)) { phase_postmlp<1>(F); }
#undef IN
#undef SEAM
}

extern "C" void kernel_launch(void* const* d_in, const int* in_sizes, int n_in, void* d_out, int out_size, void* d_ws, size_t ws_size, hipStream_t stream) {
    static int grid = 0;
    if (grid == 0) {
        if (n_in != N_IN || (size_t)out_size != O_END || ws_size < WS_END) { fprintf(stderr, "kernel_launch: unexpected shapes: n_in %d out %d ws %zu (want %d, %zu, >= %zu)\n", n_in, out_size, ws_size, (int)N_IN, (size_t)O_END, (size_t)WS_END); grid = -1; return; }
        int dev = 0, cus = 0, per_cu = 0;
        if (hipGetDevice(&dev) != hipSuccess || hipDeviceGetAttribute(&cus, hipDeviceAttributeMultiprocessorCount, dev) != hipSuccess) { grid = -1; return; }
        if (hipFuncSetAttribute((const void*)mega_fwd, hipFuncAttributeMaxDynamicSharedMemorySize, LDS_BYTES) != hipSuccess) { fprintf(stderr, "kernel_launch: hipFuncSetAttribute failed\n"); grid = -1; return; }
        if (hipOccupancyMaxActiveBlocksPerMultiprocessor(&per_cu, (const void*)mega_fwd, NTHR, LDS_BYTES) != hipSuccess || per_cu < 1) fprintf(stderr, "kernel_launch: occupancy query reports %d blocks per CU\n", per_cu);
        (void)hipGetLastError();
        grid = cus;
    }
    if (grid < 0) return;
    hipMemsetAsync((char*)d_ws + WS_CTL, 0, CTL_ZERO_BYTES, stream);
    Args a{};
    for (int i = 0; i < N_IN; ++i) a.in[i] = d_in[i];
    a.out = (float*)d_out; a.ws = (unsigned char*)d_ws;
#if MK_SPLIT
    for (int p = 0; p < NPHASE; ++p) { a.ph_lo = p; a.ph_hi = p + 1; hipLaunchKernelGGL(mega_fwd, dim3(grid), dim3(NTHR), LDS_BYTES, stream, a); }
#else
    a.ph_lo = 0; a.ph_hi = NPHASE;
    hipLaunchKernelGGL(mega_fwd, dim3(grid), dim3(NTHR), LDS_BYTES, stream, a);
#endif
    const hipError_t le = hipPeekAtLastError();
    if (le != hipSuccess) fprintf(stderr, "kernel_launch: launch failed: %s\n", hipGetErrorName(le));
}
```

```cpp
#include <hip/hip_runtime.h>
#include <cstdio>
#include <cstdint>
namespace pg8 {
#define PG8_LAS __attribute__((address_space(3)))
typedef unsigned short bf16_t;
typedef short bf16x8 __attribute__((ext_vector_type(8)));
typedef float f32x4 __attribute__((ext_vector_type(4)));
typedef unsigned u32x4 __attribute__((ext_vector_type(4)));
constexpr int BM = 256, BK = 64, HALF = 128, HTB = HALF * BK * 2  , STAGE_BYTES = 8 * HTB, NXCD = 8, WGM = 8;

__host__ __device__ __forceinline__ int lds_byte(int r, int c) { const int st = (r >> 4) * 2 + (c >> 5), rr = r & 15, cc = c & 31, ob = rr * 64 + cc * 2; return st * 1024 + (ob ^ (((ob >> 9) & 1) << 5)); }
__host__ __device__ __forceinline__ void stage_rc(int b, int& R, int& C) { const int st = b / 1024, sb = b % 1024, swz = sb ^ (((sb >> 9) & 1) << 5); R = (st >> 1) * 16 + swz / 64; C = (st & 1) * 32 + (swz % 64) / 2; }
__host__ __device__ __forceinline__ int perm32(int rho) { const int n = rho >> 4, i = rho & 15; return 8 * (i >> 2) + 4 * n + (i & 3); }

struct Unit { int pm, pn, kc; };
struct Gemm { const bf16_t* A; const bf16_t* Bt; int M, N, K, lda, ldb; };

struct StaticOrder {
    int nM, nN, nwg, G, c;
    __host__ __device__ void init(int M, int N, int G_, int c_) { nM = M / BM; nN = N / BM; nwg = nM * nN; G = G_; c = c_; }
    __host__ __device__ bool next(int i, Unit& u) const {
        const long L = (long)i * G + c; if (L >= nwg) return false;
        int wgid = (int)L; { const int q = nwg / NXCD, r = nwg % NXCD, xcd = wgid % NXCD, off = wgid / NXCD; wgid = (xcd < r ? xcd * (q + 1) : r * (q + 1) + (xcd - r) * q) + off; }
        const int nig = WGM * nN, gid = wgid / nig, fm = gid * WGM, gsz = (nM - fm) < WGM ? (nM - fm) : WGM;
        u.pm = fm + ((wgid % nig) % gsz); u.pn = (wgid % nig) / gsz; u.kc = -1; return true;
    }
    __device__ __forceinline__ int nt(const Unit&, const Gemm& g) const { return g.K / BK; }
    __device__ __forceinline__ void a_ready(const Unit&) const {}
    __device__ __forceinline__ void done(const Unit&) const {}
    __device__ __forceinline__ size_t a_off(const Unit& u, const Gemm& g) const { return (size_t)u.pm * BM * g.lda * 2; }
    __device__ __forceinline__ size_t b_off(const Unit& u, const Gemm& g) const { return (size_t)u.pn * BM * g.ldb * 2; }
};
struct LoraOrder : StaticOrder {
    __device__ __forceinline__ int k0(const Unit& u) const { return u.pn < 4 ? 0 : (u.pn < 8 ? 64 : 192); }
    __device__ __forceinline__ int nt(const Unit& u, const Gemm&) const { return u.pn < 8 ? 2 : 4; }
    __device__ __forceinline__ size_t a_off(const Unit& u, const Gemm& g) const { return (size_t)u.pm * BM * g.lda * 2 + (size_t)k0(u) * 2; }
    __device__ __forceinline__ size_t b_off(const Unit& u, const Gemm& g) const { return (size_t)u.pn * BM * g.ldb * 2 + (size_t)k0(u) * 2; }
};
__device__ __forceinline__ unsigned cvt_pk_bf16(float lo, float hi) { unsigned r; asm volatile("v_cvt_pk_bf16_f32 %0, %1, %2" : "=v"(r) : "v"(lo), "v"(hi)); return r; }

struct EpiF32 {
    static constexpr bool PERM = false, AFTER_DRAIN = false;
    float* C; int ldc; const float* cscale;
    __device__ __forceinline__ void operator()(const f32x4 (&acc)[2][2][4][2], const Unit& u, int wr, int wc, int fr, int fq) const {
        const int row0 = u.pm * BM + wr * 64 + fr, col0 = u.pn * BM + wc * 32 + 4 * fq;
        f32x4 sv[2][2];
#pragma unroll
        for (int bj = 0; bj < 2; ++bj)
#pragma unroll
            for (int n = 0; n < 2; ++n) sv[bj][n] = cscale ? *(const f32x4*)(cscale + col0 + bj * HALF + n * 16) : (f32x4){1.f, 1.f, 1.f, 1.f};
#pragma unroll
        for (int ai = 0; ai < 2; ++ai)
#pragma unroll
            for (int m = 0; m < 4; ++m) { float* rowp = C + (size_t)(row0 + ai * HALF + m * 16) * ldc + col0;
#pragma unroll
                for (int bj = 0; bj < 2; ++bj)
#pragma unroll
                    for (int n = 0; n < 2; ++n) *(f32x4*)(rowp + bj * HALF + n * 16) = acc[ai][bj][m][n] * sv[bj][n]; }
    }
};
typedef unsigned u32x2h __attribute__((ext_vector_type(2)));
struct EpiLora {
    static constexpr bool PERM = false, AFTER_DRAIN = false;
    float* C; bf16_t* H; int ldc;
    __device__ __forceinline__ void operator()(const f32x4 (&acc)[2][2][4][2], const Unit& u, int wr, int wc, int fr, int fq) const {
        const int row0 = u.pm * BM + wr * 64 + fr, col0 = u.pn * BM + wc * 32 + 4 * fq;
#pragma unroll
        for (int ai = 0; ai < 2; ++ai)
#pragma unroll
            for (int m = 0; m < 4; ++m) { const size_t ro = (size_t)(row0 + ai * HALF + m * 16) * ldc + col0;
#pragma unroll
                for (int bj = 0; bj < 2; ++bj)
#pragma unroll
                    for (int n = 0; n < 2; ++n) { const f32x4 v = acc[ai][bj][m][n];
                        if (u.pm < 32) { u32x2h w; w.x = cvt_pk_bf16(v[0], v[1]); w.y = cvt_pk_bf16(v[2], v[3]); *(u32x2h*)(H + ro + bj * HALF + n * 16) = w; }
                        else *(f32x4*)(C + ro + bj * HALF + n * 16) = v; } }
    }
};
struct EpiRelu2 {
    static constexpr bool PERM = true, AFTER_DRAIN = false;
    bf16_t* O; int ldc; float* PART;
    __device__ __forceinline__ void operator()(const f32x4 (&acc)[2][2][4][2], const Unit& u, int wr, int wc, int fr, int fq) const {
        const int row0 = u.pm * BM + wr * 64 + fr, col0 = u.pn * BM + wc * 32 + 8 * fq;
        if (u.kc >= 0) {
            if (wr == 0) {
#pragma unroll
                for (int m = 0; m < 4; ++m) { float* rowp = PART + ((size_t)u.kc * 64 + m * 16 + fr) * ldc + col0;
#pragma unroll
                    for (int bj = 0; bj < 2; ++bj) { *(f32x4*)(rowp + bj * HALF) = acc[0][bj][m][0]; *(f32x4*)(rowp + bj * HALF + 4) = acc[0][bj][m][1]; } } }
            return;
        }
#pragma unroll
        for (int ai = 0; ai < 2; ++ai)
#pragma unroll
            for (int m = 0; m < 4; ++m) { bf16_t* rowp = O + (size_t)(row0 + ai * HALF + m * 16) * ldc + col0;
#pragma unroll
                for (int bj = 0; bj < 2; ++bj) { f32x4 v0 = acc[ai][bj][m][0], v1 = acc[ai][bj][m][1];
#pragma unroll
                    for (int j = 0; j < 4; ++j) { const float a = v0[j] > 0.f ? v0[j] : 0.f, b = v1[j] > 0.f ? v1[j] : 0.f; v0[j] = a * a; v1[j] = b * b; }
                    u32x4 w; w.x = cvt_pk_bf16(v0[0], v0[1]); w.y = cvt_pk_bf16(v0[2], v0[3]); w.z = cvt_pk_bf16(v1[0], v1[1]); w.w = cvt_pk_bf16(v1[2], v1[3]);
                    *(u32x4*)(rowp + bj * HALF) = w; } }
    }
};
template <bool POOL> struct MixOrder {
    StaticOrder so; int nmain, nN, kdiv, ntot, G, c;
    __device__ void init(int N, int K, int G_, int c_) { nN = N / BM; so.init(32 * BM, N, G_, c_); nmain = 32 * nN; kdiv = (POOL ? 512 : K) / 256; ntot = nmain + nN * kdiv; G = G_; c = c_; }
    __device__ bool next(int i, Unit& u) const {
        const int L = i * G + c; if (L >= ntot) return false;
        if (L < nmain) return so.next(i, u);
        const int j = L - nmain; u.pm = 32; u.pn = j % nN; u.kc = j / nN; return true;
    }
    __device__ __forceinline__ int nt(const Unit& u, const Gemm& g) const { return u.kc >= 0 ? 4 : (POOL ? 8 : g.K / BK); }
    __device__ __forceinline__ size_t a_off(const Unit& u, const Gemm& g) const { return (size_t)u.pm * BM * g.lda * 2 + (size_t)((POOL ? (u.pn >> 1) * 512 : 0) + (u.kc >= 0 ? u.kc * 256 : 0)) * 2; }
    __device__ __forceinline__ size_t b_off(const Unit& u, const Gemm& g) const { return (size_t)u.pn * BM * g.ldb * 2 + (size_t)((POOL ? (u.pn >> 1) * 512 : 0) + (u.kc >= 0 ? u.kc * 256 : 0)) * 2; }
    __device__ __forceinline__ void a_ready(const Unit&) const {}
    __device__ __forceinline__ void done(const Unit&) const {}
};
template <int PROW> struct EpiF32S {
    static constexpr bool PERM = false, AFTER_DRAIN = false;
    bf16_t* C; int ldc; const float* cscale; float* PART;
    __device__ __forceinline__ f32x4 scl(int c) const { return cscale ? *(const f32x4*)(cscale + c) : (f32x4){1.f, 1.f, 1.f, 1.f}; }
    __device__ __forceinline__ void operator()(const f32x4 (&acc)[2][2][4][2], const Unit& u, int wr, int wc, int fr, int fq) const {
        asm volatile("" : "+v"(fr), "+v"(fq));
        const int col0 = u.pn * BM + wc * 32 + 4 * fq;
        if (u.kc < 0) {
            bf16_t* Ct = C + (size_t)u.pm * BM * ldc; const unsigned e0 = (unsigned)((wr * 64 + fr) * ldc + col0);
#pragma unroll
            for (int bj = 0; bj < 2; ++bj)
#pragma unroll
                for (int n = 0; n < 2; ++n) { const f32x4 sv = scl(col0 + bj * HALF + n * 16);
#pragma unroll
                    for (int ai = 0; ai < 2; ++ai)
#pragma unroll
                        for (int m = 0; m < 4; ++m) { const f32x4 v = acc[ai][bj][m][n] * sv; const unsigned w0 = cvt_pk_bf16(v[0], v[1]), w1 = cvt_pk_bf16(v[2], v[3]);
                            *(unsigned long long*)(Ct + e0 + (unsigned)((ai * HALF + m * 16) * ldc) + bj * HALF + n * 16) = (unsigned long long)w0 | ((unsigned long long)w1 << 32); } }
        } else if (PROW == 256) {
            float* Pk = PART + (size_t)u.kc * 256 * ldc; const unsigned e0 = (unsigned)((wr * 64 + fr) * ldc + col0);
#pragma unroll
            for (int bj = 0; bj < 2; ++bj)
#pragma unroll
                for (int n = 0; n < 2; ++n) { const f32x4 sv = scl(col0 + bj * HALF + n * 16);
#pragma unroll
                    for (int ai = 0; ai < 2; ++ai)
#pragma unroll
                        for (int m = 0; m < 4; ++m) *(f32x4*)(Pk + e0 + (unsigned)((ai * HALF + m * 16) * ldc) + bj * HALF + n * 16) = acc[ai][bj][m][n] * sv; }
        } else if (wr == 0) {
            float* Pk = PART + (size_t)u.kc * 64 * ldc; const unsigned e0 = (unsigned)(fr * ldc + col0);
#pragma unroll
            for (int bj = 0; bj < 2; ++bj)
#pragma unroll
                for (int n = 0; n < 2; ++n) { const f32x4 sv = scl(col0 + bj * HALF + n * 16);
#pragma unroll
                    for (int m = 0; m < 4; ++m) *(f32x4*)(Pk + e0 + (unsigned)(m * 16 * ldc) + bj * HALF + n * 16) = acc[0][bj][m][n] * sv; }
        }
    }
};
template <class Epi, class Sched, bool ALIGN_EPI = false, bool SP2 = false>
__device__ __forceinline__ void gemm_phase(PG8_LAS unsigned char* lds, const Gemm g, const Sched& S, const Epi& E) {
    const int tid = threadIdx.x, wid = __builtin_amdgcn_readfirstlane(tid >> 6), lane = tid & 63, wr = wid >> 2, wc = wid & 3, fr = lane & 15, fq = lane >> 4;
    unsigned voffA[2], voffB[2];
#pragma unroll
    for (int i = 0; i < 2; ++i) { int R, C; stage_rc(tid * 16 + i * 8192, R, C); const int Rb = Epi::PERM ? ((R & ~31) + perm32(R & 31)) : R;
        voffA[i] = (unsigned)(R * g.lda + C) * 2u; voffB[i] = (unsigned)(Rb * g.ldb + C) * 2u; }
    const size_t kstep = (size_t)(BK * 2);
    const size_t hsA = (size_t)HALF * g.lda * 2, hsB = (size_t)HALF * g.ldb * 2;
    const unsigned ldsw = (unsigned)wid * 1024u;
    const int aoff = lds_byte(wr * 64 + fr, fq * 8), boff = lds_byte(wc * 32 + fr, fq * 8);
#define PG8_SA(b, h) (((b) * 2 + (h)) * HTB)
#define PG8_SB(b, h) ((4 + (b) * 2 + (h)) * HTB)
#define PG8_STAGE(bufoff, gbase, voff) do { _Pragma("unroll") for (int _i = 0; _i < 2; ++_i) \
        __builtin_amdgcn_global_load_lds((const unsigned*)((const char*)(gbase) + (voff)[_i]), (PG8_LAS unsigned*)(lds + (bufoff) + ldsw + _i * 8192), 16, 0, 0); } while (0)
#define PG8_LDA(dst, b, h) do { _Pragma("unroll") for (int m = 0; m < 4; ++m) _Pragma("unroll") for (int k = 0; k < 2; ++k) dst[m][k] = *(const PG8_LAS bf16x8*)(lds + PG8_SA(b, h) + aoff + m * 2048 + k * 1024); } while (0)
#define PG8_LDB(dst, b, h) do { _Pragma("unroll") for (int n = 0; n < 2; ++n) _Pragma("unroll") for (int k = 0; k < 2; ++k) dst[n][k] = *(const PG8_LAS bf16x8*)(lds + PG8_SB(b, h) + boff + n * 2048 + k * 1024); } while (0)
#define PG8_MMA(ai, bj, At, Bt) do { __builtin_amdgcn_s_setprio(1); _Pragma("unroll") for (int m = 0; m < 4; ++m) _Pragma("unroll") for (int n = 0; n < 2; ++n) _Pragma("unroll") for (int k = 0; k < 2; ++k) \
        acc[ai][bj][m][n] = __builtin_amdgcn_mfma_f32_16x16x32_bf16(Bt[n][k], At[m][k], acc[ai][bj][m][n], 0, 0, 0); __builtin_amdgcn_s_setprio(0); } while (0)
#define PG8_WAIT_V(n) asm volatile("s_waitcnt vmcnt(" #n ")" ::: "memory")
#define PG8_WAIT_L(n) asm volatile("s_waitcnt lgkmcnt(" #n ")" ::: "memory")
#define PG8_BAR __builtin_amdgcn_s_barrier()
#define PG8_SCHED __builtin_amdgcn_sched_barrier(0)
    Unit cur, nxt; int ui = 0;
    if (!S.next(0, cur)) return;
    int nt = S.nt(cur, g);
    f32x4 acc[2][2][4][2];
#pragma unroll
    for (int a = 0; a < 2; ++a)
#pragma unroll
        for (int b = 0; b < 2; ++b)
#pragma unroll
            for (int m = 0; m < 4; ++m)
#pragma unroll
                for (int n = 0; n < 2; ++n) acc[a][b][m][n] = (f32x4){0.f, 0.f, 0.f, 0.f};
    bf16x8 At[4][2], B0[2][2], B1[2][2];
    const char* cA = (const char*)g.A + S.a_off(cur, g); const char* cB = (const char*)g.Bt + S.b_off(cur, g);
    S.a_ready(cur);
    if constexpr (SP2) {
        PG8_STAGE(PG8_SB(0, 0), cB, voffB); PG8_STAGE(PG8_SB(0, 1), cB + hsB, voffB); PG8_STAGE(PG8_SA(0, 0), cA, voffA); PG8_STAGE(PG8_SA(0, 1), cA + hsA, voffA);
        if (wr == 1) PG8_BAR;
        PG8_WAIT_V(2); PG8_BAR;
        PG8_STAGE(PG8_SB(1, 0), cB + kstep, voffB); PG8_STAGE(PG8_SA(1, 0), cA + kstep, voffA); PG8_STAGE(PG8_SB(1, 1), cB + hsB + kstep, voffB);
        PG8_WAIT_V(6); PG8_BAR;
    } else {
        PG8_STAGE(PG8_SB(0, 0), cB, voffB); PG8_STAGE(PG8_SA(0, 0), cA, voffA); PG8_STAGE(PG8_SB(0, 1), cB + hsB, voffB); PG8_STAGE(PG8_SA(0, 1), cA + hsA, voffA);
        if (wr == 1) PG8_BAR;
        PG8_WAIT_V(4); PG8_BAR;
        PG8_STAGE(PG8_SB(1, 0), cB + kstep, voffB); PG8_STAGE(PG8_SA(1, 0), cA + kstep, voffA); PG8_STAGE(PG8_SB(1, 1), cB + hsB + kstep, voffB);
        PG8_WAIT_V(6); PG8_BAR;
    }
    for (;;) {
        const bool has_next = S.next(ui + 1, nxt);
        const char* nA = has_next ? (const char*)g.A + S.a_off(nxt, g) : cA; const char* nB = has_next ? (const char*)g.Bt + S.b_off(nxt, g) : cB;
        for (int t = 0; t < nt; t += 2) {
            const bool last = (t == nt - 2);
            const char* a1 = cA + (size_t)(t + 1) * kstep;
            const char* a2 = last ? nA : cA + (size_t)(t + 2) * kstep; const char* b2 = last ? nB : cB + (size_t)(t + 2) * kstep;
            const char* a3 = a2 + kstep; const char* b3 = b2 + kstep;
            if (last && has_next) S.a_ready(nxt);
            if constexpr (SP2) {
            PG8_LDB(B0, 0, 0); PG8_LDB(B1, 0, 1); PG8_SCHED; PG8_LDA(At, 0, 0); PG8_STAGE(PG8_SA(1, 1), a1 + hsA, voffA);
            PG8_WAIT_V(8); PG8_WAIT_L(0); PG8_BAR; PG8_MMA(0, 0, At, B0); PG8_MMA(0, 1, At, B1); PG8_BAR; PG8_SCHED;
            PG8_LDA(At, 0, 1); PG8_STAGE(PG8_SB(0, 0), b2, voffB); PG8_STAGE(PG8_SB(0, 1), b2 + hsB, voffB); PG8_STAGE(PG8_SA(0, 0), a2, voffA);
            PG8_WAIT_V(8); PG8_WAIT_L(0); PG8_BAR; PG8_MMA(1, 0, At, B0); PG8_MMA(1, 1, At, B1); PG8_BAR; PG8_SCHED;
            PG8_LDB(B0, 1, 0); PG8_LDB(B1, 1, 1); PG8_SCHED; PG8_LDA(At, 1, 0); PG8_STAGE(PG8_SA(0, 1), a2 + hsA, voffA);
            PG8_WAIT_V(8); PG8_WAIT_L(0); PG8_BAR; PG8_MMA(0, 0, At, B0); PG8_MMA(0, 1, At, B1); PG8_BAR; PG8_SCHED;
            PG8_LDA(At, 1, 1); PG8_STAGE(PG8_SB(1, 0), b3, voffB); PG8_STAGE(PG8_SB(1, 1), b3 + hsB, voffB); PG8_STAGE(PG8_SA(1, 0), a3, voffA);
            PG8_WAIT_V(8); PG8_WAIT_L(0); PG8_BAR; PG8_MMA(1, 0, At, B0); PG8_MMA(1, 1, At, B1); PG8_BAR; PG8_SCHED;
            } else {
            PG8_LDB(B0, 0, 0); PG8_SCHED; PG8_LDA(At, 0, 0); PG8_STAGE(PG8_SA(1, 1), a1 + hsA, voffA);
            PG8_WAIT_L(8); PG8_BAR; PG8_WAIT_L(0); PG8_MMA(0, 0, At, B0); PG8_BAR; PG8_SCHED;
            PG8_LDB(B1, 0, 1); PG8_STAGE(PG8_SB(0, 0), b2, voffB);
            PG8_BAR; PG8_WAIT_L(0); PG8_MMA(0, 1, At, B1); PG8_BAR;
            PG8_LDA(At, 0, 1); PG8_STAGE(PG8_SA(0, 0), a2, voffA);
            PG8_BAR; PG8_WAIT_L(0); PG8_MMA(1, 0, At, B0); PG8_BAR; PG8_SCHED;
            PG8_STAGE(PG8_SB(0, 1), b2 + hsB, voffB);
            PG8_WAIT_V(6); PG8_BAR; PG8_MMA(1, 1, At, B1); PG8_BAR;
            PG8_LDB(B0, 1, 0); PG8_SCHED; PG8_LDA(At, 1, 0); PG8_STAGE(PG8_SA(0, 1), a2 + hsA, voffA);
            PG8_WAIT_L(8); PG8_BAR; PG8_WAIT_L(0); PG8_MMA(0, 0, At, B0); PG8_BAR; PG8_SCHED;
            PG8_LDB(B1, 1, 1); PG8_STAGE(PG8_SB(1, 0), b3, voffB);
            PG8_BAR; PG8_WAIT_L(0); PG8_MMA(0, 1, At, B1); PG8_BAR;
            PG8_LDA(At, 1, 1); PG8_STAGE(PG8_SA(1, 0), a3, voffA);
            PG8_BAR; PG8_WAIT_L(0); PG8_MMA(1, 0, At, B0); PG8_BAR; PG8_SCHED;
            PG8_STAGE(PG8_SB(1, 1), b3 + hsB, voffB);
            PG8_WAIT_V(6); PG8_BAR; PG8_MMA(1, 1, At, B1); PG8_BAR;
            }
        }
        if constexpr (ALIGN_EPI) { if (wr == 0) PG8_BAR; }
        if constexpr (!Epi::AFTER_DRAIN) { E(acc, cur, wr, wc, fr, fq); S.done(cur); }
        if (!has_next) break;
#pragma unroll
        for (int a = 0; a < 2; ++a)
#pragma unroll
            for (int b = 0; b < 2; ++b)
#pragma unroll
                for (int m = 0; m < 4; ++m)
#pragma unroll
                    for (int n = 0; n < 2; ++n) acc[a][b][m][n] = (f32x4){0.f, 0.f, 0.f, 0.f};
        cur = nxt; cA = nA; cB = nB; ++ui; nt = S.nt(cur, g);
        if constexpr (ALIGN_EPI) { if (wr == 1) PG8_BAR; }
    }
    PG8_WAIT_V(0);
    if constexpr (!ALIGN_EPI) { if (wr == 0) PG8_BAR; }
    PG8_BAR;
    if constexpr (Epi::AFTER_DRAIN) { E.fused(acc, cur, wr, wc, fr, fq, lds, wid, lane); S.done(cur); }
#undef PG8_SA
#undef PG8_SB
#undef PG8_STAGE
#undef PG8_LDA
#undef PG8_LDB
#undef PG8_MMA
#undef PG8_WAIT_V
#undef PG8_WAIT_L
#undef PG8_BAR
#undef PG8_SCHED
}
}

constexpr int DM = 2048, SEQ = 4096, NBATCH = 2, NPR = NBATCH * SEQ, DBAT = 8, DSEQ = 8, NSM = DBAT * DSEQ, NTOK = NPR + NSM, MP = 8448;
constexpr int HA = 8, DHA = 128, HB = 16, DHB = 64, DBR = 1024;
constexpr int BCOLS = 3520, INCOLS = 6592, INPAD = 6656, DFF = 8192, NPAGES = 128, PAGESZ = 128, PAST = 16384, PBUF = 15, NMR = 10;
constexpr float EPS_RMS = 1e-6f, EPS_LNX = 64e-5f, QK_SCALE = 0.08838834764831845f;
enum { I_XP = 0, I_XS, I_CK, I_CV, I_PT, I_SWKV, I_SSH, I_SPOOL, I_CP, I_CS, I_WADA, I_BADA, I_NG, I_WIN, I_WOUT, I_SBB, I_MU, I_W0, I_WUP, I_A0, I_AUP, I_GUP, I_KK, I_KA, I_RK, I_LNG, I_LNB, I_WPOOL, I_PSC, I_W1, I_W2, N_IN };
constexpr size_t O_YP = 0, O_YS = O_YP + (size_t)NPR * DM, O_KP = O_YS + (size_t)NSM * DM, O_VP = O_KP + (size_t)NPR * 1024, O_KS = O_VP + (size_t)NPR * 1024, O_VS = O_KS + (size_t)NSM * 1024,
                 O_WKVP = O_VS + (size_t)NSM * 1024, O_WKVS = O_WKVP + (size_t)NBATCH * HB * 64 * 64, O_SHP = O_WKVS + (size_t)DBAT * HB * 64 * 64, O_SHS = O_SHP + (size_t)NBATCH * BCOLS,
                 O_PLP = O_SHS + (size_t)DBAT * BCOLS, O_PLS = O_PLP + (size_t)NBATCH * PBUF * DM, O_END = O_PLS + (size_t)DBAT * PBUF * DM;
constexpr size_t MiB = 1u << 20;
constexpr size_t WS_CTL = 0, CTL_ZERO_BYTES = 64 * 1024, WS_MOD = 1 * MiB, WS_WIN = 2 * MiB, WS_WOUT = 28 * MiB, WS_W1 = 36 * MiB, WS_W2 = 100 * MiB, WS_WPOOL = 164 * MiB,
                 WS_H = 172 * MiB, WS_OAB = 205 * MiB, WS_M = 238 * MiB, WS_P = 271 * MiB, WS_OUT = 486 * MiB, WS_XR = 552 * MiB, WS_HF = 617 * MiB, WS_U = 682 * MiB,
                 WS_RWV = 814 * MiB, WS_SCL = 1072 * MiB, WS_G = 1075 * MiB, WS_Y = 1108 * MiB, WS_PU = 1141 * MiB, WS_Z = 1205 * MiB, WS_SC = 1237 * MiB, WS_QB = 1269 * MiB, WS_KB = 1286 * MiB, WS_VB = 1303 * MiB, WS_OP = 1320 * MiB, WS_CL = 1384 * MiB, WS_SPART = 1385 * MiB, WS_SCAR = 1394 * MiB, WS_LA = 1395 * MiB, WS_LWT = 1404 * MiB, WS_LWO = 1408 * MiB, WS_YC = 1508 * MiB, WS_PART = 1541 * MiB, WS_PARTU = 1558 * MiB, WS_END = 1575 * MiB;
static_assert(WS_WIN + (size_t)INPAD * DM * 2 <= WS_WOUT && WS_P + (size_t)MP * INPAD * 4 <= WS_OUT && WS_U + (size_t)MP * DFF * 2 <= WS_RWV && WS_RWV + (size_t)NTOK * HB * 512 * 4 <= WS_SCL, "ws map");
constexpr int CW_BAR = 4096;
constexpr int RING_BYTES = 131072, LDSCTL_OFF = RING_BYTES, MISC_OFF = LDSCTL_OFF + 320, LDS_BYTES = 147456;
constexpr int NWAVES = 8, NTHR = 512;

#define GAS __attribute__((address_space(1)))
#define LAS __attribute__((address_space(3)))
typedef unsigned short bf16;
__device__ __forceinline__ float ldbf(const bf16* p) { return __uint_as_float((unsigned)*p << 16); }
__device__ __forceinline__ float ldbf_nt(const bf16* p) { return __uint_as_float((unsigned)__builtin_nontemporal_load(p) << 16); }
typedef float f32x4 __attribute__((ext_vector_type(4)));
typedef float f32x2 __attribute__((ext_vector_type(2)));
typedef unsigned u32x2 __attribute__((ext_vector_type(2)));
typedef unsigned u32x4 __attribute__((ext_vector_type(4)));
#define LDS_WAIT() asm volatile("s_waitcnt lgkmcnt(0)" ::: "memory")
#define VM_WAIT() asm volatile("s_waitcnt vmcnt(0)" ::: "memory")
using pg8::cvt_pk_bf16;
constexpr size_t WS_PBH = WS_RWV, WS_LWH = WS_RWV + 64 * MiB;
static_assert((size_t)NPR * 3072 * 2 <= 64 * MiB && 128 * MiB <= (size_t)NPR * HB * 512 * 4, "bf16 prompt copies fit below the sample rows of RWV");
constexpr int PBLD = 3584;
struct EpiIn {
    static constexpr bool PERM = false, AFTER_DRAIN = false;
    bf16 *QB, *KB, *VB; float* PB; float* out; bf16* PBH;
    __device__ __forceinline__ void operator()(const pg8::f32x4 (&acc)[2][2][4][2], const pg8::Unit& u, int wr, int wc, int fr, int fq) const {
        const int row0 = u.pm * 256 + wr * 64 + fr, colt = u.pn * 256 + wc * 32 + 4 * fq;
        if (u.pn >= 12) {
#pragma unroll
            for (int ai = 0; ai < 2; ++ai)
#pragma unroll
                for (int m = 0; m < 4; ++m) {
                    if (u.pm < 32 && u.pn < 24) { bf16* rowh = PBH + (size_t)(row0 + ai * 128 + m * 16) * 3072 + (colt - 3072);
#pragma unroll
                        for (int bj = 0; bj < 2; ++bj)
#pragma unroll
                            for (int n = 0; n < 2; ++n) { const pg8::f32x4 v = acc[ai][bj][m][n]; u32x2 w; w.x = cvt_pk_bf16(v[0], v[1]); w.y = cvt_pk_bf16(v[2], v[3]); *(u32x2*)(rowh + bj * 128 + n * 16) = w; } }
                    else { float* rowp = PB + (size_t)(row0 + ai * 128 + m * 16) * PBLD + (colt - 3072);
#pragma unroll
                        for (int bj = 0; bj < 2; ++bj)
#pragma unroll
                            for (int n = 0; n < 2; ++n) *(pg8::f32x4*)(rowp + bj * 128 + n * 16) = acc[ai][bj][m][n]; } }
        } else {
            const int sel = u.pn >> 2, c0 = colt - sel * 1024;
            static_assert(WS_KB - WS_QB == WS_VB - WS_KB && O_VP - O_KP == (size_t)NPR * 1024 && O_VS - O_KS == (size_t)NSM * 1024, "q/k/v buffers are equally spaced");
            bf16* Bt = QB + (size_t)sel * ((WS_KB - WS_QB) / 2) + (size_t)u.pm * 256 * 1024;
            float* Ot = u.pm < 32 ? out + O_KP + (size_t)(sel ? sel - 1 : 0) * NPR * 1024 + (size_t)u.pm * 256 * 1024 : out + O_KS + (size_t)(sel ? sel - 1 : 0) * NSM * 1024;
            const int rl0 = wr * 64 + fr;
#pragma unroll
            for (int ai = 0; ai < 2; ++ai)
#pragma unroll
                for (int m = 0; m < 4; ++m) { const int rl = rl0 + ai * 128 + m * 16; const unsigned eo = (unsigned)(rl * 1024 + c0);
                    const bool wo = sel != 0 && (u.pm < 32 || rl < NSM);
#pragma unroll
                    for (int bj = 0; bj < 2; ++bj)
#pragma unroll
                        for (int n = 0; n < 2; ++n) { const pg8::f32x4 v = acc[ai][bj][m][n]; u32x2 w; w.x = cvt_pk_bf16(v[0], v[1]); w.y = cvt_pk_bf16(v[2], v[3]);
                            *(u32x2*)(Bt + eo + bj * 128 + n * 16) = w; if (wo) *(pg8::f32x4*)(Ot + eo + bj * 128 + n * 16) = v; }
                    asm volatile("" ::: "memory"); }
        }
    }
};

#define XB_TMO      128
#define XB_XCNT(j)  (256  + 64 * (j))
#define XB_XSUB(j)  (1280 + 64 * (j))
#define XB_XGEN(j)  (2304 + 64 * (j))
#define XB_TOP      3328
#define XB_TOPGEN   3392
#define XCD_BAR_WORDS 3456
#define XB_SPIN_CAP (1u << 18)

__device__ __forceinline__ unsigned xb_ld(unsigned* p)              { return __hip_atomic_load(p, __ATOMIC_RELAXED, __HIP_MEMORY_SCOPE_AGENT); }
__device__ __forceinline__ unsigned xb_add(unsigned* p, unsigned v) { return __hip_atomic_fetch_add(p, v, __ATOMIC_RELAXED, __HIP_MEMORY_SCOPE_AGENT); }
__device__ __forceinline__ unsigned xb_xcc_id() { return (unsigned)__builtin_amdgcn_s_getreg((3 << 11) | 20) & 0xFu; }
#define XB_SPIN(cond, bar) do { unsigned _sp = 0; while (cond) { __builtin_amdgcn_s_sleep(1); \
    if ((++_sp & 255u) == 0u) { if (xb_ld(&(bar)[XB_TMO])) break; if (_sp > XB_SPIN_CAP) { atomicAdd(&(bar)[XB_TMO], 1u); break; } } } } while (0)

struct XcdBarrier {
    unsigned* bar; unsigned x;
    volatile LAS unsigned* st;
};

__device__ __forceinline__ XcdBarrier xcd_barrier_post(unsigned* bar, volatile LAS unsigned* st) {
    XcdBarrier b; b.bar = bar; b.x = xb_xcc_id(); b.st = st;
    if (threadIdx.x == 0) (void)xb_add(&bar[XB_XCNT(b.x)], 1u);
    return b;
}
__device__ __forceinline__ void xcd_barrier_complete(unsigned* bar, unsigned x, unsigned& nloc, unsigned& nx) {
    const unsigned G = gridDim.x * gridDim.y * gridDim.z;
    unsigned sum, cnt, mine, sp = 0u;
    for (;;) {
        sum = 0u; cnt = 0u; mine = 0u;
#pragma unroll
        for (unsigned j = 0; j < 16; ++j) { const unsigned c = xb_ld(&bar[XB_XCNT(j)]); sum += c; cnt += (c > 0u) ? 1u : 0u; mine = (j == x) ? c : mine; }
        if (sum == G) break;
        __builtin_amdgcn_s_sleep(1);
        if ((++sp & 255u) == 0u) { if (xb_ld(&bar[XB_TMO])) break; if (sp > XB_SPIN_CAP) { atomicAdd(&bar[XB_TMO], 1u); break; } }
    }
    nloc = mine > 0u ? mine : 1u; nx = cnt > 0u ? cnt : 1u;
}

__device__ __forceinline__ void xcd_barrier(const XcdBarrier& b) {
    asm volatile("s_waitcnt vmcnt(0)" ::: "memory");
    __syncthreads();
    if (threadIdx.x == 0) {
        unsigned* bar = b.bar;
        __builtin_amdgcn_s_waitcnt(0);
        unsigned nloc = b.st[0], nx = b.st[1];
        if (nloc == 0u) { xcd_barrier_complete(bar, b.x, nloc, nx); b.st[0] = nloc; b.st[1] = nx; }
        const unsigned old = xb_add(&bar[XB_XSUB(b.x)], 1u);
        const unsigned gen = old / nloc;
        if (old + 1u == (gen + 1u) * nloc) {
            __builtin_amdgcn_fence(__ATOMIC_RELEASE, "agent");
            asm volatile("s_waitcnt vmcnt(0)" ::: "memory");
            const unsigned og = xb_add(&bar[XB_TOP], 1u);
            const unsigned tg = og / nx;
            if (og + 1u == (tg + 1u) * nx) xb_add(&bar[XB_TOPGEN], 1u);
            else XB_SPIN(xb_ld(&bar[XB_TOPGEN]) == tg, bar);
            __builtin_amdgcn_fence(__ATOMIC_ACQUIRE, "agent");
            xb_add(&bar[XB_XGEN(b.x)], 1u);
            asm volatile("s_waitcnt vmcnt(0)" ::: "memory");
        } else {
            XB_SPIN(xb_ld(&bar[XB_XGEN(b.x)]) == gen, bar);
            __builtin_amdgcn_fence(__ATOMIC_ACQUIRE, "agent");
            asm volatile("s_waitcnt vmcnt(0)" ::: "memory");
        }
    }
    __syncthreads();
}


struct Ctx {
    LAS unsigned char* lds; int tid, lane, wave, vcu, G;
    __device__ __forceinline__ const float* in(int i) const { return ((const float* const __attribute__((address_space(4)))*)__builtin_amdgcn_kernarg_segment_ptr())[i]; }
    __device__ __forceinline__ float* outp() const { return ((float* const __attribute__((address_space(4)))*)__builtin_amdgcn_kernarg_segment_ptr())[N_IN]; }
    __device__ __forceinline__ unsigned char* wsp() const { return ((unsigned char* const __attribute__((address_space(4)))*)__builtin_amdgcn_kernarg_segment_ptr())[N_IN + 1]; }
};
template <int CTRL> __device__ __forceinline__ float dpp_f(float x) { return __builtin_bit_cast(float, __builtin_amdgcn_mov_dpp(__builtin_bit_cast(int, x), CTRL, 0xf, 0xf, true)); }
#define readlane_f(x, l) __builtin_bit_cast(float, __builtin_amdgcn_readlane(__builtin_bit_cast(int, (float)(x)), (l)))
__device__ __forceinline__ float wave_sum(float v) {
    v += dpp_f<0xB1>(v); v += dpp_f<0x4E>(v); v += dpp_f<0x141>(v); v += dpp_f<0x140>(v);
    auto s = __builtin_amdgcn_permlane16_swap(__float_as_uint(v), __float_as_uint(v), false, false);
    v = __uint_as_float(s[0]) + __uint_as_float(s[1]);
    auto t = __builtin_amdgcn_permlane32_swap(__float_as_uint(v), __float_as_uint(v), false, false);
    return __uint_as_float(t[0]) + __uint_as_float(t[1]);
}
__device__ __forceinline__ float sigmoidf_(float x) { return 1.f / (1.f + __expf(-x)); }
__device__ __forceinline__ float softplusf_(float x) { return fmaxf(x, 0.f) + log1pf(__expf(-fabsf(x))); }
__device__ __forceinline__ int mod_row(int r) { return r < NPR ? (r >> 12) : 2 + ((r - NPR) >> 3); }
#define WSP(T, off) ((T*)(F.wsp() + (off)))

struct CvtItem { const float* W; bf16* WT; int ldw, ldt, k0, n0; };
__device__ __forceinline__ void item_load(float (&tv)[32], const CvtItem& d, int lane) {
#pragma unroll
    for (int i = 0; i < 32; ++i) tv[i] = __builtin_nontemporal_load(d.W + (size_t)(d.k0 + 2 * i + (lane >> 5)) * d.ldw + d.n0 + (lane & 31));
}
__device__ __forceinline__ void item_store(const float (&tv)[32], const CvtItem& d, LAS float* scr, int lane) {
#pragma unroll
    for (int i = 0; i < 32; ++i) scr[(2 * i + (lane >> 5)) * 33 + (lane & 31)] = tv[i];
    LDS_WAIT(); asm volatile("" ::: "memory");
    const int c = lane & 7;
#pragma unroll
    for (int j = 0; j < 4; ++j) { const int n = (lane >> 3) + 8 * j; const LAS float* s = scr + (8 * c) * 33 + n;
        u32x4 o; o.x = cvt_pk_bf16(s[0 * 33], s[1 * 33]); o.y = cvt_pk_bf16(s[2 * 33], s[3 * 33]); o.z = cvt_pk_bf16(s[4 * 33], s[5 * 33]); o.w = cvt_pk_bf16(s[6 * 33], s[7 * 33]);
        *(GAS u32x4*)(d.WT + (size_t)(d.n0 + n) * d.ldt + d.k0 + 8 * c) = o; }
    LDS_WAIT(); asm volatile("" ::: "memory");
}
constexpr int IT_IN = 32 * 206, IT_OUT = 32 * 64, IT_W1 = 32 * 256, IT_W2 = 128 * 64, IT_PL = 8 * 16, NIT_ALL = IT_IN + IT_OUT + 2 * IT_W1 + 2 * IT_W2 + 4 * IT_PL;
__device__ __forceinline__ CvtItem item_decode(Ctx& F, int it) {
    int r = it; CvtItem d; int N;
    if (r < IT_IN) { d.W = F.in(I_WIN); d.WT = WSP(bf16, WS_WIN); N = INCOLS; d.ldt = DM; }
    else if ((r -= IT_IN) < IT_OUT) { d.W = F.in(I_WOUT); d.WT = WSP(bf16, WS_WOUT); N = DM; d.ldt = DM; }
    else if ((r -= IT_OUT) < 2 * IT_W1) { const int l = r / IT_W1; r -= l * IT_W1; d.W = F.in(I_W1) + (size_t)l * DM * DFF; d.WT = WSP(bf16, WS_W1) + (size_t)l * DFF * DM; N = DFF; d.ldt = DM; }
    else if ((r -= 2 * IT_W1) < 2 * IT_W2) { const int l = r / IT_W2; r -= l * IT_W2; d.W = F.in(I_W2) + (size_t)l * DFF * DM; d.WT = WSP(bf16, WS_W2) + (size_t)l * DM * DFF; N = DM; d.ldt = DFF; }
    else { r -= 2 * IT_W2; const int g = r / IT_PL; r -= g * IT_PL; d.W = F.in(I_WPOOL) + (size_t)g * 512 * 512; d.WT = WSP(bf16, WS_WPOOL) + (size_t)(g * 512) * DM + g * 512; N = 512; d.ldt = DM; }
    const int nblk = N / 32, kb = r / nblk, nb = r - kb * nblk;
    d.ldw = N; d.k0 = 64 * kb; d.n0 = 32 * nb; return d;
}
__device__ __forceinline__ void convert_run(Ctx& F, int first, int stride, int lim, LAS float* scr) {
    int it = first; if (it >= lim) return;
    float ta[32], tb[32]; CvtItem da = item_decode(F, it), db = da; item_load(ta, da, F.lane);
    for (;;) {
        const int i2 = it + stride; const bool h2 = i2 < lim; if (h2) { db = item_decode(F, i2); item_load(tb, db, F.lane); }
        item_store(ta, da, scr, F.lane); if (!h2) break;
        const int i3 = i2 + stride; const bool h3 = i3 < lim; if (h3) { da = item_decode(F, i3); item_load(ta, da, F.lane); }
        item_store(tb, db, scr, F.lane); if (!h3) break;
        it = i3; }
}
constexpr int NCVT = 40, N_HIDE = 24000;
__device__ __forceinline__ void phase_prologue(Ctx& F) {
    LAS float* scr = (LAS float*)(F.lds + F.wave * 16384);
    const int gw = F.vcu * NWAVES + F.wave, NGW = F.G * NWAVES;
    convert_run(F, gw, NGW, IT_IN, scr);
    if (F.G > NCVT + 8) convert_run(F, IT_IN + N_HIDE + gw, NGW, NIT_ALL, scr); else convert_run(F, IT_IN + gw, NGW, NIT_ALL, scr);
    for (int i = F.vcu * NTHR + F.tid; i < 3072 * 64; i += F.G * NTHR) {
        const int kc = i / 3072, n = i - kc * 3072, reg = n >> 10, nn = n & 1023;
        float v[8];
        if (reg == 0) {
#pragma unroll
            for (int j = 0; j < 8; ++j) { const int k = 8 * kc + j; v[j] = (k < 96) ? F.in(I_WUP)[(size_t)k * 1024 + nn] : 0.f; } }
        else if (reg == 1) {
#pragma unroll
            for (int j = 0; j < 8; ++j) { const int k = 8 * kc + j - 96; v[j] = (k >= 0 && k < 96) ? F.in(I_AUP)[(size_t)k * 1024 + nn] : 0.f; } }
        else {
#pragma unroll
            for (int j = 0; j < 8; ++j) { const int k = 8 * kc + j - 192; v[j] = (k >= 0 && k < 256) ? F.in(I_GUP)[(size_t)k * 1024 + nn] : 0.f; } }
        u32x4 o; o.x = cvt_pk_bf16(v[0], v[1]); o.y = cvt_pk_bf16(v[2], v[3]); o.z = cvt_pk_bf16(v[4], v[5]); o.w = cvt_pk_bf16(v[6], v[7]);
        *(GAS u32x4*)(WSP(bf16, WS_LWT) + (size_t)n * 512 + 8 * kc) = o;
    }
    __syncthreads();
    LAS float* scs = (LAS float*)F.lds;
    LAS float* part = (LAS float*)(F.lds + 16384);
    float* PARTM = WSP(float, WS_G);
    for (int su = F.vcu; su < 768; su += F.G) {
        const int task = su >> 3, ke = su & 7, l = task / 48, cb = (task - l * 48) * 256;
        for (int i = F.tid; i < NMR * 256; i += NTHR) { const int r = i >> 8, k = ke * 256 + (i & 255); const float c = r < 2 ? F.in(I_CP)[r * DM + k] : F.in(I_CS)[(r - 2) * DM + k]; scs[i] = c / (1.f + __expf(-c)); }
        __syncthreads();
        const float* W = F.in(I_WADA) + ((size_t)l * DM + ke * 256 + F.wave * 32) * 12288 + cb + F.lane * 4;
        f32x4 acc[NMR];
#pragma unroll
        for (int r = 0; r < NMR; ++r) acc[r] = (f32x4){0.f, 0.f, 0.f, 0.f};
        for (int k = 0; k < 32; k += 8) {
            f32x4 wv[8];
#pragma unroll
            for (int j = 0; j < 8; ++j) wv[j] = __builtin_nontemporal_load((const GAS f32x4*)(W + (size_t)(k + j) * 12288));
#pragma unroll
            for (int j = 0; j < 8; j += 4)
#pragma unroll
                for (int r = 0; r < NMR; ++r) { const f32x4 sv = *(const LAS f32x4*)(scs + r * 256 + F.wave * 32 + k + j); acc[r] += (wv[j] * sv.x + wv[j + 1] * sv.y) + (wv[j + 2] * sv.z + wv[j + 3] * sv.w); }
        }
#pragma unroll
        for (int r = 0; r < NMR; ++r) *(LAS f32x4*)(part + (F.wave * NMR + r) * 256 + F.lane * 4) = acc[r];
        __syncthreads();
        for (int i = F.tid; i < NMR * 64; i += NTHR) { const int r = i >> 6, c4 = (i & 63) * 4; f32x4 sm = *(const LAS f32x4*)(part + r * 256 + c4);
#pragma unroll
            for (int w = 1; w < NWAVES; ++w) sm += *(const LAS f32x4*)(part + (w * NMR + r) * 256 + c4);
            *(GAS f32x4*)(PARTM + ((size_t)ke * 2 * NMR + l * NMR + r) * 12288 + cb + c4) = sm; }
        __syncthreads();
    }
}

struct Row { f32x4 v[8]; };
__device__ __forceinline__ void row_load(Row& R, const float* p, int lane) {
#pragma unroll
    for (int j = 0; j < 8; ++j) R.v[j] = *(const GAS f32x4*)(p + j * 256 + lane * 4);
}
__device__ __forceinline__ void row_load_bf16(Row& R, const bf16* p, int lane) {
#pragma unroll
    for (int j = 0; j < 8; ++j) { const u32x2 w = *(const GAS u32x2*)(p + j * 256 + lane * 4);
        R.v[j] = (f32x4){__uint_as_float(w.x << 16), __uint_as_float(w.x & 0xffff0000u), __uint_as_float(w.y << 16), __uint_as_float(w.y & 0xffff0000u)}; }
}
__device__ __forceinline__ float row_sumsq(const Row& R) { float s = 0.f;
#pragma unroll
    for (int j = 0; j < 8; ++j) s += (R.v[j].x * R.v[j].x + R.v[j].y * R.v[j].y) + (R.v[j].z * R.v[j].z + R.v[j].w * R.v[j].w);
    return wave_sum(s); }
__device__ __forceinline__ const float* x_in_row(Ctx& F, int r) { return r < NPR ? F.in(I_XP) + (size_t)r * DM : F.in(I_XS) + (size_t)(r - NPR) * DM; }
__device__ __forceinline__ void row_modulate(Row& H, const Row& X, float rstd, const float* g, const float* shift, const float* scale, int lane) {
#pragma unroll
    for (int j = 0; j < 8; ++j) { const int c = j * 256 + lane * 4; const f32x4 gg = *(const GAS f32x4*)(g + c), sh = *(const GAS f32x4*)(shift + c), sc = *(const GAS f32x4*)(scale + c);
        H.v[j] = X.v[j] * rstd * gg * (sc + 1.f) + sh; }
}
__device__ __forceinline__ void row_store_bf16(const Row& H, bf16* p, int lane) {
#pragma unroll
    for (int j = 0; j < 8; ++j) { u32x2 w; w.x = cvt_pk_bf16(H.v[j].x, H.v[j].y); w.y = cvt_pk_bf16(H.v[j].z, H.v[j].w); *(GAS u32x2*)(p + j * 256 + lane * 4) = w; }
}
__device__ __forceinline__ void row_store_f32(const Row& H, float* p, int lane) {
#pragma unroll
    for (int j = 0; j < 8; ++j) *(GAS f32x4*)(p + j * 256 + lane * 4) = H.v[j];
}
__device__ __forceinline__ void row_store_f32_nt(const Row& H, float* p, int lane) {
#pragma unroll
    for (int j = 0; j < 8; ++j) __builtin_nontemporal_store(H.v[j], (GAS f32x4*)(p + j * 256 + lane * 4));
}
struct RowB { u32x2 w[8]; };
__device__ __forceinline__ void rowb_load(RowB& R, const bf16* p, int lane) {
#pragma unroll
    for (int j = 0; j < 8; ++j) R.w[j] = *(const GAS u32x2*)(p + j * 256 + lane * 4);
}
__device__ __forceinline__ void rowb_cvt(Row& R, const RowB& B) {
#pragma unroll
    for (int j = 0; j < 8; ++j) R.v[j] = (f32x4){__uint_as_float(B.w[j].x << 16), __uint_as_float(B.w[j].x & 0xffff0000u), __uint_as_float(B.w[j].y << 16), __uint_as_float(B.w[j].y & 0xffff0000u)};
}
constexpr int PSET_FLOATS = 3 * DM;
static_assert(NSM == 64 && 3 * PSET_FLOATS * 4 + 7 * DM * 4 <= RING_BYTES, "row phases: 8 workgroups x 8 waves take the sample rows; three parameter sets in LDS");
template <int KIND, int L> __device__ __forceinline__ void stage_row_params(Ctx& F) {
    const float* MOD = WSP(float, WS_MOD); const float* ng = F.in(I_NG) + (size_t)L * 4 * DM;
    const int nset = F.vcu < 64 ? 3 : 2;
#define RP_LD4(p) (*(const GAS f32x4*)(p))
    for (int i = F.tid; i < nset * (DM / 4); i += NTHR) {
        const int s = i >> 9, c = (i & 511) * 4, mr = s < 2 ? s : 2 + (F.vcu >> 3);
        const float* m = MOD + (size_t)(L * NMR + mr) * 12288;
        f32x4 v0 = {0.f, 0.f, 0.f, 0.f}, v1 = v0, v2 = v0;
        if (KIND == 0) {
            const float* pm = WSP(float, WS_G) + (size_t)mr * 12288; f32x4 sh = RP_LD4(F.in(I_BADA) + c), scl = RP_LD4(F.in(I_BADA) + DM + c);
#pragma unroll
            for (int ke = 0; ke < 8; ++ke) { sh += RP_LD4(pm + (size_t)ke * 2 * NMR * 12288 + c); scl += RP_LD4(pm + (size_t)ke * 2 * NMR * 12288 + DM + c); }
            v1 = RP_LD4(ng + c) * (scl + 1.f); v2 = sh; }
        else if (KIND == 1) { v0 = RP_LD4(m + 2 * DM + c) * RP_LD4(ng + DM + c); v1 = RP_LD4(ng + 2 * DM + c) * (RP_LD4(m + 4 * DM + c) + 1.f); v2 = RP_LD4(m + 3 * DM + c); }
        else { v0 = RP_LD4(m + 5 * DM + c) * RP_LD4(ng + 3 * DM + c);
               if (KIND == 2) { const float* m1 = MOD + (size_t)(1 * NMR + mr) * 12288; v1 = RP_LD4(F.in(I_NG) + (size_t)4 * DM + c) * (RP_LD4(m1 + DM + c) + 1.f); v2 = RP_LD4(m1 + c); } }
        LAS float* d = (LAS float*)F.lds + s * PSET_FLOATS + c;
        *(LAS f32x4*)d = v0; *(LAS f32x4*)(d + DM) = v1; *(LAS f32x4*)(d + 2 * DM) = v2;
    }
#undef RP_LD4
    __syncthreads();
}
__device__ __forceinline__ const LAS float* row_pset(Ctx& F, int r) { return (const LAS float*)F.lds + (r < NPR ? (r >> 12) : 2) * PSET_FLOATS; }
__device__ __forceinline__ void row_residual_l(Row& X, const Row& O, const LAS float* ps, int lane) {
    const float rstd = rsqrtf(row_sumsq(O) * (1.f / DM) + EPS_RMS);
#pragma unroll
    for (int j = 0; j < 8; ++j) { const f32x4 gt = *(const LAS f32x4*)(ps + j * 256 + lane * 4); X.v[j] = X.v[j] + gt * (O.v[j] * rstd); }
}
__device__ __forceinline__ void row_modulate_l(Row& H, const Row& X, const LAS float* ps, int lane) {
    const float rstd = rsqrtf(row_sumsq(X) * (1.f / DM) + EPS_RMS);
#pragma unroll
    for (int j = 0; j < 8; ++j) { const int c = j * 256 + lane * 4; const f32x4 a = *(const LAS f32x4*)(ps + DM + c), sh = *(const LAS f32x4*)(ps + 2 * DM + c); H.v[j] = X.v[j] * rstd * a + sh; }
}
__device__ __forceinline__ void phase_mod0(Ctx& F) {
    stage_row_params<0, 0>(F);
    const int gw = F.vcu * NWAVES + F.wave, NGW = F.G * NWAVES, samp = (F.vcu < 64 && F.wave == 0) ? NPR + F.vcu : NTOK; bf16* Hb = WSP(bf16, WS_H);
    Row Xn; row_load(Xn, x_in_row(F, gw), F.lane);
    for (int r = gw; r < NPR; r += NGW) {
        Row X = Xn, H; const int rn = r + NGW, rp = rn < NPR ? rn : (samp < NTOK ? samp : r);
        row_load(Xn, x_in_row(F, rp), F.lane);
        row_modulate_l(H, X, row_pset(F, r), F.lane);
        row_store_bf16(H, Hb + (size_t)r * DM, F.lane);
    }
    if (samp < NTOK) { Row H; row_modulate_l(H, Xn, row_pset(F, samp), F.lane); row_store_bf16(H, Hb + (size_t)samp * DM, F.lane); }
}
__device__ __forceinline__ void row_residual(Row& X, const Row& O, const float* ga, const float* gate, int lane) {
    const float rstd = rsqrtf(row_sumsq(O) * (1.f / DM) + EPS_RMS);
#pragma unroll
    for (int j = 0; j < 8; ++j) { const int c = j * 256 + lane * 4; const f32x4 gg = *(const GAS f32x4*)(ga + c), gt = *(const GAS f32x4*)(gate + c); X.v[j] = X.v[j] + gt * (O.v[j] * rstd * gg); }
}
template <int NK> __device__ __forceinline__ void row_load_out(Ctx& F, Row& O, int r, int lane) {
    if (r < NPR) { const bf16* op = WSP(bf16, WS_OUT) + (size_t)r * DM;
#pragma unroll
        for (int j = 0; j < 8; ++j) { const u32x2 w = *(const GAS u32x2*)(op + j * 256 + lane * 4);
            O.v[j] = (f32x4){__uint_as_float(w.x << 16), __uint_as_float(w.x & 0xffff0000u), __uint_as_float(w.y << 16), __uint_as_float(w.y & 0xffff0000u)}; }
        return; }
    const float* pp = WSP(float, WS_PART) + (size_t)(r - NPR) * DM;
    row_load(O, pp, lane);
    for (int kc = 1; kc < NK; ++kc) { Row T; row_load(T, pp + (size_t)kc * 64 * DM, lane);
#pragma unroll
        for (int j = 0; j < 8; ++j) O.v[j] += T.v[j]; }
}
__device__ __forceinline__ f32x4 ld_bf4(const bf16* p) { const u32x2 w = *(const GAS u32x2*)p; return (f32x4){__uint_as_float(w.x << 16), __uint_as_float(w.x & 0xffff0000u), __uint_as_float(w.y << 16), __uint_as_float(w.y & 0xffff0000u)}; }
__device__ __forceinline__ void row_load_pool(Ctx& F, Row& O, int r, int lane) {
    if (r < NPR && (r & (SEQ - 1)) >= PBUF) { const bf16* op = WSP(bf16, WS_OUT) + (size_t)r * DM + lane * 4;
#pragma unroll
        for (int j8 = 0; j8 < 8; ++j8) { const int wlen = 2 << (j8 >> 1);
            const f32x4 cur = ld_bf4(op + j8 * 256); f32x4 sum = cur;
#pragma unroll
            for (int j = 1; j < wlen; ++j) sum += ld_bf4(op + j8 * 256 - (size_t)j * DM);
            O.v[j8] = sum * (1.f / (float)wlen) - cur; }
    } else if (r < NPR) { const int t = r & (SEQ - 1); const bf16* op = WSP(bf16, WS_OUT) + (size_t)r * DM + lane * 4;
#pragma unroll
        for (int j8 = 0; j8 < 8; ++j8) { const int wlen = 2 << (j8 >> 1), n = (t + 1) < wlen ? (t + 1) : wlen;
            const f32x4 cur = ld_bf4(op + j8 * 256); f32x4 sum = cur;
            for (int j = 1; j < n; ++j) sum += ld_bf4(op + j8 * 256 - (size_t)j * DM);
            O.v[j8] = sum * (1.f / (float)n) - cur; }
    } else { const int rs = r - NPR, b = rs >> 3, t = rs & 7; const float* pp = WSP(float, WS_PART) + lane * 4;
#pragma unroll
        for (int j8 = 0; j8 < 8; ++j8) { const int wlen = 2 << (j8 >> 1); f32x4 cur = {0.f, 0.f, 0.f, 0.f}, sum = {0.f, 0.f, 0.f, 0.f};
#pragma unroll
            for (int j = 0; j < wlen; ++j) { const int tj = t - j, pr = tj >= 0 ? rs - j : 64 + b * PBUF + PBUF + tj;
                const f32x4 g = *(const GAS f32x4*)(pp + (size_t)pr * DM + j8 * 256) + *(const GAS f32x4*)(pp + (size_t)(256 + pr) * DM + j8 * 256);
                sum += g; if (j == 0) cur = g; }
            O.v[j8] = sum * (1.f / (float)wlen) - cur; }
    }
}
template <int NK> __device__ __forceinline__ void sample_row_gather(Ctx& F, Row& O, int s) {
    constexpr int PER = NK / 8; const float* pp = WSP(float, WS_PART) + ((size_t)(F.wave * PER) * 64 + s) * DM; Row T[PER];
#pragma unroll
    for (int k = 0; k < PER; ++k) row_load(T[k], pp + (size_t)k * 64 * DM, F.lane);
    O = T[0];
#pragma unroll
    for (int k = 1; k < PER; ++k)
#pragma unroll
        for (int j = 0; j < 8; ++j) O.v[j] += T[k].v[j];
    LAS float* sl = (LAS float*)F.lds + 3 * PSET_FLOATS;
    if (F.wave > 0) {
#pragma unroll
        for (int j = 0; j < 8; ++j) *(LAS f32x4*)(sl + (F.wave - 1) * DM + j * 256 + F.lane * 4) = O.v[j]; }
    __syncthreads();
    if (F.wave == 0) {
#pragma unroll
        for (int w = 0; w < 7; ++w)
#pragma unroll
            for (int j = 0; j < 8; ++j) O.v[j] += *(const LAS f32x4*)(sl + w * DM + j * 256 + F.lane * 4); }
}
template <int L> __device__ __forceinline__ void phase_postmix(Ctx& F) {
    stage_row_params<1, L>(F);
    const int gw = F.vcu * NWAVES + F.wave, NGW = F.G * NWAVES, samp = (F.vcu < 64 && F.wave == 0) ? NPR + F.vcu : NTOK;
    bf16* Hb = WSP(bf16, WS_H); bf16* XR = WSP(bf16, WS_XR); const bf16* OUTb = WSP(bf16, WS_OUT);
    Row Xf; RowB Xb, Ob;
    if (L == 0) { row_load(Xf, x_in_row(F, gw), F.lane); rowb_load(Ob, OUTb + (size_t)gw * DM, F.lane); } else rowb_load(Xb, XR + (size_t)gw * DM, F.lane);
    for (int r = gw; r < NPR; r += NGW) {
        Row X, O, H; const int rn = r + NGW, rp = rn < NPR ? rn : (samp < NTOK ? samp : r), ro = rn < NPR ? rn : r;
        if (L == 0) { X = Xf; rowb_cvt(O, Ob); row_load(Xf, x_in_row(F, rp), F.lane); rowb_load(Ob, OUTb + (size_t)ro * DM, F.lane); }
        else { rowb_cvt(X, Xb); rowb_load(Xb, XR + (size_t)rp * DM, F.lane); row_load_pool(F, O, r, F.lane); }
        const LAS float* ps = row_pset(F, r);
        row_residual_l(X, O, ps, F.lane);
        row_store_bf16(X, XR + (size_t)r * DM, F.lane);
        row_modulate_l(H, X, ps, F.lane);
        row_store_bf16(H, Hb + (size_t)r * DM, F.lane);
    }
    Row Og; if (L == 0 && F.vcu < 64) sample_row_gather<8>(F, Og, F.vcu);
    if (samp < NTOK) { Row X, O, H; if (L == 0) { X = Xf; O = Og; } else { rowb_cvt(X, Xb); row_load_pool(F, O, samp, F.lane); }
        const LAS float* ps = row_pset(F, samp);
        row_residual_l(X, O, ps, F.lane);
        row_store_bf16(X, XR + (size_t)samp * DM, F.lane);
        row_modulate_l(H, X, ps, F.lane);
        row_store_bf16(H, Hb + (size_t)samp * DM, F.lane); }
}
template <int L> __device__ __forceinline__ void phase_postmlp(Ctx& F) {
    stage_row_params<L == 0 ? 2 : 3, L>(F);
    const int gw = F.vcu * NWAVES + F.wave, NGW = F.G * NWAVES, samp = (F.vcu < 64 && F.wave == 0) ? NPR + F.vcu : NTOK;
    bf16* XR = WSP(bf16, WS_XR); const bf16* OUTb = WSP(bf16, WS_OUT);
    RowB Xb, Ob; rowb_load(Xb, XR + (size_t)gw * DM, F.lane); rowb_load(Ob, OUTb + (size_t)gw * DM, F.lane);
    for (int r = gw; r < NPR; r += NGW) {
        Row X, O; const int rn = r + NGW, rp = rn < NPR ? rn : (samp < NTOK ? samp : r), ro = rn < NPR ? rn : r;
        rowb_cvt(X, Xb); rowb_cvt(O, Ob); rowb_load(Xb, XR + (size_t)rp * DM, F.lane); rowb_load(Ob, OUTb + (size_t)ro * DM, F.lane);
        const LAS float* ps = row_pset(F, r);
        row_residual_l(X, O, ps, F.lane);
        if (L == 0) {
            row_store_bf16(X, XR + (size_t)r * DM, F.lane);
            Row H; row_modulate_l(H, X, ps, F.lane);
            row_store_bf16(H, WSP(bf16, WS_H) + (size_t)r * DM, F.lane);
            const int t = r & (SEQ - 1); if (t >= SEQ - PBUF) row_store_f32(H, F.outp() + O_PLP + ((size_t)(r >> 12) * PBUF + (t - (SEQ - PBUF))) * DM, F.lane);
        } else row_store_f32_nt(X, F.outp() + O_YP + (size_t)r * DM, F.lane);
    }
    Row Og; if (F.vcu < 64) sample_row_gather<32>(F, Og, F.vcu);
    if (samp < NTOK) { Row X, O = Og; rowb_cvt(X, Xb);
        const LAS float* ps = row_pset(F, samp); const int rs = samp - NPR;
        row_residual_l(X, O, ps, F.lane);
        if (L == 0) {
            row_store_bf16(X, XR + (size_t)samp * DM, F.lane);
            Row H; row_modulate_l(H, X, ps, F.lane);
            row_store_bf16(H, WSP(bf16, WS_H) + (size_t)samp * DM, F.lane);
            row_store_f32(H, F.outp() + O_PLS + ((size_t)(rs >> 3) * PBUF + 7 + (rs & 7)) * DM, F.lane);
        } else row_store_f32_nt(X, F.outp() + O_YS + (size_t)rs * DM, F.lane); }
    if (L == 0) {
        const float* SP = F.in(I_SPOOL); bf16* Hb = WSP(bf16, WS_H);
        for (int i = F.vcu * NTHR + F.tid; i < DBAT * PBUF * 512; i += F.G * NTHR) { const int c4 = (i & 511) * 4, bi = i >> 9, b = bi / PBUF, k = bi - b * PBUF;
            const f32x4 v = *(const GAS f32x4*)(SP + (size_t)bi * DM + c4); u32x2 w; w.x = cvt_pk_bf16(v.x, v.y); w.y = cvt_pk_bf16(v.z, v.w);
            *(GAS u32x2*)(Hb + (size_t)(NTOK + bi) * DM + c4) = w;
            if (k >= 8) *(GAS f32x4*)(F.outp() + O_PLS + ((size_t)b * PBUF + (k - 8)) * DM + c4) = v; }
    }
}

__device__ __forceinline__ void phase_kv_prep(Ctx& F) {
    { const float* PM = WSP(float, WS_G); float* MOD = WSP(float, WS_MOD);
      for (int i = F.vcu * NTHR + F.tid; i < 2 * NMR * 12288 / 4; i += F.G * NTHR) { const int row = i / 3072, c4 = (i - row * 3072) * 4, l = row / NMR;
          f32x4 sm = *(const GAS f32x4*)(F.in(I_BADA) + (size_t)l * 12288 + c4);
#pragma unroll
          for (int ke = 0; ke < 8; ++ke) sm += *(const GAS f32x4*)(PM + ((size_t)ke * 2 * NMR + row) * 12288 + c4);
          *(GAS f32x4*)(MOD + (size_t)row * 12288 + c4) = sm; } }
    const float* P = WSP(float, WS_P);
    for (int i = F.vcu * NTHR + F.tid; i < (NBATCH + DBAT) * BCOLS; i += F.G * NTHR) {
        const int b = i / BCOLS, c = i - b * BCOLS; const int r = b < NBATCH ? b * SEQ + SEQ - 1 : NPR + (b - NBATCH) * DSEQ + DSEQ - 1;
        F.outp()[(b < NBATCH ? O_SHP + (size_t)b * BCOLS : O_SHS + (size_t)(b - NBATCH) * BCOLS) + c] = (b < NBATCH && c < 3072) ? ldbf(WSP(bf16, WS_PBH) + (size_t)r * 3072 + c) : P[(size_t)r * PBLD + c];
    }
    { const int gw = F.vcu * NWAVES + F.wave, NGW = F.G * NWAVES; const float* mu = F.in(I_MU); bf16* LA = WSP(bf16, WS_LA);
      for (int r = gw; r < NTOK; r += NGW) {
        const float* pb = P + (size_t)r * PBLD; const float* prev; bool hp;
        if (r < NPR) { const int t = r & (SEQ - 1); hp = t > 0; prev = pb - PBLD; }
        else { const int rs = r - NPR, b = rs >> 3, t = rs & 7; hp = true; prev = t > 0 ? pb - PBLD : F.in(I_SSH) + (size_t)b * BCOLS; }
        float v[8];
        { const int c0 = 3072 + F.lane * 8; const bool act = F.lane < 56; const f32x4 z4 = {0.f, 0.f, 0.f, 0.f};
          f32x4 pa = z4, pc = z4, qa = z4, qc = z4, ma = z4, mc = z4;
          if (act) { pa = *(const GAS f32x4*)(pb + c0); pc = *(const GAS f32x4*)(pb + c0 + 4); ma = *(const GAS f32x4*)(mu + c0); mc = *(const GAS f32x4*)(mu + c0 + 4);
                     if (hp) { qa = *(const GAS f32x4*)(prev + c0); qc = *(const GAS f32x4*)(prev + c0 + 4); } }
          const f32x4 za = pa + ma * (qa - pa), zc = pc + mc * (qc - pc);
          const float kz = F.lane < 12 ? 2.f : 1.f;
#pragma unroll
          for (int j = 0; j < 8; ++j) { const float z = j < 4 ? za[j & 3] : zc[j & 3]; const float sg = 1.f / (1.f + __expf(-kz * z));
              v[j] = !act ? 0.f : (F.lane < 12 ? 2.f * sg - 1.f : (F.lane < 24 ? z : sg)); } }
        u32x4 o; o.x = cvt_pk_bf16(v[0], v[1]); o.y = cvt_pk_bf16(v[2], v[3]); o.z = cvt_pk_bf16(v[4], v[5]); o.w = cvt_pk_bf16(v[6], v[7]);
        *(GAS u32x4*)(LA + (size_t)r * 512 + F.lane * 8) = o;
      } }
}
__device__ __forceinline__ void phase_rwkv_prep(Ctx& F) {
    const float* P = WSP(float, WS_P); const float* LWO = WSP(float, WS_LWO);
    const int gw = F.vcu * NWAVES + F.wave, NGW = F.G * NWAVES;
    float* RWV = WSP(float, WS_RWV); float* SCL = WSP(float, WS_SCL);
    const float* mu = F.in(I_MU);
    for (int u = gw; u < NSM * 4; u += NGW) {
        const int r = NPR + (u >> 2), hq = u & 3;
        const float* pb = P + (size_t)r * PBLD; const float* prev; const bool hp = true;
        { const int rs = r - NPR, b = rs >> 3, t = rs & 7; prev = t > 0 ? pb - PBLD : F.in(I_SSH) + (size_t)b * BCOLS; }
        const float* lw = LWO + (size_t)r * 3072;
        float pr[4], pk[4], pv[4], qr_[4], qk[4], qv[4], lwl[4], lal[4], lgl[4];
#pragma unroll
        for (int i = 0; i < 4; ++i) { const int col = (hq * 4 + i) * 64 + F.lane;
            pr[i] = pb[col]; pk[i] = pb[1024 + col]; pv[i] = pb[2048 + col];
            qr_[i] = hp ? prev[col] : 0.f; qk[i] = hp ? prev[1024 + col] : 0.f; qv[i] = hp ? prev[2048 + col] : 0.f;
            lwl[i] = lw[col]; lal[i] = lw[1024 + col]; lgl[i] = lw[2048 + col]; }
#pragma unroll
        for (int i = 0; i < 4; ++i) { const int h = hq * 4 + i, col = h * 64 + F.lane;
            const float zr = pr[i] + mu[col] * (qr_[i] - pr[i]), zk = pk[i] + mu[1024 + col] * (qk[i] - pk[i]), zv = pv[i] + mu[2048 + col] * (qv[i] - pv[i]);
            const float wl = F.in(I_W0)[col] + lwl[i], al = F.in(I_A0)[col] + lal[i], gl = lgl[i];
            const float wlog = -softplusf_(-wl) - 0.5f, decay = __expf(-__expf(wlog));
            const float a = sigmoidf_(al);
            const float kkr = zk * F.in(I_KK)[col], kk = kkr * rsqrtf(wave_sum(kkr * kkr) + 1e-12f);
            const float k = zk * (1.f + (a - 1.f) * F.in(I_KA)[col]);
            const float bb = kk * a;
            const float bonus = wave_sum(zr * k * F.in(I_RK)[col]), beta = wave_sum(bb * zr), kappa = wave_sum(k * zr);
            float* base = RWV + ((size_t)r * HB + h) * 512;
            base[F.lane] = decay; base[64 + F.lane] = kk; base[128 + F.lane] = bb; base[192 + F.lane] = k; base[256 + F.lane] = zr; base[320 + F.lane] = zv; base[384 + F.lane] = decay * zr;
            if (F.lane == 0) { float* s_ = SCL + ((size_t)r * HB + h) * 4; s_[0] = beta; s_[1] = kappa; s_[2] = bonus; s_[3] = 0.f; }
        }
    }
}

namespace sba {
typedef short bf16x8 __attribute__((ext_vector_type(8)));
typedef short s16x4 __attribute__((ext_vector_type(4)));
typedef float f32x16 __attribute__((ext_vector_type(16)));
constexpr int SHM = 16384, LDQ = 1024;
#define SB_KSWZ(row, colB) ((row) * 256 + ((colB) ^ (((row) & 7) << 4)))
#define SB_SBAR() __builtin_amdgcn_sched_barrier(0)
__device__ __forceinline__ int v_st(int k, int c) { const int kk = (k & ~0xC) | ((k & 4) << 1) | ((k & 8) >> 1); return ((kk >> 3) * 4 + (c >> 5)) * 512 + ((kk & 7) * 32 + (c & 31)) * 2; }
__device__ __forceinline__ int v_rd_base(int lane) { return ((lane & 3) << 3) | (((lane >> 2) & 3) << 6) | (((lane >> 4) & 1) << 5) | (((lane >> 5) & 1) << 8); }
__device__ __forceinline__ int crow(int r, int hi) { return (r & 3) + 8 * (r >> 2) + 4 * hi; }
__device__ __forceinline__ void qkt(f32x16& p0, f32x16& p1, const char* Kt, int r32, int hi, const bf16x8* qr) {
    p0 = f32x16{}; p1 = f32x16{};
    const char* kb[4];
#pragma unroll
    for (int dd = 0; dd < 4; ++dd) kb[dd] = Kt + SB_KSWZ(r32, (dd * 16 + hi * 8) * 2);
#pragma unroll
    for (int d0 = 0; d0 < 8; ++d0) { const char* a = kb[d0 & 3] + (d0 >> 2) * 128;
        const bf16x8 b0 = *reinterpret_cast<const bf16x8*>(a);
        const bf16x8 b1 = *reinterpret_cast<const bf16x8*>(a + 32 * 256);
        p0 = __builtin_amdgcn_mfma_f32_32x32x16_bf16(b0, qr[d0], p0, 0, 0, 0);
        p1 = __builtin_amdgcn_mfma_f32_32x32x16_bf16(b1, qr[d0], p1, 0, 0, 0); }
}
__device__ __forceinline__ void pv_tile(f32x16* o, int vb0, bf16x8 pa0, bf16x8 pa1, bf16x8 pa2, bf16x8 pa3) {
#define SB_TRRD(dst, off) asm volatile("ds_read_b64_tr_b16 %0, %1 offset:%2" : "=&v"(dst) : "v"(vb0), "i"(off) : "memory")
#define SB_PV_D0(d0) do { s16x4 l0, l1, l2, l3, h0, h1, h2, h3; constexpr int b_ = (d0) * 512; \
        SB_TRRD(l0, b_); SB_TRRD(h0, b_ + 2048); SB_TRRD(l1, b_ + 4096); SB_TRRD(h1, b_ + 6144); SB_TRRD(l2, b_ + 8192); SB_TRRD(h2, b_ + 10240); SB_TRRD(l3, b_ + 12288); SB_TRRD(h3, b_ + 14336); \
        asm volatile("s_waitcnt lgkmcnt(0)" ::: "memory"); SB_SBAR(); \
        o[d0] = __builtin_amdgcn_mfma_f32_32x32x16_bf16(pa0, (bf16x8){l0[0], l0[1], l0[2], l0[3], h0[0], h0[1], h0[2], h0[3]}, o[d0], 0, 0, 0); \
        o[d0] = __builtin_amdgcn_mfma_f32_32x32x16_bf16(pa1, (bf16x8){l1[0], l1[1], l1[2], l1[3], h1[0], h1[1], h1[2], h1[3]}, o[d0], 0, 0, 0); \
        o[d0] = __builtin_amdgcn_mfma_f32_32x32x16_bf16(pa2, (bf16x8){l2[0], l2[1], l2[2], l2[3], h2[0], h2[1], h2[2], h2[3]}, o[d0], 0, 0, 0); \
        o[d0] = __builtin_amdgcn_mfma_f32_32x32x16_bf16(pa3, (bf16x8){l3[0], l3[1], l3[2], l3[3], h3[0], h3[1], h3[2], h3[3]}, o[d0], 0, 0, 0); } while (0)
    SB_PV_D0(0); SB_PV_D0(1); SB_PV_D0(2); SB_PV_D0(3);
#undef SB_PV_D0
#undef SB_TRRD
}
__device__ __forceinline__ float swap_other(float x, int hi) {
    auto rr = __builtin_amdgcn_permlane32_swap(__float_as_uint(x), __float_as_uint(x), false, false);
    return __uint_as_float(hi ? rr[0] : rr[1]);
}
template <bool MASK> __device__ __forceinline__ void sb_weights(f32x16& p0, f32x16& p1, float& carry, float C2, float b2, int dq, int hi) {
    float T[8];
#pragma unroll
    for (int g = 0; g < 8; ++g) {
        float iv[4], be[4];
#pragma unroll
        for (int k = 0; k < 4; ++k) { const int r = (g & 3) * 4 + k; const float s = g < 4 ? p0[r] : p1[r];
            const float z2 = fminf(fmaf(s, C2, b2), 64.f), e = __builtin_amdgcn_exp2f(z2), i_ = __builtin_amdgcn_rcpf(1.f + e); float b_ = e * i_, ii = i_;
            if (MASK) { const int c = (r & 3) + 8 * (r >> 2) + (g < 4 ? 0 : 32); const bool vis = c < dq; ii = vis ? ii : 1.f; b_ = vis ? b_ : 0.f; }
            iv[k] = ii; be[k] = b_; }
        const float ex2 = iv[3], ex1 = iv[2] * iv[3], ex0 = iv[1] * ex1; T[g] = iv[0] * ex0;
        const float w0 = be[0] * ex0, w1 = be[1] * ex1, w2 = be[2] * ex2, w3 = be[3];
        if (g < 4) { p0[(g & 3) * 4 + 0] = w0; p0[(g & 3) * 4 + 1] = w1; p0[(g & 3) * 4 + 2] = w2; p0[(g & 3) * 4 + 3] = w3; }
        else { p1[(g & 3) * 4 + 0] = w0; p1[(g & 3) * 4 + 1] = w1; p1[(g & 3) * 4 + 2] = w2; p1[(g & 3) * 4 + 3] = w3; }
    }
    float suf = carry;
#pragma unroll
    for (int g = 7; g >= 0; --g) {
        const float To = swap_other(T[g], hi);
        const float E = hi ? suf : suf * To;
#pragma unroll
        for (int k = 0; k < 4; ++k) { if (g < 4) p0[(g & 3) * 4 + k] *= E; else p1[(g & 3) * 4 + k] *= E; }
        suf = suf * (T[g] * To);
    }
    carry = suf;
}
__device__ __forceinline__ void pack_p(const f32x16& p0, const f32x16& p1, bf16x8& pa0, bf16x8& pa1, bf16x8& pa2, bf16x8& pa3) {
#define SB_PK4(P, B_, OUT) do { unsigned a0 = cvt_pk_bf16(P[B_ + 0], P[B_ + 1]), a1 = cvt_pk_bf16(P[B_ + 2], P[B_ + 3]); \
        unsigned b0 = cvt_pk_bf16(P[B_ + 4], P[B_ + 5]), b1 = cvt_pk_bf16(P[B_ + 6], P[B_ + 7]); \
        auto r0 = __builtin_amdgcn_permlane32_swap(a0, b0, false, false); auto r1 = __builtin_amdgcn_permlane32_swap(a1, b1, false, false); \
        u32x4 w = {r0[0], r1[0], r0[1], r1[1]}; OUT = *reinterpret_cast<bf16x8*>(&w); } while (0)
    SB_PK4(p0, 0, pa0); SB_PK4(p0, 8, pa1); SB_PK4(p1, 0, pa2); SB_PK4(p1, 8, pa3);
#undef SB_PK4
}
__device__ __forceinline__ void attn_half(Ctx& F, int bh, int x, int half) {
    const int tid = F.tid, wid = F.wave, lane = F.lane, r32 = lane & 31, hi = lane >> 5, b = bh >> 3, h = bh & 7;
    const bf16* Qg = WSP(bf16, WS_QB) + (size_t)(b * SEQ + 256 * x) * LDQ + h * 128;
    const bf16* Kg = WSP(bf16, WS_KB) + (size_t)(b * SEQ) * LDQ + h * 128; const bf16* Vg = WSP(bf16, WS_VB) + (size_t)(b * SEQ) * LDQ + h * 128;
    const int NT = 4 * (x + 1), t_hi = half == 0 ? NT : NT / 2, t_lo = half == 0 ? NT / 2 : 0;
    const int qlo = 256 * x + 32 * wid, qpos = qlo + r32;
    char* V_lds = (char*)F.lds; char* K_lds = (char*)F.lds + 2 * SHM;
    bf16x8 qr[8];
#pragma unroll
    for (int d0 = 0; d0 < 8; ++d0) qr[d0] = *reinterpret_cast<const bf16x8*>(Qg + (size_t)(wid * 32 + r32) * LDQ + d0 * 16 + hi * 8);
    const int sr = tid >> 4, sc = (tid & 15) * 8, vst0 = v_st(sr, sc), vst1 = v_st(32 + sr, sc), kws = SB_KSWZ(sr, sc * 2);
    const int vb0 = (int)(uintptr_t)V_lds + v_rd_base(lane);
    bf16x8 st_k0, st_k1, st_v0, st_v1;
    const unsigned so0 = (unsigned)(sr * LDQ + sc) * 2u, so1 = so0 + 32u * LDQ * 2u;
#define SB_SLOAD(t) do { const char* kt_ = (const char*)Kg + (size_t)(t) * (64 * LDQ * 2); const char* vt_ = (const char*)Vg + (size_t)(t) * (64 * LDQ * 2); \
        st_k0 = *reinterpret_cast<const bf16x8*>(kt_ + so0); st_k1 = *reinterpret_cast<const bf16x8*>(kt_ + so1); st_v0 = *reinterpret_cast<const bf16x8*>(vt_ + so0); st_v1 = *reinterpret_cast<const bf16x8*>(vt_ + so1); } while (0)
#define SB_SWRITE(bf) do { *(bf16x8*)(K_lds + (bf) * SHM + kws) = st_k0; *(bf16x8*)(K_lds + (bf) * SHM + kws + 32 * 256) = st_k1; \
        *(bf16x8*)(V_lds + (bf) * SHM + vst0) = st_v0; *(bf16x8*)(V_lds + (bf) * SHM + vst1) = st_v1; } while (0)
    __syncthreads();
    SB_SLOAD(t_hi - 1); VM_WAIT(); SB_SWRITE(0);
    __syncthreads();
    const float C2 = QK_SCALE * 1.4426950408889634f, b2 = F.in(I_SBB)[h] * 1.4426950408889634f;
    float carry = 1.f; f32x16 o[4] = {};
    int buf = 0;
    for (int t = t_hi - 1; t >= t_lo; --t) {
        if (t > t_lo) SB_SLOAD(t - 1);
        const int kb = 64 * t;
        if (kb < qlo + 31) {
            f32x16 p0, p1; bf16x8 pa0, pa1, pa2, pa3;
            qkt(p0, p1, K_lds + buf * SHM, r32, hi, qr);
            if (kb + 63 >= qlo) sb_weights<true>(p0, p1, carry, C2, b2, qpos - kb - 4 * hi, hi); else sb_weights<false>(p0, p1, carry, C2, b2, 0, hi);
            pack_p(p0, p1, pa0, pa1, pa2, pa3);
            pv_tile(o, vb0 + buf * SHM, pa0, pa1, pa2, pa3);
        }
        if (t > t_lo) { VM_WAIT(); SB_SWRITE(buf ^ 1); }
        __syncthreads();
        buf ^= 1;
    }
#undef SB_SLOAD
#undef SB_SWRITE
    float* Op = WSP(float, WS_OP) + ((size_t)half * NPR + b * SEQ + 256 * x + wid * 32) * 1024 + h * 128;
    const unsigned lo_ = (unsigned)(4 * hi * 1024 + r32);
#pragma unroll
    for (int r = 0; r < 16; ++r) { float* Opr = Op + (size_t)((r & 3) + 8 * (r >> 2)) * 1024;
#pragma unroll
        for (int d0 = 0; d0 < 4; ++d0) Opr[lo_ + d0 * 32] = o[d0][r]; }
    if (half == 0 && hi == 0) WSP(float, WS_CL)[(size_t)(b * SEQ + qpos) * HA + h] = carry;
}
#undef SB_KSWZ
#undef SB_SBAR
}
namespace sba {
__device__ __forceinline__ void sb_weights32(f32x16& p0, float& carry, float C2, float b2, int hi) {
    float T[4];
#pragma unroll
    for (int g = 0; g < 4; ++g) {
        float iv[4], be[4];
#pragma unroll
        for (int k = 0; k < 4; ++k) { const float z2 = fminf(fmaf(p0[g * 4 + k], C2, b2), 64.f), e = __builtin_amdgcn_exp2f(z2), i_ = __builtin_amdgcn_rcpf(1.f + e); iv[k] = i_; be[k] = e * i_; }
        const float ex2 = iv[3], ex1 = iv[2] * iv[3], ex0 = iv[1] * ex1; T[g] = iv[0] * ex0;
        p0[g * 4 + 0] = be[0] * ex0; p0[g * 4 + 1] = be[1] * ex1; p0[g * 4 + 2] = be[2] * ex2; p0[g * 4 + 3] = be[3];
    }
    float suf = carry;
#pragma unroll
    for (int g = 3; g >= 0; --g) { const float To = swap_other(T[g], hi); const float E = hi ? suf : suf * To;
#pragma unroll
        for (int k = 0; k < 4; ++k) p0[g * 4 + k] *= E;
        suf = suf * (T[g] * To); }
    carry = suf;
}
__device__ __forceinline__ void attn_sample_unit(Ctx& F, int bh, int pg, char* wl  ) {
    const int lane = F.lane, r32 = lane & 31, hi = lane >> 5, b = bh >> 3, h = bh & 7;
    char* K_lds = wl; char* V_lds = wl + 8192;
    bf16x8 qr[8];
    { const bf16* Qg = WSP(bf16, WS_QB) + (size_t)(NPR + b * DSEQ + (r32 & 7)) * LDQ + h * 128;
#pragma unroll
      for (int d0 = 0; d0 < 8; ++d0) { bf16x8 v = *reinterpret_cast<const bf16x8*>(Qg + d0 * 16 + hi * 8); if (r32 >= 8) v = bf16x8{}; qr[d0] = v; } }
    const int kl = lane >> 5, c4 = (lane & 31) * 4;
    const unsigned goff = (unsigned)(kl * 1024 + c4) * 4u;
    const int vb0 = (int)(uintptr_t)V_lds + v_rd_base(lane);
    const float C2 = QK_SCALE * 1.4426950408889634f, b2 = F.in(I_SBB)[h] * 1.4426950408889634f;
    const int* pt = ((const int*)F.in(I_PT)) + b * NPAGES + pg * 4;
    f32x4 sa[8], sb[8];
#define SU_BASE(n) ({ const int i_ = (n) >> 2, k_ = (n) & 3, tt_ = 15 - i_; const int phys_ = pt[tt_ >> 2]; \
        (const char*)((k_ & 2) ? F.in(I_CV) : F.in(I_CK)) + (((size_t)phys_ * PAGESZ + (tt_ & 3) * 32 + (k_ & 1) * 16) * 1024 + h * 128) * 4; })
#define SU_LOAD(S, n) do { const char* bp_ = SU_BASE(n); _Pragma("unroll") for (int j = 0; j < 8; ++j) S[j] = __builtin_nontemporal_load((const GAS f32x4*)(bp_ + goff + (size_t)j * 8192)); } while (0)
#define SU_WRK(S, kh) do { _Pragma("unroll") for (int j = 0; j < 8; ++j) { const int key = (kh) * 16 + 2 * j + kl; u32x2 w; w.x = cvt_pk_bf16(S[j].x, S[j].y); w.y = cvt_pk_bf16(S[j].z, S[j].w); \
        *(u32x2*)(K_lds + (key * 256 + ((c4 * 2) ^ ((key & 7) << 4)))) = w; } } while (0)
#define SU_WRV(S, kh) do { _Pragma("unroll") for (int j = 0; j < 8; ++j) { const int key = (kh) * 16 + 2 * j + kl; u32x2 w; w.x = cvt_pk_bf16(S[j].x, S[j].y); w.y = cvt_pk_bf16(S[j].z, S[j].w); \
        *(u32x2*)(V_lds + v_st(key, c4)) = w; } } while (0)
    SU_LOAD(sa, 0); SU_LOAD(sb, 1);
    float carry = 1.f; f32x16 o[4] = {};
    for (int i = 0; i < 16; ++i) {
        asm volatile("s_waitcnt vmcnt(8)" ::: "memory"); SU_WRK(sa, 0); SU_LOAD(sa, 4 * i + 2);
        asm volatile("s_waitcnt vmcnt(8)" ::: "memory"); SU_WRK(sb, 1); SU_LOAD(sb, 4 * i + 3);
        asm volatile("s_waitcnt vmcnt(8)" ::: "memory"); SU_WRV(sa, 0); if (i < 15) SU_LOAD(sa, 4 * i + 4);
        if (i < 15) asm volatile("s_waitcnt vmcnt(8)" ::: "memory"); else asm volatile("s_waitcnt vmcnt(0)" ::: "memory");
        SU_WRV(sb, 1); if (i < 15) SU_LOAD(sb, 4 * i + 5);
        asm volatile("s_waitcnt lgkmcnt(0)" ::: "memory");
        f32x16 p0 = f32x16{};
        { const char* kb[4];
#pragma unroll
          for (int dd = 0; dd < 4; ++dd) kb[dd] = K_lds + (r32 * 256 + (((dd * 16 + hi * 8) * 2) ^ ((r32 & 7) << 4)));
#pragma unroll
          for (int d0 = 0; d0 < 8; ++d0) { const bf16x8 b0 = *reinterpret_cast<const bf16x8*>(kb[d0 & 3] + (d0 >> 2) * 128); p0 = __builtin_amdgcn_mfma_f32_32x32x16_bf16(b0, qr[d0], p0, 0, 0, 0); } }
        sb_weights32(p0, carry, C2, b2, hi);
        bf16x8 pa0, pa1;
        { unsigned a0 = cvt_pk_bf16(p0[0], p0[1]), a1 = cvt_pk_bf16(p0[2], p0[3]), b0 = cvt_pk_bf16(p0[4], p0[5]), b1 = cvt_pk_bf16(p0[6], p0[7]);
          auto r0 = __builtin_amdgcn_permlane32_swap(a0, b0, false, false); auto r1 = __builtin_amdgcn_permlane32_swap(a1, b1, false, false);
          u32x4 w = {r0[0], r1[0], r0[1], r1[1]}; pa0 = *reinterpret_cast<bf16x8*>(&w); }
        { unsigned a0 = cvt_pk_bf16(p0[8], p0[9]), a1 = cvt_pk_bf16(p0[10], p0[11]), b0 = cvt_pk_bf16(p0[12], p0[13]), b1 = cvt_pk_bf16(p0[14], p0[15]);
          auto r0 = __builtin_amdgcn_permlane32_swap(a0, b0, false, false); auto r1 = __builtin_amdgcn_permlane32_swap(a1, b1, false, false);
          u32x4 w = {r0[0], r1[0], r0[1], r1[1]}; pa1 = *reinterpret_cast<bf16x8*>(&w); }
#define SU_TRRD(dst, off) asm volatile("ds_read_b64_tr_b16 %0, %1 offset:%2" : "=&v"(dst) : "v"(vb0), "i"(off) : "memory")
#define SU_PV(d0) do { s16x4 l0, l1, h0, h1; constexpr int b_ = (d0) * 512; SU_TRRD(l0, b_); SU_TRRD(h0, b_ + 2048); SU_TRRD(l1, b_ + 4096); SU_TRRD(h1, b_ + 6144); \
        asm volatile("s_waitcnt lgkmcnt(0)" ::: "memory"); __builtin_amdgcn_sched_barrier(0); \
        o[d0] = __builtin_amdgcn_mfma_f32_32x32x16_bf16(pa0, (bf16x8){l0[0], l0[1], l0[2], l0[3], h0[0], h0[1], h0[2], h0[3]}, o[d0], 0, 0, 0); \
        o[d0] = __builtin_amdgcn_mfma_f32_32x32x16_bf16(pa1, (bf16x8){l1[0], l1[1], l1[2], l1[3], h1[0], h1[1], h1[2], h1[3]}, o[d0], 0, 0, 0); } while (0)
        SU_PV(0); SU_PV(1); SU_PV(2); SU_PV(3);
        asm volatile("s_waitcnt lgkmcnt(0)" ::: "memory");
    }
#undef SU_PV
#undef SU_TRRD
#undef SU_WRV
#undef SU_WRK
#undef SU_LOAD
#undef SU_BASE
    float* Sp = WSP(float, WS_SPART) + ((size_t)(bh * 32 + pg) * 8) * 128;
#pragma unroll
    for (int r = 0; r < 4; ++r)
#pragma unroll
        for (int d0 = 0; d0 < 4; ++d0) Sp[(size_t)(r + 4 * hi) * 128 + d0 * 32 + r32] = o[d0][r];
    if (hi == 0 && r32 < 8) WSP(float, WS_SCAR)[(size_t)(bh * 32 + pg) * 8 + r32] = carry;
}
}
__device__ __forceinline__ void sample_combine(Ctx& F) {
    const int gw = F.vcu * NWAVES + F.wave, NGW = F.G * NWAVES; bf16* OAB = WSP(bf16, WS_OAB);
    const float* SPt = WSP(float, WS_SPART); const float* SCr = WSP(float, WS_SCAR);
    for (int task = gw; task < DBAT * HA * DSEQ; task += NGW) { const int bh = task >> 3, i = task & 7, b = bh >> 3, h = bh & 7; const float bias = F.in(I_SBB)[h];
        f32x2 po[32]; float sc[32];
#pragma unroll
        for (int pg = 0; pg < 32; ++pg) { po[pg] = *(const GAS f32x2*)(SPt + ((size_t)(bh * 32 + pg) * 8 + i) * 128 + 2 * F.lane); sc[pg] = SCr[(size_t)(bh * 32 + pg) * 8 + i]; }
        f32x2 q; { const unsigned qw = *(const GAS unsigned*)(WSP(bf16, WS_QB) + (size_t)(NPR + b * DSEQ + i) * 1024 + h * 128 + 2 * F.lane); q.x = __uint_as_float(qw << 16); q.y = __uint_as_float(qw & 0xffff0000u); }
        float carry = 1.f, a0 = 0.f, a1 = 0.f;
        for (int j = i - 1; j >= 0; --j) { const size_t ko = (size_t)(b * DSEQ + j) * 1024 + h * 128 + 2 * F.lane; const f32x2 k = *(const GAS f32x2*)(F.outp() + O_KS + ko), v = *(const GAS f32x2*)(F.outp() + O_VS + ko);
            const float z = wave_sum(q.x * k.x + q.y * k.y) * QK_SCALE + bias, e = __expf(fminf(z, 40.f)), om = 1.f / (1.f + e), w = e * om * carry;
            a0 += w * v.x; a1 += w * v.y; carry *= om; }
#pragma unroll
        for (int pg = 31; pg >= 0; --pg) { a0 += carry * po[pg].x; a1 += carry * po[pg].y; carry *= sc[pg]; }
        *(GAS unsigned*)(OAB + (size_t)(NPR + b * DSEQ + i) * DM + h * 128 + 2 * F.lane) = cvt_pk_bf16(a0, a1);
    }
}
__device__ __forceinline__ void phase_attn_prompt(Ctx& F) {
    for (int it2 = 2 * F.vcu; it2 < 2 * NBATCH * HA * 16; it2 += (it2 & 1) ? 2 * F.G - 1 : 1) { const int item = it2 >> 1, half = it2 & 1, bh = item >> 4, x = item & 15;
        sba::attn_half(F, bh, half ? 15 - x : x, half); }
    __syncthreads();
}
__device__ __forceinline__ void dots16(float& sig, float& rho, float kkv, float wrv, const float (&s)[16]) {
    asm("s_nop 1\n\t"
        "v_fmac_f32_dpp %0, %2, %4 row_newbcast:0 row_mask:0xf bank_mask:0xf\n\t"
        "v_fmac_f32_dpp %1, %3, %4 row_newbcast:0 row_mask:0xf bank_mask:0xf\n\t"
        "v_fmac_f32_dpp %0, %2, %5 row_newbcast:1 row_mask:0xf bank_mask:0xf\n\t"
        "v_fmac_f32_dpp %1, %3, %5 row_newbcast:1 row_mask:0xf bank_mask:0xf\n\t"
        "v_fmac_f32_dpp %0, %2, %6 row_newbcast:2 row_mask:0xf bank_mask:0xf\n\t"
        "v_fmac_f32_dpp %1, %3, %6 row_newbcast:2 row_mask:0xf bank_mask:0xf\n\t"
        "v_fmac_f32_dpp %0, %2, %7 row_newbcast:3 row_mask:0xf bank_mask:0xf\n\t"
        "v_fmac_f32_dpp %1, %3, %7 row_newbcast:3 row_mask:0xf bank_mask:0xf\n\t"
        "v_fmac_f32_dpp %0, %2, %8 row_newbcast:4 row_mask:0xf bank_mask:0xf\n\t"
        "v_fmac_f32_dpp %1, %3, %8 row_newbcast:4 row_mask:0xf bank_mask:0xf\n\t"
        "v_fmac_f32_dpp %0, %2, %9 row_newbcast:5 row_mask:0xf bank_mask:0xf\n\t"
        "v_fmac_f32_dpp %1, %3, %9 row_newbcast:5 row_mask:0xf bank_mask:0xf\n\t"
        "v_fmac_f32_dpp %0, %2, %10 row_newbcast:6 row_mask:0xf bank_mask:0xf\n\t"
        "v_fmac_f32_dpp %1, %3, %10 row_newbcast:6 row_mask:0xf bank_mask:0xf\n\t"
        "v_fmac_f32_dpp %0, %2, %11 row_newbcast:7 row_mask:0xf bank_mask:0xf\n\t"
        "v_fmac_f32_dpp %1, %3, %11 row_newbcast:7 row_mask:0xf bank_mask:0xf\n\t"
        "v_fmac_f32_dpp %0, %2, %12 row_newbcast:8 row_mask:0xf bank_mask:0xf\n\t"
        "v_fmac_f32_dpp %1, %3, %12 row_newbcast:8 row_mask:0xf bank_mask:0xf\n\t"
        "v_fmac_f32_dpp %0, %2, %13 row_newbcast:9 row_mask:0xf bank_mask:0xf\n\t"
        "v_fmac_f32_dpp %1, %3, %13 row_newbcast:9 row_mask:0xf bank_mask:0xf\n\t"
        "v_fmac_f32_dpp %0, %2, %14 row_newbcast:10 row_mask:0xf bank_mask:0xf\n\t"
        "v_fmac_f32_dpp %1, %3, %14 row_newbcast:10 row_mask:0xf bank_mask:0xf\n\t"
        "v_fmac_f32_dpp %0, %2, %15 row_newbcast:11 row_mask:0xf bank_mask:0xf\n\t"
        "v_fmac_f32_dpp %1, %3, %15 row_newbcast:11 row_mask:0xf bank_mask:0xf\n\t"
        "v_fmac_f32_dpp %0, %2, %16 row_newbcast:12 row_mask:0xf bank_mask:0xf\n\t"
        "v_fmac_f32_dpp %1, %3, %16 row_newbcast:12 row_mask:0xf bank_mask:0xf\n\t"
        "v_fmac_f32_dpp %0, %2, %17 row_newbcast:13 row_mask:0xf bank_mask:0xf\n\t"
        "v_fmac_f32_dpp %1, %3, %17 row_newbcast:13 row_mask:0xf bank_mask:0xf\n\t"
        "v_fmac_f32_dpp %0, %2, %18 row_newbcast:14 row_mask:0xf bank_mask:0xf\n\t"
        "v_fmac_f32_dpp %1, %3, %18 row_newbcast:14 row_mask:0xf bank_mask:0xf\n\t"
        "v_fmac_f32_dpp %0, %2, %19 row_newbcast:15 row_mask:0xf bank_mask:0xf\n\t"
        "v_fmac_f32_dpp %1, %3, %19 row_newbcast:15 row_mask:0xf bank_mask:0xf\n\t"
        "s_nop 1"
        : "+v"(sig), "+v"(rho) : "v"(kkv), "v"(wrv), "v"(s[0]), "v"(s[1]), "v"(s[2]), "v"(s[3]), "v"(s[4]), "v"(s[5]), "v"(s[6]), "v"(s[7]), "v"(s[8]), "v"(s[9]), "v"(s[10]), "v"(s[11]), "v"(s[12]), "v"(s[13]), "v"(s[14]), "v"(s[15]));
}
__device__ __forceinline__ void dot16(float& acc, float zv, const float (&s)[16]) {
    asm("s_nop 1\n\t"
        "v_fmac_f32_dpp %0, %1, %2 row_newbcast:0 row_mask:0xf bank_mask:0xf\n\t"
        "v_fmac_f32_dpp %0, %1, %3 row_newbcast:1 row_mask:0xf bank_mask:0xf\n\t"
        "v_fmac_f32_dpp %0, %1, %4 row_newbcast:2 row_mask:0xf bank_mask:0xf\n\t"
        "v_fmac_f32_dpp %0, %1, %5 row_newbcast:3 row_mask:0xf bank_mask:0xf\n\t"
        "v_fmac_f32_dpp %0, %1, %6 row_newbcast:4 row_mask:0xf bank_mask:0xf\n\t"
        "v_fmac_f32_dpp %0, %1, %7 row_newbcast:5 row_mask:0xf bank_mask:0xf\n\t"
        "v_fmac_f32_dpp %0, %1, %8 row_newbcast:6 row_mask:0xf bank_mask:0xf\n\t"
        "v_fmac_f32_dpp %0, %1, %9 row_newbcast:7 row_mask:0xf bank_mask:0xf\n\t"
        "v_fmac_f32_dpp %0, %1, %10 row_newbcast:8 row_mask:0xf bank_mask:0xf\n\t"
        "v_fmac_f32_dpp %0, %1, %11 row_newbcast:9 row_mask:0xf bank_mask:0xf\n\t"
        "v_fmac_f32_dpp %0, %1, %12 row_newbcast:10 row_mask:0xf bank_mask:0xf\n\t"
        "v_fmac_f32_dpp %0, %1, %13 row_newbcast:11 row_mask:0xf bank_mask:0xf\n\t"
        "v_fmac_f32_dpp %0, %1, %14 row_newbcast:12 row_mask:0xf bank_mask:0xf\n\t"
        "v_fmac_f32_dpp %0, %1, %15 row_newbcast:13 row_mask:0xf bank_mask:0xf\n\t"
        "v_fmac_f32_dpp %0, %1, %16 row_newbcast:14 row_mask:0xf bank_mask:0xf\n\t"
        "v_fmac_f32_dpp %0, %1, %17 row_newbcast:15 row_mask:0xf bank_mask:0xf\n\t"
        "s_nop 1"
        : "+v"(acc) : "v"(zv), "v"(s[0]), "v"(s[1]), "v"(s[2]), "v"(s[3]), "v"(s[4]), "v"(s[5]), "v"(s[6]), "v"(s[7]), "v"(s[8]), "v"(s[9]), "v"(s[10]), "v"(s[11]), "v"(s[12]), "v"(s[13]), "v"(s[14]), "v"(s[15]));
}
__device__ __forceinline__ void upd16_v(float (&s)[16], float wv, float kv, float bv, float vv, float ns) {
    asm("s_nop 1\n\t"
        "v_mul_f32_dpp %0, %16, %0 row_newbcast:0 row_mask:0xf bank_mask:0xf\n\t"
        "v_mul_f32_dpp %1, %16, %1 row_newbcast:1 row_mask:0xf bank_mask:0xf\n\t"
        "v_mul_f32_dpp %2, %16, %2 row_newbcast:2 row_mask:0xf bank_mask:0xf\n\t"
        "v_mul_f32_dpp %3, %16, %3 row_newbcast:3 row_mask:0xf bank_mask:0xf\n\t"
        "v_mul_f32_dpp %4, %16, %4 row_newbcast:4 row_mask:0xf bank_mask:0xf\n\t"
        "v_mul_f32_dpp %5, %16, %5 row_newbcast:5 row_mask:0xf bank_mask:0xf\n\t"
        "v_mul_f32_dpp %6, %16, %6 row_newbcast:6 row_mask:0xf bank_mask:0xf\n\t"
        "v_mul_f32_dpp %7, %16, %7 row_newbcast:7 row_mask:0xf bank_mask:0xf\n\t"
        "v_mul_f32_dpp %8, %16, %8 row_newbcast:8 row_mask:0xf bank_mask:0xf\n\t"
        "v_mul_f32_dpp %9, %16, %9 row_newbcast:9 row_mask:0xf bank_mask:0xf\n\t"
        "v_mul_f32_dpp %10, %16, %10 row_newbcast:10 row_mask:0xf bank_mask:0xf\n\t"
        "v_mul_f32_dpp %11, %16, %11 row_newbcast:11 row_mask:0xf bank_mask:0xf\n\t"
        "v_mul_f32_dpp %12, %16, %12 row_newbcast:12 row_mask:0xf bank_mask:0xf\n\t"
        "v_mul_f32_dpp %13, %16, %13 row_newbcast:13 row_mask:0xf bank_mask:0xf\n\t"
        "v_mul_f32_dpp %14, %16, %14 row_newbcast:14 row_mask:0xf bank_mask:0xf\n\t"
        "v_mul_f32_dpp %15, %16, %15 row_newbcast:15 row_mask:0xf bank_mask:0xf\n\t"
        "v_fmac_f32_dpp %0, %17, %19 row_newbcast:0 row_mask:0xf bank_mask:0xf\n\t"
        "v_fmac_f32_dpp %1, %17, %19 row_newbcast:1 row_mask:0xf bank_mask:0xf\n\t"
        "v_fmac_f32_dpp %2, %17, %19 row_newbcast:2 row_mask:0xf bank_mask:0xf\n\t"
        "v_fmac_f32_dpp %3, %17, %19 row_newbcast:3 row_mask:0xf bank_mask:0xf\n\t"
        "v_fmac_f32_dpp %4, %17, %19 row_newbcast:4 row_mask:0xf bank_mask:0xf\n\t"
        "v_fmac_f32_dpp %5, %17, %19 row_newbcast:5 row_mask:0xf bank_mask:0xf\n\t"
        "v_fmac_f32_dpp %6, %17, %19 row_newbcast:6 row_mask:0xf bank_mask:0xf\n\t"
        "v_fmac_f32_dpp %7, %17, %19 row_newbcast:7 row_mask:0xf bank_mask:0xf\n\t"
        "v_fmac_f32_dpp %8, %17, %19 row_newbcast:8 row_mask:0xf bank_mask:0xf\n\t"
        "v_fmac_f32_dpp %9, %17, %19 row_newbcast:9 row_mask:0xf bank_mask:0xf\n\t"
        "v_fmac_f32_dpp %10, %17, %19 row_newbcast:10 row_mask:0xf bank_mask:0xf\n\t"
        "v_fmac_f32_dpp %11, %17, %19 row_newbcast:11 row_mask:0xf bank_mask:0xf\n\t"
        "v_fmac_f32_dpp %12, %17, %19 row_newbcast:12 row_mask:0xf bank_mask:0xf\n\t"
        "v_fmac_f32_dpp %13, %17, %19 row_newbcast:13 row_mask:0xf bank_mask:0xf\n\t"
        "v_fmac_f32_dpp %14, %17, %19 row_newbcast:14 row_mask:0xf bank_mask:0xf\n\t"
        "v_fmac_f32_dpp %15, %17, %19 row_newbcast:15 row_mask:0xf bank_mask:0xf\n\t"
        "v_fmac_f32_dpp %0, %18, %20 row_newbcast:0 row_mask:0xf bank_mask:0xf\n\t"
        "v_fmac_f32_dpp %1, %18, %20 row_newbcast:1 row_mask:0xf bank_mask:0xf\n\t"
        "v_fmac_f32_dpp %2, %18, %20 row_newbcast:2 row_mask:0xf bank_mask:0xf\n\t"
        "v_fmac_f32_dpp %3, %18, %20 row_newbcast:3 row_mask:0xf bank_mask:0xf\n\t"
        "v_fmac_f32_dpp %4, %18, %20 row_newbcast:4 row_mask:0xf bank_mask:0xf\n\t"
        "v_fmac_f32_dpp %5, %18, %20 row_newbcast:5 row_mask:0xf bank_mask:0xf\n\t"
        "v_fmac_f32_dpp %6, %18, %20 row_newbcast:6 row_mask:0xf bank_mask:0xf\n\t"
        "v_fmac_f32_dpp %7, %18, %20 row_newbcast:7 row_mask:0xf bank_mask:0xf\n\t"
        "v_fmac_f32_dpp %8, %18, %20 row_newbcast:8 row_mask:0xf bank_mask:0xf\n\t"
        "v_fmac_f32_dpp %9, %18, %20 row_newbcast:9 row_mask:0xf bank_mask:0xf\n\t"
        "v_fmac_f32_dpp %10, %18, %20 row_newbcast:10 row_mask:0xf bank_mask:0xf\n\t"
        "v_fmac_f32_dpp %11, %18, %20 row_newbcast:11 row_mask:0xf bank_mask:0xf\n\t"
        "v_fmac_f32_dpp %12, %18, %20 row_newbcast:12 row_mask:0xf bank_mask:0xf\n\t"
        "v_fmac_f32_dpp %13, %18, %20 row_newbcast:13 row_mask:0xf bank_mask:0xf\n\t"
        "v_fmac_f32_dpp %14, %18, %20 row_newbcast:14 row_mask:0xf bank_mask:0xf\n\t"
        "v_fmac_f32_dpp %15, %18, %20 row_newbcast:15 row_mask:0xf bank_mask:0xf\n\t"
        "s_nop 1"
        : "+v"(s[0]), "+v"(s[1]), "+v"(s[2]), "+v"(s[3]), "+v"(s[4]), "+v"(s[5]), "+v"(s[6]), "+v"(s[7]), "+v"(s[8]), "+v"(s[9]), "+v"(s[10]), "+v"(s[11]), "+v"(s[12]), "+v"(s[13]), "+v"(s[14]), "+v"(s[15]) : "v"(wv), "v"(kv), "v"(bv), "v"(vv), "v"(ns));
}
__device__ __forceinline__ void upd16_nov(float (&s)[16], float wv, float kv, float bv, float vv, float ns) {
    asm("s_nop 1\n\t"
        "v_mul_f32_dpp %0, %16, %0 row_newbcast:0 row_mask:0xf bank_mask:0xf\n\t"
        "v_mul_f32_dpp %1, %16, %1 row_newbcast:1 row_mask:0xf bank_mask:0xf\n\t"
        "v_mul_f32_dpp %2, %16, %2 row_newbcast:2 row_mask:0xf bank_mask:0xf\n\t"
        "v_mul_f32_dpp %3, %16, %3 row_newbcast:3 row_mask:0xf bank_mask:0xf\n\t"
        "v_mul_f32_dpp %4, %16, %4 row_newbcast:4 row_mask:0xf bank_mask:0xf\n\t"
        "v_mul_f32_dpp %5, %16, %5 row_newbcast:5 row_mask:0xf bank_mask:0xf\n\t"
        "v_mul_f32_dpp %6, %16, %6 row_newbcast:6 row_mask:0xf bank_mask:0xf\n\t"
        "v_mul_f32_dpp %7, %16, %7 row_newbcast:7 row_mask:0xf bank_mask:0xf\n\t"
        "v_mul_f32_dpp %8, %16, %8 row_newbcast:8 row_mask:0xf bank_mask:0xf\n\t"
        "v_mul_f32_dpp %9, %16, %9 row_newbcast:9 row_mask:0xf bank_mask:0xf\n\t"
        "v_mul_f32_dpp %10, %16, %10 row_newbcast:10 row_mask:0xf bank_mask:0xf\n\t"
        "v_mul_f32_dpp %11, %16, %11 row_newbcast:11 row_mask:0xf bank_mask:0xf\n\t"
        "v_mul_f32_dpp %12, %16, %12 row_newbcast:12 row_mask:0xf bank_mask:0xf\n\t"
        "v_mul_f32_dpp %13, %16, %13 row_newbcast:13 row_mask:0xf bank_mask:0xf\n\t"
        "v_mul_f32_dpp %14, %16, %14 row_newbcast:14 row_mask:0xf bank_mask:0xf\n\t"
        "v_mul_f32_dpp %15, %16, %15 row_newbcast:15 row_mask:0xf bank_mask:0xf\n\t"
        "v_fmac_f32_dpp %0, %18, %20 row_newbcast:0 row_mask:0xf bank_mask:0xf\n\t"
        "v_fmac_f32_dpp %1, %18, %20 row_newbcast:1 row_mask:0xf bank_mask:0xf\n\t"
        "v_fmac_f32_dpp %2, %18, %20 row_newbcast:2 row_mask:0xf bank_mask:0xf\n\t"
        "v_fmac_f32_dpp %3, %18, %20 row_newbcast:3 row_mask:0xf bank_mask:0xf\n\t"
        "v_fmac_f32_dpp %4, %18, %20 row_newbcast:4 row_mask:0xf bank_mask:0xf\n\t"
        "v_fmac_f32_dpp %5, %18, %20 row_newbcast:5 row_mask:0xf bank_mask:0xf\n\t"
        "v_fmac_f32_dpp %6, %18, %20 row_newbcast:6 row_mask:0xf bank_mask:0xf\n\t"
        "v_fmac_f32_dpp %7, %18, %20 row_newbcast:7 row_mask:0xf bank_mask:0xf\n\t"
        "v_fmac_f32_dpp %8, %18, %20 row_newbcast:8 row_mask:0xf bank_mask:0xf\n\t"
        "v_fmac_f32_dpp %9, %18, %20 row_newbcast:9 row_mask:0xf bank_mask:0xf\n\t"
        "v_fmac_f32_dpp %10, %18, %20 row_newbcast:10 row_mask:0xf bank_mask:0xf\n\t"
        "v_fmac_f32_dpp %11, %18, %20 row_newbcast:11 row_mask:0xf bank_mask:0xf\n\t"
        "v_fmac_f32_dpp %12, %18, %20 row_newbcast:12 row_mask:0xf bank_mask:0xf\n\t"
        "v_fmac_f32_dpp %13, %18, %20 row_newbcast:13 row_mask:0xf bank_mask:0xf\n\t"
        "v_fmac_f32_dpp %14, %18, %20 row_newbcast:14 row_mask:0xf bank_mask:0xf\n\t"
        "v_fmac_f32_dpp %15, %18, %20 row_newbcast:15 row_mask:0xf bank_mask:0xf\n\t"
        "s_nop 1"
        : "+v"(s[0]), "+v"(s[1]), "+v"(s[2]), "+v"(s[3]), "+v"(s[4]), "+v"(s[5]), "+v"(s[6]), "+v"(s[7]), "+v"(s[8]), "+v"(s[9]), "+v"(s[10]), "+v"(s[11]), "+v"(s[12]), "+v"(s[13]), "+v"(s[14]), "+v"(s[15]) : "v"(wv), "v"(kv), "v"(bv), "v"(vv), "v"(ns));
}
__device__ __forceinline__ float xrow16_sum(float x) {
    auto s = __builtin_amdgcn_permlane16_swap(__float_as_uint(x), __float_as_uint(x), false, false);
    x = __uint_as_float(s[0]) + __uint_as_float(s[1]);
    auto t = __builtin_amdgcn_permlane32_swap(__float_as_uint(x), __float_as_uint(x), false, false);
    return __uint_as_float(t[0]) + __uint_as_float(t[1]);
}
struct StepIn { float wv, kkv, bv, kv, wrv, vv, beta, kappa; };
template <bool PROW> __device__ __forceinline__ void scan_load(StepIn& x, const float* RWV, const float* SCL, int r, int h, int lane, int row) {
    const float* base = RWV + ((size_t)r * HB + h) * 512; const float* sc = SCL + ((size_t)r * HB + h) * 4;
    x.wv = base[lane]; x.kkv = base[64 + lane]; x.bv = base[128 + lane]; x.wrv = base[384 + lane]; x.beta = sc[0];
    if (!PROW) { x.kv = base[192 + lane]; x.vv = base[320 + row]; x.kappa = sc[1]; } else { x.kv = 0.f; x.vv = 0.f; x.kappa = 0.f; }
}
template <bool PROW, bool SAMP> __device__ __forceinline__ void scan_wave(Ctx& F, int bh, int c, int g) {
    const int lane = F.lane, q = lane >> 4, m = lane & 15, row = 16 * g + m, h = bh & 15, b = bh >> 4;
    constexpr int L = SAMP ? DSEQ : 64; const int r0 = SAMP ? NPR + b * DSEQ : b * SEQ + c * 64; const int ch = bh * 64 + c;
    const float* RWV = WSP(float, WS_RWV); const float* SCL = WSP(float, WS_SCL); float* Y = WSP(float, WS_Y); float* Z = WSP(float, WS_Z); float* PU = WSP(float, WS_PU);
    float s[16];
    if (SAMP) { const float* st = F.in(I_SWKV) + ((size_t)bh * 64 + row) * 64 + 16 * q;
#pragma unroll
        for (int i = 0; i < 16; i += 4) { const f32x4 v = *(const GAS f32x4*)(st + i); s[i] = v.x; s[i + 1] = v.y; s[i + 2] = v.z; s[i + 3] = v.w; } }
    else {
#pragma unroll
        for (int i = 0; i < 16; ++i) s[i] = (PROW && (16 * q + i) == row) ? 1.f : 0.f; }
    StepIn buf[4];
#pragma unroll
    for (int u = 0; u < 4; ++u) scan_load<PROW>(buf[u], RWV, SCL, r0 + u, h, lane, row);
    for (int t = 0; t < L; t += 4) {
#pragma unroll
        for (int u = 0; u < 4; ++u) {
            const StepIn x = buf[u];
            if (t + u + 4 < L) scan_load<PROW>(buf[u], RWV, SCL, r0 + t + u + 4, h, lane, row);
            float sig = 0.f, rho = 0.f;
            dots16(sig, rho, x.kkv, x.wrv, s);
            sig = xrow16_sum(sig); rho = xrow16_sum(rho);
            const float ns = -sig;
            float y = rho + ns * x.beta; if (!PROW) y += x.vv * x.kappa;
            if (q == 0) { if (PROW) Z[((size_t)ch * 64 + t + u) * 64 + row] = y; else Y[(size_t)(r0 + t + u) * 1024 + h * 64 + row] = y; }
            if (PROW) upd16_nov(s, x.wv, x.kv, x.bv, x.vv, ns); else upd16_v(s, x.wv, x.kv, x.bv, x.vv, ns);
        }
    }
    float* dst = SAMP ? F.outp() + O_WKVS + ((size_t)bh * 64 + row) * 64 + 16 * q : PU + (((size_t)ch * 2 + (PROW ? 1 : 0)) * 64 + row) * 64 + 16 * q;
#pragma unroll
    for (int i = 0; i < 16; i += 4) *(GAS f32x4*)(dst + i) = (f32x4){s[i], s[i + 1], s[i + 2], s[i + 3]};
}
__device__ __forceinline__ void dots2_h0(float& sgu, float& rhu, float& sgp, float& rhp, float kkv, float wrv, const float (&su)[16], const float (&sp)[16]) {
    asm("s_nop 1\n\t"
        "v_fmac_f32_dpp %0, %4, %6 row_newbcast:0 row_mask:0xf bank_mask:0xf\n\t"
        "v_fmac_f32_dpp %1, %5, %6 row_newbcast:0 row_mask:0xf bank_mask:0xf\n\t"
        "v_fmac_f32_dpp %2, %4, %14 row_newbcast:0 row_mask:0xf bank_mask:0xf\n\t"
        "v_fmac_f32_dpp %3, %5, %14 row_newbcast:0 row_mask:0xf bank_mask:0xf\n\t"
        "v_fmac_f32_dpp %0, %4, %7 row_newbcast:1 row_mask:0xf bank_mask:0xf\n\t"
        "v_fmac_f32_dpp %1, %5, %7 row_newbcast:1 row_mask:0xf bank_mask:0xf\n\t"
        "v_fmac_f32_dpp %2, %4, %15 row_newbcast:1 row_mask:0xf bank_mask:0xf\n\t"
        "v_fmac_f32_dpp %3, %5, %15 row_newbcast:1 row_mask:0xf bank_mask:0xf\n\t"
        "v_fmac_f32_dpp %0, %4, %8 row_newbcast:2 row_mask:0xf bank_mask:0xf\n\t"
        "v_fmac_f32_dpp %1, %5, %8 row_newbcast:2 row_mask:0xf bank_mask:0xf\n\t"
        "v_fmac_f32_dpp %2, %4, %16 row_newbcast:2 row_mask:0xf bank_mask:0xf\n\t"
        "v_fmac_f32_dpp %3, %5, %16 row_newbcast:2 row_mask:0xf bank_mask:0xf\n\t"
        "v_fmac_f32_dpp %0, %4, %9 row_newbcast:3 row_mask:0xf bank_mask:0xf\n\t"
        "v_fmac_f32_dpp %1, %5, %9 row_newbcast:3 row_mask:0xf bank_mask:0xf\n\t"
        "v_fmac_f32_dpp %2, %4, %17 row_newbcast:3 row_mask:0xf bank_mask:0xf\n\t"
        "v_fmac_f32_dpp %3, %5, %17 row_newbcast:3 row_mask:0xf bank_mask:0xf\n\t"
        "v_fmac_f32_dpp %0, %4, %10 row_newbcast:4 row_mask:0xf bank_mask:0xf\n\t"
        "v_fmac_f32_dpp %1, %5, %10 row_newbcast:4 row_mask:0xf bank_mask:0xf\n\t"
        "v_fmac_f32_dpp %2, %4, %18 row_newbcast:4 row_mask:0xf bank_mask:0xf\n\t"
        "v_fmac_f32_dpp %3, %5, %18 row_newbcast:4 row_mask:0xf bank_mask:0xf\n\t"
        "v_fmac_f32_dpp %0, %4, %11 row_newbcast:5 row_mask:0xf bank_mask:0xf\n\t"
        "v_fmac_f32_dpp %1, %5, %11 row_newbcast:5 row_mask:0xf bank_mask:0xf\n\t"
        "v_fmac_f32_dpp %2, %4, %19 row_newbcast:5 row_mask:0xf bank_mask:0xf\n\t"
        "v_fmac_f32_dpp %3, %5, %19 row_newbcast:5 row_mask:0xf bank_mask:0xf\n\t"
        "v_fmac_f32_dpp %0, %4, %12 row_newbcast:6 row_mask:0xf bank_mask:0xf\n\t"
        "v_fmac_f32_dpp %1, %5, %12 row_newbcast:6 row_mask:0xf bank_mask:0xf\n\t"
        "v_fmac_f32_dpp %2, %4, %20 row_newbcast:6 row_mask:0xf bank_mask:0xf\n\t"
        "v_fmac_f32_dpp %3, %5, %20 row_newbcast:6 row_mask:0xf bank_mask:0xf\n\t"
        "v_fmac_f32_dpp %0, %4, %13 row_newbcast:7 row_mask:0xf bank_mask:0xf\n\t"
        "v_fmac_f32_dpp %1, %5, %13 row_newbcast:7 row_mask:0xf bank_mask:0xf\n\t"
        "v_fmac_f32_dpp %2, %4, %21 row_newbcast:7 row_mask:0xf bank_mask:0xf\n\t"
        "v_fmac_f32_dpp %3, %5, %21 row_newbcast:7 row_mask:0xf bank_mask:0xf\n\t"
        "s_nop 1"
        : "+v"(sgu), "+v"(rhu), "+v"(sgp), "+v"(rhp) : "v"(kkv), "v"(wrv), "v"(su[0]), "v"(su[1]), "v"(su[2]), "v"(su[3]), "v"(su[4]), "v"(su[5]), "v"(su[6]), "v"(su[7]), "v"(sp[0]), "v"(sp[1]), "v"(sp[2]), "v"(sp[3]), "v"(sp[4]), "v"(sp[5]), "v"(sp[6]), "v"(sp[7]));
}
__device__ __forceinline__ void dots2_h1(float& sgu, float& rhu, float& sgp, float& rhp, float kkv, float wrv, const float (&su)[16], const float (&sp)[16]) {
    asm("s_nop 1\n\t"
        "v_fmac_f32_dpp %0, %4, %6 row_newbcast:8 row_mask:0xf bank_mask:0xf\n\t"
        "v_fmac_f32_dpp %1, %5, %6 row_newbcast:8 row_mask:0xf bank_mask:0xf\n\t"
        "v_fmac_f32_dpp %2, %4, %14 row_newbcast:8 row_mask:0xf bank_mask:0xf\n\t"
        "v_fmac_f32_dpp %3, %5, %14 row_newbcast:8 row_mask:0xf bank_mask:0xf\n\t"
        "v_fmac_f32_dpp %0, %4, %7 row_newbcast:9 row_mask:0xf bank_mask:0xf\n\t"
        "v_fmac_f32_dpp %1, %5, %7 row_newbcast:9 row_mask:0xf bank_mask:0xf\n\t"
        "v_fmac_f32_dpp %2, %4, %15 row_newbcast:9 row_mask:0xf bank_mask:0xf\n\t"
        "v_fmac_f32_dpp %3, %5, %15 row_newbcast:9 row_mask:0xf bank_mask:0xf\n\t"
        "v_fmac_f32_dpp %0, %4, %8 row_newbcast:10 row_mask:0xf bank_mask:0xf\n\t"
        "v_fmac_f32_dpp %1, %5, %8 row_newbcast:10 row_mask:0xf bank_mask:0xf\n\t"
        "v_fmac_f32_dpp %2, %4, %16 row_newbcast:10 row_mask:0xf bank_mask:0xf\n\t"
        "v_fmac_f32_dpp %3, %5, %16 row_newbcast:10 row_mask:0xf bank_mask:0xf\n\t"
        "v_fmac_f32_dpp %0, %4, %9 row_newbcast:11 row_mask:0xf bank_mask:0xf\n\t"
        "v_fmac_f32_dpp %1, %5, %9 row_newbcast:11 row_mask:0xf bank_mask:0xf\n\t"
        "v_fmac_f32_dpp %2, %4, %17 row_newbcast:11 row_mask:0xf bank_mask:0xf\n\t"
        "v_fmac_f32_dpp %3, %5, %17 row_newbcast:11 row_mask:0xf bank_mask:0xf\n\t"
        "v_fmac_f32_dpp %0, %4, %10 row_newbcast:12 row_mask:0xf bank_mask:0xf\n\t"
        "v_fmac_f32_dpp %1, %5, %10 row_newbcast:12 row_mask:0xf bank_mask:0xf\n\t"
        "v_fmac_f32_dpp %2, %4, %18 row_newbcast:12 row_mask:0xf bank_mask:0xf\n\t"
        "v_fmac_f32_dpp %3, %5, %18 row_newbcast:12 row_mask:0xf bank_mask:0xf\n\t"
        "v_fmac_f32_dpp %0, %4, %11 row_newbcast:13 row_mask:0xf bank_mask:0xf\n\t"
        "v_fmac_f32_dpp %1, %5, %11 row_newbcast:13 row_mask:0xf bank_mask:0xf\n\t"
        "v_fmac_f32_dpp %2, %4, %19 row_newbcast:13 row_mask:0xf bank_mask:0xf\n\t"
        "v_fmac_f32_dpp %3, %5, %19 row_newbcast:13 row_mask:0xf bank_mask:0xf\n\t"
        "v_fmac_f32_dpp %0, %4, %12 row_newbcast:14 row_mask:0xf bank_mask:0xf\n\t"
        "v_fmac_f32_dpp %1, %5, %12 row_newbcast:14 row_mask:0xf bank_mask:0xf\n\t"
        "v_fmac_f32_dpp %2, %4, %20 row_newbcast:14 row_mask:0xf bank_mask:0xf\n\t"
        "v_fmac_f32_dpp %3, %5, %20 row_newbcast:14 row_mask:0xf bank_mask:0xf\n\t"
        "v_fmac_f32_dpp %0, %4, %13 row_newbcast:15 row_mask:0xf bank_mask:0xf\n\t"
        "v_fmac_f32_dpp %1, %5, %13 row_newbcast:15 row_mask:0xf bank_mask:0xf\n\t"
        "v_fmac_f32_dpp %2, %4, %21 row_newbcast:15 row_mask:0xf bank_mask:0xf\n\t"
        "v_fmac_f32_dpp %3, %5, %21 row_newbcast:15 row_mask:0xf bank_mask:0xf\n\t"
        "s_nop 1"
        : "+v"(sgu), "+v"(rhu), "+v"(sgp), "+v"(rhp) : "v"(kkv), "v"(wrv), "v"(su[8]), "v"(su[9]), "v"(su[10]), "v"(su[11]), "v"(su[12]), "v"(su[13]), "v"(su[14]), "v"(su[15]), "v"(sp[8]), "v"(sp[9]), "v"(sp[10]), "v"(sp[11]), "v"(sp[12]), "v"(sp[13]), "v"(sp[14]), "v"(sp[15]));
}
__device__ __forceinline__ void scan_wave_up(Ctx& F, int bh, int c, int g) {
    const int lane = F.lane, q = lane >> 4, m = lane & 15, row = 16 * g + m, h = bh & 15, b = bh >> 4;
    const int r0 = b * SEQ + c * 64, ch = bh * 64 + c;
    const float* RWV = WSP(float, WS_RWV); const float* SCL = WSP(float, WS_SCL); float* Y = WSP(float, WS_Y); float* Z = WSP(float, WS_Z); float* PU = WSP(float, WS_PU);
    float su[16], sp[16];
#pragma unroll
    for (int i = 0; i < 16; ++i) { su[i] = 0.f; sp[i] = ((16 * q + i) == row) ? 1.f : 0.f; }
    StepIn buf[4];
#pragma unroll
    for (int u = 0; u < 4; ++u) scan_load<false>(buf[u], RWV, SCL, r0 + u, h, lane, row);
    for (int t = 0; t < 64; t += 4) {
#pragma unroll
        for (int u = 0; u < 4; ++u) {
            const StepIn x = buf[u];
            if (t + u + 4 < 64) scan_load<false>(buf[u], RWV, SCL, r0 + t + u + 4, h, lane, row);
            float sgu = 0.f, rhu = 0.f, sgp = 0.f, rhp = 0.f;
            dots2_h0(sgu, rhu, sgp, rhp, x.kkv, x.wrv, su, sp); dots2_h1(sgu, rhu, sgp, rhp, x.kkv, x.wrv, su, sp);
            sgu = xrow16_sum(sgu); rhu = xrow16_sum(rhu); sgp = xrow16_sum(sgp); rhp = xrow16_sum(rhp);
            const float nsu = -sgu, nsp = -sgp;
            const float y = rhu + nsu * x.beta + x.vv * x.kappa, z = rhp + nsp * x.beta;
            if (q == 0) { Y[(size_t)(r0 + t + u) * 1024 + h * 64 + row] = y; Z[((size_t)ch * 64 + t + u) * 64 + row] = z; }
            upd16_v(su, x.wv, x.kv, x.bv, x.vv, nsu); upd16_nov(sp, x.wv, x.kv, x.bv, x.vv, nsp);
        }
    }
    float* du = PU + (((size_t)ch * 2 + 0) * 64 + row) * 64 + 16 * q; float* dp = PU + (((size_t)ch * 2 + 1) * 64 + row) * 64 + 16 * q;
#pragma unroll
    for (int i = 0; i < 16; i += 4) { *(GAS f32x4*)(du + i) = (f32x4){su[i], su[i + 1], su[i + 2], su[i + 3]}; *(GAS f32x4*)(dp + i) = (f32x4){sp[i], sp[i + 1], sp[i + 2], sp[i + 3]}; }
}
__device__ __forceinline__ void phase_scan1_stream(Ctx& F) {
    LAS int* ctr = (LAS int*)(F.lds + LDSCTL_OFF);
    __syncthreads(); if (F.tid == 0) *ctr = 0; __syncthreads();
    if (F.wave >= 6) { for (int u = F.vcu * 2 + (F.wave - 6); u < DBAT * HA * 32; u += 2 * F.G) sba::attn_sample_unit(F, u >> 5, u & 31, (char*)F.lds + F.wave * 16384); }
    constexpr int NSU = DBAT * HB / 2, NU = NSU + NBATCH * HB * 64;
    const int nunits = F.vcu < NU ? (NU - 1 - F.vcu) / F.G + 1 : 0, ntasks = nunits * 8;
    for (;;) {
        int t = 0; if (F.lane == 0) t = __hip_atomic_fetch_add(ctr, 1, __ATOMIC_RELAXED, __HIP_MEMORY_SCOPE_WORKGROUP);
        t = __builtin_amdgcn_readfirstlane(t); if (t >= ntasks) break;
        const int u = F.vcu + (t >> 3) * F.G, g8 = t & 7;
        if (u < NSU) scan_wave<false, true>(F, u * 2 + (g8 >> 2), 0, g8 & 3);
        else if (g8 < 4) { const int ch = u - NSU; scan_wave_up(F, ch >> 6, ch & 63, g8); }
    }
}
namespace msc {
using sba::bf16x8; using sba::f32x16; using sba::crow; using sba::swap_other;
constexpr int S_AQ = 136, S_BKT = 104, S_L = 40;
constexpr int O_AQ = 0, O_BK = 32 * S_AQ, O_L24 = O_BK, O_TL3 = O_BK + 32 * S_L, O_BKT = 2 * 32 * S_AQ, BLK_BYTES = O_BKT + 64 * S_BKT, O_GL = 4 * BLK_BYTES, O_GP = O_GL + 256, GRP_BYTES = O_GP + 4 * 256;
static_assert(BLK_BYTES % 8 == 0 && 2 * GRP_BYTES <= RING_BYTES, "scan LDS map");
typedef __bf16 nbf2 __attribute__((ext_vector_type(2)));
__device__ __forceinline__ unsigned cvt2(float lo, float hi) { return __builtin_bit_cast(unsigned, __builtin_convertvector((f32x2){lo, hi}, nbf2)); }
__device__ __forceinline__ bf16x8 pack8(float a0, float a1, float a2, float a3, float a4, float a5, float a6, float a7) {
    u32x4 w = {cvt2(a0, a1), cvt2(a2, a3), cvt2(a4, a5), cvt2(a6, a7)}; return *reinterpret_cast<bf16x8*>(&w); }
__device__ __forceinline__ bf16x8 pack_lo(const f32x16& c) { return pack8(c[0], c[1], c[2], c[3], c[4], c[5], c[6], c[7]); }
__device__ __forceinline__ bf16x8 pack_hi(const f32x16& c) { return pack8(c[8], c[9], c[10], c[11], c[12], c[13], c[14], c[15]); }
__device__ __forceinline__ bf16x8 perm_read(const LAS char* img, int row, int pitch, int col0, int g) {
    const LAS char* p = img + row * pitch + (col0 + 4 * g) * 2; const u32x2 lo = *(const LAS u32x2*)p, hi = *(const LAS u32x2*)(p + 16);
    u32x4 w = {lo.x, lo.y, hi.x, hi.y}; return *reinterpret_cast<bf16x8*>(&w); }
__device__ __forceinline__ bf16x8 nat_read(const LAS char* img, int row, int pitch, int col0) {
    const LAS char* p = img + row * pitch + col0 * 2; const u32x2 lo = *(const LAS u32x2*)p, hi = *(const LAS u32x2*)(p + 8);
    u32x4 w = {lo.x, lo.y, hi.x, hi.y}; return *reinterpret_cast<bf16x8*>(&w); }
__device__ __forceinline__ unsigned short bf1(float x) { return (unsigned short)(cvt_pk_bf16(x, 0.f) & 0xffffu); }
struct PrepRegs { float pr[17], pk[17], pv[17], lwl[16]; const bf16* lw; };
__device__ __forceinline__ void prep_load(Ctx& F, PrepRegs& L, int rb, int h) {
    const bf16* pb = WSP(bf16, WS_PBH) + (size_t)rb * 3072 + h * 64 + F.lane; const bf16* lw = WSP(bf16, WS_LWH) + (size_t)rb * 3072 + h * 64 + F.lane;
    L.lw = lw;
#pragma unroll
    for (int t = 0; t < 16; ++t) L.lwl[t] = ldbf_nt(lw + (size_t)t * 3072);
    if ((rb & (SEQ - 1)) != 0) { L.pr[0] = ldbf_nt(pb - 3072); L.pk[0] = ldbf_nt(pb + 1024 - 3072); L.pv[0] = ldbf_nt(pb + 2048 - 3072); } else { L.pr[0] = 0.f; L.pk[0] = 0.f; L.pv[0] = 0.f; }
#pragma unroll
    for (int t = 0; t < 16; ++t) { L.pr[t + 1] = ldbf_nt(pb + (size_t)t * 3072); L.pk[t + 1] = ldbf_nt(pb + (size_t)t * 3072 + 1024); L.pv[t + 1] = ldbf_nt(pb + (size_t)t * 3072 + 2048); }
}
__device__ __forceinline__ void prep_block(Ctx& F, PrepRegs& L, int rb, int h, int j, LAS char* gbase) {
    const int lane = F.lane, n = lane & 31, hi = lane >> 5, col = h * 64 + lane; LAS char* blk = gbase + j * BLK_BYTES;
    float lal[16];
#pragma unroll
    for (int t = 0; t < 16; ++t) lal[t] = ldbf_nt(L.lw + (size_t)t * 3072 + 1024);
    const float* mu = F.in(I_MU); const float mu_r = mu[col], mu_k = mu[1024 + col], mu_v = mu[2048 + col];
    const float w0 = F.in(I_W0)[col], a0 = F.in(I_A0)[col], kkw = F.in(I_KK)[col], kaw = F.in(I_KA)[col], rkw = F.in(I_RK)[col];
    float cw[16];
#pragma unroll
    for (int t = 0; t < 16; ++t) { const float wl = w0 + L.lwl[t], wlog = -softplusf_(-wl) - 0.5f; cw[t] = __expf(-__expf(wlog)); }
#pragma unroll
    for (int t = 1; t < 16; ++t) cw[t] *= cw[t - 1];
    *(LAS float*)(gbase + O_GP + (j * 64 + lane) * 4) = cw[15];
    __syncthreads();
    const float g0 = *(const LAS float*)(gbase + O_GP + lane * 4), g1 = *(const LAS float*)(gbase + O_GP + (64 + lane) * 4), g2 = *(const LAS float*)(gbase + O_GP + (128 + lane) * 4);
    const float G0 = (j > 0 ? g0 : 1.f) * (j > 1 ? g1 : 1.f) * (j > 2 ? g2 : 1.f);
    if (j == 3) *(LAS float*)(gbase + O_GL + lane * 4) = G0 * cw[15];
    float* SCL = WSP(float, WS_SCL) + ((size_t)rb * HB + h) * 4;
#pragma unroll
    for (int tl = 0; tl < 16; tl += 2) {
        float nb[2], kt[2], vz[2];
#pragma unroll
        for (int u = 0; u < 2; ++u) { const int t = tl + u;
            const float zr = L.pr[t + 1] + mu_r * (L.pr[t] - L.pr[t + 1]), zk = L.pk[t + 1] + mu_k * (L.pk[t] - L.pk[t + 1]); vz[u] = L.pv[t + 1] + mu_v * (L.pv[t] - L.pv[t + 1]);
            const float a_ = sigmoidf_(a0 + lal[t]);
            const float kkr = zk * kkw, kk = kkr * rsqrtf(wave_sum(kkr * kkr) + 1e-12f);
            const float k = zk * (1.f + (a_ - 1.f) * kaw), bb = kk * a_;
            const float bonus = wave_sum(zr * k * rkw);
            if (lane == 0) SCL[(size_t)t * HB * 4 + 2] = bonus;
            const float Gp = t ? G0 * cw[t ? t - 1 : 0] : G0, G = G0 * cw[t], gi = 1.f / G;
            const float a = kk * Gp, q = zr * G, bt = bb * gi; kt[u] = k * gi; nb[u] = -bt;
            *(LAS unsigned short*)(blk + O_AQ + t * S_AQ + lane * 2) = bf1(a); *(LAS unsigned short*)(blk + O_AQ + (16 + t) * S_AQ + lane * 2) = bf1(q);
            *(LAS unsigned short*)(blk + O_BK + t * S_AQ + lane * 2) = bf1(bt); *(LAS unsigned short*)(blk + O_BK + (16 + t) * S_AQ + lane * 2) = bf1(kt[u]); }
        *(LAS unsigned*)(blk + O_BKT + lane * S_BKT + tl * 2) = cvt_pk_bf16(nb[0], nb[1]); *(LAS unsigned*)(blk + O_BKT + lane * S_BKT + (16 + tl) * 2) = cvt_pk_bf16(kt[0], kt[1]);
        *(LAS unsigned*)(blk + O_BKT + lane * S_BKT + (32 + tl) * 2) = cvt_pk_bf16(vz[0], vz[1]);
    }
    LDS_WAIT(); asm volatile("" ::: "memory");
    f32x16 mt = f32x16{};
#pragma unroll
    for (int ks = 0; ks < 4; ++ks) mt = __builtin_amdgcn_mfma_f32_32x32x16_bf16(nat_read(blk + O_AQ, n, S_AQ, 16 * ks + 8 * hi), nat_read(blk + O_BK, n, S_AQ, 16 * ks + 8 * hi), mt, 0, 0, 0);
    float l1[8];
    const int i = n & 15;
#pragma unroll
    for (int r = 0; r < 16; ++r) { const int t = crow(r, hi) & 15; float val = mt[r];
        if (r < 8) { val = t > i ? val : 0.f; if (n >= 16) *(LAS unsigned short*)(blk + O_L24 + t * S_L + i * 2) = bf1(val); l1[r] = val; }
        else { val = t >= i ? val : 0.f; if (n >= 16) *(LAS unsigned short*)(blk + O_L24 + (16 + t) * S_L + i * 2) = bf1(val); else *(LAS unsigned short*)(blk + O_TL3 + (16 + t) * S_L + i * 2) = bf1(-val); } }
    float rowv[16];
#pragma unroll
    for (int r = 0; r < 8; ++r) { const float own = l1[r], oth = swap_other(own, hi); const int p0 = (r & 3) + 8 * (r >> 2); rowv[p0] = hi ? oth : own; rowv[p0 + 4] = hi ? own : oth; }
    float tl_[16];
    tl_[0] = lane == 0 ? 1.f : 0.f;
#pragma unroll
    for (int t = 1; t < 16; ++t) { float acc = lane == t ? 1.f : 0.f;
#pragma unroll
        for (int jj = 0; jj < t; ++jj) acc -= readlane_f(rowv[t], jj) * tl_[jj];
        tl_[t] = acc; }
    if (lane < 16) {
#pragma unroll
        for (int t = 0; t < 16; ++t) *(LAS unsigned short*)(blk + O_TL3 + t * S_L + lane * 2) = bf1(tl_[t]); }
    LDS_WAIT(); asm volatile("" ::: "memory");
}
__device__ __forceinline__ void chain(Ctx& F, int bh, int c, int isP, int half, const LAS char* gbase) {
    const int lane = F.lane, n = lane & 31, hi = lane >> 5, rowg = 32 * half + n, h = bh & 15, b = bh >> 4, r0 = b * SEQ + c * 64, ch = bh * 64 + c;
    const float* RWV = WSP(float, WS_RWV);
    f32x16 st0 = f32x16{}, st1 = f32x16{};
    if (isP) {
#pragma unroll
        for (int r = 0; r < 16; ++r) { st0[r] = crow(r, hi) == rowg ? 1.f : 0.f; st1[r] = 32 + crow(r, hi) == rowg ? 1.f : 0.f; } }
    for (int blk_i = 0; blk_i < 4; ++blk_i) {
        const LAS char* blk = gbase + blk_i * BLK_BYTES;
        f32x16 wt = f32x16{};
        wt = __builtin_amdgcn_mfma_f32_32x32x16_bf16(perm_read(blk + O_AQ, n, S_AQ, 0, hi), pack_lo(st0), wt, 0, 0, 0);
        wt = __builtin_amdgcn_mfma_f32_32x32x16_bf16(perm_read(blk + O_AQ, n, S_AQ, 16, hi), pack_hi(st0), wt, 0, 0, 0);
        wt = __builtin_amdgcn_mfma_f32_32x32x16_bf16(perm_read(blk + O_AQ, n, S_AQ, 32, hi), pack_lo(st1), wt, 0, 0, 0);
        wt = __builtin_amdgcn_mfma_f32_32x32x16_bf16(perm_read(blk + O_AQ, n, S_AQ, 48, hi), pack_hi(st1), wt, 0, 0, 0);
        bf16x8 bV = bf16x8{};
        if (!isP) { bV = perm_read(blk + O_BKT, rowg, S_BKT, 32, hi);
            wt = __builtin_amdgcn_mfma_f32_32x32x16_bf16(perm_read(blk + O_L24, n, S_L, 0, hi), bV, wt, 0, 0, 0); }
        const bf16x8 tl3 = perm_read(blk + O_TL3, n, S_L, 0, hi);
        const bf16x8 a_tl = n < 16 ? tl3 : bf16x8{}, a_l3 = n >= 16 ? tl3 : bf16x8{};
        const f32x16 sg = __builtin_amdgcn_mfma_f32_32x32x16_bf16(a_tl, pack_lo(wt), f32x16{}, 0, 0, 0);
        const bf16x8 bSg = pack_lo(sg);
        const f32x16 yy = __builtin_amdgcn_mfma_f32_32x32x16_bf16(a_l3, bSg, wt, 0, 0, 0);
#pragma unroll
        for (int r = 8; r < 16; ++r) { const int t = blk_i * 16 + (r & 3) + 8 * ((r - 8) >> 2) + 4 * hi;
            if (isP) WSP(float, WS_Z)[((size_t)ch * 64 + t) * 64 + rowg] = yy[r]; else WSP(float, WS_Y)[(size_t)(r0 + t) * 1024 + h * 64 + rowg] = yy[r]; }
        st0 = __builtin_amdgcn_mfma_f32_32x32x16_bf16(perm_read(blk + O_BKT, n, S_BKT, 0, hi), bSg, st0, 0, 0, 0);
        st1 = __builtin_amdgcn_mfma_f32_32x32x16_bf16(perm_read(blk + O_BKT, 32 + n, S_BKT, 0, hi), bSg, st1, 0, 0, 0);
        if (!isP) { st0 = __builtin_amdgcn_mfma_f32_32x32x16_bf16(perm_read(blk + O_BKT, n, S_BKT, 16, hi), bV, st0, 0, 0, 0);
                    st1 = __builtin_amdgcn_mfma_f32_32x32x16_bf16(perm_read(blk + O_BKT, 32 + n, S_BKT, 16, hi), bV, st1, 0, 0, 0); }
    }
    const LAS float* GL = (const LAS float*)(gbase + O_GL); float* dst = WSP(float, WS_PU) + (((size_t)ch * 2 + isP) * 64 + rowg) * 64;
#pragma unroll
    for (int g4 = 0; g4 < 4; ++g4) { const int k0 = 8 * g4 + 4 * hi; const f32x4 ga = *(const LAS f32x4*)(GL + k0), gb = *(const LAS f32x4*)(GL + 32 + k0);
        *(GAS f32x4*)(dst + k0) = (f32x4){st0[4 * g4] * ga.x, st0[4 * g4 + 1] * ga.y, st0[4 * g4 + 2] * ga.z, st0[4 * g4 + 3] * ga.w};
        *(GAS f32x4*)(dst + 32 + k0) = (f32x4){st1[4 * g4] * gb.x, st1[4 * g4 + 1] * gb.y, st1[4 * g4 + 2] * gb.z, st1[4 * g4 + 3] * gb.w}; }
}
}
__device__ __forceinline__ void phase_sample_stream(Ctx& F) {
    for (int u = F.vcu * NWAVES + F.wave; u < DBAT * HA * 32; u += NWAVES * F.G) sba::attn_sample_unit(F, (u >> 8) * HA + (u & 7), (u >> 3) & 31, (char*)F.lds + F.wave * 16384);
}
__device__ __forceinline__ void phase_scan1_mfma(Ctx& F) {
    __syncthreads();
    const int grp = F.wave >> 2, wq = F.wave & 3; LAS char* gbase = (LAS char*)F.lds + grp * msc::GRP_BYTES;
    msc::PrepRegs L;
    { const int ch = 2 * F.vcu + grp; if (ch < NBATCH * HB * 64) msc::prep_load(F, L, (ch >> 10) * SEQ + (ch & 63) * 64 + 16 * wq, (ch >> 6) & 15); }
    for (int base = 2 * F.vcu; base < NBATCH * HB * 64; base += 2 * F.G) {
        const int ch = base + grp, bh = ch >> 6, c = ch & 63;
        msc::prep_block(F, L, (bh >> 4) * SEQ + c * 64 + 16 * wq, bh & 15, wq, gbase);
        __syncthreads();
        { const int chn = ch + 2 * F.G; if (chn < NBATCH * HB * 64) msc::prep_load(F, L, (chn >> 10) * SEQ + (chn & 63) * 64 + 16 * wq, (chn >> 6) & 15); }
        msc::chain(F, bh, c, wq >> 1, wq & 1, gbase);
    }
}
__device__ __forceinline__ void phase_scan2(Ctx& F) {
    LAS float* Pb = (LAS float*)(F.lds + 4096);
    const float* PU = WSP(float, WS_PU); float* SC = WSP(float, WS_SC);
    for (int unit = F.vcu; unit < NBATCH * HB * 8; unit += F.G) {
        const int bh = unit >> 3, r0 = (unit & 7) * 8, r = F.wave, col = F.lane;
        __syncthreads();
        { const float* P0 = PU + ((size_t)(bh * 64) * 2 + 1) * 4096; const f32x4 a = *(const GAS f32x4*)(P0 + F.tid * 4), bq = *(const GAS f32x4*)(P0 + 2048 + F.tid * 4);
          *(LAS f32x4*)(Pb + F.tid * 4) = a; *(LAS f32x4*)(Pb + 2048 + F.tid * 4) = bq; }
        float ucur = PU[((size_t)(bh * 64) * 2 + 0) * 4096 + (r0 + r) * 64 + col], scur = 0.f;
        __syncthreads();
        for (int c = 0; c < 64; ++c) {
            const int ch = bh * 64 + c; LAS float* Pc = Pb + (c & 1) * 4096;
            SC[((size_t)ch * 64 + r0 + r) * 64 + col] = scur;
            f32x4 pa = {0.f, 0.f, 0.f, 0.f}, pq = {0.f, 0.f, 0.f, 0.f}; float unext = 0.f;
            if (c + 1 < 64) { const float* Pn = PU + ((size_t)(ch + 1) * 2 + 1) * 4096; pa = *(const GAS f32x4*)(Pn + F.tid * 4); pq = *(const GAS f32x4*)(Pn + 2048 + F.tid * 4);
                unext = PU[((size_t)(ch + 1) * 2 + 0) * 4096 + (r0 + r) * 64 + col]; }
            float a0 = ucur, a1 = 0.f, a2 = 0.f, a3 = 0.f;
#pragma unroll
            for (int j = 0; j < 64; j += 4) {
                const float s0 = readlane_f(scur, j), s1 = readlane_f(scur, j + 1), s2 = readlane_f(scur, j + 2), s3 = readlane_f(scur, j + 3);
                a0 += s0 * Pc[(j + 0) * 64 + col]; a1 += s1 * Pc[(j + 1) * 64 + col]; a2 += s2 * Pc[(j + 2) * 64 + col]; a3 += s3 * Pc[(j + 3) * 64 + col]; }
            const float acc = (a0 + a1) + (a2 + a3);
            if (c + 1 < 64) { LAS float* Pn = Pb + ((c + 1) & 1) * 4096; *(LAS f32x4*)(Pn + F.tid * 4) = pa; *(LAS f32x4*)(Pn + 2048 + F.tid * 4) = pq; }
            __syncthreads();
            scur = acc; ucur = unext;
        }
        F.outp()[O_WKVP + ((size_t)bh * 64 + r0 + r) * 64 + col] = scur;
    }
}
__device__ __forceinline__ void phase_scan3(Ctx& F) {
    const int gw = F.vcu * NWAVES + F.wave, NGW = F.G * NWAVES, lane = F.lane, q = lane >> 4, m = lane & 15;
    const float* SC = WSP(float, WS_SC); const float* Z = WSP(float, WS_Z); float* Y = WSP(float, WS_YC);
    for (int task = gw; task < NBATCH * HB * 63 * 4; task += NGW) {
        const int g = task & 3, cc = task >> 2, bh = cc / 63, c = 1 + (cc - bh * 63), ch = bh * 64 + c, h = bh & 15, b = bh >> 4, row = 16 * g + m;
        const float* st = SC + ((size_t)ch * 64 + row) * 64 + 16 * q; float s[16];
#pragma unroll
        for (int i = 0; i < 16; i += 4) { const f32x4 v = *(const GAS f32x4*)(st + i); s[i] = v.x; s[i + 1] = v.y; s[i + 2] = v.z; s[i + 3] = v.w; }
        const float* zp = Z + (size_t)ch * 4096 + lane; float* yp = Y + (size_t)(b * SEQ + c * 64) * 1024 + h * 64 + row;
        float zb[4];
#pragma unroll
        for (int u = 0; u < 4; ++u) zb[u] = zp[u * 64];
        for (int t = 0; t < 64; t += 4) {
#pragma unroll
            for (int u = 0; u < 4; ++u) {
                const float zv = zb[u]; if (t + u + 4 < 64) zb[u] = zp[(t + u + 4) * 64];
                float acc = 0.f; dot16(acc, zv, s); acc = xrow16_sum(acc);
                if (q == 0) yp[(size_t)(t + u) * 1024] = acc;
            }
        }
    }
}
__device__ __forceinline__ float sum32(float v) {
    v += dpp_f<0xB1>(v); v += dpp_f<0x4E>(v); v += dpp_f<0x141>(v); v += dpp_f<0x140>(v);
    auto s = __builtin_amdgcn_permlane16_swap(__float_as_uint(v), __float_as_uint(v), false, false);
    return __uint_as_float(s[0]) + __uint_as_float(s[1]);
}
__device__ __forceinline__ sba::bf16x8 ld8_bf16(const float* p) { const f32x4 a = *(const GAS f32x4*)p, b = *(const GAS f32x4*)(p + 4); return msc::pack8(a.x, a.y, a.z, a.w, b.x, b.y, b.z, b.w); }
__device__ __forceinline__ void comb_load(Ctx& F, size_t i, f32x4& a, f32x4& e, float& cl) {
    const size_t ic = i < (size_t)NPR * 256 ? i : (size_t)NPR * 256 - 1; const int r = (int)(ic >> 8), c4 = (int)(ic & 255) * 4, h = c4 >> 7;
    const float* OP = WSP(float, WS_OP);
    a = *(const GAS f32x4*)(OP + (size_t)r * 1024 + c4); e = *(const GAS f32x4*)(OP + ((size_t)NPR + r) * 1024 + c4); cl = WSP(float, WS_CL)[(size_t)r * HA + h];
}
__device__ __forceinline__ void comb_store(Ctx& F, size_t i, const f32x4& a, const f32x4& e, float cl) {
    if (i < (size_t)NPR * 256) { const int r = (int)(i >> 8), c4 = (int)(i & 255) * 4;
        const f32x4 o = a + e * cl; u32x2 w; w.x = cvt_pk_bf16(o.x, o.y); w.y = cvt_pk_bf16(o.z, o.w);
        *(GAS u32x2*)(WSP(bf16, WS_OAB) + (size_t)r * DM + c4) = w; }
}
__device__ __forceinline__ void phase_scan3_post(Ctx& F, size_t& ci, const size_t istr) {
    const int gw = F.vcu * NWAVES + F.wave, NGW = F.G * NWAVES, lane = F.lane, n = lane & 31, hi = lane >> 5;
    const float* SC = WSP(float, WS_SC); const float* Z = WSP(float, WS_Z); const float* Y = WSP(float, WS_Y); const bf16* LWH = WSP(bf16, WS_LWH); const bf16* PBH = WSP(bf16, WS_PBH);
    const float* SCL = WSP(float, WS_SCL); bf16* OAB = WSP(bf16, WS_OAB);
    for (int ch = gw; ch < NBATCH * HB * 64; ch += NGW) {
        const int bh = ch >> 6, c = ch & 63, h = bh & 15, b = bh >> 4, r0 = b * SEQ + c * 64, col0 = h * 64 + n;
        const float lg0 = F.in(I_LNG)[col0], lg1 = F.in(I_LNG)[col0 + 32], lb0 = F.in(I_LNB)[col0], lb1 = F.in(I_LNB)[col0 + 32], mv0 = F.in(I_MU)[2048 + col0], mv1 = F.in(I_MU)[2048 + col0 + 32];
        sba::bf16x8 sb0[4], sb1[4];
        if (c > 0) { const float* Sp = SC + (size_t)ch * 4096 + n * 64 + 8 * hi;
#pragma unroll
            for (int ks = 0; ks < 4; ++ks) { sb0[ks] = ld8_bf16(Sp + 16 * ks); sb1[ks] = ld8_bf16(Sp + 32 * 64 + 16 * ks); } }
        else {
#pragma unroll
            for (int ks = 0; ks < 4; ++ks) { sb0[ks] = sba::bf16x8{}; sb1[ks] = sba::bf16x8{}; } }
        for (int tt = 0; tt < 2; ++tt) {
            sba::f32x16 a0 = sba::f32x16{}, a1 = sba::f32x16{};
            if (c > 0) { const float* Zp = Z + (size_t)ch * 4096 + (32 * tt + n) * 64 + 8 * hi;
#pragma unroll
                for (int ks = 0; ks < 4; ++ks) { const sba::bf16x8 za = ld8_bf16(Zp + 16 * ks);
                    a0 = __builtin_amdgcn_mfma_f32_32x32x16_bf16(za, sb0[ks], a0, 0, 0, 0); a1 = __builtin_amdgcn_mfma_f32_32x32x16_bf16(za, sb1[ks], a1, 0, 0, 0); } }
#pragma unroll
            for (int rg = 0; rg < 16; rg += 4) {
                float y0[4], y1[4], g0[4], g1[4], p0[4], p1[4], q0[4], q1[4], bn[4];
                f32x4 ca0, ce0, ca1, ce1; float cc0, cc1; const size_t ci0 = ci, ci1 = ci + istr; ci += 2 * istr;
                comb_load(F, ci0, ca0, ce0, cc0); comb_load(F, ci1, ca1, ce1, cc1);
#pragma unroll
                for (int i = 0; i < 4; ++i) { const int t = 32 * tt + sba::crow(rg + i, hi), r = r0 + t;
                    y0[i] = Y[(size_t)r * 1024 + col0]; y1[i] = Y[(size_t)r * 1024 + col0 + 32];
                    g0[i] = ldbf(LWH + (size_t)r * 3072 + 2048 + col0); g1[i] = ldbf(LWH + (size_t)r * 3072 + 2048 + col0 + 32);
                    const bf16* pb = PBH + (size_t)r * 3072 + 2048 + col0; p0[i] = ldbf(pb); p1[i] = ldbf(pb + 32);
                    const bool hp = (r & (SEQ - 1)) != 0; q0[i] = hp ? ldbf(pb - 3072) : 0.f; q1[i] = hp ? ldbf(pb + 32 - 3072) : 0.f;
                    bn[i] = SCL[((size_t)r * HB + h) * 4 + 2]; }
#pragma unroll
                for (int i = 0; i < 4; ++i) { const int t = 32 * tt + sba::crow(rg + i, hi), r = r0 + t;
                    const float v0 = y0[i] + a0[rg + i], v1 = y1[i] + a1[rg + i];
                    const float mean = sum32(v0 + v1) * (1.f / 64.f), d0 = v0 - mean, d1 = v1 - mean, var = sum32(d0 * d0 + d1 * d1) * (1.f / 64.f), rs = rsqrtf(var + EPS_LNX);
                    const float zv0 = p0[i] + mv0 * (q0[i] - p0[i]), zv1 = p1[i] + mv1 * (q1[i] - p1[i]);
                    const float o0 = (d0 * rs * lg0 + lb0 + bn[i] * zv0) * g0[i], o1 = (d1 * rs * lg1 + lb1 + bn[i] * zv1) * g1[i];
                    const float o0n = dpp_f<0xB1>(o0), o1n = dpp_f<0xB1>(o1);
                    if ((lane & 1) == 0) { *(GAS unsigned*)(OAB + (size_t)r * DM + 1024 + col0) = cvt_pk_bf16(o0, o0n); *(GAS unsigned*)(OAB + (size_t)r * DM + 1024 + col0 + 32) = cvt_pk_bf16(o1, o1n); } }
                comb_store(F, ci0, ca0, ce0, cc0); comb_store(F, ci1, ca1, ce1, cc1);
            }
        }
    }
}
__device__ __forceinline__ void phase_postscan(Ctx& F, size_t ci, const size_t istr) {
    const int gw = F.vcu * NWAVES + F.wave, NGW = F.G * NWAVES;
    const float* Y = WSP(float, WS_Y); const float* RWV = WSP(float, WS_RWV); const float* SCL = WSP(float, WS_SCL); const float* LWO = WSP(float, WS_LWO); const float* Pp = WSP(float, WS_P); bf16* OAB = WSP(bf16, WS_OAB);
    for (int u = NPR * 4 + gw; u < NTOK * 4; u += NGW) {
        const int r = u >> 2, hq = u & 3; const bool corr = false;
        float yv[4], gv[4], vv[4], bn[4];
#pragma unroll
        for (int i = 0; i < 4; ++i) { const int h = hq * 4 + i, col = h * 64 + F.lane;
            yv[i] = Y[(size_t)r * 1024 + col]; if (corr) yv[i] += WSP(float, WS_YC)[(size_t)r * 1024 + col];
            gv[i] = LWO[(size_t)r * 3072 + 2048 + col]; bn[i] = SCL[((size_t)r * HB + h) * 4 + 2];
            vv[i] = RWV[((size_t)r * HB + h) * 512 + 320 + F.lane]; }
#pragma unroll
        for (int i = 0; i < 4; ++i) { const int h = hq * 4 + i, col = h * 64 + F.lane;
            const float mean = wave_sum(yv[i]) * (1.f / 64.f), d = yv[i] - mean, var = wave_sum(d * d) * (1.f / 64.f);
            const float yn = d * rsqrtf(var + EPS_LNX) * F.in(I_LNG)[col] + F.in(I_LNB)[col] + bn[i] * vv[i];
            const float o = yn * gv[i];
            const float o1 = dpp_f<0xB1>(o);
            if ((F.lane & 1) == 0) *(GAS unsigned*)(OAB + (size_t)r * DM + 1024 + col) = cvt_pk_bf16(o, o1); }
    }
    sample_combine(F);
    const float* OP = WSP(float, WS_OP); const float* CL = WSP(float, WS_CL);
    for (size_t i = ci; i < (size_t)NPR * 256; i += istr) {
        const int r = (int)(i >> 8), c4 = (int)(i & 255) * 4, h = c4 >> 7;
        const f32x4 a = *(const GAS f32x4*)(OP + (size_t)r * 1024 + c4), e = *(const GAS f32x4*)(OP + ((size_t)NPR + r) * 1024 + c4); const float cl = CL[(size_t)r * HA + h];
        const f32x4 o = a + e * cl; u32x2 w; w.x = cvt_pk_bf16(o.x, o.y); w.y = cvt_pk_bf16(o.z, o.w);
        *(GAS u32x2*)(OAB + (size_t)r * DM + c4) = w;
    }
}
__device__ __forceinline__ void phase_usample(Ctx& F) {
    const float* PU_ = WSP(float, WS_PARTU); bf16* U = WSP(bf16, WS_U);
    for (int i = F.vcu * NTHR + F.tid; i < NSM * DFF / 4; i += F.G * NTHR) { const int r = i / (DFF / 4), c4 = (i - r * (DFF / 4)) * 4;
        f32x4 a = *(const GAS f32x4*)(PU_ + (size_t)r * DFF + c4);
#pragma unroll
        for (int kc = 1; kc < 8; ++kc) a += *(const GAS f32x4*)(PU_ + ((size_t)kc * 64 + r) * DFF + c4);
        const float x0 = fmaxf(a.x, 0.f), x1 = fmaxf(a.y, 0.f), x2 = fmaxf(a.z, 0.f), x3 = fmaxf(a.w, 0.f);
        u32x2 w; w.x = cvt_pk_bf16(x0 * x0, x1 * x1); w.y = cvt_pk_bf16(x2 * x2, x3 * x3);
        *(GAS u32x2*)(U + (size_t)(NPR + r) * DFF + c4) = w; }
}
#ifndef MK_SPLIT
#define MK_SPLIT 0
#endif
constexpr int NPHASE = 21;
struct Args { const void* in[N_IN]; float* out; unsigned char* ws; int ph_lo, ph_hi; };
__global__ void __launch_bounds__(NTHR, 2) mega_fwd(Args args) {
    extern __shared__ __attribute__((aligned(16))) unsigned char lds_raw[];
    Ctx F;
    F.lds = (LAS unsigned char*)lds_raw; F.tid = threadIdx.x; F.lane = F.tid & 63; F.wave = __builtin_amdgcn_readfirstlane(F.tid >> 6);
    F.G = gridDim.x; { const int bx = blockIdx.x; F.vcu = (F.G % 8 == 0) ? (bx % 8) * (F.G / 8) + bx / 8 : bx; }
    for (int u = F.tid; u < (LDS_BYTES - LDSCTL_OFF) / 4; u += NTHR) ((LAS unsigned*)(F.lds + LDSCTL_OFF))[u] = 0u;
    __syncthreads();
    unsigned* ctl = (unsigned*)(args.ws + WS_CTL);
    XcdBarrier bar; bar.bar = ctl + CW_BAR; bar.x = 0; bar.st = nullptr;
    if (!MK_SPLIT) bar = xcd_barrier_post(ctl + CW_BAR, (volatile LAS unsigned*)(F.lds + MISC_OFF) + 8);
    const int lo = args.ph_lo, hi = args.ph_hi;
#define IN(k) (lo <= (k) && (k) < hi)
#define SEAM(k) do { if (IN(k) && IN((k) + 1)) xcd_barrier(bar); } while (0)
    if (IN(0)) { phase_prologue(F); } SEAM(0);
    if (IN(1)) { phase_mod0(F); } SEAM(1);
    if (IN(2)) { const bool hide = F.G > NCVT + 8; const int ng = hide ? F.G - NCVT : F.G;
        if ((int)blockIdx.x < ng) { pg8::Gemm g{WSP(bf16, WS_H), WSP(bf16, WS_WIN), MP, INPAD, DM, DM, DM}; pg8::StaticOrder S; S.init(MP, INPAD, ng, (int)blockIdx.x); EpiIn E{WSP(bf16, WS_QB), WSP(bf16, WS_KB), WSP(bf16, WS_VB), WSP(float, WS_P), F.outp(), WSP(bf16, WS_PBH)};
            pg8::gemm_phase<EpiIn, pg8::StaticOrder, true, true>(F.lds, g, S, E); }
        else convert_run(F, IT_IN + ((int)blockIdx.x - ng) * NWAVES + F.wave, NCVT * NWAVES, IT_IN + N_HIDE, (LAS float*)(F.lds + F.wave * 16384)); } SEAM(2);
    if (IN(3)) { phase_kv_prep(F); } SEAM(3);
    if (IN(4)) { pg8::Gemm g{WSP(bf16, WS_LA), WSP(bf16, WS_LWT), MP, 3072, 512, 512, 512}; pg8::LoraOrder S; S.init(MP, 3072, F.G, (int)blockIdx.x); pg8::EpiLora E{WSP(float, WS_LWO), WSP(bf16, WS_LWH), 3072};
        pg8::gemm_phase<pg8::EpiLora, pg8::LoraOrder, true, true>(F.lds, g, S, E); } SEAM(4);
    if (IN(6)) { phase_rwkv_prep(F);
        const bool stream_first = (F.vcu & 1) != 0;
        if (stream_first) phase_sample_stream(F); else phase_scan1_mfma(F);
        __syncthreads();
        phase_attn_prompt(F);
        if (!stream_first) phase_sample_stream(F); else phase_scan1_mfma(F); } SEAM(7);
    if (IN(8)) {
        if (F.wave < 2) for (int t = F.vcu * 2 + F.wave; t < DBAT * HB * 4; t += 2 * F.G) scan_wave<false, true>(F, t >> 2, 0, t & 3);
        phase_scan2(F); } SEAM(8);
    if (IN(10)) { size_t ci = (size_t)F.vcu * NTHR + F.tid; const size_t istr = (size_t)F.G * NTHR; phase_scan3_post(F, ci, istr); phase_postscan(F, ci, istr); } SEAM(10);
    if (IN(11)) { pg8::Gemm g{WSP(bf16, WS_OAB), WSP(bf16, WS_WOUT), MP, DM, DM, DM, DM}; pg8::MixOrder<false> S; S.init(DM, DM, F.G, (int)blockIdx.x); pg8::EpiF32S<64> E{WSP(bf16, WS_OUT), DM, nullptr, WSP(float, WS_PART)};
        pg8::gemm_phase<pg8::EpiF32S<64>, pg8::MixOrder<false>, true, true>(F.lds, g, S, E); } SEAM(11);
    if (IN(12)) { phase_postmix<0>(F); } SEAM(12);
    if (IN(13)) { pg8::Gemm g{WSP(bf16, WS_H), WSP(bf16, WS_W1), MP, DFF, DM, DM, DM}; pg8::MixOrder<false> S; S.init(DFF, DM, F.G, (int)blockIdx.x); pg8::EpiRelu2 E{WSP(bf16, WS_U), DFF, WSP(float, WS_PARTU)};
        pg8::gemm_phase<pg8::EpiRelu2, pg8::MixOrder<false>, true, true>(F.lds, g, S, E); } SEAM(13);
    if (IN(14)) { phase_usample(F); if (!MK_SPLIT) xcd_barrier(bar); pg8::Gemm g{WSP(bf16, WS_U), WSP(bf16, WS_W2), MP, DM, DFF, DFF, DFF}; pg8::MixOrder<false> S; S.init(DM, DFF, F.G, (int)blockIdx.x); pg8::EpiF32S<64> E{WSP(bf16, WS_OUT), DM, nullptr, WSP(float, WS_PART)};
        pg8::gemm_phase<pg8::EpiF32S<64>, pg8::MixOrder<false>, true, true>(F.lds, g, S, E); } SEAM(14);
    if (IN(15)) { phase_postmlp<0>(F); } SEAM(15);
    if (IN(16)) { pg8::Gemm g{WSP(bf16, WS_H), WSP(bf16, WS_WPOOL), MP, DM, DM, DM, DM}; pg8::MixOrder<true> S; S.init(DM, DM, F.G, (int)blockIdx.x); pg8::EpiF32S<256> E{WSP(bf16, WS_OUT), DM, F.in(I_PSC), WSP(float, WS_PART)};
        pg8::gemm_phase<pg8::EpiF32S<256>, pg8::MixOrder<true>, true, true>(F.lds, g, S, E); } SEAM(16);
    if (IN(17)) { phase_postmix<1>(F); } SEAM(17);
    if (IN(18)) { pg8::Gemm g{WSP(bf16, WS_H), WSP(bf16, WS_W1) + (size_t)DFF * DM, MP, DFF, DM, DM, DM}; pg8::MixOrder<false> S; S.init(DFF, DM, F.G, (int)blockIdx.x); pg8::EpiRelu2 E{WSP(bf16, WS_U), DFF, WSP(float, WS_PARTU)};
        pg8::gemm_phase<pg8::EpiRelu2, pg8::MixOrder<false>, true, true>(F.lds, g, S, E); } SEAM(18);
    if (IN(19)) { phase_usample(F); if (!MK_SPLIT) xcd_barrier(bar); pg8::Gemm g{WSP(bf16, WS_U), WSP(bf16, WS_W2) + (size_t)DM * DFF, MP, DM, DFF, DFF, DFF}; pg8::MixOrder<false> S; S.init(DM, DFF, F.G, (int)blockIdx.x); pg8::EpiF32S<64> E{WSP(bf16, WS_OUT), DM, nullptr, WSP(float, WS_PART)};
        pg8::gemm_phase<pg8::EpiF32S<64>, pg8::MixOrder<false>, true, true>(F.lds, g, S, E); } SEAM(19);
    if (IN(20)) { phase_postmlp<1>(F); }
#undef IN
#undef SEAM
}

extern "C" void kernel_launch(void* const* d_in, const int* in_sizes, int n_in, void* d_out, int out_size, void* d_ws, size_t ws_size, hipStream_t stream) {
    static int grid = 0;
    if (grid == 0) {
        if (n_in != N_IN || (size_t)out_size != O_END || ws_size < WS_END) { fprintf(stderr, "kernel_launch: unexpected shapes: n_in %d out %d ws %zu (want %d, %zu, >= %zu)\n", n_in, out_size, ws_size, (int)N_IN, (size_t)O_END, (size_t)WS_END); grid = -1; return; }
        int dev = 0, cus = 0, per_cu = 0;
        if (hipGetDevice(&dev) != hipSuccess || hipDeviceGetAttribute(&cus, hipDeviceAttributeMultiprocessorCount, dev) != hipSuccess) { grid = -1; return; }
        if (hipFuncSetAttribute((const void*)mega_fwd, hipFuncAttributeMaxDynamicSharedMemorySize, LDS_BYTES) != hipSuccess) { fprintf(stderr, "kernel_launch: hipFuncSetAttribute failed\n"); grid = -1; return; }
        if (hipOccupancyMaxActiveBlocksPerMultiprocessor(&per_cu, (const void*)mega_fwd, NTHR, LDS_BYTES) != hipSuccess || per_cu < 1) fprintf(stderr, "kernel_launch: occupancy query reports %d blocks per CU\n", per_cu);
        (void)hipGetLastError();
        grid = cus;
    }
    if (grid < 0) return;
    hipMemsetAsync((char*)d_ws + WS_CTL, 0, CTL_ZERO_BYTES, stream);
    Args a{};
    for (int i = 0; i < N_IN; ++i) a.in[i] = d_in[i];
    a.out = (float*)d_out; a.ws = (unsigned char*)d_ws;
#if MK_SPLIT
    for (int p = 0; p < NPHASE; ++p) { a.ph_lo = p; a.ph_hi = p + 1; hipLaunchKernelGGL(mega_fwd, dim3(grid), dim3(NTHR), LDS_BYTES, stream, a); }
#else
    a.ph_lo = 0; a.ph_hi = NPHASE;
    hipLaunchKernelGGL(mega_fwd, dim3(grid), dim3(NTHR), LDS_BYTES, stream, a);
#endif
    const hipError_t le = hipPeekAtLastError();
    if (le != hipSuccess) fprintf(stderr, "kernel_launch: launch failed: %s\n", hipGetErrorName(le));
}
```

```cpp
#include <hip/hip_runtime.h>
#include <cstdio>
#include <cstdint>
namespace pg8 {
#define PG8_LAS __attribute__((address_space(3)))
typedef unsigned short bf16_t;
typedef short bf16x8 __attribute__((ext_vector_type(8)));
typedef float f32x4 __attribute__((ext_vector_type(4)));
typedef unsigned u32x4 __attribute__((ext_vector_type(4)));
constexpr int BM = 256, BK = 64, HALF = 128, HTB = HALF * BK * 2  , STAGE_BYTES = 8 * HTB, NXCD = 8, WGM = 8;

__host__ __device__ __forceinline__ int lds_byte(int r, int c) { const int st = (r >> 4) * 2 + (c >> 5), rr = r & 15, cc = c & 31, ob = rr * 64 + cc * 2; return st * 1024 + (ob ^ (((ob >> 9) & 1) << 5)); }
__host__ __device__ __forceinline__ void stage_rc(int b, int& R, int& C) { const int st = b / 1024, sb = b % 1024, swz = sb ^ (((sb >> 9) & 1) << 5); R = (st >> 1) * 16 + swz / 64; C = (st & 1) * 32 + (swz % 64) / 2; }
__host__ __device__ __forceinline__ int perm32(int rho) { const int n = rho >> 4, i = rho & 15; return 8 * (i >> 2) + 4 * n + (i & 3); }

struct Unit { int pm, pn, kc; };
struct Gemm { const bf16_t* A; const bf16_t* Bt; int M, N, K, lda, ldb; };

struct StaticOrder {
    int nM, nN, nwg, G, c;
    __host__ __device__ void init(int M, int N, int G_, int c_) { nM = M / BM; nN = N / BM; nwg = nM * nN; G = G_; c = c_; }
    __host__ __device__ bool next(int i, Unit& u) const {
        const long L = (long)i * G + c; if (L >= nwg) return false;
        int wgid = (int)L; { const int q = nwg / NXCD, r = nwg % NXCD, xcd = wgid % NXCD, off = wgid / NXCD; wgid = (xcd < r ? xcd * (q + 1) : r * (q + 1) + (xcd - r) * q) + off; }
        const int nig = WGM * nN, gid = wgid / nig, fm = gid * WGM, gsz = (nM - fm) < WGM ? (nM - fm) : WGM;
        u.pm = fm + ((wgid % nig) % gsz); u.pn = (wgid % nig) / gsz; u.kc = -1; return true;
    }
    __device__ __forceinline__ int nt(const Unit&, const Gemm& g) const { return g.K / BK; }
    __device__ __forceinline__ void a_ready(const Unit&) const {}
    __device__ __forceinline__ void done(const Unit&) const {}
    __device__ __forceinline__ size_t a_off(const Unit& u, const Gemm& g) const { return (size_t)u.pm * BM * g.lda * 2; }
    __device__ __forceinline__ size_t b_off(const Unit& u, const Gemm& g) const { return (size_t)u.pn * BM * g.ldb * 2; }
};
struct LoraOrder : StaticOrder {
    __device__ __forceinline__ int k0(const Unit& u) const { return u.pn < 4 ? 0 : (u.pn < 8 ? 64 : 192); }
    __device__ __forceinline__ int nt(const Unit& u, const Gemm&) const { return u.pn < 8 ? 2 : 4; }
    __device__ __forceinline__ size_t a_off(const Unit& u, const Gemm& g) const { return (size_t)u.pm * BM * g.lda * 2 + (size_t)k0(u) * 2; }
    __device__ __forceinline__ size_t b_off(const Unit& u, const Gemm& g) const { return (size_t)u.pn * BM * g.ldb * 2 + (size_t)k0(u) * 2; }
};
__device__ __forceinline__ unsigned cvt_pk_bf16(float lo, float hi) { unsigned r; asm volatile("v_cvt_pk_bf16_f32 %0, %1, %2" : "=v"(r) : "v"(lo), "v"(hi)); return r; }

struct EpiF32 {
    static constexpr bool PERM = false, AFTER_DRAIN = false;
    float* C; int ldc; const float* cscale;
    __device__ __forceinline__ void operator()(const f32x4 (&acc)[2][2][4][2], const Unit& u, int wr, int wc, int fr, int fq) const {
        const int row0 = u.pm * BM + wr * 64 + fr, col0 = u.pn * BM + wc * 32 + 4 * fq;
        f32x4 sv[2][2];
#pragma unroll
        for (int bj = 0; bj < 2; ++bj)
#pragma unroll
            for (int n = 0; n < 2; ++n) sv[bj][n] = cscale ? *(const f32x4*)(cscale + col0 + bj * HALF + n * 16) : (f32x4){1.f, 1.f, 1.f, 1.f};
#pragma unroll
        for (int ai = 0; ai < 2; ++ai)
#pragma unroll
            for (int m = 0; m < 4; ++m) { float* rowp = C + (size_t)(row0 + ai * HALF + m * 16) * ldc + col0;
#pragma unroll
                for (int bj = 0; bj < 2; ++bj)
#pragma unroll
                    for (int n = 0; n < 2; ++n) *(f32x4*)(rowp + bj * HALF + n * 16) = acc[ai][bj][m][n] * sv[bj][n]; }
    }
};
typedef unsigned u32x2h __attribute__((ext_vector_type(2)));
struct EpiLora {
    static constexpr bool PERM = false, AFTER_DRAIN = false;
    float* C; bf16_t* H; int ldc;
    __device__ __forceinline__ void operator()(const f32x4 (&acc)[2][2][4][2], const Unit& u, int wr, int wc, int fr, int fq) const {
        const int row0 = u.pm * BM + wr * 64 + fr, col0 = u.pn * BM + wc * 32 + 4 * fq;
#pragma unroll
        for (int ai = 0; ai < 2; ++ai)
#pragma unroll
            for (int m = 0; m < 4; ++m) { const size_t ro = (size_t)(row0 + ai * HALF + m * 16) * ldc + col0;
#pragma unroll
                for (int bj = 0; bj < 2; ++bj)
#pragma unroll
                    for (int n = 0; n < 2; ++n) { const f32x4 v = acc[ai][bj][m][n];
                        if (u.pm < 32) { u32x2h w; w.x = cvt_pk_bf16(v[0], v[1]); w.y = cvt_pk_bf16(v[2], v[3]); *(u32x2h*)(H + ro + bj * HALF + n * 16) = w; }
                        else *(f32x4*)(C + ro + bj * HALF + n * 16) = v; } }
    }
};
struct EpiRelu2 {
    static constexpr bool PERM = true, AFTER_DRAIN = false;
    bf16_t* O; int ldc; float* PART;
    __device__ __forceinline__ void operator()(const f32x4 (&acc)[2][2][4][2], const Unit& u, int wr, int wc, int fr, int fq) const {
        const int row0 = u.pm * BM + wr * 64 + fr, col0 = u.pn * BM + wc * 32 + 8 * fq;
        if (u.kc >= 0) {
            if (wr == 0) {
#pragma unroll
                for (int m = 0; m < 4; ++m) { float* rowp = PART + ((size_t)u.kc * 64 + m * 16 + fr) * ldc + col0;
#pragma unroll
                    for (int bj = 0; bj < 2; ++bj) { *(f32x4*)(rowp + bj * HALF) = acc[0][bj][m][0]; *(f32x4*)(rowp + bj * HALF + 4) = acc[0][bj][m][1]; } } }
            return;
        }
#pragma unroll
        for (int ai = 0; ai < 2; ++ai)
#pragma unroll
            for (int m = 0; m < 4; ++m) { bf16_t* rowp = O + (size_t)(row0 + ai * HALF + m * 16) * ldc + col0;
#pragma unroll
                for (int bj = 0; bj < 2; ++bj) { f32x4 v0 = acc[ai][bj][m][0], v1 = acc[ai][bj][m][1];
#pragma unroll
                    for (int j = 0; j < 4; ++j) { const float a = v0[j] > 0.f ? v0[j] : 0.f, b = v1[j] > 0.f ? v1[j] : 0.f; v0[j] = a * a; v1[j] = b * b; }
                    u32x4 w; w.x = cvt_pk_bf16(v0[0], v0[1]); w.y = cvt_pk_bf16(v0[2], v0[3]); w.z = cvt_pk_bf16(v1[0], v1[1]); w.w = cvt_pk_bf16(v1[2], v1[3]);
                    *(u32x4*)(rowp + bj * HALF) = w; } }
    }
};
template <bool POOL> struct MixOrder {
    StaticOrder so; int nmain, nN, kdiv, ntot, G, c;
    __device__ void init(int N, int K, int G_, int c_) { nN = N / BM; so.init(32 * BM, N, G_, c_); nmain = 32 * nN; kdiv = (POOL ? 512 : K) / 256; ntot = nmain + nN * kdiv; G = G_; c = c_; }
    __device__ bool next(int i, Unit& u) const {
        const int L = i * G + c; if (L >= ntot) return false;
        if (L < nmain) return so.next(i, u);
        const int j = L - nmain; u.pm = 32; u.pn = j % nN; u.kc = j / nN; return true;
    }
    __device__ __forceinline__ int nt(const Unit& u, const Gemm& g) const { return u.kc >= 0 ? 4 : (POOL ? 8 : g.K / BK); }
    __device__ __forceinline__ size_t a_off(const Unit& u, const Gemm& g) const { return (size_t)u.pm * BM * g.lda * 2 + (size_t)((POOL ? (u.pn >> 1) * 512 : 0) + (u.kc >= 0 ? u.kc * 256 : 0)) * 2; }
    __device__ __forceinline__ size_t b_off(const Unit& u, const Gemm& g) const { return (size_t)u.pn * BM * g.ldb * 2 + (size_t)((POOL ? (u.pn >> 1) * 512 : 0) + (u.kc >= 0 ? u.kc * 256 : 0)) * 2; }
    __device__ __forceinline__ void a_ready(const Unit&) const {}
    __device__ __forceinline__ void done(const Unit&) const {}
};
template <int PROW> struct EpiF32S {
    static constexpr bool PERM = false, AFTER_DRAIN = false;
    bf16_t* C; int ldc; const float* cscale; float* PART;
    __device__ __forceinline__ f32x4 scl(int c) const { return cscale ? *(const f32x4*)(cscale + c) : (f32x4){1.f, 1.f, 1.f, 1.f}; }
    __device__ __forceinline__ void operator()(const f32x4 (&acc)[2][2][4][2], const Unit& u, int wr, int wc, int fr, int fq) const {
        asm volatile("" : "+v"(fr), "+v"(fq));
        const int col0 = u.pn * BM + wc * 32 + 4 * fq;
        if (u.kc < 0) {
            bf16_t* Ct = C + (size_t)u.pm * BM * ldc; const unsigned e0 = (unsigned)((wr * 64 + fr) * ldc + col0);
#pragma unroll
            for (int bj = 0; bj < 2; ++bj)
#pragma unroll
                for (int n = 0; n < 2; ++n) { const f32x4 sv = scl(col0 + bj * HALF + n * 16);
#pragma unroll
                    for (int ai = 0; ai < 2; ++ai)
#pragma unroll
                        for (int m = 0; m < 4; ++m) { const f32x4 v = acc[ai][bj][m][n] * sv; const unsigned w0 = cvt_pk_bf16(v[0], v[1]), w1 = cvt_pk_bf16(v[2], v[3]);
                            *(unsigned long long*)(Ct + e0 + (unsigned)((ai * HALF + m * 16) * ldc) + bj * HALF + n * 16) = (unsigned long long)w0 | ((unsigned long long)w1 << 32); } }
        } else if (PROW == 256) {
            float* Pk = PART + (size_t)u.kc * 256 * ldc; const unsigned e0 = (unsigned)((wr * 64 + fr) * ldc + col0);
#pragma unroll
            for (int bj = 0; bj < 2; ++bj)
#pragma unroll
                for (int n = 0; n < 2; ++n) { const f32x4 sv = scl(col0 + bj * HALF + n * 16);
#pragma unroll
                    for (int ai = 0; ai < 2; ++ai)
#pragma unroll
                        for (int m = 0; m < 4; ++m) *(f32x4*)(Pk + e0 + (unsigned)((ai * HALF + m * 16) * ldc) + bj * HALF + n * 16) = acc[ai][bj][m][n] * sv; }
        } else if (wr == 0) {
            float* Pk = PART + (size_t)u.kc * 64 * ldc; const unsigned e0 = (unsigned)(fr * ldc + col0);
#pragma unroll
            for (int bj = 0; bj < 2; ++bj)
#pragma unroll
                for (int n = 0; n < 2; ++n) { const f32x4 sv = scl(col0 + bj * HALF + n * 16);
#pragma unroll
                    for (int m = 0; m < 4; ++m) *(f32x4*)(Pk + e0 + (unsigned)(m * 16 * ldc) + bj * HALF + n * 16) = acc[0][bj][m][n] * sv; }
        }
    }
};
template <class Epi, class Sched, bool ALIGN_EPI = false, bool SP2 = false>
__device__ __forceinline__ void gemm_phase(PG8_LAS unsigned char* lds, const Gemm g, const Sched& S, const Epi& E) {
    const int tid = threadIdx.x, wid = __builtin_amdgcn_readfirstlane(tid >> 6), lane = tid & 63, wr = wid >> 2, wc = wid & 3, fr = lane & 15, fq = lane >> 4;
    unsigned voffA[2], voffB[2];
#pragma unroll
    for (int i = 0; i < 2; ++i) { int R, C; stage_rc(tid * 16 + i * 8192, R, C); const int Rb = Epi::PERM ? ((R & ~31) + perm32(R & 31)) : R;
        voffA[i] = (unsigned)(R * g.lda + C) * 2u; voffB[i] = (unsigned)(Rb * g.ldb + C) * 2u; }
    const size_t kstep = (size_t)(BK * 2);
    const size_t hsA = (size_t)HALF * g.lda * 2, hsB = (size_t)HALF * g.ldb * 2;
    const unsigned ldsw = (unsigned)wid * 1024u;
    const int aoff = lds_byte(wr * 64 + fr, fq * 8), boff = lds_byte(wc * 32 + fr, fq * 8);
#define PG8_SA(b, h) (((b) * 2 + (h)) * HTB)
#define PG8_SB(b, h) ((4 + (b) * 2 + (h)) * HTB)
#define PG8_STAGE(bufoff, gbase, voff) do { _Pragma("unroll") for (int _i = 0; _i < 2; ++_i) \
        __builtin_amdgcn_global_load_lds((const unsigned*)((const char*)(gbase) + (voff)[_i]), (PG8_LAS unsigned*)(lds + (bufoff) + ldsw + _i * 8192), 16, 0, 0); } while (0)
#define PG8_LDA(dst, b, h) do { _Pragma("unroll") for (int m = 0; m < 4; ++m) _Pragma("unroll") for (int k = 0; k < 2; ++k) dst[m][k] = *(const PG8_LAS bf16x8*)(lds + PG8_SA(b, h) + aoff + m * 2048 + k * 1024); } while (0)
#define PG8_LDB(dst, b, h) do { _Pragma("unroll") for (int n = 0; n < 2; ++n) _Pragma("unroll") for (int k = 0; k < 2; ++k) dst[n][k] = *(const PG8_LAS bf16x8*)(lds + PG8_SB(b, h) + boff + n * 2048 + k * 1024); } while (0)
#define PG8_MMA(ai, bj, At, Bt) do { __builtin_amdgcn_s_setprio(1); _Pragma("unroll") for (int m = 0; m < 4; ++m) _Pragma("unroll") for (int n = 0; n < 2; ++n) _Pragma("unroll") for (int k = 0; k < 2; ++k) \
        acc[ai][bj][m][n] = __builtin_amdgcn_mfma_f32_16x16x32_bf16(Bt[n][k], At[m][k], acc[ai][bj][m][n], 0, 0, 0); __builtin_amdgcn_s_setprio(0); } while (0)
#define PG8_WAIT_V(n) asm volatile("s_waitcnt vmcnt(" #n ")" ::: "memory")
#define PG8_WAIT_L(n) asm volatile("s_waitcnt lgkmcnt(" #n ")" ::: "memory")
#define PG8_BAR __builtin_amdgcn_s_barrier()
#define PG8_SCHED __builtin_amdgcn_sched_barrier(0)
    Unit cur, nxt; int ui = 0;
    if (!S.next(0, cur)) return;
    int nt = S.nt(cur, g);
    f32x4 acc[2][2][4][2];
#pragma unroll
    for (int a = 0; a < 2; ++a)
#pragma unroll
        for (int b = 0; b < 2; ++b)
#pragma unroll
            for (int m = 0; m < 4; ++m)
#pragma unroll
                for (int n = 0; n < 2; ++n) acc[a][b][m][n] = (f32x4){0.f, 0.f, 0.f, 0.f};
    bf16x8 At[4][2], B0[2][2], B1[2][2];
    const char* cA = (const char*)g.A + S.a_off(cur, g); const char* cB = (const char*)g.Bt + S.b_off(cur, g);
    S.a_ready(cur);
    if constexpr (SP2) {
        PG8_STAGE(PG8_SB(0, 0), cB, voffB); PG8_STAGE(PG8_SB(0, 1), cB + hsB, voffB); PG8_STAGE(PG8_SA(0, 0), cA, voffA); PG8_STAGE(PG8_SA(0, 1), cA + hsA, voffA);
        if (wr == 1) PG8_BAR;
        PG8_WAIT_V(2); PG8_BAR;
        PG8_STAGE(PG8_SB(1, 0), cB + kstep, voffB); PG8_STAGE(PG8_SA(1, 0), cA + kstep, voffA); PG8_STAGE(PG8_SB(1, 1), cB + hsB + kstep, voffB);
        PG8_WAIT_V(6); PG8_BAR;
    } else {
        PG8_STAGE(PG8_SB(0, 0), cB, voffB); PG8_STAGE(PG8_SA(0, 0), cA, voffA); PG8_STAGE(PG8_SB(0, 1), cB + hsB, voffB); PG8_STAGE(PG8_SA(0, 1), cA + hsA, voffA);
        if (wr == 1) PG8_BAR;
        PG8_WAIT_V(4); PG8_BAR;
        PG8_STAGE(PG8_SB(1, 0), cB + kstep, voffB); PG8_STAGE(PG8_SA(1, 0), cA + kstep, voffA); PG8_STAGE(PG8_SB(1, 1), cB + hsB + kstep, voffB);
        PG8_WAIT_V(6); PG8_BAR;
    }
    for (;;) {
        const bool has_next = S.next(ui + 1, nxt);
        const char* nA = has_next ? (const char*)g.A + S.a_off(nxt, g) : cA; const char* nB = has_next ? (const char*)g.Bt + S.b_off(nxt, g) : cB;
        for (int t = 0; t < nt; t += 2) {
            const bool last = (t == nt - 2);
            const char* a1 = cA + (size_t)(t + 1) * kstep;
            const char* a2 = last ? nA : cA + (size_t)(t + 2) * kstep; const char* b2 = last ? nB : cB + (size_t)(t + 2) * kstep;
            const char* a3 = a2 + kstep; const char* b3 = b2 + kstep;
            if (last && has_next) S.a_ready(nxt);
            if constexpr (SP2) {
            PG8_LDB(B0, 0, 0); PG8_LDB(B1, 0, 1); PG8_SCHED; PG8_LDA(At, 0, 0); PG8_STAGE(PG8_SA(1, 1), a1 + hsA, voffA);
            PG8_WAIT_V(8); PG8_WAIT_L(0); PG8_BAR; PG8_MMA(0, 0, At, B0); PG8_MMA(0, 1, At, B1); PG8_BAR; PG8_SCHED;
            PG8_LDA(At, 0, 1); PG8_STAGE(PG8_SB(0, 0), b2, voffB); PG8_STAGE(PG8_SB(0, 1), b2 + hsB, voffB); PG8_STAGE(PG8_SA(0, 0), a2, voffA);
            PG8_WAIT_V(8); PG8_WAIT_L(0); PG8_BAR; PG8_MMA(1, 0, At, B0); PG8_MMA(1, 1, At, B1); PG8_BAR; PG8_SCHED;
            PG8_LDB(B0, 1, 0); PG8_LDB(B1, 1, 1); PG8_SCHED; PG8_LDA(At, 1, 0); PG8_STAGE(PG8_SA(0, 1), a2 + hsA, voffA);
            PG8_WAIT_V(8); PG8_WAIT_L(0); PG8_BAR; PG8_MMA(0, 0, At, B0); PG8_MMA(0, 1, At, B1); PG8_BAR; PG8_SCHED;
            PG8_LDA(At, 1, 1); PG8_STAGE(PG8_SB(1, 0), b3, voffB); PG8_STAGE(PG8_SB(1, 1), b3 + hsB, voffB); PG8_STAGE(PG8_SA(1, 0), a3, voffA);
            PG8_WAIT_V(8); PG8_WAIT_L(0); PG8_BAR; PG8_MMA(1, 0, At, B0); PG8_MMA(1, 1, At, B1); PG8_BAR; PG8_SCHED;
            } else {
            PG8_LDB(B0, 0, 0); PG8_SCHED; PG8_LDA(At, 0, 0); PG8_STAGE(PG8_SA(1, 1), a1 + hsA, voffA);
            PG8_WAIT_L(8); PG8_BAR; PG8_WAIT_L(0); PG8_MMA(0, 0, At, B0); PG8_BAR; PG8_SCHED;
            PG8_LDB(B1, 0, 1); PG8_STAGE(PG8_SB(0, 0), b2, voffB);
            PG8_BAR; PG8_WAIT_L(0); PG8_MMA(0, 1, At, B1); PG8_BAR;
            PG8_LDA(At, 0, 1); PG8_STAGE(PG8_SA(0, 0), a2, voffA);
            PG8_BAR; PG8_WAIT_L(0); PG8_MMA(1, 0, At, B0); PG8_BAR; PG8_SCHED;
            PG8_STAGE(PG8_SB(0, 1), b2 + hsB, voffB);
            PG8_WAIT_V(6); PG8_BAR; PG8_MMA(1, 1, At, B1); PG8_BAR;
            PG8_LDB(B0, 1, 0); PG8_SCHED; PG8_LDA(At, 1, 0); PG8_STAGE(PG8_SA(0, 1), a2 + hsA, voffA);
            PG8_WAIT_L(8); PG8_BAR; PG8_WAIT_L(0); PG8_MMA(0, 0, At, B0); PG8_BAR; PG8_SCHED;
            PG8_LDB(B1, 1, 1); PG8_STAGE(PG8_SB(1, 0), b3, voffB);
            PG8_BAR; PG8_WAIT_L(0); PG8_MMA(0, 1, At, B1); PG8_BAR;
            PG8_LDA(At, 1, 1); PG8_STAGE(PG8_SA(1, 0), a3, voffA);
            PG8_BAR; PG8_WAIT_L(0); PG8_MMA(1, 0, At, B0); PG8_BAR; PG8_SCHED;
            PG8_STAGE(PG8_SB(1, 1), b3 + hsB, voffB);
            PG8_WAIT_V(6); PG8_BAR; PG8_MMA(1, 1, At, B1); PG8_BAR;
            }
        }
        if constexpr (ALIGN_EPI) { if (wr == 0) PG8_BAR; }
        if constexpr (!Epi::AFTER_DRAIN) { E(acc, cur, wr, wc, fr, fq); S.done(cur); }
        if (!has_next) break;
#pragma unroll
        for (int a = 0; a < 2; ++a)
#pragma unroll
            for (int b = 0; b < 2; ++b)
#pragma unroll
                for (int m = 0; m < 4; ++m)
#pragma unroll
                    for (int n = 0; n < 2; ++n) acc[a][b][m][n] = (f32x4){0.f, 0.f, 0.f, 0.f};
        cur = nxt; cA = nA; cB = nB; ++ui; nt = S.nt(cur, g);
        if constexpr (ALIGN_EPI) { if (wr == 1) PG8_BAR; }
    }
    PG8_WAIT_V(0);
    if constexpr (!ALIGN_EPI) { if (wr == 0) PG8_BAR; }
    PG8_BAR;
    if constexpr (Epi::AFTER_DRAIN) { E.fused(acc, cur, wr, wc, fr, fq, lds, wid, lane); S.done(cur); }
#undef PG8_SA
#undef PG8_SB
#undef PG8_STAGE
#undef PG8_LDA
#undef PG8_LDB
#undef PG8_MMA
#undef PG8_WAIT_V
#undef PG8_WAIT_L
#undef PG8_BAR
#undef PG8_SCHED
}
}

constexpr int DM = 2048, SEQ = 4096, NBATCH = 2, NPR = NBATCH * SEQ, DBAT = 8, DSEQ = 8, NSM = DBAT * DSEQ, NTOK = NPR + NSM, MP = 8448;
constexpr int HA = 8, DHA = 128, HB = 16, DHB = 64, DBR = 1024;
constexpr int BCOLS = 3520, INCOLS = 6592, INPAD = 6656, DFF = 8192, NPAGES = 128, PAGESZ = 128, PAST = 16384, PBUF = 15, NMR = 10;
constexpr float EPS_RMS = 1e-6f, EPS_LNX = 64e-5f, QK_SCALE = 0.08838834764831845f;
enum { I_XP = 0, I_XS, I_CK, I_CV, I_PT, I_SWKV, I_SSH, I_SPOOL, I_CP, I_CS, I_WADA, I_BADA, I_NG, I_WIN, I_WOUT, I_SBB, I_MU, I_W0, I_WUP, I_A0, I_AUP, I_GUP, I_KK, I_KA, I_RK, I_LNG, I_LNB, I_WPOOL, I_PSC, I_W1, I_W2, N_IN };
constexpr size_t O_YP = 0, O_YS = O_YP + (size_t)NPR * DM, O_KP = O_YS + (size_t)NSM * DM, O_VP = O_KP + (size_t)NPR * 1024, O_KS = O_VP + (size_t)NPR * 1024, O_VS = O_KS + (size_t)NSM * 1024,
                 O_WKVP = O_VS + (size_t)NSM * 1024, O_WKVS = O_WKVP + (size_t)NBATCH * HB * 64 * 64, O_SHP = O_WKVS + (size_t)DBAT * HB * 64 * 64, O_SHS = O_SHP + (size_t)NBATCH * BCOLS,
                 O_PLP = O_SHS + (size_t)DBAT * BCOLS, O_PLS = O_PLP + (size_t)NBATCH * PBUF * DM, O_END = O_PLS + (size_t)DBAT * PBUF * DM;
constexpr size_t MiB = 1u << 20;
constexpr size_t WS_CTL = 0, CTL_ZERO_BYTES = 64 * 1024, WS_MOD = 1 * MiB, WS_WIN = 2 * MiB, WS_WOUT = 28 * MiB, WS_W1 = 36 * MiB, WS_W2 = 100 * MiB, WS_WPOOL = 164 * MiB,
                 WS_H = 172 * MiB, WS_OAB = 205 * MiB, WS_M = 238 * MiB, WS_P = 271 * MiB, WS_OUT = 486 * MiB, WS_XR = 552 * MiB, WS_HF = 617 * MiB, WS_U = 682 * MiB,
                 WS_RWV = 814 * MiB, WS_SCL = 1072 * MiB, WS_G = 1075 * MiB, WS_Y = 1108 * MiB, WS_PU = 1141 * MiB, WS_Z = 1205 * MiB, WS_SC = 1237 * MiB, WS_QB = 1269 * MiB, WS_KB = 1286 * MiB, WS_VB = 1303 * MiB, WS_OP = 1320 * MiB, WS_CL = 1384 * MiB, WS_SPART = 1385 * MiB, WS_SCAR = 1394 * MiB, WS_LA = 1395 * MiB, WS_LWT = 1404 * MiB, WS_LWO = 1408 * MiB, WS_YC = 1508 * MiB, WS_PART = 1541 * MiB, WS_PARTU = 1558 * MiB, WS_END = 1575 * MiB;
static_assert(WS_WIN + (size_t)INPAD * DM * 2 <= WS_WOUT && WS_P + (size_t)MP * INPAD * 4 <= WS_OUT && WS_U + (size_t)MP * DFF * 2 <= WS_RWV && WS_RWV + (size_t)NTOK * HB * 512 * 4 <= WS_SCL, "ws map");
constexpr int CW_BAR = 4096;
constexpr int RING_BYTES = 131072, LDSCTL_OFF = RING_BYTES, MISC_OFF = LDSCTL_OFF + 320, LDS_BYTES = 147456;
constexpr int NWAVES = 8, NTHR = 512;

#define GAS __attribute__((address_space(1)))
#define LAS __attribute__((address_space(3)))
typedef unsigned short bf16;
__device__ __forceinline__ float ldbf(const bf16* p) { return __uint_as_float((unsigned)*p << 16); }
__device__ __forceinline__ float ldbf_nt(const bf16* p) { return __uint_as_float((unsigned)__builtin_nontemporal_load(p) << 16); }
typedef float f32x4 __attribute__((ext_vector_type(4)));
typedef float f32x2 __attribute__((ext_vector_type(2)));
typedef unsigned u32x2 __attribute__((ext_vector_type(2)));
typedef unsigned u32x4 __attribute__((ext_vector_type(4)));
#define LDS_WAIT() asm volatile("s_waitcnt lgkmcnt(0)" ::: "memory")
#define VM_WAIT() asm volatile("s_waitcnt vmcnt(0)" ::: "memory")
using pg8::cvt_pk_bf16;
constexpr size_t WS_PBH = WS_RWV, WS_LWH = WS_RWV + 64 * MiB;
static_assert((size_t)NPR * 3072 * 2 <= 64 * MiB && 128 * MiB <= (size_t)NPR * HB * 512 * 4, "bf16 prompt copies fit below the sample rows of RWV");
constexpr int PBLD = 3584;
struct EpiIn {
    static constexpr bool PERM = false, AFTER_DRAIN = false;
    bf16 *QB, *KB, *VB; float* PB; float* out; bf16* PBH;
    __device__ __forceinline__ void operator()(const pg8::f32x4 (&acc)[2][2][4][2], const pg8::Unit& u, int wr, int wc, int fr, int fq) const {
        const int row0 = u.pm * 256 + wr * 64 + fr, colt = u.pn * 256 + wc * 32 + 4 * fq;
        if (u.pn >= 12) {
#pragma unroll
            for (int ai = 0; ai < 2; ++ai)
#pragma unroll
                for (int m = 0; m < 4; ++m) {
                    if (u.pm < 32 && u.pn < 24) { bf16* rowh = PBH + (size_t)(row0 + ai * 128 + m * 16) * 3072 + (colt - 3072);
#pragma unroll
                        for (int bj = 0; bj < 2; ++bj)
#pragma unroll
                            for (int n = 0; n < 2; ++n) { const pg8::f32x4 v = acc[ai][bj][m][n]; u32x2 w; w.x = cvt_pk_bf16(v[0], v[1]); w.y = cvt_pk_bf16(v[2], v[3]); *(u32x2*)(rowh + bj * 128 + n * 16) = w; } }
                    else { float* rowp = PB + (size_t)(row0 + ai * 128 + m * 16) * PBLD + (colt - 3072);
#pragma unroll
                        for (int bj = 0; bj < 2; ++bj)
#pragma unroll
                            for (int n = 0; n < 2; ++n) *(pg8::f32x4*)(rowp + bj * 128 + n * 16) = acc[ai][bj][m][n]; } }
        } else {
            const int sel = u.pn >> 2, c0 = colt - sel * 1024;
            static_assert(WS_KB - WS_QB == WS_VB - WS_KB && O_VP - O_KP == (size_t)NPR * 1024 && O_VS - O_KS == (size_t)NSM * 1024, "q/k/v buffers are equally spaced");
            bf16* Bt = QB + (size_t)sel * ((WS_KB - WS_QB) / 2) + (size_t)u.pm * 256 * 1024;
            float* Ot = u.pm < 32 ? out + O_KP + (size_t)(sel ? sel - 1 : 0) * NPR * 1024 + (size_t)u.pm * 256 * 1024 : out + O_KS + (size_t)(sel ? sel - 1 : 0) * NSM * 1024;
            const int rl0 = wr * 64 + fr;
#pragma unroll
            for (int ai = 0; ai < 2; ++ai)
#pragma unroll
                for (int m = 0; m < 4; ++m) { const int rl = rl0 + ai * 128 + m * 16; const unsigned eo = (unsigned)(rl * 1024 + c0);
                    const bool wo = sel != 0 && (u.pm < 32 || rl < NSM);
#pragma unroll
                    for (int bj = 0; bj < 2; ++bj)
#pragma unroll
                        for (int n = 0; n < 2; ++n) { const pg8::f32x4 v = acc[ai][bj][m][n]; u32x2 w; w.x = cvt_pk_bf16(v[0], v[1]); w.y = cvt_pk_bf16(v[2], v[3]);
                            *(u32x2*)(Bt + eo + bj * 128 + n * 16) = w; if (wo) *(pg8::f32x4*)(Ot + eo + bj * 128 + n * 16) = v; }
                    asm volatile("" ::: "memory"); }
        }
    }
};

#define XB_TMO      128
#define XB_XCNT(j)  (256  + 64 * (j))
#define XB_XSUB(j)  (1280 + 64 * (j))
#define XB_XGEN(j)  (2304 + 64 * (j))
#define XB_TOP      3328
#define XB_TOPGEN   3392
#define XCD_BAR_WORDS 3456
#define XB_SPIN_CAP (1u << 18)

__device__ __forceinline__ unsigned xb_ld(unsigned* p)              { return __hip_atomic_load(p, __ATOMIC_RELAXED, __HIP_MEMORY_SCOPE_AGENT); }
__device__ __forceinline__ unsigned xb_add(unsigned* p, unsigned v) { return __hip_atomic_fetch_add(p, v, __ATOMIC_RELAXED, __HIP_MEMORY_SCOPE_AGENT); }
__device__ __forceinline__ unsigned xb_xcc_id() { return (unsigned)__builtin_amdgcn_s_getreg((3 << 11) | 20) & 0xFu; }
#define XB_SPIN(cond, bar) do { unsigned _sp = 0; while (cond) { __builtin_amdgcn_s_sleep(1); \
    if ((++_sp & 255u) == 0u) { if (xb_ld(&(bar)[XB_TMO])) break; if (_sp > XB_SPIN_CAP) { atomicAdd(&(bar)[XB_TMO], 1u); break; } } } } while (0)

struct XcdBarrier {
    unsigned* bar; unsigned x;
    volatile LAS unsigned* st;
};

__device__ __forceinline__ XcdBarrier xcd_barrier_post(unsigned* bar, volatile LAS unsigned* st) {
    XcdBarrier b; b.bar = bar; b.x = xb_xcc_id(); b.st = st;
    if (threadIdx.x == 0) (void)xb_add(&bar[XB_XCNT(b.x)], 1u);
    return b;
}
__device__ __forceinline__ void xcd_barrier_complete(unsigned* bar, unsigned x, unsigned& nloc, unsigned& nx) {
    const unsigned G = gridDim.x * gridDim.y * gridDim.z;
    unsigned sum, cnt, mine, sp = 0u;
    for (;;) {
        sum = 0u; cnt = 0u; mine = 0u;
#pragma unroll
        for (unsigned j = 0; j < 16; ++j) { const unsigned c = xb_ld(&bar[XB_XCNT(j)]); sum += c; cnt += (c > 0u) ? 1u : 0u; mine = (j == x) ? c : mine; }
        if (sum == G) break;
        __builtin_amdgcn_s_sleep(1);
        if ((++sp & 255u) == 0u) { if (xb_ld(&bar[XB_TMO])) break; if (sp > XB_SPIN_CAP) { atomicAdd(&bar[XB_TMO], 1u); break; } }
    }
    nloc = mine > 0u ? mine : 1u; nx = cnt > 0u ? cnt : 1u;
}

__device__ __forceinline__ void xcd_barrier(const XcdBarrier& b) {
    asm volatile("s_waitcnt vmcnt(0)" ::: "memory");
    __syncthreads();
    if (threadIdx.x == 0) {
        unsigned* bar = b.bar;
        __builtin_amdgcn_s_waitcnt(0);
        unsigned nloc = b.st[0], nx = b.st[1];
        if (nloc == 0u) { xcd_barrier_complete(bar, b.x, nloc, nx); b.st[0] = nloc; b.st[1] = nx; }
        const unsigned old = xb_add(&bar[XB_XSUB(b.x)], 1u);
        const unsigned gen = old / nloc;
        if (old + 1u == (gen + 1u) * nloc) {
            __builtin_amdgcn_fence(__ATOMIC_RELEASE, "agent");
            asm volatile("s_waitcnt vmcnt(0)" ::: "memory");
            const unsigned og = xb_add(&bar[XB_TOP], 1u);
            const unsigned tg = og / nx;
            if (og + 1u == (tg + 1u) * nx) xb_add(&bar[XB_TOPGEN], 1u);
            else XB_SPIN(xb_ld(&bar[XB_TOPGEN]) == tg, bar);
            __builtin_amdgcn_fence(__ATOMIC_ACQUIRE, "agent");
            xb_add(&bar[XB_XGEN(b.x)], 1u);
            asm volatile("s_waitcnt vmcnt(0)" ::: "memory");
        } else {
            XB_SPIN(xb_ld(&bar[XB_XGEN(b.x)]) == gen, bar);
            __builtin_amdgcn_fence(__ATOMIC_ACQUIRE, "agent");
            asm volatile("s_waitcnt vmcnt(0)" ::: "memory");
        }
    }
    __syncthreads();
}


struct Ctx {
    LAS unsigned char* lds; int tid, lane, wave, vcu, G;
    __device__ __forceinline__ const float* in(int i) const { return ((const float* const __attribute__((address_space(4)))*)__builtin_amdgcn_kernarg_segment_ptr())[i]; }
    __device__ __forceinline__ float* outp() const { return ((float* const __attribute__((address_space(4)))*)__builtin_amdgcn_kernarg_segment_ptr())[N_IN]; }
    __device__ __forceinline__ unsigned char* wsp() const { return ((unsigned char* const __attribute__((address_space(4)))*)__builtin_amdgcn_kernarg_segment_ptr())[N_IN + 1]; }
};
template <int CTRL> __device__ __forceinline__ float dpp_f(float x) { return __builtin_bit_cast(float, __builtin_amdgcn_mov_dpp(__builtin_bit_cast(int, x), CTRL, 0xf, 0xf, true)); }
#define readlane_f(x, l) __builtin_bit_cast(float, __builtin_amdgcn_readlane(__builtin_bit_cast(int, (float)(x)), (l)))
__device__ __forceinline__ float wave_sum(float v) {
    v += dpp_f<0xB1>(v); v += dpp_f<0x4E>(v); v += dpp_f<0x141>(v); v += dpp_f<0x140>(v);
    auto s = __builtin_amdgcn_permlane16_swap(__float_as_uint(v), __float_as_uint(v), false, false);
    v = __uint_as_float(s[0]) + __uint_as_float(s[1]);
    auto t = __builtin_amdgcn_permlane32_swap(__float_as_uint(v), __float_as_uint(v), false, false);
    return __uint_as_float(t[0]) + __uint_as_float(t[1]);
}
__device__ __forceinline__ float sigmoidf_(float x) { return 1.f / (1.f + __expf(-x)); }
__device__ __forceinline__ float softplusf_(float x) { return fmaxf(x, 0.f) + log1pf(__expf(-fabsf(x))); }
__device__ __forceinline__ int mod_row(int r) { return r < NPR ? (r >> 12) : 2 + ((r - NPR) >> 3); }
#define WSP(T, off) ((T*)(F.wsp() + (off)))

struct CvtItem { const float* W; bf16* WT; int ldw, ldt, k0, n0; };
__device__ __forceinline__ void item_load(float (&tv)[32], const CvtItem& d, int lane) {
#pragma unroll
    for (int i = 0; i < 32; ++i) tv[i] = __builtin_nontemporal_load(d.W + (size_t)(d.k0 + 2 * i + (lane >> 5)) * d.ldw + d.n0 + (lane & 31));
}
__device__ __forceinline__ void item_store(const float (&tv)[32], const CvtItem& d, LAS float* scr, int lane) {
#pragma unroll
    for (int i = 0; i < 32; ++i) scr[(2 * i + (lane >> 5)) * 33 + (lane & 31)] = tv[i];
    LDS_WAIT(); asm volatile("" ::: "memory");
    const int c = lane & 7;
#pragma unroll
    for (int j = 0; j < 4; ++j) { const int n = (lane >> 3) + 8 * j; const LAS float* s = scr + (8 * c) * 33 + n;
        u32x4 o; o.x = cvt_pk_bf16(s[0 * 33], s[1 * 33]); o.y = cvt_pk_bf16(s[2 * 33], s[3 * 33]); o.z = cvt_pk_bf16(s[4 * 33], s[5 * 33]); o.w = cvt_pk_bf16(s[6 * 33], s[7 * 33]);
        *(GAS u32x4*)(d.WT + (size_t)(d.n0 + n) * d.ldt + d.k0 + 8 * c) = o; }
    LDS_WAIT(); asm volatile("" ::: "memory");
}
constexpr int IT_IN = 32 * 206, IT_OUT = 32 * 64, IT_W1 = 32 * 256, IT_W2 = 128 * 64, IT_PL = 8 * 16, NIT_ALL = IT_IN + IT_OUT + 2 * IT_W1 + 2 * IT_W2 + 4 * IT_PL;
__device__ __forceinline__ CvtItem item_decode(Ctx& F, int it) {
    int r = it; CvtItem d; int N;
    if (r < IT_IN) { d.W = F.in(I_WIN); d.WT = WSP(bf16, WS_WIN); N = INCOLS; d.ldt = DM; }
    else if ((r -= IT_IN) < IT_OUT) { d.W = F.in(I_WOUT); d.WT = WSP(bf16, WS_WOUT); N = DM; d.ldt = DM; }
    else if ((r -= IT_OUT) < 2 * IT_W1) { const int l = r / IT_W1; r -= l * IT_W1; d.W = F.in(I_W1) + (size_t)l * DM * DFF; d.WT = WSP(bf16, WS_W1) + (size_t)l * DFF * DM; N = DFF; d.ldt = DM; }
    else if ((r -= 2 * IT_W1) < 2 * IT_W2) { const int l = r / IT_W2; r -= l * IT_W2; d.W = F.in(I_W2) + (size_t)l * DFF * DM; d.WT = WSP(bf16, WS_W2) + (size_t)l * DM * DFF; N = DM; d.ldt = DFF; }
    else { r -= 2 * IT_W2; const int g = r / IT_PL; r -= g * IT_PL; d.W = F.in(I_WPOOL) + (size_t)g * 512 * 512; d.WT = WSP(bf16, WS_WPOOL) + (size_t)(g * 512) * DM + g * 512; N = 512; d.ldt = DM; }
    const int nblk = N / 32, kb = r / nblk, nb = r - kb * nblk;
    d.ldw = N; d.k0 = 64 * kb; d.n0 = 32 * nb; return d;
}
__device__ __forceinline__ void convert_run(Ctx& F, int first, int stride, int lim, LAS float* scr) {
    int it = first; if (it >= lim) return;
    float ta[32], tb[32]; CvtItem da = item_decode(F, it), db = da; item_load(ta, da, F.lane);
    for (;;) {
        const int i2 = it + stride; const bool h2 = i2 < lim; if (h2) { db = item_decode(F, i2); item_load(tb, db, F.lane); }
        item_store(ta, da, scr, F.lane); if (!h2) break;
        const int i3 = i2 + stride; const bool h3 = i3 < lim; if (h3) { da = item_decode(F, i3); item_load(ta, da, F.lane); }
        item_store(tb, db, scr, F.lane); if (!h3) break;
        it = i3; }
}
constexpr int NCVT = 40, N_HIDE = 24000;
__device__ __forceinline__ void phase_prologue(Ctx& F) {
    LAS float* scr = (LAS float*)(F.lds + F.wave * 16384);
    const int gw = F.vcu * NWAVES + F.wave, NGW = F.G * NWAVES;
    convert_run(F, gw, NGW, IT_IN, scr);
    if (F.G > NCVT + 8) convert_run(F, IT_IN + N_HIDE + gw, NGW, NIT_ALL, scr); else convert_run(F, IT_IN + gw, NGW, NIT_ALL, scr);
    for (int i = F.vcu * NTHR + F.tid; i < 3072 * 64; i += F.G * NTHR) {
        const int kc = i / 3072, n = i - kc * 3072, reg = n >> 10, nn = n & 1023;
        float v[8];
        if (reg == 0) {
#pragma unroll
            for (int j = 0; j < 8; ++j) { const int k = 8 * kc + j; v[j] = (k < 96) ? F.in(I_WUP)[(size_t)k * 1024 + nn] : 0.f; } }
        else if (reg == 1) {
#pragma unroll
            for (int j = 0; j < 8; ++j) { const int k = 8 * kc + j - 96; v[j] = (k >= 0 && k < 96) ? F.in(I_AUP)[(size_t)k * 1024 + nn] : 0.f; } }
        else {
#pragma unroll
            for (int j = 0; j < 8; ++j) { const int k = 8 * kc + j - 192; v[j] = (k >= 0 && k < 256) ? F.in(I_GUP)[(size_t)k * 1024 + nn] : 0.f; } }
        u32x4 o; o.x = cvt_pk_bf16(v[0], v[1]); o.y = cvt_pk_bf16(v[2], v[3]); o.z = cvt_pk_bf16(v[4], v[5]); o.w = cvt_pk_bf16(v[6], v[7]);
        *(GAS u32x4*)(WSP(bf16, WS_LWT) + (size_t)n * 512 + 8 * kc) = o;
    }
    __syncthreads();
    LAS float* scs = (LAS float*)F.lds;
    LAS float* part = (LAS float*)(F.lds + 16384);
    float* PARTM = WSP(float, WS_G);
    for (int su = F.vcu; su < 768; su += F.G) {
        const int task = su >> 3, ke = su & 7, l = task / 48, cb = (task - l * 48) * 256;
        for (int i = F.tid; i < NMR * 256; i += NTHR) { const int r = i >> 8, k = ke * 256 + (i & 255); const float c = r < 2 ? F.in(I_CP)[r * DM + k] : F.in(I_CS)[(r - 2) * DM + k]; scs[i] = c / (1.f + __expf(-c)); }
        __syncthreads();
        const float* W = F.in(I_WADA) + ((size_t)l * DM + ke * 256 + F.wave * 32) * 12288 + cb + F.lane * 4;
        f32x4 acc[NMR];
#pragma unroll
        for (int r = 0; r < NMR; ++r) acc[r] = (f32x4){0.f, 0.f, 0.f, 0.f};
        for (int k = 0; k < 32; k += 8) {
            f32x4 wv[8];
#pragma unroll
            for (int j = 0; j < 8; ++j) wv[j] = __builtin_nontemporal_load((const GAS f32x4*)(W + (size_t)(k + j) * 12288));
#pragma unroll
            for (int j = 0; j < 8; j += 4)
#pragma unroll
                for (int r = 0; r < NMR; ++r) { const f32x4 sv = *(const LAS f32x4*)(scs + r * 256 + F.wave * 32 + k + j); acc[r] += (wv[j] * sv.x + wv[j + 1] * sv.y) + (wv[j + 2] * sv.z + wv[j + 3] * sv.w); }
        }
#pragma unroll
        for (int r = 0; r < NMR; ++r) *(LAS f32x4*)(part + (F.wave * NMR + r) * 256 + F.lane * 4) = acc[r];
        __syncthreads();
        for (int i = F.tid; i < NMR * 64; i += NTHR) { const int r = i >> 6, c4 = (i & 63) * 4; f32x4 sm = *(const LAS f32x4*)(part + r * 256 + c4);
#pragma unroll
            for (int w = 1; w < NWAVES; ++w) sm += *(const LAS f32x4*)(part + (w * NMR + r) * 256 + c4);
            *(GAS f32x4*)(PARTM + ((size_t)ke * 2 * NMR + l * NMR + r) * 12288 + cb + c4) = sm; }
        __syncthreads();
    }
}

struct Row { f32x4 v[8]; };
__device__ __forceinline__ void row_load(Row& R, const float* p, int lane) {
#pragma unroll
    for (int j = 0; j < 8; ++j) R.v[j] = *(const GAS f32x4*)(p + j * 256 + lane * 4);
}
__device__ __forceinline__ void row_load_bf16(Row& R, const bf16* p, int lane) {
#pragma unroll
    for (int j = 0; j < 8; ++j) { const u32x2 w = *(const GAS u32x2*)(p + j * 256 + lane * 4);
        R.v[j] = (f32x4){__uint_as_float(w.x << 16), __uint_as_float(w.x & 0xffff0000u), __uint_as_float(w.y << 16), __uint_as_float(w.y & 0xffff0000u)}; }
}
__device__ __forceinline__ float row_sumsq(const Row& R) { float s = 0.f;
#pragma unroll
    for (int j = 0; j < 8; ++j) s += (R.v[j].x * R.v[j].x + R.v[j].y * R.v[j].y) + (R.v[j].z * R.v[j].z + R.v[j].w * R.v[j].w);
    return wave_sum(s); }
__device__ __forceinline__ const float* x_in_row(Ctx& F, int r) { return r < NPR ? F.in(I_XP) + (size_t)r * DM : F.in(I_XS) + (size_t)(r - NPR) * DM; }
__device__ __forceinline__ void row_modulate(Row& H, const Row& X, float rstd, const float* g, const float* shift, const float* scale, int lane) {
#pragma unroll
    for (int j = 0; j < 8; ++j) { const int c = j * 256 + lane * 4; const f32x4 gg = *(const GAS f32x4*)(g + c), sh = *(const GAS f32x4*)(shift + c), sc = *(const GAS f32x4*)(scale + c);
        H.v[j] = X.v[j] * rstd * gg * (sc + 1.f) + sh; }
}
__device__ __forceinline__ void row_store_bf16(const Row& H, bf16* p, int lane) {
#pragma unroll
    for (int j = 0; j < 8; ++j) { u32x2 w; w.x = cvt_pk_bf16(H.v[j].x, H.v[j].y); w.y = cvt_pk_bf16(H.v[j].z, H.v[j].w); *(GAS u32x2*)(p + j * 256 + lane * 4) = w; }
}
__device__ __forceinline__ void row_store_f32(const Row& H, float* p, int lane) {
#pragma unroll
    for (int j = 0; j < 8; ++j) *(GAS f32x4*)(p + j * 256 + lane * 4) = H.v[j];
}
__device__ __forceinline__ void row_store_f32_nt(const Row& H, float* p, int lane) {
#pragma unroll
    for (int j = 0; j < 8; ++j) __builtin_nontemporal_store(H.v[j], (GAS f32x4*)(p + j * 256 + lane * 4));
}
struct RowB { u32x2 w[8]; };
__device__ __forceinline__ void rowb_load(RowB& R, const bf16* p, int lane) {
#pragma unroll
    for (int j = 0; j < 8; ++j) R.w[j] = *(const GAS u32x2*)(p + j * 256 + lane * 4);
}
__device__ __forceinline__ void rowb_cvt(Row& R, const RowB& B) {
#pragma unroll
    for (int j = 0; j < 8; ++j) R.v[j] = (f32x4){__uint_as_float(B.w[j].x << 16), __uint_as_float(B.w[j].x & 0xffff0000u), __uint_as_float(B.w[j].y << 16), __uint_as_float(B.w[j].y & 0xffff0000u)};
}
constexpr int PSET_FLOATS = 3 * DM;
static_assert(NSM == 64 && 3 * PSET_FLOATS * 4 + 7 * DM * 4 <= RING_BYTES, "row phases: 8 workgroups x 8 waves take the sample rows; three parameter sets in LDS");
template <int KIND, int L> __device__ __forceinline__ void stage_row_params(Ctx& F) {
    const float* MOD = WSP(float, WS_MOD); const float* ng = F.in(I_NG) + (size_t)L * 4 * DM;
    const int nset = F.vcu < 64 ? 3 : 2;
#define RP_LD4(p) (*(const GAS f32x4*)(p))
    for (int i = F.tid; i < nset * (DM / 4); i += NTHR) {
        const int s = i >> 9, c = (i & 511) * 4, mr = s < 2 ? s : 2 + (F.vcu >> 3);
        const float* m = MOD + (size_t)(L * NMR + mr) * 12288;
        f32x4 v0 = {0.f, 0.f, 0.f, 0.f}, v1 = v0, v2 = v0;
        if (KIND == 0) {
            const float* pm = WSP(float, WS_G) + (size_t)mr * 12288; f32x4 sh = RP_LD4(F.in(I_BADA) + c), scl = RP_LD4(F.in(I_BADA) + DM + c);
#pragma unroll
            for (int ke = 0; ke < 8; ++ke) { sh += RP_LD4(pm + (size_t)ke * 2 * NMR * 12288 + c); scl += RP_LD4(pm + (size_t)ke * 2 * NMR * 12288 + DM + c); }
            v1 = RP_LD4(ng + c) * (scl + 1.f); v2 = sh; }
        else if (KIND == 1) { v0 = RP_LD4(m + 2 * DM + c) * RP_LD4(ng + DM + c); v1 = RP_LD4(ng + 2 * DM + c) * (RP_LD4(m + 4 * DM + c) + 1.f); v2 = RP_LD4(m + 3 * DM + c); }
        else { v0 = RP_LD4(m + 5 * DM + c) * RP_LD4(ng + 3 * DM + c);
               if (KIND == 2) { const float* m1 = MOD + (size_t)(1 * NMR + mr) * 12288; v1 = RP_LD4(F.in(I_NG) + (size_t)4 * DM + c) * (RP_LD4(m1 + DM + c) + 1.f); v2 = RP_LD4(m1 + c); } }
        LAS float* d = (LAS float*)F.lds + s * PSET_FLOATS + c;
        *(LAS f32x4*)d = v0; *(LAS f32x4*)(d + DM) = v1; *(LAS f32x4*)(d + 2 * DM) = v2;
    }
#undef RP_LD4
    __syncthreads();
}
__device__ __forceinline__ const LAS float* row_pset(Ctx& F, int r) { return (const LAS float*)F.lds + (r < NPR ? (r >> 12) : 2) * PSET_FLOATS; }
__device__ __forceinline__ void row_residual_l(Row& X, const Row& O, const LAS float* ps, int lane) {
    const float rstd = rsqrtf(row_sumsq(O) * (1.f / DM) + EPS_RMS);
#pragma unroll
    for (int j = 0; j < 8; ++j) { const f32x4 gt = *(const LAS f32x4*)(ps + j * 256 + lane * 4); X.v[j] = X.v[j] + gt * (O.v[j] * rstd); }
}
__device__ __forceinline__ void row_modulate_l(Row& H, const Row& X, const LAS float* ps, int lane) {
    const float rstd = rsqrtf(row_sumsq(X) * (1.f / DM) + EPS_RMS);
#pragma unroll
    for (int j = 0; j < 8; ++j) { const int c = j * 256 + lane * 4; const f32x4 a = *(const LAS f32x4*)(ps + DM + c), sh = *(const LAS f32x4*)(ps + 2 * DM + c); H.v[j] = X.v[j] * rstd * a + sh; }
}
__device__ __forceinline__ void phase_mod0(Ctx& F) {
    stage_row_params<0, 0>(F);
    const int gw = F.vcu * NWAVES + F.wave, NGW = F.G * NWAVES, samp = (F.vcu < 64 && F.wave == 0) ? NPR + F.vcu : NTOK; bf16* Hb = WSP(bf16, WS_H);
    Row Xn; row_load(Xn, x_in_row(F, gw), F.lane);
    for (int r = gw; r < NPR; r += NGW) {
        Row X = Xn, H; const int rn = r + NGW, rp = rn < NPR ? rn : (samp < NTOK ? samp : r);
        row_load(Xn, x_in_row(F, rp), F.lane);
        row_modulate_l(H, X, row_pset(F, r), F.lane);
        row_store_bf16(H, Hb + (size_t)r * DM, F.lane);
    }
    if (samp < NTOK) { Row H; row_modulate_l(H, Xn, row_pset(F, samp), F.lane); row_store_bf16(H, Hb + (size_t)samp * DM, F.lane); }
}
__device__ __forceinline__ void row_residual(Row& X, const Row& O, const float* ga, const float* gate, int lane) {
    const float rstd = rsqrtf(row_sumsq(O) * (1.f / DM) + EPS_RMS);
#pragma unroll
    for (int j = 0; j < 8; ++j) { const int c = j * 256 + lane * 4; const f32x4 gg = *(const GAS f32x4*)(ga + c), gt = *(const GAS f32x4*)(gate + c); X.v[j] = X.v[j] + gt * (O.v[j] * rstd * gg); }
}
template <int NK> __device__ __forceinline__ void row_load_out(Ctx& F, Row& O, int r, int lane) {
    if (r < NPR) { const bf16* op = WSP(bf16, WS_OUT) + (size_t)r * DM;
#pragma unroll
        for (int j = 0; j < 8; ++j) { const u32x2 w = *(const GAS u32x2*)(op + j * 256 + lane * 4);
            O.v[j] = (f32x4){__uint_as_float(w.x << 16), __uint_as_float(w.x & 0xffff0000u), __uint_as_float(w.y << 16), __uint_as_float(w.y & 0xffff0000u)}; }
        return; }
    const float* pp = WSP(float, WS_PART) + (size_t)(r - NPR) * DM;
    row_load(O, pp, lane);
    for (int kc = 1; kc < NK; ++kc) { Row T; row_load(T, pp + (size_t)kc * 64 * DM, lane);
#pragma unroll
        for (int j = 0; j < 8; ++j) O.v[j] += T.v[j]; }
}
__device__ __forceinline__ f32x4 ld_bf4(const bf16* p) { const u32x2 w = *(const GAS u32x2*)p; return (f32x4){__uint_as_float(w.x << 16), __uint_as_float(w.x & 0xffff0000u), __uint_as_float(w.y << 16), __uint_as_float(w.y & 0xffff0000u)}; }
__device__ __forceinline__ void row_load_pool(Ctx& F, Row& O, int r, int lane) {
    if (r < NPR && (r & (SEQ - 1)) >= PBUF) { const bf16* op = WSP(bf16, WS_OUT) + (size_t)r * DM + lane * 4;
#pragma unroll
        for (int j8 = 0; j8 < 8; ++j8) { const int wlen = 2 << (j8 >> 1);
            const f32x4 cur = ld_bf4(op + j8 * 256); f32x4 sum = cur;
#pragma unroll
            for (int j = 1; j < wlen; ++j) sum += ld_bf4(op + j8 * 256 - (size_t)j * DM);
            O.v[j8] = sum * (1.f / (float)wlen) - cur; }
    } else if (r < NPR) { const int t = r & (SEQ - 1); const bf16* op = WSP(bf16, WS_OUT) + (size_t)r * DM + lane * 4;
#pragma unroll
        for (int j8 = 0; j8 < 8; ++j8) { const int wlen = 2 << (j8 >> 1), n = (t + 1) < wlen ? (t + 1) : wlen;
            const f32x4 cur = ld_bf4(op + j8 * 256); f32x4 sum = cur;
            for (int j = 1; j < n; ++j) sum += ld_bf4(op + j8 * 256 - (size_t)j * DM);
            O.v[j8] = sum * (1.f / (float)n) - cur; }
    } else { const int rs = r - NPR, b = rs >> 3, t = rs & 7; const float* pp = WSP(float, WS_PART) + lane * 4;
#pragma unroll
        for (int j8 = 0; j8 < 8; ++j8) { const int wlen = 2 << (j8 >> 1); f32x4 cur = {0.f, 0.f, 0.f, 0.f}, sum = {0.f, 0.f, 0.f, 0.f};
#pragma unroll
            for (int j = 0; j < wlen; ++j) { const int tj = t - j, pr = tj >= 0 ? rs - j : 64 + b * PBUF + PBUF + tj;
                const f32x4 g = *(const GAS f32x4*)(pp + (size_t)pr * DM + j8 * 256) + *(const GAS f32x4*)(pp + (size_t)(256 + pr) * DM + j8 * 256);
                sum += g; if (j == 0) cur = g; }
            O.v[j8] = sum * (1.f / (float)wlen) - cur; }
    }
}
template <int NK> __device__ __forceinline__ void sample_row_gather(Ctx& F, Row& O, int s) {
    constexpr int PER = NK / 8; const float* pp = WSP(float, WS_PART) + ((size_t)(F.wave * PER) * 64 + s) * DM; Row T[PER];
#pragma unroll
    for (int k = 0; k < PER; ++k) row_load(T[k], pp + (size_t)k * 64 * DM, F.lane);
    O = T[0];
#pragma unroll
    for (int k = 1; k < PER; ++k)
#pragma unroll
        for (int j = 0; j < 8; ++j) O.v[j] += T[k].v[j];
    LAS float* sl = (LAS float*)F.lds + 3 * PSET_FLOATS;
    if (F.wave > 0) {
#pragma unroll
        for (int j = 0; j < 8; ++j) *(LAS f32x4*)(sl + (F.wave - 1) * DM + j * 256 + F.lane * 4) = O.v[j]; }
    __syncthreads();
    if (F.wave == 0) {
#pragma unroll
        for (int w = 0; w < 7; ++w)
#pragma unroll
            for (int j = 0; j < 8; ++j) O.v[j] += *(const LAS f32x4*)(sl + w * DM + j * 256 + F.lane * 4); }
}
template <int L> __device__ __forceinline__ void phase_postmix(Ctx& F) {
    stage_row_params<1, L>(F);
    const int gw = F.vcu * NWAVES + F.wave, NGW = F.G * NWAVES, samp = (F.vcu < 64 && F.wave == 0) ? NPR + F.vcu : NTOK;
    bf16* Hb = WSP(bf16, WS_H); bf16* XR = WSP(bf16, WS_XR); const bf16* OUTb = WSP(bf16, WS_OUT);
    Row Xf; RowB Xb, Ob;
    if (L == 0) { row_load(Xf, x_in_row(F, gw), F.lane); rowb_load(Ob, OUTb + (size_t)gw * DM, F.lane); } else rowb_load(Xb, XR + (size_t)gw * DM, F.lane);
    for (int r = gw; r < NPR; r += NGW) {
        Row X, O, H; const int rn = r + NGW, rp = rn < NPR ? rn : (samp < NTOK ? samp : r), ro = rn < NPR ? rn : r;
        if (L == 0) { X = Xf; rowb_cvt(O, Ob); row_load(Xf, x_in_row(F, rp), F.lane); rowb_load(Ob, OUTb + (size_t)ro * DM, F.lane); }
        else { rowb_cvt(X, Xb); rowb_load(Xb, XR + (size_t)rp * DM, F.lane); row_load_pool(F, O, r, F.lane); }
        const LAS float* ps = row_pset(F, r);
        row_residual_l(X, O, ps, F.lane);
        row_store_bf16(X, XR + (size_t)r * DM, F.lane);
        row_modulate_l(H, X, ps, F.lane);
        row_store_bf16(H, Hb + (size_t)r * DM, F.lane);
    }
    Row Og; if (L == 0 && F.vcu < 64) sample_row_gather<8>(F, Og, F.vcu);
    if (samp < NTOK) { Row X, O, H; if (L == 0) { X = Xf; O = Og; } else { rowb_cvt(X, Xb); row_load_pool(F, O, samp, F.lane); }
        const LAS float* ps = row_pset(F, samp);
        row_residual_l(X, O, ps, F.lane);
        row_store_bf16(X, XR + (size_t)samp * DM, F.lane);
        row_modulate_l(H, X, ps, F.lane);
        row_store_bf16(H, Hb + (size_t)samp * DM, F.lane); }
}
template <int L> __device__ __forceinline__ void phase_postmlp(Ctx& F) {
    stage_row_params<L == 0 ? 2 : 3, L>(F);
    const int gw = F.vcu * NWAVES + F.wave, NGW = F.G * NWAVES, samp = (F.vcu < 64 && F.wave == 0) ? NPR + F.vcu : NTOK;
    bf16* XR = WSP(bf16, WS_XR); const bf16* OUTb = WSP(bf16, WS_OUT);
    RowB Xb, Ob; rowb_load(Xb, XR + (size_t)gw * DM, F.lane); rowb_load(Ob, OUTb + (size_t)gw * DM, F.lane);
    for (int r = gw; r < NPR; r += NGW) {
        Row X, O; const int rn = r + NGW, rp = rn < NPR ? rn : (samp < NTOK ? samp : r), ro = rn < NPR ? rn : r;
        rowb_cvt(X, Xb); rowb_cvt(O, Ob); rowb_load(Xb, XR + (size_t)rp * DM, F.lane); rowb_load(Ob, OUTb + (size_t)ro * DM, F.lane);
        const LAS float* ps = row_pset(F, r);
        row_residual_l(X, O, ps, F.lane);
        if (L == 0) {
            row_store_bf16(X, XR + (size_t)r * DM, F.lane);
            Row H; row_modulate_l(H, X, ps, F.lane);
            row_store_bf16(H, WSP(bf16, WS_H) + (size_t)r * DM, F.lane);
            const int t = r & (SEQ - 1); if (t >= SEQ - PBUF) row_store_f32(H, F.outp() + O_PLP + ((size_t)(r >> 12) * PBUF + (t - (SEQ - PBUF))) * DM, F.lane);
        } else row_store_f32_nt(X, F.outp() + O_YP + (size_t)r * DM, F.lane);
    }
    Row Og; if (F.vcu < 64) sample_row_gather<32>(F, Og, F.vcu);
    if (samp < NTOK) { Row X, O = Og; rowb_cvt(X, Xb);
        const LAS float* ps = row_pset(F, samp); const int rs = samp - NPR;
        row_residual_l(X, O, ps, F.lane);
        if (L == 0) {
            row_store_bf16(X, XR + (size_t)samp * DM, F.lane);
            Row H; row_modulate_l(H, X, ps, F.lane);
            row_store_bf16(H, WSP(bf16, WS_H) + (size_t)samp * DM, F.lane);
            row_store_f32(H, F.outp() + O_PLS + ((size_t)(rs >> 3) * PBUF + 7 + (rs & 7)) * DM, F.lane);
        } else row_store_f32_nt(X, F.outp() + O_YS + (size_t)rs * DM, F.lane); }
    if (L == 0) {
        const float* SP = F.in(I_SPOOL); bf16* Hb = WSP(bf16, WS_H);
        for (int i = F.vcu * NTHR + F.tid; i < DBAT * PBUF * 512; i += F.G * NTHR) { const int c4 = (i & 511) * 4, bi = i >> 9, b = bi / PBUF, k = bi - b * PBUF;
            const f32x4 v = *(const GAS f32x4*)(SP + (size_t)bi * DM + c4); u32x2 w; w.x = cvt_pk_bf16(v.x, v.y); w.y = cvt_pk_bf16(v.z, v.w);
            *(GAS u32x2*)(Hb + (size_t)(NTOK + bi) * DM + c4) = w;
            if (k >= 8) *(GAS f32x4*)(F.outp() + O_PLS + ((size_t)b * PBUF + (k - 8)) * DM + c4) = v; }
    }
}

__device__ __forceinline__ void phase_kv_prep(Ctx& F) {
    { const float* PM = WSP(float, WS_G); float* MOD = WSP(float, WS_MOD);
      for (int i = F.vcu * NTHR + F.tid; i < 2 * NMR * 12288 / 4; i += F.G * NTHR) { const int row = i / 3072, c4 = (i - row * 3072) * 4, l = row / NMR;
          f32x4 sm = *(const GAS f32x4*)(F.in(I_BADA) + (size_t)l * 12288 + c4);
#pragma unroll
          for (int ke = 0; ke < 8; ++ke) sm += *(const GAS f32x4*)(PM + ((size_t)ke * 2 * NMR + row) * 12288 + c4);
          *(GAS f32x4*)(MOD + (size_t)row * 12288 + c4) = sm; } }
    const float* P = WSP(float, WS_P);
    for (int i = F.vcu * NTHR + F.tid; i < (NBATCH + DBAT) * BCOLS; i += F.G * NTHR) {
        const int b = i / BCOLS, c = i - b * BCOLS; const int r = b < NBATCH ? b * SEQ + SEQ - 1 : NPR + (b - NBATCH) * DSEQ + DSEQ - 1;
        F.outp()[(b < NBATCH ? O_SHP + (size_t)b * BCOLS : O_SHS + (size_t)(b - NBATCH) * BCOLS) + c] = (b < NBATCH && c < 3072) ? ldbf(WSP(bf16, WS_PBH) + (size_t)r * 3072 + c) : P[(size_t)r * PBLD + c];
    }
    { const int gw = F.vcu * NWAVES + F.wave, NGW = F.G * NWAVES; const float* mu = F.in(I_MU); bf16* LA = WSP(bf16, WS_LA);
      for (int r = gw; r < NTOK; r += NGW) {
        const float* pb = P + (size_t)r * PBLD; const float* prev; bool hp;
        if (r < NPR) { const int t = r & (SEQ - 1); hp = t > 0; prev = pb - PBLD; }
        else { const int rs = r - NPR, b = rs >> 3, t = rs & 7; hp = true; prev = t > 0 ? pb - PBLD : F.in(I_SSH) + (size_t)b * BCOLS; }
        float v[8];
        { const int c0 = 3072 + F.lane * 8; const bool act = F.lane < 56; const f32x4 z4 = {0.f, 0.f, 0.f, 0.f};
          f32x4 pa = z4, pc = z4, qa = z4, qc = z4, ma = z4, mc = z4;
          if (act) { pa = *(const GAS f32x4*)(pb + c0); pc = *(const GAS f32x4*)(pb + c0 + 4); ma = *(const GAS f32x4*)(mu + c0); mc = *(const GAS f32x4*)(mu + c0 + 4);
                     if (hp) { qa = *(const GAS f32x4*)(prev + c0); qc = *(const GAS f32x4*)(prev + c0 + 4); } }
          const f32x4 za = pa + ma * (qa - pa), zc = pc + mc * (qc - pc);
          const float kz = F.lane < 12 ? 2.f : 1.f;
#pragma unroll
          for (int j = 0; j < 8; ++j) { const float z = j < 4 ? za[j & 3] : zc[j & 3]; const float sg = 1.f / (1.f + __expf(-kz * z));
              v[j] = !act ? 0.f : (F.lane < 12 ? 2.f * sg - 1.f : (F.lane < 24 ? z : sg)); } }
        u32x4 o; o.x = cvt_pk_bf16(v[0], v[1]); o.y = cvt_pk_bf16(v[2], v[3]); o.z = cvt_pk_bf16(v[4], v[5]); o.w = cvt_pk_bf16(v[6], v[7]);
        *(GAS u32x4*)(LA + (size_t)r * 512 + F.lane * 8) = o;
      } }
}
__device__ __forceinline__ void phase_rwkv_prep(Ctx& F) {
    const float* P = WSP(float, WS_P); const float* LWO = WSP(float, WS_LWO);
    const int gw = F.vcu * NWAVES + F.wave, NGW = F.G * NWAVES;
    float* RWV = WSP(float, WS_RWV); float* SCL = WSP(float, WS_SCL);
    const float* mu = F.in(I_MU);
    for (int u = gw; u < NSM * 4; u += NGW) {
        const int r = NPR + (u >> 2), hq = u & 3;
        const float* pb = P + (size_t)r * PBLD; const float* prev; const bool hp = true;
        { const int rs = r - NPR, b = rs >> 3, t = rs & 7; prev = t > 0 ? pb - PBLD : F.in(I_SSH) + (size_t)b * BCOLS; }
        const float* lw = LWO + (size_t)r * 3072;
        float pr[4], pk[4], pv[4], qr_[4], qk[4], qv[4], lwl[4], lal[4], lgl[4];
#pragma unroll
        for (int i = 0; i < 4; ++i) { const int col = (hq * 4 + i) * 64 + F.lane;
            pr[i] = pb[col]; pk[i] = pb[1024 + col]; pv[i] = pb[2048 + col];
            qr_[i] = hp ? prev[col] : 0.f; qk[i] = hp ? prev[1024 + col] : 0.f; qv[i] = hp ? prev[2048 + col] : 0.f;
            lwl[i] = lw[col]; lal[i] = lw[1024 + col]; lgl[i] = lw[2048 + col]; }
#pragma unroll
        for (int i = 0; i < 4; ++i) { const int h = hq * 4 + i, col = h * 64 + F.lane;
            const float zr = pr[i] + mu[col] * (qr_[i] - pr[i]), zk = pk[i] + mu[1024 + col] * (qk[i] - pk[i]), zv = pv[i] + mu[2048 + col] * (qv[i] - pv[i]);
            const float wl = F.in(I_W0)[col] + lwl[i], al = F.in(I_A0)[col] + lal[i], gl = lgl[i];
            const float wlog = -softplusf_(-wl) - 0.5f, decay = __expf(-__expf(wlog));
            const float a = sigmoidf_(al);
            const float kkr = zk * F.in(I_KK)[col], kk = kkr * rsqrtf(wave_sum(kkr * kkr) + 1e-12f);
            const float k = zk * (1.f + (a - 1.f) * F.in(I_KA)[col]);
            const float bb = kk * a;
            const float bonus = wave_sum(zr * k * F.in(I_RK)[col]), beta = wave_sum(bb * zr), kappa = wave_sum(k * zr);
            float* base = RWV + ((size_t)r * HB + h) * 512;
            base[F.lane] = decay; base[64 + F.lane] = kk; base[128 + F.lane] = bb; base[192 + F.lane] = k; base[256 + F.lane] = zr; base[320 + F.lane] = zv; base[384 + F.lane] = decay * zr;
            if (F.lane == 0) { float* s_ = SCL + ((size_t)r * HB + h) * 4; s_[0] = beta; s_[1] = kappa; s_[2] = bonus; s_[3] = 0.f; }
        }
    }
}

namespace sba {
typedef short bf16x8 __attribute__((ext_vector_type(8)));
typedef short s16x4 __attribute__((ext_vector_type(4)));
typedef float f32x16 __attribute__((ext_vector_type(16)));
constexpr int SHM = 16384, LDQ = 1024;
#define SB_KSWZ(row, colB) ((row) * 256 + ((colB) ^ (((row) & 7) << 4)))
#define SB_SBAR() __builtin_amdgcn_sched_barrier(0)
__device__ __forceinline__ int v_st(int k, int c) { const int kk = (k & ~0xC) | ((k & 4) << 1) | ((k & 8) >> 1); return ((kk >> 3) * 4 + (c >> 5)) * 512 + ((kk & 7) * 32 + (c & 31)) * 2; }
__device__ __forceinline__ int v_rd_base(int lane) { return ((lane & 3) << 3) | (((lane >> 2) & 3) << 6) | (((lane >> 4) & 1) << 5) | (((lane >> 5) & 1) << 8); }
__device__ __forceinline__ int crow(int r, int hi) { return (r & 3) + 8 * (r >> 2) + 4 * hi; }
__device__ __forceinline__ void qkt(f32x16& p0, f32x16& p1, const char* Kt, int r32, int hi, const bf16x8* qr) {
    p0 = f32x16{}; p1 = f32x16{};
    const char* kb[4];
#pragma unroll
    for (int dd = 0; dd < 4; ++dd) kb[dd] = Kt + SB_KSWZ(r32, (dd * 16 + hi * 8) * 2);
#pragma unroll
    for (int d0 = 0; d0 < 8; ++d0) { const char* a = kb[d0 & 3] + (d0 >> 2) * 128;
        const bf16x8 b0 = *reinterpret_cast<const bf16x8*>(a);
        const bf16x8 b1 = *reinterpret_cast<const bf16x8*>(a + 32 * 256);
        p0 = __builtin_amdgcn_mfma_f32_32x32x16_bf16(b0, qr[d0], p0, 0, 0, 0);
        p1 = __builtin_amdgcn_mfma_f32_32x32x16_bf16(b1, qr[d0], p1, 0, 0, 0); }
}
__device__ __forceinline__ void pv_tile(f32x16* o, int vb0, bf16x8 pa0, bf16x8 pa1, bf16x8 pa2, bf16x8 pa3) {
#define SB_TRRD(dst, off) asm volatile("ds_read_b64_tr_b16 %0, %1 offset:%2" : "=&v"(dst) : "v"(vb0), "i"(off) : "memory")
#define SB_PV_D0(d0) do { s16x4 l0, l1, l2, l3, h0, h1, h2, h3; constexpr int b_ = (d0) * 512; \
        SB_TRRD(l0, b_); SB_TRRD(h0, b_ + 2048); SB_TRRD(l1, b_ + 4096); SB_TRRD(h1, b_ + 6144); SB_TRRD(l2, b_ + 8192); SB_TRRD(h2, b_ + 10240); SB_TRRD(l3, b_ + 12288); SB_TRRD(h3, b_ + 14336); \
        asm volatile("s_waitcnt lgkmcnt(0)" ::: "memory"); SB_SBAR(); \
        o[d0] = __builtin_amdgcn_mfma_f32_32x32x16_bf16(pa0, (bf16x8){l0[0], l0[1], l0[2], l0[3], h0[0], h0[1], h0[2], h0[3]}, o[d0], 0, 0, 0); \
        o[d0] = __builtin_amdgcn_mfma_f32_32x32x16_bf16(pa1, (bf16x8){l1[0], l1[1], l1[2], l1[3], h1[0], h1[1], h1[2], h1[3]}, o[d0], 0, 0, 0); \
        o[d0] = __builtin_amdgcn_mfma_f32_32x32x16_bf16(pa2, (bf16x8){l2[0], l2[1], l2[2], l2[3], h2[0], h2[1], h2[2], h2[3]}, o[d0], 0, 0, 0); \
        o[d0] = __builtin_amdgcn_mfma_f32_32x32x16_bf16(pa3, (bf16x8){l3[0], l3[1], l3[2], l3[3], h3[0], h3[1], h3[2], h3[3]}, o[d0], 0, 0, 0); } while (0)
    SB_PV_D0(0); SB_PV_D0(1); SB_PV_D0(2); SB_PV_D0(3);
#undef SB_PV_D0
#undef SB_TRRD
}
__device__ __forceinline__ float swap_other(float x, int hi) {
    auto rr = __builtin_amdgcn_permlane32_swap(__float_as_uint(x), __float_as_uint(x), false, false);
    return __uint_as_float(hi ? rr[0] : rr[1]);
}
template <bool MASK> __device__ __forceinline__ void sb_weights(f32x16& p0, f32x16& p1, float& carry, float C2, float b2, int dq, int hi) {
    float T[8];
#pragma unroll
    for (int g = 0; g < 8; ++g) {
        float iv[4], be[4];
#pragma unroll
        for (int k = 0; k < 4; ++k) { const int r = (g & 3) * 4 + k; const float s = g < 4 ? p0[r] : p1[r];
            const float z2 = fminf(fmaf(s, C2, b2), 64.f), e = __builtin_amdgcn_exp2f(z2), i_ = __builtin_amdgcn_rcpf(1.f + e); float b_ = e * i_, ii = i_;
            if (MASK) { const int c = (r & 3) + 8 * (r >> 2) + (g < 4 ? 0 : 32); const bool vis = c < dq; ii = vis ? ii : 1.f; b_ = vis ? b_ : 0.f; }
            iv[k] = ii; be[k] = b_; }
        const float ex2 = iv[3], ex1 = iv[2] * iv[3], ex0 = iv[1] * ex1; T[g] = iv[0] * ex0;
        const float w0 = be[0] * ex0, w1 = be[1] * ex1, w2 = be[2] * ex2, w3 = be[3];
        if (g < 4) { p0[(g & 3) * 4 + 0] = w0; p0[(g & 3) * 4 + 1] = w1; p0[(g & 3) * 4 + 2] = w2; p0[(g & 3) * 4 + 3] = w3; }
        else { p1[(g & 3) * 4 + 0] = w0; p1[(g & 3) * 4 + 1] = w1; p1[(g & 3) * 4 + 2] = w2; p1[(g & 3) * 4 + 3] = w3; }
    }
    float suf = carry;
#pragma unroll
    for (int g = 7; g >= 0; --g) {
        const float To = swap_other(T[g], hi);
        const float E = hi ? suf : suf * To;
#pragma unroll
        for (int k = 0; k < 4; ++k) { if (g < 4) p0[(g & 3) * 4 + k] *= E; else p1[(g & 3) * 4 + k] *= E; }
        suf = suf * (T[g] * To);
    }
    carry = suf;
}
__device__ __forceinline__ void pack_p(const f32x16& p0, const f32x16& p1, bf16x8& pa0, bf16x8& pa1, bf16x8& pa2, bf16x8& pa3) {
#define SB_PK4(P, B_, OUT) do { unsigned a0 = cvt_pk_bf16(P[B_ + 0], P[B_ + 1]), a1 = cvt_pk_bf16(P[B_ + 2], P[B_ + 3]); \
        unsigned b0 = cvt_pk_bf16(P[B_ + 4], P[B_ + 5]), b1 = cvt_pk_bf16(P[B_ + 6], P[B_ + 7]); \
        auto r0 = __builtin_amdgcn_permlane32_swap(a0, b0, false, false); auto r1 = __builtin_amdgcn_permlane32_swap(a1, b1, false, false); \
        u32x4 w = {r0[0], r1[0], r0[1], r1[1]}; OUT = *reinterpret_cast<bf16x8*>(&w); } while (0)
    SB_PK4(p0, 0, pa0); SB_PK4(p0, 8, pa1); SB_PK4(p1, 0, pa2); SB_PK4(p1, 8, pa3);
#undef SB_PK4
}
__device__ __forceinline__ void attn_half(Ctx& F, int bh, int x, int half) {
    const int tid = F.tid, wid = F.wave, lane = F.lane, r32 = lane & 31, hi = lane >> 5, b = bh >> 3, h = bh & 7;
    const bf16* Qg = WSP(bf16, WS_QB) + (size_t)(b * SEQ + 256 * x) * LDQ + h * 128;
    const bf16* Kg = WSP(bf16, WS_KB) + (size_t)(b * SEQ) * LDQ + h * 128; const bf16* Vg = WSP(bf16, WS_VB) + (size_t)(b * SEQ) * LDQ + h * 128;
    const int NT = 4 * (x + 1), t_hi = half == 0 ? NT : NT / 2, t_lo = half == 0 ? NT / 2 : 0;
    const int qlo = 256 * x + 32 * wid, qpos = qlo + r32;
    char* V_lds = (char*)F.lds; char* K_lds = (char*)F.lds + 2 * SHM;
    bf16x8 qr[8];
#pragma unroll
    for (int d0 = 0; d0 < 8; ++d0) qr[d0] = *reinterpret_cast<const bf16x8*>(Qg + (size_t)(wid * 32 + r32) * LDQ + d0 * 16 + hi * 8);
    const int sr = tid >> 4, sc = (tid & 15) * 8, vst0 = v_st(sr, sc), vst1 = v_st(32 + sr, sc), kws = SB_KSWZ(sr, sc * 2);
    const int vb0 = (int)(uintptr_t)V_lds + v_rd_base(lane);
    bf16x8 st_k0, st_k1, st_v0, st_v1;
    const unsigned so0 = (unsigned)(sr * LDQ + sc) * 2u, so1 = so0 + 32u * LDQ * 2u;
#define SB_SLOAD(t) do { const char* kt_ = (const char*)Kg + (size_t)(t) * (64 * LDQ * 2); const char* vt_ = (const char*)Vg + (size_t)(t) * (64 * LDQ * 2); \
        st_k0 = *reinterpret_cast<const bf16x8*>(kt_ + so0); st_k1 = *reinterpret_cast<const bf16x8*>(kt_ + so1); st_v0 = *reinterpret_cast<const bf16x8*>(vt_ + so0); st_v1 = *reinterpret_cast<const bf16x8*>(vt_ + so1); } while (0)
#define SB_SWRITE(bf) do { *(bf16x8*)(K_lds + (bf) * SHM + kws) = st_k0; *(bf16x8*)(K_lds + (bf) * SHM + kws + 32 * 256) = st_k1; \
        *(bf16x8*)(V_lds + (bf) * SHM + vst0) = st_v0; *(bf16x8*)(V_lds + (bf) * SHM + vst1) = st_v1; } while (0)
    __syncthreads();
    SB_SLOAD(t_hi - 1); VM_WAIT(); SB_SWRITE(0);
    __syncthreads();
    const float C2 = QK_SCALE * 1.4426950408889634f, b2 = F.in(I_SBB)[h] * 1.4426950408889634f;
    float carry = 1.f; f32x16 o[4] = {};
    int buf = 0;
    for (int t = t_hi - 1; t >= t_lo; --t) {
        if (t > t_lo) SB_SLOAD(t - 1);
        const int kb = 64 * t;
        if (kb < qlo + 31) {
            f32x16 p0, p1; bf16x8 pa0, pa1, pa2, pa3;
            qkt(p0, p1, K_lds + buf * SHM, r32, hi, qr);
            if (kb + 63 >= qlo) sb_weights<true>(p0, p1, carry, C2, b2, qpos - kb - 4 * hi, hi); else sb_weights<false>(p0, p1, carry, C2, b2, 0, hi);
            pack_p(p0, p1, pa0, pa1, pa2, pa3);
            pv_tile(o, vb0 + buf * SHM, pa0, pa1, pa2, pa3);
        }
        if (t > t_lo) { VM_WAIT(); SB_SWRITE(buf ^ 1); }
        __syncthreads();
        buf ^= 1;
    }
#undef SB_SLOAD
#undef SB_SWRITE
    float* Op = WSP(float, WS_OP) + ((size_t)half * NPR + b * SEQ + 256 * x + wid * 32) * 1024 + h * 128;
    const unsigned lo_ = (unsigned)(4 * hi * 1024 + r32);
#pragma unroll
    for (int r = 0; r < 16; ++r) { float* Opr = Op + (size_t)((r & 3) + 8 * (r >> 2)) * 1024;
#pragma unroll
        for (int d0 = 0; d0 < 4; ++d0) Opr[lo_ + d0 * 32] = o[d0][r]; }
    if (half == 0 && hi == 0) WSP(float, WS_CL)[(size_t)(b * SEQ + qpos) * HA + h] = carry;
}
#undef SB_KSWZ
#undef SB_SBAR
}
namespace sba {
__device__ __forceinline__ void sb_weights32(f32x16& p0, float& carry, float C2, float b2, int hi) {
    float T[4];
#pragma unroll
    for (int g = 0; g < 4; ++g) {
        float iv[4], be[4];
#pragma unroll
        for (int k = 0; k < 4; ++k) { const float z2 = fminf(fmaf(p0[g * 4 + k], C2, b2), 64.f), e = __builtin_amdgcn_exp2f(z2), i_ = __builtin_amdgcn_rcpf(1.f + e); iv[k] = i_; be[k] = e * i_; }
        const float ex2 = iv[3], ex1 = iv[2] * iv[3], ex0 = iv[1] * ex1; T[g] = iv[0] * ex0;
        p0[g * 4 + 0] = be[0] * ex0; p0[g * 4 + 1] = be[1] * ex1; p0[g * 4 + 2] = be[2] * ex2; p0[g * 4 + 3] = be[3];
    }
    float suf = carry;
#pragma unroll
    for (int g = 3; g >= 0; --g) { const float To = swap_other(T[g], hi); const float E = hi ? suf : suf * To;
#pragma unroll
        for (int k = 0; k < 4; ++k) p0[g * 4 + k] *= E;
        suf = suf * (T[g] * To); }
    carry = suf;
}
__device__ __forceinline__ void attn_sample_unit(Ctx& F, int bh, int pg, char* wl  ) {
    const int lane = F.lane, r32 = lane & 31, hi = lane >> 5, b = bh >> 3, h = bh & 7;
    char* K_lds = wl; char* V_lds = wl + 8192;
    bf16x8 qr[8];
    { const bf16* Qg = WSP(bf16, WS_QB) + (size_t)(NPR + b * DSEQ + (r32 & 7)) * LDQ + h * 128;
#pragma unroll
      for (int d0 = 0; d0 < 8; ++d0) { bf16x8 v = *reinterpret_cast<const bf16x8*>(Qg + d0 * 16 + hi * 8); if (r32 >= 8) v = bf16x8{}; qr[d0] = v; } }
    const int kl = lane >> 5, c4 = (lane & 31) * 4;
    const unsigned goff = (unsigned)(kl * 1024 + c4) * 4u;
    const int vb0 = (int)(uintptr_t)V_lds + v_rd_base(lane);
    const float C2 = QK_SCALE * 1.4426950408889634f, b2 = F.in(I_SBB)[h] * 1.4426950408889634f;
    const int* pt = ((const int*)F.in(I_PT)) + b * NPAGES + pg * 4;
    f32x4 sa[8], sb[8];
#define SU_BASE(n) ({ const int i_ = (n) >> 2, k_ = (n) & 3, tt_ = 15 - i_; const int phys_ = pt[tt_ >> 2]; \
        (const char*)((k_ & 2) ? F.in(I_CV) : F.in(I_CK)) + (((size_t)phys_ * PAGESZ + (tt_ & 3) * 32 + (k_ & 1) * 16) * 1024 + h * 128) * 4; })
#define SU_LOAD(S, n) do { const char* bp_ = SU_BASE(n); _Pragma("unroll") for (int j = 0; j < 8; ++j) S[j] = __builtin_nontemporal_load((const GAS f32x4*)(bp_ + goff + (size_t)j * 8192)); } while (0)
#define SU_WRK(S, kh) do { _Pragma("unroll") for (int j = 0; j < 8; ++j) { const int key = (kh) * 16 + 2 * j + kl; u32x2 w; w.x = cvt_pk_bf16(S[j].x, S[j].y); w.y = cvt_pk_bf16(S[j].z, S[j].w); \
        *(u32x2*)(K_lds + (key * 256 + ((c4 * 2) ^ ((key & 7) << 4)))) = w; } } while (0)
#define SU_WRV(S, kh) do { _Pragma("unroll") for (int j = 0; j < 8; ++j) { const int key = (kh) * 16 + 2 * j + kl; u32x2 w; w.x = cvt_pk_bf16(S[j].x, S[j].y); w.y = cvt_pk_bf16(S[j].z, S[j].w); \
        *(u32x2*)(V_lds + v_st(key, c4)) = w; } } while (0)
    SU_LOAD(sa, 0); SU_LOAD(sb, 1);
    float carry = 1.f; f32x16 o[4] = {};
    for (int i = 0; i < 16; ++i) {
        asm volatile("s_waitcnt vmcnt(8)" ::: "memory"); SU_WRK(sa, 0); SU_LOAD(sa, 4 * i + 2);
        asm volatile("s_waitcnt vmcnt(8)" ::: "memory"); SU_WRK(sb, 1); SU_LOAD(sb, 4 * i + 3);
        asm volatile("s_waitcnt vmcnt(8)" ::: "memory"); SU_WRV(sa, 0); if (i < 15) SU_LOAD(sa, 4 * i + 4);
        if (i < 15) asm volatile("s_waitcnt vmcnt(8)" ::: "memory"); else asm volatile("s_waitcnt vmcnt(0)" ::: "memory");
        SU_WRV(sb, 1); if (i < 15) SU_LOAD(sb, 4 * i + 5);
        asm volatile("s_waitcnt lgkmcnt(0)" ::: "memory");
        f32x16 p0 = f32x16{};
        { const char* kb[4];
#pragma unroll
          for (int dd = 0; dd < 4; ++dd) kb[dd] = K_lds + (r32 * 256 + (((dd * 16 + hi * 8) * 2) ^ ((r32 & 7) << 4)));
#pragma unroll
          for (int d0 = 0; d0 < 8; ++d0) { const bf16x8 b0 = *reinterpret_cast<const bf16x8*>(kb[d0 & 3] + (d0 >> 2) * 128); p0 = __builtin_amdgcn_mfma_f32_32x32x16_bf16(b0, qr[d0], p0, 0, 0, 0); } }
        sb_weights32(p0, carry, C2, b2, hi);
        bf16x8 pa0, pa1;
        { unsigned a0 = cvt_pk_bf16(p0[0], p0[1]), a1 = cvt_pk_bf16(p0[2], p0[3]), b0 = cvt_pk_bf16(p0[4], p0[5]), b1 = cvt_pk_bf16(p0[6], p0[7]);
          auto r0 = __builtin_amdgcn_permlane32_swap(a0, b0, false, false); auto r1 = __builtin_amdgcn_permlane32_swap(a1, b1, false, false);
          u32x4 w = {r0[0], r1[0], r0[1], r1[1]}; pa0 = *reinterpret_cast<bf16x8*>(&w); }
        { unsigned a0 = cvt_pk_bf16(p0[8], p0[9]), a1 = cvt_pk_bf16(p0[10], p0[11]), b0 = cvt_pk_bf16(p0[12], p0[13]), b1 = cvt_pk_bf16(p0[14], p0[15]);
          auto r0 = __builtin_amdgcn_permlane32_swap(a0, b0, false, false); auto r1 = __builtin_amdgcn_permlane32_swap(a1, b1, false, false);
          u32x4 w = {r0[0], r1[0], r0[1], r1[1]}; pa1 = *reinterpret_cast<bf16x8*>(&w); }
#define SU_TRRD(dst, off) asm volatile("ds_read_b64_tr_b16 %0, %1 offset:%2" : "=&v"(dst) : "v"(vb0), "i"(off) : "memory")
#define SU_PV(d0) do { s16x4 l0, l1, h0, h1; constexpr int b_ = (d0) * 512; SU_TRRD(l0, b_); SU_TRRD(h0, b_ + 2048); SU_TRRD(l1, b_ + 4096); SU_TRRD(h1, b_ + 6144); \
        asm volatile("s_waitcnt lgkmcnt(0)" ::: "memory"); __builtin_amdgcn_sched_barrier(0); \
        o[d0] = __builtin_amdgcn_mfma_f32_32x32x16_bf16(pa0, (bf16x8){l0[0], l0[1], l0[2], l0[3], h0[0], h0[1], h0[2], h0[3]}, o[d0], 0, 0, 0); \
        o[d0] = __builtin_amdgcn_mfma_f32_32x32x16_bf16(pa1, (bf16x8){l1[0], l1[1], l1[2], l1[3], h1[0], h1[1], h1[2], h1[3]}, o[d0], 0, 0, 0); } while (0)
        SU_PV(0); SU_PV(1); SU_PV(2); SU_PV(3);
        asm volatile("s_waitcnt lgkmcnt(0)" ::: "memory");
    }
#undef SU_PV
#undef SU_TRRD
#undef SU_WRV
#undef SU_WRK
#undef SU_LOAD
#undef SU_BASE
    float* Sp = WSP(float, WS_SPART) + ((size_t)(bh * 32 + pg) * 8) * 128;
#pragma unroll
    for (int r = 0; r < 4; ++r)
#pragma unroll
        for (int d0 = 0; d0 < 4; ++d0) Sp[(size_t)(r + 4 * hi) * 128 + d0 * 32 + r32] = o[d0][r];
    if (hi == 0 && r32 < 8) WSP(float, WS_SCAR)[(size_t)(bh * 32 + pg) * 8 + r32] = carry;
}
}
__device__ __forceinline__ void sample_combine(Ctx& F) {
    const int gw = F.vcu * NWAVES + F.wave, NGW = F.G * NWAVES; bf16* OAB = WSP(bf16, WS_OAB);
    const float* SPt = WSP(float, WS_SPART); const float* SCr = WSP(float, WS_SCAR);
    const int gw2 = NGW >= 1024 ? (gw >= 512 ? gw - 512 : gw + NGW - 512) : gw;
    for (int task = gw2; task < DBAT * HA * DSEQ; task += NGW) { const int bh = task >> 3, i = task & 7, b = bh >> 3, h = bh & 7; const float bias = F.in(I_SBB)[h];
        f32x2 po[32]; float sc[32];
#pragma unroll
        for (int pg = 0; pg < 32; ++pg) { po[pg] = *(const GAS f32x2*)(SPt + ((size_t)(bh * 32 + pg) * 8 + i) * 128 + 2 * F.lane); sc[pg] = SCr[(size_t)(bh * 32 + pg) * 8 + i]; }
        f32x2 q; { const unsigned qw = *(const GAS unsigned*)(WSP(bf16, WS_QB) + (size_t)(NPR + b * DSEQ + i) * 1024 + h * 128 + 2 * F.lane); q.x = __uint_as_float(qw << 16); q.y = __uint_as_float(qw & 0xffff0000u); }
        float carry = 1.f, a0 = 0.f, a1 = 0.f;
        f32x2 kn[DSEQ - 1], vn[DSEQ - 1];
#pragma unroll
        for (int jj = 0; jj < DSEQ - 1; ++jj) { const int j = i - 1 - jj, jc = j > 0 ? j : 0; const size_t ko = (size_t)(b * DSEQ + jc) * 1024 + h * 128 + 2 * F.lane;
            kn[jj] = *(const GAS f32x2*)(F.outp() + O_KS + ko); vn[jj] = *(const GAS f32x2*)(F.outp() + O_VS + ko); }
#pragma unroll
        for (int jj = 0; jj < DSEQ - 1; ++jj) { const bool valid = i - 1 - jj >= 0;
            const float z = wave_sum(q.x * kn[jj].x + q.y * kn[jj].y) * QK_SCALE + bias, e = valid ? __expf(fminf(z, 40.f)) : 0.f, om = 1.f / (1.f + e), w = e * om * carry;
            a0 += w * vn[jj].x; a1 += w * vn[jj].y; carry *= om; }
#pragma unroll
        for (int pg = 31; pg >= 0; --pg) { a0 += carry * po[pg].x; a1 += carry * po[pg].y; carry *= sc[pg]; }
        *(GAS unsigned*)(OAB + (size_t)(NPR + b * DSEQ + i) * DM + h * 128 + 2 * F.lane) = cvt_pk_bf16(a0, a1);
    }
}
__device__ __forceinline__ void phase_attn_prompt(Ctx& F) {
    for (int it2 = 2 * F.vcu; it2 < 2 * NBATCH * HA * 16; it2 += (it2 & 1) ? 2 * F.G - 1 : 1) { const int item = it2 >> 1, half = it2 & 1, bh = item >> 4, x = item & 15;
        sba::attn_half(F, bh, half ? 15 - x : x, half); }
    __syncthreads();
}
__device__ __forceinline__ void dots16(float& sig, float& rho, float kkv, float wrv, const float (&s)[16]) {
    asm("s_nop 1\n\t"
        "v_fmac_f32_dpp %0, %2, %4 row_newbcast:0 row_mask:0xf bank_mask:0xf\n\t"
        "v_fmac_f32_dpp %1, %3, %4 row_newbcast:0 row_mask:0xf bank_mask:0xf\n\t"
        "v_fmac_f32_dpp %0, %2, %5 row_newbcast:1 row_mask:0xf bank_mask:0xf\n\t"
        "v_fmac_f32_dpp %1, %3, %5 row_newbcast:1 row_mask:0xf bank_mask:0xf\n\t"
        "v_fmac_f32_dpp %0, %2, %6 row_newbcast:2 row_mask:0xf bank_mask:0xf\n\t"
        "v_fmac_f32_dpp %1, %3, %6 row_newbcast:2 row_mask:0xf bank_mask:0xf\n\t"
        "v_fmac_f32_dpp %0, %2, %7 row_newbcast:3 row_mask:0xf bank_mask:0xf\n\t"
        "v_fmac_f32_dpp %1, %3, %7 row_newbcast:3 row_mask:0xf bank_mask:0xf\n\t"
        "v_fmac_f32_dpp %0, %2, %8 row_newbcast:4 row_mask:0xf bank_mask:0xf\n\t"
        "v_fmac_f32_dpp %1, %3, %8 row_newbcast:4 row_mask:0xf bank_mask:0xf\n\t"
        "v_fmac_f32_dpp %0, %2, %9 row_newbcast:5 row_mask:0xf bank_mask:0xf\n\t"
        "v_fmac_f32_dpp %1, %3, %9 row_newbcast:5 row_mask:0xf bank_mask:0xf\n\t"
        "v_fmac_f32_dpp %0, %2, %10 row_newbcast:6 row_mask:0xf bank_mask:0xf\n\t"
        "v_fmac_f32_dpp %1, %3, %10 row_newbcast:6 row_mask:0xf bank_mask:0xf\n\t"
        "v_fmac_f32_dpp %0, %2, %11 row_newbcast:7 row_mask:0xf bank_mask:0xf\n\t"
        "v_fmac_f32_dpp %1, %3, %11 row_newbcast:7 row_mask:0xf bank_mask:0xf\n\t"
        "v_fmac_f32_dpp %0, %2, %12 row_newbcast:8 row_mask:0xf bank_mask:0xf\n\t"
        "v_fmac_f32_dpp %1, %3, %12 row_newbcast:8 row_mask:0xf bank_mask:0xf\n\t"
        "v_fmac_f32_dpp %0, %2, %13 row_newbcast:9 row_mask:0xf bank_mask:0xf\n\t"
        "v_fmac_f32_dpp %1, %3, %13 row_newbcast:9 row_mask:0xf bank_mask:0xf\n\t"
        "v_fmac_f32_dpp %0, %2, %14 row_newbcast:10 row_mask:0xf bank_mask:0xf\n\t"
        "v_fmac_f32_dpp %1, %3, %14 row_newbcast:10 row_mask:0xf bank_mask:0xf\n\t"
        "v_fmac_f32_dpp %0, %2, %15 row_newbcast:11 row_mask:0xf bank_mask:0xf\n\t"
        "v_fmac_f32_dpp %1, %3, %15 row_newbcast:11 row_mask:0xf bank_mask:0xf\n\t"
        "v_fmac_f32_dpp %0, %2, %16 row_newbcast:12 row_mask:0xf bank_mask:0xf\n\t"
        "v_fmac_f32_dpp %1, %3, %16 row_newbcast:12 row_mask:0xf bank_mask:0xf\n\t"
        "v_fmac_f32_dpp %0, %2, %17 row_newbcast:13 row_mask:0xf bank_mask:0xf\n\t"
        "v_fmac_f32_dpp %1, %3, %17 row_newbcast:13 row_mask:0xf bank_mask:0xf\n\t"
        "v_fmac_f32_dpp %0, %2, %18 row_newbcast:14 row_mask:0xf bank_mask:0xf\n\t"
        "v_fmac_f32_dpp %1, %3, %18 row_newbcast:14 row_mask:0xf bank_mask:0xf\n\t"
        "v_fmac_f32_dpp %0, %2, %19 row_newbcast:15 row_mask:0xf bank_mask:0xf\n\t"
        "v_fmac_f32_dpp %1, %3, %19 row_newbcast:15 row_mask:0xf bank_mask:0xf\n\t"
        "s_nop 1"
        : "+v"(sig), "+v"(rho) : "v"(kkv), "v"(wrv), "v"(s[0]), "v"(s[1]), "v"(s[2]), "v"(s[3]), "v"(s[4]), "v"(s[5]), "v"(s[6]), "v"(s[7]), "v"(s[8]), "v"(s[9]), "v"(s[10]), "v"(s[11]), "v"(s[12]), "v"(s[13]), "v"(s[14]), "v"(s[15]));
}
__device__ __forceinline__ void dot16(float& acc, float zv, const float (&s)[16]) {
    asm("s_nop 1\n\t"
        "v_fmac_f32_dpp %0, %1, %2 row_newbcast:0 row_mask:0xf bank_mask:0xf\n\t"
        "v_fmac_f32_dpp %0, %1, %3 row_newbcast:1 row_mask:0xf bank_mask:0xf\n\t"
        "v_fmac_f32_dpp %0, %1, %4 row_newbcast:2 row_mask:0xf bank_mask:0xf\n\t"
        "v_fmac_f32_dpp %0, %1, %5 row_newbcast:3 row_mask:0xf bank_mask:0xf\n\t"
        "v_fmac_f32_dpp %0, %1, %6 row_newbcast:4 row_mask:0xf bank_mask:0xf\n\t"
        "v_fmac_f32_dpp %0, %1, %7 row_newbcast:5 row_mask:0xf bank_mask:0xf\n\t"
        "v_fmac_f32_dpp %0, %1, %8 row_newbcast:6 row_mask:0xf bank_mask:0xf\n\t"
        "v_fmac_f32_dpp %0, %1, %9 row_newbcast:7 row_mask:0xf bank_mask:0xf\n\t"
        "v_fmac_f32_dpp %0, %1, %10 row_newbcast:8 row_mask:0xf bank_mask:0xf\n\t"
        "v_fmac_f32_dpp %0, %1, %11 row_newbcast:9 row_mask:0xf bank_mask:0xf\n\t"
        "v_fmac_f32_dpp %0, %1, %12 row_newbcast:10 row_mask:0xf bank_mask:0xf\n\t"
        "v_fmac_f32_dpp %0, %1, %13 row_newbcast:11 row_mask:0xf bank_mask:0xf\n\t"
        "v_fmac_f32_dpp %0, %1, %14 row_newbcast:12 row_mask:0xf bank_mask:0xf\n\t"
        "v_fmac_f32_dpp %0, %1, %15 row_newbcast:13 row_mask:0xf bank_mask:0xf\n\t"
        "v_fmac_f32_dpp %0, %1, %16 row_newbcast:14 row_mask:0xf bank_mask:0xf\n\t"
        "v_fmac_f32_dpp %0, %1, %17 row_newbcast:15 row_mask:0xf bank_mask:0xf\n\t"
        "s_nop 1"
        : "+v"(acc) : "v"(zv), "v"(s[0]), "v"(s[1]), "v"(s[2]), "v"(s[3]), "v"(s[4]), "v"(s[5]), "v"(s[6]), "v"(s[7]), "v"(s[8]), "v"(s[9]), "v"(s[10]), "v"(s[11]), "v"(s[12]), "v"(s[13]), "v"(s[14]), "v"(s[15]));
}
__device__ __forceinline__ void upd16_v(float (&s)[16], float wv, float kv, float bv, float vv, float ns) {
    asm("s_nop 1\n\t"
        "v_mul_f32_dpp %0, %16, %0 row_newbcast:0 row_mask:0xf bank_mask:0xf\n\t"
        "v_mul_f32_dpp %1, %16, %1 row_newbcast:1 row_mask:0xf bank_mask:0xf\n\t"
        "v_mul_f32_dpp %2, %16, %2 row_newbcast:2 row_mask:0xf bank_mask:0xf\n\t"
        "v_mul_f32_dpp %3, %16, %3 row_newbcast:3 row_mask:0xf bank_mask:0xf\n\t"
        "v_mul_f32_dpp %4, %16, %4 row_newbcast:4 row_mask:0xf bank_mask:0xf\n\t"
        "v_mul_f32_dpp %5, %16, %5 row_newbcast:5 row_mask:0xf bank_mask:0xf\n\t"
        "v_mul_f32_dpp %6, %16, %6 row_newbcast:6 row_mask:0xf bank_mask:0xf\n\t"
        "v_mul_f32_dpp %7, %16, %7 row_newbcast:7 row_mask:0xf bank_mask:0xf\n\t"
        "v_mul_f32_dpp %8, %16, %8 row_newbcast:8 row_mask:0xf bank_mask:0xf\n\t"
        "v_mul_f32_dpp %9, %16, %9 row_newbcast:9 row_mask:0xf bank_mask:0xf\n\t"
        "v_mul_f32_dpp %10, %16, %10 row_newbcast:10 row_mask:0xf bank_mask:0xf\n\t"
        "v_mul_f32_dpp %11, %16, %11 row_newbcast:11 row_mask:0xf bank_mask:0xf\n\t"
        "v_mul_f32_dpp %12, %16, %12 row_newbcast:12 row_mask:0xf bank_mask:0xf\n\t"
        "v_mul_f32_dpp %13, %16, %13 row_newbcast:13 row_mask:0xf bank_mask:0xf\n\t"
        "v_mul_f32_dpp %14, %16, %14 row_newbcast:14 row_mask:0xf bank_mask:0xf\n\t"
        "v_mul_f32_dpp %15, %16, %15 row_newbcast:15 row_mask:0xf bank_mask:0xf\n\t"
        "v_fmac_f32_dpp %0, %17, %19 row_newbcast:0 row_mask:0xf bank_mask:0xf\n\t"
        "v_fmac_f32_dpp %1, %17, %19 row_newbcast:1 row_mask:0xf bank_mask:0xf\n\t"
        "v_fmac_f32_dpp %2, %17, %19 row_newbcast:2 row_mask:0xf bank_mask:0xf\n\t"
        "v_fmac_f32_dpp %3, %17, %19 row_newbcast:3 row_mask:0xf bank_mask:0xf\n\t"
        "v_fmac_f32_dpp %4, %17, %19 row_newbcast:4 row_mask:0xf bank_mask:0xf\n\t"
        "v_fmac_f32_dpp %5, %17, %19 row_newbcast:5 row_mask:0xf bank_mask:0xf\n\t"
        "v_fmac_f32_dpp %6, %17, %19 row_newbcast:6 row_mask:0xf bank_mask:0xf\n\t"
        "v_fmac_f32_dpp %7, %17, %19 row_newbcast:7 row_mask:0xf bank_mask:0xf\n\t"
        "v_fmac_f32_dpp %8, %17, %19 row_newbcast:8 row_mask:0xf bank_mask:0xf\n\t"
        "v_fmac_f32_dpp %9, %17, %19 row_newbcast:9 row_mask:0xf bank_mask:0xf\n\t"
        "v_fmac_f32_dpp %10, %17, %19 row_newbcast:10 row_mask:0xf bank_mask:0xf\n\t"
        "v_fmac_f32_dpp %11, %17, %19 row_newbcast:11 row_mask:0xf bank_mask:0xf\n\t"
        "v_fmac_f32_dpp %12, %17, %19 row_newbcast:12 row_mask:0xf bank_mask:0xf\n\t"
        "v_fmac_f32_dpp %13, %17, %19 row_newbcast:13 row_mask:0xf bank_mask:0xf\n\t"
        "v_fmac_f32_dpp %14, %17, %19 row_newbcast:14 row_mask:0xf bank_mask:0xf\n\t"
        "v_fmac_f32_dpp %15, %17, %19 row_newbcast:15 row_mask:0xf bank_mask:0xf\n\t"
        "v_fmac_f32_dpp %0, %18, %20 row_newbcast:0 row_mask:0xf bank_mask:0xf\n\t"
        "v_fmac_f32_dpp %1, %18, %20 row_newbcast:1 row_mask:0xf bank_mask:0xf\n\t"
        "v_fmac_f32_dpp %2, %18, %20 row_newbcast:2 row_mask:0xf bank_mask:0xf\n\t"
        "v_fmac_f32_dpp %3, %18, %20 row_newbcast:3 row_mask:0xf bank_mask:0xf\n\t"
        "v_fmac_f32_dpp %4, %18, %20 row_newbcast:4 row_mask:0xf bank_mask:0xf\n\t"
        "v_fmac_f32_dpp %5, %18, %20 row_newbcast:5 row_mask:0xf bank_mask:0xf\n\t"
        "v_fmac_f32_dpp %6, %18, %20 row_newbcast:6 row_mask:0xf bank_mask:0xf\n\t"
        "v_fmac_f32_dpp %7, %18, %20 row_newbcast:7 row_mask:0xf bank_mask:0xf\n\t"
        "v_fmac_f32_dpp %8, %18, %20 row_newbcast:8 row_mask:0xf bank_mask:0xf\n\t"
        "v_fmac_f32_dpp %9, %18, %20 row_newbcast:9 row_mask:0xf bank_mask:0xf\n\t"
        "v_fmac_f32_dpp %10, %18, %20 row_newbcast:10 row_mask:0xf bank_mask:0xf\n\t"
        "v_fmac_f32_dpp %11, %18, %20 row_newbcast:11 row_mask:0xf bank_mask:0xf\n\t"
        "v_fmac_f32_dpp %12, %18, %20 row_newbcast:12 row_mask:0xf bank_mask:0xf\n\t"
        "v_fmac_f32_dpp %13, %18, %20 row_newbcast:13 row_mask:0xf bank_mask:0xf\n\t"
        "v_fmac_f32_dpp %14, %18, %20 row_newbcast:14 row_mask:0xf bank_mask:0xf\n\t"
        "v_fmac_f32_dpp %15, %18, %20 row_newbcast:15 row_mask:0xf bank_mask:0xf\n\t"
        "s_nop 1"
        : "+v"(s[0]), "+v"(s[1]), "+v"(s[2]), "+v"(s[3]), "+v"(s[4]), "+v"(s[5]), "+v"(s[6]), "+v"(s[7]), "+v"(s[8]), "+v"(s[9]), "+v"(s[10]), "+v"(s[11]), "+v"(s[12]), "+v"(s[13]), "+v"(s[14]), "+v"(s[15]) : "v"(wv), "v"(kv), "v"(bv), "v"(vv), "v"(ns));
}
__device__ __forceinline__ void upd16_nov(float (&s)[16], float wv, float kv, float bv, float vv, float ns) {
    asm("s_nop 1\n\t"
        "v_mul_f32_dpp %0, %16, %0 row_newbcast:0 row_mask:0xf bank_mask:0xf\n\t"
        "v_mul_f32_dpp %1, %16, %1 row_newbcast:1 row_mask:0xf bank_mask:0xf\n\t"
        "v_mul_f32_dpp %2, %16, %2 row_newbcast:2 row_mask:0xf bank_mask:0xf\n\t"
        "v_mul_f32_dpp %3, %16, %3 row_newbcast:3 row_mask:0xf bank_mask:0xf\n\t"
        "v_mul_f32_dpp %4, %16, %4 row_newbcast:4 row_mask:0xf bank_mask:0xf\n\t"
        "v_mul_f32_dpp %5, %16, %5 row_newbcast:5 row_mask:0xf bank_mask:0xf\n\t"
        "v_mul_f32_dpp %6, %16, %6 row_newbcast:6 row_mask:0xf bank_mask:0xf\n\t"
        "v_mul_f32_dpp %7, %16, %7 row_newbcast:7 row_mask:0xf bank_mask:0xf\n\t"
        "v_mul_f32_dpp %8, %16, %8 row_newbcast:8 row_mask:0xf bank_mask:0xf\n\t"
        "v_mul_f32_dpp %9, %16, %9 row_newbcast:9 row_mask:0xf bank_mask:0xf\n\t"
        "v_mul_f32_dpp %10, %16, %10 row_newbcast:10 row_mask:0xf bank_mask:0xf\n\t"
        "v_mul_f32_dpp %11, %16, %11 row_newbcast:11 row_mask:0xf bank_mask:0xf\n\t"
        "v_mul_f32_dpp %12, %16, %12 row_newbcast:12 row_mask:0xf bank_mask:0xf\n\t"
        "v_mul_f32_dpp %13, %16, %13 row_newbcast:13 row_mask:0xf bank_mask:0xf\n\t"
        "v_mul_f32_dpp %14, %16, %14 row_newbcast:14 row_mask:0xf bank_mask:0xf\n\t"
        "v_mul_f32_dpp %15, %16, %15 row_newbcast:15 row_mask:0xf bank_mask:0xf\n\t"
        "v_fmac_f32_dpp %0, %18, %20 row_newbcast:0 row_mask:0xf bank_mask:0xf\n\t"
        "v_fmac_f32_dpp %1, %18, %20 row_newbcast:1 row_mask:0xf bank_mask:0xf\n\t"
        "v_fmac_f32_dpp %2, %18, %20 row_newbcast:2 row_mask:0xf bank_mask:0xf\n\t"
        "v_fmac_f32_dpp %3, %18, %20 row_newbcast:3 row_mask:0xf bank_mask:0xf\n\t"
        "v_fmac_f32_dpp %4, %18, %20 row_newbcast:4 row_mask:0xf bank_mask:0xf\n\t"
        "v_fmac_f32_dpp %5, %18, %20 row_newbcast:5 row_mask:0xf bank_mask:0xf\n\t"
        "v_fmac_f32_dpp %6, %18, %20 row_newbcast:6 row_mask:0xf bank_mask:0xf\n\t"
        "v_fmac_f32_dpp %7, %18, %20 row_newbcast:7 row_mask:0xf bank_mask:0xf\n\t"
        "v_fmac_f32_dpp %8, %18, %20 row_newbcast:8 row_mask:0xf bank_mask:0xf\n\t"
        "v_fmac_f32_dpp %9, %18, %20 row_newbcast:9 row_mask:0xf bank_mask:0xf\n\t"
        "v_fmac_f32_dpp %10, %18, %20 row_newbcast:10 row_mask:0xf bank_mask:0xf\n\t"
        "v_fmac_f32_dpp %11, %18, %20 row_newbcast:11 row_mask:0xf bank_mask:0xf\n\t"
        "v_fmac_f32_dpp %12, %18, %20 row_newbcast:12 row_mask:0xf bank_mask:0xf\n\t"
        "v_fmac_f32_dpp %13, %18, %20 row_newbcast:13 row_mask:0xf bank_mask:0xf\n\t"
        "v_fmac_f32_dpp %14, %18, %20 row_newbcast:14 row_mask:0xf bank_mask:0xf\n\t"
        "v_fmac_f32_dpp %15, %18, %20 row_newbcast:15 row_mask:0xf bank_mask:0xf\n\t"
        "s_nop 1"
        : "+v"(s[0]), "+v"(s[1]), "+v"(s[2]), "+v"(s[3]), "+v"(s[4]), "+v"(s[5]), "+v"(s[6]), "+v"(s[7]), "+v"(s[8]), "+v"(s[9]), "+v"(s[10]), "+v"(s[11]), "+v"(s[12]), "+v"(s[13]), "+v"(s[14]), "+v"(s[15]) : "v"(wv), "v"(kv), "v"(bv), "v"(vv), "v"(ns));
}
__device__ __forceinline__ float xrow16_sum(float x) {
    auto s = __builtin_amdgcn_permlane16_swap(__float_as_uint(x), __float_as_uint(x), false, false);
    x = __uint_as_float(s[0]) + __uint_as_float(s[1]);
    auto t = __builtin_amdgcn_permlane32_swap(__float_as_uint(x), __float_as_uint(x), false, false);
    return __uint_as_float(t[0]) + __uint_as_float(t[1]);
}
struct StepIn { float wv, kkv, bv, kv, wrv, vv, beta, kappa; };
template <bool PROW> __device__ __forceinline__ void scan_load(StepIn& x, const float* RWV, const float* SCL, int r, int h, int lane, int row) {
    const float* base = RWV + ((size_t)r * HB + h) * 512; const float* sc = SCL + ((size_t)r * HB + h) * 4;
    x.wv = base[lane]; x.kkv = base[64 + lane]; x.bv = base[128 + lane]; x.wrv = base[384 + lane]; x.beta = sc[0];
    if (!PROW) { x.kv = base[192 + lane]; x.vv = base[320 + row]; x.kappa = sc[1]; } else { x.kv = 0.f; x.vv = 0.f; x.kappa = 0.f; }
}
template <bool PROW, bool SAMP> __device__ __forceinline__ void scan_wave(Ctx& F, int bh, int c, int g) {
    const int lane = F.lane, q = lane >> 4, m = lane & 15, row = 16 * g + m, h = bh & 15, b = bh >> 4;
    constexpr int L = SAMP ? DSEQ : 64; const int r0 = SAMP ? NPR + b * DSEQ : b * SEQ + c * 64; const int ch = bh * 64 + c;
    const float* RWV = WSP(float, WS_RWV); const float* SCL = WSP(float, WS_SCL); float* Y = WSP(float, WS_Y); float* Z = WSP(float, WS_Z); float* PU = WSP(float, WS_PU);
    float s[16];
    if (SAMP) { const float* st = F.in(I_SWKV) + ((size_t)bh * 64 + row) * 64 + 16 * q;
#pragma unroll
        for (int i = 0; i < 16; i += 4) { const f32x4 v = *(const GAS f32x4*)(st + i); s[i] = v.x; s[i + 1] = v.y; s[i + 2] = v.z; s[i + 3] = v.w; } }
    else {
#pragma unroll
        for (int i = 0; i < 16; ++i) s[i] = (PROW && (16 * q + i) == row) ? 1.f : 0.f; }
    StepIn buf[4];
#pragma unroll
    for (int u = 0; u < 4; ++u) scan_load<PROW>(buf[u], RWV, SCL, r0 + u, h, lane, row);
    for (int t = 0; t < L; t += 4) {
#pragma unroll
        for (int u = 0; u < 4; ++u) {
            const StepIn x = buf[u];
            if (t + u + 4 < L) scan_load<PROW>(buf[u], RWV, SCL, r0 + t + u + 4, h, lane, row);
            float sig = 0.f, rho = 0.f;
            dots16(sig, rho, x.kkv, x.wrv, s);
            sig = xrow16_sum(sig); rho = xrow16_sum(rho);
            const float ns = -sig;
            float y = rho + ns * x.beta; if (!PROW) y += x.vv * x.kappa;
            if (q == 0) { if (PROW) Z[((size_t)ch * 64 + t + u) * 64 + row] = y; else Y[(size_t)(r0 + t + u) * 1024 + h * 64 + row] = y; }
            if (PROW) upd16_nov(s, x.wv, x.kv, x.bv, x.vv, ns); else upd16_v(s, x.wv, x.kv, x.bv, x.vv, ns);
        }
    }
    float* dst = SAMP ? F.outp() + O_WKVS + ((size_t)bh * 64 + row) * 64 + 16 * q : PU + (((size_t)ch * 2 + (PROW ? 1 : 0)) * 64 + row) * 64 + 16 * q;
#pragma unroll
    for (int i = 0; i < 16; i += 4) *(GAS f32x4*)(dst + i) = (f32x4){s[i], s[i + 1], s[i + 2], s[i + 3]};
}
__device__ __forceinline__ void dots2_h0(float& sgu, float& rhu, float& sgp, float& rhp, float kkv, float wrv, const float (&su)[16], const float (&sp)[16]) {
    asm("s_nop 1\n\t"
        "v_fmac_f32_dpp %0, %4, %6 row_newbcast:0 row_mask:0xf bank_mask:0xf\n\t"
        "v_fmac_f32_dpp %1, %5, %6 row_newbcast:0 row_mask:0xf bank_mask:0xf\n\t"
        "v_fmac_f32_dpp %2, %4, %14 row_newbcast:0 row_mask:0xf bank_mask:0xf\n\t"
        "v_fmac_f32_dpp %3, %5, %14 row_newbcast:0 row_mask:0xf bank_mask:0xf\n\t"
        "v_fmac_f32_dpp %0, %4, %7 row_newbcast:1 row_mask:0xf bank_mask:0xf\n\t"
        "v_fmac_f32_dpp %1, %5, %7 row_newbcast:1 row_mask:0xf bank_mask:0xf\n\t"
        "v_fmac_f32_dpp %2, %4, %15 row_newbcast:1 row_mask:0xf bank_mask:0xf\n\t"
        "v_fmac_f32_dpp %3, %5, %15 row_newbcast:1 row_mask:0xf bank_mask:0xf\n\t"
        "v_fmac_f32_dpp %0, %4, %8 row_newbcast:2 row_mask:0xf bank_mask:0xf\n\t"
        "v_fmac_f32_dpp %1, %5, %8 row_newbcast:2 row_mask:0xf bank_mask:0xf\n\t"
        "v_fmac_f32_dpp %2, %4, %16 row_newbcast:2 row_mask:0xf bank_mask:0xf\n\t"
        "v_fmac_f32_dpp %3, %5, %16 row_newbcast:2 row_mask:0xf bank_mask:0xf\n\t"
        "v_fmac_f32_dpp %0, %4, %9 row_newbcast:3 row_mask:0xf bank_mask:0xf\n\t"
        "v_fmac_f32_dpp %1, %5, %9 row_newbcast:3 row_mask:0xf bank_mask:0xf\n\t"
        "v_fmac_f32_dpp %2, %4, %17 row_newbcast:3 row_mask:0xf bank_mask:0xf\n\t"
        "v_fmac_f32_dpp %3, %5, %17 row_newbcast:3 row_mask:0xf bank_mask:0xf\n\t"
        "v_fmac_f32_dpp %0, %4, %10 row_newbcast:4 row_mask:0xf bank_mask:0xf\n\t"
        "v_fmac_f32_dpp %1, %5, %10 row_newbcast:4 row_mask:0xf bank_mask:0xf\n\t"
        "v_fmac_f32_dpp %2, %4, %18 row_newbcast:4 row_mask:0xf bank_mask:0xf\n\t"
        "v_fmac_f32_dpp %3, %5, %18 row_newbcast:4 row_mask:0xf bank_mask:0xf\n\t"
        "v_fmac_f32_dpp %0, %4, %11 row_newbcast:5 row_mask:0xf bank_mask:0xf\n\t"
        "v_fmac_f32_dpp %1, %5, %11 row_newbcast:5 row_mask:0xf bank_mask:0xf\n\t"
        "v_fmac_f32_dpp %2, %4, %19 row_newbcast:5 row_mask:0xf bank_mask:0xf\n\t"
        "v_fmac_f32_dpp %3, %5, %19 row_newbcast:5 row_mask:0xf bank_mask:0xf\n\t"
        "v_fmac_f32_dpp %0, %4, %12 row_newbcast:6 row_mask:0xf bank_mask:0xf\n\t"
        "v_fmac_f32_dpp %1, %5, %12 row_newbcast:6 row_mask:0xf bank_mask:0xf\n\t"
        "v_fmac_f32_dpp %2, %4, %20 row_newbcast:6 row_mask:0xf bank_mask:0xf\n\t"
        "v_fmac_f32_dpp %3, %5, %20 row_newbcast:6 row_mask:0xf bank_mask:0xf\n\t"
        "v_fmac_f32_dpp %0, %4, %13 row_newbcast:7 row_mask:0xf bank_mask:0xf\n\t"
        "v_fmac_f32_dpp %1, %5, %13 row_newbcast:7 row_mask:0xf bank_mask:0xf\n\t"
        "v_fmac_f32_dpp %2, %4, %21 row_newbcast:7 row_mask:0xf bank_mask:0xf\n\t"
        "v_fmac_f32_dpp %3, %5, %21 row_newbcast:7 row_mask:0xf bank_mask:0xf\n\t"
        "s_nop 1"
        : "+v"(sgu), "+v"(rhu), "+v"(sgp), "+v"(rhp) : "v"(kkv), "v"(wrv), "v"(su[0]), "v"(su[1]), "v"(su[2]), "v"(su[3]), "v"(su[4]), "v"(su[5]), "v"(su[6]), "v"(su[7]), "v"(sp[0]), "v"(sp[1]), "v"(sp[2]), "v"(sp[3]), "v"(sp[4]), "v"(sp[5]), "v"(sp[6]), "v"(sp[7]));
}
__device__ __forceinline__ void dots2_h1(float& sgu, float& rhu, float& sgp, float& rhp, float kkv, float wrv, const float (&su)[16], const float (&sp)[16]) {
    asm("s_nop 1\n\t"
        "v_fmac_f32_dpp %0, %4, %6 row_newbcast:8 row_mask:0xf bank_mask:0xf\n\t"
        "v_fmac_f32_dpp %1, %5, %6 row_newbcast:8 row_mask:0xf bank_mask:0xf\n\t"
        "v_fmac_f32_dpp %2, %4, %14 row_newbcast:8 row_mask:0xf bank_mask:0xf\n\t"
        "v_fmac_f32_dpp %3, %5, %14 row_newbcast:8 row_mask:0xf bank_mask:0xf\n\t"
        "v_fmac_f32_dpp %0, %4, %7 row_newbcast:9 row_mask:0xf bank_mask:0xf\n\t"
        "v_fmac_f32_dpp %1, %5, %7 row_newbcast:9 row_mask:0xf bank_mask:0xf\n\t"
        "v_fmac_f32_dpp %2, %4, %15 row_newbcast:9 row_mask:0xf bank_mask:0xf\n\t"
        "v_fmac_f32_dpp %3, %5, %15 row_newbcast:9 row_mask:0xf bank_mask:0xf\n\t"
        "v_fmac_f32_dpp %0, %4, %8 row_newbcast:10 row_mask:0xf bank_mask:0xf\n\t"
        "v_fmac_f32_dpp %1, %5, %8 row_newbcast:10 row_mask:0xf bank_mask:0xf\n\t"
        "v_fmac_f32_dpp %2, %4, %16 row_newbcast:10 row_mask:0xf bank_mask:0xf\n\t"
        "v_fmac_f32_dpp %3, %5, %16 row_newbcast:10 row_mask:0xf bank_mask:0xf\n\t"
        "v_fmac_f32_dpp %0, %4, %9 row_newbcast:11 row_mask:0xf bank_mask:0xf\n\t"
        "v_fmac_f32_dpp %1, %5, %9 row_newbcast:11 row_mask:0xf bank_mask:0xf\n\t"
        "v_fmac_f32_dpp %2, %4, %17 row_newbcast:11 row_mask:0xf bank_mask:0xf\n\t"
        "v_fmac_f32_dpp %3, %5, %17 row_newbcast:11 row_mask:0xf bank_mask:0xf\n\t"
        "v_fmac_f32_dpp %0, %4, %10 row_newbcast:12 row_mask:0xf bank_mask:0xf\n\t"
        "v_fmac_f32_dpp %1, %5, %10 row_newbcast:12 row_mask:0xf bank_mask:0xf\n\t"
        "v_fmac_f32_dpp %2, %4, %18 row_newbcast:12 row_mask:0xf bank_mask:0xf\n\t"
        "v_fmac_f32_dpp %3, %5, %18 row_newbcast:12 row_mask:0xf bank_mask:0xf\n\t"
        "v_fmac_f32_dpp %0, %4, %11 row_newbcast:13 row_mask:0xf bank_mask:0xf\n\t"
        "v_fmac_f32_dpp %1, %5, %11 row_newbcast:13 row_mask:0xf bank_mask:0xf\n\t"
        "v_fmac_f32_dpp %2, %4, %19 row_newbcast:13 row_mask:0xf bank_mask:0xf\n\t"
        "v_fmac_f32_dpp %3, %5, %19 row_newbcast:13 row_mask:0xf bank_mask:0xf\n\t"
        "v_fmac_f32_dpp %0, %4, %12 row_newbcast:14 row_mask:0xf bank_mask:0xf\n\t"
        "v_fmac_f32_dpp %1, %5, %12 row_newbcast:14 row_mask:0xf bank_mask:0xf\n\t"
        "v_fmac_f32_dpp %2, %4, %20 row_newbcast:14 row_mask:0xf bank_mask:0xf\n\t"
        "v_fmac_f32_dpp %3, %5, %20 row_newbcast:14 row_mask:0xf bank_mask:0xf\n\t"
        "v_fmac_f32_dpp %0, %4, %13 row_newbcast:15 row_mask:0xf bank_mask:0xf\n\t"
        "v_fmac_f32_dpp %1, %5, %13 row_newbcast:15 row_mask:0xf bank_mask:0xf\n\t"
        "v_fmac_f32_dpp %2, %4, %21 row_newbcast:15 row_mask:0xf bank_mask:0xf\n\t"
        "v_fmac_f32_dpp %3, %5, %21 row_newbcast:15 row_mask:0xf bank_mask:0xf\n\t"
        "s_nop 1"
        : "+v"(sgu), "+v"(rhu), "+v"(sgp), "+v"(rhp) : "v"(kkv), "v"(wrv), "v"(su[8]), "v"(su[9]), "v"(su[10]), "v"(su[11]), "v"(su[12]), "v"(su[13]), "v"(su[14]), "v"(su[15]), "v"(sp[8]), "v"(sp[9]), "v"(sp[10]), "v"(sp[11]), "v"(sp[12]), "v"(sp[13]), "v"(sp[14]), "v"(sp[15]));
}
__device__ __forceinline__ void scan_wave_up(Ctx& F, int bh, int c, int g) {
    const int lane = F.lane, q = lane >> 4, m = lane & 15, row = 16 * g + m, h = bh & 15, b = bh >> 4;
    const int r0 = b * SEQ + c * 64, ch = bh * 64 + c;
    const float* RWV = WSP(float, WS_RWV); const float* SCL = WSP(float, WS_SCL); float* Y = WSP(float, WS_Y); float* Z = WSP(float, WS_Z); float* PU = WSP(float, WS_PU);
    float su[16], sp[16];
#pragma unroll
    for (int i = 0; i < 16; ++i) { su[i] = 0.f; sp[i] = ((16 * q + i) == row) ? 1.f : 0.f; }
    StepIn buf[4];
#pragma unroll
    for (int u = 0; u < 4; ++u) scan_load<false>(buf[u], RWV, SCL, r0 + u, h, lane, row);
    for (int t = 0; t < 64; t += 4) {
#pragma unroll
        for (int u = 0; u < 4; ++u) {
            const StepIn x = buf[u];
            if (t + u + 4 < 64) scan_load<false>(buf[u], RWV, SCL, r0 + t + u + 4, h, lane, row);
            float sgu = 0.f, rhu = 0.f, sgp = 0.f, rhp = 0.f;
            dots2_h0(sgu, rhu, sgp, rhp, x.kkv, x.wrv, su, sp); dots2_h1(sgu, rhu, sgp, rhp, x.kkv, x.wrv, su, sp);
            sgu = xrow16_sum(sgu); rhu = xrow16_sum(rhu); sgp = xrow16_sum(sgp); rhp = xrow16_sum(rhp);
            const float nsu = -sgu, nsp = -sgp;
            const float y = rhu + nsu * x.beta + x.vv * x.kappa, z = rhp + nsp * x.beta;
            if (q == 0) { Y[(size_t)(r0 + t + u) * 1024 + h * 64 + row] = y; Z[((size_t)ch * 64 + t + u) * 64 + row] = z; }
            upd16_v(su, x.wv, x.kv, x.bv, x.vv, nsu); upd16_nov(sp, x.wv, x.kv, x.bv, x.vv, nsp);
        }
    }
    float* du = PU + (((size_t)ch * 2 + 0) * 64 + row) * 64 + 16 * q; float* dp = PU + (((size_t)ch * 2 + 1) * 64 + row) * 64 + 16 * q;
#pragma unroll
    for (int i = 0; i < 16; i += 4) { *(GAS f32x4*)(du + i) = (f32x4){su[i], su[i + 1], su[i + 2], su[i + 3]}; *(GAS f32x4*)(dp + i) = (f32x4){sp[i], sp[i + 1], sp[i + 2], sp[i + 3]}; }
}
__device__ __forceinline__ void phase_scan1_stream(Ctx& F) {
    LAS int* ctr = (LAS int*)(F.lds + LDSCTL_OFF);
    __syncthreads(); if (F.tid == 0) *ctr = 0; __syncthreads();
    if (F.wave >= 6) { for (int u = F.vcu * 2 + (F.wave - 6); u < DBAT * HA * 32; u += 2 * F.G) sba::attn_sample_unit(F, u >> 5, u & 31, (char*)F.lds + F.wave * 16384); }
    constexpr int NSU = DBAT * HB / 2, NU = NSU + NBATCH * HB * 64;
    const int nunits = F.vcu < NU ? (NU - 1 - F.vcu) / F.G + 1 : 0, ntasks = nunits * 8;
    for (;;) {
        int t = 0; if (F.lane == 0) t = __hip_atomic_fetch_add(ctr, 1, __ATOMIC_RELAXED, __HIP_MEMORY_SCOPE_WORKGROUP);
        t = __builtin_amdgcn_readfirstlane(t); if (t >= ntasks) break;
        const int u = F.vcu + (t >> 3) * F.G, g8 = t & 7;
        if (u < NSU) scan_wave<false, true>(F, u * 2 + (g8 >> 2), 0, g8 & 3);
        else if (g8 < 4) { const int ch = u - NSU; scan_wave_up(F, ch >> 6, ch & 63, g8); }
    }
}
namespace msc {
using sba::bf16x8; using sba::f32x16; using sba::crow; using sba::swap_other;
constexpr int S_AQ = 136, S_BKT = 104, S_L = 40;
constexpr int O_AQ = 0, O_BK = 32 * S_AQ, O_L24 = O_BK, O_TL3 = O_BK + 32 * S_L, O_BKT = 2 * 32 * S_AQ, BLK_BYTES = O_BKT + 64 * S_BKT, O_GL = 4 * BLK_BYTES, O_GP = O_GL + 256, GRP_BYTES = O_GP + 4 * 256;
static_assert(BLK_BYTES % 8 == 0 && 2 * GRP_BYTES <= RING_BYTES, "scan LDS map");
typedef __bf16 nbf2 __attribute__((ext_vector_type(2)));
__device__ __forceinline__ unsigned cvt2(float lo, float hi) { return __builtin_bit_cast(unsigned, __builtin_convertvector((f32x2){lo, hi}, nbf2)); }
__device__ __forceinline__ bf16x8 pack8(float a0, float a1, float a2, float a3, float a4, float a5, float a6, float a7) {
    u32x4 w = {cvt2(a0, a1), cvt2(a2, a3), cvt2(a4, a5), cvt2(a6, a7)}; return *reinterpret_cast<bf16x8*>(&w); }
__device__ __forceinline__ bf16x8 pack_lo(const f32x16& c) { return pack8(c[0], c[1], c[2], c[3], c[4], c[5], c[6], c[7]); }
__device__ __forceinline__ bf16x8 pack_hi(const f32x16& c) { return pack8(c[8], c[9], c[10], c[11], c[12], c[13], c[14], c[15]); }
__device__ __forceinline__ bf16x8 perm_read(const LAS char* img, int row, int pitch, int col0, int g) {
    const LAS char* p = img + row * pitch + (col0 + 4 * g) * 2; const u32x2 lo = *(const LAS u32x2*)p, hi = *(const LAS u32x2*)(p + 16);
    u32x4 w = {lo.x, lo.y, hi.x, hi.y}; return *reinterpret_cast<bf16x8*>(&w); }
__device__ __forceinline__ bf16x8 nat_read(const LAS char* img, int row, int pitch, int col0) {
    const LAS char* p = img + row * pitch + col0 * 2; const u32x2 lo = *(const LAS u32x2*)p, hi = *(const LAS u32x2*)(p + 8);
    u32x4 w = {lo.x, lo.y, hi.x, hi.y}; return *reinterpret_cast<bf16x8*>(&w); }
__device__ __forceinline__ unsigned short bf1(float x) { return (unsigned short)(cvt_pk_bf16(x, 0.f) & 0xffffu); }
struct PrepRegs { float pr[17], pk[17], pv[17], lwl[16]; const bf16* lw; };
__device__ __forceinline__ void prep_load(Ctx& F, PrepRegs& L, int rb, int h) {
    const bf16* pb = WSP(bf16, WS_PBH) + (size_t)rb * 3072 + h * 64 + F.lane; const bf16* lw = WSP(bf16, WS_LWH) + (size_t)rb * 3072 + h * 64 + F.lane;
    L.lw = lw;
#pragma unroll
    for (int t = 0; t < 16; ++t) L.lwl[t] = ldbf_nt(lw + (size_t)t * 3072);
    if ((rb & (SEQ - 1)) != 0) { L.pr[0] = ldbf_nt(pb - 3072); L.pk[0] = ldbf_nt(pb + 1024 - 3072); L.pv[0] = ldbf_nt(pb + 2048 - 3072); } else { L.pr[0] = 0.f; L.pk[0] = 0.f; L.pv[0] = 0.f; }
#pragma unroll
    for (int t = 0; t < 16; ++t) { L.pr[t + 1] = ldbf_nt(pb + (size_t)t * 3072); L.pk[t + 1] = ldbf_nt(pb + (size_t)t * 3072 + 1024); L.pv[t + 1] = ldbf_nt(pb + (size_t)t * 3072 + 2048); }
}
__device__ __forceinline__ void prep_block(Ctx& F, PrepRegs& L, int rb, int h, int j, LAS char* gbase) {
    const int lane = F.lane, n = lane & 31, hi = lane >> 5, col = h * 64 + lane; LAS char* blk = gbase + j * BLK_BYTES;
    float lal[16];
#pragma unroll
    for (int t = 0; t < 16; ++t) lal[t] = ldbf_nt(L.lw + (size_t)t * 3072 + 1024);
    const float* mu = F.in(I_MU); const float mu_r = mu[col], mu_k = mu[1024 + col], mu_v = mu[2048 + col];
    const float w0 = F.in(I_W0)[col], a0 = F.in(I_A0)[col], kkw = F.in(I_KK)[col], kaw = F.in(I_KA)[col], rkw = F.in(I_RK)[col];
    float cw[16];
#pragma unroll
    for (int t = 0; t < 16; ++t) { const float wl = w0 + L.lwl[t], wlog = -softplusf_(-wl) - 0.5f; cw[t] = __expf(-__expf(wlog)); }
#pragma unroll
    for (int t = 1; t < 16; ++t) cw[t] *= cw[t - 1];
    *(LAS float*)(gbase + O_GP + (j * 64 + lane) * 4) = cw[15];
    __syncthreads();
    const float g0 = *(const LAS float*)(gbase + O_GP + lane * 4), g1 = *(const LAS float*)(gbase + O_GP + (64 + lane) * 4), g2 = *(const LAS float*)(gbase + O_GP + (128 + lane) * 4);
    const float G0 = (j > 0 ? g0 : 1.f) * (j > 1 ? g1 : 1.f) * (j > 2 ? g2 : 1.f);
    if (j == 3) *(LAS float*)(gbase + O_GL + lane * 4) = G0 * cw[15];
    float* SCL = WSP(float, WS_SCL) + ((size_t)rb * HB + h) * 4;
#pragma unroll
    for (int tl = 0; tl < 16; tl += 2) {
        float nb[2], kt[2], vz[2];
#pragma unroll
        for (int u = 0; u < 2; ++u) { const int t = tl + u;
            const float zr = L.pr[t + 1] + mu_r * (L.pr[t] - L.pr[t + 1]), zk = L.pk[t + 1] + mu_k * (L.pk[t] - L.pk[t + 1]); vz[u] = L.pv[t + 1] + mu_v * (L.pv[t] - L.pv[t + 1]);
            const float a_ = sigmoidf_(a0 + lal[t]);
            const float kkr = zk * kkw, kk = kkr * rsqrtf(wave_sum(kkr * kkr) + 1e-12f);
            const float k = zk * (1.f + (a_ - 1.f) * kaw), bb = kk * a_;
            const float bonus = wave_sum(zr * k * rkw);
            if (lane == 0) SCL[(size_t)t * HB * 4 + 2] = bonus;
            const float Gp = t ? G0 * cw[t ? t - 1 : 0] : G0, G = G0 * cw[t], gi = 1.f / G;
            const float a = kk * Gp, q = zr * G, bt = bb * gi; kt[u] = k * gi; nb[u] = -bt;
            *(LAS unsigned short*)(blk + O_AQ + t * S_AQ + lane * 2) = bf1(a); *(LAS unsigned short*)(blk + O_AQ + (16 + t) * S_AQ + lane * 2) = bf1(q);
            *(LAS unsigned short*)(blk + O_BK + t * S_AQ + lane * 2) = bf1(bt); *(LAS unsigned short*)(blk + O_BK + (16 + t) * S_AQ + lane * 2) = bf1(kt[u]); }
        *(LAS unsigned*)(blk + O_BKT + lane * S_BKT + tl * 2) = cvt_pk_bf16(nb[0], nb[1]); *(LAS unsigned*)(blk + O_BKT + lane * S_BKT + (16 + tl) * 2) = cvt_pk_bf16(kt[0], kt[1]);
        *(LAS unsigned*)(blk + O_BKT + lane * S_BKT + (32 + tl) * 2) = cvt_pk_bf16(vz[0], vz[1]);
    }
    LDS_WAIT(); asm volatile("" ::: "memory");
    f32x16 mt = f32x16{};
#pragma unroll
    for (int ks = 0; ks < 4; ++ks) mt = __builtin_amdgcn_mfma_f32_32x32x16_bf16(nat_read(blk + O_AQ, n, S_AQ, 16 * ks + 8 * hi), nat_read(blk + O_BK, n, S_AQ, 16 * ks + 8 * hi), mt, 0, 0, 0);
    float l1[8];
    const int i = n & 15;
#pragma unroll
    for (int r = 0; r < 16; ++r) { const int t = crow(r, hi) & 15; float val = mt[r];
        if (r < 8) { val = t > i ? val : 0.f; if (n >= 16) *(LAS unsigned short*)(blk + O_L24 + t * S_L + i * 2) = bf1(val); l1[r] = val; }
        else { val = t >= i ? val : 0.f; if (n >= 16) *(LAS unsigned short*)(blk + O_L24 + (16 + t) * S_L + i * 2) = bf1(val); else *(LAS unsigned short*)(blk + O_TL3 + (16 + t) * S_L + i * 2) = bf1(-val); } }
    float rowv[16];
#pragma unroll
    for (int r = 0; r < 8; ++r) { const float own = l1[r], oth = swap_other(own, hi); const int p0 = (r & 3) + 8 * (r >> 2); rowv[p0] = hi ? oth : own; rowv[p0 + 4] = hi ? own : oth; }
    float tl_[16];
    tl_[0] = lane == 0 ? 1.f : 0.f;
#pragma unroll
    for (int t = 1; t < 16; ++t) { float acc = lane == t ? 1.f : 0.f;
#pragma unroll
        for (int jj = 0; jj < t; ++jj) acc -= readlane_f(rowv[t], jj) * tl_[jj];
        tl_[t] = acc; }
    if (lane < 16) {
#pragma unroll
        for (int t = 0; t < 16; ++t) *(LAS unsigned short*)(blk + O_TL3 + t * S_L + lane * 2) = bf1(tl_[t]); }
    LDS_WAIT(); asm volatile("" ::: "memory");
}
__device__ __forceinline__ void chain(Ctx& F, int bh, int c, int isP, int half, const LAS char* gbase) {
    const int lane = F.lane, n = lane & 31, hi = lane >> 5, rowg = 32 * half + n, h = bh & 15, b = bh >> 4, r0 = b * SEQ + c * 64, ch = bh * 64 + c;
    const float* RWV = WSP(float, WS_RWV);
    f32x16 st0 = f32x16{}, st1 = f32x16{};
    if (isP) {
#pragma unroll
        for (int r = 0; r < 16; ++r) { st0[r] = crow(r, hi) == rowg ? 1.f : 0.f; st1[r] = 32 + crow(r, hi) == rowg ? 1.f : 0.f; } }
    for (int blk_i = 0; blk_i < 4; ++blk_i) {
        const LAS char* blk = gbase + blk_i * BLK_BYTES;
        f32x16 wt = f32x16{};
        wt = __builtin_amdgcn_mfma_f32_32x32x16_bf16(perm_read(blk + O_AQ, n, S_AQ, 0, hi), pack_lo(st0), wt, 0, 0, 0);
        wt = __builtin_amdgcn_mfma_f32_32x32x16_bf16(perm_read(blk + O_AQ, n, S_AQ, 16, hi), pack_hi(st0), wt, 0, 0, 0);
        wt = __builtin_amdgcn_mfma_f32_32x32x16_bf16(perm_read(blk + O_AQ, n, S_AQ, 32, hi), pack_lo(st1), wt, 0, 0, 0);
        wt = __builtin_amdgcn_mfma_f32_32x32x16_bf16(perm_read(blk + O_AQ, n, S_AQ, 48, hi), pack_hi(st1), wt, 0, 0, 0);
        bf16x8 bV = bf16x8{};
        if (!isP) { bV = perm_read(blk + O_BKT, rowg, S_BKT, 32, hi);
            wt = __builtin_amdgcn_mfma_f32_32x32x16_bf16(perm_read(blk + O_L24, n, S_L, 0, hi), bV, wt, 0, 0, 0); }
        const bf16x8 tl3 = perm_read(blk + O_TL3, n, S_L, 0, hi);
        const bf16x8 a_tl = n < 16 ? tl3 : bf16x8{}, a_l3 = n >= 16 ? tl3 : bf16x8{};
        const f32x16 sg = __builtin_amdgcn_mfma_f32_32x32x16_bf16(a_tl, pack_lo(wt), f32x16{}, 0, 0, 0);
        const bf16x8 bSg = pack_lo(sg);
        const f32x16 yy = __builtin_amdgcn_mfma_f32_32x32x16_bf16(a_l3, bSg, wt, 0, 0, 0);
#pragma unroll
        for (int r = 8; r < 16; ++r) { const int t = blk_i * 16 + (r & 3) + 8 * ((r - 8) >> 2) + 4 * hi;
            if (isP) WSP(float, WS_Z)[((size_t)ch * 64 + t) * 64 + rowg] = yy[r]; else WSP(float, WS_Y)[(size_t)(r0 + t) * 1024 + h * 64 + rowg] = yy[r]; }
        st0 = __builtin_amdgcn_mfma_f32_32x32x16_bf16(perm_read(blk + O_BKT, n, S_BKT, 0, hi), bSg, st0, 0, 0, 0);
        st1 = __builtin_amdgcn_mfma_f32_32x32x16_bf16(perm_read(blk + O_BKT, 32 + n, S_BKT, 0, hi), bSg, st1, 0, 0, 0);
        if (!isP) { st0 = __builtin_amdgcn_mfma_f32_32x32x16_bf16(perm_read(blk + O_BKT, n, S_BKT, 16, hi), bV, st0, 0, 0, 0);
                    st1 = __builtin_amdgcn_mfma_f32_32x32x16_bf16(perm_read(blk + O_BKT, 32 + n, S_BKT, 16, hi), bV, st1, 0, 0, 0); }
    }
    const LAS float* GL = (const LAS float*)(gbase + O_GL); float* dst = WSP(float, WS_PU) + (((size_t)ch * 2 + isP) * 64 + rowg) * 64;
#pragma unroll
    for (int g4 = 0; g4 < 4; ++g4) { const int k0 = 8 * g4 + 4 * hi; const f32x4 ga = *(const LAS f32x4*)(GL + k0), gb = *(const LAS f32x4*)(GL + 32 + k0);
        *(GAS f32x4*)(dst + k0) = (f32x4){st0[4 * g4] * ga.x, st0[4 * g4 + 1] * ga.y, st0[4 * g4 + 2] * ga.z, st0[4 * g4 + 3] * ga.w};
        *(GAS f32x4*)(dst + 32 + k0) = (f32x4){st1[4 * g4] * gb.x, st1[4 * g4 + 1] * gb.y, st1[4 * g4 + 2] * gb.z, st1[4 * g4 + 3] * gb.w}; }
}
}
__device__ __forceinline__ void phase_sample_stream(Ctx& F) {
    for (int u = F.vcu * NWAVES + F.wave; u < DBAT * HA * 32; u += NWAVES * F.G) sba::attn_sample_unit(F, (u >> 8) * HA + (u & 7), (u >> 3) & 31, (char*)F.lds + F.wave * 16384);
}
__device__ __forceinline__ void phase_scan1_mfma(Ctx& F) {
    __syncthreads();
    const int grp = F.wave >> 2, wq = F.wave & 3; LAS char* gbase = (LAS char*)F.lds + grp * msc::GRP_BYTES;
    msc::PrepRegs L;
    { const int ch = 2 * F.vcu + grp; if (ch < NBATCH * HB * 64) msc::prep_load(F, L, (ch >> 10) * SEQ + (ch & 63) * 64 + 16 * wq, (ch >> 6) & 15); }
    for (int base = 2 * F.vcu; base < NBATCH * HB * 64; base += 2 * F.G) {
        const int ch = base + grp, bh = ch >> 6, c = ch & 63;
        msc::prep_block(F, L, (bh >> 4) * SEQ + c * 64 + 16 * wq, bh & 15, wq, gbase);
        __syncthreads();
        { const int chn = ch + 2 * F.G; if (chn < NBATCH * HB * 64) msc::prep_load(F, L, (chn >> 10) * SEQ + (chn & 63) * 64 + 16 * wq, (chn >> 6) & 15); }
        msc::chain(F, bh, c, wq >> 1, wq & 1, gbase);
    }
}
__device__ __forceinline__ void phase_scan2(Ctx& F) {
    LAS float* Pb = (LAS float*)(F.lds + 4096);
    const float* PU = WSP(float, WS_PU); float* SC = WSP(float, WS_SC);
    for (int unit = F.vcu; unit < NBATCH * HB * 8; unit += F.G) {
        const int bh = unit >> 3, r0 = (unit & 7) * 8, r = F.wave, col = F.lane;
        __syncthreads();
        { const float* P0 = PU + ((size_t)(bh * 64) * 2 + 1) * 4096; const f32x4 a = *(const GAS f32x4*)(P0 + F.tid * 4), bq = *(const GAS f32x4*)(P0 + 2048 + F.tid * 4);
          *(LAS f32x4*)(Pb + F.tid * 4) = a; *(LAS f32x4*)(Pb + 2048 + F.tid * 4) = bq; }
        float ucur = PU[((size_t)(bh * 64) * 2 + 0) * 4096 + (r0 + r) * 64 + col], scur = 0.f;
        __syncthreads();
        for (int c = 0; c < 64; ++c) {
            const int ch = bh * 64 + c; LAS float* Pc = Pb + (c & 1) * 4096;
            SC[((size_t)ch * 64 + r0 + r) * 64 + col] = scur;
            f32x4 pa = {0.f, 0.f, 0.f, 0.f}, pq = {0.f, 0.f, 0.f, 0.f}; float unext = 0.f;
            if (c + 1 < 64) { const float* Pn = PU + ((size_t)(ch + 1) * 2 + 1) * 4096; pa = *(const GAS f32x4*)(Pn + F.tid * 4); pq = *(const GAS f32x4*)(Pn + 2048 + F.tid * 4);
                unext = PU[((size_t)(ch + 1) * 2 + 0) * 4096 + (r0 + r) * 64 + col]; }
            float a0 = ucur, a1 = 0.f, a2 = 0.f, a3 = 0.f;
#pragma unroll
            for (int j = 0; j < 64; j += 4) {
                const float s0 = readlane_f(scur, j), s1 = readlane_f(scur, j + 1), s2 = readlane_f(scur, j + 2), s3 = readlane_f(scur, j + 3);
                a0 += s0 * Pc[(j + 0) * 64 + col]; a1 += s1 * Pc[(j + 1) * 64 + col]; a2 += s2 * Pc[(j + 2) * 64 + col]; a3 += s3 * Pc[(j + 3) * 64 + col]; }
            const float acc = (a0 + a1) + (a2 + a3);
            if (c + 1 < 64) { LAS float* Pn = Pb + ((c + 1) & 1) * 4096; *(LAS f32x4*)(Pn + F.tid * 4) = pa; *(LAS f32x4*)(Pn + 2048 + F.tid * 4) = pq; }
            __syncthreads();
            scur = acc; ucur = unext;
        }
        F.outp()[O_WKVP + ((size_t)bh * 64 + r0 + r) * 64 + col] = scur;
    }
}
__device__ __forceinline__ void phase_scan3(Ctx& F) {
    const int gw = F.vcu * NWAVES + F.wave, NGW = F.G * NWAVES, lane = F.lane, q = lane >> 4, m = lane & 15;
    const float* SC = WSP(float, WS_SC); const float* Z = WSP(float, WS_Z); float* Y = WSP(float, WS_YC);
    for (int task = gw; task < NBATCH * HB * 63 * 4; task += NGW) {
        const int g = task & 3, cc = task >> 2, bh = cc / 63, c = 1 + (cc - bh * 63), ch = bh * 64 + c, h = bh & 15, b = bh >> 4, row = 16 * g + m;
        const float* st = SC + ((size_t)ch * 64 + row) * 64 + 16 * q; float s[16];
#pragma unroll
        for (int i = 0; i < 16; i += 4) { const f32x4 v = *(const GAS f32x4*)(st + i); s[i] = v.x; s[i + 1] = v.y; s[i + 2] = v.z; s[i + 3] = v.w; }
        const float* zp = Z + (size_t)ch * 4096 + lane; float* yp = Y + (size_t)(b * SEQ + c * 64) * 1024 + h * 64 + row;
        float zb[4];
#pragma unroll
        for (int u = 0; u < 4; ++u) zb[u] = zp[u * 64];
        for (int t = 0; t < 64; t += 4) {
#pragma unroll
            for (int u = 0; u < 4; ++u) {
                const float zv = zb[u]; if (t + u + 4 < 64) zb[u] = zp[(t + u + 4) * 64];
                float acc = 0.f; dot16(acc, zv, s); acc = xrow16_sum(acc);
                if (q == 0) yp[(size_t)(t + u) * 1024] = acc;
            }
        }
    }
}
__device__ __forceinline__ float sum32(float v) {
    v += dpp_f<0xB1>(v); v += dpp_f<0x4E>(v); v += dpp_f<0x141>(v); v += dpp_f<0x140>(v);
    auto s = __builtin_amdgcn_permlane16_swap(__float_as_uint(v), __float_as_uint(v), false, false);
    return __uint_as_float(s[0]) + __uint_as_float(s[1]);
}
__device__ __forceinline__ sba::bf16x8 ld8_bf16(const float* p) { const f32x4 a = *(const GAS f32x4*)p, b = *(const GAS f32x4*)(p + 4); return msc::pack8(a.x, a.y, a.z, a.w, b.x, b.y, b.z, b.w); }
__device__ __forceinline__ void comb_load(Ctx& F, size_t i, f32x4& a, f32x4& e, float& cl) {
    const size_t ic = i < (size_t)NPR * 256 ? i : (size_t)NPR * 256 - 1; const int r = (int)(ic >> 8), c4 = (int)(ic & 255) * 4, h = c4 >> 7;
    const float* OP = WSP(float, WS_OP);
    a = *(const GAS f32x4*)(OP + (size_t)r * 1024 + c4); e = *(const GAS f32x4*)(OP + ((size_t)NPR + r) * 1024 + c4); cl = WSP(float, WS_CL)[(size_t)r * HA + h];
}
__device__ __forceinline__ void comb_store(Ctx& F, size_t i, const f32x4& a, const f32x4& e, float cl) {
    if (i < (size_t)NPR * 256) { const int r = (int)(i >> 8), c4 = (int)(i & 255) * 4;
        const f32x4 o = a + e * cl; u32x2 w; w.x = cvt_pk_bf16(o.x, o.y); w.y = cvt_pk_bf16(o.z, o.w);
        *(GAS u32x2*)(WSP(bf16, WS_OAB) + (size_t)r * DM + c4) = w; }
}
__device__ __forceinline__ void phase_scan3_post(Ctx& F, size_t& ci, const size_t istr) {
    const int gw = F.vcu * NWAVES + F.wave, NGW = F.G * NWAVES, lane = F.lane, n = lane & 31, hi = lane >> 5;
    const float* SC = WSP(float, WS_SC); const float* Z = WSP(float, WS_Z); const float* Y = WSP(float, WS_Y); const bf16* LWH = WSP(bf16, WS_LWH); const bf16* PBH = WSP(bf16, WS_PBH);
    const float* SCL = WSP(float, WS_SCL); bf16* OAB = WSP(bf16, WS_OAB);
    for (int ch = gw; ch < NBATCH * HB * 64; ch += NGW) {
        const int bh = ch >> 6, c = ch & 63, h = bh & 15, b = bh >> 4, r0 = b * SEQ + c * 64, col0 = h * 64 + n;
        const float lg0 = F.in(I_LNG)[col0], lg1 = F.in(I_LNG)[col0 + 32], lb0 = F.in(I_LNB)[col0], lb1 = F.in(I_LNB)[col0 + 32], mv0 = F.in(I_MU)[2048 + col0], mv1 = F.in(I_MU)[2048 + col0 + 32];
        sba::bf16x8 sb0[4], sb1[4];
        if (c > 0) { const float* Sp = SC + (size_t)ch * 4096 + n * 64 + 8 * hi;
#pragma unroll
            for (int ks = 0; ks < 4; ++ks) { sb0[ks] = ld8_bf16(Sp + 16 * ks); sb1[ks] = ld8_bf16(Sp + 32 * 64 + 16 * ks); } }
        else {
#pragma unroll
            for (int ks = 0; ks < 4; ++ks) { sb0[ks] = sba::bf16x8{}; sb1[ks] = sba::bf16x8{}; } }
        for (int tt = 0; tt < 2; ++tt) {
            sba::f32x16 a0 = sba::f32x16{}, a1 = sba::f32x16{};
            if (c > 0) { const float* Zp = Z + (size_t)ch * 4096 + (32 * tt + n) * 64 + 8 * hi;
#pragma unroll
                for (int ks = 0; ks < 4; ++ks) { const sba::bf16x8 za = ld8_bf16(Zp + 16 * ks);
                    a0 = __builtin_amdgcn_mfma_f32_32x32x16_bf16(za, sb0[ks], a0, 0, 0, 0); a1 = __builtin_amdgcn_mfma_f32_32x32x16_bf16(za, sb1[ks], a1, 0, 0, 0); } }
#pragma unroll
            for (int rg = 0; rg < 16; rg += 4) {
                float y0[4], y1[4], g0[4], g1[4], p0[4], p1[4], q0[4], q1[4], bn[4];
                f32x4 ca0, ce0, ca1, ce1; float cc0, cc1; const size_t ci0 = ci, ci1 = ci + istr; ci += 2 * istr;
                comb_load(F, ci0, ca0, ce0, cc0); comb_load(F, ci1, ca1, ce1, cc1);
#pragma unroll
                for (int i = 0; i < 4; ++i) { const int t = 32 * tt + sba::crow(rg + i, hi), r = r0 + t;
                    y0[i] = Y[(size_t)r * 1024 + col0]; y1[i] = Y[(size_t)r * 1024 + col0 + 32];
                    g0[i] = ldbf(LWH + (size_t)r * 3072 + 2048 + col0); g1[i] = ldbf(LWH + (size_t)r * 3072 + 2048 + col0 + 32);
                    const bf16* pb = PBH + (size_t)r * 3072 + 2048 + col0; p0[i] = ldbf(pb); p1[i] = ldbf(pb + 32);
                    const bool hp = (r & (SEQ - 1)) != 0; q0[i] = hp ? ldbf(pb - 3072) : 0.f; q1[i] = hp ? ldbf(pb + 32 - 3072) : 0.f;
                    bn[i] = SCL[((size_t)r * HB + h) * 4 + 2]; }
#pragma unroll
                for (int i = 0; i < 4; ++i) { const int t = 32 * tt + sba::crow(rg + i, hi), r = r0 + t;
                    const float v0 = y0[i] + a0[rg + i], v1 = y1[i] + a1[rg + i];
                    const float mean = sum32(v0 + v1) * (1.f / 64.f), d0 = v0 - mean, d1 = v1 - mean, var = sum32(d0 * d0 + d1 * d1) * (1.f / 64.f), rs = rsqrtf(var + EPS_LNX);
                    const float zv0 = p0[i] + mv0 * (q0[i] - p0[i]), zv1 = p1[i] + mv1 * (q1[i] - p1[i]);
                    const float o0 = (d0 * rs * lg0 + lb0 + bn[i] * zv0) * g0[i], o1 = (d1 * rs * lg1 + lb1 + bn[i] * zv1) * g1[i];
                    const float o0n = dpp_f<0xB1>(o0), o1n = dpp_f<0xB1>(o1);
                    if ((lane & 1) == 0) { *(GAS unsigned*)(OAB + (size_t)r * DM + 1024 + col0) = cvt_pk_bf16(o0, o0n); *(GAS unsigned*)(OAB + (size_t)r * DM + 1024 + col0 + 32) = cvt_pk_bf16(o1, o1n); } }
                comb_store(F, ci0, ca0, ce0, cc0); comb_store(F, ci1, ca1, ce1, cc1);
            }
        }
    }
}
__device__ __forceinline__ void phase_postscan(Ctx& F, size_t ci, const size_t istr) {
    const int gw = F.vcu * NWAVES + F.wave, NGW = F.G * NWAVES;
    const float* Y = WSP(float, WS_Y); const float* RWV = WSP(float, WS_RWV); const float* SCL = WSP(float, WS_SCL); const float* LWO = WSP(float, WS_LWO); const float* Pp = WSP(float, WS_P); bf16* OAB = WSP(bf16, WS_OAB);
    for (int u = NPR * 4 + gw; u < NTOK * 4; u += NGW) {
        const int r = u >> 2, hq = u & 3; const bool corr = false;
        float yv[4], gv[4], vv[4], bn[4];
#pragma unroll
        for (int i = 0; i < 4; ++i) { const int h = hq * 4 + i, col = h * 64 + F.lane;
            yv[i] = Y[(size_t)r * 1024 + col]; if (corr) yv[i] += WSP(float, WS_YC)[(size_t)r * 1024 + col];
            gv[i] = LWO[(size_t)r * 3072 + 2048 + col]; bn[i] = SCL[((size_t)r * HB + h) * 4 + 2];
            vv[i] = RWV[((size_t)r * HB + h) * 512 + 320 + F.lane]; }
#pragma unroll
        for (int i = 0; i < 4; ++i) { const int h = hq * 4 + i, col = h * 64 + F.lane;
            const float mean = wave_sum(yv[i]) * (1.f / 64.f), d = yv[i] - mean, var = wave_sum(d * d) * (1.f / 64.f);
            const float yn = d * rsqrtf(var + EPS_LNX) * F.in(I_LNG)[col] + F.in(I_LNB)[col] + bn[i] * vv[i];
            const float o = yn * gv[i];
            const float o1 = dpp_f<0xB1>(o);
            if ((F.lane & 1) == 0) *(GAS unsigned*)(OAB + (size_t)r * DM + 1024 + col) = cvt_pk_bf16(o, o1); }
    }
    sample_combine(F);
    const float* OP = WSP(float, WS_OP); const float* CL = WSP(float, WS_CL);
    for (size_t i = ci; i < (size_t)NPR * 256; i += istr) {
        const int r = (int)(i >> 8), c4 = (int)(i & 255) * 4, h = c4 >> 7;
        const f32x4 a = *(const GAS f32x4*)(OP + (size_t)r * 1024 + c4), e = *(const GAS f32x4*)(OP + ((size_t)NPR + r) * 1024 + c4); const float cl = CL[(size_t)r * HA + h];
        const f32x4 o = a + e * cl; u32x2 w; w.x = cvt_pk_bf16(o.x, o.y); w.y = cvt_pk_bf16(o.z, o.w);
        *(GAS u32x2*)(OAB + (size_t)r * DM + c4) = w;
    }
}
__device__ __forceinline__ void phase_usample(Ctx& F) {
    const float* PU_ = WSP(float, WS_PARTU); bf16* U = WSP(bf16, WS_U);
    for (int i = F.vcu * NTHR + F.tid; i < NSM * DFF / 4; i += F.G * NTHR) { const int r = i / (DFF / 4), c4 = (i - r * (DFF / 4)) * 4;
        f32x4 a = *(const GAS f32x4*)(PU_ + (size_t)r * DFF + c4);
#pragma unroll
        for (int kc = 1; kc < 8; ++kc) a += *(const GAS f32x4*)(PU_ + ((size_t)kc * 64 + r) * DFF + c4);
        const float x0 = fmaxf(a.x, 0.f), x1 = fmaxf(a.y, 0.f), x2 = fmaxf(a.z, 0.f), x3 = fmaxf(a.w, 0.f);
        u32x2 w; w.x = cvt_pk_bf16(x0 * x0, x1 * x1); w.y = cvt_pk_bf16(x2 * x2, x3 * x3);
        *(GAS u32x2*)(U + (size_t)(NPR + r) * DFF + c4) = w; }
}
#ifndef MK_SPLIT
#define MK_SPLIT 0
#endif
constexpr int NPHASE = 21;
struct Args { const void* in[N_IN]; float* out; unsigned char* ws; int ph_lo, ph_hi; };
__global__ void __launch_bounds__(NTHR, 2) mega_fwd(Args args) {
    extern __shared__ __attribute__((aligned(16))) unsigned char lds_raw[];
    Ctx F;
    F.lds = (LAS unsigned char*)lds_raw; F.tid = threadIdx.x; F.lane = F.tid & 63; F.wave = __builtin_amdgcn_readfirstlane(F.tid >> 6);
    F.G = gridDim.x; { const int bx = blockIdx.x; F.vcu = (F.G % 8 == 0) ? (bx % 8) * (F.G / 8) + bx / 8 : bx; }
    for (int u = F.tid; u < (LDS_BYTES - LDSCTL_OFF) / 4; u += NTHR) ((LAS unsigned*)(F.lds + LDSCTL_OFF))[u] = 0u;
    __syncthreads();
    unsigned* ctl = (unsigned*)(args.ws + WS_CTL);
    XcdBarrier bar; bar.bar = ctl + CW_BAR; bar.x = 0; bar.st = nullptr;
    if (!MK_SPLIT) bar = xcd_barrier_post(ctl + CW_BAR, (volatile LAS unsigned*)(F.lds + MISC_OFF) + 8);
    const int lo = args.ph_lo, hi = args.ph_hi;
#define IN(k) (lo <= (k) && (k) < hi)
#define SEAM(k) do { if (IN(k) && IN((k) + 1)) xcd_barrier(bar); } while (0)
    if (IN(0)) { phase_prologue(F); } SEAM(0);
    if (IN(1)) { phase_mod0(F); } SEAM(1);
    if (IN(2)) { const bool hide = F.G > NCVT + 8; const int ng = hide ? F.G - NCVT : F.G;
        if ((int)blockIdx.x < ng) { pg8::Gemm g{WSP(bf16, WS_H), WSP(bf16, WS_WIN), MP, INPAD, DM, DM, DM}; pg8::StaticOrder S; S.init(MP, INPAD, ng, (int)blockIdx.x); EpiIn E{WSP(bf16, WS_QB), WSP(bf16, WS_KB), WSP(bf16, WS_VB), WSP(float, WS_P), F.outp(), WSP(bf16, WS_PBH)};
            pg8::gemm_phase<EpiIn, pg8::StaticOrder, true, true>(F.lds, g, S, E); }
        else convert_run(F, IT_IN + ((int)blockIdx.x - ng) * NWAVES + F.wave, NCVT * NWAVES, IT_IN + N_HIDE, (LAS float*)(F.lds + F.wave * 16384)); } SEAM(2);
    if (IN(3)) { phase_kv_prep(F); } SEAM(3);
    if (IN(4)) { pg8::Gemm g{WSP(bf16, WS_LA), WSP(bf16, WS_LWT), MP, 3072, 512, 512, 512}; pg8::LoraOrder S; S.init(MP, 3072, F.G, (int)blockIdx.x); pg8::EpiLora E{WSP(float, WS_LWO), WSP(bf16, WS_LWH), 3072};
        pg8::gemm_phase<pg8::EpiLora, pg8::LoraOrder, true, true>(F.lds, g, S, E); } SEAM(4);
    if (IN(6)) { phase_rwkv_prep(F);
        const bool stream_first = (F.vcu & 1) != 0;
        if (stream_first) phase_sample_stream(F); else phase_scan1_mfma(F);
        __syncthreads();
        phase_attn_prompt(F);
        if (!stream_first) phase_sample_stream(F); else phase_scan1_mfma(F); } SEAM(7);
    if (IN(8)) {
        if (F.wave < 2) for (int t = F.vcu * 2 + F.wave; t < DBAT * HB * 4; t += 2 * F.G) scan_wave<false, true>(F, t >> 2, 0, t & 3);
        phase_scan2(F); } SEAM(8);
    if (IN(10)) { size_t ci = (size_t)F.vcu * NTHR + F.tid; const size_t istr = (size_t)F.G * NTHR; phase_scan3_post(F, ci, istr); phase_postscan(F, ci, istr); } SEAM(10);
    if (IN(11)) { pg8::Gemm g{WSP(bf16, WS_OAB), WSP(bf16, WS_WOUT), MP, DM, DM, DM, DM}; pg8::MixOrder<false> S; S.init(DM, DM, F.G, (int)blockIdx.x); pg8::EpiF32S<64> E{WSP(bf16, WS_OUT), DM, nullptr, WSP(float, WS_PART)};
        pg8::gemm_phase<pg8::EpiF32S<64>, pg8::MixOrder<false>, true, true>(F.lds, g, S, E); } SEAM(11);
    if (IN(12)) { phase_postmix<0>(F); } SEAM(12);
    if (IN(13)) { pg8::Gemm g{WSP(bf16, WS_H), WSP(bf16, WS_W1), MP, DFF, DM, DM, DM}; pg8::MixOrder<false> S; S.init(DFF, DM, F.G, (int)blockIdx.x); pg8::EpiRelu2 E{WSP(bf16, WS_U), DFF, WSP(float, WS_PARTU)};
        pg8::gemm_phase<pg8::EpiRelu2, pg8::MixOrder<false>, true, true>(F.lds, g, S, E); } SEAM(13);
    if (IN(14)) { phase_usample(F); if (!MK_SPLIT) xcd_barrier(bar); pg8::Gemm g{WSP(bf16, WS_U), WSP(bf16, WS_W2), MP, DM, DFF, DFF, DFF}; pg8::MixOrder<false> S; S.init(DM, DFF, F.G, (int)blockIdx.x); pg8::EpiF32S<64> E{WSP(bf16, WS_OUT), DM, nullptr, WSP(float, WS_PART)};
        pg8::gemm_phase<pg8::EpiF32S<64>, pg8::MixOrder<false>, true, true>(F.lds, g, S, E); } SEAM(14);
    if (IN(15)) { phase_postmlp<0>(F); } SEAM(15);
    if (IN(16)) { pg8::Gemm g{WSP(bf16, WS_H), WSP(bf16, WS_WPOOL), MP, DM, DM, DM, DM}; pg8::MixOrder<true> S; S.init(DM, DM, F.G, (int)blockIdx.x); pg8::EpiF32S<256> E{WSP(bf16, WS_OUT), DM, F.in(I_PSC), WSP(float, WS_PART)};
        pg8::gemm_phase<pg8::EpiF32S<256>, pg8::MixOrder<true>, true, true>(F.lds, g, S, E); } SEAM(16);
    if (IN(17)) { phase_postmix<1>(F); } SEAM(17);
    if (IN(18)) { pg8::Gemm g{WSP(bf16, WS_H), WSP(bf16, WS_W1) + (size_t)DFF * DM, MP, DFF, DM, DM, DM}; pg8::MixOrder<false> S; S.init(DFF, DM, F.G, (int)blockIdx.x); pg8::EpiRelu2 E{WSP(bf16, WS_U), DFF, WSP(float, WS_PARTU)};
        pg8::gemm_phase<pg8::EpiRelu2, pg8::MixOrder<false>, true, true>(F.lds, g, S, E); } SEAM(18);
    if (IN(19)) { phase_usample(F); if (!MK_SPLIT) xcd_barrier(bar); pg8::Gemm g{WSP(bf16, WS_U), WSP(bf16, WS_W2) + (size_t)DM * DFF, MP, DM, DFF, DFF, DFF}; pg8::MixOrder<false> S; S.init(DM, DFF, F.G, (int)blockIdx.x); pg8::EpiF32S<64> E{WSP(bf16, WS_OUT), DM, nullptr, WSP(float, WS_PART)};
        pg8::gemm_phase<pg8::EpiF32S<64>, pg8::MixOrder<false>, true, true>(F.lds, g, S, E); } SEAM(19);
    if (IN(20)) { phase_postmlp<1>(F); }
#undef IN
#undef SEAM
}

extern "C" void kernel_launch(void* const* d_in, const int* in_sizes, int n_in, void* d_out, int out_size, void* d_ws, size_t ws_size, hipStream_t stream) {
    static int grid = 0;
    if (grid == 0) {
        if (n_in != N_IN || (size_t)out_size != O_END || ws_size < WS_END) { fprintf(stderr, "kernel_launch: unexpected shapes: n_in %d out %d ws %zu (want %d, %zu, >= %zu)\n", n_in, out_size, ws_size, (int)N_IN, (size_t)O_END, (size_t)WS_END); grid = -1; return; }
        int dev = 0, cus = 0, per_cu = 0;
        if (hipGetDevice(&dev) != hipSuccess || hipDeviceGetAttribute(&cus, hipDeviceAttributeMultiprocessorCount, dev) != hipSuccess) { grid = -1; return; }
        if (hipFuncSetAttribute((const void*)mega_fwd, hipFuncAttributeMaxDynamicSharedMemorySize, LDS_BYTES) != hipSuccess) { fprintf(stderr, "kernel_launch: hipFuncSetAttribute failed\n"); grid = -1; return; }
        if (hipOccupancyMaxActiveBlocksPerMultiprocessor(&per_cu, (const void*)mega_fwd, NTHR, LDS_BYTES) != hipSuccess || per_cu < 1) fprintf(stderr, "kernel_launch: occupancy query reports %d blocks per CU\n", per_cu);
        (void)hipGetLastError();
        grid = cus;
    }
    if (grid < 0) return;
    hipMemsetAsync((char*)d_ws + WS_CTL, 0, CTL_ZERO_BYTES, stream);
    Args a{};
    for (int i = 0; i < N_IN; ++i) a.in[i] = d_in[i];
    a.out = (float*)d_out; a.ws = (unsigned char*)d_ws;
#if MK_SPLIT
    for (int p = 0; p < NPHASE; ++p) { a.ph_lo = p; a.ph_hi = p + 1; hipLaunchKernelGGL(mega_fwd, dim3(grid), dim3(NTHR), LDS_BYTES, stream, a); }
#else
    a.ph_lo = 0; a.ph_hi = NPHASE;
    hipLaunchKernelGGL(mega_fwd, dim3(grid), dim3(NTHR), LDS_BYTES, stream, a);
#endif
    const hipError_t le = hipPeekAtLastError();
    if (le != hipSuccess) fprintf(stderr, "kernel_launch: launch failed: %s\n", hipGetErrorName(le));
}
```

```cpp
#include <hip/hip_runtime.h>
#include <cstdio>
#include <cstdint>
namespace pg8 {
#define PG8_LAS __attribute__((address_space(3)))
typedef unsigned short bf16_t;
typedef short bf16x8 __attribute__((ext_vector_type(8)));
typedef float f32x4 __attribute__((ext_vector_type(4)));
typedef unsigned u32x4 __attribute__((ext_vector_type(4)));
constexpr int BM = 256, BK = 64, HALF = 128, HTB = HALF * BK * 2  , STAGE_BYTES = 8 * HTB, NXCD = 8, WGM = 8;

__host__ __device__ __forceinline__ int lds_byte(int r, int c) { const int st = (r >> 4) * 2 + (c >> 5), rr = r & 15, cc = c & 31, ob = rr * 64 + cc * 2; return st * 1024 + (ob ^ (((ob >> 9) & 1) << 5)); }
__host__ __device__ __forceinline__ void stage_rc(int b, int& R, int& C) { const int st = b / 1024, sb = b % 1024, swz = sb ^ (((sb >> 9) & 1) << 5); R = (st >> 1) * 16 + swz / 64; C = (st & 1) * 32 + (swz % 64) / 2; }
__host__ __device__ __forceinline__ int perm32(int rho) { const int n = rho >> 4, i = rho & 15; return 8 * (i >> 2) + 4 * n + (i & 3); }

struct Unit { int pm, pn, kc; };
struct Gemm { const bf16_t* A; const bf16_t* Bt; int M, N, K, lda, ldb; };

struct StaticOrder {
    int nM, nN, nwg, G, c;
    __host__ __device__ void init(int M, int N, int G_, int c_) { nM = M / BM; nN = N / BM; nwg = nM * nN; G = G_; c = c_; }
    __host__ __device__ bool next(int i, Unit& u) const {
        const long L = (long)i * G + c; if (L >= nwg) return false;
        int wgid = (int)L; { const int q = nwg / NXCD, r = nwg % NXCD, xcd = wgid % NXCD, off = wgid / NXCD; wgid = (xcd < r ? xcd * (q + 1) : r * (q + 1) + (xcd - r) * q) + off; }
        const int nig = WGM * nN, gid = wgid / nig, fm = gid * WGM, gsz = (nM - fm) < WGM ? (nM - fm) : WGM;
        u.pm = fm + ((wgid % nig) % gsz); u.pn = (wgid % nig) / gsz; u.kc = -1; return true;
    }
    __device__ __forceinline__ int nt(const Unit&, const Gemm& g) const { return g.K / BK; }
    __device__ __forceinline__ void a_ready(const Unit&) const {}
    __device__ __forceinline__ void done(const Unit&) const {}
    __device__ __forceinline__ size_t a_off(const Unit& u, const Gemm& g) const { return (size_t)u.pm * BM * g.lda * 2; }
    __device__ __forceinline__ size_t b_off(const Unit& u, const Gemm& g) const { return (size_t)u.pn * BM * g.ldb * 2; }
};
struct LoraOrder : StaticOrder {
    __device__ __forceinline__ int k0(const Unit& u) const { return u.pn < 4 ? 0 : (u.pn < 8 ? 64 : 192); }
    __device__ __forceinline__ int nt(const Unit& u, const Gemm&) const { return u.pn < 8 ? 2 : 4; }
    __device__ __forceinline__ size_t a_off(const Unit& u, const Gemm& g) const { return (size_t)u.pm * BM * g.lda * 2 + (size_t)k0(u) * 2; }
    __device__ __forceinline__ size_t b_off(const Unit& u, const Gemm& g) const { return (size_t)u.pn * BM * g.ldb * 2 + (size_t)k0(u) * 2; }
};
__device__ __forceinline__ unsigned cvt_pk_bf16(float lo, float hi) { unsigned r; asm volatile("v_cvt_pk_bf16_f32 %0, %1, %2" : "=v"(r) : "v"(lo), "v"(hi)); return r; }

struct EpiF32 {
    static constexpr bool PERM = false, AFTER_DRAIN = false;
    float* C; int ldc; const float* cscale;
    __device__ __forceinline__ void operator()(const f32x4 (&acc)[2][2][4][2], const Unit& u, int wr, int wc, int fr, int fq) const {
        const int row0 = u.pm * BM + wr * 64 + fr, col0 = u.pn * BM + wc * 32 + 4 * fq;
        f32x4 sv[2][2];
#pragma unroll
        for (int bj = 0; bj < 2; ++bj)
#pragma unroll
            for (int n = 0; n < 2; ++n) sv[bj][n] = cscale ? *(const f32x4*)(cscale + col0 + bj * HALF + n * 16) : (f32x4){1.f, 1.f, 1.f, 1.f};
#pragma unroll
        for (int ai = 0; ai < 2; ++ai)
#pragma unroll
            for (int m = 0; m < 4; ++m) { float* rowp = C + (size_t)(row0 + ai * HALF + m * 16) * ldc + col0;
#pragma unroll
                for (int bj = 0; bj < 2; ++bj)
#pragma unroll
                    for (int n = 0; n < 2; ++n) *(f32x4*)(rowp + bj * HALF + n * 16) = acc[ai][bj][m][n] * sv[bj][n]; }
    }
};
typedef unsigned u32x2h __attribute__((ext_vector_type(2)));
struct EpiLora {
    static constexpr bool PERM = false, AFTER_DRAIN = false;
    float* C; bf16_t* H; int ldc;
    __device__ __forceinline__ void operator()(const f32x4 (&acc)[2][2][4][2], const Unit& u, int wr, int wc, int fr, int fq) const {
        const int row0 = u.pm * BM + wr * 64 + fr, col0 = u.pn * BM + wc * 32 + 4 * fq;
#pragma unroll
        for (int ai = 0; ai < 2; ++ai)
#pragma unroll
            for (int m = 0; m < 4; ++m) { const size_t ro = (size_t)(row0 + ai * HALF + m * 16) * ldc + col0;
#pragma unroll
                for (int bj = 0; bj < 2; ++bj)
#pragma unroll
                    for (int n = 0; n < 2; ++n) { const f32x4 v = acc[ai][bj][m][n];
                        if (u.pm < 32) { u32x2h w; w.x = cvt_pk_bf16(v[0], v[1]); w.y = cvt_pk_bf16(v[2], v[3]); *(u32x2h*)(H + ro + bj * HALF + n * 16) = w; }
                        else *(f32x4*)(C + ro + bj * HALF + n * 16) = v; } }
    }
};
struct EpiRelu2 {
    static constexpr bool PERM = true, AFTER_DRAIN = false;
    bf16_t* O; int ldc; float* PART;
    __device__ __forceinline__ void operator()(const f32x4 (&acc)[2][2][4][2], const Unit& u, int wr, int wc, int fr, int fq) const {
        const int row0 = u.pm * BM + wr * 64 + fr, col0 = u.pn * BM + wc * 32 + 8 * fq;
        if (u.kc >= 0) {
            if (wr == 0) {
#pragma unroll
                for (int m = 0; m < 4; ++m) { float* rowp = PART + ((size_t)u.kc * 64 + m * 16 + fr) * ldc + col0;
#pragma unroll
                    for (int bj = 0; bj < 2; ++bj) { *(f32x4*)(rowp + bj * HALF) = acc[0][bj][m][0]; *(f32x4*)(rowp + bj * HALF + 4) = acc[0][bj][m][1]; } } }
            return;
        }
#pragma unroll
        for (int ai = 0; ai < 2; ++ai)
#pragma unroll
            for (int m = 0; m < 4; ++m) { bf16_t* rowp = O + (size_t)(row0 + ai * HALF + m * 16) * ldc + col0;
#pragma unroll
                for (int bj = 0; bj < 2; ++bj) { f32x4 v0 = acc[ai][bj][m][0], v1 = acc[ai][bj][m][1];
#pragma unroll
                    for (int j = 0; j < 4; ++j) { const float a = v0[j] > 0.f ? v0[j] : 0.f, b = v1[j] > 0.f ? v1[j] : 0.f; v0[j] = a * a; v1[j] = b * b; }
                    u32x4 w; w.x = cvt_pk_bf16(v0[0], v0[1]); w.y = cvt_pk_bf16(v0[2], v0[3]); w.z = cvt_pk_bf16(v1[0], v1[1]); w.w = cvt_pk_bf16(v1[2], v1[3]);
                    *(u32x4*)(rowp + bj * HALF) = w; } }
    }
};
template <bool POOL> struct MixOrder {
    StaticOrder so; int nmain, nN, kdiv, ntot, G, c;
    __device__ void init(int N, int K, int G_, int c_) { nN = N / BM; so.init(32 * BM, N, G_, c_); nmain = 32 * nN; kdiv = (POOL ? 512 : K) / 256; ntot = nmain + nN * kdiv; G = G_; c = c_; }
    __device__ bool next(int i, Unit& u) const {
        const int L = i * G + c; if (L >= ntot) return false;
        if (L < nmain) return so.next(i, u);
        const int j = L - nmain; u.pm = 32; u.pn = j % nN; u.kc = j / nN; return true;
    }
    __device__ __forceinline__ int nt(const Unit& u, const Gemm& g) const { return u.kc >= 0 ? 4 : (POOL ? 8 : g.K / BK); }
    __device__ __forceinline__ size_t a_off(const Unit& u, const Gemm& g) const { return (size_t)u.pm * BM * g.lda * 2 + (size_t)((POOL ? (u.pn >> 1) * 512 : 0) + (u.kc >= 0 ? u.kc * 256 : 0)) * 2; }
    __device__ __forceinline__ size_t b_off(const Unit& u, const Gemm& g) const { return (size_t)u.pn * BM * g.ldb * 2 + (size_t)((POOL ? (u.pn >> 1) * 512 : 0) + (u.kc >= 0 ? u.kc * 256 : 0)) * 2; }
    __device__ __forceinline__ void a_ready(const Unit&) const {}
    __device__ __forceinline__ void done(const Unit&) const {}
};
template <int PROW> struct EpiF32S {
    static constexpr bool PERM = false, AFTER_DRAIN = false;
    bf16_t* C; int ldc; const float* cscale; float* PART;
    __device__ __forceinline__ f32x4 scl(int c) const { return cscale ? *(const f32x4*)(cscale + c) : (f32x4){1.f, 1.f, 1.f, 1.f}; }
    __device__ __forceinline__ void operator()(const f32x4 (&acc)[2][2][4][2], const Unit& u, int wr, int wc, int fr, int fq) const {
        asm volatile("" : "+v"(fr), "+v"(fq));
        const int col0 = u.pn * BM + wc * 32 + 4 * fq;
        if (u.kc < 0) {
            bf16_t* Ct = C + (size_t)u.pm * BM * ldc; const unsigned e0 = (unsigned)((wr * 64 + fr) * ldc + col0);
#pragma unroll
            for (int bj = 0; bj < 2; ++bj)
#pragma unroll
                for (int n = 0; n < 2; ++n) { const f32x4 sv = scl(col0 + bj * HALF + n * 16);
#pragma unroll
                    for (int ai = 0; ai < 2; ++ai)
#pragma unroll
                        for (int m = 0; m < 4; ++m) { const f32x4 v = acc[ai][bj][m][n] * sv; const unsigned w0 = cvt_pk_bf16(v[0], v[1]), w1 = cvt_pk_bf16(v[2], v[3]);
                            *(unsigned long long*)(Ct + e0 + (unsigned)((ai * HALF + m * 16) * ldc) + bj * HALF + n * 16) = (unsigned long long)w0 | ((unsigned long long)w1 << 32); } }
        } else if (PROW == 256) {
            float* Pk = PART + (size_t)u.kc * 256 * ldc; const unsigned e0 = (unsigned)((wr * 64 + fr) * ldc + col0);
#pragma unroll
            for (int bj = 0; bj < 2; ++bj)
#pragma unroll
                for (int n = 0; n < 2; ++n) { const f32x4 sv = scl(col0 + bj * HALF + n * 16);
#pragma unroll
                    for (int ai = 0; ai < 2; ++ai)
#pragma unroll
                        for (int m = 0; m < 4; ++m) *(f32x4*)(Pk + e0 + (unsigned)((ai * HALF + m * 16) * ldc) + bj * HALF + n * 16) = acc[ai][bj][m][n] * sv; }
        } else if (wr == 0) {
            float* Pk = PART + (size_t)u.kc * 64 * ldc; const unsigned e0 = (unsigned)(fr * ldc + col0);
#pragma unroll
            for (int bj = 0; bj < 2; ++bj)
#pragma unroll
                for (int n = 0; n < 2; ++n) { const f32x4 sv = scl(col0 + bj * HALF + n * 16);
#pragma unroll
                    for (int m = 0; m < 4; ++m) *(f32x4*)(Pk + e0 + (unsigned)(m * 16 * ldc) + bj * HALF + n * 16) = acc[0][bj][m][n] * sv; }
        }
    }
};
template <class Epi, class Sched, bool ALIGN_EPI = false, bool SP2 = false>
__device__ __forceinline__ void gemm_phase(PG8_LAS unsigned char* lds, const Gemm g, const Sched& S, const Epi& E) {
    const int tid = threadIdx.x, wid = __builtin_amdgcn_readfirstlane(tid >> 6), lane = tid & 63, wr = wid >> 2, wc = wid & 3, fr = lane & 15, fq = lane >> 4;
    unsigned voffA[2], voffB[2];
#pragma unroll
    for (int i = 0; i < 2; ++i) { int R, C; stage_rc(tid * 16 + i * 8192, R, C); const int Rb = Epi::PERM ? ((R & ~31) + perm32(R & 31)) : R;
        voffA[i] = (unsigned)(R * g.lda + C) * 2u; voffB[i] = (unsigned)(Rb * g.ldb + C) * 2u; }
    const size_t kstep = (size_t)(BK * 2);
    const size_t hsA = (size_t)HALF * g.lda * 2, hsB = (size_t)HALF * g.ldb * 2;
    const unsigned ldsw = (unsigned)wid * 1024u;
    const int aoff = lds_byte(wr * 64 + fr, fq * 8), boff = lds_byte(wc * 32 + fr, fq * 8);
#define PG8_SA(b, h) (((b) * 2 + (h)) * HTB)
#define PG8_SB(b, h) ((4 + (b) * 2 + (h)) * HTB)
#define PG8_STAGE(bufoff, gbase, voff) do { _Pragma("unroll") for (int _i = 0; _i < 2; ++_i) \
        __builtin_amdgcn_global_load_lds((const unsigned*)((const char*)(gbase) + (voff)[_i]), (PG8_LAS unsigned*)(lds + (bufoff) + ldsw + _i * 8192), 16, 0, 0); } while (0)
#define PG8_LDA(dst, b, h) do { _Pragma("unroll") for (int m = 0; m < 4; ++m) _Pragma("unroll") for (int k = 0; k < 2; ++k) dst[m][k] = *(const PG8_LAS bf16x8*)(lds + PG8_SA(b, h) + aoff + m * 2048 + k * 1024); } while (0)
#define PG8_LDB(dst, b, h) do { _Pragma("unroll") for (int n = 0; n < 2; ++n) _Pragma("unroll") for (int k = 0; k < 2; ++k) dst[n][k] = *(const PG8_LAS bf16x8*)(lds + PG8_SB(b, h) + boff + n * 2048 + k * 1024); } while (0)
#define PG8_MMA(ai, bj, At, Bt) do { __builtin_amdgcn_s_setprio(1); _Pragma("unroll") for (int m = 0; m < 4; ++m) _Pragma("unroll") for (int n = 0; n < 2; ++n) _Pragma("unroll") for (int k = 0; k < 2; ++k) \
        acc[ai][bj][m][n] = __builtin_amdgcn_mfma_f32_16x16x32_bf16(Bt[n][k], At[m][k], acc[ai][bj][m][n], 0, 0, 0); __builtin_amdgcn_s_setprio(0); } while (0)
#define PG8_WAIT_V(n) asm volatile("s_waitcnt vmcnt(" #n ")" ::: "memory")
#define PG8_WAIT_L(n) asm volatile("s_waitcnt lgkmcnt(" #n ")" ::: "memory")
#define PG8_BAR __builtin_amdgcn_s_barrier()
#define PG8_SCHED __builtin_amdgcn_sched_barrier(0)
    Unit cur, nxt; int ui = 0;
    if (!S.next(0, cur)) return;
    int nt = S.nt(cur, g);
    f32x4 acc[2][2][4][2];
#pragma unroll
    for (int a = 0; a < 2; ++a)
#pragma unroll
        for (int b = 0; b < 2; ++b)
#pragma unroll
            for (int m = 0; m < 4; ++m)
#pragma unroll
                for (int n = 0; n < 2; ++n) acc[a][b][m][n] = (f32x4){0.f, 0.f, 0.f, 0.f};
    bf16x8 At[4][2], B0[2][2], B1[2][2];
    const char* cA = (const char*)g.A + S.a_off(cur, g); const char* cB = (const char*)g.Bt + S.b_off(cur, g);
    S.a_ready(cur);
    if constexpr (SP2) {
        PG8_STAGE(PG8_SB(0, 0), cB, voffB); PG8_STAGE(PG8_SB(0, 1), cB + hsB, voffB); PG8_STAGE(PG8_SA(0, 0), cA, voffA); PG8_STAGE(PG8_SA(0, 1), cA + hsA, voffA);
        if (wr == 1) PG8_BAR;
        PG8_WAIT_V(2); PG8_BAR;
        PG8_STAGE(PG8_SB(1, 0), cB + kstep, voffB); PG8_STAGE(PG8_SA(1, 0), cA + kstep, voffA); PG8_STAGE(PG8_SB(1, 1), cB + hsB + kstep, voffB);
        PG8_WAIT_V(6); PG8_BAR;
    } else {
        PG8_STAGE(PG8_SB(0, 0), cB, voffB); PG8_STAGE(PG8_SA(0, 0), cA, voffA); PG8_STAGE(PG8_SB(0, 1), cB + hsB, voffB); PG8_STAGE(PG8_SA(0, 1), cA + hsA, voffA);
        if (wr == 1) PG8_BAR;
        PG8_WAIT_V(4); PG8_BAR;
        PG8_STAGE(PG8_SB(1, 0), cB + kstep, voffB); PG8_STAGE(PG8_SA(1, 0), cA + kstep, voffA); PG8_STAGE(PG8_SB(1, 1), cB + hsB + kstep, voffB);
        PG8_WAIT_V(6); PG8_BAR;
    }
    for (;;) {
        const bool has_next = S.next(ui + 1, nxt);
        const char* nA = has_next ? (const char*)g.A + S.a_off(nxt, g) : cA; const char* nB = has_next ? (const char*)g.Bt + S.b_off(nxt, g) : cB;
        for (int t = 0; t < nt; t += 2) {
            const bool last = (t == nt - 2);
            const char* a1 = cA + (size_t)(t + 1) * kstep;
            const char* a2 = last ? nA : cA + (size_t)(t + 2) * kstep; const char* b2 = last ? nB : cB + (size_t)(t + 2) * kstep;
            const char* a3 = a2 + kstep; const char* b3 = b2 + kstep;
            if (last && has_next) S.a_ready(nxt);
            if constexpr (SP2) {
            PG8_LDB(B0, 0, 0); PG8_LDB(B1, 0, 1); PG8_SCHED; PG8_LDA(At, 0, 0); PG8_STAGE(PG8_SA(1, 1), a1 + hsA, voffA);
            PG8_WAIT_V(8); PG8_WAIT_L(0); PG8_BAR; PG8_MMA(0, 0, At, B0); PG8_MMA(0, 1, At, B1); PG8_BAR; PG8_SCHED;
            PG8_LDA(At, 0, 1); PG8_STAGE(PG8_SB(0, 0), b2, voffB); PG8_STAGE(PG8_SB(0, 1), b2 + hsB, voffB); PG8_STAGE(PG8_SA(0, 0), a2, voffA);
            PG8_WAIT_V(8); PG8_WAIT_L(0); PG8_BAR; PG8_MMA(1, 0, At, B0); PG8_MMA(1, 1, At, B1); PG8_BAR; PG8_SCHED;
            PG8_LDB(B0, 1, 0); PG8_LDB(B1, 1, 1); PG8_SCHED; PG8_LDA(At, 1, 0); PG8_STAGE(PG8_SA(0, 1), a2 + hsA, voffA);
            PG8_WAIT_V(8); PG8_WAIT_L(0); PG8_BAR; PG8_MMA(0, 0, At, B0); PG8_MMA(0, 1, At, B1); PG8_BAR; PG8_SCHED;
            PG8_LDA(At, 1, 1); PG8_STAGE(PG8_SB(1, 0), b3, voffB); PG8_STAGE(PG8_SB(1, 1), b3 + hsB, voffB); PG8_STAGE(PG8_SA(1, 0), a3, voffA);
            PG8_WAIT_V(8); PG8_WAIT_L(0); PG8_BAR; PG8_MMA(1, 0, At, B0); PG8_MMA(1, 1, At, B1); PG8_BAR; PG8_SCHED;
            } else {
            PG8_LDB(B0, 0, 0); PG8_SCHED; PG8_LDA(At, 0, 0); PG8_STAGE(PG8_SA(1, 1), a1 + hsA, voffA);
            PG8_WAIT_L(8); PG8_BAR; PG8_WAIT_L(0); PG8_MMA(0, 0, At, B0); PG8_BAR; PG8_SCHED;
            PG8_LDB(B1, 0, 1); PG8_STAGE(PG8_SB(0, 0), b2, voffB);
            PG8_BAR; PG8_WAIT_L(0); PG8_MMA(0, 1, At, B1); PG8_BAR;
            PG8_LDA(At, 0, 1); PG8_STAGE(PG8_SA(0, 0), a2, voffA);
            PG8_BAR; PG8_WAIT_L(0); PG8_MMA(1, 0, At, B0); PG8_BAR; PG8_SCHED;
            PG8_STAGE(PG8_SB(0, 1), b2 + hsB, voffB);
            PG8_WAIT_V(6); PG8_BAR; PG8_MMA(1, 1, At, B1); PG8_BAR;
            PG8_LDB(B0, 1, 0); PG8_SCHED; PG8_LDA(At, 1, 0); PG8_STAGE(PG8_SA(0, 1), a2 + hsA, voffA);
            PG8_WAIT_L(8); PG8_BAR; PG8_WAIT_L(0); PG8_MMA(0, 0, At, B0); PG8_BAR; PG8_SCHED;
            PG8_LDB(B1, 1, 1); PG8_STAGE(PG8_SB(1, 0), b3, voffB);
            PG8_BAR; PG8_WAIT_L(0); PG8_MMA(0, 1, At, B1); PG8_BAR;
            PG8_LDA(At, 1, 1); PG8_STAGE(PG8_SA(1, 0), a3, voffA);
            PG8_BAR; PG8_WAIT_L(0); PG8_MMA(1, 0, At, B0); PG8_BAR; PG8_SCHED;
            PG8_STAGE(PG8_SB(1, 1), b3 + hsB, voffB);
            PG8_WAIT_V(6); PG8_BAR; PG8_MMA(1, 1, At, B1); PG8_BAR;
            }
        }
        if constexpr (ALIGN_EPI) { if (wr == 0) PG8_BAR; }
        if constexpr (!Epi::AFTER_DRAIN) { E(acc, cur, wr, wc, fr, fq); S.done(cur); }
        if (!has_next) break;
#pragma unroll
        for (int a = 0; a < 2; ++a)
#pragma unroll
            for (int b = 0; b < 2; ++b)
#pragma unroll
                for (int m = 0; m < 4; ++m)
#pragma unroll
                    for (int n = 0; n < 2; ++n) acc[a][b][m][n] = (f32x4){0.f, 0.f, 0.f, 0.f};
        cur = nxt; cA = nA; cB = nB; ++ui; nt = S.nt(cur, g);
        if constexpr (ALIGN_EPI) { if (wr == 1) PG8_BAR; }
    }
    PG8_WAIT_V(0);
    if constexpr (!ALIGN_EPI) { if (wr == 0) PG8_BAR; }
    PG8_BAR;
    if constexpr (Epi::AFTER_DRAIN) { E.fused(acc, cur, wr, wc, fr, fq, lds, wid, lane); S.done(cur); }
#undef PG8_SA
#undef PG8_SB
#undef PG8_STAGE
#undef PG8_LDA
#undef PG8_LDB
#undef PG8_MMA
#undef PG8_WAIT_V
#undef PG8_WAIT_L
#undef PG8_BAR
#undef PG8_SCHED
}
}

constexpr int DM = 2048, SEQ = 4096, NBATCH = 2, NPR = NBATCH * SEQ, DBAT = 8, DSEQ = 8, NSM = DBAT * DSEQ, NTOK = NPR + NSM, MP = 8448;
constexpr int HA = 8, DHA = 128, HB = 16, DHB = 64, DBR = 1024;
constexpr int BCOLS = 3520, INCOLS = 6592, INPAD = 6656, DFF = 8192, NPAGES = 128, PAGESZ = 128, PAST = 16384, PBUF = 15, NMR = 10;
constexpr float EPS_RMS = 1e-6f, EPS_LNX = 64e-5f, QK_SCALE = 0.08838834764831845f;
enum { I_XP = 0, I_XS, I_CK, I_CV, I_PT, I_SWKV, I_SSH, I_SPOOL, I_CP, I_CS, I_WADA, I_BADA, I_NG, I_WIN, I_WOUT, I_SBB, I_MU, I_W0, I_WUP, I_A0, I_AUP, I_GUP, I_KK, I_KA, I_RK, I_LNG, I_LNB, I_WPOOL, I_PSC, I_W1, I_W2, N_IN };
constexpr size_t O_YP = 0, O_YS = O_YP + (size_t)NPR * DM, O_KP = O_YS + (size_t)NSM * DM, O_VP = O_KP + (size_t)NPR * 1024, O_KS = O_VP + (size_t)NPR * 1024, O_VS = O_KS + (size_t)NSM * 1024,
                 O_WKVP = O_VS + (size_t)NSM * 1024, O_WKVS = O_WKVP + (size_t)NBATCH * HB * 64 * 64, O_SHP = O_WKVS + (size_t)DBAT * HB * 64 * 64, O_SHS = O_SHP + (size_t)NBATCH * BCOLS,
                 O_PLP = O_SHS + (size_t)DBAT * BCOLS, O_PLS = O_PLP + (size_t)NBATCH * PBUF * DM, O_END = O_PLS + (size_t)DBAT * PBUF * DM;
constexpr size_t MiB = 1u << 20;
constexpr size_t WS_CTL = 0, CTL_ZERO_BYTES = 64 * 1024, WS_MOD = 1 * MiB, WS_WIN = 2 * MiB, WS_WOUT = 28 * MiB, WS_W1 = 36 * MiB, WS_W2 = 100 * MiB, WS_WPOOL = 164 * MiB,
                 WS_H = 172 * MiB, WS_OAB = 205 * MiB, WS_M = 238 * MiB, WS_P = 271 * MiB, WS_OUT = 486 * MiB, WS_XR = 552 * MiB, WS_HF = 617 * MiB, WS_U = 682 * MiB,
                 WS_RWV = 814 * MiB, WS_SCL = 1072 * MiB, WS_G = 1075 * MiB, WS_Y = 1108 * MiB, WS_PU = 1141 * MiB, WS_Z = 1205 * MiB, WS_SC = 1237 * MiB, WS_QB = 1269 * MiB, WS_KB = 1286 * MiB, WS_VB = 1303 * MiB, WS_OP = 1320 * MiB, WS_CL = 1384 * MiB, WS_SPART = 1385 * MiB, WS_SCAR = 1394 * MiB, WS_LA = 1395 * MiB, WS_LWT = 1404 * MiB, WS_LWO = 1408 * MiB, WS_YC = 1508 * MiB, WS_PART = 1541 * MiB, WS_PARTU = 1558 * MiB, WS_END = 1575 * MiB;
static_assert(WS_WIN + (size_t)INPAD * DM * 2 <= WS_WOUT && WS_P + (size_t)MP * INPAD * 4 <= WS_OUT && WS_U + (size_t)MP * DFF * 2 <= WS_RWV && WS_RWV + (size_t)NTOK * HB * 512 * 4 <= WS_SCL, "ws map");
constexpr int CW_BAR = 4096;
constexpr int RING_BYTES = 131072, LDSCTL_OFF = RING_BYTES, MISC_OFF = LDSCTL_OFF + 320, LDS_BYTES = 147456;
constexpr int NWAVES = 8, NTHR = 512;

#define GAS __attribute__((address_space(1)))
#define LAS __attribute__((address_space(3)))
typedef unsigned short bf16;
__device__ __forceinline__ float ldbf(const bf16* p) { return __uint_as_float((unsigned)*p << 16); }
__device__ __forceinline__ float ldbf_nt(const bf16* p) { return __uint_as_float((unsigned)__builtin_nontemporal_load(p) << 16); }
typedef float f32x4 __attribute__((ext_vector_type(4)));
typedef float f32x2 __attribute__((ext_vector_type(2)));
typedef unsigned u32x2 __attribute__((ext_vector_type(2)));
typedef unsigned u32x4 __attribute__((ext_vector_type(4)));
#define LDS_WAIT() asm volatile("s_waitcnt lgkmcnt(0)" ::: "memory")
#define VM_WAIT() asm volatile("s_waitcnt vmcnt(0)" ::: "memory")
using pg8::cvt_pk_bf16;
constexpr size_t WS_PBH = WS_RWV, WS_LWH = WS_RWV + 64 * MiB;
static_assert((size_t)NPR * 3072 * 2 <= 64 * MiB && 128 * MiB <= (size_t)NPR * HB * 512 * 4, "bf16 prompt copies fit below the sample rows of RWV");
constexpr int PBLD = 3584;
struct EpiIn {
    static constexpr bool PERM = false, AFTER_DRAIN = false;
    bf16 *QB, *KB, *VB; float* PB; float* out; bf16* PBH;
    __device__ __forceinline__ void operator()(const pg8::f32x4 (&acc)[2][2][4][2], const pg8::Unit& u, int wr, int wc, int fr, int fq) const {
        const int row0 = u.pm * 256 + wr * 64 + fr, colt = u.pn * 256 + wc * 32 + 4 * fq;
        if (u.pn >= 12) {
#pragma unroll
            for (int ai = 0; ai < 2; ++ai)
#pragma unroll
                for (int m = 0; m < 4; ++m) {
                    if (u.pm < 32 && u.pn < 24) { bf16* rowh = PBH + (size_t)(row0 + ai * 128 + m * 16) * 3072 + (colt - 3072);
#pragma unroll
                        for (int bj = 0; bj < 2; ++bj)
#pragma unroll
                            for (int n = 0; n < 2; ++n) { const pg8::f32x4 v = acc[ai][bj][m][n]; u32x2 w; w.x = cvt_pk_bf16(v[0], v[1]); w.y = cvt_pk_bf16(v[2], v[3]); *(u32x2*)(rowh + bj * 128 + n * 16) = w; } }
                    else { float* rowp = PB + (size_t)(row0 + ai * 128 + m * 16) * PBLD + (colt - 3072);
#pragma unroll
                        for (int bj = 0; bj < 2; ++bj)
#pragma unroll
                            for (int n = 0; n < 2; ++n) *(pg8::f32x4*)(rowp + bj * 128 + n * 16) = acc[ai][bj][m][n]; } }
        } else {
            const int sel = u.pn >> 2, c0 = colt - sel * 1024;
            static_assert(WS_KB - WS_QB == WS_VB - WS_KB && O_VP - O_KP == (size_t)NPR * 1024 && O_VS - O_KS == (size_t)NSM * 1024, "q/k/v buffers are equally spaced");
            bf16* Bt = QB + (size_t)sel * ((WS_KB - WS_QB) / 2) + (size_t)u.pm * 256 * 1024;
            float* Ot = u.pm < 32 ? out + O_KP + (size_t)(sel ? sel - 1 : 0) * NPR * 1024 + (size_t)u.pm * 256 * 1024 : out + O_KS + (size_t)(sel ? sel - 1 : 0) * NSM * 1024;
            const int rl0 = wr * 64 + fr;
#pragma unroll
            for (int ai = 0; ai < 2; ++ai)
#pragma unroll
                for (int m = 0; m < 4; ++m) { const int rl = rl0 + ai * 128 + m * 16; const unsigned eo = (unsigned)(rl * 1024 + c0);
                    const bool wo = sel != 0 && (u.pm < 32 || rl < NSM);
#pragma unroll
                    for (int bj = 0; bj < 2; ++bj)
#pragma unroll
                        for (int n = 0; n < 2; ++n) { const pg8::f32x4 v = acc[ai][bj][m][n]; u32x2 w; w.x = cvt_pk_bf16(v[0], v[1]); w.y = cvt_pk_bf16(v[2], v[3]);
                            *(u32x2*)(Bt + eo + bj * 128 + n * 16) = w; if (wo) *(pg8::f32x4*)(Ot + eo + bj * 128 + n * 16) = v; }
                    asm volatile("" ::: "memory"); }
        }
    }
};

#define XB_TMO      128
#define XB_XCNT(j)  (256  + 64 * (j))
#define XB_XSUB(j)  (1280 + 64 * (j))
#define XB_XGEN(j)  (2304 + 64 * (j))
#define XB_TOP      3328
#define XB_TOPGEN   3392
#define XCD_BAR_WORDS 3456
#define XB_SPIN_CAP (1u << 18)

__device__ __forceinline__ unsigned xb_ld(unsigned* p)              { return __hip_atomic_load(p, __ATOMIC_RELAXED, __HIP_MEMORY_SCOPE_AGENT); }
__device__ __forceinline__ unsigned xb_add(unsigned* p, unsigned v) { return __hip_atomic_fetch_add(p, v, __ATOMIC_RELAXED, __HIP_MEMORY_SCOPE_AGENT); }
__device__ __forceinline__ unsigned xb_xcc_id() { return (unsigned)__builtin_amdgcn_s_getreg((3 << 11) | 20) & 0xFu; }
#define XB_SPIN(cond, bar) do { unsigned _sp = 0; while (cond) { __builtin_amdgcn_s_sleep(1); \
    if ((++_sp & 255u) == 0u) { if (xb_ld(&(bar)[XB_TMO])) break; if (_sp > XB_SPIN_CAP) { atomicAdd(&(bar)[XB_TMO], 1u); break; } } } } while (0)

struct XcdBarrier {
    unsigned* bar; unsigned x;
    volatile LAS unsigned* st;
};

__device__ __forceinline__ XcdBarrier xcd_barrier_post(unsigned* bar, volatile LAS unsigned* st) {
    XcdBarrier b; b.bar = bar; b.x = xb_xcc_id(); b.st = st;
    if (threadIdx.x == 0) (void)xb_add(&bar[XB_XCNT(b.x)], 1u);
    return b;
}
__device__ __forceinline__ void xcd_barrier_complete(unsigned* bar, unsigned x, unsigned& nloc, unsigned& nx) {
    const unsigned G = gridDim.x * gridDim.y * gridDim.z;
    unsigned sum, cnt, mine, sp = 0u;
    for (;;) {
        sum = 0u; cnt = 0u; mine = 0u;
#pragma unroll
        for (unsigned j = 0; j < 16; ++j) { const unsigned c = xb_ld(&bar[XB_XCNT(j)]); sum += c; cnt += (c > 0u) ? 1u : 0u; mine = (j == x) ? c : mine; }
        if (sum == G) break;
        __builtin_amdgcn_s_sleep(1);
        if ((++sp & 255u) == 0u) { if (xb_ld(&bar[XB_TMO])) break; if (sp > XB_SPIN_CAP) { atomicAdd(&bar[XB_TMO], 1u); break; } }
    }
    nloc = mine > 0u ? mine : 1u; nx = cnt > 0u ? cnt : 1u;
}

__device__ __forceinline__ void xcd_barrier(const XcdBarrier& b) {
    asm volatile("s_waitcnt vmcnt(0)" ::: "memory");
    __syncthreads();
    if (threadIdx.x == 0) {
        unsigned* bar = b.bar;
        __builtin_amdgcn_s_waitcnt(0);
        unsigned nloc = b.st[0], nx = b.st[1];
        if (nloc == 0u) { xcd_barrier_complete(bar, b.x, nloc, nx); b.st[0] = nloc; b.st[1] = nx; }
        const unsigned old = xb_add(&bar[XB_XSUB(b.x)], 1u);
        const unsigned gen = old / nloc;
        if (old + 1u == (gen + 1u) * nloc) {
            __builtin_amdgcn_fence(__ATOMIC_RELEASE, "agent");
            asm volatile("s_waitcnt vmcnt(0)" ::: "memory");
            const unsigned og = xb_add(&bar[XB_TOP], 1u);
            const unsigned tg = og / nx;
            if (og + 1u == (tg + 1u) * nx) xb_add(&bar[XB_TOPGEN], 1u);
            else XB_SPIN(xb_ld(&bar[XB_TOPGEN]) == tg, bar);
            __builtin_amdgcn_fence(__ATOMIC_ACQUIRE, "agent");
            xb_add(&bar[XB_XGEN(b.x)], 1u);
            asm volatile("s_waitcnt vmcnt(0)" ::: "memory");
        } else {
            XB_SPIN(xb_ld(&bar[XB_XGEN(b.x)]) == gen, bar);
            __builtin_amdgcn_fence(__ATOMIC_ACQUIRE, "agent");
            asm volatile("s_waitcnt vmcnt(0)" ::: "memory");
        }
    }
    __syncthreads();
}


struct Ctx {
    LAS unsigned char* lds; int tid, lane, wave, vcu, G;
    __device__ __forceinline__ const float* in(int i) const { return ((const float* const __attribute__((address_space(4)))*)__builtin_amdgcn_kernarg_segment_ptr())[i]; }
    __device__ __forceinline__ float* outp() const { return ((float* const __attribute__((address_space(4)))*)__builtin_amdgcn_kernarg_segment_ptr())[N_IN]; }
    __device__ __forceinline__ unsigned char* wsp() const { return ((unsigned char* const __attribute__((address_space(4)))*)__builtin_amdgcn_kernarg_segment_ptr())[N_IN + 1]; }
};
template <int CTRL> __device__ __forceinline__ float dpp_f(float x) { return __builtin_bit_cast(float, __builtin_amdgcn_mov_dpp(__builtin_bit_cast(int, x), CTRL, 0xf, 0xf, true)); }
#define readlane_f(x, l) __builtin_bit_cast(float, __builtin_amdgcn_readlane(__builtin_bit_cast(int, (float)(x)), (l)))
__device__ __forceinline__ float wave_sum(float v) {
    v += dpp_f<0xB1>(v); v += dpp_f<0x4E>(v); v += dpp_f<0x141>(v); v += dpp_f<0x140>(v);
    auto s = __builtin_amdgcn_permlane16_swap(__float_as_uint(v), __float_as_uint(v), false, false);
    v = __uint_as_float(s[0]) + __uint_as_float(s[1]);
    auto t = __builtin_amdgcn_permlane32_swap(__float_as_uint(v), __float_as_uint(v), false, false);
    return __uint_as_float(t[0]) + __uint_as_float(t[1]);
}
__device__ __forceinline__ float sigmoidf_(float x) { return 1.f / (1.f + __expf(-x)); }
__device__ __forceinline__ float softplusf_(float x) { return fmaxf(x, 0.f) + log1pf(__expf(-fabsf(x))); }
__device__ __forceinline__ int mod_row(int r) { return r < NPR ? (r >> 12) : 2 + ((r - NPR) >> 3); }
#define WSP(T, off) ((T*)(F.wsp() + (off)))

struct CvtItem { const float* W; bf16* WT; int ldw, ldt, k0, n0; };
__device__ __forceinline__ void item_load(float (&tv)[32], const CvtItem& d, int lane) {
#pragma unroll
    for (int i = 0; i < 32; ++i) tv[i] = __builtin_nontemporal_load(d.W + (size_t)(d.k0 + 2 * i + (lane >> 5)) * d.ldw + d.n0 + (lane & 31));
}
__device__ __forceinline__ void item_store(const float (&tv)[32], const CvtItem& d, LAS float* scr, int lane) {
#pragma unroll
    for (int i = 0; i < 32; ++i) scr[(2 * i + (lane >> 5)) * 33 + (lane & 31)] = tv[i];
    LDS_WAIT(); asm volatile("" ::: "memory");
    const int c = lane & 7;
#pragma unroll
    for (int j = 0; j < 4; ++j) { const int n = (lane >> 3) + 8 * j; const LAS float* s = scr + (8 * c) * 33 + n;
        u32x4 o; o.x = cvt_pk_bf16(s[0 * 33], s[1 * 33]); o.y = cvt_pk_bf16(s[2 * 33], s[3 * 33]); o.z = cvt_pk_bf16(s[4 * 33], s[5 * 33]); o.w = cvt_pk_bf16(s[6 * 33], s[7 * 33]);
        *(GAS u32x4*)(d.WT + (size_t)(d.n0 + n) * d.ldt + d.k0 + 8 * c) = o; }
    LDS_WAIT(); asm volatile("" ::: "memory");
}
constexpr int IT_IN = 32 * 206, IT_OUT = 32 * 64, IT_W1 = 32 * 256, IT_W2 = 128 * 64, IT_PL = 8 * 16, NIT_ALL = IT_IN + IT_OUT + 2 * IT_W1 + 2 * IT_W2 + 4 * IT_PL;
__device__ __forceinline__ CvtItem item_decode(Ctx& F, int it) {
    int r = it; CvtItem d; int N;
    if (r < IT_IN) { d.W = F.in(I_WIN); d.WT = WSP(bf16, WS_WIN); N = INCOLS; d.ldt = DM; }
    else if ((r -= IT_IN) < IT_OUT) { d.W = F.in(I_WOUT); d.WT = WSP(bf16, WS_WOUT); N = DM; d.ldt = DM; }
    else if ((r -= IT_OUT) < 2 * IT_W1) { const int l = r / IT_W1; r -= l * IT_W1; d.W = F.in(I_W1) + (size_t)l * DM * DFF; d.WT = WSP(bf16, WS_W1) + (size_t)l * DFF * DM; N = DFF; d.ldt = DM; }
    else if ((r -= 2 * IT_W1) < 2 * IT_W2) { const int l = r / IT_W2; r -= l * IT_W2; d.W = F.in(I_W2) + (size_t)l * DFF * DM; d.WT = WSP(bf16, WS_W2) + (size_t)l * DM * DFF; N = DM; d.ldt = DFF; }
    else { r -= 2 * IT_W2; const int g = r / IT_PL; r -= g * IT_PL; d.W = F.in(I_WPOOL) + (size_t)g * 512 * 512; d.WT = WSP(bf16, WS_WPOOL) + (size_t)(g * 512) * DM + g * 512; N = 512; d.ldt = DM; }
    const int nblk = N / 32, kb = r / nblk, nb = r - kb * nblk;
    d.ldw = N; d.k0 = 64 * kb; d.n0 = 32 * nb; return d;
}
__device__ __forceinline__ void convert_run(Ctx& F, int first, int stride, int lim, LAS float* scr) {
    int it = first; if (it >= lim) return;
    float ta[32], tb[32]; CvtItem da = item_decode(F, it), db = da; item_load(ta, da, F.lane);
    for (;;) {
        const int i2 = it + stride; const bool h2 = i2 < lim; if (h2) { db = item_decode(F, i2); item_load(tb, db, F.lane); }
        item_store(ta, da, scr, F.lane); if (!h2) break;
        const int i3 = i2 + stride; const bool h3 = i3 < lim; if (h3) { da = item_decode(F, i3); item_load(ta, da, F.lane); }
        item_store(tb, db, scr, F.lane); if (!h3) break;
        it = i3; }
}
constexpr int NCVT = 40, N_HIDE = 24000;
__device__ __forceinline__ void phase_prologue(Ctx& F) {
    LAS float* scr = (LAS float*)(F.lds + F.wave * 16384);
    const int gw = F.vcu * NWAVES + F.wave, NGW = F.G * NWAVES;
    convert_run(F, gw, NGW, IT_IN, scr);
    if (F.G > NCVT + 8) convert_run(F, IT_IN + N_HIDE + gw, NGW, NIT_ALL, scr); else convert_run(F, IT_IN + gw, NGW, NIT_ALL, scr);
    for (int i = F.vcu * NTHR + F.tid; i < 3072 * 64; i += F.G * NTHR) {
        const int kc = i / 3072, n = i - kc * 3072, reg = n >> 10, nn = n & 1023;
        float v[8];
        if (reg == 0) {
#pragma unroll
            for (int j = 0; j < 8; ++j) { const int k = 8 * kc + j; v[j] = (k < 96) ? F.in(I_WUP)[(size_t)k * 1024 + nn] : 0.f; } }
        else if (reg == 1) {
#pragma unroll
            for (int j = 0; j < 8; ++j) { const int k = 8 * kc + j - 96; v[j] = (k >= 0 && k < 96) ? F.in(I_AUP)[(size_t)k * 1024 + nn] : 0.f; } }
        else {
#pragma unroll
            for (int j = 0; j < 8; ++j) { const int k = 8 * kc + j - 192; v[j] = (k >= 0 && k < 256) ? F.in(I_GUP)[(size_t)k * 1024 + nn] : 0.f; } }
        u32x4 o; o.x = cvt_pk_bf16(v[0], v[1]); o.y = cvt_pk_bf16(v[2], v[3]); o.z = cvt_pk_bf16(v[4], v[5]); o.w = cvt_pk_bf16(v[6], v[7]);
        *(GAS u32x4*)(WSP(bf16, WS_LWT) + (size_t)n * 512 + 8 * kc) = o;
    }
    __syncthreads();
    LAS float* scs = (LAS float*)F.lds;
    LAS float* part = (LAS float*)(F.lds + 16384);
    float* PARTM = WSP(float, WS_G);
    for (int su = F.vcu; su < 768; su += F.G) {
        const int task = su >> 3, ke = su & 7, l = task / 48, cb = (task - l * 48) * 256;
        for (int i = F.tid; i < NMR * 256; i += NTHR) { const int r = i >> 8, k = ke * 256 + (i & 255); const float c = r < 2 ? F.in(I_CP)[r * DM + k] : F.in(I_CS)[(r - 2) * DM + k]; scs[i] = c / (1.f + __expf(-c)); }
        __syncthreads();
        const float* W = F.in(I_WADA) + ((size_t)l * DM + ke * 256 + F.wave * 32) * 12288 + cb + F.lane * 4;
        f32x4 acc[NMR];
#pragma unroll
        for (int r = 0; r < NMR; ++r) acc[r] = (f32x4){0.f, 0.f, 0.f, 0.f};
        for (int k = 0; k < 32; k += 8) {
            f32x4 wv[8];
#pragma unroll
            for (int j = 0; j < 8; ++j) wv[j] = __builtin_nontemporal_load((const GAS f32x4*)(W + (size_t)(k + j) * 12288));
#pragma unroll
            for (int j = 0; j < 8; j += 4)
#pragma unroll
                for (int r = 0; r < NMR; ++r) { const f32x4 sv = *(const LAS f32x4*)(scs + r * 256 + F.wave * 32 + k + j); acc[r] += (wv[j] * sv.x + wv[j + 1] * sv.y) + (wv[j + 2] * sv.z + wv[j + 3] * sv.w); }
        }
#pragma unroll
        for (int r = 0; r < NMR; ++r) *(LAS f32x4*)(part + (F.wave * NMR + r) * 256 + F.lane * 4) = acc[r];
        __syncthreads();
        for (int i = F.tid; i < NMR * 64; i += NTHR) { const int r = i >> 6, c4 = (i & 63) * 4; f32x4 sm = *(const LAS f32x4*)(part + r * 256 + c4);
#pragma unroll
            for (int w = 1; w < NWAVES; ++w) sm += *(const LAS f32x4*)(part + (w * NMR + r) * 256 + c4);
            *(GAS f32x4*)(PARTM + ((size_t)ke * 2 * NMR + l * NMR + r) * 12288 + cb + c4) = sm; }
        __syncthreads();
    }
}

struct Row { f32x4 v[8]; };
__device__ __forceinline__ void row_load(Row& R, const float* p, int lane) {
#pragma unroll
    for (int j = 0; j < 8; ++j) R.v[j] = *(const GAS f32x4*)(p + j * 256 + lane * 4);
}
__device__ __forceinline__ void row_load_bf16(Row& R, const bf16* p, int lane) {
#pragma unroll
    for (int j = 0; j < 8; ++j) { const u32x2 w = *(const GAS u32x2*)(p + j * 256 + lane * 4);
        R.v[j] = (f32x4){__uint_as_float(w.x << 16), __uint_as_float(w.x & 0xffff0000u), __uint_as_float(w.y << 16), __uint_as_float(w.y & 0xffff0000u)}; }
}
__device__ __forceinline__ float row_sumsq(const Row& R) { float s = 0.f;
#pragma unroll
    for (int j = 0; j < 8; ++j) s += (R.v[j].x * R.v[j].x + R.v[j].y * R.v[j].y) + (R.v[j].z * R.v[j].z + R.v[j].w * R.v[j].w);
    return wave_sum(s); }
__device__ __forceinline__ const float* x_in_row(Ctx& F, int r) { return r < NPR ? F.in(I_XP) + (size_t)r * DM : F.in(I_XS) + (size_t)(r - NPR) * DM; }
__device__ __forceinline__ void row_modulate(Row& H, const Row& X, float rstd, const float* g, const float* shift, const float* scale, int lane) {
#pragma unroll
    for (int j = 0; j < 8; ++j) { const int c = j * 256 + lane * 4; const f32x4 gg = *(const GAS f32x4*)(g + c), sh = *(const GAS f32x4*)(shift + c), sc = *(const GAS f32x4*)(scale + c);
        H.v[j] = X.v[j] * rstd * gg * (sc + 1.f) + sh; }
}
__device__ __forceinline__ void row_store_bf16(const Row& H, bf16* p, int lane) {
#pragma unroll
    for (int j = 0; j < 8; ++j) { u32x2 w; w.x = cvt_pk_bf16(H.v[j].x, H.v[j].y); w.y = cvt_pk_bf16(H.v[j].z, H.v[j].w); *(GAS u32x2*)(p + j * 256 + lane * 4) = w; }
}
__device__ __forceinline__ void row_store_f32(const Row& H, float* p, int lane) {
#pragma unroll
    for (int j = 0; j < 8; ++j) *(GAS f32x4*)(p + j * 256 + lane * 4) = H.v[j];
}
__device__ __forceinline__ void row_store_f32_nt(const Row& H, float* p, int lane) {
#pragma unroll
    for (int j = 0; j < 8; ++j) __builtin_nontemporal_store(H.v[j], (GAS f32x4*)(p + j * 256 + lane * 4));
}
struct RowB { u32x2 w[8]; };
__device__ __forceinline__ void rowb_load(RowB& R, const bf16* p, int lane) {
#pragma unroll
    for (int j = 0; j < 8; ++j) R.w[j] = *(const GAS u32x2*)(p + j * 256 + lane * 4);
}
__device__ __forceinline__ void rowb_cvt(Row& R, const RowB& B) {
#pragma unroll
    for (int j = 0; j < 8; ++j) R.v[j] = (f32x4){__uint_as_float(B.w[j].x << 16), __uint_as_float(B.w[j].x & 0xffff0000u), __uint_as_float(B.w[j].y << 16), __uint_as_float(B.w[j].y & 0xffff0000u)};
}
constexpr int PSET_FLOATS = 3 * DM;
static_assert(NSM == 64 && 3 * PSET_FLOATS * 4 + 7 * DM * 4 <= RING_BYTES, "row phases: 8 workgroups x 8 waves take the sample rows; three parameter sets in LDS");
template <int KIND, int L> __device__ __forceinline__ void stage_row_params(Ctx& F) {
    const float* MOD = WSP(float, WS_MOD); const float* ng = F.in(I_NG) + (size_t)L * 4 * DM;
    const int nset = F.vcu < 64 ? 3 : 2;
#define RP_LD4(p) (*(const GAS f32x4*)(p))
    for (int i = F.tid; i < nset * (DM / 4); i += NTHR) {
        const int s = i >> 9, c = (i & 511) * 4, mr = s < 2 ? s : 2 + (F.vcu >> 3);
        const float* m = MOD + (size_t)(L * NMR + mr) * 12288;
        f32x4 v0 = {0.f, 0.f, 0.f, 0.f}, v1 = v0, v2 = v0;
        if (KIND == 0) {
            const float* pm = WSP(float, WS_G) + (size_t)mr * 12288; f32x4 sh = RP_LD4(F.in(I_BADA) + c), scl = RP_LD4(F.in(I_BADA) + DM + c);
#pragma unroll
            for (int ke = 0; ke < 8; ++ke) { sh += RP_LD4(pm + (size_t)ke * 2 * NMR * 12288 + c); scl += RP_LD4(pm + (size_t)ke * 2 * NMR * 12288 + DM + c); }
            v1 = RP_LD4(ng + c) * (scl + 1.f); v2 = sh; }
        else if (KIND == 1) { v0 = RP_LD4(m + 2 * DM + c) * RP_LD4(ng + DM + c); v1 = RP_LD4(ng + 2 * DM + c) * (RP_LD4(m + 4 * DM + c) + 1.f); v2 = RP_LD4(m + 3 * DM + c); }
        else { v0 = RP_LD4(m + 5 * DM + c) * RP_LD4(ng + 3 * DM + c);
               if (KIND == 2) { const float* m1 = MOD + (size_t)(1 * NMR + mr) * 12288; v1 = RP_LD4(F.in(I_NG) + (size_t)4 * DM + c) * (RP_LD4(m1 + DM + c) + 1.f); v2 = RP_LD4(m1 + c); } }
        LAS float* d = (LAS float*)F.lds + s * PSET_FLOATS + c;
        *(LAS f32x4*)d = v0; *(LAS f32x4*)(d + DM) = v1; *(LAS f32x4*)(d + 2 * DM) = v2;
    }
#undef RP_LD4
    __syncthreads();
}
__device__ __forceinline__ const LAS float* row_pset(Ctx& F, int r) { return (const LAS float*)F.lds + (r < NPR ? (r >> 12) : 2) * PSET_FLOATS; }
__device__ __forceinline__ void row_residual_l(Row& X, const Row& O, const LAS float* ps, int lane) {
    const float rstd = rsqrtf(row_sumsq(O) * (1.f / DM) + EPS_RMS);
#pragma unroll
    for (int j = 0; j < 8; ++j) { const f32x4 gt = *(const LAS f32x4*)(ps + j * 256 + lane * 4); X.v[j] = X.v[j] + gt * (O.v[j] * rstd); }
}
__device__ __forceinline__ void row_modulate_l(Row& H, const Row& X, const LAS float* ps, int lane) {
    const float rstd = rsqrtf(row_sumsq(X) * (1.f / DM) + EPS_RMS);
#pragma unroll
    for (int j = 0; j < 8; ++j) { const int c = j * 256 + lane * 4; const f32x4 a = *(const LAS f32x4*)(ps + DM + c), sh = *(const LAS f32x4*)(ps + 2 * DM + c); H.v[j] = X.v[j] * rstd * a + sh; }
}
__device__ __forceinline__ void phase_mod0(Ctx& F) {
    stage_row_params<0, 0>(F);
    const int gw = F.vcu * NWAVES + F.wave, NGW = F.G * NWAVES, samp = (F.vcu < 64 && F.wave == 0) ? NPR + F.vcu : NTOK; bf16* Hb = WSP(bf16, WS_H);
    Row Xn; row_load(Xn, x_in_row(F, gw), F.lane);
    for (int r = gw; r < NPR; r += NGW) {
        Row X = Xn, H; const int rn = r + NGW, rp = rn < NPR ? rn : (samp < NTOK ? samp : r);
        row_load(Xn, x_in_row(F, rp), F.lane);
        row_modulate_l(H, X, row_pset(F, r), F.lane);
        row_store_bf16(H, Hb + (size_t)r * DM, F.lane);
    }
    if (samp < NTOK) { Row H; row_modulate_l(H, Xn, row_pset(F, samp), F.lane); row_store_bf16(H, Hb + (size_t)samp * DM, F.lane); }
}
__device__ __forceinline__ void row_residual(Row& X, const Row& O, const float* ga, const float* gate, int lane) {
    const float rstd = rsqrtf(row_sumsq(O) * (1.f / DM) + EPS_RMS);
#pragma unroll
    for (int j = 0; j < 8; ++j) { const int c = j * 256 + lane * 4; const f32x4 gg = *(const GAS f32x4*)(ga + c), gt = *(const GAS f32x4*)(gate + c); X.v[j] = X.v[j] + gt * (O.v[j] * rstd * gg); }
}
template <int NK> __device__ __forceinline__ void row_load_out(Ctx& F, Row& O, int r, int lane) {
    if (r < NPR) { const bf16* op = WSP(bf16, WS_OUT) + (size_t)r * DM;
#pragma unroll
        for (int j = 0; j < 8; ++j) { const u32x2 w = *(const GAS u32x2*)(op + j * 256 + lane * 4);
            O.v[j] = (f32x4){__uint_as_float(w.x << 16), __uint_as_float(w.x & 0xffff0000u), __uint_as_float(w.y << 16), __uint_as_float(w.y & 0xffff0000u)}; }
        return; }
    const float* pp = WSP(float, WS_PART) + (size_t)(r - NPR) * DM;
    row_load(O, pp, lane);
    for (int kc = 1; kc < NK; ++kc) { Row T; row_load(T, pp + (size_t)kc * 64 * DM, lane);
#pragma unroll
        for (int j = 0; j < 8; ++j) O.v[j] += T.v[j]; }
}
__device__ __forceinline__ f32x4 ld_bf4(const bf16* p) { const u32x2 w = *(const GAS u32x2*)p; return (f32x4){__uint_as_float(w.x << 16), __uint_as_float(w.x & 0xffff0000u), __uint_as_float(w.y << 16), __uint_as_float(w.y & 0xffff0000u)}; }
__device__ __forceinline__ void row_load_pool(Ctx& F, Row& O, int r, int lane) {
    if (r < NPR && (r & (SEQ - 1)) >= PBUF) { const bf16* op = WSP(bf16, WS_OUT) + (size_t)r * DM + lane * 4;
#pragma unroll
        for (int j8 = 0; j8 < 8; ++j8) { const int wlen = 2 << (j8 >> 1);
            const f32x4 cur = ld_bf4(op + j8 * 256); f32x4 sum = cur;
#pragma unroll
            for (int j = 1; j < wlen; ++j) sum += ld_bf4(op + j8 * 256 - (size_t)j * DM);
            O.v[j8] = sum * (1.f / (float)wlen) - cur; }
    } else if (r < NPR) { const int t = r & (SEQ - 1); const bf16* op = WSP(bf16, WS_OUT) + (size_t)r * DM + lane * 4;
#pragma unroll
        for (int j8 = 0; j8 < 8; ++j8) { const int wlen = 2 << (j8 >> 1), n = (t + 1) < wlen ? (t + 1) : wlen;
            const f32x4 cur = ld_bf4(op + j8 * 256); f32x4 sum = cur;
            for (int j = 1; j < n; ++j) sum += ld_bf4(op + j8 * 256 - (size_t)j * DM);
            O.v[j8] = sum * (1.f / (float)n) - cur; }
    } else { const int rs = r - NPR, b = rs >> 3, t = rs & 7; const float* pp = WSP(float, WS_PART) + lane * 4;
#pragma unroll
        for (int j8 = 0; j8 < 8; ++j8) { const int wlen = 2 << (j8 >> 1); f32x4 cur = {0.f, 0.f, 0.f, 0.f}, sum = {0.f, 0.f, 0.f, 0.f};
#pragma unroll
            for (int j = 0; j < wlen; ++j) { const int tj = t - j, pr = tj >= 0 ? rs - j : 64 + b * PBUF + PBUF + tj;
                const f32x4 g = *(const GAS f32x4*)(pp + (size_t)pr * DM + j8 * 256) + *(const GAS f32x4*)(pp + (size_t)(256 + pr) * DM + j8 * 256);
                sum += g; if (j == 0) cur = g; }
            O.v[j8] = sum * (1.f / (float)wlen) - cur; }
    }
}
template <int NK> __device__ __forceinline__ void sample_row_gather(Ctx& F, Row& O, int s) {
    constexpr int PER = NK / 8; const float* pp = WSP(float, WS_PART) + ((size_t)(F.wave * PER) * 64 + s) * DM; Row T[PER];
#pragma unroll
    for (int k = 0; k < PER; ++k) row_load(T[k], pp + (size_t)k * 64 * DM, F.lane);
    O = T[0];
#pragma unroll
    for (int k = 1; k < PER; ++k)
#pragma unroll
        for (int j = 0; j < 8; ++j) O.v[j] += T[k].v[j];
    LAS float* sl = (LAS float*)F.lds + 3 * PSET_FLOATS;
    if (F.wave > 0) {
#pragma unroll
        for (int j = 0; j < 8; ++j) *(LAS f32x4*)(sl + (F.wave - 1) * DM + j * 256 + F.lane * 4) = O.v[j]; }
    __syncthreads();
    if (F.wave == 0) {
#pragma unroll
        for (int w = 0; w < 7; ++w)
#pragma unroll
            for (int j = 0; j < 8; ++j) O.v[j] += *(const LAS f32x4*)(sl + w * DM + j * 256 + F.lane * 4); }
}
template <int L> __device__ __forceinline__ void phase_postmix(Ctx& F) {
    stage_row_params<1, L>(F);
    const int gw = F.vcu * NWAVES + F.wave, NGW = F.G * NWAVES, samp = (F.vcu < 64 && F.wave == 0) ? NPR + F.vcu : NTOK;
    bf16* Hb = WSP(bf16, WS_H); bf16* XR = WSP(bf16, WS_XR); const bf16* OUTb = WSP(bf16, WS_OUT);
    Row Xf; RowB Xb, Ob;
    if (L == 0) { row_load(Xf, x_in_row(F, gw), F.lane); rowb_load(Ob, OUTb + (size_t)gw * DM, F.lane); } else rowb_load(Xb, XR + (size_t)gw * DM, F.lane);
    for (int r = gw; r < NPR; r += NGW) {
        Row X, O, H; const int rn = r + NGW, rp = rn < NPR ? rn : (samp < NTOK ? samp : r), ro = rn < NPR ? rn : r;
        if (L == 0) { X = Xf; rowb_cvt(O, Ob); row_load(Xf, x_in_row(F, rp), F.lane); rowb_load(Ob, OUTb + (size_t)ro * DM, F.lane); }
        else { rowb_cvt(X, Xb); rowb_load(Xb, XR + (size_t)rp * DM, F.lane); row_load_pool(F, O, r, F.lane); }
        const LAS float* ps = row_pset(F, r);
        row_residual_l(X, O, ps, F.lane);
        row_store_bf16(X, XR + (size_t)r * DM, F.lane);
        row_modulate_l(H, X, ps, F.lane);
        row_store_bf16(H, Hb + (size_t)r * DM, F.lane);
    }
    Row Og; if (L == 0 && F.vcu < 64) sample_row_gather<8>(F, Og, F.vcu);
    if (samp < NTOK) { Row X, O, H; if (L == 0) { X = Xf; O = Og; } else { rowb_cvt(X, Xb); row_load_pool(F, O, samp, F.lane); }
        const LAS float* ps = row_pset(F, samp);
        row_residual_l(X, O, ps, F.lane);
        row_store_bf16(X, XR + (size_t)samp * DM, F.lane);
        row_modulate_l(H, X, ps, F.lane);
        row_store_bf16(H, Hb + (size_t)samp * DM, F.lane); }
}
template <int L> __device__ __forceinline__ void phase_postmlp(Ctx& F) {
    stage_row_params<L == 0 ? 2 : 3, L>(F);
    const int gw = F.vcu * NWAVES + F.wave, NGW = F.G * NWAVES, samp = (F.vcu < 64 && F.wave == 0) ? NPR + F.vcu : NTOK;
    bf16* XR = WSP(bf16, WS_XR); const bf16* OUTb = WSP(bf16, WS_OUT);
    RowB Xb, Ob; rowb_load(Xb, XR + (size_t)gw * DM, F.lane); rowb_load(Ob, OUTb + (size_t)gw * DM, F.lane);
    for (int r = gw; r < NPR; r += NGW) {
        Row X, O; const int rn = r + NGW, rp = rn < NPR ? rn : (samp < NTOK ? samp : r), ro = rn < NPR ? rn : r;
        rowb_cvt(X, Xb); rowb_cvt(O, Ob); rowb_load(Xb, XR + (size_t)rp * DM, F.lane); rowb_load(Ob, OUTb + (size_t)ro * DM, F.lane);
        const LAS float* ps = row_pset(F, r);
        row_residual_l(X, O, ps, F.lane);
        if (L == 0) {
            row_store_bf16(X, XR + (size_t)r * DM, F.lane);
            Row H; row_modulate_l(H, X, ps, F.lane);
            row_store_bf16(H, WSP(bf16, WS_H) + (size_t)r * DM, F.lane);
            const int t = r & (SEQ - 1); if (t >= SEQ - PBUF) row_store_f32(H, F.outp() + O_PLP + ((size_t)(r >> 12) * PBUF + (t - (SEQ - PBUF))) * DM, F.lane);
        } else row_store_f32_nt(X, F.outp() + O_YP + (size_t)r * DM, F.lane);
    }
    Row Og; if (F.vcu < 64) sample_row_gather<32>(F, Og, F.vcu);
    if (samp < NTOK) { Row X, O = Og; rowb_cvt(X, Xb);
        const LAS float* ps = row_pset(F, samp); const int rs = samp - NPR;
        row_residual_l(X, O, ps, F.lane);
        if (L == 0) {
            row_store_bf16(X, XR + (size_t)samp * DM, F.lane);
            Row H; row_modulate_l(H, X, ps, F.lane);
            row_store_bf16(H, WSP(bf16, WS_H) + (size_t)samp * DM, F.lane);
            row_store_f32(H, F.outp() + O_PLS + ((size_t)(rs >> 3) * PBUF + 7 + (rs & 7)) * DM, F.lane);
        } else row_store_f32_nt(X, F.outp() + O_YS + (size_t)rs * DM, F.lane); }
    if (L == 0) {
        const float* SP = F.in(I_SPOOL); bf16* Hb = WSP(bf16, WS_H);
        for (int i = F.vcu * NTHR + F.tid; i < DBAT * PBUF * 512; i += F.G * NTHR) { const int c4 = (i & 511) * 4, bi = i >> 9, b = bi / PBUF, k = bi - b * PBUF;
            const f32x4 v = *(const GAS f32x4*)(SP + (size_t)bi * DM + c4); u32x2 w; w.x = cvt_pk_bf16(v.x, v.y); w.y = cvt_pk_bf16(v.z, v.w);
            *(GAS u32x2*)(Hb + (size_t)(NTOK + bi) * DM + c4) = w;
            if (k >= 8) *(GAS f32x4*)(F.outp() + O_PLS + ((size_t)b * PBUF + (k - 8)) * DM + c4) = v; }
    }
}

__device__ __forceinline__ void phase_kv_prep(Ctx& F) {
    { const float* PM = WSP(float, WS_G); float* MOD = WSP(float, WS_MOD);
      for (int i = F.vcu * NTHR + F.tid; i < 2 * NMR * 12288 / 4; i += F.G * NTHR) { const int row = i / 3072, c4 = (i - row * 3072) * 4, l = row / NMR;
          f32x4 sm = *(const GAS f32x4*)(F.in(I_BADA) + (size_t)l * 12288 + c4);
#pragma unroll
          for (int ke = 0; ke < 8; ++ke) sm += *(const GAS f32x4*)(PM + ((size_t)ke * 2 * NMR + row) * 12288 + c4);
          *(GAS f32x4*)(MOD + (size_t)row * 12288 + c4) = sm; } }
    const float* P = WSP(float, WS_P);
    for (int i = F.vcu * NTHR + F.tid; i < (NBATCH + DBAT) * BCOLS; i += F.G * NTHR) {
        const int b = i / BCOLS, c = i - b * BCOLS; const int r = b < NBATCH ? b * SEQ + SEQ - 1 : NPR + (b - NBATCH) * DSEQ + DSEQ - 1;
        F.outp()[(b < NBATCH ? O_SHP + (size_t)b * BCOLS : O_SHS + (size_t)(b - NBATCH) * BCOLS) + c] = (b < NBATCH && c < 3072) ? ldbf(WSP(bf16, WS_PBH) + (size_t)r * 3072 + c) : P[(size_t)r * PBLD + c];
    }
    { const int gw = F.vcu * NWAVES + F.wave, NGW = F.G * NWAVES; const float* mu = F.in(I_MU); bf16* LA = WSP(bf16, WS_LA);
      for (int r = gw; r < NTOK; r += NGW) {
        const float* pb = P + (size_t)r * PBLD; const float* prev; bool hp;
        if (r < NPR) { const int t = r & (SEQ - 1); hp = t > 0; prev = pb - PBLD; }
        else { const int rs = r - NPR, b = rs >> 3, t = rs & 7; hp = true; prev = t > 0 ? pb - PBLD : F.in(I_SSH) + (size_t)b * BCOLS; }
        float v[8];
        { const int c0 = 3072 + F.lane * 8; const bool act = F.lane < 56; const f32x4 z4 = {0.f, 0.f, 0.f, 0.f};
          f32x4 pa = z4, pc = z4, qa = z4, qc = z4, ma = z4, mc = z4;
          if (act) { pa = *(const GAS f32x4*)(pb + c0); pc = *(const GAS f32x4*)(pb + c0 + 4); ma = *(const GAS f32x4*)(mu + c0); mc = *(const GAS f32x4*)(mu + c0 + 4);
                     if (hp) { qa = *(const GAS f32x4*)(prev + c0); qc = *(const GAS f32x4*)(prev + c0 + 4); } }
          const f32x4 za = pa + ma * (qa - pa), zc = pc + mc * (qc - pc);
          const float kz = F.lane < 12 ? 2.f : 1.f;
#pragma unroll
          for (int j = 0; j < 8; ++j) { const float z = j < 4 ? za[j & 3] : zc[j & 3]; const float sg = 1.f / (1.f + __expf(-kz * z));
              v[j] = !act ? 0.f : (F.lane < 12 ? 2.f * sg - 1.f : (F.lane < 24 ? z : sg)); } }
        u32x4 o; o.x = cvt_pk_bf16(v[0], v[1]); o.y = cvt_pk_bf16(v[2], v[3]); o.z = cvt_pk_bf16(v[4], v[5]); o.w = cvt_pk_bf16(v[6], v[7]);
        *(GAS u32x4*)(LA + (size_t)r * 512 + F.lane * 8) = o;
      } }
}
__device__ __forceinline__ void phase_rwkv_prep(Ctx& F) {
    const float* P = WSP(float, WS_P); const float* LWO = WSP(float, WS_LWO);
    const int gw = F.vcu * NWAVES + F.wave, NGW = F.G * NWAVES;
    float* RWV = WSP(float, WS_RWV); float* SCL = WSP(float, WS_SCL);
    const float* mu = F.in(I_MU);
    for (int u = gw; u < NSM * 4; u += NGW) {
        const int r = NPR + (u >> 2), hq = u & 3;
        const float* pb = P + (size_t)r * PBLD; const float* prev; const bool hp = true;
        { const int rs = r - NPR, b = rs >> 3, t = rs & 7; prev = t > 0 ? pb - PBLD : F.in(I_SSH) + (size_t)b * BCOLS; }
        const float* lw = LWO + (size_t)r * 3072;
        float pr[4], pk[4], pv[4], qr_[4], qk[4], qv[4], lwl[4], lal[4], lgl[4];
#pragma unroll
        for (int i = 0; i < 4; ++i) { const int col = (hq * 4 + i) * 64 + F.lane;
            pr[i] = pb[col]; pk[i] = pb[1024 + col]; pv[i] = pb[2048 + col];
            qr_[i] = hp ? prev[col] : 0.f; qk[i] = hp ? prev[1024 + col] : 0.f; qv[i] = hp ? prev[2048 + col] : 0.f;
            lwl[i] = lw[col]; lal[i] = lw[1024 + col]; lgl[i] = lw[2048 + col]; }
#pragma unroll
        for (int i = 0; i < 4; ++i) { const int h = hq * 4 + i, col = h * 64 + F.lane;
            const float zr = pr[i] + mu[col] * (qr_[i] - pr[i]), zk = pk[i] + mu[1024 + col] * (qk[i] - pk[i]), zv = pv[i] + mu[2048 + col] * (qv[i] - pv[i]);
            const float wl = F.in(I_W0)[col] + lwl[i], al = F.in(I_A0)[col] + lal[i], gl = lgl[i];
            const float wlog = -softplusf_(-wl) - 0.5f, decay = __expf(-__expf(wlog));
            const float a = sigmoidf_(al);
            const float kkr = zk * F.in(I_KK)[col], kk = kkr * rsqrtf(wave_sum(kkr * kkr) + 1e-12f);
            const float k = zk * (1.f + (a - 1.f) * F.in(I_KA)[col]);
            const float bb = kk * a;
            const float bonus = wave_sum(zr * k * F.in(I_RK)[col]), beta = wave_sum(bb * zr), kappa = wave_sum(k * zr);
            float* base = RWV + ((size_t)r * HB + h) * 512;
            base[F.lane] = decay; base[64 + F.lane] = kk; base[128 + F.lane] = bb; base[192 + F.lane] = k; base[256 + F.lane] = zr; base[320 + F.lane] = zv; base[384 + F.lane] = decay * zr;
            if (F.lane == 0) { float* s_ = SCL + ((size_t)r * HB + h) * 4; s_[0] = beta; s_[1] = kappa; s_[2] = bonus; s_[3] = 0.f; }
        }
    }
}

namespace sba {
typedef short bf16x8 __attribute__((ext_vector_type(8)));
typedef short s16x4 __attribute__((ext_vector_type(4)));
typedef float f32x16 __attribute__((ext_vector_type(16)));
constexpr int SHM = 16384, LDQ = 1024;
#define SB_KSWZ(row, colB) ((row) * 256 + ((colB) ^ (((row) & 7) << 4)))
#define SB_SBAR() __builtin_amdgcn_sched_barrier(0)
__device__ __forceinline__ int v_st(int k, int c) { const int kk = (k & ~0xC) | ((k & 4) << 1) | ((k & 8) >> 1); return ((kk >> 3) * 4 + (c >> 5)) * 512 + ((kk & 7) * 32 + (c & 31)) * 2; }
__device__ __forceinline__ int v_rd_base(int lane) { return ((lane & 3) << 3) | (((lane >> 2) & 3) << 6) | (((lane >> 4) & 1) << 5) | (((lane >> 5) & 1) << 8); }
__device__ __forceinline__ int crow(int r, int hi) { return (r & 3) + 8 * (r >> 2) + 4 * hi; }
__device__ __forceinline__ void qkt(f32x16& p0, f32x16& p1, const char* Kt, int r32, int hi, const bf16x8* qr) {
    p0 = f32x16{}; p1 = f32x16{};
    const char* kb[4];
#pragma unroll
    for (int dd = 0; dd < 4; ++dd) kb[dd] = Kt + SB_KSWZ(r32, (dd * 16 + hi * 8) * 2);
#pragma unroll
    for (int d0 = 0; d0 < 8; ++d0) { const char* a = kb[d0 & 3] + (d0 >> 2) * 128;
        const bf16x8 b0 = *reinterpret_cast<const bf16x8*>(a);
        const bf16x8 b1 = *reinterpret_cast<const bf16x8*>(a + 32 * 256);
        p0 = __builtin_amdgcn_mfma_f32_32x32x16_bf16(b0, qr[d0], p0, 0, 0, 0);
        p1 = __builtin_amdgcn_mfma_f32_32x32x16_bf16(b1, qr[d0], p1, 0, 0, 0); }
}
__device__ __forceinline__ void pv_tile(f32x16* o, int vb0, bf16x8 pa0, bf16x8 pa1, bf16x8 pa2, bf16x8 pa3) {
#define SB_TRRD(dst, off) asm volatile("ds_read_b64_tr_b16 %0, %1 offset:%2" : "=&v"(dst) : "v"(vb0), "i"(off) : "memory")
#define SB_PV_D0(d0) do { s16x4 l0, l1, l2, l3, h0, h1, h2, h3; constexpr int b_ = (d0) * 512; \
        SB_TRRD(l0, b_); SB_TRRD(h0, b_ + 2048); SB_TRRD(l1, b_ + 4096); SB_TRRD(h1, b_ + 6144); SB_TRRD(l2, b_ + 8192); SB_TRRD(h2, b_ + 10240); SB_TRRD(l3, b_ + 12288); SB_TRRD(h3, b_ + 14336); \
        asm volatile("s_waitcnt lgkmcnt(0)" ::: "memory"); SB_SBAR(); \
        o[d0] = __builtin_amdgcn_mfma_f32_32x32x16_bf16(pa0, (bf16x8){l0[0], l0[1], l0[2], l0[3], h0[0], h0[1], h0[2], h0[3]}, o[d0], 0, 0, 0); \
        o[d0] = __builtin_amdgcn_mfma_f32_32x32x16_bf16(pa1, (bf16x8){l1[0], l1[1], l1[2], l1[3], h1[0], h1[1], h1[2], h1[3]}, o[d0], 0, 0, 0); \
        o[d0] = __builtin_amdgcn_mfma_f32_32x32x16_bf16(pa2, (bf16x8){l2[0], l2[1], l2[2], l2[3], h2[0], h2[1], h2[2], h2[3]}, o[d0], 0, 0, 0); \
        o[d0] = __builtin_amdgcn_mfma_f32_32x32x16_bf16(pa3, (bf16x8){l3[0], l3[1], l3[2], l3[3], h3[0], h3[1], h3[2], h3[3]}, o[d0], 0, 0, 0); } while (0)
    SB_PV_D0(0); SB_PV_D0(1); SB_PV_D0(2); SB_PV_D0(3);
#undef SB_PV_D0
#undef SB_TRRD
}
__device__ __forceinline__ float swap_other(float x, int hi) {
    auto rr = __builtin_amdgcn_permlane32_swap(__float_as_uint(x), __float_as_uint(x), false, false);
    return __uint_as_float(hi ? rr[0] : rr[1]);
}
template <bool MASK> __device__ __forceinline__ void sb_weights(f32x16& p0, f32x16& p1, float& carry, float C2, float b2, int dq, int hi) {
    float T[8];
#pragma unroll
    for (int g = 0; g < 8; ++g) {
        float iv[4], be[4];
#pragma unroll
        for (int k = 0; k < 4; ++k) { const int r = (g & 3) * 4 + k; const float s = g < 4 ? p0[r] : p1[r];
            const float z2 = fminf(fmaf(s, C2, b2), 64.f), e = __builtin_amdgcn_exp2f(z2), i_ = __builtin_amdgcn_rcpf(1.f + e); float b_ = e * i_, ii = i_;
            if (MASK) { const int c = (r & 3) + 8 * (r >> 2) + (g < 4 ? 0 : 32); const bool vis = c < dq; ii = vis ? ii : 1.f; b_ = vis ? b_ : 0.f; }
            iv[k] = ii; be[k] = b_; }
        const float ex2 = iv[3], ex1 = iv[2] * iv[3], ex0 = iv[1] * ex1; T[g] = iv[0] * ex0;
        const float w0 = be[0] * ex0, w1 = be[1] * ex1, w2 = be[2] * ex2, w3 = be[3];
        if (g < 4) { p0[(g & 3) * 4 + 0] = w0; p0[(g & 3) * 4 + 1] = w1; p0[(g & 3) * 4 + 2] = w2; p0[(g & 3) * 4 + 3] = w3; }
        else { p1[(g & 3) * 4 + 0] = w0; p1[(g & 3) * 4 + 1] = w1; p1[(g & 3) * 4 + 2] = w2; p1[(g & 3) * 4 + 3] = w3; }
    }
    float suf = carry;
#pragma unroll
    for (int g = 7; g >= 0; --g) {
        const float To = swap_other(T[g], hi);
        const float E = hi ? suf : suf * To;
#pragma unroll
        for (int k = 0; k < 4; ++k) { if (g < 4) p0[(g & 3) * 4 + k] *= E; else p1[(g & 3) * 4 + k] *= E; }
        suf = suf * (T[g] * To);
    }
    carry = suf;
}
__device__ __forceinline__ void pack_p(const f32x16& p0, const f32x16& p1, bf16x8& pa0, bf16x8& pa1, bf16x8& pa2, bf16x8& pa3) {
#define SB_PK4(P, B_, OUT) do { unsigned a0 = cvt_pk_bf16(P[B_ + 0], P[B_ + 1]), a1 = cvt_pk_bf16(P[B_ + 2], P[B_ + 3]); \
        unsigned b0 = cvt_pk_bf16(P[B_ + 4], P[B_ + 5]), b1 = cvt_pk_bf16(P[B_ + 6], P[B_ + 7]); \
        auto r0 = __builtin_amdgcn_permlane32_swap(a0, b0, false, false); auto r1 = __builtin_amdgcn_permlane32_swap(a1, b1, false, false); \
        u32x4 w = {r0[0], r1[0], r0[1], r1[1]}; OUT = *reinterpret_cast<bf16x8*>(&w); } while (0)
    SB_PK4(p0, 0, pa0); SB_PK4(p0, 8, pa1); SB_PK4(p1, 0, pa2); SB_PK4(p1, 8, pa3);
#undef SB_PK4
}
__device__ __forceinline__ void attn_half(Ctx& F, int bh, int x, int half) {
    const int tid = F.tid, wid = F.wave, lane = F.lane, r32 = lane & 31, hi = lane >> 5, b = bh >> 3, h = bh & 7;
    const bf16* Qg = WSP(bf16, WS_QB) + (size_t)(b * SEQ + 256 * x) * LDQ + h * 128;
    const bf16* Kg = WSP(bf16, WS_KB) + (size_t)(b * SEQ) * LDQ + h * 128; const bf16* Vg = WSP(bf16, WS_VB) + (size_t)(b * SEQ) * LDQ + h * 128;
    const int NT = 4 * (x + 1), t_hi = half == 0 ? NT : NT / 2, t_lo = half == 0 ? NT / 2 : 0;
    const int qlo = 256 * x + 32 * wid, qpos = qlo + r32;
    char* V_lds = (char*)F.lds; char* K_lds = (char*)F.lds + 2 * SHM;
    bf16x8 qr[8];
#pragma unroll
    for (int d0 = 0; d0 < 8; ++d0) qr[d0] = *reinterpret_cast<const bf16x8*>(Qg + (size_t)(wid * 32 + r32) * LDQ + d0 * 16 + hi * 8);
    const int sr = tid >> 4, sc = (tid & 15) * 8, vst0 = v_st(sr, sc), vst1 = v_st(32 + sr, sc), kws = SB_KSWZ(sr, sc * 2);
    const int vb0 = (int)(uintptr_t)V_lds + v_rd_base(lane);
    bf16x8 st_k0, st_k1, st_v0, st_v1;
    const unsigned so0 = (unsigned)(sr * LDQ + sc) * 2u, so1 = so0 + 32u * LDQ * 2u;
#define SB_SLOAD(t) do { const char* kt_ = (const char*)Kg + (size_t)(t) * (64 * LDQ * 2); const char* vt_ = (const char*)Vg + (size_t)(t) * (64 * LDQ * 2); \
        st_k0 = *reinterpret_cast<const bf16x8*>(kt_ + so0); st_k1 = *reinterpret_cast<const bf16x8*>(kt_ + so1); st_v0 = *reinterpret_cast<const bf16x8*>(vt_ + so0); st_v1 = *reinterpret_cast<const bf16x8*>(vt_ + so1); } while (0)
#define SB_SWRITE(bf) do { *(bf16x8*)(K_lds + (bf) * SHM + kws) = st_k0; *(bf16x8*)(K_lds + (bf) * SHM + kws + 32 * 256) = st_k1; \
        *(bf16x8*)(V_lds + (bf) * SHM + vst0) = st_v0; *(bf16x8*)(V_lds + (bf) * SHM + vst1) = st_v1; } while (0)
    __syncthreads();
    SB_SLOAD(t_hi - 1); VM_WAIT(); SB_SWRITE(0);
    __syncthreads();
    const float C2 = QK_SCALE * 1.4426950408889634f, b2 = F.in(I_SBB)[h] * 1.4426950408889634f;
    float carry = 1.f; f32x16 o[4] = {};
    int buf = 0;
    for (int t = t_hi - 1; t >= t_lo; --t) {
        if (t > t_lo) SB_SLOAD(t - 1);
        const int kb = 64 * t;
        if (kb < qlo + 31) {
            f32x16 p0, p1; bf16x8 pa0, pa1, pa2, pa3;
            qkt(p0, p1, K_lds + buf * SHM, r32, hi, qr);
            if (kb + 63 >= qlo) sb_weights<true>(p0, p1, carry, C2, b2, qpos - kb - 4 * hi, hi); else sb_weights<false>(p0, p1, carry, C2, b2, 0, hi);
            pack_p(p0, p1, pa0, pa1, pa2, pa3);
            pv_tile(o, vb0 + buf * SHM, pa0, pa1, pa2, pa3);
        }
        if (t > t_lo) { VM_WAIT(); SB_SWRITE(buf ^ 1); }
        __syncthreads();
        buf ^= 1;
    }
#undef SB_SLOAD
#undef SB_SWRITE
    float* Op = WSP(float, WS_OP) + ((size_t)half * NPR + b * SEQ + 256 * x + wid * 32) * 1024 + h * 128;
    const unsigned lo_ = (unsigned)(4 * hi * 1024 + r32);
#pragma unroll
    for (int r = 0; r < 16; ++r) { float* Opr = Op + (size_t)((r & 3) + 8 * (r >> 2)) * 1024;
#pragma unroll
        for (int d0 = 0; d0 < 4; ++d0) Opr[lo_ + d0 * 32] = o[d0][r]; }
    if (half == 0 && hi == 0) WSP(float, WS_CL)[(size_t)(b * SEQ + qpos) * HA + h] = carry;
}
#undef SB_KSWZ
#undef SB_SBAR
}
namespace sba {
__device__ __forceinline__ void sb_weights32(f32x16& p0, float& carry, float C2, float b2, int hi) {
    float T[4];
#pragma unroll
    for (int g = 0; g < 4; ++g) {
        float iv[4], be[4];
#pragma unroll
        for (int k = 0; k < 4; ++k) { const float z2 = fminf(fmaf(p0[g * 4 + k], C2, b2), 64.f), e = __builtin_amdgcn_exp2f(z2), i_ = __builtin_amdgcn_rcpf(1.f + e); iv[k] = i_; be[k] = e * i_; }
        const float ex2 = iv[3], ex1 = iv[2] * iv[3], ex0 = iv[1] * ex1; T[g] = iv[0] * ex0;
        p0[g * 4 + 0] = be[0] * ex0; p0[g * 4 + 1] = be[1] * ex1; p0[g * 4 + 2] = be[2] * ex2; p0[g * 4 + 3] = be[3];
    }
    float suf = carry;
#pragma unroll
    for (int g = 3; g >= 0; --g) { const float To = swap_other(T[g], hi); const float E = hi ? suf : suf * To;
#pragma unroll
        for (int k = 0; k < 4; ++k) p0[g * 4 + k] *= E;
        suf = suf * (T[g] * To); }
    carry = suf;
}
__device__ __forceinline__ void attn_sample_unit(Ctx& F, int bh, int pg, char* wl  ) {
    const int lane = F.lane, r32 = lane & 31, hi = lane >> 5, b = bh >> 3, h = bh & 7;
    char* K_lds = wl; char* V_lds = wl + 8192;
    bf16x8 qr[8];
    { const bf16* Qg = WSP(bf16, WS_QB) + (size_t)(NPR + b * DSEQ + (r32 & 7)) * LDQ + h * 128;
#pragma unroll
      for (int d0 = 0; d0 < 8; ++d0) { bf16x8 v = *reinterpret_cast<const bf16x8*>(Qg + d0 * 16 + hi * 8); if (r32 >= 8) v = bf16x8{}; qr[d0] = v; } }
    const int kl = lane >> 5, c4 = (lane & 31) * 4;
    const unsigned goff = (unsigned)(kl * 1024 + c4) * 4u;
    const int vb0 = (int)(uintptr_t)V_lds + v_rd_base(lane);
    const float C2 = QK_SCALE * 1.4426950408889634f, b2 = F.in(I_SBB)[h] * 1.4426950408889634f;
    const int* pt = ((const int*)F.in(I_PT)) + b * NPAGES + pg * 4;
    f32x4 sa[8], sb[8];
#define SU_BASE(n) ({ const int i_ = (n) >> 2, k_ = (n) & 3, tt_ = 15 - i_; const int phys_ = pt[tt_ >> 2]; \
        (const char*)((k_ & 2) ? F.in(I_CV) : F.in(I_CK)) + (((size_t)phys_ * PAGESZ + (tt_ & 3) * 32 + (k_ & 1) * 16) * 1024 + h * 128) * 4; })
#define SU_LOAD(S, n) do { const char* bp_ = SU_BASE(n); _Pragma("unroll") for (int j = 0; j < 8; ++j) S[j] = __builtin_nontemporal_load((const GAS f32x4*)(bp_ + goff + (size_t)j * 8192)); } while (0)
#define SU_WRK(S, kh) do { _Pragma("unroll") for (int j = 0; j < 8; ++j) { const int key = (kh) * 16 + 2 * j + kl; u32x2 w; w.x = cvt_pk_bf16(S[j].x, S[j].y); w.y = cvt_pk_bf16(S[j].z, S[j].w); \
        *(u32x2*)(K_lds + (key * 256 + ((c4 * 2) ^ ((key & 7) << 4)))) = w; } } while (0)
#define SU_WRV(S, kh) do { _Pragma("unroll") for (int j = 0; j < 8; ++j) { const int key = (kh) * 16 + 2 * j + kl; u32x2 w; w.x = cvt_pk_bf16(S[j].x, S[j].y); w.y = cvt_pk_bf16(S[j].z, S[j].w); \
        *(u32x2*)(V_lds + v_st(key, c4)) = w; } } while (0)
    SU_LOAD(sa, 0); SU_LOAD(sb, 1);
    float carry = 1.f; f32x16 o[4] = {};
    for (int i = 0; i < 16; ++i) {
        asm volatile("s_waitcnt vmcnt(8)" ::: "memory"); SU_WRK(sa, 0); SU_LOAD(sa, 4 * i + 2);
        asm volatile("s_waitcnt vmcnt(8)" ::: "memory"); SU_WRK(sb, 1); SU_LOAD(sb, 4 * i + 3);
        asm volatile("s_waitcnt vmcnt(8)" ::: "memory"); SU_WRV(sa, 0); if (i < 15) SU_LOAD(sa, 4 * i + 4);
        if (i < 15) asm volatile("s_waitcnt vmcnt(8)" ::: "memory"); else asm volatile("s_waitcnt vmcnt(0)" ::: "memory");
        SU_WRV(sb, 1); if (i < 15) SU_LOAD(sb, 4 * i + 5);
        asm volatile("s_waitcnt lgkmcnt(0)" ::: "memory");
        f32x16 p0 = f32x16{};
        { const char* kb[4];
#pragma unroll
          for (int dd = 0; dd < 4; ++dd) kb[dd] = K_lds + (r32 * 256 + (((dd * 16 + hi * 8) * 2) ^ ((r32 & 7) << 4)));
#pragma unroll
          for (int d0 = 0; d0 < 8; ++d0) { const bf16x8 b0 = *reinterpret_cast<const bf16x8*>(kb[d0 & 3] + (d0 >> 2) * 128); p0 = __builtin_amdgcn_mfma_f32_32x32x16_bf16(b0, qr[d0], p0, 0, 0, 0); } }
        sb_weights32(p0, carry, C2, b2, hi);
        bf16x8 pa0, pa1;
        { unsigned a0 = cvt_pk_bf16(p0[0], p0[1]), a1 = cvt_pk_bf16(p0[2], p0[3]), b0 = cvt_pk_bf16(p0[4], p0[5]), b1 = cvt_pk_bf16(p0[6], p0[7]);
          auto r0 = __builtin_amdgcn_permlane32_swap(a0, b0, false, false); auto r1 = __builtin_amdgcn_permlane32_swap(a1, b1, false, false);
          u32x4 w = {r0[0], r1[0], r0[1], r1[1]}; pa0 = *reinterpret_cast<bf16x8*>(&w); }
        { unsigned a0 = cvt_pk_bf16(p0[8], p0[9]), a1 = cvt_pk_bf16(p0[10], p0[11]), b0 = cvt_pk_bf16(p0[12], p0[13]), b1 = cvt_pk_bf16(p0[14], p0[15]);
          auto r0 = __builtin_amdgcn_permlane32_swap(a0, b0, false, false); auto r1 = __builtin_amdgcn_permlane32_swap(a1, b1, false, false);
          u32x4 w = {r0[0], r1[0], r0[1], r1[1]}; pa1 = *reinterpret_cast<bf16x8*>(&w); }
#define SU_TRRD(dst, off) asm volatile("ds_read_b64_tr_b16 %0, %1 offset:%2" : "=&v"(dst) : "v"(vb0), "i"(off) : "memory")
#define SU_PV(d0) do { s16x4 l0, l1, h0, h1; constexpr int b_ = (d0) * 512; SU_TRRD(l0, b_); SU_TRRD(h0, b_ + 2048); SU_TRRD(l1, b_ + 4096); SU_TRRD(h1, b_ + 6144); \
        asm volatile("s_waitcnt lgkmcnt(0)" ::: "memory"); __builtin_amdgcn_sched_barrier(0); \
        o[d0] = __builtin_amdgcn_mfma_f32_32x32x16_bf16(pa0, (bf16x8){l0[0], l0[1], l0[2], l0[3], h0[0], h0[1], h0[2], h0[3]}, o[d0], 0, 0, 0); \
        o[d0] = __builtin_amdgcn_mfma_f32_32x32x16_bf16(pa1, (bf16x8){l1[0], l1[1], l1[2], l1[3], h1[0], h1[1], h1[2], h1[3]}, o[d0], 0, 0, 0); } while (0)
        SU_PV(0); SU_PV(1); SU_PV(2); SU_PV(3);
        asm volatile("s_waitcnt lgkmcnt(0)" ::: "memory");
    }
#undef SU_PV
#undef SU_TRRD
#undef SU_WRV
#undef SU_WRK
#undef SU_LOAD
#undef SU_BASE
    float* Sp = WSP(float, WS_SPART) + ((size_t)(bh * 32 + pg) * 8) * 128;
#pragma unroll
    for (int r = 0; r < 4; ++r)
#pragma unroll
        for (int d0 = 0; d0 < 4; ++d0) Sp[(size_t)(r + 4 * hi) * 128 + d0 * 32 + r32] = o[d0][r];
    if (hi == 0 && r32 < 8) WSP(float, WS_SCAR)[(size_t)(bh * 32 + pg) * 8 + r32] = carry;
}
}
__device__ __forceinline__ void sample_combine(Ctx& F) {
    const int gw = F.vcu * NWAVES + F.wave, NGW = F.G * NWAVES; bf16* OAB = WSP(bf16, WS_OAB);
    const float* SPt = WSP(float, WS_SPART); const float* SCr = WSP(float, WS_SCAR);
    const int gw2 = NGW >= 1024 ? (gw >= 512 ? gw - 512 : gw + NGW - 512) : gw;
    for (int task = gw2; task < DBAT * HA * DSEQ; task += NGW) { const int bh = task >> 3, i = task & 7, b = bh >> 3, h = bh & 7; const float bias = F.in(I_SBB)[h];
        f32x2 po[32]; float sc[32];
#pragma unroll
        for (int pg = 0; pg < 32; ++pg) { po[pg] = *(const GAS f32x2*)(SPt + ((size_t)(bh * 32 + pg) * 8 + i) * 128 + 2 * F.lane); sc[pg] = SCr[(size_t)(bh * 32 + pg) * 8 + i]; }
        f32x2 q; { const unsigned qw = *(const GAS unsigned*)(WSP(bf16, WS_QB) + (size_t)(NPR + b * DSEQ + i) * 1024 + h * 128 + 2 * F.lane); q.x = __uint_as_float(qw << 16); q.y = __uint_as_float(qw & 0xffff0000u); }
        float carry = 1.f, a0 = 0.f, a1 = 0.f;
        f32x2 kn[DSEQ - 1], vn[DSEQ - 1];
#pragma unroll
        for (int jj = 0; jj < DSEQ - 1; ++jj) { const int j = i - 1 - jj, jc = j > 0 ? j : 0; const size_t ko = (size_t)(b * DSEQ + jc) * 1024 + h * 128 + 2 * F.lane;
            kn[jj] = *(const GAS f32x2*)(F.outp() + O_KS + ko); vn[jj] = *(const GAS f32x2*)(F.outp() + O_VS + ko); }
#pragma unroll
        for (int jj = 0; jj < DSEQ - 1; ++jj) { const bool valid = i - 1 - jj >= 0;
            const float z = wave_sum(q.x * kn[jj].x + q.y * kn[jj].y) * QK_SCALE + bias, e = valid ? __expf(fminf(z, 40.f)) : 0.f, om = 1.f / (1.f + e), w = e * om * carry;
            a0 += w * vn[jj].x; a1 += w * vn[jj].y; carry *= om; }
#pragma unroll
        for (int pg = 31; pg >= 0; --pg) { a0 += carry * po[pg].x; a1 += carry * po[pg].y; carry *= sc[pg]; }
        *(GAS unsigned*)(OAB + (size_t)(NPR + b * DSEQ + i) * DM + h * 128 + 2 * F.lane) = cvt_pk_bf16(a0, a1);
    }
}
__device__ __forceinline__ void phase_attn_prompt(Ctx& F) {
    for (int it2 = 2 * F.vcu; it2 < 2 * NBATCH * HA * 16; it2 += (it2 & 1) ? 2 * F.G - 1 : 1) { const int item = it2 >> 1, half = it2 & 1, bh = item >> 4, x = item & 15;
        sba::attn_half(F, bh, half ? 15 - x : x, half); }
    __syncthreads();
}
__device__ __forceinline__ void dots16(float& sig, float& rho, float kkv, float wrv, const float (&s)[16]) {
    asm("s_nop 1\n\t"
        "v_fmac_f32_dpp %0, %2, %4 row_newbcast:0 row_mask:0xf bank_mask:0xf\n\t"
        "v_fmac_f32_dpp %1, %3, %4 row_newbcast:0 row_mask:0xf bank_mask:0xf\n\t"
        "v_fmac_f32_dpp %0, %2, %5 row_newbcast:1 row_mask:0xf bank_mask:0xf\n\t"
        "v_fmac_f32_dpp %1, %3, %5 row_newbcast:1 row_mask:0xf bank_mask:0xf\n\t"
        "v_fmac_f32_dpp %0, %2, %6 row_newbcast:2 row_mask:0xf bank_mask:0xf\n\t"
        "v_fmac_f32_dpp %1, %3, %6 row_newbcast:2 row_mask:0xf bank_mask:0xf\n\t"
        "v_fmac_f32_dpp %0, %2, %7 row_newbcast:3 row_mask:0xf bank_mask:0xf\n\t"
        "v_fmac_f32_dpp %1, %3, %7 row_newbcast:3 row_mask:0xf bank_mask:0xf\n\t"
        "v_fmac_f32_dpp %0, %2, %8 row_newbcast:4 row_mask:0xf bank_mask:0xf\n\t"
        "v_fmac_f32_dpp %1, %3, %8 row_newbcast:4 row_mask:0xf bank_mask:0xf\n\t"
        "v_fmac_f32_dpp %0, %2, %9 row_newbcast:5 row_mask:0xf bank_mask:0xf\n\t"
        "v_fmac_f32_dpp %1, %3, %9 row_newbcast:5 row_mask:0xf bank_mask:0xf\n\t"
        "v_fmac_f32_dpp %0, %2, %10 row_newbcast:6 row_mask:0xf bank_mask:0xf\n\t"
        "v_fmac_f32_dpp %1, %3, %10 row_newbcast:6 row_mask:0xf bank_mask:0xf\n\t"
        "v_fmac_f32_dpp %0, %2, %11 row_newbcast:7 row_mask:0xf bank_mask:0xf\n\t"
        "v_fmac_f32_dpp %1, %3, %11 row_newbcast:7 row_mask:0xf bank_mask:0xf\n\t"
        "v_fmac_f32_dpp %0, %2, %12 row_newbcast:8 row_mask:0xf bank_mask:0xf\n\t"
        "v_fmac_f32_dpp %1, %3, %12 row_newbcast:8 row_mask:0xf bank_mask:0xf\n\t"
        "v_fmac_f32_dpp %0, %2, %13 row_newbcast:9 row_mask:0xf bank_mask:0xf\n\t"
        "v_fmac_f32_dpp %1, %3, %13 row_newbcast:9 row_mask:0xf bank_mask:0xf\n\t"
        "v_fmac_f32_dpp %0, %2, %14 row_newbcast:10 row_mask:0xf bank_mask:0xf\n\t"
        "v_fmac_f32_dpp %1, %3, %14 row_newbcast:10 row_mask:0xf bank_mask:0xf\n\t"
        "v_fmac_f32_dpp %0, %2, %15 row_newbcast:11 row_mask:0xf bank_mask:0xf\n\t"
        "v_fmac_f32_dpp %1, %3, %15 row_newbcast:11 row_mask:0xf bank_mask:0xf\n\t"
        "v_fmac_f32_dpp %0, %2, %16 row_newbcast:12 row_mask:0xf bank_mask:0xf\n\t"
        "v_fmac_f32_dpp %1, %3, %16 row_newbcast:12 row_mask:0xf bank_mask:0xf\n\t"
        "v_fmac_f32_dpp %0, %2, %17 row_newbcast:13 row_mask:0xf bank_mask:0xf\n\t"
        "v_fmac_f32_dpp %1, %3, %17 row_newbcast:13 row_mask:0xf bank_mask:0xf\n\t"
        "v_fmac_f32_dpp %0, %2, %18 row_newbcast:14 row_mask:0xf bank_mask:0xf\n\t"
        "v_fmac_f32_dpp %1, %3, %18 row_newbcast:14 row_mask:0xf bank_mask:0xf\n\t"
        "v_fmac_f32_dpp %0, %2, %19 row_newbcast:15 row_mask:0xf bank_mask:0xf\n\t"
        "v_fmac_f32_dpp %1, %3, %19 row_newbcast:15 row_mask:0xf bank_mask:0xf\n\t"
        "s_nop 1"
        : "+v"(sig), "+v"(rho) : "v"(kkv), "v"(wrv), "v"(s[0]), "v"(s[1]), "v"(s[2]), "v"(s[3]), "v"(s[4]), "v"(s[5]), "v"(s[6]), "v"(s[7]), "v"(s[8]), "v"(s[9]), "v"(s[10]), "v"(s[11]), "v"(s[12]), "v"(s[13]), "v"(s[14]), "v"(s[15]));
}
__device__ __forceinline__ void dot16(float& acc, float zv, const float (&s)[16]) {
    asm("s_nop 1\n\t"
        "v_fmac_f32_dpp %0, %1, %2 row_newbcast:0 row_mask:0xf bank_mask:0xf\n\t"
        "v_fmac_f32_dpp %0, %1, %3 row_newbcast:1 row_mask:0xf bank_mask:0xf\n\t"
        "v_fmac_f32_dpp %0, %1, %4 row_newbcast:2 row_mask:0xf bank_mask:0xf\n\t"
        "v_fmac_f32_dpp %0, %1, %5 row_newbcast:3 row_mask:0xf bank_mask:0xf\n\t"
        "v_fmac_f32_dpp %0, %1, %6 row_newbcast:4 row_mask:0xf bank_mask:0xf\n\t"
        "v_fmac_f32_dpp %0, %1, %7 row_newbcast:5 row_mask:0xf bank_mask:0xf\n\t"
        "v_fmac_f32_dpp %0, %1, %8 row_newbcast:6 row_mask:0xf bank_mask:0xf\n\t"
        "v_fmac_f32_dpp %0, %1, %9 row_newbcast:7 row_mask:0xf bank_mask:0xf\n\t"
        "v_fmac_f32_dpp %0, %1, %10 row_newbcast:8 row_mask:0xf bank_mask:0xf\n\t"
        "v_fmac_f32_dpp %0, %1, %11 row_newbcast:9 row_mask:0xf bank_mask:0xf\n\t"
        "v_fmac_f32_dpp %0, %1, %12 row_newbcast:10 row_mask:0xf bank_mask:0xf\n\t"
        "v_fmac_f32_dpp %0, %1, %13 row_newbcast:11 row_mask:0xf bank_mask:0xf\n\t"
        "v_fmac_f32_dpp %0, %1, %14 row_newbcast:12 row_mask:0xf bank_mask:0xf\n\t"
        "v_fmac_f32_dpp %0, %1, %15 row_newbcast:13 row_mask:0xf bank_mask:0xf\n\t"
        "v_fmac_f32_dpp %0, %1, %16 row_newbcast:14 row_mask:0xf bank_mask:0xf\n\t"
        "v_fmac_f32_dpp %0, %1, %17 row_newbcast:15 row_mask:0xf bank_mask:0xf\n\t"
        "s_nop 1"
        : "+v"(acc) : "v"(zv), "v"(s[0]), "v"(s[1]), "v"(s[2]), "v"(s[3]), "v"(s[4]), "v"(s[5]), "v"(s[6]), "v"(s[7]), "v"(s[8]), "v"(s[9]), "v"(s[10]), "v"(s[11]), "v"(s[12]), "v"(s[13]), "v"(s[14]), "v"(s[15]));
}
__device__ __forceinline__ void upd16_v(float (&s)[16], float wv, float kv, float bv, float vv, float ns) {
    asm("s_nop 1\n\t"
        "v_mul_f32_dpp %0, %16, %0 row_newbcast:0 row_mask:0xf bank_mask:0xf\n\t"
        "v_mul_f32_dpp %1, %16, %1 row_newbcast:1 row_mask:0xf bank_mask:0xf\n\t"
        "v_mul_f32_dpp %2, %16, %2 row_newbcast:2 row_mask:0xf bank_mask:0xf\n\t"
        "v_mul_f32_dpp %3, %16, %3 row_newbcast:3 row_mask:0xf bank_mask:0xf\n\t"
        "v_mul_f32_dpp %4, %16, %4 row_newbcast:4 row_mask:0xf bank_mask:0xf\n\t"
        "v_mul_f32_dpp %5, %16, %5 row_newbcast:5 row_mask:0xf bank_mask:0xf\n\t"
        "v_mul_f32_dpp %6, %16, %6 row_newbcast:6 row_mask:0xf bank_mask:0xf\n\t"
        "v_mul_f32_dpp %7, %16, %7 row_newbcast:7 row_mask:0xf bank_mask:0xf\n\t"
        "v_mul_f32_dpp %8, %16, %8 row_newbcast:8 row_mask:0xf bank_mask:0xf\n\t"
        "v_mul_f32_dpp %9, %16, %9 row_newbcast:9 row_mask:0xf bank_mask:0xf\n\t"
        "v_mul_f32_dpp %10, %16, %10 row_newbcast:10 row_mask:0xf bank_mask:0xf\n\t"
        "v_mul_f32_dpp %11, %16, %11 row_newbcast:11 row_mask:0xf bank_mask:0xf\n\t"
        "v_mul_f32_dpp %12, %16, %12 row_newbcast:12 row_mask:0xf bank_mask:0xf\n\t"
        "v_mul_f32_dpp %13, %16, %13 row_newbcast:13 row_mask:0xf bank_mask:0xf\n\t"
        "v_mul_f32_dpp %14, %16, %14 row_newbcast:14 row_mask:0xf bank_mask:0xf\n\t"
        "v_mul_f32_dpp %15, %16, %15 row_newbcast:15 row_mask:0xf bank_mask:0xf\n\t"
        "v_fmac_f32_dpp %0, %17, %19 row_newbcast:0 row_mask:0xf bank_mask:0xf\n\t"
        "v_fmac_f32_dpp %1, %17, %19 row_newbcast:1 row_mask:0xf bank_mask:0xf\n\t"
        "v_fmac_f32_dpp %2, %17, %19 row_newbcast:2 row_mask:0xf bank_mask:0xf\n\t"
        "v_fmac_f32_dpp %3, %17, %19 row_newbcast:3 row_mask:0xf bank_mask:0xf\n\t"
        "v_fmac_f32_dpp %4, %17, %19 row_newbcast:4 row_mask:0xf bank_mask:0xf\n\t"
        "v_fmac_f32_dpp %5, %17, %19 row_newbcast:5 row_mask:0xf bank_mask:0xf\n\t"
        "v_fmac_f32_dpp %6, %17, %19 row_newbcast:6 row_mask:0xf bank_mask:0xf\n\t"
        "v_fmac_f32_dpp %7, %17, %19 row_newbcast:7 row_mask:0xf bank_mask:0xf\n\t"
        "v_fmac_f32_dpp %8, %17, %19 row_newbcast:8 row_mask:0xf bank_mask:0xf\n\t"
        "v_fmac_f32_dpp %9, %17, %19 row_newbcast:9 row_mask:0xf bank_mask:0xf\n\t"
        "v_fmac_f32_dpp %10, %17, %19 row_newbcast:10 row_mask:0xf bank_mask:0xf\n\t"
        "v_fmac_f32_dpp %11, %17, %19 row_newbcast:11 row_mask:0xf bank_mask:0xf\n\t"
        "v_fmac_f32_dpp %12, %17, %19 row_newbcast:12 row_mask:0xf bank_mask:0xf\n\t"
        "v_fmac_f32_dpp %13, %17, %19 row_newbcast:13 row_mask:0xf bank_mask:0xf\n\t"
        "v_fmac_f32_dpp %14, %17, %19 row_newbcast:14 row_mask:0xf bank_mask:0xf\n\t"
        "v_fmac_f32_dpp %15, %17, %19 row_newbcast:15 row_mask:0xf bank_mask:0xf\n\t"
        "v_fmac_f32_dpp %0, %18, %20 row_newbcast:0 row_mask:0xf bank_mask:0xf\n\t"
        "v_fmac_f32_dpp %1, %18, %20 row_newbcast:1 row_mask:0xf bank_mask:0xf\n\t"
        "v_fmac_f32_dpp %2, %18, %20 row_newbcast:2 row_mask:0xf bank_mask:0xf\n\t"
        "v_fmac_f32_dpp %3, %18, %20 row_newbcast:3 row_mask:0xf bank_mask:0xf\n\t"
        "v_fmac_f32_dpp %4, %18, %20 row_newbcast:4 row_mask:0xf bank_mask:0xf\n\t"
        "v_fmac_f32_dpp %5, %18, %20 row_newbcast:5 row_mask:0xf bank_mask:0xf\n\t"
        "v_fmac_f32_dpp %6, %18, %20 row_newbcast:6 row_mask:0xf bank_mask:0xf\n\t"
        "v_fmac_f32_dpp %7, %18, %20 row_newbcast:7 row_mask:0xf bank_mask:0xf\n\t"
        "v_fmac_f32_dpp %8, %18, %20 row_newbcast:8 row_mask:0xf bank_mask:0xf\n\t"
        "v_fmac_f32_dpp %9, %18, %20 row_newbcast:9 row_mask:0xf bank_mask:0xf\n\t"
        "v_fmac_f32_dpp %10, %18, %20 row_newbcast:10 row_mask:0xf bank_mask:0xf\n\t"
        "v_fmac_f32_dpp %11, %18, %20 row_newbcast:11 row_mask:0xf bank_mask:0xf\n\t"
        "v_fmac_f32_dpp %12, %18, %20 row_newbcast:12 row_mask:0xf bank_mask:0xf\n\t"
        "v_fmac_f32_dpp %13, %18, %20 row_newbcast:13 row_mask:0xf bank_mask:0xf\n\t"
        "v_fmac_f32_dpp %14, %18, %20 row_newbcast:14 row_mask:0xf bank_mask:0xf\n\t"
        "v_fmac_f32_dpp %15, %18, %20 row_newbcast:15 row_mask:0xf bank_mask:0xf\n\t"
        "s_nop 1"
        : "+v"(s[0]), "+v"(s[1]), "+v"(s[2]), "+v"(s[3]), "+v"(s[4]), "+v"(s[5]), "+v"(s[6]), "+v"(s[7]), "+v"(s[8]), "+v"(s[9]), "+v"(s[10]), "+v"(s[11]), "+v"(s[12]), "+v"(s[13]), "+v"(s[14]), "+v"(s[15]) : "v"(wv), "v"(kv), "v"(bv), "v"(vv), "v"(ns));
}
__device__ __forceinline__ void upd16_nov(float (&s)[16], float wv, float kv, float bv, float vv, float ns) {
    asm("s_nop 1\n\t"
        "v_mul_f32_dpp %0, %16, %0 row_newbcast:0 row_mask:0xf bank_mask:0xf\n\t"
        "v_mul_f32_dpp %1, %16, %1 row_newbcast:1 row_mask:0xf bank_mask:0xf\n\t"
        "v_mul_f32_dpp %2, %16, %2 row_newbcast:2 row_mask:0xf bank_mask:0xf\n\t"
        "v_mul_f32_dpp %3, %16, %3 row_newbcast:3 row_mask:0xf bank_mask:0xf\n\t"
        "v_mul_f32_dpp %4, %16, %4 row_newbcast:4 row_mask:0xf bank_mask:0xf\n\t"
        "v_mul_f32_dpp %5, %16, %5 row_newbcast:5 row_mask:0xf bank_mask:0xf\n\t"
        "v_mul_f32_dpp %6, %16, %6 row_newbcast:6 row_mask:0xf bank_mask:0xf\n\t"
        "v_mul_f32_dpp %7, %16, %7 row_newbcast:7 row_mask:0xf bank_mask:0xf\n\t"
        "v_mul_f32_dpp %8, %16, %8 row_newbcast:8 row_mask:0xf bank_mask:0xf\n\t"
        "v_mul_f32_dpp %9, %16, %9 row_newbcast:9 row_mask:0xf bank_mask:0xf\n\t"
        "v_mul_f32_dpp %10, %16, %10 row_newbcast:10 row_mask:0xf bank_mask:0xf\n\t"
        "v_mul_f32_dpp %11, %16, %11 row_newbcast:11 row_mask:0xf bank_mask:0xf\n\t"
        "v_mul_f32_dpp %12, %16, %12 row_newbcast:12 row_mask:0xf bank_mask:0xf\n\t"
        "v_mul_f32_dpp %13, %16, %13 row_newbcast:13 row_mask:0xf bank_mask:0xf\n\t"
        "v_mul_f32_dpp %14, %16, %14 row_newbcast:14 row_mask:0xf bank_mask:0xf\n\t"
        "v_mul_f32_dpp %15, %16, %15 row_newbcast:15 row_mask:0xf bank_mask:0xf\n\t"
        "v_fmac_f32_dpp %0, %18, %20 row_newbcast:0 row_mask:0xf bank_mask:0xf\n\t"
        "v_fmac_f32_dpp %1, %18, %20 row_newbcast:1 row_mask:0xf bank_mask:0xf\n\t"
        "v_fmac_f32_dpp %2, %18, %20 row_newbcast:2 row_mask:0xf bank_mask:0xf\n\t"
        "v_fmac_f32_dpp %3, %18, %20 row_newbcast:3 row_mask:0xf bank_mask:0xf\n\t"
        "v_fmac_f32_dpp %4, %18, %20 row_newbcast:4 row_mask:0xf bank_mask:0xf\n\t"
        "v_fmac_f32_dpp %5, %18, %20 row_newbcast:5 row_mask:0xf bank_mask:0xf\n\t"
        "v_fmac_f32_dpp %6, %18, %20 row_newbcast:6 row_mask:0xf bank_mask:0xf\n\t"
        "v_fmac_f32_dpp %7, %18, %20 row_newbcast:7 row_mask:0xf bank_mask:0xf\n\t"
        "v_fmac_f32_dpp %8, %18, %20 row_newbcast:8 row_mask:0xf bank_mask:0xf\n\t"
        "v_fmac_f32_dpp %9, %18, %20 row_newbcast:9 row_mask:0xf bank_mask:0xf\n\t"
        "v_fmac_f32_dpp %10, %18, %20 row_newbcast:10 row_mask:0xf bank_mask:0xf\n\t"
        "v_fmac_f32_dpp %11, %18, %20 row_newbcast:11 row_mask:0xf bank_mask:0xf\n\t"
        "v_fmac_f32_dpp %12, %18, %20 row_newbcast:12 row_mask:0xf bank_mask:0xf\n\t"
        "v_fmac_f32_dpp %13, %18, %20 row_newbcast:13 row_mask:0xf bank_mask:0xf\n\t"
        "v_fmac_f32_dpp %14, %18, %20 row_newbcast:14 row_mask:0xf bank_mask:0xf\n\t"
        "v_fmac_f32_dpp %15, %18, %20 row_newbcast:15 row_mask:0xf bank_mask:0xf\n\t"
        "s_nop 1"
        : "+v"(s[0]), "+v"(s[1]), "+v"(s[2]), "+v"(s[3]), "+v"(s[4]), "+v"(s[5]), "+v"(s[6]), "+v"(s[7]), "+v"(s[8]), "+v"(s[9]), "+v"(s[10]), "+v"(s[11]), "+v"(s[12]), "+v"(s[13]), "+v"(s[14]), "+v"(s[15]) : "v"(wv), "v"(kv), "v"(bv), "v"(vv), "v"(ns));
}
__device__ __forceinline__ float xrow16_sum(float x) {
    auto s = __builtin_amdgcn_permlane16_swap(__float_as_uint(x), __float_as_uint(x), false, false);
    x = __uint_as_float(s[0]) + __uint_as_float(s[1]);
    auto t = __builtin_amdgcn_permlane32_swap(__float_as_uint(x), __float_as_uint(x), false, false);
    return __uint_as_float(t[0]) + __uint_as_float(t[1]);
}
struct StepIn { float wv, kkv, bv, kv, wrv, vv, beta, kappa; };
template <bool PROW> __device__ __forceinline__ void scan_load(StepIn& x, const float* RWV, const float* SCL, int r, int h, int lane, int row) {
    const float* base = RWV + ((size_t)r * HB + h) * 512; const float* sc = SCL + ((size_t)r * HB + h) * 4;
    x.wv = base[lane]; x.kkv = base[64 + lane]; x.bv = base[128 + lane]; x.wrv = base[384 + lane]; x.beta = sc[0];
    if (!PROW) { x.kv = base[192 + lane]; x.vv = base[320 + row]; x.kappa = sc[1]; } else { x.kv = 0.f; x.vv = 0.f; x.kappa = 0.f; }
}
template <bool PROW, bool SAMP> __device__ __forceinline__ void scan_wave(Ctx& F, int bh, int c, int g) {
    const int lane = F.lane, q = lane >> 4, m = lane & 15, row = 16 * g + m, h = bh & 15, b = bh >> 4;
    constexpr int L = SAMP ? DSEQ : 64; const int r0 = SAMP ? NPR + b * DSEQ : b * SEQ + c * 64; const int ch = bh * 64 + c;
    const float* RWV = WSP(float, WS_RWV); const float* SCL = WSP(float, WS_SCL); float* Y = WSP(float, WS_Y); float* Z = WSP(float, WS_Z); float* PU = WSP(float, WS_PU);
    float s[16];
    if (SAMP) { const float* st = F.in(I_SWKV) + ((size_t)bh * 64 + row) * 64 + 16 * q;
#pragma unroll
        for (int i = 0; i < 16; i += 4) { const f32x4 v = *(const GAS f32x4*)(st + i); s[i] = v.x; s[i + 1] = v.y; s[i + 2] = v.z; s[i + 3] = v.w; } }
    else {
#pragma unroll
        for (int i = 0; i < 16; ++i) s[i] = (PROW && (16 * q + i) == row) ? 1.f : 0.f; }
    StepIn buf[4];
#pragma unroll
    for (int u = 0; u < 4; ++u) scan_load<PROW>(buf[u], RWV, SCL, r0 + u, h, lane, row);
    for (int t = 0; t < L; t += 4) {
#pragma unroll
        for (int u = 0; u < 4; ++u) {
            const StepIn x = buf[u];
            if (t + u + 4 < L) scan_load<PROW>(buf[u], RWV, SCL, r0 + t + u + 4, h, lane, row);
            float sig = 0.f, rho = 0.f;
            dots16(sig, rho, x.kkv, x.wrv, s);
            sig = xrow16_sum(sig); rho = xrow16_sum(rho);
            const float ns = -sig;
            float y = rho + ns * x.beta; if (!PROW) y += x.vv * x.kappa;
            if (q == 0) { if (PROW) Z[((size_t)ch * 64 + t + u) * 64 + row] = y; else Y[(size_t)(r0 + t + u) * 1024 + h * 64 + row] = y; }
            if (PROW) upd16_nov(s, x.wv, x.kv, x.bv, x.vv, ns); else upd16_v(s, x.wv, x.kv, x.bv, x.vv, ns);
        }
    }
    float* dst = SAMP ? F.outp() + O_WKVS + ((size_t)bh * 64 + row) * 64 + 16 * q : PU + (((size_t)ch * 2 + (PROW ? 1 : 0)) * 64 + row) * 64 + 16 * q;
#pragma unroll
    for (int i = 0; i < 16; i += 4) *(GAS f32x4*)(dst + i) = (f32x4){s[i], s[i + 1], s[i + 2], s[i + 3]};
}
__device__ __forceinline__ void dots2_h0(float& sgu, float& rhu, float& sgp, float& rhp, float kkv, float wrv, const float (&su)[16], const float (&sp)[16]) {
    asm("s_nop 1\n\t"
        "v_fmac_f32_dpp %0, %4, %6 row_newbcast:0 row_mask:0xf bank_mask:0xf\n\t"
        "v_fmac_f32_dpp %1, %5, %6 row_newbcast:0 row_mask:0xf bank_mask:0xf\n\t"
        "v_fmac_f32_dpp %2, %4, %14 row_newbcast:0 row_mask:0xf bank_mask:0xf\n\t"
        "v_fmac_f32_dpp %3, %5, %14 row_newbcast:0 row_mask:0xf bank_mask:0xf\n\t"
        "v_fmac_f32_dpp %0, %4, %7 row_newbcast:1 row_mask:0xf bank_mask:0xf\n\t"
        "v_fmac_f32_dpp %1, %5, %7 row_newbcast:1 row_mask:0xf bank_mask:0xf\n\t"
        "v_fmac_f32_dpp %2, %4, %15 row_newbcast:1 row_mask:0xf bank_mask:0xf\n\t"
        "v_fmac_f32_dpp %3, %5, %15 row_newbcast:1 row_mask:0xf bank_mask:0xf\n\t"
        "v_fmac_f32_dpp %0, %4, %8 row_newbcast:2 row_mask:0xf bank_mask:0xf\n\t"
        "v_fmac_f32_dpp %1, %5, %8 row_newbcast:2 row_mask:0xf bank_mask:0xf\n\t"
        "v_fmac_f32_dpp %2, %4, %16 row_newbcast:2 row_mask:0xf bank_mask:0xf\n\t"
        "v_fmac_f32_dpp %3, %5, %16 row_newbcast:2 row_mask:0xf bank_mask:0xf\n\t"
        "v_fmac_f32_dpp %0, %4, %9 row_newbcast:3 row_mask:0xf bank_mask:0xf\n\t"
        "v_fmac_f32_dpp %1, %5, %9 row_newbcast:3 row_mask:0xf bank_mask:0xf\n\t"
        "v_fmac_f32_dpp %2, %4, %17 row_newbcast:3 row_mask:0xf bank_mask:0xf\n\t"
        "v_fmac_f32_dpp %3, %5, %17 row_newbcast:3 row_mask:0xf bank_mask:0xf\n\t"
        "v_fmac_f32_dpp %0, %4, %10 row_newbcast:4 row_mask:0xf bank_mask:0xf\n\t"
        "v_fmac_f32_dpp %1, %5, %10 row_newbcast:4 row_mask:0xf bank_mask:0xf\n\t"
        "v_fmac_f32_dpp %2, %4, %18 row_newbcast:4 row_mask:0xf bank_mask:0xf\n\t"
        "v_fmac_f32_dpp %3, %5, %18 row_newbcast:4 row_mask:0xf bank_mask:0xf\n\t"
        "v_fmac_f32_dpp %0, %4, %11 row_newbcast:5 row_mask:0xf bank_mask:0xf\n\t"
        "v_fmac_f32_dpp %1, %5, %11 row_newbcast:5 row_mask:0xf bank_mask:0xf\n\t"
        "v_fmac_f32_dpp %2, %4, %19 row_newbcast:5 row_mask:0xf bank_mask:0xf\n\t"
        "v_fmac_f32_dpp %3, %5, %19 row_newbcast:5 row_mask:0xf bank_mask:0xf\n\t"
        "v_fmac_f32_dpp %0, %4, %12 row_newbcast:6 row_mask:0xf bank_mask:0xf\n\t"
        "v_fmac_f32_dpp %1, %5, %12 row_newbcast:6 row_mask:0xf bank_mask:0xf\n\t"
        "v_fmac_f32_dpp %2, %4, %20 row_newbcast:6 row_mask:0xf bank_mask:0xf\n\t"
        "v_fmac_f32_dpp %3, %5, %20 row_newbcast:6 row_mask:0xf bank_mask:0xf\n\t"
        "v_fmac_f32_dpp %0, %4, %13 row_newbcast:7 row_mask:0xf bank_mask:0xf\n\t"
        "v_fmac_f32_dpp %1, %5, %13 row_newbcast:7 row_mask:0xf bank_mask:0xf\n\t"
        "v_fmac_f32_dpp %2, %4, %21 row_newbcast:7 row_mask:0xf bank_mask:0xf\n\t"
        "v_fmac_f32_dpp %3, %5, %21 row_newbcast:7 row_mask:0xf bank_mask:0xf\n\t"
        "s_nop 1"
        : "+v"(sgu), "+v"(rhu), "+v"(sgp), "+v"(rhp) : "v"(kkv), "v"(wrv), "v"(su[0]), "v"(su[1]), "v"(su[2]), "v"(su[3]), "v"(su[4]), "v"(su[5]), "v"(su[6]), "v"(su[7]), "v"(sp[0]), "v"(sp[1]), "v"(sp[2]), "v"(sp[3]), "v"(sp[4]), "v"(sp[5]), "v"(sp[6]), "v"(sp[7]));
}
__device__ __forceinline__ void dots2_h1(float& sgu, float& rhu, float& sgp, float& rhp, float kkv, float wrv, const float (&su)[16], const float (&sp)[16]) {
    asm("s_nop 1\n\t"
        "v_fmac_f32_dpp %0, %4, %6 row_newbcast:8 row_mask:0xf bank_mask:0xf\n\t"
        "v_fmac_f32_dpp %1, %5, %6 row_newbcast:8 row_mask:0xf bank_mask:0xf\n\t"
        "v_fmac_f32_dpp %2, %4, %14 row_newbcast:8 row_mask:0xf bank_mask:0xf\n\t"
        "v_fmac_f32_dpp %3, %5, %14 row_newbcast:8 row_mask:0xf bank_mask:0xf\n\t"
        "v_fmac_f32_dpp %0, %4, %7 row_newbcast:9 row_mask:0xf bank_mask:0xf\n\t"
        "v_fmac_f32_dpp %1, %5, %7 row_newbcast:9 row_mask:0xf bank_mask:0xf\n\t"
        "v_fmac_f32_dpp %2, %4, %15 row_newbcast:9 row_mask:0xf bank_mask:0xf\n\t"
        "v_fmac_f32_dpp %3, %5, %15 row_newbcast:9 row_mask:0xf bank_mask:0xf\n\t"
        "v_fmac_f32_dpp %0, %4, %8 row_newbcast:10 row_mask:0xf bank_mask:0xf\n\t"
        "v_fmac_f32_dpp %1, %5, %8 row_newbcast:10 row_mask:0xf bank_mask:0xf\n\t"
        "v_fmac_f32_dpp %2, %4, %16 row_newbcast:10 row_mask:0xf bank_mask:0xf\n\t"
        "v_fmac_f32_dpp %3, %5, %16 row_newbcast:10 row_mask:0xf bank_mask:0xf\n\t"
        "v_fmac_f32_dpp %0, %4, %9 row_newbcast:11 row_mask:0xf bank_mask:0xf\n\t"
        "v_fmac_f32_dpp %1, %5, %9 row_newbcast:11 row_mask:0xf bank_mask:0xf\n\t"
        "v_fmac_f32_dpp %2, %4, %17 row_newbcast:11 row_mask:0xf bank_mask:0xf\n\t"
        "v_fmac_f32_dpp %3, %5, %17 row_newbcast:11 row_mask:0xf bank_mask:0xf\n\t"
        "v_fmac_f32_dpp %0, %4, %10 row_newbcast:12 row_mask:0xf bank_mask:0xf\n\t"
        "v_fmac_f32_dpp %1, %5, %10 row_newbcast:12 row_mask:0xf bank_mask:0xf\n\t"
        "v_fmac_f32_dpp %2, %4, %18 row_newbcast:12 row_mask:0xf bank_mask:0xf\n\t"
        "v_fmac_f32_dpp %3, %5, %18 row_newbcast:12 row_mask:0xf bank_mask:0xf\n\t"
        "v_fmac_f32_dpp %0, %4, %11 row_newbcast:13 row_mask:0xf bank_mask:0xf\n\t"
        "v_fmac_f32_dpp %1, %5, %11 row_newbcast:13 row_mask:0xf bank_mask:0xf\n\t"
        "v_fmac_f32_dpp %2, %4, %19 row_newbcast:13 row_mask:0xf bank_mask:0xf\n\t"
        "v_fmac_f32_dpp %3, %5, %19 row_newbcast:13 row_mask:0xf bank_mask:0xf\n\t"
        "v_fmac_f32_dpp %0, %4, %12 row_newbcast:14 row_mask:0xf bank_mask:0xf\n\t"
        "v_fmac_f32_dpp %1, %5, %12 row_newbcast:14 row_mask:0xf bank_mask:0xf\n\t"
        "v_fmac_f32_dpp %2, %4, %20 row_newbcast:14 row_mask:0xf bank_mask:0xf\n\t"
        "v_fmac_f32_dpp %3, %5, %20 row_newbcast:14 row_mask:0xf bank_mask:0xf\n\t"
        "v_fmac_f32_dpp %0, %4, %13 row_newbcast:15 row_mask:0xf bank_mask:0xf\n\t"
        "v_fmac_f32_dpp %1, %5, %13 row_newbcast:15 row_mask:0xf bank_mask:0xf\n\t"
        "v_fmac_f32_dpp %2, %4, %21 row_newbcast:15 row_mask:0xf bank_mask:0xf\n\t"
        "v_fmac_f32_dpp %3, %5, %21 row_newbcast:15 row_mask:0xf bank_mask:0xf\n\t"
        "s_nop 1"
        : "+v"(sgu), "+v"(rhu), "+v"(sgp), "+v"(rhp) : "v"(kkv), "v"(wrv), "v"(su[8]), "v"(su[9]), "v"(su[10]), "v"(su[11]), "v"(su[12]), "v"(su[13]), "v"(su[14]), "v"(su[15]), "v"(sp[8]), "v"(sp[9]), "v"(sp[10]), "v"(sp[11]), "v"(sp[12]), "v"(sp[13]), "v"(sp[14]), "v"(sp[15]));
}
__device__ __forceinline__ void scan_wave_up(Ctx& F, int bh, int c, int g) {
    const int lane = F.lane, q = lane >> 4, m = lane & 15, row = 16 * g + m, h = bh & 15, b = bh >> 4;
    const int r0 = b * SEQ + c * 64, ch = bh * 64 + c;
    const float* RWV = WSP(float, WS_RWV); const float* SCL = WSP(float, WS_SCL); float* Y = WSP(float, WS_Y); float* Z = WSP(float, WS_Z); float* PU = WSP(float, WS_PU);
    float su[16], sp[16];
#pragma unroll
    for (int i = 0; i < 16; ++i) { su[i] = 0.f; sp[i] = ((16 * q + i) == row) ? 1.f : 0.f; }
    StepIn buf[4];
#pragma unroll
    for (int u = 0; u < 4; ++u) scan_load<false>(buf[u], RWV, SCL, r0 + u, h, lane, row);
    for (int t = 0; t < 64; t += 4) {
#pragma unroll
        for (int u = 0; u < 4; ++u) {
            const StepIn x = buf[u];
            if (t + u + 4 < 64) scan_load<false>(buf[u], RWV, SCL, r0 + t + u + 4, h, lane, row);
            float sgu = 0.f, rhu = 0.f, sgp = 0.f, rhp = 0.f;
            dots2_h0(sgu, rhu, sgp, rhp, x.kkv, x.wrv, su, sp); dots2_h1(sgu, rhu, sgp, rhp, x.kkv, x.wrv, su, sp);
            sgu = xrow16_sum(sgu); rhu = xrow16_sum(rhu); sgp = xrow16_sum(sgp); rhp = xrow16_sum(rhp);
            const float nsu = -sgu, nsp = -sgp;
            const float y = rhu + nsu * x.beta + x.vv * x.kappa, z = rhp + nsp * x.beta;
            if (q == 0) { Y[(size_t)(r0 + t + u) * 1024 + h * 64 + row] = y; Z[((size_t)ch * 64 + t + u) * 64 + row] = z; }
            upd16_v(su, x.wv, x.kv, x.bv, x.vv, nsu); upd16_nov(sp, x.wv, x.kv, x.bv, x.vv, nsp);
        }
    }
    float* du = PU + (((size_t)ch * 2 + 0) * 64 + row) * 64 + 16 * q; float* dp = PU + (((size_t)ch * 2 + 1) * 64 + row) * 64 + 16 * q;
#pragma unroll
    for (int i = 0; i < 16; i += 4) { *(GAS f32x4*)(du + i) = (f32x4){su[i], su[i + 1], su[i + 2], su[i + 3]}; *(GAS f32x4*)(dp + i) = (f32x4){sp[i], sp[i + 1], sp[i + 2], sp[i + 3]}; }
}
__device__ __forceinline__ void phase_scan1_stream(Ctx& F) {
    LAS int* ctr = (LAS int*)(F.lds + LDSCTL_OFF);
    __syncthreads(); if (F.tid == 0) *ctr = 0; __syncthreads();
    if (F.wave >= 6) { for (int u = F.vcu * 2 + (F.wave - 6); u < DBAT * HA * 32; u += 2 * F.G) sba::attn_sample_unit(F, u >> 5, u & 31, (char*)F.lds + F.wave * 16384); }
    constexpr int NSU = DBAT * HB / 2, NU = NSU + NBATCH * HB * 64;
    const int nunits = F.vcu < NU ? (NU - 1 - F.vcu) / F.G + 1 : 0, ntasks = nunits * 8;
    for (;;) {
        int t = 0; if (F.lane == 0) t = __hip_atomic_fetch_add(ctr, 1, __ATOMIC_RELAXED, __HIP_MEMORY_SCOPE_WORKGROUP);
        t = __builtin_amdgcn_readfirstlane(t); if (t >= ntasks) break;
        const int u = F.vcu + (t >> 3) * F.G, g8 = t & 7;
        if (u < NSU) scan_wave<false, true>(F, u * 2 + (g8 >> 2), 0, g8 & 3);
        else if (g8 < 4) { const int ch = u - NSU; scan_wave_up(F, ch >> 6, ch & 63, g8); }
    }
}
namespace msc {
using sba::bf16x8; using sba::f32x16; using sba::crow; using sba::swap_other;
constexpr int S_AQ = 136, S_BKT = 104, S_L = 40;
constexpr int O_AQ = 0, O_BK = 32 * S_AQ, O_L24 = O_BK, O_TL3 = O_BK + 32 * S_L, O_BKT = 2 * 32 * S_AQ, BLK_BYTES = O_BKT + 64 * S_BKT, O_GL = 4 * BLK_BYTES, O_GP = O_GL + 256, GRP_BYTES = O_GP + 4 * 256;
static_assert(BLK_BYTES % 8 == 0 && 2 * GRP_BYTES <= RING_BYTES, "scan LDS map");
typedef __bf16 nbf2 __attribute__((ext_vector_type(2)));
__device__ __forceinline__ unsigned cvt2(float lo, float hi) { return __builtin_bit_cast(unsigned, __builtin_convertvector((f32x2){lo, hi}, nbf2)); }
__device__ __forceinline__ bf16x8 pack8(float a0, float a1, float a2, float a3, float a4, float a5, float a6, float a7) {
    u32x4 w = {cvt2(a0, a1), cvt2(a2, a3), cvt2(a4, a5), cvt2(a6, a7)}; return *reinterpret_cast<bf16x8*>(&w); }
__device__ __forceinline__ bf16x8 pack_lo(const f32x16& c) { return pack8(c[0], c[1], c[2], c[3], c[4], c[5], c[6], c[7]); }
__device__ __forceinline__ bf16x8 pack_hi(const f32x16& c) { return pack8(c[8], c[9], c[10], c[11], c[12], c[13], c[14], c[15]); }
__device__ __forceinline__ bf16x8 perm_read(const LAS char* img, int row, int pitch, int col0, int g) {
    const LAS char* p = img + row * pitch + (col0 + 4 * g) * 2; const u32x2 lo = *(const LAS u32x2*)p, hi = *(const LAS u32x2*)(p + 16);
    u32x4 w = {lo.x, lo.y, hi.x, hi.y}; return *reinterpret_cast<bf16x8*>(&w); }
__device__ __forceinline__ bf16x8 nat_read(const LAS char* img, int row, int pitch, int col0) {
    const LAS char* p = img + row * pitch + col0 * 2; const u32x2 lo = *(const LAS u32x2*)p, hi = *(const LAS u32x2*)(p + 8);
    u32x4 w = {lo.x, lo.y, hi.x, hi.y}; return *reinterpret_cast<bf16x8*>(&w); }
__device__ __forceinline__ unsigned short bf1(float x) { return (unsigned short)(cvt_pk_bf16(x, 0.f) & 0xffffu); }
struct PrepRegs { float pr[17], pk[17], pv[17], lwl[16]; const bf16* lw; };
__device__ __forceinline__ void prep_load(Ctx& F, PrepRegs& L, int rb, int h) {
    const bf16* pb = WSP(bf16, WS_PBH) + (size_t)rb * 3072 + h * 64 + F.lane; const bf16* lw = WSP(bf16, WS_LWH) + (size_t)rb * 3072 + h * 64 + F.lane;
    L.lw = lw;
#pragma unroll
    for (int t = 0; t < 16; ++t) L.lwl[t] = ldbf_nt(lw + (size_t)t * 3072);
    if ((rb & (SEQ - 1)) != 0) { L.pr[0] = ldbf_nt(pb - 3072); L.pk[0] = ldbf_nt(pb + 1024 - 3072); L.pv[0] = ldbf_nt(pb + 2048 - 3072); } else { L.pr[0] = 0.f; L.pk[0] = 0.f; L.pv[0] = 0.f; }
#pragma unroll
    for (int t = 0; t < 16; ++t) { L.pr[t + 1] = ldbf_nt(pb + (size_t)t * 3072); L.pk[t + 1] = ldbf_nt(pb + (size_t)t * 3072 + 1024); L.pv[t + 1] = ldbf_nt(pb + (size_t)t * 3072 + 2048); }
}
__device__ __forceinline__ void prep_block(Ctx& F, PrepRegs& L, int rb, int h, int j, LAS char* gbase) {
    const int lane = F.lane, n = lane & 31, hi = lane >> 5, col = h * 64 + lane; LAS char* blk = gbase + j * BLK_BYTES;
    float lal[16];
#pragma unroll
    for (int t = 0; t < 16; ++t) lal[t] = ldbf_nt(L.lw + (size_t)t * 3072 + 1024);
    const float* mu = F.in(I_MU); const float mu_r = mu[col], mu_k = mu[1024 + col], mu_v = mu[2048 + col];
    const float w0 = F.in(I_W0)[col], a0 = F.in(I_A0)[col], kkw = F.in(I_KK)[col], kaw = F.in(I_KA)[col], rkw = F.in(I_RK)[col];
    float cw[16];
#pragma unroll
    for (int t = 0; t < 16; ++t) { const float wl = w0 + L.lwl[t], wlog = -softplusf_(-wl) - 0.5f; cw[t] = __expf(-__expf(wlog)); }
#pragma unroll
    for (int t = 1; t < 16; ++t) cw[t] *= cw[t - 1];
    *(LAS float*)(gbase + O_GP + (j * 64 + lane) * 4) = cw[15];
    __syncthreads();
    const float g0 = *(const LAS float*)(gbase + O_GP + lane * 4), g1 = *(const LAS float*)(gbase + O_GP + (64 + lane) * 4), g2 = *(const LAS float*)(gbase + O_GP + (128 + lane) * 4);
    const float G0 = (j > 0 ? g0 : 1.f) * (j > 1 ? g1 : 1.f) * (j > 2 ? g2 : 1.f);
    if (j == 3) *(LAS float*)(gbase + O_GL + lane * 4) = G0 * cw[15];
    float* SCL = WSP(float, WS_SCL) + ((size_t)rb * HB + h) * 4;
#pragma unroll
    for (int tl = 0; tl < 16; tl += 2) {
        float nb[2], kt[2], vz[2];
#pragma unroll
        for (int u = 0; u < 2; ++u) { const int t = tl + u;
            const float zr = L.pr[t + 1] + mu_r * (L.pr[t] - L.pr[t + 1]), zk = L.pk[t + 1] + mu_k * (L.pk[t] - L.pk[t + 1]); vz[u] = L.pv[t + 1] + mu_v * (L.pv[t] - L.pv[t + 1]);
            const float a_ = sigmoidf_(a0 + lal[t]);
            const float kkr = zk * kkw, kk = kkr * rsqrtf(wave_sum(kkr * kkr) + 1e-12f);
            const float k = zk * (1.f + (a_ - 1.f) * kaw), bb = kk * a_;
            const float bonus = wave_sum(zr * k * rkw);
            if (lane == 0) SCL[(size_t)t * HB * 4 + 2] = bonus;
            const float Gp = t ? G0 * cw[t ? t - 1 : 0] : G0, G = G0 * cw[t], gi = 1.f / G;
            const float a = kk * Gp, q = zr * G, bt = bb * gi; kt[u] = k * gi; nb[u] = -bt;
            *(LAS unsigned short*)(blk + O_AQ + t * S_AQ + lane * 2) = bf1(a); *(LAS unsigned short*)(blk + O_AQ + (16 + t) * S_AQ + lane * 2) = bf1(q);
            *(LAS unsigned short*)(blk + O_BK + t * S_AQ + lane * 2) = bf1(bt); *(LAS unsigned short*)(blk + O_BK + (16 + t) * S_AQ + lane * 2) = bf1(kt[u]); }
        *(LAS unsigned*)(blk + O_BKT + lane * S_BKT + tl * 2) = cvt_pk_bf16(nb[0], nb[1]); *(LAS unsigned*)(blk + O_BKT + lane * S_BKT + (16 + tl) * 2) = cvt_pk_bf16(kt[0], kt[1]);
        *(LAS unsigned*)(blk + O_BKT + lane * S_BKT + (32 + tl) * 2) = cvt_pk_bf16(vz[0], vz[1]);
    }
    LDS_WAIT(); asm volatile("" ::: "memory");
    f32x16 mt = f32x16{};
#pragma unroll
    for (int ks = 0; ks < 4; ++ks) mt = __builtin_amdgcn_mfma_f32_32x32x16_bf16(nat_read(blk + O_AQ, n, S_AQ, 16 * ks + 8 * hi), nat_read(blk + O_BK, n, S_AQ, 16 * ks + 8 * hi), mt, 0, 0, 0);
    float l1[8];
    const int i = n & 15;
#pragma unroll
    for (int r = 0; r < 16; ++r) { const int t = crow(r, hi) & 15; float val = mt[r];
        if (r < 8) { val = t > i ? val : 0.f; if (n >= 16) *(LAS unsigned short*)(blk + O_L24 + t * S_L + i * 2) = bf1(val); l1[r] = val; }
        else { val = t >= i ? val : 0.f; if (n >= 16) *(LAS unsigned short*)(blk + O_L24 + (16 + t) * S_L + i * 2) = bf1(val); else *(LAS unsigned short*)(blk + O_TL3 + (16 + t) * S_L + i * 2) = bf1(-val); } }
    float rowv[16];
#pragma unroll
    for (int r = 0; r < 8; ++r) { const float own = l1[r], oth = swap_other(own, hi); const int p0 = (r & 3) + 8 * (r >> 2); rowv[p0] = hi ? oth : own; rowv[p0 + 4] = hi ? own : oth; }
    float tl_[16];
    tl_[0] = lane == 0 ? 1.f : 0.f;
#pragma unroll
    for (int t = 1; t < 16; ++t) { float acc = lane == t ? 1.f : 0.f;
#pragma unroll
        for (int jj = 0; jj < t; ++jj) acc -= readlane_f(rowv[t], jj) * tl_[jj];
        tl_[t] = acc; }
    if (lane < 16) {
#pragma unroll
        for (int t = 0; t < 16; ++t) *(LAS unsigned short*)(blk + O_TL3 + t * S_L + lane * 2) = bf1(tl_[t]); }
    LDS_WAIT(); asm volatile("" ::: "memory");
}
__device__ __forceinline__ void chain(Ctx& F, int bh, int c, int isP, int half, const LAS char* gbase) {
    const int lane = F.lane, n = lane & 31, hi = lane >> 5, rowg = 32 * half + n, h = bh & 15, b = bh >> 4, r0 = b * SEQ + c * 64, ch = bh * 64 + c;
    const float* RWV = WSP(float, WS_RWV);
    f32x16 st0 = f32x16{}, st1 = f32x16{};
    if (isP) {
#pragma unroll
        for (int r = 0; r < 16; ++r) { st0[r] = crow(r, hi) == rowg ? 1.f : 0.f; st1[r] = 32 + crow(r, hi) == rowg ? 1.f : 0.f; } }
    for (int blk_i = 0; blk_i < 4; ++blk_i) {
        const LAS char* blk = gbase + blk_i * BLK_BYTES;
        f32x16 wt = f32x16{};
        wt = __builtin_amdgcn_mfma_f32_32x32x16_bf16(perm_read(blk + O_AQ, n, S_AQ, 0, hi), pack_lo(st0), wt, 0, 0, 0);
        wt = __builtin_amdgcn_mfma_f32_32x32x16_bf16(perm_read(blk + O_AQ, n, S_AQ, 16, hi), pack_hi(st0), wt, 0, 0, 0);
        wt = __builtin_amdgcn_mfma_f32_32x32x16_bf16(perm_read(blk + O_AQ, n, S_AQ, 32, hi), pack_lo(st1), wt, 0, 0, 0);
        wt = __builtin_amdgcn_mfma_f32_32x32x16_bf16(perm_read(blk + O_AQ, n, S_AQ, 48, hi), pack_hi(st1), wt, 0, 0, 0);
        bf16x8 bV = bf16x8{};
        if (!isP) { bV = perm_read(blk + O_BKT, rowg, S_BKT, 32, hi);
            wt = __builtin_amdgcn_mfma_f32_32x32x16_bf16(perm_read(blk + O_L24, n, S_L, 0, hi), bV, wt, 0, 0, 0); }
        const bf16x8 tl3 = perm_read(blk + O_TL3, n, S_L, 0, hi);
        const bf16x8 a_tl = n < 16 ? tl3 : bf16x8{}, a_l3 = n >= 16 ? tl3 : bf16x8{};
        const f32x16 sg = __builtin_amdgcn_mfma_f32_32x32x16_bf16(a_tl, pack_lo(wt), f32x16{}, 0, 0, 0);
        const bf16x8 bSg = pack_lo(sg);
        const f32x16 yy = __builtin_amdgcn_mfma_f32_32x32x16_bf16(a_l3, bSg, wt, 0, 0, 0);
#pragma unroll
        for (int r = 8; r < 16; ++r) { const int t = blk_i * 16 + (r & 3) + 8 * ((r - 8) >> 2) + 4 * hi;
            if (isP) WSP(float, WS_Z)[((size_t)ch * 64 + t) * 64 + rowg] = yy[r]; else WSP(float, WS_Y)[(size_t)(r0 + t) * 1024 + h * 64 + rowg] = yy[r]; }
        st0 = __builtin_amdgcn_mfma_f32_32x32x16_bf16(perm_read(blk + O_BKT, n, S_BKT, 0, hi), bSg, st0, 0, 0, 0);
        st1 = __builtin_amdgcn_mfma_f32_32x32x16_bf16(perm_read(blk + O_BKT, 32 + n, S_BKT, 0, hi), bSg, st1, 0, 0, 0);
        if (!isP) { st0 = __builtin_amdgcn_mfma_f32_32x32x16_bf16(perm_read(blk + O_BKT, n, S_BKT, 16, hi), bV, st0, 0, 0, 0);
                    st1 = __builtin_amdgcn_mfma_f32_32x32x16_bf16(perm_read(blk + O_BKT, 32 + n, S_BKT, 16, hi), bV, st1, 0, 0, 0); }
    }
    const LAS float* GL = (const LAS float*)(gbase + O_GL); float* dst = WSP(float, WS_PU) + (((size_t)ch * 2 + isP) * 64 + rowg) * 64;
#pragma unroll
    for (int g4 = 0; g4 < 4; ++g4) { const int k0 = 8 * g4 + 4 * hi; const f32x4 ga = *(const LAS f32x4*)(GL + k0), gb = *(const LAS f32x4*)(GL + 32 + k0);
        *(GAS f32x4*)(dst + k0) = (f32x4){st0[4 * g4] * ga.x, st0[4 * g4 + 1] * ga.y, st0[4 * g4 + 2] * ga.z, st0[4 * g4 + 3] * ga.w};
        *(GAS f32x4*)(dst + 32 + k0) = (f32x4){st1[4 * g4] * gb.x, st1[4 * g4 + 1] * gb.y, st1[4 * g4 + 2] * gb.z, st1[4 * g4 + 3] * gb.w}; }
}
}
__device__ __forceinline__ void phase_sample_stream(Ctx& F) {
    for (int u = F.vcu * NWAVES + F.wave; u < DBAT * HA * 32; u += NWAVES * F.G) sba::attn_sample_unit(F, (u >> 8) * HA + (u & 7), (u >> 3) & 31, (char*)F.lds + F.wave * 16384);
}
__device__ __forceinline__ void phase_scan1_mfma(Ctx& F) {
    __syncthreads();
    const int grp = F.wave >> 2, wq = F.wave & 3; LAS char* gbase = (LAS char*)F.lds + grp * msc::GRP_BYTES;
    msc::PrepRegs L;
    { const int ch = 2 * F.vcu + grp; if (ch < NBATCH * HB * 64) msc::prep_load(F, L, (ch >> 10) * SEQ + (ch & 63) * 64 + 16 * wq, (ch >> 6) & 15); }
    for (int base = 2 * F.vcu; base < NBATCH * HB * 64; base += 2 * F.G) {
        const int ch = base + grp, bh = ch >> 6, c = ch & 63;
        msc::prep_block(F, L, (bh >> 4) * SEQ + c * 64 + 16 * wq, bh & 15, wq, gbase);
        __syncthreads();
        { const int chn = ch + 2 * F.G; if (chn < NBATCH * HB * 64) msc::prep_load(F, L, (chn >> 10) * SEQ + (chn & 63) * 64 + 16 * wq, (chn >> 6) & 15); }
        msc::chain(F, bh, c, wq >> 1, wq & 1, gbase);
    }
}
__device__ __forceinline__ void phase_scan2(Ctx& F) {
    LAS float* Pb = (LAS float*)(F.lds + 4096);
    const float* PU = WSP(float, WS_PU); float* SC = WSP(float, WS_SC);
    for (int unit = F.vcu; unit < NBATCH * HB * 8; unit += F.G) {
        const int bh = unit >> 3, r0 = (unit & 7) * 8, r = F.wave, col = F.lane;
        __syncthreads();
        { const float* P0 = PU + ((size_t)(bh * 64) * 2 + 1) * 4096; const f32x4 a = *(const GAS f32x4*)(P0 + F.tid * 4), bq = *(const GAS f32x4*)(P0 + 2048 + F.tid * 4);
          *(LAS f32x4*)(Pb + F.tid * 4) = a; *(LAS f32x4*)(Pb + 2048 + F.tid * 4) = bq; }
        float ucur = PU[((size_t)(bh * 64) * 2 + 0) * 4096 + (r0 + r) * 64 + col], scur = 0.f;
        __syncthreads();
        for (int c = 0; c < 64; ++c) {
            const int ch = bh * 64 + c; LAS float* Pc = Pb + (c & 1) * 4096;
            SC[((size_t)ch * 64 + r0 + r) * 64 + col] = scur;
            f32x4 pa = {0.f, 0.f, 0.f, 0.f}, pq = {0.f, 0.f, 0.f, 0.f}; float unext = 0.f;
            if (c + 1 < 64) { const float* Pn = PU + ((size_t)(ch + 1) * 2 + 1) * 4096; pa = *(const GAS f32x4*)(Pn + F.tid * 4); pq = *(const GAS f32x4*)(Pn + 2048 + F.tid * 4);
                unext = PU[((size_t)(ch + 1) * 2 + 0) * 4096 + (r0 + r) * 64 + col]; }
            float a0 = ucur, a1 = 0.f, a2 = 0.f, a3 = 0.f;
#pragma unroll
            for (int j = 0; j < 64; j += 4) {
                const float s0 = readlane_f(scur, j), s1 = readlane_f(scur, j + 1), s2 = readlane_f(scur, j + 2), s3 = readlane_f(scur, j + 3);
                a0 += s0 * Pc[(j + 0) * 64 + col]; a1 += s1 * Pc[(j + 1) * 64 + col]; a2 += s2 * Pc[(j + 2) * 64 + col]; a3 += s3 * Pc[(j + 3) * 64 + col]; }
            const float acc = (a0 + a1) + (a2 + a3);
            if (c + 1 < 64) { LAS float* Pn = Pb + ((c + 1) & 1) * 4096; *(LAS f32x4*)(Pn + F.tid * 4) = pa; *(LAS f32x4*)(Pn + 2048 + F.tid * 4) = pq; }
            __syncthreads();
            scur = acc; ucur = unext;
        }
        F.outp()[O_WKVP + ((size_t)bh * 64 + r0 + r) * 64 + col] = scur;
    }
}
__device__ __forceinline__ void phase_scan3(Ctx& F) {
    const int gw = F.vcu * NWAVES + F.wave, NGW = F.G * NWAVES, lane = F.lane, q = lane >> 4, m = lane & 15;
    const float* SC = WSP(float, WS_SC); const float* Z = WSP(float, WS_Z); float* Y = WSP(float, WS_YC);
    for (int task = gw; task < NBATCH * HB * 63 * 4; task += NGW) {
        const int g = task & 3, cc = task >> 2, bh = cc / 63, c = 1 + (cc - bh * 63), ch = bh * 64 + c, h = bh & 15, b = bh >> 4, row = 16 * g + m;
        const float* st = SC + ((size_t)ch * 64 + row) * 64 + 16 * q; float s[16];
#pragma unroll
        for (int i = 0; i < 16; i += 4) { const f32x4 v = *(const GAS f32x4*)(st + i); s[i] = v.x; s[i + 1] = v.y; s[i + 2] = v.z; s[i + 3] = v.w; }
        const float* zp = Z + (size_t)ch * 4096 + lane; float* yp = Y + (size_t)(b * SEQ + c * 64) * 1024 + h * 64 + row;
        float zb[4];
#pragma unroll
        for (int u = 0; u < 4; ++u) zb[u] = zp[u * 64];
        for (int t = 0; t < 64; t += 4) {
#pragma unroll
            for (int u = 0; u < 4; ++u) {
                const float zv = zb[u]; if (t + u + 4 < 64) zb[u] = zp[(t + u + 4) * 64];
                float acc = 0.f; dot16(acc, zv, s); acc = xrow16_sum(acc);
                if (q == 0) yp[(size_t)(t + u) * 1024] = acc;
            }
        }
    }
}
__device__ __forceinline__ float sum32(float v) {
    v += dpp_f<0xB1>(v); v += dpp_f<0x4E>(v); v += dpp_f<0x141>(v); v += dpp_f<0x140>(v);
    auto s = __builtin_amdgcn_permlane16_swap(__float_as_uint(v), __float_as_uint(v), false, false);
    return __uint_as_float(s[0]) + __uint_as_float(s[1]);
}
__device__ __forceinline__ sba::bf16x8 ld8_bf16(const float* p) { const f32x4 a = *(const GAS f32x4*)p, b = *(const GAS f32x4*)(p + 4); return msc::pack8(a.x, a.y, a.z, a.w, b.x, b.y, b.z, b.w); }
__device__ __forceinline__ void comb_load(Ctx& F, size_t i, f32x4& a, f32x4& e, float& cl) {
    const size_t ic = i < (size_t)NPR * 256 ? i : (size_t)NPR * 256 - 1; const int r = (int)(ic >> 8), c4 = (int)(ic & 255) * 4, h = c4 >> 7;
    const float* OP = WSP(float, WS_OP);
    a = *(const GAS f32x4*)(OP + (size_t)r * 1024 + c4); e = *(const GAS f32x4*)(OP + ((size_t)NPR + r) * 1024 + c4); cl = WSP(float, WS_CL)[(size_t)r * HA + h];
}
__device__ __forceinline__ void comb_store(Ctx& F, size_t i, const f32x4& a, const f32x4& e, float cl) {
    if (i < (size_t)NPR * 256) { const int r = (int)(i >> 8), c4 = (int)(i & 255) * 4;
        const f32x4 o = a + e * cl; u32x2 w; w.x = cvt_pk_bf16(o.x, o.y); w.y = cvt_pk_bf16(o.z, o.w);
        *(GAS u32x2*)(WSP(bf16, WS_OAB) + (size_t)r * DM + c4) = w; }
}
__device__ __forceinline__ void phase_scan3_post(Ctx& F, size_t& ci, const size_t istr) {
    const int gw = F.vcu * NWAVES + F.wave, NGW = F.G * NWAVES, lane = F.lane, n = lane & 31, hi = lane >> 5;
    const float* SC = WSP(float, WS_SC); const float* Z = WSP(float, WS_Z); const float* Y = WSP(float, WS_Y); const bf16* LWH = WSP(bf16, WS_LWH); const bf16* PBH = WSP(bf16, WS_PBH);
    const float* SCL = WSP(float, WS_SCL); bf16* OAB = WSP(bf16, WS_OAB);
    for (int ch = gw; ch < NBATCH * HB * 64; ch += NGW) {
        const int bh = ch >> 6, c = ch & 63, h = bh & 15, b = bh >> 4, r0 = b * SEQ + c * 64, col0 = h * 64 + n;
        const float lg0 = F.in(I_LNG)[col0], lg1 = F.in(I_LNG)[col0 + 32], lb0 = F.in(I_LNB)[col0], lb1 = F.in(I_LNB)[col0 + 32], mv0 = F.in(I_MU)[2048 + col0], mv1 = F.in(I_MU)[2048 + col0 + 32];
        sba::bf16x8 sb0[4], sb1[4];
        if (c > 0) { const float* Sp = SC + (size_t)ch * 4096 + n * 64 + 8 * hi;
#pragma unroll
            for (int ks = 0; ks < 4; ++ks) { sb0[ks] = ld8_bf16(Sp + 16 * ks); sb1[ks] = ld8_bf16(Sp + 32 * 64 + 16 * ks); } }
        else {
#pragma unroll
            for (int ks = 0; ks < 4; ++ks) { sb0[ks] = sba::bf16x8{}; sb1[ks] = sba::bf16x8{}; } }
        for (int tt = 0; tt < 2; ++tt) {
            sba::f32x16 a0 = sba::f32x16{}, a1 = sba::f32x16{};
            if (c > 0) { const float* Zp = Z + (size_t)ch * 4096 + (32 * tt + n) * 64 + 8 * hi;
#pragma unroll
                for (int ks = 0; ks < 4; ++ks) { const sba::bf16x8 za = ld8_bf16(Zp + 16 * ks);
                    a0 = __builtin_amdgcn_mfma_f32_32x32x16_bf16(za, sb0[ks], a0, 0, 0, 0); a1 = __builtin_amdgcn_mfma_f32_32x32x16_bf16(za, sb1[ks], a1, 0, 0, 0); } }
#pragma unroll
            for (int rg = 0; rg < 16; rg += 4) {
                float y0[4], y1[4], g0[4], g1[4], p0[4], p1[4], q0[4], q1[4], bn[4];
                f32x4 ca0, ce0, ca1, ce1; float cc0, cc1; const size_t ci0 = ci, ci1 = ci + istr; ci += 2 * istr;
                comb_load(F, ci0, ca0, ce0, cc0); comb_load(F, ci1, ca1, ce1, cc1);
#pragma unroll
                for (int i = 0; i < 4; ++i) { const int t = 32 * tt + sba::crow(rg + i, hi), r = r0 + t;
                    y0[i] = Y[(size_t)r * 1024 + col0]; y1[i] = Y[(size_t)r * 1024 + col0 + 32];
                    g0[i] = ldbf(LWH + (size_t)r * 3072 + 2048 + col0); g1[i] = ldbf(LWH + (size_t)r * 3072 + 2048 + col0 + 32);
                    const bf16* pb = PBH + (size_t)r * 3072 + 2048 + col0; p0[i] = ldbf(pb); p1[i] = ldbf(pb + 32);
                    const bool hp = (r & (SEQ - 1)) != 0; q0[i] = hp ? ldbf(pb - 3072) : 0.f; q1[i] = hp ? ldbf(pb + 32 - 3072) : 0.f;
                    bn[i] = SCL[((size_t)r * HB + h) * 4 + 2]; }
#pragma unroll
                for (int i = 0; i < 4; ++i) { const int t = 32 * tt + sba::crow(rg + i, hi), r = r0 + t;
                    const float v0 = y0[i] + a0[rg + i], v1 = y1[i] + a1[rg + i];
                    const float mean = sum32(v0 + v1) * (1.f / 64.f), d0 = v0 - mean, d1 = v1 - mean, var = sum32(d0 * d0 + d1 * d1) * (1.f / 64.f), rs = rsqrtf(var + EPS_LNX);
                    const float zv0 = p0[i] + mv0 * (q0[i] - p0[i]), zv1 = p1[i] + mv1 * (q1[i] - p1[i]);
                    const float o0 = (d0 * rs * lg0 + lb0 + bn[i] * zv0) * g0[i], o1 = (d1 * rs * lg1 + lb1 + bn[i] * zv1) * g1[i];
                    const float o0n = dpp_f<0xB1>(o0), o1n = dpp_f<0xB1>(o1);
                    if ((lane & 1) == 0) { *(GAS unsigned*)(OAB + (size_t)r * DM + 1024 + col0) = cvt_pk_bf16(o0, o0n); *(GAS unsigned*)(OAB + (size_t)r * DM + 1024 + col0 + 32) = cvt_pk_bf16(o1, o1n); } }
                comb_store(F, ci0, ca0, ce0, cc0); comb_store(F, ci1, ca1, ce1, cc1);
            }
        }
    }
}
__device__ __forceinline__ void phase_postscan(Ctx& F, size_t ci, const size_t istr) {
    const int gw = F.vcu * NWAVES + F.wave, NGW = F.G * NWAVES;
    const float* Y = WSP(float, WS_Y); const float* RWV = WSP(float, WS_RWV); const float* SCL = WSP(float, WS_SCL); const float* LWO = WSP(float, WS_LWO); const float* Pp = WSP(float, WS_P); bf16* OAB = WSP(bf16, WS_OAB);
    for (int u = NPR * 4 + gw; u < NTOK * 4; u += NGW) {
        const int r = u >> 2, hq = u & 3; const bool corr = false;
        float yv[4], gv[4], vv[4], bn[4];
#pragma unroll
        for (int i = 0; i < 4; ++i) { const int h = hq * 4 + i, col = h * 64 + F.lane;
            yv[i] = Y[(size_t)r * 1024 + col]; if (corr) yv[i] += WSP(float, WS_YC)[(size_t)r * 1024 + col];
            gv[i] = LWO[(size_t)r * 3072 + 2048 + col]; bn[i] = SCL[((size_t)r * HB + h) * 4 + 2];
            vv[i] = RWV[((size_t)r * HB + h) * 512 + 320 + F.lane]; }
#pragma unroll
        for (int i = 0; i < 4; ++i) { const int h = hq * 4 + i, col = h * 64 + F.lane;
            const float mean = wave_sum(yv[i]) * (1.f / 64.f), d = yv[i] - mean, var = wave_sum(d * d) * (1.f / 64.f);
            const float yn = d * rsqrtf(var + EPS_LNX) * F.in(I_LNG)[col] + F.in(I_LNB)[col] + bn[i] * vv[i];
            const float o = yn * gv[i];
            const float o1 = dpp_f<0xB1>(o);
            if ((F.lane & 1) == 0) *(GAS unsigned*)(OAB + (size_t)r * DM + 1024 + col) = cvt_pk_bf16(o, o1); }
    }
    sample_combine(F);
    const float* OP = WSP(float, WS_OP); const float* CL = WSP(float, WS_CL);
    for (size_t i = ci; i < (size_t)NPR * 256; i += istr) {
        const int r = (int)(i >> 8), c4 = (int)(i & 255) * 4, h = c4 >> 7;
        const f32x4 a = *(const GAS f32x4*)(OP + (size_t)r * 1024 + c4), e = *(const GAS f32x4*)(OP + ((size_t)NPR + r) * 1024 + c4); const float cl = CL[(size_t)r * HA + h];
        const f32x4 o = a + e * cl; u32x2 w; w.x = cvt_pk_bf16(o.x, o.y); w.y = cvt_pk_bf16(o.z, o.w);
        *(GAS u32x2*)(OAB + (size_t)r * DM + c4) = w;
    }
}
__device__ __forceinline__ void phase_usample(Ctx& F) {
    const float* PU_ = WSP(float, WS_PARTU); bf16* U = WSP(bf16, WS_U);
    for (int i = F.vcu * NTHR + F.tid; i < NSM * DFF / 4; i += F.G * NTHR) { const int r = i / (DFF / 4), c4 = (i - r * (DFF / 4)) * 4;
        f32x4 a = *(const GAS f32x4*)(PU_ + (size_t)r * DFF + c4);
#pragma unroll
        for (int kc = 1; kc < 8; ++kc) a += *(const GAS f32x4*)(PU_ + ((size_t)kc * 64 + r) * DFF + c4);
        const float x0 = fmaxf(a.x, 0.f), x1 = fmaxf(a.y, 0.f), x2 = fmaxf(a.z, 0.f), x3 = fmaxf(a.w, 0.f);
        u32x2 w; w.x = cvt_pk_bf16(x0 * x0, x1 * x1); w.y = cvt_pk_bf16(x2 * x2, x3 * x3);
        *(GAS u32x2*)(U + (size_t)(NPR + r) * DFF + c4) = w; }
}
#ifndef MK_SPLIT
#define MK_SPLIT 0
#endif
constexpr int NPHASE = 21;
struct Args { const void* in[N_IN]; float* out; unsigned char* ws; int ph_lo, ph_hi; };
__global__ void __launch_bounds__(NTHR, 2) mega_fwd(Args args) {
    extern __shared__ __attribute__((aligned(16))) unsigned char lds_raw[];
    Ctx F;
    F.lds = (LAS unsigned char*)lds_raw; F.tid = threadIdx.x; F.lane = F.tid & 63; F.wave = __builtin_amdgcn_readfirstlane(F.tid >> 6);
    F.G = gridDim.x; { const int bx = blockIdx.x; F.vcu = (F.G % 8 == 0) ? (bx % 8) * (F.G / 8) + bx / 8 : bx; }
    for (int u = F.tid; u < (LDS_BYTES - LDSCTL_OFF) / 4; u += NTHR) ((LAS unsigned*)(F.lds + LDSCTL_OFF))[u] = 0u;
    __syncthreads();
    unsigned* ctl = (unsigned*)(args.ws + WS_CTL);
    XcdBarrier bar; bar.bar = ctl + CW_BAR; bar.x = 0; bar.st = nullptr;
    if (!MK_SPLIT) bar = xcd_barrier_post(ctl + CW_BAR, (volatile LAS unsigned*)(F.lds + MISC_OFF) + 8);
    const int lo = args.ph_lo, hi = args.ph_hi;
#define IN(k) (lo <= (k) && (k) < hi)
#define SEAM(k) do { if (IN(k) && IN((k) + 1)) xcd_barrier(bar); } while (0)
    if (IN(0)) { phase_prologue(F); } SEAM(0);
    if (IN(1)) { phase_mod0(F); } SEAM(1);
    if (IN(2)) { const bool hide = F.G > NCVT + 8; const int ng = hide ? F.G - NCVT : F.G;
        if ((int)blockIdx.x < ng) { pg8::Gemm g{WSP(bf16, WS_H), WSP(bf16, WS_WIN), MP, INPAD, DM, DM, DM}; pg8::StaticOrder S; S.init(MP, INPAD, ng, (int)blockIdx.x); EpiIn E{WSP(bf16, WS_QB), WSP(bf16, WS_KB), WSP(bf16, WS_VB), WSP(float, WS_P), F.outp(), WSP(bf16, WS_PBH)};
            pg8::gemm_phase<EpiIn, pg8::StaticOrder, true, true>(F.lds, g, S, E); }
        else convert_run(F, IT_IN + ((int)blockIdx.x - ng) * NWAVES + F.wave, NCVT * NWAVES, IT_IN + N_HIDE, (LAS float*)(F.lds + F.wave * 16384)); } SEAM(2);
    if (IN(3)) { phase_kv_prep(F); } SEAM(3);
    if (IN(4)) { pg8::Gemm g{WSP(bf16, WS_LA), WSP(bf16, WS_LWT), MP, 3072, 512, 512, 512}; pg8::LoraOrder S; S.init(MP, 3072, F.G, (int)blockIdx.x); pg8::EpiLora E{WSP(float, WS_LWO), WSP(bf16, WS_LWH), 3072};
        pg8::gemm_phase<pg8::EpiLora, pg8::LoraOrder, true, true>(F.lds, g, S, E); } SEAM(4);
    if (IN(6)) { phase_rwkv_prep(F);
        const int rot = F.vcu % 3;
        if (rot == 0)      { phase_sample_stream(F); __syncthreads(); phase_attn_prompt(F); __syncthreads(); phase_scan1_mfma(F); }
        else if (rot == 1) { phase_attn_prompt(F); __syncthreads(); phase_scan1_mfma(F); __syncthreads(); phase_sample_stream(F); }
        else               { phase_scan1_mfma(F); __syncthreads(); phase_sample_stream(F); __syncthreads(); phase_attn_prompt(F); } } SEAM(7);
    if (IN(8)) {
        if (F.wave < 2) for (int t = F.vcu * 2 + F.wave; t < DBAT * HB * 4; t += 2 * F.G) scan_wave<false, true>(F, t >> 2, 0, t & 3);
        phase_scan2(F); } SEAM(8);
    if (IN(10)) { size_t ci = (size_t)F.vcu * NTHR + F.tid; const size_t istr = (size_t)F.G * NTHR; phase_scan3_post(F, ci, istr); phase_postscan(F, ci, istr); } SEAM(10);
    if (IN(11)) { pg8::Gemm g{WSP(bf16, WS_OAB), WSP(bf16, WS_WOUT), MP, DM, DM, DM, DM}; pg8::MixOrder<false> S; S.init(DM, DM, F.G, (int)blockIdx.x); pg8::EpiF32S<64> E{WSP(bf16, WS_OUT), DM, nullptr, WSP(float, WS_PART)};
        pg8::gemm_phase<pg8::EpiF32S<64>, pg8::MixOrder<false>, true, true>(F.lds, g, S, E); } SEAM(11);
    if (IN(12)) { phase_postmix<0>(F); } SEAM(12);
    if (IN(13)) { pg8::Gemm g{WSP(bf16, WS_H), WSP(bf16, WS_W1), MP, DFF, DM, DM, DM}; pg8::MixOrder<false> S; S.init(DFF, DM, F.G, (int)blockIdx.x); pg8::EpiRelu2 E{WSP(bf16, WS_U), DFF, WSP(float, WS_PARTU)};
        pg8::gemm_phase<pg8::EpiRelu2, pg8::MixOrder<false>, true, true>(F.lds, g, S, E); } SEAM(13);
    if (IN(14)) { phase_usample(F); if (!MK_SPLIT) xcd_barrier(bar); pg8::Gemm g{WSP(bf16, WS_U), WSP(bf16, WS_W2), MP, DM, DFF, DFF, DFF}; pg8::MixOrder<false> S; S.init(DM, DFF, F.G, (int)blockIdx.x); pg8::EpiF32S<64> E{WSP(bf16, WS_OUT), DM, nullptr, WSP(float, WS_PART)};
        pg8::gemm_phase<pg8::EpiF32S<64>, pg8::MixOrder<false>, true, true>(F.lds, g, S, E); } SEAM(14);
    if (IN(15)) { phase_postmlp<0>(F); } SEAM(15);
    if (IN(16)) { pg8::Gemm g{WSP(bf16, WS_H), WSP(bf16, WS_WPOOL), MP, DM, DM, DM, DM}; pg8::MixOrder<true> S; S.init(DM, DM, F.G, (int)blockIdx.x); pg8::EpiF32S<256> E{WSP(bf16, WS_OUT), DM, F.in(I_PSC), WSP(float, WS_PART)};
        pg8::gemm_phase<pg8::EpiF32S<256>, pg8::MixOrder<true>, true, true>(F.lds, g, S, E); } SEAM(16);
    if (IN(17)) { phase_postmix<1>(F); } SEAM(17);
    if (IN(18)) { pg8::Gemm g{WSP(bf16, WS_H), WSP(bf16, WS_W1) + (size_t)DFF * DM, MP, DFF, DM, DM, DM}; pg8::MixOrder<false> S; S.init(DFF, DM, F.G, (int)blockIdx.x); pg8::EpiRelu2 E{WSP(bf16, WS_U), DFF, WSP(float, WS_PARTU)};
        pg8::gemm_phase<pg8::EpiRelu2, pg8::MixOrder<false>, true, true>(F.lds, g, S, E); } SEAM(18);
    if (IN(19)) { phase_usample(F); if (!MK_SPLIT) xcd_barrier(bar); pg8::Gemm g{WSP(bf16, WS_U), WSP(bf16, WS_W2) + (size_t)DM * DFF, MP, DM, DFF, DFF, DFF}; pg8::MixOrder<false> S; S.init(DM, DFF, F.G, (int)blockIdx.x); pg8::EpiF32S<64> E{WSP(bf16, WS_OUT), DM, nullptr, WSP(float, WS_PART)};
        pg8::gemm_phase<pg8::EpiF32S<64>, pg8::MixOrder<false>, true, true>(F.lds, g, S, E); } SEAM(19);
    if (IN(20)) { phase_postmlp<1>(F); }
#undef IN
#undef SEAM
}

extern "C" void kernel_launch(void* const* d_in, const int* in_sizes, int n_in, void* d_out, int out_size, void* d_ws, size_t ws_size, hipStream_t stream) {
    static int grid = 0;
    if (grid == 0) {
        if (n_in != N_IN || (size_t)out_size != O_END || ws_size < WS_END) { fprintf(stderr, "kernel_launch: unexpected shapes: n_in %d out %d ws %zu (want %d, %zu, >= %zu)\n", n_in, out_size, ws_size, (int)N_IN, (size_t)O_END, (size_t)WS_END); grid = -1; return; }
        int dev = 0, cus = 0, per_cu = 0;
        if (hipGetDevice(&dev) != hipSuccess || hipDeviceGetAttribute(&cus, hipDeviceAttributeMultiprocessorCount, dev) != hipSuccess) { grid = -1; return; }
        if (hipFuncSetAttribute((const void*)mega_fwd, hipFuncAttributeMaxDynamicSharedMemorySize, LDS_BYTES) != hipSuccess) { fprintf(stderr, "kernel_launch: hipFuncSetAttribute failed\n"); grid = -1; return; }
        if (hipOccupancyMaxActiveBlocksPerMultiprocessor(&per_cu, (const void*)mega_fwd, NTHR, LDS_BYTES) != hipSuccess || per_cu < 1) fprintf(stderr, "kernel_launch: occupancy query reports %d blocks per CU\n", per_cu);
        (void)hipGetLastError();
        grid = cus;
    }
    if (grid < 0) return;
    hipMemsetAsync((char*)d_ws + WS_CTL, 0, CTL_ZERO_BYTES, stream);
    Args a{};
    for (int i = 0; i < N_IN; ++i) a.in[i] = d_in[i];
    a.out = (float*)d_out; a.ws = (unsigned char*)d_ws;
#if MK_SPLIT
    for (int p = 0; p < NPHASE; ++p) { a.ph_lo = p; a.ph_hi = p + 1; hipLaunchKernelGGL(mega_fwd, dim3(grid), dim3(NTHR), LDS_BYTES, stream, a); }
#else
    a.ph_lo = 0; a.ph_hi = NPHASE;
    hipLaunchKernelGGL(mega_fwd, dim3(grid), dim3(NTHR), LDS_BYTES, stream, a);
#endif
    const hipError_t le = hipPeekAtLastError();
    if (le != hipSuccess) fprintf(stderr, "kernel_launch: launch failed: %s\n", hipGetErrorName(le));
}
```
